# Optimizing an MI355X kernel written in HIP

```python
import math
import jax, jax.numpy as jnp
from jax import lax
import numpy as np

D_MODEL = 1024
BATCH = 32
SEQ = 2048
DEPTH = 2

HEAD_DIM = 64
SWA_Q_HEADS = 8
SWA_KV_HEADS = 2
WINDOW = 128
DSA_Q_HEADS = 8
DSA_KV_HEADS = 2
IDX_HEADS = 8
IDX_DIM = 32
TOPK_MAX = 256
QBLOCK = 128
CHUNK = 128
SG_GROUPS = 8
SG_DIM = 64
N_EXPERTS = 32
TOP_K = 4
D_FF = D_MODEL
SWIGLU_LIMIT = 7.0
SWIGLU_ALPHA = 1.702
EXPERT_BLOCK = 512
RMS_EPS = 1e-5
LN_EPS = 1e-5
N_BRANCHES = 3

SWA_Q_W = SWA_Q_HEADS * HEAD_DIM
SWA_KV_W = SWA_KV_HEADS * HEAD_DIM
DSA_Q_W = DSA_Q_HEADS * HEAD_DIM
DSA_KV_W = DSA_KV_HEADS * HEAD_DIM
SG_W = SG_GROUPS * SG_DIM
BRANCH_W = SWA_Q_W
IN_SIZES = (SWA_Q_W, SWA_KV_W, SWA_KV_W, DSA_Q_W, DSA_KV_W, DSA_KV_W,
            IDX_HEADS * IDX_DIM, IDX_DIM, IDX_HEADS, SG_W, SG_W, N_BRANCHES * D_MODEL)
IN_WIDTH = sum(IN_SIZES)

kernel_name = "hybrid_swa_dsa_gmlp_moe_block"


def rmsnorm(x, g):
    x32 = x.astype(jnp.float32)
    y = x32 * lax.rsqrt(jnp.mean(x32 * x32, axis=-1, keepdims=True) + RMS_EPS)
    return y.astype(x.dtype) * g


def layernorm(x, g):
    x32 = x.astype(jnp.float32)
    xc = x32 - jnp.mean(x32, axis=-1, keepdims=True)
    y = xc * lax.rsqrt(jnp.mean(xc * xc, axis=-1, keepdims=True) + LN_EPS)
    return y.astype(x.dtype) * g


def swa_attention(q, k, v, sinks):
    b, t, hq, hd = q.shape
    hkv = k.shape[2]
    g = hq // hkv
    nb = t // WINDOW
    qb = q.reshape(b, nb, WINDOW, hkv, g, hd)
    kb = k.reshape(b, nb, WINDOW, hkv, hd)
    vb = v.reshape(b, nb, WINDOW, hkv, hd)
    pad = ((0, 0), (1, 0), (0, 0), (0, 0), (0, 0))
    kk = jnp.concatenate([jnp.pad(kb, pad)[:, :-1], kb], axis=2)
    vv = jnp.concatenate([jnp.pad(vb, pad)[:, :-1], vb], axis=2)
    s = jnp.einsum('bnqkgd,bnskd->bnkgqs', qb, kk).astype(jnp.float32) * (hd ** -0.5)
    i = jnp.arange(WINDOW)[:, None]
    j = jnp.arange(2 * WINDOW)[None, :]
    band = (j > i) & (j <= i + WINDOW)
    blk = jnp.arange(nb)[:, None, None]
    mask = band[None] & ((blk > 0) | (j >= WINDOW)[None])
    s = jnp.where(mask[None, :, None, None], s, -jnp.inf)
    sink = sinks.astype(jnp.float32).reshape(hkv, g)[None, None, :, :, None, None]
    m = jnp.maximum(jnp.max(s, axis=-1, keepdims=True), sink)
    p = jnp.exp(s - m)
    p = p / (jnp.sum(p, axis=-1, keepdims=True) + jnp.exp(sink - m))
    o = jnp.einsum('bnkgqs,bnskd->bnqkgd', p.astype(v.dtype), vv)
    return o.reshape(b, t, hq * hd)


def dsa_attention(q, k, v, qi, ki, wi):
    b, t, hq, hd = q.shape
    hkv = k.shape[2]
    g = hq // hkv
    topk = min(TOPK_MAX, t // 4)
    nq = t // QBLOCK
    key_pos = jnp.arange(t)
    bidx = jnp.arange(b)[:, None, None]
    w_scale = (IDX_DIM ** -0.5) * (IDX_HEADS ** -0.5)

    def block(args):
        qb, qib, wib, pos = args
        dots = jnp.einsum('bqhd,bsd->bqhs', qib, ki)
        iscore = jnp.einsum('bqh,bqhs->bqs', wib * w_scale, jax.nn.relu(dots)).astype(jnp.float32)
        causal = key_pos[None, :] <= pos[:, None]
        iscore = jnp.where(causal[None], iscore, -jnp.inf)
        _, sel = lax.top_k(iscore, topk)
        valid = sel <= pos[None, :, None]
        ks = k[bidx, sel]
        vs = v[bidx, sel]
        qg = qb.reshape(b, QBLOCK, hkv, g, hd)
        s = jnp.einsum('bqkgd,bqnkd->bkgqn', qg, ks).astype(jnp.float32) * (hd ** -0.5)
        s = jnp.where(valid[:, None, None], s, -jnp.inf)
        p = jax.nn.softmax(s, axis=-1)
        o = jnp.einsum('bkgqn,bqnkd->bqkgd', p.astype(v.dtype), vs)
        return o.reshape(b, QBLOCK, hq * hd)

    def to_blocks(a):
        return jnp.moveaxis(a.reshape((b, nq, QBLOCK) + a.shape[2:]), 1, 0)

    pos = jnp.arange(t).reshape(nq, QBLOCK)
    out = lax.map(block, (to_blocks(q), to_blocks(qi), to_blocks(wi), pos))
    return jnp.moveaxis(out, 0, 1).reshape(b, t, hq * hd)


def spatial_gating(u, v, sg_w, sg_b, sg_ln_g):
    b, t, _ = u.shape
    nc = t // CHUNK
    v = layernorm(v, sg_ln_g)
    vc = v.reshape(b, nc, CHUNK, SG_GROUPS, SG_DIM)
    w = sg_w * jnp.tril(jnp.ones((CHUNK, CHUNK), sg_w.dtype))[None]
    mixed = jnp.einsum('gts,bnsgd->bntgd', w, vc) + sg_b.T[None, None, :, :, None]
    return u * mixed.reshape(b, t, SG_W)


def token_mixer(h, w_in, sinks, sg_w, sg_b, sg_ln_g, w_branch, w_out):
    b, t, d = h.shape
    proj = h @ w_in
    cuts = np.cumsum(np.array(IN_SIZES))[:-1].tolist()
    qa, ka, va, qb, kb, vb, qi, ki, wi, u, v, gates = jnp.split(proj, cuts, axis=-1)
    o_a = swa_attention(qa.reshape(b, t, SWA_Q_HEADS, HEAD_DIM),
                        ka.reshape(b, t, SWA_KV_HEADS, HEAD_DIM),
                        va.reshape(b, t, SWA_KV_HEADS, HEAD_DIM), sinks)
    o_b = dsa_attention(qb.reshape(b, t, DSA_Q_HEADS, HEAD_DIM),
                        kb.reshape(b, t, DSA_KV_HEADS, HEAD_DIM),
                        vb.reshape(b, t, DSA_KV_HEADS, HEAD_DIM),
                        qi.reshape(b, t, IDX_HEADS, IDX_DIM), ki, wi)
    o_c = spatial_gating(jax.nn.gelu(u), jax.nn.gelu(v), sg_w, sg_b, sg_ln_g)
    gt = jax.nn.sigmoid(gates.reshape(b, t, N_BRANCHES, d))
    merged = (gt[:, :, 0] * (o_a @ w_branch[0])
              + gt[:, :, 1] * (o_b @ w_branch[1])
              + gt[:, :, 2] * (o_c @ w_branch[2]))
    return merged @ w_out


def moe(h, w_router, b_router, w1, b1, w2, b2):
    b, t, d = h.shape
    hf = h.reshape(-1, d)
    n = hf.shape[0]
    logits = (hf @ w_router + b_router).astype(jnp.float32)
    top_logit, top_e = lax.top_k(logits, TOP_K)
    top_w = jax.nn.softmax(top_logit, axis=-1)
    n_slots = n * TOP_K
    flat_e = top_e.reshape(-1)
    flat_tok = jnp.arange(n_slots, dtype=jnp.int32) // TOP_K
    flat_w = top_w.reshape(-1)
    order = jnp.argsort(flat_e)
    sorted_e = flat_e[order]
    counts = jnp.bincount(flat_e, length=N_EXPERTS)
    padded = (counts + EXPERT_BLOCK - 1) // EXPERT_BLOCK * EXPERT_BLOCK
    pad_end = jnp.cumsum(padded)
    pad_start = pad_end - padded
    start = jnp.cumsum(counts) - counts
    dest = pad_start[sorted_e] + jnp.arange(n_slots) - start[sorted_e]
    n_rows = (-(-n_slots // EXPERT_BLOCK) + N_EXPERTS) * EXPERT_BLOCK
    n_blocks = n_rows // EXPERT_BLOCK
    row_tok = jnp.zeros((n_rows,), jnp.int32).at[dest].set(flat_tok[order])
    row_w = jnp.zeros((n_rows,), jnp.float32).at[dest].set(flat_w[order])
    block_e = jnp.clip(jnp.searchsorted(pad_end, jnp.arange(n_blocks) * EXPERT_BLOCK, side='right'),
                       0, N_EXPERTS - 1)

    def step(acc, args):
        tok, e, wr = args
        xb = hf[tok]
        hid = xb @ w1[e] + b1[e]
        glu = jnp.minimum(hid[:, 0::2], SWIGLU_LIMIT)
        lin = jnp.clip(hid[:, 1::2], -SWIGLU_LIMIT, SWIGLU_LIMIT)
        act = glu * jax.nn.sigmoid(SWIGLU_ALPHA * glu) * (lin + 1)
        y = act @ w2[e] + b2[e]
        return acc.at[tok].add(y * wr[:, None].astype(y.dtype)), None

    out, _ = lax.scan(step, jnp.zeros_like(hf),
                      (row_tok.reshape(n_blocks, EXPERT_BLOCK), block_e,
                       row_w.reshape(n_blocks, EXPERT_BLOCK)))
    return out.reshape(b, t, d)


def setup_inputs(seed: int = 0) -> dict:
    key = jax.random.key(seed)
    ks = jax.random.split(key, 24)

    def nrm(k, shape, scale):
        return jax.random.normal(k, shape, jnp.float32) * scale

    L, D, E, F = DEPTH, D_MODEL, N_EXPERTS, D_FF
    return {
        "x": nrm(ks[0], (BATCH, SEQ, D), 1.0),
        "c": nrm(ks[1], (BATCH, D), 1.0),
        "w_ada": nrm(ks[2], (L, D, 6 * D), 0.5 * D ** -0.5),
        "b_ada": nrm(ks[3], (L, 6 * D), 0.02),
        "g_pre_mix": 1.0 + nrm(ks[4], (L, D), 0.05),
        "g_post_mix": 1.0 + nrm(ks[5], (L, D), 0.05),
        "g_pre_ffn": 1.0 + nrm(ks[6], (L, D), 0.05),
        "g_post_ffn": 1.0 + nrm(ks[7], (L, D), 0.05),
        "w_in": nrm(ks[8], (L, D, IN_WIDTH), D ** -0.5),
        "sinks": nrm(ks[9], (L, SWA_Q_HEADS), 0.5),
        "sg_w": nrm(ks[10], (L, SG_GROUPS, CHUNK, CHUNK), CHUNK ** -0.5),
        "sg_b": 1.0 + nrm(ks[11], (L, SG_GROUPS, CHUNK), 0.1),
        "sg_ln_g": 1.0 + nrm(ks[12], (L, SG_W), 0.05),
        "w_branch": nrm(ks[13], (L, N_BRANCHES, BRANCH_W, D), BRANCH_W ** -0.5),
        "w_out": nrm(ks[14], (L, D, D), D ** -0.5),
        "w_router": nrm(ks[15], (L, D, E), D ** -0.5),
        "b_router": nrm(ks[16], (L, E), 0.01),
        "w1": nrm(ks[17], (L, E, D, 2 * F), D ** -0.5),
        "b1": nrm(ks[18], (L, E, 2 * F), 0.01),
        "w2": nrm(ks[19], (L, E, F, D), F ** -0.5),
        "b2": nrm(ks[20], (L, E, D), 0.01),
    }


def reference(x, c, w_ada, b_ada, g_pre_mix, g_post_mix, g_pre_ffn, g_post_ffn, w_in, sinks,
              sg_w, sg_b, sg_ln_g, w_branch, w_out, w_router, b_router, w1, b1, w2, b2):
    cs = jax.nn.silu(c)
    for l in range(DEPTH):
        mod = cs @ w_ada[l] + b_ada[l]
        sh1, sc1, ga1, sh2, sc2, ga2 = jnp.split(mod[:, None, :], 6, axis=-1)
        h = rmsnorm(x, g_pre_mix[l]) * (1 + sc1) + sh1
        y = token_mixer(h, w_in[l], sinks[l], sg_w[l], sg_b[l], sg_ln_g[l], w_branch[l], w_out[l])
        x = x + ga1 * rmsnorm(y, g_post_mix[l])
        h = rmsnorm(x, g_pre_ffn[l]) * (1 + sc2) + sh2
        y = moe(h, w_router[l], b_router[l], w1[l], b1[l], w2[l], b2[l])
        x = x + ga2 * rmsnorm(y, g_post_ffn[l])
    return x
```

```cpp
#include <hip/hip_runtime.h>
#include <cstdio>
#include <cstdint>

#define LAS __attribute__((address_space(3)))
#define GAS __attribute__((address_space(1)))
typedef unsigned short bf16_t;
typedef short bf16x8 __attribute__((ext_vector_type(8)));
typedef float f32x2 __attribute__((ext_vector_type(2)));
typedef float f32x4 __attribute__((ext_vector_type(4)));
typedef float f32x16 __attribute__((ext_vector_type(16)));
typedef unsigned u32x2 __attribute__((ext_vector_type(2)));
typedef unsigned u32x4 __attribute__((ext_vector_type(4)));
typedef short v4i16_t __attribute__((ext_vector_type(4)));

constexpr int BATCH = 32, SEQ = 2048, DM = 1024, MTOK = BATCH * SEQ, DEPTH = 2;
constexpr int NPROJ = 6144;
constexpr int C_QA = 0, C_KA = 512, C_VA = 640, C_QB = 768, C_KB = 1280, C_VB = 1408, C_QI = 1536, C_KI = 1792, C_WI = 1824, C_U = 2048, C_V = 2560, C_G = 3072;
constexpr int NE = 32, FF = 1024;
constexpr float RMS_EPS = 1e-5f, LN_EPS = 1e-5f;
constexpr float LOG2E = 1.4426950408889634f;
constexpr float QSCALE = 0.125f * LOG2E;

__device__ __forceinline__ unsigned f2bf(float f) { unsigned u = __builtin_bit_cast(unsigned, f); return (u + 0x7fffu + ((u >> 16) & 1u)) >> 16; }
__device__ __forceinline__ unsigned cvt_pk_bf16(float lo, float hi) { unsigned r; asm volatile("v_cvt_pk_bf16_f32 %0, %1, %2" : "=v"(r) : "v"(lo), "v"(hi)); return r; }
__device__ __forceinline__ float bf_lo(unsigned w) { return __builtin_bit_cast(float, w << 16); }
__device__ __forceinline__ float bf_hi(unsigned w) { return __builtin_bit_cast(float, w & 0xffff0000u); }
__device__ __forceinline__ float fexp2(float x) { return __builtin_amdgcn_exp2f(x); }
__device__ __forceinline__ float frcp(float x) { return __builtin_amdgcn_rcpf(x); }
__device__ __forceinline__ float sigmoidf_(float x) { return frcp(1.f + fexp2(-LOG2E * x)); }
__device__ __forceinline__ float gelu_tanh(float x) { const float t = x + 0.044715f * x * x * x; return x * frcp(1.f + fexp2(-2.302208198f * t)); }
__device__ __forceinline__ float wave_sum(float v) {
#pragma unroll
    for (int o = 1; o < 64; o <<= 1) v += __shfl_xor(v, o);
    return v;
}
__device__ __forceinline__ unsigned wave_sum_u32(unsigned v) {
    v += (unsigned)__builtin_amdgcn_update_dpp(0, (int)v, 0xB1, 0xF, 0xF, false);
    v += (unsigned)__builtin_amdgcn_update_dpp(0, (int)v, 0x4E, 0xF, 0xF, false);
    v += (unsigned)__builtin_amdgcn_update_dpp(0, (int)v, 0x141, 0xF, 0xF, false);
    v += (unsigned)__builtin_amdgcn_update_dpp(0, (int)v, 0x140, 0xF, 0xF, false);
    return __builtin_amdgcn_readlane(v, 0) + __builtin_amdgcn_readlane(v, 16) + __builtin_amdgcn_readlane(v, 32) + __builtin_amdgcn_readlane(v, 48);
}
__device__ __forceinline__ unsigned wave_max_u32(unsigned v) {
    unsigned t;
    t = (unsigned)__builtin_amdgcn_update_dpp(0, (int)v, 0xB1, 0xF, 0xF, false); v = v > t ? v : t;
    t = (unsigned)__builtin_amdgcn_update_dpp(0, (int)v, 0x4E, 0xF, 0xF, false); v = v > t ? v : t;
    t = (unsigned)__builtin_amdgcn_update_dpp(0, (int)v, 0x141, 0xF, 0xF, false); v = v > t ? v : t;
    t = (unsigned)__builtin_amdgcn_update_dpp(0, (int)v, 0x140, 0xF, 0xF, false); v = v > t ? v : t;
    unsigned a = __builtin_amdgcn_readlane(v, 0), b = __builtin_amdgcn_readlane(v, 16), c = __builtin_amdgcn_readlane(v, 32), d = __builtin_amdgcn_readlane(v, 48);
    a = a > b ? a : b; c = c > d ? c : d; return a > c ? a : c;
}
#define LDS_WAIT() asm volatile("s_waitcnt lgkmcnt(0)" ::: "memory")
#define VM_WAIT() asm volatile("s_waitcnt vmcnt(0)" ::: "memory")

namespace pg8 {
constexpr int BM = 256, BK = 64, HALF = 128, HTB = HALF * BK * 2  , STAGE_BYTES = 8 * HTB, NXCD = 8, WGM = 8;
__host__ __device__ __forceinline__ int lds_byte(int r, int c) { const int st = (r >> 4) * 2 + (c >> 5), rr = r & 15, cc = c & 31, ob = rr * 64 + cc * 2; return st * 1024 + (ob ^ (((ob >> 9) & 1) << 5)); }
__host__ __device__ __forceinline__ void stage_rc(int b, int& R, int& C) { const int st = b / 1024, sb = b % 1024, swz = sb ^ (((sb >> 9) & 1) << 5); R = (st >> 1) * 16 + swz / 64; C = (st & 1) * 32 + (swz % 64) / 2; }
__host__ __device__ __forceinline__ int perm32(int rho) { const int n = rho >> 4, i = rho & 15; return 8 * (i >> 2) + 4 * n + (i & 3); }

struct Unit { int pm, pn; };
struct Gemm { const bf16_t* A; const bf16_t* Bt; int K; };

struct StaticOrder {
    int nM, nN, nwg, G, c;
    __device__ void init(int nM_, int nN_, int G_, int c_) { nM = nM_; nN = nN_; nwg = nM * nN; G = G_; c = c_; }
    __device__ __forceinline__ bool tile(int i, int& pm, int& pn) const {
        const long L = (long)i * G + c; if (L >= nwg) return false;
        int wgid = (int)L; { const int q = nwg / NXCD, r = nwg % NXCD, xcd = wgid % NXCD, off = wgid / NXCD; wgid = (xcd < r ? xcd * (q + 1) : r * (q + 1) + (xcd - r) * q) + off; }
        const int nig = WGM * nN, gid = wgid / nig, fm = gid * WGM, gsz = (nM - fm) < WGM ? (nM - fm) : WGM;
        pm = fm + ((wgid % nig) % gsz); pn = (wgid % nig) / gsz; return true;
    }
    __device__ __forceinline__ bool next(int i, Unit& u) const { return tile(i, u.pm, u.pn); }
};

template <class Epi, class Sched, bool GATHER>
__device__ __forceinline__ void gemm_phase(LAS unsigned char* lds, const Gemm g, const Sched& S, const Epi& E) {
    int tid = threadIdx.x; asm volatile("" : "+v"(tid));
    const int wid = __builtin_amdgcn_readfirstlane(tid >> 6), lane = tid & 63, wr = wid >> 2, wc = wid & 3, fr = lane & 15, fq = lane >> 4;
    const int K = g.K, nt = K / BK;
    unsigned voffA[2], voffB[2]; int RA[2], CA[2];
#pragma unroll
    for (int i = 0; i < 2; ++i) { int R, C; stage_rc(tid * 16 + i * 8192, R, C); const int Rb = (R & ~31) + perm32(R & 31); RA[i] = R; CA[i] = C;
        voffA[i] = (unsigned)(R * K + C) * 2u; voffB[i] = (unsigned)(Rb * K + C) * 2u; }
    const size_t kstep = (size_t)(BK * 2);
    const size_t hstep = (size_t)HALF * K * 2;
    const size_t tstep = 2 * hstep;
    const unsigned ldsw = (unsigned)wid * 1024u;
    const int aoff = lds_byte(wr * 64 + fr, fq * 8), boff = lds_byte(wc * 32 + fr, fq * 8);
#define PG8_SA(b, h) (((b) * 2 + (h)) * HTB)
#define PG8_SB(b, h) ((4 + (b) * 2 + (h)) * HTB)
#define PG8_STAGE(bufoff, gbase, voff) do { _Pragma("unroll") for (int _i = 0; _i < 2; ++_i) \
        __builtin_amdgcn_global_load_lds((const unsigned*)((const char*)(gbase) + (voff)[_i]), (LAS unsigned*)(lds + (bufoff) + ldsw + _i * 8192), 16, 0, 0); } while (0)
#define PG8_STAGE_A(bufoff, h, ubase, koff, VO) do { if constexpr (GATHER) { PG8_STAGE(bufoff, (const char*)g.A + (koff), VO[h]); } else { PG8_STAGE(bufoff, (ubase) + (h) * hstep + (koff), voffA); } } while (0)
#define PG8_LDA(dst, b, h) do { _Pragma("unroll") for (int m = 0; m < 4; ++m) _Pragma("unroll") for (int k = 0; k < 2; ++k) dst[m][k] = *(const LAS bf16x8*)(lds + PG8_SA(b, h) + aoff + m * 2048 + k * 1024); } while (0)
#define PG8_LDB(dst, b, h) do { _Pragma("unroll") for (int n = 0; n < 2; ++n) _Pragma("unroll") for (int k = 0; k < 2; ++k) dst[n][k] = *(const LAS bf16x8*)(lds + PG8_SB(b, h) + boff + n * 2048 + k * 1024); } while (0)
#define PG8_MMA(ai, bj, At, Bt) do { __builtin_amdgcn_s_setprio(1); _Pragma("unroll") for (int m = 0; m < 4; ++m) _Pragma("unroll") for (int n = 0; n < 2; ++n) _Pragma("unroll") for (int k = 0; k < 2; ++k) \
        acc[ai][bj][m][n] = __builtin_amdgcn_mfma_f32_16x16x32_bf16(Bt[n][k], At[m][k], acc[ai][bj][m][n], 0, 0, 0); __builtin_amdgcn_s_setprio(0); } while (0)
#define PG8_WAIT_V(n) asm volatile("s_waitcnt vmcnt(" #n ")" ::: "memory")
#define PG8_WAIT_L(n) asm volatile("s_waitcnt lgkmcnt(" #n ")" ::: "memory")
#define PG8_BAR __builtin_amdgcn_s_barrier()
#define PG8_SCHED __builtin_amdgcn_sched_barrier(0)
    Unit cur, nxt; int ui = 0;
    if (!S.next(0, cur)) return;
    f32x4 acc[2][2][4][2];
#pragma unroll
    for (int a = 0; a < 2; ++a)
#pragma unroll
        for (int b = 0; b < 2; ++b)
#pragma unroll
            for (int m = 0; m < 4; ++m)
#pragma unroll
                for (int n = 0; n < 2; ++n) acc[a][b][m][n] = (f32x4){0.f, 0.f, 0.f, 0.f};
    bf16x8 At[4][2], B0[2][2], B1[2][2];
    unsigned oc[2][2], on[2][2];
    if constexpr (GATHER) {
#pragma unroll
        for (int h = 0; h < 2; ++h)
#pragma unroll
            for (int i = 0; i < 2; ++i) { oc[h][i] = (unsigned)(S.src_row(cur, h * HALF + RA[i]) * K + CA[i]) * 2u; on[h][i] = oc[h][i]; }
    }
    const char* cA = GATHER ? (const char*)g.A : (const char*)g.A + (size_t)cur.pm * tstep; const char* cB = (const char*)g.Bt + (size_t)cur.pn * tstep;
    PG8_STAGE(PG8_SB(0, 0), cB, voffB); PG8_STAGE(PG8_SB(0, 1), cB + hstep, voffB); PG8_STAGE_A(PG8_SA(0, 0), 0, cA, 0, oc); PG8_STAGE_A(PG8_SA(0, 1), 1, cA, 0, oc);
    if (wr == 1) PG8_BAR;
    PG8_WAIT_V(2); PG8_BAR;
    PG8_STAGE(PG8_SB(1, 0), cB + kstep, voffB); PG8_STAGE_A(PG8_SA(1, 0), 0, cA, kstep, oc); PG8_STAGE(PG8_SB(1, 1), cB + hstep + kstep, voffB);
    PG8_WAIT_V(6); PG8_BAR;
    for (;;) {
        const bool has_next = S.next(ui + 1, nxt);
        const char* nA = GATHER ? (const char*)g.A : (has_next ? (const char*)g.A + (size_t)nxt.pm * tstep : cA); const char* nB = has_next ? (const char*)g.Bt + (size_t)nxt.pn * tstep : cB;
        if constexpr (GATHER) {
            if (has_next) {
#pragma unroll
                for (int h = 0; h < 2; ++h)
#pragma unroll
                    for (int i = 0; i < 2; ++i) on[h][i] = (unsigned)(S.src_row(nxt, h * HALF + RA[i]) * K + CA[i]) * 2u;
            }
        }
        for (int t = 0; t < nt; t += 2) {
            const bool last = (t == nt - 2);
            const size_t k1 = (size_t)(t + 1) * kstep;
            const size_t k2 = last ? (size_t)0 : (size_t)(t + 2) * kstep, k3 = k2 + kstep;
            const char* a2 = last ? nA : cA; const char* b2 = last ? nB : cB;
            unsigned o2[2][2];
            if constexpr (GATHER) {
#pragma unroll
                for (int h = 0; h < 2; ++h)
#pragma unroll
                    for (int i = 0; i < 2; ++i) o2[h][i] = last ? on[h][i] : oc[h][i];
            }
            PG8_LDB(B0, 0, 0); PG8_LDB(B1, 0, 1); PG8_SCHED; PG8_LDA(At, 0, 0); PG8_STAGE_A(PG8_SA(1, 1), 1, cA, k1, oc);
            PG8_WAIT_V(8); PG8_WAIT_L(0); PG8_BAR; PG8_MMA(0, 0, At, B0); PG8_MMA(0, 1, At, B1); PG8_BAR; PG8_SCHED;
            PG8_LDA(At, 0, 1); PG8_STAGE(PG8_SB(0, 0), b2 + k2, voffB); PG8_STAGE(PG8_SB(0, 1), b2 + hstep + k2, voffB); PG8_STAGE_A(PG8_SA(0, 0), 0, a2, k2, o2);
            PG8_WAIT_V(8); PG8_WAIT_L(0); PG8_BAR; PG8_MMA(1, 0, At, B0); PG8_MMA(1, 1, At, B1); PG8_BAR; PG8_SCHED;
            PG8_LDB(B0, 1, 0); PG8_LDB(B1, 1, 1); PG8_SCHED; PG8_LDA(At, 1, 0); PG8_STAGE_A(PG8_SA(0, 1), 1, a2, k2, o2);
            PG8_WAIT_V(8); PG8_WAIT_L(0); PG8_BAR; PG8_MMA(0, 0, At, B0); PG8_MMA(0, 1, At, B1); PG8_BAR; PG8_SCHED;
            PG8_LDA(At, 1, 1); PG8_STAGE(PG8_SB(1, 0), b2 + k3, voffB); PG8_STAGE(PG8_SB(1, 1), b2 + hstep + k3, voffB); PG8_STAGE_A(PG8_SA(1, 0), 0, a2, k3, o2);
            PG8_WAIT_V(8); PG8_WAIT_L(0); PG8_BAR; PG8_MMA(1, 0, At, B0); PG8_MMA(1, 1, At, B1); PG8_BAR; PG8_SCHED;
        }
        if (wr == 0) PG8_BAR;
        E(acc, cur, wr, wc, fr, fq);
        if (!has_next) break;
#pragma unroll
        for (int a = 0; a < 2; ++a)
#pragma unroll
            for (int b = 0; b < 2; ++b)
#pragma unroll
                for (int m = 0; m < 4; ++m)
#pragma unroll
                    for (int n = 0; n < 2; ++n) acc[a][b][m][n] = (f32x4){0.f, 0.f, 0.f, 0.f};
        cur = nxt; cA = nA; cB = nB; ++ui;
        if constexpr (GATHER) {
#pragma unroll
            for (int h = 0; h < 2; ++h)
#pragma unroll
                for (int i = 0; i < 2; ++i) oc[h][i] = on[h][i];
        }
        if (wr == 1) PG8_BAR;
    }
    PG8_WAIT_V(0);
    PG8_BAR;
#undef PG8_SA
#undef PG8_SB
#undef PG8_STAGE
#undef PG8_STAGE_A
#undef PG8_LDA
#undef PG8_LDB
#undef PG8_MMA
#undef PG8_WAIT_V
#undef PG8_WAIT_L
#undef PG8_BAR
#undef PG8_SCHED
}
}
typedef f32x4 acc_t[2][2][4][2];

struct EpiProj {
    bf16_t* O;
    __device__ __forceinline__ void operator()(const acc_t& acc, const pg8::Unit& u, int wr, int wc, int fr, int fq) const {
        const int pn = u.pn;
        const int act = (pn <= 1 || pn == 3 || pn == 4) ? 1 : (pn >= 12 ? 3 : (pn >= 8 ? 2 : 0));
        const int row0 = u.pm * 256 + wr * 64 + fr, col0 = pn * 256 + wc * 32 + 8 * fq;
#pragma unroll
        for (int ai = 0; ai < 2; ++ai)
#pragma unroll
            for (int m = 0; m < 4; ++m) { bf16_t* rowp = O + (size_t)(row0 + ai * 128 + m * 16) * NPROJ + col0;
#pragma unroll
                for (int bj = 0; bj < 2; ++bj) { f32x4 v0 = acc[ai][bj][m][0], v1 = acc[ai][bj][m][1];
                    if (act == 1) { v0 = v0 * QSCALE; v1 = v1 * QSCALE; }
                    else if (act == 2) {
#pragma unroll
                        for (int i = 0; i < 4; ++i) { v0[i] = gelu_tanh(v0[i]); v1[i] = gelu_tanh(v1[i]); } }
                    else if (act == 3) {
#pragma unroll
                        for (int i = 0; i < 4; ++i) { v0[i] = sigmoidf_(v0[i]); v1[i] = sigmoidf_(v1[i]); } }
                    u32x4 w; w.x = cvt_pk_bf16(v0[0], v0[1]); w.y = cvt_pk_bf16(v0[2], v0[3]); w.z = cvt_pk_bf16(v1[0], v1[1]); w.w = cvt_pk_bf16(v1[2], v1[3]);
                    *(u32x4*)(rowp + bj * 128) = w; } }
    }
};

struct BranchOrder {
    pg8::StaticOrder so;
    __device__ __forceinline__ bool next(int j, pg8::Unit& u) const { const int i = j / 3, br = j - 3 * i; int pm, pn; if (!so.tile(i, pm, pn)) return false; u.pm = br * 256 + pm; u.pn = br * 4 + pn; return true; }
};
struct EpiBranch {
    const bf16_t* PROJ; float* slab  ; bf16_t* MERGED;
    __device__ __forceinline__ void operator()(const acc_t& acc, const pg8::Unit& u, int wr, int wc, int fr, int fq) const {
        const int br = u.pn >> 2, pn = u.pn & 3, pm = u.pm & 255;
        const int row0 = pm * 256 + wr * 64 + fr, col0 = pn * 256 + wc * 32 + 8 * fq;
        int tx = threadIdx.x; asm volatile("" : "+v"(tx));
        float* sl = slab + (size_t)tx * 8;
#pragma unroll
        for (int ai = 0; ai < 2; ++ai)
#pragma unroll
            for (int m = 0; m < 4; ++m) { const size_t row = (size_t)(row0 + ai * 128 + m * 16);
#pragma unroll
                for (int bj = 0; bj < 2; ++bj) {
                    const u32x4 gw = *(const u32x4*)(PROJ + row * NPROJ + C_G + br * 1024 + col0 + bj * 128);
                    f32x4 v0 = acc[ai][bj][m][0], v1 = acc[ai][bj][m][1];
                    v0[0] *= bf_lo(gw.x); v0[1] *= bf_hi(gw.x); v0[2] *= bf_lo(gw.y); v0[3] *= bf_hi(gw.y);
                    v1[0] *= bf_lo(gw.z); v1[1] *= bf_hi(gw.z); v1[2] *= bf_lo(gw.w); v1[3] *= bf_hi(gw.w);
                    float* sp = sl + (size_t)((ai * 4 + m) * 2 + bj) * 4096;
                    if (br != 0) { v0 = v0 + *(const f32x4*)sp; v1 = v1 + *(const f32x4*)(sp + 4); }
                    if (br != 2) { *(f32x4*)sp = v0; *(f32x4*)(sp + 4) = v1; }
                    else { u32x4 w; w.x = cvt_pk_bf16(v0[0], v0[1]); w.y = cvt_pk_bf16(v0[2], v0[3]); w.z = cvt_pk_bf16(v1[0], v1[1]); w.w = cvt_pk_bf16(v1[2], v1[3]);
                        *(u32x4*)(MERGED + row * DM + col0 + bj * 128) = w; } }
                asm volatile("" ::: "memory"); }
    }
};

struct EpiWout {
    float* Y; float* SSP;
    __device__ __forceinline__ void operator()(const acc_t& acc, const pg8::Unit& u, int wr, int wc, int fr, int fq) const {
        const int row0 = u.pm * 256 + wr * 64 + fr, col0 = u.pn * 256 + wc * 32 + 8 * fq;
#pragma unroll
        for (int ai = 0; ai < 2; ++ai)
#pragma unroll
            for (int m = 0; m < 4; ++m) { const size_t row = (size_t)(row0 + ai * 128 + m * 16); float ss = 0.f;
#pragma unroll
                for (int bj = 0; bj < 2; ++bj) { const f32x4 v0 = acc[ai][bj][m][0], v1 = acc[ai][bj][m][1];
                    ss += (v0[0] * v0[0] + v0[1] * v0[1]) + (v0[2] * v0[2] + v0[3] * v0[3]) + (v1[0] * v1[0] + v1[1] * v1[1]) + (v1[2] * v1[2] + v1[3] * v1[3]);
                    float* yp = Y + row * DM + col0 + bj * 128; *(f32x4*)yp = v0; *(f32x4*)(yp + 4) = v1; }
                ss += __shfl_xor(ss, 16); ss += __shfl_xor(ss, 32);
                if (fq == 0) SSP[row * 16 + u.pn * 4 + wc] = ss; }
    }
};

struct MoeOrder {
    int u0, u1, NB, rt_lo;
    const LAS int* tile_e;
    const LAS int* rowidx;
    __device__ __forceinline__ bool next(int i, pg8::Unit& u) const { const int x = u0 + i; if (x >= u1) return false; const int rt = x / NB, pn = x - rt * NB; u.pm = rt; u.pn = tile_e[rt] * NB + pn; return true; }
    __device__ __forceinline__ int src_row(const pg8::Unit& u, int r) const { return rowidx[(u.pm - rt_lo) * 256 + r]; }
};
struct EpiW1 {
    bf16_t* ACT; const float* b1  ;
    __device__ __forceinline__ void operator()(const acc_t& acc, const pg8::Unit& u, int wr, int wc, int fr, int fq) const {
        const int e = u.pn >> 3, pn = u.pn & 7;
        const int row0 = u.pm * 256 + wr * 64 + fr, j0 = pn * 128 + wc * 32 + 8 * fq;
        const float* bp = b1 + (size_t)e * (2 * FF) + 2 * j0;
        float bg[8], bl[8];
#pragma unroll
        for (int q = 0; q < 4; ++q) { const f32x4 t = *(const f32x4*)(bp + 4 * q); bg[2 * q] = t[0]; bl[2 * q] = t[1]; bg[2 * q + 1] = t[2]; bl[2 * q + 1] = t[3]; }
#pragma unroll
        for (int ai = 0; ai < 2; ++ai)
#pragma unroll
            for (int m = 0; m < 4; ++m) { float a[8];
#pragma unroll
                for (int i = 0; i < 8; ++i) { float gl = acc[ai][0][m][i >> 2][i & 3] + bg[i], li = acc[ai][1][m][i >> 2][i & 3] + bl[i];
                    gl = fminf(gl, 7.f); li = fminf(fmaxf(li, -7.f), 7.f);
                    a[i] = gl * frcp(1.f + fexp2(-1.702f * LOG2E * gl)) * (li + 1.f); }
                u32x4 w; w.x = cvt_pk_bf16(a[0], a[1]); w.y = cvt_pk_bf16(a[2], a[3]); w.z = cvt_pk_bf16(a[4], a[5]); w.w = cvt_pk_bf16(a[6], a[7]);
                *(u32x4*)(ACT + (size_t)(row0 + ai * 128 + m * 16) * FF + j0) = w; }
    }
};
struct EpiW2 {
    bf16_t* Y2; const float* b2  ;
    __device__ __forceinline__ void operator()(const acc_t& acc, const pg8::Unit& u, int wr, int wc, int fr, int fq) const {
        const int e = u.pn >> 2, pn = u.pn & 3;
        const int row0 = u.pm * 256 + wr * 64 + fr, col0 = pn * 256 + wc * 32 + 8 * fq;
        f32x4 bv[2][2];
#pragma unroll
        for (int bj = 0; bj < 2; ++bj)
#pragma unroll
            for (int n = 0; n < 2; ++n) bv[bj][n] = *(const f32x4*)(b2 + (size_t)e * DM + col0 + bj * 128 + 4 * n);
#pragma unroll
        for (int ai = 0; ai < 2; ++ai)
#pragma unroll
            for (int m = 0; m < 4; ++m) { bf16_t* rowp = Y2 + (size_t)(row0 + ai * 128 + m * 16) * DM + col0;
#pragma unroll
                for (int bj = 0; bj < 2; ++bj) { const f32x4 v0 = acc[ai][bj][m][0] + bv[bj][0], v1 = acc[ai][bj][m][1] + bv[bj][1];
                    u32x4 w; w.x = cvt_pk_bf16(v0[0], v0[1]); w.y = cvt_pk_bf16(v0[2], v0[3]); w.z = cvt_pk_bf16(v1[0], v1[1]); w.w = cvt_pk_bf16(v1[2], v1[3]);
                    *(u32x4*)(rowp + bj * 128) = w; } }
    }
};
#define XB_TMO      128
#define XB_XCNT(j)  (256  + 64 * (j))
#define XB_XSUB(j)  (1280 + 64 * (j))
#define XB_XGEN(j)  (2304 + 64 * (j))
#define XB_TOP      3328
#define XB_TOPGEN   3392
#define XCD_BAR_WORDS 3456
#define XB_SPIN_CAP (1u << 18)

__device__ __forceinline__ unsigned xb_ld(unsigned* p)              { return __hip_atomic_load(p, __ATOMIC_RELAXED, __HIP_MEMORY_SCOPE_AGENT); }
__device__ __forceinline__ unsigned xb_add(unsigned* p, unsigned v) { return __hip_atomic_fetch_add(p, v, __ATOMIC_RELAXED, __HIP_MEMORY_SCOPE_AGENT); }
__device__ __forceinline__ unsigned xb_xcc_id() { return (unsigned)__builtin_amdgcn_s_getreg((3 << 11) | 20) & 0xFu; }
#define XB_SPIN(cond, bar) do { unsigned _sp = 0; while (cond) { __builtin_amdgcn_s_sleep(1); \
    if ((++_sp & 255u) == 0u) { if (xb_ld(&(bar)[XB_TMO])) break; if (_sp > XB_SPIN_CAP) { atomicAdd(&(bar)[XB_TMO], 1u); break; } } } } while (0)

struct XcdBarrier {
    unsigned* bar; unsigned x;
    volatile LAS unsigned* st;
};

__device__ __forceinline__ XcdBarrier xcd_barrier_post(unsigned* bar, volatile LAS unsigned* st) {
    XcdBarrier b; b.bar = bar; b.x = xb_xcc_id(); b.st = st;
    if (threadIdx.x == 0) (void)xb_add(&bar[XB_XCNT(b.x)], 1u);
    return b;
}
__device__ __forceinline__ void xcd_barrier_complete(unsigned* bar, unsigned x, unsigned& nloc, unsigned& nx) {
    const unsigned G = gridDim.x * gridDim.y * gridDim.z;
    unsigned sum, cnt, mine, sp = 0u;
    for (;;) {
        sum = 0u; cnt = 0u; mine = 0u;
#pragma unroll
        for (unsigned j = 0; j < 16; ++j) { const unsigned c = xb_ld(&bar[XB_XCNT(j)]); sum += c; cnt += (c > 0u) ? 1u : 0u; mine = (j == x) ? c : mine; }
        if (sum == G) break;
        __builtin_amdgcn_s_sleep(1);
        if ((++sp & 255u) == 0u) { if (xb_ld(&bar[XB_TMO])) break; if (sp > XB_SPIN_CAP) { atomicAdd(&bar[XB_TMO], 1u); break; } }
    }
    nloc = mine > 0u ? mine : 1u; nx = cnt > 0u ? cnt : 1u;
}

__device__ __forceinline__ void xcd_barrier(const XcdBarrier& b) {
    asm volatile("s_waitcnt vmcnt(0)" ::: "memory");
    __syncthreads();
    if (threadIdx.x == 0) {
        unsigned* bar = b.bar;
        __builtin_amdgcn_s_waitcnt(0);
        unsigned nloc = b.st[0], nx = b.st[1];
        if (nloc == 0u) { xcd_barrier_complete(bar, b.x, nloc, nx); b.st[0] = nloc; b.st[1] = nx; }
        const unsigned old = xb_add(&bar[XB_XSUB(b.x)], 1u);
        const unsigned gen = old / nloc;
        if (old + 1u == (gen + 1u) * nloc) {
            __builtin_amdgcn_fence(__ATOMIC_RELEASE, "agent");
            asm volatile("s_waitcnt vmcnt(0)" ::: "memory");
            const unsigned og = xb_add(&bar[XB_TOP], 1u);
            const unsigned tg = og / nx;
            if (og + 1u == (tg + 1u) * nx) xb_add(&bar[XB_TOPGEN], 1u);
            else XB_SPIN(xb_ld(&bar[XB_TOPGEN]) == tg, bar);
            __builtin_amdgcn_fence(__ATOMIC_ACQUIRE, "agent");
            xb_add(&bar[XB_XGEN(b.x)], 1u);
            asm volatile("s_waitcnt vmcnt(0)" ::: "memory");
        } else {
            XB_SPIN(xb_ld(&bar[XB_XGEN(b.x)]) == gen, bar);
            __builtin_amdgcn_fence(__ATOMIC_ACQUIRE, "agent");
            asm volatile("s_waitcnt vmcnt(0)" ::: "memory");
        }
    }
    __syncthreads();
}

constexpr size_t MiB = 1u << 20;
constexpr size_t WS_CTL = 0, CTL_ZERO_BYTES = 1 * MiB;
constexpr size_t WS_MOD = 1 * MiB;
constexpr size_t WS_SGW = 3 * MiB;
constexpr size_t WS_WRT = 3 * MiB + 512 * 1024;
constexpr size_t WS_W = 8 * MiB, W_LAYER = 209 * MiB;
constexpr size_t WO_WIN = 0, WO_WBR = 12 * MiB, WO_WOUT = 15 * MiB, WO_W1 = 17 * MiB, WO_W2 = 145 * MiB;
constexpr size_t WS_PROJ = 426 * MiB;
constexpr size_t WS_ACT = WS_PROJ;
constexpr size_t WS_H = 1194 * MiB;
constexpr size_t WS_O = 1322 * MiB;
constexpr size_t WS_Y = 1514 * MiB;
constexpr size_t WS_BITS = 1770 * MiB;
constexpr size_t WS_Y2 = WS_O;
constexpr size_t WS_SSP = 1850 * MiB;
constexpr size_t WS_ROWTOK = 1854 * MiB;
constexpr size_t WS_TOKINFO = 1862 * MiB;
constexpr size_t WS_SLAB = 1864 * MiB;
constexpr size_t WS_END = 1928 * MiB;
static_assert(WS_Y2 + (size_t)270336 * 2048 <= WS_SSP && WS_W + 2 * W_LAYER <= WS_PROJ && WS_PROJ + (size_t)MTOK * NPROJ * 2 <= WS_H, "d_ws map");
constexpr int CW_BAR = 4096;
constexpr int CW_CNT = 16384;

constexpr int RING_BYTES = 131072;
constexpr int MISC_OFF = RING_BYTES;
constexpr int TS_OFF = MISC_OFF + 512;
constexpr int TILE_E_OFF = MISC_OFF + 1024;
constexpr int ROWIDX_OFF = MISC_OFF + 5632;
constexpr int LDS_BYTES = 147456;
static_assert(ROWIDX_OFF + 8192 <= LDS_BYTES, "LDS map");

struct Args {
    const float* in[21]; float* out; unsigned char* ws; int ph_lo, ph_hi;
};
struct Frame {
    LAS unsigned char* lds; int tid, lane, wave, vcu, G;
};
__device__ __forceinline__ Frame phase_frame(const Frame& F0) { Frame F = F0; int t = threadIdx.x; asm volatile("" : "+v"(t)); F.tid = t; F.lane = t & 63; F.wave = __builtin_amdgcn_readfirstlane(t >> 6); return F; }
template <class T> __device__ __forceinline__ T* opq(T* p) { asm volatile("" : "+s"(p)); return p; }

__device__ __forceinline__ void p0_mod(const Frame& F, const float* c, const float* w_ada, const float* b_ada, float* MOD) {
    LAS float* csT = (LAS float*)F.lds;
    for (int i = F.tid; i < BATCH * DM; i += 512) { const int b = i & 31, k = i >> 5; const float v = c[b * DM + k]; csT[k * 32 + b] = v * sigmoidf_(v); }
    __syncthreads();
    const int gw = F.vcu * 8 + F.wave, NGW = F.G * 8;
    const int cg = F.lane & 15, kq = F.lane >> 4;
    for (int task = gw; task < DEPTH * 384; task += NGW) {
        const int l = task / 384, n = (task % 384) * 16 + cg;
        float acc[32];
#pragma unroll
        for (int b = 0; b < 32; ++b) acc[b] = 0.f;
        const float* w = w_ada + ((size_t)l * DM + kq * 256) * (6 * DM) + n;
#pragma unroll 4
        for (int k = 0; k < 256; ++k) {
            const float wv = w[(size_t)k * (6 * DM)];
            const LAS f32x4* cs = (const LAS f32x4*)(csT + (kq * 256 + k) * 32);
#pragma unroll
            for (int q = 0; q < 8; ++q) { const f32x4 c4 = cs[q]; acc[4 * q] += c4[0] * wv; acc[4 * q + 1] += c4[1] * wv; acc[4 * q + 2] += c4[2] * wv; acc[4 * q + 3] += c4[3] * wv; }
        }
#pragma unroll
        for (int b = 0; b < 32; ++b) { acc[b] += __shfl_xor(acc[b], 16); acc[b] += __shfl_xor(acc[b], 32); }
        if (kq == 0) { const float bb = b_ada[l * 6 * DM + n];
#pragma unroll
            for (int b = 0; b < 32; ++b) MOD[((size_t)l * BATCH + b) * (6 * DM) + n] = acc[b] + bb; }
    }
    __syncthreads();
}
__device__ __forceinline__ void tr_item(const float* W, size_t ldw, int srccol, bool valid, bf16_t* dst  , int K, LAS float* scr, int lane) {
    const float* wp = W + srccol;
#pragma unroll 8
    for (int i = 0; i < 32; ++i) { const int kk = 2 * i + (lane >> 5); scr[kk * 33 + (lane & 31)] = valid ? wp[(size_t)kk * ldw] : 0.f; }
    LDS_WAIT(); asm volatile("" ::: "memory");
    const int c = lane & 7;
#pragma unroll
    for (int j = 0; j < 4; ++j) { const int n = (lane >> 3) + 8 * j; const LAS float* s = scr + (8 * c) * 33 + n;
        u32x4 o; o.x = cvt_pk_bf16(s[0 * 33], s[1 * 33]); o.y = cvt_pk_bf16(s[2 * 33], s[3 * 33]); o.z = cvt_pk_bf16(s[4 * 33], s[5 * 33]); o.w = cvt_pk_bf16(s[6 * 33], s[7 * 33]);
        *(u32x4*)(dst + (size_t)n * K + 8 * c) = o; }
    LDS_WAIT(); asm volatile("" ::: "memory");
}
__device__ __forceinline__ void p0_weights(const Frame& F, const Args& a) {
    LAS float* scr = (LAS float*)(F.lds + F.wave * 16384);
    const int gw = F.vcu * 8 + F.wave, NGW = F.G * 8, lane = F.lane, jl = lane & 31;
    const float *w_in = a.in[8], *w_branch = a.in[13], *w_out = a.in[14], *w_router = a.in[15], *w1 = a.in[17], *w2 = a.in[19];
    constexpr int I_IN = 16 * 192, I_BR = 3 * 8 * 32, I_OUT = 16 * 32, I_RT = 16, I_W1 = 32 * 16 * 64, I_W2 = 32 * 16 * 32;
    constexpr int I_LAYER = I_IN + I_BR + I_OUT + I_RT + I_W1 + I_W2;
    for (int it = gw; it < DEPTH * I_LAYER; it += NGW) {
        const int l = it / I_LAYER; int r = it - l * I_LAYER;
        unsigned char* wl = a.ws + WS_W + (size_t)l * W_LAYER;
        if (r < I_IN) {
            const int kb = r / 192, nb = r % 192, n = nb * 32 + jl; const bool valid = (n < 1832) || (n >= 2048); const int src = n < 1832 ? n : n - 216;
            tr_item(w_in + (size_t)l * DM * 5928 + (size_t)kb * 64 * 5928, 5928, valid ? src : 0, valid, (bf16_t*)(wl + WO_WIN) + (size_t)nb * 32 * DM + kb * 64, DM, scr, lane); continue; }
        r -= I_IN;
        if (r < I_BR) {
            const int br = r / 256, q = r % 256, kb = q / 32, nb = q % 32;
            tr_item(w_branch + ((size_t)(l * 3 + br) * 512 + kb * 64) * DM, DM, nb * 32 + jl, true, (bf16_t*)(wl + WO_WBR) + (size_t)(br * 1024 + nb * 32) * 512 + kb * 64, 512, scr, lane); continue; }
        r -= I_BR;
        if (r < I_OUT) {
            const int kb = r / 32, nb = r % 32;
            tr_item(w_out + ((size_t)l * DM + kb * 64) * DM, DM, nb * 32 + jl, true, (bf16_t*)(wl + WO_WOUT) + (size_t)nb * 32 * DM + kb * 64, DM, scr, lane); continue; }
        r -= I_OUT;
        if (r < I_RT) {
            const int kb = r;
            tr_item(w_router + ((size_t)l * DM + kb * 64) * NE, NE, jl, true, (bf16_t*)(a.ws + WS_WRT) + (size_t)l * NE * DM + kb * 64, DM, scr, lane); continue; }
        r -= I_RT;
        if (r < I_W1) {
            const int e = r / 1024, q = r % 1024, kb = q / 64, nb = q % 64, n = nb * 32 + jl;
            const int pn = n >> 8, s = (n >> 7) & 1, jj = n & 127, src = 2 * (128 * pn + jj) + s;
            tr_item(w1 + ((size_t)(l * NE + e) * DM + kb * 64) * (2 * FF), 2 * FF, src, true, (bf16_t*)(wl + WO_W1) + ((size_t)e * 2048 + nb * 32) * DM + kb * 64, DM, scr, lane); continue; }
        r -= I_W1;
        {
            const int e = r / 512, q = r % 512, kb = q / 32, nb = q % 32;
            tr_item(w2 + ((size_t)(l * NE + e) * FF + kb * 64) * DM, DM, nb * 32 + jl, true, (bf16_t*)(wl + WO_W2) + ((size_t)e * DM + nb * 32) * FF + kb * 64, FF, scr, lane); }
    }
    const float* sg_w = a.in[10]; bf16_t* SGW = (bf16_t*)(a.ws + WS_SGW);
    for (int i = (F.vcu * 512 + F.tid) * 2; i < DEPTH * 8 * 128 * 128; i += F.G * 512 * 2) { const int s = i & 127, t = (i >> 7) & 127; const f32x2 v = *(const f32x2*)(sg_w + i);
        *(unsigned*)(SGW + i) = cvt_pk_bf16(s <= t ? v[0] : 0.f, (s + 1) <= t ? v[1] : 0.f); }
}

__device__ __forceinline__ void norm_mod_row(const f32x4 (&v)[4], float ss, const float* g, const float* sc, const float* sh, bf16_t* orow, int lane) {
    const float rstd = 1.f / sqrtf(ss * (1.f / DM) + RMS_EPS);
#pragma unroll
    for (int j = 0; j < 4; ++j) { const int c = 4 * lane + 256 * j; const f32x4 gg = *(const f32x4*)(g + c), s1 = *(const f32x4*)(sc + c), s0 = *(const f32x4*)(sh + c);
        const f32x4 o = (v[j] * rstd) * gg * (s1 + 1.f) + s0; u32x2 w; w.x = cvt_pk_bf16(o[0], o[1]); w.y = cvt_pk_bf16(o[2], o[3]); *(u32x2*)(orow + c) = w; }
}
__device__ __forceinline__ void p1_norm(const Frame& F, const float* x, const float* g, const float* MOD0, bf16_t* H) {
    const int gw = F.vcu * 8 + F.wave, NGW = F.G * 8;
    for (int row = gw; row < MTOK; row += NGW) { const int b = row >> 11; const float* xr = x + (size_t)row * DM; f32x4 v[4]; float ss = 0.f;
#pragma unroll
        for (int j = 0; j < 4; ++j) { v[j] = *(const f32x4*)(xr + 4 * F.lane + 256 * j); ss += (v[j][0] * v[j][0] + v[j][1] * v[j][1]) + (v[j][2] * v[j][2] + v[j][3] * v[j][3]); }
        ss = wave_sum(ss);
        const float* mb = MOD0 + (size_t)b * 6 * DM;
        norm_mod_row(v, ss, g, mb + DM, mb, H + (size_t)row * DM, F.lane); }
}
constexpr int TOPK_SEL = 256;
__device__ __forceinline__ void dsa_index_unit(const Frame& F, const bf16_t* __restrict__ PROJ, unsigned long long* __restrict__ bits64, int b, int qg) {
    const int lane = F.lane, wid = F.wave, n = lane & 31, hi = lane >> 5;
    const int q0 = qg * 16, nkb = (q0 + 16 + 31) >> 5;
    const size_t tokbase = (size_t)b * SEQ;
    LAS float* sc = (LAS float*)F.lds;
    bf16x8 af[4][2]; float wv[4][16];
    { const int m = n, hm = (m >> 2) & 1, idx = (m & 3) + 4 * (m >> 3), aq = 2 * hm + (idx >> 3), ah = idx & 7;
#pragma unroll
      for (int qgp = 0; qgp < 4; ++qgp) { const bf16_t* qp = PROJ + (tokbase + q0 + 4 * qgp + aq) * NPROJ + C_QI + ah * 32 + 8 * hi;
          af[qgp][0] = *(const bf16x8*)qp; af[qgp][1] = *(const bf16x8*)(qp + 16);
#pragma unroll
          for (int qq = 0; qq < 2; ++qq) { const u32x4 w = *(const u32x4*)(PROJ + (tokbase + q0 + 4 * qgp + 2 * hi + qq) * NPROJ + C_WI);
              wv[qgp][8 * qq + 0] = bf_lo(w.x) * 0.0625f; wv[qgp][8 * qq + 1] = bf_hi(w.x) * 0.0625f; wv[qgp][8 * qq + 2] = bf_lo(w.y) * 0.0625f; wv[qgp][8 * qq + 3] = bf_hi(w.y) * 0.0625f;
              wv[qgp][8 * qq + 4] = bf_lo(w.z) * 0.0625f; wv[qgp][8 * qq + 5] = bf_hi(w.z) * 0.0625f; wv[qgp][8 * qq + 6] = bf_lo(w.w) * 0.0625f; wv[qgp][8 * qq + 7] = bf_hi(w.w) * 0.0625f; } } }
    for (int kb = wid; kb < nkb; kb += 8) {
        const bf16_t* kp = PROJ + (tokbase + 32 * kb + n) * NPROJ + C_KI + 8 * hi;
        const bf16x8 kf0 = *(const bf16x8*)kp, kf1 = *(const bf16x8*)(kp + 16);
#pragma unroll
        for (int qgp = 0; qgp < 4; ++qgp) {
            f32x16 d = {0.f, 0.f, 0.f, 0.f, 0.f, 0.f, 0.f, 0.f, 0.f, 0.f, 0.f, 0.f, 0.f, 0.f, 0.f, 0.f};
            d = __builtin_amdgcn_mfma_f32_32x32x16_bf16(af[qgp][0], kf0, d, 0, 0, 0);
            d = __builtin_amdgcn_mfma_f32_32x32x16_bf16(af[qgp][1], kf1, d, 0, 0, 0);
            float sa = 0.f, sb = 0.f;
#pragma unroll
            for (int r = 0; r < 8; ++r) { sa += wv[qgp][r] * fmaxf(d[r], 0.f); sb += wv[qgp][8 + r] * fmaxf(d[8 + r], 0.f); }
            sc[(4 * qgp + 2 * hi) * 2048 + 32 * kb + n] = sa; sc[(4 * qgp + 2 * hi + 1) * 2048 + 32 * kb + n] = sb;
        }
    }
    __syncthreads();
#pragma unroll 1
    for (int qq = 0; qq < 2; ++qq) {
        const int ql = 2 * wid + qq, pos = q0 + ql, nn = pos + 1, nr = (nn + 63) >> 6;
        const LAS float* scq = sc + ql * 2048;
        unsigned long long myw = 0ull;
        if (nn <= TOPK_SEL) {
#pragma unroll
            for (int r = 0; r < 4; ++r) if (r < nr) { const unsigned long long bal = __ballot(64 * r + lane <= pos); if (lane == r) myw = bal; }
        } else {
            unsigned u[32];
#pragma unroll
            for (int r = 0; r < 32; ++r) { u[r] = 0u;
                if (r < nr) { const int j = 64 * r + lane; float s = scq[j]; s = (s == 0.f) ? 0.f : s; const unsigned bts = __builtin_bit_cast(unsigned, s);
                    const unsigned uu = (bts & 0x80000000u) ? ~bts : (bts | 0x80000000u); u[r] = (j <= pos) ? uu : 0u; } }
            unsigned mx = 0u;
#pragma unroll
            for (int r = 0; r < 32; ++r) mx = u[r] > mx ? u[r] : mx;
            const unsigned umax = wave_max_u32(mx);
#define CNT_GE(cand, out) do { unsigned c_ = 0u; _Pragma("unroll") for (int g4 = 0; g4 < 8; ++g4) { if (4 * g4 < nr) { c_ += (u[4 * g4] >= (cand)); c_ += (u[4 * g4 + 1] >= (cand)); c_ += (u[4 * g4 + 2] >= (cand)); c_ += (u[4 * g4 + 3] >= (cand)); } } out = wave_sum_u32(c_); } while (0)
            unsigned L = 0u, t = 0u; bool exact = false; unsigned c;
            if (umax > 0x80000000u + (3u << 23)) { const unsigned Lg = umax - (3u << 23); CNT_GE(Lg, c); if (c >= (unsigned)TOPK_SEL) { L = Lg; if (c == (unsigned)TOPK_SEL) { exact = true; t = Lg; } } }
            if (!exact) {
                const unsigned R = umax - L; unsigned tp = 0u;
                int bit = 31 - __builtin_clz(R | 1u);
#pragma unroll 1
                for (; bit >= 0; --bit) { const unsigned cand_off = tp | (1u << bit); if (cand_off > R) continue; const unsigned cand = L + cand_off; CNT_GE(cand, c);
                    if (c >= (unsigned)TOPK_SEL) { tp = cand_off; if (c == (unsigned)TOPK_SEL) { exact = true; break; } } }
                t = L + tp;
            }
            if (exact) {
#pragma unroll
                for (int r = 0; r < 32; ++r) if (r < nr) { const unsigned long long bal = __ballot(u[r] >= t); if (lane == r) myw = bal; }
            } else {
                unsigned cgt; { const unsigned t1 = t + 1u; CNT_GE(t1, cgt); }
                const unsigned need = (unsigned)TOPK_SEL - cgt; unsigned run = 0u;
#pragma unroll
                for (int r = 0; r < 32; ++r) if (r < nr) { const unsigned long long eqm = __ballot(u[r] == t);
                    const unsigned pre = run + __builtin_amdgcn_mbcnt_hi((unsigned)(eqm >> 32), __builtin_amdgcn_mbcnt_lo((unsigned)eqm, 0u));
                    const unsigned long long bal = __ballot((u[r] > t) || ((u[r] == t) && (pre < need)));
                    run += (unsigned)__builtin_popcountll(eqm); if (lane == r) myw = bal; }
            }
#undef CNT_GE
        }
        if (lane < nr) bits64[(tokbase + pos) * 32 + lane] = myw;
    }
    __syncthreads();
}

constexpr int KS = 144, VS = 144;
#ifndef USE_TR
#define USE_TR 1
#endif
template <int MODE>
__device__ __forceinline__ void attn_unit(const Frame& F, const bf16_t* __restrict__ PROJ, bf16_t* __restrict__ O, const unsigned* __restrict__ bits, const float* __restrict__ sinks, int b, int g, int qb) {
    const int tid = F.tid, lane = F.lane, wid = F.wave, n = lane & 31, hi = lane >> 5;
    constexpr int CQ = MODE ? C_QB : C_QA, CK = MODE ? C_KB : C_KA, CV = MODE ? C_VB : C_VA;
    const int hq = 4 * g + (wid >> 1), qpos = qb * 64 + 32 * (wid & 1) + n;
    const size_t tokbase = (size_t)b * SEQ;
    LAS unsigned char* Ks = F.lds; LAS unsigned char* Vs = F.lds + 64 * KS;
    bf16x8 qf[4];
    { const bf16_t* qp = PROJ + (tokbase + qpos) * NPROJ + CQ + hq * 64 + 8 * hi;
#pragma unroll
      for (int s = 0; s < 4; ++s) qf[s] = *(const bf16x8*)(qp + 16 * s); }
    f32x16 o0, o1;
#pragma unroll
    for (int r = 0; r < 16; ++r) { o0[r] = 0.f; o1[r] = 0.f; }
    float mrun, lsum;
    if (MODE == 0) { mrun = sinks[hq] * LOG2E; lsum = (hi == 0) ? 1.f : 0.f; } else { mrun = -1e30f; lsum = 0.f; }
    const int kt_lo = (MODE == 0) ? (qb >= 2 ? qb - 2 : 0) : 0, kt_hi = qb;
    const int srow = tid >> 3, sch = tid & 7;
    const bf16_t* kg = PROJ + (tokbase + srow) * NPROJ + CK + g * 64 + sch * 8;
    const bf16_t* vg = PROJ + (tokbase + srow) * NPROJ + CV + g * 64 + sch * 8;
    const unsigned* bp = bits + (tokbase + qpos) * 64;
    u32x4 kreg = *(const u32x4*)(kg + (size_t)kt_lo * 64 * NPROJ), vreg = *(const u32x4*)(vg + (size_t)kt_lo * 64 * NPROJ);
    u32x2 mreg = {0u, 0u};
    if (MODE == 1) mreg = *(const u32x2*)(bp + 2 * kt_lo);
    const int vbase = (4 * hi + ((lane & 15) >> 2)) * VS + (16 * ((lane >> 4) & 1) + 4 * (lane & 3)) * 2;
    for (int kt = kt_lo; kt <= kt_hi; ++kt) {
        __syncthreads();
        *(LAS u32x4*)(Ks + srow * KS + sch * 16) = kreg; *(LAS u32x4*)(Vs + srow * VS + sch * 16) = vreg;
        const u32x2 mcur = mreg;
        __syncthreads();
        if (kt < kt_hi) { kreg = *(const u32x4*)(kg + (size_t)(kt + 1) * 64 * NPROJ); vreg = *(const u32x4*)(vg + (size_t)(kt + 1) * 64 * NPROJ); if (MODE == 1) mreg = *(const u32x2*)(bp + 2 * (kt + 1)); }
        f32x16 p0, p1;
#pragma unroll
        for (int r = 0; r < 16; ++r) { p0[r] = 0.f; p1[r] = 0.f; }
#pragma unroll
        for (int s = 0; s < 4; ++s) { const bf16x8 k0 = *(const LAS bf16x8*)(Ks + n * KS + (16 * s + 8 * hi) * 2), k1 = *(const LAS bf16x8*)(Ks + (n + 32) * KS + (16 * s + 8 * hi) * 2);
            p0 = __builtin_amdgcn_mfma_f32_32x32x16_bf16(k0, qf[s], p0, 0, 0, 0); p1 = __builtin_amdgcn_mfma_f32_32x32x16_bf16(k1, qf[s], p1, 0, 0, 0); }
        unsigned w0, w1;
        if (MODE == 1) { w0 = mcur.x >> (4 * hi); w1 = mcur.y >> (4 * hi); }
        else {
#pragma unroll
            for (int blk = 0; blk < 2; ++blk) { const int d0 = qpos - (kt * 64 + 32 * blk); unsigned mk = 0u;
                if (d0 >= 0) { const int hb = d0 > 31 ? 31 : d0; int lo = d0 - 127; if (lo <= 31) { if (lo < 0) lo = 0; mk = (0xFFFFFFFFu >> (31 - hb)) & (0xFFFFFFFFu << lo); } }
                if (blk == 0) w0 = mk >> (4 * hi); else w1 = mk >> (4 * hi); }
        }
        float mx = -INFINITY;
#pragma unroll
        for (int r = 0; r < 16; ++r) { const int bitpos = 8 * (r >> 2) + (r & 3);
            p0[r] = ((w0 >> bitpos) & 1u) ? p0[r] : -INFINITY; p1[r] = ((w1 >> bitpos) & 1u) ? p1[r] : -INFINITY; mx = fmaxf(mx, fmaxf(p0[r], p1[r])); }
        mx = fmaxf(mx, __shfl_xor(mx, 32));
        const float mnew = fmaxf(mrun, mx), alpha = fexp2(mrun - mnew); mrun = mnew;
        float ps = 0.f;
#pragma unroll
        for (int r = 0; r < 16; ++r) { p0[r] = fexp2(p0[r] - mnew); p1[r] = fexp2(p1[r] - mnew); ps += p0[r] + p1[r]; }
        lsum = lsum * alpha + ps;
#pragma unroll
        for (int r = 0; r < 16; ++r) { o0[r] *= alpha; o1[r] *= alpha; }
        bf16x8 pf[2][2];
#pragma unroll
        for (int s2 = 0; s2 < 2; ++s2) { u32x4 a, c;
            a.x = cvt_pk_bf16(p0[8 * s2 + 0], p0[8 * s2 + 1]); a.y = cvt_pk_bf16(p0[8 * s2 + 2], p0[8 * s2 + 3]); a.z = cvt_pk_bf16(p0[8 * s2 + 4], p0[8 * s2 + 5]); a.w = cvt_pk_bf16(p0[8 * s2 + 6], p0[8 * s2 + 7]);
            c.x = cvt_pk_bf16(p1[8 * s2 + 0], p1[8 * s2 + 1]); c.y = cvt_pk_bf16(p1[8 * s2 + 2], p1[8 * s2 + 3]); c.z = cvt_pk_bf16(p1[8 * s2 + 4], p1[8 * s2 + 5]); c.w = cvt_pk_bf16(p1[8 * s2 + 6], p1[8 * s2 + 7]);
            pf[0][s2] = __builtin_bit_cast(bf16x8, a); pf[1][s2] = __builtin_bit_cast(bf16x8, c); }
#pragma unroll
        for (int db = 0; db < 2; ++db)
#pragma unroll
            for (int blk = 0; blk < 2; ++blk)
#pragma unroll
                for (int s2 = 0; s2 < 2; ++s2) {
                    bf16x8 vf;
#if USE_TR
                    const v4i16_t t0 = __builtin_amdgcn_ds_read_tr16_b64_v4i16((LAS v4i16_t*)(Vs + vbase + (32 * blk + 16 * s2) * VS + 64 * db));
                    const v4i16_t t1 = __builtin_amdgcn_ds_read_tr16_b64_v4i16((LAS v4i16_t*)(Vs + vbase + (32 * blk + 16 * s2 + 8) * VS + 64 * db));
                    vf = (bf16x8){t0[0], t0[1], t0[2], t0[3], t1[0], t1[1], t1[2], t1[3]};
#else
#pragma unroll
                    for (int j = 0; j < 8; ++j) vf[j] = *(const LAS short*)(Vs + (32 * blk + 16 * s2 + 8 * (j >> 2) + 4 * hi + (j & 3)) * VS + (32 * db + n) * 2);
#endif
                    if (db == 0) o0 = __builtin_amdgcn_mfma_f32_32x32x16_bf16(vf, pf[blk][s2], o0, 0, 0, 0); else o1 = __builtin_amdgcn_mfma_f32_32x32x16_bf16(vf, pf[blk][s2], o1, 0, 0, 0);
                }
    }
    const float lt = lsum + __shfl_xor(lsum, 32), inv = 1.f / lt;
    bf16_t* op = O + (tokbase + qpos) * 512 + hq * 64 + 4 * hi;
#pragma unroll
    for (int rq = 0; rq < 4; ++rq) { u32x2 w;
        w.x = cvt_pk_bf16(o0[4 * rq] * inv, o0[4 * rq + 1] * inv); w.y = cvt_pk_bf16(o0[4 * rq + 2] * inv, o0[4 * rq + 3] * inv); *(u32x2*)(op + 8 * rq) = w;
        w.x = cvt_pk_bf16(o1[4 * rq] * inv, o1[4 * rq + 1] * inv); w.y = cvt_pk_bf16(o1[4 * rq + 2] * inv, o1[4 * rq + 3] * inv); *(u32x2*)(op + 32 + 8 * rq) = w; }
}

constexpr int SGS = 1040;
__device__ __forceinline__ void sg_unit(const Frame& F, const bf16_t* __restrict__ PROJ, const bf16_t* __restrict__ SGWl, const float* __restrict__ sgb, const float* __restrict__ lng, bf16_t* __restrict__ OC, int b, int ch) {
    const int lane = F.lane, wid = F.wave, n = lane & 31, hi = lane >> 5;
    const size_t tok0 = (size_t)b * SEQ + ch * 128;
    LAS unsigned char* V = F.lds;
    __syncthreads();
    float gl[8];
    { const f32x4 g0 = *(const f32x4*)(lng + 8 * lane), g1 = *(const f32x4*)(lng + 8 * lane + 4); gl[0] = g0[0]; gl[1] = g0[1]; gl[2] = g0[2]; gl[3] = g0[3]; gl[4] = g1[0]; gl[5] = g1[1]; gl[6] = g1[2]; gl[7] = g1[3]; }
    for (int rr = 0; rr < 16; ++rr) { const int row = 16 * wid + rr;
        const u32x4 w = *(const u32x4*)(PROJ + (tok0 + row) * NPROJ + C_V + 8 * lane);
        float x[8] = {bf_lo(w.x), bf_hi(w.x), bf_lo(w.y), bf_hi(w.y), bf_lo(w.z), bf_hi(w.z), bf_lo(w.w), bf_hi(w.w)};
        float s = 0.f;
#pragma unroll
        for (int i = 0; i < 8; ++i) s += x[i];
        const float mean = wave_sum(s) * (1.f / 512.f); float q = 0.f;
#pragma unroll
        for (int i = 0; i < 8; ++i) { x[i] -= mean; q += x[i] * x[i]; }
        const float rstd = 1.f / sqrtf(wave_sum(q) * (1.f / 512.f) + LN_EPS);
        u32x4 o; o.x = cvt_pk_bf16(x[0] * rstd * gl[0], x[1] * rstd * gl[1]); o.y = cvt_pk_bf16(x[2] * rstd * gl[2], x[3] * rstd * gl[3]);
        o.z = cvt_pk_bf16(x[4] * rstd * gl[4], x[5] * rstd * gl[5]); o.w = cvt_pk_bf16(x[6] * rstd * gl[6], x[7] * rstd * gl[7]);
        *(LAS u32x4*)(V + row * SGS + 16 * lane) = o; }
    __syncthreads();
    const int g = wid;
    const int vbase = (8 * hi + ((lane & 15) >> 2)) * SGS + (g * 64 + 16 * ((lane >> 4) & 1) + 4 * (lane & 3)) * 2;
    const bf16_t* wg = SGWl + (size_t)g * 128 * 128;
#pragma unroll 1
    for (int tb = 0; tb < 4; ++tb) {
        f32x16 a0, a1;
#pragma unroll
        for (int r = 0; r < 16; ++r) { a0[r] = 0.f; a1[r] = 0.f; }
        const bf16_t* wrow = wg + (size_t)(32 * tb + n) * 128 + 8 * hi;
        for (int ks = 0; ks < 2 * tb + 2; ++ks) {
            const bf16x8 af = *(const bf16x8*)(wrow + 16 * ks);
#pragma unroll
            for (int db = 0; db < 2; ++db) { bf16x8 vf;
#if USE_TR
                const v4i16_t t0 = __builtin_amdgcn_ds_read_tr16_b64_v4i16((LAS v4i16_t*)(V + vbase + (16 * ks) * SGS + 64 * db));
                const v4i16_t t1 = __builtin_amdgcn_ds_read_tr16_b64_v4i16((LAS v4i16_t*)(V + vbase + (16 * ks + 4) * SGS + 64 * db));
                vf = (bf16x8){t0[0], t0[1], t0[2], t0[3], t1[0], t1[1], t1[2], t1[3]};
#else
#pragma unroll
                for (int j = 0; j < 8; ++j) vf[j] = *(const LAS short*)(V + (16 * ks + 8 * hi + j) * SGS + (g * 64 + 32 * db + n) * 2);
#endif
                if (db == 0) a0 = __builtin_amdgcn_mfma_f32_32x32x16_bf16(af, vf, a0, 0, 0, 0); else a1 = __builtin_amdgcn_mfma_f32_32x32x16_bf16(af, vf, a1, 0, 0, 0); }
        }
#pragma unroll
        for (int r = 0; r < 16; ++r) { const int t = 32 * tb + 8 * (r >> 2) + 4 * hi + (r & 3); const float bb = sgb[g * 128 + t];
            const bf16_t* up = PROJ + (tok0 + t) * NPROJ + C_U + g * 64 + n; bf16_t* op = OC + (tok0 + t) * 512 + g * 64 + n;
            const float u0 = __builtin_bit_cast(float, (unsigned)up[0] << 16), u1 = __builtin_bit_cast(float, (unsigned)up[32] << 16);
            op[0] = (bf16_t)f2bf((a0[r] + bb) * u0); op[32] = (bf16_t)f2bf((a1[r] + bb) * u1); }
    }
}
constexpr int HS_STRIDE = 2064;
constexpr int P7_PART = 32 * HS_STRIDE;
constexpr int P7_LOG = P7_PART + 8 * 4096;
constexpr int P7_HIST = P7_LOG + 32 * 33 * 4;
__device__ __forceinline__ void p7_route(const Frame& F, const Args& a, int l, const float* xin, float* xout, const float* Y, const float* SSP, const float* MODl, bf16_t* H,
                                         const bf16_t* WRTl, unsigned* cnt, int* ROWTOK, unsigned* TOKINFO) {
    const int tid = F.tid, lane = F.lane, wid = F.wave, n = lane & 31, hi = lane >> 5;
    const float* g_post = a.in[5] + l * DM; const float* g_pre = a.in[6] + l * DM; const float* b_router = a.in[16] + l * NE;
    LAS unsigned char* hs = F.lds; LAS float* part = (LAS float*)(F.lds + P7_PART); LAS float* lg = (LAS float*)(F.lds + P7_LOG); LAS int* hist = (LAS int*)(F.lds + P7_HIST); LAS int* base = hist + 32;
    if (tid < 32) hist[tid] = 0;
    __syncthreads();
    for (int bt = F.vcu; bt < MTOK / 32; bt += F.G) {
        const int row0 = bt * 32, b = row0 >> 11;
        const float* mb = MODl + (size_t)b * 6 * DM;
#pragma unroll 1
        for (int rr = 0; rr < 4; ++rr) { const int rl = 4 * wid + rr; const size_t row = (size_t)row0 + rl;
            const f32x4 s4 = *(const f32x4*)(SSP + row * 16 + 4 * (lane & 3));
            float ssy = (s4[0] + s4[1]) + (s4[2] + s4[3]); ssy += __shfl_xor(ssy, 1); ssy += __shfl_xor(ssy, 2);
            const float rstd1 = 1.f / sqrtf(ssy * (1.f / DM) + RMS_EPS);
            f32x4 v[4]; float ss = 0.f;
#pragma unroll
            for (int j = 0; j < 4; ++j) { const int c = 4 * lane + 256 * j; const f32x4 yy = *(const f32x4*)(Y + row * DM + c), xx = *(const f32x4*)(xin + row * DM + c);
                const f32x4 gp = *(const f32x4*)(g_post + c), ga = *(const f32x4*)(mb + 2 * DM + c);
                v[j] = xx + ga * (yy * rstd1 * gp); *(f32x4*)(xout + row * DM + c) = v[j];
                ss += (v[j][0] * v[j][0] + v[j][1] * v[j][1]) + (v[j][2] * v[j][2] + v[j][3] * v[j][3]); }
            ss = wave_sum(ss);
            const float rstd = 1.f / sqrtf(ss * (1.f / DM) + RMS_EPS);
#pragma unroll
            for (int j = 0; j < 4; ++j) { const int c = 4 * lane + 256 * j; const f32x4 gg = *(const f32x4*)(g_pre + c), s1 = *(const f32x4*)(mb + 4 * DM + c), s0 = *(const f32x4*)(mb + 3 * DM + c);
                const f32x4 o = (v[j] * rstd) * gg * (s1 + 1.f) + s0; u32x2 w; w.x = cvt_pk_bf16(o[0], o[1]); w.y = cvt_pk_bf16(o[2], o[3]);
                *(u32x2*)(H + row * DM + c) = w; *(LAS u32x2*)(hs + rl * HS_STRIDE + c * 2) = w; } }
        __syncthreads();
        {
            f32x16 d;
#pragma unroll
            for (int r = 0; r < 16; ++r) d[r] = 0.f;
#pragma unroll
            for (int ks = 0; ks < 8; ++ks) { const int k0 = (8 * wid + ks) * 16 + 8 * hi;
                const bf16x8 af = *(const LAS bf16x8*)(hs + n * HS_STRIDE + k0 * 2); const bf16x8 bf = *(const bf16x8*)(WRTl + (size_t)n * DM + k0);
                d = __builtin_amdgcn_mfma_f32_32x32x16_bf16(af, bf, d, 0, 0, 0); }
#pragma unroll
            for (int r = 0; r < 16; ++r) part[wid * 1024 + (8 * (r >> 2) + 4 * hi + (r & 3)) * 32 + n] = d[r];
        }
        __syncthreads();
        for (int i = tid; i < 1024; i += 512) { float s = b_router[i & 31];
#pragma unroll
            for (int w = 0; w < 8; ++w) s += part[w * 1024 + i]; lg[(i >> 5) * 33 + (i & 31)] = s; }
        __syncthreads();
        int e_k[4] = {0, 0, 0, 0}, lp_k[4] = {0, 0, 0, 0}; float w_k[4] = {0.f, 0.f, 0.f, 0.f};
        if (tid < 32) { LAS float* mylg = lg + tid * 33; float tl[4];
#pragma unroll
            for (int k = 0; k < 4; ++k) { float best = -INFINITY; int bi = 0;
                for (int e = 0; e < 32; ++e) { const float vv = mylg[e]; if (vv > best) { best = vv; bi = e; } }
                tl[k] = best; e_k[k] = bi; mylg[bi] = -INFINITY; }
            float sum = 0.f;
#pragma unroll
            for (int k = 0; k < 4; ++k) { w_k[k] = __expf(tl[k] - tl[0]); sum += w_k[k]; }
            const float inv = 1.f / sum;
#pragma unroll
            for (int k = 0; k < 4; ++k) { w_k[k] *= inv; lp_k[k] = __hip_atomic_fetch_add(&hist[e_k[k]], 1, __ATOMIC_RELAXED, __HIP_MEMORY_SCOPE_WORKGROUP); } }
        __syncthreads();
        if (tid < 32) { const int hc = hist[tid]; base[tid] = hc > 0 ? (int)__hip_atomic_fetch_add(cnt + 64 * tid, (unsigned)hc, __ATOMIC_RELAXED, __HIP_MEMORY_SCOPE_AGENT) : 0; hist[tid] = 0; }
        __syncthreads();
        if (tid < 32) { const int token = row0 + tid; u32x4 info; f32x4 ww;
#pragma unroll
            for (int k = 0; k < 4; ++k) { const int pos = base[e_k[k]] + lp_k[k]; ROWTOK[e_k[k] * 65536 + pos] = token; info[k] = ((unsigned)e_k[k] << 17) | (unsigned)pos; ww[k] = w_k[k]; }
            *(u32x4*)(TOKINFO + (size_t)token * 8) = info; *(f32x4*)(TOKINFO + (size_t)token * 8 + 4) = ww; }
        __syncthreads();
    }
}

__device__ __forceinline__ int moe_tables(const Frame& F, unsigned* cnt) {
    LAS int* ts = (LAS int*)(F.lds + TS_OFF); LAS int* te = (LAS int*)(F.lds + TILE_E_OFF);
    __syncthreads();
    if (F.tid == 0) { int acc = 0; for (int e = 0; e < NE; ++e) { ts[e] = acc; const unsigned c = __hip_atomic_load(cnt + 64 * e, __ATOMIC_RELAXED, __HIP_MEMORY_SCOPE_AGENT); acc += (int)((c + 255u) >> 8); } ts[NE] = acc; }
    __syncthreads();
    const int RT = ts[NE];
    for (int rt = F.tid; rt < RT; rt += 512) { int e = 0;
#pragma unroll 1
        for (int q = 1; q < NE; ++q) e += (ts[q] <= rt) ? 1 : 0;
        te[rt] = e; }
    __syncthreads();
    return RT;
}

__device__ __forceinline__ void p10_combine(const Frame& F, const Args& a, int l, float* xio, const bf16_t* Y2, const unsigned* TOKINFO, const float* MODbase, bf16_t* H) {
    const int lane = F.lane; const LAS int* ts = (const LAS int*)(F.lds + TS_OFF);
    const float* g_postf = a.in[7] + l * DM;
    const int gw = F.vcu * 8 + F.wave, NGW = F.G * 8;
    for (int row = gw; row < MTOK; row += NGW) { const int b = row >> 11;
        const u32x4 info = *(const u32x4*)(TOKINFO + (size_t)row * 8); const f32x4 ww = *(const f32x4*)(TOKINFO + (size_t)row * 8 + 4);
        f32x4 y[4];
#pragma unroll
        for (int j = 0; j < 4; ++j) y[j] = (f32x4){0.f, 0.f, 0.f, 0.f};
#pragma unroll
        for (int k = 0; k < 4; ++k) { const int e = (int)(info[k] >> 17), pos = (int)(info[k] & 0x1ffffu); const size_t slot = (size_t)ts[e] * 256 + pos; const float wk = ww[k];
#pragma unroll
            for (int j = 0; j < 4; ++j) { const u32x2 w = *(const u32x2*)(Y2 + slot * DM + 4 * lane + 256 * j);
                y[j][0] += wk * bf_lo(w.x); y[j][1] += wk * bf_hi(w.x); y[j][2] += wk * bf_lo(w.y); y[j][3] += wk * bf_hi(w.y); } }
        float ss = 0.f;
#pragma unroll
        for (int j = 0; j < 4; ++j) ss += (y[j][0] * y[j][0] + y[j][1] * y[j][1]) + (y[j][2] * y[j][2] + y[j][3] * y[j][3]);
        ss = wave_sum(ss);
        const float rstd = 1.f / sqrtf(ss * (1.f / DM) + RMS_EPS);
        const float* mb = MODbase + ((size_t)l * BATCH + b) * 6 * DM;
        f32x4 v[4]; float s2 = 0.f;
#pragma unroll
        for (int j = 0; j < 4; ++j) { const int c = 4 * lane + 256 * j; const f32x4 xx = *(const f32x4*)(xio + (size_t)row * DM + c), gp = *(const f32x4*)(g_postf + c), ga = *(const f32x4*)(mb + 5 * DM + c);
            v[j] = xx + ga * (y[j] * rstd * gp); *(f32x4*)(xio + (size_t)row * DM + c) = v[j];
            s2 += (v[j][0] * v[j][0] + v[j][1] * v[j][1]) + (v[j][2] * v[j][2] + v[j][3] * v[j][3]); }
        if (l + 1 < DEPTH) { s2 = wave_sum(s2); const float* mb1 = MODbase + ((size_t)(l + 1) * BATCH + b) * 6 * DM;
            norm_mod_row(v, s2, a.in[4] + (l + 1) * DM, mb1 + DM, mb1, H + (size_t)row * DM, lane); }
    }
}
#ifndef MK_ONE_LAUNCH
#define MK_ONE_LAUNCH 0
#endif
constexpr int N_PHASES = 2 + 9 * DEPTH;
__global__ void __launch_bounds__(512, 2) fwd(Args args) {
    extern __shared__ __attribute__((aligned(16))) unsigned char lds_raw[];
    Frame F0;
    F0.lds = (LAS unsigned char*)lds_raw;
    F0.tid = threadIdx.x; F0.lane = F0.tid & 63; F0.wave = __builtin_amdgcn_readfirstlane(F0.tid >> 6);
    F0.G = gridDim.x; { const int bx = blockIdx.x; F0.vcu = (F0.G % 8 == 0) ? (bx % 8) * (F0.G / 8) + bx / 8 : bx; }
    volatile LAS unsigned* MISC = (volatile LAS unsigned*)(F0.lds + MISC_OFF);
    for (int u = F0.tid; u < 128; u += 512) MISC[u] = 0u;
    __syncthreads();
    unsigned* ctl = (unsigned*)(args.ws + WS_CTL);
    const int lo = args.ph_lo, hi = args.ph_hi;
    XcdBarrier bar; bar.bar = ctl + CW_BAR; bar.x = 0; bar.st = nullptr;
    if (hi - lo > 1) bar = xcd_barrier_post(ctl + CW_BAR, MISC + 8);
#ifndef PHASE_MASK
#define PHASE_MASK 0x7ff
#endif
#define PHON(j) ((PHASE_MASK >> (j)) & 1)
#define IN(k) (lo <= (k) && (k) < hi)
#define BOTH(k) (IN(k) && IN((k) + 1))
#define GRID_BAR() xcd_barrier(bar)
#define PH_BEGIN() const Frame F = phase_frame(F0); unsigned char* ws = opq(args.ws); (void)ws
    if (PHON(0) && IN(0)) { PH_BEGIN(); p0_mod(F, args.in[1], args.in[2], args.in[3], (float*)(ws + WS_MOD)); p0_weights(F, args); if (BOTH(0)) GRID_BAR(); }
    if (PHON(1) && IN(1)) { PH_BEGIN(); p1_norm(F, args.in[0], args.in[4], (const float*)(ws + WS_MOD), (bf16_t*)(ws + WS_H)); if (BOTH(1)) GRID_BAR(); }

#pragma unroll 1
    for (int l = 0; l < DEPTH; ++l) {
        const int pb = 2 + 9 * l;
        if (PHON(2) && IN(pb + 0)) { PH_BEGIN();
            pg8::Gemm g{(const bf16_t*)(ws + WS_H), (const bf16_t*)(ws + WS_W + (size_t)l * W_LAYER + WO_WIN), DM}; pg8::StaticOrder S; S.init(MTOK / 256, NPROJ / 256, F.G, (int)blockIdx.x);
            EpiProj E{(bf16_t*)(ws + WS_PROJ)};
            pg8::gemm_phase<EpiProj, pg8::StaticOrder, false>(F.lds, g, S, E);
            if (BOTH(pb + 0)) GRID_BAR();
        }
        if (PHON(3) && IN(pb + 1)) { PH_BEGIN();
            const bf16_t* PROJ = (const bf16_t*)(ws + WS_PROJ); bf16_t* OABC = (bf16_t*)(ws + WS_O);
            for (int u = F.vcu; u < 4096; u += F.G) dsa_index_unit(F, PROJ, (unsigned long long*)(ws + WS_BITS), u & 31, u >> 5);
            for (int u = F.vcu; u < 2048; u += F.G) { const int cu = u & 255, j = u >> 8, bg = cu >> 2, s = cu & 3, qb = (j & 1) ? (8 * (j >> 1) + 7 - s) : (8 * (j >> 1) + s);
                attn_unit<0>(F, PROJ, OABC, nullptr, args.in[9] + l * 8, bg >> 1, bg & 1, qb); }
            for (int u = F.vcu; u < 512; u += F.G)
                sg_unit(F, PROJ, (const bf16_t*)(ws + WS_SGW) + (size_t)l * 8 * 128 * 128, args.in[11] + l * 8 * 128, args.in[12] + l * 512, OABC + (size_t)2 * MTOK * 512, u >> 4, u & 15);
            if (BOTH(pb + 1)) GRID_BAR();
        }
        if (PHON(4) && IN(pb + 2)) { PH_BEGIN();
            for (int u = F.vcu; u < 2048; u += F.G) { const int cu = u & 255, j = u >> 8, bg = cu >> 2, s = cu & 3, qb = (j & 1) ? (8 * (j >> 1) + 7 - s) : (8 * (j >> 1) + s);
                attn_unit<1>(F, (const bf16_t*)(ws + WS_PROJ), (bf16_t*)(ws + WS_O) + (size_t)MTOK * 512, (const unsigned*)(ws + WS_BITS), nullptr, bg >> 1, bg & 1, qb); }
            __syncthreads();
            if (BOTH(pb + 2)) GRID_BAR();
        }
        if (PHON(5) && IN(pb + 3)) { PH_BEGIN();
            pg8::Gemm g{(const bf16_t*)(ws + WS_O), (const bf16_t*)(ws + WS_W + (size_t)l * W_LAYER + WO_WBR), 512}; BranchOrder S; S.so.init(MTOK / 256, DM / 256, F.G, (int)blockIdx.x);
            EpiBranch E{(const bf16_t*)(ws + WS_PROJ), (float*)(ws + WS_SLAB) + (size_t)blockIdx.x * 65536, (bf16_t*)(ws + WS_H)};
            pg8::gemm_phase<EpiBranch, BranchOrder, false>(F.lds, g, S, E);
            if (BOTH(pb + 3)) GRID_BAR();
        }
        if (PHON(6) && IN(pb + 4)) { PH_BEGIN();
            pg8::Gemm g{(const bf16_t*)(ws + WS_H), (const bf16_t*)(ws + WS_W + (size_t)l * W_LAYER + WO_WOUT), DM}; pg8::StaticOrder S; S.init(MTOK / 256, DM / 256, F.G, (int)blockIdx.x);
            EpiWout E{(float*)(ws + WS_Y), (float*)(ws + WS_SSP)};
            pg8::gemm_phase<EpiWout, pg8::StaticOrder, false>(F.lds, g, S, E);
            if (BOTH(pb + 4)) GRID_BAR();
        }
        if (PHON(7) && IN(pb + 5)) { PH_BEGIN();
            p7_route(F, args, l, l == 0 ? args.in[0] : (const float*)args.out, args.out, (const float*)(ws + WS_Y), (const float*)(ws + WS_SSP), (const float*)(ws + WS_MOD) + (size_t)l * BATCH * 6 * DM, (bf16_t*)(ws + WS_H),
                     (const bf16_t*)(ws + WS_WRT) + (size_t)l * NE * DM, (unsigned*)(ws + WS_CTL) + CW_CNT + l * 32 * 64, (int*)(ws + WS_ROWTOK), (unsigned*)(ws + WS_TOKINFO));
            if (BOTH(pb + 5)) GRID_BAR();
        }
        if (PHON(8) && IN(pb + 6)) { PH_BEGIN();
            unsigned* cnt = (unsigned*)(ws + WS_CTL) + CW_CNT + l * 32 * 64; const int* ROWTOK = (const int*)(ws + WS_ROWTOK);
            const int RT = moe_tables(F, cnt);
            LAS int* ts = (LAS int*)(F.lds + TS_OFF); LAS int* te = (LAS int*)(F.lds + TILE_E_OFF); LAS int* ri = (LAS int*)(F.lds + ROWIDX_OFF);
            const long U = (long)RT * 8; MoeOrder S; S.u0 = (int)(U * F.vcu / F.G); S.u1 = (int)(U * (F.vcu + 1) / F.G); S.NB = 8; S.rt_lo = S.u0 / 8; S.tile_e = te; S.rowidx = ri;
            if (S.u1 > S.u0) { const int rt_hi = (S.u1 - 1) / 8; int ntile = rt_hi - S.rt_lo + 1; if (ntile > 8) ntile = 8;
                for (int i = F.tid; i < ntile * 256; i += 512) { const int rt = S.rt_lo + (i >> 8), r = i & 255, e = te[rt], first = (rt - ts[e]) * 256 + r;
                    const int c = (int)__hip_atomic_load(cnt + 64 * e, __ATOMIC_RELAXED, __HIP_MEMORY_SCOPE_AGENT); ri[i] = first < c ? ROWTOK[e * 65536 + first] : 0; } }
            __syncthreads();
            pg8::Gemm g{(const bf16_t*)(ws + WS_H), (const bf16_t*)(ws + WS_W + (size_t)l * W_LAYER + WO_W1), DM};
            EpiW1 E{(bf16_t*)(ws + WS_ACT), args.in[18] + (size_t)l * NE * 2 * FF};
            pg8::gemm_phase<EpiW1, MoeOrder, true>(F.lds, g, S, E);
            if (BOTH(pb + 6)) GRID_BAR();
        }
        if (PHON(9) && IN(pb + 7)) { PH_BEGIN();
            const int RT = moe_tables(F, (unsigned*)(ws + WS_CTL) + CW_CNT + l * 32 * 64);
            const long U = (long)RT * 4; MoeOrder S; S.u0 = (int)(U * F.vcu / F.G); S.u1 = (int)(U * (F.vcu + 1) / F.G); S.NB = 4; S.rt_lo = 0; S.tile_e = (LAS int*)(F.lds + TILE_E_OFF); S.rowidx = nullptr;
            pg8::Gemm g{(const bf16_t*)(ws + WS_ACT), (const bf16_t*)(ws + WS_W + (size_t)l * W_LAYER + WO_W2), FF};
            EpiW2 E{(bf16_t*)(ws + WS_Y2), args.in[20] + (size_t)l * NE * DM};
            pg8::gemm_phase<EpiW2, MoeOrder, false>(F.lds, g, S, E);
            if (BOTH(pb + 7)) GRID_BAR();
        }
        if (PHON(10) && IN(pb + 8)) { PH_BEGIN();
            (void)moe_tables(F, (unsigned*)(ws + WS_CTL) + CW_CNT + l * 32 * 64);
            p10_combine(F, args, l, args.out, (const bf16_t*)(ws + WS_Y2), (const unsigned*)(ws + WS_TOKINFO), (const float*)(ws + WS_MOD), (bf16_t*)(ws + WS_H));
            if (BOTH(pb + 8)) GRID_BAR();
        }
    }
#undef PH_BEGIN
#undef IN
#undef BOTH
#undef GRID_BAR
}

extern "C" void kernel_launch(void* const* d_in, const int* in_sizes, int n_in, void* d_out, int out_size, void* d_ws, size_t ws_size, hipStream_t stream) {
    static int grid = 0;
    if (grid == 0) {
        if (n_in != 21 || out_size != MTOK * DM || ws_size < WS_END) { fprintf(stderr, "kernel_launch: unexpected shapes (n_in %d, out %d, ws %zu); nothing launched\n", n_in, out_size, ws_size); grid = -1; return; }
        int dev = 0, cus = 0, per_cu = 0;
        if (hipGetDevice(&dev) != hipSuccess || hipDeviceGetAttribute(&cus, hipDeviceAttributeMultiprocessorCount, dev) != hipSuccess) { grid = -1; return; }
        if (hipFuncSetAttribute((const void*)fwd, hipFuncAttributeMaxDynamicSharedMemorySize, LDS_BYTES) != hipSuccess) { fprintf(stderr, "kernel_launch: hipFuncSetAttribute failed\n"); grid = -1; return; }
        if (hipOccupancyMaxActiveBlocksPerMultiprocessor(&per_cu, (const void*)fwd, 512, LDS_BYTES) != hipSuccess || per_cu < 1) { fprintf(stderr, "kernel_launch: occupancy query says %d\n", per_cu); }
        (void)hipGetLastError();
        grid = cus > 256 ? 256 : cus;
    }
    if (grid < 0) return;
    (void)hipMemsetAsync((char*)d_ws + WS_CTL, 0, CTL_ZERO_BYTES, stream);
    Args a{};
    for (int i = 0; i < 21; ++i) a.in[i] = (const float*)d_in[i];
    a.out = (float*)d_out; a.ws = (unsigned char*)d_ws;
#if MK_ONE_LAUNCH
    a.ph_lo = 0; a.ph_hi = N_PHASES;
    hipLaunchKernelGGL(fwd, dim3(grid), dim3(512), LDS_BYTES, stream, a);
#else
    for (int p = 0; p < N_PHASES; ++p) { a.ph_lo = p; a.ph_hi = p + 1; hipLaunchKernelGGL(fwd, dim3(grid), dim3(512), LDS_BYTES, stream, a); }
#endif
}
```

```cpp
#include <hip/hip_runtime.h>
#include <cstdio>
#include <cstdint>

#define LAS __attribute__((address_space(3)))
#define GAS __attribute__((address_space(1)))
typedef unsigned short bf16_t;
typedef short bf16x8 __attribute__((ext_vector_type(8)));
typedef float f32x2 __attribute__((ext_vector_type(2)));
typedef float f32x4 __attribute__((ext_vector_type(4)));
typedef float f32x16 __attribute__((ext_vector_type(16)));
typedef unsigned u32x2 __attribute__((ext_vector_type(2)));
typedef unsigned u32x4 __attribute__((ext_vector_type(4)));
typedef short v4i16_t __attribute__((ext_vector_type(4)));

constexpr int BATCH = 32, SEQ = 2048, DM = 1024, MTOK = BATCH * SEQ, DEPTH = 2;
constexpr int NPROJ = 6144;
constexpr int C_QA = 0, C_KA = 512, C_VA = 640, C_QB = 768, C_KB = 1280, C_VB = 1408, C_QI = 1536, C_KI = 1792, C_WI = 1824, C_U = 2048, C_V = 2560, C_G = 3072;
constexpr int NE = 32, FF = 1024;
constexpr float RMS_EPS = 1e-5f, LN_EPS = 1e-5f;
constexpr float LOG2E = 1.4426950408889634f;
constexpr float QSCALE = 0.125f * LOG2E;

__device__ __forceinline__ unsigned f2bf(float f) { unsigned u = __builtin_bit_cast(unsigned, f); return (u + 0x7fffu + ((u >> 16) & 1u)) >> 16; }
__device__ __forceinline__ unsigned cvt_pk_bf16(float lo, float hi) { unsigned r; asm volatile("v_cvt_pk_bf16_f32 %0, %1, %2" : "=v"(r) : "v"(lo), "v"(hi)); return r; }
__device__ __forceinline__ float bf_lo(unsigned w) { return __builtin_bit_cast(float, w << 16); }
__device__ __forceinline__ float bf_hi(unsigned w) { return __builtin_bit_cast(float, w & 0xffff0000u); }
__device__ __forceinline__ float fexp2(float x) { return __builtin_amdgcn_exp2f(x); }
__device__ __forceinline__ float frcp(float x) { return __builtin_amdgcn_rcpf(x); }
__device__ __forceinline__ float sigmoidf_(float x) { return frcp(1.f + fexp2(-LOG2E * x)); }
__device__ __forceinline__ float gelu_tanh(float x) { const float t = x + 0.044715f * x * x * x; return x * frcp(1.f + fexp2(-2.302208198f * t)); }
__device__ __forceinline__ float wave_sum(float v) {
#pragma unroll
    for (int o = 1; o < 64; o <<= 1) v += __shfl_xor(v, o);
    return v;
}
__device__ __forceinline__ unsigned wave_sum_u32(unsigned v) {
    v += (unsigned)__builtin_amdgcn_update_dpp(0, (int)v, 0xB1, 0xF, 0xF, false);
    v += (unsigned)__builtin_amdgcn_update_dpp(0, (int)v, 0x4E, 0xF, 0xF, false);
    v += (unsigned)__builtin_amdgcn_update_dpp(0, (int)v, 0x141, 0xF, 0xF, false);
    v += (unsigned)__builtin_amdgcn_update_dpp(0, (int)v, 0x140, 0xF, 0xF, false);
    return __builtin_amdgcn_readlane(v, 0) + __builtin_amdgcn_readlane(v, 16) + __builtin_amdgcn_readlane(v, 32) + __builtin_amdgcn_readlane(v, 48);
}
__device__ __forceinline__ unsigned wave_max_u32(unsigned v) {
    unsigned t;
    t = (unsigned)__builtin_amdgcn_update_dpp(0, (int)v, 0xB1, 0xF, 0xF, false); v = v > t ? v : t;
    t = (unsigned)__builtin_amdgcn_update_dpp(0, (int)v, 0x4E, 0xF, 0xF, false); v = v > t ? v : t;
    t = (unsigned)__builtin_amdgcn_update_dpp(0, (int)v, 0x141, 0xF, 0xF, false); v = v > t ? v : t;
    t = (unsigned)__builtin_amdgcn_update_dpp(0, (int)v, 0x140, 0xF, 0xF, false); v = v > t ? v : t;
    unsigned a = __builtin_amdgcn_readlane(v, 0), b = __builtin_amdgcn_readlane(v, 16), c = __builtin_amdgcn_readlane(v, 32), d = __builtin_amdgcn_readlane(v, 48);
    a = a > b ? a : b; c = c > d ? c : d; return a > c ? a : c;
}
#define LDS_WAIT() asm volatile("s_waitcnt lgkmcnt(0)" ::: "memory")
#define VM_WAIT() asm volatile("s_waitcnt vmcnt(0)" ::: "memory")

namespace pg8 {
constexpr int BM = 256, BK = 64, HALF = 128, HTB = HALF * BK * 2  , STAGE_BYTES = 8 * HTB, NXCD = 8, WGM = 8;
__host__ __device__ __forceinline__ int lds_byte(int r, int c) { const int st = (r >> 4) * 2 + (c >> 5), rr = r & 15, cc = c & 31, ob = rr * 64 + cc * 2; return st * 1024 + (ob ^ (((ob >> 9) & 1) << 5)); }
__host__ __device__ __forceinline__ void stage_rc(int b, int& R, int& C) { const int st = b / 1024, sb = b % 1024, swz = sb ^ (((sb >> 9) & 1) << 5); R = (st >> 1) * 16 + swz / 64; C = (st & 1) * 32 + (swz % 64) / 2; }
__host__ __device__ __forceinline__ int perm32(int rho) { const int n = rho >> 4, i = rho & 15; return 8 * (i >> 2) + 4 * n + (i & 3); }

struct Unit { int pm, pn; };
struct Gemm { const bf16_t* A; const bf16_t* Bt; int K; };

struct StaticOrder {
    int nM, nN, nwg, G, c;
    __device__ void init(int nM_, int nN_, int G_, int c_) { nM = nM_; nN = nN_; nwg = nM * nN; G = G_; c = c_; }
    __device__ __forceinline__ bool tile(int i, int& pm, int& pn) const {
        const long L = (long)i * G + c; if (L >= nwg) return false;
        int wgid = (int)L; { const int q = nwg / NXCD, r = nwg % NXCD, xcd = wgid % NXCD, off = wgid / NXCD; wgid = (xcd < r ? xcd * (q + 1) : r * (q + 1) + (xcd - r) * q) + off; }
        const int nig = WGM * nN, gid = wgid / nig, fm = gid * WGM, gsz = (nM - fm) < WGM ? (nM - fm) : WGM;
        pm = fm + ((wgid % nig) % gsz); pn = (wgid % nig) / gsz; return true;
    }
    __device__ __forceinline__ bool next(int i, Unit& u) const { return tile(i, u.pm, u.pn); }
};

template <class Epi, class Sched, bool GATHER>
__device__ __forceinline__ void gemm_phase(LAS unsigned char* lds, const Gemm g, const Sched& S, const Epi& E) {
    int tid = threadIdx.x; asm volatile("" : "+v"(tid));
    const int wid = __builtin_amdgcn_readfirstlane(tid >> 6), lane = tid & 63, wr = wid >> 2, wc = wid & 3, fr = lane & 15, fq = lane >> 4;
    const int K = g.K, nt = K / BK;
    unsigned voffA[2], voffB[2]; int RA[2], CA[2];
#pragma unroll
    for (int i = 0; i < 2; ++i) { int R, C; stage_rc(tid * 16 + i * 8192, R, C); const int Rb = (R & ~31) + perm32(R & 31); RA[i] = R; CA[i] = C;
        voffA[i] = (unsigned)(R * K + C) * 2u; voffB[i] = (unsigned)(Rb * K + C) * 2u; }
    const size_t kstep = (size_t)(BK * 2);
    const size_t hstep = (size_t)HALF * K * 2;
    const size_t tstep = 2 * hstep;
    const unsigned ldsw = (unsigned)wid * 1024u;
    const int aoff = lds_byte(wr * 64 + fr, fq * 8), boff = lds_byte(wc * 32 + fr, fq * 8);
#define PG8_SA(b, h) (((b) * 2 + (h)) * HTB)
#define PG8_SB(b, h) ((4 + (b) * 2 + (h)) * HTB)
#define PG8_STAGE(bufoff, gbase, voff) do { _Pragma("unroll") for (int _i = 0; _i < 2; ++_i) \
        __builtin_amdgcn_global_load_lds((const unsigned*)((const char*)(gbase) + (voff)[_i]), (LAS unsigned*)(lds + (bufoff) + ldsw + _i * 8192), 16, 0, 0); } while (0)
#define PG8_STAGE_A(bufoff, h, ubase, koff, VO) do { if constexpr (GATHER) { PG8_STAGE(bufoff, (const char*)g.A + (koff), VO[h]); } else { PG8_STAGE(bufoff, (ubase) + (h) * hstep + (koff), voffA); } } while (0)
#define PG8_LDA(dst, b, h) do { _Pragma("unroll") for (int m = 0; m < 4; ++m) _Pragma("unroll") for (int k = 0; k < 2; ++k) dst[m][k] = *(const LAS bf16x8*)(lds + PG8_SA(b, h) + aoff + m * 2048 + k * 1024); } while (0)
#define PG8_LDB(dst, b, h) do { _Pragma("unroll") for (int n = 0; n < 2; ++n) _Pragma("unroll") for (int k = 0; k < 2; ++k) dst[n][k] = *(const LAS bf16x8*)(lds + PG8_SB(b, h) + boff + n * 2048 + k * 1024); } while (0)
#define PG8_MMA(ai, bj, At, Bt) do { __builtin_amdgcn_s_setprio(1); _Pragma("unroll") for (int m = 0; m < 4; ++m) _Pragma("unroll") for (int n = 0; n < 2; ++n) _Pragma("unroll") for (int k = 0; k < 2; ++k) \
        acc[ai][bj][m][n] = __builtin_amdgcn_mfma_f32_16x16x32_bf16(Bt[n][k], At[m][k], acc[ai][bj][m][n], 0, 0, 0); __builtin_amdgcn_s_setprio(0); } while (0)
#define PG8_WAIT_V(n) asm volatile("s_waitcnt vmcnt(" #n ")" ::: "memory")
#define PG8_WAIT_L(n) asm volatile("s_waitcnt lgkmcnt(" #n ")" ::: "memory")
#define PG8_BAR __builtin_amdgcn_s_barrier()
#define PG8_SCHED __builtin_amdgcn_sched_barrier(0)
    Unit cur, nxt; int ui = 0;
    if (!S.next(0, cur)) return;
    f32x4 acc[2][2][4][2];
#pragma unroll
    for (int a = 0; a < 2; ++a)
#pragma unroll
        for (int b = 0; b < 2; ++b)
#pragma unroll
            for (int m = 0; m < 4; ++m)
#pragma unroll
                for (int n = 0; n < 2; ++n) acc[a][b][m][n] = (f32x4){0.f, 0.f, 0.f, 0.f};
    bf16x8 At[4][2], B0[2][2], B1[2][2];
    unsigned oc[2][2], on[2][2];
    if constexpr (GATHER) {
#pragma unroll
        for (int h = 0; h < 2; ++h)
#pragma unroll
            for (int i = 0; i < 2; ++i) { oc[h][i] = (unsigned)(S.src_row(cur, h * HALF + RA[i]) * K + CA[i]) * 2u; on[h][i] = oc[h][i]; }
    }
    const char* cA = GATHER ? (const char*)g.A : (const char*)g.A + (size_t)cur.pm * tstep; const char* cB = (const char*)g.Bt + (size_t)cur.pn * tstep;
    PG8_STAGE(PG8_SB(0, 0), cB, voffB); PG8_STAGE(PG8_SB(0, 1), cB + hstep, voffB); PG8_STAGE_A(PG8_SA(0, 0), 0, cA, 0, oc); PG8_STAGE_A(PG8_SA(0, 1), 1, cA, 0, oc);
    if (wr == 1) PG8_BAR;
    PG8_WAIT_V(2); PG8_BAR;
    PG8_STAGE(PG8_SB(1, 0), cB + kstep, voffB); PG8_STAGE_A(PG8_SA(1, 0), 0, cA, kstep, oc); PG8_STAGE(PG8_SB(1, 1), cB + hstep + kstep, voffB);
    PG8_WAIT_V(6); PG8_BAR;
    for (;;) {
        const bool has_next = S.next(ui + 1, nxt);
        const char* nA = GATHER ? (const char*)g.A : (has_next ? (const char*)g.A + (size_t)nxt.pm * tstep : cA); const char* nB = has_next ? (const char*)g.Bt + (size_t)nxt.pn * tstep : cB;
        if constexpr (GATHER) {
            if (has_next) {
#pragma unroll
                for (int h = 0; h < 2; ++h)
#pragma unroll
                    for (int i = 0; i < 2; ++i) on[h][i] = (unsigned)(S.src_row(nxt, h * HALF + RA[i]) * K + CA[i]) * 2u;
            }
        }
        for (int t = 0; t < nt; t += 2) {
            const bool last = (t == nt - 2);
            const size_t k1 = (size_t)(t + 1) * kstep;
            const size_t k2 = last ? (size_t)0 : (size_t)(t + 2) * kstep, k3 = k2 + kstep;
            const char* a2 = last ? nA : cA; const char* b2 = last ? nB : cB;
            unsigned o2[2][2];
            if constexpr (GATHER) {
#pragma unroll
                for (int h = 0; h < 2; ++h)
#pragma unroll
                    for (int i = 0; i < 2; ++i) o2[h][i] = last ? on[h][i] : oc[h][i];
            }
            PG8_LDB(B0, 0, 0); PG8_LDB(B1, 0, 1); PG8_SCHED; PG8_LDA(At, 0, 0); PG8_STAGE_A(PG8_SA(1, 1), 1, cA, k1, oc);
            PG8_WAIT_V(8); PG8_WAIT_L(0); PG8_BAR; PG8_MMA(0, 0, At, B0); PG8_MMA(0, 1, At, B1); PG8_BAR; PG8_SCHED;
            PG8_LDA(At, 0, 1); PG8_STAGE(PG8_SB(0, 0), b2 + k2, voffB); PG8_STAGE(PG8_SB(0, 1), b2 + hstep + k2, voffB); PG8_STAGE_A(PG8_SA(0, 0), 0, a2, k2, o2);
            PG8_WAIT_V(8); PG8_WAIT_L(0); PG8_BAR; PG8_MMA(1, 0, At, B0); PG8_MMA(1, 1, At, B1); PG8_BAR; PG8_SCHED;
            PG8_LDB(B0, 1, 0); PG8_LDB(B1, 1, 1); PG8_SCHED; PG8_LDA(At, 1, 0); PG8_STAGE_A(PG8_SA(0, 1), 1, a2, k2, o2);
            PG8_WAIT_V(8); PG8_WAIT_L(0); PG8_BAR; PG8_MMA(0, 0, At, B0); PG8_MMA(0, 1, At, B1); PG8_BAR; PG8_SCHED;
            PG8_LDA(At, 1, 1); PG8_STAGE(PG8_SB(1, 0), b2 + k3, voffB); PG8_STAGE(PG8_SB(1, 1), b2 + hstep + k3, voffB); PG8_STAGE_A(PG8_SA(1, 0), 0, a2, k3, o2);
            PG8_WAIT_V(8); PG8_WAIT_L(0); PG8_BAR; PG8_MMA(1, 0, At, B0); PG8_MMA(1, 1, At, B1); PG8_BAR; PG8_SCHED;
        }
        if (wr == 0) PG8_BAR;
        E(acc, cur, wr, wc, fr, fq);
        if (!has_next) break;
#pragma unroll
        for (int a = 0; a < 2; ++a)
#pragma unroll
            for (int b = 0; b < 2; ++b)
#pragma unroll
                for (int m = 0; m < 4; ++m)
#pragma unroll
                    for (int n = 0; n < 2; ++n) acc[a][b][m][n] = (f32x4){0.f, 0.f, 0.f, 0.f};
        cur = nxt; cA = nA; cB = nB; ++ui;
        if constexpr (GATHER) {
#pragma unroll
            for (int h = 0; h < 2; ++h)
#pragma unroll
                for (int i = 0; i < 2; ++i) oc[h][i] = on[h][i];
        }
        if (wr == 1) PG8_BAR;
    }
    PG8_WAIT_V(0);
    PG8_BAR;
#undef PG8_SA
#undef PG8_SB
#undef PG8_STAGE
#undef PG8_STAGE_A
#undef PG8_LDA
#undef PG8_LDB
#undef PG8_MMA
#undef PG8_WAIT_V
#undef PG8_WAIT_L
#undef PG8_BAR
#undef PG8_SCHED
}
}
typedef f32x4 acc_t[2][2][4][2];

struct EpiProj {
    bf16_t* O;
    __device__ __forceinline__ void operator()(const acc_t& acc, const pg8::Unit& u, int wr, int wc, int fr, int fq) const {
        const int pn = u.pn;
        const int act = (pn <= 1 || pn == 3 || pn == 4) ? 1 : (pn >= 12 ? 3 : (pn >= 8 ? 2 : 0));
        const int row0 = u.pm * 256 + wr * 64 + fr, col0 = pn * 256 + wc * 32 + 8 * fq;
#pragma unroll
        for (int ai = 0; ai < 2; ++ai)
#pragma unroll
            for (int m = 0; m < 4; ++m) { bf16_t* rowp = O + (size_t)(row0 + ai * 128 + m * 16) * NPROJ + col0;
#pragma unroll
                for (int bj = 0; bj < 2; ++bj) { f32x4 v0 = acc[ai][bj][m][0], v1 = acc[ai][bj][m][1];
                    if (act == 1) { v0 = v0 * QSCALE; v1 = v1 * QSCALE; }
                    else if (act == 2) {
#pragma unroll
                        for (int i = 0; i < 4; ++i) { v0[i] = gelu_tanh(v0[i]); v1[i] = gelu_tanh(v1[i]); } }
                    else if (act == 3) {
#pragma unroll
                        for (int i = 0; i < 4; ++i) { v0[i] = sigmoidf_(v0[i]); v1[i] = sigmoidf_(v1[i]); } }
                    u32x4 w; w.x = cvt_pk_bf16(v0[0], v0[1]); w.y = cvt_pk_bf16(v0[2], v0[3]); w.z = cvt_pk_bf16(v1[0], v1[1]); w.w = cvt_pk_bf16(v1[2], v1[3]);
                    *(u32x4*)(rowp + bj * 128) = w; } }
    }
};

struct BranchOrder {
    pg8::StaticOrder so;
    __device__ __forceinline__ bool next(int j, pg8::Unit& u) const { const int i = j / 3, br = j - 3 * i; int pm, pn; if (!so.tile(i, pm, pn)) return false; u.pm = br * 256 + pm; u.pn = br * 4 + pn; return true; }
};
struct EpiBranch {
    const bf16_t* PROJ; float* slab  ; bf16_t* MERGED;
    __device__ __forceinline__ void operator()(const acc_t& acc, const pg8::Unit& u, int wr, int wc, int fr, int fq) const {
        const int br = u.pn >> 2, pn = u.pn & 3, pm = u.pm & 255;
        const int row0 = pm * 256 + wr * 64 + fr, col0 = pn * 256 + wc * 32 + 8 * fq;
        int tx = threadIdx.x; asm volatile("" : "+v"(tx));
        float* sl = slab + (size_t)tx * 8;
#pragma unroll
        for (int ai = 0; ai < 2; ++ai)
#pragma unroll
            for (int m = 0; m < 4; ++m) { const size_t row = (size_t)(row0 + ai * 128 + m * 16);
#pragma unroll
                for (int bj = 0; bj < 2; ++bj) {
                    const u32x4 gw = *(const u32x4*)(PROJ + row * NPROJ + C_G + br * 1024 + col0 + bj * 128);
                    f32x4 v0 = acc[ai][bj][m][0], v1 = acc[ai][bj][m][1];
                    v0[0] *= bf_lo(gw.x); v0[1] *= bf_hi(gw.x); v0[2] *= bf_lo(gw.y); v0[3] *= bf_hi(gw.y);
                    v1[0] *= bf_lo(gw.z); v1[1] *= bf_hi(gw.z); v1[2] *= bf_lo(gw.w); v1[3] *= bf_hi(gw.w);
                    float* sp = sl + (size_t)((ai * 4 + m) * 2 + bj) * 4096;
                    if (br != 0) { v0 = v0 + *(const f32x4*)sp; v1 = v1 + *(const f32x4*)(sp + 4); }
                    if (br != 2) { *(f32x4*)sp = v0; *(f32x4*)(sp + 4) = v1; }
                    else { u32x4 w; w.x = cvt_pk_bf16(v0[0], v0[1]); w.y = cvt_pk_bf16(v0[2], v0[3]); w.z = cvt_pk_bf16(v1[0], v1[1]); w.w = cvt_pk_bf16(v1[2], v1[3]);
                        *(u32x4*)(MERGED + row * DM + col0 + bj * 128) = w; } }
                asm volatile("" ::: "memory"); }
    }
};

struct EpiWout {
    float* Y; float* SSP;
    __device__ __forceinline__ void operator()(const acc_t& acc, const pg8::Unit& u, int wr, int wc, int fr, int fq) const {
        const int row0 = u.pm * 256 + wr * 64 + fr, col0 = u.pn * 256 + wc * 32 + 8 * fq;
#pragma unroll
        for (int ai = 0; ai < 2; ++ai)
#pragma unroll
            for (int m = 0; m < 4; ++m) { const size_t row = (size_t)(row0 + ai * 128 + m * 16); float ss = 0.f;
#pragma unroll
                for (int bj = 0; bj < 2; ++bj) { const f32x4 v0 = acc[ai][bj][m][0], v1 = acc[ai][bj][m][1];
                    ss += (v0[0] * v0[0] + v0[1] * v0[1]) + (v0[2] * v0[2] + v0[3] * v0[3]) + (v1[0] * v1[0] + v1[1] * v1[1]) + (v1[2] * v1[2] + v1[3] * v1[3]);
                    float* yp = Y + row * DM + col0 + bj * 128; *(f32x4*)yp = v0; *(f32x4*)(yp + 4) = v1; }
                ss += __shfl_xor(ss, 16); ss += __shfl_xor(ss, 32);
                if (fq == 0) SSP[row * 16 + u.pn * 4 + wc] = ss; }
    }
};

struct MoeOrder {
    int u0, u1, NB, rt_lo;
    const LAS int* tile_e;
    const LAS int* rowidx;
    __device__ __forceinline__ bool next(int i, pg8::Unit& u) const { const int x = u0 + i; if (x >= u1) return false; const int rt = x / NB, pn = x - rt * NB; u.pm = rt; u.pn = tile_e[rt] * NB + pn; return true; }
    __device__ __forceinline__ int src_row(const pg8::Unit& u, int r) const { return rowidx[(u.pm - rt_lo) * 256 + r]; }
};
struct EpiW1 {
    bf16_t* ACT; const float* b1  ;
    __device__ __forceinline__ void operator()(const acc_t& acc, const pg8::Unit& u, int wr, int wc, int fr, int fq) const {
        const int e = u.pn >> 3, pn = u.pn & 7;
        const int row0 = u.pm * 256 + wr * 64 + fr, j0 = pn * 128 + wc * 32 + 8 * fq;
        const float* bp = b1 + (size_t)e * (2 * FF) + 2 * j0;
        float bg[8], bl[8];
#pragma unroll
        for (int q = 0; q < 4; ++q) { const f32x4 t = *(const f32x4*)(bp + 4 * q); bg[2 * q] = t[0]; bl[2 * q] = t[1]; bg[2 * q + 1] = t[2]; bl[2 * q + 1] = t[3]; }
#pragma unroll
        for (int ai = 0; ai < 2; ++ai)
#pragma unroll
            for (int m = 0; m < 4; ++m) { float a[8];
#pragma unroll
                for (int i = 0; i < 8; ++i) { float gl = acc[ai][0][m][i >> 2][i & 3] + bg[i], li = acc[ai][1][m][i >> 2][i & 3] + bl[i];
                    gl = fminf(gl, 7.f); li = fminf(fmaxf(li, -7.f), 7.f);
                    a[i] = gl * frcp(1.f + fexp2(-1.702f * LOG2E * gl)) * (li + 1.f); }
                u32x4 w; w.x = cvt_pk_bf16(a[0], a[1]); w.y = cvt_pk_bf16(a[2], a[3]); w.z = cvt_pk_bf16(a[4], a[5]); w.w = cvt_pk_bf16(a[6], a[7]);
                *(u32x4*)(ACT + (size_t)(row0 + ai * 128 + m * 16) * FF + j0) = w; }
    }
};
struct EpiW2 {
    bf16_t* Y2; const float* b2  ;
    __device__ __forceinline__ void operator()(const acc_t& acc, const pg8::Unit& u, int wr, int wc, int fr, int fq) const {
        const int e = u.pn >> 2, pn = u.pn & 3;
        const int row0 = u.pm * 256 + wr * 64 + fr, col0 = pn * 256 + wc * 32 + 8 * fq;
        f32x4 bv[2][2];
#pragma unroll
        for (int bj = 0; bj < 2; ++bj)
#pragma unroll
            for (int n = 0; n < 2; ++n) bv[bj][n] = *(const f32x4*)(b2 + (size_t)e * DM + col0 + bj * 128 + 4 * n);
#pragma unroll
        for (int ai = 0; ai < 2; ++ai)
#pragma unroll
            for (int m = 0; m < 4; ++m) { bf16_t* rowp = Y2 + (size_t)(row0 + ai * 128 + m * 16) * DM + col0;
#pragma unroll
                for (int bj = 0; bj < 2; ++bj) { const f32x4 v0 = acc[ai][bj][m][0] + bv[bj][0], v1 = acc[ai][bj][m][1] + bv[bj][1];
                    u32x4 w; w.x = cvt_pk_bf16(v0[0], v0[1]); w.y = cvt_pk_bf16(v0[2], v0[3]); w.z = cvt_pk_bf16(v1[0], v1[1]); w.w = cvt_pk_bf16(v1[2], v1[3]);
                    *(u32x4*)(rowp + bj * 128) = w; } }
    }
};
#define XB_TMO      128
#define XB_XCNT(j)  (256  + 64 * (j))
#define XB_XSUB(j)  (1280 + 64 * (j))
#define XB_XGEN(j)  (2304 + 64 * (j))
#define XB_TOP      3328
#define XB_TOPGEN   3392
#define XCD_BAR_WORDS 3456
#define XB_SPIN_CAP (1u << 18)

__device__ __forceinline__ unsigned xb_ld(unsigned* p)              { return __hip_atomic_load(p, __ATOMIC_RELAXED, __HIP_MEMORY_SCOPE_AGENT); }
__device__ __forceinline__ unsigned xb_add(unsigned* p, unsigned v) { return __hip_atomic_fetch_add(p, v, __ATOMIC_RELAXED, __HIP_MEMORY_SCOPE_AGENT); }
__device__ __forceinline__ unsigned xb_xcc_id() { return (unsigned)__builtin_amdgcn_s_getreg((3 << 11) | 20) & 0xFu; }
#define XB_SPIN(cond, bar) do { unsigned _sp = 0; while (cond) { __builtin_amdgcn_s_sleep(1); \
    if ((++_sp & 255u) == 0u) { if (xb_ld(&(bar)[XB_TMO])) break; if (_sp > XB_SPIN_CAP) { atomicAdd(&(bar)[XB_TMO], 1u); break; } } } } while (0)

struct XcdBarrier {
    unsigned* bar; unsigned x;
    volatile LAS unsigned* st;
};

__device__ __forceinline__ XcdBarrier xcd_barrier_post(unsigned* bar, volatile LAS unsigned* st) {
    XcdBarrier b; b.bar = bar; b.x = xb_xcc_id(); b.st = st;
    if (threadIdx.x == 0) (void)xb_add(&bar[XB_XCNT(b.x)], 1u);
    return b;
}
__device__ __forceinline__ void xcd_barrier_complete(unsigned* bar, unsigned x, unsigned& nloc, unsigned& nx) {
    const unsigned G = gridDim.x * gridDim.y * gridDim.z;
    unsigned sum, cnt, mine, sp = 0u;
    for (;;) {
        sum = 0u; cnt = 0u; mine = 0u;
#pragma unroll
        for (unsigned j = 0; j < 16; ++j) { const unsigned c = xb_ld(&bar[XB_XCNT(j)]); sum += c; cnt += (c > 0u) ? 1u : 0u; mine = (j == x) ? c : mine; }
        if (sum == G) break;
        __builtin_amdgcn_s_sleep(1);
        if ((++sp & 255u) == 0u) { if (xb_ld(&bar[XB_TMO])) break; if (sp > XB_SPIN_CAP) { atomicAdd(&bar[XB_TMO], 1u); break; } }
    }
    nloc = mine > 0u ? mine : 1u; nx = cnt > 0u ? cnt : 1u;
}

__device__ __forceinline__ void xcd_barrier(const XcdBarrier& b) {
    asm volatile("s_waitcnt vmcnt(0)" ::: "memory");
    __syncthreads();
    if (threadIdx.x == 0) {
        unsigned* bar = b.bar;
        __builtin_amdgcn_s_waitcnt(0);
        unsigned nloc = b.st[0], nx = b.st[1];
        if (nloc == 0u) { xcd_barrier_complete(bar, b.x, nloc, nx); b.st[0] = nloc; b.st[1] = nx; }
        const unsigned old = xb_add(&bar[XB_XSUB(b.x)], 1u);
        const unsigned gen = old / nloc;
        if (old + 1u == (gen + 1u) * nloc) {
            __builtin_amdgcn_fence(__ATOMIC_RELEASE, "agent");
            asm volatile("s_waitcnt vmcnt(0)" ::: "memory");
            const unsigned og = xb_add(&bar[XB_TOP], 1u);
            const unsigned tg = og / nx;
            if (og + 1u == (tg + 1u) * nx) xb_add(&bar[XB_TOPGEN], 1u);
            else XB_SPIN(xb_ld(&bar[XB_TOPGEN]) == tg, bar);
            __builtin_amdgcn_fence(__ATOMIC_ACQUIRE, "agent");
            xb_add(&bar[XB_XGEN(b.x)], 1u);
            asm volatile("s_waitcnt vmcnt(0)" ::: "memory");
        } else {
            XB_SPIN(xb_ld(&bar[XB_XGEN(b.x)]) == gen, bar);
            __builtin_amdgcn_fence(__ATOMIC_ACQUIRE, "agent");
            asm volatile("s_waitcnt vmcnt(0)" ::: "memory");
        }
    }
    __syncthreads();
}

constexpr size_t MiB = 1u << 20;
constexpr size_t WS_CTL = 0, CTL_ZERO_BYTES = 1 * MiB;
constexpr size_t WS_MOD = 1 * MiB;
constexpr size_t WS_SGW = 3 * MiB;
constexpr size_t WS_WRT = 3 * MiB + 512 * 1024;
constexpr size_t WS_W = 8 * MiB, W_LAYER = 209 * MiB;
constexpr size_t WO_WIN = 0, WO_WBR = 12 * MiB, WO_WOUT = 15 * MiB, WO_W1 = 17 * MiB, WO_W2 = 145 * MiB;
constexpr size_t WS_PROJ = 426 * MiB;
constexpr size_t WS_ACT = WS_PROJ;
constexpr size_t WS_H = 1194 * MiB;
constexpr size_t WS_O = 1322 * MiB;
constexpr size_t WS_Y = 1514 * MiB;
constexpr size_t WS_BITS = 1770 * MiB;
constexpr size_t WS_Y2 = WS_O;
constexpr size_t WS_SSP = 1850 * MiB;
constexpr size_t WS_ROWTOK = 1854 * MiB;
constexpr size_t WS_TOKINFO = 1862 * MiB;
constexpr size_t WS_SLAB = 1864 * MiB;
constexpr size_t WS_END = 1928 * MiB;
static_assert(WS_Y2 + (size_t)270336 * 2048 <= WS_SSP && WS_W + 2 * W_LAYER <= WS_PROJ && WS_PROJ + (size_t)MTOK * NPROJ * 2 <= WS_H, "d_ws map");
constexpr int CW_BAR = 4096;
constexpr int CW_CNT = 16384;

constexpr int RING_BYTES = 131072;
constexpr int MISC_OFF = 134144;
constexpr int TS_OFF = MISC_OFF + 512;
constexpr int TILE_E_OFF = MISC_OFF + 1024;
constexpr int ROWIDX_OFF = MISC_OFF + 5632;
constexpr int LDS_BYTES = 151552;
static_assert(ROWIDX_OFF + 8192 <= LDS_BYTES, "LDS map");

struct Args {
    const float* in[21]; float* out; unsigned char* ws; int ph_lo, ph_hi;
};
struct Frame {
    LAS unsigned char* lds; int tid, lane, wave, vcu, G;
};
__device__ __forceinline__ Frame phase_frame(const Frame& F0) { Frame F = F0; int t = threadIdx.x; asm volatile("" : "+v"(t)); F.tid = t; F.lane = t & 63; F.wave = __builtin_amdgcn_readfirstlane(t >> 6); return F; }
template <class T> __device__ __forceinline__ T* opq(T* p) { asm volatile("" : "+s"(p)); return p; }

__device__ __forceinline__ void p0_mod(const Frame& F, const float* c, const float* w_ada, const float* b_ada, float* MOD) {
    LAS float* csT = (LAS float*)F.lds;
    for (int i = F.tid; i < BATCH * DM; i += 512) { const int b = i & 31, k = i >> 5; const float v = c[b * DM + k]; csT[k * 32 + b] = v * sigmoidf_(v); }
    __syncthreads();
    const int gw = F.vcu * 8 + F.wave, NGW = F.G * 8;
    const int cg = F.lane & 15, kq = F.lane >> 4;
    for (int task = gw; task < DEPTH * 384; task += NGW) {
        const int l = task / 384, n = (task % 384) * 16 + cg;
        float acc[32];
#pragma unroll
        for (int b = 0; b < 32; ++b) acc[b] = 0.f;
        const float* w = w_ada + ((size_t)l * DM + kq * 256) * (6 * DM) + n;
#pragma unroll 4
        for (int k = 0; k < 256; ++k) {
            const float wv = w[(size_t)k * (6 * DM)];
            const LAS f32x4* cs = (const LAS f32x4*)(csT + (kq * 256 + k) * 32);
#pragma unroll
            for (int q = 0; q < 8; ++q) { const f32x4 c4 = cs[q]; acc[4 * q] += c4[0] * wv; acc[4 * q + 1] += c4[1] * wv; acc[4 * q + 2] += c4[2] * wv; acc[4 * q + 3] += c4[3] * wv; }
        }
#pragma unroll
        for (int b = 0; b < 32; ++b) { acc[b] += __shfl_xor(acc[b], 16); acc[b] += __shfl_xor(acc[b], 32); }
        if (kq == 0) { const float bb = b_ada[l * 6 * DM + n];
#pragma unroll
            for (int b = 0; b < 32; ++b) MOD[((size_t)l * BATCH + b) * (6 * DM) + n] = acc[b] + bb; }
    }
    __syncthreads();
}
__device__ __forceinline__ void tr_item(const float* W, size_t ldw, int srccol, bool valid, bf16_t* dst  , int K, LAS float* scr, int lane) {
    const float* wp = W + srccol;
#pragma unroll 8
    for (int i = 0; i < 32; ++i) { const int kk = 2 * i + (lane >> 5); scr[kk * 33 + (lane & 31)] = valid ? wp[(size_t)kk * ldw] : 0.f; }
    LDS_WAIT(); asm volatile("" ::: "memory");
    const int c = lane & 7;
#pragma unroll
    for (int j = 0; j < 4; ++j) { const int n = (lane >> 3) + 8 * j; const LAS float* s = scr + (8 * c) * 33 + n;
        u32x4 o; o.x = cvt_pk_bf16(s[0 * 33], s[1 * 33]); o.y = cvt_pk_bf16(s[2 * 33], s[3 * 33]); o.z = cvt_pk_bf16(s[4 * 33], s[5 * 33]); o.w = cvt_pk_bf16(s[6 * 33], s[7 * 33]);
        *(u32x4*)(dst + (size_t)n * K + 8 * c) = o; }
    LDS_WAIT(); asm volatile("" ::: "memory");
}
__device__ __forceinline__ void p0_weights(const Frame& F, const Args& a) {
    LAS float* scr = (LAS float*)(F.lds + F.wave * 16384);
    const int gw = F.vcu * 8 + F.wave, NGW = F.G * 8, lane = F.lane, jl = lane & 31;
    const float *w_in = a.in[8], *w_branch = a.in[13], *w_out = a.in[14], *w_router = a.in[15], *w1 = a.in[17], *w2 = a.in[19];
    constexpr int I_IN = 16 * 192, I_BR = 3 * 8 * 32, I_OUT = 16 * 32, I_RT = 16, I_W1 = 32 * 16 * 64, I_W2 = 32 * 16 * 32;
    constexpr int I_LAYER = I_IN + I_BR + I_OUT + I_RT + I_W1 + I_W2;
    for (int it = gw; it < DEPTH * I_LAYER; it += NGW) {
        const int l = it / I_LAYER; int r = it - l * I_LAYER;
        unsigned char* wl = a.ws + WS_W + (size_t)l * W_LAYER;
        if (r < I_IN) {
            const int kb = r / 192, nb = r % 192, n = nb * 32 + jl; const bool valid = (n < 1832) || (n >= 2048); const int src = n < 1832 ? n : n - 216;
            tr_item(w_in + (size_t)l * DM * 5928 + (size_t)kb * 64 * 5928, 5928, valid ? src : 0, valid, (bf16_t*)(wl + WO_WIN) + (size_t)nb * 32 * DM + kb * 64, DM, scr, lane); continue; }
        r -= I_IN;
        if (r < I_BR) {
            const int br = r / 256, q = r % 256, kb = q / 32, nb = q % 32;
            tr_item(w_branch + ((size_t)(l * 3 + br) * 512 + kb * 64) * DM, DM, nb * 32 + jl, true, (bf16_t*)(wl + WO_WBR) + (size_t)(br * 1024 + nb * 32) * 512 + kb * 64, 512, scr, lane); continue; }
        r -= I_BR;
        if (r < I_OUT) {
            const int kb = r / 32, nb = r % 32;
            tr_item(w_out + ((size_t)l * DM + kb * 64) * DM, DM, nb * 32 + jl, true, (bf16_t*)(wl + WO_WOUT) + (size_t)nb * 32 * DM + kb * 64, DM, scr, lane); continue; }
        r -= I_OUT;
        if (r < I_RT) {
            const int kb = r;
            tr_item(w_router + ((size_t)l * DM + kb * 64) * NE, NE, jl, true, (bf16_t*)(a.ws + WS_WRT) + (size_t)l * NE * DM + kb * 64, DM, scr, lane); continue; }
        r -= I_RT;
        if (r < I_W1) {
            const int e = r / 1024, q = r % 1024, kb = q / 64, nb = q % 64, n = nb * 32 + jl;
            const int pn = n >> 8, s = (n >> 7) & 1, jj = n & 127, src = 2 * (128 * pn + jj) + s;
            tr_item(w1 + ((size_t)(l * NE + e) * DM + kb * 64) * (2 * FF), 2 * FF, src, true, (bf16_t*)(wl + WO_W1) + ((size_t)e * 2048 + nb * 32) * DM + kb * 64, DM, scr, lane); continue; }
        r -= I_W1;
        {
            const int e = r / 512, q = r % 512, kb = q / 32, nb = q % 32;
            tr_item(w2 + ((size_t)(l * NE + e) * FF + kb * 64) * DM, DM, nb * 32 + jl, true, (bf16_t*)(wl + WO_W2) + ((size_t)e * DM + nb * 32) * FF + kb * 64, FF, scr, lane); }
    }
    const float* sg_w = a.in[10]; bf16_t* SGW = (bf16_t*)(a.ws + WS_SGW);
    for (int i = (F.vcu * 512 + F.tid) * 2; i < DEPTH * 8 * 128 * 128; i += F.G * 512 * 2) { const int s = i & 127, t = (i >> 7) & 127; const f32x2 v = *(const f32x2*)(sg_w + i);
        *(unsigned*)(SGW + i) = cvt_pk_bf16(s <= t ? v[0] : 0.f, (s + 1) <= t ? v[1] : 0.f); }
}

__device__ __forceinline__ void norm_mod_row(const f32x4 (&v)[4], float ss, const float* g, const float* sc, const float* sh, bf16_t* orow, int lane) {
    const float rstd = 1.f / sqrtf(ss * (1.f / DM) + RMS_EPS);
#pragma unroll
    for (int j = 0; j < 4; ++j) { const int c = 4 * lane + 256 * j; const f32x4 gg = *(const f32x4*)(g + c), s1 = *(const f32x4*)(sc + c), s0 = *(const f32x4*)(sh + c);
        const f32x4 o = (v[j] * rstd) * gg * (s1 + 1.f) + s0; u32x2 w; w.x = cvt_pk_bf16(o[0], o[1]); w.y = cvt_pk_bf16(o[2], o[3]); *(u32x2*)(orow + c) = w; }
}
__device__ __forceinline__ void p1_norm(const Frame& F, const float* x, const float* g, const float* MOD0, bf16_t* H) {
    const int gw = F.vcu * 8 + F.wave, NGW = F.G * 8;
    for (int row = gw; row < MTOK; row += NGW) { const int b = row >> 11; const float* xr = x + (size_t)row * DM; f32x4 v[4]; float ss = 0.f;
#pragma unroll
        for (int j = 0; j < 4; ++j) { v[j] = *(const f32x4*)(xr + 4 * F.lane + 256 * j); ss += (v[j][0] * v[j][0] + v[j][1] * v[j][1]) + (v[j][2] * v[j][2] + v[j][3] * v[j][3]); }
        ss = wave_sum(ss);
        const float* mb = MOD0 + (size_t)b * 6 * DM;
        norm_mod_row(v, ss, g, mb + DM, mb, H + (size_t)row * DM, F.lane); }
}
constexpr int TOPK_SEL = 256;
__device__ __forceinline__ void dsa_index_unit(const Frame& F, const bf16_t* __restrict__ PROJ, unsigned long long* __restrict__ bits64, int b, int qg) {
    const int lane = F.lane, wid = F.wave, n = lane & 31, hi = lane >> 5;
    const int q0 = qg * 16, nkb = (q0 + 16 + 31) >> 5;
    const size_t tokbase = (size_t)b * SEQ;
    LAS float* sc = (LAS float*)F.lds;
    bf16x8 af[4][2]; float wv[4][16];
    { const int m = n, hm = (m >> 2) & 1, idx = (m & 3) + 4 * (m >> 3), aq = 2 * hm + (idx >> 3), ah = idx & 7;
#pragma unroll
      for (int qgp = 0; qgp < 4; ++qgp) { const bf16_t* qp = PROJ + (tokbase + q0 + 4 * qgp + aq) * NPROJ + C_QI + ah * 32 + 8 * hi;
          af[qgp][0] = *(const bf16x8*)qp; af[qgp][1] = *(const bf16x8*)(qp + 16);
#pragma unroll
          for (int qq = 0; qq < 2; ++qq) { const u32x4 w = *(const u32x4*)(PROJ + (tokbase + q0 + 4 * qgp + 2 * hi + qq) * NPROJ + C_WI);
              wv[qgp][8 * qq + 0] = bf_lo(w.x) * 0.0625f; wv[qgp][8 * qq + 1] = bf_hi(w.x) * 0.0625f; wv[qgp][8 * qq + 2] = bf_lo(w.y) * 0.0625f; wv[qgp][8 * qq + 3] = bf_hi(w.y) * 0.0625f;
              wv[qgp][8 * qq + 4] = bf_lo(w.z) * 0.0625f; wv[qgp][8 * qq + 5] = bf_hi(w.z) * 0.0625f; wv[qgp][8 * qq + 6] = bf_lo(w.w) * 0.0625f; wv[qgp][8 * qq + 7] = bf_hi(w.w) * 0.0625f; } } }
    for (int kb = wid; kb < nkb; kb += 8) {
        const bf16_t* kp = PROJ + (tokbase + 32 * kb + n) * NPROJ + C_KI + 8 * hi;
        const bf16x8 kf0 = *(const bf16x8*)kp, kf1 = *(const bf16x8*)(kp + 16);
#pragma unroll
        for (int qgp = 0; qgp < 4; ++qgp) {
            f32x16 d = {0.f, 0.f, 0.f, 0.f, 0.f, 0.f, 0.f, 0.f, 0.f, 0.f, 0.f, 0.f, 0.f, 0.f, 0.f, 0.f};
            d = __builtin_amdgcn_mfma_f32_32x32x16_bf16(af[qgp][0], kf0, d, 0, 0, 0);
            d = __builtin_amdgcn_mfma_f32_32x32x16_bf16(af[qgp][1], kf1, d, 0, 0, 0);
            float sa = 0.f, sb = 0.f;
#pragma unroll
            for (int r = 0; r < 8; ++r) { sa += wv[qgp][r] * fmaxf(d[r], 0.f); sb += wv[qgp][8 + r] * fmaxf(d[8 + r], 0.f); }
            sc[(4 * qgp + 2 * hi) * 2048 + 32 * kb + n] = sa; sc[(4 * qgp + 2 * hi + 1) * 2048 + 32 * kb + n] = sb;
        }
    }
    __syncthreads();
#pragma unroll 1
    for (int qq = 0; qq < 2; ++qq) {
        const int ql = 2 * wid + qq, pos = q0 + ql, nn = pos + 1, nr = (nn + 63) >> 6;
        const LAS float* scq = sc + ql * 2048;
        unsigned long long myw = 0ull;
        if (nn <= TOPK_SEL) {
#pragma unroll
            for (int r = 0; r < 4; ++r) if (r < nr) { const unsigned long long bal = __ballot(64 * r + lane <= pos); if (lane == r) myw = bal; }
        } else {
            unsigned u[32];
#pragma unroll
            for (int r = 0; r < 32; ++r) { u[r] = 0u;
                if (r < nr) { const int j = 64 * r + lane; float s = scq[j]; s = (s == 0.f) ? 0.f : s; const unsigned bts = __builtin_bit_cast(unsigned, s);
                    const unsigned uu = (bts & 0x80000000u) ? ~bts : (bts | 0x80000000u); u[r] = (j <= pos) ? uu : 0u; } }
            unsigned mx = 0u;
#pragma unroll
            for (int r = 0; r < 32; ++r) mx = u[r] > mx ? u[r] : mx;
            const unsigned umax = wave_max_u32(mx);
#define CNT_GE(cand, out) do { unsigned c_ = 0u; _Pragma("unroll") for (int g4 = 0; g4 < 8; ++g4) { if (4 * g4 < nr) { c_ += (u[4 * g4] >= (cand)); c_ += (u[4 * g4 + 1] >= (cand)); c_ += (u[4 * g4 + 2] >= (cand)); c_ += (u[4 * g4 + 3] >= (cand)); } } out = wave_sum_u32(c_); } while (0)
            unsigned L = 0u, t = 0u; bool exact = false; unsigned c;
            if (umax > 0x80000000u + (3u << 23)) { const unsigned Lg = umax - (3u << 23); CNT_GE(Lg, c); if (c >= (unsigned)TOPK_SEL) { L = Lg; if (c == (unsigned)TOPK_SEL) { exact = true; t = Lg; } } }
            if (!exact) {
                const unsigned R = umax - L; unsigned tp = 0u;
                int bit = 31 - __builtin_clz(R | 1u);
#pragma unroll 1
                for (; bit >= 0; --bit) { const unsigned cand_off = tp | (1u << bit); if (cand_off > R) continue; const unsigned cand = L + cand_off; CNT_GE(cand, c);
                    if (c >= (unsigned)TOPK_SEL) { tp = cand_off; if (c == (unsigned)TOPK_SEL) { exact = true; break; } } }
                t = L + tp;
            }
            if (exact) {
#pragma unroll
                for (int r = 0; r < 32; ++r) if (r < nr) { const unsigned long long bal = __ballot(u[r] >= t); if (lane == r) myw = bal; }
            } else {
                unsigned cgt; { const unsigned t1 = t + 1u; CNT_GE(t1, cgt); }
                const unsigned need = (unsigned)TOPK_SEL - cgt; unsigned run = 0u;
#pragma unroll
                for (int r = 0; r < 32; ++r) if (r < nr) { const unsigned long long eqm = __ballot(u[r] == t);
                    const unsigned pre = run + __builtin_amdgcn_mbcnt_hi((unsigned)(eqm >> 32), __builtin_amdgcn_mbcnt_lo((unsigned)eqm, 0u));
                    const unsigned long long bal = __ballot((u[r] > t) || ((u[r] == t) && (pre < need)));
                    run += (unsigned)__builtin_popcountll(eqm); if (lane == r) myw = bal; }
            }
#undef CNT_GE
        }
        if (lane < nr) bits64[(tokbase + pos) * 32 + lane] = myw;
    }
    __syncthreads();
}

constexpr int KS = 144, VS = 144;
#ifndef USE_TR
#define USE_TR 1
#endif
template <int MODE>
__device__ __forceinline__ void attn_unit(const Frame& F, const bf16_t* __restrict__ PROJ, bf16_t* __restrict__ O, const unsigned* __restrict__ bits, const float* __restrict__ sinks, int b, int g, int qb) {
    const int tid = F.tid, lane = F.lane, wid = F.wave, n = lane & 31, hi = lane >> 5;
    constexpr int CQ = MODE ? C_QB : C_QA, CK = MODE ? C_KB : C_KA, CV = MODE ? C_VB : C_VA;
    const int hq = 4 * g + (wid >> 1), qpos = qb * 64 + 32 * (wid & 1) + n;
    const size_t tokbase = (size_t)b * SEQ;
    LAS unsigned char* Ks = F.lds; LAS unsigned char* Vs = F.lds + 64 * KS;
    bf16x8 qf[4];
    { const bf16_t* qp = PROJ + (tokbase + qpos) * NPROJ + CQ + hq * 64 + 8 * hi;
#pragma unroll
      for (int s = 0; s < 4; ++s) qf[s] = *(const bf16x8*)(qp + 16 * s); }
    f32x16 o0, o1;
#pragma unroll
    for (int r = 0; r < 16; ++r) { o0[r] = 0.f; o1[r] = 0.f; }
    float mrun, lsum;
    if (MODE == 0) { mrun = sinks[hq] * LOG2E; lsum = (hi == 0) ? 1.f : 0.f; } else { mrun = -1e30f; lsum = 0.f; }
    const int kt_lo = (MODE == 0) ? (qb >= 2 ? qb - 2 : 0) : 0, kt_hi = qb;
    const int srow = tid >> 3, sch = tid & 7;
    const bf16_t* kg = PROJ + (tokbase + srow) * NPROJ + CK + g * 64 + sch * 8;
    const bf16_t* vg = PROJ + (tokbase + srow) * NPROJ + CV + g * 64 + sch * 8;
    const unsigned* bp = bits + (tokbase + qpos) * 64;
    u32x4 kreg = *(const u32x4*)(kg + (size_t)kt_lo * 64 * NPROJ), vreg = *(const u32x4*)(vg + (size_t)kt_lo * 64 * NPROJ);
    u32x2 mreg = {0u, 0u};
    if (MODE == 1) mreg = *(const u32x2*)(bp + 2 * kt_lo);
    const int vbase = (4 * hi + ((lane & 15) >> 2)) * VS + (16 * ((lane >> 4) & 1) + 4 * (lane & 3)) * 2;
    for (int kt = kt_lo; kt <= kt_hi; ++kt) {
        __syncthreads();
        *(LAS u32x4*)(Ks + srow * KS + sch * 16) = kreg; *(LAS u32x4*)(Vs + srow * VS + sch * 16) = vreg;
        const u32x2 mcur = mreg;
        __syncthreads();
        if (kt < kt_hi) { kreg = *(const u32x4*)(kg + (size_t)(kt + 1) * 64 * NPROJ); vreg = *(const u32x4*)(vg + (size_t)(kt + 1) * 64 * NPROJ); if (MODE == 1) mreg = *(const u32x2*)(bp + 2 * (kt + 1)); }
        f32x16 p0, p1;
#pragma unroll
        for (int r = 0; r < 16; ++r) { p0[r] = 0.f; p1[r] = 0.f; }
#pragma unroll
        for (int s = 0; s < 4; ++s) { const bf16x8 k0 = *(const LAS bf16x8*)(Ks + n * KS + (16 * s + 8 * hi) * 2), k1 = *(const LAS bf16x8*)(Ks + (n + 32) * KS + (16 * s + 8 * hi) * 2);
            p0 = __builtin_amdgcn_mfma_f32_32x32x16_bf16(k0, qf[s], p0, 0, 0, 0); p1 = __builtin_amdgcn_mfma_f32_32x32x16_bf16(k1, qf[s], p1, 0, 0, 0); }
        unsigned w0, w1;
        if (MODE == 1) { w0 = mcur.x >> (4 * hi); w1 = mcur.y >> (4 * hi); }
        else {
#pragma unroll
            for (int blk = 0; blk < 2; ++blk) { const int d0 = qpos - (kt * 64 + 32 * blk); unsigned mk = 0u;
                if (d0 >= 0) { const int hb = d0 > 31 ? 31 : d0; int lo = d0 - 127; if (lo <= 31) { if (lo < 0) lo = 0; mk = (0xFFFFFFFFu >> (31 - hb)) & (0xFFFFFFFFu << lo); } }
                if (blk == 0) w0 = mk >> (4 * hi); else w1 = mk >> (4 * hi); }
        }
        float mx = -INFINITY;
#pragma unroll
        for (int r = 0; r < 16; ++r) { const int bitpos = 8 * (r >> 2) + (r & 3);
            p0[r] = ((w0 >> bitpos) & 1u) ? p0[r] : -INFINITY; p1[r] = ((w1 >> bitpos) & 1u) ? p1[r] : -INFINITY; mx = fmaxf(mx, fmaxf(p0[r], p1[r])); }
        mx = fmaxf(mx, __shfl_xor(mx, 32));
        const float mnew = fmaxf(mrun, mx), alpha = fexp2(mrun - mnew); mrun = mnew;
        float ps = 0.f;
#pragma unroll
        for (int r = 0; r < 16; ++r) { p0[r] = fexp2(p0[r] - mnew); p1[r] = fexp2(p1[r] - mnew); ps += p0[r] + p1[r]; }
        lsum = lsum * alpha + ps;
#pragma unroll
        for (int r = 0; r < 16; ++r) { o0[r] *= alpha; o1[r] *= alpha; }
        bf16x8 pf[2][2];
#pragma unroll
        for (int s2 = 0; s2 < 2; ++s2) { u32x4 a, c;
            a.x = cvt_pk_bf16(p0[8 * s2 + 0], p0[8 * s2 + 1]); a.y = cvt_pk_bf16(p0[8 * s2 + 2], p0[8 * s2 + 3]); a.z = cvt_pk_bf16(p0[8 * s2 + 4], p0[8 * s2 + 5]); a.w = cvt_pk_bf16(p0[8 * s2 + 6], p0[8 * s2 + 7]);
            c.x = cvt_pk_bf16(p1[8 * s2 + 0], p1[8 * s2 + 1]); c.y = cvt_pk_bf16(p1[8 * s2 + 2], p1[8 * s2 + 3]); c.z = cvt_pk_bf16(p1[8 * s2 + 4], p1[8 * s2 + 5]); c.w = cvt_pk_bf16(p1[8 * s2 + 6], p1[8 * s2 + 7]);
            pf[0][s2] = __builtin_bit_cast(bf16x8, a); pf[1][s2] = __builtin_bit_cast(bf16x8, c); }
#pragma unroll
        for (int db = 0; db < 2; ++db)
#pragma unroll
            for (int blk = 0; blk < 2; ++blk)
#pragma unroll
                for (int s2 = 0; s2 < 2; ++s2) {
                    bf16x8 vf;
#if USE_TR
                    const v4i16_t t0 = __builtin_amdgcn_ds_read_tr16_b64_v4i16((LAS v4i16_t*)(Vs + vbase + (32 * blk + 16 * s2) * VS + 64 * db));
                    const v4i16_t t1 = __builtin_amdgcn_ds_read_tr16_b64_v4i16((LAS v4i16_t*)(Vs + vbase + (32 * blk + 16 * s2 + 8) * VS + 64 * db));
                    vf = (bf16x8){t0[0], t0[1], t0[2], t0[3], t1[0], t1[1], t1[2], t1[3]};
#else
#pragma unroll
                    for (int j = 0; j < 8; ++j) vf[j] = *(const LAS short*)(Vs + (32 * blk + 16 * s2 + 8 * (j >> 2) + 4 * hi + (j & 3)) * VS + (32 * db + n) * 2);
#endif
                    if (db == 0) o0 = __builtin_amdgcn_mfma_f32_32x32x16_bf16(vf, pf[blk][s2], o0, 0, 0, 0); else o1 = __builtin_amdgcn_mfma_f32_32x32x16_bf16(vf, pf[blk][s2], o1, 0, 0, 0);
                }
    }
    const float lt = lsum + __shfl_xor(lsum, 32), inv = 1.f / lt;
    bf16_t* op = O + (tokbase + qpos) * 512 + hq * 64 + 4 * hi;
#pragma unroll
    for (int rq = 0; rq < 4; ++rq) { u32x2 w;
        w.x = cvt_pk_bf16(o0[4 * rq] * inv, o0[4 * rq + 1] * inv); w.y = cvt_pk_bf16(o0[4 * rq + 2] * inv, o0[4 * rq + 3] * inv); *(u32x2*)(op + 8 * rq) = w;
        w.x = cvt_pk_bf16(o1[4 * rq] * inv, o1[4 * rq + 1] * inv); w.y = cvt_pk_bf16(o1[4 * rq + 2] * inv, o1[4 * rq + 3] * inv); *(u32x2*)(op + 32 + 8 * rq) = w; }
}

constexpr int SGS = 1040;
static_assert(128 * SGS <= MISC_OFF, "spatial-gating tile vs LDS control words");
__device__ __forceinline__ void sg_unit(const Frame& F, const bf16_t* __restrict__ PROJ, const bf16_t* __restrict__ SGWl, const float* __restrict__ sgb, const float* __restrict__ lng, bf16_t* __restrict__ OC, int b, int ch) {
    const int lane = F.lane, wid = F.wave, n = lane & 31, hi = lane >> 5;
    const size_t tok0 = (size_t)b * SEQ + ch * 128;
    LAS unsigned char* V = F.lds;
    __syncthreads();
    float gl[8];
    { const f32x4 g0 = *(const f32x4*)(lng + 8 * lane), g1 = *(const f32x4*)(lng + 8 * lane + 4); gl[0] = g0[0]; gl[1] = g0[1]; gl[2] = g0[2]; gl[3] = g0[3]; gl[4] = g1[0]; gl[5] = g1[1]; gl[6] = g1[2]; gl[7] = g1[3]; }
    for (int rr = 0; rr < 16; ++rr) { const int row = 16 * wid + rr;
        const u32x4 w = *(const u32x4*)(PROJ + (tok0 + row) * NPROJ + C_V + 8 * lane);
        float x[8] = {bf_lo(w.x), bf_hi(w.x), bf_lo(w.y), bf_hi(w.y), bf_lo(w.z), bf_hi(w.z), bf_lo(w.w), bf_hi(w.w)};
        float s = 0.f;
#pragma unroll
        for (int i = 0; i < 8; ++i) s += x[i];
        const float mean = wave_sum(s) * (1.f / 512.f); float q = 0.f;
#pragma unroll
        for (int i = 0; i < 8; ++i) { x[i] -= mean; q += x[i] * x[i]; }
        const float rstd = 1.f / sqrtf(wave_sum(q) * (1.f / 512.f) + LN_EPS);
        u32x4 o; o.x = cvt_pk_bf16(x[0] * rstd * gl[0], x[1] * rstd * gl[1]); o.y = cvt_pk_bf16(x[2] * rstd * gl[2], x[3] * rstd * gl[3]);
        o.z = cvt_pk_bf16(x[4] * rstd * gl[4], x[5] * rstd * gl[5]); o.w = cvt_pk_bf16(x[6] * rstd * gl[6], x[7] * rstd * gl[7]);
        *(LAS u32x4*)(V + row * SGS + 16 * lane) = o; }
    __syncthreads();
    const int g = wid;
    const int vbase = (8 * hi + ((lane & 15) >> 2)) * SGS + (g * 64 + 16 * ((lane >> 4) & 1) + 4 * (lane & 3)) * 2;
    const bf16_t* wg = SGWl + (size_t)g * 128 * 128;
#pragma unroll 1
    for (int tb = 0; tb < 4; ++tb) {
        f32x16 a0, a1;
#pragma unroll
        for (int r = 0; r < 16; ++r) { a0[r] = 0.f; a1[r] = 0.f; }
        const bf16_t* wrow = wg + (size_t)(32 * tb + n) * 128 + 8 * hi;
        for (int ks = 0; ks < 2 * tb + 2; ++ks) {
            const bf16x8 af = *(const bf16x8*)(wrow + 16 * ks);
#pragma unroll
            for (int db = 0; db < 2; ++db) { bf16x8 vf;
#if USE_TR
                const v4i16_t t0 = __builtin_amdgcn_ds_read_tr16_b64_v4i16((LAS v4i16_t*)(V + vbase + (16 * ks) * SGS + 64 * db));
                const v4i16_t t1 = __builtin_amdgcn_ds_read_tr16_b64_v4i16((LAS v4i16_t*)(V + vbase + (16 * ks + 4) * SGS + 64 * db));
                vf = (bf16x8){t0[0], t0[1], t0[2], t0[3], t1[0], t1[1], t1[2], t1[3]};
#else
#pragma unroll
                for (int j = 0; j < 8; ++j) vf[j] = *(const LAS short*)(V + (16 * ks + 8 * hi + j) * SGS + (g * 64 + 32 * db + n) * 2);
#endif
                if (db == 0) a0 = __builtin_amdgcn_mfma_f32_32x32x16_bf16(af, vf, a0, 0, 0, 0); else a1 = __builtin_amdgcn_mfma_f32_32x32x16_bf16(af, vf, a1, 0, 0, 0); }
        }
#pragma unroll
        for (int r = 0; r < 16; ++r) { const int t = 32 * tb + 8 * (r >> 2) + 4 * hi + (r & 3); const float bb = sgb[g * 128 + t];
            const bf16_t* up = PROJ + (tok0 + t) * NPROJ + C_U + g * 64 + n; bf16_t* op = OC + (tok0 + t) * 512 + g * 64 + n;
            const float u0 = __builtin_bit_cast(float, (unsigned)up[0] << 16), u1 = __builtin_bit_cast(float, (unsigned)up[32] << 16);
            op[0] = (bf16_t)f2bf((a0[r] + bb) * u0); op[32] = (bf16_t)f2bf((a1[r] + bb) * u1); }
    }
}
constexpr int HS_STRIDE = 2064;
constexpr int P7_PART = 32 * HS_STRIDE;
constexpr int P7_LOG = P7_PART + 8 * 4096;
constexpr int P7_HIST = P7_LOG + 32 * 33 * 4;
__device__ __forceinline__ void p7_route(const Frame& F, const Args& a, int l, const float* xin, float* xout, const float* Y, const float* SSP, const float* MODl, bf16_t* H,
                                         const bf16_t* WRTl, unsigned* cnt, int* ROWTOK, unsigned* TOKINFO) {
    const int tid = F.tid, lane = F.lane, wid = F.wave, n = lane & 31, hi = lane >> 5;
    const float* g_post = a.in[5] + l * DM; const float* g_pre = a.in[6] + l * DM; const float* b_router = a.in[16] + l * NE;
    LAS unsigned char* hs = F.lds; LAS float* part = (LAS float*)(F.lds + P7_PART); LAS float* lg = (LAS float*)(F.lds + P7_LOG); LAS int* hist = (LAS int*)(F.lds + P7_HIST); LAS int* base = hist + 32;
    if (tid < 32) hist[tid] = 0;
    __syncthreads();
    for (int bt = F.vcu; bt < MTOK / 32; bt += F.G) {
        const int row0 = bt * 32, b = row0 >> 11;
        const float* mb = MODl + (size_t)b * 6 * DM;
#pragma unroll 1
        for (int rr = 0; rr < 4; ++rr) { const int rl = 4 * wid + rr; const size_t row = (size_t)row0 + rl;
            const f32x4 s4 = *(const f32x4*)(SSP + row * 16 + 4 * (lane & 3));
            float ssy = (s4[0] + s4[1]) + (s4[2] + s4[3]); ssy += __shfl_xor(ssy, 1); ssy += __shfl_xor(ssy, 2);
            const float rstd1 = 1.f / sqrtf(ssy * (1.f / DM) + RMS_EPS);
            f32x4 v[4]; float ss = 0.f;
#pragma unroll
            for (int j = 0; j < 4; ++j) { const int c = 4 * lane + 256 * j; const f32x4 yy = *(const f32x4*)(Y + row * DM + c), xx = *(const f32x4*)(xin + row * DM + c);
                const f32x4 gp = *(const f32x4*)(g_post + c), ga = *(const f32x4*)(mb + 2 * DM + c);
                v[j] = xx + ga * (yy * rstd1 * gp); *(f32x4*)(xout + row * DM + c) = v[j];
                ss += (v[j][0] * v[j][0] + v[j][1] * v[j][1]) + (v[j][2] * v[j][2] + v[j][3] * v[j][3]); }
            ss = wave_sum(ss);
            const float rstd = 1.f / sqrtf(ss * (1.f / DM) + RMS_EPS);
#pragma unroll
            for (int j = 0; j < 4; ++j) { const int c = 4 * lane + 256 * j; const f32x4 gg = *(const f32x4*)(g_pre + c), s1 = *(const f32x4*)(mb + 4 * DM + c), s0 = *(const f32x4*)(mb + 3 * DM + c);
                const f32x4 o = (v[j] * rstd) * gg * (s1 + 1.f) + s0; u32x2 w; w.x = cvt_pk_bf16(o[0], o[1]); w.y = cvt_pk_bf16(o[2], o[3]);
                *(u32x2*)(H + row * DM + c) = w; *(LAS u32x2*)(hs + rl * HS_STRIDE + c * 2) = w; } }
        __syncthreads();
        {
            f32x16 d;
#pragma unroll
            for (int r = 0; r < 16; ++r) d[r] = 0.f;
#pragma unroll
            for (int ks = 0; ks < 8; ++ks) { const int k0 = (8 * wid + ks) * 16 + 8 * hi;
                const bf16x8 af = *(const LAS bf16x8*)(hs + n * HS_STRIDE + k0 * 2); const bf16x8 bf = *(const bf16x8*)(WRTl + (size_t)n * DM + k0);
                d = __builtin_amdgcn_mfma_f32_32x32x16_bf16(af, bf, d, 0, 0, 0); }
#pragma unroll
            for (int r = 0; r < 16; ++r) part[wid * 1024 + (8 * (r >> 2) + 4 * hi + (r & 3)) * 32 + n] = d[r];
        }
        __syncthreads();
        for (int i = tid; i < 1024; i += 512) { float s = b_router[i & 31];
#pragma unroll
            for (int w = 0; w < 8; ++w) s += part[w * 1024 + i]; lg[(i >> 5) * 33 + (i & 31)] = s; }
        __syncthreads();
        int e_k[4] = {0, 0, 0, 0}, lp_k[4] = {0, 0, 0, 0}; float w_k[4] = {0.f, 0.f, 0.f, 0.f};
        if (tid < 32) { LAS float* mylg = lg + tid * 33; float tl[4];
#pragma unroll
            for (int k = 0; k < 4; ++k) { float best = -INFINITY; int bi = 0;
                for (int e = 0; e < 32; ++e) { const float vv = mylg[e]; if (vv > best) { best = vv; bi = e; } }
                tl[k] = best; e_k[k] = bi; mylg[bi] = -INFINITY; }
            float sum = 0.f;
#pragma unroll
            for (int k = 0; k < 4; ++k) { w_k[k] = __expf(tl[k] - tl[0]); sum += w_k[k]; }
            const float inv = 1.f / sum;
#pragma unroll
            for (int k = 0; k < 4; ++k) { w_k[k] *= inv; lp_k[k] = __hip_atomic_fetch_add(&hist[e_k[k]], 1, __ATOMIC_RELAXED, __HIP_MEMORY_SCOPE_WORKGROUP); } }
        __syncthreads();
        if (tid < 32) { const int hc = hist[tid]; base[tid] = hc > 0 ? (int)__hip_atomic_fetch_add(cnt + 64 * tid, (unsigned)hc, __ATOMIC_RELAXED, __HIP_MEMORY_SCOPE_AGENT) : 0; hist[tid] = 0; }
        __syncthreads();
        if (tid < 32) { const int token = row0 + tid; u32x4 info; f32x4 ww;
#pragma unroll
            for (int k = 0; k < 4; ++k) { const int pos = base[e_k[k]] + lp_k[k]; ROWTOK[e_k[k] * 65536 + pos] = token; info[k] = ((unsigned)e_k[k] << 17) | (unsigned)pos; ww[k] = w_k[k]; }
            *(u32x4*)(TOKINFO + (size_t)token * 8) = info; *(f32x4*)(TOKINFO + (size_t)token * 8 + 4) = ww; }
        __syncthreads();
    }
}

__device__ __forceinline__ int moe_tables(const Frame& F, unsigned* cnt) {
    LAS int* ts = (LAS int*)(F.lds + TS_OFF); LAS int* te = (LAS int*)(F.lds + TILE_E_OFF);
    __syncthreads();
    if (F.tid == 0) { int acc = 0; for (int e = 0; e < NE; ++e) { ts[e] = acc; const unsigned c = __hip_atomic_load(cnt + 64 * e, __ATOMIC_RELAXED, __HIP_MEMORY_SCOPE_AGENT); acc += (int)((c + 255u) >> 8); } ts[NE] = acc; }
    __syncthreads();
    const int RT = ts[NE];
    for (int rt = F.tid; rt < RT; rt += 512) { int e = 0;
#pragma unroll 1
        for (int q = 1; q < NE; ++q) e += (ts[q] <= rt) ? 1 : 0;
        te[rt] = e; }
    __syncthreads();
    return RT;
}

__device__ __forceinline__ void p10_combine(const Frame& F, const Args& a, int l, float* xio, const bf16_t* Y2, const unsigned* TOKINFO, const float* MODbase, bf16_t* H) {
    const int lane = F.lane; const LAS int* ts = (const LAS int*)(F.lds + TS_OFF);
    const float* g_postf = a.in[7] + l * DM;
    const int gw = F.vcu * 8 + F.wave, NGW = F.G * 8;
    for (int row = gw; row < MTOK; row += NGW) { const int b = row >> 11;
        const u32x4 info = *(const u32x4*)(TOKINFO + (size_t)row * 8); const f32x4 ww = *(const f32x4*)(TOKINFO + (size_t)row * 8 + 4);
        f32x4 y[4];
#pragma unroll
        for (int j = 0; j < 4; ++j) y[j] = (f32x4){0.f, 0.f, 0.f, 0.f};
#pragma unroll
        for (int k = 0; k < 4; ++k) { const int e = (int)(info[k] >> 17), pos = (int)(info[k] & 0x1ffffu); const size_t slot = (size_t)ts[e] * 256 + pos; const float wk = ww[k];
#pragma unroll
            for (int j = 0; j < 4; ++j) { const u32x2 w = *(const u32x2*)(Y2 + slot * DM + 4 * lane + 256 * j);
                y[j][0] += wk * bf_lo(w.x); y[j][1] += wk * bf_hi(w.x); y[j][2] += wk * bf_lo(w.y); y[j][3] += wk * bf_hi(w.y); } }
        float ss = 0.f;
#pragma unroll
        for (int j = 0; j < 4; ++j) ss += (y[j][0] * y[j][0] + y[j][1] * y[j][1]) + (y[j][2] * y[j][2] + y[j][3] * y[j][3]);
        ss = wave_sum(ss);
        const float rstd = 1.f / sqrtf(ss * (1.f / DM) + RMS_EPS);
        const float* mb = MODbase + ((size_t)l * BATCH + b) * 6 * DM;
        f32x4 v[4]; float s2 = 0.f;
#pragma unroll
        for (int j = 0; j < 4; ++j) { const int c = 4 * lane + 256 * j; const f32x4 xx = *(const f32x4*)(xio + (size_t)row * DM + c), gp = *(const f32x4*)(g_postf + c), ga = *(const f32x4*)(mb + 5 * DM + c);
            v[j] = xx + ga * (y[j] * rstd * gp); *(f32x4*)(xio + (size_t)row * DM + c) = v[j];
            s2 += (v[j][0] * v[j][0] + v[j][1] * v[j][1]) + (v[j][2] * v[j][2] + v[j][3] * v[j][3]); }
        if (l + 1 < DEPTH) { s2 = wave_sum(s2); const float* mb1 = MODbase + ((size_t)(l + 1) * BATCH + b) * 6 * DM;
            norm_mod_row(v, s2, a.in[4] + (l + 1) * DM, mb1 + DM, mb1, H + (size_t)row * DM, lane); }
    }
}
#ifndef MK_ONE_LAUNCH
#define MK_ONE_LAUNCH 1
#endif
constexpr int N_PHASES = 2 + 9 * DEPTH;
__global__ void __launch_bounds__(512, 2) fwd(Args args) {
    extern __shared__ __attribute__((aligned(16))) unsigned char lds_raw[];
    Frame F0;
    F0.lds = (LAS unsigned char*)lds_raw;
    F0.tid = threadIdx.x; F0.lane = F0.tid & 63; F0.wave = __builtin_amdgcn_readfirstlane(F0.tid >> 6);
    F0.G = gridDim.x; { const int bx = blockIdx.x; F0.vcu = (F0.G % 8 == 0) ? (bx % 8) * (F0.G / 8) + bx / 8 : bx; }
    volatile LAS unsigned* MISC = (volatile LAS unsigned*)(F0.lds + MISC_OFF);
    for (int u = F0.tid; u < 128; u += 512) MISC[u] = 0u;
    __syncthreads();
    unsigned* ctl = (unsigned*)(args.ws + WS_CTL);
    const int lo = args.ph_lo, hi = args.ph_hi;
    XcdBarrier bar; bar.bar = ctl + CW_BAR; bar.x = 0; bar.st = nullptr;
    if (hi - lo > 1) bar = xcd_barrier_post(ctl + CW_BAR, MISC + 8);
#ifndef PHASE_MASK
#define PHASE_MASK 0x7ff
#endif
#define PHON(j) ((PHASE_MASK >> (j)) & 1)
#define IN(k) (lo <= (k) && (k) < hi)
#define BOTH(k) (IN(k) && IN((k) + 1))
#define GRID_BAR() xcd_barrier(bar)
#define PH_BEGIN() const Frame F = phase_frame(F0); unsigned char* ws = opq(args.ws); (void)ws
    if (PHON(0) && IN(0)) { PH_BEGIN(); p0_mod(F, args.in[1], args.in[2], args.in[3], (float*)(ws + WS_MOD)); p0_weights(F, args); if (BOTH(0)) GRID_BAR(); }
    if (PHON(1) && IN(1)) { PH_BEGIN(); p1_norm(F, args.in[0], args.in[4], (const float*)(ws + WS_MOD), (bf16_t*)(ws + WS_H)); if (BOTH(1)) GRID_BAR(); }

#pragma unroll 1
    for (int l = 0; l < DEPTH; ++l) {
        const int pb = 2 + 9 * l;
        if (PHON(2) && IN(pb + 0)) { PH_BEGIN();
            pg8::Gemm g{(const bf16_t*)(ws + WS_H), (const bf16_t*)(ws + WS_W + (size_t)l * W_LAYER + WO_WIN), DM}; pg8::StaticOrder S; S.init(MTOK / 256, NPROJ / 256, F.G, (int)blockIdx.x);
            EpiProj E{(bf16_t*)(ws + WS_PROJ)};
            pg8::gemm_phase<EpiProj, pg8::StaticOrder, false>(F.lds, g, S, E);
            if (BOTH(pb + 0)) GRID_BAR();
        }
        if (PHON(3) && IN(pb + 1)) { PH_BEGIN();
            const bf16_t* PROJ = (const bf16_t*)(ws + WS_PROJ); bf16_t* OABC = (bf16_t*)(ws + WS_O);
            for (int u = F.vcu; u < 4096; u += F.G) dsa_index_unit(F, PROJ, (unsigned long long*)(ws + WS_BITS), u & 31, u >> 5);
            for (int u = F.vcu; u < 2048; u += F.G) { const int cu = u & 255, j = u >> 8, bg = cu >> 2, s = cu & 3, qb = (j & 1) ? (8 * (j >> 1) + 7 - s) : (8 * (j >> 1) + s);
                attn_unit<0>(F, PROJ, OABC, nullptr, args.in[9] + l * 8, bg >> 1, bg & 1, qb); }
            for (int u = F.vcu; u < 512; u += F.G)
                sg_unit(F, PROJ, (const bf16_t*)(ws + WS_SGW) + (size_t)l * 8 * 128 * 128, args.in[11] + l * 8 * 128, args.in[12] + l * 512, OABC + (size_t)2 * MTOK * 512, u >> 4, u & 15);
            if (BOTH(pb + 1)) GRID_BAR();
        }
        if (PHON(4) && IN(pb + 2)) { PH_BEGIN();
            for (int u = F.vcu; u < 2048; u += F.G) { const int cu = u & 255, j = u >> 8, bg = cu >> 2, s = cu & 3, qb = (j & 1) ? (8 * (j >> 1) + 7 - s) : (8 * (j >> 1) + s);
                attn_unit<1>(F, (const bf16_t*)(ws + WS_PROJ), (bf16_t*)(ws + WS_O) + (size_t)MTOK * 512, (const unsigned*)(ws + WS_BITS), nullptr, bg >> 1, bg & 1, qb); }
            __syncthreads();
            if (BOTH(pb + 2)) GRID_BAR();
        }
        if (PHON(5) && IN(pb + 3)) { PH_BEGIN();
            pg8::Gemm g{(const bf16_t*)(ws + WS_O), (const bf16_t*)(ws + WS_W + (size_t)l * W_LAYER + WO_WBR), 512}; BranchOrder S; S.so.init(MTOK / 256, DM / 256, F.G, (int)blockIdx.x);
            EpiBranch E{(const bf16_t*)(ws + WS_PROJ), (float*)(ws + WS_SLAB) + (size_t)blockIdx.x * 65536, (bf16_t*)(ws + WS_H)};
            pg8::gemm_phase<EpiBranch, BranchOrder, false>(F.lds, g, S, E);
            if (BOTH(pb + 3)) GRID_BAR();
        }
        if (PHON(6) && IN(pb + 4)) { PH_BEGIN();
            pg8::Gemm g{(const bf16_t*)(ws + WS_H), (const bf16_t*)(ws + WS_W + (size_t)l * W_LAYER + WO_WOUT), DM}; pg8::StaticOrder S; S.init(MTOK / 256, DM / 256, F.G, (int)blockIdx.x);
            EpiWout E{(float*)(ws + WS_Y), (float*)(ws + WS_SSP)};
            pg8::gemm_phase<EpiWout, pg8::StaticOrder, false>(F.lds, g, S, E);
            if (BOTH(pb + 4)) GRID_BAR();
        }
        if (PHON(7) && IN(pb + 5)) { PH_BEGIN();
            p7_route(F, args, l, l == 0 ? args.in[0] : (const float*)args.out, args.out, (const float*)(ws + WS_Y), (const float*)(ws + WS_SSP), (const float*)(ws + WS_MOD) + (size_t)l * BATCH * 6 * DM, (bf16_t*)(ws + WS_H),
                     (const bf16_t*)(ws + WS_WRT) + (size_t)l * NE * DM, (unsigned*)(ws + WS_CTL) + CW_CNT + l * 32 * 64, (int*)(ws + WS_ROWTOK), (unsigned*)(ws + WS_TOKINFO));
            if (BOTH(pb + 5)) GRID_BAR();
        }
        if (PHON(8) && IN(pb + 6)) { PH_BEGIN();
            unsigned* cnt = (unsigned*)(ws + WS_CTL) + CW_CNT + l * 32 * 64; const int* ROWTOK = (const int*)(ws + WS_ROWTOK);
            const int RT = moe_tables(F, cnt);
            LAS int* ts = (LAS int*)(F.lds + TS_OFF); LAS int* te = (LAS int*)(F.lds + TILE_E_OFF); LAS int* ri = (LAS int*)(F.lds + ROWIDX_OFF);
            const long U = (long)RT * 8; MoeOrder S; S.u0 = (int)(U * F.vcu / F.G); S.u1 = (int)(U * (F.vcu + 1) / F.G); S.NB = 8; S.rt_lo = S.u0 / 8; S.tile_e = te; S.rowidx = ri;
            if (S.u1 > S.u0) { const int rt_hi = (S.u1 - 1) / 8; int ntile = rt_hi - S.rt_lo + 1; if (ntile > 8) ntile = 8;
                for (int i = F.tid; i < ntile * 256; i += 512) { const int rt = S.rt_lo + (i >> 8), r = i & 255, e = te[rt], first = (rt - ts[e]) * 256 + r;
                    const int c = (int)__hip_atomic_load(cnt + 64 * e, __ATOMIC_RELAXED, __HIP_MEMORY_SCOPE_AGENT); ri[i] = first < c ? ROWTOK[e * 65536 + first] : 0; } }
            __syncthreads();
            pg8::Gemm g{(const bf16_t*)(ws + WS_H), (const bf16_t*)(ws + WS_W + (size_t)l * W_LAYER + WO_W1), DM};
            EpiW1 E{(bf16_t*)(ws + WS_ACT), args.in[18] + (size_t)l * NE * 2 * FF};
            pg8::gemm_phase<EpiW1, MoeOrder, true>(F.lds, g, S, E);
            if (BOTH(pb + 6)) GRID_BAR();
        }
        if (PHON(9) && IN(pb + 7)) { PH_BEGIN();
            const int RT = moe_tables(F, (unsigned*)(ws + WS_CTL) + CW_CNT + l * 32 * 64);
            const long U = (long)RT * 4; MoeOrder S; S.u0 = (int)(U * F.vcu / F.G); S.u1 = (int)(U * (F.vcu + 1) / F.G); S.NB = 4; S.rt_lo = 0; S.tile_e = (LAS int*)(F.lds + TILE_E_OFF); S.rowidx = nullptr;
            pg8::Gemm g{(const bf16_t*)(ws + WS_ACT), (const bf16_t*)(ws + WS_W + (size_t)l * W_LAYER + WO_W2), FF};
            EpiW2 E{(bf16_t*)(ws + WS_Y2), args.in[20] + (size_t)l * NE * DM};
            pg8::gemm_phase<EpiW2, MoeOrder, false>(F.lds, g, S, E);
            if (BOTH(pb + 7)) GRID_BAR();
        }
        if (PHON(10) && IN(pb + 8)) { PH_BEGIN();
            (void)moe_tables(F, (unsigned*)(ws + WS_CTL) + CW_CNT + l * 32 * 64);
            p10_combine(F, args, l, args.out, (const bf16_t*)(ws + WS_Y2), (const unsigned*)(ws + WS_TOKINFO), (const float*)(ws + WS_MOD), (bf16_t*)(ws + WS_H));
            if (BOTH(pb + 8)) GRID_BAR();
        }
    }
#undef PH_BEGIN
#undef IN
#undef BOTH
#undef GRID_BAR
}

extern "C" void kernel_launch(void* const* d_in, const int* in_sizes, int n_in, void* d_out, int out_size, void* d_ws, size_t ws_size, hipStream_t stream) {
    static int grid = 0;
    if (grid == 0) {
        if (n_in != 21 || out_size != MTOK * DM || ws_size < WS_END) { fprintf(stderr, "kernel_launch: unexpected shapes (n_in %d, out %d, ws %zu); nothing launched\n", n_in, out_size, ws_size); grid = -1; return; }
        int dev = 0, cus = 0, per_cu = 0;
        if (hipGetDevice(&dev) != hipSuccess || hipDeviceGetAttribute(&cus, hipDeviceAttributeMultiprocessorCount, dev) != hipSuccess) { grid = -1; return; }
        if (hipFuncSetAttribute((const void*)fwd, hipFuncAttributeMaxDynamicSharedMemorySize, LDS_BYTES) != hipSuccess) { fprintf(stderr, "kernel_launch: hipFuncSetAttribute failed\n"); grid = -1; return; }
        if (hipOccupancyMaxActiveBlocksPerMultiprocessor(&per_cu, (const void*)fwd, 512, LDS_BYTES) != hipSuccess || per_cu < 1) { fprintf(stderr, "kernel_launch: occupancy query says %d\n", per_cu); }
        (void)hipGetLastError();
        grid = cus > 256 ? 256 : cus;
    }
    if (grid < 0) return;
    (void)hipMemsetAsync((char*)d_ws + WS_CTL, 0, CTL_ZERO_BYTES, stream);
    Args a{};
    for (int i = 0; i < 21; ++i) a.in[i] = (const float*)d_in[i];
    a.out = (float*)d_out; a.ws = (unsigned char*)d_ws;
#if MK_ONE_LAUNCH
    a.ph_lo = 0; a.ph_hi = N_PHASES;
    hipLaunchKernelGGL(fwd, dim3(grid), dim3(512), LDS_BYTES, stream, a);
#else
    for (int p = 0; p < N_PHASES; ++p) { a.ph_lo = p; a.ph_hi = p + 1; hipLaunchKernelGGL(fwd, dim3(grid), dim3(512), LDS_BYTES, stream, a); }
#endif
}
```

```cpp
#include <hip/hip_runtime.h>
#include <cstdio>
#include <cstdint>
#include <type_traits>

#define LAS __attribute__((address_space(3)))
#define GAS __attribute__((address_space(1)))
typedef unsigned short bf16_t;
typedef short bf16x8 __attribute__((ext_vector_type(8)));
typedef float f32x2 __attribute__((ext_vector_type(2)));
typedef float f32x4 __attribute__((ext_vector_type(4)));
typedef float f32x16 __attribute__((ext_vector_type(16)));
typedef unsigned u32x2 __attribute__((ext_vector_type(2)));
typedef unsigned u32x4 __attribute__((ext_vector_type(4)));
typedef short v4i16_t __attribute__((ext_vector_type(4)));
typedef int i32x4 __attribute__((ext_vector_type(4)));

constexpr int BATCH = 32, SEQ = 2048, DM = 1024, MTOK = BATCH * SEQ, DEPTH = 2;
constexpr int NPROJ = 6144;
constexpr int C_QA = 0, C_KA = 512, C_VA = 640, C_QB = 768, C_KB = 1280, C_VB = 1408, C_QI = 1536, C_KI = 1792, C_WI = 1824, C_U = 2048, C_V = 2560, C_G = 3072;
constexpr int NE = 32, FF = 1024;
constexpr float RMS_EPS = 1e-5f, LN_EPS = 1e-5f;
constexpr float LOG2E = 1.4426950408889634f;
constexpr float QSCALE = 0.125f * LOG2E;

__device__ __forceinline__ unsigned f2bf(float f) { unsigned u = __builtin_bit_cast(unsigned, f); return (u + 0x7fffu + ((u >> 16) & 1u)) >> 16; }
__device__ __forceinline__ unsigned cvt_pk_bf16(float lo, float hi) { unsigned r; asm volatile("v_cvt_pk_bf16_f32 %0, %1, %2" : "=v"(r) : "v"(lo), "v"(hi)); return r; }
__device__ __forceinline__ float bf_lo(unsigned w) { return __builtin_bit_cast(float, w << 16); }
__device__ __forceinline__ float bf_hi(unsigned w) { return __builtin_bit_cast(float, w & 0xffff0000u); }
__device__ __forceinline__ float fexp2(float x) { return __builtin_amdgcn_exp2f(x); }
__device__ __forceinline__ float frcp(float x) { return __builtin_amdgcn_rcpf(x); }
__device__ __forceinline__ float sigmoidf_(float x) { return frcp(1.f + fexp2(-LOG2E * x)); }
__device__ __forceinline__ float gelu_tanh(float x) { const float t = x + 0.044715f * x * x * x; return x * frcp(1.f + fexp2(-2.302208198f * t)); }
__device__ __forceinline__ float wave_sum(float v) {
#pragma unroll
    for (int o = 1; o < 64; o <<= 1) v += __shfl_xor(v, o);
    return v;
}
__device__ __forceinline__ unsigned wave_sum_u32(unsigned v) {
    v += (unsigned)__builtin_amdgcn_update_dpp(0, (int)v, 0xB1, 0xF, 0xF, false);
    v += (unsigned)__builtin_amdgcn_update_dpp(0, (int)v, 0x4E, 0xF, 0xF, false);
    v += (unsigned)__builtin_amdgcn_update_dpp(0, (int)v, 0x141, 0xF, 0xF, false);
    v += (unsigned)__builtin_amdgcn_update_dpp(0, (int)v, 0x140, 0xF, 0xF, false);
    return __builtin_amdgcn_readlane(v, 0) + __builtin_amdgcn_readlane(v, 16) + __builtin_amdgcn_readlane(v, 32) + __builtin_amdgcn_readlane(v, 48);
}
__device__ __forceinline__ unsigned wave_max_u32(unsigned v) {
    unsigned t;
    t = (unsigned)__builtin_amdgcn_update_dpp(0, (int)v, 0xB1, 0xF, 0xF, false); v = v > t ? v : t;
    t = (unsigned)__builtin_amdgcn_update_dpp(0, (int)v, 0x4E, 0xF, 0xF, false); v = v > t ? v : t;
    t = (unsigned)__builtin_amdgcn_update_dpp(0, (int)v, 0x141, 0xF, 0xF, false); v = v > t ? v : t;
    t = (unsigned)__builtin_amdgcn_update_dpp(0, (int)v, 0x140, 0xF, 0xF, false); v = v > t ? v : t;
    unsigned a = __builtin_amdgcn_readlane(v, 0), b = __builtin_amdgcn_readlane(v, 16), c = __builtin_amdgcn_readlane(v, 32), d = __builtin_amdgcn_readlane(v, 48);
    a = a > b ? a : b; c = c > d ? c : d; return a > c ? a : c;
}
#define LDS_WAIT() asm volatile("s_waitcnt lgkmcnt(0)" ::: "memory")
#define VM_WAIT() asm volatile("s_waitcnt vmcnt(0)" ::: "memory")

namespace pg8 {
constexpr int BM = 256, BK = 64, HALF = 128, HTB = HALF * BK * 2  , STAGE_BYTES = 8 * HTB, NXCD = 8, WGM = 8;
__host__ __device__ __forceinline__ int lds_byte(int r, int c) { const int st = (r >> 4) * 2 + (c >> 5), rr = r & 15, cc = c & 31, ob = rr * 64 + cc * 2; return st * 1024 + (ob ^ (((ob >> 9) & 1) << 5)); }
__host__ __device__ __forceinline__ void stage_rc(int b, int& R, int& C) { const int st = b / 1024, sb = b % 1024, swz = sb ^ (((sb >> 9) & 1) << 5); R = (st >> 1) * 16 + swz / 64; C = (st & 1) * 32 + (swz % 64) / 2; }
__host__ __device__ __forceinline__ int perm32(int rho) { const int n = rho >> 4, i = rho & 15; return 8 * (i >> 2) + 4 * n + (i & 3); }

struct Unit { int pm, pn; };
struct Gemm { const bf16_t* A; const bf16_t* Bt; int K; };

struct StaticOrder {
    int nM, nN, nwg, G, c;
    __device__ void init(int nM_, int nN_, int G_, int c_) { nM = nM_; nN = nN_; nwg = nM * nN; G = G_; c = c_; }
    __device__ __forceinline__ bool tile(int i, int& pm, int& pn) const {
        const long L = (long)i * G + c; if (L >= nwg) return false;
        int wgid = (int)L; { const int q = nwg / NXCD, r = nwg % NXCD, xcd = wgid % NXCD, off = wgid / NXCD; wgid = (xcd < r ? xcd * (q + 1) : r * (q + 1) + (xcd - r) * q) + off; }
        const int nig = WGM * nN, gid = wgid / nig, fm = gid * WGM, gsz = (nM - fm) < WGM ? (nM - fm) : WGM;
        pm = fm + ((wgid % nig) % gsz); pn = (wgid % nig) / gsz; return true;
    }
    __device__ __forceinline__ bool next(int i, Unit& u) const { return tile(i, u.pm, u.pn); }
};

template <class Epi, class Sched, bool GATHER, bool I8 = false>
__device__ __forceinline__ void gemm_phase(LAS unsigned char* lds, const Gemm g, const Sched& S, const Epi& E) {
    int tid = threadIdx.x; asm volatile("" : "+v"(tid));
    const int wid = __builtin_amdgcn_readfirstlane(tid >> 6), lane = tid & 63, wr = wid >> 2, wc = wid & 3, fr = lane & 15, fq = lane >> 4;
    const int K = g.K, RB = I8 ? K : 2 * K  , nt = RB / (BK * 2);
    unsigned voffA[2], voffB[2]; int RA[2], CA[2];
#pragma unroll
    for (int i = 0; i < 2; ++i) { int R, C; stage_rc(tid * 16 + i * 8192, R, C); const int Rb = (R & ~31) + perm32(R & 31); RA[i] = R; CA[i] = C;
        voffA[i] = (unsigned)(R * RB + C * 2); voffB[i] = (unsigned)(Rb * RB + C * 2); }
    const size_t kstep = (size_t)(BK * 2);
    const size_t hstep = (size_t)HALF * RB;
    const size_t tstep = 2 * hstep;
    const unsigned ldsw = (unsigned)wid * 1024u;
    const int aoff = lds_byte(wr * 64 + fr, fq * 8), boff = lds_byte(wc * 32 + fr, fq * 8);
#define PG8_SA(b, h) (((b) * 2 + (h)) * HTB)
#define PG8_SB(b, h) ((4 + (b) * 2 + (h)) * HTB)
#define PG8_STAGE(bufoff, gbase, voff) do { _Pragma("unroll") for (int _i = 0; _i < 2; ++_i) \
        __builtin_amdgcn_global_load_lds((const unsigned*)((const char*)(gbase) + (voff)[_i]), (LAS unsigned*)(lds + (bufoff) + ldsw + _i * 8192), 16, 0, 0); } while (0)
#define PG8_STAGE_A(bufoff, h, ubase, koff, VO) do { if constexpr (GATHER) { PG8_STAGE(bufoff, (const char*)g.A + (koff), VO[h]); } else { PG8_STAGE(bufoff, (ubase) + (h) * hstep + (koff), voffA); } } while (0)
#define PG8_LDA(dst, b, h) do { _Pragma("unroll") for (int m = 0; m < 4; ++m) _Pragma("unroll") for (int k = 0; k < 2; ++k) dst[m][k] = *(const LAS bf16x8*)(lds + PG8_SA(b, h) + aoff + m * 2048 + k * 1024); } while (0)
#define PG8_LDB(dst, b, h) do { _Pragma("unroll") for (int n = 0; n < 2; ++n) _Pragma("unroll") for (int k = 0; k < 2; ++k) dst[n][k] = *(const LAS bf16x8*)(lds + PG8_SB(b, h) + boff + n * 2048 + k * 1024); } while (0)
#define PG8_MMA(ai, bj, At, Bt) do { __builtin_amdgcn_s_setprio(1); _Pragma("unroll") for (int m = 0; m < 4; ++m) _Pragma("unroll") for (int n = 0; n < 2; ++n) _Pragma("unroll") for (int k = 0; k < 2; ++k) \
        { if constexpr (I8) acc[ai][bj][m][n] = __builtin_amdgcn_mfma_i32_16x16x64_i8(__builtin_bit_cast(i32x4, Bt[n][k]), __builtin_bit_cast(i32x4, At[m][k]), acc[ai][bj][m][n], 0, 0, 0); \
          else acc[ai][bj][m][n] = __builtin_amdgcn_mfma_f32_16x16x32_bf16(Bt[n][k], At[m][k], acc[ai][bj][m][n], 0, 0, 0); } __builtin_amdgcn_s_setprio(0); } while (0)
#define PG8_WAIT_V(n) asm volatile("s_waitcnt vmcnt(" #n ")" ::: "memory")
#define PG8_WAIT_L(n) asm volatile("s_waitcnt lgkmcnt(" #n ")" ::: "memory")
#define PG8_BAR __builtin_amdgcn_s_barrier()
#define PG8_SCHED __builtin_amdgcn_sched_barrier(0)
    Unit cur, nxt; int ui = 0;
    if (!S.next(0, cur)) return;
    typedef typename std::conditional<I8, i32x4, f32x4>::type accv_t;
    accv_t acc[2][2][4][2];
#pragma unroll
    for (int a = 0; a < 2; ++a)
#pragma unroll
        for (int b = 0; b < 2; ++b)
#pragma unroll
            for (int m = 0; m < 4; ++m)
#pragma unroll
                for (int n = 0; n < 2; ++n) acc[a][b][m][n] = (accv_t){0, 0, 0, 0};
    bf16x8 At[4][2], B0[2][2], B1[2][2];
    unsigned oc[2][2], on[2][2];
    if constexpr (GATHER) {
#pragma unroll
        for (int h = 0; h < 2; ++h)
#pragma unroll
            for (int i = 0; i < 2; ++i) { oc[h][i] = (unsigned)(S.src_row(cur, h * HALF + RA[i]) * RB + CA[i] * 2); on[h][i] = oc[h][i]; }
    }
    const char* cA = GATHER ? (const char*)g.A : (const char*)g.A + (size_t)cur.pm * tstep; const char* cB = (const char*)g.Bt + (size_t)cur.pn * tstep;
    PG8_STAGE(PG8_SB(0, 0), cB, voffB); PG8_STAGE(PG8_SB(0, 1), cB + hstep, voffB); PG8_STAGE_A(PG8_SA(0, 0), 0, cA, 0, oc); PG8_STAGE_A(PG8_SA(0, 1), 1, cA, 0, oc);
    if (wr == 1) PG8_BAR;
    PG8_WAIT_V(2); PG8_BAR;
    PG8_STAGE(PG8_SB(1, 0), cB + kstep, voffB); PG8_STAGE_A(PG8_SA(1, 0), 0, cA, kstep, oc); PG8_STAGE(PG8_SB(1, 1), cB + hstep + kstep, voffB);
    PG8_WAIT_V(6); PG8_BAR;
    for (;;) {
        const bool has_next = S.next(ui + 1, nxt);
        const char* nA = GATHER ? (const char*)g.A : (has_next ? (const char*)g.A + (size_t)nxt.pm * tstep : cA); const char* nB = has_next ? (const char*)g.Bt + (size_t)nxt.pn * tstep : cB;
        if constexpr (GATHER) {
            if (has_next) {
#pragma unroll
                for (int h = 0; h < 2; ++h)
#pragma unroll
                    for (int i = 0; i < 2; ++i) on[h][i] = (unsigned)(S.src_row(nxt, h * HALF + RA[i]) * RB + CA[i] * 2);
            }
        }
        for (int t = 0; t < nt; t += 2) {
            const bool last = (t == nt - 2);
            const size_t k1 = (size_t)(t + 1) * kstep;
            const size_t k2 = last ? (size_t)0 : (size_t)(t + 2) * kstep, k3 = k2 + kstep;
            const char* a2 = last ? nA : cA; const char* b2 = last ? nB : cB;
            unsigned o2[2][2];
            if constexpr (GATHER) {
#pragma unroll
                for (int h = 0; h < 2; ++h)
#pragma unroll
                    for (int i = 0; i < 2; ++i) o2[h][i] = last ? on[h][i] : oc[h][i];
            }
            PG8_LDB(B0, 0, 0); PG8_LDB(B1, 0, 1); PG8_SCHED; PG8_LDA(At, 0, 0); PG8_STAGE_A(PG8_SA(1, 1), 1, cA, k1, oc);
            PG8_WAIT_V(8); PG8_WAIT_L(0); PG8_BAR; PG8_MMA(0, 0, At, B0); PG8_MMA(0, 1, At, B1); PG8_BAR; PG8_SCHED;
            PG8_LDA(At, 0, 1); PG8_STAGE(PG8_SB(0, 0), b2 + k2, voffB); PG8_STAGE(PG8_SB(0, 1), b2 + hstep + k2, voffB); PG8_STAGE_A(PG8_SA(0, 0), 0, a2, k2, o2);
            PG8_WAIT_V(8); PG8_WAIT_L(0); PG8_BAR; PG8_MMA(1, 0, At, B0); PG8_MMA(1, 1, At, B1); PG8_BAR; PG8_SCHED;
            PG8_LDB(B0, 1, 0); PG8_LDB(B1, 1, 1); PG8_SCHED; PG8_LDA(At, 1, 0); PG8_STAGE_A(PG8_SA(0, 1), 1, a2, k2, o2);
            PG8_WAIT_V(8); PG8_WAIT_L(0); PG8_BAR; PG8_MMA(0, 0, At, B0); PG8_MMA(0, 1, At, B1); PG8_BAR; PG8_SCHED;
            PG8_LDA(At, 1, 1); PG8_STAGE(PG8_SB(1, 0), b2 + k3, voffB); PG8_STAGE(PG8_SB(1, 1), b2 + hstep + k3, voffB); PG8_STAGE_A(PG8_SA(1, 0), 0, a2, k3, o2);
            PG8_WAIT_V(8); PG8_WAIT_L(0); PG8_BAR; PG8_MMA(1, 0, At, B0); PG8_MMA(1, 1, At, B1); PG8_BAR; PG8_SCHED;
        }
        if (wr == 0) PG8_BAR;
        const bool rst = E(acc, cur, wr, wc, fr, fq);
        if (!has_next) break;
        if (rst) {
#pragma unroll
        for (int a = 0; a < 2; ++a)
#pragma unroll
            for (int b = 0; b < 2; ++b)
#pragma unroll
                for (int m = 0; m < 4; ++m)
#pragma unroll
                    for (int n = 0; n < 2; ++n) acc[a][b][m][n] = (accv_t){0, 0, 0, 0};
        }
        cur = nxt; cA = nA; cB = nB; ++ui;
        if constexpr (GATHER) {
#pragma unroll
            for (int h = 0; h < 2; ++h)
#pragma unroll
                for (int i = 0; i < 2; ++i) oc[h][i] = on[h][i];
        }
        if (wr == 1) PG8_BAR;
    }
    PG8_WAIT_V(0);
    PG8_BAR;
#undef PG8_SA
#undef PG8_SB
#undef PG8_STAGE
#undef PG8_STAGE_A
#undef PG8_LDA
#undef PG8_LDB
#undef PG8_MMA
#undef PG8_WAIT_V
#undef PG8_WAIT_L
#undef PG8_BAR
#undef PG8_SCHED
}
}
typedef f32x4 acc_t[2][2][4][2];
typedef i32x4 acci_t[2][2][4][2];

struct EpiProj {
    bf16_t* O; const float* RS  ; const float* CS  ;
    __device__ __forceinline__ bool operator()(acci_t& acc, const pg8::Unit& u, int wr, int wc, int fr, int fq) const {
        const int pn = u.pn;
        const int act = (pn <= 1 || pn == 3 || pn == 4) ? 1 : (pn >= 12 ? 3 : (pn >= 8 ? 2 : 0));
        const int row0 = u.pm * 256 + wr * 64 + fr, col0 = pn * 256 + wc * 32 + 8 * fq;
        float cs[2][8];
#pragma unroll
        for (int bj = 0; bj < 2; ++bj) { const f32x4 c0 = *(const f32x4*)(CS + col0 + bj * 128), c1 = *(const f32x4*)(CS + col0 + bj * 128 + 4);
#pragma unroll
            for (int i = 0; i < 4; ++i) { cs[bj][i] = c0[i] * (act == 1 ? QSCALE : 1.f); cs[bj][4 + i] = c1[i] * (act == 1 ? QSCALE : 1.f); } }
#pragma unroll
        for (int ai = 0; ai < 2; ++ai)
#pragma unroll
            for (int m = 0; m < 4; ++m) { const int row = row0 + ai * 128 + m * 16; bf16_t* rowp = O + (size_t)row * NPROJ + col0; const float rs = RS[row];
#pragma unroll
                for (int bj = 0; bj < 2; ++bj) { f32x4 v0, v1;
#pragma unroll
                    for (int i = 0; i < 4; ++i) { v0[i] = (float)acc[ai][bj][m][0][i] * (rs * cs[bj][i]); v1[i] = (float)acc[ai][bj][m][1][i] * (rs * cs[bj][4 + i]); }
                    if (act == 2) {
#pragma unroll
                        for (int i = 0; i < 4; ++i) { v0[i] = gelu_tanh(v0[i]); v1[i] = gelu_tanh(v1[i]); } }
                    else if (act == 3) {
#pragma unroll
                        for (int i = 0; i < 4; ++i) { v0[i] = sigmoidf_(v0[i]); v1[i] = sigmoidf_(v1[i]); } }
                    u32x4 w; w.x = cvt_pk_bf16(v0[0], v0[1]); w.y = cvt_pk_bf16(v0[2], v0[3]); w.z = cvt_pk_bf16(v1[0], v1[1]); w.w = cvt_pk_bf16(v1[2], v1[3]);
                    *(u32x4*)(rowp + bj * 128) = w; } }
        return true;
    }
};

struct BranchOrder {
    pg8::StaticOrder so;
    __device__ __forceinline__ bool next(int j, pg8::Unit& u) const { const int i = j / 3, br = j - 3 * i; int pm, pn; if (!so.tile(i, pm, pn)) return false; u.pm = br * 256 + pm; u.pn = br * 4 + pn; return true; }
};
struct EpiBranch {
    const bf16_t* PROJ; bf16_t* MERGED;
    __device__ __forceinline__ bool operator()(acc_t& acc, const pg8::Unit& u, int wr, int wc, int fr, int fq) const {
        const int br = u.pn >> 2, pn = u.pn & 3, pm = u.pm & 255;
        const int row0 = pm * 256 + wr * 64 + fr, col0 = pn * 256 + wc * 32 + 8 * fq;
#pragma unroll
        for (int rnd = 0; rnd < 4; ++rnd) { const int ai = rnd >> 1, m0 = (rnd & 1) * 2;
            u32x4 gw[4][2], gd[4][2];
#pragma unroll
            for (int m = m0; m < m0 + 2; ++m)
#pragma unroll
                for (int bj = 0; bj < 2; ++bj) { const bf16_t* gp = PROJ + (size_t)(row0 + ai * 128 + m * 16) * NPROJ + C_G + br * 1024 + col0 + bj * 128;
                    gw[m][bj] = *(const u32x4*)gp; if (br != 2) gd[m][bj] = *(const u32x4*)(gp + 1024); }
#pragma unroll
            for (int m = m0; m < m0 + 2; ++m) { const size_t row = (size_t)(row0 + ai * 128 + m * 16);
#pragma unroll
                for (int bj = 0; bj < 2; ++bj) {
                    const u32x4 g = gw[m][bj];
                    float gn[8] = {bf_lo(g.x), bf_hi(g.x), bf_lo(g.y), bf_hi(g.y), bf_lo(g.z), bf_hi(g.z), bf_lo(g.w), bf_hi(g.w)};
                    if (br != 2) { const u32x4 d = gd[m][bj];
                        const float dn[8] = {bf_lo(d.x), bf_hi(d.x), bf_lo(d.y), bf_hi(d.y), bf_lo(d.z), bf_hi(d.z), bf_lo(d.w), bf_hi(d.w)};
#pragma unroll
                        for (int i = 0; i < 8; ++i) gn[i] = fmaxf(gn[i], 1e-18f) * frcp(fmaxf(dn[i], 1e-18f)); }
                    else {
#pragma unroll
                        for (int i = 0; i < 8; ++i) gn[i] = fmaxf(gn[i], 1e-18f); }
                    f32x4 v0 = acc[ai][bj][m][0], v1 = acc[ai][bj][m][1];
                    v0[0] *= gn[0]; v0[1] *= gn[1]; v0[2] *= gn[2]; v0[3] *= gn[3]; v1[0] *= gn[4]; v1[1] *= gn[5]; v1[2] *= gn[6]; v1[3] *= gn[7];
                    if (br != 2) { acc[ai][bj][m][0] = v0; acc[ai][bj][m][1] = v1; }
                    else { u32x4 w; w.x = cvt_pk_bf16(v0[0], v0[1]); w.y = cvt_pk_bf16(v0[2], v0[3]); w.z = cvt_pk_bf16(v1[0], v1[1]); w.w = cvt_pk_bf16(v1[2], v1[3]);
                        *(u32x4*)(MERGED + row * DM + col0 + bj * 128) = w; } } }
            asm volatile("" ::: "memory");
        }
        return br == 2;
    }
};

struct EpiWout {
    float* Y; float* SSP;
    __device__ __forceinline__ bool operator()(acc_t& acc, const pg8::Unit& u, int wr, int wc, int fr, int fq) const {
        const int row0 = u.pm * 256 + wr * 64 + fr, col0 = u.pn * 256 + wc * 32 + 8 * fq;
#pragma unroll
        for (int ai = 0; ai < 2; ++ai)
#pragma unroll
            for (int m = 0; m < 4; ++m) { const size_t row = (size_t)(row0 + ai * 128 + m * 16); float ss = 0.f;
#pragma unroll
                for (int bj = 0; bj < 2; ++bj) { const f32x4 v0 = acc[ai][bj][m][0], v1 = acc[ai][bj][m][1];
                    ss += (v0[0] * v0[0] + v0[1] * v0[1]) + (v0[2] * v0[2] + v0[3] * v0[3]) + (v1[0] * v1[0] + v1[1] * v1[1]) + (v1[2] * v1[2] + v1[3] * v1[3]);
                    float* yp = Y + row * DM + col0 + bj * 128; *(f32x4*)yp = v0; *(f32x4*)(yp + 4) = v1; }
                ss += __shfl_xor(ss, 16); ss += __shfl_xor(ss, 32);
                if (fq == 0) SSP[row * 16 + u.pn * 4 + wc] = ss; }
        return true;
    }
};

struct MoeOrder {
    int u0, u1, NB, rt_lo;
    const LAS int* tile_e;
    const LAS int* rowidx;
    __device__ __forceinline__ bool next(int i, pg8::Unit& u) const { const int x = u0 + i; if (x >= u1) return false; const int rt = x / NB, pn = x - rt * NB; u.pm = rt; u.pn = tile_e[rt] * NB + pn; return true; }
    __device__ __forceinline__ int src_row(const pg8::Unit& u, int r) const { return rowidx[(u.pm - rt_lo) * 256 + r]; }
};
struct EpiW1 {
    bf16_t* ACT; const float* b1  ;
    __device__ __forceinline__ bool operator()(acc_t& acc, const pg8::Unit& u, int wr, int wc, int fr, int fq) const {
        const int e = u.pn >> 3, pn = u.pn & 7;
        const int row0 = u.pm * 256 + wr * 64 + fr, j0 = pn * 128 + wc * 32 + 8 * fq;
        const float* bp = b1 + (size_t)e * (2 * FF) + 2 * j0;
        float bg[8], bl[8];
#pragma unroll
        for (int q = 0; q < 4; ++q) { const f32x4 t = *(const f32x4*)(bp + 4 * q); bg[2 * q] = t[0]; bl[2 * q] = t[1]; bg[2 * q + 1] = t[2]; bl[2 * q + 1] = t[3]; }
#pragma unroll
        for (int ai = 0; ai < 2; ++ai)
#pragma unroll
            for (int m = 0; m < 4; ++m) { float a[8];
#pragma unroll
                for (int i = 0; i < 8; ++i) { float gl = acc[ai][0][m][i >> 2][i & 3] + bg[i], li = acc[ai][1][m][i >> 2][i & 3] + bl[i];
                    gl = fminf(gl, 7.f); li = fminf(fmaxf(li, -7.f), 7.f);
                    a[i] = gl * frcp(1.f + fexp2(-1.702f * LOG2E * gl)) * (li + 1.f); }
                u32x4 w; w.x = cvt_pk_bf16(a[0], a[1]); w.y = cvt_pk_bf16(a[2], a[3]); w.z = cvt_pk_bf16(a[4], a[5]); w.w = cvt_pk_bf16(a[6], a[7]);
                *(u32x4*)(ACT + (size_t)(row0 + ai * 128 + m * 16) * FF + j0) = w; }
        return true;
    }
};
struct EpiW1I8 {
    bf16_t* ACT; const float* b1  ; const float* RS  ; const float* CS  ;
    const LAS int* rowidx; int rt_lo;
    __device__ __forceinline__ bool operator()(acci_t& acc, const pg8::Unit& u, int wr, int wc, int fr, int fq) const {
        const int e = u.pn >> 3, pn = u.pn & 7;
        const int rl0 = wr * 64 + fr, row0 = u.pm * 256 + rl0, j0 = pn * 128 + wc * 32 + 8 * fq;
        const float* bp = b1 + (size_t)e * (2 * FF) + 2 * j0;
        float bg[8], bl[8], cg[8], cl[8];
#pragma unroll
        for (int q = 0; q < 4; ++q) { const f32x4 t = *(const f32x4*)(bp + 4 * q); bg[2 * q] = t[0]; bl[2 * q] = t[1]; bg[2 * q + 1] = t[2]; bl[2 * q + 1] = t[3]; }
        { const float* cp = CS + (size_t)e * 2048 + pn * 256 + wc * 32 + 8 * fq;
          const f32x4 a0 = *(const f32x4*)cp, a1 = *(const f32x4*)(cp + 4), c0 = *(const f32x4*)(cp + 128), c1 = *(const f32x4*)(cp + 132);
#pragma unroll
          for (int i = 0; i < 4; ++i) { cg[i] = a0[i]; cg[4 + i] = a1[i]; cl[i] = c0[i]; cl[4 + i] = c1[i]; } }
        const LAS int* ri = rowidx + (u.pm - rt_lo) * 256 + rl0;
#pragma unroll
        for (int ai = 0; ai < 2; ++ai)
#pragma unroll
            for (int m = 0; m < 4; ++m) { const float rs = RS[ri[ai * 128 + m * 16]]; float a[8];
#pragma unroll
                for (int i = 0; i < 8; ++i) { float gl = (float)acc[ai][0][m][i >> 2][i & 3] * (rs * cg[i]) + bg[i], li = (float)acc[ai][1][m][i >> 2][i & 3] * (rs * cl[i]) + bl[i];
                    gl = fminf(gl, 7.f); li = fminf(fmaxf(li, -7.f), 7.f);
                    a[i] = gl * frcp(1.f + fexp2(-1.702f * LOG2E * gl)) * (li + 1.f); }
                u32x4 w; w.x = cvt_pk_bf16(a[0], a[1]); w.y = cvt_pk_bf16(a[2], a[3]); w.z = cvt_pk_bf16(a[4], a[5]); w.w = cvt_pk_bf16(a[6], a[7]);
                *(u32x4*)(ACT + (size_t)(row0 + ai * 128 + m * 16) * FF + j0) = w; }
        return true;
    }
};
struct EpiW2 {
    bf16_t* Y2; const float* b2  ;
    __device__ __forceinline__ bool operator()(acc_t& acc, const pg8::Unit& u, int wr, int wc, int fr, int fq) const {
        const int e = u.pn >> 2, pn = u.pn & 3;
        const int row0 = u.pm * 256 + wr * 64 + fr, col0 = pn * 256 + wc * 32 + 8 * fq;
        f32x4 bv[2][2];
#pragma unroll
        for (int bj = 0; bj < 2; ++bj)
#pragma unroll
            for (int n = 0; n < 2; ++n) bv[bj][n] = *(const f32x4*)(b2 + (size_t)e * DM + col0 + bj * 128 + 4 * n);
#pragma unroll
        for (int ai = 0; ai < 2; ++ai)
#pragma unroll
            for (int m = 0; m < 4; ++m) { bf16_t* rowp = Y2 + (size_t)(row0 + ai * 128 + m * 16) * DM + col0;
#pragma unroll
                for (int bj = 0; bj < 2; ++bj) { const f32x4 v0 = acc[ai][bj][m][0] + bv[bj][0], v1 = acc[ai][bj][m][1] + bv[bj][1];
                    u32x4 w; w.x = cvt_pk_bf16(v0[0], v0[1]); w.y = cvt_pk_bf16(v0[2], v0[3]); w.z = cvt_pk_bf16(v1[0], v1[1]); w.w = cvt_pk_bf16(v1[2], v1[3]);
                    *(u32x4*)(rowp + bj * 128) = w; } }
        return true;
    }
};
#define XB_TMO      128
#define XB_XCNT(j)  (256  + 64 * (j))
#define XB_XSUB(j)  (1280 + 64 * (j))
#define XB_XGEN(j)  (2304 + 64 * (j))
#define XB_TOP      3328
#define XB_TOPGEN   3392
#define XCD_BAR_WORDS 3456
#define XB_SPIN_CAP (1u << 18)

__device__ __forceinline__ unsigned xb_ld(unsigned* p)              { return __hip_atomic_load(p, __ATOMIC_RELAXED, __HIP_MEMORY_SCOPE_AGENT); }
__device__ __forceinline__ unsigned xb_add(unsigned* p, unsigned v) { return __hip_atomic_fetch_add(p, v, __ATOMIC_RELAXED, __HIP_MEMORY_SCOPE_AGENT); }
__device__ __forceinline__ unsigned xb_xcc_id() { return (unsigned)__builtin_amdgcn_s_getreg((3 << 11) | 20) & 0xFu; }
#define XB_SPIN(cond, bar) do { unsigned _sp = 0; while (cond) { __builtin_amdgcn_s_sleep(1); \
    if ((++_sp & 255u) == 0u) { if (xb_ld(&(bar)[XB_TMO])) break; if (_sp > XB_SPIN_CAP) { atomicAdd(&(bar)[XB_TMO], 1u); break; } } } } while (0)

struct XcdBarrier {
    unsigned* bar; unsigned x;
    volatile LAS unsigned* st;
};

__device__ __forceinline__ XcdBarrier xcd_barrier_post(unsigned* bar, volatile LAS unsigned* st) {
    XcdBarrier b; b.bar = bar; b.x = xb_xcc_id(); b.st = st;
    if (threadIdx.x == 0) (void)xb_add(&bar[XB_XCNT(b.x)], 1u);
    return b;
}
__device__ __forceinline__ void xcd_barrier_complete(unsigned* bar, unsigned x, unsigned& nloc, unsigned& nx) {
    const unsigned G = gridDim.x * gridDim.y * gridDim.z;
    unsigned sum, cnt, mine, sp = 0u;
    for (;;) {
        sum = 0u; cnt = 0u; mine = 0u;
#pragma unroll
        for (unsigned j = 0; j < 16; ++j) { const unsigned c = xb_ld(&bar[XB_XCNT(j)]); sum += c; cnt += (c > 0u) ? 1u : 0u; mine = (j == x) ? c : mine; }
        if (sum == G) break;
        __builtin_amdgcn_s_sleep(1);
        if ((++sp & 255u) == 0u) { if (xb_ld(&bar[XB_TMO])) break; if (sp > XB_SPIN_CAP) { atomicAdd(&bar[XB_TMO], 1u); break; } }
    }
    nloc = mine > 0u ? mine : 1u; nx = cnt > 0u ? cnt : 1u;
}

__device__ __forceinline__ void xcd_barrier(const XcdBarrier& b) {
    asm volatile("s_waitcnt vmcnt(0)" ::: "memory");
    __syncthreads();
    if (threadIdx.x == 0) {
        unsigned* bar = b.bar;
        __builtin_amdgcn_s_waitcnt(0);
        unsigned nloc = b.st[0], nx = b.st[1];
        if (nloc == 0u) { xcd_barrier_complete(bar, b.x, nloc, nx); b.st[0] = nloc; b.st[1] = nx; }
        const unsigned old = xb_add(&bar[XB_XSUB(b.x)], 1u);
        const unsigned gen = old / nloc;
        if (old + 1u == (gen + 1u) * nloc) {
            __builtin_amdgcn_fence(__ATOMIC_RELEASE, "agent");
            asm volatile("s_waitcnt vmcnt(0)" ::: "memory");
            const unsigned og = xb_add(&bar[XB_TOP], 1u);
            const unsigned tg = og / nx;
            if (og + 1u == (tg + 1u) * nx) xb_add(&bar[XB_TOPGEN], 1u);
            else XB_SPIN(xb_ld(&bar[XB_TOPGEN]) == tg, bar);
            __builtin_amdgcn_fence(__ATOMIC_ACQUIRE, "agent");
            xb_add(&bar[XB_XGEN(b.x)], 1u);
            asm volatile("s_waitcnt vmcnt(0)" ::: "memory");
        } else {
            XB_SPIN(xb_ld(&bar[XB_XGEN(b.x)]) == gen, bar);
            __builtin_amdgcn_fence(__ATOMIC_ACQUIRE, "agent");
            asm volatile("s_waitcnt vmcnt(0)" ::: "memory");
        }
    }
    __syncthreads();
}

constexpr size_t MiB = 1u << 20;
constexpr size_t WS_CTL = 0, CTL_ZERO_BYTES = 1 * MiB;
constexpr size_t WS_MOD = 1 * MiB;
constexpr size_t WS_SGW = 3 * MiB;
constexpr size_t WS_WRT = 3 * MiB + 512 * 1024;
constexpr size_t WS_RS = 4 * MiB;
constexpr size_t WS_CS1 = 5 * MiB;
constexpr size_t WS_CSIN = 6 * MiB;
constexpr size_t WS_W = 8 * MiB, W_LAYER = 209 * MiB;
constexpr size_t WO_WIN = 0, WO_WBR = 12 * MiB, WO_WOUT = 15 * MiB, WO_W1 = 17 * MiB, WO_W2 = 145 * MiB;
constexpr size_t WS_PROJ = 426 * MiB;
constexpr size_t WS_ACT = WS_PROJ;
constexpr size_t WS_H = 1194 * MiB;
constexpr size_t WS_O = 1322 * MiB;
constexpr size_t WS_Y = 1514 * MiB;
constexpr size_t WS_BITS = 1770 * MiB;
constexpr size_t WS_Y2 = WS_O;
constexpr size_t WS_SSP = 1850 * MiB;
constexpr size_t WS_ROWTOK = 1854 * MiB;
constexpr size_t WS_TOKINFO = 1862 * MiB;
constexpr size_t WS_SLAB = 1864 * MiB;
constexpr size_t WS_END = 1928 * MiB;
static_assert(WS_Y2 + (size_t)270336 * 2048 <= WS_SSP && WS_W + 2 * W_LAYER <= WS_PROJ && WS_PROJ + (size_t)MTOK * NPROJ * 2 <= WS_H, "d_ws map");
constexpr int CW_BAR = 4096;
constexpr int CW_CNT = 16384;

constexpr int RING_BYTES = 131072;
constexpr int MISC_OFF = 134144;
constexpr int TS_OFF = MISC_OFF + 512;
constexpr int TILE_E_OFF = MISC_OFF + 1024;
constexpr int ROWIDX_OFF = MISC_OFF + 5632;
constexpr int LDS_BYTES = 151552;
static_assert(ROWIDX_OFF + 8192 <= LDS_BYTES, "LDS map");

struct Args {
    const float* in[21]; float* out; unsigned char* ws; int ph_lo, ph_hi;
};
struct Frame {
    LAS unsigned char* lds; int tid, lane, wave, vcu, G;
};
__device__ __forceinline__ Frame phase_frame(const Frame& F0) { Frame F = F0; int t = threadIdx.x; asm volatile("" : "+v"(t)); F.tid = t; F.lane = t & 63; F.wave = __builtin_amdgcn_readfirstlane(t >> 6); return F; }
template <class T> __device__ __forceinline__ T* opq(T* p) { long z = 0; asm volatile("" : "+s"(z)); return (T*)((unsigned char*)p + z); }

__device__ __forceinline__ void p0_mod(const Frame& F, const float* c, const float* w_ada, const float* b_ada, float* MOD) {
    LAS float* csT = (LAS float*)F.lds;
    for (int i = F.tid; i < BATCH * DM; i += 512) { const int b = i & 31, k = i >> 5; const float v = c[b * DM + k]; csT[k * 32 + b] = v * sigmoidf_(v); }
    __syncthreads();
    const int gw = F.vcu * 8 + F.wave, NGW = F.G * 8;
    const int cg = F.lane & 15, kq = F.lane >> 4;
    for (int task = gw; task < DEPTH * 384; task += NGW) {
        const int l = task / 384, n = (task % 384) * 16 + cg;
        float acc[32];
#pragma unroll
        for (int b = 0; b < 32; ++b) acc[b] = 0.f;
        const float* w = w_ada + ((size_t)l * DM + kq * 256) * (6 * DM) + n;
#pragma unroll 4
        for (int k = 0; k < 256; ++k) {
            const float wv = w[(size_t)k * (6 * DM)];
            const LAS f32x4* cs = (const LAS f32x4*)(csT + (kq * 256 + k) * 32);
#pragma unroll
            for (int q = 0; q < 8; ++q) { const f32x4 c4 = cs[q]; acc[4 * q] += c4[0] * wv; acc[4 * q + 1] += c4[1] * wv; acc[4 * q + 2] += c4[2] * wv; acc[4 * q + 3] += c4[3] * wv; }
        }
#pragma unroll
        for (int b = 0; b < 32; ++b) { acc[b] += __shfl_xor(acc[b], 16); acc[b] += __shfl_xor(acc[b], 32); }
        if (kq == 0) { const float bb = b_ada[l * 6 * DM + n];
#pragma unroll
            for (int b = 0; b < 32; ++b) MOD[((size_t)l * BATCH + b) * (6 * DM) + n] = acc[b] + bb; }
    }
    __syncthreads();
}
__device__ __forceinline__ void tr_item(const float* W, size_t ldw, int srccol, bool valid, bf16_t* dst  , int K, LAS float* scr, int lane) {
    const float* wp = W + srccol;
#pragma unroll 8
    for (int i = 0; i < 32; ++i) { const int kk = 2 * i + (lane >> 5); scr[kk * 33 + (lane & 31)] = valid ? wp[(size_t)kk * ldw] : 0.f; }
    LDS_WAIT(); asm volatile("" ::: "memory");
    const int c = lane & 7;
#pragma unroll
    for (int j = 0; j < 4; ++j) { const int n = (lane >> 3) + 8 * j; const LAS float* s = scr + (8 * c) * 33 + n;
        u32x4 o; o.x = cvt_pk_bf16(s[0 * 33], s[1 * 33]); o.y = cvt_pk_bf16(s[2 * 33], s[3 * 33]); o.z = cvt_pk_bf16(s[4 * 33], s[5 * 33]); o.w = cvt_pk_bf16(s[6 * 33], s[7 * 33]);
        *(u32x4*)(dst + (size_t)n * K + 8 * c) = o; }
    LDS_WAIT(); asm volatile("" ::: "memory");
}
__device__ __forceinline__ void p0_weights(const Frame& F, const Args& a) {
    LAS float* scr = (LAS float*)(F.lds + F.wave * 16384);
    const int gw = F.vcu * 8 + F.wave, NGW = F.G * 8, lane = F.lane, jl = lane & 31;
    const float *w_in = a.in[8], *w_branch = a.in[13], *w_out = a.in[14], *w_router = a.in[15], *w1 = a.in[17], *w2 = a.in[19];
    constexpr int I_BR = 3 * 8 * 32, I_OUT = 16 * 32, I_RT = 16, I_W2 = 32 * 16 * 32;
    constexpr int I_LAYER = I_BR + I_OUT + I_RT + I_W2;
    for (int it = gw; it < DEPTH * I_LAYER; it += NGW) {
        const int l = it / I_LAYER; int r = it - l * I_LAYER;
        unsigned char* wl = a.ws + WS_W + (size_t)l * W_LAYER;
        if (r < I_BR) {
            const int br = r / 256, q = r % 256, kb = q / 32, nb = q % 32;
            tr_item(w_branch + ((size_t)(l * 3 + br) * 512 + kb * 64) * DM, DM, nb * 32 + jl, true, (bf16_t*)(wl + WO_WBR) + (size_t)(br * 1024 + nb * 32) * 512 + kb * 64, 512, scr, lane); continue; }
        r -= I_BR;
        if (r < I_OUT) {
            const int kb = r / 32, nb = r % 32;
            tr_item(w_out + ((size_t)l * DM + kb * 64) * DM, DM, nb * 32 + jl, true, (bf16_t*)(wl + WO_WOUT) + (size_t)nb * 32 * DM + kb * 64, DM, scr, lane); continue; }
        r -= I_OUT;
        if (r < I_RT) {
            const int kb = r;
            tr_item(w_router + ((size_t)l * DM + kb * 64) * NE, NE, jl, true, (bf16_t*)(a.ws + WS_WRT) + (size_t)l * NE * DM + kb * 64, DM, scr, lane); continue; }
        r -= I_RT;
        {
            const int e = r / 512, q = r % 512, kb = q / 32, nb = q % 32;
            tr_item(w2 + ((size_t)(l * NE + e) * FF + kb * 64) * DM, DM, nb * 32 + jl, true, (bf16_t*)(wl + WO_W2) + ((size_t)e * DM + nb * 32) * FF + kb * 64, FF, scr, lane); }
    }
    constexpr int ST_W1 = NE * 64, ST_IN = 192, ST_LAYER = ST_W1 + ST_IN;
    for (int st = gw; st < DEPTH * ST_LAYER; st += NGW) {
        const int l = st / ST_LAYER, q = st % ST_LAYER;
        const float* wp; size_t ldw; bool valid = true; signed char* dst; float* csp;
        if (q < ST_W1) { const int e = q / 64, nb = q % 64, n = nb * 32 + jl, pn = n >> 8, sgl = (n >> 7) & 1, jj = n & 127, src = 2 * (128 * pn + jj) + sgl;
            wp = w1 + ((size_t)(l * NE + e) * DM) * (2 * FF) + src; ldw = 2 * FF;
            dst = (signed char*)(a.ws + WS_W + (size_t)l * W_LAYER + WO_W1) + ((size_t)e * 2048 + nb * 32) * DM; csp = (float*)(a.ws + WS_CS1) + ((size_t)l * NE + e) * 2048 + n; }
        else { const int nb = q - ST_W1, n = nb * 32 + jl; valid = (n < 1832) || (n >= 2048); const int src = n < 1832 ? n : n - 216;
            wp = w_in + (size_t)l * DM * 5928 + (valid ? src : 0); ldw = 5928;
            dst = (signed char*)(a.ws + WS_W + (size_t)l * W_LAYER + WO_WIN) + (size_t)nb * 32 * DM; csp = (float*)(a.ws + WS_CSIN) + (size_t)l * NPROJ + n; }
        float am = 0.f;
#pragma unroll 16
        for (int i = 0; i < 512; ++i) am = fmaxf(am, fabsf(wp[(size_t)(2 * i + (lane >> 5)) * ldw]));
        am = fmaxf(am, __shfl_xor(am, 32));
        const float scale = valid ? fmaxf(am, 1e-30f) * (1.f / 127.f) : 1.f, inv = valid ? 1.f / scale : 0.f;
        if (lane < 32) *csp = scale;
        for (int kb = 0; kb < 16; ++kb) {
#pragma unroll 16
            for (int i = 0; i < 32; ++i) { const int kk = 2 * i + (lane >> 5); scr[kk * 33 + jl] = wp[(size_t)(kb * 64 + kk) * ldw] * inv; }
            LDS_WAIT(); asm volatile("" ::: "memory");
            { const int nr_ = lane >> 1, hb = lane & 1;
#pragma unroll
              for (int c16 = 0; c16 < 2; ++c16) { unsigned wq[4];
#pragma unroll
                  for (int d4 = 0; d4 < 4; ++d4) { unsigned v = 0u;
#pragma unroll
                      for (int bb = 0; bb < 4; ++bb) { const float x = scr[(hb * 32 + c16 * 16 + d4 * 4 + bb) * 33 + nr_]; int qi_ = (int)rintf(x); qi_ = qi_ > 127 ? 127 : (qi_ < -127 ? -127 : qi_); v |= ((unsigned)qi_ & 0xffu) << (8 * bb); }
                      wq[d4] = v; }
                  *(u32x4*)(dst + (size_t)nr_ * DM + kb * 64 + hb * 32 + c16 * 16) = (u32x4){wq[0], wq[1], wq[2], wq[3]}; } }
            LDS_WAIT(); asm volatile("" ::: "memory");
        }
    }
    const float* sg_w = a.in[10]; bf16_t* SGW = (bf16_t*)(a.ws + WS_SGW);
    for (int i = (F.vcu * 512 + F.tid) * 2; i < DEPTH * 8 * 128 * 128; i += F.G * 512 * 2) { const int s = i & 127, t = (i >> 7) & 127; const f32x2 v = *(const f32x2*)(sg_w + i);
        *(unsigned*)(SGW + i) = cvt_pk_bf16(s <= t ? v[0] : 0.f, (s + 1) <= t ? v[1] : 0.f); }
}

__device__ __forceinline__ void norm_mod_row(const f32x4 (&v)[4], float ss, const float* g, const float* sc, const float* sh, signed char* orow, float* rs, int lane) {
    const float rstd = 1.f / sqrtf(ss * (1.f / DM) + RMS_EPS);
    f32x4 o[4]; float am = 0.f;
#pragma unroll
    for (int j = 0; j < 4; ++j) { const int c = 4 * lane + 256 * j; const f32x4 gg = *(const f32x4*)(g + c), s1 = *(const f32x4*)(sc + c), s0 = *(const f32x4*)(sh + c);
        o[j] = (v[j] * rstd) * gg * (s1 + 1.f) + s0;
        am = fmaxf(am, fmaxf(fmaxf(fabsf(o[j][0]), fabsf(o[j][1])), fmaxf(fabsf(o[j][2]), fabsf(o[j][3])))); }
#pragma unroll
    for (int shf = 1; shf < 64; shf <<= 1) am = fmaxf(am, __shfl_xor(am, shf));
    const float scale = fmaxf(am, 1e-30f) * (1.f / 127.f), inv = 1.f / scale;
    if (lane == 0) *rs = scale;
#pragma unroll
    for (int j = 0; j < 4; ++j) { unsigned pk = 0u;
#pragma unroll
        for (int i = 0; i < 4; ++i) { int q = (int)rintf(o[j][i] * inv); q = q > 127 ? 127 : (q < -127 ? -127 : q); pk |= ((unsigned)q & 0xffu) << (8 * i); }
        *(unsigned*)(orow + 4 * lane + 256 * j) = pk; }
}
__device__ __forceinline__ void p1_norm(const Frame& F, const float* x, const float* g, const float* MOD0, signed char* H8, float* RS) {
    const int gw = F.vcu * 8 + F.wave, NGW = F.G * 8;
    for (int row = gw; row < MTOK; row += NGW) { const int b = row >> 11; const float* xr = x + (size_t)row * DM; f32x4 v[4]; float ss = 0.f;
#pragma unroll
        for (int j = 0; j < 4; ++j) { v[j] = *(const f32x4*)(xr + 4 * F.lane + 256 * j); ss += (v[j][0] * v[j][0] + v[j][1] * v[j][1]) + (v[j][2] * v[j][2] + v[j][3] * v[j][3]); }
        ss = wave_sum(ss);
        const float* mb = MOD0 + (size_t)b * 6 * DM;
        norm_mod_row(v, ss, g, mb + DM, mb, H8 + (size_t)row * DM, RS + row, F.lane); }
}
constexpr int TOPK_SEL = 256;
struct IdxOps { bf16x8 af[4][2]; u32x4 wraw[4][2]; bf16x8 kf[4][2]; };
__device__ __forceinline__ void dsa_index_load(IdxOps& P, const bf16_t* __restrict__ PROJ, int b, int qg, int lane, int wid) {
    const int n = lane & 31, hi = lane >> 5;
    const int q0 = qg * 16;
    const size_t tokbase = (size_t)b * SEQ;
    const int m = n, hm = (m >> 2) & 1, idx = (m & 3) + 4 * (m >> 3), aq = 2 * hm + (idx >> 3), ah = idx & 7;
#pragma unroll
    for (int qgp = 0; qgp < 4; ++qgp) { const bf16_t* qp = PROJ + (tokbase + q0 + 4 * qgp + aq) * NPROJ + C_QI + ah * 32 + 8 * hi;
        P.af[qgp][0] = *(const bf16x8*)qp; P.af[qgp][1] = *(const bf16x8*)(qp + 16); }
}
__device__ __forceinline__ void dsa_index_load_k(IdxOps& P, const bf16_t* __restrict__ PROJ, int b, int qg, int lane, int wid) {
    const int n = lane & 31, hi = lane >> 5;
    const int q0 = qg * 16, nkb = (q0 + 16 + 31) >> 5;
    const size_t tokbase = (size_t)b * SEQ;
#pragma unroll
    for (int qgp = 0; qgp < 4; ++qgp)
#pragma unroll
        for (int qq = 0; qq < 2; ++qq) P.wraw[qgp][qq] = *(const u32x4*)(PROJ + (tokbase + q0 + 4 * qgp + 2 * hi + qq) * NPROJ + C_WI);
#pragma unroll
    for (int i = 0; i < 4; ++i) { const int kb = wid + 8 * i;
        if (kb < nkb) { const bf16_t* kp = PROJ + (tokbase + 32 * kb + n) * NPROJ + C_KI + 8 * hi; P.kf[i][0] = *(const bf16x8*)kp; P.kf[i][1] = *(const bf16x8*)(kp + 16); } }
}
__device__ __forceinline__ void dsa_index_scores(IdxOps& P, const bf16_t* __restrict__ PROJ, LAS float* sc, int b, int qg, int lane, int wid) {
    const int n = lane & 31, hi = lane >> 5;
    const int q0 = qg * 16, nkb = (q0 + 16 + 31) >> 5;
    const size_t tokbase = (size_t)b * SEQ;
    LAS float* scw = sc + (2 * hi) * 2048 + 32 * wid + n;
    float wv[4][16];
#pragma unroll
    for (int qgp = 0; qgp < 4; ++qgp)
#pragma unroll
        for (int qq = 0; qq < 2; ++qq) { const u32x4 w = P.wraw[qgp][qq];
            wv[qgp][8 * qq + 0] = bf_lo(w.x) * 0.0625f; wv[qgp][8 * qq + 1] = bf_hi(w.x) * 0.0625f; wv[qgp][8 * qq + 2] = bf_lo(w.y) * 0.0625f; wv[qgp][8 * qq + 3] = bf_hi(w.y) * 0.0625f;
            wv[qgp][8 * qq + 4] = bf_lo(w.z) * 0.0625f; wv[qgp][8 * qq + 5] = bf_hi(w.z) * 0.0625f; wv[qgp][8 * qq + 6] = bf_lo(w.w) * 0.0625f; wv[qgp][8 * qq + 7] = bf_hi(w.w) * 0.0625f; }
#pragma unroll
    for (int i = 0; i < 8; ++i) { const int kb = wid + 8 * i;
        if (kb < nkb) {
            const bf16x8 k0 = P.kf[i & 3][0], k1 = P.kf[i & 3][1];
            if (i < 4 && kb + 32 < nkb) { const bf16_t* kp = PROJ + (tokbase + 32 * (kb + 32) + n) * NPROJ + C_KI + 8 * hi; P.kf[i & 3][0] = *(const bf16x8*)kp; P.kf[i & 3][1] = *(const bf16x8*)(kp + 16); }
#pragma unroll
            for (int qgp = 0; qgp < 4; ++qgp) {
                f32x16 d = {0.f, 0.f, 0.f, 0.f, 0.f, 0.f, 0.f, 0.f, 0.f, 0.f, 0.f, 0.f, 0.f, 0.f, 0.f, 0.f};
                d = __builtin_amdgcn_mfma_f32_32x32x16_bf16(P.af[qgp][0], k0, d, 0, 0, 0);
                d = __builtin_amdgcn_mfma_f32_32x32x16_bf16(P.af[qgp][1], k1, d, 0, 0, 0);
                float sa = 0.f, sb = 0.f;
#pragma unroll
                for (int r = 0; r < 8; ++r) { sa += wv[qgp][r] * fmaxf(d[r], 0.f); sb += wv[qgp][8 + r] * fmaxf(d[8 + r], 0.f); }
                scw[(4 * qgp) * 2048 + 256 * i] = sa; scw[(4 * qgp + 1) * 2048 + 256 * i] = sb;
            } } }
}
__device__ __forceinline__ void dsa_index_select(LAS float* sc, unsigned long long* __restrict__ bits64, int b, int qg, int lane, int wid) {
    const int q0 = qg * 16;
    const size_t tokbase = (size_t)b * SEQ;
#pragma unroll 1
    for (int qq = 0; qq < 2; ++qq) {
        const int ql = 2 * wid + qq, pos = q0 + ql, nn = pos + 1, nr = (nn + 63) >> 6;
        const LAS float* scq = sc + ql * 2048;
        unsigned long long myw = 0ull;
        if (nn <= TOPK_SEL) {
#pragma unroll
            for (int r = 0; r < 4; ++r) if (r < nr) { const unsigned long long bal = __ballot(64 * r + lane <= pos); if (lane == r) myw = bal; }
        } else {
            unsigned u[32];
#pragma unroll
            for (int r = 0; r < 32; ++r) { u[r] = 0u;
                if (r < nr) { const int j = 64 * r + lane; float s = scq[j]; s = (s == 0.f) ? 0.f : s; const unsigned bts = __builtin_bit_cast(unsigned, s);
                    const unsigned uu = (bts & 0x80000000u) ? ~bts : (bts | 0x80000000u); u[r] = (j <= pos) ? uu : 0u; } }
            unsigned mx = 0u;
#pragma unroll
            for (int r = 0; r < 32; ++r) mx = u[r] > mx ? u[r] : mx;
            const unsigned umax = wave_max_u32(mx);
#define CNT_GE(cand, out) do { unsigned c_ = 0u; const unsigned cd_ = (cand); _Pragma("unroll") for (int g8 = 0; g8 < 4; ++g8) { if (8 * g8 < nr) { unsigned long long m_[8]; _Pragma("unroll") for (int q_ = 0; q_ < 8; ++q_) asm("v_cmp_le_u32_e64 %0, %1, %2" : "=s"(m_[q_]) : "s"(cd_), "v"(u[8 * g8 + q_])); _Pragma("unroll") for (int q_ = 0; q_ < 8; ++q_) c_ += (unsigned)__builtin_popcountll(m_[q_]); } } out = c_; } while (0)
            unsigned L = 0u, t = 0u; bool exact = false; unsigned c;
            if (umax > 0x80000000u + (3u << 23)) { const unsigned Lg = umax - (3u << 23); CNT_GE(Lg, c); if (c >= (unsigned)TOPK_SEL) { L = Lg; if (c == (unsigned)TOPK_SEL) { exact = true; t = Lg; } } }
            if (!exact) {
                const unsigned R = umax - L; unsigned tp = 0u;
                int bit = 31 - __builtin_clz(R | 1u);
#pragma unroll 1
                for (; bit >= 0; --bit) { const unsigned cand_off = tp | (1u << bit); if (cand_off > R) continue; const unsigned cand = L + cand_off; CNT_GE(cand, c);
                    if (c >= (unsigned)TOPK_SEL) { tp = cand_off; if (c == (unsigned)TOPK_SEL) { exact = true; break; } } }
                t = L + tp;
            }
            if (exact) {
#pragma unroll
                for (int r = 0; r < 32; ++r) if (r < nr) { const unsigned long long bal = __ballot(u[r] >= t); if (lane == r) myw = bal; }
            } else {
                unsigned cgt; { const unsigned t1 = t + 1u; CNT_GE(t1, cgt); }
                const unsigned need = (unsigned)TOPK_SEL - cgt; unsigned run = 0u;
#pragma unroll
                for (int r = 0; r < 32; ++r) if (r < nr) { const unsigned long long eqm = __ballot(u[r] == t);
                    const unsigned pre = run + __builtin_amdgcn_mbcnt_hi((unsigned)(eqm >> 32), __builtin_amdgcn_mbcnt_lo((unsigned)eqm, 0u));
                    const unsigned long long bal = __ballot((u[r] > t) || ((u[r] == t) && (pre < need)));
                    run += (unsigned)__builtin_popcountll(eqm); if (lane == r) myw = bal; }
            }
#undef CNT_GE
        }
        if (lane < nr) bits64[(tokbase + pos) * 32 + lane] = myw;
    }
}
__device__ __forceinline__ void dsa_index_phase(const Frame& F, const bf16_t* __restrict__ PROJ, unsigned long long* __restrict__ bits64) {
    LAS float* sc = (LAS float*)F.lds;
    IdxOps P;
    int u = F.vcu;
    if (u < 4096) { dsa_index_load(P, PROJ, u & 31, u >> 5, F.lane, F.wave); dsa_index_load_k(P, PROJ, u & 31, u >> 5, F.lane, F.wave); }
#pragma unroll 1
    for (; u < 4096; u += F.G) {
        dsa_index_scores(P, PROJ, sc, u & 31, u >> 5, F.lane, F.wave);
#ifdef T_SC2
        asm volatile("" ::: "memory"); dsa_index_load_k(P, PROJ, u & 31, u >> 5, F.lane, F.wave); dsa_index_scores(P, PROJ, sc, u & 31, u >> 5, F.lane, F.wave);
#endif
        __syncthreads();
        const int un = u + F.G;
        if (un < 4096) { dsa_index_load(P, PROJ, un & 31, un >> 5, F.lane, F.wave); dsa_index_load_k(P, PROJ, un & 31, un >> 5, F.lane, F.wave); }
        dsa_index_select(sc, bits64, u & 31, u >> 5, F.lane, F.wave);
#ifdef T_SEL2
        asm volatile("" ::: "memory"); dsa_index_select(sc, bits64, u & 31, u >> 5, F.lane, F.wave);
#endif
        __syncthreads();
    }
}

constexpr int KS = 144, VS = 144;
#ifndef USE_TR
#define USE_TR 1
#endif
template <int MODE>
__device__ __forceinline__ void attn_unit(const Frame& F, const bf16_t* __restrict__ PROJ, bf16_t* __restrict__ O, const unsigned* __restrict__ bits, const float* __restrict__ sinks, int b, int g, int qb) {
    const int tid = F.tid, lane = F.lane, wid = F.wave, n = lane & 31, hi = lane >> 5;
    constexpr int CQ = MODE ? C_QB : C_QA, CK = MODE ? C_KB : C_KA, CV = MODE ? C_VB : C_VA;
    const int hq = 4 * g + (wid >> 1), qpos = qb * 64 + 32 * (wid & 1) + n;
    const size_t tokbase = (size_t)b * SEQ;
    LAS unsigned char* Ks = F.lds; LAS unsigned char* Vs = F.lds + 64 * KS;
    bf16x8 qf[4];
    { const bf16_t* qp = PROJ + (tokbase + qpos) * NPROJ + CQ + hq * 64 + 8 * hi;
#pragma unroll
      for (int s = 0; s < 4; ++s) qf[s] = *(const bf16x8*)(qp + 16 * s); }
    f32x16 o0, o1;
#pragma unroll
    for (int r = 0; r < 16; ++r) { o0[r] = 0.f; o1[r] = 0.f; }
    float mrun, lsum;
    if (MODE == 0) { mrun = sinks[hq] * LOG2E; lsum = (hi == 0) ? 1.f : 0.f; } else { mrun = -1e30f; lsum = 0.f; }
    const int kt_lo = (MODE == 0) ? (qb >= 2 ? qb - 2 : 0) : 0, kt_hi = qb;
    const int srow = tid >> 3, sch = tid & 7;
    const bf16_t* kg = PROJ + (tokbase + srow) * NPROJ + CK + g * 64 + sch * 8;
    const bf16_t* vg = PROJ + (tokbase + srow) * NPROJ + CV + g * 64 + sch * 8;
    const unsigned* bp = bits + (tokbase + qpos) * 64;
    u32x4 kreg = *(const u32x4*)(kg + (size_t)kt_lo * 64 * NPROJ), vreg = *(const u32x4*)(vg + (size_t)kt_lo * 64 * NPROJ);
    u32x2 mreg = {0u, 0u};
    if (MODE == 1) mreg = *(const u32x2*)(bp + 2 * kt_lo);
    const int vbase = (4 * hi + ((lane & 15) >> 2)) * VS + (16 * ((lane >> 4) & 1) + 4 * (lane & 3)) * 2;
    for (int kt = kt_lo; kt <= kt_hi; ++kt) {
        __syncthreads();
        *(LAS u32x4*)(Ks + srow * KS + sch * 16) = kreg; *(LAS u32x4*)(Vs + srow * VS + sch * 16) = vreg;
        const u32x2 mcur = mreg;
        __syncthreads();
        if (kt < kt_hi) { kreg = *(const u32x4*)(kg + (size_t)(kt + 1) * 64 * NPROJ); vreg = *(const u32x4*)(vg + (size_t)(kt + 1) * 64 * NPROJ); if (MODE == 1) mreg = *(const u32x2*)(bp + 2 * (kt + 1)); }
        f32x16 p0, p1;
#pragma unroll
        for (int r = 0; r < 16; ++r) { p0[r] = 0.f; p1[r] = 0.f; }
#pragma unroll
        for (int s = 0; s < 4; ++s) { const bf16x8 k0 = *(const LAS bf16x8*)(Ks + n * KS + (16 * s + 8 * hi) * 2), k1 = *(const LAS bf16x8*)(Ks + (n + 32) * KS + (16 * s + 8 * hi) * 2);
            p0 = __builtin_amdgcn_mfma_f32_32x32x16_bf16(k0, qf[s], p0, 0, 0, 0); p1 = __builtin_amdgcn_mfma_f32_32x32x16_bf16(k1, qf[s], p1, 0, 0, 0); }
        unsigned w0, w1;
        if (MODE == 1) { w0 = mcur.x >> (4 * hi); w1 = mcur.y >> (4 * hi); }
        else {
#pragma unroll
            for (int blk = 0; blk < 2; ++blk) { const int d0 = qpos - (kt * 64 + 32 * blk); unsigned mk = 0u;
                if (d0 >= 0) { const int hb = d0 > 31 ? 31 : d0; int lo = d0 - 127; if (lo <= 31) { if (lo < 0) lo = 0; mk = (0xFFFFFFFFu >> (31 - hb)) & (0xFFFFFFFFu << lo); } }
                if (blk == 0) w0 = mk >> (4 * hi); else w1 = mk >> (4 * hi); }
        }
        float mx = -INFINITY;
#pragma unroll
        for (int r = 0; r < 16; ++r) { const int bitpos = 8 * (r >> 2) + (r & 3);
            p0[r] = ((w0 >> bitpos) & 1u) ? p0[r] : -INFINITY; p1[r] = ((w1 >> bitpos) & 1u) ? p1[r] : -INFINITY; mx = fmaxf(mx, fmaxf(p0[r], p1[r])); }
        mx = fmaxf(mx, __shfl_xor(mx, 32));
        const float mnew = fmaxf(mrun, mx), alpha = fexp2(mrun - mnew); mrun = mnew;
        float ps = 0.f;
#pragma unroll
        for (int r = 0; r < 16; ++r) { p0[r] = fexp2(p0[r] - mnew); p1[r] = fexp2(p1[r] - mnew); ps += p0[r] + p1[r]; }
        lsum = lsum * alpha + ps;
#pragma unroll
        for (int r = 0; r < 16; ++r) { o0[r] *= alpha; o1[r] *= alpha; }
        bf16x8 pf[2][2];
#pragma unroll
        for (int s2 = 0; s2 < 2; ++s2) { u32x4 a, c;
            a.x = cvt_pk_bf16(p0[8 * s2 + 0], p0[8 * s2 + 1]); a.y = cvt_pk_bf16(p0[8 * s2 + 2], p0[8 * s2 + 3]); a.z = cvt_pk_bf16(p0[8 * s2 + 4], p0[8 * s2 + 5]); a.w = cvt_pk_bf16(p0[8 * s2 + 6], p0[8 * s2 + 7]);
            c.x = cvt_pk_bf16(p1[8 * s2 + 0], p1[8 * s2 + 1]); c.y = cvt_pk_bf16(p1[8 * s2 + 2], p1[8 * s2 + 3]); c.z = cvt_pk_bf16(p1[8 * s2 + 4], p1[8 * s2 + 5]); c.w = cvt_pk_bf16(p1[8 * s2 + 6], p1[8 * s2 + 7]);
            pf[0][s2] = __builtin_bit_cast(bf16x8, a); pf[1][s2] = __builtin_bit_cast(bf16x8, c); }
#pragma unroll
        for (int db = 0; db < 2; ++db)
#pragma unroll
            for (int blk = 0; blk < 2; ++blk)
#pragma unroll
                for (int s2 = 0; s2 < 2; ++s2) {
                    bf16x8 vf;
#if USE_TR
                    const v4i16_t t0 = __builtin_amdgcn_ds_read_tr16_b64_v4i16((LAS v4i16_t*)(Vs + vbase + (32 * blk + 16 * s2) * VS + 64 * db));
                    const v4i16_t t1 = __builtin_amdgcn_ds_read_tr16_b64_v4i16((LAS v4i16_t*)(Vs + vbase + (32 * blk + 16 * s2 + 8) * VS + 64 * db));
                    vf = (bf16x8){t0[0], t0[1], t0[2], t0[3], t1[0], t1[1], t1[2], t1[3]};
#else
#pragma unroll
                    for (int j = 0; j < 8; ++j) vf[j] = *(const LAS short*)(Vs + (32 * blk + 16 * s2 + 8 * (j >> 2) + 4 * hi + (j & 3)) * VS + (32 * db + n) * 2);
#endif
                    if (db == 0) o0 = __builtin_amdgcn_mfma_f32_32x32x16_bf16(vf, pf[blk][s2], o0, 0, 0, 0); else o1 = __builtin_amdgcn_mfma_f32_32x32x16_bf16(vf, pf[blk][s2], o1, 0, 0, 0);
                }
    }
    const float lt = lsum + __shfl_xor(lsum, 32), inv = 1.f / lt;
    bf16_t* op = O + (tokbase + qpos) * 512 + hq * 64 + 4 * hi;
#pragma unroll
    for (int rq = 0; rq < 4; ++rq) { u32x2 w;
        w.x = cvt_pk_bf16(o0[4 * rq] * inv, o0[4 * rq + 1] * inv); w.y = cvt_pk_bf16(o0[4 * rq + 2] * inv, o0[4 * rq + 3] * inv); *(u32x2*)(op + 8 * rq) = w;
        w.x = cvt_pk_bf16(o1[4 * rq] * inv, o1[4 * rq + 1] * inv); w.y = cvt_pk_bf16(o1[4 * rq + 2] * inv, o1[4 * rq + 3] * inv); *(u32x2*)(op + 32 + 8 * rq) = w; }
}

constexpr int SGS = 1040;
static_assert(128 * SGS <= MISC_OFF, "spatial-gating tile vs LDS control words");
__device__ __forceinline__ void sg_unit(const Frame& F, const bf16_t* __restrict__ PROJ, const bf16_t* __restrict__ SGWl, const float* __restrict__ sgb, const float* __restrict__ lng, bf16_t* __restrict__ OC, int b, int ch) {
    const int lane = F.lane, wid = F.wave, n = lane & 31, hi = lane >> 5;
    const size_t tok0 = (size_t)b * SEQ + ch * 128;
    LAS unsigned char* V = F.lds;
    __syncthreads();
    float gl[8];
    { const f32x4 g0 = *(const f32x4*)(lng + 8 * lane), g1 = *(const f32x4*)(lng + 8 * lane + 4); gl[0] = g0[0]; gl[1] = g0[1]; gl[2] = g0[2]; gl[3] = g0[3]; gl[4] = g1[0]; gl[5] = g1[1]; gl[6] = g1[2]; gl[7] = g1[3]; }
    u32x4 wrow16[16];
#pragma unroll
    for (int rr = 0; rr < 16; ++rr) wrow16[rr] = *(const u32x4*)(PROJ + (tok0 + 16 * wid + rr) * NPROJ + C_V + 8 * lane);
#pragma unroll
    for (int rr = 0; rr < 16; ++rr) { const int row = 16 * wid + rr;
        const u32x4 w = wrow16[rr];
        float x[8] = {bf_lo(w.x), bf_hi(w.x), bf_lo(w.y), bf_hi(w.y), bf_lo(w.z), bf_hi(w.z), bf_lo(w.w), bf_hi(w.w)};
        float s = 0.f;
#pragma unroll
        for (int i = 0; i < 8; ++i) s += x[i];
        const float mean = wave_sum(s) * (1.f / 512.f); float q = 0.f;
#pragma unroll
        for (int i = 0; i < 8; ++i) { x[i] -= mean; q += x[i] * x[i]; }
        const float rstd = 1.f / sqrtf(wave_sum(q) * (1.f / 512.f) + LN_EPS);
        u32x4 o; o.x = cvt_pk_bf16(x[0] * rstd * gl[0], x[1] * rstd * gl[1]); o.y = cvt_pk_bf16(x[2] * rstd * gl[2], x[3] * rstd * gl[3]);
        o.z = cvt_pk_bf16(x[4] * rstd * gl[4], x[5] * rstd * gl[5]); o.w = cvt_pk_bf16(x[6] * rstd * gl[6], x[7] * rstd * gl[7]);
        *(LAS u32x4*)(V + row * SGS + 16 * lane) = o; }
    __syncthreads();
    const int g = wid;
    const int vbase = (8 * hi + ((lane & 15) >> 2)) * SGS + (g * 64 + 16 * ((lane >> 4) & 1) + 4 * (lane & 3)) * 2;
    const bf16_t* wg = SGWl + (size_t)g * 128 * 128;
#pragma unroll 1
    for (int tb = 0; tb < 4; ++tb) {
        f32x16 a0, a1;
#pragma unroll
        for (int r = 0; r < 16; ++r) { a0[r] = 0.f; a1[r] = 0.f; }
        const bf16_t* wrow = wg + (size_t)(32 * tb + n) * 128 + 8 * hi;
        bf16x8 afr[8];
#pragma unroll
        for (int ks = 0; ks < 8; ++ks) if (ks < 2 * tb + 2) afr[ks] = *(const bf16x8*)(wrow + 16 * ks);
#pragma unroll
        for (int ks = 0; ks < 8; ++ks) if (ks < 2 * tb + 2) {
            const bf16x8 af = afr[ks];
#pragma unroll
            for (int db = 0; db < 2; ++db) { bf16x8 vf;
#if USE_TR
                const v4i16_t t0 = __builtin_amdgcn_ds_read_tr16_b64_v4i16((LAS v4i16_t*)(V + vbase + (16 * ks) * SGS + 64 * db));
                const v4i16_t t1 = __builtin_amdgcn_ds_read_tr16_b64_v4i16((LAS v4i16_t*)(V + vbase + (16 * ks + 4) * SGS + 64 * db));
                vf = (bf16x8){t0[0], t0[1], t0[2], t0[3], t1[0], t1[1], t1[2], t1[3]};
#else
#pragma unroll
                for (int j = 0; j < 8; ++j) vf[j] = *(const LAS short*)(V + (16 * ks + 8 * hi + j) * SGS + (g * 64 + 32 * db + n) * 2);
#endif
                if (db == 0) a0 = __builtin_amdgcn_mfma_f32_32x32x16_bf16(af, vf, a0, 0, 0, 0); else a1 = __builtin_amdgcn_mfma_f32_32x32x16_bf16(af, vf, a1, 0, 0, 0); }
        }
#pragma unroll
        for (int r = 0; r < 16; ++r) { const int t = 32 * tb + 8 * (r >> 2) + 4 * hi + (r & 3); const float bb = sgb[g * 128 + t];
            const bf16_t* up = PROJ + (tok0 + t) * NPROJ + C_U + g * 64 + n; bf16_t* op = OC + (tok0 + t) * 512 + g * 64 + n;
            const float u0 = __builtin_bit_cast(float, (unsigned)up[0] << 16), u1 = __builtin_bit_cast(float, (unsigned)up[32] << 16);
            op[0] = (bf16_t)f2bf((a0[r] + bb) * u0); op[32] = (bf16_t)f2bf((a1[r] + bb) * u1); }
    }
}
constexpr int HS_STRIDE = 2064;
constexpr int P7_PART = 32 * HS_STRIDE;
constexpr int P7_LOG = P7_PART + 8 * 4096;
constexpr int P7_HIST = P7_LOG + 32 * 33 * 4;
__device__ __forceinline__ void p7_route(const Frame& F, const Args& a, int l, const float* xin, float* xout, const float* Y, const float* SSP, const float* MODl, signed char* H8, float* RS,
                                         const bf16_t* WRTl, unsigned* cnt, int* ROWTOK, unsigned* TOKINFO) {
    const int tid = F.tid, lane = F.lane, wid = F.wave, n = lane & 31, hi = lane >> 5;
    const float* g_post = a.in[5] + l * DM; const float* g_pre = a.in[6] + l * DM; const float* b_router = a.in[16] + l * NE;
    LAS unsigned char* hs = F.lds; LAS float* part = (LAS float*)(F.lds + P7_PART); LAS float* lg = (LAS float*)(F.lds + P7_LOG); LAS int* hist = (LAS int*)(F.lds + P7_HIST); LAS int* base = hist + 32;
    if (tid < 32) hist[tid] = 0;
    __syncthreads();
    for (int bt = F.vcu; bt < MTOK / 32; bt += F.G) {
        const int row0 = bt * 32, b = row0 >> 11;
        const float* mb = MODl + (size_t)b * 6 * DM;
#pragma unroll 1
        for (int rr = 0; rr < 4; ++rr) { const int rl = 4 * wid + rr; const size_t row = (size_t)row0 + rl;
            const f32x4 s4 = *(const f32x4*)(SSP + row * 16 + 4 * (lane & 3));
            float ssy = (s4[0] + s4[1]) + (s4[2] + s4[3]); ssy += __shfl_xor(ssy, 1); ssy += __shfl_xor(ssy, 2);
            const float rstd1 = 1.f / sqrtf(ssy * (1.f / DM) + RMS_EPS);
            f32x4 v[4]; float ss = 0.f;
#pragma unroll
            for (int j = 0; j < 4; ++j) { const int c = 4 * lane + 256 * j; const f32x4 yy = *(const f32x4*)(Y + row * DM + c), xx = *(const f32x4*)(xin + row * DM + c);
                const f32x4 gp = *(const f32x4*)(g_post + c), ga = *(const f32x4*)(mb + 2 * DM + c);
                v[j] = xx + ga * (yy * rstd1 * gp); *(f32x4*)(xout + row * DM + c) = v[j];
                ss += (v[j][0] * v[j][0] + v[j][1] * v[j][1]) + (v[j][2] * v[j][2] + v[j][3] * v[j][3]); }
            ss = wave_sum(ss);
            const float rstd = 1.f / sqrtf(ss * (1.f / DM) + RMS_EPS);
            f32x4 o[4]; float am = 0.f;
#pragma unroll
            for (int j = 0; j < 4; ++j) { const int c = 4 * lane + 256 * j; const f32x4 gg = *(const f32x4*)(g_pre + c), s1 = *(const f32x4*)(mb + 4 * DM + c), s0 = *(const f32x4*)(mb + 3 * DM + c);
                o[j] = (v[j] * rstd) * gg * (s1 + 1.f) + s0; u32x2 w; w.x = cvt_pk_bf16(o[j][0], o[j][1]); w.y = cvt_pk_bf16(o[j][2], o[j][3]);
                *(LAS u32x2*)(hs + rl * HS_STRIDE + c * 2) = w;
                am = fmaxf(am, fmaxf(fmaxf(fabsf(o[j][0]), fabsf(o[j][1])), fmaxf(fabsf(o[j][2]), fabsf(o[j][3])))); }
#pragma unroll
            for (int sh = 1; sh < 64; sh <<= 1) am = fmaxf(am, __shfl_xor(am, sh));
            const float scale = fmaxf(am, 1e-30f) * (1.f / 127.f), inv = 1.f / scale;
            if (lane == 0) RS[row] = scale;
#pragma unroll
            for (int j = 0; j < 4; ++j) { unsigned pk = 0u;
#pragma unroll
                for (int i = 0; i < 4; ++i) { int q = (int)rintf(o[j][i] * inv); q = q > 127 ? 127 : (q < -127 ? -127 : q); pk |= ((unsigned)q & 0xffu) << (8 * i); }
                *(unsigned*)(H8 + row * DM + 4 * lane + 256 * j) = pk; } }
        __syncthreads();
        {
            f32x16 d;
#pragma unroll
            for (int r = 0; r < 16; ++r) d[r] = 0.f;
#pragma unroll
            for (int ks = 0; ks < 8; ++ks) { const int k0 = (8 * wid + ks) * 16 + 8 * hi;
                const bf16x8 af = *(const LAS bf16x8*)(hs + n * HS_STRIDE + k0 * 2); const bf16x8 bf = *(const bf16x8*)(WRTl + (size_t)n * DM + k0);
                d = __builtin_amdgcn_mfma_f32_32x32x16_bf16(af, bf, d, 0, 0, 0); }
#pragma unroll
            for (int r = 0; r < 16; ++r) part[wid * 1024 + (8 * (r >> 2) + 4 * hi + (r & 3)) * 32 + n] = d[r];
        }
        __syncthreads();
        for (int i = tid; i < 1024; i += 512) { float s = b_router[i & 31];
#pragma unroll
            for (int w = 0; w < 8; ++w) s += part[w * 1024 + i]; lg[(i >> 5) * 33 + (i & 31)] = s; }
        __syncthreads();
        int e_k[4] = {0, 0, 0, 0}, lp_k[4] = {0, 0, 0, 0}; float w_k[4] = {0.f, 0.f, 0.f, 0.f};
        if (tid < 32) { LAS float* mylg = lg + tid * 33; float tl[4];
#pragma unroll
            for (int k = 0; k < 4; ++k) { float best = -INFINITY; int bi = 0;
                for (int e = 0; e < 32; ++e) { const float vv = mylg[e]; if (vv > best) { best = vv; bi = e; } }
                tl[k] = best; e_k[k] = bi; mylg[bi] = -INFINITY; }
            float sum = 0.f;
#pragma unroll
            for (int k = 0; k < 4; ++k) { w_k[k] = __expf(tl[k] - tl[0]); sum += w_k[k]; }
            const float inv = 1.f / sum;
#pragma unroll
            for (int k = 0; k < 4; ++k) { w_k[k] *= inv; lp_k[k] = __hip_atomic_fetch_add(&hist[e_k[k]], 1, __ATOMIC_RELAXED, __HIP_MEMORY_SCOPE_WORKGROUP); } }
        __syncthreads();
        if (tid < 32) { const int hc = hist[tid]; base[tid] = hc > 0 ? (int)__hip_atomic_fetch_add(cnt + 64 * tid, (unsigned)hc, __ATOMIC_RELAXED, __HIP_MEMORY_SCOPE_AGENT) : 0; hist[tid] = 0; }
        __syncthreads();
        if (tid < 32) { const int token = row0 + tid; u32x4 info; f32x4 ww;
#pragma unroll
            for (int k = 0; k < 4; ++k) { const int pos = base[e_k[k]] + lp_k[k]; ROWTOK[e_k[k] * 65536 + pos] = token; info[k] = ((unsigned)e_k[k] << 17) | (unsigned)pos; ww[k] = w_k[k]; }
            *(u32x4*)(TOKINFO + (size_t)token * 8) = info; *(f32x4*)(TOKINFO + (size_t)token * 8 + 4) = ww; }
        __syncthreads();
    }
}

__device__ __forceinline__ int moe_tables(const Frame& F, unsigned* cnt) {
    LAS int* ts = (LAS int*)(F.lds + TS_OFF); LAS int* te = (LAS int*)(F.lds + TILE_E_OFF);
    __syncthreads();
    if (F.tid == 0) { int acc = 0; for (int e = 0; e < NE; ++e) { ts[e] = acc; const unsigned c = __hip_atomic_load(cnt + 64 * e, __ATOMIC_RELAXED, __HIP_MEMORY_SCOPE_AGENT); acc += (int)((c + 255u) >> 8); } ts[NE] = acc; }
    __syncthreads();
    const int RT = ts[NE];
    for (int rt = F.tid; rt < RT; rt += 512) { int e = 0;
#pragma unroll 1
        for (int q = 1; q < NE; ++q) e += (ts[q] <= rt) ? 1 : 0;
        te[rt] = e; }
    __syncthreads();
    return RT;
}

__device__ __forceinline__ void p10_combine(const Frame& F, const Args& a, int l, float* xio, const bf16_t* Y2, const unsigned* TOKINFO, const float* MODbase, signed char* H8, float* RS) {
    const int lane = F.lane; const LAS int* ts = (const LAS int*)(F.lds + TS_OFF);
    const float* g_postf = a.in[7] + l * DM;
    const int gw = F.vcu * 8 + F.wave, NGW = F.G * 8;
    for (int row = gw; row < MTOK; row += NGW) { const int b = row >> 11;
        const u32x4 info = *(const u32x4*)(TOKINFO + (size_t)row * 8); const f32x4 ww = *(const f32x4*)(TOKINFO + (size_t)row * 8 + 4);
        f32x4 y[4];
#pragma unroll
        for (int j = 0; j < 4; ++j) y[j] = (f32x4){0.f, 0.f, 0.f, 0.f};
#pragma unroll
        for (int k = 0; k < 4; ++k) { const int e = (int)(info[k] >> 17), pos = (int)(info[k] & 0x1ffffu); const size_t slot = (size_t)ts[e] * 256 + pos; const float wk = ww[k];
#pragma unroll
            for (int j = 0; j < 4; ++j) { const u32x2 w = *(const u32x2*)(Y2 + slot * DM + 4 * lane + 256 * j);
                y[j][0] += wk * bf_lo(w.x); y[j][1] += wk * bf_hi(w.x); y[j][2] += wk * bf_lo(w.y); y[j][3] += wk * bf_hi(w.y); } }
        float ss = 0.f;
#pragma unroll
        for (int j = 0; j < 4; ++j) ss += (y[j][0] * y[j][0] + y[j][1] * y[j][1]) + (y[j][2] * y[j][2] + y[j][3] * y[j][3]);
        ss = wave_sum(ss);
        const float rstd = 1.f / sqrtf(ss * (1.f / DM) + RMS_EPS);
        const float* mb = MODbase + ((size_t)l * BATCH + b) * 6 * DM;
        f32x4 v[4]; float s2 = 0.f;
#pragma unroll
        for (int j = 0; j < 4; ++j) { const int c = 4 * lane + 256 * j; const f32x4 xx = *(const f32x4*)(xio + (size_t)row * DM + c), gp = *(const f32x4*)(g_postf + c), ga = *(const f32x4*)(mb + 5 * DM + c);
            v[j] = xx + ga * (y[j] * rstd * gp); *(f32x4*)(xio + (size_t)row * DM + c) = v[j];
            s2 += (v[j][0] * v[j][0] + v[j][1] * v[j][1]) + (v[j][2] * v[j][2] + v[j][3] * v[j][3]); }
        if (l + 1 < DEPTH) { s2 = wave_sum(s2); const float* mb1 = MODbase + ((size_t)(l + 1) * BATCH + b) * 6 * DM;
            norm_mod_row(v, s2, a.in[4] + (l + 1) * DM, mb1 + DM, mb1, H8 + (size_t)row * DM, RS + row, lane); }
    }
}
#ifndef MK_ONE_LAUNCH
#define MK_ONE_LAUNCH 1
#endif
constexpr int N_PHASES = 2 + 9 * DEPTH;
__global__ void __launch_bounds__(512, 2) fwd(Args args) {
    extern __shared__ __attribute__((aligned(16))) unsigned char lds_raw[];
    Frame F0;
    F0.lds = (LAS unsigned char*)lds_raw;
    F0.tid = threadIdx.x; F0.lane = F0.tid & 63; F0.wave = __builtin_amdgcn_readfirstlane(F0.tid >> 6);
    F0.G = gridDim.x; { const int bx = blockIdx.x; F0.vcu = (F0.G % 8 == 0) ? (bx % 8) * (F0.G / 8) + bx / 8 : bx; }
    volatile LAS unsigned* MISC = (volatile LAS unsigned*)(F0.lds + MISC_OFF);
    for (int u = F0.tid; u < 128; u += 512) MISC[u] = 0u;
    __syncthreads();
    unsigned* ctl = (unsigned*)(args.ws + WS_CTL);
    const int lo = args.ph_lo, hi = args.ph_hi;
    XcdBarrier bar; bar.bar = ctl + CW_BAR; bar.x = 0; bar.st = nullptr;
    if (hi - lo > 1) bar = xcd_barrier_post(ctl + CW_BAR, MISC + 8);
#ifndef PHASE_MASK
#define PHASE_MASK 0x7ff
#endif
#define PHON(j) ((PHASE_MASK >> (j)) & 1)
#ifndef REPEAT_MASK
#define REPEAT_MASK 0
#endif
#define REP(j) for (int rep_ = 0; rep_ <= ((REPEAT_MASK >> (j)) & 1); ++rep_)
#define IN(k) (lo <= (k) && (k) < hi)
#define BOTH(k) (IN(k) && IN((k) + 1))
#define GRID_BAR() xcd_barrier(bar)
#define PH_BEGIN() const Frame F = phase_frame(F0); unsigned char* ws = opq(args.ws); (void)ws
    if (PHON(0) && IN(0)) REP(0) { PH_BEGIN(); p0_mod(F, args.in[1], args.in[2], args.in[3], (float*)(ws + WS_MOD)); p0_weights(F, args); if (BOTH(0)) GRID_BAR(); }
    if (PHON(1) && IN(1)) REP(1) { PH_BEGIN(); p1_norm(F, args.in[0], args.in[4], (const float*)(ws + WS_MOD), (signed char*)(ws + WS_H), (float*)(ws + WS_RS)); if (BOTH(1)) GRID_BAR(); }

#pragma unroll 1
    for (int l = 0; l < DEPTH; ++l) {
        const int pb = 2 + 9 * l;
        if (PHON(2) && IN(pb + 0)) REP(2) { PH_BEGIN();
            pg8::Gemm g{(const bf16_t*)(ws + WS_H), (const bf16_t*)(ws + WS_W + (size_t)l * W_LAYER + WO_WIN), DM}; pg8::StaticOrder S; S.init(MTOK / 256, NPROJ / 256, F.G, (int)blockIdx.x);
            EpiProj E{(bf16_t*)(ws + WS_PROJ), (const float*)(ws + WS_RS), (const float*)(ws + WS_CSIN) + (size_t)l * NPROJ};
            pg8::gemm_phase<EpiProj, pg8::StaticOrder, false, true>(F.lds, g, S, E);
            if (BOTH(pb + 0)) GRID_BAR();
        }
        if (PHON(3) && IN(pb + 1)) REP(3) { PH_BEGIN();
            const bf16_t* PROJ = (const bf16_t*)(ws + WS_PROJ); bf16_t* OABC = (bf16_t*)(ws + WS_O);
#ifndef SUBREP
#define SUBREP 0
#endif
            for (int r_ = 0; r_ <= (SUBREP & 1); ++r_) dsa_index_phase(F, PROJ, (unsigned long long*)(ws + WS_BITS));
            for (int r_ = 0; r_ <= ((SUBREP >> 1) & 1); ++r_)
            for (int u = F.vcu; u < 2048; u += F.G) { const int cu = u & 255, j = u >> 8, bg = cu >> 2, s = cu & 3, qb = (j & 1) ? (8 * (j >> 1) + 7 - s) : (8 * (j >> 1) + s);
                attn_unit<0>(F, PROJ, OABC, nullptr, args.in[9] + l * 8, bg >> 1, bg & 1, qb); }
            for (int r_ = 0; r_ <= ((SUBREP >> 2) & 1); ++r_)
            for (int u = F.vcu; u < 512; u += F.G)
                sg_unit(F, PROJ, (const bf16_t*)(ws + WS_SGW) + (size_t)l * 8 * 128 * 128, args.in[11] + l * 8 * 128, args.in[12] + l * 512, OABC + (size_t)2 * MTOK * 512, u >> 4, u & 15);
            if (BOTH(pb + 1)) GRID_BAR();
        }
        if (PHON(4) && IN(pb + 2)) REP(4) { PH_BEGIN();
            for (int u = F.vcu; u < 2048; u += F.G) { const int cu = u & 255, j = u >> 8, bg = cu >> 2, s = cu & 3, qb = (j & 1) ? (8 * (j >> 1) + 7 - s) : (8 * (j >> 1) + s);
                attn_unit<1>(F, (const bf16_t*)(ws + WS_PROJ), (bf16_t*)(ws + WS_O) + (size_t)MTOK * 512, (const unsigned*)(ws + WS_BITS), nullptr, bg >> 1, bg & 1, qb); }
            __syncthreads();
            if (BOTH(pb + 2)) GRID_BAR();
        }
        if (PHON(5) && IN(pb + 3)) REP(5) { PH_BEGIN();
            pg8::Gemm g{(const bf16_t*)(ws + WS_O), (const bf16_t*)(ws + WS_W + (size_t)l * W_LAYER + WO_WBR), 512}; BranchOrder S; S.so.init(MTOK / 256, DM / 256, F.G, (int)blockIdx.x);
            EpiBranch E{(const bf16_t*)(ws + WS_PROJ), (bf16_t*)(ws + WS_H)};
            pg8::gemm_phase<EpiBranch, BranchOrder, false>(F.lds, g, S, E);
            if (BOTH(pb + 3)) GRID_BAR();
        }
        if (PHON(6) && IN(pb + 4)) REP(6) { PH_BEGIN();
            pg8::Gemm g{(const bf16_t*)(ws + WS_H), (const bf16_t*)(ws + WS_W + (size_t)l * W_LAYER + WO_WOUT), DM}; pg8::StaticOrder S; S.init(MTOK / 256, DM / 256, F.G, (int)blockIdx.x);
            EpiWout E{(float*)(ws + WS_Y), (float*)(ws + WS_SSP)};
            pg8::gemm_phase<EpiWout, pg8::StaticOrder, false>(F.lds, g, S, E);
            if (BOTH(pb + 4)) GRID_BAR();
        }
        if (PHON(7) && IN(pb + 5)) REP(7) { PH_BEGIN();
            p7_route(F, args, l, l == 0 ? args.in[0] : (const float*)args.out, args.out, (const float*)(ws + WS_Y), (const float*)(ws + WS_SSP), (const float*)(ws + WS_MOD) + (size_t)l * BATCH * 6 * DM, (signed char*)(ws + WS_H), (float*)(ws + WS_RS),
                     (const bf16_t*)(ws + WS_WRT) + (size_t)l * NE * DM, (unsigned*)(ws + WS_CTL) + CW_CNT + l * 32 * 64, (int*)(ws + WS_ROWTOK), (unsigned*)(ws + WS_TOKINFO));
            if (BOTH(pb + 5)) GRID_BAR();
        }
        if (PHON(8) && IN(pb + 6)) REP(8) { PH_BEGIN();
            unsigned* cnt = (unsigned*)(ws + WS_CTL) + CW_CNT + l * 32 * 64; const int* ROWTOK = (const int*)(ws + WS_ROWTOK);
            const int RT = moe_tables(F, cnt);
            LAS int* ts = (LAS int*)(F.lds + TS_OFF); LAS int* te = (LAS int*)(F.lds + TILE_E_OFF); LAS int* ri = (LAS int*)(F.lds + ROWIDX_OFF);
            const long U = (long)RT * 8; MoeOrder S; S.u0 = (int)(U * F.vcu / F.G); S.u1 = (int)(U * (F.vcu + 1) / F.G); S.NB = 8; S.rt_lo = S.u0 / 8; S.tile_e = te; S.rowidx = ri;
            if (S.u1 > S.u0) { const int rt_hi = (S.u1 - 1) / 8; int ntile = rt_hi - S.rt_lo + 1; if (ntile > 8) ntile = 8;
                for (int i = F.tid; i < ntile * 256; i += 512) { const int rt = S.rt_lo + (i >> 8), r = i & 255, e = te[rt], first = (rt - ts[e]) * 256 + r;
                    const int c = (int)__hip_atomic_load(cnt + 64 * e, __ATOMIC_RELAXED, __HIP_MEMORY_SCOPE_AGENT); ri[i] = first < c ? ROWTOK[e * 65536 + first] : 0; } }
            __syncthreads();
            pg8::Gemm g{(const bf16_t*)(ws + WS_H), (const bf16_t*)(ws + WS_W + (size_t)l * W_LAYER + WO_W1), DM};
            EpiW1I8 E{(bf16_t*)(ws + WS_ACT), args.in[18] + (size_t)l * NE * 2 * FF, (const float*)(ws + WS_RS), (const float*)(ws + WS_CS1) + (size_t)l * NE * 2048, ri, S.rt_lo};
            pg8::gemm_phase<EpiW1I8, MoeOrder, true, true>(F.lds, g, S, E);
            if (BOTH(pb + 6)) GRID_BAR();
        }
        if (PHON(9) && IN(pb + 7)) REP(9) { PH_BEGIN();
            const int RT = moe_tables(F, (unsigned*)(ws + WS_CTL) + CW_CNT + l * 32 * 64);
            const long U = (long)RT * 4; MoeOrder S; S.u0 = (int)(U * F.vcu / F.G); S.u1 = (int)(U * (F.vcu + 1) / F.G); S.NB = 4; S.rt_lo = 0; S.tile_e = (LAS int*)(F.lds + TILE_E_OFF); S.rowidx = nullptr;
            pg8::Gemm g{(const bf16_t*)(ws + WS_ACT), (const bf16_t*)(ws + WS_W + (size_t)l * W_LAYER + WO_W2), FF};
            EpiW2 E{(bf16_t*)(ws + WS_Y2), args.in[20] + (size_t)l * NE * DM};
            pg8::gemm_phase<EpiW2, MoeOrder, false>(F.lds, g, S, E);
            if (BOTH(pb + 7)) GRID_BAR();
        }
        if (PHON(10) && IN(pb + 8)) REP(10) { PH_BEGIN();
            (void)moe_tables(F, (unsigned*)(ws + WS_CTL) + CW_CNT + l * 32 * 64);
            p10_combine(F, args, l, args.out, (const bf16_t*)(ws + WS_Y2), (const unsigned*)(ws + WS_TOKINFO), (const float*)(ws + WS_MOD), (signed char*)(ws + WS_H), (float*)(ws + WS_RS));
            if (BOTH(pb + 8)) GRID_BAR();
        }
    }
#undef PH_BEGIN
#undef IN
#undef BOTH
#undef GRID_BAR
}

extern "C" void kernel_launch(void* const* d_in, const int* in_sizes, int n_in, void* d_out, int out_size, void* d_ws, size_t ws_size, hipStream_t stream) {
    static int grid = 0;
    if (grid == 0) {
        if (n_in != 21 || out_size != MTOK * DM || ws_size < WS_END) { fprintf(stderr, "kernel_launch: unexpected shapes (n_in %d, out %d, ws %zu); nothing launched\n", n_in, out_size, ws_size); grid = -1; return; }
        int dev = 0, cus = 0, per_cu = 0;
        if (hipGetDevice(&dev) != hipSuccess || hipDeviceGetAttribute(&cus, hipDeviceAttributeMultiprocessorCount, dev) != hipSuccess) { grid = -1; return; }
        if (hipFuncSetAttribute((const void*)fwd, hipFuncAttributeMaxDynamicSharedMemorySize, LDS_BYTES) != hipSuccess) { fprintf(stderr, "kernel_launch: hipFuncSetAttribute failed\n"); grid = -1; return; }
        if (hipOccupancyMaxActiveBlocksPerMultiprocessor(&per_cu, (const void*)fwd, 512, LDS_BYTES) != hipSuccess || per_cu < 1) { fprintf(stderr, "kernel_launch: occupancy query says %d\n", per_cu); }
        (void)hipGetLastError();
        grid = cus > 256 ? 256 : cus;
    }
    if (grid < 0) return;
    (void)hipMemsetAsync((char*)d_ws + WS_CTL, 0, CTL_ZERO_BYTES, stream);
    Args a{};
    for (int i = 0; i < 21; ++i) a.in[i] = (const float*)d_in[i];
    a.out = (float*)d_out; a.ws = (unsigned char*)d_ws;
#if MK_ONE_LAUNCH
    a.ph_lo = 0; a.ph_hi = N_PHASES;
    hipLaunchKernelGGL(fwd, dim3(grid), dim3(512), LDS_BYTES, stream, a);
#else
    for (int p = 0; p < N_PHASES; ++p) { a.ph_lo = p; a.ph_hi = p + 1; hipLaunchKernelGGL(fwd, dim3(grid), dim3(512), LDS_BYTES, stream, a); }
#endif
}
```

```cpp
#include <hip/hip_runtime.h>
#include <cstdio>
#include <cstdint>
#include <type_traits>

#define LAS __attribute__((address_space(3)))
#define GAS __attribute__((address_space(1)))
typedef unsigned short bf16_t;
typedef short bf16x8 __attribute__((ext_vector_type(8)));
typedef float f32x2 __attribute__((ext_vector_type(2)));
typedef float f32x4 __attribute__((ext_vector_type(4)));
typedef float f32x16 __attribute__((ext_vector_type(16)));
typedef unsigned u32x2 __attribute__((ext_vector_type(2)));
typedef unsigned u32x4 __attribute__((ext_vector_type(4)));
typedef short v4i16_t __attribute__((ext_vector_type(4)));
typedef int i32x4 __attribute__((ext_vector_type(4)));

constexpr int BATCH = 32, SEQ = 2048, DM = 1024, MTOK = BATCH * SEQ, DEPTH = 2;
constexpr int NPROJ = 6144;
constexpr int PLD = 3072;
constexpr int C_QA = 0, C_KA = 512, C_VA = 640, C_QB = 768, C_KB = 1280, C_VB = 1408, C_QI = 1536, C_KI = 1792, C_WI = 1824, C_U = 2048, C_V = 2560, C_G = 3072;
constexpr int NE = 32, FF = 1024;
constexpr float RMS_EPS = 1e-5f, LN_EPS = 1e-5f;
constexpr float LOG2E = 1.4426950408889634f;
constexpr float QSCALE = 0.125f * LOG2E;

__device__ __forceinline__ unsigned f2bf(float f) { unsigned u = __builtin_bit_cast(unsigned, f); return (u + 0x7fffu + ((u >> 16) & 1u)) >> 16; }
__device__ __forceinline__ unsigned cvt_pk_bf16(float lo, float hi) { unsigned r; asm volatile("v_cvt_pk_bf16_f32 %0, %1, %2" : "=v"(r) : "v"(lo), "v"(hi)); return r; }
__device__ __forceinline__ float bf_lo(unsigned w) { return __builtin_bit_cast(float, w << 16); }
__device__ __forceinline__ float bf_hi(unsigned w) { return __builtin_bit_cast(float, w & 0xffff0000u); }
__device__ __forceinline__ float fexp2(float x) { return __builtin_amdgcn_exp2f(x); }
__device__ __forceinline__ float frcp(float x) { return __builtin_amdgcn_rcpf(x); }
__device__ __forceinline__ float sigmoidf_(float x) { return frcp(1.f + fexp2(-LOG2E * x)); }
__device__ __forceinline__ float gelu_tanh(float x) { const float t = x + 0.044715f * x * x * x; return x * frcp(1.f + fexp2(-2.302208198f * t)); }
__device__ __forceinline__ float wave_sum(float v) {
#pragma unroll
    for (int o = 1; o < 64; o <<= 1) v += __shfl_xor(v, o);
    return v;
}
__device__ __forceinline__ unsigned wave_sum_u32(unsigned v) {
    v += (unsigned)__builtin_amdgcn_update_dpp(0, (int)v, 0xB1, 0xF, 0xF, false);
    v += (unsigned)__builtin_amdgcn_update_dpp(0, (int)v, 0x4E, 0xF, 0xF, false);
    v += (unsigned)__builtin_amdgcn_update_dpp(0, (int)v, 0x141, 0xF, 0xF, false);
    v += (unsigned)__builtin_amdgcn_update_dpp(0, (int)v, 0x140, 0xF, 0xF, false);
    return __builtin_amdgcn_readlane(v, 0) + __builtin_amdgcn_readlane(v, 16) + __builtin_amdgcn_readlane(v, 32) + __builtin_amdgcn_readlane(v, 48);
}
__device__ __forceinline__ unsigned wave_max_u32(unsigned v) {
    unsigned t;
    t = (unsigned)__builtin_amdgcn_update_dpp(0, (int)v, 0xB1, 0xF, 0xF, false); v = v > t ? v : t;
    t = (unsigned)__builtin_amdgcn_update_dpp(0, (int)v, 0x4E, 0xF, 0xF, false); v = v > t ? v : t;
    t = (unsigned)__builtin_amdgcn_update_dpp(0, (int)v, 0x141, 0xF, 0xF, false); v = v > t ? v : t;
    t = (unsigned)__builtin_amdgcn_update_dpp(0, (int)v, 0x140, 0xF, 0xF, false); v = v > t ? v : t;
    unsigned a = __builtin_amdgcn_readlane(v, 0), b = __builtin_amdgcn_readlane(v, 16), c = __builtin_amdgcn_readlane(v, 32), d = __builtin_amdgcn_readlane(v, 48);
    a = a > b ? a : b; c = c > d ? c : d; return a > c ? a : c;
}
#define LDS_WAIT() asm volatile("s_waitcnt lgkmcnt(0)" ::: "memory")
#define VM_WAIT() asm volatile("s_waitcnt vmcnt(0)" ::: "memory")

namespace pg8 {
constexpr int BM = 256, BK = 64, HALF = 128, HTB = HALF * BK * 2  , STAGE_BYTES = 8 * HTB, NXCD = 8, WGM = 8;
__host__ __device__ __forceinline__ int lds_byte(int r, int c) { const int st = (r >> 4) * 2 + (c >> 5), rr = r & 15, cc = c & 31, ob = rr * 64 + cc * 2; return st * 1024 + (ob ^ (((ob >> 9) & 1) << 5)); }
__host__ __device__ __forceinline__ void stage_rc(int b, int& R, int& C) { const int st = b / 1024, sb = b % 1024, swz = sb ^ (((sb >> 9) & 1) << 5); R = (st >> 1) * 16 + swz / 64; C = (st & 1) * 32 + (swz % 64) / 2; }
__host__ __device__ __forceinline__ int perm32(int rho) { const int n = rho >> 4, i = rho & 15; return 8 * (i >> 2) + 4 * n + (i & 3); }

struct Unit { int pm, pn; };
struct Gemm { const bf16_t* A; const bf16_t* Bt; int K; };

struct StaticOrder {
    int nM, nN, nwg, G, c;
    __device__ void init(int nM_, int nN_, int G_, int c_) { nM = nM_; nN = nN_; nwg = nM * nN; G = G_; c = c_; }
    __device__ __forceinline__ bool tile(int i, int& pm, int& pn) const {
        const long L = (long)i * G + c; if (L >= nwg) return false;
        int wgid = (int)L; { const int q = nwg / NXCD, r = nwg % NXCD, xcd = wgid % NXCD, off = wgid / NXCD; wgid = (xcd < r ? xcd * (q + 1) : r * (q + 1) + (xcd - r) * q) + off; }
        const int nig = WGM * nN, gid = wgid / nig, fm = gid * WGM, gsz = (nM - fm) < WGM ? (nM - fm) : WGM;
        pm = fm + ((wgid % nig) % gsz); pn = (wgid % nig) / gsz; return true;
    }
    __device__ __forceinline__ bool next(int i, Unit& u) const { return tile(i, u.pm, u.pn); }
};

template <class Epi, class Sched, bool GATHER, bool I8 = false>
__device__ __forceinline__ void gemm_phase(LAS unsigned char* lds, const Gemm g, const Sched& S, const Epi& E) {
    int tid = threadIdx.x; asm volatile("" : "+v"(tid));
    const int wid = __builtin_amdgcn_readfirstlane(tid >> 6), lane = tid & 63, wr = wid >> 2, wc = wid & 3, fr = lane & 15, fq = lane >> 4;
    const int K = g.K, RB = I8 ? K : 2 * K  , nt = RB / (BK * 2);
    unsigned voffA[2], voffB[2]; int RA[2], CA[2];
#pragma unroll
    for (int i = 0; i < 2; ++i) { int R, C; stage_rc(tid * 16 + i * 8192, R, C); const int Rb = (R & ~31) + perm32(R & 31); RA[i] = R; CA[i] = C;
        voffA[i] = (unsigned)(R * RB + C * 2); voffB[i] = (unsigned)(Rb * RB + C * 2); }
    const size_t kstep = (size_t)(BK * 2);
    const size_t hstep = (size_t)HALF * RB;
    const size_t tstep = 2 * hstep;
    const unsigned ldsw = (unsigned)wid * 1024u;
    const int aoff = lds_byte(wr * 64 + fr, fq * 8), boff = lds_byte(wc * 32 + fr, fq * 8);
#define PG8_SA(b, h) (((b) * 2 + (h)) * HTB)
#define PG8_SB(b, h) ((4 + (b) * 2 + (h)) * HTB)
#define PG8_STAGE(bufoff, gbase, voff) do { _Pragma("unroll") for (int _i = 0; _i < 2; ++_i) \
        __builtin_amdgcn_global_load_lds((const unsigned*)((const char*)(gbase) + (voff)[_i]), (LAS unsigned*)(lds + (bufoff) + ldsw + _i * 8192), 16, 0, 0); } while (0)
#define PG8_STAGE_A(bufoff, h, ubase, koff, VO) do { if constexpr (GATHER) { PG8_STAGE(bufoff, (const char*)g.A + (koff), VO[h]); } else { PG8_STAGE(bufoff, (ubase) + (h) * hstep + (koff), voffA); } } while (0)
#define PG8_LDA(dst, b, h) do { _Pragma("unroll") for (int m = 0; m < 4; ++m) _Pragma("unroll") for (int k = 0; k < 2; ++k) dst[m][k] = *(const LAS bf16x8*)(lds + PG8_SA(b, h) + aoff + m * 2048 + k * 1024); } while (0)
#define PG8_LDB(dst, b, h) do { _Pragma("unroll") for (int n = 0; n < 2; ++n) _Pragma("unroll") for (int k = 0; k < 2; ++k) dst[n][k] = *(const LAS bf16x8*)(lds + PG8_SB(b, h) + boff + n * 2048 + k * 1024); } while (0)
#define PG8_MMA(ai, bj, At, Bt) do { __builtin_amdgcn_s_setprio(1); _Pragma("unroll") for (int m = 0; m < 4; ++m) _Pragma("unroll") for (int n = 0; n < 2; ++n) _Pragma("unroll") for (int k = 0; k < 2; ++k) \
        { if constexpr (I8) acc[ai][bj][m][n] = __builtin_amdgcn_mfma_i32_16x16x64_i8(__builtin_bit_cast(i32x4, Bt[n][k]), __builtin_bit_cast(i32x4, At[m][k]), acc[ai][bj][m][n], 0, 0, 0); \
          else acc[ai][bj][m][n] = __builtin_amdgcn_mfma_f32_16x16x32_bf16(Bt[n][k], At[m][k], acc[ai][bj][m][n], 0, 0, 0); } __builtin_amdgcn_s_setprio(0); } while (0)
#define PG8_WAIT_V(n) asm volatile("s_waitcnt vmcnt(" #n ")" ::: "memory")
#define PG8_WAIT_L(n) asm volatile("s_waitcnt lgkmcnt(" #n ")" ::: "memory")
#define PG8_BAR __builtin_amdgcn_s_barrier()
#define PG8_SCHED __builtin_amdgcn_sched_barrier(0)
    Unit cur, nxt; int ui = 0;
    if (!S.next(0, cur)) return;
    typedef typename std::conditional<I8, i32x4, f32x4>::type accv_t;
    accv_t acc[2][2][4][2];
#pragma unroll
    for (int a = 0; a < 2; ++a)
#pragma unroll
        for (int b = 0; b < 2; ++b)
#pragma unroll
            for (int m = 0; m < 4; ++m)
#pragma unroll
                for (int n = 0; n < 2; ++n) acc[a][b][m][n] = (accv_t){0, 0, 0, 0};
    bf16x8 At[4][2], B0[2][2], B1[2][2];
    unsigned oc[2][2], on[2][2];
    if constexpr (GATHER) {
#pragma unroll
        for (int h = 0; h < 2; ++h)
#pragma unroll
            for (int i = 0; i < 2; ++i) { oc[h][i] = (unsigned)(S.src_row(cur, h * HALF + RA[i]) * RB + CA[i] * 2); on[h][i] = oc[h][i]; }
    }
    const char* cA = GATHER ? (const char*)g.A : (const char*)g.A + (size_t)cur.pm * tstep; const char* cB = (const char*)g.Bt + (size_t)cur.pn * tstep;
    PG8_STAGE(PG8_SB(0, 0), cB, voffB); PG8_STAGE(PG8_SB(0, 1), cB + hstep, voffB); PG8_STAGE_A(PG8_SA(0, 0), 0, cA, 0, oc); PG8_STAGE_A(PG8_SA(0, 1), 1, cA, 0, oc);
    if (wr == 1) PG8_BAR;
    PG8_WAIT_V(2); PG8_BAR;
    PG8_STAGE(PG8_SB(1, 0), cB + kstep, voffB); PG8_STAGE_A(PG8_SA(1, 0), 0, cA, kstep, oc); PG8_STAGE(PG8_SB(1, 1), cB + hstep + kstep, voffB);
    PG8_WAIT_V(6); PG8_BAR;
    for (;;) {
        const bool has_next = S.next(ui + 1, nxt);
        const char* nA = GATHER ? (const char*)g.A : (has_next ? (const char*)g.A + (size_t)nxt.pm * tstep : cA); const char* nB = has_next ? (const char*)g.Bt + (size_t)nxt.pn * tstep : cB;
        if constexpr (GATHER) {
            if (has_next) {
#pragma unroll
                for (int h = 0; h < 2; ++h)
#pragma unroll
                    for (int i = 0; i < 2; ++i) on[h][i] = (unsigned)(S.src_row(nxt, h * HALF + RA[i]) * RB + CA[i] * 2);
            }
        }
        for (int t = 0; t < nt; t += 2) {
            const bool last = (t == nt - 2);
            const size_t k1 = (size_t)(t + 1) * kstep;
            const size_t k2 = last ? (size_t)0 : (size_t)(t + 2) * kstep, k3 = k2 + kstep;
            const char* a2 = last ? nA : cA; const char* b2 = last ? nB : cB;
            unsigned o2[2][2];
            if constexpr (GATHER) {
#pragma unroll
                for (int h = 0; h < 2; ++h)
#pragma unroll
                    for (int i = 0; i < 2; ++i) o2[h][i] = last ? on[h][i] : oc[h][i];
            }
            PG8_LDB(B0, 0, 0); PG8_LDB(B1, 0, 1); PG8_SCHED; PG8_LDA(At, 0, 0); PG8_STAGE_A(PG8_SA(1, 1), 1, cA, k1, oc);
            PG8_WAIT_V(8); PG8_WAIT_L(0); PG8_BAR; PG8_MMA(0, 0, At, B0); PG8_MMA(0, 1, At, B1); PG8_BAR; PG8_SCHED;
            PG8_LDA(At, 0, 1); PG8_STAGE(PG8_SB(0, 0), b2 + k2, voffB); PG8_STAGE(PG8_SB(0, 1), b2 + hstep + k2, voffB); PG8_STAGE_A(PG8_SA(0, 0), 0, a2, k2, o2);
            PG8_WAIT_V(8); PG8_WAIT_L(0); PG8_BAR; PG8_MMA(1, 0, At, B0); PG8_MMA(1, 1, At, B1); PG8_BAR; PG8_SCHED;
            PG8_LDB(B0, 1, 0); PG8_LDB(B1, 1, 1); PG8_SCHED; PG8_LDA(At, 1, 0); PG8_STAGE_A(PG8_SA(0, 1), 1, a2, k2, o2);
            PG8_WAIT_V(8); PG8_WAIT_L(0); PG8_BAR; PG8_MMA(0, 0, At, B0); PG8_MMA(0, 1, At, B1); PG8_BAR; PG8_SCHED;
            PG8_LDA(At, 1, 1); PG8_STAGE(PG8_SB(1, 0), b2 + k3, voffB); PG8_STAGE(PG8_SB(1, 1), b2 + hstep + k3, voffB); PG8_STAGE_A(PG8_SA(1, 0), 0, a2, k3, o2);
            PG8_WAIT_V(8); PG8_WAIT_L(0); PG8_BAR; PG8_MMA(1, 0, At, B0); PG8_MMA(1, 1, At, B1); PG8_BAR; PG8_SCHED;
        }
        if (wr == 0) PG8_BAR;
        const bool rst = E(acc, cur, wr, wc, fr, fq);
        if (!has_next) break;
        if (rst) {
#pragma unroll
        for (int a = 0; a < 2; ++a)
#pragma unroll
            for (int b = 0; b < 2; ++b)
#pragma unroll
                for (int m = 0; m < 4; ++m)
#pragma unroll
                    for (int n = 0; n < 2; ++n) acc[a][b][m][n] = (accv_t){0, 0, 0, 0};
        }
        cur = nxt; cA = nA; cB = nB; ++ui;
        if constexpr (GATHER) {
#pragma unroll
            for (int h = 0; h < 2; ++h)
#pragma unroll
                for (int i = 0; i < 2; ++i) oc[h][i] = on[h][i];
        }
        if (wr == 1) PG8_BAR;
    }
    PG8_WAIT_V(0);
    PG8_BAR;
#undef PG8_SA
#undef PG8_SB
#undef PG8_STAGE
#undef PG8_STAGE_A
#undef PG8_LDA
#undef PG8_LDB
#undef PG8_MMA
#undef PG8_WAIT_V
#undef PG8_WAIT_L
#undef PG8_BAR
#undef PG8_SCHED
}
}
typedef f32x4 acc_t[2][2][4][2];
typedef i32x4 acci_t[2][2][4][2];

struct EpiProj {
    bf16_t* O; unsigned char* G8; const float* RS  ; const float* CS  ;
    __device__ __forceinline__ bool operator()(acci_t& acc, const pg8::Unit& u, int wr, int wc, int fr, int fq) const {
        const int pn = u.pn;
        const int act = (pn <= 1 || pn == 3 || pn == 4) ? 1 : (pn >= 12 ? 3 : (pn >= 8 ? 2 : 0));
        const int row0 = u.pm * 256 + wr * 64 + fr, col0 = pn * 256 + wc * 32 + 8 * fq;
        float cs[2][8];
#pragma unroll
        for (int bj = 0; bj < 2; ++bj) { const f32x4 c0 = *(const f32x4*)(CS + col0 + bj * 128), c1 = *(const f32x4*)(CS + col0 + bj * 128 + 4);
#pragma unroll
            for (int i = 0; i < 4; ++i) { cs[bj][i] = c0[i] * (act == 1 ? QSCALE : 1.f); cs[bj][4 + i] = c1[i] * (act == 1 ? QSCALE : 1.f); } }
#pragma unroll
        for (int ai = 0; ai < 2; ++ai)
#pragma unroll
            for (int m = 0; m < 4; ++m) { const int row = row0 + ai * 128 + m * 16; bf16_t* rowp = O + (size_t)row * PLD + col0; const float rs = RS[row];
#pragma unroll
                for (int bj = 0; bj < 2; ++bj) { f32x4 v0, v1;
#pragma unroll
                    for (int i = 0; i < 4; ++i) { v0[i] = (float)acc[ai][bj][m][0][i] * (rs * cs[bj][i]); v1[i] = (float)acc[ai][bj][m][1][i] * (rs * cs[bj][4 + i]); }
                    if (act == 2) {
#pragma unroll
                        for (int i = 0; i < 4; ++i) { v0[i] = gelu_tanh(v0[i]); v1[i] = gelu_tanh(v1[i]); } }
                    else if (act == 3) {
                        u32x2 w8;
#pragma unroll
                        for (int h_ = 0; h_ < 2; ++h_) { unsigned pk = 0u;
#pragma unroll
                            for (int i = 0; i < 4; ++i) { const float gq = sigmoidf_(h_ ? v1[i] : v0[i]) * 256.f; int q = (int)gq; q = q > 255 ? 255 : (q < 0 ? 0 : q); pk |= (unsigned)q << (8 * i); }
                            w8[h_] = pk; }
                        *(u32x2*)(G8 + (size_t)row * 3072 + (col0 - C_G) + bj * 128) = w8; continue; }
                    u32x4 w; w.x = cvt_pk_bf16(v0[0], v0[1]); w.y = cvt_pk_bf16(v0[2], v0[3]); w.z = cvt_pk_bf16(v1[0], v1[1]); w.w = cvt_pk_bf16(v1[2], v1[3]);
                    *(u32x4*)(rowp + bj * 128) = w; } }
        return true;
    }
};

struct BranchOrder {
    pg8::StaticOrder so;
    __device__ __forceinline__ bool next(int j, pg8::Unit& u) const { const int i = j / 3, br = j - 3 * i; int pm, pn; if (!so.tile(i, pm, pn)) return false; u.pm = br * 256 + pm; u.pn = br * 4 + pn; return true; }
};
struct EpiBranch {
    const unsigned char* G8  ; bf16_t* MERGED;
    __device__ __forceinline__ bool operator()(acc_t& acc, const pg8::Unit& u, int wr, int wc, int fr, int fq) const {
        const int br = u.pn >> 2, pn = u.pn & 3, pm = u.pm & 255;
        const int row0 = pm * 256 + wr * 64 + fr, col0 = pn * 256 + wc * 32 + 8 * fq;
#pragma unroll
        for (int rnd = 0; rnd < 2; ++rnd) { const int ai = rnd, m0 = 0;
            u32x2 gw[4][2], gd[4][2];
#pragma unroll
            for (int m = m0; m < m0 + 4; ++m)
#pragma unroll
                for (int bj = 0; bj < 2; ++bj) { const unsigned char* gp = G8 + (size_t)(row0 + ai * 128 + m * 16) * 3072 + br * 1024 + col0 + bj * 128;
                    gw[m][bj] = *(const u32x2*)gp; if (br != 2) gd[m][bj] = *(const u32x2*)(gp + 1024); }
#pragma unroll
            for (int m = m0; m < m0 + 4; ++m) { const size_t row = (size_t)(row0 + ai * 128 + m * 16);
#pragma unroll
                for (int bj = 0; bj < 2; ++bj) {
                    const u32x2 g = gw[m][bj];
                    float gn[8];
#pragma unroll
                    for (int i = 0; i < 8; ++i) gn[i] = (float)((g[i >> 2] >> (8 * (i & 3))) & 0xffu) + 0.5f;
                    if (br != 2) { const u32x2 d = gd[m][bj];
#pragma unroll
                        for (int i = 0; i < 8; ++i) gn[i] = gn[i] * frcp((float)((d[i >> 2] >> (8 * (i & 3))) & 0xffu) + 0.5f); }
                    else {
#pragma unroll
                        for (int i = 0; i < 8; ++i) gn[i] *= (1.f / 256.f); }
                    f32x4 v0 = acc[ai][bj][m][0], v1 = acc[ai][bj][m][1];
                    v0[0] *= gn[0]; v0[1] *= gn[1]; v0[2] *= gn[2]; v0[3] *= gn[3]; v1[0] *= gn[4]; v1[1] *= gn[5]; v1[2] *= gn[6]; v1[3] *= gn[7];
                    if (br != 2) { acc[ai][bj][m][0] = v0; acc[ai][bj][m][1] = v1; }
                    else { u32x4 w; w.x = cvt_pk_bf16(v0[0], v0[1]); w.y = cvt_pk_bf16(v0[2], v0[3]); w.z = cvt_pk_bf16(v1[0], v1[1]); w.w = cvt_pk_bf16(v1[2], v1[3]);
                        *(u32x4*)(MERGED + row * DM + col0 + bj * 128) = w; } } }
            asm volatile("" ::: "memory");
        }
        return br == 2;
    }
};

struct EpiWout {
    bf16_t* Y; float* SSP;
    __device__ __forceinline__ bool operator()(acc_t& acc, const pg8::Unit& u, int wr, int wc, int fr, int fq) const {
        const int row0 = u.pm * 256 + wr * 64 + fr, col0 = u.pn * 256 + wc * 32 + 8 * fq;
#pragma unroll
        for (int ai = 0; ai < 2; ++ai)
#pragma unroll
            for (int m = 0; m < 4; ++m) { const size_t row = (size_t)(row0 + ai * 128 + m * 16); float ss = 0.f;
#pragma unroll
                for (int bj = 0; bj < 2; ++bj) { const f32x4 v0 = acc[ai][bj][m][0], v1 = acc[ai][bj][m][1];
                    ss += (v0[0] * v0[0] + v0[1] * v0[1]) + (v0[2] * v0[2] + v0[3] * v0[3]) + (v1[0] * v1[0] + v1[1] * v1[1]) + (v1[2] * v1[2] + v1[3] * v1[3]);
                    u32x4 w; w.x = cvt_pk_bf16(v0[0], v0[1]); w.y = cvt_pk_bf16(v0[2], v0[3]); w.z = cvt_pk_bf16(v1[0], v1[1]); w.w = cvt_pk_bf16(v1[2], v1[3]);
                    *(u32x4*)(Y + row * DM + col0 + bj * 128) = w; }
                ss += __shfl_xor(ss, 16); ss += __shfl_xor(ss, 32);
                if (fq == 0) SSP[row * 16 + u.pn * 4 + wc] = ss; }
        return true;
    }
};

struct MoeOrder {
    int u0, u1, NB, rt_lo;
    const LAS int* tile_e;
    const LAS int* rowidx;
    __device__ __forceinline__ bool next(int i, pg8::Unit& u) const { const int x = u0 + i; if (x >= u1) return false; const int rt = x / NB, pn = x - rt * NB; u.pm = rt; u.pn = tile_e[rt] * NB + pn; return true; }
    __device__ __forceinline__ int src_row(const pg8::Unit& u, int r) const { return rowidx[(u.pm - rt_lo) * 256 + r]; }
};
struct EpiW1 {
    bf16_t* ACT; const float* b1  ;
    __device__ __forceinline__ bool operator()(acc_t& acc, const pg8::Unit& u, int wr, int wc, int fr, int fq) const {
        const int e = u.pn >> 3, pn = u.pn & 7;
        const int row0 = u.pm * 256 + wr * 64 + fr, j0 = pn * 128 + wc * 32 + 8 * fq;
        const float* bp = b1 + (size_t)e * (2 * FF) + 2 * j0;
        float bg[8], bl[8];
#pragma unroll
        for (int q = 0; q < 4; ++q) { const f32x4 t = *(const f32x4*)(bp + 4 * q); bg[2 * q] = t[0]; bl[2 * q] = t[1]; bg[2 * q + 1] = t[2]; bl[2 * q + 1] = t[3]; }
#pragma unroll
        for (int ai = 0; ai < 2; ++ai)
#pragma unroll
            for (int m = 0; m < 4; ++m) { float a[8];
#pragma unroll
                for (int i = 0; i < 8; ++i) { float gl = acc[ai][0][m][i >> 2][i & 3] + bg[i], li = acc[ai][1][m][i >> 2][i & 3] + bl[i];
                    gl = fminf(gl, 7.f); li = fminf(fmaxf(li, -7.f), 7.f);
                    a[i] = gl * frcp(1.f + fexp2(-1.702f * LOG2E * gl)) * (li + 1.f); }
                u32x4 w; w.x = cvt_pk_bf16(a[0], a[1]); w.y = cvt_pk_bf16(a[2], a[3]); w.z = cvt_pk_bf16(a[4], a[5]); w.w = cvt_pk_bf16(a[6], a[7]);
                *(u32x4*)(ACT + (size_t)(row0 + ai * 128 + m * 16) * FF + j0) = w; }
        return true;
    }
};
constexpr float ACT_SCALE = 12.f / 127.f;
struct EpiW1I8 {
    signed char* ACT  ; const float* b1  ; const float* RS  ; const float* CS  ;
    const LAS int* rowidx; int rt_lo;
    __device__ __forceinline__ bool operator()(acci_t& acc, const pg8::Unit& u, int wr, int wc, int fr, int fq) const {
        const int e = u.pn >> 3, pn = u.pn & 7;
        const int rl0 = wr * 64 + fr, row0 = u.pm * 256 + rl0, j0 = pn * 128 + wc * 32 + 8 * fq;
        const float* bp = b1 + (size_t)e * (2 * FF) + 2 * j0;
        float bg[8], bl[8], cg[8], cl[8];
#pragma unroll
        for (int q = 0; q < 4; ++q) { const f32x4 t = *(const f32x4*)(bp + 4 * q); bg[2 * q] = t[0]; bl[2 * q] = t[1]; bg[2 * q + 1] = t[2]; bl[2 * q + 1] = t[3]; }
        { const float* cp = CS + (size_t)e * 2048 + pn * 256 + wc * 32 + 8 * fq;
          const f32x4 a0 = *(const f32x4*)cp, a1 = *(const f32x4*)(cp + 4), c0 = *(const f32x4*)(cp + 128), c1 = *(const f32x4*)(cp + 132);
#pragma unroll
          for (int i = 0; i < 4; ++i) { cg[i] = a0[i]; cg[4 + i] = a1[i]; cl[i] = c0[i]; cl[4 + i] = c1[i]; } }
        const LAS int* ri = rowidx + (u.pm - rt_lo) * 256 + rl0;
#pragma unroll
        for (int ai = 0; ai < 2; ++ai)
#pragma unroll
            for (int m = 0; m < 4; ++m) { const float rs = RS[ri[ai * 128 + m * 16]]; float a[8];
#pragma unroll
                for (int i = 0; i < 8; ++i) { float gl = (float)acc[ai][0][m][i >> 2][i & 3] * (rs * cg[i]) + bg[i], li = (float)acc[ai][1][m][i >> 2][i & 3] * (rs * cl[i]) + bl[i];
                    gl = fminf(gl, 7.f); li = fminf(fmaxf(li, -7.f), 7.f);
                    a[i] = gl * frcp(1.f + fexp2(-1.702f * LOG2E * gl)) * (li + 1.f); }
                u32x2 w;
#pragma unroll
                for (int h2_ = 0; h2_ < 2; ++h2_) { unsigned pk = 0u;
#pragma unroll
                    for (int i = 0; i < 4; ++i) { int q = (int)rintf(a[4 * h2_ + i] * (1.f / ACT_SCALE)); q = q > 127 ? 127 : (q < -127 ? -127 : q); pk |= ((unsigned)q & 0xffu) << (8 * i); }
                    w[h2_] = pk; }
                *(u32x2*)(ACT + (size_t)(row0 + ai * 128 + m * 16) * FF + j0) = w; }
        return true;
    }
};
struct EpiW2 {
    bf16_t* Y2; const float* b2  ; const float* CS  ;
    __device__ __forceinline__ bool operator()(acci_t& acc, const pg8::Unit& u, int wr, int wc, int fr, int fq) const {
        const int e = u.pn >> 2, pn = u.pn & 3;
        const int row0 = u.pm * 256 + wr * 64 + fr, col0 = pn * 256 + wc * 32 + 8 * fq;
        f32x4 bv[2][2], cv[2][2];
#pragma unroll
        for (int bj = 0; bj < 2; ++bj)
#pragma unroll
            for (int n = 0; n < 2; ++n) { bv[bj][n] = *(const f32x4*)(b2 + (size_t)e * DM + col0 + bj * 128 + 4 * n); cv[bj][n] = *(const f32x4*)(CS + (size_t)e * DM + col0 + bj * 128 + 4 * n) * ACT_SCALE; }
#pragma unroll
        for (int ai = 0; ai < 2; ++ai)
#pragma unroll
            for (int m = 0; m < 4; ++m) { bf16_t* rowp = Y2 + (size_t)(row0 + ai * 128 + m * 16) * DM + col0;
#pragma unroll
                for (int bj = 0; bj < 2; ++bj) { f32x4 v0, v1;
#pragma unroll
                    for (int i = 0; i < 4; ++i) { v0[i] = (float)acc[ai][bj][m][0][i] * cv[bj][0][i] + bv[bj][0][i]; v1[i] = (float)acc[ai][bj][m][1][i] * cv[bj][1][i] + bv[bj][1][i]; }
                    u32x4 w; w.x = cvt_pk_bf16(v0[0], v0[1]); w.y = cvt_pk_bf16(v0[2], v0[3]); w.z = cvt_pk_bf16(v1[0], v1[1]); w.w = cvt_pk_bf16(v1[2], v1[3]);
                    *(u32x4*)(rowp + bj * 128) = w; } }
        return true;
    }
};
#define XB_TMO      128
#define XB_XCNT(j)  (256  + 64 * (j))
#define XB_XSUB(j)  (1280 + 64 * (j))
#define XB_XGEN(j)  (2304 + 64 * (j))
#define XB_TOP      3328
#define XB_TOPGEN   3392
#define XCD_BAR_WORDS 3456
#define XB_SPIN_CAP (1u << 18)

__device__ __forceinline__ unsigned xb_ld(unsigned* p)              { return __hip_atomic_load(p, __ATOMIC_RELAXED, __HIP_MEMORY_SCOPE_AGENT); }
__device__ __forceinline__ unsigned xb_add(unsigned* p, unsigned v) { return __hip_atomic_fetch_add(p, v, __ATOMIC_RELAXED, __HIP_MEMORY_SCOPE_AGENT); }
__device__ __forceinline__ unsigned xb_xcc_id() { return (unsigned)__builtin_amdgcn_s_getreg((3 << 11) | 20) & 0xFu; }
#define XB_SPIN(cond, bar) do { unsigned _sp = 0; while (cond) { __builtin_amdgcn_s_sleep(1); \
    if ((++_sp & 255u) == 0u) { if (xb_ld(&(bar)[XB_TMO])) break; if (_sp > XB_SPIN_CAP) { atomicAdd(&(bar)[XB_TMO], 1u); break; } } } } while (0)

struct XcdBarrier {
    unsigned* bar; unsigned x;
    volatile LAS unsigned* st;
};

__device__ __forceinline__ XcdBarrier xcd_barrier_post(unsigned* bar, volatile LAS unsigned* st) {
    XcdBarrier b; b.bar = bar; b.x = xb_xcc_id(); b.st = st;
    if (threadIdx.x == 0) (void)xb_add(&bar[XB_XCNT(b.x)], 1u);
    return b;
}
__device__ __forceinline__ void xcd_barrier_complete(unsigned* bar, unsigned x, unsigned& nloc, unsigned& nx) {
    const unsigned G = gridDim.x * gridDim.y * gridDim.z;
    unsigned sum, cnt, mine, sp = 0u;
    for (;;) {
        sum = 0u; cnt = 0u; mine = 0u;
#pragma unroll
        for (unsigned j = 0; j < 16; ++j) { const unsigned c = xb_ld(&bar[XB_XCNT(j)]); sum += c; cnt += (c > 0u) ? 1u : 0u; mine = (j == x) ? c : mine; }
        if (sum == G) break;
        __builtin_amdgcn_s_sleep(1);
        if ((++sp & 255u) == 0u) { if (xb_ld(&bar[XB_TMO])) break; if (sp > XB_SPIN_CAP) { atomicAdd(&bar[XB_TMO], 1u); break; } }
    }
    nloc = mine > 0u ? mine : 1u; nx = cnt > 0u ? cnt : 1u;
}

__device__ __forceinline__ void xcd_barrier(const XcdBarrier& b) {
    asm volatile("s_waitcnt vmcnt(0)" ::: "memory");
    __syncthreads();
    if (threadIdx.x == 0) {
        unsigned* bar = b.bar;
        __builtin_amdgcn_s_waitcnt(0);
        unsigned nloc = b.st[0], nx = b.st[1];
        if (nloc == 0u) { xcd_barrier_complete(bar, b.x, nloc, nx); b.st[0] = nloc; b.st[1] = nx; }
        const unsigned old = xb_add(&bar[XB_XSUB(b.x)], 1u);
        const unsigned gen = old / nloc;
        if (old + 1u == (gen + 1u) * nloc) {
            __builtin_amdgcn_fence(__ATOMIC_RELEASE, "agent");
            asm volatile("s_waitcnt vmcnt(0)" ::: "memory");
            const unsigned og = xb_add(&bar[XB_TOP], 1u);
            const unsigned tg = og / nx;
            if (og + 1u == (tg + 1u) * nx) xb_add(&bar[XB_TOPGEN], 1u);
            else XB_SPIN(xb_ld(&bar[XB_TOPGEN]) == tg, bar);
            __builtin_amdgcn_fence(__ATOMIC_ACQUIRE, "agent");
            xb_add(&bar[XB_XGEN(b.x)], 1u);
            asm volatile("s_waitcnt vmcnt(0)" ::: "memory");
        } else {
            XB_SPIN(xb_ld(&bar[XB_XGEN(b.x)]) == gen, bar);
            __builtin_amdgcn_fence(__ATOMIC_ACQUIRE, "agent");
            asm volatile("s_waitcnt vmcnt(0)" ::: "memory");
        }
    }
    __syncthreads();
}

constexpr size_t MiB = 1u << 20;
constexpr size_t WS_CTL = 0, CTL_ZERO_BYTES = 1 * MiB;
constexpr size_t WS_MOD = 1 * MiB;
constexpr size_t WS_SGW = 3 * MiB;
constexpr size_t WS_WRT = 3 * MiB + 512 * 1024;
constexpr size_t WS_RS = 4 * MiB;
constexpr size_t WS_CS1 = 5 * MiB;
constexpr size_t WS_CS2 = 6 * MiB + 512 * 1024;
constexpr size_t WS_CSIN = 6 * MiB;
constexpr size_t WS_W = 8 * MiB, W_LAYER = 209 * MiB;
constexpr size_t WO_WIN = 0, WO_WBR = 12 * MiB, WO_WOUT = 15 * MiB, WO_W1 = 17 * MiB, WO_W2 = 145 * MiB;
constexpr size_t WS_PROJ = 426 * MiB;
constexpr size_t WS_GATES = 810 * MiB;
constexpr size_t WS_ACT = WS_PROJ;
constexpr size_t WS_H = 1194 * MiB;
constexpr size_t WS_O = 1322 * MiB;
constexpr size_t WS_Y = 1514 * MiB;
constexpr size_t WS_BITS = 1770 * MiB;
constexpr size_t WS_Y2 = WS_O;
constexpr size_t WS_SSP = 1850 * MiB;
constexpr size_t WS_ROWTOK = 1854 * MiB;
constexpr size_t WS_TOKINFO = 1862 * MiB;
constexpr size_t WS_SLAB = 1864 * MiB;
constexpr size_t WS_END = 1928 * MiB;
static_assert(WS_Y2 + (size_t)270336 * 2048 <= WS_SSP && WS_W + 2 * W_LAYER <= WS_PROJ && WS_PROJ + (size_t)MTOK * PLD * 2 <= WS_GATES && WS_GATES + (size_t)MTOK * 3072 <= WS_H, "d_ws map");
constexpr int CW_BAR = 4096;
constexpr int CW_CNT = 16384;

constexpr int RING_BYTES = 131072;
constexpr int MISC_OFF = 134144;
constexpr int TS_OFF = MISC_OFF + 512;
constexpr int TILE_E_OFF = MISC_OFF + 1024;
constexpr int ROWIDX_OFF = MISC_OFF + 5632;
constexpr int LDS_BYTES = 151552;
static_assert(ROWIDX_OFF + 8192 <= LDS_BYTES, "LDS map");

struct Args {
    const float* in[21]; float* out; unsigned char* ws; int ph_lo, ph_hi;
};
struct Frame {
    LAS unsigned char* lds; int tid, lane, wave, vcu, G;
};
__device__ __forceinline__ Frame phase_frame(const Frame& F0) { Frame F = F0; int t = threadIdx.x; asm volatile("" : "+v"(t)); F.tid = t; F.lane = t & 63; F.wave = __builtin_amdgcn_readfirstlane(t >> 6); return F; }
template <class T> __device__ __forceinline__ T* opq(T* p) { long z = 0; asm volatile("" : "+s"(z)); return (T*)((unsigned char*)p + z); }

__device__ __forceinline__ void p0_mod(const Frame& F, const float* c, const float* w_ada, const float* b_ada, float* MOD) {
    LAS float* csT = (LAS float*)F.lds;
    for (int i = F.tid; i < BATCH * DM; i += 512) { const int b = i & 31, k = i >> 5; const float v = c[b * DM + k]; csT[k * 32 + b] = v * sigmoidf_(v); }
    __syncthreads();
    const int gw = F.vcu * 8 + F.wave, NGW = F.G * 8;
    const int cg = F.lane & 15, kq = F.lane >> 4;
    for (int task = gw; task < DEPTH * 384; task += NGW) {
        const int l = task / 384, n = (task % 384) * 16 + cg;
        float acc[32];
#pragma unroll
        for (int b = 0; b < 32; ++b) acc[b] = 0.f;
        const float* w = w_ada + ((size_t)l * DM + kq * 256) * (6 * DM) + n;
#pragma unroll 4
        for (int k = 0; k < 256; ++k) {
            const float wv = w[(size_t)k * (6 * DM)];
            const LAS f32x4* cs = (const LAS f32x4*)(csT + (kq * 256 + k) * 32);
#pragma unroll
            for (int q = 0; q < 8; ++q) { const f32x4 c4 = cs[q]; acc[4 * q] += c4[0] * wv; acc[4 * q + 1] += c4[1] * wv; acc[4 * q + 2] += c4[2] * wv; acc[4 * q + 3] += c4[3] * wv; }
        }
#pragma unroll
        for (int b = 0; b < 32; ++b) { acc[b] += __shfl_xor(acc[b], 16); acc[b] += __shfl_xor(acc[b], 32); }
        if (kq == 0) { const float bb = b_ada[l * 6 * DM + n];
#pragma unroll
            for (int b = 0; b < 32; ++b) MOD[((size_t)l * BATCH + b) * (6 * DM) + n] = acc[b] + bb; }
    }
    __syncthreads();
}
__device__ __forceinline__ void tr_item(const float* W, size_t ldw, int srccol, bool valid, bf16_t* dst  , int K, LAS float* scr, int lane) {
    const float* wp = W + srccol;
#pragma unroll 8
    for (int i = 0; i < 32; ++i) { const int kk = 2 * i + (lane >> 5); scr[kk * 33 + (lane & 31)] = valid ? wp[(size_t)kk * ldw] : 0.f; }
    LDS_WAIT(); asm volatile("" ::: "memory");
    const int c = lane & 7;
#pragma unroll
    for (int j = 0; j < 4; ++j) { const int n = (lane >> 3) + 8 * j; const LAS float* s = scr + (8 * c) * 33 + n;
        u32x4 o; o.x = cvt_pk_bf16(s[0 * 33], s[1 * 33]); o.y = cvt_pk_bf16(s[2 * 33], s[3 * 33]); o.z = cvt_pk_bf16(s[4 * 33], s[5 * 33]); o.w = cvt_pk_bf16(s[6 * 33], s[7 * 33]);
        *(u32x4*)(dst + (size_t)n * K + 8 * c) = o; }
    LDS_WAIT(); asm volatile("" ::: "memory");
}
__device__ __forceinline__ void p0_weights(const Frame& F, const Args& a) {
    LAS float* scr = (LAS float*)(F.lds + F.wave * 16384);
    const int gw = F.vcu * 8 + F.wave, NGW = F.G * 8, lane = F.lane, jl = lane & 31;
    const float *w_in = a.in[8], *w_branch = a.in[13], *w_out = a.in[14], *w_router = a.in[15], *w1 = a.in[17], *w2 = a.in[19];
    constexpr int I_BR = 3 * 8 * 32, I_OUT = 16 * 32, I_RT = 16;
    constexpr int I_LAYER = I_BR + I_OUT + I_RT;
    for (int it = gw; it < DEPTH * I_LAYER; it += NGW) {
        const int l = it / I_LAYER; int r = it - l * I_LAYER;
        unsigned char* wl = a.ws + WS_W + (size_t)l * W_LAYER;
        if (r < I_BR) {
            const int br = r / 256, q = r % 256, kb = q / 32, nb = q % 32;
            tr_item(w_branch + ((size_t)(l * 3 + br) * 512 + kb * 64) * DM, DM, nb * 32 + jl, true, (bf16_t*)(wl + WO_WBR) + (size_t)(br * 1024 + nb * 32) * 512 + kb * 64, 512, scr, lane); continue; }
        r -= I_BR;
        if (r < I_OUT) {
            const int kb = r / 32, nb = r % 32;
            tr_item(w_out + ((size_t)l * DM + kb * 64) * DM, DM, nb * 32 + jl, true, (bf16_t*)(wl + WO_WOUT) + (size_t)nb * 32 * DM + kb * 64, DM, scr, lane); continue; }
        r -= I_OUT;
        {
            const int kb = r;
            tr_item(w_router + ((size_t)l * DM + kb * 64) * NE, NE, jl, true, (bf16_t*)(a.ws + WS_WRT) + (size_t)l * NE * DM + kb * 64, DM, scr, lane); }
        (void)r;
    }
    __syncthreads();
    {
    LAS float* T = (LAS float*)F.lds; LAS float* red = (LAS float*)(F.lds + ROWIDX_OFF);
    const int half = lane >> 5, wave = F.wave;
    constexpr int ST_W1 = NE * 64, ST_IN = 192, ST_W2 = NE * 32, ST_LAYER = ST_W1 + ST_IN + ST_W2;
    for (int st = F.vcu; st < DEPTH * ST_LAYER; st += F.G) {
        const int l = st / ST_LAYER, q = st % ST_LAYER;
        const float* wp; size_t ldw; bool valid = true; signed char* dst; float* csp;
        if (q < ST_W1) { const int e = q / 64, r6 = q % 64, pn = r6 >> 3, jjg = (r6 >> 1) & 3, sgl = r6 & 1, nb = pn * 8 + sgl * 4 + jjg, n = nb * 32 + jl, src = 2 * (128 * pn + jjg * 32 + jl) + sgl;
            wp = w1 + ((size_t)(l * NE + e) * DM) * (2 * FF) + src; ldw = 2 * FF;
            dst = (signed char*)(a.ws + WS_W + (size_t)l * W_LAYER + WO_W1) + ((size_t)e * 2048 + nb * 32) * DM; csp = (float*)(a.ws + WS_CS1) + ((size_t)l * NE + e) * 2048 + n; }
        else if (q >= ST_W1 + ST_IN) { const int q2 = q - ST_W1 - ST_IN, e = q2 / 32, nb = q2 % 32, n = nb * 32 + jl;
            wp = w2 + ((size_t)(l * NE + e) * FF) * DM + n; ldw = DM;
            dst = (signed char*)(a.ws + WS_W + (size_t)l * W_LAYER + WO_W2) + ((size_t)e * DM + nb * 32) * FF; csp = (float*)(a.ws + WS_CS2) + ((size_t)l * NE + e) * DM + n; }
        else { const int nb = q - ST_W1, n = nb * 32 + jl; valid = (n < 1832) || (n >= 2048); const int src = n < 1832 ? n : n - 216;
            wp = w_in + (size_t)l * DM * 5928 + (valid ? src : 0); ldw = 5928;
            dst = (signed char*)(a.ws + WS_W + (size_t)l * W_LAYER + WO_WIN) + (size_t)nb * 32 * DM; csp = (float*)(a.ws + WS_CSIN) + (size_t)l * NPROJ + n; }
        float am = 0.f;
#pragma unroll
        for (int ib = 0; ib < 2; ++ib) { float vv[32];
#pragma unroll
            for (int i = 0; i < 32; ++i) { const int k = wave * 128 + 2 * (ib * 32 + i) + half; vv[i] = valid ? __builtin_nontemporal_load(wp + (size_t)k * ldw) : 0.f; }
#pragma unroll
            for (int i = 0; i < 32; ++i) { const int k = wave * 128 + 2 * (ib * 32 + i) + half; am = fmaxf(am, fabsf(vv[i])); T[k * 32 + (jl ^ (k & 31))] = vv[i]; } }
        red[(wave * 2 + half) * 32 + jl] = am;
        __syncthreads();
        float amx = 0.f;
#pragma unroll
        for (int p = 0; p < 16; ++p) amx = fmaxf(amx, red[p * 32 + jl]);
        const float scale = valid ? fmaxf(amx, 1e-30f) * (1.f / 127.f) : 1.f, inv = valid ? 1.f / scale : 0.f;
        if (wave == 0 && half == 0) *csp = scale;
        const int k0 = 64 * (wave * 2 + half);
#pragma unroll
        for (int c16 = 0; c16 < 4; ++c16) { unsigned wq[4];
#pragma unroll
            for (int d4 = 0; d4 < 4; ++d4) { unsigned v = 0u;
#pragma unroll
                for (int bb = 0; bb < 4; ++bb) { const int k = k0 + c16 * 16 + d4 * 4 + bb; const float x = T[k * 32 + (jl ^ (k & 31))] * inv; int qi_ = (int)rintf(x); qi_ = qi_ > 127 ? 127 : (qi_ < -127 ? -127 : qi_); v |= ((unsigned)qi_ & 0xffu) << (8 * bb); }
                wq[d4] = v; }
            *(u32x4*)(dst + (size_t)jl * DM + k0 + c16 * 16) = (u32x4){wq[0], wq[1], wq[2], wq[3]}; }
        __syncthreads();
    }
    }
    const float* sg_w = a.in[10]; bf16_t* SGW = (bf16_t*)(a.ws + WS_SGW);
    for (int i = (F.vcu * 512 + F.tid) * 2; i < DEPTH * 8 * 128 * 128; i += F.G * 512 * 2) { const int s = i & 127, t = (i >> 7) & 127; const f32x2 v = *(const f32x2*)(sg_w + i);
        *(unsigned*)(SGW + i) = cvt_pk_bf16(s <= t ? v[0] : 0.f, (s + 1) <= t ? v[1] : 0.f); }
}

__device__ __forceinline__ void norm_mod_row(const f32x4 (&v)[4], float ss, const float* g, const float* sc, const float* sh, signed char* orow, float* rs, int lane) {
    const float rstd = 1.f / sqrtf(ss * (1.f / DM) + RMS_EPS);
    f32x4 o[4]; float am = 0.f;
#pragma unroll
    for (int j = 0; j < 4; ++j) { const int c = 4 * lane + 256 * j; const f32x4 gg = *(const f32x4*)(g + c), s1 = *(const f32x4*)(sc + c), s0 = *(const f32x4*)(sh + c);
        o[j] = (v[j] * rstd) * gg * (s1 + 1.f) + s0;
        am = fmaxf(am, fmaxf(fmaxf(fabsf(o[j][0]), fabsf(o[j][1])), fmaxf(fabsf(o[j][2]), fabsf(o[j][3])))); }
#pragma unroll
    for (int shf = 1; shf < 64; shf <<= 1) am = fmaxf(am, __shfl_xor(am, shf));
    const float scale = fmaxf(am, 1e-30f) * (1.f / 127.f), inv = 1.f / scale;
    if (lane == 0) *rs = scale;
#pragma unroll
    for (int j = 0; j < 4; ++j) { unsigned pk = 0u;
#pragma unroll
        for (int i = 0; i < 4; ++i) { int q = (int)rintf(o[j][i] * inv); q = q > 127 ? 127 : (q < -127 ? -127 : q); pk |= ((unsigned)q & 0xffu) << (8 * i); }
        *(unsigned*)(orow + 4 * lane + 256 * j) = pk; }
}
__device__ __forceinline__ void p1_norm(const Frame& F, const float* x, const float* g, const float* MOD0, signed char* H8, float* RS) {
    const int gw = F.vcu * 8 + F.wave, NGW = F.G * 8;
    for (int row0 = gw * 4; row0 < MTOK; row0 += NGW * 4) { f32x4 v[4][4];
#pragma unroll
        for (int rr = 0; rr < 4; ++rr)
#pragma unroll
            for (int j = 0; j < 4; ++j) v[rr][j] = __builtin_nontemporal_load((const f32x4*)(x + (size_t)(row0 + rr) * DM + 4 * F.lane + 256 * j));
#pragma unroll
        for (int rr = 0; rr < 4; ++rr) { const int row = row0 + rr, b = row >> 11; float ss = 0.f;
#pragma unroll
            for (int j = 0; j < 4; ++j) ss += (v[rr][j][0] * v[rr][j][0] + v[rr][j][1] * v[rr][j][1]) + (v[rr][j][2] * v[rr][j][2] + v[rr][j][3] * v[rr][j][3]);
            ss = wave_sum(ss);
            const float* mb = MOD0 + (size_t)b * 6 * DM;
            norm_mod_row(v[rr], ss, g, mb + DM, mb, H8 + (size_t)row * DM, RS + row, F.lane); } }
}
constexpr int TOPK_SEL = 256;
struct IdxOps { bf16x8 af[4][2]; u32x4 wraw[4][2]; bf16x8 kf[4][2]; };
__device__ __forceinline__ void dsa_index_load(IdxOps& P, const bf16_t* __restrict__ PROJ, int b, int qg, int lane, int wid) {
    const int n = lane & 31, hi = lane >> 5;
    const int q0 = qg * 16;
    const size_t tokbase = (size_t)b * SEQ;
    const int m = n, hm = (m >> 2) & 1, idx = (m & 3) + 4 * (m >> 3), aq = 2 * hm + (idx >> 3), ah = idx & 7;
#pragma unroll
    for (int qgp = 0; qgp < 4; ++qgp) { const bf16_t* qp = PROJ + (tokbase + q0 + 4 * qgp + aq) * PLD + C_QI + ah * 32 + 8 * hi;
        P.af[qgp][0] = *(const bf16x8*)qp; P.af[qgp][1] = *(const bf16x8*)(qp + 16); }
}
__device__ __forceinline__ void dsa_index_load_k(IdxOps& P, const bf16_t* __restrict__ PROJ, int b, int qg, int lane, int wid) {
    const int n = lane & 31, hi = lane >> 5;
    const int q0 = qg * 16, nkb = (q0 + 16 + 31) >> 5;
    const size_t tokbase = (size_t)b * SEQ;
#pragma unroll
    for (int qgp = 0; qgp < 4; ++qgp)
#pragma unroll
        for (int qq = 0; qq < 2; ++qq) P.wraw[qgp][qq] = *(const u32x4*)(PROJ + (tokbase + q0 + 4 * qgp + 2 * hi + qq) * PLD + C_WI);
#pragma unroll
    for (int i = 0; i < 4; ++i) { const int kb = wid + 8 * i;
        if (kb < nkb) { const bf16_t* kp = PROJ + (tokbase + 32 * kb + n) * PLD + C_KI + 8 * hi; P.kf[i][0] = *(const bf16x8*)kp; P.kf[i][1] = *(const bf16x8*)(kp + 16); } }
}
__device__ __forceinline__ void dsa_index_scores(IdxOps& P, const bf16_t* __restrict__ PROJ, LAS float* sc, int b, int qg, int lane, int wid) {
    const int n = lane & 31, hi = lane >> 5;
    const int q0 = qg * 16, nkb = (q0 + 16 + 31) >> 5;
    const size_t tokbase = (size_t)b * SEQ;
    LAS float* scw = sc + (2 * hi) * 2048 + 32 * wid + n;
    float wv[4][16];
#pragma unroll
    for (int qgp = 0; qgp < 4; ++qgp)
#pragma unroll
        for (int qq = 0; qq < 2; ++qq) { const u32x4 w = P.wraw[qgp][qq];
            wv[qgp][8 * qq + 0] = bf_lo(w.x) * 0.0625f; wv[qgp][8 * qq + 1] = bf_hi(w.x) * 0.0625f; wv[qgp][8 * qq + 2] = bf_lo(w.y) * 0.0625f; wv[qgp][8 * qq + 3] = bf_hi(w.y) * 0.0625f;
            wv[qgp][8 * qq + 4] = bf_lo(w.z) * 0.0625f; wv[qgp][8 * qq + 5] = bf_hi(w.z) * 0.0625f; wv[qgp][8 * qq + 6] = bf_lo(w.w) * 0.0625f; wv[qgp][8 * qq + 7] = bf_hi(w.w) * 0.0625f; }
#pragma unroll
    for (int i = 0; i < 8; ++i) { const int kb = wid + 8 * i;
        if (kb < nkb) {
            const bf16x8 k0 = P.kf[i & 3][0], k1 = P.kf[i & 3][1];
            if (i < 4 && kb + 32 < nkb) { const bf16_t* kp = PROJ + (tokbase + 32 * (kb + 32) + n) * PLD + C_KI + 8 * hi; P.kf[i & 3][0] = *(const bf16x8*)kp; P.kf[i & 3][1] = *(const bf16x8*)(kp + 16); }
#pragma unroll
            for (int qgp = 0; qgp < 4; ++qgp) {
                f32x16 d = {0.f, 0.f, 0.f, 0.f, 0.f, 0.f, 0.f, 0.f, 0.f, 0.f, 0.f, 0.f, 0.f, 0.f, 0.f, 0.f};
                d = __builtin_amdgcn_mfma_f32_32x32x16_bf16(P.af[qgp][0], k0, d, 0, 0, 0);
                d = __builtin_amdgcn_mfma_f32_32x32x16_bf16(P.af[qgp][1], k1, d, 0, 0, 0);
                float sa = 0.f, sb = 0.f;
#pragma unroll
                for (int r = 0; r < 8; ++r) { sa += wv[qgp][r] * fmaxf(d[r], 0.f); sb += wv[qgp][8 + r] * fmaxf(d[8 + r], 0.f); }
                scw[(4 * qgp) * 2048 + 256 * i] = sa; scw[(4 * qgp + 1) * 2048 + 256 * i] = sb;
            } } }
}
__device__ __forceinline__ void dsa_index_select(LAS float* sc, unsigned long long* __restrict__ bits64, int b, int qg, int lane, int wid) {
    const int q0 = qg * 16;
    const size_t tokbase = (size_t)b * SEQ;
#pragma unroll 1
    for (int qq = 0; qq < 2; ++qq) {
        const int ql = 2 * wid + qq, pos = q0 + ql, nn = pos + 1, nr = (nn + 63) >> 6;
        const LAS float* scq = sc + ql * 2048;
        unsigned long long myw = 0ull;
        if (nn <= TOPK_SEL) {
#pragma unroll
            for (int r = 0; r < 4; ++r) if (r < nr) { const unsigned long long bal = __ballot(64 * r + lane <= pos); if (lane == r) myw = bal; }
        } else {
            unsigned u[32];
#pragma unroll
            for (int r = 0; r < 32; ++r) { u[r] = 0u;
                if (r < nr) { const int j = 64 * r + lane; float s = scq[j]; s = (s == 0.f) ? 0.f : s; const unsigned bts = __builtin_bit_cast(unsigned, s);
                    const unsigned uu = (bts & 0x80000000u) ? ~bts : (bts | 0x80000000u); u[r] = (j <= pos) ? uu : 0u; } }
            unsigned mx = 0u;
#pragma unroll
            for (int r = 0; r < 32; ++r) mx = u[r] > mx ? u[r] : mx;
            const unsigned umax = wave_max_u32(mx);
#define CNT_GE(cand, out) do { unsigned c_ = 0u; const unsigned cd_ = (cand); _Pragma("unroll") for (int g8 = 0; g8 < 4; ++g8) { if (8 * g8 < nr) { unsigned long long m_[8]; _Pragma("unroll") for (int q_ = 0; q_ < 8; ++q_) asm("v_cmp_le_u32_e64 %0, %1, %2" : "=s"(m_[q_]) : "s"(cd_), "v"(u[8 * g8 + q_])); _Pragma("unroll") for (int q_ = 0; q_ < 8; ++q_) c_ += (unsigned)__builtin_popcountll(m_[q_]); } } out = c_; } while (0)
            unsigned L = 0u, t = 0u; bool exact = false; unsigned c;
            if (umax > 0x80000000u + (3u << 23)) { const unsigned Lg = umax - (3u << 23); CNT_GE(Lg, c); if (c >= (unsigned)TOPK_SEL) { L = Lg; if (c == (unsigned)TOPK_SEL) { exact = true; t = Lg; } } }
            if (!exact) {
                const unsigned R = umax - L; unsigned tp = 0u;
                int bit = 31 - __builtin_clz(R | 1u);
#pragma unroll 1
                for (; bit >= 0; --bit) { const unsigned cand_off = tp | (1u << bit); if (cand_off > R) continue; const unsigned cand = L + cand_off; CNT_GE(cand, c);
                    if (c >= (unsigned)TOPK_SEL) { tp = cand_off; if (c == (unsigned)TOPK_SEL) { exact = true; break; } } }
                t = L + tp;
            }
            if (exact) {
#pragma unroll
                for (int r = 0; r < 32; ++r) if (r < nr) { const unsigned long long bal = __ballot(u[r] >= t); if (lane == r) myw = bal; }
            } else {
                unsigned cgt; { const unsigned t1 = t + 1u; CNT_GE(t1, cgt); }
                const unsigned need = (unsigned)TOPK_SEL - cgt; unsigned run = 0u;
#pragma unroll
                for (int r = 0; r < 32; ++r) if (r < nr) { const unsigned long long eqm = __ballot(u[r] == t);
                    const unsigned pre = run + __builtin_amdgcn_mbcnt_hi((unsigned)(eqm >> 32), __builtin_amdgcn_mbcnt_lo((unsigned)eqm, 0u));
                    const unsigned long long bal = __ballot((u[r] > t) || ((u[r] == t) && (pre < need)));
                    run += (unsigned)__builtin_popcountll(eqm); if (lane == r) myw = bal; }
            }
#undef CNT_GE
        }
        if (lane < nr) bits64[(tokbase + pos) * 32 + lane] = myw;
    }
}
__device__ __forceinline__ void dsa_index_phase(const Frame& F, const bf16_t* __restrict__ PROJ, unsigned long long* __restrict__ bits64) {
    LAS float* sc = (LAS float*)F.lds;
    IdxOps P;
    int u = F.vcu;
    if (u < 4096) { dsa_index_load(P, PROJ, u & 31, u >> 5, F.lane, F.wave); dsa_index_load_k(P, PROJ, u & 31, u >> 5, F.lane, F.wave); }
#pragma unroll 1
    for (; u < 4096; u += F.G) {
        dsa_index_scores(P, PROJ, sc, u & 31, u >> 5, F.lane, F.wave);
#ifdef T_SC2
        asm volatile("" ::: "memory"); dsa_index_load_k(P, PROJ, u & 31, u >> 5, F.lane, F.wave); dsa_index_scores(P, PROJ, sc, u & 31, u >> 5, F.lane, F.wave);
#endif
        __syncthreads();
        const int un = u + F.G;
        if (un < 4096) { dsa_index_load(P, PROJ, un & 31, un >> 5, F.lane, F.wave); dsa_index_load_k(P, PROJ, un & 31, un >> 5, F.lane, F.wave); }
        dsa_index_select(sc, bits64, u & 31, u >> 5, F.lane, F.wave);
#ifdef T_SEL2
        asm volatile("" ::: "memory"); dsa_index_select(sc, bits64, u & 31, u >> 5, F.lane, F.wave);
#endif
        __syncthreads();
    }
}

constexpr int KS = 144, VS = 144;
#ifndef USE_TR
#define USE_TR 1
#endif
template <int MODE>
__device__ __forceinline__ void attn_unit(const Frame& F, const bf16_t* __restrict__ PROJ, bf16_t* __restrict__ O, const unsigned* __restrict__ bits, const float* __restrict__ sinks, int b, int g, int qb) {
    const int tid = F.tid, lane = F.lane, wid = F.wave, n = lane & 31, hi = lane >> 5;
    constexpr int CQ = MODE ? C_QB : C_QA, CK = MODE ? C_KB : C_KA, CV = MODE ? C_VB : C_VA;
    const int hq = 4 * g + (wid >> 1), qpos = qb * 64 + 32 * (wid & 1) + n;
    const size_t tokbase = (size_t)b * SEQ;
    LAS unsigned char* Ks = F.lds; LAS unsigned char* Vs = F.lds + 64 * KS;
    bf16x8 qf[4];
    { const bf16_t* qp = PROJ + (tokbase + qpos) * PLD + CQ + hq * 64 + 8 * hi;
#pragma unroll
      for (int s = 0; s < 4; ++s) qf[s] = *(const bf16x8*)(qp + 16 * s); }
    f32x16 o0, o1;
#pragma unroll
    for (int r = 0; r < 16; ++r) { o0[r] = 0.f; o1[r] = 0.f; }
    float mrun, lsum;
    if (MODE == 0) { mrun = sinks[hq] * LOG2E; lsum = (hi == 0) ? 1.f : 0.f; } else { mrun = -1e30f; lsum = 0.f; }
    const int kt_lo = (MODE == 0) ? (qb >= 2 ? qb - 2 : 0) : 0, kt_hi = qb;
    const int srow = tid >> 3, sch = tid & 7;
    const bf16_t* kg = PROJ + (tokbase + srow) * PLD + CK + g * 64 + sch * 8;
    const bf16_t* vg = PROJ + (tokbase + srow) * PLD + CV + g * 64 + sch * 8;
    const unsigned* bp = bits + (tokbase + qpos) * 64;
    u32x4 kreg = *(const u32x4*)(kg + (size_t)kt_lo * 64 * PLD), vreg = *(const u32x4*)(vg + (size_t)kt_lo * 64 * PLD);
    u32x2 mreg = {0u, 0u};
    if (MODE == 1) mreg = *(const u32x2*)(bp + 2 * kt_lo);
    const int vbase = (4 * hi + ((lane & 15) >> 2)) * VS + (16 * ((lane >> 4) & 1) + 4 * (lane & 3)) * 2;
    for (int kt = kt_lo; kt <= kt_hi; ++kt) {
        __syncthreads();
        *(LAS u32x4*)(Ks + srow * KS + sch * 16) = kreg; *(LAS u32x4*)(Vs + srow * VS + sch * 16) = vreg;
        const u32x2 mcur = mreg;
        __syncthreads();
        if (kt < kt_hi) { kreg = *(const u32x4*)(kg + (size_t)(kt + 1) * 64 * PLD); vreg = *(const u32x4*)(vg + (size_t)(kt + 1) * 64 * PLD); if (MODE == 1) mreg = *(const u32x2*)(bp + 2 * (kt + 1)); }
        f32x16 p0, p1;
#pragma unroll
        for (int r = 0; r < 16; ++r) { p0[r] = 0.f; p1[r] = 0.f; }
#pragma unroll
        for (int s = 0; s < 4; ++s) { const bf16x8 k0 = *(const LAS bf16x8*)(Ks + n * KS + (16 * s + 8 * hi) * 2), k1 = *(const LAS bf16x8*)(Ks + (n + 32) * KS + (16 * s + 8 * hi) * 2);
            p0 = __builtin_amdgcn_mfma_f32_32x32x16_bf16(k0, qf[s], p0, 0, 0, 0); p1 = __builtin_amdgcn_mfma_f32_32x32x16_bf16(k1, qf[s], p1, 0, 0, 0); }
        unsigned w0, w1;
        if (MODE == 1) { w0 = mcur.x >> (4 * hi); w1 = mcur.y >> (4 * hi); }
        else {
#pragma unroll
            for (int blk = 0; blk < 2; ++blk) { const int d0 = qpos - (kt * 64 + 32 * blk); unsigned mk = 0u;
                if (d0 >= 0) { const int hb = d0 > 31 ? 31 : d0; int lo = d0 - 127; if (lo <= 31) { if (lo < 0) lo = 0; mk = (0xFFFFFFFFu >> (31 - hb)) & (0xFFFFFFFFu << lo); } }
                if (blk == 0) w0 = mk >> (4 * hi); else w1 = mk >> (4 * hi); }
        }
        float mx = fmaxf(fmaxf(p0[0], p0[1]), fmaxf(p1[0], p1[1]));
#pragma unroll
        for (int r = 2; r < 16; r += 2) mx = fmaxf(mx, fmaxf(fmaxf(p0[r], p0[r + 1]), fmaxf(p1[r], p1[r + 1])));
        mx = fmaxf(mx, __shfl_xor(mx, 32));
        const float mnew = fmaxf(mrun, mx), alpha = fexp2(mrun - mnew); mrun = mnew;
        float ps = 0.f;
#pragma unroll
        for (int r = 0; r < 16; ++r) { const int bitpos = 8 * (r >> 2) + (r & 3);
            const float e0 = fexp2(p0[r] - mnew), e1 = fexp2(p1[r] - mnew);
            p0[r] = __builtin_bit_cast(float, __builtin_bit_cast(unsigned, e0) & (unsigned)__builtin_amdgcn_sbfe((int)w0, bitpos, 1));
            p1[r] = __builtin_bit_cast(float, __builtin_bit_cast(unsigned, e1) & (unsigned)__builtin_amdgcn_sbfe((int)w1, bitpos, 1));
            ps += p0[r] + p1[r]; }
        lsum = lsum * alpha + ps;
        if (__builtin_amdgcn_ballot_w64(alpha != 1.f) != 0ull) {
#pragma unroll
            for (int r = 0; r < 16; ++r) { o0[r] *= alpha; o1[r] *= alpha; } }
        bf16x8 pf[2][2];
#pragma unroll
        for (int s2 = 0; s2 < 2; ++s2) { u32x4 a, c;
            a.x = cvt_pk_bf16(p0[8 * s2 + 0], p0[8 * s2 + 1]); a.y = cvt_pk_bf16(p0[8 * s2 + 2], p0[8 * s2 + 3]); a.z = cvt_pk_bf16(p0[8 * s2 + 4], p0[8 * s2 + 5]); a.w = cvt_pk_bf16(p0[8 * s2 + 6], p0[8 * s2 + 7]);
            c.x = cvt_pk_bf16(p1[8 * s2 + 0], p1[8 * s2 + 1]); c.y = cvt_pk_bf16(p1[8 * s2 + 2], p1[8 * s2 + 3]); c.z = cvt_pk_bf16(p1[8 * s2 + 4], p1[8 * s2 + 5]); c.w = cvt_pk_bf16(p1[8 * s2 + 6], p1[8 * s2 + 7]);
            pf[0][s2] = __builtin_bit_cast(bf16x8, a); pf[1][s2] = __builtin_bit_cast(bf16x8, c); }
#pragma unroll
        for (int db = 0; db < 2; ++db)
#pragma unroll
            for (int blk = 0; blk < 2; ++blk)
#pragma unroll
                for (int s2 = 0; s2 < 2; ++s2) {
                    bf16x8 vf;
#if USE_TR
                    const v4i16_t t0 = __builtin_amdgcn_ds_read_tr16_b64_v4i16((LAS v4i16_t*)(Vs + vbase + (32 * blk + 16 * s2) * VS + 64 * db));
                    const v4i16_t t1 = __builtin_amdgcn_ds_read_tr16_b64_v4i16((LAS v4i16_t*)(Vs + vbase + (32 * blk + 16 * s2 + 8) * VS + 64 * db));
                    vf = (bf16x8){t0[0], t0[1], t0[2], t0[3], t1[0], t1[1], t1[2], t1[3]};
#else
#pragma unroll
                    for (int j = 0; j < 8; ++j) vf[j] = *(const LAS short*)(Vs + (32 * blk + 16 * s2 + 8 * (j >> 2) + 4 * hi + (j & 3)) * VS + (32 * db + n) * 2);
#endif
                    if (db == 0) o0 = __builtin_amdgcn_mfma_f32_32x32x16_bf16(vf, pf[blk][s2], o0, 0, 0, 0); else o1 = __builtin_amdgcn_mfma_f32_32x32x16_bf16(vf, pf[blk][s2], o1, 0, 0, 0);
                }
    }
    const float lt = lsum + __shfl_xor(lsum, 32), inv = 1.f / lt;
    bf16_t* op = O + (tokbase + qpos) * 512 + hq * 64 + 4 * hi;
#pragma unroll
    for (int rq = 0; rq < 4; ++rq) { u32x2 w;
        w.x = cvt_pk_bf16(o0[4 * rq] * inv, o0[4 * rq + 1] * inv); w.y = cvt_pk_bf16(o0[4 * rq + 2] * inv, o0[4 * rq + 3] * inv); *(u32x2*)(op + 8 * rq) = w;
        w.x = cvt_pk_bf16(o1[4 * rq] * inv, o1[4 * rq + 1] * inv); w.y = cvt_pk_bf16(o1[4 * rq + 2] * inv, o1[4 * rq + 3] * inv); *(u32x2*)(op + 32 + 8 * rq) = w; }
}

constexpr int SGS = 1040;
static_assert(128 * SGS <= MISC_OFF, "spatial-gating tile vs LDS control words");
__device__ __forceinline__ void sg_unit(const Frame& F, const bf16_t* __restrict__ PROJ, const bf16_t* __restrict__ SGWl, const float* __restrict__ sgb, const float* __restrict__ lng, bf16_t* __restrict__ OC, int b, int ch) {
    const int lane = F.lane, wid = F.wave, n = lane & 31, hi = lane >> 5;
    const size_t tok0 = (size_t)b * SEQ + ch * 128;
    LAS unsigned char* V = F.lds;
    __syncthreads();
    float gl[8];
    { const f32x4 g0 = *(const f32x4*)(lng + 8 * lane), g1 = *(const f32x4*)(lng + 8 * lane + 4); gl[0] = g0[0]; gl[1] = g0[1]; gl[2] = g0[2]; gl[3] = g0[3]; gl[4] = g1[0]; gl[5] = g1[1]; gl[6] = g1[2]; gl[7] = g1[3]; }
    u32x4 wrow16[16];
#pragma unroll
    for (int rr = 0; rr < 16; ++rr) wrow16[rr] = *(const u32x4*)(PROJ + (tok0 + 16 * wid + rr) * PLD + C_V + 8 * lane);
#pragma unroll
    for (int rr = 0; rr < 16; ++rr) { const int row = 16 * wid + rr;
        const u32x4 w = wrow16[rr];
        float x[8] = {bf_lo(w.x), bf_hi(w.x), bf_lo(w.y), bf_hi(w.y), bf_lo(w.z), bf_hi(w.z), bf_lo(w.w), bf_hi(w.w)};
        float s = 0.f;
#pragma unroll
        for (int i = 0; i < 8; ++i) s += x[i];
        const float mean = wave_sum(s) * (1.f / 512.f); float q = 0.f;
#pragma unroll
        for (int i = 0; i < 8; ++i) { x[i] -= mean; q += x[i] * x[i]; }
        const float rstd = 1.f / sqrtf(wave_sum(q) * (1.f / 512.f) + LN_EPS);
        u32x4 o; o.x = cvt_pk_bf16(x[0] * rstd * gl[0], x[1] * rstd * gl[1]); o.y = cvt_pk_bf16(x[2] * rstd * gl[2], x[3] * rstd * gl[3]);
        o.z = cvt_pk_bf16(x[4] * rstd * gl[4], x[5] * rstd * gl[5]); o.w = cvt_pk_bf16(x[6] * rstd * gl[6], x[7] * rstd * gl[7]);
        *(LAS u32x4*)(V + row * SGS + 16 * lane) = o; }
    __syncthreads();
    const int g = wid;
    const int vbase = (8 * hi + ((lane & 15) >> 2)) * SGS + (g * 64 + 16 * ((lane >> 4) & 1) + 4 * (lane & 3)) * 2;
    const bf16_t* wg = SGWl + (size_t)g * 128 * 128;
#pragma unroll 1
    for (int tb = 0; tb < 4; ++tb) {
        f32x16 a0, a1;
#pragma unroll
        for (int r = 0; r < 16; ++r) { a0[r] = 0.f; a1[r] = 0.f; }
        const bf16_t* wrow = wg + (size_t)(32 * tb + n) * 128 + 8 * hi;
        bf16x8 afr[8];
#pragma unroll
        for (int ks = 0; ks < 8; ++ks) if (ks < 2 * tb + 2) afr[ks] = *(const bf16x8*)(wrow + 16 * ks);
#pragma unroll
        for (int ks = 0; ks < 8; ++ks) if (ks < 2 * tb + 2) {
            const bf16x8 af = afr[ks];
#pragma unroll
            for (int db = 0; db < 2; ++db) { bf16x8 vf;
#if USE_TR
                const v4i16_t t0 = __builtin_amdgcn_ds_read_tr16_b64_v4i16((LAS v4i16_t*)(V + vbase + (16 * ks) * SGS + 64 * db));
                const v4i16_t t1 = __builtin_amdgcn_ds_read_tr16_b64_v4i16((LAS v4i16_t*)(V + vbase + (16 * ks + 4) * SGS + 64 * db));
                vf = (bf16x8){t0[0], t0[1], t0[2], t0[3], t1[0], t1[1], t1[2], t1[3]};
#else
#pragma unroll
                for (int j = 0; j < 8; ++j) vf[j] = *(const LAS short*)(V + (16 * ks + 8 * hi + j) * SGS + (g * 64 + 32 * db + n) * 2);
#endif
                if (db == 0) a0 = __builtin_amdgcn_mfma_f32_32x32x16_bf16(af, vf, a0, 0, 0, 0); else a1 = __builtin_amdgcn_mfma_f32_32x32x16_bf16(af, vf, a1, 0, 0, 0); }
        }
#pragma unroll
        for (int r = 0; r < 16; ++r) { const int t = 32 * tb + 8 * (r >> 2) + 4 * hi + (r & 3); const float bb = sgb[g * 128 + t];
            const bf16_t* up = PROJ + (tok0 + t) * PLD + C_U + g * 64 + n; bf16_t* op = OC + (tok0 + t) * 512 + g * 64 + n;
            const float u0 = __builtin_bit_cast(float, (unsigned)up[0] << 16), u1 = __builtin_bit_cast(float, (unsigned)up[32] << 16);
            op[0] = (bf16_t)f2bf((a0[r] + bb) * u0); op[32] = (bf16_t)f2bf((a1[r] + bb) * u1); }
    }
}
constexpr int HS_STRIDE = 2064;
constexpr int P7_PART = 32 * HS_STRIDE;
constexpr int P7_LOG = P7_PART + 8 * 4096;
constexpr int P7_HIST = P7_LOG + 32 * 33 * 4;
__device__ __forceinline__ void p7_route(const Frame& F, const Args& a, int l, const float* xin, float* xout, const bf16_t* Y, const float* SSP, const float* MODl, signed char* H8, float* RS,
                                         const bf16_t* WRTl, unsigned* cnt, int* ROWTOK, unsigned* TOKINFO) {
    const int tid = F.tid, lane = F.lane, wid = F.wave, n = lane & 31, hi = lane >> 5;
    const float* g_post = a.in[5] + l * DM; const float* g_pre = a.in[6] + l * DM; const float* b_router = a.in[16] + l * NE;
    LAS unsigned char* hs = F.lds; LAS float* part = (LAS float*)(F.lds + P7_PART); LAS float* lg = (LAS float*)(F.lds + P7_LOG); LAS int* hist = (LAS int*)(F.lds + P7_HIST); LAS int* base = hist + 32;
    if (tid < 32) hist[tid] = 0;
    __syncthreads();
    for (int bt = F.vcu; bt < MTOK / 32; bt += F.G) {
        const int row0 = bt * 32, b = row0 >> 11;
        const float* mb = MODl + (size_t)b * 6 * DM;
        u32x2 yv[4][4]; f32x4 xv[4][4], s4v[4];
#pragma unroll
        for (int rr = 0; rr < 4; ++rr) { const size_t row = (size_t)row0 + 4 * wid + rr; s4v[rr] = *(const f32x4*)(SSP + row * 16 + 4 * (lane & 3));
#pragma unroll
            for (int j = 0; j < 4; ++j) { const int c = 4 * lane + 256 * j; yv[rr][j] = __builtin_nontemporal_load((const u32x2*)(Y + row * DM + c)); xv[rr][j] = __builtin_nontemporal_load((const f32x4*)(xin + row * DM + c)); } }
#pragma unroll
        for (int rr = 0; rr < 4; ++rr) { const int rl = 4 * wid + rr; const size_t row = (size_t)row0 + rl;
            const f32x4 s4 = s4v[rr];
            float ssy = (s4[0] + s4[1]) + (s4[2] + s4[3]); ssy += __shfl_xor(ssy, 1); ssy += __shfl_xor(ssy, 2);
            const float rstd1 = 1.f / sqrtf(ssy * (1.f / DM) + RMS_EPS);
            f32x4 v[4]; float ss = 0.f;
#pragma unroll
            for (int j = 0; j < 4; ++j) { const int c = 4 * lane + 256 * j; const u32x2 yw_ = yv[rr][j]; const f32x4 yy = {bf_lo(yw_.x), bf_hi(yw_.x), bf_lo(yw_.y), bf_hi(yw_.y)}, xx = xv[rr][j];
                const f32x4 gp = *(const f32x4*)(g_post + c), ga = *(const f32x4*)(mb + 2 * DM + c);
                v[j] = xx + ga * (yy * rstd1 * gp); *(f32x4*)(xout + row * DM + c) = v[j];
                ss += (v[j][0] * v[j][0] + v[j][1] * v[j][1]) + (v[j][2] * v[j][2] + v[j][3] * v[j][3]); }
            ss = wave_sum(ss);
            const float rstd = 1.f / sqrtf(ss * (1.f / DM) + RMS_EPS);
            f32x4 o[4]; float am = 0.f;
#pragma unroll
            for (int j = 0; j < 4; ++j) { const int c = 4 * lane + 256 * j; const f32x4 gg = *(const f32x4*)(g_pre + c), s1 = *(const f32x4*)(mb + 4 * DM + c), s0 = *(const f32x4*)(mb + 3 * DM + c);
                o[j] = (v[j] * rstd) * gg * (s1 + 1.f) + s0; u32x2 w; w.x = cvt_pk_bf16(o[j][0], o[j][1]); w.y = cvt_pk_bf16(o[j][2], o[j][3]);
                *(LAS u32x2*)(hs + rl * HS_STRIDE + c * 2) = w;
                am = fmaxf(am, fmaxf(fmaxf(fabsf(o[j][0]), fabsf(o[j][1])), fmaxf(fabsf(o[j][2]), fabsf(o[j][3])))); }
#pragma unroll
            for (int sh = 1; sh < 64; sh <<= 1) am = fmaxf(am, __shfl_xor(am, sh));
            const float scale = fmaxf(am, 1e-30f) * (1.f / 127.f), inv = 1.f / scale;
            if (lane == 0) RS[row] = scale;
#pragma unroll
            for (int j = 0; j < 4; ++j) { unsigned pk = 0u;
#pragma unroll
                for (int i = 0; i < 4; ++i) { int q = (int)rintf(o[j][i] * inv); q = q > 127 ? 127 : (q < -127 ? -127 : q); pk |= ((unsigned)q & 0xffu) << (8 * i); }
                *(unsigned*)(H8 + row * DM + 4 * lane + 256 * j) = pk; } }
        __syncthreads();
        {
            f32x16 d;
#pragma unroll
            for (int r = 0; r < 16; ++r) d[r] = 0.f;
#pragma unroll
            for (int ks = 0; ks < 8; ++ks) { const int k0 = (8 * wid + ks) * 16 + 8 * hi;
                const bf16x8 af = *(const LAS bf16x8*)(hs + n * HS_STRIDE + k0 * 2); const bf16x8 bf = *(const bf16x8*)(WRTl + (size_t)n * DM + k0);
                d = __builtin_amdgcn_mfma_f32_32x32x16_bf16(af, bf, d, 0, 0, 0); }
#pragma unroll
            for (int r = 0; r < 16; ++r) part[wid * 1024 + (8 * (r >> 2) + 4 * hi + (r & 3)) * 32 + n] = d[r];
        }
        __syncthreads();
        for (int i = tid; i < 1024; i += 512) { float s = b_router[i & 31];
#pragma unroll
            for (int w = 0; w < 8; ++w) s += part[w * 1024 + i]; lg[(i >> 5) * 33 + (i & 31)] = s; }
        __syncthreads();
        int e_k[4] = {0, 0, 0, 0}, lp_k[4] = {0, 0, 0, 0}; float w_k[4] = {0.f, 0.f, 0.f, 0.f};
        if (tid < 32) { LAS float* mylg = lg + tid * 33; float tl[4];
#pragma unroll
            for (int k = 0; k < 4; ++k) { float best = -INFINITY; int bi = 0;
                for (int e = 0; e < 32; ++e) { const float vv = mylg[e]; if (vv > best) { best = vv; bi = e; } }
                tl[k] = best; e_k[k] = bi; mylg[bi] = -INFINITY; }
            float sum = 0.f;
#pragma unroll
            for (int k = 0; k < 4; ++k) { w_k[k] = __expf(tl[k] - tl[0]); sum += w_k[k]; }
            const float inv = 1.f / sum;
#pragma unroll
            for (int k = 0; k < 4; ++k) { w_k[k] *= inv; lp_k[k] = __hip_atomic_fetch_add(&hist[e_k[k]], 1, __ATOMIC_RELAXED, __HIP_MEMORY_SCOPE_WORKGROUP); } }
        __syncthreads();
        if (tid < 32) { const int hc = hist[tid]; base[tid] = hc > 0 ? (int)__hip_atomic_fetch_add(cnt + 64 * tid, (unsigned)hc, __ATOMIC_RELAXED, __HIP_MEMORY_SCOPE_AGENT) : 0; hist[tid] = 0; }
        __syncthreads();
        if (tid < 32) { const int token = row0 + tid; u32x4 info; f32x4 ww;
#pragma unroll
            for (int k = 0; k < 4; ++k) { const int pos = base[e_k[k]] + lp_k[k]; ROWTOK[e_k[k] * 65536 + pos] = token; info[k] = ((unsigned)e_k[k] << 17) | (unsigned)pos; ww[k] = w_k[k]; }
            *(u32x4*)(TOKINFO + (size_t)token * 8) = info; *(f32x4*)(TOKINFO + (size_t)token * 8 + 4) = ww; }
        __syncthreads();
    }
}

__device__ __forceinline__ int moe_tables(const Frame& F, unsigned* cnt) {
    LAS int* ts = (LAS int*)(F.lds + TS_OFF); LAS int* te = (LAS int*)(F.lds + TILE_E_OFF);
    __syncthreads();
    if (F.tid == 0) { int acc = 0; for (int e = 0; e < NE; ++e) { ts[e] = acc; const unsigned c = __hip_atomic_load(cnt + 64 * e, __ATOMIC_RELAXED, __HIP_MEMORY_SCOPE_AGENT); acc += (int)((c + 255u) >> 8); } ts[NE] = acc; }
    __syncthreads();
    const int RT = ts[NE];
    for (int rt = F.tid; rt < RT; rt += 512) { int e = 0;
#pragma unroll 1
        for (int q = 1; q < NE; ++q) e += (ts[q] <= rt) ? 1 : 0;
        te[rt] = e; }
    __syncthreads();
    return RT;
}

__device__ __forceinline__ void p10_combine(const Frame& F, const Args& a, int l, float* xio, const bf16_t* Y2, const unsigned* TOKINFO, const float* MODbase, signed char* H8, float* RS) {
    const int lane = F.lane; const LAS int* ts = (const LAS int*)(F.lds + TS_OFF);
    const float* g_postf = a.in[7] + l * DM;
    const int gw = F.vcu * 8 + F.wave, NGW = F.G * 8;
    for (int rowp = gw * 2; rowp < MTOK; rowp += NGW * 2) {
        u32x4 info[2]; f32x4 ww[2]; u32x2 yw[2][4][4]; f32x4 xv[2][4];
#pragma unroll
        for (int rr = 0; rr < 2; ++rr) { info[rr] = *(const u32x4*)(TOKINFO + (size_t)(rowp + rr) * 8); ww[rr] = *(const f32x4*)(TOKINFO + (size_t)(rowp + rr) * 8 + 4); }
#pragma unroll
        for (int rr = 0; rr < 2; ++rr) {
#pragma unroll
            for (int k = 0; k < 4; ++k) { const int e = (int)(info[rr][k] >> 17), pos = (int)(info[rr][k] & 0x1ffffu); const size_t slot = (size_t)ts[e] * 256 + pos;
#pragma unroll
                for (int j = 0; j < 4; ++j) yw[rr][k][j] = __builtin_nontemporal_load((const u32x2*)(Y2 + slot * DM + 4 * lane + 256 * j)); }
#pragma unroll
            for (int j = 0; j < 4; ++j) xv[rr][j] = *(const f32x4*)(xio + (size_t)(rowp + rr) * DM + 4 * lane + 256 * j); }
#pragma unroll
        for (int rr = 0; rr < 2; ++rr) { const int row = rowp + rr, b = row >> 11;
        f32x4 y[4];
#pragma unroll
        for (int j = 0; j < 4; ++j) y[j] = (f32x4){0.f, 0.f, 0.f, 0.f};
#pragma unroll
        for (int k = 0; k < 4; ++k) { const float wk = ww[rr][k];
#pragma unroll
            for (int j = 0; j < 4; ++j) { const u32x2 w = yw[rr][k][j];
                y[j][0] += wk * bf_lo(w.x); y[j][1] += wk * bf_hi(w.x); y[j][2] += wk * bf_lo(w.y); y[j][3] += wk * bf_hi(w.y); } }
        float ss = 0.f;
#pragma unroll
        for (int j = 0; j < 4; ++j) ss += (y[j][0] * y[j][0] + y[j][1] * y[j][1]) + (y[j][2] * y[j][2] + y[j][3] * y[j][3]);
        ss = wave_sum(ss);
        const float rstd = 1.f / sqrtf(ss * (1.f / DM) + RMS_EPS);
        const float* mb = MODbase + ((size_t)l * BATCH + b) * 6 * DM;
        f32x4 v[4]; float s2 = 0.f;
#pragma unroll
        for (int j = 0; j < 4; ++j) { const int c = 4 * lane + 256 * j; const f32x4 xx = xv[rr][j], gp = *(const f32x4*)(g_postf + c), ga = *(const f32x4*)(mb + 5 * DM + c);
            v[j] = xx + ga * (y[j] * rstd * gp); *(f32x4*)(xio + (size_t)row * DM + c) = v[j];
            s2 += (v[j][0] * v[j][0] + v[j][1] * v[j][1]) + (v[j][2] * v[j][2] + v[j][3] * v[j][3]); }
        if (l + 1 < DEPTH) { s2 = wave_sum(s2); const float* mb1 = MODbase + ((size_t)(l + 1) * BATCH + b) * 6 * DM;
            norm_mod_row(v, s2, a.in[4] + (l + 1) * DM, mb1 + DM, mb1, H8 + (size_t)row * DM, RS + row, lane); }
        }
    }
}
#ifndef MK_ONE_LAUNCH
#define MK_ONE_LAUNCH 1
#endif
constexpr int N_PHASES = 2 + 9 * DEPTH;
__global__ void __launch_bounds__(512, 2) fwd(Args args) {
    extern __shared__ __attribute__((aligned(16))) unsigned char lds_raw[];
    Frame F0;
    F0.lds = (LAS unsigned char*)lds_raw;
    F0.tid = threadIdx.x; F0.lane = F0.tid & 63; F0.wave = __builtin_amdgcn_readfirstlane(F0.tid >> 6);
    F0.G = gridDim.x; { const int bx = blockIdx.x; F0.vcu = (F0.G % 8 == 0) ? (bx % 8) * (F0.G / 8) + bx / 8 : bx; }
    volatile LAS unsigned* MISC = (volatile LAS unsigned*)(F0.lds + MISC_OFF);
    for (int u = F0.tid; u < 128; u += 512) MISC[u] = 0u;
    __syncthreads();
    unsigned* ctl = (unsigned*)(args.ws + WS_CTL);
    const int lo = args.ph_lo, hi = args.ph_hi;
    XcdBarrier bar; bar.bar = ctl + CW_BAR; bar.x = 0; bar.st = nullptr;
    if (hi - lo > 1) bar = xcd_barrier_post(ctl + CW_BAR, MISC + 8);
#ifndef PHASE_MASK
#define PHASE_MASK 0x7ff
#endif
#define PHON(j) ((PHASE_MASK >> (j)) & 1)
#ifndef REPEAT_MASK
#define REPEAT_MASK 0
#endif
#define REP(j) for (int rep_ = 0; rep_ <= ((REPEAT_MASK >> (j)) & 1); ++rep_)
#define IN(k) (lo <= (k) && (k) < hi)
#define BOTH(k) (IN(k) && IN((k) + 1))
#define GRID_BAR() xcd_barrier(bar)
#define PH_BEGIN() const Frame F = phase_frame(F0); unsigned char* ws = opq(args.ws); (void)ws
    if (PHON(0) && IN(0)) REP(0) { PH_BEGIN(); p0_mod(F, args.in[1], args.in[2], args.in[3], (float*)(ws + WS_MOD)); p0_weights(F, args); if (BOTH(0)) GRID_BAR(); }
    if (PHON(1) && IN(1)) REP(1) { PH_BEGIN(); p1_norm(F, args.in[0], args.in[4], (const float*)(ws + WS_MOD), (signed char*)(ws + WS_H), (float*)(ws + WS_RS)); if (BOTH(1)) GRID_BAR(); }

#pragma unroll 1
    for (int l = 0; l < DEPTH; ++l) {
        const int pb = 2 + 9 * l;
        if (PHON(2) && IN(pb + 0)) REP(2) { PH_BEGIN();
            pg8::Gemm g{(const bf16_t*)(ws + WS_H), (const bf16_t*)(ws + WS_W + (size_t)l * W_LAYER + WO_WIN), DM}; pg8::StaticOrder S; S.init(MTOK / 256, NPROJ / 256, F.G, (int)blockIdx.x);
            EpiProj E{(bf16_t*)(ws + WS_PROJ), (unsigned char*)(ws + WS_GATES), (const float*)(ws + WS_RS), (const float*)(ws + WS_CSIN) + (size_t)l * NPROJ};
            pg8::gemm_phase<EpiProj, pg8::StaticOrder, false, true>(F.lds, g, S, E);
            if (BOTH(pb + 0)) GRID_BAR();
        }
        if (PHON(3) && IN(pb + 1)) REP(3) { PH_BEGIN();
            const bf16_t* PROJ = (const bf16_t*)(ws + WS_PROJ); bf16_t* OABC = (bf16_t*)(ws + WS_O);
#ifndef SUBREP
#define SUBREP 0
#endif
            for (int r_ = 0; r_ <= (SUBREP & 1); ++r_) dsa_index_phase(F, PROJ, (unsigned long long*)(ws + WS_BITS));
            for (int r_ = 0; r_ <= ((SUBREP >> 1) & 1); ++r_)
            for (int u = F.vcu; u < 2048; u += F.G) { const int cu = u & 255, j = u >> 8, bg = cu >> 2, s = cu & 3, qb = (j & 1) ? (8 * (j >> 1) + 7 - s) : (8 * (j >> 1) + s);
                attn_unit<0>(F, PROJ, OABC, nullptr, args.in[9] + l * 8, bg >> 1, bg & 1, qb); }
            for (int r_ = 0; r_ <= ((SUBREP >> 2) & 1); ++r_)
            for (int u = F.vcu; u < 512; u += F.G)
                sg_unit(F, PROJ, (const bf16_t*)(ws + WS_SGW) + (size_t)l * 8 * 128 * 128, args.in[11] + l * 8 * 128, args.in[12] + l * 512, OABC + (size_t)2 * MTOK * 512, u >> 4, u & 15);
            if (BOTH(pb + 1)) GRID_BAR();
        }
        if (PHON(4) && IN(pb + 2)) REP(4) { PH_BEGIN();
            for (int u = F.vcu; u < 2048; u += F.G) { const int cu = u & 255, j = u >> 8, bg = cu >> 2, s = cu & 3, qb = (j & 1) ? (8 * (j >> 1) + 7 - s) : (8 * (j >> 1) + s);
                attn_unit<1>(F, (const bf16_t*)(ws + WS_PROJ), (bf16_t*)(ws + WS_O) + (size_t)MTOK * 512, (const unsigned*)(ws + WS_BITS), nullptr, bg >> 1, bg & 1, qb); }
            __syncthreads();
            if (BOTH(pb + 2)) GRID_BAR();
        }
        if (PHON(5) && IN(pb + 3)) REP(5) { PH_BEGIN();
            pg8::Gemm g{(const bf16_t*)(ws + WS_O), (const bf16_t*)(ws + WS_W + (size_t)l * W_LAYER + WO_WBR), 512}; BranchOrder S; S.so.init(MTOK / 256, DM / 256, F.G, (int)blockIdx.x);
            EpiBranch E{(const unsigned char*)(ws + WS_GATES), (bf16_t*)(ws + WS_H)};
            pg8::gemm_phase<EpiBranch, BranchOrder, false>(F.lds, g, S, E);
            if (BOTH(pb + 3)) GRID_BAR();
        }
        if (PHON(6) && IN(pb + 4)) REP(6) { PH_BEGIN();
            pg8::Gemm g{(const bf16_t*)(ws + WS_H), (const bf16_t*)(ws + WS_W + (size_t)l * W_LAYER + WO_WOUT), DM}; pg8::StaticOrder S; S.init(MTOK / 256, DM / 256, F.G, (int)blockIdx.x);
            EpiWout E{(bf16_t*)(ws + WS_Y), (float*)(ws + WS_SSP)};
            pg8::gemm_phase<EpiWout, pg8::StaticOrder, false>(F.lds, g, S, E);
            if (BOTH(pb + 4)) GRID_BAR();
        }
        if (PHON(7) && IN(pb + 5)) REP(7) { PH_BEGIN();
            p7_route(F, args, l, l == 0 ? args.in[0] : (const float*)args.out, args.out, (const bf16_t*)(ws + WS_Y), (const float*)(ws + WS_SSP), (const float*)(ws + WS_MOD) + (size_t)l * BATCH * 6 * DM, (signed char*)(ws + WS_H), (float*)(ws + WS_RS),
                     (const bf16_t*)(ws + WS_WRT) + (size_t)l * NE * DM, (unsigned*)(ws + WS_CTL) + CW_CNT + l * 32 * 64, (int*)(ws + WS_ROWTOK), (unsigned*)(ws + WS_TOKINFO));
            if (BOTH(pb + 5)) GRID_BAR();
        }
        if (PHON(8) && IN(pb + 6)) REP(8) { PH_BEGIN();
            unsigned* cnt = (unsigned*)(ws + WS_CTL) + CW_CNT + l * 32 * 64; const int* ROWTOK = (const int*)(ws + WS_ROWTOK);
            const int RT = moe_tables(F, cnt);
            LAS int* ts = (LAS int*)(F.lds + TS_OFF); LAS int* te = (LAS int*)(F.lds + TILE_E_OFF); LAS int* ri = (LAS int*)(F.lds + ROWIDX_OFF);
            const long U = (long)RT * 8; MoeOrder S; S.u0 = (int)(U * F.vcu / F.G); S.u1 = (int)(U * (F.vcu + 1) / F.G); S.NB = 8; S.rt_lo = S.u0 / 8; S.tile_e = te; S.rowidx = ri;
            if (S.u1 > S.u0) { const int rt_hi = (S.u1 - 1) / 8; int ntile = rt_hi - S.rt_lo + 1; if (ntile > 8) ntile = 8;
                for (int i = F.tid; i < ntile * 256; i += 512) { const int rt = S.rt_lo + (i >> 8), r = i & 255, e = te[rt], first = (rt - ts[e]) * 256 + r;
                    const int c = (int)__hip_atomic_load(cnt + 64 * e, __ATOMIC_RELAXED, __HIP_MEMORY_SCOPE_AGENT); ri[i] = first < c ? ROWTOK[e * 65536 + first] : 0; } }
            __syncthreads();
            pg8::Gemm g{(const bf16_t*)(ws + WS_H), (const bf16_t*)(ws + WS_W + (size_t)l * W_LAYER + WO_W1), DM};
            EpiW1I8 E{(signed char*)(ws + WS_ACT), args.in[18] + (size_t)l * NE * 2 * FF, (const float*)(ws + WS_RS), (const float*)(ws + WS_CS1) + (size_t)l * NE * 2048, ri, S.rt_lo};
            pg8::gemm_phase<EpiW1I8, MoeOrder, true, true>(F.lds, g, S, E);
            if (BOTH(pb + 6)) GRID_BAR();
        }
        if (PHON(9) && IN(pb + 7)) REP(9) { PH_BEGIN();
            const int RT = moe_tables(F, (unsigned*)(ws + WS_CTL) + CW_CNT + l * 32 * 64);
            const long U = (long)RT * 4; MoeOrder S; S.u0 = (int)(U * F.vcu / F.G); S.u1 = (int)(U * (F.vcu + 1) / F.G); S.NB = 4; S.rt_lo = 0; S.tile_e = (LAS int*)(F.lds + TILE_E_OFF); S.rowidx = nullptr;
            pg8::Gemm g{(const bf16_t*)(ws + WS_ACT), (const bf16_t*)(ws + WS_W + (size_t)l * W_LAYER + WO_W2), FF};
            EpiW2 E{(bf16_t*)(ws + WS_Y2), args.in[20] + (size_t)l * NE * DM, (const float*)(ws + WS_CS2) + (size_t)l * NE * DM};
            pg8::gemm_phase<EpiW2, MoeOrder, false, true>(F.lds, g, S, E);
            if (BOTH(pb + 7)) GRID_BAR();
        }
        if (PHON(10) && IN(pb + 8)) REP(10) { PH_BEGIN();
            (void)moe_tables(F, (unsigned*)(ws + WS_CTL) + CW_CNT + l * 32 * 64);
            p10_combine(F, args, l, args.out, (const bf16_t*)(ws + WS_Y2), (const unsigned*)(ws + WS_TOKINFO), (const float*)(ws + WS_MOD), (signed char*)(ws + WS_H), (float*)(ws + WS_RS));
            if (BOTH(pb + 8)) GRID_BAR();
        }
    }
#undef PH_BEGIN
#undef IN
#undef BOTH
#undef GRID_BAR
}

extern "C" void kernel_launch(void* const* d_in, const int* in_sizes, int n_in, void* d_out, int out_size, void* d_ws, size_t ws_size, hipStream_t stream) {
    static int grid = 0;
    if (grid == 0) {
        if (n_in != 21 || out_size != MTOK * DM || ws_size < WS_END) { fprintf(stderr, "kernel_launch: unexpected shapes (n_in %d, out %d, ws %zu); nothing launched\n", n_in, out_size, ws_size); grid = -1; return; }
        int dev = 0, cus = 0, per_cu = 0;
        if (hipGetDevice(&dev) != hipSuccess || hipDeviceGetAttribute(&cus, hipDeviceAttributeMultiprocessorCount, dev) != hipSuccess) { grid = -1; return; }
        if (hipFuncSetAttribute((const void*)fwd, hipFuncAttributeMaxDynamicSharedMemorySize, LDS_BYTES) != hipSuccess) { fprintf(stderr, "kernel_launch: hipFuncSetAttribute failed\n"); grid = -1; return; }
        if (hipOccupancyMaxActiveBlocksPerMultiprocessor(&per_cu, (const void*)fwd, 512, LDS_BYTES) != hipSuccess || per_cu < 1) { fprintf(stderr, "kernel_launch: occupancy query says %d\n", per_cu); }
        (void)hipGetLastError();
        grid = cus > 256 ? 256 : cus;
    }
    if (grid < 0) return;
    (void)hipMemsetAsync((char*)d_ws + WS_CTL, 0, CTL_ZERO_BYTES, stream);
    Args a{};
    for (int i = 0; i < 21; ++i) a.in[i] = (const float*)d_in[i];
    a.out = (float*)d_out; a.ws = (unsigned char*)d_ws;
#if MK_ONE_LAUNCH
    a.ph_lo = 0; a.ph_hi = N_PHASES;
    hipLaunchKernelGGL(fwd, dim3(grid), dim3(512), LDS_BYTES, stream, a);
#else
    for (int p = 0; p < N_PHASES; ++p) { a.ph_lo = p; a.ph_hi = p + 1; hipLaunchKernelGGL(fwd, dim3(grid), dim3(512), LDS_BYTES, stream, a); }
#endif
}
```

```cpp
#include <hip/hip_runtime.h>
#include <cstdio>
#include <cstdint>
#include <type_traits>

#define LAS __attribute__((address_space(3)))
#define GAS __attribute__((address_space(1)))
typedef unsigned short bf16_t;
typedef short bf16x8 __attribute__((ext_vector_type(8)));
typedef float f32x2 __attribute__((ext_vector_type(2)));
typedef float f32x4 __attribute__((ext_vector_type(4)));
typedef float f32x16 __attribute__((ext_vector_type(16)));
typedef unsigned u32x2 __attribute__((ext_vector_type(2)));
typedef unsigned u32x4 __attribute__((ext_vector_type(4)));
typedef short v4i16_t __attribute__((ext_vector_type(4)));
typedef int i32x4 __attribute__((ext_vector_type(4)));

constexpr int BATCH = 32, SEQ = 2048, DM = 1024, MTOK = BATCH * SEQ, DEPTH = 2;
constexpr int NPROJ = 6144;
constexpr int PLD = 3072;
constexpr int C_QA = 0, C_KA = 512, C_VA = 640, C_QB = 768, C_KB = 1280, C_VB = 1408, C_QI = 1536, C_KI = 1792, C_WI = 1824, C_U = 2048, C_V = 2560, C_G = 3072;
constexpr int NE = 32, FF = 1024;
constexpr float RMS_EPS = 1e-5f, LN_EPS = 1e-5f;
constexpr float LOG2E = 1.4426950408889634f;
constexpr float QSCALE = 0.125f * LOG2E;

__device__ __forceinline__ unsigned f2bf(float f) { unsigned u = __builtin_bit_cast(unsigned, f); return (u + 0x7fffu + ((u >> 16) & 1u)) >> 16; }
__device__ __forceinline__ unsigned cvt_pk_bf16(float lo, float hi) { unsigned r; asm volatile("v_cvt_pk_bf16_f32 %0, %1, %2" : "=v"(r) : "v"(lo), "v"(hi)); return r; }
__device__ __forceinline__ float bf_lo(unsigned w) { return __builtin_bit_cast(float, w << 16); }
__device__ __forceinline__ float bf_hi(unsigned w) { return __builtin_bit_cast(float, w & 0xffff0000u); }
__device__ __forceinline__ float fexp2(float x) { return __builtin_amdgcn_exp2f(x); }
__device__ __forceinline__ float frcp(float x) { return __builtin_amdgcn_rcpf(x); }
__device__ __forceinline__ float sigmoidf_(float x) { return frcp(1.f + fexp2(-LOG2E * x)); }
__device__ __forceinline__ float gelu_tanh(float x) { const float t = x + 0.044715f * x * x * x; return x * frcp(1.f + fexp2(-2.302208198f * t)); }
template <int CTRL> __device__ __forceinline__ float dpp_f(float v) { return __builtin_bit_cast(float, __builtin_amdgcn_update_dpp(0, __builtin_bit_cast(int, v), CTRL, 0xF, 0xF, false)); }
__device__ __forceinline__ void swap32_asm(unsigned& a, unsigned& b) { asm volatile("s_nop 1\n\tv_permlane32_swap_b32 %0, %1" : "+v"(a), "+v"(b)); }
__device__ __forceinline__ float xor16_add(float v) { return v + __builtin_bit_cast(float, __builtin_amdgcn_ds_swizzle(__builtin_bit_cast(int, v), 0x401F)); }
__device__ __forceinline__ float xor16_max(float v) { return fmaxf(v, __builtin_bit_cast(float, __builtin_amdgcn_ds_swizzle(__builtin_bit_cast(int, v), 0x401F))); }
__device__ __forceinline__ float xor32_add(float v) { unsigned a = __builtin_bit_cast(unsigned, v), b = a; swap32_asm(a, b); return __builtin_bit_cast(float, a) + __builtin_bit_cast(float, b); }
__device__ __forceinline__ float xor32_max(float v) { unsigned a = __builtin_bit_cast(unsigned, v), b = a; swap32_asm(a, b); return fmaxf(__builtin_bit_cast(float, a), __builtin_bit_cast(float, b)); }
__device__ __forceinline__ float quad_sum(float v) { v += dpp_f<0xB1>(v); v += dpp_f<0x4E>(v); return v; }
__device__ __forceinline__ float wave_sum(float v) {
    v += dpp_f<0xB1>(v); v += dpp_f<0x4E>(v); v += dpp_f<0x141>(v); v += dpp_f<0x140>(v);
    return xor32_add(xor16_add(v));
}
__device__ __forceinline__ float wave_max(float v) {
    v = fmaxf(v, dpp_f<0xB1>(v)); v = fmaxf(v, dpp_f<0x4E>(v)); v = fmaxf(v, dpp_f<0x141>(v)); v = fmaxf(v, dpp_f<0x140>(v));
    return xor32_max(xor16_max(v));
}
__device__ __forceinline__ unsigned wave_sum_u32(unsigned v) {
    v += (unsigned)__builtin_amdgcn_update_dpp(0, (int)v, 0xB1, 0xF, 0xF, false);
    v += (unsigned)__builtin_amdgcn_update_dpp(0, (int)v, 0x4E, 0xF, 0xF, false);
    v += (unsigned)__builtin_amdgcn_update_dpp(0, (int)v, 0x141, 0xF, 0xF, false);
    v += (unsigned)__builtin_amdgcn_update_dpp(0, (int)v, 0x140, 0xF, 0xF, false);
    return __builtin_amdgcn_readlane(v, 0) + __builtin_amdgcn_readlane(v, 16) + __builtin_amdgcn_readlane(v, 32) + __builtin_amdgcn_readlane(v, 48);
}
__device__ __forceinline__ unsigned wave_max_u32(unsigned v) {
    unsigned t;
    t = (unsigned)__builtin_amdgcn_update_dpp(0, (int)v, 0xB1, 0xF, 0xF, false); v = v > t ? v : t;
    t = (unsigned)__builtin_amdgcn_update_dpp(0, (int)v, 0x4E, 0xF, 0xF, false); v = v > t ? v : t;
    t = (unsigned)__builtin_amdgcn_update_dpp(0, (int)v, 0x141, 0xF, 0xF, false); v = v > t ? v : t;
    t = (unsigned)__builtin_amdgcn_update_dpp(0, (int)v, 0x140, 0xF, 0xF, false); v = v > t ? v : t;
    unsigned a = __builtin_amdgcn_readlane(v, 0), b = __builtin_amdgcn_readlane(v, 16), c = __builtin_amdgcn_readlane(v, 32), d = __builtin_amdgcn_readlane(v, 48);
    a = a > b ? a : b; c = c > d ? c : d; return a > c ? a : c;
}
__device__ __forceinline__ unsigned q8x4(float a, float b, float c, float d, float inv) {
    unsigned r = 0u;
    r = __builtin_amdgcn_cvt_pk_u8_f32(__builtin_rintf(fmaf(a, inv, 128.f)), 0u, r);
    r = __builtin_amdgcn_cvt_pk_u8_f32(__builtin_rintf(fmaf(b, inv, 128.f)), 1u, r);
    r = __builtin_amdgcn_cvt_pk_u8_f32(__builtin_rintf(fmaf(c, inv, 128.f)), 2u, r);
    r = __builtin_amdgcn_cvt_pk_u8_f32(__builtin_rintf(fmaf(d, inv, 128.f)), 3u, r);
    return r ^ 0x80808080u;
}
__device__ __forceinline__ unsigned u8x4_floor(float a, float b, float c, float d) {
    unsigned r = 0u;
    r = __builtin_amdgcn_cvt_pk_u8_f32(__builtin_floorf(a), 0u, r); r = __builtin_amdgcn_cvt_pk_u8_f32(__builtin_floorf(b), 1u, r);
    r = __builtin_amdgcn_cvt_pk_u8_f32(__builtin_floorf(c), 2u, r); r = __builtin_amdgcn_cvt_pk_u8_f32(__builtin_floorf(d), 3u, r);
    return r;
}
__device__ __forceinline__ int lane_id_volatile(int tag = 0) { int l; asm volatile("v_mbcnt_lo_u32_b32 %0, -1, 0 ; LANETAG %1\n\tv_mbcnt_hi_u32_b32 %0, -1, %0" : "=v"(l) : "s"(tag)); return l; }
#define LDS_WAIT() asm volatile("s_waitcnt lgkmcnt(0)" ::: "memory")
#define VM_WAIT() asm volatile("s_waitcnt vmcnt(0)" ::: "memory")

namespace pg8 {
constexpr int BM = 256, BK = 64, HALF = 128, HTB = HALF * BK * 2  , STAGE_BYTES = 8 * HTB, NXCD = 8, WGM = 8;
__host__ __device__ __forceinline__ int lds_byte(int r, int c) { const int st = (r >> 4) * 2 + (c >> 5), rr = r & 15, cc = c & 31, ob = rr * 64 + cc * 2; return st * 1024 + (ob ^ (((ob >> 9) & 1) << 5)); }
__host__ __device__ __forceinline__ void stage_rc(int b, int& R, int& C) { const int st = b / 1024, sb = b % 1024, swz = sb ^ (((sb >> 9) & 1) << 5); R = (st >> 1) * 16 + swz / 64; C = (st & 1) * 32 + (swz % 64) / 2; }
__host__ __device__ __forceinline__ int perm32(int rho) { const int n = rho >> 4, i = rho & 15; return 8 * (i >> 2) + 4 * n + (i & 3); }

struct Unit { int pm, pn; };
struct Gemm { const bf16_t* A; const bf16_t* Bt; int K; };

struct StaticOrder {
    int nM, nN, nwg, G, c;
    __device__ void init(int nM_, int nN_, int G_, int c_) { nM = nM_; nN = nN_; nwg = nM * nN; G = G_; c = c_; }
    __device__ __forceinline__ bool tile(int i, int& pm, int& pn) const {
        const long L = (long)i * G + c; if (L >= nwg) return false;
        int wgid = (int)L; { const int q = nwg / NXCD, r = nwg % NXCD, xcd = wgid % NXCD, off = wgid / NXCD; wgid = (xcd < r ? xcd * (q + 1) : r * (q + 1) + (xcd - r) * q) + off; }
        const int nig = WGM * nN, gid = wgid / nig, fm = gid * WGM, gsz = (nM - fm) < WGM ? (nM - fm) : WGM;
        pm = fm + ((wgid % nig) % gsz); pn = (wgid % nig) / gsz; return true;
    }
    __device__ __forceinline__ bool next(int i, Unit& u) const { return tile(i, u.pm, u.pn); }
};

template <class Epi, class Sched, bool GATHER, bool I8 = false>
__device__ __forceinline__ void gemm_phase(LAS unsigned char* lds, const Gemm g, const Sched& S, const Epi& E, int wv  ) {
    int tid = wv * 64 + lane_id_volatile(1); asm volatile("" : "+v"(tid));
    const int wid = __builtin_amdgcn_readfirstlane(tid >> 6), lane = tid & 63, wr = wid >> 2, wc = wid & 3, fr = lane & 15, fq = lane >> 4;
    const int K = g.K, RB = I8 ? K : 2 * K  , nt = RB / (BK * 2);
    unsigned voffA[2], voffB[2]; int RA[2], CA[2];
#pragma unroll
    for (int i = 0; i < 2; ++i) { int R, C; stage_rc(tid * 16 + i * 8192, R, C); const int Rb = (R & ~31) + perm32(R & 31); RA[i] = R; CA[i] = C;
        voffA[i] = (unsigned)(R * RB + C * 2); voffB[i] = (unsigned)(Rb * RB + C * 2); }
    const size_t kstep = (size_t)(BK * 2);
    const size_t hstep = (size_t)HALF * RB;
    const size_t tstep = 2 * hstep;
    const unsigned ldsw = (unsigned)wid * 1024u;
    const int aoff = lds_byte(wr * 64 + fr, fq * 8), boff = lds_byte(wc * 32 + fr, fq * 8);
#define PG8_SA(b, h) (((b) * 2 + (h)) * HTB)
#define PG8_SB(b, h) ((4 + (b) * 2 + (h)) * HTB)
#define PG8_STAGE(bufoff, gbase, voff) do { _Pragma("unroll") for (int _i = 0; _i < 2; ++_i) \
        __builtin_amdgcn_global_load_lds((const unsigned*)((const char*)(gbase) + (voff)[_i]), (LAS unsigned*)(lds + (bufoff) + ldsw + _i * 8192), 16, 0, 0); } while (0)
#define PG8_STAGE_A(bufoff, h, ubase, koff, VO) do { if constexpr (GATHER) { PG8_STAGE(bufoff, (const char*)g.A + (koff), VO[h]); } else { PG8_STAGE(bufoff, (ubase) + (h) * hstep + (koff), voffA); } } while (0)
#define PG8_LDA(dst, b, h) do { _Pragma("unroll") for (int m = 0; m < 4; ++m) _Pragma("unroll") for (int k = 0; k < 2; ++k) dst[m][k] = *(const LAS bf16x8*)(lds + PG8_SA(b, h) + aoff + m * 2048 + k * 1024); } while (0)
#define PG8_LDB(dst, b, h) do { _Pragma("unroll") for (int n = 0; n < 2; ++n) _Pragma("unroll") for (int k = 0; k < 2; ++k) dst[n][k] = *(const LAS bf16x8*)(lds + PG8_SB(b, h) + boff + n * 2048 + k * 1024); } while (0)
#define PG8_MMA(ai, bj, At, Bt) do { __builtin_amdgcn_s_setprio(1); _Pragma("unroll") for (int m = 0; m < 4; ++m) _Pragma("unroll") for (int n = 0; n < 2; ++n) _Pragma("unroll") for (int k = 0; k < 2; ++k) \
        { if constexpr (I8) acc[ai][bj][m][n] = __builtin_amdgcn_mfma_i32_16x16x64_i8(__builtin_bit_cast(i32x4, Bt[n][k]), __builtin_bit_cast(i32x4, At[m][k]), acc[ai][bj][m][n], 0, 0, 0); \
          else acc[ai][bj][m][n] = __builtin_amdgcn_mfma_f32_16x16x32_bf16(Bt[n][k], At[m][k], acc[ai][bj][m][n], 0, 0, 0); } __builtin_amdgcn_s_setprio(0); } while (0)
#define PG8_WAIT_V(n) asm volatile("s_waitcnt vmcnt(" #n ")" ::: "memory")
#define PG8_WAIT_L(n) asm volatile("s_waitcnt lgkmcnt(" #n ")" ::: "memory")
#define PG8_BAR __builtin_amdgcn_s_barrier()
#define PG8_SCHED __builtin_amdgcn_sched_barrier(0)
    Unit cur, nxt; int ui = 0;
    if (!S.next(0, cur)) return;
    typedef typename std::conditional<I8, i32x4, f32x4>::type accv_t;
    accv_t acc[2][2][4][2];
#pragma unroll
    for (int a = 0; a < 2; ++a)
#pragma unroll
        for (int b = 0; b < 2; ++b)
#pragma unroll
            for (int m = 0; m < 4; ++m)
#pragma unroll
                for (int n = 0; n < 2; ++n) acc[a][b][m][n] = (accv_t){0, 0, 0, 0};
    bf16x8 At[4][2], B0[2][2], B1[2][2];
    unsigned oc[2][2], on[2][2];
    if constexpr (GATHER) {
#pragma unroll
        for (int h = 0; h < 2; ++h)
#pragma unroll
            for (int i = 0; i < 2; ++i) { oc[h][i] = (unsigned)(S.src_row(cur, h * HALF + RA[i]) * RB + CA[i] * 2); on[h][i] = oc[h][i]; }
    }
    const char* cA = GATHER ? (const char*)g.A : (const char*)g.A + (size_t)cur.pm * tstep; const char* cB = (const char*)g.Bt + (size_t)cur.pn * tstep;
    PG8_STAGE(PG8_SB(0, 0), cB, voffB); PG8_STAGE(PG8_SB(0, 1), cB + hstep, voffB); PG8_STAGE_A(PG8_SA(0, 0), 0, cA, 0, oc); PG8_STAGE_A(PG8_SA(0, 1), 1, cA, 0, oc);
    if (wr == 1) PG8_BAR;
    PG8_WAIT_V(2); PG8_BAR;
    PG8_STAGE(PG8_SB(1, 0), cB + kstep, voffB); PG8_STAGE_A(PG8_SA(1, 0), 0, cA, kstep, oc); PG8_STAGE(PG8_SB(1, 1), cB + hstep + kstep, voffB);
    PG8_WAIT_V(6); PG8_BAR;
    for (;;) {
        const bool has_next = S.next(ui + 1, nxt);
        const char* nA = GATHER ? (const char*)g.A : (has_next ? (const char*)g.A + (size_t)nxt.pm * tstep : cA); const char* nB = has_next ? (const char*)g.Bt + (size_t)nxt.pn * tstep : cB;
        if constexpr (GATHER) {
            if (has_next) {
#pragma unroll
                for (int h = 0; h < 2; ++h)
#pragma unroll
                    for (int i = 0; i < 2; ++i) on[h][i] = (unsigned)(S.src_row(nxt, h * HALF + RA[i]) * RB + CA[i] * 2);
            }
        }
        for (int t = 0; t < nt; t += 2) {
            const bool last = (t == nt - 2);
            const size_t k1 = (size_t)(t + 1) * kstep;
            const size_t k2 = last ? (size_t)0 : (size_t)(t + 2) * kstep, k3 = k2 + kstep;
            const char* a2 = last ? nA : cA; const char* b2 = last ? nB : cB;
            unsigned o2[2][2];
            if constexpr (GATHER) {
#pragma unroll
                for (int h = 0; h < 2; ++h)
#pragma unroll
                    for (int i = 0; i < 2; ++i) o2[h][i] = last ? on[h][i] : oc[h][i];
            }
            PG8_LDB(B0, 0, 0); PG8_LDB(B1, 0, 1); PG8_SCHED; PG8_LDA(At, 0, 0); PG8_STAGE_A(PG8_SA(1, 1), 1, cA, k1, oc);
            PG8_WAIT_V(8); PG8_WAIT_L(0); PG8_BAR; PG8_MMA(0, 0, At, B0); PG8_MMA(0, 1, At, B1); PG8_BAR; PG8_SCHED;
            PG8_LDA(At, 0, 1); PG8_STAGE(PG8_SB(0, 0), b2 + k2, voffB); PG8_STAGE(PG8_SB(0, 1), b2 + hstep + k2, voffB); PG8_STAGE_A(PG8_SA(0, 0), 0, a2, k2, o2);
            PG8_WAIT_V(8); PG8_WAIT_L(0); PG8_BAR; PG8_MMA(1, 0, At, B0); PG8_MMA(1, 1, At, B1); PG8_BAR; PG8_SCHED;
            PG8_LDB(B0, 1, 0); PG8_LDB(B1, 1, 1); PG8_SCHED; PG8_LDA(At, 1, 0); PG8_STAGE_A(PG8_SA(0, 1), 1, a2, k2, o2);
            PG8_WAIT_V(8); PG8_WAIT_L(0); PG8_BAR; PG8_MMA(0, 0, At, B0); PG8_MMA(0, 1, At, B1); PG8_BAR; PG8_SCHED;
            PG8_LDA(At, 1, 1); PG8_STAGE(PG8_SB(1, 0), b2 + k3, voffB); PG8_STAGE(PG8_SB(1, 1), b2 + hstep + k3, voffB); PG8_STAGE_A(PG8_SA(1, 0), 0, a2, k3, o2);
            PG8_WAIT_V(8); PG8_WAIT_L(0); PG8_BAR; PG8_MMA(1, 0, At, B0); PG8_MMA(1, 1, At, B1); PG8_BAR; PG8_SCHED;
        }
        if (wr == 0) PG8_BAR;
        const bool rst = E(acc, cur, wr, wc, fr, fq);
        if (!has_next) break;
        if (rst) {
#pragma unroll
        for (int a = 0; a < 2; ++a)
#pragma unroll
            for (int b = 0; b < 2; ++b)
#pragma unroll
                for (int m = 0; m < 4; ++m)
#pragma unroll
                    for (int n = 0; n < 2; ++n) acc[a][b][m][n] = (accv_t){0, 0, 0, 0};
        }
        cur = nxt; cA = nA; cB = nB; ++ui;
        if constexpr (GATHER) {
#pragma unroll
            for (int h = 0; h < 2; ++h)
#pragma unroll
                for (int i = 0; i < 2; ++i) oc[h][i] = on[h][i];
        }
        if (wr == 1) PG8_BAR;
    }
    PG8_WAIT_V(0);
    PG8_BAR;
#undef PG8_SA
#undef PG8_SB
#undef PG8_STAGE
#undef PG8_STAGE_A
#undef PG8_LDA
#undef PG8_LDB
#undef PG8_MMA
#undef PG8_WAIT_V
#undef PG8_WAIT_L
#undef PG8_BAR
#undef PG8_SCHED
}
}
typedef f32x4 acc_t[2][2][4][2];
typedef i32x4 acci_t[2][2][4][2];

struct EpiProj {
    bf16_t* O; unsigned char* G8; const float* RS  ; const float* CS  ;
    __device__ __forceinline__ bool operator()(acci_t& acc, const pg8::Unit& u, int wr, int wc, int fr, int fq) const {
        const int pn = u.pn;
        const int act = (pn <= 1 || pn == 3 || pn == 4) ? 1 : (pn >= 12 ? 3 : (pn >= 8 ? 2 : 0));
        const int row0 = u.pm * 256 + wr * 64 + fr, col0 = pn * 256 + wc * 32 + 8 * fq;
        float cs[2][8];
#pragma unroll
        for (int bj = 0; bj < 2; ++bj) { const f32x4 c0 = *(const f32x4*)(CS + col0 + bj * 128), c1 = *(const f32x4*)(CS + col0 + bj * 128 + 4);
#pragma unroll
            for (int i = 0; i < 4; ++i) { cs[bj][i] = c0[i] * (act == 1 ? QSCALE : 1.f); cs[bj][4 + i] = c1[i] * (act == 1 ? QSCALE : 1.f); } }
#pragma unroll
        for (int ai = 0; ai < 2; ++ai)
#pragma unroll
            for (int m = 0; m < 4; ++m) { const int row = row0 + ai * 128 + m * 16; bf16_t* rowp = O + (size_t)row * PLD + col0; const float rs = RS[row];
#pragma unroll
                for (int bj = 0; bj < 2; ++bj) { f32x4 v0, v1;
#pragma unroll
                    for (int i = 0; i < 4; ++i) { v0[i] = (float)acc[ai][bj][m][0][i] * (rs * cs[bj][i]); v1[i] = (float)acc[ai][bj][m][1][i] * (rs * cs[bj][4 + i]); }
                    if (act == 2) {
#pragma unroll
                        for (int i = 0; i < 4; ++i) { v0[i] = gelu_tanh(v0[i]); v1[i] = gelu_tanh(v1[i]); } }
                    else if (act == 3) {
                        u32x2 w8;
                        w8.x = u8x4_floor(sigmoidf_(v0[0]) * 256.f, sigmoidf_(v0[1]) * 256.f, sigmoidf_(v0[2]) * 256.f, sigmoidf_(v0[3]) * 256.f);
                        w8.y = u8x4_floor(sigmoidf_(v1[0]) * 256.f, sigmoidf_(v1[1]) * 256.f, sigmoidf_(v1[2]) * 256.f, sigmoidf_(v1[3]) * 256.f);
                        *(u32x2*)(G8 + (size_t)row * 3072 + (col0 - C_G) + bj * 128) = w8; continue; }
                    u32x4 w; w.x = cvt_pk_bf16(v0[0], v0[1]); w.y = cvt_pk_bf16(v0[2], v0[3]); w.z = cvt_pk_bf16(v1[0], v1[1]); w.w = cvt_pk_bf16(v1[2], v1[3]);
                    *(u32x4*)(rowp + bj * 128) = w; } }
        return true;
    }
};

struct BranchOrder {
    pg8::StaticOrder so;
    __device__ __forceinline__ bool next(int j, pg8::Unit& u) const { const int i = j / 3, br = j - 3 * i; int pm, pn; if (!so.tile(i, pm, pn)) return false; u.pm = br * 256 + pm; u.pn = br * 4 + pn; return true; }
};
struct EpiBranch {
    const unsigned char* G8  ; bf16_t* MERGED;
    __device__ __forceinline__ bool operator()(acc_t& acc, const pg8::Unit& u, int wr, int wc, int fr, int fq) const {
        const int br = u.pn >> 2, pn = u.pn & 3, pm = u.pm & 255;
        const int row0 = pm * 256 + wr * 64 + fr, col0 = pn * 256 + wc * 32 + 8 * fq;
#pragma unroll
        for (int rnd = 0; rnd < 2; ++rnd) { const int ai = rnd, m0 = 0;
            u32x2 gw[4][2], gd[4][2];
#pragma unroll
            for (int m = m0; m < m0 + 4; ++m)
#pragma unroll
                for (int bj = 0; bj < 2; ++bj) { const unsigned char* gp = G8 + (size_t)(row0 + ai * 128 + m * 16) * 3072 + br * 1024 + col0 + bj * 128;
                    gw[m][bj] = *(const u32x2*)gp; if (br != 2) gd[m][bj] = *(const u32x2*)(gp + 1024); }
#pragma unroll
            for (int m = m0; m < m0 + 4; ++m) { const size_t row = (size_t)(row0 + ai * 128 + m * 16);
#pragma unroll
                for (int bj = 0; bj < 2; ++bj) {
                    const u32x2 g = gw[m][bj];
                    float gn[8];
#pragma unroll
                    for (int i = 0; i < 8; ++i) gn[i] = (float)((g[i >> 2] >> (8 * (i & 3))) & 0xffu) + 0.5f;
                    if (br != 2) { const u32x2 d = gd[m][bj];
#pragma unroll
                        for (int i = 0; i < 8; ++i) gn[i] = gn[i] * frcp((float)((d[i >> 2] >> (8 * (i & 3))) & 0xffu) + 0.5f); }
                    else {
#pragma unroll
                        for (int i = 0; i < 8; ++i) gn[i] *= (1.f / 256.f); }
                    f32x4 v0 = acc[ai][bj][m][0], v1 = acc[ai][bj][m][1];
                    v0[0] *= gn[0]; v0[1] *= gn[1]; v0[2] *= gn[2]; v0[3] *= gn[3]; v1[0] *= gn[4]; v1[1] *= gn[5]; v1[2] *= gn[6]; v1[3] *= gn[7];
                    if (br != 2) { acc[ai][bj][m][0] = v0; acc[ai][bj][m][1] = v1; }
                    else { u32x4 w; w.x = cvt_pk_bf16(v0[0], v0[1]); w.y = cvt_pk_bf16(v0[2], v0[3]); w.z = cvt_pk_bf16(v1[0], v1[1]); w.w = cvt_pk_bf16(v1[2], v1[3]);
                        *(u32x4*)(MERGED + row * DM + col0 + bj * 128) = w; } } }
            asm volatile("" ::: "memory");
        }
        return br == 2;
    }
};

struct EpiWout {
    bf16_t* Y; float* SSP;
    __device__ __forceinline__ bool operator()(acc_t& acc, const pg8::Unit& u, int wr, int wc, int fr, int fq) const {
        const int row0 = u.pm * 256 + wr * 64 + fr, col0 = u.pn * 256 + wc * 32 + 8 * fq;
#pragma unroll
        for (int ai = 0; ai < 2; ++ai)
#pragma unroll
            for (int m = 0; m < 4; ++m) { const size_t row = (size_t)(row0 + ai * 128 + m * 16); float ss = 0.f;
#pragma unroll
                for (int bj = 0; bj < 2; ++bj) { const f32x4 v0 = acc[ai][bj][m][0], v1 = acc[ai][bj][m][1];
                    ss += (v0[0] * v0[0] + v0[1] * v0[1]) + (v0[2] * v0[2] + v0[3] * v0[3]) + (v1[0] * v1[0] + v1[1] * v1[1]) + (v1[2] * v1[2] + v1[3] * v1[3]);
                    u32x4 w; w.x = cvt_pk_bf16(v0[0], v0[1]); w.y = cvt_pk_bf16(v0[2], v0[3]); w.z = cvt_pk_bf16(v1[0], v1[1]); w.w = cvt_pk_bf16(v1[2], v1[3]);
                    *(u32x4*)(Y + row * DM + col0 + bj * 128) = w; }
                ss = xor32_add(xor16_add(ss));
                if (fq == 0) SSP[row * 16 + u.pn * 4 + wc] = ss; }
        return true;
    }
};

struct MoeOrder {
    int u0, u1, NB, rt_lo;
    const LAS int* tile_e;
    const LAS int* rowidx;
    __device__ __forceinline__ bool next(int i, pg8::Unit& u) const { const int x = u0 + i; if (x >= u1) return false; const int rt = x / NB, pn = x - rt * NB; u.pm = rt; u.pn = tile_e[rt] * NB + pn; return true; }
    __device__ __forceinline__ int src_row(const pg8::Unit& u, int r) const { return rowidx[(u.pm - rt_lo) * 256 + r]; }
};
struct EpiW1 {
    bf16_t* ACT; const float* b1  ;
    __device__ __forceinline__ bool operator()(acc_t& acc, const pg8::Unit& u, int wr, int wc, int fr, int fq) const {
        const int e = u.pn >> 3, pn = u.pn & 7;
        const int row0 = u.pm * 256 + wr * 64 + fr, j0 = pn * 128 + wc * 32 + 8 * fq;
        const float* bp = b1 + (size_t)e * (2 * FF) + 2 * j0;
        float bg[8], bl[8];
#pragma unroll
        for (int q = 0; q < 4; ++q) { const f32x4 t = *(const f32x4*)(bp + 4 * q); bg[2 * q] = t[0]; bl[2 * q] = t[1]; bg[2 * q + 1] = t[2]; bl[2 * q + 1] = t[3]; }
#pragma unroll
        for (int ai = 0; ai < 2; ++ai)
#pragma unroll
            for (int m = 0; m < 4; ++m) { float a[8];
#pragma unroll
                for (int i = 0; i < 8; ++i) { float gl = acc[ai][0][m][i >> 2][i & 3] + bg[i], li = acc[ai][1][m][i >> 2][i & 3] + bl[i];
                    gl = fminf(gl, 7.f); li = fminf(fmaxf(li, -7.f), 7.f);
                    a[i] = gl * frcp(1.f + fexp2(-1.702f * LOG2E * gl)) * (li + 1.f); }
                u32x4 w; w.x = cvt_pk_bf16(a[0], a[1]); w.y = cvt_pk_bf16(a[2], a[3]); w.z = cvt_pk_bf16(a[4], a[5]); w.w = cvt_pk_bf16(a[6], a[7]);
                *(u32x4*)(ACT + (size_t)(row0 + ai * 128 + m * 16) * FF + j0) = w; }
        return true;
    }
};
constexpr float ACT_SCALE = 12.f / 127.f;
struct EpiW1I8 {
    signed char* ACT  ; const float* b1  ; const float* RS  ; const float* CS  ;
    const LAS int* rowidx; int rt_lo;
    __device__ __forceinline__ bool operator()(acci_t& acc, const pg8::Unit& u, int wr, int wc, int fr, int fq) const {
        const int e = u.pn >> 3, pn = u.pn & 7;
        const int rl0 = wr * 64 + fr, row0 = u.pm * 256 + rl0, j0 = pn * 128 + wc * 32 + 8 * fq;
        const float* bp = b1 + (size_t)e * (2 * FF) + 2 * j0;
        float bg[8], bl[8], cg[8], cl[8];
#pragma unroll
        for (int q = 0; q < 4; ++q) { const f32x4 t = *(const f32x4*)(bp + 4 * q); bg[2 * q] = t[0]; bl[2 * q] = t[1]; bg[2 * q + 1] = t[2]; bl[2 * q + 1] = t[3]; }
        { const float* cp = CS + (size_t)e * 2048 + pn * 256 + wc * 32 + 8 * fq;
          const f32x4 a0 = *(const f32x4*)cp, a1 = *(const f32x4*)(cp + 4), c0 = *(const f32x4*)(cp + 128), c1 = *(const f32x4*)(cp + 132);
#pragma unroll
          for (int i = 0; i < 4; ++i) { cg[i] = a0[i]; cg[4 + i] = a1[i]; cl[i] = c0[i]; cl[4 + i] = c1[i]; } }
        const LAS int* ri = rowidx + (u.pm - rt_lo) * 256 + rl0;
#pragma unroll
        for (int ai = 0; ai < 2; ++ai)
#pragma unroll
            for (int m = 0; m < 4; ++m) { const float rs = RS[ri[ai * 128 + m * 16]]; float a[8];
#pragma unroll
                for (int i = 0; i < 8; ++i) { float gl = (float)acc[ai][0][m][i >> 2][i & 3] * (rs * cg[i]) + bg[i], li = (float)acc[ai][1][m][i >> 2][i & 3] * (rs * cl[i]) + bl[i];
                    gl = fminf(gl, 7.f); li = fminf(fmaxf(li, -7.f), 7.f);
                    a[i] = gl * frcp(1.f + fexp2(-1.702f * LOG2E * gl)) * (li + 1.f); }
                u32x2 w; w.x = q8x4(a[0], a[1], a[2], a[3], 1.f / ACT_SCALE); w.y = q8x4(a[4], a[5], a[6], a[7], 1.f / ACT_SCALE);
                *(u32x2*)(ACT + (size_t)(row0 + ai * 128 + m * 16) * FF + j0) = w; }
        return true;
    }
};
struct EpiW2 {
    bf16_t* Y2; const float* b2  ; const float* CS  ;
    __device__ __forceinline__ bool operator()(acci_t& acc, const pg8::Unit& u, int wr, int wc, int fr, int fq) const {
        const int e = u.pn >> 2, pn = u.pn & 3;
        const int row0 = u.pm * 256 + wr * 64 + fr, col0 = pn * 256 + wc * 32 + 8 * fq;
        f32x4 bv[2][2], cv[2][2];
#pragma unroll
        for (int bj = 0; bj < 2; ++bj)
#pragma unroll
            for (int n = 0; n < 2; ++n) { bv[bj][n] = *(const f32x4*)(b2 + (size_t)e * DM + col0 + bj * 128 + 4 * n); cv[bj][n] = *(const f32x4*)(CS + (size_t)e * DM + col0 + bj * 128 + 4 * n) * ACT_SCALE; }
#pragma unroll
        for (int ai = 0; ai < 2; ++ai)
#pragma unroll
            for (int m = 0; m < 4; ++m) { bf16_t* rowp = Y2 + (size_t)(row0 + ai * 128 + m * 16) * DM + col0;
#pragma unroll
                for (int bj = 0; bj < 2; ++bj) { f32x4 v0, v1;
#pragma unroll
                    for (int i = 0; i < 4; ++i) { v0[i] = (float)acc[ai][bj][m][0][i] * cv[bj][0][i] + bv[bj][0][i]; v1[i] = (float)acc[ai][bj][m][1][i] * cv[bj][1][i] + bv[bj][1][i]; }
                    u32x4 w; w.x = cvt_pk_bf16(v0[0], v0[1]); w.y = cvt_pk_bf16(v0[2], v0[3]); w.z = cvt_pk_bf16(v1[0], v1[1]); w.w = cvt_pk_bf16(v1[2], v1[3]);
                    *(u32x4*)(rowp + bj * 128) = w; } }
        return true;
    }
};
#define XB_TMO      128
#define XB_XCNT(j)  (256  + 64 * (j))
#define XB_XSUB(j)  (1280 + 64 * (j))
#define XB_XGEN(j)  (2304 + 64 * (j))
#define XB_TOP      3328
#define XB_TOPGEN   3392
#define XCD_BAR_WORDS 3456
#define XB_SPIN_CAP (1u << 18)

__device__ __forceinline__ unsigned xb_ld(unsigned* p)              { return __hip_atomic_load(p, __ATOMIC_RELAXED, __HIP_MEMORY_SCOPE_AGENT); }
__device__ __forceinline__ unsigned xb_add(unsigned* p, unsigned v) { return __hip_atomic_fetch_add(p, v, __ATOMIC_RELAXED, __HIP_MEMORY_SCOPE_AGENT); }
__device__ __forceinline__ unsigned xb_xcc_id() { return (unsigned)__builtin_amdgcn_s_getreg((3 << 11) | 20) & 0xFu; }
#define XB_SPIN(cond, bar) do { unsigned _sp = 0; while (cond) { __builtin_amdgcn_s_sleep(1); \
    if ((++_sp & 255u) == 0u) { if (xb_ld(&(bar)[XB_TMO])) break; if (_sp > XB_SPIN_CAP) { atomicAdd(&(bar)[XB_TMO], 1u); break; } } } } while (0)

struct XcdBarrier {
    unsigned* bar; unsigned x;
    int w;
    volatile LAS unsigned* st;
};

__device__ __forceinline__ bool xb_thread0(int w) { return w == 0 && lane_id_volatile(2) == 0; }
__device__ __forceinline__ XcdBarrier xcd_barrier_post(unsigned* bar, volatile LAS unsigned* st, int w) {
    XcdBarrier b; b.bar = bar; b.x = xb_xcc_id(); b.st = st; b.w = w;
    if (xb_thread0(w)) (void)xb_add(&bar[XB_XCNT(b.x)], 1u);
    return b;
}
__device__ __forceinline__ void xcd_barrier_complete(unsigned* bar, unsigned x, unsigned& nloc, unsigned& nx) {
    const unsigned G = gridDim.x * gridDim.y * gridDim.z;
    unsigned sum, cnt, mine, sp = 0u;
    for (;;) {
        sum = 0u; cnt = 0u; mine = 0u;
#pragma unroll
        for (unsigned j = 0; j < 16; ++j) { const unsigned c = xb_ld(&bar[XB_XCNT(j)]); sum += c; cnt += (c > 0u) ? 1u : 0u; mine = (j == x) ? c : mine; }
        if (sum == G) break;
        __builtin_amdgcn_s_sleep(1);
        if ((++sp & 255u) == 0u) { if (xb_ld(&bar[XB_TMO])) break; if (sp > XB_SPIN_CAP) { atomicAdd(&bar[XB_TMO], 1u); break; } }
    }
    nloc = mine > 0u ? mine : 1u; nx = cnt > 0u ? cnt : 1u;
}

__device__ __forceinline__ void xcd_barrier(const XcdBarrier& b) {
    asm volatile("s_waitcnt vmcnt(0)" ::: "memory");
    __syncthreads();
    if (xb_thread0(b.w)) {
        unsigned* bar = b.bar;
        __builtin_amdgcn_s_waitcnt(0);
        unsigned nloc = b.st[0], nx = b.st[1];
        if (nloc == 0u) { xcd_barrier_complete(bar, b.x, nloc, nx); b.st[0] = nloc; b.st[1] = nx; }
        const unsigned old = xb_add(&bar[XB_XSUB(b.x)], 1u);
        const unsigned gen = old / nloc;
        if (old + 1u == (gen + 1u) * nloc) {
            __builtin_amdgcn_fence(__ATOMIC_RELEASE, "agent");
            asm volatile("s_waitcnt vmcnt(0)" ::: "memory");
            const unsigned og = xb_add(&bar[XB_TOP], 1u);
            const unsigned tg = og / nx;
            if (og + 1u == (tg + 1u) * nx) xb_add(&bar[XB_TOPGEN], 1u);
            else XB_SPIN(xb_ld(&bar[XB_TOPGEN]) == tg, bar);
            __builtin_amdgcn_fence(__ATOMIC_ACQUIRE, "agent");
            xb_add(&bar[XB_XGEN(b.x)], 1u);
            asm volatile("s_waitcnt vmcnt(0)" ::: "memory");
        } else {
            XB_SPIN(xb_ld(&bar[XB_XGEN(b.x)]) == gen, bar);
            __builtin_amdgcn_fence(__ATOMIC_ACQUIRE, "agent");
            asm volatile("s_waitcnt vmcnt(0)" ::: "memory");
        }
    }
    __syncthreads();
}

constexpr size_t MiB = 1u << 20;
constexpr size_t WS_CTL = 0, CTL_ZERO_BYTES = 1 * MiB;
constexpr size_t WS_MOD = 1 * MiB;
constexpr size_t WS_SGW = 3 * MiB;
constexpr size_t WS_WRT = 3 * MiB + 512 * 1024;
constexpr size_t WS_RS = 4 * MiB;
constexpr size_t WS_CS1 = 5 * MiB;
constexpr size_t WS_CS2 = 6 * MiB + 512 * 1024;
constexpr size_t WS_CSIN = 6 * MiB;
constexpr size_t WS_W = 8 * MiB, W_LAYER = 209 * MiB;
constexpr size_t WO_WIN = 0, WO_WBR = 12 * MiB, WO_WOUT = 15 * MiB, WO_W1 = 17 * MiB, WO_W2 = 145 * MiB;
constexpr size_t WS_PROJ = 426 * MiB;
constexpr size_t WS_GATES = 810 * MiB;
constexpr size_t WS_ACT = WS_PROJ;
constexpr size_t WS_H = 1194 * MiB;
constexpr size_t WS_O = 1322 * MiB;
constexpr size_t WS_Y = 1514 * MiB;
constexpr size_t WS_BITS = 1770 * MiB;
constexpr size_t WS_Y2 = WS_O;
constexpr size_t WS_SSP = 1850 * MiB;
constexpr size_t WS_ROWTOK = 1854 * MiB;
constexpr size_t WS_TOKINFO = 1862 * MiB;
constexpr size_t WS_SLAB = 1864 * MiB;
constexpr size_t WS_END = 1928 * MiB;
static_assert(WS_Y2 + (size_t)270336 * 2048 <= WS_SSP && WS_W + 2 * W_LAYER <= WS_PROJ && WS_PROJ + (size_t)MTOK * PLD * 2 <= WS_GATES && WS_GATES + (size_t)MTOK * 3072 <= WS_H, "d_ws map");
constexpr int CW_BAR = 4096;
constexpr int CW_CNT = 16384;

constexpr int RING_BYTES = 131072;
constexpr int MISC_OFF = 134144;
constexpr int TS_OFF = MISC_OFF + 512;
constexpr int TILE_E_OFF = MISC_OFF + 1024;
constexpr int ROWIDX_OFF = MISC_OFF + 5632;
constexpr int LDS_BYTES = 151552;
static_assert(ROWIDX_OFF + 8192 <= LDS_BYTES, "LDS map");

struct Args {
    const float* in[21]; float* out; unsigned char* ws; int ph_lo, ph_hi;
};
struct Frame {
    LAS unsigned char* lds; int tid, lane, wave, vcu, G;
};
__device__ __forceinline__ Frame phase_frame(const Frame& F0) { Frame F = F0; int t = F0.wave * 64 + lane_id_volatile(3); asm volatile("" : "+v"(t)); F.tid = t; F.lane = t & 63; F.wave = F0.wave; return F; }
template <class T> __device__ __forceinline__ T* opq(T* p) { long z = 0; asm volatile("" : "+s"(z)); return (T*)((unsigned char*)p + z); }

__device__ __forceinline__ void p0_mod(const Frame& F, const float* c, const float* w_ada, const float* b_ada, float* MOD) {
    LAS float* csT = (LAS float*)F.lds;
    for (int i = F.tid; i < BATCH * DM; i += 512) { const int b = i & 31, k = i >> 5; const float v = c[b * DM + k]; csT[k * 32 + b] = v * sigmoidf_(v); }
    __syncthreads();
    const int gw = F.vcu * 8 + F.wave, NGW = F.G * 8;
    const int cg = F.lane & 15, kq = F.lane >> 4;
    for (int task = gw; task < DEPTH * 384; task += NGW) {
        const int l = task / 384, n = (task % 384) * 16 + cg;
        float acc[32];
#pragma unroll
        for (int b = 0; b < 32; ++b) acc[b] = 0.f;
        const float* w = w_ada + ((size_t)l * DM + kq * 256) * (6 * DM) + n;
#pragma unroll 4
        for (int k = 0; k < 256; ++k) {
            const float wv = w[(size_t)k * (6 * DM)];
            const LAS f32x4* cs = (const LAS f32x4*)(csT + (kq * 256 + k) * 32);
#pragma unroll
            for (int q = 0; q < 8; ++q) { const f32x4 c4 = cs[q]; acc[4 * q] += c4[0] * wv; acc[4 * q + 1] += c4[1] * wv; acc[4 * q + 2] += c4[2] * wv; acc[4 * q + 3] += c4[3] * wv; }
        }
#pragma unroll
        for (int b = 0; b < 32; ++b) { acc[b] = xor32_add(xor16_add(acc[b])); }
        if (kq == 0) { const float bb = b_ada[l * 6 * DM + n];
#pragma unroll
            for (int b = 0; b < 32; ++b) MOD[((size_t)l * BATCH + b) * (6 * DM) + n] = acc[b] + bb; }
    }
    __syncthreads();
}
__device__ __forceinline__ void tr_item(const float* W, size_t ldw, int srccol, bool valid, bf16_t* dst  , int K, LAS float* scr, int lane) {
    const float* wp = W + srccol;
#pragma unroll 8
    for (int i = 0; i < 32; ++i) { const int kk = 2 * i + (lane >> 5); scr[kk * 33 + (lane & 31)] = valid ? wp[(size_t)kk * ldw] : 0.f; }
    LDS_WAIT(); asm volatile("" ::: "memory");
    const int c = lane & 7;
#pragma unroll
    for (int j = 0; j < 4; ++j) { const int n = (lane >> 3) + 8 * j; const LAS float* s = scr + (8 * c) * 33 + n;
        u32x4 o; o.x = cvt_pk_bf16(s[0 * 33], s[1 * 33]); o.y = cvt_pk_bf16(s[2 * 33], s[3 * 33]); o.z = cvt_pk_bf16(s[4 * 33], s[5 * 33]); o.w = cvt_pk_bf16(s[6 * 33], s[7 * 33]);
        *(u32x4*)(dst + (size_t)n * K + 8 * c) = o; }
    LDS_WAIT(); asm volatile("" ::: "memory");
}
__device__ __forceinline__ void p0_weights(const Frame& F, const Args& a) {
    LAS float* scr = (LAS float*)(F.lds + F.wave * 16384);
    const int gw = F.vcu * 8 + F.wave, NGW = F.G * 8, lane = F.lane, jl = lane & 31;
    const float *w_in = a.in[8], *w_branch = a.in[13], *w_out = a.in[14], *w_router = a.in[15], *w1 = a.in[17], *w2 = a.in[19];
    constexpr int I_BR = 3 * 8 * 32, I_OUT = 16 * 32, I_RT = 16;
    constexpr int I_LAYER = I_BR + I_OUT + I_RT;
    for (int it = gw; it < DEPTH * I_LAYER; it += NGW) {
        const int l = it / I_LAYER; int r = it - l * I_LAYER;
        unsigned char* wl = a.ws + WS_W + (size_t)l * W_LAYER;
        if (r < I_BR) {
            const int br = r / 256, q = r % 256, kb = q / 32, nb = q % 32;
            tr_item(w_branch + ((size_t)(l * 3 + br) * 512 + kb * 64) * DM, DM, nb * 32 + jl, true, (bf16_t*)(wl + WO_WBR) + (size_t)(br * 1024 + nb * 32) * 512 + kb * 64, 512, scr, lane); continue; }
        r -= I_BR;
        if (r < I_OUT) {
            const int kb = r / 32, nb = r % 32;
            tr_item(w_out + ((size_t)l * DM + kb * 64) * DM, DM, nb * 32 + jl, true, (bf16_t*)(wl + WO_WOUT) + (size_t)nb * 32 * DM + kb * 64, DM, scr, lane); continue; }
        r -= I_OUT;
        {
            const int kb = r;
            tr_item(w_router + ((size_t)l * DM + kb * 64) * NE, NE, jl, true, (bf16_t*)(a.ws + WS_WRT) + (size_t)l * NE * DM + kb * 64, DM, scr, lane); }
        (void)r;
    }
    __syncthreads();
    {
    LAS float* T = (LAS float*)F.lds; LAS float* red = (LAS float*)(F.lds + ROWIDX_OFF);
    const int half = lane >> 5, wave = F.wave;
    constexpr int ST_W1 = NE * 64, ST_IN = 192, ST_W2 = NE * 32, ST_LAYER = ST_W1 + ST_IN + ST_W2;
    for (int st = F.vcu; st < DEPTH * ST_LAYER; st += F.G) {
        const int l = st / ST_LAYER, q = st % ST_LAYER;
        const float* wp; size_t ldw; bool valid = true; signed char* dst; float* csp;
        if (q < ST_W1) { const int e = q / 64, r6 = q % 64, pn = r6 >> 3, jjg = (r6 >> 1) & 3, sgl = r6 & 1, nb = pn * 8 + sgl * 4 + jjg, n = nb * 32 + jl, src = 2 * (128 * pn + jjg * 32 + jl) + sgl;
            wp = w1 + ((size_t)(l * NE + e) * DM) * (2 * FF) + src; ldw = 2 * FF;
            dst = (signed char*)(a.ws + WS_W + (size_t)l * W_LAYER + WO_W1) + ((size_t)e * 2048 + nb * 32) * DM; csp = (float*)(a.ws + WS_CS1) + ((size_t)l * NE + e) * 2048 + n; }
        else if (q >= ST_W1 + ST_IN) { const int q2 = q - ST_W1 - ST_IN, e = q2 / 32, nb = q2 % 32, n = nb * 32 + jl;
            wp = w2 + ((size_t)(l * NE + e) * FF) * DM + n; ldw = DM;
            dst = (signed char*)(a.ws + WS_W + (size_t)l * W_LAYER + WO_W2) + ((size_t)e * DM + nb * 32) * FF; csp = (float*)(a.ws + WS_CS2) + ((size_t)l * NE + e) * DM + n; }
        else { const int nb = q - ST_W1, n = nb * 32 + jl; valid = (n < 1832) || (n >= 2048); const int src = n < 1832 ? n : n - 216;
            wp = w_in + (size_t)l * DM * 5928 + (valid ? src : 0); ldw = 5928;
            dst = (signed char*)(a.ws + WS_W + (size_t)l * W_LAYER + WO_WIN) + (size_t)nb * 32 * DM; csp = (float*)(a.ws + WS_CSIN) + (size_t)l * NPROJ + n; }
        float am = 0.f;
#pragma unroll
        for (int ib = 0; ib < 2; ++ib) { float vv[32];
#pragma unroll
            for (int i = 0; i < 32; ++i) { const int k = wave * 128 + 2 * (ib * 32 + i) + half; vv[i] = valid ? __builtin_nontemporal_load(wp + (size_t)k * ldw) : 0.f; }
#pragma unroll
            for (int i = 0; i < 32; ++i) { const int k = wave * 128 + 2 * (ib * 32 + i) + half; am = fmaxf(am, fabsf(vv[i])); T[k * 32 + (jl ^ (k & 31))] = vv[i]; } }
        red[(wave * 2 + half) * 32 + jl] = am;
        __syncthreads();
        float amx = 0.f;
#pragma unroll
        for (int p = 0; p < 16; ++p) amx = fmaxf(amx, red[p * 32 + jl]);
        const float scale = valid ? fmaxf(amx, 1e-30f) * (1.f / 127.f) : 1.f, inv = valid ? 1.f / scale : 0.f;
        if (wave == 0 && half == 0) *csp = scale;
        const int k0 = 64 * (wave * 2 + half);
#pragma unroll
        for (int c16 = 0; c16 < 4; ++c16) { unsigned wq[4];
#pragma unroll
            for (int d4 = 0; d4 < 4; ++d4) { const int k = k0 + c16 * 16 + d4 * 4;
                wq[d4] = q8x4(T[k * 32 + (jl ^ (k & 31))], T[(k + 1) * 32 + (jl ^ ((k + 1) & 31))], T[(k + 2) * 32 + (jl ^ ((k + 2) & 31))], T[(k + 3) * 32 + (jl ^ ((k + 3) & 31))], inv); }
            *(u32x4*)(dst + (size_t)jl * DM + k0 + c16 * 16) = (u32x4){wq[0], wq[1], wq[2], wq[3]}; }
        __syncthreads();
    }
    }
    const float* sg_w = a.in[10]; bf16_t* SGW = (bf16_t*)(a.ws + WS_SGW);
    for (int i = (F.vcu * 512 + F.tid) * 2; i < DEPTH * 8 * 128 * 128; i += F.G * 512 * 2) { const int s = i & 127, t = (i >> 7) & 127; const f32x2 v = *(const f32x2*)(sg_w + i);
        *(unsigned*)(SGW + i) = cvt_pk_bf16(s <= t ? v[0] : 0.f, (s + 1) <= t ? v[1] : 0.f); }
}

__device__ __forceinline__ void norm_mod_row(const f32x4 (&v)[4], float ss, const float* g, const float* sc, const float* sh, signed char* orow, float* rs, int lane) {
    const float rstd = 1.f / sqrtf(ss * (1.f / DM) + RMS_EPS);
    f32x4 o[4]; float am = 0.f;
#pragma unroll
    for (int j = 0; j < 4; ++j) { const int c = 4 * lane + 256 * j; const f32x4 gg = *(const f32x4*)(g + c), s1 = *(const f32x4*)(sc + c), s0 = *(const f32x4*)(sh + c);
        o[j] = (v[j] * rstd) * gg * (s1 + 1.f) + s0;
        am = fmaxf(am, fmaxf(fmaxf(fabsf(o[j][0]), fabsf(o[j][1])), fmaxf(fabsf(o[j][2]), fabsf(o[j][3])))); }
    am = wave_max(am);
    const float scale = fmaxf(am, 1e-30f) * (1.f / 127.f), inv = 1.f / scale;
    if (lane == 0) *rs = scale;
#pragma unroll
    for (int j = 0; j < 4; ++j) *(unsigned*)(orow + 4 * lane + 256 * j) = q8x4(o[j][0], o[j][1], o[j][2], o[j][3], inv);
}
__device__ __forceinline__ void p1_norm(const Frame& F, const float* x, const float* g, const float* MOD0, signed char* H8, float* RS) {
    const int gw = F.vcu * 8 + F.wave, NGW = F.G * 8;
    for (int row0 = gw * 4; row0 < MTOK; row0 += NGW * 4) { f32x4 v[4][4];
#pragma unroll
        for (int rr = 0; rr < 4; ++rr)
#pragma unroll
            for (int j = 0; j < 4; ++j) v[rr][j] = __builtin_nontemporal_load((const f32x4*)(x + (size_t)(row0 + rr) * DM + 4 * F.lane + 256 * j));
#pragma unroll
        for (int rr = 0; rr < 4; ++rr) { const int row = row0 + rr, b = row >> 11; float ss = 0.f;
#pragma unroll
            for (int j = 0; j < 4; ++j) ss += (v[rr][j][0] * v[rr][j][0] + v[rr][j][1] * v[rr][j][1]) + (v[rr][j][2] * v[rr][j][2] + v[rr][j][3] * v[rr][j][3]);
            ss = wave_sum(ss);
            const float* mb = MOD0 + (size_t)b * 6 * DM;
            norm_mod_row(v[rr], ss, g, mb + DM, mb, H8 + (size_t)row * DM, RS + row, F.lane); } }
}
constexpr int TOPK_SEL = 256;
struct IdxOps { bf16x8 af[4][2]; u32x4 wraw[4][2]; bf16x8 kf[4][2]; };
__device__ __forceinline__ void dsa_index_load(IdxOps& P, const bf16_t* __restrict__ PROJ, int b, int qg, int lane, int wid) {
    asm volatile("" : "+v"(lane));
    const int n = lane & 31, hi = lane >> 5;
    const int q0 = qg * 16;
    const size_t tokbase = (size_t)b * SEQ;
    const int m = n, hm = (m >> 2) & 1, idx = (m & 3) + 4 * (m >> 3), aq = 2 * hm + (idx >> 3), ah = idx & 7;
#pragma unroll
    for (int qgp = 0; qgp < 4; ++qgp) { const bf16_t* qp = PROJ + (tokbase + q0 + 4 * qgp + aq) * PLD + C_QI + ah * 32 + 8 * hi;
        P.af[qgp][0] = *(const bf16x8*)qp; P.af[qgp][1] = *(const bf16x8*)(qp + 16); }
}
__device__ __forceinline__ void dsa_index_load_k(IdxOps& P, const bf16_t* __restrict__ PROJ, int b, int qg, int lane, int wid) {
    asm volatile("" : "+v"(lane));
    const int n = lane & 31, hi = lane >> 5;
    const int q0 = qg * 16, nkb = (q0 + 16 + 31) >> 5;
    const size_t tokbase = (size_t)b * SEQ;
#pragma unroll
    for (int qgp = 0; qgp < 4; ++qgp)
#pragma unroll
        for (int qq = 0; qq < 2; ++qq) P.wraw[qgp][qq] = *(const u32x4*)(PROJ + (tokbase + q0 + 4 * qgp + 2 * hi + qq) * PLD + C_WI);
#pragma unroll
    for (int i = 0; i < 4; ++i) { const int kb = wid + 8 * i;
        if (kb < nkb) { const bf16_t* kp = PROJ + (tokbase + 32 * kb + n) * PLD + C_KI + 8 * hi; P.kf[i][0] = *(const bf16x8*)kp; P.kf[i][1] = *(const bf16x8*)(kp + 16); } }
}
__device__ __forceinline__ void dsa_index_scores(IdxOps& P, const bf16_t* __restrict__ PROJ, LAS float* sc, int b, int qg, int lane, int wid) {
    const int n = lane & 31, hi = lane >> 5;
    const int q0 = qg * 16, nkb = (q0 + 16 + 31) >> 5;
    const size_t tokbase = (size_t)b * SEQ;
    LAS float* scw = sc + (2 * hi) * 2048 + 32 * wid + n;
    float wv[4][16];
#pragma unroll
    for (int qgp = 0; qgp < 4; ++qgp)
#pragma unroll
        for (int qq = 0; qq < 2; ++qq) { const u32x4 w = P.wraw[qgp][qq];
            wv[qgp][8 * qq + 0] = bf_lo(w.x) * 0.0625f; wv[qgp][8 * qq + 1] = bf_hi(w.x) * 0.0625f; wv[qgp][8 * qq + 2] = bf_lo(w.y) * 0.0625f; wv[qgp][8 * qq + 3] = bf_hi(w.y) * 0.0625f;
            wv[qgp][8 * qq + 4] = bf_lo(w.z) * 0.0625f; wv[qgp][8 * qq + 5] = bf_hi(w.z) * 0.0625f; wv[qgp][8 * qq + 6] = bf_lo(w.w) * 0.0625f; wv[qgp][8 * qq + 7] = bf_hi(w.w) * 0.0625f; }
#pragma unroll
    for (int i = 0; i < 8; ++i) { const int kb = wid + 8 * i;
        if (kb < nkb) {
            const bf16x8 k0 = P.kf[i & 3][0], k1 = P.kf[i & 3][1];
            if (i < 4 && kb + 32 < nkb) { const bf16_t* kp = PROJ + (tokbase + 32 * (kb + 32) + n) * PLD + C_KI + 8 * hi; P.kf[i & 3][0] = *(const bf16x8*)kp; P.kf[i & 3][1] = *(const bf16x8*)(kp + 16); }
#pragma unroll
            for (int qgp = 0; qgp < 4; ++qgp) {
                f32x16 d = {0.f, 0.f, 0.f, 0.f, 0.f, 0.f, 0.f, 0.f, 0.f, 0.f, 0.f, 0.f, 0.f, 0.f, 0.f, 0.f};
                d = __builtin_amdgcn_mfma_f32_32x32x16_bf16(P.af[qgp][0], k0, d, 0, 0, 0);
                d = __builtin_amdgcn_mfma_f32_32x32x16_bf16(P.af[qgp][1], k1, d, 0, 0, 0);
                float sa = 0.f, sb = 0.f;
#pragma unroll
                for (int r = 0; r < 8; ++r) { sa += wv[qgp][r] * fmaxf(d[r], 0.f); sb += wv[qgp][8 + r] * fmaxf(d[8 + r], 0.f); }
                scw[(4 * qgp) * 2048 + 256 * i] = sa; scw[(4 * qgp + 1) * 2048 + 256 * i] = sb;
            } } }
}
__device__ __forceinline__ void bit_transpose32(unsigned (&a)[32]) {
#pragma unroll
    for (int k = 0; k < 16; ++k) { const unsigned lo = a[k], hi = a[k + 16];
        a[k] = __builtin_amdgcn_perm(hi, lo, 0x05040100u); a[k + 16] = __builtin_amdgcn_perm(hi, lo, 0x07060302u); }
#pragma unroll
    for (int k = 0; k < 32; ++k) if ((k & 8) == 0) { const unsigned lo = a[k], hi = a[k + 8];
        a[k] = __builtin_amdgcn_perm(hi, lo, 0x06020400u); a[k + 8] = __builtin_amdgcn_perm(hi, lo, 0x07030501u); }
#pragma unroll
    for (int s = 0; s < 3; ++s) { const int j = 4 >> s; const unsigned m = (s == 0) ? 0x0F0F0F0Fu : (s == 1) ? 0x33333333u : 0x55555555u;
#pragma unroll
        for (int k = 0; k < 32; ++k) if ((k & j) == 0) { const unsigned lo = a[k], hi = a[k + j];
            a[k] = (m & lo) | (~m & (hi << j)); a[k + j] = (m & (lo >> j)) | (~m & hi); } }
}
__device__ __forceinline__ void dsa_index_select(LAS float* sc, LAS int* qctr, unsigned long long* __restrict__ bits64, int b, int qg, int lane, int wid) {
    const int q0 = qg * 16;
    const size_t tokbase = (size_t)b * SEQ;
#pragma unroll 1
    for (;;) {
        int qn = 0; if (lane == 0) qn = __hip_atomic_fetch_add(qctr, 1, __ATOMIC_RELAXED, __HIP_MEMORY_SCOPE_WORKGROUP);
        qn = __builtin_amdgcn_readfirstlane(qn); if (qn >= 16) break;
        const int ql = 15 - qn, pos = q0 + ql, nn = pos + 1, nr = (nn + 63) >> 6;
        const LAS float* scq = sc + ql * 2048;
        unsigned mlo = 0u, mhi = 0u;
        if (nn <= TOPK_SEL) {
#pragma unroll
            for (int r = 0; r < 4; ++r) if (r < nr) { const unsigned long long bal = __ballot(64 * r + lane <= pos); asm volatile("s_nop 4\n\tv_writelane_b32 %0, %2, %4\n\tv_writelane_b32 %1, %3, %4" : "+v"(mlo), "+v"(mhi) : "s"((unsigned)bal), "s"((unsigned)(bal >> 32)), "n"(r));     }
        } else {
            unsigned u[32];
#pragma unroll
            for (int r = 0; r < 32; ++r) { u[r] = 0u;
                if (r < nr) { const int j = 64 * r + lane; float s = scq[j]; s = (s == 0.f) ? 0.f : s; const unsigned bts = __builtin_bit_cast(unsigned, s);
                    const unsigned uu = (bts & 0x80000000u) ? ~bts : (bts | 0x80000000u); u[r] = (j <= pos) ? uu : 0u; } }
            unsigned M = 0u;
#pragma unroll
            for (int r = 0; r < 32; ++r) M |= (r < nr && 64 * r + lane <= pos) ? (1u << r) : 0u;
            bit_transpose32(u);
            unsigned G = 0u; unsigned need = (unsigned)TOPK_SEL, cM = (unsigned)nn; bool done = false;
#pragma unroll
            for (int bq = 31; bq >= 0; --bq) {
                if (!done) {
                    const unsigned T = M & u[bq];
                    const unsigned c = wave_sum_u32((unsigned)__builtin_popcount(T));
                    if (c >= need) { M = T; cM = c; } else { G |= T; need -= c; M &= ~u[bq]; cM -= c; }
                    if (cM == need) { G |= M; done = true; }
                }
            }
            if (!done) {
                unsigned run = 0u;
#pragma unroll
                for (int r = 0; r < 32; ++r) if (r < nr) { const bool isc = (M >> r) & 1u; const unsigned long long eqm = __ballot(isc);
                    const unsigned pre = run + __builtin_amdgcn_mbcnt_hi((unsigned)(eqm >> 32), __builtin_amdgcn_mbcnt_lo((unsigned)eqm, 0u));
                    if (isc && pre < need) G |= (1u << r);
                    run += (unsigned)__builtin_popcountll(eqm); }
            }
#pragma unroll
            for (int r = 0; r < 32; ++r) if (r < nr) { const unsigned long long bal = __ballot((G >> r) & 1u); asm volatile("s_nop 4\n\tv_writelane_b32 %0, %2, %4\n\tv_writelane_b32 %1, %3, %4" : "+v"(mlo), "+v"(mhi) : "s"((unsigned)bal), "s"((unsigned)(bal >> 32)), "n"(r));     }
        }
        if (lane < nr) bits64[(tokbase + pos) * 32 + lane] = ((unsigned long long)mhi << 32) | mlo;
    }
}
__device__ __forceinline__ void dsa_index_phase(const Frame& F, const bf16_t* __restrict__ PROJ, unsigned long long* __restrict__ bits64, unsigned* stampw) {
    LAS float* sc = (LAS float*)F.lds;
    LAS int* qctr = (LAS int*)(F.lds + TS_OFF);
    IdxOps P;
    int u = F.vcu;
    if (u < 4096) { dsa_index_load(P, PROJ, u & 31, u >> 5, F.lane, F.wave); dsa_index_load_k(P, PROJ, u & 31, u >> 5, F.lane, F.wave); }
#ifdef T_STAMP
    unsigned long long tA = 0, tB = 0, tC = 0, tD = 0, t0 = __builtin_amdgcn_s_memrealtime(), t1;
#define STAMP(acc) do { t1 = __builtin_amdgcn_s_memrealtime(); acc += t1 - t0; t0 = t1; } while (0)
#else
#define STAMP(acc) do { } while (0)
#endif
#pragma unroll 1
    for (; u < 4096; u += F.G) {
        dsa_index_scores(P, PROJ, sc, u & 31, u >> 5, F.lane, F.wave);
        if (F.tid == 0) *qctr = 0;
        STAMP(tA);
        __syncthreads();
        STAMP(tB);
        const int un = u + F.G;
        dsa_index_select(sc, qctr, bits64, u & 31, u >> 5, F.lane, F.wave);
        asm volatile("" ::: "memory");
        if (un < 4096) { dsa_index_load(P, PROJ, un & 31, un >> 5, F.lane, F.wave); dsa_index_load_k(P, PROJ, un & 31, un >> 5, F.lane, F.wave); }
        STAMP(tC);
        __syncthreads();
        STAMP(tD);
    }
#ifdef T_STAMP
    if (stampw && blockIdx.x == 17 && F.tid == 0) { const unsigned long long tot = tA + tB + tC + tD; const unsigned long long part = (T_STAMP == 0) ? tA : (T_STAMP == 1) ? tB : (T_STAMP == 2) ? tC : tD;
        *stampw = (unsigned)((part * 64ull) / (tot ? tot : 1ull)); }
#endif
#undef STAMP
}

constexpr int KS = 144, VS = 192;
#ifndef USE_TR
#define USE_TR 1
#endif
template <int MODE>
__device__ __forceinline__ void attn_unit(const Frame& F, const bf16_t* __restrict__ PROJ, bf16_t* __restrict__ O, const unsigned* __restrict__ bits, const float* __restrict__ sinks, int b, int g, int qb) {
    const int tid = F.tid, lane = F.lane, wid = F.wave, n = lane & 31, hi = lane >> 5;
    constexpr int CQ = MODE ? C_QB : C_QA, CK = MODE ? C_KB : C_KA, CV = MODE ? C_VB : C_VA;
    const int hq = 4 * g + (wid >> 1), qpos = qb * 64 + 32 * (wid & 1) + n;
    const size_t tokbase = (size_t)b * SEQ;
    LAS unsigned char* Ks = F.lds; LAS unsigned char* Vs = F.lds + 64 * KS;
    bf16x8 qf[4];
    { const bf16_t* qp = PROJ + (tokbase + qpos) * PLD + CQ + hq * 64 + 8 * hi;
#pragma unroll
      for (int s = 0; s < 4; ++s) qf[s] = *(const bf16x8*)(qp + 16 * s); }
    f32x16 o0, o1;
#pragma unroll
    for (int r = 0; r < 16; ++r) { o0[r] = 0.f; o1[r] = 0.f; }
    float mrun, lsum;
    if (MODE == 0) { mrun = sinks[hq] * LOG2E; lsum = (hi == 0) ? 1.f : 0.f; } else { mrun = -1e30f; lsum = 0.f; }
    const int kt_lo = (MODE == 0) ? (qb >= 2 ? qb - 2 : 0) : 0, kt_hi = qb;
    const int srow = tid >> 3, sch = tid & 7;
    const bf16_t* kg = PROJ + (tokbase + srow) * PLD + CK + g * 64 + sch * 8;
    const bf16_t* vg = PROJ + (tokbase + srow) * PLD + CV + g * 64 + sch * 8;
    const unsigned* bp = bits + (tokbase + qpos) * 64;
    u32x4 kreg = *(const u32x4*)(kg + (size_t)kt_lo * 64 * PLD), vreg = *(const u32x4*)(vg + (size_t)kt_lo * 64 * PLD);
    u32x2 mreg = {0u, 0u};
    if (MODE == 1) mreg = *(const u32x2*)(bp + 2 * kt_lo);
    const int vbase = (4 * hi + ((lane & 15) >> 2)) * VS + (16 * ((lane >> 4) & 1) + 4 * (lane & 3)) * 2;
    for (int kt = kt_lo; kt <= kt_hi; ++kt) {
        __syncthreads();
        *(LAS u32x4*)(Ks + srow * KS + sch * 16) = kreg; *(LAS u32x4*)(Vs + srow * VS + sch * 16) = vreg;
        const u32x2 mcur = mreg;
        __syncthreads();
        if (kt < kt_hi) { kreg = *(const u32x4*)(kg + (size_t)(kt + 1) * 64 * PLD); vreg = *(const u32x4*)(vg + (size_t)(kt + 1) * 64 * PLD); if (MODE == 1) mreg = *(const u32x2*)(bp + 2 * (kt + 1)); }
        f32x16 p0, p1;
#pragma unroll
        for (int r = 0; r < 16; ++r) { p0[r] = 0.f; p1[r] = 0.f; }
#pragma unroll
        for (int s = 0; s < 4; ++s) { const bf16x8 k0 = *(const LAS bf16x8*)(Ks + n * KS + (16 * s + 8 * hi) * 2), k1 = *(const LAS bf16x8*)(Ks + (n + 32) * KS + (16 * s + 8 * hi) * 2);
            p0 = __builtin_amdgcn_mfma_f32_32x32x16_bf16(k0, qf[s], p0, 0, 0, 0); p1 = __builtin_amdgcn_mfma_f32_32x32x16_bf16(k1, qf[s], p1, 0, 0, 0); }
        unsigned w0, w1;
        if (MODE == 1) { w0 = mcur.x >> (4 * hi); w1 = mcur.y >> (4 * hi); }
        else {
#pragma unroll
            for (int blk = 0; blk < 2; ++blk) { const int d0 = qpos - (kt * 64 + 32 * blk); unsigned mk = 0u;
                if (d0 >= 0) { const int hb = d0 > 31 ? 31 : d0; int lo = d0 - 127; if (lo <= 31) { if (lo < 0) lo = 0; mk = (0xFFFFFFFFu >> (31 - hb)) & (0xFFFFFFFFu << lo); } }
                if (blk == 0) w0 = mk >> (4 * hi); else w1 = mk >> (4 * hi); }
        }
        float mx = fmaxf(fmaxf(p0[0], p0[1]), fmaxf(p1[0], p1[1]));
#pragma unroll
        for (int r = 2; r < 16; r += 2) mx = fmaxf(mx, fmaxf(fmaxf(p0[r], p0[r + 1]), fmaxf(p1[r], p1[r + 1])));
        mx = xor32_max(mx);
        const float mnew = fmaxf(mrun, mx), alpha = fexp2(mrun - mnew); mrun = mnew;
        float ps = 0.f;
#pragma unroll
        for (int r = 0; r < 16; ++r) { const int bitpos = 8 * (r >> 2) + (r & 3);
            const float e0 = fexp2(p0[r] - mnew), e1 = fexp2(p1[r] - mnew);
            p0[r] = __builtin_bit_cast(float, __builtin_bit_cast(unsigned, e0) & (unsigned)__builtin_amdgcn_sbfe((int)w0, bitpos, 1));
            p1[r] = __builtin_bit_cast(float, __builtin_bit_cast(unsigned, e1) & (unsigned)__builtin_amdgcn_sbfe((int)w1, bitpos, 1));
            ps += p0[r] + p1[r]; }
        lsum = lsum * alpha + ps;
        if (__builtin_amdgcn_ballot_w64(alpha != 1.f) != 0ull) {
#pragma unroll
            for (int r = 0; r < 16; ++r) { o0[r] *= alpha; o1[r] *= alpha; } }
        bf16x8 pf[2][2];
#pragma unroll
        for (int s2 = 0; s2 < 2; ++s2) { u32x4 a, c;
            a.x = cvt_pk_bf16(p0[8 * s2 + 0], p0[8 * s2 + 1]); a.y = cvt_pk_bf16(p0[8 * s2 + 2], p0[8 * s2 + 3]); a.z = cvt_pk_bf16(p0[8 * s2 + 4], p0[8 * s2 + 5]); a.w = cvt_pk_bf16(p0[8 * s2 + 6], p0[8 * s2 + 7]);
            c.x = cvt_pk_bf16(p1[8 * s2 + 0], p1[8 * s2 + 1]); c.y = cvt_pk_bf16(p1[8 * s2 + 2], p1[8 * s2 + 3]); c.z = cvt_pk_bf16(p1[8 * s2 + 4], p1[8 * s2 + 5]); c.w = cvt_pk_bf16(p1[8 * s2 + 6], p1[8 * s2 + 7]);
            pf[0][s2] = __builtin_bit_cast(bf16x8, a); pf[1][s2] = __builtin_bit_cast(bf16x8, c); }
#pragma unroll
        for (int db = 0; db < 2; ++db)
#pragma unroll
            for (int blk = 0; blk < 2; ++blk)
#pragma unroll
                for (int s2 = 0; s2 < 2; ++s2) {
                    bf16x8 vf;
#if USE_TR
                    const v4i16_t t0 = __builtin_amdgcn_ds_read_tr16_b64_v4i16((LAS v4i16_t*)(Vs + vbase + (32 * blk + 16 * s2) * VS + 64 * db));
                    const v4i16_t t1 = __builtin_amdgcn_ds_read_tr16_b64_v4i16((LAS v4i16_t*)(Vs + vbase + (32 * blk + 16 * s2 + 8) * VS + 64 * db));
                    vf = (bf16x8){t0[0], t0[1], t0[2], t0[3], t1[0], t1[1], t1[2], t1[3]};
#else
#pragma unroll
                    for (int j = 0; j < 8; ++j) vf[j] = *(const LAS short*)(Vs + (32 * blk + 16 * s2 + 8 * (j >> 2) + 4 * hi + (j & 3)) * VS + (32 * db + n) * 2);
#endif
                    if (db == 0) o0 = __builtin_amdgcn_mfma_f32_32x32x16_bf16(vf, pf[blk][s2], o0, 0, 0, 0); else o1 = __builtin_amdgcn_mfma_f32_32x32x16_bf16(vf, pf[blk][s2], o1, 0, 0, 0);
                }
    }
    const float lt = xor32_add(lsum), inv = 1.f / lt;
    bf16_t* op = O + (tokbase + qpos) * 512 + hq * 64 + 8 * hi;
#pragma unroll
    for (int db = 0; db < 2; ++db)
#pragma unroll
        for (int kp = 0; kp < 2; ++kp) { const int r0 = 8 * kp;
            unsigned ax, ay, bx, by;
            if (db == 0) { ax = cvt_pk_bf16(o0[r0] * inv, o0[r0 + 1] * inv); ay = cvt_pk_bf16(o0[r0 + 2] * inv, o0[r0 + 3] * inv); bx = cvt_pk_bf16(o0[r0 + 4] * inv, o0[r0 + 5] * inv); by = cvt_pk_bf16(o0[r0 + 6] * inv, o0[r0 + 7] * inv); }
            else { ax = cvt_pk_bf16(o1[r0] * inv, o1[r0 + 1] * inv); ay = cvt_pk_bf16(o1[r0 + 2] * inv, o1[r0 + 3] * inv); bx = cvt_pk_bf16(o1[r0 + 4] * inv, o1[r0 + 5] * inv); by = cvt_pk_bf16(o1[r0 + 6] * inv, o1[r0 + 7] * inv); }
            { auto r = __builtin_amdgcn_permlane32_swap(ax, bx, false, false); ax = r[0]; bx = r[1]; }
            { auto r = __builtin_amdgcn_permlane32_swap(ay, by, false, false); ay = r[0]; by = r[1]; }
            *(u32x4*)(op + 32 * db + 16 * kp) = (u32x4){ax, ay, bx, by}; }
}

constexpr int SGS = 1040;
static_assert(128 * SGS <= MISC_OFF, "spatial-gating tile vs LDS control words");
__device__ __forceinline__ void sg_unit(const Frame& F, const bf16_t* __restrict__ PROJ, const bf16_t* __restrict__ SGWl, const float* __restrict__ sgb, const float* __restrict__ lng, bf16_t* __restrict__ OC, int b, int ch) {
    const int lane = F.lane, wid = F.wave, n = lane & 31, hi = lane >> 5;
    const size_t tok0 = (size_t)b * SEQ + ch * 128;
    LAS unsigned char* V = F.lds;
    __syncthreads();
    float gl[8];
    { const f32x4 g0 = *(const f32x4*)(lng + 8 * lane), g1 = *(const f32x4*)(lng + 8 * lane + 4); gl[0] = g0[0]; gl[1] = g0[1]; gl[2] = g0[2]; gl[3] = g0[3]; gl[4] = g1[0]; gl[5] = g1[1]; gl[6] = g1[2]; gl[7] = g1[3]; }
    u32x4 wrow16[16];
#pragma unroll
    for (int rr = 0; rr < 16; ++rr) wrow16[rr] = *(const u32x4*)(PROJ + (tok0 + 16 * wid + rr) * PLD + C_V + 8 * lane);
#pragma unroll
    for (int rr = 0; rr < 16; ++rr) { const int row = 16 * wid + rr;
        const u32x4 w = wrow16[rr];
        float x[8] = {bf_lo(w.x), bf_hi(w.x), bf_lo(w.y), bf_hi(w.y), bf_lo(w.z), bf_hi(w.z), bf_lo(w.w), bf_hi(w.w)};
        float s = 0.f;
#pragma unroll
        for (int i = 0; i < 8; ++i) s += x[i];
        const float mean = wave_sum(s) * (1.f / 512.f); float q = 0.f;
#pragma unroll
        for (int i = 0; i < 8; ++i) { x[i] -= mean; q += x[i] * x[i]; }
        const float rstd = 1.f / sqrtf(wave_sum(q) * (1.f / 512.f) + LN_EPS);
        u32x4 o; o.x = cvt_pk_bf16(x[0] * rstd * gl[0], x[1] * rstd * gl[1]); o.y = cvt_pk_bf16(x[2] * rstd * gl[2], x[3] * rstd * gl[3]);
        o.z = cvt_pk_bf16(x[4] * rstd * gl[4], x[5] * rstd * gl[5]); o.w = cvt_pk_bf16(x[6] * rstd * gl[6], x[7] * rstd * gl[7]);
        *(LAS u32x4*)(V + row * SGS + 16 * lane) = o; }
    __syncthreads();
    const int g = wid;
    const int vbase = (8 * hi + ((lane & 15) >> 2)) * SGS + (g * 64 + 16 * ((lane >> 4) & 1) + 4 * (lane & 3)) * 2;
    const bf16_t* wg = SGWl + (size_t)g * 128 * 128;
#pragma unroll 1
    for (int tb = 0; tb < 4; ++tb) {
        f32x16 a0, a1;
#pragma unroll
        for (int r = 0; r < 16; ++r) { a0[r] = 0.f; a1[r] = 0.f; }
        const bf16_t* wrow = wg + (size_t)(32 * tb + n) * 128 + 8 * hi;
        bf16x8 afr[8];
#pragma unroll
        for (int ks = 0; ks < 8; ++ks) if (ks < 2 * tb + 2) afr[ks] = *(const bf16x8*)(wrow + 16 * ks);
#pragma unroll
        for (int ks = 0; ks < 8; ++ks) if (ks < 2 * tb + 2) {
            const bf16x8 af = afr[ks];
#pragma unroll
            for (int db = 0; db < 2; ++db) { bf16x8 vf;
#if USE_TR
                const v4i16_t t0 = __builtin_amdgcn_ds_read_tr16_b64_v4i16((LAS v4i16_t*)(V + vbase + (16 * ks) * SGS + 64 * db));
                const v4i16_t t1 = __builtin_amdgcn_ds_read_tr16_b64_v4i16((LAS v4i16_t*)(V + vbase + (16 * ks + 4) * SGS + 64 * db));
                vf = (bf16x8){t0[0], t0[1], t0[2], t0[3], t1[0], t1[1], t1[2], t1[3]};
#else
#pragma unroll
                for (int j = 0; j < 8; ++j) vf[j] = *(const LAS short*)(V + (16 * ks + 8 * hi + j) * SGS + (g * 64 + 32 * db + n) * 2);
#endif
                if (db == 0) a0 = __builtin_amdgcn_mfma_f32_32x32x16_bf16(af, vf, a0, 0, 0, 0); else a1 = __builtin_amdgcn_mfma_f32_32x32x16_bf16(af, vf, a1, 0, 0, 0); }
        }
#pragma unroll
        for (int r = 0; r < 16; ++r) { const int t = 32 * tb + 8 * (r >> 2) + 4 * hi + (r & 3); const float bb = sgb[g * 128 + t];
            const bf16_t* up = PROJ + (tok0 + t) * PLD + C_U + g * 64 + n; bf16_t* op = OC + (tok0 + t) * 512 + g * 64 + n;
            const float u0 = __builtin_bit_cast(float, (unsigned)up[0] << 16), u1 = __builtin_bit_cast(float, (unsigned)up[32] << 16);
            op[0] = (bf16_t)f2bf((a0[r] + bb) * u0); op[32] = (bf16_t)f2bf((a1[r] + bb) * u1); }
    }
}
constexpr int HS_STRIDE = 2064;
constexpr int P7_PART = 32 * HS_STRIDE;
constexpr int P7_LOG = P7_PART + 8 * 4096;
constexpr int P7_HIST = P7_LOG + 32 * 33 * 4;
__device__ __forceinline__ void p7_route(const Frame& F, const Args& a, int l, const float* xin, float* xout, const bf16_t* Y, const float* SSP, const float* MODl, signed char* H8, float* RS,
                                         const bf16_t* WRTl, unsigned* cnt, int* ROWTOK, unsigned* TOKINFO) {
    const int tid = F.tid, lane = F.lane, wid = F.wave, n = lane & 31, hi = lane >> 5;
    const float* g_post = a.in[5] + l * DM; const float* g_pre = a.in[6] + l * DM; const float* b_router = a.in[16] + l * NE;
    LAS unsigned char* hs = F.lds; LAS float* part = (LAS float*)(F.lds + P7_PART); LAS float* lg = (LAS float*)(F.lds + P7_LOG); LAS int* hist = (LAS int*)(F.lds + P7_HIST); LAS int* base = hist + 32;
    if (tid < 32) hist[tid] = 0;
    __syncthreads();
    for (int bt = F.vcu; bt < MTOK / 32; bt += F.G) {
        const int row0 = bt * 32, b = row0 >> 11;
        const float* mb = MODl + (size_t)b * 6 * DM;
        u32x2 yv[4][4]; f32x4 xv[4][4], s4v[4];
#pragma unroll
        for (int rr = 0; rr < 4; ++rr) { const size_t row = (size_t)row0 + 4 * wid + rr; s4v[rr] = *(const f32x4*)(SSP + row * 16 + 4 * (lane & 3));
#pragma unroll
            for (int j = 0; j < 4; ++j) { const int c = 4 * lane + 256 * j; yv[rr][j] = __builtin_nontemporal_load((const u32x2*)(Y + row * DM + c)); xv[rr][j] = __builtin_nontemporal_load((const f32x4*)(xin + row * DM + c)); } }
#pragma unroll
        for (int rr = 0; rr < 4; ++rr) { const int rl = 4 * wid + rr; const size_t row = (size_t)row0 + rl;
            const f32x4 s4 = s4v[rr];
            float ssy = (s4[0] + s4[1]) + (s4[2] + s4[3]); ssy = quad_sum(ssy);
            const float rstd1 = 1.f / sqrtf(ssy * (1.f / DM) + RMS_EPS);
            f32x4 v[4]; float ss = 0.f;
#pragma unroll
            for (int j = 0; j < 4; ++j) { const int c = 4 * lane + 256 * j; const u32x2 yw_ = yv[rr][j]; const f32x4 yy = {bf_lo(yw_.x), bf_hi(yw_.x), bf_lo(yw_.y), bf_hi(yw_.y)}, xx = xv[rr][j];
                const f32x4 gp = *(const f32x4*)(g_post + c), ga = *(const f32x4*)(mb + 2 * DM + c);
                v[j] = xx + ga * (yy * rstd1 * gp); *(f32x4*)(xout + row * DM + c) = v[j];
                ss += (v[j][0] * v[j][0] + v[j][1] * v[j][1]) + (v[j][2] * v[j][2] + v[j][3] * v[j][3]); }
            ss = wave_sum(ss);
            const float rstd = 1.f / sqrtf(ss * (1.f / DM) + RMS_EPS);
            f32x4 o[4]; float am = 0.f;
#pragma unroll
            for (int j = 0; j < 4; ++j) { const int c = 4 * lane + 256 * j; const f32x4 gg = *(const f32x4*)(g_pre + c), s1 = *(const f32x4*)(mb + 4 * DM + c), s0 = *(const f32x4*)(mb + 3 * DM + c);
                o[j] = (v[j] * rstd) * gg * (s1 + 1.f) + s0; u32x2 w; w.x = cvt_pk_bf16(o[j][0], o[j][1]); w.y = cvt_pk_bf16(o[j][2], o[j][3]);
                *(LAS u32x2*)(hs + rl * HS_STRIDE + c * 2) = w;
                am = fmaxf(am, fmaxf(fmaxf(fabsf(o[j][0]), fabsf(o[j][1])), fmaxf(fabsf(o[j][2]), fabsf(o[j][3])))); }
            am = wave_max(am);
            const float scale = fmaxf(am, 1e-30f) * (1.f / 127.f), inv = 1.f / scale;
            if (lane == 0) RS[row] = scale;
#pragma unroll
            for (int j = 0; j < 4; ++j) *(unsigned*)(H8 + row * DM + 4 * lane + 256 * j) = q8x4(o[j][0], o[j][1], o[j][2], o[j][3], inv); }
        __syncthreads();
        {
            f32x16 d;
#pragma unroll
            for (int r = 0; r < 16; ++r) d[r] = 0.f;
#pragma unroll
            for (int ks = 0; ks < 8; ++ks) { const int k0 = (8 * wid + ks) * 16 + 8 * hi;
                const bf16x8 af = *(const LAS bf16x8*)(hs + n * HS_STRIDE + k0 * 2); const bf16x8 bf = *(const bf16x8*)(WRTl + (size_t)n * DM + k0);
                d = __builtin_amdgcn_mfma_f32_32x32x16_bf16(af, bf, d, 0, 0, 0); }
#pragma unroll
            for (int r = 0; r < 16; ++r) part[wid * 1024 + (8 * (r >> 2) + 4 * hi + (r & 3)) * 32 + n] = d[r];
        }
        __syncthreads();
        for (int i = tid; i < 1024; i += 512) { float s = b_router[i & 31];
#pragma unroll
            for (int w = 0; w < 8; ++w) s += part[w * 1024 + i]; lg[(i >> 5) * 33 + (i & 31)] = s; }
        __syncthreads();
        int e_k[4] = {0, 0, 0, 0}, lp_k[4] = {0, 0, 0, 0}; float w_k[4] = {0.f, 0.f, 0.f, 0.f};
        if (tid < 32) { LAS float* mylg = lg + tid * 33; float tl[4];
#pragma unroll
            for (int k = 0; k < 4; ++k) { float best = -INFINITY; int bi = 0;
                for (int e = 0; e < 32; ++e) { const float vv = mylg[e]; if (vv > best) { best = vv; bi = e; } }
                tl[k] = best; e_k[k] = bi; mylg[bi] = -INFINITY; }
            float sum = 0.f;
#pragma unroll
            for (int k = 0; k < 4; ++k) { w_k[k] = __expf(tl[k] - tl[0]); sum += w_k[k]; }
            const float inv = 1.f / sum;
#pragma unroll
            for (int k = 0; k < 4; ++k) { w_k[k] *= inv; lp_k[k] = __hip_atomic_fetch_add(&hist[e_k[k]], 1, __ATOMIC_RELAXED, __HIP_MEMORY_SCOPE_WORKGROUP); } }
        __syncthreads();
        if (tid < 32) { const int hc = hist[tid]; base[tid] = hc > 0 ? (int)__hip_atomic_fetch_add(cnt + 64 * tid, (unsigned)hc, __ATOMIC_RELAXED, __HIP_MEMORY_SCOPE_AGENT) : 0; hist[tid] = 0; }
        __syncthreads();
        if (tid < 32) { const int token = row0 + tid; u32x4 info; f32x4 ww;
#pragma unroll
            for (int k = 0; k < 4; ++k) { const int pos = base[e_k[k]] + lp_k[k]; ROWTOK[e_k[k] * 65536 + pos] = token; info[k] = ((unsigned)e_k[k] << 17) | (unsigned)pos; ww[k] = w_k[k]; }
            *(u32x4*)(TOKINFO + (size_t)token * 8) = info; *(f32x4*)(TOKINFO + (size_t)token * 8 + 4) = ww; }
        __syncthreads();
    }
}

__device__ __forceinline__ int moe_tables(const Frame& F, unsigned* cnt) {
    LAS int* ts = (LAS int*)(F.lds + TS_OFF); LAS int* te = (LAS int*)(F.lds + TILE_E_OFF);
    __syncthreads();
    if (F.tid == 0) { int acc = 0; for (int e = 0; e < NE; ++e) { ts[e] = acc; const unsigned c = __hip_atomic_load(cnt + 64 * e, __ATOMIC_RELAXED, __HIP_MEMORY_SCOPE_AGENT); acc += (int)((c + 255u) >> 8); } ts[NE] = acc; }
    __syncthreads();
    const int RT = ts[NE];
    for (int rt = F.tid; rt < RT; rt += 512) { int e = 0;
#pragma unroll 1
        for (int q = 1; q < NE; ++q) e += (ts[q] <= rt) ? 1 : 0;
        te[rt] = e; }
    __syncthreads();
    return RT;
}

__device__ __forceinline__ void p10_combine(const Frame& F, const Args& a, int l, float* xio, const bf16_t* Y2, const unsigned* TOKINFO, const float* MODbase, signed char* H8, float* RS) {
    const int lane = F.lane; const LAS int* ts = (const LAS int*)(F.lds + TS_OFF);
    const float* g_postf = a.in[7] + l * DM;
    const int gw = F.vcu * 8 + F.wave, NGW = F.G * 8;
    for (int rowp = gw * 2; rowp < MTOK; rowp += NGW * 2) {
        u32x4 info[2]; f32x4 ww[2]; u32x2 yw[2][4][4]; f32x4 xv[2][4];
#pragma unroll
        for (int rr = 0; rr < 2; ++rr) { info[rr] = *(const u32x4*)(TOKINFO + (size_t)(rowp + rr) * 8); ww[rr] = *(const f32x4*)(TOKINFO + (size_t)(rowp + rr) * 8 + 4); }
#pragma unroll
        for (int rr = 0; rr < 2; ++rr) {
#pragma unroll
            for (int k = 0; k < 4; ++k) { const int e = (int)(info[rr][k] >> 17), pos = (int)(info[rr][k] & 0x1ffffu); const size_t slot = (size_t)ts[e] * 256 + pos;
#pragma unroll
                for (int j = 0; j < 4; ++j) yw[rr][k][j] = __builtin_nontemporal_load((const u32x2*)(Y2 + slot * DM + 4 * lane + 256 * j)); }
#pragma unroll
            for (int j = 0; j < 4; ++j) xv[rr][j] = *(const f32x4*)(xio + (size_t)(rowp + rr) * DM + 4 * lane + 256 * j); }
#pragma unroll
        for (int rr = 0; rr < 2; ++rr) { const int row = rowp + rr, b = row >> 11;
        f32x4 y[4];
#pragma unroll
        for (int j = 0; j < 4; ++j) y[j] = (f32x4){0.f, 0.f, 0.f, 0.f};
#pragma unroll
        for (int k = 0; k < 4; ++k) { const float wk = ww[rr][k];
#pragma unroll
            for (int j = 0; j < 4; ++j) { const u32x2 w = yw[rr][k][j];
                y[j][0] += wk * bf_lo(w.x); y[j][1] += wk * bf_hi(w.x); y[j][2] += wk * bf_lo(w.y); y[j][3] += wk * bf_hi(w.y); } }
        float ss = 0.f;
#pragma unroll
        for (int j = 0; j < 4; ++j) ss += (y[j][0] * y[j][0] + y[j][1] * y[j][1]) + (y[j][2] * y[j][2] + y[j][3] * y[j][3]);
        ss = wave_sum(ss);
        const float rstd = 1.f / sqrtf(ss * (1.f / DM) + RMS_EPS);
        const float* mb = MODbase + ((size_t)l * BATCH + b) * 6 * DM;
        f32x4 v[4]; float s2 = 0.f;
#pragma unroll
        for (int j = 0; j < 4; ++j) { const int c = 4 * lane + 256 * j; const f32x4 xx = xv[rr][j], gp = *(const f32x4*)(g_postf + c), ga = *(const f32x4*)(mb + 5 * DM + c);
            v[j] = xx + ga * (y[j] * rstd * gp);
#ifdef T_STAMP
            if (l + 1 == DEPTH) v[j] = v[j] * (1.f + (float)(*((const unsigned*)MODbase - (1u << 18) + 100)) * (1.f / 256.f));
#endif
            *(f32x4*)(xio + (size_t)row * DM + c) = v[j];
            s2 += (v[j][0] * v[j][0] + v[j][1] * v[j][1]) + (v[j][2] * v[j][2] + v[j][3] * v[j][3]); }
        if (l + 1 < DEPTH) { s2 = wave_sum(s2); const float* mb1 = MODbase + ((size_t)(l + 1) * BATCH + b) * 6 * DM;
            norm_mod_row(v, s2, a.in[4] + (l + 1) * DM, mb1 + DM, mb1, H8 + (size_t)row * DM, RS + row, lane); }
        }
    }
}
#ifndef MK_ONE_LAUNCH
#define MK_ONE_LAUNCH 1
#endif
constexpr int N_PHASES = 2 + 9 * DEPTH;
__global__ void __launch_bounds__(512, 2) fwd(Args args) {
    extern __shared__ __attribute__((aligned(16))) unsigned char lds_raw[];
    Frame F0;
    F0.lds = (LAS unsigned char*)lds_raw;
    F0.tid = threadIdx.x; F0.lane = F0.tid & 63; F0.wave = __builtin_amdgcn_readfirstlane(F0.tid >> 6);
    F0.G = gridDim.x; { const int bx = blockIdx.x; F0.vcu = (F0.G % 8 == 0) ? (bx % 8) * (F0.G / 8) + bx / 8 : bx; }
    volatile LAS unsigned* MISC = (volatile LAS unsigned*)(F0.lds + MISC_OFF);
    for (int u = F0.tid; u < 128; u += 512) MISC[u] = 0u;
    __syncthreads();
    unsigned* ctl = (unsigned*)(args.ws + WS_CTL);
    const int lo = args.ph_lo, hi = args.ph_hi;
    XcdBarrier bar; bar.bar = ctl + CW_BAR; bar.x = 0; bar.st = nullptr; bar.w = F0.wave;
    if (hi - lo > 1) bar = xcd_barrier_post(ctl + CW_BAR, MISC + 8, F0.wave);
#ifndef PHASE_MASK
#define PHASE_MASK 0x7ff
#endif
#define PHON(j) ((PHASE_MASK >> (j)) & 1)
#ifndef REPEAT_MASK
#define REPEAT_MASK 0
#endif
#define REP(j) for (int rep_ = 0; rep_ <= ((REPEAT_MASK >> (j)) & 1); ++rep_)
#define IN(k) (lo <= (k) && (k) < hi)
#define BOTH(k) (IN(k) && IN((k) + 1))
#define GRID_BAR() xcd_barrier(bar)
#define PH_BEGIN() const Frame F = phase_frame(F0); unsigned char* ws = opq(args.ws); (void)ws
    if (PHON(0) && IN(0)) REP(0) { PH_BEGIN(); p0_mod(F, args.in[1], args.in[2], args.in[3], (float*)(ws + WS_MOD)); p0_weights(F, args); if (BOTH(0)) GRID_BAR(); }
    if (PHON(1) && IN(1)) REP(1) { PH_BEGIN(); p1_norm(F, args.in[0], args.in[4], (const float*)(ws + WS_MOD), (signed char*)(ws + WS_H), (float*)(ws + WS_RS)); if (BOTH(1)) GRID_BAR(); }

#pragma unroll 1
    for (int l = 0; l < DEPTH; ++l) {
        const int pb = 2 + 9 * l;
        if (PHON(2) && IN(pb + 0)) REP(2) { PH_BEGIN();
            pg8::Gemm g{(const bf16_t*)(ws + WS_H), (const bf16_t*)(ws + WS_W + (size_t)l * W_LAYER + WO_WIN), DM}; pg8::StaticOrder S; S.init(MTOK / 256, NPROJ / 256, F.G, (int)blockIdx.x);
            EpiProj E{(bf16_t*)(ws + WS_PROJ), (unsigned char*)(ws + WS_GATES), (const float*)(ws + WS_RS), (const float*)(ws + WS_CSIN) + (size_t)l * NPROJ};
            pg8::gemm_phase<EpiProj, pg8::StaticOrder, false, true>(F.lds, g, S, E, F.wave);
            if (BOTH(pb + 0)) GRID_BAR();
        }
        if (PHON(3) && IN(pb + 1)) REP(3) {
#ifndef SUBREP
#define SUBREP 0
#endif
            { const Frame Fa = phase_frame(F0); const bf16_t* PROJa = (const bf16_t*)(opq(args.ws) + WS_PROJ); bf16_t* OAa = (bf16_t*)(opq(args.ws) + WS_O);
            for (int u = Fa.vcu; u < 2048; u += Fa.G) { const int cu = u & 255, j = u >> 8, bg = cu >> 2, s = cu & 3, qb = (j & 1) ? (8 * (j >> 1) + 7 - s) : (8 * (j >> 1) + s);
                attn_unit<0>(Fa, PROJa, OAa, nullptr, args.in[9] + l * 8, bg >> 1, bg & 1, qb); } }
            { const Frame Fb = phase_frame(F0); unsigned char* wsb = opq(args.ws);
            for (int u = Fb.vcu; u < 512; u += Fb.G)
                sg_unit(Fb, (const bf16_t*)(wsb + WS_PROJ), (const bf16_t*)(wsb + WS_SGW) + (size_t)l * 8 * 128 * 128, args.in[11] + l * 8 * 128, args.in[12] + l * 512, (bf16_t*)(wsb + WS_O) + (size_t)2 * MTOK * 512, u >> 4, u & 15); }
            __syncthreads();
            { const Frame Fi = phase_frame(F0); unsigned char* wsi = opq(args.ws);
              dsa_index_phase(Fi, (const bf16_t*)(wsi + WS_PROJ), (unsigned long long*)(wsi + WS_BITS), l == 0 ? (unsigned*)(wsi + WS_CTL) + 100 : nullptr); }
            if (BOTH(pb + 1)) GRID_BAR();
        }
        if (PHON(4) && IN(pb + 2)) REP(4) { PH_BEGIN();
            for (int u = F.vcu; u < 2048; u += F.G) { const int cu = u & 255, j = u >> 8, bg = cu >> 2, s = cu & 3, qb = (j & 1) ? (8 * (j >> 1) + 7 - s) : (8 * (j >> 1) + s);
                attn_unit<1>(F, (const bf16_t*)(ws + WS_PROJ), (bf16_t*)(ws + WS_O) + (size_t)MTOK * 512, (const unsigned*)(ws + WS_BITS), nullptr, bg >> 1, bg & 1, qb); }
            __syncthreads();
            if (BOTH(pb + 2)) GRID_BAR();
        }
        if (PHON(5) && IN(pb + 3)) REP(5) { PH_BEGIN();
            pg8::Gemm g{(const bf16_t*)(ws + WS_O), (const bf16_t*)(ws + WS_W + (size_t)l * W_LAYER + WO_WBR), 512}; BranchOrder S; S.so.init(MTOK / 256, DM / 256, F.G, (int)blockIdx.x);
            EpiBranch E{(const unsigned char*)(ws + WS_GATES), (bf16_t*)(ws + WS_H)};
            pg8::gemm_phase<EpiBranch, BranchOrder, false>(F.lds, g, S, E, F.wave);
            if (BOTH(pb + 3)) GRID_BAR();
        }
        if (PHON(6) && IN(pb + 4)) REP(6) { PH_BEGIN();
            pg8::Gemm g{(const bf16_t*)(ws + WS_H), (const bf16_t*)(ws + WS_W + (size_t)l * W_LAYER + WO_WOUT), DM}; pg8::StaticOrder S; S.init(MTOK / 256, DM / 256, F.G, (int)blockIdx.x);
            EpiWout E{(bf16_t*)(ws + WS_Y), (float*)(ws + WS_SSP)};
            pg8::gemm_phase<EpiWout, pg8::StaticOrder, false>(F.lds, g, S, E, F.wave);
            if (BOTH(pb + 4)) GRID_BAR();
        }
        if (PHON(7) && IN(pb + 5)) REP(7) { PH_BEGIN();
            p7_route(F, args, l, l == 0 ? args.in[0] : (const float*)args.out, args.out, (const bf16_t*)(ws + WS_Y), (const float*)(ws + WS_SSP), (const float*)(ws + WS_MOD) + (size_t)l * BATCH * 6 * DM, (signed char*)(ws + WS_H), (float*)(ws + WS_RS),
                     (const bf16_t*)(ws + WS_WRT) + (size_t)l * NE * DM, (unsigned*)(ws + WS_CTL) + CW_CNT + l * 32 * 64, (int*)(ws + WS_ROWTOK), (unsigned*)(ws + WS_TOKINFO));
            if (BOTH(pb + 5)) GRID_BAR();
        }
        if (PHON(8) && IN(pb + 6)) REP(8) { PH_BEGIN();
            unsigned* cnt = (unsigned*)(ws + WS_CTL) + CW_CNT + l * 32 * 64; const int* ROWTOK = (const int*)(ws + WS_ROWTOK);
            const int RT = moe_tables(F, cnt);
            LAS int* ts = (LAS int*)(F.lds + TS_OFF); LAS int* te = (LAS int*)(F.lds + TILE_E_OFF); LAS int* ri = (LAS int*)(F.lds + ROWIDX_OFF);
            const long U = (long)RT * 8; MoeOrder S; S.u0 = (int)(U * F.vcu / F.G); S.u1 = (int)(U * (F.vcu + 1) / F.G); S.NB = 8; S.rt_lo = S.u0 / 8; S.tile_e = te; S.rowidx = ri;
            if (S.u1 > S.u0) { const int rt_hi = (S.u1 - 1) / 8; int ntile = rt_hi - S.rt_lo + 1; if (ntile > 8) ntile = 8;
                for (int i = F.tid; i < ntile * 256; i += 512) { const int rt = S.rt_lo + (i >> 8), r = i & 255, e = te[rt], first = (rt - ts[e]) * 256 + r;
                    const int c = (int)__hip_atomic_load(cnt + 64 * e, __ATOMIC_RELAXED, __HIP_MEMORY_SCOPE_AGENT); ri[i] = first < c ? ROWTOK[e * 65536 + first] : 0; } }
            __syncthreads();
            pg8::Gemm g{(const bf16_t*)(ws + WS_H), (const bf16_t*)(ws + WS_W + (size_t)l * W_LAYER + WO_W1), DM};
            EpiW1I8 E{(signed char*)(ws + WS_ACT), args.in[18] + (size_t)l * NE * 2 * FF, (const float*)(ws + WS_RS), (const float*)(ws + WS_CS1) + (size_t)l * NE * 2048, ri, S.rt_lo};
            pg8::gemm_phase<EpiW1I8, MoeOrder, true, true>(F.lds, g, S, E, F.wave);
            if (BOTH(pb + 6)) GRID_BAR();
        }
        if (PHON(9) && IN(pb + 7)) REP(9) { PH_BEGIN();
            const int RT = moe_tables(F, (unsigned*)(ws + WS_CTL) + CW_CNT + l * 32 * 64);
            const long U = (long)RT * 4; MoeOrder S; S.u0 = (int)(U * F.vcu / F.G); S.u1 = (int)(U * (F.vcu + 1) / F.G); S.NB = 4; S.rt_lo = 0; S.tile_e = (LAS int*)(F.lds + TILE_E_OFF); S.rowidx = nullptr;
            pg8::Gemm g{(const bf16_t*)(ws + WS_ACT), (const bf16_t*)(ws + WS_W + (size_t)l * W_LAYER + WO_W2), FF};
            EpiW2 E{(bf16_t*)(ws + WS_Y2), args.in[20] + (size_t)l * NE * DM, (const float*)(ws + WS_CS2) + (size_t)l * NE * DM};
            pg8::gemm_phase<EpiW2, MoeOrder, false, true>(F.lds, g, S, E, F.wave);
            if (BOTH(pb + 7)) GRID_BAR();
        }
        if (PHON(10) && IN(pb + 8)) REP(10) { PH_BEGIN();
            (void)moe_tables(F, (unsigned*)(ws + WS_CTL) + CW_CNT + l * 32 * 64);
            p10_combine(F, args, l, args.out, (const bf16_t*)(ws + WS_Y2), (const unsigned*)(ws + WS_TOKINFO), (const float*)(ws + WS_MOD), (signed char*)(ws + WS_H), (float*)(ws + WS_RS));
            if (BOTH(pb + 8)) GRID_BAR();
        }
    }
#undef PH_BEGIN
#undef IN
#undef BOTH
#undef GRID_BAR
}

extern "C" void kernel_launch(void* const* d_in, const int* in_sizes, int n_in, void* d_out, int out_size, void* d_ws, size_t ws_size, hipStream_t stream) {
    static int grid = 0;
    if (grid == 0) {
        if (n_in != 21 || out_size != MTOK * DM || ws_size < WS_END) { fprintf(stderr, "kernel_launch: unexpected shapes (n_in %d, out %d, ws %zu); nothing launched\n", n_in, out_size, ws_size); grid = -1; return; }
        int dev = 0, cus = 0, per_cu = 0;
        if (hipGetDevice(&dev) != hipSuccess || hipDeviceGetAttribute(&cus, hipDeviceAttributeMultiprocessorCount, dev) != hipSuccess) { grid = -1; return; }
        if (hipFuncSetAttribute((const void*)fwd, hipFuncAttributeMaxDynamicSharedMemorySize, LDS_BYTES) != hipSuccess) { fprintf(stderr, "kernel_launch: hipFuncSetAttribute failed\n"); grid = -1; return; }
        if (hipOccupancyMaxActiveBlocksPerMultiprocessor(&per_cu, (const void*)fwd, 512, LDS_BYTES) != hipSuccess || per_cu < 1) { fprintf(stderr, "kernel_launch: occupancy query says %d\n", per_cu); }
        (void)hipGetLastError();
        grid = cus > 256 ? 256 : cus;
    }
    if (grid < 0) return;
    (void)hipMemsetAsync((char*)d_ws + WS_CTL, 0, CTL_ZERO_BYTES, stream);
    Args a{};
    for (int i = 0; i < 21; ++i) a.in[i] = (const float*)d_in[i];
    a.out = (float*)d_out; a.ws = (unsigned char*)d_ws;
#if MK_ONE_LAUNCH
    a.ph_lo = 0; a.ph_hi = N_PHASES;
    hipLaunchKernelGGL(fwd, dim3(grid), dim3(512), LDS_BYTES, stream, a);
#else
    for (int p = 0; p < N_PHASES; ++p) { a.ph_lo = p; a.ph_hi = p + 1; hipLaunchKernelGGL(fwd, dim3(grid), dim3(512), LDS_BYTES, stream, a); }
#endif
}
```

```cpp
#include <hip/hip_runtime.h>
#include <cstdio>
#include <cstdint>
#include <type_traits>

#define LAS __attribute__((address_space(3)))
#define GAS __attribute__((address_space(1)))
typedef unsigned short bf16_t;
typedef short bf16x8 __attribute__((ext_vector_type(8)));
typedef float f32x2 __attribute__((ext_vector_type(2)));
typedef float f32x4 __attribute__((ext_vector_type(4)));
typedef float f32x16 __attribute__((ext_vector_type(16)));
typedef unsigned u32x2 __attribute__((ext_vector_type(2)));
typedef unsigned u32x4 __attribute__((ext_vector_type(4)));
typedef short v4i16_t __attribute__((ext_vector_type(4)));
typedef int i32x4 __attribute__((ext_vector_type(4)));

constexpr int BATCH = 32, SEQ = 2048, DM = 1024, MTOK = BATCH * SEQ, DEPTH = 2;
constexpr int NPROJ = 6144;
constexpr int PLD = 3072;
constexpr int C_QA = 0, C_KA = 512, C_VA = 640, C_QB = 768, C_KB = 1280, C_VB = 1408, C_QI = 1536, C_KI = 1792, C_WI = 1824, C_U = 2048, C_V = 2560, C_G = 3072;
constexpr int NE = 32, FF = 1024;
constexpr float RMS_EPS = 1e-5f, LN_EPS = 1e-5f;
constexpr float LOG2E = 1.4426950408889634f;
constexpr float QSCALE = 0.125f * LOG2E;

__device__ __forceinline__ unsigned f2bf(float f) { unsigned u = __builtin_bit_cast(unsigned, f); return (u + 0x7fffu + ((u >> 16) & 1u)) >> 16; }
__device__ __forceinline__ unsigned cvt_pk_bf16(float lo, float hi) { unsigned r; asm volatile("v_cvt_pk_bf16_f32 %0, %1, %2" : "=v"(r) : "v"(lo), "v"(hi)); return r; }
__device__ __forceinline__ float bf_lo(unsigned w) { return __builtin_bit_cast(float, w << 16); }
__device__ __forceinline__ float bf_hi(unsigned w) { return __builtin_bit_cast(float, w & 0xffff0000u); }
__device__ __forceinline__ float fexp2(float x) { return __builtin_amdgcn_exp2f(x); }
__device__ __forceinline__ float frcp(float x) { return __builtin_amdgcn_rcpf(x); }
__device__ __forceinline__ float sigmoidf_(float x) { return frcp(1.f + fexp2(-LOG2E * x)); }
__device__ __forceinline__ float gelu_tanh(float x) { const float t = x + 0.044715f * x * x * x; return x * frcp(1.f + fexp2(-2.302208198f * t)); }
template <int CTRL> __device__ __forceinline__ float dpp_f(float v) { return __builtin_bit_cast(float, __builtin_amdgcn_update_dpp(0, __builtin_bit_cast(int, v), CTRL, 0xF, 0xF, false)); }
__device__ __forceinline__ void swap32_asm(unsigned& a, unsigned& b) { asm volatile("s_nop 1\n\tv_permlane32_swap_b32 %0, %1" : "+v"(a), "+v"(b)); }
__device__ __forceinline__ float xor16_add(float v) { return v + __builtin_bit_cast(float, __builtin_amdgcn_ds_swizzle(__builtin_bit_cast(int, v), 0x401F)); }
__device__ __forceinline__ float xor16_max(float v) { return fmaxf(v, __builtin_bit_cast(float, __builtin_amdgcn_ds_swizzle(__builtin_bit_cast(int, v), 0x401F))); }
__device__ __forceinline__ float xor32_add(float v) { unsigned a = __builtin_bit_cast(unsigned, v), b = a; swap32_asm(a, b); return __builtin_bit_cast(float, a) + __builtin_bit_cast(float, b); }
__device__ __forceinline__ float xor32_max(float v) { unsigned a = __builtin_bit_cast(unsigned, v), b = a; swap32_asm(a, b); return fmaxf(__builtin_bit_cast(float, a), __builtin_bit_cast(float, b)); }
__device__ __forceinline__ float quad_sum(float v) { v += dpp_f<0xB1>(v); v += dpp_f<0x4E>(v); return v; }
__device__ __forceinline__ float wave_sum(float v) {
    v += dpp_f<0xB1>(v); v += dpp_f<0x4E>(v); v += dpp_f<0x141>(v); v += dpp_f<0x140>(v);
    return xor32_add(xor16_add(v));
}
__device__ __forceinline__ float wave_max(float v) {
    v = fmaxf(v, dpp_f<0xB1>(v)); v = fmaxf(v, dpp_f<0x4E>(v)); v = fmaxf(v, dpp_f<0x141>(v)); v = fmaxf(v, dpp_f<0x140>(v));
    return xor32_max(xor16_max(v));
}
__device__ __forceinline__ unsigned wave_sum_u32(unsigned v) {
    v += (unsigned)__builtin_amdgcn_update_dpp(0, (int)v, 0xB1, 0xF, 0xF, false);
    v += (unsigned)__builtin_amdgcn_update_dpp(0, (int)v, 0x4E, 0xF, 0xF, false);
    v += (unsigned)__builtin_amdgcn_update_dpp(0, (int)v, 0x141, 0xF, 0xF, false);
    v += (unsigned)__builtin_amdgcn_update_dpp(0, (int)v, 0x140, 0xF, 0xF, false);
    return __builtin_amdgcn_readlane(v, 0) + __builtin_amdgcn_readlane(v, 16) + __builtin_amdgcn_readlane(v, 32) + __builtin_amdgcn_readlane(v, 48);
}
__device__ __forceinline__ unsigned wave_max_u32(unsigned v) {
    unsigned t;
    t = (unsigned)__builtin_amdgcn_update_dpp(0, (int)v, 0xB1, 0xF, 0xF, false); v = v > t ? v : t;
    t = (unsigned)__builtin_amdgcn_update_dpp(0, (int)v, 0x4E, 0xF, 0xF, false); v = v > t ? v : t;
    t = (unsigned)__builtin_amdgcn_update_dpp(0, (int)v, 0x141, 0xF, 0xF, false); v = v > t ? v : t;
    t = (unsigned)__builtin_amdgcn_update_dpp(0, (int)v, 0x140, 0xF, 0xF, false); v = v > t ? v : t;
    unsigned a = __builtin_amdgcn_readlane(v, 0), b = __builtin_amdgcn_readlane(v, 16), c = __builtin_amdgcn_readlane(v, 32), d = __builtin_amdgcn_readlane(v, 48);
    a = a > b ? a : b; c = c > d ? c : d; return a > c ? a : c;
}
__device__ __forceinline__ unsigned q8x4(float a, float b, float c, float d, float inv) {
    unsigned r = 0u;
    r = __builtin_amdgcn_cvt_pk_u8_f32(__builtin_rintf(fmaf(a, inv, 128.f)), 0u, r);
    r = __builtin_amdgcn_cvt_pk_u8_f32(__builtin_rintf(fmaf(b, inv, 128.f)), 1u, r);
    r = __builtin_amdgcn_cvt_pk_u8_f32(__builtin_rintf(fmaf(c, inv, 128.f)), 2u, r);
    r = __builtin_amdgcn_cvt_pk_u8_f32(__builtin_rintf(fmaf(d, inv, 128.f)), 3u, r);
    return r ^ 0x80808080u;
}
__device__ __forceinline__ unsigned u8x4_floor(float a, float b, float c, float d) {
    unsigned r = 0u;
    r = __builtin_amdgcn_cvt_pk_u8_f32(__builtin_floorf(a), 0u, r); r = __builtin_amdgcn_cvt_pk_u8_f32(__builtin_floorf(b), 1u, r);
    r = __builtin_amdgcn_cvt_pk_u8_f32(__builtin_floorf(c), 2u, r); r = __builtin_amdgcn_cvt_pk_u8_f32(__builtin_floorf(d), 3u, r);
    return r;
}
__device__ __forceinline__ int lane_id_volatile(int tag = 0) { int l; asm volatile("v_mbcnt_lo_u32_b32 %0, -1, 0 ; LANETAG %1\n\tv_mbcnt_hi_u32_b32 %0, -1, %0" : "=v"(l) : "s"(tag)); return l; }
#define LDS_WAIT() asm volatile("s_waitcnt lgkmcnt(0)" ::: "memory")
#define VM_WAIT() asm volatile("s_waitcnt vmcnt(0)" ::: "memory")

namespace pg8 {
constexpr int BM = 256, BK = 64, HALF = 128, HTB = HALF * BK * 2  , STAGE_BYTES = 8 * HTB, NXCD = 8, WGM = 8;
__host__ __device__ __forceinline__ int lds_byte(int r, int c) { const int st = (r >> 4) * 2 + (c >> 5), rr = r & 15, cc = c & 31, ob = rr * 64 + cc * 2; return st * 1024 + (ob ^ (((ob >> 9) & 1) << 5)); }
__host__ __device__ __forceinline__ void stage_rc(int b, int& R, int& C) { const int st = b / 1024, sb = b % 1024, swz = sb ^ (((sb >> 9) & 1) << 5); R = (st >> 1) * 16 + swz / 64; C = (st & 1) * 32 + (swz % 64) / 2; }
__host__ __device__ __forceinline__ int perm32(int rho) { const int n = rho >> 4, i = rho & 15; return 8 * (i >> 2) + 4 * n + (i & 3); }

struct Unit { int pm, pn; };
struct Gemm { const bf16_t* A; const bf16_t* Bt; int K; };

struct StaticOrder {
    int nM, nN, nwg, G, c;
    __device__ void init(int nM_, int nN_, int G_, int c_) { nM = nM_; nN = nN_; nwg = nM * nN; G = G_; c = c_; }
    __device__ __forceinline__ bool tile(int i, int& pm, int& pn) const {
        const long L = (long)i * G + c; if (L >= nwg) return false;
        int wgid = (int)L; { const int q = nwg / NXCD, r = nwg % NXCD, xcd = wgid % NXCD, off = wgid / NXCD; wgid = (xcd < r ? xcd * (q + 1) : r * (q + 1) + (xcd - r) * q) + off; }
        const int nig = WGM * nN, gid = wgid / nig, fm = gid * WGM, gsz = (nM - fm) < WGM ? (nM - fm) : WGM;
        pm = fm + ((wgid % nig) % gsz); pn = (wgid % nig) / gsz; return true;
    }
    __device__ __forceinline__ bool next(int i, Unit& u) const { return tile(i, u.pm, u.pn); }
};

template <class Epi, class Sched, bool GATHER, bool I8 = false>
__device__ __forceinline__ void gemm_phase(LAS unsigned char* lds, const Gemm g, const Sched& S, const Epi& E, int wv  ) {
    int tid = wv * 64 + lane_id_volatile(1); asm volatile("" : "+v"(tid));
    const int wid = __builtin_amdgcn_readfirstlane(tid >> 6), lane = tid & 63, wr = wid >> 2, wc = wid & 3, fr = lane & 15, fq = lane >> 4;
    const int K = g.K, RB = I8 ? K : 2 * K  , nt = RB / (BK * 2);
    unsigned voffA[2], voffB[2]; int RA[2], CA[2];
#pragma unroll
    for (int i = 0; i < 2; ++i) { int R, C; stage_rc(tid * 16 + i * 8192, R, C); const int Rb = (R & ~31) + perm32(R & 31); RA[i] = R; CA[i] = C;
        voffA[i] = (unsigned)(R * RB + C * 2); voffB[i] = (unsigned)(Rb * RB + C * 2); }
    const size_t kstep = (size_t)(BK * 2);
    const size_t hstep = (size_t)HALF * RB;
    const size_t tstep = 2 * hstep;
    const unsigned ldsw = (unsigned)wid * 1024u;
    const int aoff = lds_byte(wr * 64 + fr, fq * 8), boff = lds_byte(wc * 32 + fr, fq * 8);
#define PG8_SA(b, h) (((b) * 2 + (h)) * HTB)
#define PG8_SB(b, h) ((4 + (b) * 2 + (h)) * HTB)
#define PG8_STAGE(bufoff, gbase, voff) do { _Pragma("unroll") for (int _i = 0; _i < 2; ++_i) \
        __builtin_amdgcn_global_load_lds((const unsigned*)((const char*)(gbase) + (voff)[_i]), (LAS unsigned*)(lds + (bufoff) + ldsw + _i * 8192), 16, 0, 0); } while (0)
#define PG8_STAGE_A(bufoff, h, ubase, koff, VO) do { if constexpr (GATHER) { PG8_STAGE(bufoff, (const char*)g.A + (koff), VO[h]); } else { PG8_STAGE(bufoff, (ubase) + (h) * hstep + (koff), voffA); } } while (0)
#define PG8_LDA(dst, b, h) do { _Pragma("unroll") for (int m = 0; m < 4; ++m) _Pragma("unroll") for (int k = 0; k < 2; ++k) dst[m][k] = *(const LAS bf16x8*)(lds + PG8_SA(b, h) + aoff + m * 2048 + k * 1024); } while (0)
#define PG8_LDB(dst, b, h) do { _Pragma("unroll") for (int n = 0; n < 2; ++n) _Pragma("unroll") for (int k = 0; k < 2; ++k) dst[n][k] = *(const LAS bf16x8*)(lds + PG8_SB(b, h) + boff + n * 2048 + k * 1024); } while (0)
#define PG8_MMA(ai, bj, At, Bt) do { __builtin_amdgcn_s_setprio(1); _Pragma("unroll") for (int m = 0; m < 4; ++m) _Pragma("unroll") for (int n = 0; n < 2; ++n) _Pragma("unroll") for (int k = 0; k < 2; ++k) \
        { if constexpr (I8) acc[ai][bj][m][n] = __builtin_amdgcn_mfma_i32_16x16x64_i8(__builtin_bit_cast(i32x4, Bt[n][k]), __builtin_bit_cast(i32x4, At[m][k]), acc[ai][bj][m][n], 0, 0, 0); \
          else acc[ai][bj][m][n] = __builtin_amdgcn_mfma_f32_16x16x32_bf16(Bt[n][k], At[m][k], acc[ai][bj][m][n], 0, 0, 0); } __builtin_amdgcn_s_setprio(0); } while (0)
#define PG8_WAIT_V(n) asm volatile("s_waitcnt vmcnt(" #n ")" ::: "memory")
#define PG8_WAIT_L(n) asm volatile("s_waitcnt lgkmcnt(" #n ")" ::: "memory")
#define PG8_BAR __builtin_amdgcn_s_barrier()
#define PG8_SCHED __builtin_amdgcn_sched_barrier(0)
    Unit cur, nxt; int ui = 0;
    if (!S.next(0, cur)) return;
    typedef typename std::conditional<I8, i32x4, f32x4>::type accv_t;
    accv_t acc[2][2][4][2];
#pragma unroll
    for (int a = 0; a < 2; ++a)
#pragma unroll
        for (int b = 0; b < 2; ++b)
#pragma unroll
            for (int m = 0; m < 4; ++m)
#pragma unroll
                for (int n = 0; n < 2; ++n) acc[a][b][m][n] = (accv_t){0, 0, 0, 0};
    bf16x8 At[4][2], B0[2][2], B1[2][2];
    unsigned oc[2][2], on[2][2];
    if constexpr (GATHER) {
#pragma unroll
        for (int h = 0; h < 2; ++h)
#pragma unroll
            for (int i = 0; i < 2; ++i) { oc[h][i] = (unsigned)(S.src_row(cur, h * HALF + RA[i]) * RB + CA[i] * 2); on[h][i] = oc[h][i]; }
    }
    const char* cA = GATHER ? (const char*)g.A : (const char*)g.A + (size_t)cur.pm * tstep; const char* cB = (const char*)g.Bt + (size_t)cur.pn * tstep;
    PG8_STAGE(PG8_SB(0, 0), cB, voffB); PG8_STAGE(PG8_SB(0, 1), cB + hstep, voffB); PG8_STAGE_A(PG8_SA(0, 0), 0, cA, 0, oc); PG8_STAGE_A(PG8_SA(0, 1), 1, cA, 0, oc);
    if (wr == 1) PG8_BAR;
    PG8_WAIT_V(2); PG8_BAR;
    PG8_STAGE(PG8_SB(1, 0), cB + kstep, voffB); PG8_STAGE_A(PG8_SA(1, 0), 0, cA, kstep, oc); PG8_STAGE(PG8_SB(1, 1), cB + hstep + kstep, voffB);
    PG8_WAIT_V(6); PG8_BAR;
    for (;;) {
        const bool has_next = S.next(ui + 1, nxt);
        const char* nA = GATHER ? (const char*)g.A : (has_next ? (const char*)g.A + (size_t)nxt.pm * tstep : cA); const char* nB = has_next ? (const char*)g.Bt + (size_t)nxt.pn * tstep : cB;
        if constexpr (GATHER) {
            if (has_next) {
#pragma unroll
                for (int h = 0; h < 2; ++h)
#pragma unroll
                    for (int i = 0; i < 2; ++i) on[h][i] = (unsigned)(S.src_row(nxt, h * HALF + RA[i]) * RB + CA[i] * 2);
            }
        }
        for (int t = 0; t < nt; t += 2) {
            const bool last = (t == nt - 2);
            const size_t k1 = (size_t)(t + 1) * kstep;
            const size_t k2 = last ? (size_t)0 : (size_t)(t + 2) * kstep, k3 = k2 + kstep;
            const char* a2 = last ? nA : cA; const char* b2 = last ? nB : cB;
            unsigned o2[2][2];
            if constexpr (GATHER) {
#pragma unroll
                for (int h = 0; h < 2; ++h)
#pragma unroll
                    for (int i = 0; i < 2; ++i) o2[h][i] = last ? on[h][i] : oc[h][i];
            }
            PG8_LDB(B0, 0, 0); PG8_LDB(B1, 0, 1); PG8_SCHED; PG8_LDA(At, 0, 0); PG8_STAGE_A(PG8_SA(1, 1), 1, cA, k1, oc);
            PG8_WAIT_V(8); PG8_WAIT_L(0); PG8_BAR; PG8_MMA(0, 0, At, B0); PG8_MMA(0, 1, At, B1); PG8_BAR; PG8_SCHED;
            PG8_LDA(At, 0, 1); PG8_STAGE(PG8_SB(0, 0), b2 + k2, voffB); PG8_STAGE(PG8_SB(0, 1), b2 + hstep + k2, voffB); PG8_STAGE_A(PG8_SA(0, 0), 0, a2, k2, o2);
            PG8_WAIT_V(8); PG8_WAIT_L(0); PG8_BAR; PG8_MMA(1, 0, At, B0); PG8_MMA(1, 1, At, B1); PG8_BAR; PG8_SCHED;
            PG8_LDB(B0, 1, 0); PG8_LDB(B1, 1, 1); PG8_SCHED; PG8_LDA(At, 1, 0); PG8_STAGE_A(PG8_SA(0, 1), 1, a2, k2, o2);
            PG8_WAIT_V(8); PG8_WAIT_L(0); PG8_BAR; PG8_MMA(0, 0, At, B0); PG8_MMA(0, 1, At, B1); PG8_BAR; PG8_SCHED;
            PG8_LDA(At, 1, 1); PG8_STAGE(PG8_SB(1, 0), b2 + k3, voffB); PG8_STAGE(PG8_SB(1, 1), b2 + hstep + k3, voffB); PG8_STAGE_A(PG8_SA(1, 0), 0, a2, k3, o2);
            PG8_WAIT_V(8); PG8_WAIT_L(0); PG8_BAR; PG8_MMA(1, 0, At, B0); PG8_MMA(1, 1, At, B1); PG8_BAR; PG8_SCHED;
        }
        if (wr == 0) PG8_BAR;
        const bool rst = E(acc, cur, wr, wc, fr, fq);
        if (!has_next) break;
        if (rst) {
#pragma unroll
        for (int a = 0; a < 2; ++a)
#pragma unroll
            for (int b = 0; b < 2; ++b)
#pragma unroll
                for (int m = 0; m < 4; ++m)
#pragma unroll
                    for (int n = 0; n < 2; ++n) acc[a][b][m][n] = (accv_t){0, 0, 0, 0};
        }
        cur = nxt; cA = nA; cB = nB; ++ui;
        if constexpr (GATHER) {
#pragma unroll
            for (int h = 0; h < 2; ++h)
#pragma unroll
                for (int i = 0; i < 2; ++i) oc[h][i] = on[h][i];
        }
        if (wr == 1) PG8_BAR;
    }
    PG8_WAIT_V(0);
    PG8_BAR;
#undef PG8_SA
#undef PG8_SB
#undef PG8_STAGE
#undef PG8_STAGE_A
#undef PG8_LDA
#undef PG8_LDB
#undef PG8_MMA
#undef PG8_WAIT_V
#undef PG8_WAIT_L
#undef PG8_BAR
#undef PG8_SCHED
}
}
typedef f32x4 acc_t[2][2][4][2];
typedef i32x4 acci_t[2][2][4][2];

struct EpiProj {
    bf16_t* O; unsigned char* G8; const float* RS  ; const float* CS  ;
    __device__ __forceinline__ bool operator()(acci_t& acc, const pg8::Unit& u, int wr, int wc, int fr, int fq) const {
        const int pn = u.pn;
        const int act = (pn <= 1 || pn == 3 || pn == 4) ? 1 : (pn >= 12 ? 3 : (pn >= 8 ? 2 : 0));
        const int row0 = u.pm * 256 + wr * 64 + fr, col0 = pn * 256 + wc * 32 + 8 * fq;
        float cs[2][8];
#pragma unroll
        for (int bj = 0; bj < 2; ++bj) { const f32x4 c0 = *(const f32x4*)(CS + col0 + bj * 128), c1 = *(const f32x4*)(CS + col0 + bj * 128 + 4);
#pragma unroll
            for (int i = 0; i < 4; ++i) { cs[bj][i] = c0[i] * (act == 1 ? QSCALE : 1.f); cs[bj][4 + i] = c1[i] * (act == 1 ? QSCALE : 1.f); } }
#pragma unroll
        for (int ai = 0; ai < 2; ++ai)
#pragma unroll
            for (int m = 0; m < 4; ++m) { const int row = row0 + ai * 128 + m * 16; bf16_t* rowp = O + (size_t)row * PLD + col0; const float rs = RS[row];
#pragma unroll
                for (int bj = 0; bj < 2; ++bj) { f32x4 v0, v1;
#pragma unroll
                    for (int i = 0; i < 4; ++i) { v0[i] = (float)acc[ai][bj][m][0][i] * (rs * cs[bj][i]); v1[i] = (float)acc[ai][bj][m][1][i] * (rs * cs[bj][4 + i]); }
                    if (act == 2) {
#pragma unroll
                        for (int i = 0; i < 4; ++i) { v0[i] = gelu_tanh(v0[i]); v1[i] = gelu_tanh(v1[i]); } }
                    else if (act == 3) {
                        u32x2 w8;
                        w8.x = u8x4_floor(sigmoidf_(v0[0]) * 256.f, sigmoidf_(v0[1]) * 256.f, sigmoidf_(v0[2]) * 256.f, sigmoidf_(v0[3]) * 256.f);
                        w8.y = u8x4_floor(sigmoidf_(v1[0]) * 256.f, sigmoidf_(v1[1]) * 256.f, sigmoidf_(v1[2]) * 256.f, sigmoidf_(v1[3]) * 256.f);
                        *(u32x2*)(G8 + (size_t)row * 3072 + (col0 - C_G) + bj * 128) = w8; continue; }
                    u32x4 w; w.x = cvt_pk_bf16(v0[0], v0[1]); w.y = cvt_pk_bf16(v0[2], v0[3]); w.z = cvt_pk_bf16(v1[0], v1[1]); w.w = cvt_pk_bf16(v1[2], v1[3]);
                    *(u32x4*)(rowp + bj * 128) = w; } }
        return true;
    }
};

struct BranchOrder {
    pg8::StaticOrder so;
    __device__ __forceinline__ bool next(int j, pg8::Unit& u) const { const int i = j / 3, br = j - 3 * i; int pm, pn; if (!so.tile(i, pm, pn)) return false; u.pm = br * 256 + pm; u.pn = br * 4 + pn; return true; }
};
struct EpiBranch {
    const unsigned char* G8  ; bf16_t* MERGED;
    __device__ __forceinline__ bool operator()(acc_t& acc, const pg8::Unit& u, int wr, int wc, int fr, int fq) const {
        const int br = u.pn >> 2, pn = u.pn & 3, pm = u.pm & 255;
        const int row0 = pm * 256 + wr * 64 + fr, col0 = pn * 256 + wc * 32 + 8 * fq;
#pragma unroll
        for (int rnd = 0; rnd < 2; ++rnd) { const int ai = rnd, m0 = 0;
            u32x2 gw[4][2], gd[4][2];
#pragma unroll
            for (int m = m0; m < m0 + 4; ++m)
#pragma unroll
                for (int bj = 0; bj < 2; ++bj) { const unsigned char* gp = G8 + (size_t)(row0 + ai * 128 + m * 16) * 3072 + br * 1024 + col0 + bj * 128;
                    gw[m][bj] = *(const u32x2*)gp; if (br != 2) gd[m][bj] = *(const u32x2*)(gp + 1024); }
#pragma unroll
            for (int m = m0; m < m0 + 4; ++m) { const size_t row = (size_t)(row0 + ai * 128 + m * 16);
#pragma unroll
                for (int bj = 0; bj < 2; ++bj) {
                    const u32x2 g = gw[m][bj];
                    float gn[8];
#pragma unroll
                    for (int i = 0; i < 8; ++i) gn[i] = (float)((g[i >> 2] >> (8 * (i & 3))) & 0xffu) + 0.5f;
                    if (br != 2) { const u32x2 d = gd[m][bj];
#pragma unroll
                        for (int i = 0; i < 8; ++i) gn[i] = gn[i] * frcp((float)((d[i >> 2] >> (8 * (i & 3))) & 0xffu) + 0.5f); }
                    else {
#pragma unroll
                        for (int i = 0; i < 8; ++i) gn[i] *= (1.f / 256.f); }
                    f32x4 v0 = acc[ai][bj][m][0], v1 = acc[ai][bj][m][1];
                    v0[0] *= gn[0]; v0[1] *= gn[1]; v0[2] *= gn[2]; v0[3] *= gn[3]; v1[0] *= gn[4]; v1[1] *= gn[5]; v1[2] *= gn[6]; v1[3] *= gn[7];
                    if (br != 2) { acc[ai][bj][m][0] = v0; acc[ai][bj][m][1] = v1; }
                    else { u32x4 w; w.x = cvt_pk_bf16(v0[0], v0[1]); w.y = cvt_pk_bf16(v0[2], v0[3]); w.z = cvt_pk_bf16(v1[0], v1[1]); w.w = cvt_pk_bf16(v1[2], v1[3]);
                        *(u32x4*)(MERGED + row * DM + col0 + bj * 128) = w; } } }
            asm volatile("" ::: "memory");
        }
        return br == 2;
    }
};

struct EpiWout {
    bf16_t* Y; float* SSP;
    __device__ __forceinline__ bool operator()(acc_t& acc, const pg8::Unit& u, int wr, int wc, int fr, int fq) const {
        const int row0 = u.pm * 256 + wr * 64 + fr, col0 = u.pn * 256 + wc * 32 + 8 * fq;
#pragma unroll
        for (int ai = 0; ai < 2; ++ai)
#pragma unroll
            for (int m = 0; m < 4; ++m) { const size_t row = (size_t)(row0 + ai * 128 + m * 16); float ss = 0.f;
#pragma unroll
                for (int bj = 0; bj < 2; ++bj) { const f32x4 v0 = acc[ai][bj][m][0], v1 = acc[ai][bj][m][1];
                    ss += (v0[0] * v0[0] + v0[1] * v0[1]) + (v0[2] * v0[2] + v0[3] * v0[3]) + (v1[0] * v1[0] + v1[1] * v1[1]) + (v1[2] * v1[2] + v1[3] * v1[3]);
                    u32x4 w; w.x = cvt_pk_bf16(v0[0], v0[1]); w.y = cvt_pk_bf16(v0[2], v0[3]); w.z = cvt_pk_bf16(v1[0], v1[1]); w.w = cvt_pk_bf16(v1[2], v1[3]);
                    *(u32x4*)(Y + row * DM + col0 + bj * 128) = w; }
                ss = xor32_add(xor16_add(ss));
                if (fq == 0) SSP[row * 16 + u.pn * 4 + wc] = ss; }
        return true;
    }
};

struct MoeOrder {
    int u0, u1, NB, rt_lo;
    const LAS int* tile_e;
    const LAS int* rowidx;
    __device__ __forceinline__ bool next(int i, pg8::Unit& u) const { const int x = u0 + i; if (x >= u1) return false; const int rt = x / NB, pn = x - rt * NB; u.pm = rt; u.pn = tile_e[rt] * NB + pn; return true; }
    __device__ __forceinline__ int src_row(const pg8::Unit& u, int r) const { return rowidx[(u.pm - rt_lo) * 256 + r]; }
};
struct EpiW1 {
    bf16_t* ACT; const float* b1  ;
    __device__ __forceinline__ bool operator()(acc_t& acc, const pg8::Unit& u, int wr, int wc, int fr, int fq) const {
        const int e = u.pn >> 3, pn = u.pn & 7;
        const int row0 = u.pm * 256 + wr * 64 + fr, j0 = pn * 128 + wc * 32 + 8 * fq;
        const float* bp = b1 + (size_t)e * (2 * FF) + 2 * j0;
        float bg[8], bl[8];
#pragma unroll
        for (int q = 0; q < 4; ++q) { const f32x4 t = *(const f32x4*)(bp + 4 * q); bg[2 * q] = t[0]; bl[2 * q] = t[1]; bg[2 * q + 1] = t[2]; bl[2 * q + 1] = t[3]; }
#pragma unroll
        for (int ai = 0; ai < 2; ++ai)
#pragma unroll
            for (int m = 0; m < 4; ++m) { float a[8];
#pragma unroll
                for (int i = 0; i < 8; ++i) { float gl = acc[ai][0][m][i >> 2][i & 3] + bg[i], li = acc[ai][1][m][i >> 2][i & 3] + bl[i];
                    gl = fminf(gl, 7.f); li = fminf(fmaxf(li, -7.f), 7.f);
                    a[i] = gl * frcp(1.f + fexp2(-1.702f * LOG2E * gl)) * (li + 1.f); }
                u32x4 w; w.x = cvt_pk_bf16(a[0], a[1]); w.y = cvt_pk_bf16(a[2], a[3]); w.z = cvt_pk_bf16(a[4], a[5]); w.w = cvt_pk_bf16(a[6], a[7]);
                *(u32x4*)(ACT + (size_t)(row0 + ai * 128 + m * 16) * FF + j0) = w; }
        return true;
    }
};
constexpr float ACT_SCALE = 12.f / 127.f;
struct EpiW1I8 {
    signed char* ACT  ; const float* b1  ; const float* RS  ; const float* CS  ;
    const LAS int* rowidx; int rt_lo;
    __device__ __forceinline__ bool operator()(acci_t& acc, const pg8::Unit& u, int wr, int wc, int fr, int fq) const {
        const int e = u.pn >> 3, pn = u.pn & 7;
        const int rl0 = wr * 64 + fr, row0 = u.pm * 256 + rl0, j0 = pn * 128 + wc * 32 + 8 * fq;
        const float* bp = b1 + (size_t)e * (2 * FF) + 2 * j0;
        float bg[8], bl[8], cg[8], cl[8];
#pragma unroll
        for (int q = 0; q < 4; ++q) { const f32x4 t = *(const f32x4*)(bp + 4 * q); bg[2 * q] = t[0]; bl[2 * q] = t[1]; bg[2 * q + 1] = t[2]; bl[2 * q + 1] = t[3]; }
        { const float* cp = CS + (size_t)e * 2048 + pn * 256 + wc * 32 + 8 * fq;
          const f32x4 a0 = *(const f32x4*)cp, a1 = *(const f32x4*)(cp + 4), c0 = *(const f32x4*)(cp + 128), c1 = *(const f32x4*)(cp + 132);
#pragma unroll
          for (int i = 0; i < 4; ++i) { cg[i] = a0[i]; cg[4 + i] = a1[i]; cl[i] = c0[i]; cl[4 + i] = c1[i]; } }
        const LAS int* ri = rowidx + (u.pm - rt_lo) * 256 + rl0;
#pragma unroll
        for (int ai = 0; ai < 2; ++ai)
#pragma unroll
            for (int m = 0; m < 4; ++m) { const float rs = RS[ri[ai * 128 + m * 16]]; float a[8];
#pragma unroll
                for (int i = 0; i < 8; ++i) { float gl = (float)acc[ai][0][m][i >> 2][i & 3] * (rs * cg[i]) + bg[i], li = (float)acc[ai][1][m][i >> 2][i & 3] * (rs * cl[i]) + bl[i];
                    gl = fminf(gl, 7.f); li = fminf(fmaxf(li, -7.f), 7.f);
                    a[i] = gl * frcp(1.f + fexp2(-1.702f * LOG2E * gl)) * (li + 1.f); }
                u32x2 w; w.x = q8x4(a[0], a[1], a[2], a[3], 1.f / ACT_SCALE); w.y = q8x4(a[4], a[5], a[6], a[7], 1.f / ACT_SCALE);
                *(u32x2*)(ACT + (size_t)(row0 + ai * 128 + m * 16) * FF + j0) = w; }
        return true;
    }
};
struct EpiW2 {
    bf16_t* Y2; const float* b2  ; const float* CS  ;
    __device__ __forceinline__ bool operator()(acci_t& acc, const pg8::Unit& u, int wr, int wc, int fr, int fq) const {
        const int e = u.pn >> 2, pn = u.pn & 3;
        const int row0 = u.pm * 256 + wr * 64 + fr, col0 = pn * 256 + wc * 32 + 8 * fq;
        f32x4 bv[2][2], cv[2][2];
#pragma unroll
        for (int bj = 0; bj < 2; ++bj)
#pragma unroll
            for (int n = 0; n < 2; ++n) { bv[bj][n] = *(const f32x4*)(b2 + (size_t)e * DM + col0 + bj * 128 + 4 * n); cv[bj][n] = *(const f32x4*)(CS + (size_t)e * DM + col0 + bj * 128 + 4 * n) * ACT_SCALE; }
#pragma unroll
        for (int ai = 0; ai < 2; ++ai)
#pragma unroll
            for (int m = 0; m < 4; ++m) { bf16_t* rowp = Y2 + (size_t)(row0 + ai * 128 + m * 16) * DM + col0;
#pragma unroll
                for (int bj = 0; bj < 2; ++bj) { f32x4 v0, v1;
#pragma unroll
                    for (int i = 0; i < 4; ++i) { v0[i] = (float)acc[ai][bj][m][0][i] * cv[bj][0][i] + bv[bj][0][i]; v1[i] = (float)acc[ai][bj][m][1][i] * cv[bj][1][i] + bv[bj][1][i]; }
                    u32x4 w; w.x = cvt_pk_bf16(v0[0], v0[1]); w.y = cvt_pk_bf16(v0[2], v0[3]); w.z = cvt_pk_bf16(v1[0], v1[1]); w.w = cvt_pk_bf16(v1[2], v1[3]);
                    *(u32x4*)(rowp + bj * 128) = w; } }
        return true;
    }
};
#define XB_TMO      128
#define XB_XCNT(j)  (256  + 64 * (j))
#define XB_XSUB(j)  (1280 + 64 * (j))
#define XB_XGEN(j)  (2304 + 64 * (j))
#define XB_TOP      3328
#define XB_TOPGEN   3392
#define XCD_BAR_WORDS 3456
#define XB_SPIN_CAP (1u << 18)

__device__ __forceinline__ unsigned xb_ld(unsigned* p)              { return __hip_atomic_load(p, __ATOMIC_RELAXED, __HIP_MEMORY_SCOPE_AGENT); }
__device__ __forceinline__ unsigned xb_add(unsigned* p, unsigned v) { return __hip_atomic_fetch_add(p, v, __ATOMIC_RELAXED, __HIP_MEMORY_SCOPE_AGENT); }
__device__ __forceinline__ unsigned xb_xcc_id() { return (unsigned)__builtin_amdgcn_s_getreg((3 << 11) | 20) & 0xFu; }
#define XB_SPIN(cond, bar) do { unsigned _sp = 0; while (cond) { __builtin_amdgcn_s_sleep(1); \
    if ((++_sp & 255u) == 0u) { if (xb_ld(&(bar)[XB_TMO])) break; if (_sp > XB_SPIN_CAP) { atomicAdd(&(bar)[XB_TMO], 1u); break; } } } } while (0)

struct XcdBarrier {
    unsigned* bar; unsigned x;
    int w;
    volatile LAS unsigned* st;
};

__device__ __forceinline__ bool xb_thread0(int w) { return w == 0 && lane_id_volatile(2) == 0; }
__device__ __forceinline__ XcdBarrier xcd_barrier_post(unsigned* bar, volatile LAS unsigned* st, int w) {
    XcdBarrier b; b.bar = bar; b.x = xb_xcc_id(); b.st = st; b.w = w;
    if (xb_thread0(w)) (void)xb_add(&bar[XB_XCNT(b.x)], 1u);
    return b;
}
__device__ __forceinline__ void xcd_barrier_complete(unsigned* bar, unsigned x, unsigned& nloc, unsigned& nx) {
    const unsigned G = gridDim.x * gridDim.y * gridDim.z;
    unsigned sum, cnt, mine, sp = 0u;
    for (;;) {
        sum = 0u; cnt = 0u; mine = 0u;
#pragma unroll
        for (unsigned j = 0; j < 16; ++j) { const unsigned c = xb_ld(&bar[XB_XCNT(j)]); sum += c; cnt += (c > 0u) ? 1u : 0u; mine = (j == x) ? c : mine; }
        if (sum == G) break;
        __builtin_amdgcn_s_sleep(1);
        if ((++sp & 255u) == 0u) { if (xb_ld(&bar[XB_TMO])) break; if (sp > XB_SPIN_CAP) { atomicAdd(&bar[XB_TMO], 1u); break; } }
    }
    nloc = mine > 0u ? mine : 1u; nx = cnt > 0u ? cnt : 1u;
}

__device__ __forceinline__ void xcd_barrier(const XcdBarrier& b) {
    asm volatile("s_waitcnt vmcnt(0)" ::: "memory");
    __syncthreads();
    if (xb_thread0(b.w)) {
        unsigned* bar = b.bar;
        __builtin_amdgcn_s_waitcnt(0);
        unsigned nloc = b.st[0], nx = b.st[1];
        if (nloc == 0u) { xcd_barrier_complete(bar, b.x, nloc, nx); b.st[0] = nloc; b.st[1] = nx; }
        const unsigned old = xb_add(&bar[XB_XSUB(b.x)], 1u);
        const unsigned gen = old / nloc;
        if (old + 1u == (gen + 1u) * nloc) {
            __builtin_amdgcn_fence(__ATOMIC_RELEASE, "agent");
            asm volatile("s_waitcnt vmcnt(0)" ::: "memory");
            const unsigned og = xb_add(&bar[XB_TOP], 1u);
            const unsigned tg = og / nx;
            if (og + 1u == (tg + 1u) * nx) xb_add(&bar[XB_TOPGEN], 1u);
            else XB_SPIN(xb_ld(&bar[XB_TOPGEN]) == tg, bar);
            __builtin_amdgcn_fence(__ATOMIC_ACQUIRE, "agent");
            xb_add(&bar[XB_XGEN(b.x)], 1u);
            asm volatile("s_waitcnt vmcnt(0)" ::: "memory");
        } else {
            XB_SPIN(xb_ld(&bar[XB_XGEN(b.x)]) == gen, bar);
            __builtin_amdgcn_fence(__ATOMIC_ACQUIRE, "agent");
            asm volatile("s_waitcnt vmcnt(0)" ::: "memory");
        }
    }
    __syncthreads();
}

constexpr size_t MiB = 1u << 20;
constexpr size_t WS_CTL = 0, CTL_ZERO_BYTES = 1 * MiB;
constexpr size_t WS_MOD = 1 * MiB;
constexpr size_t WS_SGW = 3 * MiB;
constexpr size_t WS_WRT = 3 * MiB + 512 * 1024;
constexpr size_t WS_RS = 4 * MiB;
constexpr size_t WS_CS1 = 5 * MiB;
constexpr size_t WS_CS2 = 6 * MiB + 512 * 1024;
constexpr size_t WS_CSIN = 6 * MiB;
constexpr size_t WS_W = 8 * MiB, W_LAYER = 209 * MiB;
constexpr size_t WO_WIN = 0, WO_WBR = 12 * MiB, WO_WOUT = 15 * MiB, WO_W1 = 17 * MiB, WO_W2 = 145 * MiB;
constexpr size_t WS_PROJ = 426 * MiB;
constexpr size_t WS_GATES = 810 * MiB;
constexpr size_t WS_ACT = WS_PROJ;
constexpr size_t WS_H = 1194 * MiB;
constexpr size_t WS_O = 1322 * MiB;
constexpr size_t WS_Y = 1514 * MiB;
constexpr size_t WS_BITS = 1770 * MiB;
constexpr size_t WS_Y2 = WS_O;
constexpr size_t WS_SSP = 1850 * MiB;
constexpr size_t WS_ROWTOK = 1854 * MiB;
constexpr size_t WS_TOKINFO = 1862 * MiB;
constexpr size_t WS_SLAB = 1864 * MiB;
constexpr size_t WS_END = 1928 * MiB;
static_assert(WS_Y2 + (size_t)270336 * 2048 <= WS_SSP && WS_W + 2 * W_LAYER <= WS_PROJ && WS_PROJ + (size_t)MTOK * PLD * 2 <= WS_GATES && WS_GATES + (size_t)MTOK * 3072 <= WS_H, "d_ws map");
constexpr int CW_BAR = 4096;
constexpr int CW_CNT = 16384;

constexpr int RING_BYTES = 131072;
constexpr int MISC_OFF = 134144;
constexpr int TS_OFF = MISC_OFF + 512;
constexpr int TILE_E_OFF = MISC_OFF + 1024;
constexpr int ROWIDX_OFF = MISC_OFF + 5632;
constexpr int LDS_BYTES = 151552;
static_assert(ROWIDX_OFF + 8192 <= LDS_BYTES, "LDS map");

struct Args {
    const float* in[21]; float* out; unsigned char* ws; int ph_lo, ph_hi;
};
struct Frame {
    LAS unsigned char* lds; int tid, lane, wave, vcu, G;
};
__device__ __forceinline__ Frame phase_frame(const Frame& F0) { Frame F = F0; int t = F0.wave * 64 + lane_id_volatile(3); asm volatile("" : "+v"(t)); F.tid = t; F.lane = t & 63; F.wave = F0.wave; return F; }
template <class T> __device__ __forceinline__ T* opq(T* p) { long z = 0; asm volatile("" : "+s"(z)); return (T*)((unsigned char*)p + z); }

__device__ __forceinline__ void p0_mod(const Frame& F, const float* c, const float* w_ada, const float* b_ada, float* MOD) {
    LAS float* csT = (LAS float*)F.lds;
    for (int i = F.tid; i < BATCH * DM; i += 512) { const int b = i & 31, k = i >> 5; const float v = c[b * DM + k]; csT[k * 32 + b] = v * sigmoidf_(v); }
    __syncthreads();
    const int gw = F.vcu * 8 + F.wave, NGW = F.G * 8;
    const int cg = F.lane & 15, kq = F.lane >> 4;
    for (int task = gw; task < DEPTH * 384; task += NGW) {
        const int l = task / 384, n = (task % 384) * 16 + cg;
        float acc[32];
#pragma unroll
        for (int b = 0; b < 32; ++b) acc[b] = 0.f;
        const float* w = w_ada + ((size_t)l * DM + kq * 256) * (6 * DM) + n;
#pragma unroll 4
        for (int k = 0; k < 256; ++k) {
            const float wv = w[(size_t)k * (6 * DM)];
            const LAS f32x4* cs = (const LAS f32x4*)(csT + (kq * 256 + k) * 32);
#pragma unroll
            for (int q = 0; q < 8; ++q) { const f32x4 c4 = cs[q]; acc[4 * q] += c4[0] * wv; acc[4 * q + 1] += c4[1] * wv; acc[4 * q + 2] += c4[2] * wv; acc[4 * q + 3] += c4[3] * wv; }
        }
#pragma unroll
        for (int b = 0; b < 32; ++b) { acc[b] = xor32_add(xor16_add(acc[b])); }
        if (kq == 0) { const float bb = b_ada[l * 6 * DM + n];
#pragma unroll
            for (int b = 0; b < 32; ++b) MOD[((size_t)l * BATCH + b) * (6 * DM) + n] = acc[b] + bb; }
    }
    __syncthreads();
}
__device__ __forceinline__ void tr_item(const float* W, size_t ldw, int srccol, bool valid, bf16_t* dst  , int K, LAS float* scr, int lane) {
    const float* wp = W + srccol;
#pragma unroll 8
    for (int i = 0; i < 32; ++i) { const int kk = 2 * i + (lane >> 5); scr[kk * 33 + (lane & 31)] = valid ? wp[(size_t)kk * ldw] : 0.f; }
    LDS_WAIT(); asm volatile("" ::: "memory");
    const int c = lane & 7;
#pragma unroll
    for (int j = 0; j < 4; ++j) { const int n = (lane >> 3) + 8 * j; const LAS float* s = scr + (8 * c) * 33 + n;
        u32x4 o; o.x = cvt_pk_bf16(s[0 * 33], s[1 * 33]); o.y = cvt_pk_bf16(s[2 * 33], s[3 * 33]); o.z = cvt_pk_bf16(s[4 * 33], s[5 * 33]); o.w = cvt_pk_bf16(s[6 * 33], s[7 * 33]);
        *(u32x4*)(dst + (size_t)n * K + 8 * c) = o; }
    LDS_WAIT(); asm volatile("" ::: "memory");
}
__device__ __forceinline__ void p0_weights(const Frame& F, const Args& a) {
    LAS float* scr = (LAS float*)(F.lds + F.wave * 16384);
    const int gw = F.vcu * 8 + F.wave, NGW = F.G * 8, lane = F.lane, jl = lane & 31;
    const float *w_in = a.in[8], *w_branch = a.in[13], *w_out = a.in[14], *w_router = a.in[15], *w1 = a.in[17], *w2 = a.in[19];
    constexpr int I_BR = 3 * 8 * 32, I_OUT = 16 * 32, I_RT = 16;
    constexpr int I_LAYER = I_BR + I_OUT + I_RT;
    for (int it = gw; it < DEPTH * I_LAYER; it += NGW) {
        const int l = it / I_LAYER; int r = it - l * I_LAYER;
        unsigned char* wl = a.ws + WS_W + (size_t)l * W_LAYER;
        if (r < I_BR) {
            const int br = r / 256, q = r % 256, kb = q / 32, nb = q % 32;
            tr_item(w_branch + ((size_t)(l * 3 + br) * 512 + kb * 64) * DM, DM, nb * 32 + jl, true, (bf16_t*)(wl + WO_WBR) + (size_t)(br * 1024 + nb * 32) * 512 + kb * 64, 512, scr, lane); continue; }
        r -= I_BR;
        if (r < I_OUT) {
            const int kb = r / 32, nb = r % 32;
            tr_item(w_out + ((size_t)l * DM + kb * 64) * DM, DM, nb * 32 + jl, true, (bf16_t*)(wl + WO_WOUT) + (size_t)nb * 32 * DM + kb * 64, DM, scr, lane); continue; }
        r -= I_OUT;
        {
            const int kb = r;
            tr_item(w_router + ((size_t)l * DM + kb * 64) * NE, NE, jl, true, (bf16_t*)(a.ws + WS_WRT) + (size_t)l * NE * DM + kb * 64, DM, scr, lane); }
        (void)r;
    }
    __syncthreads();
    {
    LAS float* T = (LAS float*)F.lds; LAS float* red = (LAS float*)(F.lds + ROWIDX_OFF);
    const int half = lane >> 5, wave = F.wave;
    constexpr int ST_W1 = NE * 64, ST_IN = 192, ST_W2 = NE * 32, ST_LAYER = ST_W1 + ST_IN + ST_W2;
    for (int st = F.vcu; st < DEPTH * ST_LAYER; st += F.G) {
        const int l = st / ST_LAYER, q = st % ST_LAYER;
        const float* wp; size_t ldw; bool valid = true; signed char* dst; float* csp;
        if (q < ST_W1) { const int e = q / 64, r6 = q % 64, pn = r6 >> 3, jjg = (r6 >> 1) & 3, sgl = r6 & 1, nb = pn * 8 + sgl * 4 + jjg, n = nb * 32 + jl, src = 2 * (128 * pn + jjg * 32 + jl) + sgl;
            wp = w1 + ((size_t)(l * NE + e) * DM) * (2 * FF) + src; ldw = 2 * FF;
            dst = (signed char*)(a.ws + WS_W + (size_t)l * W_LAYER + WO_W1) + ((size_t)e * 2048 + nb * 32) * DM; csp = (float*)(a.ws + WS_CS1) + ((size_t)l * NE + e) * 2048 + n; }
        else if (q >= ST_W1 + ST_IN) { const int q2 = q - ST_W1 - ST_IN, e = q2 / 32, nb = q2 % 32, n = nb * 32 + jl;
            wp = w2 + ((size_t)(l * NE + e) * FF) * DM + n; ldw = DM;
            dst = (signed char*)(a.ws + WS_W + (size_t)l * W_LAYER + WO_W2) + ((size_t)e * DM + nb * 32) * FF; csp = (float*)(a.ws + WS_CS2) + ((size_t)l * NE + e) * DM + n; }
        else { const int nb = q - ST_W1, n = nb * 32 + jl; valid = (n < 1832) || (n >= 2048); const int src = n < 1832 ? n : n - 216;
            wp = w_in + (size_t)l * DM * 5928 + (valid ? src : 0); ldw = 5928;
            dst = (signed char*)(a.ws + WS_W + (size_t)l * W_LAYER + WO_WIN) + (size_t)nb * 32 * DM; csp = (float*)(a.ws + WS_CSIN) + (size_t)l * NPROJ + n; }
        float am = 0.f;
#pragma unroll
        for (int ib = 0; ib < 2; ++ib) { float vv[32];
#pragma unroll
            for (int i = 0; i < 32; ++i) { const int k = wave * 128 + 2 * (ib * 32 + i) + half; vv[i] = valid ? __builtin_nontemporal_load(wp + (size_t)k * ldw) : 0.f; }
#pragma unroll
            for (int i = 0; i < 32; ++i) { const int k = wave * 128 + 2 * (ib * 32 + i) + half; am = fmaxf(am, fabsf(vv[i])); T[k * 32 + (jl ^ (k & 31))] = vv[i]; } }
        red[(wave * 2 + half) * 32 + jl] = am;
        __syncthreads();
        float amx = 0.f;
#pragma unroll
        for (int p = 0; p < 16; ++p) amx = fmaxf(amx, red[p * 32 + jl]);
        const float scale = valid ? fmaxf(amx, 1e-30f) * (1.f / 127.f) : 1.f, inv = valid ? 1.f / scale : 0.f;
        if (wave == 0 && half == 0) *csp = scale;
        const int k0 = 64 * (wave * 2 + half);
#pragma unroll
        for (int c16 = 0; c16 < 4; ++c16) { unsigned wq[4];
#pragma unroll
            for (int d4 = 0; d4 < 4; ++d4) { const int k = k0 + c16 * 16 + d4 * 4;
                wq[d4] = q8x4(T[k * 32 + (jl ^ (k & 31))], T[(k + 1) * 32 + (jl ^ ((k + 1) & 31))], T[(k + 2) * 32 + (jl ^ ((k + 2) & 31))], T[(k + 3) * 32 + (jl ^ ((k + 3) & 31))], inv); }
            *(u32x4*)(dst + (size_t)jl * DM + k0 + c16 * 16) = (u32x4){wq[0], wq[1], wq[2], wq[3]}; }
        __syncthreads();
    }
    }
    const float* sg_w = a.in[10]; bf16_t* SGW = (bf16_t*)(a.ws + WS_SGW);
    for (int i = (F.vcu * 512 + F.tid) * 2; i < DEPTH * 8 * 128 * 128; i += F.G * 512 * 2) { const int s = i & 127, t = (i >> 7) & 127; const f32x2 v = *(const f32x2*)(sg_w + i);
        *(unsigned*)(SGW + i) = cvt_pk_bf16(s <= t ? v[0] : 0.f, (s + 1) <= t ? v[1] : 0.f); }
}

__device__ __forceinline__ void norm_mod_row(const f32x4 (&v)[4], float ss, const float* g, const float* sc, const float* sh, signed char* orow, float* rs, int lane) {
    const float rstd = 1.f / sqrtf(ss * (1.f / DM) + RMS_EPS);
    f32x4 o[4]; float am = 0.f;
#pragma unroll
    for (int j = 0; j < 4; ++j) { const int c = 4 * lane + 256 * j; const f32x4 gg = *(const f32x4*)(g + c), s1 = *(const f32x4*)(sc + c), s0 = *(const f32x4*)(sh + c);
        o[j] = (v[j] * rstd) * gg * (s1 + 1.f) + s0;
        am = fmaxf(am, fmaxf(fmaxf(fabsf(o[j][0]), fabsf(o[j][1])), fmaxf(fabsf(o[j][2]), fabsf(o[j][3])))); }
    am = wave_max(am);
    const float scale = fmaxf(am, 1e-30f) * (1.f / 127.f), inv = 1.f / scale;
    if (lane == 0) *rs = scale;
#pragma unroll
    for (int j = 0; j < 4; ++j) *(unsigned*)(orow + 4 * lane + 256 * j) = q8x4(o[j][0], o[j][1], o[j][2], o[j][3], inv);
}
__device__ __forceinline__ void p1_norm(const Frame& F, const float* x, const float* g, const float* MOD0, signed char* H8, float* RS) {
    const int gw = F.vcu * 8 + F.wave, NGW = F.G * 8;
    for (int row0 = gw * 4; row0 < MTOK; row0 += NGW * 4) { f32x4 v[4][4];
#pragma unroll
        for (int rr = 0; rr < 4; ++rr)
#pragma unroll
            for (int j = 0; j < 4; ++j) v[rr][j] = __builtin_nontemporal_load((const f32x4*)(x + (size_t)(row0 + rr) * DM + 4 * F.lane + 256 * j));
#pragma unroll
        for (int rr = 0; rr < 4; ++rr) { const int row = row0 + rr, b = row >> 11; float ss = 0.f;
#pragma unroll
            for (int j = 0; j < 4; ++j) ss += (v[rr][j][0] * v[rr][j][0] + v[rr][j][1] * v[rr][j][1]) + (v[rr][j][2] * v[rr][j][2] + v[rr][j][3] * v[rr][j][3]);
            ss = wave_sum(ss);
            const float* mb = MOD0 + (size_t)b * 6 * DM;
            norm_mod_row(v[rr], ss, g, mb + DM, mb, H8 + (size_t)row * DM, RS + row, F.lane); } }
}
constexpr int TOPK_SEL = 256;
struct IdxOps { bf16x8 af[4][2]; u32x4 wraw[4][2]; bf16x8 kf[4][2]; };
__device__ __forceinline__ void dsa_index_load(IdxOps& P, const bf16_t* __restrict__ PROJ, int b, int qg, int lane, int wid) {
    asm volatile("" : "+v"(lane));
    const int n = lane & 31, hi = lane >> 5;
    const int q0 = qg * 16;
    const size_t tokbase = (size_t)b * SEQ;
    const int m = n, hm = (m >> 2) & 1, idx = (m & 3) + 4 * (m >> 3), aq = 2 * hm + (idx >> 3), ah = idx & 7;
#pragma unroll
    for (int qgp = 0; qgp < 4; ++qgp) { const bf16_t* qp = PROJ + (tokbase + q0 + 4 * qgp + aq) * PLD + C_QI + ah * 32 + 8 * hi;
        P.af[qgp][0] = *(const bf16x8*)qp; P.af[qgp][1] = *(const bf16x8*)(qp + 16); }
}
__device__ __forceinline__ void dsa_index_load_k(IdxOps& P, const bf16_t* __restrict__ PROJ, int b, int qg, int lane, int wid) {
    asm volatile("" : "+v"(lane));
    const int n = lane & 31, hi = lane >> 5;
    const int q0 = qg * 16, nkb = (q0 + 16 + 31) >> 5;
    const size_t tokbase = (size_t)b * SEQ;
#pragma unroll
    for (int qgp = 0; qgp < 4; ++qgp)
#pragma unroll
        for (int qq = 0; qq < 2; ++qq) P.wraw[qgp][qq] = *(const u32x4*)(PROJ + (tokbase + q0 + 4 * qgp + 2 * hi + qq) * PLD + C_WI);
#pragma unroll
    for (int i = 0; i < 4; ++i) { const int kb = wid + 8 * i;
        if (kb < nkb) { const bf16_t* kp = PROJ + (tokbase + 32 * kb + n) * PLD + C_KI + 8 * hi; P.kf[i][0] = *(const bf16x8*)kp; P.kf[i][1] = *(const bf16x8*)(kp + 16); } }
}
__device__ __forceinline__ void dsa_index_scores(IdxOps& P, const bf16_t* __restrict__ PROJ, LAS float* sc, int b, int qg, int lane, int wid) {
    const int n = lane & 31, hi = lane >> 5;
    const int q0 = qg * 16, nkb = (q0 + 16 + 31) >> 5;
    const size_t tokbase = (size_t)b * SEQ;
    LAS float* scw = sc + (2 * hi) * 2048 + 32 * wid + n;
    float wv[4][16];
#pragma unroll
    for (int qgp = 0; qgp < 4; ++qgp)
#pragma unroll
        for (int qq = 0; qq < 2; ++qq) { const u32x4 w = P.wraw[qgp][qq];
            wv[qgp][8 * qq + 0] = bf_lo(w.x) * 0.0625f; wv[qgp][8 * qq + 1] = bf_hi(w.x) * 0.0625f; wv[qgp][8 * qq + 2] = bf_lo(w.y) * 0.0625f; wv[qgp][8 * qq + 3] = bf_hi(w.y) * 0.0625f;
            wv[qgp][8 * qq + 4] = bf_lo(w.z) * 0.0625f; wv[qgp][8 * qq + 5] = bf_hi(w.z) * 0.0625f; wv[qgp][8 * qq + 6] = bf_lo(w.w) * 0.0625f; wv[qgp][8 * qq + 7] = bf_hi(w.w) * 0.0625f; }
#pragma unroll
    for (int i = 0; i < 8; ++i) { const int kb = wid + 8 * i;
        if (kb < nkb) {
            const bf16x8 k0 = P.kf[i & 3][0], k1 = P.kf[i & 3][1];
            if (i < 4 && kb + 32 < nkb) { const bf16_t* kp = PROJ + (tokbase + 32 * (kb + 32) + n) * PLD + C_KI + 8 * hi; P.kf[i & 3][0] = *(const bf16x8*)kp; P.kf[i & 3][1] = *(const bf16x8*)(kp + 16); }
#pragma unroll
            for (int qgp = 0; qgp < 4; ++qgp) {
                f32x16 d = {0.f, 0.f, 0.f, 0.f, 0.f, 0.f, 0.f, 0.f, 0.f, 0.f, 0.f, 0.f, 0.f, 0.f, 0.f, 0.f};
                d = __builtin_amdgcn_mfma_f32_32x32x16_bf16(P.af[qgp][0], k0, d, 0, 0, 0);
                d = __builtin_amdgcn_mfma_f32_32x32x16_bf16(P.af[qgp][1], k1, d, 0, 0, 0);
                float sa = 0.f, sb = 0.f;
#pragma unroll
                for (int r = 0; r < 8; ++r) { sa += wv[qgp][r] * fmaxf(d[r], 0.f); sb += wv[qgp][8 + r] * fmaxf(d[8 + r], 0.f); }
                scw[(4 * qgp) * 2048 + 256 * i] = sa; scw[(4 * qgp + 1) * 2048 + 256 * i] = sb;
            } } }
}
__device__ __forceinline__ void bit_transpose32(unsigned (&a)[32]) {
#pragma unroll
    for (int k = 0; k < 16; ++k) { const unsigned lo = a[k], hi = a[k + 16];
        a[k] = __builtin_amdgcn_perm(hi, lo, 0x05040100u); a[k + 16] = __builtin_amdgcn_perm(hi, lo, 0x07060302u); }
#pragma unroll
    for (int k = 0; k < 32; ++k) if ((k & 8) == 0) { const unsigned lo = a[k], hi = a[k + 8];
        a[k] = __builtin_amdgcn_perm(hi, lo, 0x06020400u); a[k + 8] = __builtin_amdgcn_perm(hi, lo, 0x07030501u); }
#pragma unroll
    for (int s = 0; s < 3; ++s) { const int j = 4 >> s; const unsigned m = (s == 0) ? 0x0F0F0F0Fu : (s == 1) ? 0x33333333u : 0x55555555u;
#pragma unroll
        for (int k = 0; k < 32; ++k) if ((k & j) == 0) { const unsigned lo = a[k], hi = a[k + j];
            a[k] = (m & lo) | (~m & (hi << j)); a[k + j] = (m & (lo >> j)) | (~m & hi); } }
}
__device__ __forceinline__ void dsa_index_select(LAS float* sc, LAS int* qctr, unsigned long long* __restrict__ bits64, int b, int qg, int lane, int wid) {
    const int q0 = qg * 16;
    const size_t tokbase = (size_t)b * SEQ;
#pragma unroll 1
    for (;;) {
        int qn = 0; if (lane == 0) qn = __hip_atomic_fetch_add(qctr, 1, __ATOMIC_RELAXED, __HIP_MEMORY_SCOPE_WORKGROUP);
        qn = __builtin_amdgcn_readfirstlane(qn); if (qn >= 16) break;
        const int ql = 15 - qn, pos = q0 + ql, nn = pos + 1, nr = (nn + 63) >> 6;
        const LAS float* scq = sc + ql * 2048;
        unsigned mlo = 0u, mhi = 0u;
        if (nn <= TOPK_SEL) {
#pragma unroll
            for (int r = 0; r < 4; ++r) if (r < nr) { const unsigned long long bal = __ballot(64 * r + lane <= pos); asm volatile("s_nop 4\n\tv_writelane_b32 %0, %2, %4\n\tv_writelane_b32 %1, %3, %4" : "+v"(mlo), "+v"(mhi) : "s"((unsigned)bal), "s"((unsigned)(bal >> 32)), "n"(r));     }
        } else {
            unsigned u[32];
#pragma unroll
            for (int r = 0; r < 32; ++r) u[r] = 0u;
#pragma unroll
            for (int g8 = 0; g8 < 4; ++g8) if (8 * g8 < nr) {
#pragma unroll
                for (int q_ = 0; q_ < 8; ++q_) { const int r = 8 * g8 + q_; const int j = 64 * r + lane; float s = scq[j]; s = (s == 0.f) ? 0.f : s; const unsigned bts = __builtin_bit_cast(unsigned, s);
                    const unsigned uu = (bts & 0x80000000u) ? ~bts : (bts | 0x80000000u); u[r] = (j <= pos) ? uu : 0u; } }
            unsigned M = 0u;
#pragma unroll
            for (int r = 0; r < 32; ++r) M |= (64 * r + lane <= pos) ? (1u << r) : 0u;
            bit_transpose32(u);
            unsigned G = 0u; unsigned need = (unsigned)TOPK_SEL, cM = (unsigned)nn;
            {
#pragma unroll
            for (int bq = 31; bq >= 0; --bq) {
                const unsigned T = M & u[bq];
                const unsigned c = wave_sum_u32((unsigned)__builtin_popcount(T));
                const bool ge = c >= need;
                G |= ge ? 0u : T; M = ge ? T : (M & ~u[bq]); cM = ge ? c : cM - c; need -= ge ? 0u : c;
                if (cM == need) { G |= M; goto sel_done; }
            }
            unsigned run = 0u;
#pragma unroll
            for (int r = 0; r < 32; ++r) if (r < nr) { const bool isc = (M >> r) & 1u; const unsigned long long eqm = __ballot(isc);
                const unsigned pre = run + __builtin_amdgcn_mbcnt_hi((unsigned)(eqm >> 32), __builtin_amdgcn_mbcnt_lo((unsigned)eqm, 0u));
                if (isc && pre < need) G |= (1u << r);
                run += (unsigned)__builtin_popcountll(eqm); }
            }
            sel_done:
#pragma unroll
            for (int r = 0; r < 32; ++r) if ((r & ~7) < nr) { const unsigned long long bal = __ballot((G >> r) & 1u); asm volatile("s_nop 4\n\tv_writelane_b32 %0, %2, %4\n\tv_writelane_b32 %1, %3, %4" : "+v"(mlo), "+v"(mhi) : "s"((unsigned)bal), "s"((unsigned)(bal >> 32)), "n"(r));     }
        }
        if (lane < nr) bits64[(tokbase + pos) * 32 + lane] = ((unsigned long long)mhi << 32) | mlo;
    }
}
__device__ __forceinline__ void dsa_index_phase(const Frame& F, const bf16_t* __restrict__ PROJ, unsigned long long* __restrict__ bits64, unsigned* stampw) {
    LAS float* sc = (LAS float*)F.lds;
    LAS int* qctr = (LAS int*)(F.lds + TS_OFF);
    IdxOps P;
    int u = F.vcu;
    if (u < 4096) { dsa_index_load(P, PROJ, u & 31, u >> 5, F.lane, F.wave); dsa_index_load_k(P, PROJ, u & 31, u >> 5, F.lane, F.wave); }
#ifdef T_STAMP
    unsigned long long tA = 0, tB = 0, tC = 0, tD = 0, t0 = __builtin_amdgcn_s_memrealtime(), t1;
#define STAMP(acc) do { t1 = __builtin_amdgcn_s_memrealtime(); acc += t1 - t0; t0 = t1; } while (0)
#else
#define STAMP(acc) do { } while (0)
#endif
#pragma unroll 1
    for (; u < 4096; u += F.G) {
        dsa_index_scores(P, PROJ, sc, u & 31, u >> 5, F.lane, F.wave);
        if (F.tid == 0) *qctr = 0;
        STAMP(tA);
        __syncthreads();
        STAMP(tB);
        const int un = u + F.G;
        dsa_index_select(sc, qctr, bits64, u & 31, u >> 5, F.lane, F.wave);
        asm volatile("" ::: "memory");
        if (un < 4096) { dsa_index_load(P, PROJ, un & 31, un >> 5, F.lane, F.wave); dsa_index_load_k(P, PROJ, un & 31, un >> 5, F.lane, F.wave); }
        STAMP(tC);
        __syncthreads();
        STAMP(tD);
    }
#ifdef T_STAMP
    if (stampw && blockIdx.x == 17 && F.tid == 0) { const unsigned long long tot = tA + tB + tC + tD; const unsigned long long part = (T_STAMP == 0) ? tA : (T_STAMP == 1) ? tB : (T_STAMP == 2) ? tC : tD;
        *stampw = (unsigned)((part * 64ull) / (tot ? tot : 1ull)); }
#endif
#undef STAMP
}

constexpr int KS = 144, VS = 192;
#ifndef USE_TR
#define USE_TR 1
#endif
template <int MODE>
__device__ __forceinline__ void attn_unit(const Frame& F, const bf16_t* __restrict__ PROJ, bf16_t* __restrict__ O, const unsigned* __restrict__ bits, const float* __restrict__ sinks, int b, int g, int qb) {
    const int tid = F.tid, lane = F.lane, wid = F.wave, n = lane & 31, hi = lane >> 5;
    constexpr int CQ = MODE ? C_QB : C_QA, CK = MODE ? C_KB : C_KA, CV = MODE ? C_VB : C_VA;
    const int hq = 4 * g + (wid >> 1), qpos = qb * 64 + 32 * (wid & 1) + n;
    const size_t tokbase = (size_t)b * SEQ;
    LAS unsigned char* Ks = F.lds; LAS unsigned char* Vs = F.lds + 64 * KS;
    bf16x8 qf[4];
    { const bf16_t* qp = PROJ + (tokbase + qpos) * PLD + CQ + hq * 64 + 8 * hi;
#pragma unroll
      for (int s = 0; s < 4; ++s) qf[s] = *(const bf16x8*)(qp + 16 * s); }
    f32x16 o0, o1;
#pragma unroll
    for (int r = 0; r < 16; ++r) { o0[r] = 0.f; o1[r] = 0.f; }
    float mrun, lsum;
    if (MODE == 0) { mrun = sinks[hq] * LOG2E; lsum = (hi == 0) ? 1.f : 0.f; } else { mrun = -1e30f; lsum = 0.f; }
    const int kt_lo = (MODE == 0) ? (qb >= 2 ? qb - 2 : 0) : 0, kt_hi = qb;
    const int srow = tid >> 3, sch = tid & 7;
    const bf16_t* kg = PROJ + (tokbase + srow) * PLD + CK + g * 64 + sch * 8;
    const bf16_t* vg = PROJ + (tokbase + srow) * PLD + CV + g * 64 + sch * 8;
    const unsigned* bp = bits + (tokbase + qpos) * 64;
    u32x4 kreg = *(const u32x4*)(kg + (size_t)kt_lo * 64 * PLD), vreg = *(const u32x4*)(vg + (size_t)kt_lo * 64 * PLD);
    u32x2 mreg = {0u, 0u};
    if (MODE == 1) mreg = *(const u32x2*)(bp + 2 * kt_lo);
    const int vbase = (4 * hi + ((lane & 15) >> 2)) * VS + (16 * ((lane >> 4) & 1) + 4 * (lane & 3)) * 2;
    for (int kt = kt_lo; kt <= kt_hi; ++kt) {
        __syncthreads();
        *(LAS u32x4*)(Ks + srow * KS + sch * 16) = kreg; *(LAS u32x4*)(Vs + srow * VS + sch * 16) = vreg;
        const u32x2 mcur = mreg;
        __syncthreads();
        if (kt < kt_hi) { kreg = *(const u32x4*)(kg + (size_t)(kt + 1) * 64 * PLD); vreg = *(const u32x4*)(vg + (size_t)(kt + 1) * 64 * PLD); if (MODE == 1) mreg = *(const u32x2*)(bp + 2 * (kt + 1)); }
        f32x16 p0, p1;
#pragma unroll
        for (int r = 0; r < 16; ++r) { p0[r] = 0.f; p1[r] = 0.f; }
#pragma unroll
        for (int s = 0; s < 4; ++s) { const bf16x8 k0 = *(const LAS bf16x8*)(Ks + n * KS + (16 * s + 8 * hi) * 2), k1 = *(const LAS bf16x8*)(Ks + (n + 32) * KS + (16 * s + 8 * hi) * 2);
            p0 = __builtin_amdgcn_mfma_f32_32x32x16_bf16(k0, qf[s], p0, 0, 0, 0); p1 = __builtin_amdgcn_mfma_f32_32x32x16_bf16(k1, qf[s], p1, 0, 0, 0); }
        unsigned w0, w1;
        if (MODE == 1) { w0 = mcur.x >> (4 * hi); w1 = mcur.y >> (4 * hi); }
        else {
#pragma unroll
            for (int blk = 0; blk < 2; ++blk) { const int d0 = qpos - (kt * 64 + 32 * blk); unsigned mk = 0u;
                if (d0 >= 0) { const int hb = d0 > 31 ? 31 : d0; int lo = d0 - 127; if (lo <= 31) { if (lo < 0) lo = 0; mk = (0xFFFFFFFFu >> (31 - hb)) & (0xFFFFFFFFu << lo); } }
                if (blk == 0) w0 = mk >> (4 * hi); else w1 = mk >> (4 * hi); }
        }
        float mx = fmaxf(fmaxf(p0[0], p0[1]), fmaxf(p1[0], p1[1]));
#pragma unroll
        for (int r = 2; r < 16; r += 2) mx = fmaxf(mx, fmaxf(fmaxf(p0[r], p0[r + 1]), fmaxf(p1[r], p1[r + 1])));
        mx = xor32_max(mx);
        const float mnew = fmaxf(mrun, mx), alpha = fexp2(mrun - mnew); mrun = mnew;
        float ps = 0.f;
#pragma unroll
        for (int r = 0; r < 16; ++r) { const int bitpos = 8 * (r >> 2) + (r & 3);
            const float e0 = fexp2(p0[r] - mnew), e1 = fexp2(p1[r] - mnew);
            p0[r] = __builtin_bit_cast(float, __builtin_bit_cast(unsigned, e0) & (unsigned)__builtin_amdgcn_sbfe((int)w0, bitpos, 1));
            p1[r] = __builtin_bit_cast(float, __builtin_bit_cast(unsigned, e1) & (unsigned)__builtin_amdgcn_sbfe((int)w1, bitpos, 1));
            ps += p0[r] + p1[r]; }
        lsum = lsum * alpha + ps;
        if (__builtin_amdgcn_ballot_w64(alpha != 1.f) != 0ull) {
#pragma unroll
            for (int r = 0; r < 16; ++r) { o0[r] *= alpha; o1[r] *= alpha; } }
        bf16x8 pf[2][2];
#pragma unroll
        for (int s2 = 0; s2 < 2; ++s2) { u32x4 a, c;
            a.x = cvt_pk_bf16(p0[8 * s2 + 0], p0[8 * s2 + 1]); a.y = cvt_pk_bf16(p0[8 * s2 + 2], p0[8 * s2 + 3]); a.z = cvt_pk_bf16(p0[8 * s2 + 4], p0[8 * s2 + 5]); a.w = cvt_pk_bf16(p0[8 * s2 + 6], p0[8 * s2 + 7]);
            c.x = cvt_pk_bf16(p1[8 * s2 + 0], p1[8 * s2 + 1]); c.y = cvt_pk_bf16(p1[8 * s2 + 2], p1[8 * s2 + 3]); c.z = cvt_pk_bf16(p1[8 * s2 + 4], p1[8 * s2 + 5]); c.w = cvt_pk_bf16(p1[8 * s2 + 6], p1[8 * s2 + 7]);
            pf[0][s2] = __builtin_bit_cast(bf16x8, a); pf[1][s2] = __builtin_bit_cast(bf16x8, c); }
#pragma unroll
        for (int db = 0; db < 2; ++db)
#pragma unroll
            for (int blk = 0; blk < 2; ++blk)
#pragma unroll
                for (int s2 = 0; s2 < 2; ++s2) {
                    bf16x8 vf;
#if USE_TR
                    const v4i16_t t0 = __builtin_amdgcn_ds_read_tr16_b64_v4i16((LAS v4i16_t*)(Vs + vbase + (32 * blk + 16 * s2) * VS + 64 * db));
                    const v4i16_t t1 = __builtin_amdgcn_ds_read_tr16_b64_v4i16((LAS v4i16_t*)(Vs + vbase + (32 * blk + 16 * s2 + 8) * VS + 64 * db));
                    vf = (bf16x8){t0[0], t0[1], t0[2], t0[3], t1[0], t1[1], t1[2], t1[3]};
#else
#pragma unroll
                    for (int j = 0; j < 8; ++j) vf[j] = *(const LAS short*)(Vs + (32 * blk + 16 * s2 + 8 * (j >> 2) + 4 * hi + (j & 3)) * VS + (32 * db + n) * 2);
#endif
                    if (db == 0) o0 = __builtin_amdgcn_mfma_f32_32x32x16_bf16(vf, pf[blk][s2], o0, 0, 0, 0); else o1 = __builtin_amdgcn_mfma_f32_32x32x16_bf16(vf, pf[blk][s2], o1, 0, 0, 0);
                }
    }
    const float lt = xor32_add(lsum), inv = 1.f / lt;
    bf16_t* op = O + (tokbase + qpos) * 512 + hq * 64 + 8 * hi;
#pragma unroll
    for (int db = 0; db < 2; ++db)
#pragma unroll
        for (int kp = 0; kp < 2; ++kp) { const int r0 = 8 * kp;
            unsigned ax, ay, bx, by;
            if (db == 0) { ax = cvt_pk_bf16(o0[r0] * inv, o0[r0 + 1] * inv); ay = cvt_pk_bf16(o0[r0 + 2] * inv, o0[r0 + 3] * inv); bx = cvt_pk_bf16(o0[r0 + 4] * inv, o0[r0 + 5] * inv); by = cvt_pk_bf16(o0[r0 + 6] * inv, o0[r0 + 7] * inv); }
            else { ax = cvt_pk_bf16(o1[r0] * inv, o1[r0 + 1] * inv); ay = cvt_pk_bf16(o1[r0 + 2] * inv, o1[r0 + 3] * inv); bx = cvt_pk_bf16(o1[r0 + 4] * inv, o1[r0 + 5] * inv); by = cvt_pk_bf16(o1[r0 + 6] * inv, o1[r0 + 7] * inv); }
            { auto r = __builtin_amdgcn_permlane32_swap(ax, bx, false, false); ax = r[0]; bx = r[1]; }
            { auto r = __builtin_amdgcn_permlane32_swap(ay, by, false, false); ay = r[0]; by = r[1]; }
            *(u32x4*)(op + 32 * db + 16 * kp) = (u32x4){ax, ay, bx, by}; }
}

constexpr int SGS = 1040;
static_assert(128 * SGS <= MISC_OFF, "spatial-gating tile vs LDS control words");
__device__ __forceinline__ void sg_unit(const Frame& F, const bf16_t* __restrict__ PROJ, const bf16_t* __restrict__ SGWl, const float* __restrict__ sgb, const float* __restrict__ lng, bf16_t* __restrict__ OC, int b, int ch) {
    const int lane = F.lane, wid = F.wave, n = lane & 31, hi = lane >> 5;
    const size_t tok0 = (size_t)b * SEQ + ch * 128;
    LAS unsigned char* V = F.lds;
    __syncthreads();
    float gl[8];
    { const f32x4 g0 = *(const f32x4*)(lng + 8 * lane), g1 = *(const f32x4*)(lng + 8 * lane + 4); gl[0] = g0[0]; gl[1] = g0[1]; gl[2] = g0[2]; gl[3] = g0[3]; gl[4] = g1[0]; gl[5] = g1[1]; gl[6] = g1[2]; gl[7] = g1[3]; }
    u32x4 wrow16[16];
#pragma unroll
    for (int rr = 0; rr < 16; ++rr) wrow16[rr] = *(const u32x4*)(PROJ + (tok0 + 16 * wid + rr) * PLD + C_V + 8 * lane);
#pragma unroll
    for (int rr = 0; rr < 16; ++rr) { const int row = 16 * wid + rr;
        const u32x4 w = wrow16[rr];
        float x[8] = {bf_lo(w.x), bf_hi(w.x), bf_lo(w.y), bf_hi(w.y), bf_lo(w.z), bf_hi(w.z), bf_lo(w.w), bf_hi(w.w)};
        float s = 0.f;
#pragma unroll
        for (int i = 0; i < 8; ++i) s += x[i];
        const float mean = wave_sum(s) * (1.f / 512.f); float q = 0.f;
#pragma unroll
        for (int i = 0; i < 8; ++i) { x[i] -= mean; q += x[i] * x[i]; }
        const float rstd = 1.f / sqrtf(wave_sum(q) * (1.f / 512.f) + LN_EPS);
        u32x4 o; o.x = cvt_pk_bf16(x[0] * rstd * gl[0], x[1] * rstd * gl[1]); o.y = cvt_pk_bf16(x[2] * rstd * gl[2], x[3] * rstd * gl[3]);
        o.z = cvt_pk_bf16(x[4] * rstd * gl[4], x[5] * rstd * gl[5]); o.w = cvt_pk_bf16(x[6] * rstd * gl[6], x[7] * rstd * gl[7]);
        *(LAS u32x4*)(V + row * SGS + 16 * lane) = o; }
    __syncthreads();
    const int g = wid;
    const int vbase = (8 * hi + ((lane & 15) >> 2)) * SGS + (g * 64 + 16 * ((lane >> 4) & 1) + 4 * (lane & 3)) * 2;
    const bf16_t* wg = SGWl + (size_t)g * 128 * 128;
#pragma unroll 1
    for (int tb = 0; tb < 4; ++tb) {
        f32x16 a0, a1;
#pragma unroll
        for (int r = 0; r < 16; ++r) { a0[r] = 0.f; a1[r] = 0.f; }
        const bf16_t* wrow = wg + (size_t)(32 * tb + n) * 128 + 8 * hi;
        bf16x8 afr[8];
#pragma unroll
        for (int ks = 0; ks < 8; ++ks) if (ks < 2 * tb + 2) afr[ks] = *(const bf16x8*)(wrow + 16 * ks);
#pragma unroll
        for (int ks = 0; ks < 8; ++ks) if (ks < 2 * tb + 2) {
            const bf16x8 af = afr[ks];
#pragma unroll
            for (int db = 0; db < 2; ++db) { bf16x8 vf;
#if USE_TR
                const v4i16_t t0 = __builtin_amdgcn_ds_read_tr16_b64_v4i16((LAS v4i16_t*)(V + vbase + (16 * ks) * SGS + 64 * db));
                const v4i16_t t1 = __builtin_amdgcn_ds_read_tr16_b64_v4i16((LAS v4i16_t*)(V + vbase + (16 * ks + 4) * SGS + 64 * db));
                vf = (bf16x8){t0[0], t0[1], t0[2], t0[3], t1[0], t1[1], t1[2], t1[3]};
#else
#pragma unroll
                for (int j = 0; j < 8; ++j) vf[j] = *(const LAS short*)(V + (16 * ks + 8 * hi + j) * SGS + (g * 64 + 32 * db + n) * 2);
#endif
                if (db == 0) a0 = __builtin_amdgcn_mfma_f32_32x32x16_bf16(af, vf, a0, 0, 0, 0); else a1 = __builtin_amdgcn_mfma_f32_32x32x16_bf16(af, vf, a1, 0, 0, 0); }
        }
#pragma unroll
        for (int r = 0; r < 16; ++r) { const int t = 32 * tb + 8 * (r >> 2) + 4 * hi + (r & 3); const float bb = sgb[g * 128 + t];
            const bf16_t* up = PROJ + (tok0 + t) * PLD + C_U + g * 64 + n; bf16_t* op = OC + (tok0 + t) * 512 + g * 64 + n;
            const float u0 = __builtin_bit_cast(float, (unsigned)up[0] << 16), u1 = __builtin_bit_cast(float, (unsigned)up[32] << 16);
            op[0] = (bf16_t)f2bf((a0[r] + bb) * u0); op[32] = (bf16_t)f2bf((a1[r] + bb) * u1); }
    }
}
constexpr int HS_STRIDE = 2064;
constexpr int P7_PART = 32 * HS_STRIDE;
constexpr int P7_LOG = P7_PART + 8 * 4096;
constexpr int P7_HIST = P7_LOG + 32 * 33 * 4;
__device__ __forceinline__ void p7_route(const Frame& F, const Args& a, int l, const float* xin, float* xout, const bf16_t* Y, const float* SSP, const float* MODl, signed char* H8, float* RS,
                                         const bf16_t* WRTl, unsigned* cnt, int* ROWTOK, unsigned* TOKINFO) {
    const int tid = F.tid, lane = F.lane, wid = F.wave, n = lane & 31, hi = lane >> 5;
    const float* g_post = a.in[5] + l * DM; const float* g_pre = a.in[6] + l * DM; const float* b_router = a.in[16] + l * NE;
    LAS unsigned char* hs = F.lds; LAS float* part = (LAS float*)(F.lds + P7_PART); LAS float* lg = (LAS float*)(F.lds + P7_LOG); LAS int* hist = (LAS int*)(F.lds + P7_HIST); LAS int* base = hist + 32;
    if (tid < 32) hist[tid] = 0;
    __syncthreads();
    for (int bt = F.vcu; bt < MTOK / 32; bt += F.G) {
        const int row0 = bt * 32, b = row0 >> 11;
        const float* mb = MODl + (size_t)b * 6 * DM;
        u32x2 yv[4][4]; f32x4 xv[4][4], s4v[4];
#pragma unroll
        for (int rr = 0; rr < 4; ++rr) { const size_t row = (size_t)row0 + 4 * wid + rr; s4v[rr] = *(const f32x4*)(SSP + row * 16 + 4 * (lane & 3));
#pragma unroll
            for (int j = 0; j < 4; ++j) { const int c = 4 * lane + 256 * j; yv[rr][j] = __builtin_nontemporal_load((const u32x2*)(Y + row * DM + c)); xv[rr][j] = __builtin_nontemporal_load((const f32x4*)(xin + row * DM + c)); } }
#pragma unroll
        for (int rr = 0; rr < 4; ++rr) { const int rl = 4 * wid + rr; const size_t row = (size_t)row0 + rl;
            const f32x4 s4 = s4v[rr];
            float ssy = (s4[0] + s4[1]) + (s4[2] + s4[3]); ssy = quad_sum(ssy);
            const float rstd1 = 1.f / sqrtf(ssy * (1.f / DM) + RMS_EPS);
            f32x4 v[4]; float ss = 0.f;
#pragma unroll
            for (int j = 0; j < 4; ++j) { const int c = 4 * lane + 256 * j; const u32x2 yw_ = yv[rr][j]; const f32x4 yy = {bf_lo(yw_.x), bf_hi(yw_.x), bf_lo(yw_.y), bf_hi(yw_.y)}, xx = xv[rr][j];
                const f32x4 gp = *(const f32x4*)(g_post + c), ga = *(const f32x4*)(mb + 2 * DM + c);
                v[j] = xx + ga * (yy * rstd1 * gp); *(f32x4*)(xout + row * DM + c) = v[j];
                ss += (v[j][0] * v[j][0] + v[j][1] * v[j][1]) + (v[j][2] * v[j][2] + v[j][3] * v[j][3]); }
            ss = wave_sum(ss);
            const float rstd = 1.f / sqrtf(ss * (1.f / DM) + RMS_EPS);
            f32x4 o[4]; float am = 0.f;
#pragma unroll
            for (int j = 0; j < 4; ++j) { const int c = 4 * lane + 256 * j; const f32x4 gg = *(const f32x4*)(g_pre + c), s1 = *(const f32x4*)(mb + 4 * DM + c), s0 = *(const f32x4*)(mb + 3 * DM + c);
                o[j] = (v[j] * rstd) * gg * (s1 + 1.f) + s0; u32x2 w; w.x = cvt_pk_bf16(o[j][0], o[j][1]); w.y = cvt_pk_bf16(o[j][2], o[j][3]);
                *(LAS u32x2*)(hs + rl * HS_STRIDE + c * 2) = w;
                am = fmaxf(am, fmaxf(fmaxf(fabsf(o[j][0]), fabsf(o[j][1])), fmaxf(fabsf(o[j][2]), fabsf(o[j][3])))); }
            am = wave_max(am);
            const float scale = fmaxf(am, 1e-30f) * (1.f / 127.f), inv = 1.f / scale;
            if (lane == 0) RS[row] = scale;
#pragma unroll
            for (int j = 0; j < 4; ++j) *(unsigned*)(H8 + row * DM + 4 * lane + 256 * j) = q8x4(o[j][0], o[j][1], o[j][2], o[j][3], inv); }
        __syncthreads();
        {
            f32x16 d;
#pragma unroll
            for (int r = 0; r < 16; ++r) d[r] = 0.f;
#pragma unroll
            for (int ks = 0; ks < 8; ++ks) { const int k0 = (8 * wid + ks) * 16 + 8 * hi;
                const bf16x8 af = *(const LAS bf16x8*)(hs + n * HS_STRIDE + k0 * 2); const bf16x8 bf = *(const bf16x8*)(WRTl + (size_t)n * DM + k0);
                d = __builtin_amdgcn_mfma_f32_32x32x16_bf16(af, bf, d, 0, 0, 0); }
#pragma unroll
            for (int r = 0; r < 16; ++r) part[wid * 1024 + (8 * (r >> 2) + 4 * hi + (r & 3)) * 32 + n] = d[r];
        }
        __syncthreads();
        for (int i = tid; i < 1024; i += 512) { float s = b_router[i & 31];
#pragma unroll
            for (int w = 0; w < 8; ++w) s += part[w * 1024 + i]; lg[(i >> 5) * 33 + (i & 31)] = s; }
        __syncthreads();
        int e_k[4] = {0, 0, 0, 0}, lp_k[4] = {0, 0, 0, 0}; float w_k[4] = {0.f, 0.f, 0.f, 0.f};
        if (tid < 32) { LAS float* mylg = lg + tid * 33; float tl[4];
#pragma unroll
            for (int k = 0; k < 4; ++k) { float best = -INFINITY; int bi = 0;
                for (int e = 0; e < 32; ++e) { const float vv = mylg[e]; if (vv > best) { best = vv; bi = e; } }
                tl[k] = best; e_k[k] = bi; mylg[bi] = -INFINITY; }
            float sum = 0.f;
#pragma unroll
            for (int k = 0; k < 4; ++k) { w_k[k] = __expf(tl[k] - tl[0]); sum += w_k[k]; }
            const float inv = 1.f / sum;
#pragma unroll
            for (int k = 0; k < 4; ++k) { w_k[k] *= inv; lp_k[k] = __hip_atomic_fetch_add(&hist[e_k[k]], 1, __ATOMIC_RELAXED, __HIP_MEMORY_SCOPE_WORKGROUP); } }
        __syncthreads();
        if (tid < 32) { const int hc = hist[tid]; base[tid] = hc > 0 ? (int)__hip_atomic_fetch_add(cnt + 64 * tid, (unsigned)hc, __ATOMIC_RELAXED, __HIP_MEMORY_SCOPE_AGENT) : 0; hist[tid] = 0; }
        __syncthreads();
        if (tid < 32) { const int token = row0 + tid; u32x4 info; f32x4 ww;
#pragma unroll
            for (int k = 0; k < 4; ++k) { const int pos = base[e_k[k]] + lp_k[k]; ROWTOK[e_k[k] * 65536 + pos] = token; info[k] = ((unsigned)e_k[k] << 17) | (unsigned)pos; ww[k] = w_k[k]; }
            *(u32x4*)(TOKINFO + (size_t)token * 8) = info; *(f32x4*)(TOKINFO + (size_t)token * 8 + 4) = ww; }
        __syncthreads();
    }
}

__device__ __forceinline__ int moe_tables(const Frame& F, unsigned* cnt) {
    LAS int* ts = (LAS int*)(F.lds + TS_OFF); LAS int* te = (LAS int*)(F.lds + TILE_E_OFF);
    __syncthreads();
    if (F.tid == 0) { int acc = 0; for (int e = 0; e < NE; ++e) { ts[e] = acc; const unsigned c = __hip_atomic_load(cnt + 64 * e, __ATOMIC_RELAXED, __HIP_MEMORY_SCOPE_AGENT); acc += (int)((c + 255u) >> 8); } ts[NE] = acc; }
    __syncthreads();
    const int RT = ts[NE];
    for (int rt = F.tid; rt < RT; rt += 512) { int e = 0;
#pragma unroll 1
        for (int q = 1; q < NE; ++q) e += (ts[q] <= rt) ? 1 : 0;
        te[rt] = e; }
    __syncthreads();
    return RT;
}

__device__ __forceinline__ void p10_combine(const Frame& F, const Args& a, int l, float* xio, const bf16_t* Y2, const unsigned* TOKINFO, const float* MODbase, signed char* H8, float* RS) {
    const int lane = F.lane; const LAS int* ts = (const LAS int*)(F.lds + TS_OFF);
    const float* g_postf = a.in[7] + l * DM;
    const int gw = F.vcu * 8 + F.wave, NGW = F.G * 8;
    for (int rowp = gw * 2; rowp < MTOK; rowp += NGW * 2) {
        u32x4 info[2]; f32x4 ww[2]; u32x2 yw[2][4][4]; f32x4 xv[2][4];
#pragma unroll
        for (int rr = 0; rr < 2; ++rr) { info[rr] = *(const u32x4*)(TOKINFO + (size_t)(rowp + rr) * 8); ww[rr] = *(const f32x4*)(TOKINFO + (size_t)(rowp + rr) * 8 + 4); }
#pragma unroll
        for (int rr = 0; rr < 2; ++rr) {
#pragma unroll
            for (int k = 0; k < 4; ++k) { const int e = (int)(info[rr][k] >> 17), pos = (int)(info[rr][k] & 0x1ffffu); const size_t slot = (size_t)ts[e] * 256 + pos;
#pragma unroll
                for (int j = 0; j < 4; ++j) yw[rr][k][j] = __builtin_nontemporal_load((const u32x2*)(Y2 + slot * DM + 4 * lane + 256 * j)); }
#pragma unroll
            for (int j = 0; j < 4; ++j) xv[rr][j] = *(const f32x4*)(xio + (size_t)(rowp + rr) * DM + 4 * lane + 256 * j); }
#pragma unroll
        for (int rr = 0; rr < 2; ++rr) { const int row = rowp + rr, b = row >> 11;
        f32x4 y[4];
#pragma unroll
        for (int j = 0; j < 4; ++j) y[j] = (f32x4){0.f, 0.f, 0.f, 0.f};
#pragma unroll
        for (int k = 0; k < 4; ++k) { const float wk = ww[rr][k];
#pragma unroll
            for (int j = 0; j < 4; ++j) { const u32x2 w = yw[rr][k][j];
                y[j][0] += wk * bf_lo(w.x); y[j][1] += wk * bf_hi(w.x); y[j][2] += wk * bf_lo(w.y); y[j][3] += wk * bf_hi(w.y); } }
        float ss = 0.f;
#pragma unroll
        for (int j = 0; j < 4; ++j) ss += (y[j][0] * y[j][0] + y[j][1] * y[j][1]) + (y[j][2] * y[j][2] + y[j][3] * y[j][3]);
        ss = wave_sum(ss);
        const float rstd = 1.f / sqrtf(ss * (1.f / DM) + RMS_EPS);
        const float* mb = MODbase + ((size_t)l * BATCH + b) * 6 * DM;
        f32x4 v[4]; float s2 = 0.f;
#pragma unroll
        for (int j = 0; j < 4; ++j) { const int c = 4 * lane + 256 * j; const f32x4 xx = xv[rr][j], gp = *(const f32x4*)(g_postf + c), ga = *(const f32x4*)(mb + 5 * DM + c);
            v[j] = xx + ga * (y[j] * rstd * gp);
#ifdef T_STAMP
            if (l + 1 == DEPTH) v[j] = v[j] * (1.f + (float)(*((const unsigned*)MODbase - (1u << 18) + 100)) * (1.f / 256.f));
#endif
            *(f32x4*)(xio + (size_t)row * DM + c) = v[j];
            s2 += (v[j][0] * v[j][0] + v[j][1] * v[j][1]) + (v[j][2] * v[j][2] + v[j][3] * v[j][3]); }
        if (l + 1 < DEPTH) { s2 = wave_sum(s2); const float* mb1 = MODbase + ((size_t)(l + 1) * BATCH + b) * 6 * DM;
            norm_mod_row(v, s2, a.in[4] + (l + 1) * DM, mb1 + DM, mb1, H8 + (size_t)row * DM, RS + row, lane); }
        }
    }
}
#ifndef MK_ONE_LAUNCH
#define MK_ONE_LAUNCH 1
#endif
constexpr int N_PHASES = 2 + 9 * DEPTH;
__global__ void __launch_bounds__(512, 2) fwd(Args args) {
    extern __shared__ __attribute__((aligned(16))) unsigned char lds_raw[];
    Frame F0;
    F0.lds = (LAS unsigned char*)lds_raw;
    F0.tid = threadIdx.x; F0.lane = F0.tid & 63; F0.wave = __builtin_amdgcn_readfirstlane(F0.tid >> 6);
    F0.G = gridDim.x; { const int bx = blockIdx.x; F0.vcu = (F0.G % 8 == 0) ? (bx % 8) * (F0.G / 8) + bx / 8 : bx; }
    volatile LAS unsigned* MISC = (volatile LAS unsigned*)(F0.lds + MISC_OFF);
    for (int u = F0.tid; u < 128; u += 512) MISC[u] = 0u;
    __syncthreads();
    unsigned* ctl = (unsigned*)(args.ws + WS_CTL);
    const int lo = args.ph_lo, hi = args.ph_hi;
    XcdBarrier bar; bar.bar = ctl + CW_BAR; bar.x = 0; bar.st = nullptr; bar.w = F0.wave;
    if (hi - lo > 1) bar = xcd_barrier_post(ctl + CW_BAR, MISC + 8, F0.wave);
#ifndef PHASE_MASK
#define PHASE_MASK 0x7ff
#endif
#define PHON(j) ((PHASE_MASK >> (j)) & 1)
#ifndef REPEAT_MASK
#define REPEAT_MASK 0
#endif
#define REP(j) for (int rep_ = 0; rep_ <= ((REPEAT_MASK >> (j)) & 1); ++rep_)
#define IN(k) (lo <= (k) && (k) < hi)
#define BOTH(k) (IN(k) && IN((k) + 1))
#define GRID_BAR() xcd_barrier(bar)
#define PH_BEGIN() const Frame F = phase_frame(F0); unsigned char* ws = opq(args.ws); (void)ws
    if (PHON(0) && IN(0)) REP(0) { PH_BEGIN(); p0_mod(F, args.in[1], args.in[2], args.in[3], (float*)(ws + WS_MOD)); p0_weights(F, args); if (BOTH(0)) GRID_BAR(); }
    if (PHON(1) && IN(1)) REP(1) { PH_BEGIN(); p1_norm(F, args.in[0], args.in[4], (const float*)(ws + WS_MOD), (signed char*)(ws + WS_H), (float*)(ws + WS_RS)); if (BOTH(1)) GRID_BAR(); }

#pragma unroll 1
    for (int l = 0; l < DEPTH; ++l) {
        const int pb = 2 + 9 * l;
        if (PHON(2) && IN(pb + 0)) REP(2) { PH_BEGIN();
            pg8::Gemm g{(const bf16_t*)(ws + WS_H), (const bf16_t*)(ws + WS_W + (size_t)l * W_LAYER + WO_WIN), DM}; pg8::StaticOrder S; S.init(MTOK / 256, NPROJ / 256, F.G, (int)blockIdx.x);
            EpiProj E{(bf16_t*)(ws + WS_PROJ), (unsigned char*)(ws + WS_GATES), (const float*)(ws + WS_RS), (const float*)(ws + WS_CSIN) + (size_t)l * NPROJ};
            pg8::gemm_phase<EpiProj, pg8::StaticOrder, false, true>(F.lds, g, S, E, F.wave);
            if (BOTH(pb + 0)) GRID_BAR();
        }
        if (PHON(3) && IN(pb + 1)) REP(3) {
#ifndef SUBREP
#define SUBREP 0
#endif
            { const Frame Fa = phase_frame(F0); const bf16_t* PROJa = (const bf16_t*)(opq(args.ws) + WS_PROJ); bf16_t* OAa = (bf16_t*)(opq(args.ws) + WS_O);
            for (int u = Fa.vcu; u < 2048; u += Fa.G) { const int cu = u & 255, j = u >> 8, bg = cu >> 2, s = cu & 3, qb = (j & 1) ? (8 * (j >> 1) + 7 - s) : (8 * (j >> 1) + s);
                attn_unit<0>(Fa, PROJa, OAa, nullptr, args.in[9] + l * 8, bg >> 1, bg & 1, qb); } }
            { const Frame Fb = phase_frame(F0); unsigned char* wsb = opq(args.ws);
            for (int u = Fb.vcu; u < 512; u += Fb.G)
                sg_unit(Fb, (const bf16_t*)(wsb + WS_PROJ), (const bf16_t*)(wsb + WS_SGW) + (size_t)l * 8 * 128 * 128, args.in[11] + l * 8 * 128, args.in[12] + l * 512, (bf16_t*)(wsb + WS_O) + (size_t)2 * MTOK * 512, u >> 4, u & 15); }
            __syncthreads();
            { const Frame Fi = phase_frame(F0); unsigned char* wsi = opq(args.ws);
              dsa_index_phase(Fi, (const bf16_t*)(wsi + WS_PROJ), (unsigned long long*)(wsi + WS_BITS), l == 0 ? (unsigned*)(wsi + WS_CTL) + 100 : nullptr); }
            if (BOTH(pb + 1)) GRID_BAR();
        }
        if (PHON(4) && IN(pb + 2)) REP(4) { PH_BEGIN();
            for (int u = F.vcu; u < 2048; u += F.G) { const int cu = u & 255, j = u >> 8, bg = cu >> 2, s = cu & 3, qb = (j & 1) ? (8 * (j >> 1) + 7 - s) : (8 * (j >> 1) + s);
                attn_unit<1>(F, (const bf16_t*)(ws + WS_PROJ), (bf16_t*)(ws + WS_O) + (size_t)MTOK * 512, (const unsigned*)(ws + WS_BITS), nullptr, bg >> 1, bg & 1, qb); }
            __syncthreads();
            if (BOTH(pb + 2)) GRID_BAR();
        }
        if (PHON(5) && IN(pb + 3)) REP(5) { PH_BEGIN();
            pg8::Gemm g{(const bf16_t*)(ws + WS_O), (const bf16_t*)(ws + WS_W + (size_t)l * W_LAYER + WO_WBR), 512}; BranchOrder S; S.so.init(MTOK / 256, DM / 256, F.G, (int)blockIdx.x);
            EpiBranch E{(const unsigned char*)(ws + WS_GATES), (bf16_t*)(ws + WS_H)};
            pg8::gemm_phase<EpiBranch, BranchOrder, false>(F.lds, g, S, E, F.wave);
            if (BOTH(pb + 3)) GRID_BAR();
        }
        if (PHON(6) && IN(pb + 4)) REP(6) { PH_BEGIN();
            pg8::Gemm g{(const bf16_t*)(ws + WS_H), (const bf16_t*)(ws + WS_W + (size_t)l * W_LAYER + WO_WOUT), DM}; pg8::StaticOrder S; S.init(MTOK / 256, DM / 256, F.G, (int)blockIdx.x);
            EpiWout E{(bf16_t*)(ws + WS_Y), (float*)(ws + WS_SSP)};
            pg8::gemm_phase<EpiWout, pg8::StaticOrder, false>(F.lds, g, S, E, F.wave);
            if (BOTH(pb + 4)) GRID_BAR();
        }
        if (PHON(7) && IN(pb + 5)) REP(7) { PH_BEGIN();
            p7_route(F, args, l, l == 0 ? args.in[0] : (const float*)args.out, args.out, (const bf16_t*)(ws + WS_Y), (const float*)(ws + WS_SSP), (const float*)(ws + WS_MOD) + (size_t)l * BATCH * 6 * DM, (signed char*)(ws + WS_H), (float*)(ws + WS_RS),
                     (const bf16_t*)(ws + WS_WRT) + (size_t)l * NE * DM, (unsigned*)(ws + WS_CTL) + CW_CNT + l * 32 * 64, (int*)(ws + WS_ROWTOK), (unsigned*)(ws + WS_TOKINFO));
            if (BOTH(pb + 5)) GRID_BAR();
        }
        if (PHON(8) && IN(pb + 6)) REP(8) { PH_BEGIN();
            unsigned* cnt = (unsigned*)(ws + WS_CTL) + CW_CNT + l * 32 * 64; const int* ROWTOK = (const int*)(ws + WS_ROWTOK);
            const int RT = moe_tables(F, cnt);
            LAS int* ts = (LAS int*)(F.lds + TS_OFF); LAS int* te = (LAS int*)(F.lds + TILE_E_OFF); LAS int* ri = (LAS int*)(F.lds + ROWIDX_OFF);
            const long U = (long)RT * 8; MoeOrder S; S.u0 = (int)(U * F.vcu / F.G); S.u1 = (int)(U * (F.vcu + 1) / F.G); S.NB = 8; S.rt_lo = S.u0 / 8; S.tile_e = te; S.rowidx = ri;
            if (S.u1 > S.u0) { const int rt_hi = (S.u1 - 1) / 8; int ntile = rt_hi - S.rt_lo + 1; if (ntile > 8) ntile = 8;
                for (int i = F.tid; i < ntile * 256; i += 512) { const int rt = S.rt_lo + (i >> 8), r = i & 255, e = te[rt], first = (rt - ts[e]) * 256 + r;
                    const int c = (int)__hip_atomic_load(cnt + 64 * e, __ATOMIC_RELAXED, __HIP_MEMORY_SCOPE_AGENT); ri[i] = first < c ? ROWTOK[e * 65536 + first] : 0; } }
            __syncthreads();
            pg8::Gemm g{(const bf16_t*)(ws + WS_H), (const bf16_t*)(ws + WS_W + (size_t)l * W_LAYER + WO_W1), DM};
            EpiW1I8 E{(signed char*)(ws + WS_ACT), args.in[18] + (size_t)l * NE * 2 * FF, (const float*)(ws + WS_RS), (const float*)(ws + WS_CS1) + (size_t)l * NE * 2048, ri, S.rt_lo};
            pg8::gemm_phase<EpiW1I8, MoeOrder, true, true>(F.lds, g, S, E, F.wave);
            if (BOTH(pb + 6)) GRID_BAR();
        }
        if (PHON(9) && IN(pb + 7)) REP(9) { PH_BEGIN();
            const int RT = moe_tables(F, (unsigned*)(ws + WS_CTL) + CW_CNT + l * 32 * 64);
            const long U = (long)RT * 4; MoeOrder S; S.u0 = (int)(U * F.vcu / F.G); S.u1 = (int)(U * (F.vcu + 1) / F.G); S.NB = 4; S.rt_lo = 0; S.tile_e = (LAS int*)(F.lds + TILE_E_OFF); S.rowidx = nullptr;
            pg8::Gemm g{(const bf16_t*)(ws + WS_ACT), (const bf16_t*)(ws + WS_W + (size_t)l * W_LAYER + WO_W2), FF};
            EpiW2 E{(bf16_t*)(ws + WS_Y2), args.in[20] + (size_t)l * NE * DM, (const float*)(ws + WS_CS2) + (size_t)l * NE * DM};
            pg8::gemm_phase<EpiW2, MoeOrder, false, true>(F.lds, g, S, E, F.wave);
            if (BOTH(pb + 7)) GRID_BAR();
        }
        if (PHON(10) && IN(pb + 8)) REP(10) { PH_BEGIN();
            (void)moe_tables(F, (unsigned*)(ws + WS_CTL) + CW_CNT + l * 32 * 64);
            p10_combine(F, args, l, args.out, (const bf16_t*)(ws + WS_Y2), (const unsigned*)(ws + WS_TOKINFO), (const float*)(ws + WS_MOD), (signed char*)(ws + WS_H), (float*)(ws + WS_RS));
            if (BOTH(pb + 8)) GRID_BAR();
        }
    }
#undef PH_BEGIN
#undef IN
#undef BOTH
#undef GRID_BAR
}

extern "C" void kernel_launch(void* const* d_in, const int* in_sizes, int n_in, void* d_out, int out_size, void* d_ws, size_t ws_size, hipStream_t stream) {
    static int grid = 0;
    if (grid == 0) {
        if (n_in != 21 || out_size != MTOK * DM || ws_size < WS_END) { fprintf(stderr, "kernel_launch: unexpected shapes (n_in %d, out %d, ws %zu); nothing launched\n", n_in, out_size, ws_size); grid = -1; return; }
        int dev = 0, cus = 0, per_cu = 0;
        if (hipGetDevice(&dev) != hipSuccess || hipDeviceGetAttribute(&cus, hipDeviceAttributeMultiprocessorCount, dev) != hipSuccess) { grid = -1; return; }
        if (hipFuncSetAttribute((const void*)fwd, hipFuncAttributeMaxDynamicSharedMemorySize, LDS_BYTES) != hipSuccess) { fprintf(stderr, "kernel_launch: hipFuncSetAttribute failed\n"); grid = -1; return; }
        if (hipOccupancyMaxActiveBlocksPerMultiprocessor(&per_cu, (const void*)fwd, 512, LDS_BYTES) != hipSuccess || per_cu < 1) { fprintf(stderr, "kernel_launch: occupancy query says %d\n", per_cu); }
        (void)hipGetLastError();
        grid = cus > 256 ? 256 : cus;
    }
    if (grid < 0) return;
    (void)hipMemsetAsync((char*)d_ws + WS_CTL, 0, CTL_ZERO_BYTES, stream);
    Args a{};
    for (int i = 0; i < 21; ++i) a.in[i] = (const float*)d_in[i];
    a.out = (float*)d_out; a.ws = (unsigned char*)d_ws;
#if MK_ONE_LAUNCH
    a.ph_lo = 0; a.ph_hi = N_PHASES;
    hipLaunchKernelGGL(fwd, dim3(grid), dim3(512), LDS_BYTES, stream, a);
#else
    for (int p = 0; p < N_PHASES; ++p) { a.ph_lo = p; a.ph_hi = p + 1; hipLaunchKernelGGL(fwd, dim3(grid), dim3(512), LDS_BYTES, stream, a); }
#endif
}
```

```cpp
#include <hip/hip_runtime.h>
#include <cstdio>
#include <cstdint>
#include <type_traits>

#define LAS __attribute__((address_space(3)))
#define GAS __attribute__((address_space(1)))
typedef unsigned short bf16_t;
typedef short bf16x8 __attribute__((ext_vector_type(8)));
typedef float f32x2 __attribute__((ext_vector_type(2)));
typedef float f32x4 __attribute__((ext_vector_type(4)));
typedef float f32x16 __attribute__((ext_vector_type(16)));
typedef unsigned u32x2 __attribute__((ext_vector_type(2)));
typedef unsigned u32x4 __attribute__((ext_vector_type(4)));
typedef short v4i16_t __attribute__((ext_vector_type(4)));
typedef int i32x4 __attribute__((ext_vector_type(4)));

constexpr int BATCH = 32, SEQ = 2048, DM = 1024, MTOK = BATCH * SEQ, DEPTH = 2;
constexpr int NPROJ = 6144;
constexpr int PLD = 3072;
constexpr int C_QA = 0, C_KA = 512, C_VA = 640, C_QB = 768, C_KB = 1280, C_VB = 1408, C_QI = 1536, C_KI = 1792, C_WI = 1824, C_U = 2048, C_V = 2560, C_G = 3072;
constexpr int NE = 32, FF = 1024;
constexpr float RMS_EPS = 1e-5f, LN_EPS = 1e-5f;
constexpr float LOG2E = 1.4426950408889634f;
constexpr float QSCALE = 0.125f * LOG2E;

__device__ __forceinline__ unsigned f2bf(float f) { unsigned u = __builtin_bit_cast(unsigned, f); return (u + 0x7fffu + ((u >> 16) & 1u)) >> 16; }
__device__ __forceinline__ unsigned cvt_pk_bf16(float lo, float hi) { unsigned r; asm volatile("v_cvt_pk_bf16_f32 %0, %1, %2" : "=v"(r) : "v"(lo), "v"(hi)); return r; }
__device__ __forceinline__ float bf_lo(unsigned w) { return __builtin_bit_cast(float, w << 16); }
__device__ __forceinline__ float bf_hi(unsigned w) { return __builtin_bit_cast(float, w & 0xffff0000u); }
__device__ __forceinline__ float fexp2(float x) { return __builtin_amdgcn_exp2f(x); }
__device__ __forceinline__ float frcp(float x) { return __builtin_amdgcn_rcpf(x); }
__device__ __forceinline__ float sigmoidf_(float x) { return frcp(1.f + fexp2(-LOG2E * x)); }
__device__ __forceinline__ float gelu_tanh(float x) { const float t = x + 0.044715f * x * x * x; return x * frcp(1.f + fexp2(-2.302208198f * t)); }
template <int CTRL> __device__ __forceinline__ float dpp_f(float v) { return __builtin_bit_cast(float, __builtin_amdgcn_update_dpp(0, __builtin_bit_cast(int, v), CTRL, 0xF, 0xF, false)); }
__device__ __forceinline__ void swap32_asm(unsigned& a, unsigned& b) { asm volatile("s_nop 1\n\tv_permlane32_swap_b32 %0, %1" : "+v"(a), "+v"(b)); }
__device__ __forceinline__ float xor16_add(float v) { return v + __builtin_bit_cast(float, __builtin_amdgcn_ds_swizzle(__builtin_bit_cast(int, v), 0x401F)); }
__device__ __forceinline__ float xor16_max(float v) { return fmaxf(v, __builtin_bit_cast(float, __builtin_amdgcn_ds_swizzle(__builtin_bit_cast(int, v), 0x401F))); }
__device__ __forceinline__ float xor32_add(float v) { unsigned a = __builtin_bit_cast(unsigned, v), b = a; swap32_asm(a, b); return __builtin_bit_cast(float, a) + __builtin_bit_cast(float, b); }
__device__ __forceinline__ float xor32_max(float v) { unsigned a = __builtin_bit_cast(unsigned, v), b = a; swap32_asm(a, b); return fmaxf(__builtin_bit_cast(float, a), __builtin_bit_cast(float, b)); }
__device__ __forceinline__ float quad_sum(float v) { v += dpp_f<0xB1>(v); v += dpp_f<0x4E>(v); return v; }
__device__ __forceinline__ float wave_sum(float v) {
    v += dpp_f<0xB1>(v); v += dpp_f<0x4E>(v); v += dpp_f<0x141>(v); v += dpp_f<0x140>(v);
    return xor32_add(xor16_add(v));
}
__device__ __forceinline__ float wave_max(float v) {
    v = fmaxf(v, dpp_f<0xB1>(v)); v = fmaxf(v, dpp_f<0x4E>(v)); v = fmaxf(v, dpp_f<0x141>(v)); v = fmaxf(v, dpp_f<0x140>(v));
    return xor32_max(xor16_max(v));
}
__device__ __forceinline__ unsigned wave_sum_u32(unsigned v) {
    v += (unsigned)__builtin_amdgcn_update_dpp(0, (int)v, 0xB1, 0xF, 0xF, false);
    v += (unsigned)__builtin_amdgcn_update_dpp(0, (int)v, 0x4E, 0xF, 0xF, false);
    v += (unsigned)__builtin_amdgcn_update_dpp(0, (int)v, 0x141, 0xF, 0xF, false);
    v += (unsigned)__builtin_amdgcn_update_dpp(0, (int)v, 0x140, 0xF, 0xF, false);
    return __builtin_amdgcn_readlane(v, 0) + __builtin_amdgcn_readlane(v, 16) + __builtin_amdgcn_readlane(v, 32) + __builtin_amdgcn_readlane(v, 48);
}
__device__ __forceinline__ unsigned wave_max_u32(unsigned v) {
    unsigned t;
    t = (unsigned)__builtin_amdgcn_update_dpp(0, (int)v, 0xB1, 0xF, 0xF, false); v = v > t ? v : t;
    t = (unsigned)__builtin_amdgcn_update_dpp(0, (int)v, 0x4E, 0xF, 0xF, false); v = v > t ? v : t;
    t = (unsigned)__builtin_amdgcn_update_dpp(0, (int)v, 0x141, 0xF, 0xF, false); v = v > t ? v : t;
    t = (unsigned)__builtin_amdgcn_update_dpp(0, (int)v, 0x140, 0xF, 0xF, false); v = v > t ? v : t;
    unsigned a = __builtin_amdgcn_readlane(v, 0), b = __builtin_amdgcn_readlane(v, 16), c = __builtin_amdgcn_readlane(v, 32), d = __builtin_amdgcn_readlane(v, 48);
    a = a > b ? a : b; c = c > d ? c : d; return a > c ? a : c;
}
__device__ __forceinline__ unsigned q8x4(float a, float b, float c, float d, float inv) {
    unsigned r = 0u;
    r = __builtin_amdgcn_cvt_pk_u8_f32(__builtin_rintf(fmaf(a, inv, 128.f)), 0u, r);
    r = __builtin_amdgcn_cvt_pk_u8_f32(__builtin_rintf(fmaf(b, inv, 128.f)), 1u, r);
    r = __builtin_amdgcn_cvt_pk_u8_f32(__builtin_rintf(fmaf(c, inv, 128.f)), 2u, r);
    r = __builtin_amdgcn_cvt_pk_u8_f32(__builtin_rintf(fmaf(d, inv, 128.f)), 3u, r);
    return r ^ 0x80808080u;
}
__device__ __forceinline__ unsigned u8x4_floor(float a, float b, float c, float d) {
    unsigned r = 0u;
    r = __builtin_amdgcn_cvt_pk_u8_f32(__builtin_floorf(a), 0u, r); r = __builtin_amdgcn_cvt_pk_u8_f32(__builtin_floorf(b), 1u, r);
    r = __builtin_amdgcn_cvt_pk_u8_f32(__builtin_floorf(c), 2u, r); r = __builtin_amdgcn_cvt_pk_u8_f32(__builtin_floorf(d), 3u, r);
    return r;
}
__device__ __forceinline__ int lane_id_volatile(int tag = 0) { int l; asm volatile("v_mbcnt_lo_u32_b32 %0, -1, 0 ; LANETAG %1\n\tv_mbcnt_hi_u32_b32 %0, -1, %0" : "=v"(l) : "s"(tag)); return l; }
#define LDS_WAIT() asm volatile("s_waitcnt lgkmcnt(0)" ::: "memory")
#define VM_WAIT() asm volatile("s_waitcnt vmcnt(0)" ::: "memory")

namespace pg8 {
constexpr int BM = 256, BK = 64, HALF = 128, HTB = HALF * BK * 2  , STAGE_BYTES = 8 * HTB, NXCD = 8, WGM = 8;
__host__ __device__ __forceinline__ int lds_byte(int r, int c) { const int st = (r >> 4) * 2 + (c >> 5), rr = r & 15, cc = c & 31, ob = rr * 64 + cc * 2; return st * 1024 + (ob ^ (((ob >> 9) & 1) << 5)); }
__host__ __device__ __forceinline__ void stage_rc(int b, int& R, int& C) { const int st = b / 1024, sb = b % 1024, swz = sb ^ (((sb >> 9) & 1) << 5); R = (st >> 1) * 16 + swz / 64; C = (st & 1) * 32 + (swz % 64) / 2; }
__host__ __device__ __forceinline__ int perm32(int rho) { const int n = rho >> 4, i = rho & 15; return 8 * (i >> 2) + 4 * n + (i & 3); }

struct Unit { int pm, pn; };
struct Gemm { const bf16_t* A; const bf16_t* Bt; int K; };

struct StaticOrder {
    int nM, nN, nwg, G, c;
    __device__ void init(int nM_, int nN_, int G_, int c_) { nM = nM_; nN = nN_; nwg = nM * nN; G = G_; c = c_; }
    __device__ __forceinline__ bool tile(int i, int& pm, int& pn) const {
        const long L = (long)i * G + c; if (L >= nwg) return false;
        int wgid = (int)L; { const int q = nwg / NXCD, r = nwg % NXCD, xcd = wgid % NXCD, off = wgid / NXCD; wgid = (xcd < r ? xcd * (q + 1) : r * (q + 1) + (xcd - r) * q) + off; }
        const int nig = WGM * nN, gid = wgid / nig, fm = gid * WGM, gsz = (nM - fm) < WGM ? (nM - fm) : WGM;
        pm = fm + ((wgid % nig) % gsz); pn = (wgid % nig) / gsz; return true;
    }
    __device__ __forceinline__ bool next(int i, Unit& u) const { return tile(i, u.pm, u.pn); }
};

template <class Epi, class Sched, bool GATHER, bool I8 = false>
__device__ __forceinline__ void gemm_phase(LAS unsigned char* lds, const Gemm g, const Sched& S, const Epi& E, int wv  ) {
    int tid = wv * 64 + lane_id_volatile(1); asm volatile("" : "+v"(tid));
    const int wid = __builtin_amdgcn_readfirstlane(tid >> 6), lane = tid & 63, wr = wid >> 2, wc = wid & 3, fr = lane & 15, fq = lane >> 4;
    const int K = g.K, RB = I8 ? K : 2 * K  , nt = RB / (BK * 2);
    unsigned voffA[2], voffB[2]; int RA[2], CA[2];
#pragma unroll
    for (int i = 0; i < 2; ++i) { int R, C; stage_rc(tid * 16 + i * 8192, R, C); const int Rb = (R & ~31) + perm32(R & 31); RA[i] = R; CA[i] = C;
        voffA[i] = (unsigned)(R * RB + C * 2); voffB[i] = (unsigned)(Rb * RB + C * 2); }
    const size_t kstep = (size_t)(BK * 2);
    const size_t hstep = (size_t)HALF * RB;
    const size_t tstep = 2 * hstep;
    const unsigned ldsw = (unsigned)wid * 1024u;
    const int aoff = lds_byte(wr * 64 + fr, fq * 8), boff = lds_byte(wc * 32 + fr, fq * 8);
#define PG8_SA(b, h) (((b) * 2 + (h)) * HTB)
#define PG8_SB(b, h) ((4 + (b) * 2 + (h)) * HTB)
#define PG8_STAGE(bufoff, gbase, voff) do { _Pragma("unroll") for (int _i = 0; _i < 2; ++_i) \
        __builtin_amdgcn_global_load_lds((const unsigned*)((const char*)(gbase) + (voff)[_i]), (LAS unsigned*)(lds + (bufoff) + ldsw + _i * 8192), 16, 0, 0); } while (0)
#define PG8_STAGE_A(bufoff, h, ubase, koff, VO) do { if constexpr (GATHER) { PG8_STAGE(bufoff, (const char*)g.A + (koff), VO[h]); } else { PG8_STAGE(bufoff, (ubase) + (h) * hstep + (koff), voffA); } } while (0)
#define PG8_LDA(dst, b, h) do { _Pragma("unroll") for (int m = 0; m < 4; ++m) _Pragma("unroll") for (int k = 0; k < 2; ++k) dst[m][k] = *(const LAS bf16x8*)(lds + PG8_SA(b, h) + aoff + m * 2048 + k * 1024); } while (0)
#define PG8_LDB(dst, b, h) do { _Pragma("unroll") for (int n = 0; n < 2; ++n) _Pragma("unroll") for (int k = 0; k < 2; ++k) dst[n][k] = *(const LAS bf16x8*)(lds + PG8_SB(b, h) + boff + n * 2048 + k * 1024); } while (0)
#define PG8_MMA(ai, bj, At, Bt) do { __builtin_amdgcn_s_setprio(1); _Pragma("unroll") for (int m = 0; m < 4; ++m) _Pragma("unroll") for (int n = 0; n < 2; ++n) _Pragma("unroll") for (int k = 0; k < 2; ++k) \
        { if constexpr (I8) acc[ai][bj][m][n] = __builtin_amdgcn_mfma_i32_16x16x64_i8(__builtin_bit_cast(i32x4, Bt[n][k]), __builtin_bit_cast(i32x4, At[m][k]), acc[ai][bj][m][n], 0, 0, 0); \
          else acc[ai][bj][m][n] = __builtin_amdgcn_mfma_f32_16x16x32_bf16(Bt[n][k], At[m][k], acc[ai][bj][m][n], 0, 0, 0); } __builtin_amdgcn_s_setprio(0); } while (0)
#define PG8_WAIT_V(n) asm volatile("s_waitcnt vmcnt(" #n ")" ::: "memory")
#define PG8_WAIT_L(n) asm volatile("s_waitcnt lgkmcnt(" #n ")" ::: "memory")
#define PG8_BAR __builtin_amdgcn_s_barrier()
#define PG8_SCHED __builtin_amdgcn_sched_barrier(0)
    Unit cur, nxt; int ui = 0;
    if (!S.next(0, cur)) return;
    typedef typename std::conditional<I8, i32x4, f32x4>::type accv_t;
    accv_t acc[2][2][4][2];
#pragma unroll
    for (int a = 0; a < 2; ++a)
#pragma unroll
        for (int b = 0; b < 2; ++b)
#pragma unroll
            for (int m = 0; m < 4; ++m)
#pragma unroll
                for (int n = 0; n < 2; ++n) acc[a][b][m][n] = (accv_t){0, 0, 0, 0};
    bf16x8 At[4][2], B0[2][2], B1[2][2];
    unsigned oc[2][2], on[2][2];
    if constexpr (GATHER) {
#pragma unroll
        for (int h = 0; h < 2; ++h)
#pragma unroll
            for (int i = 0; i < 2; ++i) { oc[h][i] = (unsigned)(S.src_row(cur, h * HALF + RA[i]) * RB + CA[i] * 2); on[h][i] = oc[h][i]; }
    }
    const char* cA = GATHER ? (const char*)g.A : (const char*)g.A + (size_t)cur.pm * tstep; const char* cB = (const char*)g.Bt + (size_t)cur.pn * tstep;
    PG8_STAGE(PG8_SB(0, 0), cB, voffB); PG8_STAGE(PG8_SB(0, 1), cB + hstep, voffB); PG8_STAGE_A(PG8_SA(0, 0), 0, cA, 0, oc); PG8_STAGE_A(PG8_SA(0, 1), 1, cA, 0, oc);
    if (wr == 1) PG8_BAR;
    PG8_WAIT_V(2); PG8_BAR;
    PG8_STAGE(PG8_SB(1, 0), cB + kstep, voffB); PG8_STAGE_A(PG8_SA(1, 0), 0, cA, kstep, oc); PG8_STAGE(PG8_SB(1, 1), cB + hstep + kstep, voffB);
    PG8_WAIT_V(6); PG8_BAR;
    for (;;) {
        const bool has_next = S.next(ui + 1, nxt);
        const char* nA = GATHER ? (const char*)g.A : (has_next ? (const char*)g.A + (size_t)nxt.pm * tstep : cA); const char* nB = has_next ? (const char*)g.Bt + (size_t)nxt.pn * tstep : cB;
        if constexpr (GATHER) {
            if (has_next) {
#pragma unroll
                for (int h = 0; h < 2; ++h)
#pragma unroll
                    for (int i = 0; i < 2; ++i) on[h][i] = (unsigned)(S.src_row(nxt, h * HALF + RA[i]) * RB + CA[i] * 2);
            }
        }
        for (int t = 0; t < nt; t += 2) {
            const bool last = (t == nt - 2);
            const size_t k1 = (size_t)(t + 1) * kstep;
            const size_t k2 = last ? (size_t)0 : (size_t)(t + 2) * kstep, k3 = k2 + kstep;
            const char* a2 = last ? nA : cA; const char* b2 = last ? nB : cB;
            unsigned o2[2][2];
            if constexpr (GATHER) {
#pragma unroll
                for (int h = 0; h < 2; ++h)
#pragma unroll
                    for (int i = 0; i < 2; ++i) o2[h][i] = last ? on[h][i] : oc[h][i];
            }
            PG8_LDB(B0, 0, 0); PG8_LDB(B1, 0, 1); PG8_SCHED; PG8_LDA(At, 0, 0); PG8_STAGE_A(PG8_SA(1, 1), 1, cA, k1, oc);
            PG8_WAIT_V(8); PG8_WAIT_L(0); PG8_BAR; PG8_MMA(0, 0, At, B0); PG8_MMA(0, 1, At, B1); PG8_BAR; PG8_SCHED;
            PG8_LDA(At, 0, 1); PG8_STAGE(PG8_SB(0, 0), b2 + k2, voffB); PG8_STAGE(PG8_SB(0, 1), b2 + hstep + k2, voffB); PG8_STAGE_A(PG8_SA(0, 0), 0, a2, k2, o2);
            PG8_WAIT_V(8); PG8_WAIT_L(0); PG8_BAR; PG8_MMA(1, 0, At, B0); PG8_MMA(1, 1, At, B1); PG8_BAR; PG8_SCHED;
            PG8_LDB(B0, 1, 0); PG8_LDB(B1, 1, 1); PG8_SCHED; PG8_LDA(At, 1, 0); PG8_STAGE_A(PG8_SA(0, 1), 1, a2, k2, o2);
            PG8_WAIT_V(8); PG8_WAIT_L(0); PG8_BAR; PG8_MMA(0, 0, At, B0); PG8_MMA(0, 1, At, B1); PG8_BAR; PG8_SCHED;
            PG8_LDA(At, 1, 1); PG8_STAGE(PG8_SB(1, 0), b2 + k3, voffB); PG8_STAGE(PG8_SB(1, 1), b2 + hstep + k3, voffB); PG8_STAGE_A(PG8_SA(1, 0), 0, a2, k3, o2);
            PG8_WAIT_V(8); PG8_WAIT_L(0); PG8_BAR; PG8_MMA(1, 0, At, B0); PG8_MMA(1, 1, At, B1); PG8_BAR; PG8_SCHED;
        }
        if (wr == 0) PG8_BAR;
        const bool rst = E(acc, cur, wr, wc, fr, fq);
        if (!has_next) break;
        if (rst) {
#pragma unroll
        for (int a = 0; a < 2; ++a)
#pragma unroll
            for (int b = 0; b < 2; ++b)
#pragma unroll
                for (int m = 0; m < 4; ++m)
#pragma unroll
                    for (int n = 0; n < 2; ++n) acc[a][b][m][n] = (accv_t){0, 0, 0, 0};
        }
        cur = nxt; cA = nA; cB = nB; ++ui;
        if constexpr (GATHER) {
#pragma unroll
            for (int h = 0; h < 2; ++h)
#pragma unroll
                for (int i = 0; i < 2; ++i) oc[h][i] = on[h][i];
        }
        if (wr == 1) PG8_BAR;
    }
    PG8_WAIT_V(0);
    PG8_BAR;
#undef PG8_SA
#undef PG8_SB
#undef PG8_STAGE
#undef PG8_STAGE_A
#undef PG8_LDA
#undef PG8_LDB
#undef PG8_MMA
#undef PG8_WAIT_V
#undef PG8_WAIT_L
#undef PG8_BAR
#undef PG8_SCHED
}
}
typedef f32x4 acc_t[2][2][4][2];
typedef i32x4 acci_t[2][2][4][2];

struct EpiProj {
    bf16_t* O; unsigned char* G8; const float* RS  ; const float* CS  ;
    __device__ __forceinline__ bool operator()(acci_t& acc, const pg8::Unit& u, int wr, int wc, int fr, int fq) const {
        const int pn = u.pn;
        const int act = (pn <= 1 || pn == 3 || pn == 4) ? 1 : (pn >= 12 ? 3 : (pn >= 8 ? 2 : 0));
        const int row0 = u.pm * 256 + wr * 64 + fr, col0 = pn * 256 + wc * 32 + 8 * fq;
        float rsv[8];
#pragma unroll
        for (int q = 0; q < 8; ++q) rsv[q] = RS[row0 + (q >> 2) * 128 + (q & 3) * 16];
        f32x2 cs2[2][4];
#pragma unroll
        for (int bj = 0; bj < 2; ++bj) { const f32x4 c0 = *(const f32x4*)(CS + col0 + bj * 128), c1 = *(const f32x4*)(CS + col0 + bj * 128 + 4); const float k = (act == 1 ? QSCALE : 1.f);
            cs2[bj][0] = (f32x2){c0[0], c0[1]} * k; cs2[bj][1] = (f32x2){c0[2], c0[3]} * k; cs2[bj][2] = (f32x2){c1[0], c1[1]} * k; cs2[bj][3] = (f32x2){c1[2], c1[3]} * k; }
#pragma unroll
        for (int ai = 0; ai < 2; ++ai)
#pragma unroll
            for (int m = 0; m < 4; ++m) { const int row = row0 + ai * 128 + m * 16; bf16_t* rowp = O + (size_t)row * PLD + col0; const float rs = rsv[ai * 4 + m];
#pragma unroll
                for (int bj = 0; bj < 2; ++bj) { f32x2 v[4];
#pragma unroll
                    for (int p = 0; p < 4; ++p) { const int i0 = 2 * p; v[p] = (f32x2){(float)acc[ai][bj][m][i0 >> 2][i0 & 3], (float)acc[ai][bj][m][(i0 + 1) >> 2][(i0 + 1) & 3]} * (cs2[bj][p] * rs); }
                    if (act == 2) {
#pragma unroll
                        for (int p = 0; p < 4; ++p) { const f32x2 x = v[p], t = (x * x * 0.044715f + 1.f) * x * (-2.302208198f); f32x2 d = {fexp2(t[0]), fexp2(t[1])}; d = d + 1.f; v[p] = x * (f32x2){frcp(d[0]), frcp(d[1])}; } }
                    else if (act == 3) {
                        f32x2 gq[4];
#pragma unroll
                        for (int p = 0; p < 4; ++p) { const f32x2 t = v[p] * (-LOG2E); f32x2 d = {fexp2(t[0]), fexp2(t[1])}; d = d + 1.f; gq[p] = (f32x2){frcp(d[0]), frcp(d[1])} * 256.f; }
                        u32x2 w8; w8.x = u8x4_floor(gq[0][0], gq[0][1], gq[1][0], gq[1][1]); w8.y = u8x4_floor(gq[2][0], gq[2][1], gq[3][0], gq[3][1]);
                        *(u32x2*)(G8 + (size_t)row * 3072 + (col0 - C_G) + bj * 128) = w8; continue; }
                    u32x4 w; w.x = cvt_pk_bf16(v[0][0], v[0][1]); w.y = cvt_pk_bf16(v[1][0], v[1][1]); w.z = cvt_pk_bf16(v[2][0], v[2][1]); w.w = cvt_pk_bf16(v[3][0], v[3][1]);
                    *(u32x4*)(rowp + bj * 128) = w; } }
        return true;
    }
};

struct BranchOrder {
    pg8::StaticOrder so;
    __device__ __forceinline__ bool next(int j, pg8::Unit& u) const { const int i = j / 3, br = j - 3 * i; int pm, pn; if (!so.tile(i, pm, pn)) return false; u.pm = br * 256 + pm; u.pn = br * 4 + pn; return true; }
};
struct EpiBranch {
    const unsigned char* G8  ; bf16_t* MERGED;
    __device__ __forceinline__ bool operator()(acc_t& acc, const pg8::Unit& u, int wr, int wc, int fr, int fq) const {
        const int br = u.pn >> 2, pn = u.pn & 3, pm = u.pm & 255;
        const int row0 = pm * 256 + wr * 64 + fr, col0 = pn * 256 + wc * 32 + 8 * fq;
#pragma unroll
        for (int rnd = 0; rnd < 2; ++rnd) { const int ai = rnd, m0 = 0;
            u32x2 gw[4][2], gd[4][2];
#pragma unroll
            for (int m = m0; m < m0 + 4; ++m)
#pragma unroll
                for (int bj = 0; bj < 2; ++bj) { const unsigned char* gp = G8 + (size_t)(row0 + ai * 128 + m * 16) * 3072 + br * 1024 + col0 + bj * 128;
                    gw[m][bj] = *(const u32x2*)gp; if (br != 2) gd[m][bj] = *(const u32x2*)(gp + 1024); }
#pragma unroll
            for (int m = m0; m < m0 + 4; ++m) { const size_t row = (size_t)(row0 + ai * 128 + m * 16);
#pragma unroll
                for (int bj = 0; bj < 2; ++bj) {
                    const u32x2 g = gw[m][bj];
                    float gn[8];
#pragma unroll
                    for (int i = 0; i < 8; ++i) gn[i] = (float)((g[i >> 2] >> (8 * (i & 3))) & 0xffu) + 0.5f;
                    if (br != 2) { const u32x2 d = gd[m][bj];
#pragma unroll
                        for (int i = 0; i < 8; ++i) gn[i] = gn[i] * frcp((float)((d[i >> 2] >> (8 * (i & 3))) & 0xffu) + 0.5f); }
                    else {
#pragma unroll
                        for (int i = 0; i < 8; ++i) gn[i] *= (1.f / 256.f); }
                    f32x4 v0 = acc[ai][bj][m][0], v1 = acc[ai][bj][m][1];
                    v0[0] *= gn[0]; v0[1] *= gn[1]; v0[2] *= gn[2]; v0[3] *= gn[3]; v1[0] *= gn[4]; v1[1] *= gn[5]; v1[2] *= gn[6]; v1[3] *= gn[7];
                    if (br != 2) { acc[ai][bj][m][0] = v0; acc[ai][bj][m][1] = v1; }
                    else { u32x4 w; w.x = cvt_pk_bf16(v0[0], v0[1]); w.y = cvt_pk_bf16(v0[2], v0[3]); w.z = cvt_pk_bf16(v1[0], v1[1]); w.w = cvt_pk_bf16(v1[2], v1[3]);
                        *(u32x4*)(MERGED + row * DM + col0 + bj * 128) = w; } } }
            asm volatile("" ::: "memory");
        }
        return br == 2;
    }
};

struct EpiWout {
    bf16_t* Y; float* SSP;
    __device__ __forceinline__ bool operator()(acc_t& acc, const pg8::Unit& u, int wr, int wc, int fr, int fq) const {
        const int row0 = u.pm * 256 + wr * 64 + fr, col0 = u.pn * 256 + wc * 32 + 8 * fq;
#pragma unroll
        for (int ai = 0; ai < 2; ++ai)
#pragma unroll
            for (int m = 0; m < 4; ++m) { const size_t row = (size_t)(row0 + ai * 128 + m * 16); float ss = 0.f;
#pragma unroll
                for (int bj = 0; bj < 2; ++bj) { const f32x4 v0 = acc[ai][bj][m][0], v1 = acc[ai][bj][m][1];
                    ss += (v0[0] * v0[0] + v0[1] * v0[1]) + (v0[2] * v0[2] + v0[3] * v0[3]) + (v1[0] * v1[0] + v1[1] * v1[1]) + (v1[2] * v1[2] + v1[3] * v1[3]);
                    u32x4 w; w.x = cvt_pk_bf16(v0[0], v0[1]); w.y = cvt_pk_bf16(v0[2], v0[3]); w.z = cvt_pk_bf16(v1[0], v1[1]); w.w = cvt_pk_bf16(v1[2], v1[3]);
                    *(u32x4*)(Y + row * DM + col0 + bj * 128) = w; }
                ss = xor32_add(xor16_add(ss));
                if (fq == 0) SSP[row * 16 + u.pn * 4 + wc] = ss; }
        return true;
    }
};

struct MoeOrder {
    int u0, u1, NB, rt_lo;
    const LAS int* tile_e;
    const LAS int* rowidx;
    __device__ __forceinline__ bool next(int i, pg8::Unit& u) const { const int x = u0 + i; if (x >= u1) return false; const int rt = x / NB, pn = x - rt * NB; u.pm = rt; u.pn = tile_e[rt] * NB + pn; return true; }
    __device__ __forceinline__ int src_row(const pg8::Unit& u, int r) const { return rowidx[(u.pm - rt_lo) * 256 + r]; }
};
struct EpiW1 {
    bf16_t* ACT; const float* b1  ;
    __device__ __forceinline__ bool operator()(acc_t& acc, const pg8::Unit& u, int wr, int wc, int fr, int fq) const {
        const int e = u.pn >> 3, pn = u.pn & 7;
        const int row0 = u.pm * 256 + wr * 64 + fr, j0 = pn * 128 + wc * 32 + 8 * fq;
        const float* bp = b1 + (size_t)e * (2 * FF) + 2 * j0;
        float bg[8], bl[8];
#pragma unroll
        for (int q = 0; q < 4; ++q) { const f32x4 t = *(const f32x4*)(bp + 4 * q); bg[2 * q] = t[0]; bl[2 * q] = t[1]; bg[2 * q + 1] = t[2]; bl[2 * q + 1] = t[3]; }
#pragma unroll
        for (int ai = 0; ai < 2; ++ai)
#pragma unroll
            for (int m = 0; m < 4; ++m) { float a[8];
#pragma unroll
                for (int i = 0; i < 8; ++i) { float gl = acc[ai][0][m][i >> 2][i & 3] + bg[i], li = acc[ai][1][m][i >> 2][i & 3] + bl[i];
                    gl = fminf(gl, 7.f); li = fminf(fmaxf(li, -7.f), 7.f);
                    a[i] = gl * frcp(1.f + fexp2(-1.702f * LOG2E * gl)) * (li + 1.f); }
                u32x4 w; w.x = cvt_pk_bf16(a[0], a[1]); w.y = cvt_pk_bf16(a[2], a[3]); w.z = cvt_pk_bf16(a[4], a[5]); w.w = cvt_pk_bf16(a[6], a[7]);
                *(u32x4*)(ACT + (size_t)(row0 + ai * 128 + m * 16) * FF + j0) = w; }
        return true;
    }
};
constexpr float ACT_SCALE = 12.f / 127.f;
struct EpiW1I8 {
    signed char* ACT  ; const float* b1  ; const float* RS  ; const float* CS  ;
    const LAS int* rowidx; int rt_lo;
    __device__ __forceinline__ bool operator()(acci_t& acc, const pg8::Unit& u, int wr, int wc, int fr, int fq) const {
        const int e = u.pn >> 3, pn = u.pn & 7;
        const int rl0 = wr * 64 + fr, row0 = u.pm * 256 + rl0, j0 = pn * 128 + wc * 32 + 8 * fq;
        const float* bp = b1 + (size_t)e * (2 * FF) + 2 * j0;
        float bg[8], bl[8], cg[8], cl[8];
#pragma unroll
        for (int q = 0; q < 4; ++q) { const f32x4 t = *(const f32x4*)(bp + 4 * q); bg[2 * q] = t[0]; bl[2 * q] = t[1]; bg[2 * q + 1] = t[2]; bl[2 * q + 1] = t[3]; }
        { const float* cp = CS + (size_t)e * 2048 + pn * 256 + wc * 32 + 8 * fq;
          const f32x4 a0 = *(const f32x4*)cp, a1 = *(const f32x4*)(cp + 4), c0 = *(const f32x4*)(cp + 128), c1 = *(const f32x4*)(cp + 132);
#pragma unroll
          for (int i = 0; i < 4; ++i) { cg[i] = a0[i]; cg[4 + i] = a1[i]; cl[i] = c0[i]; cl[4 + i] = c1[i]; } }
        const LAS int* ri = rowidx + (u.pm - rt_lo) * 256 + rl0;
        float rsv[8];
#pragma unroll
        for (int q = 0; q < 8; ++q) rsv[q] = RS[ri[(q >> 2) * 128 + (q & 3) * 16]];
        f32x2 bg2[4], bl2[4], cg2[4], cl2[4];
#pragma unroll
        for (int p = 0; p < 4; ++p) { bg2[p] = (f32x2){bg[2 * p], bg[2 * p + 1]}; bl2[p] = (f32x2){bl[2 * p], bl[2 * p + 1]}; cg2[p] = (f32x2){cg[2 * p], cg[2 * p + 1]}; cl2[p] = (f32x2){cl[2 * p], cl[2 * p + 1]}; }
#pragma unroll
        for (int ai = 0; ai < 2; ++ai)
#pragma unroll
            for (int m = 0; m < 4; ++m) { const float rs = rsv[ai * 4 + m]; f32x2 a2[4];
#pragma unroll
                for (int p = 0; p < 4; ++p) { const int i0 = 2 * p;
                    const f32x2 ag = {(float)acc[ai][0][m][i0 >> 2][i0 & 3], (float)acc[ai][0][m][(i0 + 1) >> 2][(i0 + 1) & 3]}, al = {(float)acc[ai][1][m][i0 >> 2][i0 & 3], (float)acc[ai][1][m][(i0 + 1) >> 2][(i0 + 1) & 3]};
                    f32x2 gl = ag * (cg2[p] * rs) + bg2[p], li = al * (cl2[p] * rs) + bl2[p];
                    gl[0] = fminf(gl[0], 7.f); gl[1] = fminf(gl[1], 7.f); li[0] = fminf(fmaxf(li[0], -7.f), 7.f); li[1] = fminf(fmaxf(li[1], -7.f), 7.f);
                    const f32x2 ex = gl * (-1.702f * LOG2E); f32x2 den = {fexp2(ex[0]), fexp2(ex[1])}; den = den + 1.f; const f32x2 rc = {frcp(den[0]), frcp(den[1])};
                    a2[p] = (gl * rc) * (li + 1.f); }
                u32x2 w; w.x = q8x4(a2[0][0], a2[0][1], a2[1][0], a2[1][1], 1.f / ACT_SCALE); w.y = q8x4(a2[2][0], a2[2][1], a2[3][0], a2[3][1], 1.f / ACT_SCALE);
                *(u32x2*)(ACT + (size_t)(row0 + ai * 128 + m * 16) * FF + j0) = w; }
        return true;
    }
};
struct EpiW2 {
    bf16_t* Y2; const float* b2  ; const float* CS  ;
    __device__ __forceinline__ bool operator()(acci_t& acc, const pg8::Unit& u, int wr, int wc, int fr, int fq) const {
        const int e = u.pn >> 2, pn = u.pn & 3;
        const int row0 = u.pm * 256 + wr * 64 + fr, col0 = pn * 256 + wc * 32 + 8 * fq;
        f32x4 bv[2][2], cv[2][2];
#pragma unroll
        for (int bj = 0; bj < 2; ++bj)
#pragma unroll
            for (int n = 0; n < 2; ++n) { bv[bj][n] = *(const f32x4*)(b2 + (size_t)e * DM + col0 + bj * 128 + 4 * n); cv[bj][n] = *(const f32x4*)(CS + (size_t)e * DM + col0 + bj * 128 + 4 * n) * ACT_SCALE; }
#pragma unroll
        for (int ai = 0; ai < 2; ++ai)
#pragma unroll
            for (int m = 0; m < 4; ++m) { bf16_t* rowp = Y2 + (size_t)(row0 + ai * 128 + m * 16) * DM + col0;
#pragma unroll
                for (int bj = 0; bj < 2; ++bj) { const i32x4 a0 = acc[ai][bj][m][0], a1 = acc[ai][bj][m][1];
                    const f32x4 v0 = (f32x4){(float)a0[0], (float)a0[1], (float)a0[2], (float)a0[3]} * cv[bj][0] + bv[bj][0], v1 = (f32x4){(float)a1[0], (float)a1[1], (float)a1[2], (float)a1[3]} * cv[bj][1] + bv[bj][1];
                    u32x4 w; w.x = cvt_pk_bf16(v0[0], v0[1]); w.y = cvt_pk_bf16(v0[2], v0[3]); w.z = cvt_pk_bf16(v1[0], v1[1]); w.w = cvt_pk_bf16(v1[2], v1[3]);
                    *(u32x4*)(rowp + bj * 128) = w; } }
        return true;
    }
};
#define XB_TMO      128
#define XB_XCNT(j)  (256  + 64 * (j))
#define XB_XSUB(j)  (1280 + 64 * (j))
#define XB_XGEN(j)  (2304 + 64 * (j))
#define XB_TOP      3328
#define XB_TOPGEN   3392
#define XCD_BAR_WORDS 3456
#define XB_SPIN_CAP (1u << 18)

__device__ __forceinline__ unsigned xb_ld(unsigned* p)              { return __hip_atomic_load(p, __ATOMIC_RELAXED, __HIP_MEMORY_SCOPE_AGENT); }
__device__ __forceinline__ unsigned xb_add(unsigned* p, unsigned v) { return __hip_atomic_fetch_add(p, v, __ATOMIC_RELAXED, __HIP_MEMORY_SCOPE_AGENT); }
__device__ __forceinline__ unsigned xb_xcc_id() { return (unsigned)__builtin_amdgcn_s_getreg((3 << 11) | 20) & 0xFu; }
#define XB_SPIN(cond, bar) do { unsigned _sp = 0; while (cond) { __builtin_amdgcn_s_sleep(1); \
    if ((++_sp & 255u) == 0u) { if (xb_ld(&(bar)[XB_TMO])) break; if (_sp > XB_SPIN_CAP) { atomicAdd(&(bar)[XB_TMO], 1u); break; } } } } while (0)

struct XcdBarrier {
    unsigned* bar; unsigned x;
    int w;
    volatile LAS unsigned* st;
};

__device__ __forceinline__ bool xb_thread0(int w) { return w == 0 && lane_id_volatile(2) == 0; }
__device__ __forceinline__ XcdBarrier xcd_barrier_post(unsigned* bar, volatile LAS unsigned* st, int w) {
    XcdBarrier b; b.bar = bar; b.x = xb_xcc_id(); b.st = st; b.w = w;
    if (xb_thread0(w)) (void)xb_add(&bar[XB_XCNT(b.x)], 1u);
    return b;
}
__device__ __forceinline__ void xcd_barrier_complete(unsigned* bar, unsigned x, unsigned& nloc, unsigned& nx) {
    const unsigned G = gridDim.x * gridDim.y * gridDim.z;
    unsigned sum, cnt, mine, sp = 0u;
    for (;;) {
        sum = 0u; cnt = 0u; mine = 0u;
#pragma unroll
        for (unsigned j = 0; j < 16; ++j) { const unsigned c = xb_ld(&bar[XB_XCNT(j)]); sum += c; cnt += (c > 0u) ? 1u : 0u; mine = (j == x) ? c : mine; }
        if (sum == G) break;
        __builtin_amdgcn_s_sleep(1);
        if ((++sp & 255u) == 0u) { if (xb_ld(&bar[XB_TMO])) break; if (sp > XB_SPIN_CAP) { atomicAdd(&bar[XB_TMO], 1u); break; } }
    }
    nloc = mine > 0u ? mine : 1u; nx = cnt > 0u ? cnt : 1u;
}

__device__ __forceinline__ void xcd_barrier(const XcdBarrier& b) {
    asm volatile("s_waitcnt vmcnt(0)" ::: "memory");
    __syncthreads();
    if (xb_thread0(b.w)) {
        unsigned* bar = b.bar;
        __builtin_amdgcn_s_waitcnt(0);
        unsigned nloc = b.st[0], nx = b.st[1];
        if (nloc == 0u) { xcd_barrier_complete(bar, b.x, nloc, nx); b.st[0] = nloc; b.st[1] = nx; }
        const unsigned old = xb_add(&bar[XB_XSUB(b.x)], 1u);
        const unsigned gen = old / nloc;
        if (old + 1u == (gen + 1u) * nloc) {
            __builtin_amdgcn_fence(__ATOMIC_RELEASE, "agent");
            asm volatile("s_waitcnt vmcnt(0)" ::: "memory");
            const unsigned og = xb_add(&bar[XB_TOP], 1u);
            const unsigned tg = og / nx;
            if (og + 1u == (tg + 1u) * nx) xb_add(&bar[XB_TOPGEN], 1u);
            else XB_SPIN(xb_ld(&bar[XB_TOPGEN]) == tg, bar);
            __builtin_amdgcn_fence(__ATOMIC_ACQUIRE, "agent");
            xb_add(&bar[XB_XGEN(b.x)], 1u);
            asm volatile("s_waitcnt vmcnt(0)" ::: "memory");
        } else {
            XB_SPIN(xb_ld(&bar[XB_XGEN(b.x)]) == gen, bar);
            __builtin_amdgcn_fence(__ATOMIC_ACQUIRE, "agent");
            asm volatile("s_waitcnt vmcnt(0)" ::: "memory");
        }
    }
    __syncthreads();
}

constexpr size_t MiB = 1u << 20;
constexpr size_t WS_CTL = 0, CTL_ZERO_BYTES = 1 * MiB;
constexpr size_t WS_MOD = 1 * MiB;
constexpr size_t WS_SGW = 3 * MiB;
constexpr size_t WS_WRT = 3 * MiB + 512 * 1024;
constexpr size_t WS_RS = 4 * MiB;
constexpr size_t WS_CS1 = 5 * MiB;
constexpr size_t WS_CS2 = 6 * MiB + 512 * 1024;
constexpr size_t WS_CSIN = 6 * MiB;
constexpr size_t WS_W = 8 * MiB, W_LAYER = 209 * MiB;
constexpr size_t WO_WIN = 0, WO_WBR = 12 * MiB, WO_WOUT = 15 * MiB, WO_W1 = 17 * MiB, WO_W2 = 145 * MiB;
constexpr size_t WS_PROJ = 426 * MiB;
constexpr size_t WS_GATES = 810 * MiB;
constexpr size_t WS_ACT = WS_PROJ;
constexpr size_t WS_H = 1194 * MiB;
constexpr size_t WS_O = 1322 * MiB;
constexpr size_t WS_Y = 1514 * MiB;
constexpr size_t WS_BITS = 1770 * MiB;
constexpr size_t WS_Y2 = WS_O;
constexpr size_t WS_SSP = 1850 * MiB;
constexpr size_t WS_ROWTOK = 1854 * MiB;
constexpr size_t WS_TOKINFO = 1862 * MiB;
constexpr size_t WS_SLAB = 1864 * MiB;
constexpr size_t WS_END = 1928 * MiB;
static_assert(WS_Y2 + (size_t)270336 * 2048 <= WS_SSP && WS_W + 2 * W_LAYER <= WS_PROJ && WS_PROJ + (size_t)MTOK * PLD * 2 <= WS_GATES && WS_GATES + (size_t)MTOK * 3072 <= WS_H, "d_ws map");
constexpr int CW_BAR = 4096;
constexpr int CW_CNT = 16384;

constexpr int RING_BYTES = 131072;
constexpr int MISC_OFF = 134144;
constexpr int TS_OFF = MISC_OFF + 512;
constexpr int TILE_E_OFF = MISC_OFF + 1024;
constexpr int ROWIDX_OFF = MISC_OFF + 5632;
constexpr int LDS_BYTES = 151552;
static_assert(ROWIDX_OFF + 8192 <= LDS_BYTES, "LDS map");

struct Args {
    const float* in[21]; float* out; unsigned char* ws; int ph_lo, ph_hi;
};
struct Frame {
    LAS unsigned char* lds; int tid, lane, wave, vcu, G;
};
__device__ __forceinline__ Frame phase_frame(const Frame& F0) { Frame F = F0; int t = F0.wave * 64 + lane_id_volatile(3); asm volatile("" : "+v"(t)); F.tid = t; F.lane = t & 63; F.wave = F0.wave; return F; }
template <class T> __device__ __forceinline__ T* opq(T* p) { long z = 0; asm volatile("" : "+s"(z)); return (T*)((unsigned char*)p + z); }

__device__ __forceinline__ void p0_mod(const Frame& F, const float* c, const float* w_ada, const float* b_ada, float* MOD) {
    LAS float* csT = (LAS float*)F.lds;
    for (int i = F.tid; i < BATCH * DM; i += 512) { const int b = i & 31, k = i >> 5; const float v = c[b * DM + k]; csT[k * 32 + b] = v * sigmoidf_(v); }
    __syncthreads();
    const int gw = F.vcu * 8 + F.wave, NGW = F.G * 8;
    const int cg = F.lane & 15, kq = F.lane >> 4;
    for (int task = gw; task < DEPTH * 384; task += NGW) {
        const int l = task / 384, n = (task % 384) * 16 + cg;
        float acc[32];
#pragma unroll
        for (int b = 0; b < 32; ++b) acc[b] = 0.f;
        const float* w = w_ada + ((size_t)l * DM + kq * 256) * (6 * DM) + n;
#pragma unroll 4
        for (int k = 0; k < 256; ++k) {
            const float wv = w[(size_t)k * (6 * DM)];
            const LAS f32x4* cs = (const LAS f32x4*)(csT + (kq * 256 + k) * 32);
#pragma unroll
            for (int q = 0; q < 8; ++q) { const f32x4 c4 = cs[q]; acc[4 * q] += c4[0] * wv; acc[4 * q + 1] += c4[1] * wv; acc[4 * q + 2] += c4[2] * wv; acc[4 * q + 3] += c4[3] * wv; }
        }
#pragma unroll
        for (int b = 0; b < 32; ++b) { acc[b] = xor32_add(xor16_add(acc[b])); }
        if (kq == 0) { const float bb = b_ada[l * 6 * DM + n];
#pragma unroll
            for (int b = 0; b < 32; ++b) MOD[((size_t)l * BATCH + b) * (6 * DM) + n] = acc[b] + bb; }
    }
    __syncthreads();
}
__device__ __forceinline__ void tr_item(const float* W, size_t ldw, int srccol, bool valid, bf16_t* dst  , int K, LAS float* scr, int lane) {
    const float* wp = W + srccol;
#pragma unroll 8
    for (int i = 0; i < 32; ++i) { const int kk = 2 * i + (lane >> 5); scr[kk * 33 + (lane & 31)] = valid ? wp[(size_t)kk * ldw] : 0.f; }
    LDS_WAIT(); asm volatile("" ::: "memory");
    const int c = lane & 7;
#pragma unroll
    for (int j = 0; j < 4; ++j) { const int n = (lane >> 3) + 8 * j; const LAS float* s = scr + (8 * c) * 33 + n;
        u32x4 o; o.x = cvt_pk_bf16(s[0 * 33], s[1 * 33]); o.y = cvt_pk_bf16(s[2 * 33], s[3 * 33]); o.z = cvt_pk_bf16(s[4 * 33], s[5 * 33]); o.w = cvt_pk_bf16(s[6 * 33], s[7 * 33]);
        *(u32x4*)(dst + (size_t)n * K + 8 * c) = o; }
    LDS_WAIT(); asm volatile("" ::: "memory");
}
__device__ __forceinline__ void p0_weights(const Frame& F, const Args& a) {
    LAS float* scr = (LAS float*)(F.lds + F.wave * 16384);
    const int gw = F.vcu * 8 + F.wave, NGW = F.G * 8, lane = F.lane, jl = lane & 31;
    const float *w_in = a.in[8], *w_branch = a.in[13], *w_out = a.in[14], *w_router = a.in[15], *w1 = a.in[17], *w2 = a.in[19];
    constexpr int I_BR = 3 * 8 * 32, I_OUT = 16 * 32, I_RT = 16;
    constexpr int I_LAYER = I_BR + I_OUT + I_RT;
    for (int it = gw; it < DEPTH * I_LAYER; it += NGW) {
        const int l = it / I_LAYER; int r = it - l * I_LAYER;
        unsigned char* wl = a.ws + WS_W + (size_t)l * W_LAYER;
        if (r < I_BR) {
            const int br = r / 256, q = r % 256, kb = q / 32, nb = q % 32;
            tr_item(w_branch + ((size_t)(l * 3 + br) * 512 + kb * 64) * DM, DM, nb * 32 + jl, true, (bf16_t*)(wl + WO_WBR) + (size_t)(br * 1024 + nb * 32) * 512 + kb * 64, 512, scr, lane); continue; }
        r -= I_BR;
        if (r < I_OUT) {
            const int kb = r / 32, nb = r % 32;
            tr_item(w_out + ((size_t)l * DM + kb * 64) * DM, DM, nb * 32 + jl, true, (bf16_t*)(wl + WO_WOUT) + (size_t)nb * 32 * DM + kb * 64, DM, scr, lane); continue; }
        r -= I_OUT;
        {
            const int kb = r;
            tr_item(w_router + ((size_t)l * DM + kb * 64) * NE, NE, jl, true, (bf16_t*)(a.ws + WS_WRT) + (size_t)l * NE * DM + kb * 64, DM, scr, lane); }
        (void)r;
    }
    __syncthreads();
    {
    LAS float* T = (LAS float*)F.lds; LAS float* red = (LAS float*)(F.lds + ROWIDX_OFF);
    const int half = lane >> 5, wave = F.wave;
    constexpr int ST_W1 = NE * 64, ST_IN = 192, ST_W2 = NE * 32, ST_LAYER = ST_W1 + ST_IN + ST_W2;
    for (int st = F.vcu; st < DEPTH * ST_LAYER; st += F.G) {
        const int l = st / ST_LAYER, q = st % ST_LAYER;
        const float* wp; size_t ldw; bool valid = true; signed char* dst; float* csp;
        if (q < ST_W1) { const int e = q / 64, r6 = q % 64, pn = r6 >> 3, jjg = (r6 >> 1) & 3, sgl = r6 & 1, nb = pn * 8 + sgl * 4 + jjg, n = nb * 32 + jl, src = 2 * (128 * pn + jjg * 32 + jl) + sgl;
            wp = w1 + ((size_t)(l * NE + e) * DM) * (2 * FF) + src; ldw = 2 * FF;
            dst = (signed char*)(a.ws + WS_W + (size_t)l * W_LAYER + WO_W1) + ((size_t)e * 2048 + nb * 32) * DM; csp = (float*)(a.ws + WS_CS1) + ((size_t)l * NE + e) * 2048 + n; }
        else if (q >= ST_W1 + ST_IN) { const int q2 = q - ST_W1 - ST_IN, e = q2 / 32, nb = q2 % 32, n = nb * 32 + jl;
            wp = w2 + ((size_t)(l * NE + e) * FF) * DM + n; ldw = DM;
            dst = (signed char*)(a.ws + WS_W + (size_t)l * W_LAYER + WO_W2) + ((size_t)e * DM + nb * 32) * FF; csp = (float*)(a.ws + WS_CS2) + ((size_t)l * NE + e) * DM + n; }
        else { const int nb = q - ST_W1, n = nb * 32 + jl; valid = (n < 1832) || (n >= 2048); const int src = n < 1832 ? n : n - 216;
            wp = w_in + (size_t)l * DM * 5928 + (valid ? src : 0); ldw = 5928;
            dst = (signed char*)(a.ws + WS_W + (size_t)l * W_LAYER + WO_WIN) + (size_t)nb * 32 * DM; csp = (float*)(a.ws + WS_CSIN) + (size_t)l * NPROJ + n; }
        float am = 0.f;
#pragma unroll
        for (int ib = 0; ib < 2; ++ib) { float vv[32];
#pragma unroll
            for (int i = 0; i < 32; ++i) { const int k = wave * 128 + 2 * (ib * 32 + i) + half; vv[i] = valid ? __builtin_nontemporal_load(wp + (size_t)k * ldw) : 0.f; }
#pragma unroll
            for (int i = 0; i < 32; ++i) { const int k = wave * 128 + 2 * (ib * 32 + i) + half; am = fmaxf(am, fabsf(vv[i])); T[k * 32 + (jl ^ (k & 31))] = vv[i]; } }
        red[(wave * 2 + half) * 32 + jl] = am;
        __syncthreads();
        float amx = 0.f;
#pragma unroll
        for (int p = 0; p < 16; ++p) amx = fmaxf(amx, red[p * 32 + jl]);
        const float scale = valid ? fmaxf(amx, 1e-30f) * (1.f / 127.f) : 1.f, inv = valid ? 1.f / scale : 0.f;
        if (wave == 0 && half == 0) *csp = scale;
        const int k0 = 64 * (wave * 2 + half);
#pragma unroll
        for (int c16 = 0; c16 < 4; ++c16) { unsigned wq[4];
#pragma unroll
            for (int d4 = 0; d4 < 4; ++d4) { const int k = k0 + c16 * 16 + d4 * 4;
                wq[d4] = q8x4(T[k * 32 + (jl ^ (k & 31))], T[(k + 1) * 32 + (jl ^ ((k + 1) & 31))], T[(k + 2) * 32 + (jl ^ ((k + 2) & 31))], T[(k + 3) * 32 + (jl ^ ((k + 3) & 31))], inv); }
            *(u32x4*)(dst + (size_t)jl * DM + k0 + c16 * 16) = (u32x4){wq[0], wq[1], wq[2], wq[3]}; }
        __syncthreads();
    }
    }
    const float* sg_w = a.in[10]; bf16_t* SGW = (bf16_t*)(a.ws + WS_SGW);
    for (int i = (F.vcu * 512 + F.tid) * 2; i < DEPTH * 8 * 128 * 128; i += F.G * 512 * 2) { const int s = i & 127, t = (i >> 7) & 127; const f32x2 v = *(const f32x2*)(sg_w + i);
        *(unsigned*)(SGW + i) = cvt_pk_bf16(s <= t ? v[0] : 0.f, (s + 1) <= t ? v[1] : 0.f); }
}

__device__ __forceinline__ void norm_mod_row(const f32x4 (&v)[4], float ss, const float* g, const float* sc, const float* sh, signed char* orow, float* rs, int lane) {
    const float rstd = 1.f / sqrtf(ss * (1.f / DM) + RMS_EPS);
    f32x4 o[4]; float am = 0.f;
#pragma unroll
    for (int j = 0; j < 4; ++j) { const int c = 4 * lane + 256 * j; const f32x4 gg = *(const f32x4*)(g + c), s1 = *(const f32x4*)(sc + c), s0 = *(const f32x4*)(sh + c);
        o[j] = (v[j] * rstd) * gg * (s1 + 1.f) + s0;
        am = fmaxf(am, fmaxf(fmaxf(fabsf(o[j][0]), fabsf(o[j][1])), fmaxf(fabsf(o[j][2]), fabsf(o[j][3])))); }
    am = wave_max(am);
    const float scale = fmaxf(am, 1e-30f) * (1.f / 127.f), inv = 1.f / scale;
    if (lane == 0) *rs = scale;
#pragma unroll
    for (int j = 0; j < 4; ++j) *(unsigned*)(orow + 4 * lane + 256 * j) = q8x4(o[j][0], o[j][1], o[j][2], o[j][3], inv);
}
__device__ __forceinline__ void p1_norm(const Frame& F, const float* x, const float* g, const float* MOD0, signed char* H8, float* RS) {
    const int gw = F.vcu * 8 + F.wave, NGW = F.G * 8;
    for (int row0 = gw * 4; row0 < MTOK; row0 += NGW * 4) { f32x4 v[4][4];
#pragma unroll
        for (int rr = 0; rr < 4; ++rr)
#pragma unroll
            for (int j = 0; j < 4; ++j) v[rr][j] = __builtin_nontemporal_load((const f32x4*)(x + (size_t)(row0 + rr) * DM + 4 * F.lane + 256 * j));
#pragma unroll
        for (int rr = 0; rr < 4; ++rr) { const int row = row0 + rr, b = row >> 11; float ss = 0.f;
#pragma unroll
            for (int j = 0; j < 4; ++j) ss += (v[rr][j][0] * v[rr][j][0] + v[rr][j][1] * v[rr][j][1]) + (v[rr][j][2] * v[rr][j][2] + v[rr][j][3] * v[rr][j][3]);
            ss = wave_sum(ss);
            const float* mb = MOD0 + (size_t)b * 6 * DM;
            norm_mod_row(v[rr], ss, g, mb + DM, mb, H8 + (size_t)row * DM, RS + row, F.lane); } }
}
constexpr int TOPK_SEL = 256;
struct IdxOps { bf16x8 af[4][2]; u32x4 wraw[4][2]; bf16x8 kf[4][2]; };
__device__ __forceinline__ void dsa_index_load(IdxOps& P, const bf16_t* __restrict__ PROJ, int b, int qg, int lane, int wid) {
    asm volatile("" : "+v"(lane));
    const int n = lane & 31, hi = lane >> 5;
    const int q0 = qg * 16;
    const size_t tokbase = (size_t)b * SEQ;
    const int m = n, hm = (m >> 2) & 1, idx = (m & 3) + 4 * (m >> 3), aq = 2 * hm + (idx >> 3), ah = idx & 7;
#pragma unroll
    for (int qgp = 0; qgp < 4; ++qgp) { const bf16_t* qp = PROJ + (tokbase + q0 + 4 * qgp + aq) * PLD + C_QI + ah * 32 + 8 * hi;
        P.af[qgp][0] = *(const bf16x8*)qp; P.af[qgp][1] = *(const bf16x8*)(qp + 16); }
}
__device__ __forceinline__ void dsa_index_load_k(IdxOps& P, const bf16_t* __restrict__ PROJ, int b, int qg, int lane, int wid) {
    asm volatile("" : "+v"(lane));
    const int n = lane & 31, hi = lane >> 5;
    const int q0 = qg * 16, nkb = (q0 + 16 + 31) >> 5;
    const size_t tokbase = (size_t)b * SEQ;
#pragma unroll
    for (int qgp = 0; qgp < 4; ++qgp)
#pragma unroll
        for (int qq = 0; qq < 2; ++qq) P.wraw[qgp][qq] = *(const u32x4*)(PROJ + (tokbase + q0 + 4 * qgp + 2 * hi + qq) * PLD + C_WI);
#pragma unroll
    for (int i = 0; i < 4; ++i) { const int kb = wid + 8 * i;
        if (kb < nkb) { const bf16_t* kp = PROJ + (tokbase + 32 * kb + n) * PLD + C_KI + 8 * hi; P.kf[i][0] = *(const bf16x8*)kp; P.kf[i][1] = *(const bf16x8*)(kp + 16); } }
}
__device__ __forceinline__ void dsa_index_scores(IdxOps& P, const bf16_t* __restrict__ PROJ, LAS float* sc, int b, int qg, int lane, int wid) {
    const int n = lane & 31, hi = lane >> 5;
    const int q0 = qg * 16, nkb = (q0 + 16 + 31) >> 5;
    const size_t tokbase = (size_t)b * SEQ;
    LAS float* scw = sc + (2 * hi) * 2048 + 32 * wid + n;
    float wv[4][16];
#pragma unroll
    for (int qgp = 0; qgp < 4; ++qgp)
#pragma unroll
        for (int qq = 0; qq < 2; ++qq) { const u32x4 w = P.wraw[qgp][qq];
            wv[qgp][8 * qq + 0] = bf_lo(w.x) * 0.0625f; wv[qgp][8 * qq + 1] = bf_hi(w.x) * 0.0625f; wv[qgp][8 * qq + 2] = bf_lo(w.y) * 0.0625f; wv[qgp][8 * qq + 3] = bf_hi(w.y) * 0.0625f;
            wv[qgp][8 * qq + 4] = bf_lo(w.z) * 0.0625f; wv[qgp][8 * qq + 5] = bf_hi(w.z) * 0.0625f; wv[qgp][8 * qq + 6] = bf_lo(w.w) * 0.0625f; wv[qgp][8 * qq + 7] = bf_hi(w.w) * 0.0625f; }
#pragma unroll
    for (int i = 0; i < 8; ++i) { const int kb = wid + 8 * i;
        if (kb < nkb) {
            const bf16x8 k0 = P.kf[i & 3][0], k1 = P.kf[i & 3][1];
            if (i < 4 && kb + 32 < nkb) { const bf16_t* kp = PROJ + (tokbase + 32 * (kb + 32) + n) * PLD + C_KI + 8 * hi; P.kf[i & 3][0] = *(const bf16x8*)kp; P.kf[i & 3][1] = *(const bf16x8*)(kp + 16); }
#pragma unroll
            for (int qgp = 0; qgp < 4; ++qgp) {
                f32x16 d = {0.f, 0.f, 0.f, 0.f, 0.f, 0.f, 0.f, 0.f, 0.f, 0.f, 0.f, 0.f, 0.f, 0.f, 0.f, 0.f};
                d = __builtin_amdgcn_mfma_f32_32x32x16_bf16(P.af[qgp][0], k0, d, 0, 0, 0);
                d = __builtin_amdgcn_mfma_f32_32x32x16_bf16(P.af[qgp][1], k1, d, 0, 0, 0);
                float sa = 0.f, sb = 0.f;
#pragma unroll
                for (int r = 0; r < 8; ++r) { sa += wv[qgp][r] * fmaxf(d[r], 0.f); sb += wv[qgp][8 + r] * fmaxf(d[8 + r], 0.f); }
                scw[(4 * qgp) * 2048 + 256 * i] = sa; scw[(4 * qgp + 1) * 2048 + 256 * i] = sb;
            } } }
}
__device__ __forceinline__ void bit_transpose32(unsigned (&a)[32]) {
#pragma unroll
    for (int k = 0; k < 16; ++k) { const unsigned lo = a[k], hi = a[k + 16];
        a[k] = __builtin_amdgcn_perm(hi, lo, 0x05040100u); a[k + 16] = __builtin_amdgcn_perm(hi, lo, 0x07060302u); }
#pragma unroll
    for (int k = 0; k < 32; ++k) if ((k & 8) == 0) { const unsigned lo = a[k], hi = a[k + 8];
        a[k] = __builtin_amdgcn_perm(hi, lo, 0x06020400u); a[k + 8] = __builtin_amdgcn_perm(hi, lo, 0x07030501u); }
#pragma unroll
    for (int s = 0; s < 3; ++s) { const int j = 4 >> s; const unsigned m = (s == 0) ? 0x0F0F0F0Fu : (s == 1) ? 0x33333333u : 0x55555555u;
#pragma unroll
        for (int k = 0; k < 32; ++k) if ((k & j) == 0) { const unsigned lo = a[k], hi = a[k + j];
            a[k] = (m & lo) | (~m & (hi << j)); a[k + j] = (m & (lo >> j)) | (~m & hi); } }
}
__device__ __forceinline__ void dsa_index_select(LAS float* sc, LAS int* qctr, unsigned long long* __restrict__ bits64, int b, int qg, int lane, int wid) {
    const int q0 = qg * 16;
    const size_t tokbase = (size_t)b * SEQ;
#pragma unroll 1
    for (;;) {
        int qn = 0; if (lane == 0) qn = __hip_atomic_fetch_add(qctr, 1, __ATOMIC_RELAXED, __HIP_MEMORY_SCOPE_WORKGROUP);
        qn = __builtin_amdgcn_readfirstlane(qn); if (qn >= 16) break;
        const int ql = 15 - qn, pos = q0 + ql, nn = pos + 1, nr = (nn + 63) >> 6;
        const LAS float* scq = sc + ql * 2048;
        unsigned mlo = 0u, mhi = 0u;
        if (nn <= TOPK_SEL) {
#pragma unroll
            for (int r = 0; r < 4; ++r) if (r < nr) { const unsigned long long bal = __ballot(64 * r + lane <= pos); asm volatile("s_nop 4\n\tv_writelane_b32 %0, %2, %4\n\tv_writelane_b32 %1, %3, %4" : "+v"(mlo), "+v"(mhi) : "s"((unsigned)bal), "s"((unsigned)(bal >> 32)), "n"(r));     }
        } else {
            unsigned u[32];
#pragma unroll
            for (int r = 0; r < 32; ++r) u[r] = 0u;
#pragma unroll
            for (int g8 = 0; g8 < 4; ++g8) if (8 * g8 < nr) {
#pragma unroll
                for (int q_ = 0; q_ < 8; ++q_) { const int r = 8 * g8 + q_; const int j = 64 * r + lane; float s = scq[j]; s = (s == 0.f) ? 0.f : s; const unsigned bts = __builtin_bit_cast(unsigned, s);
                    const unsigned uu = (bts & 0x80000000u) ? ~bts : (bts | 0x80000000u); u[r] = (j <= pos) ? uu : 0u; } }
            unsigned M = 0u;
#pragma unroll
            for (int r = 0; r < 32; ++r) M |= (64 * r + lane <= pos) ? (1u << r) : 0u;
            bit_transpose32(u);
            unsigned G = 0u; unsigned need = (unsigned)TOPK_SEL, cM = (unsigned)nn;
            {
#pragma unroll
            for (int bq = 31; bq >= 0; --bq) {
                const unsigned T = M & u[bq];
                const unsigned c = wave_sum_u32((unsigned)__builtin_popcount(T));
                const bool ge = c >= need;
                G |= ge ? 0u : T; M = ge ? T : (M & ~u[bq]); cM = ge ? c : cM - c; need -= ge ? 0u : c;
                if (cM == need) { G |= M; goto sel_done; }
            }
            unsigned run = 0u;
#pragma unroll
            for (int r = 0; r < 32; ++r) if (r < nr) { const bool isc = (M >> r) & 1u; const unsigned long long eqm = __ballot(isc);
                const unsigned pre = run + __builtin_amdgcn_mbcnt_hi((unsigned)(eqm >> 32), __builtin_amdgcn_mbcnt_lo((unsigned)eqm, 0u));
                if (isc && pre < need) G |= (1u << r);
                run += (unsigned)__builtin_popcountll(eqm); }
            }
            sel_done:
#pragma unroll
            for (int r = 0; r < 32; ++r) if ((r & ~7) < nr) { const unsigned long long bal = __ballot((G >> r) & 1u); asm volatile("s_nop 4\n\tv_writelane_b32 %0, %2, %4\n\tv_writelane_b32 %1, %3, %4" : "+v"(mlo), "+v"(mhi) : "s"((unsigned)bal), "s"((unsigned)(bal >> 32)), "n"(r));     }
        }
        if (lane < nr) bits64[(tokbase + pos) * 32 + lane] = ((unsigned long long)mhi << 32) | mlo;
    }
}
__device__ __forceinline__ void dsa_index_phase(const Frame& F, const bf16_t* __restrict__ PROJ, unsigned long long* __restrict__ bits64, unsigned* stampw) {
    LAS float* sc = (LAS float*)F.lds;
    LAS int* qctr = (LAS int*)(F.lds + TS_OFF);
    IdxOps P;
    int u = F.vcu;
    if (u < 4096) { dsa_index_load(P, PROJ, u & 31, u >> 5, F.lane, F.wave); dsa_index_load_k(P, PROJ, u & 31, u >> 5, F.lane, F.wave); }
#ifdef T_STAMP
    unsigned long long tA = 0, tB = 0, tC = 0, tD = 0, t0 = __builtin_amdgcn_s_memrealtime(), t1;
#define STAMP(acc) do { t1 = __builtin_amdgcn_s_memrealtime(); acc += t1 - t0; t0 = t1; } while (0)
#else
#define STAMP(acc) do { } while (0)
#endif
#pragma unroll 1
    for (; u < 4096; u += F.G) {
        dsa_index_scores(P, PROJ, sc, u & 31, u >> 5, F.lane, F.wave);
        if (F.tid == 0) *qctr = 0;
        STAMP(tA);
        __syncthreads();
        STAMP(tB);
        const int un = u + F.G;
        dsa_index_select(sc, qctr, bits64, u & 31, u >> 5, F.lane, F.wave);
        asm volatile("" ::: "memory");
        if (un < 4096) { dsa_index_load(P, PROJ, un & 31, un >> 5, F.lane, F.wave); dsa_index_load_k(P, PROJ, un & 31, un >> 5, F.lane, F.wave); }
        STAMP(tC);
        __syncthreads();
        STAMP(tD);
    }
#ifdef T_STAMP
    if (stampw && blockIdx.x == 17 && F.tid == 0) { const unsigned long long tot = tA + tB + tC + tD; const unsigned long long part = (T_STAMP == 0) ? tA : (T_STAMP == 1) ? tB : (T_STAMP == 2) ? tC : tD;
        *stampw = (unsigned)((part * 64ull) / (tot ? tot : 1ull)); }
#endif
#undef STAMP
}

constexpr int KS = 144, VS = 192;
#ifndef USE_TR
#define USE_TR 1
#endif
template <int MODE>
__device__ __forceinline__ void attn_unit(const Frame& F, const bf16_t* __restrict__ PROJ, bf16_t* __restrict__ O, const unsigned* __restrict__ bits, const float* __restrict__ sinks, int b, int g, int qb) {
    const int tid = F.tid, lane = F.lane, wid = F.wave, n = lane & 31, hi = lane >> 5;
    constexpr int CQ = MODE ? C_QB : C_QA, CK = MODE ? C_KB : C_KA, CV = MODE ? C_VB : C_VA;
    const int hq = 4 * g + (wid >> 1), qpos = qb * 64 + 32 * (wid & 1) + n;
    const size_t tokbase = (size_t)b * SEQ;
    LAS unsigned char* Ks = F.lds; LAS unsigned char* Vs = F.lds + 64 * KS;
    bf16x8 qf[4];
    { const bf16_t* qp = PROJ + (tokbase + qpos) * PLD + CQ + hq * 64 + 8 * hi;
#pragma unroll
      for (int s = 0; s < 4; ++s) qf[s] = *(const bf16x8*)(qp + 16 * s); }
    f32x16 o0, o1;
#pragma unroll
    for (int r = 0; r < 16; ++r) { o0[r] = 0.f; o1[r] = 0.f; }
    float mrun, lsum;
    if (MODE == 0) { mrun = sinks[hq] * LOG2E; lsum = (hi == 0) ? 1.f : 0.f; } else { mrun = -1e30f; lsum = 0.f; }
    const int kt_lo = (MODE == 0) ? (qb >= 2 ? qb - 2 : 0) : 0, kt_hi = qb;
    const int srow = tid >> 3, sch = tid & 7;
    const bf16_t* kg = PROJ + (tokbase + srow) * PLD + CK + g * 64 + sch * 8;
    const bf16_t* vg = PROJ + (tokbase + srow) * PLD + CV + g * 64 + sch * 8;
    const unsigned* bp = bits + (tokbase + qpos) * 64;
    u32x4 kreg = *(const u32x4*)(kg + (size_t)kt_lo * 64 * PLD), vreg = *(const u32x4*)(vg + (size_t)kt_lo * 64 * PLD);
    u32x2 mreg = {0u, 0u};
    if (MODE == 1) mreg = *(const u32x2*)(bp + 2 * kt_lo);
    const int vbase = (4 * hi + ((lane & 15) >> 2)) * VS + (16 * ((lane >> 4) & 1) + 4 * (lane & 3)) * 2;
    for (int kt = kt_lo; kt <= kt_hi; ++kt) {
        __syncthreads();
        *(LAS u32x4*)(Ks + srow * KS + sch * 16) = kreg; *(LAS u32x4*)(Vs + srow * VS + sch * 16) = vreg;
        const u32x2 mcur = mreg;
        __syncthreads();
        if (kt < kt_hi) { kreg = *(const u32x4*)(kg + (size_t)(kt + 1) * 64 * PLD); vreg = *(const u32x4*)(vg + (size_t)(kt + 1) * 64 * PLD); if (MODE == 1) mreg = *(const u32x2*)(bp + 2 * (kt + 1)); }
        f32x16 p0, p1;
#pragma unroll
        for (int r = 0; r < 16; ++r) { p0[r] = 0.f; p1[r] = 0.f; }
#pragma unroll
        for (int s = 0; s < 4; ++s) { const bf16x8 k0 = *(const LAS bf16x8*)(Ks + n * KS + (16 * s + 8 * hi) * 2), k1 = *(const LAS bf16x8*)(Ks + (n + 32) * KS + (16 * s + 8 * hi) * 2);
            p0 = __builtin_amdgcn_mfma_f32_32x32x16_bf16(k0, qf[s], p0, 0, 0, 0); p1 = __builtin_amdgcn_mfma_f32_32x32x16_bf16(k1, qf[s], p1, 0, 0, 0); }
        unsigned w0, w1;
        if (MODE == 1) { w0 = mcur.x >> (4 * hi); w1 = mcur.y >> (4 * hi); }
        else {
#pragma unroll
            for (int blk = 0; blk < 2; ++blk) { const int d0 = qpos - (kt * 64 + 32 * blk); unsigned mk = 0u;
                if (d0 >= 0) { const int hb = d0 > 31 ? 31 : d0; int lo = d0 - 127; if (lo <= 31) { if (lo < 0) lo = 0; mk = (0xFFFFFFFFu >> (31 - hb)) & (0xFFFFFFFFu << lo); } }
                if (blk == 0) w0 = mk >> (4 * hi); else w1 = mk >> (4 * hi); }
        }
        float mx = fmaxf(fmaxf(p0[0], p0[1]), fmaxf(p1[0], p1[1]));
#pragma unroll
        for (int r = 2; r < 16; r += 2) mx = fmaxf(mx, fmaxf(fmaxf(p0[r], p0[r + 1]), fmaxf(p1[r], p1[r + 1])));
        mx = xor32_max(mx);
        const float mnew = fmaxf(mrun, mx), alpha = fexp2(mrun - mnew); mrun = mnew;
        float ps = 0.f;
#pragma unroll
        for (int r = 0; r < 16; ++r) { const int bitpos = 8 * (r >> 2) + (r & 3);
            const float e0 = fexp2(p0[r] - mnew), e1 = fexp2(p1[r] - mnew);
            p0[r] = __builtin_bit_cast(float, __builtin_bit_cast(unsigned, e0) & (unsigned)__builtin_amdgcn_sbfe((int)w0, bitpos, 1));
            p1[r] = __builtin_bit_cast(float, __builtin_bit_cast(unsigned, e1) & (unsigned)__builtin_amdgcn_sbfe((int)w1, bitpos, 1));
            ps += p0[r] + p1[r]; }
        lsum = lsum * alpha + ps;
        if (__builtin_amdgcn_ballot_w64(alpha != 1.f) != 0ull) {
#pragma unroll
            for (int r = 0; r < 16; ++r) { o0[r] *= alpha; o1[r] *= alpha; } }
        bf16x8 pf[2][2];
#pragma unroll
        for (int s2 = 0; s2 < 2; ++s2) { u32x4 a, c;
            a.x = cvt_pk_bf16(p0[8 * s2 + 0], p0[8 * s2 + 1]); a.y = cvt_pk_bf16(p0[8 * s2 + 2], p0[8 * s2 + 3]); a.z = cvt_pk_bf16(p0[8 * s2 + 4], p0[8 * s2 + 5]); a.w = cvt_pk_bf16(p0[8 * s2 + 6], p0[8 * s2 + 7]);
            c.x = cvt_pk_bf16(p1[8 * s2 + 0], p1[8 * s2 + 1]); c.y = cvt_pk_bf16(p1[8 * s2 + 2], p1[8 * s2 + 3]); c.z = cvt_pk_bf16(p1[8 * s2 + 4], p1[8 * s2 + 5]); c.w = cvt_pk_bf16(p1[8 * s2 + 6], p1[8 * s2 + 7]);
            pf[0][s2] = __builtin_bit_cast(bf16x8, a); pf[1][s2] = __builtin_bit_cast(bf16x8, c); }
#pragma unroll
        for (int db = 0; db < 2; ++db)
#pragma unroll
            for (int blk = 0; blk < 2; ++blk)
#pragma unroll
                for (int s2 = 0; s2 < 2; ++s2) {
                    bf16x8 vf;
#if USE_TR
                    const v4i16_t t0 = __builtin_amdgcn_ds_read_tr16_b64_v4i16((LAS v4i16_t*)(Vs + vbase + (32 * blk + 16 * s2) * VS + 64 * db));
                    const v4i16_t t1 = __builtin_amdgcn_ds_read_tr16_b64_v4i16((LAS v4i16_t*)(Vs + vbase + (32 * blk + 16 * s2 + 8) * VS + 64 * db));
                    vf = (bf16x8){t0[0], t0[1], t0[2], t0[3], t1[0], t1[1], t1[2], t1[3]};
#else
#pragma unroll
                    for (int j = 0; j < 8; ++j) vf[j] = *(const LAS short*)(Vs + (32 * blk + 16 * s2 + 8 * (j >> 2) + 4 * hi + (j & 3)) * VS + (32 * db + n) * 2);
#endif
                    if (db == 0) o0 = __builtin_amdgcn_mfma_f32_32x32x16_bf16(vf, pf[blk][s2], o0, 0, 0, 0); else o1 = __builtin_amdgcn_mfma_f32_32x32x16_bf16(vf, pf[blk][s2], o1, 0, 0, 0);
                }
    }
    const float lt = xor32_add(lsum), inv = 1.f / lt;
    bf16_t* op = O + (tokbase + qpos) * 512 + hq * 64 + 8 * hi;
#pragma unroll
    for (int db = 0; db < 2; ++db)
#pragma unroll
        for (int kp = 0; kp < 2; ++kp) { const int r0 = 8 * kp;
            unsigned ax, ay, bx, by;
            if (db == 0) { ax = cvt_pk_bf16(o0[r0] * inv, o0[r0 + 1] * inv); ay = cvt_pk_bf16(o0[r0 + 2] * inv, o0[r0 + 3] * inv); bx = cvt_pk_bf16(o0[r0 + 4] * inv, o0[r0 + 5] * inv); by = cvt_pk_bf16(o0[r0 + 6] * inv, o0[r0 + 7] * inv); }
            else { ax = cvt_pk_bf16(o1[r0] * inv, o1[r0 + 1] * inv); ay = cvt_pk_bf16(o1[r0 + 2] * inv, o1[r0 + 3] * inv); bx = cvt_pk_bf16(o1[r0 + 4] * inv, o1[r0 + 5] * inv); by = cvt_pk_bf16(o1[r0 + 6] * inv, o1[r0 + 7] * inv); }
            { auto r = __builtin_amdgcn_permlane32_swap(ax, bx, false, false); ax = r[0]; bx = r[1]; }
            { auto r = __builtin_amdgcn_permlane32_swap(ay, by, false, false); ay = r[0]; by = r[1]; }
            *(u32x4*)(op + 32 * db + 16 * kp) = (u32x4){ax, ay, bx, by}; }
}

constexpr int SGS = 1040;
static_assert(128 * SGS <= MISC_OFF, "spatial-gating tile vs LDS control words");
__device__ __forceinline__ void sg_unit(const Frame& F, const bf16_t* __restrict__ PROJ, const bf16_t* __restrict__ SGWl, const float* __restrict__ sgb, const float* __restrict__ lng, bf16_t* __restrict__ OC, int b, int ch) {
    const int lane = F.lane, wid = F.wave, n = lane & 31, hi = lane >> 5;
    const size_t tok0 = (size_t)b * SEQ + ch * 128;
    LAS unsigned char* V = F.lds;
    __syncthreads();
    float gl[8];
    { const f32x4 g0 = *(const f32x4*)(lng + 8 * lane), g1 = *(const f32x4*)(lng + 8 * lane + 4); gl[0] = g0[0]; gl[1] = g0[1]; gl[2] = g0[2]; gl[3] = g0[3]; gl[4] = g1[0]; gl[5] = g1[1]; gl[6] = g1[2]; gl[7] = g1[3]; }
    u32x4 wrow16[16];
#pragma unroll
    for (int rr = 0; rr < 16; ++rr) wrow16[rr] = *(const u32x4*)(PROJ + (tok0 + 16 * wid + rr) * PLD + C_V + 8 * lane);
#pragma unroll
    for (int rr = 0; rr < 16; ++rr) { const int row = 16 * wid + rr;
        const u32x4 w = wrow16[rr];
        float x[8] = {bf_lo(w.x), bf_hi(w.x), bf_lo(w.y), bf_hi(w.y), bf_lo(w.z), bf_hi(w.z), bf_lo(w.w), bf_hi(w.w)};
        float s = 0.f;
#pragma unroll
        for (int i = 0; i < 8; ++i) s += x[i];
        const float mean = wave_sum(s) * (1.f / 512.f); float q = 0.f;
#pragma unroll
        for (int i = 0; i < 8; ++i) { x[i] -= mean; q += x[i] * x[i]; }
        const float rstd = 1.f / sqrtf(wave_sum(q) * (1.f / 512.f) + LN_EPS);
        u32x4 o; o.x = cvt_pk_bf16(x[0] * rstd * gl[0], x[1] * rstd * gl[1]); o.y = cvt_pk_bf16(x[2] * rstd * gl[2], x[3] * rstd * gl[3]);
        o.z = cvt_pk_bf16(x[4] * rstd * gl[4], x[5] * rstd * gl[5]); o.w = cvt_pk_bf16(x[6] * rstd * gl[6], x[7] * rstd * gl[7]);
        *(LAS u32x4*)(V + row * SGS + 16 * lane) = o; }
    __syncthreads();
    const int g = wid;
    const int vbase = (8 * hi + ((lane & 15) >> 2)) * SGS + (g * 64 + 16 * ((lane >> 4) & 1) + 4 * (lane & 3)) * 2;
    const bf16_t* wg = SGWl + (size_t)g * 128 * 128;
#pragma unroll 1
    for (int tb = 0; tb < 4; ++tb) {
        f32x16 a0, a1;
#pragma unroll
        for (int r = 0; r < 16; ++r) { a0[r] = 0.f; a1[r] = 0.f; }
        const bf16_t* wrow = wg + (size_t)(32 * tb + n) * 128 + 8 * hi;
        bf16x8 afr[8];
#pragma unroll
        for (int ks = 0; ks < 8; ++ks) if (ks < 2 * tb + 2) afr[ks] = *(const bf16x8*)(wrow + 16 * ks);
#pragma unroll
        for (int ks = 0; ks < 8; ++ks) if (ks < 2 * tb + 2) {
            const bf16x8 af = afr[ks];
#pragma unroll
            for (int db = 0; db < 2; ++db) { bf16x8 vf;
#if USE_TR
                const v4i16_t t0 = __builtin_amdgcn_ds_read_tr16_b64_v4i16((LAS v4i16_t*)(V + vbase + (16 * ks) * SGS + 64 * db));
                const v4i16_t t1 = __builtin_amdgcn_ds_read_tr16_b64_v4i16((LAS v4i16_t*)(V + vbase + (16 * ks + 4) * SGS + 64 * db));
                vf = (bf16x8){t0[0], t0[1], t0[2], t0[3], t1[0], t1[1], t1[2], t1[3]};
#else
#pragma unroll
                for (int j = 0; j < 8; ++j) vf[j] = *(const LAS short*)(V + (16 * ks + 8 * hi + j) * SGS + (g * 64 + 32 * db + n) * 2);
#endif
                if (db == 0) a0 = __builtin_amdgcn_mfma_f32_32x32x16_bf16(af, vf, a0, 0, 0, 0); else a1 = __builtin_amdgcn_mfma_f32_32x32x16_bf16(af, vf, a1, 0, 0, 0); }
        }
#pragma unroll
        for (int r = 0; r < 16; ++r) { const int t = 32 * tb + 8 * (r >> 2) + 4 * hi + (r & 3); const float bb = sgb[g * 128 + t];
            const bf16_t* up = PROJ + (tok0 + t) * PLD + C_U + g * 64 + n; bf16_t* op = OC + (tok0 + t) * 512 + g * 64 + n;
            const float u0 = __builtin_bit_cast(float, (unsigned)up[0] << 16), u1 = __builtin_bit_cast(float, (unsigned)up[32] << 16);
            op[0] = (bf16_t)f2bf((a0[r] + bb) * u0); op[32] = (bf16_t)f2bf((a1[r] + bb) * u1); }
    }
}
constexpr int HS_STRIDE = 2064;
constexpr int P7_PART = 32 * HS_STRIDE;
constexpr int P7_LOG = P7_PART + 8 * 4096;
constexpr int P7_HIST = P7_LOG + 32 * 33 * 4;
__device__ __forceinline__ void p7_route(const Frame& F, const Args& a, int l, const float* xin, float* xout, const bf16_t* Y, const float* SSP, const float* MODl, signed char* H8, float* RS,
                                         const bf16_t* WRTl, unsigned* cnt, int* ROWTOK, unsigned* TOKINFO) {
    const int tid = F.tid, lane = F.lane, wid = F.wave, n = lane & 31, hi = lane >> 5;
    const float* g_post = a.in[5] + l * DM; const float* g_pre = a.in[6] + l * DM; const float* b_router = a.in[16] + l * NE;
    LAS unsigned char* hs = F.lds; LAS float* part = (LAS float*)(F.lds + P7_PART); LAS float* lg = (LAS float*)(F.lds + P7_LOG); LAS int* hist = (LAS int*)(F.lds + P7_HIST); LAS int* base = hist + 32;
    if (tid < 32) hist[tid] = 0;
    __syncthreads();
    for (int bt = F.vcu; bt < MTOK / 32; bt += F.G) {
        const int row0 = bt * 32, b = row0 >> 11;
        const float* mb = MODl + (size_t)b * 6 * DM;
        u32x2 yv[4][4]; f32x4 xv[4][4], s4v[4];
#pragma unroll
        for (int rr = 0; rr < 4; ++rr) { const size_t row = (size_t)row0 + 4 * wid + rr; s4v[rr] = *(const f32x4*)(SSP + row * 16 + 4 * (lane & 3));
#pragma unroll
            for (int j = 0; j < 4; ++j) { const int c = 4 * lane + 256 * j; yv[rr][j] = __builtin_nontemporal_load((const u32x2*)(Y + row * DM + c)); xv[rr][j] = __builtin_nontemporal_load((const f32x4*)(xin + row * DM + c)); } }
#pragma unroll
        for (int rr = 0; rr < 4; ++rr) { const int rl = 4 * wid + rr; const size_t row = (size_t)row0 + rl;
            const f32x4 s4 = s4v[rr];
            float ssy = (s4[0] + s4[1]) + (s4[2] + s4[3]); ssy = quad_sum(ssy);
            const float rstd1 = 1.f / sqrtf(ssy * (1.f / DM) + RMS_EPS);
            f32x4 v[4]; float ss = 0.f;
#pragma unroll
            for (int j = 0; j < 4; ++j) { const int c = 4 * lane + 256 * j; const u32x2 yw_ = yv[rr][j]; const f32x4 yy = {bf_lo(yw_.x), bf_hi(yw_.x), bf_lo(yw_.y), bf_hi(yw_.y)}, xx = xv[rr][j];
                const f32x4 gp = *(const f32x4*)(g_post + c), ga = *(const f32x4*)(mb + 2 * DM + c);
                v[j] = xx + ga * (yy * rstd1 * gp); *(f32x4*)(xout + row * DM + c) = v[j];
                ss += (v[j][0] * v[j][0] + v[j][1] * v[j][1]) + (v[j][2] * v[j][2] + v[j][3] * v[j][3]); }
            ss = wave_sum(ss);
            const float rstd = 1.f / sqrtf(ss * (1.f / DM) + RMS_EPS);
            f32x4 o[4]; float am = 0.f;
#pragma unroll
            for (int j = 0; j < 4; ++j) { const int c = 4 * lane + 256 * j; const f32x4 gg = *(const f32x4*)(g_pre + c), s1 = *(const f32x4*)(mb + 4 * DM + c), s0 = *(const f32x4*)(mb + 3 * DM + c);
                o[j] = (v[j] * rstd) * gg * (s1 + 1.f) + s0; u32x2 w; w.x = cvt_pk_bf16(o[j][0], o[j][1]); w.y = cvt_pk_bf16(o[j][2], o[j][3]);
                *(LAS u32x2*)(hs + rl * HS_STRIDE + c * 2) = w;
                am = fmaxf(am, fmaxf(fmaxf(fabsf(o[j][0]), fabsf(o[j][1])), fmaxf(fabsf(o[j][2]), fabsf(o[j][3])))); }
            am = wave_max(am);
            const float scale = fmaxf(am, 1e-30f) * (1.f / 127.f), inv = 1.f / scale;
            if (lane == 0) RS[row] = scale;
#pragma unroll
            for (int j = 0; j < 4; ++j) *(unsigned*)(H8 + row * DM + 4 * lane + 256 * j) = q8x4(o[j][0], o[j][1], o[j][2], o[j][3], inv); }
        __syncthreads();
        {
            f32x16 d;
#pragma unroll
            for (int r = 0; r < 16; ++r) d[r] = 0.f;
#pragma unroll
            for (int ks = 0; ks < 8; ++ks) { const int k0 = (8 * wid + ks) * 16 + 8 * hi;
                const bf16x8 af = *(const LAS bf16x8*)(hs + n * HS_STRIDE + k0 * 2); const bf16x8 bf = *(const bf16x8*)(WRTl + (size_t)n * DM + k0);
                d = __builtin_amdgcn_mfma_f32_32x32x16_bf16(af, bf, d, 0, 0, 0); }
#pragma unroll
            for (int r = 0; r < 16; ++r) part[wid * 1024 + (8 * (r >> 2) + 4 * hi + (r & 3)) * 32 + n] = d[r];
        }
        __syncthreads();
        for (int i = tid; i < 1024; i += 512) { float s = b_router[i & 31];
#pragma unroll
            for (int w = 0; w < 8; ++w) s += part[w * 1024 + i]; lg[(i >> 5) * 33 + (i & 31)] = s; }
        __syncthreads();
        int e_k[4] = {0, 0, 0, 0}, lp_k[4] = {0, 0, 0, 0}; float w_k[4] = {0.f, 0.f, 0.f, 0.f};
        if (tid < 32) { LAS float* mylg = lg + tid * 33; float tl[4];
#pragma unroll
            for (int k = 0; k < 4; ++k) { float best = -INFINITY; int bi = 0;
                for (int e = 0; e < 32; ++e) { const float vv = mylg[e]; if (vv > best) { best = vv; bi = e; } }
                tl[k] = best; e_k[k] = bi; mylg[bi] = -INFINITY; }
            float sum = 0.f;
#pragma unroll
            for (int k = 0; k < 4; ++k) { w_k[k] = __expf(tl[k] - tl[0]); sum += w_k[k]; }
            const float inv = 1.f / sum;
#pragma unroll
            for (int k = 0; k < 4; ++k) { w_k[k] *= inv; lp_k[k] = __hip_atomic_fetch_add(&hist[e_k[k]], 1, __ATOMIC_RELAXED, __HIP_MEMORY_SCOPE_WORKGROUP); } }
        __syncthreads();
        if (tid < 32) { const int hc = hist[tid]; base[tid] = hc > 0 ? (int)__hip_atomic_fetch_add(cnt + 64 * tid, (unsigned)hc, __ATOMIC_RELAXED, __HIP_MEMORY_SCOPE_AGENT) : 0; hist[tid] = 0; }
        __syncthreads();
        if (tid < 32) { const int token = row0 + tid; u32x4 info; f32x4 ww;
#pragma unroll
            for (int k = 0; k < 4; ++k) { const int pos = base[e_k[k]] + lp_k[k]; ROWTOK[e_k[k] * 65536 + pos] = token; info[k] = ((unsigned)e_k[k] << 17) | (unsigned)pos; ww[k] = w_k[k]; }
            *(u32x4*)(TOKINFO + (size_t)token * 8) = info; *(f32x4*)(TOKINFO + (size_t)token * 8 + 4) = ww; }
        __syncthreads();
    }
}

__device__ __forceinline__ int moe_tables(const Frame& F, unsigned* cnt) {
    LAS int* ts = (LAS int*)(F.lds + TS_OFF); LAS int* te = (LAS int*)(F.lds + TILE_E_OFF);
    __syncthreads();
    if (F.tid == 0) { int acc = 0; for (int e = 0; e < NE; ++e) { ts[e] = acc; const unsigned c = __hip_atomic_load(cnt + 64 * e, __ATOMIC_RELAXED, __HIP_MEMORY_SCOPE_AGENT); acc += (int)((c + 255u) >> 8); } ts[NE] = acc; }
    __syncthreads();
    const int RT = ts[NE];
    for (int rt = F.tid; rt < RT; rt += 512) { int e = 0;
#pragma unroll 1
        for (int q = 1; q < NE; ++q) e += (ts[q] <= rt) ? 1 : 0;
        te[rt] = e; }
    __syncthreads();
    return RT;
}

__device__ __forceinline__ void p10_combine(const Frame& F, const Args& a, int l, float* xio, const bf16_t* Y2, const unsigned* TOKINFO, const float* MODbase, signed char* H8, float* RS) {
    const int lane = F.lane; const LAS int* ts = (const LAS int*)(F.lds + TS_OFF);
    const float* g_postf = a.in[7] + l * DM;
    const int gw = F.vcu * 8 + F.wave, NGW = F.G * 8;
    for (int rowp = gw * 2; rowp < MTOK; rowp += NGW * 2) {
        u32x4 info[2]; f32x4 ww[2]; u32x2 yw[2][4][4]; f32x4 xv[2][4];
#pragma unroll
        for (int rr = 0; rr < 2; ++rr) { info[rr] = *(const u32x4*)(TOKINFO + (size_t)(rowp + rr) * 8); ww[rr] = *(const f32x4*)(TOKINFO + (size_t)(rowp + rr) * 8 + 4); }
#pragma unroll
        for (int rr = 0; rr < 2; ++rr) {
#pragma unroll
            for (int k = 0; k < 4; ++k) { const int e = (int)(info[rr][k] >> 17), pos = (int)(info[rr][k] & 0x1ffffu); const size_t slot = (size_t)ts[e] * 256 + pos;
#pragma unroll
                for (int j = 0; j < 4; ++j) yw[rr][k][j] = __builtin_nontemporal_load((const u32x2*)(Y2 + slot * DM + 4 * lane + 256 * j)); }
#pragma unroll
            for (int j = 0; j < 4; ++j) xv[rr][j] = *(const f32x4*)(xio + (size_t)(rowp + rr) * DM + 4 * lane + 256 * j); }
#pragma unroll
        for (int rr = 0; rr < 2; ++rr) { const int row = rowp + rr, b = row >> 11;
        f32x4 y[4];
#pragma unroll
        for (int j = 0; j < 4; ++j) y[j] = (f32x4){0.f, 0.f, 0.f, 0.f};
#pragma unroll
        for (int k = 0; k < 4; ++k) { const float wk = ww[rr][k];
#pragma unroll
            for (int j = 0; j < 4; ++j) { const u32x2 w = yw[rr][k][j];
                y[j][0] += wk * bf_lo(w.x); y[j][1] += wk * bf_hi(w.x); y[j][2] += wk * bf_lo(w.y); y[j][3] += wk * bf_hi(w.y); } }
        float ss = 0.f;
#pragma unroll
        for (int j = 0; j < 4; ++j) ss += (y[j][0] * y[j][0] + y[j][1] * y[j][1]) + (y[j][2] * y[j][2] + y[j][3] * y[j][3]);
        ss = wave_sum(ss);
        const float rstd = 1.f / sqrtf(ss * (1.f / DM) + RMS_EPS);
        const float* mb = MODbase + ((size_t)l * BATCH + b) * 6 * DM;
        f32x4 v[4]; float s2 = 0.f;
#pragma unroll
        for (int j = 0; j < 4; ++j) { const int c = 4 * lane + 256 * j; const f32x4 xx = xv[rr][j], gp = *(const f32x4*)(g_postf + c), ga = *(const f32x4*)(mb + 5 * DM + c);
            v[j] = xx + ga * (y[j] * rstd * gp);
#ifdef T_STAMP
            if (l + 1 == DEPTH) v[j] = v[j] * (1.f + (float)(*((const unsigned*)MODbase - (1u << 18) + 100)) * (1.f / 256.f));
#endif
            *(f32x4*)(xio + (size_t)row * DM + c) = v[j];
            s2 += (v[j][0] * v[j][0] + v[j][1] * v[j][1]) + (v[j][2] * v[j][2] + v[j][3] * v[j][3]); }
        if (l + 1 < DEPTH) { s2 = wave_sum(s2); const float* mb1 = MODbase + ((size_t)(l + 1) * BATCH + b) * 6 * DM;
            norm_mod_row(v, s2, a.in[4] + (l + 1) * DM, mb1 + DM, mb1, H8 + (size_t)row * DM, RS + row, lane); }
        }
    }
}
#ifndef MK_ONE_LAUNCH
#define MK_ONE_LAUNCH 1
#endif
constexpr int N_PHASES = 2 + 9 * DEPTH;
__global__ void __launch_bounds__(512, 2) fwd(Args args) {
    extern __shared__ __attribute__((aligned(16))) unsigned char lds_raw[];
    Frame F0;
    F0.lds = (LAS unsigned char*)lds_raw;
    F0.tid = threadIdx.x; F0.lane = F0.tid & 63; F0.wave = __builtin_amdgcn_readfirstlane(F0.tid >> 6);
    F0.G = gridDim.x; { const int bx = blockIdx.x; F0.vcu = (F0.G % 8 == 0) ? (bx % 8) * (F0.G / 8) + bx / 8 : bx; }
    volatile LAS unsigned* MISC = (volatile LAS unsigned*)(F0.lds + MISC_OFF);
    for (int u = F0.tid; u < 128; u += 512) MISC[u] = 0u;
    __syncthreads();
    unsigned* ctl = (unsigned*)(args.ws + WS_CTL);
    const int lo = args.ph_lo, hi = args.ph_hi;
    XcdBarrier bar; bar.bar = ctl + CW_BAR; bar.x = 0; bar.st = nullptr; bar.w = F0.wave;
    if (hi - lo > 1) bar = xcd_barrier_post(ctl + CW_BAR, MISC + 8, F0.wave);
#ifndef PHASE_MASK
#define PHASE_MASK 0x7ff
#endif
#define PHON(j) ((PHASE_MASK >> (j)) & 1)
#ifndef REPEAT_MASK
#define REPEAT_MASK 0
#endif
#define REP(j) for (int rep_ = 0; rep_ <= ((REPEAT_MASK >> (j)) & 1); ++rep_)
#define IN(k) (lo <= (k) && (k) < hi)
#define BOTH(k) (IN(k) && IN((k) + 1))
#define GRID_BAR() xcd_barrier(bar)
#define PH_BEGIN() const Frame F = phase_frame(F0); unsigned char* ws = opq(args.ws); (void)ws
    if (PHON(0) && IN(0)) REP(0) { PH_BEGIN(); p0_mod(F, args.in[1], args.in[2], args.in[3], (float*)(ws + WS_MOD)); p0_weights(F, args); if (BOTH(0)) GRID_BAR(); }
    if (PHON(1) && IN(1)) REP(1) { PH_BEGIN(); p1_norm(F, args.in[0], args.in[4], (const float*)(ws + WS_MOD), (signed char*)(ws + WS_H), (float*)(ws + WS_RS)); if (BOTH(1)) GRID_BAR(); }

#pragma unroll 1
    for (int l = 0; l < DEPTH; ++l) {
        const int pb = 2 + 9 * l;
        if (PHON(2) && IN(pb + 0)) REP(2) { PH_BEGIN();
            pg8::Gemm g{(const bf16_t*)(ws + WS_H), (const bf16_t*)(ws + WS_W + (size_t)l * W_LAYER + WO_WIN), DM}; pg8::StaticOrder S; S.init(MTOK / 256, NPROJ / 256, F.G, (int)blockIdx.x);
            EpiProj E{(bf16_t*)(ws + WS_PROJ), (unsigned char*)(ws + WS_GATES), (const float*)(ws + WS_RS), (const float*)(ws + WS_CSIN) + (size_t)l * NPROJ};
            pg8::gemm_phase<EpiProj, pg8::StaticOrder, false, true>(F.lds, g, S, E, F.wave);
            if (BOTH(pb + 0)) GRID_BAR();
        }
        if (PHON(3) && IN(pb + 1)) REP(3) {
#ifndef SUBREP
#define SUBREP 0
#endif
            { const Frame Fa = phase_frame(F0); const bf16_t* PROJa = (const bf16_t*)(opq(args.ws) + WS_PROJ); bf16_t* OAa = (bf16_t*)(opq(args.ws) + WS_O);
            for (int u = Fa.vcu; u < 2048; u += Fa.G) { const int cu = u & 255, j = u >> 8, bg = cu >> 2, s = cu & 3, qb = (j & 1) ? (8 * (j >> 1) + 7 - s) : (8 * (j >> 1) + s);
                attn_unit<0>(Fa, PROJa, OAa, nullptr, args.in[9] + l * 8, bg >> 1, bg & 1, qb); } }
            { const Frame Fb = phase_frame(F0); unsigned char* wsb = opq(args.ws);
            for (int u = Fb.vcu; u < 512; u += Fb.G)
                sg_unit(Fb, (const bf16_t*)(wsb + WS_PROJ), (const bf16_t*)(wsb + WS_SGW) + (size_t)l * 8 * 128 * 128, args.in[11] + l * 8 * 128, args.in[12] + l * 512, (bf16_t*)(wsb + WS_O) + (size_t)2 * MTOK * 512, u >> 4, u & 15); }
            __syncthreads();
            { const Frame Fi = phase_frame(F0); unsigned char* wsi = opq(args.ws);
              dsa_index_phase(Fi, (const bf16_t*)(wsi + WS_PROJ), (unsigned long long*)(wsi + WS_BITS), l == 0 ? (unsigned*)(wsi + WS_CTL) + 100 : nullptr); }
            if (BOTH(pb + 1)) GRID_BAR();
        }
        if (PHON(4) && IN(pb + 2)) REP(4) { PH_BEGIN();
            for (int u = F.vcu; u < 2048; u += F.G) { const int cu = u & 255, j = u >> 8, bg = cu >> 2, s = cu & 3, qb = (j & 1) ? (8 * (j >> 1) + 7 - s) : (8 * (j >> 1) + s);
                attn_unit<1>(F, (const bf16_t*)(ws + WS_PROJ), (bf16_t*)(ws + WS_O) + (size_t)MTOK * 512, (const unsigned*)(ws + WS_BITS), nullptr, bg >> 1, bg & 1, qb); }
            __syncthreads();
            if (BOTH(pb + 2)) GRID_BAR();
        }
        if (PHON(5) && IN(pb + 3)) REP(5) { PH_BEGIN();
            pg8::Gemm g{(const bf16_t*)(ws + WS_O), (const bf16_t*)(ws + WS_W + (size_t)l * W_LAYER + WO_WBR), 512}; BranchOrder S; S.so.init(MTOK / 256, DM / 256, F.G, (int)blockIdx.x);
            EpiBranch E{(const unsigned char*)(ws + WS_GATES), (bf16_t*)(ws + WS_H)};
            pg8::gemm_phase<EpiBranch, BranchOrder, false>(F.lds, g, S, E, F.wave);
            if (BOTH(pb + 3)) GRID_BAR();
        }
        if (PHON(6) && IN(pb + 4)) REP(6) { PH_BEGIN();
            pg8::Gemm g{(const bf16_t*)(ws + WS_H), (const bf16_t*)(ws + WS_W + (size_t)l * W_LAYER + WO_WOUT), DM}; pg8::StaticOrder S; S.init(MTOK / 256, DM / 256, F.G, (int)blockIdx.x);
            EpiWout E{(bf16_t*)(ws + WS_Y), (float*)(ws + WS_SSP)};
            pg8::gemm_phase<EpiWout, pg8::StaticOrder, false>(F.lds, g, S, E, F.wave);
            if (BOTH(pb + 4)) GRID_BAR();
        }
        if (PHON(7) && IN(pb + 5)) REP(7) { PH_BEGIN();
            p7_route(F, args, l, l == 0 ? args.in[0] : (const float*)args.out, args.out, (const bf16_t*)(ws + WS_Y), (const float*)(ws + WS_SSP), (const float*)(ws + WS_MOD) + (size_t)l * BATCH * 6 * DM, (signed char*)(ws + WS_H), (float*)(ws + WS_RS),
                     (const bf16_t*)(ws + WS_WRT) + (size_t)l * NE * DM, (unsigned*)(ws + WS_CTL) + CW_CNT + l * 32 * 64, (int*)(ws + WS_ROWTOK), (unsigned*)(ws + WS_TOKINFO));
            if (BOTH(pb + 5)) GRID_BAR();
        }
        if (PHON(8) && IN(pb + 6)) REP(8) { PH_BEGIN();
            unsigned* cnt = (unsigned*)(ws + WS_CTL) + CW_CNT + l * 32 * 64; const int* ROWTOK = (const int*)(ws + WS_ROWTOK);
            const int RT = moe_tables(F, cnt);
            LAS int* ts = (LAS int*)(F.lds + TS_OFF); LAS int* te = (LAS int*)(F.lds + TILE_E_OFF); LAS int* ri = (LAS int*)(F.lds + ROWIDX_OFF);
            const long U = (long)RT * 8; MoeOrder S; S.u0 = (int)(U * F.vcu / F.G); S.u1 = (int)(U * (F.vcu + 1) / F.G); S.NB = 8; S.rt_lo = S.u0 / 8; S.tile_e = te; S.rowidx = ri;
            if (S.u1 > S.u0) { const int rt_hi = (S.u1 - 1) / 8; int ntile = rt_hi - S.rt_lo + 1; if (ntile > 8) ntile = 8;
                for (int i = F.tid; i < ntile * 256; i += 512) { const int rt = S.rt_lo + (i >> 8), r = i & 255, e = te[rt], first = (rt - ts[e]) * 256 + r;
                    const int c = (int)__hip_atomic_load(cnt + 64 * e, __ATOMIC_RELAXED, __HIP_MEMORY_SCOPE_AGENT); ri[i] = first < c ? ROWTOK[e * 65536 + first] : 0; } }
            __syncthreads();
            pg8::Gemm g{(const bf16_t*)(ws + WS_H), (const bf16_t*)(ws + WS_W + (size_t)l * W_LAYER + WO_W1), DM};
            EpiW1I8 E{(signed char*)(ws + WS_ACT), args.in[18] + (size_t)l * NE * 2 * FF, (const float*)(ws + WS_RS), (const float*)(ws + WS_CS1) + (size_t)l * NE * 2048, ri, S.rt_lo};
            pg8::gemm_phase<EpiW1I8, MoeOrder, true, true>(F.lds, g, S, E, F.wave);
            if (BOTH(pb + 6)) GRID_BAR();
        }
        if (PHON(9) && IN(pb + 7)) REP(9) { PH_BEGIN();
            const int RT = moe_tables(F, (unsigned*)(ws + WS_CTL) + CW_CNT + l * 32 * 64);
            const long U = (long)RT * 4; MoeOrder S; S.u0 = (int)(U * F.vcu / F.G); S.u1 = (int)(U * (F.vcu + 1) / F.G); S.NB = 4; S.rt_lo = 0; S.tile_e = (LAS int*)(F.lds + TILE_E_OFF); S.rowidx = nullptr;
            pg8::Gemm g{(const bf16_t*)(ws + WS_ACT), (const bf16_t*)(ws + WS_W + (size_t)l * W_LAYER + WO_W2), FF};
            EpiW2 E{(bf16_t*)(ws + WS_Y2), args.in[20] + (size_t)l * NE * DM, (const float*)(ws + WS_CS2) + (size_t)l * NE * DM};
            pg8::gemm_phase<EpiW2, MoeOrder, false, true>(F.lds, g, S, E, F.wave);
            if (BOTH(pb + 7)) GRID_BAR();
        }
        if (PHON(10) && IN(pb + 8)) REP(10) { PH_BEGIN();
            (void)moe_tables(F, (unsigned*)(ws + WS_CTL) + CW_CNT + l * 32 * 64);
            p10_combine(F, args, l, args.out, (const bf16_t*)(ws + WS_Y2), (const unsigned*)(ws + WS_TOKINFO), (const float*)(ws + WS_MOD), (signed char*)(ws + WS_H), (float*)(ws + WS_RS));
            if (BOTH(pb + 8)) GRID_BAR();
        }
    }
#undef PH_BEGIN
#undef IN
#undef BOTH
#undef GRID_BAR
}

extern "C" void kernel_launch(void* const* d_in, const int* in_sizes, int n_in, void* d_out, int out_size, void* d_ws, size_t ws_size, hipStream_t stream) {
    static int grid = 0;
    if (grid == 0) {
        if (n_in != 21 || out_size != MTOK * DM || ws_size < WS_END) { fprintf(stderr, "kernel_launch: unexpected shapes (n_in %d, out %d, ws %zu); nothing launched\n", n_in, out_size, ws_size); grid = -1; return; }
        int dev = 0, cus = 0, per_cu = 0;
        if (hipGetDevice(&dev) != hipSuccess || hipDeviceGetAttribute(&cus, hipDeviceAttributeMultiprocessorCount, dev) != hipSuccess) { grid = -1; return; }
        if (hipFuncSetAttribute((const void*)fwd, hipFuncAttributeMaxDynamicSharedMemorySize, LDS_BYTES) != hipSuccess) { fprintf(stderr, "kernel_launch: hipFuncSetAttribute failed\n"); grid = -1; return; }
        if (hipOccupancyMaxActiveBlocksPerMultiprocessor(&per_cu, (const void*)fwd, 512, LDS_BYTES) != hipSuccess || per_cu < 1) { fprintf(stderr, "kernel_launch: occupancy query says %d\n", per_cu); }
        (void)hipGetLastError();
        grid = cus > 256 ? 256 : cus;
    }
    if (grid < 0) return;
    (void)hipMemsetAsync((char*)d_ws + WS_CTL, 0, CTL_ZERO_BYTES, stream);
    Args a{};
    for (int i = 0; i < 21; ++i) a.in[i] = (const float*)d_in[i];
    a.out = (float*)d_out; a.ws = (unsigned char*)d_ws;
#if MK_ONE_LAUNCH
    a.ph_lo = 0; a.ph_hi = N_PHASES;
    hipLaunchKernelGGL(fwd, dim3(grid), dim3(512), LDS_BYTES, stream, a);
#else
    for (int p = 0; p < N_PHASES; ++p) { a.ph_lo = p; a.ph_hi = p + 1; hipLaunchKernelGGL(fwd, dim3(grid), dim3(512), LDS_BYTES, stream, a); }
#endif
}
```

```cpp
#include <hip/hip_runtime.h>
#include <cstdio>
#include <cstdint>
#include <type_traits>

#define LAS __attribute__((address_space(3)))
#define GAS __attribute__((address_space(1)))
typedef unsigned short bf16_t;
typedef short bf16x8 __attribute__((ext_vector_type(8)));
typedef float f32x2 __attribute__((ext_vector_type(2)));
typedef float f32x4 __attribute__((ext_vector_type(4)));
typedef float f32x16 __attribute__((ext_vector_type(16)));
typedef unsigned u32x2 __attribute__((ext_vector_type(2)));
typedef unsigned u32x4 __attribute__((ext_vector_type(4)));
typedef short v4i16_t __attribute__((ext_vector_type(4)));
typedef int i32x4 __attribute__((ext_vector_type(4)));

constexpr int BATCH = 32, SEQ = 2048, DM = 1024, MTOK = BATCH * SEQ, DEPTH = 2;
constexpr int NPROJ = 6144;
constexpr int PLD = 3072;
constexpr int C_QA = 0, C_KA = 512, C_VA = 640, C_QB = 768, C_KB = 1280, C_VB = 1408, C_QI = 1536, C_KI = 1792, C_WI = 1824, C_U = 2048, C_V = 2560, C_G = 3072;
constexpr int NE = 32, FF = 1024;
constexpr float RMS_EPS = 1e-5f, LN_EPS = 1e-5f;
constexpr float LOG2E = 1.4426950408889634f;
constexpr float QSCALE = 0.125f * LOG2E;

__device__ __forceinline__ unsigned f2bf(float f) { unsigned u = __builtin_bit_cast(unsigned, f); return (u + 0x7fffu + ((u >> 16) & 1u)) >> 16; }
__device__ __forceinline__ unsigned cvt_pk_bf16(float lo, float hi) { unsigned r; asm volatile("v_cvt_pk_bf16_f32 %0, %1, %2" : "=v"(r) : "v"(lo), "v"(hi)); return r; }
__device__ __forceinline__ float bf_lo(unsigned w) { return __builtin_bit_cast(float, w << 16); }
__device__ __forceinline__ float bf_hi(unsigned w) { return __builtin_bit_cast(float, w & 0xffff0000u); }
__device__ __forceinline__ float fexp2(float x) { return __builtin_amdgcn_exp2f(x); }
__device__ __forceinline__ float frcp(float x) { return __builtin_amdgcn_rcpf(x); }
__device__ __forceinline__ float sigmoidf_(float x) { return frcp(1.f + fexp2(-LOG2E * x)); }
__device__ __forceinline__ float gelu_tanh(float x) { const float t = x + 0.044715f * x * x * x; return x * frcp(1.f + fexp2(-2.302208198f * t)); }
template <int CTRL> __device__ __forceinline__ float dpp_f(float v) { return __builtin_bit_cast(float, __builtin_amdgcn_update_dpp(0, __builtin_bit_cast(int, v), CTRL, 0xF, 0xF, false)); }
__device__ __forceinline__ void swap32_asm(unsigned& a, unsigned& b) { asm volatile("s_nop 1\n\tv_permlane32_swap_b32 %0, %1" : "+v"(a), "+v"(b)); }
__device__ __forceinline__ float xor16_add(float v) { return v + __builtin_bit_cast(float, __builtin_amdgcn_ds_swizzle(__builtin_bit_cast(int, v), 0x401F)); }
__device__ __forceinline__ float xor16_max(float v) { return fmaxf(v, __builtin_bit_cast(float, __builtin_amdgcn_ds_swizzle(__builtin_bit_cast(int, v), 0x401F))); }
__device__ __forceinline__ float xor32_add(float v) { unsigned a = __builtin_bit_cast(unsigned, v), b = a; swap32_asm(a, b); return __builtin_bit_cast(float, a) + __builtin_bit_cast(float, b); }
__device__ __forceinline__ float xor32_max(float v) { unsigned a = __builtin_bit_cast(unsigned, v), b = a; swap32_asm(a, b); return fmaxf(__builtin_bit_cast(float, a), __builtin_bit_cast(float, b)); }
__device__ __forceinline__ float quad_sum(float v) { v += dpp_f<0xB1>(v); v += dpp_f<0x4E>(v); return v; }
__device__ __forceinline__ float wave_sum(float v) {
    v += dpp_f<0xB1>(v); v += dpp_f<0x4E>(v); v += dpp_f<0x141>(v); v += dpp_f<0x140>(v);
    return xor32_add(xor16_add(v));
}
__device__ __forceinline__ float wave_max(float v) {
    v = fmaxf(v, dpp_f<0xB1>(v)); v = fmaxf(v, dpp_f<0x4E>(v)); v = fmaxf(v, dpp_f<0x141>(v)); v = fmaxf(v, dpp_f<0x140>(v));
    return xor32_max(xor16_max(v));
}
__device__ __forceinline__ unsigned wave_sum_u32(unsigned v) {
    v += (unsigned)__builtin_amdgcn_update_dpp(0, (int)v, 0xB1, 0xF, 0xF, false);
    v += (unsigned)__builtin_amdgcn_update_dpp(0, (int)v, 0x4E, 0xF, 0xF, false);
    v += (unsigned)__builtin_amdgcn_update_dpp(0, (int)v, 0x141, 0xF, 0xF, false);
    v += (unsigned)__builtin_amdgcn_update_dpp(0, (int)v, 0x140, 0xF, 0xF, false);
    return __builtin_amdgcn_readlane(v, 0) + __builtin_amdgcn_readlane(v, 16) + __builtin_amdgcn_readlane(v, 32) + __builtin_amdgcn_readlane(v, 48);
}
__device__ __forceinline__ unsigned wave_max_u32(unsigned v) {
    unsigned t;
    t = (unsigned)__builtin_amdgcn_update_dpp(0, (int)v, 0xB1, 0xF, 0xF, false); v = v > t ? v : t;
    t = (unsigned)__builtin_amdgcn_update_dpp(0, (int)v, 0x4E, 0xF, 0xF, false); v = v > t ? v : t;
    t = (unsigned)__builtin_amdgcn_update_dpp(0, (int)v, 0x141, 0xF, 0xF, false); v = v > t ? v : t;
    t = (unsigned)__builtin_amdgcn_update_dpp(0, (int)v, 0x140, 0xF, 0xF, false); v = v > t ? v : t;
    unsigned a = __builtin_amdgcn_readlane(v, 0), b = __builtin_amdgcn_readlane(v, 16), c = __builtin_amdgcn_readlane(v, 32), d = __builtin_amdgcn_readlane(v, 48);
    a = a > b ? a : b; c = c > d ? c : d; return a > c ? a : c;
}
__device__ __forceinline__ unsigned q8x4(float a, float b, float c, float d, float inv) {
    unsigned r = 0u;
    r = __builtin_amdgcn_cvt_pk_u8_f32(__builtin_rintf(fmaf(a, inv, 128.f)), 0u, r);
    r = __builtin_amdgcn_cvt_pk_u8_f32(__builtin_rintf(fmaf(b, inv, 128.f)), 1u, r);
    r = __builtin_amdgcn_cvt_pk_u8_f32(__builtin_rintf(fmaf(c, inv, 128.f)), 2u, r);
    r = __builtin_amdgcn_cvt_pk_u8_f32(__builtin_rintf(fmaf(d, inv, 128.f)), 3u, r);
    return r ^ 0x80808080u;
}
__device__ __forceinline__ unsigned u8x4_floor(float a, float b, float c, float d) {
    unsigned r = 0u;
    r = __builtin_amdgcn_cvt_pk_u8_f32(__builtin_floorf(a), 0u, r); r = __builtin_amdgcn_cvt_pk_u8_f32(__builtin_floorf(b), 1u, r);
    r = __builtin_amdgcn_cvt_pk_u8_f32(__builtin_floorf(c), 2u, r); r = __builtin_amdgcn_cvt_pk_u8_f32(__builtin_floorf(d), 3u, r);
    return r;
}
__device__ __forceinline__ int lane_id_volatile(int tag = 0) { int l; asm volatile("v_mbcnt_lo_u32_b32 %0, -1, 0 ; LANETAG %1\n\tv_mbcnt_hi_u32_b32 %0, -1, %0" : "=v"(l) : "s"(tag)); return l; }
#define LDS_WAIT() asm volatile("s_waitcnt lgkmcnt(0)" ::: "memory")
#define VM_WAIT() asm volatile("s_waitcnt vmcnt(0)" ::: "memory")

namespace pg8 {
constexpr int BM = 256, BK = 64, HALF = 128, HTB = HALF * BK * 2  , STAGE_BYTES = 8 * HTB, NXCD = 8, WGM = 8;
__host__ __device__ __forceinline__ int lds_byte(int r, int c) { const int st = (r >> 4) * 2 + (c >> 5), rr = r & 15, cc = c & 31, ob = rr * 64 + cc * 2; return st * 1024 + (ob ^ (((ob >> 9) & 1) << 5)); }
__host__ __device__ __forceinline__ void stage_rc(int b, int& R, int& C) { const int st = b / 1024, sb = b % 1024, swz = sb ^ (((sb >> 9) & 1) << 5); R = (st >> 1) * 16 + swz / 64; C = (st & 1) * 32 + (swz % 64) / 2; }
__host__ __device__ __forceinline__ int perm32(int rho) { const int n = rho >> 4, i = rho & 15; return 8 * (i >> 2) + 4 * n + (i & 3); }

struct Unit { int pm, pn; };
struct Gemm { const bf16_t* A; const bf16_t* Bt; int K; };

template <int NM, int NN> struct StaticOrder {
    int G, c;
    __device__ void init(int G_, int c_) { G = G_; c = c_; }
    __device__ __forceinline__ bool tile(int i, int& pm, int& pn) const {
        constexpr int nwg = NM * NN;
        const long L = (long)i * G + c; if (L >= nwg) return false;
        int wgid = (int)L; { constexpr int q = nwg / NXCD, r = nwg % NXCD; const int xcd = wgid % NXCD, off = wgid / NXCD; wgid = (xcd < r ? xcd * (q + 1) : r * (q + 1) + (xcd - r) * q) + off; }
        constexpr int nig = WGM * NN; static_assert(NM % WGM == 0, "row tiles in whole groups");
        const int gid = wgid / nig, fm = gid * WGM, rem = wgid % nig;
        pm = fm + (rem % WGM); pn = rem / WGM; return true;
    }
    __device__ __forceinline__ bool next(int i, Unit& u) const { return tile(i, u.pm, u.pn); }
};

template <class Epi, class Sched, bool GATHER, bool I8 = false>
__device__ __forceinline__ void gemm_phase(LAS unsigned char* lds, const Gemm g, const Sched& S, const Epi& E, int wv  ) {
    int tid = wv * 64 + lane_id_volatile(1); asm volatile("" : "+v"(tid));
    const int wid = __builtin_amdgcn_readfirstlane(tid >> 6), lane = tid & 63, wr = wid >> 2, wc = wid & 3, fr = lane & 15, fq = lane >> 4;
    const int K = g.K, RB = I8 ? K : 2 * K  , nt = RB / (BK * 2);
    unsigned voffA[2], voffB[2]; int RA[2], CA[2];
#pragma unroll
    for (int i = 0; i < 2; ++i) { int R, C; stage_rc(tid * 16 + i * 8192, R, C); const int Rb = (R & ~31) + perm32(R & 31); RA[i] = R; CA[i] = C;
        voffA[i] = (unsigned)(R * RB + C * 2); voffB[i] = (unsigned)(Rb * RB + C * 2); }
    const size_t kstep = (size_t)(BK * 2);
    const size_t hstep = (size_t)HALF * RB;
    const size_t tstep = 2 * hstep;
    const unsigned ldsw = (unsigned)wid * 1024u;
    const int aoff = lds_byte(wr * 64 + fr, fq * 8), boff = lds_byte(wc * 32 + fr, fq * 8);
#define PG8_SA(b, h) (((b) * 2 + (h)) * HTB)
#define PG8_SB(b, h) ((4 + (b) * 2 + (h)) * HTB)
#define PG8_STAGE(bufoff, gbase, voff) do { _Pragma("unroll") for (int _i = 0; _i < 2; ++_i) \
        __builtin_amdgcn_global_load_lds((const unsigned*)((const char*)(gbase) + (voff)[_i]), (LAS unsigned*)(lds + (bufoff) + ldsw + _i * 8192), 16, 0, 0); } while (0)
#define PG8_STAGE_A(bufoff, h, ubase, koff, VO) do { if constexpr (GATHER) { PG8_STAGE(bufoff, (const char*)g.A + (koff), VO[h]); } else { PG8_STAGE(bufoff, (ubase) + (h) * hstep + (koff), voffA); } } while (0)
#define PG8_LDA(dst, b, h) do { _Pragma("unroll") for (int m = 0; m < 4; ++m) _Pragma("unroll") for (int k = 0; k < 2; ++k) dst[m][k] = *(const LAS bf16x8*)(lds + PG8_SA(b, h) + aoff + m * 2048 + k * 1024); } while (0)
#define PG8_LDB(dst, b, h) do { _Pragma("unroll") for (int n = 0; n < 2; ++n) _Pragma("unroll") for (int k = 0; k < 2; ++k) dst[n][k] = *(const LAS bf16x8*)(lds + PG8_SB(b, h) + boff + n * 2048 + k * 1024); } while (0)
#define PG8_MMA(ai, bj, At, Bt) do { __builtin_amdgcn_s_setprio(1); _Pragma("unroll") for (int m = 0; m < 4; ++m) _Pragma("unroll") for (int n = 0; n < 2; ++n) _Pragma("unroll") for (int k = 0; k < 2; ++k) \
        { if constexpr (I8) acc[ai][bj][m][n] = __builtin_amdgcn_mfma_i32_16x16x64_i8(__builtin_bit_cast(i32x4, Bt[n][k]), __builtin_bit_cast(i32x4, At[m][k]), acc[ai][bj][m][n], 0, 0, 0); \
          else acc[ai][bj][m][n] = __builtin_amdgcn_mfma_f32_16x16x32_bf16(Bt[n][k], At[m][k], acc[ai][bj][m][n], 0, 0, 0); } __builtin_amdgcn_s_setprio(0); } while (0)
#define PG8_WAIT_V(n) asm volatile("s_waitcnt vmcnt(" #n ")" ::: "memory")
#define PG8_WAIT_L(n) asm volatile("s_waitcnt lgkmcnt(" #n ")" ::: "memory")
#define PG8_BAR __builtin_amdgcn_s_barrier()
#define PG8_SCHED __builtin_amdgcn_sched_barrier(0)
    Unit cur, nxt; int ui = 0;
    if (!S.next(0, cur)) return;
    typedef typename std::conditional<I8, i32x4, f32x4>::type accv_t;
    accv_t acc[2][2][4][2];
#pragma unroll
    for (int a = 0; a < 2; ++a)
#pragma unroll
        for (int b = 0; b < 2; ++b)
#pragma unroll
            for (int m = 0; m < 4; ++m)
#pragma unroll
                for (int n = 0; n < 2; ++n) acc[a][b][m][n] = (accv_t){0, 0, 0, 0};
    bf16x8 At[4][2], B0[2][2], B1[2][2];
    unsigned oc[2][2], on[2][2];
    if constexpr (GATHER) {
#pragma unroll
        for (int h = 0; h < 2; ++h)
#pragma unroll
            for (int i = 0; i < 2; ++i) { oc[h][i] = (unsigned)(S.src_row(cur, h * HALF + RA[i]) * RB + CA[i] * 2); on[h][i] = oc[h][i]; }
    }
    const char* cA = GATHER ? (const char*)g.A : (const char*)g.A + (size_t)cur.pm * tstep; const char* cB = (const char*)g.Bt + (size_t)cur.pn * tstep;
    PG8_STAGE(PG8_SB(0, 0), cB, voffB); PG8_STAGE(PG8_SB(0, 1), cB + hstep, voffB); PG8_STAGE_A(PG8_SA(0, 0), 0, cA, 0, oc); PG8_STAGE_A(PG8_SA(0, 1), 1, cA, 0, oc);
    if (wr == 1) PG8_BAR;
    PG8_WAIT_V(2); PG8_BAR;
    PG8_STAGE(PG8_SB(1, 0), cB + kstep, voffB); PG8_STAGE_A(PG8_SA(1, 0), 0, cA, kstep, oc); PG8_STAGE(PG8_SB(1, 1), cB + hstep + kstep, voffB);
    PG8_WAIT_V(6); PG8_BAR;
    for (;;) {
        const bool has_next = S.next(ui + 1, nxt);
        const char* nA = GATHER ? (const char*)g.A : (has_next ? (const char*)g.A + (size_t)nxt.pm * tstep : cA); const char* nB = has_next ? (const char*)g.Bt + (size_t)nxt.pn * tstep : cB;
        if constexpr (GATHER) {
            if (has_next) {
#pragma unroll
                for (int h = 0; h < 2; ++h)
#pragma unroll
                    for (int i = 0; i < 2; ++i) on[h][i] = (unsigned)(S.src_row(nxt, h * HALF + RA[i]) * RB + CA[i] * 2);
            }
        }
        for (int t = 0; t < nt; t += 2) {
            const bool last = (t == nt - 2);
            const size_t k1 = (size_t)(t + 1) * kstep;
            const size_t k2 = last ? (size_t)0 : (size_t)(t + 2) * kstep, k3 = k2 + kstep;
            const char* a2 = last ? nA : cA; const char* b2 = last ? nB : cB;
            unsigned o2[2][2];
            if constexpr (GATHER) {
#pragma unroll
                for (int h = 0; h < 2; ++h)
#pragma unroll
                    for (int i = 0; i < 2; ++i) o2[h][i] = last ? on[h][i] : oc[h][i];
            }
            PG8_LDB(B0, 0, 0); PG8_LDB(B1, 0, 1); PG8_SCHED; PG8_LDA(At, 0, 0); PG8_STAGE_A(PG8_SA(1, 1), 1, cA, k1, oc);
            PG8_WAIT_V(8); PG8_WAIT_L(0); PG8_BAR; PG8_MMA(0, 0, At, B0); PG8_MMA(0, 1, At, B1); PG8_BAR; PG8_SCHED;
            PG8_LDA(At, 0, 1); PG8_STAGE(PG8_SB(0, 0), b2 + k2, voffB); PG8_STAGE(PG8_SB(0, 1), b2 + hstep + k2, voffB); PG8_STAGE_A(PG8_SA(0, 0), 0, a2, k2, o2);
            PG8_WAIT_V(8); PG8_WAIT_L(0); PG8_BAR; PG8_MMA(1, 0, At, B0); PG8_MMA(1, 1, At, B1); PG8_BAR; PG8_SCHED;
            PG8_LDB(B0, 1, 0); PG8_LDB(B1, 1, 1); PG8_SCHED; PG8_LDA(At, 1, 0); PG8_STAGE_A(PG8_SA(0, 1), 1, a2, k2, o2);
            PG8_WAIT_V(8); PG8_WAIT_L(0); PG8_BAR; PG8_MMA(0, 0, At, B0); PG8_MMA(0, 1, At, B1); PG8_BAR; PG8_SCHED;
            PG8_LDA(At, 1, 1); PG8_STAGE(PG8_SB(1, 0), b2 + k3, voffB); PG8_STAGE(PG8_SB(1, 1), b2 + hstep + k3, voffB); PG8_STAGE_A(PG8_SA(1, 0), 0, a2, k3, o2);
            PG8_WAIT_V(8); PG8_WAIT_L(0); PG8_BAR; PG8_MMA(1, 0, At, B0); PG8_MMA(1, 1, At, B1); PG8_BAR; PG8_SCHED;
        }
        if (wr == 0) PG8_BAR;
        const bool rst = E(acc, cur, wr, wc, fr, fq);
        if (!has_next) break;
        if (rst) {
#pragma unroll
        for (int a = 0; a < 2; ++a)
#pragma unroll
            for (int b = 0; b < 2; ++b)
#pragma unroll
                for (int m = 0; m < 4; ++m)
#pragma unroll
                    for (int n = 0; n < 2; ++n) acc[a][b][m][n] = (accv_t){0, 0, 0, 0};
        }
        cur = nxt; cA = nA; cB = nB; ++ui;
        if constexpr (GATHER) {
#pragma unroll
            for (int h = 0; h < 2; ++h)
#pragma unroll
                for (int i = 0; i < 2; ++i) oc[h][i] = on[h][i];
        }
        if (wr == 1) PG8_BAR;
    }
    PG8_WAIT_V(0);
    PG8_BAR;
#undef PG8_SA
#undef PG8_SB
#undef PG8_STAGE
#undef PG8_STAGE_A
#undef PG8_LDA
#undef PG8_LDB
#undef PG8_MMA
#undef PG8_WAIT_V
#undef PG8_WAIT_L
#undef PG8_BAR
#undef PG8_SCHED
}
}
typedef f32x4 acc_t[2][2][4][2];
typedef i32x4 acci_t[2][2][4][2];

struct EpiProj {
    bf16_t* O; unsigned char* G8; const float* RS  ; const float* CS  ;
    __device__ __forceinline__ bool operator()(acci_t& acc, const pg8::Unit& u, int wr, int wc, int fr, int fq) const {
        const int pn = u.pn;
        const int act = (pn <= 1 || pn == 3 || pn == 4) ? 1 : (pn >= 12 ? 3 : (pn >= 8 ? 2 : 0));
        const int row0 = u.pm * 256 + wr * 64 + fr, col0 = pn * 256 + wc * 32 + 8 * fq;
        float rsv[8];
#pragma unroll
        for (int q = 0; q < 8; ++q) rsv[q] = RS[row0 + (q >> 2) * 128 + (q & 3) * 16];
        f32x2 cs2[2][4];
#pragma unroll
        for (int bj = 0; bj < 2; ++bj) { const f32x4 c0 = *(const f32x4*)(CS + col0 + bj * 128), c1 = *(const f32x4*)(CS + col0 + bj * 128 + 4); const float k = (act == 1 ? QSCALE : 1.f);
            cs2[bj][0] = (f32x2){c0[0], c0[1]} * k; cs2[bj][1] = (f32x2){c0[2], c0[3]} * k; cs2[bj][2] = (f32x2){c1[0], c1[1]} * k; cs2[bj][3] = (f32x2){c1[2], c1[3]} * k; }
#pragma unroll
        for (int ai = 0; ai < 2; ++ai)
#pragma unroll
            for (int m = 0; m < 4; ++m) { const int row = row0 + ai * 128 + m * 16; bf16_t* rowp = O + (size_t)row * PLD + col0; const float rs = rsv[ai * 4 + m];
#pragma unroll
                for (int bj = 0; bj < 2; ++bj) { f32x2 v[4];
#pragma unroll
                    for (int p = 0; p < 4; ++p) { const int i0 = 2 * p; v[p] = (f32x2){(float)acc[ai][bj][m][i0 >> 2][i0 & 3], (float)acc[ai][bj][m][(i0 + 1) >> 2][(i0 + 1) & 3]} * (cs2[bj][p] * rs); }
                    if (act == 2) {
#pragma unroll
                        for (int p = 0; p < 4; ++p) { const f32x2 x = v[p], t = (x * x * 0.044715f + 1.f) * x * (-2.302208198f); f32x2 d = {fexp2(t[0]), fexp2(t[1])}; d = d + 1.f; v[p] = x * (f32x2){frcp(d[0]), frcp(d[1])}; } }
                    else if (act == 3) {
                        f32x2 gq[4];
#pragma unroll
                        for (int p = 0; p < 4; ++p) { const f32x2 t = v[p] * (-LOG2E); f32x2 d = {fexp2(t[0]), fexp2(t[1])}; d = d + 1.f; gq[p] = (f32x2){frcp(d[0]), frcp(d[1])} * 256.f; }
                        u32x2 w8; w8.x = u8x4_floor(gq[0][0], gq[0][1], gq[1][0], gq[1][1]); w8.y = u8x4_floor(gq[2][0], gq[2][1], gq[3][0], gq[3][1]);
                        *(u32x2*)(G8 + (size_t)row * 3072 + (col0 - C_G) + bj * 128) = w8; continue; }
                    u32x4 w; w.x = cvt_pk_bf16(v[0][0], v[0][1]); w.y = cvt_pk_bf16(v[1][0], v[1][1]); w.z = cvt_pk_bf16(v[2][0], v[2][1]); w.w = cvt_pk_bf16(v[3][0], v[3][1]);
                    *(u32x4*)(rowp + bj * 128) = w; } }
        return true;
    }
};

struct BranchOrder {
    pg8::StaticOrder<MTOK / 256, DM / 256> so;
    __device__ __forceinline__ bool next(int j, pg8::Unit& u) const { const int i = j / 3, br = j - 3 * i; int pm, pn; if (!so.tile(i, pm, pn)) return false; u.pm = br * 256 + pm; u.pn = br * 4 + pn; return true; }
};
struct EpiBranch {
    const unsigned char* G8  ; bf16_t* MERGED;
    __device__ __forceinline__ bool operator()(acc_t& acc, const pg8::Unit& u, int wr, int wc, int fr, int fq) const {
        const int br = u.pn >> 2, pn = u.pn & 3, pm = u.pm & 255;
        const int row0 = pm * 256 + wr * 64 + fr, col0 = pn * 256 + wc * 32 + 8 * fq;
#pragma unroll
        for (int rnd = 0; rnd < 2; ++rnd) { const int ai = rnd, m0 = 0;
            u32x2 gw[4][2], gd[4][2];
#pragma unroll
            for (int m = m0; m < m0 + 4; ++m)
#pragma unroll
                for (int bj = 0; bj < 2; ++bj) { const unsigned char* gp = G8 + (size_t)(row0 + ai * 128 + m * 16) * 3072 + br * 1024 + col0 + bj * 128;
                    gw[m][bj] = *(const u32x2*)gp; if (br != 2) gd[m][bj] = *(const u32x2*)(gp + 1024); }
#pragma unroll
            for (int m = m0; m < m0 + 4; ++m) { const size_t row = (size_t)(row0 + ai * 128 + m * 16);
#pragma unroll
                for (int bj = 0; bj < 2; ++bj) {
                    const u32x2 g = gw[m][bj];
                    float gn[8];
#pragma unroll
                    for (int i = 0; i < 8; ++i) gn[i] = (float)((g[i >> 2] >> (8 * (i & 3))) & 0xffu) + 0.5f;
                    if (br != 2) { const u32x2 d = gd[m][bj];
#pragma unroll
                        for (int i = 0; i < 8; ++i) gn[i] = gn[i] * frcp((float)((d[i >> 2] >> (8 * (i & 3))) & 0xffu) + 0.5f); }
                    else {
#pragma unroll
                        for (int i = 0; i < 8; ++i) gn[i] *= (1.f / 256.f); }
                    f32x4 v0 = acc[ai][bj][m][0], v1 = acc[ai][bj][m][1];
                    v0[0] *= gn[0]; v0[1] *= gn[1]; v0[2] *= gn[2]; v0[3] *= gn[3]; v1[0] *= gn[4]; v1[1] *= gn[5]; v1[2] *= gn[6]; v1[3] *= gn[7];
                    if (br != 2) { acc[ai][bj][m][0] = v0; acc[ai][bj][m][1] = v1; }
                    else { u32x4 w; w.x = cvt_pk_bf16(v0[0], v0[1]); w.y = cvt_pk_bf16(v0[2], v0[3]); w.z = cvt_pk_bf16(v1[0], v1[1]); w.w = cvt_pk_bf16(v1[2], v1[3]);
                        *(u32x4*)(MERGED + row * DM + col0 + bj * 128) = w; } } }
            asm volatile("" ::: "memory");
        }
        return br == 2;
    }
};

struct EpiWout {
    bf16_t* Y; float* SSP;
    __device__ __forceinline__ bool operator()(acc_t& acc, const pg8::Unit& u, int wr, int wc, int fr, int fq) const {
        const int row0 = u.pm * 256 + wr * 64 + fr, col0 = u.pn * 256 + wc * 32 + 8 * fq;
#pragma unroll
        for (int ai = 0; ai < 2; ++ai)
#pragma unroll
            for (int m = 0; m < 4; ++m) { const size_t row = (size_t)(row0 + ai * 128 + m * 16); float ss = 0.f;
#pragma unroll
                for (int bj = 0; bj < 2; ++bj) { const f32x4 v0 = acc[ai][bj][m][0], v1 = acc[ai][bj][m][1];
                    ss += (v0[0] * v0[0] + v0[1] * v0[1]) + (v0[2] * v0[2] + v0[3] * v0[3]) + (v1[0] * v1[0] + v1[1] * v1[1]) + (v1[2] * v1[2] + v1[3] * v1[3]);
                    u32x4 w; w.x = cvt_pk_bf16(v0[0], v0[1]); w.y = cvt_pk_bf16(v0[2], v0[3]); w.z = cvt_pk_bf16(v1[0], v1[1]); w.w = cvt_pk_bf16(v1[2], v1[3]);
                    *(u32x4*)(Y + row * DM + col0 + bj * 128) = w; }
                ss = xor32_add(xor16_add(ss));
                if (fq == 0) SSP[row * 16 + u.pn * 4 + wc] = ss; }
        return true;
    }
};

struct MoeOrder {
    int u0, u1, NB, rt_lo;
    const LAS int* tile_e;
    const LAS int* rowidx;
    __device__ __forceinline__ bool next(int i, pg8::Unit& u) const { const int x = u0 + i; if (x >= u1) return false; const int rt = x / NB, pn = x - rt * NB; u.pm = rt; u.pn = tile_e[rt] * NB + pn; return true; }
    __device__ __forceinline__ int src_row(const pg8::Unit& u, int r) const { return rowidx[(u.pm - rt_lo) * 256 + r]; }
};
struct EpiW1 {
    bf16_t* ACT; const float* b1  ;
    __device__ __forceinline__ bool operator()(acc_t& acc, const pg8::Unit& u, int wr, int wc, int fr, int fq) const {
        const int e = u.pn >> 3, pn = u.pn & 7;
        const int row0 = u.pm * 256 + wr * 64 + fr, j0 = pn * 128 + wc * 32 + 8 * fq;
        const float* bp = b1 + (size_t)e * (2 * FF) + 2 * j0;
        float bg[8], bl[8];
#pragma unroll
        for (int q = 0; q < 4; ++q) { const f32x4 t = *(const f32x4*)(bp + 4 * q); bg[2 * q] = t[0]; bl[2 * q] = t[1]; bg[2 * q + 1] = t[2]; bl[2 * q + 1] = t[3]; }
#pragma unroll
        for (int ai = 0; ai < 2; ++ai)
#pragma unroll
            for (int m = 0; m < 4; ++m) { float a[8];
#pragma unroll
                for (int i = 0; i < 8; ++i) { float gl = acc[ai][0][m][i >> 2][i & 3] + bg[i], li = acc[ai][1][m][i >> 2][i & 3] + bl[i];
                    gl = fminf(gl, 7.f); li = fminf(fmaxf(li, -7.f), 7.f);
                    a[i] = gl * frcp(1.f + fexp2(-1.702f * LOG2E * gl)) * (li + 1.f); }
                u32x4 w; w.x = cvt_pk_bf16(a[0], a[1]); w.y = cvt_pk_bf16(a[2], a[3]); w.z = cvt_pk_bf16(a[4], a[5]); w.w = cvt_pk_bf16(a[6], a[7]);
                *(u32x4*)(ACT + (size_t)(row0 + ai * 128 + m * 16) * FF + j0) = w; }
        return true;
    }
};
constexpr float ACT_SCALE = 12.f / 127.f;
struct EpiW1I8 {
    signed char* ACT  ; const float* b1  ; const float* RS  ; const float* CS  ;
    const LAS int* rowidx; int rt_lo;
    __device__ __forceinline__ bool operator()(acci_t& acc, const pg8::Unit& u, int wr, int wc, int fr, int fq) const {
        const int e = u.pn >> 3, pn = u.pn & 7;
        const int rl0 = wr * 64 + fr, row0 = u.pm * 256 + rl0, j0 = pn * 128 + wc * 32 + 8 * fq;
        const float* bp = b1 + (size_t)e * (2 * FF) + 2 * j0;
        float bg[8], bl[8], cg[8], cl[8];
#pragma unroll
        for (int q = 0; q < 4; ++q) { const f32x4 t = *(const f32x4*)(bp + 4 * q); bg[2 * q] = t[0]; bl[2 * q] = t[1]; bg[2 * q + 1] = t[2]; bl[2 * q + 1] = t[3]; }
        { const float* cp = CS + (size_t)e * 2048 + pn * 256 + wc * 32 + 8 * fq;
          const f32x4 a0 = *(const f32x4*)cp, a1 = *(const f32x4*)(cp + 4), c0 = *(const f32x4*)(cp + 128), c1 = *(const f32x4*)(cp + 132);
#pragma unroll
          for (int i = 0; i < 4; ++i) { cg[i] = a0[i]; cg[4 + i] = a1[i]; cl[i] = c0[i]; cl[4 + i] = c1[i]; } }
        const LAS int* ri = rowidx + (u.pm - rt_lo) * 256 + rl0;
        float rsv[8];
#pragma unroll
        for (int q = 0; q < 8; ++q) rsv[q] = RS[ri[(q >> 2) * 128 + (q & 3) * 16]];
        f32x2 bg2[4], bl2[4], cg2[4], cl2[4];
#pragma unroll
        for (int p = 0; p < 4; ++p) { bg2[p] = (f32x2){bg[2 * p], bg[2 * p + 1]}; bl2[p] = (f32x2){bl[2 * p], bl[2 * p + 1]}; cg2[p] = (f32x2){cg[2 * p], cg[2 * p + 1]}; cl2[p] = (f32x2){cl[2 * p], cl[2 * p + 1]}; }
#pragma unroll
        for (int ai = 0; ai < 2; ++ai)
#pragma unroll
            for (int m = 0; m < 4; ++m) { const float rs = rsv[ai * 4 + m]; f32x2 a2[4];
#pragma unroll
                for (int p = 0; p < 4; ++p) { const int i0 = 2 * p;
                    const f32x2 ag = {(float)acc[ai][0][m][i0 >> 2][i0 & 3], (float)acc[ai][0][m][(i0 + 1) >> 2][(i0 + 1) & 3]}, al = {(float)acc[ai][1][m][i0 >> 2][i0 & 3], (float)acc[ai][1][m][(i0 + 1) >> 2][(i0 + 1) & 3]};
                    f32x2 gl = ag * (cg2[p] * rs) + bg2[p], li = al * (cl2[p] * rs) + bl2[p];
                    gl[0] = fminf(gl[0], 7.f); gl[1] = fminf(gl[1], 7.f); li[0] = fminf(fmaxf(li[0], -7.f), 7.f); li[1] = fminf(fmaxf(li[1], -7.f), 7.f);
                    const f32x2 ex = gl * (-1.702f * LOG2E); f32x2 den = {fexp2(ex[0]), fexp2(ex[1])}; den = den + 1.f; const f32x2 rc = {frcp(den[0]), frcp(den[1])};
                    a2[p] = (gl * rc) * (li + 1.f); }
                u32x2 w; w.x = q8x4(a2[0][0], a2[0][1], a2[1][0], a2[1][1], 1.f / ACT_SCALE); w.y = q8x4(a2[2][0], a2[2][1], a2[3][0], a2[3][1], 1.f / ACT_SCALE);
                *(u32x2*)(ACT + (size_t)(row0 + ai * 128 + m * 16) * FF + j0) = w; }
        return true;
    }
};
struct EpiW2 {
    bf16_t* Y2; const float* b2  ; const float* CS  ;
    __device__ __forceinline__ bool operator()(acci_t& acc, const pg8::Unit& u, int wr, int wc, int fr, int fq) const {
        const int e = u.pn >> 2, pn = u.pn & 3;
        const int row0 = u.pm * 256 + wr * 64 + fr, col0 = pn * 256 + wc * 32 + 8 * fq;
        f32x4 bv[2][2], cv[2][2];
#pragma unroll
        for (int bj = 0; bj < 2; ++bj)
#pragma unroll
            for (int n = 0; n < 2; ++n) { bv[bj][n] = *(const f32x4*)(b2 + (size_t)e * DM + col0 + bj * 128 + 4 * n); cv[bj][n] = *(const f32x4*)(CS + (size_t)e * DM + col0 + bj * 128 + 4 * n) * ACT_SCALE; }
#pragma unroll
        for (int ai = 0; ai < 2; ++ai)
#pragma unroll
            for (int m = 0; m < 4; ++m) { bf16_t* rowp = Y2 + (size_t)(row0 + ai * 128 + m * 16) * DM + col0;
#pragma unroll
                for (int bj = 0; bj < 2; ++bj) { const i32x4 a0 = acc[ai][bj][m][0], a1 = acc[ai][bj][m][1];
                    const f32x4 v0 = (f32x4){(float)a0[0], (float)a0[1], (float)a0[2], (float)a0[3]} * cv[bj][0] + bv[bj][0], v1 = (f32x4){(float)a1[0], (float)a1[1], (float)a1[2], (float)a1[3]} * cv[bj][1] + bv[bj][1];
                    u32x4 w; w.x = cvt_pk_bf16(v0[0], v0[1]); w.y = cvt_pk_bf16(v0[2], v0[3]); w.z = cvt_pk_bf16(v1[0], v1[1]); w.w = cvt_pk_bf16(v1[2], v1[3]);
                    *(u32x4*)(rowp + bj * 128) = w; } }
        return true;
    }
};
#define XB_TMO      128
#define XB_XCNT(j)  (256  + 64 * (j))
#define XB_XSUB(j)  (1280 + 64 * (j))
#define XB_XGEN(j)  (2304 + 64 * (j))
#define XB_TOP      3328
#define XB_TOPGEN   3392
#define XCD_BAR_WORDS 3456
#define XB_SPIN_CAP (1u << 18)

__device__ __forceinline__ unsigned xb_ld(unsigned* p)              { return __hip_atomic_load(p, __ATOMIC_RELAXED, __HIP_MEMORY_SCOPE_AGENT); }
__device__ __forceinline__ unsigned xb_add(unsigned* p, unsigned v) { return __hip_atomic_fetch_add(p, v, __ATOMIC_RELAXED, __HIP_MEMORY_SCOPE_AGENT); }
__device__ __forceinline__ unsigned xb_xcc_id() { return (unsigned)__builtin_amdgcn_s_getreg((3 << 11) | 20) & 0xFu; }
#define XB_SPIN(cond, bar) do { unsigned _sp = 0; while (cond) { __builtin_amdgcn_s_sleep(1); \
    if ((++_sp & 255u) == 0u) { if (xb_ld(&(bar)[XB_TMO])) break; if (_sp > XB_SPIN_CAP) { atomicAdd(&(bar)[XB_TMO], 1u); break; } } } } while (0)

struct XcdBarrier {
    unsigned* bar; unsigned x;
    int w;
    volatile LAS unsigned* st;
};

__device__ __forceinline__ bool xb_thread0(int w) { return w == 0 && lane_id_volatile(2) == 0; }
__device__ __forceinline__ XcdBarrier xcd_barrier_post(unsigned* bar, volatile LAS unsigned* st, int w) {
    XcdBarrier b; b.bar = bar; b.x = xb_xcc_id(); b.st = st; b.w = w;
    if (xb_thread0(w)) (void)xb_add(&bar[XB_XCNT(b.x)], 1u);
    return b;
}
__device__ __forceinline__ void xcd_barrier_complete(unsigned* bar, unsigned x, unsigned& nloc, unsigned& nx) {
    const unsigned G = gridDim.x * gridDim.y * gridDim.z;
    unsigned sum, cnt, mine, sp = 0u;
    for (;;) {
        sum = 0u; cnt = 0u; mine = 0u;
#pragma unroll
        for (unsigned j = 0; j < 16; ++j) { const unsigned c = xb_ld(&bar[XB_XCNT(j)]); sum += c; cnt += (c > 0u) ? 1u : 0u; mine = (j == x) ? c : mine; }
        if (sum == G) break;
        __builtin_amdgcn_s_sleep(1);
        if ((++sp & 255u) == 0u) { if (xb_ld(&bar[XB_TMO])) break; if (sp > XB_SPIN_CAP) { atomicAdd(&bar[XB_TMO], 1u); break; } }
    }
    nloc = mine > 0u ? mine : 1u; nx = cnt > 0u ? cnt : 1u;
}

__device__ __forceinline__ void xcd_barrier(const XcdBarrier& b) {
    asm volatile("s_waitcnt vmcnt(0)" ::: "memory");
    __syncthreads();
    if (xb_thread0(b.w)) {
        unsigned* bar = b.bar;
        __builtin_amdgcn_s_waitcnt(0);
        unsigned nloc = b.st[0], nx = b.st[1];
        if (nloc == 0u) { xcd_barrier_complete(bar, b.x, nloc, nx); b.st[0] = nloc; b.st[1] = nx; }
        const unsigned old = xb_add(&bar[XB_XSUB(b.x)], 1u);
        const unsigned gen = old / nloc;
        if (old + 1u == (gen + 1u) * nloc) {
            __builtin_amdgcn_fence(__ATOMIC_RELEASE, "agent");
            asm volatile("s_waitcnt vmcnt(0)" ::: "memory");
            const unsigned og = xb_add(&bar[XB_TOP], 1u);
            const unsigned tg = og / nx;
            if (og + 1u == (tg + 1u) * nx) xb_add(&bar[XB_TOPGEN], 1u);
            else XB_SPIN(xb_ld(&bar[XB_TOPGEN]) == tg, bar);
            __builtin_amdgcn_fence(__ATOMIC_ACQUIRE, "agent");
            xb_add(&bar[XB_XGEN(b.x)], 1u);
            asm volatile("s_waitcnt vmcnt(0)" ::: "memory");
        } else {
            XB_SPIN(xb_ld(&bar[XB_XGEN(b.x)]) == gen, bar);
            __builtin_amdgcn_fence(__ATOMIC_ACQUIRE, "agent");
            asm volatile("s_waitcnt vmcnt(0)" ::: "memory");
        }
    }
    __syncthreads();
}

constexpr size_t MiB = 1u << 20;
constexpr size_t WS_CTL = 0, CTL_ZERO_BYTES = 1 * MiB;
constexpr size_t WS_MOD = 1 * MiB;
constexpr size_t WS_SGW = 3 * MiB;
constexpr size_t WS_WRT = 3 * MiB + 512 * 1024;
constexpr size_t WS_RS = 4 * MiB;
constexpr size_t WS_CS1 = 5 * MiB;
constexpr size_t WS_CS2 = 6 * MiB + 512 * 1024;
constexpr size_t WS_CSIN = 6 * MiB;
constexpr size_t WS_W = 8 * MiB, W_LAYER = 209 * MiB;
constexpr size_t WO_WIN = 0, WO_WBR = 12 * MiB, WO_WOUT = 15 * MiB, WO_W1 = 17 * MiB, WO_W2 = 145 * MiB;
constexpr size_t WS_PROJ = 426 * MiB;
constexpr size_t WS_GATES = 810 * MiB;
constexpr size_t WS_ACT = WS_PROJ;
constexpr size_t WS_H = 1194 * MiB;
constexpr size_t WS_O = 1322 * MiB;
constexpr size_t WS_Y = 1514 * MiB;
constexpr size_t WS_BITS = 1770 * MiB;
constexpr size_t WS_Y2 = WS_O;
constexpr size_t WS_SSP = 1850 * MiB;
constexpr size_t WS_ROWTOK = 1854 * MiB;
constexpr size_t WS_TOKINFO = 1862 * MiB;
constexpr size_t WS_SLAB = 1864 * MiB;
constexpr size_t WS_END = 1928 * MiB;
static_assert(WS_Y2 + (size_t)270336 * 2048 <= WS_SSP && WS_W + 2 * W_LAYER <= WS_PROJ && WS_PROJ + (size_t)MTOK * PLD * 2 <= WS_GATES && WS_GATES + (size_t)MTOK * 3072 <= WS_H, "d_ws map");
constexpr int CW_BAR = 4096;
constexpr int CW_CNT = 16384;

constexpr int RING_BYTES = 131072;
constexpr int MISC_OFF = 134144;
constexpr int TS_OFF = MISC_OFF + 512;
constexpr int TILE_E_OFF = MISC_OFF + 1024;
constexpr int ROWIDX_OFF = MISC_OFF + 5632;
constexpr int LDS_BYTES = 151552;
static_assert(ROWIDX_OFF + 8192 <= LDS_BYTES, "LDS map");

struct Args {
    const float* in[21]; float* out; unsigned char* ws; int ph_lo, ph_hi;
};
struct Frame {
    LAS unsigned char* lds; int tid, lane, wave, vcu, G;
};
__device__ __forceinline__ Frame phase_frame(const Frame& F0) { Frame F = F0; int t = F0.wave * 64 + lane_id_volatile(3); asm volatile("" : "+v"(t)); F.tid = t; F.lane = t & 63; F.wave = F0.wave; return F; }
template <class T> __device__ __forceinline__ T* opq(T* p) { long z = 0; asm volatile("" : "+s"(z)); return (T*)((unsigned char*)p + z); }

__device__ __forceinline__ void p0_mod(const Frame& F, const float* c, const float* w_ada, const float* b_ada, float* MOD) {
    LAS float* csT = (LAS float*)F.lds;
    for (int i = F.tid; i < BATCH * DM; i += 512) { const int b = i & 31, k = i >> 5; const float v = c[b * DM + k]; csT[k * 32 + b] = v * sigmoidf_(v); }
    __syncthreads();
    const int gw = F.vcu * 8 + F.wave, NGW = F.G * 8;
    const int cg = F.lane & 15, kq = F.lane >> 4;
    for (int task = gw; task < DEPTH * 384; task += NGW) {
        const int l = task / 384, n = (task % 384) * 16 + cg;
        float acc[32];
#pragma unroll
        for (int b = 0; b < 32; ++b) acc[b] = 0.f;
        const float* w = w_ada + ((size_t)l * DM + kq * 256) * (6 * DM) + n;
#pragma unroll 4
        for (int k = 0; k < 256; ++k) {
            const float wv = w[(size_t)k * (6 * DM)];
            const LAS f32x4* cs = (const LAS f32x4*)(csT + (kq * 256 + k) * 32);
#pragma unroll
            for (int q = 0; q < 8; ++q) { const f32x4 c4 = cs[q]; acc[4 * q] += c4[0] * wv; acc[4 * q + 1] += c4[1] * wv; acc[4 * q + 2] += c4[2] * wv; acc[4 * q + 3] += c4[3] * wv; }
        }
#pragma unroll
        for (int b = 0; b < 32; ++b) { acc[b] = xor32_add(xor16_add(acc[b])); }
        if (kq == 0) { const float bb = b_ada[l * 6 * DM + n];
#pragma unroll
            for (int b = 0; b < 32; ++b) MOD[((size_t)l * BATCH + b) * (6 * DM) + n] = acc[b] + bb; }
    }
    __syncthreads();
}
__device__ __forceinline__ void tr_item(const float* W, size_t ldw, int srccol, bool valid, bf16_t* dst  , int K, LAS float* scr, int lane) {
    const float* wp = W + srccol;
#pragma unroll 8
    for (int i = 0; i < 32; ++i) { const int kk = 2 * i + (lane >> 5); scr[kk * 33 + (lane & 31)] = valid ? wp[(size_t)kk * ldw] : 0.f; }
    LDS_WAIT(); asm volatile("" ::: "memory");
    const int c = lane & 7;
#pragma unroll
    for (int j = 0; j < 4; ++j) { const int n = (lane >> 3) + 8 * j; const LAS float* s = scr + (8 * c) * 33 + n;
        u32x4 o; o.x = cvt_pk_bf16(s[0 * 33], s[1 * 33]); o.y = cvt_pk_bf16(s[2 * 33], s[3 * 33]); o.z = cvt_pk_bf16(s[4 * 33], s[5 * 33]); o.w = cvt_pk_bf16(s[6 * 33], s[7 * 33]);
        *(u32x4*)(dst + (size_t)n * K + 8 * c) = o; }
    LDS_WAIT(); asm volatile("" ::: "memory");
}
__device__ __forceinline__ void p0_weights(const Frame& F, const Args& a) {
    LAS float* scr = (LAS float*)(F.lds + F.wave * 16384);
    const int gw = F.vcu * 8 + F.wave, NGW = F.G * 8, lane = F.lane, jl = lane & 31;
    const float *w_in = a.in[8], *w_branch = a.in[13], *w_out = a.in[14], *w_router = a.in[15], *w1 = a.in[17], *w2 = a.in[19];
    constexpr int I_BR = 3 * 8 * 32, I_OUT = 16 * 32, I_RT = 16;
    constexpr int I_LAYER = I_BR + I_OUT + I_RT;
    for (int it = gw; it < DEPTH * I_LAYER; it += NGW) {
        const int l = it / I_LAYER; int r = it - l * I_LAYER;
        unsigned char* wl = a.ws + WS_W + (size_t)l * W_LAYER;
        if (r < I_BR) {
            const int br = r / 256, q = r % 256, kb = q / 32, nb = q % 32;
            tr_item(w_branch + ((size_t)(l * 3 + br) * 512 + kb * 64) * DM, DM, nb * 32 + jl, true, (bf16_t*)(wl + WO_WBR) + (size_t)(br * 1024 + nb * 32) * 512 + kb * 64, 512, scr, lane); continue; }
        r -= I_BR;
        if (r < I_OUT) {
            const int kb = r / 32, nb = r % 32;
            tr_item(w_out + ((size_t)l * DM + kb * 64) * DM, DM, nb * 32 + jl, true, (bf16_t*)(wl + WO_WOUT) + (size_t)nb * 32 * DM + kb * 64, DM, scr, lane); continue; }
        r -= I_OUT;
        {
            const int kb = r;
            tr_item(w_router + ((size_t)l * DM + kb * 64) * NE, NE, jl, true, (bf16_t*)(a.ws + WS_WRT) + (size_t)l * NE * DM + kb * 64, DM, scr, lane); }
        (void)r;
    }
    __syncthreads();
    {
    LAS float* T = (LAS float*)F.lds; LAS float* red = (LAS float*)(F.lds + ROWIDX_OFF);
    const int half = lane >> 5, wave = F.wave;
    constexpr int ST_W1 = NE * 64, ST_IN = 192, ST_W2 = NE * 32, ST_LAYER = ST_W1 + ST_IN + ST_W2;
    for (int st = F.vcu; st < DEPTH * ST_LAYER; st += F.G) {
        const int l = st / ST_LAYER, q = st % ST_LAYER;
        const float* wp; size_t ldw; bool valid = true; signed char* dst; float* csp;
        if (q < ST_W1) { const int e = q / 64, r6 = q % 64, pn = r6 >> 3, jjg = (r6 >> 1) & 3, sgl = r6 & 1, nb = pn * 8 + sgl * 4 + jjg, n = nb * 32 + jl, src = 2 * (128 * pn + jjg * 32 + jl) + sgl;
            wp = w1 + ((size_t)(l * NE + e) * DM) * (2 * FF) + src; ldw = 2 * FF;
            dst = (signed char*)(a.ws + WS_W + (size_t)l * W_LAYER + WO_W1) + ((size_t)e * 2048 + nb * 32) * DM; csp = (float*)(a.ws + WS_CS1) + ((size_t)l * NE + e) * 2048 + n; }
        else if (q >= ST_W1 + ST_IN) { const int q2 = q - ST_W1 - ST_IN, e = q2 / 32, nb = q2 % 32, n = nb * 32 + jl;
            wp = w2 + ((size_t)(l * NE + e) * FF) * DM + n; ldw = DM;
            dst = (signed char*)(a.ws + WS_W + (size_t)l * W_LAYER + WO_W2) + ((size_t)e * DM + nb * 32) * FF; csp = (float*)(a.ws + WS_CS2) + ((size_t)l * NE + e) * DM + n; }
        else { const int nb = q - ST_W1, n = nb * 32 + jl; valid = (n < 1832) || (n >= 2048); const int src = n < 1832 ? n : n - 216;
            wp = w_in + (size_t)l * DM * 5928 + (valid ? src : 0); ldw = 5928;
            dst = (signed char*)(a.ws + WS_W + (size_t)l * W_LAYER + WO_WIN) + (size_t)nb * 32 * DM; csp = (float*)(a.ws + WS_CSIN) + (size_t)l * NPROJ + n; }
        float am = 0.f;
#pragma unroll
        for (int ib = 0; ib < 2; ++ib) { float vv[32];
#pragma unroll
            for (int i = 0; i < 32; ++i) { const int k = wave * 128 + 2 * (ib * 32 + i) + half; vv[i] = valid ? __builtin_nontemporal_load(wp + (size_t)k * ldw) : 0.f; }
#pragma unroll
            for (int i = 0; i < 32; ++i) { const int k = wave * 128 + 2 * (ib * 32 + i) + half; am = fmaxf(am, fabsf(vv[i])); T[k * 32 + (jl ^ (k & 31))] = vv[i]; } }
        red[(wave * 2 + half) * 32 + jl] = am;
        __syncthreads();
        float amx = 0.f;
#pragma unroll
        for (int p = 0; p < 16; ++p) amx = fmaxf(amx, red[p * 32 + jl]);
        const float scale = valid ? fmaxf(amx, 1e-30f) * (1.f / 127.f) : 1.f, inv = valid ? 1.f / scale : 0.f;
        if (wave == 0 && half == 0) *csp = scale;
        const int k0 = 64 * (wave * 2 + half);
#pragma unroll
        for (int c16 = 0; c16 < 4; ++c16) { unsigned wq[4];
#pragma unroll
            for (int d4 = 0; d4 < 4; ++d4) { const int k = k0 + c16 * 16 + d4 * 4;
                wq[d4] = q8x4(T[k * 32 + (jl ^ (k & 31))], T[(k + 1) * 32 + (jl ^ ((k + 1) & 31))], T[(k + 2) * 32 + (jl ^ ((k + 2) & 31))], T[(k + 3) * 32 + (jl ^ ((k + 3) & 31))], inv); }
            *(u32x4*)(dst + (size_t)jl * DM + k0 + c16 * 16) = (u32x4){wq[0], wq[1], wq[2], wq[3]}; }
        __syncthreads();
    }
    }
    const float* sg_w = a.in[10]; bf16_t* SGW = (bf16_t*)(a.ws + WS_SGW);
    for (int i = (F.vcu * 512 + F.tid) * 2; i < DEPTH * 8 * 128 * 128; i += F.G * 512 * 2) { const int s = i & 127, t = (i >> 7) & 127; const f32x2 v = *(const f32x2*)(sg_w + i);
        *(unsigned*)(SGW + i) = cvt_pk_bf16(s <= t ? v[0] : 0.f, (s + 1) <= t ? v[1] : 0.f); }
}

__device__ __forceinline__ void norm_mod_row(const f32x4 (&v)[4], float ss, const float* g, const float* sc, const float* sh, signed char* orow, float* rs, int lane) {
    const float rstd = 1.f / sqrtf(ss * (1.f / DM) + RMS_EPS);
    f32x4 o[4]; float am = 0.f;
#pragma unroll
    for (int j = 0; j < 4; ++j) { const int c = 4 * lane + 256 * j; const f32x4 gg = *(const f32x4*)(g + c), s1 = *(const f32x4*)(sc + c), s0 = *(const f32x4*)(sh + c);
        o[j] = (v[j] * rstd) * gg * (s1 + 1.f) + s0;
        am = fmaxf(am, fmaxf(fmaxf(fabsf(o[j][0]), fabsf(o[j][1])), fmaxf(fabsf(o[j][2]), fabsf(o[j][3])))); }
    am = wave_max(am);
    const float scale = fmaxf(am, 1e-30f) * (1.f / 127.f), inv = 1.f / scale;
    if (lane == 0) *rs = scale;
#pragma unroll
    for (int j = 0; j < 4; ++j) *(unsigned*)(orow + 4 * lane + 256 * j) = q8x4(o[j][0], o[j][1], o[j][2], o[j][3], inv);
}
__device__ __forceinline__ void p1_norm(const Frame& F, const float* x, const float* g, const float* MOD0, signed char* H8, float* RS) {
    const int gw = F.vcu * 8 + F.wave, NGW = F.G * 8;
    for (int row0 = gw * 4; row0 < MTOK; row0 += NGW * 4) { f32x4 v[4][4];
#pragma unroll
        for (int rr = 0; rr < 4; ++rr)
#pragma unroll
            for (int j = 0; j < 4; ++j) v[rr][j] = __builtin_nontemporal_load((const f32x4*)(x + (size_t)(row0 + rr) * DM + 4 * F.lane + 256 * j));
#pragma unroll
        for (int rr = 0; rr < 4; ++rr) { const int row = row0 + rr, b = row >> 11; float ss = 0.f;
#pragma unroll
            for (int j = 0; j < 4; ++j) ss += (v[rr][j][0] * v[rr][j][0] + v[rr][j][1] * v[rr][j][1]) + (v[rr][j][2] * v[rr][j][2] + v[rr][j][3] * v[rr][j][3]);
            ss = wave_sum(ss);
            const float* mb = MOD0 + (size_t)b * 6 * DM;
            norm_mod_row(v[rr], ss, g, mb + DM, mb, H8 + (size_t)row * DM, RS + row, F.lane); } }
}
constexpr int TOPK_SEL = 256;
struct IdxOps { bf16x8 af[4][2]; u32x4 wraw[4][2]; bf16x8 kf[4][2]; };
__device__ __forceinline__ void dsa_index_load(IdxOps& P, const bf16_t* __restrict__ PROJ, int b, int qg, int lane, int wid) {
    asm volatile("" : "+v"(lane));
    const int n = lane & 31, hi = lane >> 5;
    const int q0 = qg * 16;
    const size_t tokbase = (size_t)b * SEQ;
    const int m = n, hm = (m >> 2) & 1, idx = (m & 3) + 4 * (m >> 3), aq = 2 * hm + (idx >> 3), ah = idx & 7;
#pragma unroll
    for (int qgp = 0; qgp < 4; ++qgp) { const bf16_t* qp = PROJ + (tokbase + q0 + 4 * qgp + aq) * PLD + C_QI + ah * 32 + 8 * hi;
        P.af[qgp][0] = *(const bf16x8*)qp; P.af[qgp][1] = *(const bf16x8*)(qp + 16); }
}
__device__ __forceinline__ void dsa_index_load_k(IdxOps& P, const bf16_t* __restrict__ PROJ, int b, int qg, int lane, int wid) {
    asm volatile("" : "+v"(lane));
    const int n = lane & 31, hi = lane >> 5;
    const int q0 = qg * 16, nkb = (q0 + 16 + 31) >> 5;
    const size_t tokbase = (size_t)b * SEQ;
#pragma unroll
    for (int qgp = 0; qgp < 4; ++qgp)
#pragma unroll
        for (int qq = 0; qq < 2; ++qq) P.wraw[qgp][qq] = *(const u32x4*)(PROJ + (tokbase + q0 + 4 * qgp + 2 * hi + qq) * PLD + C_WI);
#pragma unroll
    for (int i = 0; i < 4; ++i) { const int kb = wid + 8 * i;
        if (kb < nkb) { const bf16_t* kp = PROJ + (tokbase + 32 * kb + n) * PLD + C_KI + 8 * hi; P.kf[i][0] = *(const bf16x8*)kp; P.kf[i][1] = *(const bf16x8*)(kp + 16); } }
}
__device__ __forceinline__ void dsa_index_scores(IdxOps& P, const bf16_t* __restrict__ PROJ, LAS float* sc, int b, int qg, int lane, int wid) {
    const int n = lane & 31, hi = lane >> 5;
    const int q0 = qg * 16, nkb = (q0 + 16 + 31) >> 5;
    const size_t tokbase = (size_t)b * SEQ;
    LAS float* scw = sc + (2 * hi) * 2048 + 32 * wid + n;
    float wv[4][16];
#pragma unroll
    for (int qgp = 0; qgp < 4; ++qgp)
#pragma unroll
        for (int qq = 0; qq < 2; ++qq) { const u32x4 w = P.wraw[qgp][qq];
            wv[qgp][8 * qq + 0] = bf_lo(w.x) * 0.0625f; wv[qgp][8 * qq + 1] = bf_hi(w.x) * 0.0625f; wv[qgp][8 * qq + 2] = bf_lo(w.y) * 0.0625f; wv[qgp][8 * qq + 3] = bf_hi(w.y) * 0.0625f;
            wv[qgp][8 * qq + 4] = bf_lo(w.z) * 0.0625f; wv[qgp][8 * qq + 5] = bf_hi(w.z) * 0.0625f; wv[qgp][8 * qq + 6] = bf_lo(w.w) * 0.0625f; wv[qgp][8 * qq + 7] = bf_hi(w.w) * 0.0625f; }
#pragma unroll
    for (int i = 0; i < 8; ++i) { const int kb = wid + 8 * i;
        if (kb < nkb) {
            const bf16x8 k0 = P.kf[i & 3][0], k1 = P.kf[i & 3][1];
            if (i < 4 && kb + 32 < nkb) { const bf16_t* kp = PROJ + (tokbase + 32 * (kb + 32) + n) * PLD + C_KI + 8 * hi; P.kf[i & 3][0] = *(const bf16x8*)kp; P.kf[i & 3][1] = *(const bf16x8*)(kp + 16); }
#pragma unroll
            for (int qgp = 0; qgp < 4; ++qgp) {
                f32x16 d = {0.f, 0.f, 0.f, 0.f, 0.f, 0.f, 0.f, 0.f, 0.f, 0.f, 0.f, 0.f, 0.f, 0.f, 0.f, 0.f};
                d = __builtin_amdgcn_mfma_f32_32x32x16_bf16(P.af[qgp][0], k0, d, 0, 0, 0);
                d = __builtin_amdgcn_mfma_f32_32x32x16_bf16(P.af[qgp][1], k1, d, 0, 0, 0);
                float sa = 0.f, sb = 0.f;
#pragma unroll
                for (int r = 0; r < 8; ++r) { sa += wv[qgp][r] * fmaxf(d[r], 0.f); sb += wv[qgp][8 + r] * fmaxf(d[8 + r], 0.f); }
                scw[(4 * qgp) * 2048 + 256 * i] = sa; scw[(4 * qgp + 1) * 2048 + 256 * i] = sb;
            } } }
}
__device__ __forceinline__ void bit_transpose32(unsigned (&a)[32]) {
#pragma unroll
    for (int k = 0; k < 16; ++k) { const unsigned lo = a[k], hi = a[k + 16];
        a[k] = __builtin_amdgcn_perm(hi, lo, 0x05040100u); a[k + 16] = __builtin_amdgcn_perm(hi, lo, 0x07060302u); }
#pragma unroll
    for (int k = 0; k < 32; ++k) if ((k & 8) == 0) { const unsigned lo = a[k], hi = a[k + 8];
        a[k] = __builtin_amdgcn_perm(hi, lo, 0x06020400u); a[k + 8] = __builtin_amdgcn_perm(hi, lo, 0x07030501u); }
#pragma unroll
    for (int s = 0; s < 3; ++s) { const int j = 4 >> s; const unsigned m = (s == 0) ? 0x0F0F0F0Fu : (s == 1) ? 0x33333333u : 0x55555555u;
#pragma unroll
        for (int k = 0; k < 32; ++k) if ((k & j) == 0) { const unsigned lo = a[k], hi = a[k + j];
            a[k] = (m & lo) | (~m & (hi << j)); a[k + j] = (m & (lo >> j)) | (~m & hi); } }
}
__device__ __forceinline__ void dsa_index_select(LAS float* sc, LAS int* qctr, unsigned long long* __restrict__ bits64, int b, int qg, int lane, int wid) {
    const int q0 = qg * 16;
    const size_t tokbase = (size_t)b * SEQ;
#pragma unroll 1
    for (;;) {
        int qn = 0; if (lane == 0) qn = __hip_atomic_fetch_add(qctr, 1, __ATOMIC_RELAXED, __HIP_MEMORY_SCOPE_WORKGROUP);
        qn = __builtin_amdgcn_readfirstlane(qn); if (qn >= 16) break;
        const int ql = 15 - qn, pos = q0 + ql, nn = pos + 1, nr = (nn + 63) >> 6;
        const LAS float* scq = sc + ql * 2048;
        unsigned mlo = 0u, mhi = 0u;
        if (nn <= TOPK_SEL) {
#pragma unroll
            for (int r = 0; r < 4; ++r) if (r < nr) { const unsigned long long bal = __ballot(64 * r + lane <= pos); asm volatile("s_nop 4\n\tv_writelane_b32 %0, %2, %4\n\tv_writelane_b32 %1, %3, %4" : "+v"(mlo), "+v"(mhi) : "s"((unsigned)bal), "s"((unsigned)(bal >> 32)), "n"(r));     }
        } else {
            unsigned u[32];
#pragma unroll
            for (int r = 0; r < 32; ++r) u[r] = 0u;
#pragma unroll
            for (int g8 = 0; g8 < 4; ++g8) if (8 * g8 < nr) {
#pragma unroll
                for (int q_ = 0; q_ < 8; ++q_) { const int r = 8 * g8 + q_; const int j = 64 * r + lane; float s = scq[j]; s = (s == 0.f) ? 0.f : s; const unsigned bts = __builtin_bit_cast(unsigned, s);
                    const unsigned uu = (bts & 0x80000000u) ? ~bts : (bts | 0x80000000u); u[r] = (j <= pos) ? uu : 0u; } }
            unsigned M = 0u;
#pragma unroll
            for (int r = 0; r < 32; ++r) M |= (64 * r + lane <= pos) ? (1u << r) : 0u;
            bit_transpose32(u);
            unsigned G = 0u; unsigned need = (unsigned)TOPK_SEL, cM = (unsigned)nn;
            {
#pragma unroll
            for (int bq = 31; bq >= 0; --bq) {
                const unsigned T = M & u[bq];
                const unsigned c = wave_sum_u32((unsigned)__builtin_popcount(T));
                const bool ge = c >= need;
                G |= ge ? 0u : T; M = ge ? T : (M & ~u[bq]); cM = ge ? c : cM - c; need -= ge ? 0u : c;
                if (cM == need) { G |= M; goto sel_done; }
            }
            unsigned run = 0u;
#pragma unroll
            for (int r = 0; r < 32; ++r) if (r < nr) { const bool isc = (M >> r) & 1u; const unsigned long long eqm = __ballot(isc);
                const unsigned pre = run + __builtin_amdgcn_mbcnt_hi((unsigned)(eqm >> 32), __builtin_amdgcn_mbcnt_lo((unsigned)eqm, 0u));
                if (isc && pre < need) G |= (1u << r);
                run += (unsigned)__builtin_popcountll(eqm); }
            }
            sel_done:
#pragma unroll
            for (int r = 0; r < 32; ++r) if ((r & ~7) < nr) { const unsigned long long bal = __ballot((G >> r) & 1u); asm volatile("s_nop 4\n\tv_writelane_b32 %0, %2, %4\n\tv_writelane_b32 %1, %3, %4" : "+v"(mlo), "+v"(mhi) : "s"((unsigned)bal), "s"((unsigned)(bal >> 32)), "n"(r));     }
        }
        if (lane < nr) bits64[(tokbase + pos) * 32 + lane] = ((unsigned long long)mhi << 32) | mlo;
    }
}
__device__ __forceinline__ void dsa_index_phase(const Frame& F, const bf16_t* __restrict__ PROJ, unsigned long long* __restrict__ bits64, unsigned* stampw) {
    LAS float* sc = (LAS float*)F.lds;
    LAS int* qctr = (LAS int*)(F.lds + TS_OFF);
    IdxOps P;
    int u = F.vcu;
    if (u < 4096) { dsa_index_load(P, PROJ, u & 31, u >> 5, F.lane, F.wave); dsa_index_load_k(P, PROJ, u & 31, u >> 5, F.lane, F.wave); }
#ifdef T_STAMP
    unsigned long long tA = 0, tB = 0, tC = 0, tD = 0, t0 = __builtin_amdgcn_s_memrealtime(), t1;
#define STAMP(acc) do { t1 = __builtin_amdgcn_s_memrealtime(); acc += t1 - t0; t0 = t1; } while (0)
#else
#define STAMP(acc) do { } while (0)
#endif
#pragma unroll 1
    for (; u < 4096; u += F.G) {
        dsa_index_scores(P, PROJ, sc, u & 31, u >> 5, F.lane, F.wave);
        if (F.tid == 0) *qctr = 0;
        STAMP(tA);
        __syncthreads();
        STAMP(tB);
        const int un = u + F.G;
        dsa_index_select(sc, qctr, bits64, u & 31, u >> 5, F.lane, F.wave);
        asm volatile("" ::: "memory");
        if (un < 4096) { dsa_index_load(P, PROJ, un & 31, un >> 5, F.lane, F.wave); dsa_index_load_k(P, PROJ, un & 31, un >> 5, F.lane, F.wave); }
        STAMP(tC);
        __syncthreads();
        STAMP(tD);
    }
#ifdef T_STAMP
    if (stampw && blockIdx.x == 17 && F.tid == 0) { const unsigned long long tot = tA + tB + tC + tD; const unsigned long long part = (T_STAMP == 0) ? tA : (T_STAMP == 1) ? tB : (T_STAMP == 2) ? tC : tD;
        *stampw = (unsigned)((part * 64ull) / (tot ? tot : 1ull)); }
#endif
#undef STAMP
}

constexpr int KS = 144, VS = 192;
#ifndef USE_TR
#define USE_TR 1
#endif
template <int MODE>
__device__ __forceinline__ void attn_unit(const Frame& F, const bf16_t* __restrict__ PROJ, bf16_t* __restrict__ O, const unsigned* __restrict__ bits, const float* __restrict__ sinks, int b, int g, int qb) {
    const int tid = F.tid, lane = F.lane, wid = F.wave, n = lane & 31, hi = lane >> 5;
    constexpr int CQ = MODE ? C_QB : C_QA, CK = MODE ? C_KB : C_KA, CV = MODE ? C_VB : C_VA;
    const int hq = 4 * g + (wid >> 1), qpos = qb * 64 + 32 * (wid & 1) + n;
    const size_t tokbase = (size_t)b * SEQ;
    LAS unsigned char* Ks = F.lds; LAS unsigned char* Vs = F.lds + 64 * KS;
    bf16x8 qf[4];
    { const bf16_t* qp = PROJ + (tokbase + qpos) * PLD + CQ + hq * 64 + 8 * hi;
#pragma unroll
      for (int s = 0; s < 4; ++s) qf[s] = *(const bf16x8*)(qp + 16 * s); }
    f32x16 o0, o1;
#pragma unroll
    for (int r = 0; r < 16; ++r) { o0[r] = 0.f; o1[r] = 0.f; }
    float mrun, lsum;
    if (MODE == 0) { mrun = sinks[hq] * LOG2E; lsum = (hi == 0) ? 1.f : 0.f; } else { mrun = -1e30f; lsum = 0.f; }
    const int kt_lo = (MODE == 0) ? (qb >= 2 ? qb - 2 : 0) : 0, kt_hi = qb;
    const int srow = tid >> 3, sch = tid & 7;
    const bf16_t* kg = PROJ + (tokbase + srow) * PLD + CK + g * 64 + sch * 8;
    const bf16_t* vg = PROJ + (tokbase + srow) * PLD + CV + g * 64 + sch * 8;
    const unsigned* bp = bits + (tokbase + qpos) * 64;
    u32x4 kreg = *(const u32x4*)(kg + (size_t)kt_lo * 64 * PLD), vreg = *(const u32x4*)(vg + (size_t)kt_lo * 64 * PLD);
    u32x2 mreg = {0u, 0u};
    if (MODE == 1) mreg = *(const u32x2*)(bp + 2 * kt_lo);
    const int vbase = (4 * hi + ((lane & 15) >> 2)) * VS + (16 * ((lane >> 4) & 1) + 4 * (lane & 3)) * 2;
    for (int kt = kt_lo; kt <= kt_hi; ++kt) {
        __syncthreads();
        *(LAS u32x4*)(Ks + srow * KS + sch * 16) = kreg; *(LAS u32x4*)(Vs + srow * VS + sch * 16) = vreg;
        const u32x2 mcur = mreg;
        __syncthreads();
        if (kt < kt_hi) { kreg = *(const u32x4*)(kg + (size_t)(kt + 1) * 64 * PLD); vreg = *(const u32x4*)(vg + (size_t)(kt + 1) * 64 * PLD); if (MODE == 1) mreg = *(const u32x2*)(bp + 2 * (kt + 1)); }
        f32x16 p0, p1;
#pragma unroll
        for (int r = 0; r < 16; ++r) { p0[r] = 0.f; p1[r] = 0.f; }
#pragma unroll
        for (int s = 0; s < 4; ++s) { const bf16x8 k0 = *(const LAS bf16x8*)(Ks + n * KS + (16 * s + 8 * hi) * 2), k1 = *(const LAS bf16x8*)(Ks + (n + 32) * KS + (16 * s + 8 * hi) * 2);
            p0 = __builtin_amdgcn_mfma_f32_32x32x16_bf16(k0, qf[s], p0, 0, 0, 0); p1 = __builtin_amdgcn_mfma_f32_32x32x16_bf16(k1, qf[s], p1, 0, 0, 0); }
        unsigned w0, w1;
        if (MODE == 1) { w0 = mcur.x >> (4 * hi); w1 = mcur.y >> (4 * hi); }
        else {
#pragma unroll
            for (int blk = 0; blk < 2; ++blk) { const int d0 = qpos - (kt * 64 + 32 * blk); unsigned mk = 0u;
                if (d0 >= 0) { const int hb = d0 > 31 ? 31 : d0; int lo = d0 - 127; if (lo <= 31) { if (lo < 0) lo = 0; mk = (0xFFFFFFFFu >> (31 - hb)) & (0xFFFFFFFFu << lo); } }
                if (blk == 0) w0 = mk >> (4 * hi); else w1 = mk >> (4 * hi); }
        }
        float mx = fmaxf(fmaxf(p0[0], p0[1]), fmaxf(p1[0], p1[1]));
#pragma unroll
        for (int r = 2; r < 16; r += 2) mx = fmaxf(mx, fmaxf(fmaxf(p0[r], p0[r + 1]), fmaxf(p1[r], p1[r + 1])));
        mx = xor32_max(mx);
        const float mnew = fmaxf(mrun, mx), alpha = fexp2(mrun - mnew); mrun = mnew;
        float ps = 0.f;
#pragma unroll
        for (int r = 0; r < 16; ++r) { const int bitpos = 8 * (r >> 2) + (r & 3);
            const float e0 = fexp2(p0[r] - mnew), e1 = fexp2(p1[r] - mnew);
            p0[r] = __builtin_bit_cast(float, __builtin_bit_cast(unsigned, e0) & (unsigned)__builtin_amdgcn_sbfe((int)w0, bitpos, 1));
            p1[r] = __builtin_bit_cast(float, __builtin_bit_cast(unsigned, e1) & (unsigned)__builtin_amdgcn_sbfe((int)w1, bitpos, 1));
            ps += p0[r] + p1[r]; }
        lsum = lsum * alpha + ps;
        if (__builtin_amdgcn_ballot_w64(alpha != 1.f) != 0ull) {
#pragma unroll
            for (int r = 0; r < 16; ++r) { o0[r] *= alpha; o1[r] *= alpha; } }
        bf16x8 pf[2][2];
#pragma unroll
        for (int s2 = 0; s2 < 2; ++s2) { u32x4 a, c;
            a.x = cvt_pk_bf16(p0[8 * s2 + 0], p0[8 * s2 + 1]); a.y = cvt_pk_bf16(p0[8 * s2 + 2], p0[8 * s2 + 3]); a.z = cvt_pk_bf16(p0[8 * s2 + 4], p0[8 * s2 + 5]); a.w = cvt_pk_bf16(p0[8 * s2 + 6], p0[8 * s2 + 7]);
            c.x = cvt_pk_bf16(p1[8 * s2 + 0], p1[8 * s2 + 1]); c.y = cvt_pk_bf16(p1[8 * s2 + 2], p1[8 * s2 + 3]); c.z = cvt_pk_bf16(p1[8 * s2 + 4], p1[8 * s2 + 5]); c.w = cvt_pk_bf16(p1[8 * s2 + 6], p1[8 * s2 + 7]);
            pf[0][s2] = __builtin_bit_cast(bf16x8, a); pf[1][s2] = __builtin_bit_cast(bf16x8, c); }
#pragma unroll
        for (int db = 0; db < 2; ++db)
#pragma unroll
            for (int blk = 0; blk < 2; ++blk)
#pragma unroll
                for (int s2 = 0; s2 < 2; ++s2) {
                    bf16x8 vf;
#if USE_TR
                    const v4i16_t t0 = __builtin_amdgcn_ds_read_tr16_b64_v4i16((LAS v4i16_t*)(Vs + vbase + (32 * blk + 16 * s2) * VS + 64 * db));
                    const v4i16_t t1 = __builtin_amdgcn_ds_read_tr16_b64_v4i16((LAS v4i16_t*)(Vs + vbase + (32 * blk + 16 * s2 + 8) * VS + 64 * db));
                    vf = (bf16x8){t0[0], t0[1], t0[2], t0[3], t1[0], t1[1], t1[2], t1[3]};
#else
#pragma unroll
                    for (int j = 0; j < 8; ++j) vf[j] = *(const LAS short*)(Vs + (32 * blk + 16 * s2 + 8 * (j >> 2) + 4 * hi + (j & 3)) * VS + (32 * db + n) * 2);
#endif
                    if (db == 0) o0 = __builtin_amdgcn_mfma_f32_32x32x16_bf16(vf, pf[blk][s2], o0, 0, 0, 0); else o1 = __builtin_amdgcn_mfma_f32_32x32x16_bf16(vf, pf[blk][s2], o1, 0, 0, 0);
                }
    }
    const float lt = xor32_add(lsum), inv = 1.f / lt;
    bf16_t* op = O + (tokbase + qpos) * 512 + hq * 64 + 8 * hi;
#pragma unroll
    for (int db = 0; db < 2; ++db)
#pragma unroll
        for (int kp = 0; kp < 2; ++kp) { const int r0 = 8 * kp;
            unsigned ax, ay, bx, by;
            if (db == 0) { ax = cvt_pk_bf16(o0[r0] * inv, o0[r0 + 1] * inv); ay = cvt_pk_bf16(o0[r0 + 2] * inv, o0[r0 + 3] * inv); bx = cvt_pk_bf16(o0[r0 + 4] * inv, o0[r0 + 5] * inv); by = cvt_pk_bf16(o0[r0 + 6] * inv, o0[r0 + 7] * inv); }
            else { ax = cvt_pk_bf16(o1[r0] * inv, o1[r0 + 1] * inv); ay = cvt_pk_bf16(o1[r0 + 2] * inv, o1[r0 + 3] * inv); bx = cvt_pk_bf16(o1[r0 + 4] * inv, o1[r0 + 5] * inv); by = cvt_pk_bf16(o1[r0 + 6] * inv, o1[r0 + 7] * inv); }
            { auto r = __builtin_amdgcn_permlane32_swap(ax, bx, false, false); ax = r[0]; bx = r[1]; }
            { auto r = __builtin_amdgcn_permlane32_swap(ay, by, false, false); ay = r[0]; by = r[1]; }
            *(u32x4*)(op + 32 * db + 16 * kp) = (u32x4){ax, ay, bx, by}; }
}

constexpr int SGS = 1040;
static_assert(128 * SGS <= MISC_OFF, "spatial-gating tile vs LDS control words");
__device__ __forceinline__ void sg_unit(const Frame& F, const bf16_t* __restrict__ PROJ, const bf16_t* __restrict__ SGWl, const float* __restrict__ sgb, const float* __restrict__ lng, bf16_t* __restrict__ OC, int b, int ch) {
    const int lane = F.lane, wid = F.wave, n = lane & 31, hi = lane >> 5;
    const size_t tok0 = (size_t)b * SEQ + ch * 128;
    LAS unsigned char* V = F.lds;
    __syncthreads();
    float gl[8];
    { const f32x4 g0 = *(const f32x4*)(lng + 8 * lane), g1 = *(const f32x4*)(lng + 8 * lane + 4); gl[0] = g0[0]; gl[1] = g0[1]; gl[2] = g0[2]; gl[3] = g0[3]; gl[4] = g1[0]; gl[5] = g1[1]; gl[6] = g1[2]; gl[7] = g1[3]; }
    u32x4 wrow16[16];
#pragma unroll
    for (int rr = 0; rr < 16; ++rr) wrow16[rr] = *(const u32x4*)(PROJ + (tok0 + 16 * wid + rr) * PLD + C_V + 8 * lane);
#pragma unroll
    for (int rr = 0; rr < 16; ++rr) { const int row = 16 * wid + rr;
        const u32x4 w = wrow16[rr];
        float x[8] = {bf_lo(w.x), bf_hi(w.x), bf_lo(w.y), bf_hi(w.y), bf_lo(w.z), bf_hi(w.z), bf_lo(w.w), bf_hi(w.w)};
        float s = 0.f;
#pragma unroll
        for (int i = 0; i < 8; ++i) s += x[i];
        const float mean = wave_sum(s) * (1.f / 512.f); float q = 0.f;
#pragma unroll
        for (int i = 0; i < 8; ++i) { x[i] -= mean; q += x[i] * x[i]; }
        const float rstd = 1.f / sqrtf(wave_sum(q) * (1.f / 512.f) + LN_EPS);
        u32x4 o; o.x = cvt_pk_bf16(x[0] * rstd * gl[0], x[1] * rstd * gl[1]); o.y = cvt_pk_bf16(x[2] * rstd * gl[2], x[3] * rstd * gl[3]);
        o.z = cvt_pk_bf16(x[4] * rstd * gl[4], x[5] * rstd * gl[5]); o.w = cvt_pk_bf16(x[6] * rstd * gl[6], x[7] * rstd * gl[7]);
        *(LAS u32x4*)(V + row * SGS + 16 * lane) = o; }
    __syncthreads();
    const int g = wid;
    const int vbase = (8 * hi + ((lane & 15) >> 2)) * SGS + (g * 64 + 16 * ((lane >> 4) & 1) + 4 * (lane & 3)) * 2;
    const bf16_t* wg = SGWl + (size_t)g * 128 * 128;
#pragma unroll 1
    for (int tb = 0; tb < 4; ++tb) {
        f32x16 a0, a1;
#pragma unroll
        for (int r = 0; r < 16; ++r) { a0[r] = 0.f; a1[r] = 0.f; }
        const bf16_t* wrow = wg + (size_t)(32 * tb + n) * 128 + 8 * hi;
        bf16x8 afr[8];
#pragma unroll
        for (int ks = 0; ks < 8; ++ks) if (ks < 2 * tb + 2) afr[ks] = *(const bf16x8*)(wrow + 16 * ks);
#pragma unroll
        for (int ks = 0; ks < 8; ++ks) if (ks < 2 * tb + 2) {
            const bf16x8 af = afr[ks];
#pragma unroll
            for (int db = 0; db < 2; ++db) { bf16x8 vf;
#if USE_TR
                const v4i16_t t0 = __builtin_amdgcn_ds_read_tr16_b64_v4i16((LAS v4i16_t*)(V + vbase + (16 * ks) * SGS + 64 * db));
                const v4i16_t t1 = __builtin_amdgcn_ds_read_tr16_b64_v4i16((LAS v4i16_t*)(V + vbase + (16 * ks + 4) * SGS + 64 * db));
                vf = (bf16x8){t0[0], t0[1], t0[2], t0[3], t1[0], t1[1], t1[2], t1[3]};
#else
#pragma unroll
                for (int j = 0; j < 8; ++j) vf[j] = *(const LAS short*)(V + (16 * ks + 8 * hi + j) * SGS + (g * 64 + 32 * db + n) * 2);
#endif
                if (db == 0) a0 = __builtin_amdgcn_mfma_f32_32x32x16_bf16(af, vf, a0, 0, 0, 0); else a1 = __builtin_amdgcn_mfma_f32_32x32x16_bf16(af, vf, a1, 0, 0, 0); }
        }
#pragma unroll
        for (int r = 0; r < 16; ++r) { const int t = 32 * tb + 8 * (r >> 2) + 4 * hi + (r & 3); const float bb = sgb[g * 128 + t];
            const bf16_t* up = PROJ + (tok0 + t) * PLD + C_U + g * 64 + n; bf16_t* op = OC + (tok0 + t) * 512 + g * 64 + n;
            const float u0 = __builtin_bit_cast(float, (unsigned)up[0] << 16), u1 = __builtin_bit_cast(float, (unsigned)up[32] << 16);
            op[0] = (bf16_t)f2bf((a0[r] + bb) * u0); op[32] = (bf16_t)f2bf((a1[r] + bb) * u1); }
    }
}
constexpr int HS_STRIDE = 2064;
constexpr int P7_PART = 32 * HS_STRIDE;
constexpr int P7_LOG = P7_PART + 8 * 4096;
constexpr int P7_HIST = P7_LOG + 32 * 33 * 4;
__device__ __forceinline__ void p7_route(const Frame& F, const Args& a, int l, const float* xin, float* xout, const bf16_t* Y, const float* SSP, const float* MODl, signed char* H8, float* RS,
                                         const bf16_t* WRTl, unsigned* cnt, int* ROWTOK, unsigned* TOKINFO) {
    const int tid = F.tid, lane = F.lane, wid = F.wave, n = lane & 31, hi = lane >> 5;
    const float* g_post = a.in[5] + l * DM; const float* g_pre = a.in[6] + l * DM; const float* b_router = a.in[16] + l * NE;
    LAS unsigned char* hs = F.lds; LAS float* part = (LAS float*)(F.lds + P7_PART); LAS float* lg = (LAS float*)(F.lds + P7_LOG); LAS int* hist = (LAS int*)(F.lds + P7_HIST); LAS int* base = hist + 32;
    if (tid < 32) hist[tid] = 0;
    __syncthreads();
    for (int bt = F.vcu; bt < MTOK / 32; bt += F.G) {
        const int row0 = bt * 32, b = row0 >> 11;
        const float* mb = MODl + (size_t)b * 6 * DM;
        u32x2 yv[4][4]; f32x4 xv[4][4], s4v[4];
#pragma unroll
        for (int rr = 0; rr < 4; ++rr) { const size_t row = (size_t)row0 + 4 * wid + rr; s4v[rr] = *(const f32x4*)(SSP + row * 16 + 4 * (lane & 3));
#pragma unroll
            for (int j = 0; j < 4; ++j) { const int c = 4 * lane + 256 * j; yv[rr][j] = __builtin_nontemporal_load((const u32x2*)(Y + row * DM + c)); xv[rr][j] = __builtin_nontemporal_load((const f32x4*)(xin + row * DM + c)); } }
#pragma unroll
        for (int rr = 0; rr < 4; ++rr) { const int rl = 4 * wid + rr; const size_t row = (size_t)row0 + rl;
            const f32x4 s4 = s4v[rr];
            float ssy = (s4[0] + s4[1]) + (s4[2] + s4[3]); ssy = quad_sum(ssy);
            const float rstd1 = 1.f / sqrtf(ssy * (1.f / DM) + RMS_EPS);
            f32x4 v[4]; float ss = 0.f;
#pragma unroll
            for (int j = 0; j < 4; ++j) { const int c = 4 * lane + 256 * j; const u32x2 yw_ = yv[rr][j]; const f32x4 yy = {bf_lo(yw_.x), bf_hi(yw_.x), bf_lo(yw_.y), bf_hi(yw_.y)}, xx = xv[rr][j];
                const f32x4 gp = *(const f32x4*)(g_post + c), ga = *(const f32x4*)(mb + 2 * DM + c);
                v[j] = xx + ga * (yy * rstd1 * gp); *(f32x4*)(xout + row * DM + c) = v[j];
                ss += (v[j][0] * v[j][0] + v[j][1] * v[j][1]) + (v[j][2] * v[j][2] + v[j][3] * v[j][3]); }
            ss = wave_sum(ss);
            const float rstd = 1.f / sqrtf(ss * (1.f / DM) + RMS_EPS);
            f32x4 o[4]; float am = 0.f;
#pragma unroll
            for (int j = 0; j < 4; ++j) { const int c = 4 * lane + 256 * j; const f32x4 gg = *(const f32x4*)(g_pre + c), s1 = *(const f32x4*)(mb + 4 * DM + c), s0 = *(const f32x4*)(mb + 3 * DM + c);
                o[j] = (v[j] * rstd) * gg * (s1 + 1.f) + s0; u32x2 w; w.x = cvt_pk_bf16(o[j][0], o[j][1]); w.y = cvt_pk_bf16(o[j][2], o[j][3]);
                *(LAS u32x2*)(hs + rl * HS_STRIDE + c * 2) = w;
                am = fmaxf(am, fmaxf(fmaxf(fabsf(o[j][0]), fabsf(o[j][1])), fmaxf(fabsf(o[j][2]), fabsf(o[j][3])))); }
            am = wave_max(am);
            const float scale = fmaxf(am, 1e-30f) * (1.f / 127.f), inv = 1.f / scale;
            if (lane == 0) RS[row] = scale;
#pragma unroll
            for (int j = 0; j < 4; ++j) *(unsigned*)(H8 + row * DM + 4 * lane + 256 * j) = q8x4(o[j][0], o[j][1], o[j][2], o[j][3], inv); }
        __syncthreads();
        {
            f32x16 d;
#pragma unroll
            for (int r = 0; r < 16; ++r) d[r] = 0.f;
#pragma unroll
            for (int ks = 0; ks < 8; ++ks) { const int k0 = (8 * wid + ks) * 16 + 8 * hi;
                const bf16x8 af = *(const LAS bf16x8*)(hs + n * HS_STRIDE + k0 * 2); const bf16x8 bf = *(const bf16x8*)(WRTl + (size_t)n * DM + k0);
                d = __builtin_amdgcn_mfma_f32_32x32x16_bf16(af, bf, d, 0, 0, 0); }
#pragma unroll
            for (int r = 0; r < 16; ++r) part[wid * 1024 + (8 * (r >> 2) + 4 * hi + (r & 3)) * 32 + n] = d[r];
        }
        __syncthreads();
        for (int i = tid; i < 1024; i += 512) { float s = b_router[i & 31];
#pragma unroll
            for (int w = 0; w < 8; ++w) s += part[w * 1024 + i]; lg[(i >> 5) * 33 + (i & 31)] = s; }
        __syncthreads();
        int e_k[4] = {0, 0, 0, 0}, lp_k[4] = {0, 0, 0, 0}; float w_k[4] = {0.f, 0.f, 0.f, 0.f};
        if (tid < 32) { LAS float* mylg = lg + tid * 33; float tl[4];
#pragma unroll
            for (int k = 0; k < 4; ++k) { float best = -INFINITY; int bi = 0;
                for (int e = 0; e < 32; ++e) { const float vv = mylg[e]; if (vv > best) { best = vv; bi = e; } }
                tl[k] = best; e_k[k] = bi; mylg[bi] = -INFINITY; }
            float sum = 0.f;
#pragma unroll
            for (int k = 0; k < 4; ++k) { w_k[k] = __expf(tl[k] - tl[0]); sum += w_k[k]; }
            const float inv = 1.f / sum;
#pragma unroll
            for (int k = 0; k < 4; ++k) { w_k[k] *= inv; lp_k[k] = __hip_atomic_fetch_add(&hist[e_k[k]], 1, __ATOMIC_RELAXED, __HIP_MEMORY_SCOPE_WORKGROUP); } }
        __syncthreads();
        if (tid < 32) { const int hc = hist[tid]; base[tid] = hc > 0 ? (int)__hip_atomic_fetch_add(cnt + 64 * tid, (unsigned)hc, __ATOMIC_RELAXED, __HIP_MEMORY_SCOPE_AGENT) : 0; hist[tid] = 0; }
        __syncthreads();
        if (tid < 32) { const int token = row0 + tid; u32x4 info; f32x4 ww;
#pragma unroll
            for (int k = 0; k < 4; ++k) { const int pos = base[e_k[k]] + lp_k[k]; ROWTOK[e_k[k] * 65536 + pos] = token; info[k] = ((unsigned)e_k[k] << 17) | (unsigned)pos; ww[k] = w_k[k]; }
            *(u32x4*)(TOKINFO + (size_t)token * 8) = info; *(f32x4*)(TOKINFO + (size_t)token * 8 + 4) = ww; }
        __syncthreads();
    }
}

__device__ __forceinline__ int moe_tables(const Frame& F, unsigned* cnt) {
    LAS int* ts = (LAS int*)(F.lds + TS_OFF); LAS int* te = (LAS int*)(F.lds + TILE_E_OFF);
    __syncthreads();
    if (F.tid == 0) { int acc = 0; for (int e = 0; e < NE; ++e) { ts[e] = acc; const unsigned c = __hip_atomic_load(cnt + 64 * e, __ATOMIC_RELAXED, __HIP_MEMORY_SCOPE_AGENT); acc += (int)((c + 255u) >> 8); } ts[NE] = acc; }
    __syncthreads();
    const int RT = ts[NE];
    for (int rt = F.tid; rt < RT; rt += 512) { int e = 0;
#pragma unroll 1
        for (int q = 1; q < NE; ++q) e += (ts[q] <= rt) ? 1 : 0;
        te[rt] = e; }
    __syncthreads();
    return RT;
}

__device__ __forceinline__ void p10_combine(const Frame& F, const Args& a, int l, float* xio, const bf16_t* Y2, const unsigned* TOKINFO, const float* MODbase, signed char* H8, float* RS) {
    const int lane = F.lane; const LAS int* ts = (const LAS int*)(F.lds + TS_OFF);
    const float* g_postf = a.in[7] + l * DM;
    const int gw = F.vcu * 8 + F.wave, NGW = F.G * 8;
    for (int rowp = gw * 2; rowp < MTOK; rowp += NGW * 2) {
        u32x4 info[2]; f32x4 ww[2]; u32x2 yw[2][4][4]; f32x4 xv[2][4];
#pragma unroll
        for (int rr = 0; rr < 2; ++rr) { info[rr] = *(const u32x4*)(TOKINFO + (size_t)(rowp + rr) * 8); ww[rr] = *(const f32x4*)(TOKINFO + (size_t)(rowp + rr) * 8 + 4); }
#pragma unroll
        for (int rr = 0; rr < 2; ++rr) {
#pragma unroll
            for (int k = 0; k < 4; ++k) { const int e = (int)(info[rr][k] >> 17), pos = (int)(info[rr][k] & 0x1ffffu); const size_t slot = (size_t)ts[e] * 256 + pos;
#pragma unroll
                for (int j = 0; j < 4; ++j) yw[rr][k][j] = __builtin_nontemporal_load((const u32x2*)(Y2 + slot * DM + 4 * lane + 256 * j)); }
#pragma unroll
            for (int j = 0; j < 4; ++j) xv[rr][j] = *(const f32x4*)(xio + (size_t)(rowp + rr) * DM + 4 * lane + 256 * j); }
#pragma unroll
        for (int rr = 0; rr < 2; ++rr) { const int row = rowp + rr, b = row >> 11;
        f32x4 y[4];
#pragma unroll
        for (int j = 0; j < 4; ++j) y[j] = (f32x4){0.f, 0.f, 0.f, 0.f};
#pragma unroll
        for (int k = 0; k < 4; ++k) { const float wk = ww[rr][k];
#pragma unroll
            for (int j = 0; j < 4; ++j) { const u32x2 w = yw[rr][k][j];
                y[j][0] += wk * bf_lo(w.x); y[j][1] += wk * bf_hi(w.x); y[j][2] += wk * bf_lo(w.y); y[j][3] += wk * bf_hi(w.y); } }
        float ss = 0.f;
#pragma unroll
        for (int j = 0; j < 4; ++j) ss += (y[j][0] * y[j][0] + y[j][1] * y[j][1]) + (y[j][2] * y[j][2] + y[j][3] * y[j][3]);
        ss = wave_sum(ss);
        const float rstd = 1.f / sqrtf(ss * (1.f / DM) + RMS_EPS);
        const float* mb = MODbase + ((size_t)l * BATCH + b) * 6 * DM;
        f32x4 v[4]; float s2 = 0.f;
#pragma unroll
        for (int j = 0; j < 4; ++j) { const int c = 4 * lane + 256 * j; const f32x4 xx = xv[rr][j], gp = *(const f32x4*)(g_postf + c), ga = *(const f32x4*)(mb + 5 * DM + c);
            v[j] = xx + ga * (y[j] * rstd * gp);
#ifdef T_STAMP
            if (l + 1 == DEPTH) v[j] = v[j] * (1.f + (float)(*((const unsigned*)MODbase - (1u << 18) + 100)) * (1.f / 256.f));
#endif
            *(f32x4*)(xio + (size_t)row * DM + c) = v[j];
            s2 += (v[j][0] * v[j][0] + v[j][1] * v[j][1]) + (v[j][2] * v[j][2] + v[j][3] * v[j][3]); }
        if (l + 1 < DEPTH) { s2 = wave_sum(s2); const float* mb1 = MODbase + ((size_t)(l + 1) * BATCH + b) * 6 * DM;
            norm_mod_row(v, s2, a.in[4] + (l + 1) * DM, mb1 + DM, mb1, H8 + (size_t)row * DM, RS + row, lane); }
        }
    }
}
#ifndef MK_ONE_LAUNCH
#define MK_ONE_LAUNCH 1
#endif
constexpr int N_PHASES = 2 + 9 * DEPTH;
__global__ void __launch_bounds__(512, 2) fwd(Args args) {
    extern __shared__ __attribute__((aligned(16))) unsigned char lds_raw[];
    Frame F0;
    F0.lds = (LAS unsigned char*)lds_raw;
    F0.tid = threadIdx.x; F0.lane = F0.tid & 63; F0.wave = __builtin_amdgcn_readfirstlane(F0.tid >> 6);
    F0.G = gridDim.x; { const int bx = blockIdx.x; F0.vcu = (F0.G % 8 == 0) ? (bx % 8) * (F0.G / 8) + bx / 8 : bx; }
    volatile LAS unsigned* MISC = (volatile LAS unsigned*)(F0.lds + MISC_OFF);
    for (int u = F0.tid; u < 128; u += 512) MISC[u] = 0u;
    __syncthreads();
    unsigned* ctl = (unsigned*)(args.ws + WS_CTL);
    const int lo = args.ph_lo, hi = args.ph_hi;
    XcdBarrier bar; bar.bar = ctl + CW_BAR; bar.x = 0; bar.st = nullptr; bar.w = F0.wave;
    if (hi - lo > 1) bar = xcd_barrier_post(ctl + CW_BAR, MISC + 8, F0.wave);
#ifndef PHASE_MASK
#define PHASE_MASK 0x7ff
#endif
#define PHON(j) ((PHASE_MASK >> (j)) & 1)
#ifndef REPEAT_MASK
#define REPEAT_MASK 0
#endif
#define REP(j) for (int rep_ = 0; rep_ <= ((REPEAT_MASK >> (j)) & 1); ++rep_)
#define IN(k) (lo <= (k) && (k) < hi)
#define BOTH(k) (IN(k) && IN((k) + 1))
#define GRID_BAR() xcd_barrier(bar)
#define PH_BEGIN() const Frame F = phase_frame(F0); unsigned char* ws = opq(args.ws); (void)ws
    if (PHON(0) && IN(0)) REP(0) { PH_BEGIN(); p0_mod(F, args.in[1], args.in[2], args.in[3], (float*)(ws + WS_MOD)); p0_weights(F, args); if (BOTH(0)) GRID_BAR(); }
    if (PHON(1) && IN(1)) REP(1) { PH_BEGIN(); p1_norm(F, args.in[0], args.in[4], (const float*)(ws + WS_MOD), (signed char*)(ws + WS_H), (float*)(ws + WS_RS)); if (BOTH(1)) GRID_BAR(); }

#pragma unroll 1
    for (int l = 0; l < DEPTH; ++l) {
        const int pb = 2 + 9 * l;
        if (PHON(2) && IN(pb + 0)) REP(2) { PH_BEGIN();
            pg8::Gemm g{(const bf16_t*)(ws + WS_H), (const bf16_t*)(ws + WS_W + (size_t)l * W_LAYER + WO_WIN), DM}; pg8::StaticOrder<MTOK / 256, NPROJ / 256> S; S.init(F.G, (int)blockIdx.x);
            EpiProj E{(bf16_t*)(ws + WS_PROJ), (unsigned char*)(ws + WS_GATES), (const float*)(ws + WS_RS), (const float*)(ws + WS_CSIN) + (size_t)l * NPROJ};
            pg8::gemm_phase<EpiProj, pg8::StaticOrder<MTOK / 256, NPROJ / 256>, false, true>(F.lds, g, S, E, F.wave);
            if (BOTH(pb + 0)) GRID_BAR();
        }
        if (PHON(3) && IN(pb + 1)) REP(3) {
#ifndef SUBREP
#define SUBREP 0
#endif
            { const Frame Fa = phase_frame(F0); const bf16_t* PROJa = (const bf16_t*)(opq(args.ws) + WS_PROJ); bf16_t* OAa = (bf16_t*)(opq(args.ws) + WS_O);
            for (int u = Fa.vcu; u < 2048; u += Fa.G) { const int cu = u & 255, j = u >> 8, bg = cu >> 2, s = cu & 3, qb = (j & 1) ? (8 * (j >> 1) + 7 - s) : (8 * (j >> 1) + s);
                attn_unit<0>(Fa, PROJa, OAa, nullptr, args.in[9] + l * 8, bg >> 1, bg & 1, qb); } }
            { const Frame Fb = phase_frame(F0); unsigned char* wsb = opq(args.ws);
            for (int u = Fb.vcu; u < 512; u += Fb.G)
                sg_unit(Fb, (const bf16_t*)(wsb + WS_PROJ), (const bf16_t*)(wsb + WS_SGW) + (size_t)l * 8 * 128 * 128, args.in[11] + l * 8 * 128, args.in[12] + l * 512, (bf16_t*)(wsb + WS_O) + (size_t)2 * MTOK * 512, u >> 4, u & 15); }
            __syncthreads();
            { const Frame Fi = phase_frame(F0); unsigned char* wsi = opq(args.ws);
              dsa_index_phase(Fi, (const bf16_t*)(wsi + WS_PROJ), (unsigned long long*)(wsi + WS_BITS), l == 0 ? (unsigned*)(wsi + WS_CTL) + 100 : nullptr); }
            if (BOTH(pb + 1)) GRID_BAR();
        }
        if (PHON(4) && IN(pb + 2)) REP(4) { PH_BEGIN();
            for (int u = F.vcu; u < 2048; u += F.G) { const int cu = u & 255, j = u >> 8, bg = cu >> 2, s = cu & 3, qb = (j & 1) ? (8 * (j >> 1) + 7 - s) : (8 * (j >> 1) + s);
                attn_unit<1>(F, (const bf16_t*)(ws + WS_PROJ), (bf16_t*)(ws + WS_O) + (size_t)MTOK * 512, (const unsigned*)(ws + WS_BITS), nullptr, bg >> 1, bg & 1, qb); }
            __syncthreads();
            if (BOTH(pb + 2)) GRID_BAR();
        }
        if (PHON(5) && IN(pb + 3)) REP(5) { PH_BEGIN();
            pg8::Gemm g{(const bf16_t*)(ws + WS_O), (const bf16_t*)(ws + WS_W + (size_t)l * W_LAYER + WO_WBR), 512}; BranchOrder S; S.so.init(F.G, (int)blockIdx.x);
            EpiBranch E{(const unsigned char*)(ws + WS_GATES), (bf16_t*)(ws + WS_H)};
            pg8::gemm_phase<EpiBranch, BranchOrder, false>(F.lds, g, S, E, F.wave);
            if (BOTH(pb + 3)) GRID_BAR();
        }
        if (PHON(6) && IN(pb + 4)) REP(6) { PH_BEGIN();
            pg8::Gemm g{(const bf16_t*)(ws + WS_H), (const bf16_t*)(ws + WS_W + (size_t)l * W_LAYER + WO_WOUT), DM}; pg8::StaticOrder<MTOK / 256, DM / 256> S; S.init(F.G, (int)blockIdx.x);
            EpiWout E{(bf16_t*)(ws + WS_Y), (float*)(ws + WS_SSP)};
            pg8::gemm_phase<EpiWout, pg8::StaticOrder<MTOK / 256, DM / 256>, false>(F.lds, g, S, E, F.wave);
            if (BOTH(pb + 4)) GRID_BAR();
        }
        if (PHON(7) && IN(pb + 5)) REP(7) { PH_BEGIN();
            p7_route(F, args, l, l == 0 ? args.in[0] : (const float*)args.out, args.out, (const bf16_t*)(ws + WS_Y), (const float*)(ws + WS_SSP), (const float*)(ws + WS_MOD) + (size_t)l * BATCH * 6 * DM, (signed char*)(ws + WS_H), (float*)(ws + WS_RS),
                     (const bf16_t*)(ws + WS_WRT) + (size_t)l * NE * DM, (unsigned*)(ws + WS_CTL) + CW_CNT + l * 32 * 64, (int*)(ws + WS_ROWTOK), (unsigned*)(ws + WS_TOKINFO));
            if (BOTH(pb + 5)) GRID_BAR();
        }
        if (PHON(8) && IN(pb + 6)) REP(8) { PH_BEGIN();
            unsigned* cnt = (unsigned*)(ws + WS_CTL) + CW_CNT + l * 32 * 64; const int* ROWTOK = (const int*)(ws + WS_ROWTOK);
            const int RT = moe_tables(F, cnt);
            LAS int* ts = (LAS int*)(F.lds + TS_OFF); LAS int* te = (LAS int*)(F.lds + TILE_E_OFF); LAS int* ri = (LAS int*)(F.lds + ROWIDX_OFF);
            const long U = (long)RT * 8; MoeOrder S; S.u0 = (int)(U * F.vcu / F.G); S.u1 = (int)(U * (F.vcu + 1) / F.G); S.NB = 8; S.rt_lo = S.u0 / 8; S.tile_e = te; S.rowidx = ri;
            if (S.u1 > S.u0) { const int rt_hi = (S.u1 - 1) / 8; int ntile = rt_hi - S.rt_lo + 1; if (ntile > 8) ntile = 8;
                for (int i = F.tid; i < ntile * 256; i += 512) { const int rt = S.rt_lo + (i >> 8), r = i & 255, e = te[rt], first = (rt - ts[e]) * 256 + r;
                    const int c = (int)__hip_atomic_load(cnt + 64 * e, __ATOMIC_RELAXED, __HIP_MEMORY_SCOPE_AGENT); ri[i] = first < c ? ROWTOK[e * 65536 + first] : 0; } }
            __syncthreads();
            pg8::Gemm g{(const bf16_t*)(ws + WS_H), (const bf16_t*)(ws + WS_W + (size_t)l * W_LAYER + WO_W1), DM};
            EpiW1I8 E{(signed char*)(ws + WS_ACT), args.in[18] + (size_t)l * NE * 2 * FF, (const float*)(ws + WS_RS), (const float*)(ws + WS_CS1) + (size_t)l * NE * 2048, ri, S.rt_lo};
            pg8::gemm_phase<EpiW1I8, MoeOrder, true, true>(F.lds, g, S, E, F.wave);
            if (BOTH(pb + 6)) GRID_BAR();
        }
        if (PHON(9) && IN(pb + 7)) REP(9) { PH_BEGIN();
            const int RT = moe_tables(F, (unsigned*)(ws + WS_CTL) + CW_CNT + l * 32 * 64);
            const long U = (long)RT * 4; MoeOrder S; S.u0 = (int)(U * F.vcu / F.G); S.u1 = (int)(U * (F.vcu + 1) / F.G); S.NB = 4; S.rt_lo = 0; S.tile_e = (LAS int*)(F.lds + TILE_E_OFF); S.rowidx = nullptr;
            pg8::Gemm g{(const bf16_t*)(ws + WS_ACT), (const bf16_t*)(ws + WS_W + (size_t)l * W_LAYER + WO_W2), FF};
            EpiW2 E{(bf16_t*)(ws + WS_Y2), args.in[20] + (size_t)l * NE * DM, (const float*)(ws + WS_CS2) + (size_t)l * NE * DM};
            pg8::gemm_phase<EpiW2, MoeOrder, false, true>(F.lds, g, S, E, F.wave);
            if (BOTH(pb + 7)) GRID_BAR();
        }
        if (PHON(10) && IN(pb + 8)) REP(10) { PH_BEGIN();
            (void)moe_tables(F, (unsigned*)(ws + WS_CTL) + CW_CNT + l * 32 * 64);
            p10_combine(F, args, l, args.out, (const bf16_t*)(ws + WS_Y2), (const unsigned*)(ws + WS_TOKINFO), (const float*)(ws + WS_MOD), (signed char*)(ws + WS_H), (float*)(ws + WS_RS));
            if (BOTH(pb + 8)) GRID_BAR();
        }
    }
#undef PH_BEGIN
#undef IN
#undef BOTH
#undef GRID_BAR
}

extern "C" void kernel_launch(void* const* d_in, const int* in_sizes, int n_in, void* d_out, int out_size, void* d_ws, size_t ws_size, hipStream_t stream) {
    static int grid = 0;
    if (grid == 0) {
        if (n_in != 21 || out_size != MTOK * DM || ws_size < WS_END) { fprintf(stderr, "kernel_launch: unexpected shapes (n_in %d, out %d, ws %zu); nothing launched\n", n_in, out_size, ws_size); grid = -1; return; }
        int dev = 0, cus = 0, per_cu = 0;
        if (hipGetDevice(&dev) != hipSuccess || hipDeviceGetAttribute(&cus, hipDeviceAttributeMultiprocessorCount, dev) != hipSuccess) { grid = -1; return; }
        if (hipFuncSetAttribute((const void*)fwd, hipFuncAttributeMaxDynamicSharedMemorySize, LDS_BYTES) != hipSuccess) { fprintf(stderr, "kernel_launch: hipFuncSetAttribute failed\n"); grid = -1; return; }
        if (hipOccupancyMaxActiveBlocksPerMultiprocessor(&per_cu, (const void*)fwd, 512, LDS_BYTES) != hipSuccess || per_cu < 1) { fprintf(stderr, "kernel_launch: occupancy query says %d\n", per_cu); }
        (void)hipGetLastError();
        grid = cus > 256 ? 256 : cus;
    }
    if (grid < 0) return;
    (void)hipMemsetAsync((char*)d_ws + WS_CTL, 0, CTL_ZERO_BYTES, stream);
    Args a{};
    for (int i = 0; i < 21; ++i) a.in[i] = (const float*)d_in[i];
    a.out = (float*)d_out; a.ws = (unsigned char*)d_ws;
#if MK_ONE_LAUNCH
    a.ph_lo = 0; a.ph_hi = N_PHASES;
    hipLaunchKernelGGL(fwd, dim3(grid), dim3(512), LDS_BYTES, stream, a);
#else
    for (int p = 0; p < N_PHASES; ++p) { a.ph_lo = p; a.ph_hi = p + 1; hipLaunchKernelGGL(fwd, dim3(grid), dim3(512), LDS_BYTES, stream, a); }
#endif
}
```

```cpp
#include <hip/hip_runtime.h>
#include <cstdio>
#include <cstdint>
#include <type_traits>

#define LAS __attribute__((address_space(3)))
#define GAS __attribute__((address_space(1)))
typedef unsigned short bf16_t;
typedef short bf16x8 __attribute__((ext_vector_type(8)));
typedef float f32x2 __attribute__((ext_vector_type(2)));
typedef float f32x4 __attribute__((ext_vector_type(4)));
typedef float f32x16 __attribute__((ext_vector_type(16)));
typedef unsigned u32x2 __attribute__((ext_vector_type(2)));
typedef unsigned u32x4 __attribute__((ext_vector_type(4)));
typedef short v4i16_t __attribute__((ext_vector_type(4)));
typedef int i32x4 __attribute__((ext_vector_type(4)));

constexpr int BATCH = 32, SEQ = 2048, DM = 1024, MTOK = BATCH * SEQ, DEPTH = 2;
constexpr int NPROJ = 6144;
constexpr int PLD = 3072;
constexpr int C_QA = 0, C_KA = 512, C_VA = 640, C_QB = 768, C_KB = 1280, C_VB = 1408, C_QI = 1536, C_KI = 1792, C_WI = 1824, C_U = 2048, C_V = 2560, C_G = 3072;
constexpr int NE = 32, FF = 1024;
constexpr float RMS_EPS = 1e-5f, LN_EPS = 1e-5f;
constexpr float LOG2E = 1.4426950408889634f;
constexpr float QSCALE = 0.125f * LOG2E;

__device__ __forceinline__ unsigned f2bf(float f) { unsigned u = __builtin_bit_cast(unsigned, f); return (u + 0x7fffu + ((u >> 16) & 1u)) >> 16; }
__device__ __forceinline__ unsigned cvt_pk_bf16(float lo, float hi) { unsigned r; asm volatile("v_cvt_pk_bf16_f32 %0, %1, %2" : "=v"(r) : "v"(lo), "v"(hi)); return r; }
__device__ __forceinline__ float bf_lo(unsigned w) { return __builtin_bit_cast(float, w << 16); }
__device__ __forceinline__ float bf_hi(unsigned w) { return __builtin_bit_cast(float, w & 0xffff0000u); }
__device__ __forceinline__ float fexp2(float x) { return __builtin_amdgcn_exp2f(x); }
__device__ __forceinline__ float frcp(float x) { return __builtin_amdgcn_rcpf(x); }
__device__ __forceinline__ float sigmoidf_(float x) { return frcp(1.f + fexp2(-LOG2E * x)); }
__device__ __forceinline__ float gelu_tanh(float x) { const float t = x + 0.044715f * x * x * x; return x * frcp(1.f + fexp2(-2.302208198f * t)); }
template <int CTRL> __device__ __forceinline__ float dpp_f(float v) { return __builtin_bit_cast(float, __builtin_amdgcn_update_dpp(0, __builtin_bit_cast(int, v), CTRL, 0xF, 0xF, false)); }
__device__ __forceinline__ void swap32_asm(unsigned& a, unsigned& b) { asm volatile("s_nop 1\n\tv_permlane32_swap_b32 %0, %1" : "+v"(a), "+v"(b)); }
__device__ __forceinline__ float xor16_add(float v) { return v + __builtin_bit_cast(float, __builtin_amdgcn_ds_swizzle(__builtin_bit_cast(int, v), 0x401F)); }
__device__ __forceinline__ float xor16_max(float v) { return fmaxf(v, __builtin_bit_cast(float, __builtin_amdgcn_ds_swizzle(__builtin_bit_cast(int, v), 0x401F))); }
__device__ __forceinline__ float xor32_add(float v) { unsigned a = __builtin_bit_cast(unsigned, v), b = a; swap32_asm(a, b); return __builtin_bit_cast(float, a) + __builtin_bit_cast(float, b); }
__device__ __forceinline__ float xor32_max(float v) { unsigned a = __builtin_bit_cast(unsigned, v), b = a; swap32_asm(a, b); return fmaxf(__builtin_bit_cast(float, a), __builtin_bit_cast(float, b)); }
__device__ __forceinline__ float quad_sum(float v) { v += dpp_f<0xB1>(v); v += dpp_f<0x4E>(v); return v; }
__device__ __forceinline__ float wave_sum(float v) {
    v += dpp_f<0xB1>(v); v += dpp_f<0x4E>(v); v += dpp_f<0x141>(v); v += dpp_f<0x140>(v);
    return xor32_add(xor16_add(v));
}
__device__ __forceinline__ float wave_max(float v) {
    v = fmaxf(v, dpp_f<0xB1>(v)); v = fmaxf(v, dpp_f<0x4E>(v)); v = fmaxf(v, dpp_f<0x141>(v)); v = fmaxf(v, dpp_f<0x140>(v));
    return xor32_max(xor16_max(v));
}
__device__ __forceinline__ unsigned wave_sum_u32(unsigned v) {
    v += (unsigned)__builtin_amdgcn_update_dpp(0, (int)v, 0xB1, 0xF, 0xF, false);
    v += (unsigned)__builtin_amdgcn_update_dpp(0, (int)v, 0x4E, 0xF, 0xF, false);
    v += (unsigned)__builtin_amdgcn_update_dpp(0, (int)v, 0x141, 0xF, 0xF, false);
    v += (unsigned)__builtin_amdgcn_update_dpp(0, (int)v, 0x140, 0xF, 0xF, false);
    return __builtin_amdgcn_readlane(v, 0) + __builtin_amdgcn_readlane(v, 16) + __builtin_amdgcn_readlane(v, 32) + __builtin_amdgcn_readlane(v, 48);
}
__device__ __forceinline__ unsigned wave_max_u32(unsigned v) {
    unsigned t;
    t = (unsigned)__builtin_amdgcn_update_dpp(0, (int)v, 0xB1, 0xF, 0xF, false); v = v > t ? v : t;
    t = (unsigned)__builtin_amdgcn_update_dpp(0, (int)v, 0x4E, 0xF, 0xF, false); v = v > t ? v : t;
    t = (unsigned)__builtin_amdgcn_update_dpp(0, (int)v, 0x141, 0xF, 0xF, false); v = v > t ? v : t;
    t = (unsigned)__builtin_amdgcn_update_dpp(0, (int)v, 0x140, 0xF, 0xF, false); v = v > t ? v : t;
    unsigned a = __builtin_amdgcn_readlane(v, 0), b = __builtin_amdgcn_readlane(v, 16), c = __builtin_amdgcn_readlane(v, 32), d = __builtin_amdgcn_readlane(v, 48);
    a = a > b ? a : b; c = c > d ? c : d; return a > c ? a : c;
}
__device__ __forceinline__ unsigned q8x4(float a, float b, float c, float d, float inv) {
    unsigned r = 0u;
    r = __builtin_amdgcn_cvt_pk_u8_f32(__builtin_rintf(fmaf(a, inv, 128.f)), 0u, r);
    r = __builtin_amdgcn_cvt_pk_u8_f32(__builtin_rintf(fmaf(b, inv, 128.f)), 1u, r);
    r = __builtin_amdgcn_cvt_pk_u8_f32(__builtin_rintf(fmaf(c, inv, 128.f)), 2u, r);
    r = __builtin_amdgcn_cvt_pk_u8_f32(__builtin_rintf(fmaf(d, inv, 128.f)), 3u, r);
    return r ^ 0x80808080u;
}
__device__ __forceinline__ unsigned u8x4_floor(float a, float b, float c, float d) {
    unsigned r = 0u;
    r = __builtin_amdgcn_cvt_pk_u8_f32(__builtin_floorf(a), 0u, r); r = __builtin_amdgcn_cvt_pk_u8_f32(__builtin_floorf(b), 1u, r);
    r = __builtin_amdgcn_cvt_pk_u8_f32(__builtin_floorf(c), 2u, r); r = __builtin_amdgcn_cvt_pk_u8_f32(__builtin_floorf(d), 3u, r);
    return r;
}
__device__ __forceinline__ int lane_id_volatile(int tag = 0) { int l; asm volatile("v_mbcnt_lo_u32_b32 %0, -1, 0 ; LANETAG %1\n\tv_mbcnt_hi_u32_b32 %0, -1, %0" : "=v"(l) : "s"(tag)); return l; }
#define LDS_WAIT() asm volatile("s_waitcnt lgkmcnt(0)" ::: "memory")
#define VM_WAIT() asm volatile("s_waitcnt vmcnt(0)" ::: "memory")

namespace pg8 {
constexpr int BM = 256, BK = 64, HALF = 128, HTB = HALF * BK * 2  , STAGE_BYTES = 8 * HTB, NXCD = 8, WGM = 8;
__host__ __device__ __forceinline__ int lds_byte(int r, int c) { const int st = (r >> 4) * 2 + (c >> 5), rr = r & 15, cc = c & 31, ob = rr * 64 + cc * 2; return st * 1024 + (ob ^ (((ob >> 9) & 1) << 5)); }
__host__ __device__ __forceinline__ void stage_rc(int b, int& R, int& C) { const int st = b / 1024, sb = b % 1024, swz = sb ^ (((sb >> 9) & 1) << 5); R = (st >> 1) * 16 + swz / 64; C = (st & 1) * 32 + (swz % 64) / 2; }
__host__ __device__ __forceinline__ int perm32(int rho) { const int n = rho >> 4, i = rho & 15; return 8 * (i >> 2) + 4 * n + (i & 3); }

struct Unit { int pm, pn; };
struct Gemm { const bf16_t* A; const bf16_t* Bt; int K; bool skip_epi = false; };

template <int NM, int NN> struct StaticOrder {
    int G, c;
    __device__ void init(int G_, int c_) { G = G_; c = c_; }
    __device__ __forceinline__ bool tile(int i, int& pm, int& pn) const {
        constexpr int nwg = NM * NN;
        const long L = (long)i * G + c; if (L >= nwg) return false;
        int wgid = (int)L; { constexpr int q = nwg / NXCD, r = nwg % NXCD; const int xcd = wgid % NXCD, off = wgid / NXCD; wgid = (xcd < r ? xcd * (q + 1) : r * (q + 1) + (xcd - r) * q) + off; }
        constexpr int nig = WGM * NN; static_assert(NM % WGM == 0, "row tiles in whole groups");
        const int gid = wgid / nig, fm = gid * WGM, rem = wgid % nig;
        pm = fm + (rem % WGM); pn = rem / WGM; return true;
    }
    __device__ __forceinline__ bool next(int i, Unit& u) const { return tile(i, u.pm, u.pn); }
};

template <class Epi, class Sched, bool GATHER, bool I8 = false>
__device__ __forceinline__ void gemm_phase(LAS unsigned char* lds, const Gemm g, const Sched& S, const Epi& E, int wv  ) {
    int tid = wv * 64 + lane_id_volatile(1); asm volatile("" : "+v"(tid));
    const int wid = __builtin_amdgcn_readfirstlane(tid >> 6), lane = tid & 63, wr = wid >> 2, wc = wid & 3, fr = lane & 15, fq = lane >> 4;
    const int K = g.K, RB = I8 ? K : 2 * K  , nt = RB / (BK * 2);
    unsigned voffA[2], voffB[2]; int RA[2], CA[2];
#pragma unroll
    for (int i = 0; i < 2; ++i) { int R, C; stage_rc(tid * 16 + i * 8192, R, C); const int Rb = (R & ~31) + perm32(R & 31); RA[i] = R; CA[i] = C;
        voffA[i] = (unsigned)(R * RB + C * 2); voffB[i] = (unsigned)(Rb * RB + C * 2); }
    const size_t kstep = (size_t)(BK * 2);
    const size_t hstep = (size_t)HALF * RB;
    const size_t tstep = 2 * hstep;
    const unsigned ldsw = (unsigned)wid * 1024u;
    const int aoff = lds_byte(wr * 64 + fr, fq * 8), boff = lds_byte(wc * 32 + fr, fq * 8);
#define PG8_SA(b, h) (((b) * 2 + (h)) * HTB)
#define PG8_SB(b, h) ((4 + (b) * 2 + (h)) * HTB)
#define PG8_STAGE(bufoff, gbase, voff) do { _Pragma("unroll") for (int _i = 0; _i < 2; ++_i) \
        __builtin_amdgcn_global_load_lds((const unsigned*)((const char*)(gbase) + (voff)[_i]), (LAS unsigned*)(lds + (bufoff) + ldsw + _i * 8192), 16, 0, 0); } while (0)
#define PG8_STAGE_A(bufoff, h, ubase, koff, VO) do { if constexpr (GATHER) { PG8_STAGE(bufoff, (const char*)g.A + (koff), VO[h]); } else { PG8_STAGE(bufoff, (ubase) + (h) * hstep + (koff), voffA); } } while (0)
#define PG8_LDA(dst, b, h) do { _Pragma("unroll") for (int m = 0; m < 4; ++m) _Pragma("unroll") for (int k = 0; k < 2; ++k) dst[m][k] = *(const LAS bf16x8*)(lds + PG8_SA(b, h) + aoff + m * 2048 + k * 1024); } while (0)
#define PG8_LDB(dst, b, h) do { _Pragma("unroll") for (int n = 0; n < 2; ++n) _Pragma("unroll") for (int k = 0; k < 2; ++k) dst[n][k] = *(const LAS bf16x8*)(lds + PG8_SB(b, h) + boff + n * 2048 + k * 1024); } while (0)
#define PG8_MMA(ai, bj, At, Bt) do { __builtin_amdgcn_s_setprio(1); _Pragma("unroll") for (int m = 0; m < 4; ++m) _Pragma("unroll") for (int n = 0; n < 2; ++n) _Pragma("unroll") for (int k = 0; k < 2; ++k) \
        { if constexpr (I8) acc[ai][bj][m][n] = __builtin_amdgcn_mfma_i32_16x16x64_i8(__builtin_bit_cast(i32x4, Bt[n][k]), __builtin_bit_cast(i32x4, At[m][k]), acc[ai][bj][m][n], 0, 0, 0); \
          else acc[ai][bj][m][n] = __builtin_amdgcn_mfma_f32_16x16x32_bf16(Bt[n][k], At[m][k], acc[ai][bj][m][n], 0, 0, 0); } __builtin_amdgcn_s_setprio(0); } while (0)
#define PG8_WAIT_V(n) asm volatile("s_waitcnt vmcnt(" #n ")" ::: "memory")
#define PG8_WAIT_L(n) asm volatile("s_waitcnt lgkmcnt(" #n ")" ::: "memory")
#define PG8_BAR __builtin_amdgcn_s_barrier()
#define PG8_SCHED __builtin_amdgcn_sched_barrier(0)
    Unit cur, nxt; int ui = 0;
    if (!S.next(0, cur)) return;
    typedef typename std::conditional<I8, i32x4, f32x4>::type accv_t;
    accv_t acc[2][2][4][2];
#pragma unroll
    for (int a = 0; a < 2; ++a)
#pragma unroll
        for (int b = 0; b < 2; ++b)
#pragma unroll
            for (int m = 0; m < 4; ++m)
#pragma unroll
                for (int n = 0; n < 2; ++n) acc[a][b][m][n] = (accv_t){0, 0, 0, 0};
    bf16x8 At[4][2], B0[2][2], B1[2][2];
    unsigned oc[2][2], on[2][2];
    if constexpr (GATHER) {
#pragma unroll
        for (int h = 0; h < 2; ++h)
#pragma unroll
            for (int i = 0; i < 2; ++i) { oc[h][i] = (unsigned)(S.src_row(cur, h * HALF + RA[i]) * RB + CA[i] * 2); on[h][i] = oc[h][i]; }
    }
    const char* cA = GATHER ? (const char*)g.A : (const char*)g.A + (size_t)cur.pm * tstep; const char* cB = (const char*)g.Bt + (size_t)cur.pn * tstep;
    PG8_STAGE(PG8_SB(0, 0), cB, voffB); PG8_STAGE(PG8_SB(0, 1), cB + hstep, voffB); PG8_STAGE_A(PG8_SA(0, 0), 0, cA, 0, oc); PG8_STAGE_A(PG8_SA(0, 1), 1, cA, 0, oc);
    if (wr == 1) PG8_BAR;
    PG8_WAIT_V(2); PG8_BAR;
    PG8_STAGE(PG8_SB(1, 0), cB + kstep, voffB); PG8_STAGE_A(PG8_SA(1, 0), 0, cA, kstep, oc); PG8_STAGE(PG8_SB(1, 1), cB + hstep + kstep, voffB);
    PG8_WAIT_V(6); PG8_BAR;
    for (;;) {
        const bool has_next = S.next(ui + 1, nxt);
        const char* nA = GATHER ? (const char*)g.A : (has_next ? (const char*)g.A + (size_t)nxt.pm * tstep : cA); const char* nB = has_next ? (const char*)g.Bt + (size_t)nxt.pn * tstep : cB;
        if constexpr (GATHER) {
            if (has_next) {
#pragma unroll
                for (int h = 0; h < 2; ++h)
#pragma unroll
                    for (int i = 0; i < 2; ++i) on[h][i] = (unsigned)(S.src_row(nxt, h * HALF + RA[i]) * RB + CA[i] * 2);
            }
        }
        for (int t = 0; t < nt; t += 2) {
            const bool last = (t == nt - 2);
            const size_t k1 = (size_t)(t + 1) * kstep;
            const size_t k2 = last ? (size_t)0 : (size_t)(t + 2) * kstep, k3 = k2 + kstep;
            const char* a2 = last ? nA : cA; const char* b2 = last ? nB : cB;
            unsigned o2[2][2];
            if constexpr (GATHER) {
#pragma unroll
                for (int h = 0; h < 2; ++h)
#pragma unroll
                    for (int i = 0; i < 2; ++i) o2[h][i] = last ? on[h][i] : oc[h][i];
            }
            PG8_LDB(B0, 0, 0); PG8_LDB(B1, 0, 1); PG8_SCHED; PG8_LDA(At, 0, 0); PG8_STAGE_A(PG8_SA(1, 1), 1, cA, k1, oc);
            PG8_WAIT_V(8); PG8_WAIT_L(0); PG8_BAR; PG8_MMA(0, 0, At, B0); PG8_MMA(0, 1, At, B1); PG8_BAR; PG8_SCHED;
            PG8_LDA(At, 0, 1); PG8_STAGE(PG8_SB(0, 0), b2 + k2, voffB); PG8_STAGE(PG8_SB(0, 1), b2 + hstep + k2, voffB); PG8_STAGE_A(PG8_SA(0, 0), 0, a2, k2, o2);
            PG8_WAIT_V(8); PG8_WAIT_L(0); PG8_BAR; PG8_MMA(1, 0, At, B0); PG8_MMA(1, 1, At, B1); PG8_BAR; PG8_SCHED;
            PG8_LDB(B0, 1, 0); PG8_LDB(B1, 1, 1); PG8_SCHED; PG8_LDA(At, 1, 0); PG8_STAGE_A(PG8_SA(0, 1), 1, a2, k2, o2);
            PG8_WAIT_V(8); PG8_WAIT_L(0); PG8_BAR; PG8_MMA(0, 0, At, B0); PG8_MMA(0, 1, At, B1); PG8_BAR; PG8_SCHED;
            PG8_LDA(At, 1, 1); PG8_STAGE(PG8_SB(1, 0), b2 + k3, voffB); PG8_STAGE(PG8_SB(1, 1), b2 + hstep + k3, voffB); PG8_STAGE_A(PG8_SA(1, 0), 0, a2, k3, o2);
            PG8_WAIT_V(8); PG8_WAIT_L(0); PG8_BAR; PG8_MMA(1, 0, At, B0); PG8_MMA(1, 1, At, B1); PG8_BAR; PG8_SCHED;
        }
        if (wr == 0) PG8_BAR;
#ifdef SKIP_EPI_PROBE
        bool rst = true; if (!g.skip_epi) rst = E(acc, cur, wr, wc, fr, fq);
#else
        const bool rst = E(acc, cur, wr, wc, fr, fq);
#endif
        if (!has_next) break;
        if (rst) {
#pragma unroll
        for (int a = 0; a < 2; ++a)
#pragma unroll
            for (int b = 0; b < 2; ++b)
#pragma unroll
                for (int m = 0; m < 4; ++m)
#pragma unroll
                    for (int n = 0; n < 2; ++n) acc[a][b][m][n] = (accv_t){0, 0, 0, 0};
        }
        cur = nxt; cA = nA; cB = nB; ++ui;
        if constexpr (GATHER) {
#pragma unroll
            for (int h = 0; h < 2; ++h)
#pragma unroll
                for (int i = 0; i < 2; ++i) oc[h][i] = on[h][i];
        }
        if (wr == 1) PG8_BAR;
    }
    PG8_WAIT_V(0);
    PG8_BAR;
#undef PG8_SA
#undef PG8_SB
#undef PG8_STAGE
#undef PG8_STAGE_A
#undef PG8_LDA
#undef PG8_LDB
#undef PG8_MMA
#undef PG8_WAIT_V
#undef PG8_WAIT_L
#undef PG8_BAR
#undef PG8_SCHED
}
}
typedef f32x4 acc_t[2][2][4][2];
typedef i32x4 acci_t[2][2][4][2];

struct EpiProj {
    bf16_t* O; unsigned char* G8; const float* RS  ; const float* CS  ;
    __device__ __forceinline__ bool operator()(acci_t& acc, const pg8::Unit& u, int wr, int wc, int fr, int fq) const {
        const int pn = u.pn;
        const int act = (pn <= 1 || pn == 3 || pn == 4) ? 1 : (pn >= 12 ? 3 : (pn >= 8 ? 2 : 0));
        const int row0 = u.pm * 256 + wr * 64 + fr, col0 = pn * 256 + wc * 32 + 8 * fq;
        float rsv[8];
#pragma unroll
        for (int q = 0; q < 8; ++q) rsv[q] = RS[row0 + (q >> 2) * 128 + (q & 3) * 16];
        f32x2 cs2[2][4];
#pragma unroll
        for (int bj = 0; bj < 2; ++bj) { const f32x4 c0 = *(const f32x4*)(CS + col0 + bj * 128), c1 = *(const f32x4*)(CS + col0 + bj * 128 + 4); const float k = (act == 1 ? QSCALE : 1.f);
            cs2[bj][0] = (f32x2){c0[0], c0[1]} * k; cs2[bj][1] = (f32x2){c0[2], c0[3]} * k; cs2[bj][2] = (f32x2){c1[0], c1[1]} * k; cs2[bj][3] = (f32x2){c1[2], c1[3]} * k; }
#pragma unroll
        for (int ai = 0; ai < 2; ++ai)
#pragma unroll
            for (int m = 0; m < 4; ++m) { const int row = row0 + ai * 128 + m * 16; bf16_t* rowp = O + (size_t)row * PLD + col0; const float rs = rsv[ai * 4 + m];
#pragma unroll
                for (int bj = 0; bj < 2; ++bj) { f32x2 v[4];
#pragma unroll
                    for (int p = 0; p < 4; ++p) { const int i0 = 2 * p; v[p] = (f32x2){(float)acc[ai][bj][m][i0 >> 2][i0 & 3], (float)acc[ai][bj][m][(i0 + 1) >> 2][(i0 + 1) & 3]} * (cs2[bj][p] * rs); }
                    if (act == 2) {
#pragma unroll
                        for (int p = 0; p < 4; ++p) { const f32x2 x = v[p], t = (x * x * 0.044715f + 1.f) * x * (-2.302208198f); f32x2 d = {fexp2(t[0]), fexp2(t[1])}; d = d + 1.f; v[p] = x * (f32x2){frcp(d[0]), frcp(d[1])}; } }
                    else if (act == 3) {
                        f32x2 gq[4];
#pragma unroll
                        for (int p = 0; p < 4; ++p) { const f32x2 t = v[p] * (-LOG2E); f32x2 d = {fexp2(t[0]), fexp2(t[1])}; d = d + 1.f; gq[p] = (f32x2){frcp(d[0]), frcp(d[1])} * 256.f; }
                        u32x2 w8; w8.x = u8x4_floor(gq[0][0], gq[0][1], gq[1][0], gq[1][1]); w8.y = u8x4_floor(gq[2][0], gq[2][1], gq[3][0], gq[3][1]);
                        *(u32x2*)(G8 + (size_t)row * 3072 + (col0 - C_G) + bj * 128) = w8; continue; }
                    u32x4 w; w.x = cvt_pk_bf16(v[0][0], v[0][1]); w.y = cvt_pk_bf16(v[1][0], v[1][1]); w.z = cvt_pk_bf16(v[2][0], v[2][1]); w.w = cvt_pk_bf16(v[3][0], v[3][1]);
                    *(u32x4*)(rowp + bj * 128) = w; } }
        return true;
    }
};

struct BranchOrder {
    pg8::StaticOrder<MTOK / 256, DM / 256> so;
    __device__ __forceinline__ bool next(int j, pg8::Unit& u) const { const int i = j / 3, br = j - 3 * i; int pm, pn; if (!so.tile(i, pm, pn)) return false; u.pm = br * 256 + pm; u.pn = br * 4 + pn; return true; }
};
struct EpiBranch {
    const unsigned char* G8  ; bf16_t* MERGED;
    __device__ __forceinline__ bool operator()(acc_t& acc, const pg8::Unit& u, int wr, int wc, int fr, int fq) const {
        const int br = u.pn >> 2, pn = u.pn & 3, pm = u.pm & 255;
        const int row0 = pm * 256 + wr * 64 + fr, col0 = pn * 256 + wc * 32 + 8 * fq;
#pragma unroll
        for (int rnd = 0; rnd < 2; ++rnd) { const int ai = rnd, m0 = 0;
            u32x2 gw[4][2], gd[4][2];
#pragma unroll
            for (int m = m0; m < m0 + 4; ++m)
#pragma unroll
                for (int bj = 0; bj < 2; ++bj) { const unsigned char* gp = G8 + (size_t)(row0 + ai * 128 + m * 16) * 3072 + br * 1024 + col0 + bj * 128;
                    gw[m][bj] = *(const u32x2*)gp; if (br != 2) gd[m][bj] = *(const u32x2*)(gp + 1024); }
#pragma unroll
            for (int m = m0; m < m0 + 4; ++m) { const size_t row = (size_t)(row0 + ai * 128 + m * 16);
#pragma unroll
                for (int bj = 0; bj < 2; ++bj) {
                    const u32x2 g = gw[m][bj];
                    float gn[8];
#pragma unroll
                    for (int i = 0; i < 8; ++i) gn[i] = (float)((g[i >> 2] >> (8 * (i & 3))) & 0xffu) + 0.5f;
                    if (br != 2) { const u32x2 d = gd[m][bj];
#pragma unroll
                        for (int i = 0; i < 8; ++i) gn[i] = gn[i] * frcp((float)((d[i >> 2] >> (8 * (i & 3))) & 0xffu) + 0.5f); }
                    else {
#pragma unroll
                        for (int i = 0; i < 8; ++i) gn[i] *= (1.f / 256.f); }
                    f32x4 v0 = acc[ai][bj][m][0], v1 = acc[ai][bj][m][1];
                    v0[0] *= gn[0]; v0[1] *= gn[1]; v0[2] *= gn[2]; v0[3] *= gn[3]; v1[0] *= gn[4]; v1[1] *= gn[5]; v1[2] *= gn[6]; v1[3] *= gn[7];
                    if (br != 2) { acc[ai][bj][m][0] = v0; acc[ai][bj][m][1] = v1; }
                    else { u32x4 w; w.x = cvt_pk_bf16(v0[0], v0[1]); w.y = cvt_pk_bf16(v0[2], v0[3]); w.z = cvt_pk_bf16(v1[0], v1[1]); w.w = cvt_pk_bf16(v1[2], v1[3]);
                        *(u32x4*)(MERGED + row * DM + col0 + bj * 128) = w; } } }
            asm volatile("" ::: "memory");
        }
        return br == 2;
    }
};

#ifndef WOUT_VARIANT
#define WOUT_VARIANT 0
#endif
struct EpiWout {
    bf16_t* Y; float* SSP; bool pv = false;
    __device__ __forceinline__ bool operator()(acc_t& acc, const pg8::Unit& u, int wr, int wc, int fr, int fq) const {
        const int row0 = u.pm * 256 + wr * 64 + fr, col0 = u.pn * 256 + wc * 32 + 8 * fq;
#pragma unroll
        for (int ai = 0; ai < 2; ++ai)
#pragma unroll
            for (int m = 0; m < 4; ++m) { const size_t row = (size_t)(row0 + ai * 128 + m * 16); float ss = 0.f;
#pragma unroll
                for (int bj = 0; bj < 2; ++bj) { const f32x4 v0 = acc[ai][bj][m][0], v1 = acc[ai][bj][m][1];
                    ss += (v0[0] * v0[0] + v0[1] * v0[1]) + (v0[2] * v0[2] + v0[3] * v0[3]) + (v1[0] * v1[0] + v1[1] * v1[1]) + (v1[2] * v1[2] + v1[3] * v1[3]);
                    u32x4 w; w.x = cvt_pk_bf16(v0[0], v0[1]); w.y = cvt_pk_bf16(v0[2], v0[3]); w.z = cvt_pk_bf16(v1[0], v1[1]); w.w = cvt_pk_bf16(v1[2], v1[3]);
                    if (!(WOUT_VARIANT == 2 && pv)) *(u32x4*)(Y + row * DM + col0 + bj * 128) = w; }
                if (!(WOUT_VARIANT == 3 && pv)) ss = xor32_add(xor16_add(ss));
                if (fq == 0 && !((WOUT_VARIANT == 1 || WOUT_VARIANT == 3) && pv)) SSP[row * 16 + u.pn * 4 + wc] = ss; }
        return true;
    }
};

struct MoeOrder {
    int u0, u1, NB, rt_lo;
    const LAS int* tile_e;
    const LAS int* rowidx;
    __device__ __forceinline__ bool next(int i, pg8::Unit& u) const { const int x = u0 + i; if (x >= u1) return false; const int rt = x / NB, pn = x - rt * NB; u.pm = rt; u.pn = tile_e[rt] * NB + pn; return true; }
    __device__ __forceinline__ int src_row(const pg8::Unit& u, int r) const { return rowidx[(u.pm - rt_lo) * 256 + r]; }
};
struct EpiW1 {
    bf16_t* ACT; const float* b1  ;
    __device__ __forceinline__ bool operator()(acc_t& acc, const pg8::Unit& u, int wr, int wc, int fr, int fq) const {
        const int e = u.pn >> 3, pn = u.pn & 7;
        const int row0 = u.pm * 256 + wr * 64 + fr, j0 = pn * 128 + wc * 32 + 8 * fq;
        const float* bp = b1 + (size_t)e * (2 * FF) + 2 * j0;
        float bg[8], bl[8];
#pragma unroll
        for (int q = 0; q < 4; ++q) { const f32x4 t = *(const f32x4*)(bp + 4 * q); bg[2 * q] = t[0]; bl[2 * q] = t[1]; bg[2 * q + 1] = t[2]; bl[2 * q + 1] = t[3]; }
#pragma unroll
        for (int ai = 0; ai < 2; ++ai)
#pragma unroll
            for (int m = 0; m < 4; ++m) { float a[8];
#pragma unroll
                for (int i = 0; i < 8; ++i) { float gl = acc[ai][0][m][i >> 2][i & 3] + bg[i], li = acc[ai][1][m][i >> 2][i & 3] + bl[i];
                    gl = fminf(gl, 7.f); li = fminf(fmaxf(li, -7.f), 7.f);
                    a[i] = gl * frcp(1.f + fexp2(-1.702f * LOG2E * gl)) * (li + 1.f); }
                u32x4 w; w.x = cvt_pk_bf16(a[0], a[1]); w.y = cvt_pk_bf16(a[2], a[3]); w.z = cvt_pk_bf16(a[4], a[5]); w.w = cvt_pk_bf16(a[6], a[7]);
                *(u32x4*)(ACT + (size_t)(row0 + ai * 128 + m * 16) * FF + j0) = w; }
        return true;
    }
};
constexpr float ACT_SCALE = 12.f / 127.f;
struct EpiW1I8 {
    signed char* ACT  ; const float* b1  ; const float* RS  ; const float* CS  ;
    const LAS int* rowidx; int rt_lo;
    __device__ __forceinline__ bool operator()(acci_t& acc, const pg8::Unit& u, int wr, int wc, int fr, int fq) const {
        const int e = u.pn >> 3, pn = u.pn & 7;
        const int rl0 = wr * 64 + fr, row0 = u.pm * 256 + rl0, j0 = pn * 128 + wc * 32 + 8 * fq;
        const float* bp = b1 + (size_t)e * (2 * FF) + 2 * j0;
        float bg[8], bl[8], cg[8], cl[8];
#pragma unroll
        for (int q = 0; q < 4; ++q) { const f32x4 t = *(const f32x4*)(bp + 4 * q); bg[2 * q] = t[0]; bl[2 * q] = t[1]; bg[2 * q + 1] = t[2]; bl[2 * q + 1] = t[3]; }
        { const float* cp = CS + (size_t)e * 2048 + pn * 256 + wc * 32 + 8 * fq;
          const f32x4 a0 = *(const f32x4*)cp, a1 = *(const f32x4*)(cp + 4), c0 = *(const f32x4*)(cp + 128), c1 = *(const f32x4*)(cp + 132);
#pragma unroll
          for (int i = 0; i < 4; ++i) { cg[i] = a0[i]; cg[4 + i] = a1[i]; cl[i] = c0[i]; cl[4 + i] = c1[i]; } }
        const LAS int* ri = rowidx + (u.pm - rt_lo) * 256 + rl0;
        float rsv[8];
#pragma unroll
        for (int q = 0; q < 8; ++q) rsv[q] = RS[ri[(q >> 2) * 128 + (q & 3) * 16]];
        f32x2 bg2[4], bl2[4], cg2[4], cl2[4];
#pragma unroll
        for (int p = 0; p < 4; ++p) { bg2[p] = (f32x2){bg[2 * p], bg[2 * p + 1]}; bl2[p] = (f32x2){bl[2 * p], bl[2 * p + 1]}; cg2[p] = (f32x2){cg[2 * p], cg[2 * p + 1]}; cl2[p] = (f32x2){cl[2 * p], cl[2 * p + 1]}; }
#pragma unroll
        for (int ai = 0; ai < 2; ++ai)
#pragma unroll
            for (int m = 0; m < 4; ++m) { const float rs = rsv[ai * 4 + m]; f32x2 a2[4];
#pragma unroll
                for (int p = 0; p < 4; ++p) { const int i0 = 2 * p;
                    const f32x2 ag = {(float)acc[ai][0][m][i0 >> 2][i0 & 3], (float)acc[ai][0][m][(i0 + 1) >> 2][(i0 + 1) & 3]}, al = {(float)acc[ai][1][m][i0 >> 2][i0 & 3], (float)acc[ai][1][m][(i0 + 1) >> 2][(i0 + 1) & 3]};
                    f32x2 gl = ag * (cg2[p] * rs) + bg2[p], li = al * (cl2[p] * rs) + bl2[p];
                    gl[0] = fminf(gl[0], 7.f); gl[1] = fminf(gl[1], 7.f); li[0] = fminf(fmaxf(li[0], -7.f), 7.f); li[1] = fminf(fmaxf(li[1], -7.f), 7.f);
                    const f32x2 ex = gl * (-1.702f * LOG2E); f32x2 den = {fexp2(ex[0]), fexp2(ex[1])}; den = den + 1.f; const f32x2 rc = {frcp(den[0]), frcp(den[1])};
                    a2[p] = (gl * rc) * (li + 1.f); }
                u32x2 w; w.x = q8x4(a2[0][0], a2[0][1], a2[1][0], a2[1][1], 1.f / ACT_SCALE); w.y = q8x4(a2[2][0], a2[2][1], a2[3][0], a2[3][1], 1.f / ACT_SCALE);
                *(u32x2*)(ACT + (size_t)(row0 + ai * 128 + m * 16) * FF + j0) = w; }
        return true;
    }
};
struct EpiW2 {
    bf16_t* Y2; const float* b2  ; const float* CS  ;
    __device__ __forceinline__ bool operator()(acci_t& acc, const pg8::Unit& u, int wr, int wc, int fr, int fq) const {
        const int e = u.pn >> 2, pn = u.pn & 3;
        const int row0 = u.pm * 256 + wr * 64 + fr, col0 = pn * 256 + wc * 32 + 8 * fq;
        f32x4 bv[2][2], cv[2][2];
#pragma unroll
        for (int bj = 0; bj < 2; ++bj)
#pragma unroll
            for (int n = 0; n < 2; ++n) { bv[bj][n] = *(const f32x4*)(b2 + (size_t)e * DM + col0 + bj * 128 + 4 * n); cv[bj][n] = *(const f32x4*)(CS + (size_t)e * DM + col0 + bj * 128 + 4 * n) * ACT_SCALE; }
#pragma unroll
        for (int ai = 0; ai < 2; ++ai)
#pragma unroll
            for (int m = 0; m < 4; ++m) { bf16_t* rowp = Y2 + (size_t)(row0 + ai * 128 + m * 16) * DM + col0;
#pragma unroll
                for (int bj = 0; bj < 2; ++bj) { const i32x4 a0 = acc[ai][bj][m][0], a1 = acc[ai][bj][m][1];
                    const f32x4 v0 = (f32x4){(float)a0[0], (float)a0[1], (float)a0[2], (float)a0[3]} * cv[bj][0] + bv[bj][0], v1 = (f32x4){(float)a1[0], (float)a1[1], (float)a1[2], (float)a1[3]} * cv[bj][1] + bv[bj][1];
                    u32x4 w; w.x = cvt_pk_bf16(v0[0], v0[1]); w.y = cvt_pk_bf16(v0[2], v0[3]); w.z = cvt_pk_bf16(v1[0], v1[1]); w.w = cvt_pk_bf16(v1[2], v1[3]);
                    *(u32x4*)(rowp + bj * 128) = w; } }
        return true;
    }
};
#define XB_TMO      128
#define XB_XCNT(j)  (256  + 64 * (j))
#define XB_XSUB(j)  (1280 + 64 * (j))
#define XB_XGEN(j)  (2304 + 64 * (j))
#define XB_TOP      3328
#define XB_TOPGEN   3392
#define XCD_BAR_WORDS 3456
#define XB_SPIN_CAP (1u << 18)

__device__ __forceinline__ unsigned xb_ld(unsigned* p)              { return __hip_atomic_load(p, __ATOMIC_RELAXED, __HIP_MEMORY_SCOPE_AGENT); }
__device__ __forceinline__ unsigned xb_add(unsigned* p, unsigned v) { return __hip_atomic_fetch_add(p, v, __ATOMIC_RELAXED, __HIP_MEMORY_SCOPE_AGENT); }
__device__ __forceinline__ unsigned xb_xcc_id() { return (unsigned)__builtin_amdgcn_s_getreg((3 << 11) | 20) & 0xFu; }
#define XB_SPIN(cond, bar) do { unsigned _sp = 0; while (cond) { __builtin_amdgcn_s_sleep(1); \
    if ((++_sp & 255u) == 0u) { if (xb_ld(&(bar)[XB_TMO])) break; if (_sp > XB_SPIN_CAP) { atomicAdd(&(bar)[XB_TMO], 1u); break; } } } } while (0)

struct XcdBarrier {
    unsigned* bar; unsigned x;
    int w;
    volatile LAS unsigned* st;
};

__device__ __forceinline__ bool xb_thread0(int w) { return w == 0 && lane_id_volatile(2) == 0; }
__device__ __forceinline__ XcdBarrier xcd_barrier_post(unsigned* bar, volatile LAS unsigned* st, int w) {
    XcdBarrier b; b.bar = bar; b.x = xb_xcc_id(); b.st = st; b.w = w;
    if (xb_thread0(w)) (void)xb_add(&bar[XB_XCNT(b.x)], 1u);
    return b;
}
__device__ __forceinline__ void xcd_barrier_complete(unsigned* bar, unsigned x, unsigned& nloc, unsigned& nx) {
    const unsigned G = gridDim.x * gridDim.y * gridDim.z;
    unsigned sum, cnt, mine, sp = 0u;
    for (;;) {
        sum = 0u; cnt = 0u; mine = 0u;
#pragma unroll
        for (unsigned j = 0; j < 16; ++j) { const unsigned c = xb_ld(&bar[XB_XCNT(j)]); sum += c; cnt += (c > 0u) ? 1u : 0u; mine = (j == x) ? c : mine; }
        if (sum == G) break;
        __builtin_amdgcn_s_sleep(1);
        if ((++sp & 255u) == 0u) { if (xb_ld(&bar[XB_TMO])) break; if (sp > XB_SPIN_CAP) { atomicAdd(&bar[XB_TMO], 1u); break; } }
    }
    nloc = mine > 0u ? mine : 1u; nx = cnt > 0u ? cnt : 1u;
}

__device__ __forceinline__ void xcd_barrier(const XcdBarrier& b) {
    asm volatile("s_waitcnt vmcnt(0)" ::: "memory");
    __syncthreads();
    if (xb_thread0(b.w)) {
        unsigned* bar = b.bar;
        __builtin_amdgcn_s_waitcnt(0);
        unsigned nloc = b.st[0], nx = b.st[1];
        if (nloc == 0u) { xcd_barrier_complete(bar, b.x, nloc, nx); b.st[0] = nloc; b.st[1] = nx; }
        const unsigned old = xb_add(&bar[XB_XSUB(b.x)], 1u);
        const unsigned gen = old / nloc;
        if (old + 1u == (gen + 1u) * nloc) {
            __builtin_amdgcn_fence(__ATOMIC_RELEASE, "agent");
            asm volatile("s_waitcnt vmcnt(0)" ::: "memory");
            const unsigned og = xb_add(&bar[XB_TOP], 1u);
            const unsigned tg = og / nx;
            if (og + 1u == (tg + 1u) * nx) xb_add(&bar[XB_TOPGEN], 1u);
            else XB_SPIN(xb_ld(&bar[XB_TOPGEN]) == tg, bar);
            __builtin_amdgcn_fence(__ATOMIC_ACQUIRE, "agent");
            xb_add(&bar[XB_XGEN(b.x)], 1u);
            asm volatile("s_waitcnt vmcnt(0)" ::: "memory");
        } else {
            XB_SPIN(xb_ld(&bar[XB_XGEN(b.x)]) == gen, bar);
            __builtin_amdgcn_fence(__ATOMIC_ACQUIRE, "agent");
            asm volatile("s_waitcnt vmcnt(0)" ::: "memory");
        }
    }
    __syncthreads();
}

constexpr size_t MiB = 1u << 20;
constexpr size_t WS_CTL = 0, CTL_ZERO_BYTES = 1 * MiB;
constexpr size_t WS_MOD = 1 * MiB;
constexpr size_t WS_SGW = 3 * MiB;
constexpr size_t WS_WRT = 3 * MiB + 512 * 1024;
constexpr size_t WS_RS = 4 * MiB;
constexpr size_t WS_CS1 = 5 * MiB;
constexpr size_t WS_CS2 = 6 * MiB + 512 * 1024;
constexpr size_t WS_CSIN = 6 * MiB;
constexpr size_t WS_W = 8 * MiB, W_LAYER = 209 * MiB;
constexpr size_t WO_WIN = 0, WO_WBR = 12 * MiB, WO_WOUT = 15 * MiB, WO_W1 = 17 * MiB, WO_W2 = 145 * MiB;
constexpr size_t WS_PROJ = 426 * MiB;
constexpr size_t WS_GATES = 810 * MiB;
constexpr size_t WS_ACT = WS_PROJ;
constexpr size_t WS_X = 1002 * MiB;
constexpr size_t WS_H = 1194 * MiB;
constexpr size_t WS_O = 1322 * MiB;
constexpr size_t WS_Y = 1514 * MiB;
constexpr size_t WS_BITS = 1770 * MiB;
constexpr size_t WS_Y2 = WS_O;
constexpr size_t WS_SSP = 1850 * MiB;
constexpr size_t WS_ROWTOK = 1854 * MiB;
constexpr size_t WS_TOKINFO = 1862 * MiB;
constexpr size_t WS_SLAB = 1864 * MiB;
constexpr size_t WS_END = 1928 * MiB;
static_assert(WS_Y2 + (size_t)270336 * 2048 <= WS_SSP && WS_W + 2 * W_LAYER <= WS_PROJ && WS_PROJ + (size_t)MTOK * PLD * 2 <= WS_GATES && WS_GATES + (size_t)MTOK * 3072 <= WS_H, "d_ws map");
constexpr int CW_BAR = 4096;
constexpr int CW_CNT = 16384;

constexpr int RING_BYTES = 131072;
constexpr int MISC_OFF = 134144;
constexpr int TS_OFF = MISC_OFF + 512;
constexpr int TILE_E_OFF = MISC_OFF + 1024;
constexpr int ROWIDX_OFF = MISC_OFF + 5632;
constexpr int LDS_BYTES = 151552;
static_assert(ROWIDX_OFF + 8192 <= LDS_BYTES, "LDS map");

struct Args {
    const float* in[21]; float* out; unsigned char* ws; int ph_lo, ph_hi;
};
struct Frame {
    LAS unsigned char* lds; int tid, lane, wave, vcu, G;
};
__device__ __forceinline__ Frame phase_frame(const Frame& F0) { Frame F = F0; int t = F0.wave * 64 + lane_id_volatile(3); asm volatile("" : "+v"(t)); F.tid = t; F.lane = t & 63; F.wave = F0.wave; return F; }
template <class T> __device__ __forceinline__ T* opq(T* p) { long z = 0; asm volatile("" : "+s"(z)); return (T*)((unsigned char*)p + z); }

__device__ __forceinline__ void p0_mod(const Frame& F, const float* c, const float* w_ada, const float* b_ada, float* MOD) {
    LAS float* csT = (LAS float*)F.lds;
    for (int i = F.tid; i < BATCH * DM; i += 512) { const int b = i & 31, k = i >> 5; const float v = c[b * DM + k]; csT[k * 32 + b] = v * sigmoidf_(v); }
    __syncthreads();
    const int gw = F.vcu * 8 + F.wave, NGW = F.G * 8;
    const int cg = F.lane & 15, kq = F.lane >> 4;
    for (int task = gw; task < DEPTH * 384; task += NGW) {
        const int l = task / 384, n = (task % 384) * 16 + cg;
        float acc[32];
#pragma unroll
        for (int b = 0; b < 32; ++b) acc[b] = 0.f;
        const float* w = w_ada + ((size_t)l * DM + kq * 256) * (6 * DM) + n;
#pragma unroll 4
        for (int k = 0; k < 256; ++k) {
            const float wv = w[(size_t)k * (6 * DM)];
            const LAS f32x4* cs = (const LAS f32x4*)(csT + (kq * 256 + k) * 32);
#pragma unroll
            for (int q = 0; q < 8; ++q) { const f32x4 c4 = cs[q]; acc[4 * q] += c4[0] * wv; acc[4 * q + 1] += c4[1] * wv; acc[4 * q + 2] += c4[2] * wv; acc[4 * q + 3] += c4[3] * wv; }
        }
#pragma unroll
        for (int b = 0; b < 32; ++b) { acc[b] = xor32_add(xor16_add(acc[b])); }
        if (kq == 0) { const float bb = b_ada[l * 6 * DM + n];
#pragma unroll
            for (int b = 0; b < 32; ++b) MOD[((size_t)l * BATCH + b) * (6 * DM) + n] = acc[b] + bb; }
    }
    __syncthreads();
}
__device__ __forceinline__ void tr_item(const float* W, size_t ldw, int srccol, bool valid, bf16_t* dst  , int K, LAS float* scr, int lane) {
    const float* wp = W + srccol;
#pragma unroll 8
    for (int i = 0; i < 32; ++i) { const int kk = 2 * i + (lane >> 5); scr[kk * 33 + (lane & 31)] = valid ? wp[(size_t)kk * ldw] : 0.f; }
    LDS_WAIT(); asm volatile("" ::: "memory");
    const int c = lane & 7;
#pragma unroll
    for (int j = 0; j < 4; ++j) { const int n = (lane >> 3) + 8 * j; const LAS float* s = scr + (8 * c) * 33 + n;
        u32x4 o; o.x = cvt_pk_bf16(s[0 * 33], s[1 * 33]); o.y = cvt_pk_bf16(s[2 * 33], s[3 * 33]); o.z = cvt_pk_bf16(s[4 * 33], s[5 * 33]); o.w = cvt_pk_bf16(s[6 * 33], s[7 * 33]);
        *(u32x4*)(dst + (size_t)n * K + 8 * c) = o; }
    LDS_WAIT(); asm volatile("" ::: "memory");
}
__device__ __forceinline__ void p0_weights(const Frame& F, const Args& a) {
    LAS float* scr = (LAS float*)(F.lds + F.wave * 16384);
    const int gw = F.vcu * 8 + F.wave, NGW = F.G * 8, lane = F.lane, jl = lane & 31;
    const float *w_in = a.in[8], *w_branch = a.in[13], *w_out = a.in[14], *w_router = a.in[15], *w1 = a.in[17], *w2 = a.in[19];
    constexpr int I_BR = 3 * 8 * 32, I_OUT = 16 * 32, I_RT = 16;
    constexpr int I_LAYER = I_BR + I_OUT + I_RT;
    for (int it = gw; it < DEPTH * I_LAYER; it += NGW) {
        const int l = it / I_LAYER; int r = it - l * I_LAYER;
        unsigned char* wl = a.ws + WS_W + (size_t)l * W_LAYER;
        if (r < I_BR) {
            const int br = r / 256, q = r % 256, kb = q / 32, nb = q % 32;
            tr_item(w_branch + ((size_t)(l * 3 + br) * 512 + kb * 64) * DM, DM, nb * 32 + jl, true, (bf16_t*)(wl + WO_WBR) + (size_t)(br * 1024 + nb * 32) * 512 + kb * 64, 512, scr, lane); continue; }
        r -= I_BR;
        if (r < I_OUT) {
            const int kb = r / 32, nb = r % 32;
            tr_item(w_out + ((size_t)l * DM + kb * 64) * DM, DM, nb * 32 + jl, true, (bf16_t*)(wl + WO_WOUT) + (size_t)nb * 32 * DM + kb * 64, DM, scr, lane); continue; }
        r -= I_OUT;
        {
            const int kb = r;
            tr_item(w_router + ((size_t)l * DM + kb * 64) * NE, NE, jl, true, (bf16_t*)(a.ws + WS_WRT) + (size_t)l * NE * DM + kb * 64, DM, scr, lane); }
        (void)r;
    }
    __syncthreads();
    {
    LAS float* T = (LAS float*)F.lds; LAS float* red = (LAS float*)(F.lds + ROWIDX_OFF);
    const int half = lane >> 5, wave = F.wave;
    constexpr int ST_W1 = NE * 64, ST_IN = 192, ST_W2 = NE * 32, ST_LAYER = ST_W1 + ST_IN + ST_W2;
    for (int st = F.vcu; st < DEPTH * ST_LAYER; st += F.G) {
        const int l = st / ST_LAYER, q = st % ST_LAYER;
        const float* wp; size_t ldw; bool valid = true; signed char* dst; float* csp;
        if (q < ST_W1) { const int e = q / 64, r6 = q % 64, pn = r6 >> 3, jjg = (r6 >> 1) & 3, sgl = r6 & 1, nb = pn * 8 + sgl * 4 + jjg, n = nb * 32 + jl, src = 2 * (128 * pn + jjg * 32 + jl) + sgl;
            wp = w1 + ((size_t)(l * NE + e) * DM) * (2 * FF) + src; ldw = 2 * FF;
            dst = (signed char*)(a.ws + WS_W + (size_t)l * W_LAYER + WO_W1) + ((size_t)e * 2048 + nb * 32) * DM; csp = (float*)(a.ws + WS_CS1) + ((size_t)l * NE + e) * 2048 + n; }
        else if (q >= ST_W1 + ST_IN) { const int q2 = q - ST_W1 - ST_IN, e = q2 / 32, nb = q2 % 32, n = nb * 32 + jl;
            wp = w2 + ((size_t)(l * NE + e) * FF) * DM + n; ldw = DM;
            dst = (signed char*)(a.ws + WS_W + (size_t)l * W_LAYER + WO_W2) + ((size_t)e * DM + nb * 32) * FF; csp = (float*)(a.ws + WS_CS2) + ((size_t)l * NE + e) * DM + n; }
        else { const int nb = q - ST_W1, n = nb * 32 + jl; valid = (n < 1832) || (n >= 2048); const int src = n < 1832 ? n : n - 216;
            wp = w_in + (size_t)l * DM * 5928 + (valid ? src : 0); ldw = 5928;
            dst = (signed char*)(a.ws + WS_W + (size_t)l * W_LAYER + WO_WIN) + (size_t)nb * 32 * DM; csp = (float*)(a.ws + WS_CSIN) + (size_t)l * NPROJ + n; }
        float am = 0.f;
#pragma unroll
        for (int ib = 0; ib < 2; ++ib) { float vv[32];
#pragma unroll
            for (int i = 0; i < 32; ++i) { const int k = wave * 128 + 2 * (ib * 32 + i) + half; vv[i] = valid ? __builtin_nontemporal_load(wp + (size_t)k * ldw) : 0.f; }
#pragma unroll
            for (int i = 0; i < 32; ++i) { const int k = wave * 128 + 2 * (ib * 32 + i) + half; am = fmaxf(am, fabsf(vv[i])); T[k * 32 + (jl ^ (k & 31))] = vv[i]; } }
        red[(wave * 2 + half) * 32 + jl] = am;
        __syncthreads();
        float amx = 0.f;
#pragma unroll
        for (int p = 0; p < 16; ++p) amx = fmaxf(amx, red[p * 32 + jl]);
        const float scale = valid ? fmaxf(amx, 1e-30f) * (1.f / 127.f) : 1.f, inv = valid ? 1.f / scale : 0.f;
        if (wave == 0 && half == 0) *csp = scale;
        const int k0 = 64 * (wave * 2 + half);
#pragma unroll
        for (int c16 = 0; c16 < 4; ++c16) { unsigned wq[4];
#pragma unroll
            for (int d4 = 0; d4 < 4; ++d4) { const int k = k0 + c16 * 16 + d4 * 4;
                wq[d4] = q8x4(T[k * 32 + (jl ^ (k & 31))], T[(k + 1) * 32 + (jl ^ ((k + 1) & 31))], T[(k + 2) * 32 + (jl ^ ((k + 2) & 31))], T[(k + 3) * 32 + (jl ^ ((k + 3) & 31))], inv); }
            *(u32x4*)(dst + (size_t)jl * DM + k0 + c16 * 16) = (u32x4){wq[0], wq[1], wq[2], wq[3]}; }
        __syncthreads();
    }
    }
    const float* sg_w = a.in[10]; bf16_t* SGW = (bf16_t*)(a.ws + WS_SGW);
    for (int i = (F.vcu * 512 + F.tid) * 2; i < DEPTH * 8 * 128 * 128; i += F.G * 512 * 2) { const int s = i & 127, t = (i >> 7) & 127; const f32x2 v = *(const f32x2*)(sg_w + i);
        *(unsigned*)(SGW + i) = cvt_pk_bf16(s <= t ? v[0] : 0.f, (s + 1) <= t ? v[1] : 0.f); }
}

__device__ __forceinline__ void norm_mod_row(const f32x4 (&v)[4], float ss, const float* g, const float* sc, const float* sh, signed char* orow, float* rs, int lane) {
    const float rstd = 1.f / sqrtf(ss * (1.f / DM) + RMS_EPS);
    f32x4 o[4]; float am = 0.f;
#pragma unroll
    for (int j = 0; j < 4; ++j) { const int c = 4 * lane + 256 * j; const f32x4 gg = *(const f32x4*)(g + c), s1 = *(const f32x4*)(sc + c), s0 = *(const f32x4*)(sh + c);
        o[j] = (v[j] * rstd) * gg * (s1 + 1.f) + s0;
        am = fmaxf(am, fmaxf(fmaxf(fabsf(o[j][0]), fabsf(o[j][1])), fmaxf(fabsf(o[j][2]), fabsf(o[j][3])))); }
    am = wave_max(am);
    const float scale = fmaxf(am, 1e-30f) * (1.f / 127.f), inv = 1.f / scale;
    if (lane == 0) *rs = scale;
#pragma unroll
    for (int j = 0; j < 4; ++j) *(unsigned*)(orow + 4 * lane + 256 * j) = q8x4(o[j][0], o[j][1], o[j][2], o[j][3], inv);
}
__device__ __forceinline__ void p1_norm(const Frame& F, const float* x, const float* g, const float* MOD0, signed char* H8, float* RS, bf16_t* X16) {
    const int gw = F.vcu * 8 + F.wave, NGW = F.G * 8;
    for (int row0 = gw * 4; row0 < MTOK; row0 += NGW * 4) { f32x4 v[4][4];
#pragma unroll
        for (int rr = 0; rr < 4; ++rr)
#pragma unroll
            for (int j = 0; j < 4; ++j) v[rr][j] = __builtin_nontemporal_load((const f32x4*)(x + (size_t)(row0 + rr) * DM + 4 * F.lane + 256 * j));
#pragma unroll
        for (int rr = 0; rr < 4; ++rr) { const int row = row0 + rr, b = row >> 11; float ss = 0.f;
#pragma unroll
            for (int j = 0; j < 4; ++j) ss += (v[rr][j][0] * v[rr][j][0] + v[rr][j][1] * v[rr][j][1]) + (v[rr][j][2] * v[rr][j][2] + v[rr][j][3] * v[rr][j][3]);
            ss = wave_sum(ss);
#pragma unroll
            for (int j = 0; j < 4; ++j) { u32x2 w; w.x = cvt_pk_bf16(v[rr][j][0], v[rr][j][1]); w.y = cvt_pk_bf16(v[rr][j][2], v[rr][j][3]); *(u32x2*)(X16 + (size_t)row * DM + 4 * F.lane + 256 * j) = w; }
            const float* mb = MOD0 + (size_t)b * 6 * DM;
            norm_mod_row(v[rr], ss, g, mb + DM, mb, H8 + (size_t)row * DM, RS + row, F.lane); } }
}
constexpr int TOPK_SEL = 256;
struct IdxOps { bf16x8 af[4][2]; u32x4 wraw[4][2]; bf16x8 kf[4][2]; };
__device__ __forceinline__ void dsa_index_load(IdxOps& P, const bf16_t* __restrict__ PROJ, int b, int qg, int lane, int wid) {
    asm volatile("" : "+v"(lane));
    const int n = lane & 31, hi = lane >> 5;
    const int q0 = qg * 16;
    const size_t tokbase = (size_t)b * SEQ;
    const int m = n, hm = (m >> 2) & 1, idx = (m & 3) + 4 * (m >> 3), aq = 2 * hm + (idx >> 3), ah = idx & 7;
#pragma unroll
    for (int qgp = 0; qgp < 4; ++qgp) { const bf16_t* qp = PROJ + (tokbase + q0 + 4 * qgp + aq) * PLD + C_QI + ah * 32 + 8 * hi;
        P.af[qgp][0] = *(const bf16x8*)qp; P.af[qgp][1] = *(const bf16x8*)(qp + 16); }
}
__device__ __forceinline__ void dsa_index_load_k(IdxOps& P, const bf16_t* __restrict__ PROJ, int b, int qg, int lane, int wid) {
    asm volatile("" : "+v"(lane));
    const int n = lane & 31, hi = lane >> 5;
    const int q0 = qg * 16, nkb = (q0 + 16 + 31) >> 5;
    const size_t tokbase = (size_t)b * SEQ;
#pragma unroll
    for (int qgp = 0; qgp < 4; ++qgp)
#pragma unroll
        for (int qq = 0; qq < 2; ++qq) P.wraw[qgp][qq] = *(const u32x4*)(PROJ + (tokbase + q0 + 4 * qgp + 2 * hi + qq) * PLD + C_WI);
#pragma unroll
    for (int i = 0; i < 4; ++i) { const int kb = wid + 8 * i;
        if (kb < nkb) { const bf16_t* kp = PROJ + (tokbase + 32 * kb + n) * PLD + C_KI + 8 * hi; P.kf[i][0] = *(const bf16x8*)kp; P.kf[i][1] = *(const bf16x8*)(kp + 16); } }
}
__device__ __forceinline__ void dsa_index_scores(IdxOps& P, const bf16_t* __restrict__ PROJ, LAS float* sc, int b, int qg, int lane, int wid) {
    const int n = lane & 31, hi = lane >> 5;
    const int q0 = qg * 16, nkb = (q0 + 16 + 31) >> 5;
    const size_t tokbase = (size_t)b * SEQ;
    LAS float* scw = sc + (2 * hi) * 2048 + 32 * wid + n;
    float wv[4][16];
#pragma unroll
    for (int qgp = 0; qgp < 4; ++qgp)
#pragma unroll
        for (int qq = 0; qq < 2; ++qq) { const u32x4 w = P.wraw[qgp][qq];
            wv[qgp][8 * qq + 0] = bf_lo(w.x) * 0.0625f; wv[qgp][8 * qq + 1] = bf_hi(w.x) * 0.0625f; wv[qgp][8 * qq + 2] = bf_lo(w.y) * 0.0625f; wv[qgp][8 * qq + 3] = bf_hi(w.y) * 0.0625f;
            wv[qgp][8 * qq + 4] = bf_lo(w.z) * 0.0625f; wv[qgp][8 * qq + 5] = bf_hi(w.z) * 0.0625f; wv[qgp][8 * qq + 6] = bf_lo(w.w) * 0.0625f; wv[qgp][8 * qq + 7] = bf_hi(w.w) * 0.0625f; }
#pragma unroll
    for (int i = 0; i < 8; ++i) { const int kb = wid + 8 * i;
        if (kb < nkb) {
            const bf16x8 k0 = P.kf[i & 3][0], k1 = P.kf[i & 3][1];
            if (i < 4 && kb + 32 < nkb) { const bf16_t* kp = PROJ + (tokbase + 32 * (kb + 32) + n) * PLD + C_KI + 8 * hi; P.kf[i & 3][0] = *(const bf16x8*)kp; P.kf[i & 3][1] = *(const bf16x8*)(kp + 16); }
#pragma unroll
            for (int qgp = 0; qgp < 4; ++qgp) {
                f32x16 d = {0.f, 0.f, 0.f, 0.f, 0.f, 0.f, 0.f, 0.f, 0.f, 0.f, 0.f, 0.f, 0.f, 0.f, 0.f, 0.f};
                d = __builtin_amdgcn_mfma_f32_32x32x16_bf16(P.af[qgp][0], k0, d, 0, 0, 0);
                d = __builtin_amdgcn_mfma_f32_32x32x16_bf16(P.af[qgp][1], k1, d, 0, 0, 0);
                float sa = 0.f, sb = 0.f;
#pragma unroll
                for (int r = 0; r < 8; ++r) { sa += wv[qgp][r] * fmaxf(d[r], 0.f); sb += wv[qgp][8 + r] * fmaxf(d[8 + r], 0.f); }
                scw[(4 * qgp) * 2048 + 256 * i] = sa; scw[(4 * qgp + 1) * 2048 + 256 * i] = sb;
            } } }
}
__device__ __forceinline__ void bit_transpose32(unsigned (&a)[32]) {
#pragma unroll
    for (int k = 0; k < 16; ++k) { const unsigned lo = a[k], hi = a[k + 16];
        a[k] = __builtin_amdgcn_perm(hi, lo, 0x05040100u); a[k + 16] = __builtin_amdgcn_perm(hi, lo, 0x07060302u); }
#pragma unroll
    for (int k = 0; k < 32; ++k) if ((k & 8) == 0) { const unsigned lo = a[k], hi = a[k + 8];
        a[k] = __builtin_amdgcn_perm(hi, lo, 0x06020400u); a[k + 8] = __builtin_amdgcn_perm(hi, lo, 0x07030501u); }
#pragma unroll
    for (int s = 0; s < 3; ++s) { const int j = 4 >> s; const unsigned m = (s == 0) ? 0x0F0F0F0Fu : (s == 1) ? 0x33333333u : 0x55555555u;
#pragma unroll
        for (int k = 0; k < 32; ++k) if ((k & j) == 0) { const unsigned lo = a[k], hi = a[k + j];
            a[k] = (m & lo) | (~m & (hi << j)); a[k + j] = (m & (lo >> j)) | (~m & hi); } }
}
__device__ __forceinline__ void dsa_index_select(LAS float* sc, LAS int* qctr, unsigned long long* __restrict__ bits64, int b, int qg, int lane, int wid) {
    const int q0 = qg * 16;
    const size_t tokbase = (size_t)b * SEQ;
#pragma unroll 1
    for (;;) {
        int qn = 0; if (lane == 0) qn = __hip_atomic_fetch_add(qctr, 1, __ATOMIC_RELAXED, __HIP_MEMORY_SCOPE_WORKGROUP);
        qn = __builtin_amdgcn_readfirstlane(qn); if (qn >= 16) break;
        const int ql = 15 - qn, pos = q0 + ql, nn = pos + 1, nr = (nn + 63) >> 6;
        const LAS float* scq = sc + ql * 2048;
        unsigned mlo = 0u, mhi = 0u;
        if (nn <= TOPK_SEL) {
#pragma unroll
            for (int r = 0; r < 4; ++r) if (r < nr) { const unsigned long long bal = __ballot(64 * r + lane <= pos); asm volatile("s_nop 4\n\tv_writelane_b32 %0, %2, %4\n\tv_writelane_b32 %1, %3, %4" : "+v"(mlo), "+v"(mhi) : "s"((unsigned)bal), "s"((unsigned)(bal >> 32)), "n"(r));     }
        } else {
            unsigned u[32];
#pragma unroll
            for (int r = 0; r < 32; ++r) u[r] = 0u;
#pragma unroll
            for (int g8 = 0; g8 < 4; ++g8) if (8 * g8 < nr) {
#pragma unroll
                for (int q_ = 0; q_ < 8; ++q_) { const int r = 8 * g8 + q_; const int j = 64 * r + lane; float s = scq[j]; s = (s == 0.f) ? 0.f : s; const unsigned bts = __builtin_bit_cast(unsigned, s);
                    const unsigned uu = (bts & 0x80000000u) ? ~bts : (bts | 0x80000000u); u[r] = (j <= pos) ? uu : 0u; } }
            unsigned M = 0u;
#pragma unroll
            for (int r = 0; r < 32; ++r) M |= (64 * r + lane <= pos) ? (1u << r) : 0u;
            bit_transpose32(u);
            unsigned G = 0u; unsigned need = (unsigned)TOPK_SEL, cM = (unsigned)nn;
            {
#pragma unroll
            for (int bq = 31; bq >= 0; --bq) {
                const unsigned T = M & u[bq];
                const unsigned c = wave_sum_u32((unsigned)__builtin_popcount(T));
                const bool ge = c >= need;
                G |= ge ? 0u : T; M = ge ? T : (M & ~u[bq]); cM = ge ? c : cM - c; need -= ge ? 0u : c;
                if (cM == need) { G |= M; goto sel_done; }
            }
            unsigned run = 0u;
#pragma unroll
            for (int r = 0; r < 32; ++r) if (r < nr) { const bool isc = (M >> r) & 1u; const unsigned long long eqm = __ballot(isc);
                const unsigned pre = run + __builtin_amdgcn_mbcnt_hi((unsigned)(eqm >> 32), __builtin_amdgcn_mbcnt_lo((unsigned)eqm, 0u));
                if (isc && pre < need) G |= (1u << r);
                run += (unsigned)__builtin_popcountll(eqm); }
            }
            sel_done:
#pragma unroll
            for (int r = 0; r < 32; ++r) if ((r & ~7) < nr) { const unsigned long long bal = __ballot((G >> r) & 1u); asm volatile("s_nop 4\n\tv_writelane_b32 %0, %2, %4\n\tv_writelane_b32 %1, %3, %4" : "+v"(mlo), "+v"(mhi) : "s"((unsigned)bal), "s"((unsigned)(bal >> 32)), "n"(r));     }
        }
        if (lane < nr) bits64[(tokbase + pos) * 32 + lane] = ((unsigned long long)mhi << 32) | mlo;
    }
}
__device__ __forceinline__ void dsa_index_phase(const Frame& F, const bf16_t* __restrict__ PROJ, unsigned long long* __restrict__ bits64, unsigned* stampw) {
    LAS float* sc = (LAS float*)F.lds;
    LAS int* qctr = (LAS int*)(F.lds + TS_OFF);
    IdxOps P;
    int u = F.vcu;
    if (u < 4096) { dsa_index_load(P, PROJ, u & 31, u >> 5, F.lane, F.wave); dsa_index_load_k(P, PROJ, u & 31, u >> 5, F.lane, F.wave); }
#ifdef T_STAMP
    unsigned long long tA = 0, tB = 0, tC = 0, tD = 0, t0 = __builtin_amdgcn_s_memrealtime(), t1;
#define STAMP(acc) do { t1 = __builtin_amdgcn_s_memrealtime(); acc += t1 - t0; t0 = t1; } while (0)
#else
#define STAMP(acc) do { } while (0)
#endif
#pragma unroll 1
    for (; u < 4096; u += F.G) {
        dsa_index_scores(P, PROJ, sc, u & 31, u >> 5, F.lane, F.wave);
        if (F.tid == 0) *qctr = 0;
        STAMP(tA);
        __syncthreads();
        STAMP(tB);
        const int un = u + F.G;
        dsa_index_select(sc, qctr, bits64, u & 31, u >> 5, F.lane, F.wave);
        asm volatile("" ::: "memory");
        if (un < 4096) { dsa_index_load(P, PROJ, un & 31, un >> 5, F.lane, F.wave); dsa_index_load_k(P, PROJ, un & 31, un >> 5, F.lane, F.wave); }
        STAMP(tC);
        __syncthreads();
        STAMP(tD);
    }
#ifdef T_STAMP
    if (stampw && blockIdx.x == 17 && F.tid == 0) { const unsigned long long tot = tA + tB + tC + tD; const unsigned long long part = (T_STAMP == 0) ? tA : (T_STAMP == 1) ? tB : (T_STAMP == 2) ? tC : tD;
        *stampw = (unsigned)((part * 64ull) / (tot ? tot : 1ull)); }
#endif
#undef STAMP
}

constexpr int KS = 144, VS = 192;
#ifndef USE_TR
#define USE_TR 1
#endif
template <int MODE>
__device__ __forceinline__ void attn_unit(const Frame& F, const bf16_t* __restrict__ PROJ, bf16_t* __restrict__ O, const unsigned* __restrict__ bits, const float* __restrict__ sinks, int b, int g, int qb) {
    const int tid = F.tid, lane = F.lane, wid = F.wave, n = lane & 31, hi = lane >> 5;
    constexpr int CQ = MODE ? C_QB : C_QA, CK = MODE ? C_KB : C_KA, CV = MODE ? C_VB : C_VA;
    const int hq = 4 * g + (wid >> 1), qpos = qb * 64 + 32 * (wid & 1) + n;
    const size_t tokbase = (size_t)b * SEQ;
    LAS unsigned char* Ks = F.lds; LAS unsigned char* Vs = F.lds + 64 * KS;
    bf16x8 qf[4];
    { const bf16_t* qp = PROJ + (tokbase + qpos) * PLD + CQ + hq * 64 + 8 * hi;
#pragma unroll
      for (int s = 0; s < 4; ++s) qf[s] = *(const bf16x8*)(qp + 16 * s); }
    f32x16 o0, o1;
#pragma unroll
    for (int r = 0; r < 16; ++r) { o0[r] = 0.f; o1[r] = 0.f; }
    float mrun, lsum;
    if (MODE == 0) { mrun = sinks[hq] * LOG2E; lsum = (hi == 0) ? 1.f : 0.f; } else { mrun = -1e30f; lsum = 0.f; }
    const int kt_lo = (MODE == 0) ? (qb >= 2 ? qb - 2 : 0) : 0, kt_hi = qb;
    const int srow = tid >> 3, sch = tid & 7;
    const bf16_t* kg = PROJ + (tokbase + srow) * PLD + CK + g * 64 + sch * 8;
    const bf16_t* vg = PROJ + (tokbase + srow) * PLD + CV + g * 64 + sch * 8;
    const unsigned* bp = bits + (tokbase + qpos) * 64;
    u32x4 kreg = *(const u32x4*)(kg + (size_t)kt_lo * 64 * PLD), vreg = *(const u32x4*)(vg + (size_t)kt_lo * 64 * PLD);
    u32x2 mreg = {0u, 0u};
    if (MODE == 1) mreg = *(const u32x2*)(bp + 2 * kt_lo);
    const int vbase = (4 * hi + ((lane & 15) >> 2)) * VS + (16 * ((lane >> 4) & 1) + 4 * (lane & 3)) * 2;
    for (int kt = kt_lo; kt <= kt_hi; ++kt) {
        __syncthreads();
        *(LAS u32x4*)(Ks + srow * KS + sch * 16) = kreg; *(LAS u32x4*)(Vs + srow * VS + sch * 16) = vreg;
        const u32x2 mcur = mreg;
        __syncthreads();
        if (kt < kt_hi) { kreg = *(const u32x4*)(kg + (size_t)(kt + 1) * 64 * PLD); vreg = *(const u32x4*)(vg + (size_t)(kt + 1) * 64 * PLD); if (MODE == 1) mreg = *(const u32x2*)(bp + 2 * (kt + 1)); }
        f32x16 p0, p1;
#pragma unroll
        for (int r = 0; r < 16; ++r) { p0[r] = 0.f; p1[r] = 0.f; }
#pragma unroll
        for (int s = 0; s < 4; ++s) { const bf16x8 k0 = *(const LAS bf16x8*)(Ks + n * KS + (16 * s + 8 * hi) * 2), k1 = *(const LAS bf16x8*)(Ks + (n + 32) * KS + (16 * s + 8 * hi) * 2);
            p0 = __builtin_amdgcn_mfma_f32_32x32x16_bf16(k0, qf[s], p0, 0, 0, 0); p1 = __builtin_amdgcn_mfma_f32_32x32x16_bf16(k1, qf[s], p1, 0, 0, 0); }
        unsigned w0, w1;
        if (MODE == 1) { w0 = mcur.x >> (4 * hi); w1 = mcur.y >> (4 * hi); }
        else {
#pragma unroll
            for (int blk = 0; blk < 2; ++blk) { const int d0 = qpos - (kt * 64 + 32 * blk); unsigned mk = 0u;
                if (d0 >= 0) { const int hb = d0 > 31 ? 31 : d0; int lo = d0 - 127; if (lo <= 31) { if (lo < 0) lo = 0; mk = (0xFFFFFFFFu >> (31 - hb)) & (0xFFFFFFFFu << lo); } }
                if (blk == 0) w0 = mk >> (4 * hi); else w1 = mk >> (4 * hi); }
        }
        float mx = fmaxf(fmaxf(p0[0], p0[1]), fmaxf(p1[0], p1[1]));
#pragma unroll
        for (int r = 2; r < 16; r += 2) mx = fmaxf(mx, fmaxf(fmaxf(p0[r], p0[r + 1]), fmaxf(p1[r], p1[r + 1])));
        mx = xor32_max(mx);
        const float mnew = fmaxf(mrun, mx), alpha = fexp2(mrun - mnew); mrun = mnew;
        float ps = 0.f;
#pragma unroll
        for (int r = 0; r < 16; ++r) { const int bitpos = 8 * (r >> 2) + (r & 3);
            const float e0 = fexp2(p0[r] - mnew), e1 = fexp2(p1[r] - mnew);
            p0[r] = __builtin_bit_cast(float, __builtin_bit_cast(unsigned, e0) & (unsigned)__builtin_amdgcn_sbfe((int)w0, bitpos, 1));
            p1[r] = __builtin_bit_cast(float, __builtin_bit_cast(unsigned, e1) & (unsigned)__builtin_amdgcn_sbfe((int)w1, bitpos, 1));
            ps += p0[r] + p1[r]; }
        lsum = lsum * alpha + ps;
        if (__builtin_amdgcn_ballot_w64(alpha != 1.f) != 0ull) {
#pragma unroll
            for (int r = 0; r < 16; ++r) { o0[r] *= alpha; o1[r] *= alpha; } }
        bf16x8 pf[2][2];
#pragma unroll
        for (int s2 = 0; s2 < 2; ++s2) { u32x4 a, c;
            a.x = cvt_pk_bf16(p0[8 * s2 + 0], p0[8 * s2 + 1]); a.y = cvt_pk_bf16(p0[8 * s2 + 2], p0[8 * s2 + 3]); a.z = cvt_pk_bf16(p0[8 * s2 + 4], p0[8 * s2 + 5]); a.w = cvt_pk_bf16(p0[8 * s2 + 6], p0[8 * s2 + 7]);
            c.x = cvt_pk_bf16(p1[8 * s2 + 0], p1[8 * s2 + 1]); c.y = cvt_pk_bf16(p1[8 * s2 + 2], p1[8 * s2 + 3]); c.z = cvt_pk_bf16(p1[8 * s2 + 4], p1[8 * s2 + 5]); c.w = cvt_pk_bf16(p1[8 * s2 + 6], p1[8 * s2 + 7]);
            pf[0][s2] = __builtin_bit_cast(bf16x8, a); pf[1][s2] = __builtin_bit_cast(bf16x8, c); }
#pragma unroll
        for (int db = 0; db < 2; ++db)
#pragma unroll
            for (int blk = 0; blk < 2; ++blk)
#pragma unroll
                for (int s2 = 0; s2 < 2; ++s2) {
                    bf16x8 vf;
#if USE_TR
                    const v4i16_t t0 = __builtin_amdgcn_ds_read_tr16_b64_v4i16((LAS v4i16_t*)(Vs + vbase + (32 * blk + 16 * s2) * VS + 64 * db));
                    const v4i16_t t1 = __builtin_amdgcn_ds_read_tr16_b64_v4i16((LAS v4i16_t*)(Vs + vbase + (32 * blk + 16 * s2 + 8) * VS + 64 * db));
                    vf = (bf16x8){t0[0], t0[1], t0[2], t0[3], t1[0], t1[1], t1[2], t1[3]};
#else
#pragma unroll
                    for (int j = 0; j < 8; ++j) vf[j] = *(const LAS short*)(Vs + (32 * blk + 16 * s2 + 8 * (j >> 2) + 4 * hi + (j & 3)) * VS + (32 * db + n) * 2);
#endif
                    if (db == 0) o0 = __builtin_amdgcn_mfma_f32_32x32x16_bf16(vf, pf[blk][s2], o0, 0, 0, 0); else o1 = __builtin_amdgcn_mfma_f32_32x32x16_bf16(vf, pf[blk][s2], o1, 0, 0, 0);
                }
    }
    const float lt = xor32_add(lsum), inv = 1.f / lt;
    bf16_t* op = O + (tokbase + qpos) * 512 + hq * 64 + 8 * hi;
#pragma unroll
    for (int db = 0; db < 2; ++db)
#pragma unroll
        for (int kp = 0; kp < 2; ++kp) { const int r0 = 8 * kp;
            unsigned ax, ay, bx, by;
            if (db == 0) { ax = cvt_pk_bf16(o0[r0] * inv, o0[r0 + 1] * inv); ay = cvt_pk_bf16(o0[r0 + 2] * inv, o0[r0 + 3] * inv); bx = cvt_pk_bf16(o0[r0 + 4] * inv, o0[r0 + 5] * inv); by = cvt_pk_bf16(o0[r0 + 6] * inv, o0[r0 + 7] * inv); }
            else { ax = cvt_pk_bf16(o1[r0] * inv, o1[r0 + 1] * inv); ay = cvt_pk_bf16(o1[r0 + 2] * inv, o1[r0 + 3] * inv); bx = cvt_pk_bf16(o1[r0 + 4] * inv, o1[r0 + 5] * inv); by = cvt_pk_bf16(o1[r0 + 6] * inv, o1[r0 + 7] * inv); }
            { auto r = __builtin_amdgcn_permlane32_swap(ax, bx, false, false); ax = r[0]; bx = r[1]; }
            { auto r = __builtin_amdgcn_permlane32_swap(ay, by, false, false); ay = r[0]; by = r[1]; }
            *(u32x4*)(op + 32 * db + 16 * kp) = (u32x4){ax, ay, bx, by}; }
}

constexpr int SGS = 1040;
static_assert(128 * SGS <= MISC_OFF, "spatial-gating tile vs LDS control words");
__device__ __forceinline__ void sg_unit(const Frame& F, const bf16_t* __restrict__ PROJ, const bf16_t* __restrict__ SGWl, const float* __restrict__ sgb, const float* __restrict__ lng, bf16_t* __restrict__ OC, int b, int ch) {
    const int lane = F.lane, wid = F.wave, n = lane & 31, hi = lane >> 5;
    const size_t tok0 = (size_t)b * SEQ + ch * 128;
    LAS unsigned char* V = F.lds;
    __syncthreads();
    float gl[8];
    { const f32x4 g0 = *(const f32x4*)(lng + 8 * lane), g1 = *(const f32x4*)(lng + 8 * lane + 4); gl[0] = g0[0]; gl[1] = g0[1]; gl[2] = g0[2]; gl[3] = g0[3]; gl[4] = g1[0]; gl[5] = g1[1]; gl[6] = g1[2]; gl[7] = g1[3]; }
    u32x4 wrow16[16];
#pragma unroll
    for (int rr = 0; rr < 16; ++rr) wrow16[rr] = *(const u32x4*)(PROJ + (tok0 + 16 * wid + rr) * PLD + C_V + 8 * lane);
#pragma unroll
    for (int rr = 0; rr < 16; ++rr) { const int row = 16 * wid + rr;
        const u32x4 w = wrow16[rr];
        float x[8] = {bf_lo(w.x), bf_hi(w.x), bf_lo(w.y), bf_hi(w.y), bf_lo(w.z), bf_hi(w.z), bf_lo(w.w), bf_hi(w.w)};
        float s = 0.f;
#pragma unroll
        for (int i = 0; i < 8; ++i) s += x[i];
        const float mean = wave_sum(s) * (1.f / 512.f); float q = 0.f;
#pragma unroll
        for (int i = 0; i < 8; ++i) { x[i] -= mean; q += x[i] * x[i]; }
        const float rstd = 1.f / sqrtf(wave_sum(q) * (1.f / 512.f) + LN_EPS);
        u32x4 o; o.x = cvt_pk_bf16(x[0] * rstd * gl[0], x[1] * rstd * gl[1]); o.y = cvt_pk_bf16(x[2] * rstd * gl[2], x[3] * rstd * gl[3]);
        o.z = cvt_pk_bf16(x[4] * rstd * gl[4], x[5] * rstd * gl[5]); o.w = cvt_pk_bf16(x[6] * rstd * gl[6], x[7] * rstd * gl[7]);
        *(LAS u32x4*)(V + row * SGS + 16 * lane) = o; }
    __syncthreads();
    const int g = wid;
    const int vbase = (8 * hi + ((lane & 15) >> 2)) * SGS + (g * 64 + 16 * ((lane >> 4) & 1) + 4 * (lane & 3)) * 2;
    const bf16_t* wg = SGWl + (size_t)g * 128 * 128;
#pragma unroll 1
    for (int tb = 0; tb < 4; ++tb) {
        f32x16 a0, a1;
#pragma unroll
        for (int r = 0; r < 16; ++r) { a0[r] = 0.f; a1[r] = 0.f; }
        const bf16_t* wrow = wg + (size_t)(32 * tb + n) * 128 + 8 * hi;
        bf16x8 afr[8];
#pragma unroll
        for (int ks = 0; ks < 8; ++ks) if (ks < 2 * tb + 2) afr[ks] = *(const bf16x8*)(wrow + 16 * ks);
#pragma unroll
        for (int ks = 0; ks < 8; ++ks) if (ks < 2 * tb + 2) {
            const bf16x8 af = afr[ks];
#pragma unroll
            for (int db = 0; db < 2; ++db) { bf16x8 vf;
#if USE_TR
                const v4i16_t t0 = __builtin_amdgcn_ds_read_tr16_b64_v4i16((LAS v4i16_t*)(V + vbase + (16 * ks) * SGS + 64 * db));
                const v4i16_t t1 = __builtin_amdgcn_ds_read_tr16_b64_v4i16((LAS v4i16_t*)(V + vbase + (16 * ks + 4) * SGS + 64 * db));
                vf = (bf16x8){t0[0], t0[1], t0[2], t0[3], t1[0], t1[1], t1[2], t1[3]};
#else
#pragma unroll
                for (int j = 0; j < 8; ++j) vf[j] = *(const LAS short*)(V + (16 * ks + 8 * hi + j) * SGS + (g * 64 + 32 * db + n) * 2);
#endif
                if (db == 0) a0 = __builtin_amdgcn_mfma_f32_32x32x16_bf16(af, vf, a0, 0, 0, 0); else a1 = __builtin_amdgcn_mfma_f32_32x32x16_bf16(af, vf, a1, 0, 0, 0); }
        }
#pragma unroll
        for (int r = 0; r < 16; ++r) { const int t = 32 * tb + 8 * (r >> 2) + 4 * hi + (r & 3); const float bb = sgb[g * 128 + t];
            const bf16_t* up = PROJ + (tok0 + t) * PLD + C_U + g * 64 + n; bf16_t* op = OC + (tok0 + t) * 512 + g * 64 + n;
            const float u0 = __builtin_bit_cast(float, (unsigned)up[0] << 16), u1 = __builtin_bit_cast(float, (unsigned)up[32] << 16);
            op[0] = (bf16_t)f2bf((a0[r] + bb) * u0); op[32] = (bf16_t)f2bf((a1[r] + bb) * u1); }
    }
}
constexpr int HS_STRIDE = 2064;
constexpr int P7_PART = 32 * HS_STRIDE;
constexpr int P7_LOG = P7_PART + 8 * 4096;
constexpr int P7_HIST = P7_LOG + 32 * 33 * 4;
__device__ __forceinline__ void p7_route(const Frame& F, const Args& a, int l, bf16_t* X16  , const bf16_t* Y, const float* SSP, const float* MODl, signed char* H8, float* RS,
                                         const bf16_t* WRTl, unsigned* cnt, int* ROWTOK, unsigned* TOKINFO) {
    const int tid = F.tid, lane = F.lane, wid = F.wave, n = lane & 31, hi = lane >> 5;
    const float* g_post = a.in[5] + l * DM; const float* g_pre = a.in[6] + l * DM; const float* b_router = a.in[16] + l * NE;
    LAS unsigned char* hs = F.lds; LAS float* part = (LAS float*)(F.lds + P7_PART); LAS float* lg = (LAS float*)(F.lds + P7_LOG); LAS int* hist = (LAS int*)(F.lds + P7_HIST); LAS int* base = hist + 32;
    if (tid < 32) hist[tid] = 0;
    __syncthreads();
    for (int bt = F.vcu; bt < MTOK / 32; bt += F.G) {
        const int row0 = bt * 32, b = row0 >> 11;
        const float* mb = MODl + (size_t)b * 6 * DM;
        u32x2 yv[4][4], xv[4][4]; f32x4 s4v[4];
#pragma unroll
        for (int rr = 0; rr < 4; ++rr) { const size_t row = (size_t)row0 + 4 * wid + rr; s4v[rr] = *(const f32x4*)(SSP + row * 16 + 4 * (lane & 3));
#pragma unroll
            for (int j = 0; j < 4; ++j) { const int c = 4 * lane + 256 * j; yv[rr][j] = __builtin_nontemporal_load((const u32x2*)(Y + row * DM + c)); xv[rr][j] = __builtin_nontemporal_load((const u32x2*)(X16 + row * DM + c)); } }
#pragma unroll
        for (int rr = 0; rr < 4; ++rr) { const int rl = 4 * wid + rr; const size_t row = (size_t)row0 + rl;
            const f32x4 s4 = s4v[rr];
            float ssy = (s4[0] + s4[1]) + (s4[2] + s4[3]); ssy = quad_sum(ssy);
            const float rstd1 = 1.f / sqrtf(ssy * (1.f / DM) + RMS_EPS);
            f32x4 v[4]; float ss = 0.f;
#pragma unroll
            for (int j = 0; j < 4; ++j) { const int c = 4 * lane + 256 * j; const u32x2 yw_ = yv[rr][j]; const u32x2 xw_ = xv[rr][j]; const f32x4 yy = {bf_lo(yw_.x), bf_hi(yw_.x), bf_lo(yw_.y), bf_hi(yw_.y)}, xx = {bf_lo(xw_.x), bf_hi(xw_.x), bf_lo(xw_.y), bf_hi(xw_.y)};
                const f32x4 gp = *(const f32x4*)(g_post + c), ga = *(const f32x4*)(mb + 2 * DM + c);
                v[j] = xx + ga * (yy * rstd1 * gp); { u32x2 xo; xo.x = cvt_pk_bf16(v[j][0], v[j][1]); xo.y = cvt_pk_bf16(v[j][2], v[j][3]); *(u32x2*)(X16 + row * DM + c) = xo; }
                ss += (v[j][0] * v[j][0] + v[j][1] * v[j][1]) + (v[j][2] * v[j][2] + v[j][3] * v[j][3]); }
            ss = wave_sum(ss);
            const float rstd = 1.f / sqrtf(ss * (1.f / DM) + RMS_EPS);
            f32x4 o[4]; float am = 0.f;
#pragma unroll
            for (int j = 0; j < 4; ++j) { const int c = 4 * lane + 256 * j; const f32x4 gg = *(const f32x4*)(g_pre + c), s1 = *(const f32x4*)(mb + 4 * DM + c), s0 = *(const f32x4*)(mb + 3 * DM + c);
                o[j] = (v[j] * rstd) * gg * (s1 + 1.f) + s0; u32x2 w; w.x = cvt_pk_bf16(o[j][0], o[j][1]); w.y = cvt_pk_bf16(o[j][2], o[j][3]);
                *(LAS u32x2*)(hs + rl * HS_STRIDE + c * 2) = w;
                am = fmaxf(am, fmaxf(fmaxf(fabsf(o[j][0]), fabsf(o[j][1])), fmaxf(fabsf(o[j][2]), fabsf(o[j][3])))); }
            am = wave_max(am);
            const float scale = fmaxf(am, 1e-30f) * (1.f / 127.f), inv = 1.f / scale;
            if (lane == 0) RS[row] = scale;
#pragma unroll
            for (int j = 0; j < 4; ++j) *(unsigned*)(H8 + row * DM + 4 * lane + 256 * j) = q8x4(o[j][0], o[j][1], o[j][2], o[j][3], inv); }
        __syncthreads();
        {
            f32x16 d;
#pragma unroll
            for (int r = 0; r < 16; ++r) d[r] = 0.f;
#pragma unroll
            for (int ks = 0; ks < 8; ++ks) { const int k0 = (8 * wid + ks) * 16 + 8 * hi;
                const bf16x8 af = *(const LAS bf16x8*)(hs + n * HS_STRIDE + k0 * 2); const bf16x8 bf = *(const bf16x8*)(WRTl + (size_t)n * DM + k0);
                d = __builtin_amdgcn_mfma_f32_32x32x16_bf16(af, bf, d, 0, 0, 0); }
#pragma unroll
            for (int r = 0; r < 16; ++r) part[wid * 1024 + (8 * (r >> 2) + 4 * hi + (r & 3)) * 32 + n] = d[r];
        }
        __syncthreads();
        for (int i = tid; i < 1024; i += 512) { float s = b_router[i & 31];
#pragma unroll
            for (int w = 0; w < 8; ++w) s += part[w * 1024 + i]; lg[(i >> 5) * 33 + (i & 31)] = s; }
        __syncthreads();
        int e_k[4] = {0, 0, 0, 0}, lp_k[4] = {0, 0, 0, 0}; float w_k[4] = {0.f, 0.f, 0.f, 0.f};
        if (tid < 32) { LAS float* mylg = lg + tid * 33; float tl[4];
#pragma unroll
            for (int k = 0; k < 4; ++k) { float best = -INFINITY; int bi = 0;
                for (int e = 0; e < 32; ++e) { const float vv = mylg[e]; if (vv > best) { best = vv; bi = e; } }
                tl[k] = best; e_k[k] = bi; mylg[bi] = -INFINITY; }
            float sum = 0.f;
#pragma unroll
            for (int k = 0; k < 4; ++k) { w_k[k] = __expf(tl[k] - tl[0]); sum += w_k[k]; }
            const float inv = 1.f / sum;
#pragma unroll
            for (int k = 0; k < 4; ++k) { w_k[k] *= inv; lp_k[k] = __hip_atomic_fetch_add(&hist[e_k[k]], 1, __ATOMIC_RELAXED, __HIP_MEMORY_SCOPE_WORKGROUP); } }
        __syncthreads();
        if (tid < 32) { const int hc = hist[tid]; base[tid] = hc > 0 ? (int)__hip_atomic_fetch_add(cnt + 64 * tid, (unsigned)hc, __ATOMIC_RELAXED, __HIP_MEMORY_SCOPE_AGENT) : 0; hist[tid] = 0; }
        __syncthreads();
        if (tid < 32) { const int token = row0 + tid; u32x4 info; f32x4 ww;
#pragma unroll
            for (int k = 0; k < 4; ++k) { const int pos = base[e_k[k]] + lp_k[k]; ROWTOK[e_k[k] * 65536 + pos] = token; info[k] = ((unsigned)e_k[k] << 17) | (unsigned)pos; ww[k] = w_k[k]; }
            *(u32x4*)(TOKINFO + (size_t)token * 8) = info; *(f32x4*)(TOKINFO + (size_t)token * 8 + 4) = ww; }
        __syncthreads();
    }
}

__device__ __forceinline__ int moe_tables(const Frame& F, unsigned* cnt) {
    LAS int* ts = (LAS int*)(F.lds + TS_OFF); LAS int* te = (LAS int*)(F.lds + TILE_E_OFF);
    __syncthreads();
    if (F.tid == 0) { int acc = 0; for (int e = 0; e < NE; ++e) { ts[e] = acc; const unsigned c = __hip_atomic_load(cnt + 64 * e, __ATOMIC_RELAXED, __HIP_MEMORY_SCOPE_AGENT); acc += (int)((c + 255u) >> 8); } ts[NE] = acc; }
    __syncthreads();
    const int RT = ts[NE];
    for (int rt = F.tid; rt < RT; rt += 512) { int e = 0;
#pragma unroll 1
        for (int q = 1; q < NE; ++q) e += (ts[q] <= rt) ? 1 : 0;
        te[rt] = e; }
    __syncthreads();
    return RT;
}

__device__ __forceinline__ void p10_combine(const Frame& F, const Args& a, int l, bf16_t* X16, float* out, const bf16_t* Y2, const unsigned* TOKINFO, const float* MODbase, signed char* H8, float* RS) {
    const int lane = F.lane; const LAS int* ts = (const LAS int*)(F.lds + TS_OFF);
    const float* g_postf = a.in[7] + l * DM;
    const int gw = F.vcu * 8 + F.wave, NGW = F.G * 8;
    for (int rowp = gw * 2; rowp < MTOK; rowp += NGW * 2) {
        u32x4 info[2]; f32x4 ww[2]; u32x2 yw[2][4][4], xv[2][4];
#pragma unroll
        for (int rr = 0; rr < 2; ++rr) { info[rr] = *(const u32x4*)(TOKINFO + (size_t)(rowp + rr) * 8); ww[rr] = *(const f32x4*)(TOKINFO + (size_t)(rowp + rr) * 8 + 4); }
#pragma unroll
        for (int rr = 0; rr < 2; ++rr) {
#pragma unroll
            for (int k = 0; k < 4; ++k) { const int e = (int)(info[rr][k] >> 17), pos = (int)(info[rr][k] & 0x1ffffu); const size_t slot = (size_t)ts[e] * 256 + pos;
#pragma unroll
                for (int j = 0; j < 4; ++j) yw[rr][k][j] = __builtin_nontemporal_load((const u32x2*)(Y2 + slot * DM + 4 * lane + 256 * j)); }
#pragma unroll
            for (int j = 0; j < 4; ++j) xv[rr][j] = *(const u32x2*)(X16 + (size_t)(rowp + rr) * DM + 4 * lane + 256 * j); }
#pragma unroll
        for (int rr = 0; rr < 2; ++rr) { const int row = rowp + rr, b = row >> 11;
        f32x4 y[4];
#pragma unroll
        for (int j = 0; j < 4; ++j) y[j] = (f32x4){0.f, 0.f, 0.f, 0.f};
#pragma unroll
        for (int k = 0; k < 4; ++k) { const float wk = ww[rr][k];
#pragma unroll
            for (int j = 0; j < 4; ++j) { const u32x2 w = yw[rr][k][j];
                y[j][0] += wk * bf_lo(w.x); y[j][1] += wk * bf_hi(w.x); y[j][2] += wk * bf_lo(w.y); y[j][3] += wk * bf_hi(w.y); } }
        float ss = 0.f;
#pragma unroll
        for (int j = 0; j < 4; ++j) ss += (y[j][0] * y[j][0] + y[j][1] * y[j][1]) + (y[j][2] * y[j][2] + y[j][3] * y[j][3]);
        ss = wave_sum(ss);
        const float rstd = 1.f / sqrtf(ss * (1.f / DM) + RMS_EPS);
        const float* mb = MODbase + ((size_t)l * BATCH + b) * 6 * DM;
        f32x4 v[4]; float s2 = 0.f;
#pragma unroll
        for (int j = 0; j < 4; ++j) { const int c = 4 * lane + 256 * j; const u32x2 xw_ = xv[rr][j]; const f32x4 xx = {bf_lo(xw_.x), bf_hi(xw_.x), bf_lo(xw_.y), bf_hi(xw_.y)}, gp = *(const f32x4*)(g_postf + c), ga = *(const f32x4*)(mb + 5 * DM + c);
            v[j] = xx + ga * (y[j] * rstd * gp);
#ifdef T_STAMP
            if (l + 1 == DEPTH) v[j] = v[j] * (1.f + (float)(*((const unsigned*)MODbase - (1u << 18) + 100)) * (1.f / 256.f));
#endif
            if (l + 1 < DEPTH) { u32x2 xo; xo.x = cvt_pk_bf16(v[j][0], v[j][1]); xo.y = cvt_pk_bf16(v[j][2], v[j][3]); *(u32x2*)(X16 + (size_t)row * DM + c) = xo; }
            else *(f32x4*)(out + (size_t)row * DM + c) = v[j];
            s2 += (v[j][0] * v[j][0] + v[j][1] * v[j][1]) + (v[j][2] * v[j][2] + v[j][3] * v[j][3]); }
        if (l + 1 < DEPTH) { s2 = wave_sum(s2); const float* mb1 = MODbase + ((size_t)(l + 1) * BATCH + b) * 6 * DM;
            norm_mod_row(v, s2, a.in[4] + (l + 1) * DM, mb1 + DM, mb1, H8 + (size_t)row * DM, RS + row, lane); }
        }
    }
}
#ifndef MK_ONE_LAUNCH
#define MK_ONE_LAUNCH 1
#endif
constexpr int N_PHASES = 2 + 9 * DEPTH;
__global__ void __launch_bounds__(512, 2) fwd(Args args) {
    extern __shared__ __attribute__((aligned(16))) unsigned char lds_raw[];
    Frame F0;
    F0.lds = (LAS unsigned char*)lds_raw;
    F0.tid = threadIdx.x; F0.lane = F0.tid & 63; F0.wave = __builtin_amdgcn_readfirstlane(F0.tid >> 6);
    F0.G = gridDim.x; { const int bx = blockIdx.x; F0.vcu = (F0.G % 8 == 0) ? (bx % 8) * (F0.G / 8) + bx / 8 : bx; }
    volatile LAS unsigned* MISC = (volatile LAS unsigned*)(F0.lds + MISC_OFF);
    for (int u = F0.tid; u < 128; u += 512) MISC[u] = 0u;
    __syncthreads();
    unsigned* ctl = (unsigned*)(args.ws + WS_CTL);
    const int lo = args.ph_lo, hi = args.ph_hi;
    XcdBarrier bar; bar.bar = ctl + CW_BAR; bar.x = 0; bar.st = nullptr; bar.w = F0.wave;
    if (hi - lo > 1) bar = xcd_barrier_post(ctl + CW_BAR, MISC + 8, F0.wave);
#ifndef PHASE_MASK
#define PHASE_MASK 0x7ff
#endif
#define PHON(j) ((PHASE_MASK >> (j)) & 1)
#ifndef REPEAT_MASK
#define REPEAT_MASK 0
#endif
#define REP(j) for (int rep_ = 0; rep_ <= ((REPEAT_MASK >> (j)) & 1); ++rep_)
#define IN(k) (lo <= (k) && (k) < hi)
#define BOTH(k) (IN(k) && IN((k) + 1))
#define GRID_BAR() xcd_barrier(bar)
#define PH_BEGIN() const Frame F = phase_frame(F0); unsigned char* ws = opq(args.ws); (void)ws
    if (PHON(0) && IN(0)) REP(0) { PH_BEGIN(); p0_mod(F, args.in[1], args.in[2], args.in[3], (float*)(ws + WS_MOD)); p0_weights(F, args); if (BOTH(0)) GRID_BAR(); }
    if (PHON(1) && IN(1)) REP(1) { PH_BEGIN(); p1_norm(F, args.in[0], args.in[4], (const float*)(ws + WS_MOD), (signed char*)(ws + WS_H), (float*)(ws + WS_RS), (bf16_t*)(ws + WS_X)); if (BOTH(1)) GRID_BAR(); }

#pragma unroll 1
#ifndef EXTRA_PHASE
#define EXTRA_PHASE (-1)
#endif
#ifdef SKIP_EPI_PROBE
#define SKIPV ex_
#else
#define SKIPV false
#endif
#ifndef STAG_MASK
#define STAG_MASK 0
#endif
#ifndef STAG_TICKS
#define STAG_TICKS 240
#endif
#define STAGGER(j) do { if ((STAG_MASK >> (j)) & 1) { const unsigned long long t0_ = __builtin_amdgcn_s_memrealtime(), dl_ = (unsigned long long)(F.vcu / (F.G / 8)) * STAG_TICKS; while (__builtin_amdgcn_s_memrealtime() - t0_ < dl_) __builtin_amdgcn_s_sleep(8); } } while (0)
#define EXOK(j) (EXTRA_PHASE < 0 || !ex_ || EXTRA_PHASE == (j))
    for (int it_ = 0; it_ < DEPTH + (EXTRA_PHASE >= 0 ? 1 : 0); ++it_) {
        const int l = it_ < DEPTH ? it_ : DEPTH - 1; const bool ex_ = it_ >= DEPTH; (void)ex_;
        const int pb = 2 + 9 * l;
        if (PHON(2) && EXOK(2) && IN(pb + 0)) REP(2) { PH_BEGIN();
            pg8::Gemm g{(const bf16_t*)(ws + WS_H), (const bf16_t*)(ws + WS_W + (size_t)l * W_LAYER + WO_WIN), DM}; g.skip_epi = SKIPV; pg8::StaticOrder<MTOK / 256, NPROJ / 256> S; S.init(F.G, (int)blockIdx.x);
            EpiProj E{(bf16_t*)(ws + WS_PROJ), (unsigned char*)(ws + WS_GATES), (const float*)(ws + WS_RS), (const float*)(ws + WS_CSIN) + (size_t)l * NPROJ};
            STAGGER(2); pg8::gemm_phase<EpiProj, pg8::StaticOrder<MTOK / 256, NPROJ / 256>, false, true>(F.lds, g, S, E, F.wave);
            if (BOTH(pb + 0)) GRID_BAR();
        }
        if (PHON(3) && EXOK(3) && IN(pb + 1)) REP(3) {
#ifndef SUBREP
#define SUBREP 0
#endif
            { const Frame Fa = phase_frame(F0); const bf16_t* PROJa = (const bf16_t*)(opq(args.ws) + WS_PROJ); bf16_t* OAa = (bf16_t*)(opq(args.ws) + WS_O);
            for (int u = Fa.vcu; u < 2048; u += Fa.G) { const int cu = u & 255, j = u >> 8, bg = cu >> 2, s = cu & 3, qb = (j & 1) ? (8 * (j >> 1) + 7 - s) : (8 * (j >> 1) + s);
                attn_unit<0>(Fa, PROJa, OAa, nullptr, args.in[9] + l * 8, bg >> 1, bg & 1, qb); } }
            { const Frame Fb = phase_frame(F0); unsigned char* wsb = opq(args.ws);
            for (int u = Fb.vcu; u < 512; u += Fb.G)
                sg_unit(Fb, (const bf16_t*)(wsb + WS_PROJ), (const bf16_t*)(wsb + WS_SGW) + (size_t)l * 8 * 128 * 128, args.in[11] + l * 8 * 128, args.in[12] + l * 512, (bf16_t*)(wsb + WS_O) + (size_t)2 * MTOK * 512, u >> 4, u & 15); }
            __syncthreads();
            { const Frame Fi = phase_frame(F0); unsigned char* wsi = opq(args.ws);
              dsa_index_phase(Fi, (const bf16_t*)(wsi + WS_PROJ), (unsigned long long*)(wsi + WS_BITS), l == 0 ? (unsigned*)(wsi + WS_CTL) + 100 : nullptr); }
            if (BOTH(pb + 1)) GRID_BAR();
        }
        if (PHON(4) && EXOK(4) && IN(pb + 2)) REP(4) { PH_BEGIN();
            for (int u = F.vcu; u < 2048; u += F.G) { const int cu = u & 255, j = u >> 8, bg = cu >> 2, s = cu & 3, qb = (j & 1) ? (8 * (j >> 1) + 7 - s) : (8 * (j >> 1) + s);
                attn_unit<1>(F, (const bf16_t*)(ws + WS_PROJ), (bf16_t*)(ws + WS_O) + (size_t)MTOK * 512, (const unsigned*)(ws + WS_BITS), nullptr, bg >> 1, bg & 1, qb); }
            __syncthreads();
            if (BOTH(pb + 2)) GRID_BAR();
        }
        if (PHON(5) && EXOK(5) && IN(pb + 3)) REP(5) { PH_BEGIN();
            pg8::Gemm g{(const bf16_t*)(ws + WS_O), (const bf16_t*)(ws + WS_W + (size_t)l * W_LAYER + WO_WBR), 512}; g.skip_epi = SKIPV; BranchOrder S; S.so.init(F.G, (int)blockIdx.x);
            EpiBranch E{(const unsigned char*)(ws + WS_GATES), (bf16_t*)(ws + WS_H)};
            STAGGER(5); pg8::gemm_phase<EpiBranch, BranchOrder, false>(F.lds, g, S, E, F.wave);
            if (BOTH(pb + 3)) GRID_BAR();
        }
        if (PHON(6) && EXOK(6) && IN(pb + 4)) REP(6) { PH_BEGIN();
            pg8::Gemm g{(const bf16_t*)(ws + WS_H), (const bf16_t*)(ws + WS_W + (size_t)l * W_LAYER + WO_WOUT), DM}; g.skip_epi = SKIPV; pg8::StaticOrder<MTOK / 256, DM / 256> S; S.init(F.G, (int)blockIdx.x);
            EpiWout E{(bf16_t*)(ws + WS_Y), (float*)(ws + WS_SSP)}; E.pv = ex_;
            STAGGER(6); pg8::gemm_phase<EpiWout, pg8::StaticOrder<MTOK / 256, DM / 256>, false>(F.lds, g, S, E, F.wave);
            if (BOTH(pb + 4)) GRID_BAR();
        }
        if (PHON(7) && EXOK(7) && IN(pb + 5)) REP(7) { PH_BEGIN();
            p7_route(F, args, l, (bf16_t*)(ws + WS_X), (const bf16_t*)(ws + WS_Y), (const float*)(ws + WS_SSP), (const float*)(ws + WS_MOD) + (size_t)l * BATCH * 6 * DM, (signed char*)(ws + WS_H), (float*)(ws + WS_RS),
                     (const bf16_t*)(ws + WS_WRT) + (size_t)l * NE * DM, (unsigned*)(ws + WS_CTL) + CW_CNT + l * 32 * 64, (int*)(ws + WS_ROWTOK), (unsigned*)(ws + WS_TOKINFO));
            if (BOTH(pb + 5)) GRID_BAR();
        }
        if (PHON(8) && EXOK(8) && IN(pb + 6)) REP(8) { PH_BEGIN();
            unsigned* cnt = (unsigned*)(ws + WS_CTL) + CW_CNT + l * 32 * 64; const int* ROWTOK = (const int*)(ws + WS_ROWTOK);
            const int RT = moe_tables(F, cnt);
            LAS int* ts = (LAS int*)(F.lds + TS_OFF); LAS int* te = (LAS int*)(F.lds + TILE_E_OFF); LAS int* ri = (LAS int*)(F.lds + ROWIDX_OFF);
            const long U = (long)RT * 8; MoeOrder S; S.u0 = (int)(U * F.vcu / F.G); S.u1 = (int)(U * (F.vcu + 1) / F.G); S.NB = 8; S.rt_lo = S.u0 / 8; S.tile_e = te; S.rowidx = ri;
            if (S.u1 > S.u0) { const int rt_hi = (S.u1 - 1) / 8; int ntile = rt_hi - S.rt_lo + 1; if (ntile > 8) ntile = 8;
                for (int i = F.tid; i < ntile * 256; i += 512) { const int rt = S.rt_lo + (i >> 8), r = i & 255, e = te[rt], first = (rt - ts[e]) * 256 + r;
                    const int c = (int)__hip_atomic_load(cnt + 64 * e, __ATOMIC_RELAXED, __HIP_MEMORY_SCOPE_AGENT); ri[i] = first < c ? ROWTOK[e * 65536 + first] : 0; } }
            __syncthreads();
            pg8::Gemm g{(const bf16_t*)(ws + WS_H), (const bf16_t*)(ws + WS_W + (size_t)l * W_LAYER + WO_W1), DM}; g.skip_epi = SKIPV;
            EpiW1I8 E{(signed char*)(ws + WS_ACT), args.in[18] + (size_t)l * NE * 2 * FF, (const float*)(ws + WS_RS), (const float*)(ws + WS_CS1) + (size_t)l * NE * 2048, ri, S.rt_lo};
            STAGGER(8); pg8::gemm_phase<EpiW1I8, MoeOrder, true, true>(F.lds, g, S, E, F.wave);
            if (BOTH(pb + 6)) GRID_BAR();
        }
        if (PHON(9) && EXOK(9) && IN(pb + 7)) REP(9) { PH_BEGIN();
            const int RT = moe_tables(F, (unsigned*)(ws + WS_CTL) + CW_CNT + l * 32 * 64);
            const long U = (long)RT * 4; MoeOrder S; S.u0 = (int)(U * F.vcu / F.G); S.u1 = (int)(U * (F.vcu + 1) / F.G); S.NB = 4; S.rt_lo = 0; S.tile_e = (LAS int*)(F.lds + TILE_E_OFF); S.rowidx = nullptr;
            pg8::Gemm g{(const bf16_t*)(ws + WS_ACT), (const bf16_t*)(ws + WS_W + (size_t)l * W_LAYER + WO_W2), FF}; g.skip_epi = SKIPV;
            EpiW2 E{(bf16_t*)(ws + WS_Y2), args.in[20] + (size_t)l * NE * DM, (const float*)(ws + WS_CS2) + (size_t)l * NE * DM};
            STAGGER(9); pg8::gemm_phase<EpiW2, MoeOrder, false, true>(F.lds, g, S, E, F.wave);
            if (BOTH(pb + 7)) GRID_BAR();
        }
        if (PHON(10) && EXOK(10) && IN(pb + 8)) REP(10) { PH_BEGIN();
            (void)moe_tables(F, (unsigned*)(ws + WS_CTL) + CW_CNT + l * 32 * 64);
            p10_combine(F, args, l, (bf16_t*)(ws + WS_X), args.out, (const bf16_t*)(ws + WS_Y2), (const unsigned*)(ws + WS_TOKINFO), (const float*)(ws + WS_MOD), (signed char*)(ws + WS_H), (float*)(ws + WS_RS));
            if (BOTH(pb + 8)) GRID_BAR();
        }
    }
#undef PH_BEGIN
#undef IN
#undef BOTH
#undef GRID_BAR
}

extern "C" void kernel_launch(void* const* d_in, const int* in_sizes, int n_in, void* d_out, int out_size, void* d_ws, size_t ws_size, hipStream_t stream) {
    static int grid = 0;
    if (grid == 0) {
        if (n_in != 21 || out_size != MTOK * DM || ws_size < WS_END) { fprintf(stderr, "kernel_launch: unexpected shapes (n_in %d, out %d, ws %zu); nothing launched\n", n_in, out_size, ws_size); grid = -1; return; }
        int dev = 0, cus = 0, per_cu = 0;
        if (hipGetDevice(&dev) != hipSuccess || hipDeviceGetAttribute(&cus, hipDeviceAttributeMultiprocessorCount, dev) != hipSuccess) { grid = -1; return; }
        if (hipFuncSetAttribute((const void*)fwd, hipFuncAttributeMaxDynamicSharedMemorySize, LDS_BYTES) != hipSuccess) { fprintf(stderr, "kernel_launch: hipFuncSetAttribute failed\n"); grid = -1; return; }
        if (hipOccupancyMaxActiveBlocksPerMultiprocessor(&per_cu, (const void*)fwd, 512, LDS_BYTES) != hipSuccess || per_cu < 1) { fprintf(stderr, "kernel_launch: occupancy query says %d\n", per_cu); }
        (void)hipGetLastError();
        grid = cus > 256 ? 256 : cus;
    }
    if (grid < 0) return;
    (void)hipMemsetAsync((char*)d_ws + WS_CTL, 0, CTL_ZERO_BYTES, stream);
    Args a{};
    for (int i = 0; i < 21; ++i) a.in[i] = (const float*)d_in[i];
    a.out = (float*)d_out; a.ws = (unsigned char*)d_ws;
#if MK_ONE_LAUNCH
    a.ph_lo = 0; a.ph_hi = N_PHASES;
    hipLaunchKernelGGL(fwd, dim3(grid), dim3(512), LDS_BYTES, stream, a);
#else
    for (int p = 0; p < N_PHASES; ++p) { a.ph_lo = p; a.ph_hi = p + 1; hipLaunchKernelGGL(fwd, dim3(grid), dim3(512), LDS_BYTES, stream, a); }
#endif
}
```

```cpp
#include <hip/hip_runtime.h>
#include <cstdio>
#include <cstdint>
#include <type_traits>

#define LAS __attribute__((address_space(3)))
#define GAS __attribute__((address_space(1)))
typedef unsigned short bf16_t;
typedef short bf16x8 __attribute__((ext_vector_type(8)));
typedef float f32x2 __attribute__((ext_vector_type(2)));
typedef float f32x4 __attribute__((ext_vector_type(4)));
typedef float f32x16 __attribute__((ext_vector_type(16)));
typedef unsigned u32x2 __attribute__((ext_vector_type(2)));
typedef unsigned u32x4 __attribute__((ext_vector_type(4)));
typedef short v4i16_t __attribute__((ext_vector_type(4)));
typedef int i32x4 __attribute__((ext_vector_type(4)));

constexpr int BATCH = 32, SEQ = 2048, DM = 1024, MTOK = BATCH * SEQ, DEPTH = 2;
constexpr int NPROJ = 6144;
constexpr int PLD = 3072;
constexpr int C_QA = 0, C_KA = 512, C_VA = 640, C_QB = 768, C_KB = 1280, C_VB = 1408, C_QI = 1536, C_KI = 1792, C_WI = 1824, C_U = 2048, C_V = 2560, C_G = 3072;
constexpr int NE = 32, FF = 1024;
constexpr float RMS_EPS = 1e-5f, LN_EPS = 1e-5f;
constexpr float LOG2E = 1.4426950408889634f;
constexpr float QSCALE = 0.125f * LOG2E;

__device__ __forceinline__ unsigned f2bf(float f) { unsigned u = __builtin_bit_cast(unsigned, f); return (u + 0x7fffu + ((u >> 16) & 1u)) >> 16; }
__device__ __forceinline__ unsigned cvt_pk_bf16(float lo, float hi) { unsigned r; asm volatile("v_cvt_pk_bf16_f32 %0, %1, %2" : "=v"(r) : "v"(lo), "v"(hi)); return r; }
__device__ __forceinline__ float bf_lo(unsigned w) { return __builtin_bit_cast(float, w << 16); }
__device__ __forceinline__ float bf_hi(unsigned w) { return __builtin_bit_cast(float, w & 0xffff0000u); }
__device__ __forceinline__ float fexp2(float x) { return __builtin_amdgcn_exp2f(x); }
__device__ __forceinline__ float frcp(float x) { return __builtin_amdgcn_rcpf(x); }
__device__ __forceinline__ float sigmoidf_(float x) { return frcp(1.f + fexp2(-LOG2E * x)); }
__device__ __forceinline__ float gelu_tanh(float x) { const float t = x + 0.044715f * x * x * x; return x * frcp(1.f + fexp2(-2.302208198f * t)); }
template <int CTRL> __device__ __forceinline__ float dpp_f(float v) { return __builtin_bit_cast(float, __builtin_amdgcn_update_dpp(0, __builtin_bit_cast(int, v), CTRL, 0xF, 0xF, false)); }
__device__ __forceinline__ void swap32_asm(unsigned& a, unsigned& b) { asm volatile("s_nop 1\n\tv_permlane32_swap_b32 %0, %1" : "+v"(a), "+v"(b)); }
__device__ __forceinline__ float xor16_add(float v) { return v + __builtin_bit_cast(float, __builtin_amdgcn_ds_swizzle(__builtin_bit_cast(int, v), 0x401F)); }
__device__ __forceinline__ float xor16_max(float v) { return fmaxf(v, __builtin_bit_cast(float, __builtin_amdgcn_ds_swizzle(__builtin_bit_cast(int, v), 0x401F))); }
__device__ __forceinline__ float xor32_add(float v) { unsigned a = __builtin_bit_cast(unsigned, v), b = a; swap32_asm(a, b); return __builtin_bit_cast(float, a) + __builtin_bit_cast(float, b); }
__device__ __forceinline__ float xor32_max(float v) { unsigned a = __builtin_bit_cast(unsigned, v), b = a; swap32_asm(a, b); return fmaxf(__builtin_bit_cast(float, a), __builtin_bit_cast(float, b)); }
__device__ __forceinline__ float quad_sum(float v) { v += dpp_f<0xB1>(v); v += dpp_f<0x4E>(v); return v; }
__device__ __forceinline__ float wave_sum(float v) {
    v += dpp_f<0xB1>(v); v += dpp_f<0x4E>(v); v += dpp_f<0x141>(v); v += dpp_f<0x140>(v);
    return xor32_add(xor16_add(v));
}
__device__ __forceinline__ float wave_max(float v) {
    v = fmaxf(v, dpp_f<0xB1>(v)); v = fmaxf(v, dpp_f<0x4E>(v)); v = fmaxf(v, dpp_f<0x141>(v)); v = fmaxf(v, dpp_f<0x140>(v));
    return xor32_max(xor16_max(v));
}
__device__ __forceinline__ unsigned wave_sum_u32(unsigned v) {
    v += (unsigned)__builtin_amdgcn_update_dpp(0, (int)v, 0xB1, 0xF, 0xF, false);
    v += (unsigned)__builtin_amdgcn_update_dpp(0, (int)v, 0x4E, 0xF, 0xF, false);
    v += (unsigned)__builtin_amdgcn_update_dpp(0, (int)v, 0x141, 0xF, 0xF, false);
    v += (unsigned)__builtin_amdgcn_update_dpp(0, (int)v, 0x140, 0xF, 0xF, false);
    return __builtin_amdgcn_readlane(v, 0) + __builtin_amdgcn_readlane(v, 16) + __builtin_amdgcn_readlane(v, 32) + __builtin_amdgcn_readlane(v, 48);
}
__device__ __forceinline__ unsigned wave_max_u32(unsigned v) {
    unsigned t;
    t = (unsigned)__builtin_amdgcn_update_dpp(0, (int)v, 0xB1, 0xF, 0xF, false); v = v > t ? v : t;
    t = (unsigned)__builtin_amdgcn_update_dpp(0, (int)v, 0x4E, 0xF, 0xF, false); v = v > t ? v : t;
    t = (unsigned)__builtin_amdgcn_update_dpp(0, (int)v, 0x141, 0xF, 0xF, false); v = v > t ? v : t;
    t = (unsigned)__builtin_amdgcn_update_dpp(0, (int)v, 0x140, 0xF, 0xF, false); v = v > t ? v : t;
    unsigned a = __builtin_amdgcn_readlane(v, 0), b = __builtin_amdgcn_readlane(v, 16), c = __builtin_amdgcn_readlane(v, 32), d = __builtin_amdgcn_readlane(v, 48);
    a = a > b ? a : b; c = c > d ? c : d; return a > c ? a : c;
}
__device__ __forceinline__ unsigned q8x4(float a, float b, float c, float d, float inv) {
    unsigned r = 0u;
    r = __builtin_amdgcn_cvt_pk_u8_f32(__builtin_rintf(fmaf(a, inv, 128.f)), 0u, r);
    r = __builtin_amdgcn_cvt_pk_u8_f32(__builtin_rintf(fmaf(b, inv, 128.f)), 1u, r);
    r = __builtin_amdgcn_cvt_pk_u8_f32(__builtin_rintf(fmaf(c, inv, 128.f)), 2u, r);
    r = __builtin_amdgcn_cvt_pk_u8_f32(__builtin_rintf(fmaf(d, inv, 128.f)), 3u, r);
    return r ^ 0x80808080u;
}
__device__ __forceinline__ unsigned u8x4_floor(float a, float b, float c, float d) {
    unsigned r = 0u;
    r = __builtin_amdgcn_cvt_pk_u8_f32(__builtin_floorf(a), 0u, r); r = __builtin_amdgcn_cvt_pk_u8_f32(__builtin_floorf(b), 1u, r);
    r = __builtin_amdgcn_cvt_pk_u8_f32(__builtin_floorf(c), 2u, r); r = __builtin_amdgcn_cvt_pk_u8_f32(__builtin_floorf(d), 3u, r);
    return r;
}
__device__ __forceinline__ int lane_id_volatile(int tag = 0) { int l; asm volatile("v_mbcnt_lo_u32_b32 %0, -1, 0 ; LANETAG %1\n\tv_mbcnt_hi_u32_b32 %0, -1, %0" : "=v"(l) : "s"(tag)); return l; }
#define LDS_WAIT() asm volatile("s_waitcnt lgkmcnt(0)" ::: "memory")
#define VM_WAIT() asm volatile("s_waitcnt vmcnt(0)" ::: "memory")

namespace pg8 {
constexpr int BM = 256, BK = 64, HALF = 128, HTB = HALF * BK * 2  , STAGE_BYTES = 8 * HTB, NXCD = 8, WGM = 8;
__host__ __device__ __forceinline__ int lds_byte(int r, int c) { const int st = (r >> 4) * 2 + (c >> 5), rr = r & 15, cc = c & 31, ob = rr * 64 + cc * 2; return st * 1024 + (ob ^ (((ob >> 9) & 1) << 5)); }
__host__ __device__ __forceinline__ void stage_rc(int b, int& R, int& C) { const int st = b / 1024, sb = b % 1024, swz = sb ^ (((sb >> 9) & 1) << 5); R = (st >> 1) * 16 + swz / 64; C = (st & 1) * 32 + (swz % 64) / 2; }
__host__ __device__ __forceinline__ int perm32(int rho) { const int n = rho >> 4, i = rho & 15; return 8 * (i >> 2) + 4 * n + (i & 3); }

struct Unit { int pm, pn; };
struct Gemm { const bf16_t* A; const bf16_t* Bt; int K; bool skip_epi = false; };

template <int NM, int NN> struct StaticOrder {
    int G, c;
    __device__ void init(int G_, int c_) { G = G_; c = c_; }
    __device__ __forceinline__ bool tile(int i, int& pm, int& pn) const {
        constexpr int nwg = NM * NN;
        const long L = (long)i * G + c; if (L >= nwg) return false;
        int wgid = (int)L; { constexpr int q = nwg / NXCD, r = nwg % NXCD; const int xcd = wgid % NXCD, off = wgid / NXCD; wgid = (xcd < r ? xcd * (q + 1) : r * (q + 1) + (xcd - r) * q) + off; }
        constexpr int nig = WGM * NN; static_assert(NM % WGM == 0, "row tiles in whole groups");
        const int gid = wgid / nig, fm = gid * WGM, rem = wgid % nig;
        pm = fm + (rem % WGM); pn = rem / WGM; return true;
    }
    __device__ __forceinline__ bool next(int i, Unit& u) const { return tile(i, u.pm, u.pn); }
};

template <class Epi, class Sched, bool GATHER, bool I8 = false>
__device__ __forceinline__ void gemm_phase(LAS unsigned char* lds, const Gemm g, const Sched& S, const Epi& E, int wv  ) {
    int tid = wv * 64 + lane_id_volatile(1); asm volatile("" : "+v"(tid));
    const int wid = __builtin_amdgcn_readfirstlane(tid >> 6), lane = tid & 63, wr = wid >> 2, wc = wid & 3, fr = lane & 15, fq = lane >> 4;
    const int K = g.K, RB = I8 ? K : 2 * K  , nt = RB / (BK * 2);
    unsigned voffA[2], voffB[2]; int RA[2], CA[2];
#pragma unroll
    for (int i = 0; i < 2; ++i) { int R, C; stage_rc(tid * 16 + i * 8192, R, C); const int Rb = (R & ~31) + perm32(R & 31); RA[i] = R; CA[i] = C;
        voffA[i] = (unsigned)(R * RB + C * 2); voffB[i] = (unsigned)(Rb * RB + C * 2); }
    const size_t kstep = (size_t)(BK * 2);
    const size_t hstep = (size_t)HALF * RB;
    const size_t tstep = 2 * hstep;
    const unsigned ldsw = (unsigned)wid * 1024u;
    const int aoff = lds_byte(wr * 64 + fr, fq * 8), boff = lds_byte(wc * 32 + fr, fq * 8);
#define PG8_SA(b, h) (((b) * 2 + (h)) * HTB)
#define PG8_SB(b, h) ((4 + (b) * 2 + (h)) * HTB)
#define PG8_STAGE(bufoff, gbase, voff) do { _Pragma("unroll") for (int _i = 0; _i < 2; ++_i) \
        __builtin_amdgcn_global_load_lds((const unsigned*)((const char*)(gbase) + (voff)[_i]), (LAS unsigned*)(lds + (bufoff) + ldsw + _i * 8192), 16, 0, 0); } while (0)
#define PG8_STAGE_A(bufoff, h, ubase, koff, VO) do { if constexpr (GATHER) { PG8_STAGE(bufoff, (const char*)g.A + (koff), VO[h]); } else { PG8_STAGE(bufoff, (ubase) + (h) * hstep + (koff), voffA); } } while (0)
#define PG8_LDA(dst, b, h) do { _Pragma("unroll") for (int m = 0; m < 4; ++m) _Pragma("unroll") for (int k = 0; k < 2; ++k) dst[m][k] = *(const LAS bf16x8*)(lds + PG8_SA(b, h) + aoff + m * 2048 + k * 1024); } while (0)
#define PG8_LDB(dst, b, h) do { _Pragma("unroll") for (int n = 0; n < 2; ++n) _Pragma("unroll") for (int k = 0; k < 2; ++k) dst[n][k] = *(const LAS bf16x8*)(lds + PG8_SB(b, h) + boff + n * 2048 + k * 1024); } while (0)
#define PG8_MMA(ai, bj, At, Bt) do { __builtin_amdgcn_s_setprio(1); _Pragma("unroll") for (int m = 0; m < 4; ++m) _Pragma("unroll") for (int n = 0; n < 2; ++n) _Pragma("unroll") for (int k = 0; k < 2; ++k) \
        { if constexpr (I8) acc[ai][bj][m][n] = __builtin_amdgcn_mfma_i32_16x16x64_i8(__builtin_bit_cast(i32x4, Bt[n][k]), __builtin_bit_cast(i32x4, At[m][k]), acc[ai][bj][m][n], 0, 0, 0); \
          else acc[ai][bj][m][n] = __builtin_amdgcn_mfma_f32_16x16x32_bf16(Bt[n][k], At[m][k], acc[ai][bj][m][n], 0, 0, 0); } __builtin_amdgcn_s_setprio(0); } while (0)
#define PG8_WAIT_V(n) asm volatile("s_waitcnt vmcnt(" #n ")" ::: "memory")
#define PG8_WAIT_L(n) asm volatile("s_waitcnt lgkmcnt(" #n ")" ::: "memory")
#define PG8_BAR __builtin_amdgcn_s_barrier()
#define PG8_SCHED __builtin_amdgcn_sched_barrier(0)
    Unit cur, nxt; int ui = 0;
    if (!S.next(0, cur)) return;
    typedef typename std::conditional<I8, i32x4, f32x4>::type accv_t;
    accv_t acc[2][2][4][2];
#pragma unroll
    for (int a = 0; a < 2; ++a)
#pragma unroll
        for (int b = 0; b < 2; ++b)
#pragma unroll
            for (int m = 0; m < 4; ++m)
#pragma unroll
                for (int n = 0; n < 2; ++n) acc[a][b][m][n] = (accv_t){0, 0, 0, 0};
    bf16x8 At[4][2], B0[2][2], B1[2][2];
    unsigned oc[2][2], on[2][2];
    if constexpr (GATHER) {
#pragma unroll
        for (int h = 0; h < 2; ++h)
#pragma unroll
            for (int i = 0; i < 2; ++i) { oc[h][i] = (unsigned)(S.src_row(cur, h * HALF + RA[i]) * RB + CA[i] * 2); on[h][i] = oc[h][i]; }

    }
    const char* cA = GATHER ? (const char*)g.A : (const char*)g.A + (size_t)cur.pm * tstep; const char* cB = (const char*)g.Bt + (size_t)cur.pn * tstep;
    PG8_STAGE(PG8_SB(0, 0), cB, voffB); PG8_STAGE(PG8_SB(0, 1), cB + hstep, voffB); PG8_STAGE_A(PG8_SA(0, 0), 0, cA, 0, oc); PG8_STAGE_A(PG8_SA(0, 1), 1, cA, 0, oc);
    if (wr == 1) PG8_BAR;
    PG8_WAIT_V(2); PG8_BAR;
    PG8_STAGE(PG8_SB(1, 0), cB + kstep, voffB); PG8_STAGE_A(PG8_SA(1, 0), 0, cA, kstep, oc); PG8_STAGE(PG8_SB(1, 1), cB + hstep + kstep, voffB);
    PG8_WAIT_V(6); PG8_BAR;
    for (;;) {
        const bool has_next = S.next(ui + 1, nxt);
        const char* nA = GATHER ? (const char*)g.A : (has_next ? (const char*)g.A + (size_t)nxt.pm * tstep : cA); const char* nB = has_next ? (const char*)g.Bt + (size_t)nxt.pn * tstep : cB;
        if constexpr (GATHER) {
            if (has_next) {
                const int t2 = wv * 64 + lane_id_volatile(3); int R2[2], C2[2];
#pragma unroll
                for (int i = 0; i < 2; ++i) stage_rc(t2 * 16 + i * 8192, R2[i], C2[i]);
#pragma unroll
                for (int h = 0; h < 2; ++h)
#pragma unroll
                    for (int i = 0; i < 2; ++i) on[h][i] = (unsigned)(S.src_row(nxt, h * HALF + R2[i]) * RB + C2[i] * 2);
            }
        }
        for (int t = 0; t < nt; t += 2) {
            const bool last = (t == nt - 2);
            const size_t k1 = (size_t)(t + 1) * kstep;
            const size_t k2 = last ? (size_t)0 : (size_t)(t + 2) * kstep, k3 = k2 + kstep;
            const char* a2 = last ? nA : cA; const char* b2 = last ? nB : cB;
            unsigned o2[2][2];
            if constexpr (GATHER) {
#pragma unroll
                for (int h = 0; h < 2; ++h)
#pragma unroll
                    for (int i = 0; i < 2; ++i) o2[h][i] = last ? on[h][i] : oc[h][i];
            }
            PG8_LDB(B0, 0, 0); PG8_LDB(B1, 0, 1); PG8_SCHED; PG8_LDA(At, 0, 0); PG8_STAGE_A(PG8_SA(1, 1), 1, cA, k1, oc);
            PG8_WAIT_V(8); PG8_WAIT_L(0); PG8_BAR; PG8_MMA(0, 0, At, B0); PG8_MMA(0, 1, At, B1); PG8_BAR; PG8_SCHED;
            PG8_LDA(At, 0, 1); PG8_STAGE(PG8_SB(0, 0), b2 + k2, voffB); PG8_STAGE(PG8_SB(0, 1), b2 + hstep + k2, voffB); PG8_STAGE_A(PG8_SA(0, 0), 0, a2, k2, o2);
            PG8_WAIT_V(8); PG8_WAIT_L(0); PG8_BAR; PG8_MMA(1, 0, At, B0); PG8_MMA(1, 1, At, B1); PG8_BAR; PG8_SCHED;
            PG8_LDB(B0, 1, 0); PG8_LDB(B1, 1, 1); PG8_SCHED; PG8_LDA(At, 1, 0); PG8_STAGE_A(PG8_SA(0, 1), 1, a2, k2, o2);
            PG8_WAIT_V(8); PG8_WAIT_L(0); PG8_BAR; PG8_MMA(0, 0, At, B0); PG8_MMA(0, 1, At, B1); PG8_BAR; PG8_SCHED;
            PG8_LDA(At, 1, 1); PG8_STAGE(PG8_SB(1, 0), b2 + k3, voffB); PG8_STAGE(PG8_SB(1, 1), b2 + hstep + k3, voffB); PG8_STAGE_A(PG8_SA(1, 0), 0, a2, k3, o2);
            PG8_WAIT_V(8); PG8_WAIT_L(0); PG8_BAR; PG8_MMA(1, 0, At, B0); PG8_MMA(1, 1, At, B1); PG8_BAR; PG8_SCHED;
        }
        if (wr == 0) PG8_BAR;
#ifdef SKIP_EPI_PROBE
        const int le_ = lane_id_volatile(4);
        bool rst = true; if (!g.skip_epi) rst = E(acc, cur, wr, wc, le_ & 15, le_ >> 4);
#else
        const int le_ = lane_id_volatile(4);
        const bool rst = E(acc, cur, wr, wc, le_ & 15, le_ >> 4);
#endif
        if (!has_next) break;
        if (rst) {
#pragma unroll
        for (int a = 0; a < 2; ++a)
#pragma unroll
            for (int b = 0; b < 2; ++b)
#pragma unroll
                for (int m = 0; m < 4; ++m)
#pragma unroll
                    for (int n = 0; n < 2; ++n) acc[a][b][m][n] = (accv_t){0, 0, 0, 0};
        }
        cur = nxt; cA = nA; cB = nB; ++ui;
        if constexpr (GATHER) {
#pragma unroll
            for (int h = 0; h < 2; ++h)
#pragma unroll
                for (int i = 0; i < 2; ++i) oc[h][i] = on[h][i];
        }
        if (wr == 1) PG8_BAR;
    }
    PG8_WAIT_V(0);
    PG8_BAR;
#undef PG8_SA
#undef PG8_SB
#undef PG8_STAGE
#undef PG8_STAGE_A
#undef PG8_LDA
#undef PG8_LDB
#undef PG8_MMA
#undef PG8_WAIT_V
#undef PG8_WAIT_L
#undef PG8_BAR
#undef PG8_SCHED
}
}
typedef f32x4 acc_t[2][2][4][2];
typedef i32x4 acci_t[2][2][4][2];

struct EpiProj {
    bf16_t* O; unsigned char* G8; const float* RS  ; const float* CS  ;
    __device__ __forceinline__ bool operator()(acci_t& acc, const pg8::Unit& u, int wr, int wc, int fr, int fq) const {
        const int pn = u.pn;
        const int act = (pn <= 1 || pn == 3 || pn == 4) ? 1 : (pn >= 12 ? 3 : (pn >= 8 ? 2 : 0));
        const int row0 = u.pm * 256 + wr * 64 + fr, col0 = pn * 256 + wc * 32 + 8 * fq;
        float rsv[8];
#pragma unroll
        for (int q = 0; q < 8; ++q) rsv[q] = RS[row0 + (q >> 2) * 128 + (q & 3) * 16];
        f32x2 cs2[2][4];
#pragma unroll
        for (int bj = 0; bj < 2; ++bj) { const f32x4 c0 = *(const f32x4*)(CS + col0 + bj * 128), c1 = *(const f32x4*)(CS + col0 + bj * 128 + 4); const float k = (act == 1 ? QSCALE : 1.f);
            cs2[bj][0] = (f32x2){c0[0], c0[1]} * k; cs2[bj][1] = (f32x2){c0[2], c0[3]} * k; cs2[bj][2] = (f32x2){c1[0], c1[1]} * k; cs2[bj][3] = (f32x2){c1[2], c1[3]} * k; }
#pragma unroll
        for (int ai = 0; ai < 2; ++ai)
#pragma unroll
            for (int m = 0; m < 4; ++m) { const int row = row0 + ai * 128 + m * 16; bf16_t* rowp = O + (size_t)row * PLD + col0; const float rs = rsv[ai * 4 + m];
#pragma unroll
                for (int bj = 0; bj < 2; ++bj) { f32x2 v[4];
#pragma unroll
                    for (int p = 0; p < 4; ++p) { const int i0 = 2 * p; v[p] = (f32x2){(float)acc[ai][bj][m][i0 >> 2][i0 & 3], (float)acc[ai][bj][m][(i0 + 1) >> 2][(i0 + 1) & 3]} * (cs2[bj][p] * rs); }
                    if (act == 2) {
#pragma unroll
                        for (int p = 0; p < 4; ++p) { const f32x2 x = v[p], t = (x * x * 0.044715f + 1.f) * x * (-2.302208198f); f32x2 d = {fexp2(t[0]), fexp2(t[1])}; d = d + 1.f; v[p] = x * (f32x2){frcp(d[0]), frcp(d[1])}; } }
                    else if (act == 3) {
                        f32x2 gq[4];
#pragma unroll
                        for (int p = 0; p < 4; ++p) { const f32x2 t = v[p] * (-LOG2E); f32x2 d = {fexp2(t[0]), fexp2(t[1])}; d = d + 1.f; gq[p] = (f32x2){frcp(d[0]), frcp(d[1])} * 256.f; }
                        u32x2 w8; w8.x = u8x4_floor(gq[0][0], gq[0][1], gq[1][0], gq[1][1]); w8.y = u8x4_floor(gq[2][0], gq[2][1], gq[3][0], gq[3][1]);
                        *(u32x2*)(G8 + (size_t)row * 3072 + (col0 - C_G) + bj * 128) = w8; continue; }
                    u32x4 w; w.x = cvt_pk_bf16(v[0][0], v[0][1]); w.y = cvt_pk_bf16(v[1][0], v[1][1]); w.z = cvt_pk_bf16(v[2][0], v[2][1]); w.w = cvt_pk_bf16(v[3][0], v[3][1]);
                    *(u32x4*)(rowp + bj * 128) = w; } }
        return true;
    }
};

struct BranchOrder {
    pg8::StaticOrder<MTOK / 256, DM / 256> so;
    __device__ __forceinline__ bool next(int j, pg8::Unit& u) const { const int i = j / 3, br = j - 3 * i; int pm, pn; if (!so.tile(i, pm, pn)) return false; u.pm = br * 256 + pm; u.pn = br * 4 + pn; return true; }
};
struct EpiBranch {
    const unsigned char* G8  ; bf16_t* MERGED;
    __device__ __forceinline__ bool operator()(acc_t& acc, const pg8::Unit& u, int wr, int wc, int fr, int fq) const {
        const int br = u.pn >> 2, pn = u.pn & 3, pm = u.pm & 255;
        const int row0 = pm * 256 + wr * 64 + fr, col0 = pn * 256 + wc * 32 + 8 * fq;
#pragma unroll
        for (int rnd = 0; rnd < 2; ++rnd) { const int ai = rnd, m0 = 0;
            u32x2 gw[4][2], gd[4][2];
#pragma unroll
            for (int m = m0; m < m0 + 4; ++m)
#pragma unroll
                for (int bj = 0; bj < 2; ++bj) { const unsigned char* gp = G8 + (size_t)(row0 + ai * 128 + m * 16) * 3072 + br * 1024 + col0 + bj * 128;
                    gw[m][bj] = *(const u32x2*)gp; if (br != 2) gd[m][bj] = *(const u32x2*)(gp + 1024); }
#pragma unroll
            for (int m = m0; m < m0 + 4; ++m) { const size_t row = (size_t)(row0 + ai * 128 + m * 16);
#pragma unroll
                for (int bj = 0; bj < 2; ++bj) {
                    const u32x2 g = gw[m][bj];
                    float gn[8];
#pragma unroll
                    for (int i = 0; i < 8; ++i) gn[i] = (float)((g[i >> 2] >> (8 * (i & 3))) & 0xffu) + 0.5f;
                    if (br != 2) { const u32x2 d = gd[m][bj];
#pragma unroll
                        for (int i = 0; i < 8; ++i) gn[i] = gn[i] * frcp((float)((d[i >> 2] >> (8 * (i & 3))) & 0xffu) + 0.5f); }
                    else {
#pragma unroll
                        for (int i = 0; i < 8; ++i) gn[i] *= (1.f / 256.f); }
                    f32x4 v0 = acc[ai][bj][m][0], v1 = acc[ai][bj][m][1];
                    v0[0] *= gn[0]; v0[1] *= gn[1]; v0[2] *= gn[2]; v0[3] *= gn[3]; v1[0] *= gn[4]; v1[1] *= gn[5]; v1[2] *= gn[6]; v1[3] *= gn[7];
                    if (br != 2) { acc[ai][bj][m][0] = v0; acc[ai][bj][m][1] = v1; }
                    else { u32x4 w; w.x = cvt_pk_bf16(v0[0], v0[1]); w.y = cvt_pk_bf16(v0[2], v0[3]); w.z = cvt_pk_bf16(v1[0], v1[1]); w.w = cvt_pk_bf16(v1[2], v1[3]);
                        *(u32x4*)(MERGED + row * DM + col0 + bj * 128) = w; } } }
            asm volatile("" ::: "memory");
        }
        return br == 2;
    }
};

#ifndef WOUT_VARIANT
#define WOUT_VARIANT 0
#endif
struct EpiWout {
    bf16_t* Y; float* SSP; bool pv = false;
    __device__ __forceinline__ bool operator()(acc_t& acc, const pg8::Unit& u, int wr, int wc, int fr, int fq) const {
        const int row0 = u.pm * 256 + wr * 64 + fr, col0 = u.pn * 256 + wc * 32 + 8 * fq;
#pragma unroll
        for (int ai = 0; ai < 2; ++ai)
#pragma unroll
            for (int m = 0; m < 4; ++m) { const size_t row = (size_t)(row0 + ai * 128 + m * 16); float ss = 0.f;
#pragma unroll
                for (int bj = 0; bj < 2; ++bj) { const f32x4 v0 = acc[ai][bj][m][0], v1 = acc[ai][bj][m][1];
                    ss += (v0[0] * v0[0] + v0[1] * v0[1]) + (v0[2] * v0[2] + v0[3] * v0[3]) + (v1[0] * v1[0] + v1[1] * v1[1]) + (v1[2] * v1[2] + v1[3] * v1[3]);
                    u32x4 w; w.x = cvt_pk_bf16(v0[0], v0[1]); w.y = cvt_pk_bf16(v0[2], v0[3]); w.z = cvt_pk_bf16(v1[0], v1[1]); w.w = cvt_pk_bf16(v1[2], v1[3]);
                    if (!(WOUT_VARIANT == 2 && pv)) *(u32x4*)(Y + row * DM + col0 + bj * 128) = w; }
                if (!(WOUT_VARIANT == 3 && pv)) ss = xor32_add(xor16_add(ss));
                if (fq == 0 && !((WOUT_VARIANT == 1 || WOUT_VARIANT == 3) && pv)) SSP[row * 16 + u.pn * 4 + wc] = ss; }
        return true;
    }
};

struct MoeOrder {
    int u0, u1, NB, rt_lo;
    const LAS int* tile_e;
    const LAS int* rowidx;
    __device__ __forceinline__ bool next(int i, pg8::Unit& u) const { const int x = u0 + i; if (x >= u1) return false; const int rt = x / NB, pn = x - rt * NB; u.pm = rt; u.pn = tile_e[rt] * NB + pn; return true; }
    __device__ __forceinline__ int src_row(const pg8::Unit& u, int r) const { return rowidx[(u.pm - rt_lo) * 256 + r]; }
};
struct EpiW1 {
    bf16_t* ACT; const float* b1  ;
    __device__ __forceinline__ bool operator()(acc_t& acc, const pg8::Unit& u, int wr, int wc, int fr, int fq) const {
        const int e = u.pn >> 3, pn = u.pn & 7;
        const int row0 = u.pm * 256 + wr * 64 + fr, j0 = pn * 128 + wc * 32 + 8 * fq;
        const float* bp = b1 + (size_t)e * (2 * FF) + 2 * j0;
        float bg[8], bl[8];
#pragma unroll
        for (int q = 0; q < 4; ++q) { const f32x4 t = *(const f32x4*)(bp + 4 * q); bg[2 * q] = t[0]; bl[2 * q] = t[1]; bg[2 * q + 1] = t[2]; bl[2 * q + 1] = t[3]; }
#pragma unroll
        for (int ai = 0; ai < 2; ++ai)
#pragma unroll
            for (int m = 0; m < 4; ++m) { float a[8];
#pragma unroll
                for (int i = 0; i < 8; ++i) { float gl = acc[ai][0][m][i >> 2][i & 3] + bg[i], li = acc[ai][1][m][i >> 2][i & 3] + bl[i];
                    gl = fminf(gl, 7.f); li = fminf(fmaxf(li, -7.f), 7.f);
                    a[i] = gl * frcp(1.f + fexp2(-1.702f * LOG2E * gl)) * (li + 1.f); }
                u32x4 w; w.x = cvt_pk_bf16(a[0], a[1]); w.y = cvt_pk_bf16(a[2], a[3]); w.z = cvt_pk_bf16(a[4], a[5]); w.w = cvt_pk_bf16(a[6], a[7]);
                *(u32x4*)(ACT + (size_t)(row0 + ai * 128 + m * 16) * FF + j0) = w; }
        return true;
    }
};
constexpr float ACT_SCALE = 12.f / 127.f;
struct EpiW1I8 {
    signed char* ACT  ; const float* b1  ; const float* RS  ; const float* CS  ;
    const LAS int* rowidx; int rt_lo;
    __device__ __forceinline__ bool operator()(acci_t& acc, const pg8::Unit& u, int wr, int wc, int fr, int fq) const {
        const int e = u.pn >> 3, pn = u.pn & 7;
        const int rl0 = wr * 64 + fr, row0 = u.pm * 256 + rl0, j0 = pn * 128 + wc * 32 + 8 * fq;
        const float* bp = b1 + (size_t)e * (2 * FF) + 2 * j0;
        float bg[8], bl[8], cg[8], cl[8];
#pragma unroll
        for (int q = 0; q < 4; ++q) { const f32x4 t = *(const f32x4*)(bp + 4 * q); bg[2 * q] = t[0]; bl[2 * q] = t[1]; bg[2 * q + 1] = t[2]; bl[2 * q + 1] = t[3]; }
        { const float* cp = CS + (size_t)e * 2048 + pn * 256 + wc * 32 + 8 * fq;
          const f32x4 a0 = *(const f32x4*)cp, a1 = *(const f32x4*)(cp + 4), c0 = *(const f32x4*)(cp + 128), c1 = *(const f32x4*)(cp + 132);
#pragma unroll
          for (int i = 0; i < 4; ++i) { cg[i] = a0[i]; cg[4 + i] = a1[i]; cl[i] = c0[i]; cl[4 + i] = c1[i]; } }
        const LAS int* ri = rowidx + (u.pm - rt_lo) * 256 + rl0;
        float rsv[8];
#pragma unroll
        for (int q = 0; q < 8; ++q) rsv[q] = RS[ri[(q >> 2) * 128 + (q & 3) * 16]];
        f32x2 bg2[4], bl2[4], cg2[4], cl2[4];
#pragma unroll
        for (int p = 0; p < 4; ++p) { bg2[p] = (f32x2){bg[2 * p], bg[2 * p + 1]}; bl2[p] = (f32x2){bl[2 * p], bl[2 * p + 1]}; cg2[p] = (f32x2){cg[2 * p], cg[2 * p + 1]}; cl2[p] = (f32x2){cl[2 * p], cl[2 * p + 1]}; }
#pragma unroll
        for (int ai = 0; ai < 2; ++ai)
#pragma unroll
            for (int m = 0; m < 4; ++m) { const float rs = rsv[ai * 4 + m]; f32x2 a2[4];
#pragma unroll
                for (int p = 0; p < 4; ++p) { const int i0 = 2 * p;
                    const f32x2 ag = {(float)acc[ai][0][m][i0 >> 2][i0 & 3], (float)acc[ai][0][m][(i0 + 1) >> 2][(i0 + 1) & 3]}, al = {(float)acc[ai][1][m][i0 >> 2][i0 & 3], (float)acc[ai][1][m][(i0 + 1) >> 2][(i0 + 1) & 3]};
                    f32x2 gl = ag * (cg2[p] * rs) + bg2[p], li = al * (cl2[p] * rs) + bl2[p];
                    gl[0] = fminf(gl[0], 7.f); gl[1] = fminf(gl[1], 7.f); li[0] = fminf(fmaxf(li[0], -7.f), 7.f); li[1] = fminf(fmaxf(li[1], -7.f), 7.f);
                    const f32x2 ex = gl * (-1.702f * LOG2E); f32x2 den = {fexp2(ex[0]), fexp2(ex[1])}; den = den + 1.f; const f32x2 rc = {frcp(den[0]), frcp(den[1])};
                    a2[p] = (gl * rc) * (li + 1.f); }
                u32x2 w; w.x = q8x4(a2[0][0], a2[0][1], a2[1][0], a2[1][1], 1.f / ACT_SCALE); w.y = q8x4(a2[2][0], a2[2][1], a2[3][0], a2[3][1], 1.f / ACT_SCALE);
                *(u32x2*)(ACT + (size_t)(row0 + ai * 128 + m * 16) * FF + j0) = w; }
        return true;
    }
};
struct EpiW2 {
    bf16_t* Y2; const float* b2  ; const float* CS  ;
    __device__ __forceinline__ bool operator()(acci_t& acc, const pg8::Unit& u, int wr, int wc, int fr, int fq) const {
        const int e = u.pn >> 2, pn = u.pn & 3;
        const int row0 = u.pm * 256 + wr * 64 + fr, col0 = pn * 256 + wc * 32 + 8 * fq;
        f32x4 bv[2][2], cv[2][2];
#pragma unroll
        for (int bj = 0; bj < 2; ++bj)
#pragma unroll
            for (int n = 0; n < 2; ++n) { bv[bj][n] = *(const f32x4*)(b2 + (size_t)e * DM + col0 + bj * 128 + 4 * n); cv[bj][n] = *(const f32x4*)(CS + (size_t)e * DM + col0 + bj * 128 + 4 * n) * ACT_SCALE; }
#pragma unroll
        for (int ai = 0; ai < 2; ++ai)
#pragma unroll
            for (int m = 0; m < 4; ++m) { bf16_t* rowp = Y2 + (size_t)(row0 + ai * 128 + m * 16) * DM + col0;
#pragma unroll
                for (int bj = 0; bj < 2; ++bj) { const i32x4 a0 = acc[ai][bj][m][0], a1 = acc[ai][bj][m][1];
                    const f32x4 v0 = (f32x4){(float)a0[0], (float)a0[1], (float)a0[2], (float)a0[3]} * cv[bj][0] + bv[bj][0], v1 = (f32x4){(float)a1[0], (float)a1[1], (float)a1[2], (float)a1[3]} * cv[bj][1] + bv[bj][1];
                    u32x4 w; w.x = cvt_pk_bf16(v0[0], v0[1]); w.y = cvt_pk_bf16(v0[2], v0[3]); w.z = cvt_pk_bf16(v1[0], v1[1]); w.w = cvt_pk_bf16(v1[2], v1[3]);
                    *(u32x4*)(rowp + bj * 128) = w; } }
        return true;
    }
};
#define XB_TMO      128
#define XB_XCNT(j)  (256  + 64 * (j))
#define XB_XSUB(j)  (1280 + 64 * (j))
#define XB_XGEN(j)  (2304 + 64 * (j))
#define XB_TOP      3328
#define XB_TOPGEN   3392
#define XCD_BAR_WORDS 3456
#define XB_SPIN_CAP (1u << 18)

__device__ __forceinline__ unsigned xb_ld(unsigned* p)              { return __hip_atomic_load(p, __ATOMIC_RELAXED, __HIP_MEMORY_SCOPE_AGENT); }
__device__ __forceinline__ unsigned xb_add(unsigned* p, unsigned v) { return __hip_atomic_fetch_add(p, v, __ATOMIC_RELAXED, __HIP_MEMORY_SCOPE_AGENT); }
__device__ __forceinline__ unsigned xb_xcc_id() { return (unsigned)__builtin_amdgcn_s_getreg((3 << 11) | 20) & 0xFu; }
#define XB_SPIN(cond, bar) do { unsigned _sp = 0; while (cond) { __builtin_amdgcn_s_sleep(1); \
    if ((++_sp & 255u) == 0u) { if (xb_ld(&(bar)[XB_TMO])) break; if (_sp > XB_SPIN_CAP) { atomicAdd(&(bar)[XB_TMO], 1u); break; } } } } while (0)

struct XcdBarrier {
    unsigned* bar; unsigned x;
    int w;
    volatile LAS unsigned* st;
};

__device__ __forceinline__ bool xb_thread0(int w) { return w == 0 && lane_id_volatile(2) == 0; }
__device__ __forceinline__ XcdBarrier xcd_barrier_post(unsigned* bar, volatile LAS unsigned* st, int w) {
    XcdBarrier b; b.bar = bar; b.x = xb_xcc_id(); b.st = st; b.w = w;
    if (xb_thread0(w)) (void)xb_add(&bar[XB_XCNT(b.x)], 1u);
    return b;
}
__device__ __forceinline__ void xcd_barrier_complete(unsigned* bar, unsigned x, unsigned& nloc, unsigned& nx) {
    const unsigned G = gridDim.x * gridDim.y * gridDim.z;
    unsigned sum, cnt, mine, sp = 0u;
    for (;;) {
        sum = 0u; cnt = 0u; mine = 0u;
#pragma unroll
        for (unsigned j = 0; j < 16; ++j) { const unsigned c = xb_ld(&bar[XB_XCNT(j)]); sum += c; cnt += (c > 0u) ? 1u : 0u; mine = (j == x) ? c : mine; }
        if (sum == G) break;
        __builtin_amdgcn_s_sleep(1);
        if ((++sp & 255u) == 0u) { if (xb_ld(&bar[XB_TMO])) break; if (sp > XB_SPIN_CAP) { atomicAdd(&bar[XB_TMO], 1u); break; } }
    }
    nloc = mine > 0u ? mine : 1u; nx = cnt > 0u ? cnt : 1u;
}

__device__ __forceinline__ void xcd_barrier(const XcdBarrier& b) {
    asm volatile("s_waitcnt vmcnt(0)" ::: "memory");
    __syncthreads();
    if (xb_thread0(b.w)) {
        unsigned* bar = b.bar;
        __builtin_amdgcn_s_waitcnt(0);
        unsigned nloc = b.st[0], nx = b.st[1];
        if (nloc == 0u) { xcd_barrier_complete(bar, b.x, nloc, nx); b.st[0] = nloc; b.st[1] = nx; }
        const unsigned old = xb_add(&bar[XB_XSUB(b.x)], 1u);
        const unsigned gen = old / nloc;
        if (old + 1u == (gen + 1u) * nloc) {
            __builtin_amdgcn_fence(__ATOMIC_RELEASE, "agent");
            asm volatile("s_waitcnt vmcnt(0)" ::: "memory");
            const unsigned og = xb_add(&bar[XB_TOP], 1u);
            const unsigned tg = og / nx;
            if (og + 1u == (tg + 1u) * nx) xb_add(&bar[XB_TOPGEN], 1u);
            else XB_SPIN(xb_ld(&bar[XB_TOPGEN]) == tg, bar);
            __builtin_amdgcn_fence(__ATOMIC_ACQUIRE, "agent");
            xb_add(&bar[XB_XGEN(b.x)], 1u);
            asm volatile("s_waitcnt vmcnt(0)" ::: "memory");
        } else {
            XB_SPIN(xb_ld(&bar[XB_XGEN(b.x)]) == gen, bar);
            __builtin_amdgcn_fence(__ATOMIC_ACQUIRE, "agent");
            asm volatile("s_waitcnt vmcnt(0)" ::: "memory");
        }
    }
    __syncthreads();
}

constexpr size_t MiB = 1u << 20;
constexpr size_t WS_CTL = 0, CTL_ZERO_BYTES = 1 * MiB;
constexpr size_t WS_MOD = 1 * MiB;
constexpr size_t WS_SGW = 3 * MiB;
constexpr size_t WS_WRT = 3 * MiB + 512 * 1024;
constexpr size_t WS_RS = 4 * MiB;
constexpr size_t WS_CS1 = 5 * MiB;
constexpr size_t WS_CS2 = 6 * MiB + 512 * 1024;
constexpr size_t WS_CSIN = 6 * MiB;
constexpr size_t WS_W = 8 * MiB, W_LAYER = 209 * MiB;
constexpr size_t WO_WIN = 0, WO_WBR = 12 * MiB, WO_WOUT = 15 * MiB, WO_W1 = 17 * MiB, WO_W2 = 145 * MiB;
constexpr size_t WS_PROJ = 426 * MiB;
constexpr size_t WS_GATES = 810 * MiB;
constexpr size_t WS_ACT = WS_PROJ;
constexpr size_t WS_X = 1002 * MiB;
constexpr size_t WS_H = 1194 * MiB;
constexpr size_t WS_O = 1322 * MiB;
constexpr size_t WS_Y = 1514 * MiB;
constexpr size_t WS_BITS = 1770 * MiB;
constexpr size_t WS_Y2 = WS_O;
constexpr size_t WS_SSP = 1850 * MiB;
constexpr size_t WS_ROWTOK = 1854 * MiB;
constexpr size_t WS_TOKINFO = 1862 * MiB;
constexpr size_t WS_SLAB = 1864 * MiB;
constexpr size_t WS_END = 1928 * MiB;
static_assert(WS_Y2 + (size_t)270336 * 2048 <= WS_SSP && WS_W + 2 * W_LAYER <= WS_PROJ && WS_PROJ + (size_t)MTOK * PLD * 2 <= WS_GATES && WS_GATES + (size_t)MTOK * 3072 <= WS_H, "d_ws map");
constexpr int CW_BAR = 4096;
constexpr int CW_CNT = 16384;

constexpr int RING_BYTES = 131072;
constexpr int MISC_OFF = 134144;
constexpr int TS_OFF = MISC_OFF + 512;
constexpr int TILE_E_OFF = MISC_OFF + 1024;
constexpr int ROWIDX_OFF = MISC_OFF + 5632;
constexpr int LDS_BYTES = 151552;
static_assert(ROWIDX_OFF + 8192 <= LDS_BYTES, "LDS map");

struct Args {
    const float* in[21]; float* out; unsigned char* ws; int ph_lo, ph_hi;
};
struct Frame {
    LAS unsigned char* lds; int tid, lane, wave, vcu, G;
};
__device__ __forceinline__ Frame phase_frame(const Frame& F0) { Frame F = F0; int t = F0.wave * 64 + lane_id_volatile(3); asm volatile("" : "+v"(t)); F.tid = t; F.lane = t & 63; F.wave = F0.wave; return F; }
template <class T> __device__ __forceinline__ T* opq(T* p) { long z = 0; asm volatile("" : "+s"(z)); return (T*)((unsigned char*)p + z); }

__device__ __forceinline__ void p0_mod(const Frame& F, const float* c, const float* w_ada, const float* b_ada, float* MOD) {
    LAS float* csT = (LAS float*)F.lds;
    for (int i = F.tid; i < BATCH * DM; i += 512) { const int b = i & 31, k = i >> 5; const float v = c[b * DM + k]; csT[k * 32 + b] = v * sigmoidf_(v); }
    __syncthreads();
    const int gw = F.vcu * 8 + F.wave, NGW = F.G * 8;
    const int cg = F.lane & 15, kq = F.lane >> 4;
    for (int task = gw; task < DEPTH * 384; task += NGW) {
        const int l = task / 384, n = (task % 384) * 16 + cg;
        float acc[32];
#pragma unroll
        for (int b = 0; b < 32; ++b) acc[b] = 0.f;
        const float* w = w_ada + ((size_t)l * DM + kq * 256) * (6 * DM) + n;
#pragma unroll 4
        for (int k = 0; k < 256; ++k) {
            const float wv = w[(size_t)k * (6 * DM)];
            const LAS f32x4* cs = (const LAS f32x4*)(csT + (kq * 256 + k) * 32);
#pragma unroll
            for (int q = 0; q < 8; ++q) { const f32x4 c4 = cs[q]; acc[4 * q] += c4[0] * wv; acc[4 * q + 1] += c4[1] * wv; acc[4 * q + 2] += c4[2] * wv; acc[4 * q + 3] += c4[3] * wv; }
        }
#pragma unroll
        for (int b = 0; b < 32; ++b) { acc[b] = xor32_add(xor16_add(acc[b])); }
        if (kq == 0) { const float bb = b_ada[l * 6 * DM + n];
#pragma unroll
            for (int b = 0; b < 32; ++b) MOD[((size_t)l * BATCH + b) * (6 * DM) + n] = acc[b] + bb; }
    }
    __syncthreads();
}
__device__ __forceinline__ void tr_item(const float* W, size_t ldw, int srccol, bool valid, bf16_t* dst  , int K, LAS float* scr, int lane) {
    const float* wp = W + srccol;
#pragma unroll 8
    for (int i = 0; i < 32; ++i) { const int kk = 2 * i + (lane >> 5); scr[kk * 33 + (lane & 31)] = valid ? wp[(size_t)kk * ldw] : 0.f; }
    LDS_WAIT(); asm volatile("" ::: "memory");
    const int c = lane & 7;
#pragma unroll
    for (int j = 0; j < 4; ++j) { const int n = (lane >> 3) + 8 * j; const LAS float* s = scr + (8 * c) * 33 + n;
        u32x4 o; o.x = cvt_pk_bf16(s[0 * 33], s[1 * 33]); o.y = cvt_pk_bf16(s[2 * 33], s[3 * 33]); o.z = cvt_pk_bf16(s[4 * 33], s[5 * 33]); o.w = cvt_pk_bf16(s[6 * 33], s[7 * 33]);
        *(u32x4*)(dst + (size_t)n * K + 8 * c) = o; }
    LDS_WAIT(); asm volatile("" ::: "memory");
}
__device__ __forceinline__ void p0_weights(const Frame& F, const Args& a) {
    LAS float* scr = (LAS float*)(F.lds + F.wave * 16384);
    const int gw = F.vcu * 8 + F.wave, NGW = F.G * 8, lane = F.lane, jl = lane & 31;
    const float *w_in = a.in[8], *w_branch = a.in[13], *w_out = a.in[14], *w_router = a.in[15], *w1 = a.in[17], *w2 = a.in[19];
    constexpr int I_BR = 3 * 8 * 32, I_OUT = 16 * 32, I_RT = 16;
    constexpr int I_LAYER = I_BR + I_OUT + I_RT;
    for (int it = gw; it < DEPTH * I_LAYER; it += NGW) {
        const int l = it / I_LAYER; int r = it - l * I_LAYER;
        unsigned char* wl = a.ws + WS_W + (size_t)l * W_LAYER;
        if (r < I_BR) {
            const int br = r / 256, q = r % 256, kb = q / 32, nb = q % 32;
            tr_item(w_branch + ((size_t)(l * 3 + br) * 512 + kb * 64) * DM, DM, nb * 32 + jl, true, (bf16_t*)(wl + WO_WBR) + (size_t)(br * 1024 + nb * 32) * 512 + kb * 64, 512, scr, lane); continue; }
        r -= I_BR;
        if (r < I_OUT) {
            const int kb = r / 32, nb = r % 32;
            tr_item(w_out + ((size_t)l * DM + kb * 64) * DM, DM, nb * 32 + jl, true, (bf16_t*)(wl + WO_WOUT) + (size_t)nb * 32 * DM + kb * 64, DM, scr, lane); continue; }
        r -= I_OUT;
        {
            const int kb = r;
            tr_item(w_router + ((size_t)l * DM + kb * 64) * NE, NE, jl, true, (bf16_t*)(a.ws + WS_WRT) + (size_t)l * NE * DM + kb * 64, DM, scr, lane); }
        (void)r;
    }
    __syncthreads();
    {
    LAS float* T = (LAS float*)F.lds; LAS float* red = (LAS float*)(F.lds + ROWIDX_OFF);
    const int half = lane >> 5, wave = F.wave;
    constexpr int ST_W1 = NE * 64, ST_IN = 192, ST_W2 = NE * 32, ST_LAYER = ST_W1 + ST_IN + ST_W2;
    for (int st = F.vcu; st < DEPTH * ST_LAYER; st += F.G) {
        const int l = st / ST_LAYER, q = st % ST_LAYER;
        const float* wp; size_t ldw; bool valid = true; signed char* dst; float* csp;
        if (q < ST_W1) { const int e = q / 64, r6 = q % 64, pn = r6 >> 3, jjg = (r6 >> 1) & 3, sgl = r6 & 1, nb = pn * 8 + sgl * 4 + jjg, n = nb * 32 + jl, src = 2 * (128 * pn + jjg * 32 + jl) + sgl;
            wp = w1 + ((size_t)(l * NE + e) * DM) * (2 * FF) + src; ldw = 2 * FF;
            dst = (signed char*)(a.ws + WS_W + (size_t)l * W_LAYER + WO_W1) + ((size_t)e * 2048 + nb * 32) * DM; csp = (float*)(a.ws + WS_CS1) + ((size_t)l * NE + e) * 2048 + n; }
        else if (q >= ST_W1 + ST_IN) { const int q2 = q - ST_W1 - ST_IN, e = q2 / 32, nb = q2 % 32, n = nb * 32 + jl;
            wp = w2 + ((size_t)(l * NE + e) * FF) * DM + n; ldw = DM;
            dst = (signed char*)(a.ws + WS_W + (size_t)l * W_LAYER + WO_W2) + ((size_t)e * DM + nb * 32) * FF; csp = (float*)(a.ws + WS_CS2) + ((size_t)l * NE + e) * DM + n; }
        else { const int nb = q - ST_W1, n = nb * 32 + jl; valid = (n < 1832) || (n >= 2048); const int src = n < 1832 ? n : n - 216;
            wp = w_in + (size_t)l * DM * 5928 + (valid ? src : 0); ldw = 5928;
            dst = (signed char*)(a.ws + WS_W + (size_t)l * W_LAYER + WO_WIN) + (size_t)nb * 32 * DM; csp = (float*)(a.ws + WS_CSIN) + (size_t)l * NPROJ + n; }
        float am = 0.f;
#pragma unroll
        for (int ib = 0; ib < 2; ++ib) { float vv[32];
#pragma unroll
            for (int i = 0; i < 32; ++i) { const int k = wave * 128 + 2 * (ib * 32 + i) + half; vv[i] = valid ? __builtin_nontemporal_load(wp + (size_t)k * ldw) : 0.f; }
#pragma unroll
            for (int i = 0; i < 32; ++i) { const int k = wave * 128 + 2 * (ib * 32 + i) + half; am = fmaxf(am, fabsf(vv[i])); T[k * 32 + (jl ^ (k & 31))] = vv[i]; } }
        red[(wave * 2 + half) * 32 + jl] = am;
        __syncthreads();
        float amx = 0.f;
#pragma unroll
        for (int p = 0; p < 16; ++p) amx = fmaxf(amx, red[p * 32 + jl]);
        const float scale = valid ? fmaxf(amx, 1e-30f) * (1.f / 127.f) : 1.f, inv = valid ? 1.f / scale : 0.f;
        if (wave == 0 && half == 0) *csp = scale;
        const int k0 = 64 * (wave * 2 + half);
#pragma unroll
        for (int c16 = 0; c16 < 4; ++c16) { unsigned wq[4];
#pragma unroll
            for (int d4 = 0; d4 < 4; ++d4) { const int k = k0 + c16 * 16 + d4 * 4;
                wq[d4] = q8x4(T[k * 32 + (jl ^ (k & 31))], T[(k + 1) * 32 + (jl ^ ((k + 1) & 31))], T[(k + 2) * 32 + (jl ^ ((k + 2) & 31))], T[(k + 3) * 32 + (jl ^ ((k + 3) & 31))], inv); }
            *(u32x4*)(dst + (size_t)jl * DM + k0 + c16 * 16) = (u32x4){wq[0], wq[1], wq[2], wq[3]}; }
        __syncthreads();
    }
    }
    const float* sg_w = a.in[10]; bf16_t* SGW = (bf16_t*)(a.ws + WS_SGW);
    for (int i = (F.vcu * 512 + F.tid) * 2; i < DEPTH * 8 * 128 * 128; i += F.G * 512 * 2) { const int s = i & 127, t = (i >> 7) & 127; const f32x2 v = *(const f32x2*)(sg_w + i);
        *(unsigned*)(SGW + i) = cvt_pk_bf16(s <= t ? v[0] : 0.f, (s + 1) <= t ? v[1] : 0.f); }
}

__device__ __forceinline__ void norm_mod_row(const f32x4 (&v)[4], float ss, const float* g, const float* sc, const float* sh, signed char* orow, float* rs, int lane) {
    const float rstd = 1.f / sqrtf(ss * (1.f / DM) + RMS_EPS);
    f32x4 o[4]; float am = 0.f;
#pragma unroll
    for (int j = 0; j < 4; ++j) { const int c = 4 * lane + 256 * j; const f32x4 gg = *(const f32x4*)(g + c), s1 = *(const f32x4*)(sc + c), s0 = *(const f32x4*)(sh + c);
        o[j] = (v[j] * rstd) * gg * (s1 + 1.f) + s0;
        am = fmaxf(am, fmaxf(fmaxf(fabsf(o[j][0]), fabsf(o[j][1])), fmaxf(fabsf(o[j][2]), fabsf(o[j][3])))); }
    am = wave_max(am);
    const float scale = fmaxf(am, 1e-30f) * (1.f / 127.f), inv = 1.f / scale;
    if (lane == 0) *rs = scale;
#pragma unroll
    for (int j = 0; j < 4; ++j) *(unsigned*)(orow + 4 * lane + 256 * j) = q8x4(o[j][0], o[j][1], o[j][2], o[j][3], inv);
}
__device__ __forceinline__ void p1_norm(const Frame& F, const float* x, const float* g, const float* MOD0, signed char* H8, float* RS, bf16_t* X16) {
    const int gw = F.vcu * 8 + F.wave, NGW = F.G * 8;
    for (int row0 = gw * 4; row0 < MTOK; row0 += NGW * 4) { f32x4 v[4][4];
#pragma unroll
        for (int rr = 0; rr < 4; ++rr)
#pragma unroll
            for (int j = 0; j < 4; ++j) v[rr][j] = __builtin_nontemporal_load((const f32x4*)(x + (size_t)(row0 + rr) * DM + 4 * F.lane + 256 * j));
#pragma unroll
        for (int rr = 0; rr < 4; ++rr) { const int row = row0 + rr, b = row >> 11; float ss = 0.f;
#pragma unroll
            for (int j = 0; j < 4; ++j) ss += (v[rr][j][0] * v[rr][j][0] + v[rr][j][1] * v[rr][j][1]) + (v[rr][j][2] * v[rr][j][2] + v[rr][j][3] * v[rr][j][3]);
            ss = wave_sum(ss);
#pragma unroll
            for (int j = 0; j < 4; ++j) { u32x2 w; w.x = cvt_pk_bf16(v[rr][j][0], v[rr][j][1]); w.y = cvt_pk_bf16(v[rr][j][2], v[rr][j][3]); *(u32x2*)(X16 + (size_t)row * DM + 4 * F.lane + 256 * j) = w; }
            const float* mb = MOD0 + (size_t)b * 6 * DM;
            norm_mod_row(v[rr], ss, g, mb + DM, mb, H8 + (size_t)row * DM, RS + row, F.lane); } }
}
constexpr int TOPK_SEL = 256;
struct IdxOps { bf16x8 af[4][2]; u32x4 wraw[4][2]; bf16x8 kf[4][2]; };
__device__ __forceinline__ void dsa_index_load(IdxOps& P, const bf16_t* __restrict__ PROJ, int b, int qg, int lane, int wid) {
    asm volatile("" : "+v"(lane));
    const int n = lane & 31, hi = lane >> 5;
    const int q0 = qg * 16;
    const size_t tokbase = (size_t)b * SEQ;
    const int m = n, hm = (m >> 2) & 1, idx = (m & 3) + 4 * (m >> 3), aq = 2 * hm + (idx >> 3), ah = idx & 7;
#pragma unroll
    for (int qgp = 0; qgp < 4; ++qgp) { const bf16_t* qp = PROJ + (tokbase + q0 + 4 * qgp + aq) * PLD + C_QI + ah * 32 + 8 * hi;
        P.af[qgp][0] = *(const bf16x8*)qp; P.af[qgp][1] = *(const bf16x8*)(qp + 16); }
}
__device__ __forceinline__ void dsa_index_load_k(IdxOps& P, const bf16_t* __restrict__ PROJ, int b, int qg, int lane, int wid) {
    asm volatile("" : "+v"(lane));
    const int n = lane & 31, hi = lane >> 5;
    const int q0 = qg * 16, nkb = (q0 + 16 + 31) >> 5;
    const size_t tokbase = (size_t)b * SEQ;
#pragma unroll
    for (int qgp = 0; qgp < 4; ++qgp)
#pragma unroll
        for (int qq = 0; qq < 2; ++qq) P.wraw[qgp][qq] = *(const u32x4*)(PROJ + (tokbase + q0 + 4 * qgp + 2 * hi + qq) * PLD + C_WI);
#pragma unroll
    for (int i = 0; i < 4; ++i) { const int kb = wid + 8 * i;
        if (kb < nkb) { const bf16_t* kp = PROJ + (tokbase + 32 * kb + n) * PLD + C_KI + 8 * hi; P.kf[i][0] = *(const bf16x8*)kp; P.kf[i][1] = *(const bf16x8*)(kp + 16); } }
}
__device__ __forceinline__ void dsa_index_scores(IdxOps& P, const bf16_t* __restrict__ PROJ, LAS float* sc, int b, int qg, int lane, int wid) {
    const int n = lane & 31, hi = lane >> 5;
    const int q0 = qg * 16, nkb = (q0 + 16 + 31) >> 5;
    const size_t tokbase = (size_t)b * SEQ;
    LAS float* scw = sc + (2 * hi) * 2048 + 32 * wid + n;
    float wv[4][16];
#pragma unroll
    for (int qgp = 0; qgp < 4; ++qgp)
#pragma unroll
        for (int qq = 0; qq < 2; ++qq) { const u32x4 w = P.wraw[qgp][qq];
            wv[qgp][8 * qq + 0] = bf_lo(w.x) * 0.0625f; wv[qgp][8 * qq + 1] = bf_hi(w.x) * 0.0625f; wv[qgp][8 * qq + 2] = bf_lo(w.y) * 0.0625f; wv[qgp][8 * qq + 3] = bf_hi(w.y) * 0.0625f;
            wv[qgp][8 * qq + 4] = bf_lo(w.z) * 0.0625f; wv[qgp][8 * qq + 5] = bf_hi(w.z) * 0.0625f; wv[qgp][8 * qq + 6] = bf_lo(w.w) * 0.0625f; wv[qgp][8 * qq + 7] = bf_hi(w.w) * 0.0625f; }
#pragma unroll
    for (int i = 0; i < 8; ++i) { const int kb = wid + 8 * i;
        if (kb < nkb) {
            const bf16x8 k0 = P.kf[i & 3][0], k1 = P.kf[i & 3][1];
            if (i < 4 && kb + 32 < nkb) { const bf16_t* kp = PROJ + (tokbase + 32 * (kb + 32) + n) * PLD + C_KI + 8 * hi; P.kf[i & 3][0] = *(const bf16x8*)kp; P.kf[i & 3][1] = *(const bf16x8*)(kp + 16); }
#pragma unroll
            for (int qgp = 0; qgp < 4; ++qgp) {
                f32x16 d = {0.f, 0.f, 0.f, 0.f, 0.f, 0.f, 0.f, 0.f, 0.f, 0.f, 0.f, 0.f, 0.f, 0.f, 0.f, 0.f};
                d = __builtin_amdgcn_mfma_f32_32x32x16_bf16(P.af[qgp][0], k0, d, 0, 0, 0);
                d = __builtin_amdgcn_mfma_f32_32x32x16_bf16(P.af[qgp][1], k1, d, 0, 0, 0);
                float sa = 0.f, sb = 0.f;
#pragma unroll
                for (int r = 0; r < 8; ++r) { sa += wv[qgp][r] * fmaxf(d[r], 0.f); sb += wv[qgp][8 + r] * fmaxf(d[8 + r], 0.f); }
                scw[(4 * qgp) * 2048 + 256 * i] = sa; scw[(4 * qgp + 1) * 2048 + 256 * i] = sb;
            } } }
}
__device__ __forceinline__ void bit_transpose32(unsigned (&a)[32]) {
#pragma unroll
    for (int k = 0; k < 16; ++k) { const unsigned lo = a[k], hi = a[k + 16];
        a[k] = __builtin_amdgcn_perm(hi, lo, 0x05040100u); a[k + 16] = __builtin_amdgcn_perm(hi, lo, 0x07060302u); }
#pragma unroll
    for (int k = 0; k < 32; ++k) if ((k & 8) == 0) { const unsigned lo = a[k], hi = a[k + 8];
        a[k] = __builtin_amdgcn_perm(hi, lo, 0x06020400u); a[k + 8] = __builtin_amdgcn_perm(hi, lo, 0x07030501u); }
#pragma unroll
    for (int s = 0; s < 3; ++s) { const int j = 4 >> s; const unsigned m = (s == 0) ? 0x0F0F0F0Fu : (s == 1) ? 0x33333333u : 0x55555555u;
#pragma unroll
        for (int k = 0; k < 32; ++k) if ((k & j) == 0) { const unsigned lo = a[k], hi = a[k + j];
            a[k] = (m & lo) | (~m & (hi << j)); a[k + j] = (m & (lo >> j)) | (~m & hi); } }
}
__device__ __forceinline__ void dsa_index_select(LAS float* sc, LAS int* qctr, unsigned long long* __restrict__ bits64, int b, int qg, int lane, int wid) {
    const int q0 = qg * 16;
    const size_t tokbase = (size_t)b * SEQ;
#pragma unroll 1
    for (;;) {
        int qn = 0; if (lane == 0) qn = __hip_atomic_fetch_add(qctr, 1, __ATOMIC_RELAXED, __HIP_MEMORY_SCOPE_WORKGROUP);
        qn = __builtin_amdgcn_readfirstlane(qn); if (qn >= 16) break;
        const int ql = 15 - qn, pos = q0 + ql, nn = pos + 1, nr = (nn + 63) >> 6;
        const LAS float* scq = sc + ql * 2048;
        unsigned mlo = 0u, mhi = 0u;
        if (nn <= TOPK_SEL) {
#pragma unroll
            for (int r = 0; r < 4; ++r) if (r < nr) { const unsigned long long bal = __ballot(64 * r + lane <= pos); asm volatile("s_nop 4\n\tv_writelane_b32 %0, %2, %4\n\tv_writelane_b32 %1, %3, %4" : "+v"(mlo), "+v"(mhi) : "s"((unsigned)bal), "s"((unsigned)(bal >> 32)), "n"(r));     }
        } else {
            unsigned u[32];
#pragma unroll
            for (int r = 0; r < 32; ++r) u[r] = 0u;
#pragma unroll
            for (int g8 = 0; g8 < 4; ++g8) if (8 * g8 < nr) {
#pragma unroll
                for (int q_ = 0; q_ < 8; ++q_) { const int r = 8 * g8 + q_; const int j = 64 * r + lane; float s = scq[j]; s = (s == 0.f) ? 0.f : s; const unsigned bts = __builtin_bit_cast(unsigned, s);
                    const unsigned uu = (bts & 0x80000000u) ? ~bts : (bts | 0x80000000u); u[r] = (j <= pos) ? uu : 0u; } }
            unsigned M = 0u;
#pragma unroll
            for (int r = 0; r < 32; ++r) M |= (64 * r + lane <= pos) ? (1u << r) : 0u;
            bit_transpose32(u);
            unsigned G = 0u; unsigned need = (unsigned)TOPK_SEL, cM = (unsigned)nn;
            {
#pragma unroll
            for (int bq = 31; bq >= 0; --bq) {
                const unsigned T = M & u[bq];
                const unsigned c = wave_sum_u32((unsigned)__builtin_popcount(T));
                const bool ge = c >= need;
                G |= ge ? 0u : T; M = ge ? T : (M & ~u[bq]); cM = ge ? c : cM - c; need -= ge ? 0u : c;
                if (cM == need) { G |= M; goto sel_done; }
            }
            unsigned run = 0u;
#pragma unroll
            for (int r = 0; r < 32; ++r) if (r < nr) { const bool isc = (M >> r) & 1u; const unsigned long long eqm = __ballot(isc);
                const unsigned pre = run + __builtin_amdgcn_mbcnt_hi((unsigned)(eqm >> 32), __builtin_amdgcn_mbcnt_lo((unsigned)eqm, 0u));
                if (isc && pre < need) G |= (1u << r);
                run += (unsigned)__builtin_popcountll(eqm); }
            }
            sel_done:
#pragma unroll
            for (int r = 0; r < 32; ++r) if ((r & ~7) < nr) { const unsigned long long bal = __ballot((G >> r) & 1u); asm volatile("s_nop 4\n\tv_writelane_b32 %0, %2, %4\n\tv_writelane_b32 %1, %3, %4" : "+v"(mlo), "+v"(mhi) : "s"((unsigned)bal), "s"((unsigned)(bal >> 32)), "n"(r));     }
        }
        if (lane < nr) bits64[(tokbase + pos) * 32 + lane] = ((unsigned long long)mhi << 32) | mlo;
    }
}
__device__ __forceinline__ void dsa_index_phase(const Frame& F, const bf16_t* __restrict__ PROJ, unsigned long long* __restrict__ bits64, unsigned* stampw, bool pv = false) {
    LAS float* sc = (LAS float*)F.lds;
    LAS int* qctr = (LAS int*)(F.lds + TS_OFF);
    IdxOps P;
    int u = F.vcu;
    if (u < 4096) { dsa_index_load(P, PROJ, u & 31, u >> 5, F.lane, F.wave); dsa_index_load_k(P, PROJ, u & 31, u >> 5, F.lane, F.wave); }
#ifdef T_STAMP
    unsigned long long tA = 0, tB = 0, tC = 0, tD = 0, t0 = __builtin_amdgcn_s_memrealtime(), t1;
#define STAMP(acc) do { t1 = __builtin_amdgcn_s_memrealtime(); acc += t1 - t0; t0 = t1; } while (0)
#else
#define STAMP(acc) do { } while (0)
#endif
#pragma unroll 1
    for (; u < 4096; u += F.G) {
#if defined(IDX_PROBE) && (IDX_PROBE & 1)
        if (!pv)
#endif
        dsa_index_scores(P, PROJ, sc, u & 31, u >> 5, F.lane, F.wave);
        if (F.tid == 0) *qctr = 0;
        STAMP(tA);
        __syncthreads();
        STAMP(tB);
        const int un = u + F.G;
#if defined(IDX_PROBE) && (IDX_PROBE & 2)
        if (!pv)
#endif
        dsa_index_select(sc, qctr, bits64, u & 31, u >> 5, F.lane, F.wave);
        asm volatile("" ::: "memory");
        if (un < 4096) { dsa_index_load(P, PROJ, un & 31, un >> 5, F.lane, F.wave); dsa_index_load_k(P, PROJ, un & 31, un >> 5, F.lane, F.wave); }
        STAMP(tC);
        __syncthreads();
        STAMP(tD);
    }
#ifdef T_STAMP
    if (stampw && blockIdx.x == 17 && F.tid == 0) { const unsigned long long tot = tA + tB + tC + tD; const unsigned long long part = (T_STAMP == 0) ? tA : (T_STAMP == 1) ? tB : (T_STAMP == 2) ? tC : tD;
        *stampw = (unsigned)((part * 64ull) / (tot ? tot : 1ull)); }
#endif
#undef STAMP
}

constexpr int KS = 144, VS = 192;
#ifndef USE_TR
#define USE_TR 1
#endif
template <int MODE>
__device__ __forceinline__ void attn_unit(const Frame& F, const bf16_t* __restrict__ PROJ, bf16_t* __restrict__ O, const unsigned* __restrict__ bits, const float* __restrict__ sinks, int b, int g, int qb) {
    const int tid = F.tid, lane = F.lane, wid = F.wave, n = lane & 31, hi = lane >> 5;
    constexpr int CQ = MODE ? C_QB : C_QA, CK = MODE ? C_KB : C_KA, CV = MODE ? C_VB : C_VA;
    const int hq = 4 * g + (wid >> 1), qpos = qb * 64 + 32 * (wid & 1) + n;
    const size_t tokbase = (size_t)b * SEQ;
    LAS unsigned char* Ks = F.lds; LAS unsigned char* Vs = F.lds + 64 * KS;
    bf16x8 qf[4];
    { const bf16_t* qp = PROJ + (tokbase + qpos) * PLD + CQ + hq * 64 + 8 * hi;
#pragma unroll
      for (int s = 0; s < 4; ++s) qf[s] = *(const bf16x8*)(qp + 16 * s); }
    f32x16 o0, o1;
#pragma unroll
    for (int r = 0; r < 16; ++r) { o0[r] = 0.f; o1[r] = 0.f; }
    float mrun, lsum;
    if (MODE == 0) { mrun = sinks[hq] * LOG2E; lsum = (hi == 0) ? 1.f : 0.f; } else { mrun = -1e30f; lsum = 0.f; }
    const int kt_lo = (MODE == 0) ? (qb >= 2 ? qb - 2 : 0) : 0, kt_hi = qb;
    const int srow = tid >> 3, sch = tid & 7;
    const bf16_t* kg = PROJ + (tokbase + srow) * PLD + CK + g * 64 + sch * 8;
    const bf16_t* vg = PROJ + (tokbase + srow) * PLD + CV + g * 64 + sch * 8;
    const unsigned* bp = bits + (tokbase + qpos) * 64;
    u32x4 kreg = *(const u32x4*)(kg + (size_t)kt_lo * 64 * PLD), vreg = *(const u32x4*)(vg + (size_t)kt_lo * 64 * PLD);
    u32x2 mreg = {0u, 0u};
    if (MODE == 1) mreg = *(const u32x2*)(bp + 2 * kt_lo);
    const int vbase = (4 * hi + ((lane & 15) >> 2)) * VS + (16 * ((lane >> 4) & 1) + 4 * (lane & 3)) * 2;
    for (int kt = kt_lo; kt <= kt_hi; ++kt) {
        __syncthreads();
        *(LAS u32x4*)(Ks + srow * KS + sch * 16) = kreg; *(LAS u32x4*)(Vs + srow * VS + sch * 16) = vreg;
        const u32x2 mcur = mreg;
        __syncthreads();
        if (kt < kt_hi) { kreg = *(const u32x4*)(kg + (size_t)(kt + 1) * 64 * PLD); vreg = *(const u32x4*)(vg + (size_t)(kt + 1) * 64 * PLD); if (MODE == 1) mreg = *(const u32x2*)(bp + 2 * (kt + 1)); }
        f32x16 p0, p1;
#pragma unroll
        for (int r = 0; r < 16; ++r) { p0[r] = 0.f; p1[r] = 0.f; }
#pragma unroll
        for (int s = 0; s < 4; ++s) { const bf16x8 k0 = *(const LAS bf16x8*)(Ks + n * KS + (16 * s + 8 * hi) * 2), k1 = *(const LAS bf16x8*)(Ks + (n + 32) * KS + (16 * s + 8 * hi) * 2);
            p0 = __builtin_amdgcn_mfma_f32_32x32x16_bf16(k0, qf[s], p0, 0, 0, 0); p1 = __builtin_amdgcn_mfma_f32_32x32x16_bf16(k1, qf[s], p1, 0, 0, 0); }
        unsigned w0, w1;
        if (MODE == 1) { w0 = mcur.x >> (4 * hi); w1 = mcur.y >> (4 * hi); }
        else {
#pragma unroll
            for (int blk = 0; blk < 2; ++blk) { const int d0 = qpos - (kt * 64 + 32 * blk); unsigned mk = 0u;
                if (d0 >= 0) { const int hb = d0 > 31 ? 31 : d0; int lo = d0 - 127; if (lo <= 31) { if (lo < 0) lo = 0; mk = (0xFFFFFFFFu >> (31 - hb)) & (0xFFFFFFFFu << lo); } }
                if (blk == 0) w0 = mk >> (4 * hi); else w1 = mk >> (4 * hi); }
        }
        float mx = fmaxf(fmaxf(p0[0], p0[1]), fmaxf(p1[0], p1[1]));
#pragma unroll
        for (int r = 2; r < 16; r += 2) mx = fmaxf(mx, fmaxf(fmaxf(p0[r], p0[r + 1]), fmaxf(p1[r], p1[r + 1])));
        mx = xor32_max(mx);
        const float mnew = fmaxf(mrun, mx), alpha = fexp2(mrun - mnew); mrun = mnew;
        float ps = 0.f;
#pragma unroll
        for (int r = 0; r < 16; ++r) { const int bitpos = 8 * (r >> 2) + (r & 3);
            const float e0 = fexp2(p0[r] - mnew), e1 = fexp2(p1[r] - mnew);
            p0[r] = __builtin_bit_cast(float, __builtin_bit_cast(unsigned, e0) & (unsigned)__builtin_amdgcn_sbfe((int)w0, bitpos, 1));
            p1[r] = __builtin_bit_cast(float, __builtin_bit_cast(unsigned, e1) & (unsigned)__builtin_amdgcn_sbfe((int)w1, bitpos, 1));
            ps += p0[r] + p1[r]; }
        lsum = lsum * alpha + ps;
        if (__builtin_amdgcn_ballot_w64(alpha != 1.f) != 0ull) {
#pragma unroll
            for (int r = 0; r < 16; ++r) { o0[r] *= alpha; o1[r] *= alpha; } }
        bf16x8 pf[2][2];
#pragma unroll
        for (int s2 = 0; s2 < 2; ++s2) { u32x4 a, c;
            a.x = cvt_pk_bf16(p0[8 * s2 + 0], p0[8 * s2 + 1]); a.y = cvt_pk_bf16(p0[8 * s2 + 2], p0[8 * s2 + 3]); a.z = cvt_pk_bf16(p0[8 * s2 + 4], p0[8 * s2 + 5]); a.w = cvt_pk_bf16(p0[8 * s2 + 6], p0[8 * s2 + 7]);
            c.x = cvt_pk_bf16(p1[8 * s2 + 0], p1[8 * s2 + 1]); c.y = cvt_pk_bf16(p1[8 * s2 + 2], p1[8 * s2 + 3]); c.z = cvt_pk_bf16(p1[8 * s2 + 4], p1[8 * s2 + 5]); c.w = cvt_pk_bf16(p1[8 * s2 + 6], p1[8 * s2 + 7]);
            pf[0][s2] = __builtin_bit_cast(bf16x8, a); pf[1][s2] = __builtin_bit_cast(bf16x8, c); }
#pragma unroll
        for (int db = 0; db < 2; ++db)
#pragma unroll
            for (int blk = 0; blk < 2; ++blk)
#pragma unroll
                for (int s2 = 0; s2 < 2; ++s2) {
                    bf16x8 vf;
#if USE_TR
                    const v4i16_t t0 = __builtin_amdgcn_ds_read_tr16_b64_v4i16((LAS v4i16_t*)(Vs + vbase + (32 * blk + 16 * s2) * VS + 64 * db));
                    const v4i16_t t1 = __builtin_amdgcn_ds_read_tr16_b64_v4i16((LAS v4i16_t*)(Vs + vbase + (32 * blk + 16 * s2 + 8) * VS + 64 * db));
                    vf = (bf16x8){t0[0], t0[1], t0[2], t0[3], t1[0], t1[1], t1[2], t1[3]};
#else
#pragma unroll
                    for (int j = 0; j < 8; ++j) vf[j] = *(const LAS short*)(Vs + (32 * blk + 16 * s2 + 8 * (j >> 2) + 4 * hi + (j & 3)) * VS + (32 * db + n) * 2);
#endif
                    if (db == 0) o0 = __builtin_amdgcn_mfma_f32_32x32x16_bf16(vf, pf[blk][s2], o0, 0, 0, 0); else o1 = __builtin_amdgcn_mfma_f32_32x32x16_bf16(vf, pf[blk][s2], o1, 0, 0, 0);
                }
    }
    const float lt = xor32_add(lsum), inv = 1.f / lt;
    bf16_t* op = O + (tokbase + qpos) * 512 + hq * 64 + 8 * hi;
#pragma unroll
    for (int db = 0; db < 2; ++db)
#pragma unroll
        for (int kp = 0; kp < 2; ++kp) { const int r0 = 8 * kp;
            unsigned ax, ay, bx, by;
            if (db == 0) { ax = cvt_pk_bf16(o0[r0] * inv, o0[r0 + 1] * inv); ay = cvt_pk_bf16(o0[r0 + 2] * inv, o0[r0 + 3] * inv); bx = cvt_pk_bf16(o0[r0 + 4] * inv, o0[r0 + 5] * inv); by = cvt_pk_bf16(o0[r0 + 6] * inv, o0[r0 + 7] * inv); }
            else { ax = cvt_pk_bf16(o1[r0] * inv, o1[r0 + 1] * inv); ay = cvt_pk_bf16(o1[r0 + 2] * inv, o1[r0 + 3] * inv); bx = cvt_pk_bf16(o1[r0 + 4] * inv, o1[r0 + 5] * inv); by = cvt_pk_bf16(o1[r0 + 6] * inv, o1[r0 + 7] * inv); }
            { auto r = __builtin_amdgcn_permlane32_swap(ax, bx, false, false); ax = r[0]; bx = r[1]; }
            { auto r = __builtin_amdgcn_permlane32_swap(ay, by, false, false); ay = r[0]; by = r[1]; }
            *(u32x4*)(op + 32 * db + 16 * kp) = (u32x4){ax, ay, bx, by}; }
}

constexpr int SGS = 1040;
static_assert(128 * SGS <= MISC_OFF, "spatial-gating tile vs LDS control words");
__device__ __forceinline__ void sg_unit(const Frame& F, const bf16_t* __restrict__ PROJ, const bf16_t* __restrict__ SGWl, const float* __restrict__ sgb, const float* __restrict__ lng, bf16_t* __restrict__ OC, int b, int ch) {
    const int lane = F.lane, wid = F.wave, n = lane & 31, hi = lane >> 5;
    const size_t tok0 = (size_t)b * SEQ + ch * 128;
    LAS unsigned char* V = F.lds;
    __syncthreads();
    float gl[8];
    { const f32x4 g0 = *(const f32x4*)(lng + 8 * lane), g1 = *(const f32x4*)(lng + 8 * lane + 4); gl[0] = g0[0]; gl[1] = g0[1]; gl[2] = g0[2]; gl[3] = g0[3]; gl[4] = g1[0]; gl[5] = g1[1]; gl[6] = g1[2]; gl[7] = g1[3]; }
    u32x4 wrow16[16];
#pragma unroll
    for (int rr = 0; rr < 16; ++rr) wrow16[rr] = *(const u32x4*)(PROJ + (tok0 + 16 * wid + rr) * PLD + C_V + 8 * lane);
#pragma unroll
    for (int rr = 0; rr < 16; ++rr) { const int row = 16 * wid + rr;
        const u32x4 w = wrow16[rr];
        float x[8] = {bf_lo(w.x), bf_hi(w.x), bf_lo(w.y), bf_hi(w.y), bf_lo(w.z), bf_hi(w.z), bf_lo(w.w), bf_hi(w.w)};
        float s = 0.f;
#pragma unroll
        for (int i = 0; i < 8; ++i) s += x[i];
        const float mean = wave_sum(s) * (1.f / 512.f); float q = 0.f;
#pragma unroll
        for (int i = 0; i < 8; ++i) { x[i] -= mean; q += x[i] * x[i]; }
        const float rstd = 1.f / sqrtf(wave_sum(q) * (1.f / 512.f) + LN_EPS);
        u32x4 o; o.x = cvt_pk_bf16(x[0] * rstd * gl[0], x[1] * rstd * gl[1]); o.y = cvt_pk_bf16(x[2] * rstd * gl[2], x[3] * rstd * gl[3]);
        o.z = cvt_pk_bf16(x[4] * rstd * gl[4], x[5] * rstd * gl[5]); o.w = cvt_pk_bf16(x[6] * rstd * gl[6], x[7] * rstd * gl[7]);
        *(LAS u32x4*)(V + row * SGS + 16 * lane) = o; }
    __syncthreads();
    const int g = wid;
    const int vbase = (8 * hi + ((lane & 15) >> 2)) * SGS + (g * 64 + 16 * ((lane >> 4) & 1) + 4 * (lane & 3)) * 2;
    const bf16_t* wg = SGWl + (size_t)g * 128 * 128;
#pragma unroll 1
    for (int tb = 0; tb < 4; ++tb) {
        f32x16 a0, a1;
#pragma unroll
        for (int r = 0; r < 16; ++r) { a0[r] = 0.f; a1[r] = 0.f; }
        const bf16_t* wrow = wg + (size_t)(32 * tb + n) * 128 + 8 * hi;
        bf16x8 afr[8];
#pragma unroll
        for (int ks = 0; ks < 8; ++ks) if (ks < 2 * tb + 2) afr[ks] = *(const bf16x8*)(wrow + 16 * ks);
        const int t = 32 * tb + n;
        const float bb = sgb[g * 128 + t];
        u32x2 uu[2][4];
        { const bf16_t* up = PROJ + (tok0 + t) * PLD + C_U + g * 64 + 4 * hi;
#pragma unroll
          for (int db = 0; db < 2; ++db)
#pragma unroll
              for (int q4 = 0; q4 < 4; ++q4) uu[db][q4] = *(const u32x2*)(up + 32 * db + 8 * q4); }
#pragma unroll
        for (int ks = 0; ks < 8; ++ks) if (ks < 2 * tb + 2) {
            const bf16x8 af = afr[ks];
#pragma unroll
            for (int db = 0; db < 2; ++db) { bf16x8 vf;
#if USE_TR
                const v4i16_t t0 = __builtin_amdgcn_ds_read_tr16_b64_v4i16((LAS v4i16_t*)(V + vbase + (16 * ks) * SGS + 64 * db));
                const v4i16_t t1 = __builtin_amdgcn_ds_read_tr16_b64_v4i16((LAS v4i16_t*)(V + vbase + (16 * ks + 4) * SGS + 64 * db));
                vf = (bf16x8){t0[0], t0[1], t0[2], t0[3], t1[0], t1[1], t1[2], t1[3]};
#else
#pragma unroll
                for (int j = 0; j < 8; ++j) vf[j] = *(const LAS short*)(V + (16 * ks + 8 * hi + j) * SGS + (g * 64 + 32 * db + n) * 2);
#endif
                if (db == 0) a0 = __builtin_amdgcn_mfma_f32_32x32x16_bf16(vf, af, a0, 0, 0, 0); else a1 = __builtin_amdgcn_mfma_f32_32x32x16_bf16(vf, af, a1, 0, 0, 0); }
        }
        bf16_t* op = OC + (tok0 + t) * 512 + g * 64 + 8 * hi;
#pragma unroll
        for (int db = 0; db < 2; ++db)
#pragma unroll
            for (int kp = 0; kp < 2; ++kp) { const int r0 = 8 * kp; float v[8];
#pragma unroll
                for (int i = 0; i < 8; ++i) { const u32x2 uw = uu[db][2 * kp + (i >> 2)]; const unsigned wd = (i & 2) ? uw.y : uw.x; const float uf = (i & 1) ? bf_hi(wd) : bf_lo(wd);
                    v[i] = ((db == 0 ? a0[r0 + i] : a1[r0 + i]) + bb) * uf; }
                unsigned ax = cvt_pk_bf16(v[0], v[1]), ay = cvt_pk_bf16(v[2], v[3]), bx = cvt_pk_bf16(v[4], v[5]), by = cvt_pk_bf16(v[6], v[7]);
                { auto r = __builtin_amdgcn_permlane32_swap(ax, bx, false, false); ax = r[0]; bx = r[1]; }
                { auto r = __builtin_amdgcn_permlane32_swap(ay, by, false, false); ay = r[0]; by = r[1]; }
                *(u32x4*)(op + 32 * db + 16 * kp) = (u32x4){ax, ay, bx, by}; }
    }
}
constexpr int HS_STRIDE = 2064;
constexpr int P7_PART = 32 * HS_STRIDE;
constexpr int P7_LOG = P7_PART + 8 * 4096;
constexpr int P7_HIST = P7_LOG + 32 * 33 * 4;
__device__ __forceinline__ void p7_route(const Frame& F, const Args& a, int l, bf16_t* X16  , const bf16_t* Y, const float* SSP, const float* MODl, signed char* H8, float* RS,
                                         const bf16_t* WRTl, unsigned* cnt, int* ROWTOK, unsigned* TOKINFO) {
    const int tid = F.tid, lane = F.lane, wid = F.wave, n = lane & 31, hi = lane >> 5;
    const float* g_post = a.in[5] + l * DM; const float* g_pre = a.in[6] + l * DM; const float* b_router = a.in[16] + l * NE;
    LAS unsigned char* hs = F.lds; LAS float* part = (LAS float*)(F.lds + P7_PART); LAS float* lg = (LAS float*)(F.lds + P7_LOG); LAS int* hist = (LAS int*)(F.lds + P7_HIST); LAS int* base = hist + 32;
    if (tid < 32) hist[tid] = 0;
    __syncthreads();
    for (int bt = F.vcu; bt < MTOK / 32; bt += F.G) {
        const int row0 = bt * 32, b = row0 >> 11;
        const float* mb = MODl + (size_t)b * 6 * DM;
        u32x2 yv[4][4], xv[4][4]; f32x4 s4v[4];
#pragma unroll
        for (int rr = 0; rr < 4; ++rr) { const size_t row = (size_t)row0 + 4 * wid + rr; s4v[rr] = *(const f32x4*)(SSP + row * 16 + 4 * (lane & 3));
#pragma unroll
            for (int j = 0; j < 4; ++j) { const int c = 4 * lane + 256 * j; yv[rr][j] = __builtin_nontemporal_load((const u32x2*)(Y + row * DM + c)); xv[rr][j] = __builtin_nontemporal_load((const u32x2*)(X16 + row * DM + c)); } }
#pragma unroll
        for (int rr = 0; rr < 4; ++rr) { const int rl = 4 * wid + rr; const size_t row = (size_t)row0 + rl;
            const f32x4 s4 = s4v[rr];
            float ssy = (s4[0] + s4[1]) + (s4[2] + s4[3]); ssy = quad_sum(ssy);
            const float rstd1 = 1.f / sqrtf(ssy * (1.f / DM) + RMS_EPS);
            f32x4 v[4]; float ss = 0.f;
#pragma unroll
            for (int j = 0; j < 4; ++j) { const int c = 4 * lane + 256 * j; const u32x2 yw_ = yv[rr][j]; const u32x2 xw_ = xv[rr][j]; const f32x4 yy = {bf_lo(yw_.x), bf_hi(yw_.x), bf_lo(yw_.y), bf_hi(yw_.y)}, xx = {bf_lo(xw_.x), bf_hi(xw_.x), bf_lo(xw_.y), bf_hi(xw_.y)};
                const f32x4 gp = *(const f32x4*)(g_post + c), ga = *(const f32x4*)(mb + 2 * DM + c);
                v[j] = xx + ga * (yy * rstd1 * gp); { u32x2 xo; xo.x = cvt_pk_bf16(v[j][0], v[j][1]); xo.y = cvt_pk_bf16(v[j][2], v[j][3]); *(u32x2*)(X16 + row * DM + c) = xo; }
                ss += (v[j][0] * v[j][0] + v[j][1] * v[j][1]) + (v[j][2] * v[j][2] + v[j][3] * v[j][3]); }
            ss = wave_sum(ss);
            const float rstd = 1.f / sqrtf(ss * (1.f / DM) + RMS_EPS);
            f32x4 o[4]; float am = 0.f;
#pragma unroll
            for (int j = 0; j < 4; ++j) { const int c = 4 * lane + 256 * j; const f32x4 gg = *(const f32x4*)(g_pre + c), s1 = *(const f32x4*)(mb + 4 * DM + c), s0 = *(const f32x4*)(mb + 3 * DM + c);
                o[j] = (v[j] * rstd) * gg * (s1 + 1.f) + s0; u32x2 w; w.x = cvt_pk_bf16(o[j][0], o[j][1]); w.y = cvt_pk_bf16(o[j][2], o[j][3]);
                *(LAS u32x2*)(hs + rl * HS_STRIDE + c * 2) = w;
                am = fmaxf(am, fmaxf(fmaxf(fabsf(o[j][0]), fabsf(o[j][1])), fmaxf(fabsf(o[j][2]), fabsf(o[j][3])))); }
            am = wave_max(am);
            const float scale = fmaxf(am, 1e-30f) * (1.f / 127.f), inv = 1.f / scale;
            if (lane == 0) RS[row] = scale;
#pragma unroll
            for (int j = 0; j < 4; ++j) *(unsigned*)(H8 + row * DM + 4 * lane + 256 * j) = q8x4(o[j][0], o[j][1], o[j][2], o[j][3], inv); }
        __syncthreads();
        {
            f32x16 d;
#pragma unroll
            for (int r = 0; r < 16; ++r) d[r] = 0.f;
#pragma unroll
            for (int ks = 0; ks < 8; ++ks) { const int k0 = (8 * wid + ks) * 16 + 8 * hi;
                const bf16x8 af = *(const LAS bf16x8*)(hs + n * HS_STRIDE + k0 * 2); const bf16x8 bf = *(const bf16x8*)(WRTl + (size_t)n * DM + k0);
                d = __builtin_amdgcn_mfma_f32_32x32x16_bf16(af, bf, d, 0, 0, 0); }
#pragma unroll
            for (int r = 0; r < 16; ++r) part[wid * 1024 + (8 * (r >> 2) + 4 * hi + (r & 3)) * 32 + n] = d[r];
        }
        __syncthreads();
        for (int i = tid; i < 1024; i += 512) { float s = b_router[i & 31];
#pragma unroll
            for (int w = 0; w < 8; ++w) s += part[w * 1024 + i]; lg[(i >> 5) * 33 + (i & 31)] = s; }
        __syncthreads();
        int e_k[4] = {0, 0, 0, 0}, lp_k[4] = {0, 0, 0, 0}; float w_k[4] = {0.f, 0.f, 0.f, 0.f};
        if (tid < 32) { LAS float* mylg = lg + tid * 33; float tl[4];
#pragma unroll
            for (int k = 0; k < 4; ++k) { float best = -INFINITY; int bi = 0;
                for (int e = 0; e < 32; ++e) { const float vv = mylg[e]; if (vv > best) { best = vv; bi = e; } }
                tl[k] = best; e_k[k] = bi; mylg[bi] = -INFINITY; }
            float sum = 0.f;
#pragma unroll
            for (int k = 0; k < 4; ++k) { w_k[k] = __expf(tl[k] - tl[0]); sum += w_k[k]; }
            const float inv = 1.f / sum;
#pragma unroll
            for (int k = 0; k < 4; ++k) { w_k[k] *= inv; lp_k[k] = __hip_atomic_fetch_add(&hist[e_k[k]], 1, __ATOMIC_RELAXED, __HIP_MEMORY_SCOPE_WORKGROUP); } }
        __syncthreads();
        if (tid < 32) { const int hc = hist[tid]; base[tid] = hc > 0 ? (int)__hip_atomic_fetch_add(cnt + 64 * tid, (unsigned)hc, __ATOMIC_RELAXED, __HIP_MEMORY_SCOPE_AGENT) : 0; hist[tid] = 0; }
        __syncthreads();
        if (tid < 32) { const int token = row0 + tid; u32x4 info; f32x4 ww;
#pragma unroll
            for (int k = 0; k < 4; ++k) { const int pos = base[e_k[k]] + lp_k[k]; ROWTOK[e_k[k] * 65536 + pos] = token; info[k] = ((unsigned)e_k[k] << 17) | (unsigned)pos; ww[k] = w_k[k]; }
            *(u32x4*)(TOKINFO + (size_t)token * 8) = info; *(f32x4*)(TOKINFO + (size_t)token * 8 + 4) = ww; }
        __syncthreads();
    }
}

__device__ __forceinline__ int moe_tables(const Frame& F, unsigned* cnt) {
    LAS int* ts = (LAS int*)(F.lds + TS_OFF); LAS int* te = (LAS int*)(F.lds + TILE_E_OFF);
    __syncthreads();
    if (F.tid == 0) { int acc = 0; for (int e = 0; e < NE; ++e) { ts[e] = acc; const unsigned c = __hip_atomic_load(cnt + 64 * e, __ATOMIC_RELAXED, __HIP_MEMORY_SCOPE_AGENT); acc += (int)((c + 255u) >> 8); } ts[NE] = acc; }
    __syncthreads();
    const int RT = ts[NE];
    for (int rt = F.tid; rt < RT; rt += 512) { int e = 0;
#pragma unroll 1
        for (int q = 1; q < NE; ++q) e += (ts[q] <= rt) ? 1 : 0;
        te[rt] = e; }
    __syncthreads();
    return RT;
}

__device__ __forceinline__ void p10_combine(const Frame& F, const Args& a, int l, bf16_t* X16, float* out, const bf16_t* Y2, const unsigned* TOKINFO, const float* MODbase, signed char* H8, float* RS) {
    const int lane = F.lane; const LAS int* ts = (const LAS int*)(F.lds + TS_OFF);
    const float* g_postf = a.in[7] + l * DM;
    const int gw = F.vcu * 8 + F.wave, NGW = F.G * 8;
    for (int rowp = gw * 2; rowp < MTOK; rowp += NGW * 2) {
        u32x4 info[2]; f32x4 ww[2]; u32x2 yw[2][4][4], xv[2][4];
#pragma unroll
        for (int rr = 0; rr < 2; ++rr) { info[rr] = *(const u32x4*)(TOKINFO + (size_t)(rowp + rr) * 8); ww[rr] = *(const f32x4*)(TOKINFO + (size_t)(rowp + rr) * 8 + 4); }
#pragma unroll
        for (int rr = 0; rr < 2; ++rr) {
#pragma unroll
            for (int k = 0; k < 4; ++k) { const int e = (int)(info[rr][k] >> 17), pos = (int)(info[rr][k] & 0x1ffffu); const size_t slot = (size_t)ts[e] * 256 + pos;
#pragma unroll
                for (int j = 0; j < 4; ++j) yw[rr][k][j] = __builtin_nontemporal_load((const u32x2*)(Y2 + slot * DM + 4 * lane + 256 * j)); }
#pragma unroll
            for (int j = 0; j < 4; ++j) xv[rr][j] = *(const u32x2*)(X16 + (size_t)(rowp + rr) * DM + 4 * lane + 256 * j); }
#pragma unroll
        for (int rr = 0; rr < 2; ++rr) { const int row = rowp + rr, b = row >> 11;
        f32x4 y[4];
#pragma unroll
        for (int j = 0; j < 4; ++j) y[j] = (f32x4){0.f, 0.f, 0.f, 0.f};
#pragma unroll
        for (int k = 0; k < 4; ++k) { const float wk = ww[rr][k];
#pragma unroll
            for (int j = 0; j < 4; ++j) { const u32x2 w = yw[rr][k][j];
                y[j][0] += wk * bf_lo(w.x); y[j][1] += wk * bf_hi(w.x); y[j][2] += wk * bf_lo(w.y); y[j][3] += wk * bf_hi(w.y); } }
        float ss = 0.f;
#pragma unroll
        for (int j = 0; j < 4; ++j) ss += (y[j][0] * y[j][0] + y[j][1] * y[j][1]) + (y[j][2] * y[j][2] + y[j][3] * y[j][3]);
        ss = wave_sum(ss);
        const float rstd = 1.f / sqrtf(ss * (1.f / DM) + RMS_EPS);
        const float* mb = MODbase + ((size_t)l * BATCH + b) * 6 * DM;
        f32x4 v[4]; float s2 = 0.f;
#pragma unroll
        for (int j = 0; j < 4; ++j) { const int c = 4 * lane + 256 * j; const u32x2 xw_ = xv[rr][j]; const f32x4 xx = {bf_lo(xw_.x), bf_hi(xw_.x), bf_lo(xw_.y), bf_hi(xw_.y)}, gp = *(const f32x4*)(g_postf + c), ga = *(const f32x4*)(mb + 5 * DM + c);
            v[j] = xx + ga * (y[j] * rstd * gp);
#ifdef T_STAMP
            if (l + 1 == DEPTH) v[j] = v[j] * (1.f + (float)(*((const unsigned*)MODbase - (1u << 18) + 100)) * (1.f / 256.f));
#endif
            if (l + 1 < DEPTH) { u32x2 xo; xo.x = cvt_pk_bf16(v[j][0], v[j][1]); xo.y = cvt_pk_bf16(v[j][2], v[j][3]); *(u32x2*)(X16 + (size_t)row * DM + c) = xo; }
            else *(f32x4*)(out + (size_t)row * DM + c) = v[j];
            s2 += (v[j][0] * v[j][0] + v[j][1] * v[j][1]) + (v[j][2] * v[j][2] + v[j][3] * v[j][3]); }
        if (l + 1 < DEPTH) { s2 = wave_sum(s2); const float* mb1 = MODbase + ((size_t)(l + 1) * BATCH + b) * 6 * DM;
            norm_mod_row(v, s2, a.in[4] + (l + 1) * DM, mb1 + DM, mb1, H8 + (size_t)row * DM, RS + row, lane); }
        }
    }
}
#ifndef MK_ONE_LAUNCH
#define MK_ONE_LAUNCH 1
#endif
constexpr int N_PHASES = 2 + 9 * DEPTH;
__global__ void __launch_bounds__(512, 2) fwd(Args args) {
    extern __shared__ __attribute__((aligned(16))) unsigned char lds_raw[];
    Frame F0;
    F0.lds = (LAS unsigned char*)lds_raw;
    F0.tid = threadIdx.x; F0.lane = F0.tid & 63; F0.wave = __builtin_amdgcn_readfirstlane(F0.tid >> 6);
    F0.G = gridDim.x; { const int bx = blockIdx.x; F0.vcu = (F0.G % 8 == 0) ? (bx % 8) * (F0.G / 8) + bx / 8 : bx; }
    volatile LAS unsigned* MISC = (volatile LAS unsigned*)(F0.lds + MISC_OFF);
    for (int u = F0.tid; u < 128; u += 512) MISC[u] = 0u;
    __syncthreads();
    unsigned* ctl = (unsigned*)(args.ws + WS_CTL);
    const int lo = args.ph_lo, hi = args.ph_hi;
    XcdBarrier bar; bar.bar = ctl + CW_BAR; bar.x = 0; bar.st = nullptr; bar.w = F0.wave;
    if (hi - lo > 1) bar = xcd_barrier_post(ctl + CW_BAR, MISC + 8, F0.wave);
#ifndef PHASE_MASK
#define PHASE_MASK 0x7ff
#endif
#define PHON(j) ((PHASE_MASK >> (j)) & 1)
#ifndef REPEAT_MASK
#define REPEAT_MASK 0
#endif
#define REP(j) for (int rep_ = 0; rep_ <= ((REPEAT_MASK >> (j)) & 1); ++rep_)
#define IN(k) (lo <= (k) && (k) < hi)
#define BOTH(k) (IN(k) && IN((k) + 1))
#define GRID_BAR() xcd_barrier(bar)
#define PH_BEGIN() const Frame F = phase_frame(F0); unsigned char* ws = opq(args.ws); (void)ws
    if (PHON(0) && IN(0)) REP(0) { PH_BEGIN(); p0_mod(F, args.in[1], args.in[2], args.in[3], (float*)(ws + WS_MOD)); p0_weights(F, args); if (BOTH(0)) GRID_BAR(); }
    if (PHON(1) && IN(1)) REP(1) { PH_BEGIN(); p1_norm(F, args.in[0], args.in[4], (const float*)(ws + WS_MOD), (signed char*)(ws + WS_H), (float*)(ws + WS_RS), (bf16_t*)(ws + WS_X)); if (BOTH(1)) GRID_BAR(); }

#pragma unroll 1
#ifndef EXTRA_PHASE
#define EXTRA_PHASE (-1)
#endif
#ifdef SKIP_EPI_PROBE
#define SKIPV ex_
#else
#define SKIPV false
#endif
#ifndef STAG_MASK
#define STAG_MASK 0
#endif
#ifndef STAG_TICKS
#define STAG_TICKS 240
#endif
#define STAGGER(j) do { if ((STAG_MASK >> (j)) & 1) { const unsigned long long t0_ = __builtin_amdgcn_s_memrealtime(), dl_ = (unsigned long long)(F.vcu / (F.G / 8)) * STAG_TICKS; while (__builtin_amdgcn_s_memrealtime() - t0_ < dl_) __builtin_amdgcn_s_sleep(8); } } while (0)
#ifndef EXTRA_MASK
#define EXTRA_MASK (EXTRA_PHASE >= 0 ? (1 << EXTRA_PHASE) : 0)
#endif
#define EXOK(j) (EXTRA_MASK == 0 || !ex_ || ((EXTRA_MASK >> (j)) & 1))
    for (int it_ = 0; it_ < DEPTH + (EXTRA_MASK != 0 ? 1 : 0); ++it_) {
        const int l = it_ < DEPTH ? it_ : DEPTH - 1; const bool ex_ = it_ >= DEPTH; (void)ex_;
        const int pb = 2 + 9 * l;
        if (PHON(2) && EXOK(2) && IN(pb + 0)) REP(2) { PH_BEGIN();
            pg8::Gemm g{(const bf16_t*)(ws + WS_H), (const bf16_t*)(ws + WS_W + (size_t)l * W_LAYER + WO_WIN), DM}; g.skip_epi = SKIPV; pg8::StaticOrder<MTOK / 256, NPROJ / 256> S; S.init(F.G, (int)blockIdx.x);
            EpiProj E{(bf16_t*)(ws + WS_PROJ), (unsigned char*)(ws + WS_GATES), (const float*)(ws + WS_RS), (const float*)(ws + WS_CSIN) + (size_t)l * NPROJ};
            STAGGER(2); pg8::gemm_phase<EpiProj, pg8::StaticOrder<MTOK / 256, NPROJ / 256>, false, true>(F.lds, g, S, E, F.wave);
            if (BOTH(pb + 0)) GRID_BAR();
        }
        if (PHON(3) && EXOK(3) && IN(pb + 1)) REP(3) {
#ifndef SUBREP
#define SUBREP 0
#endif
#ifndef IDX_PROBE
#define IDX_PROBE 0
#endif
            if (!((IDX_PROBE & 8) && ex_))
            { const Frame Fa = phase_frame(F0); const bf16_t* PROJa = (const bf16_t*)(opq(args.ws) + WS_PROJ); bf16_t* OAa = (bf16_t*)(opq(args.ws) + WS_O);
            for (int u = Fa.vcu; u < 2048; u += Fa.G) { const int cu = u & 255, j = u >> 8, bg = cu >> 2, s = cu & 3, qb = (j & 1) ? (8 * (j >> 1) + 7 - s) : (8 * (j >> 1) + s);
                attn_unit<0>(Fa, PROJa, OAa, nullptr, args.in[9] + l * 8, bg >> 1, bg & 1, qb); } }
            if (!((IDX_PROBE & 16) && ex_))
            { const Frame Fb = phase_frame(F0); unsigned char* wsb = opq(args.ws);
            for (int u = Fb.vcu; u < 512; u += Fb.G)
                sg_unit(Fb, (const bf16_t*)(wsb + WS_PROJ), (const bf16_t*)(wsb + WS_SGW) + (size_t)l * 8 * 128 * 128, args.in[11] + l * 8 * 128, args.in[12] + l * 512, (bf16_t*)(wsb + WS_O) + (size_t)2 * MTOK * 512, u >> 4, u & 15); }
            __syncthreads();
            if (!((IDX_PROBE & 4) && ex_))
            { const Frame Fi = phase_frame(F0); unsigned char* wsi = opq(args.ws);
              dsa_index_phase(Fi, (const bf16_t*)(wsi + WS_PROJ), (unsigned long long*)(wsi + WS_BITS), l == 0 ? (unsigned*)(wsi + WS_CTL) + 100 : nullptr, ex_); }
            if (BOTH(pb + 1)) GRID_BAR();
        }
        if (PHON(4) && EXOK(4) && IN(pb + 2)) REP(4) { PH_BEGIN();
            for (int u = F.vcu; u < 2048; u += F.G) { const int cu = u & 255, j = u >> 8, bg = cu >> 2, s = cu & 3, qb = (j & 1) ? (8 * (j >> 1) + 7 - s) : (8 * (j >> 1) + s);
                attn_unit<1>(F, (const bf16_t*)(ws + WS_PROJ), (bf16_t*)(ws + WS_O) + (size_t)MTOK * 512, (const unsigned*)(ws + WS_BITS), nullptr, bg >> 1, bg & 1, qb); }
            __syncthreads();
            if (BOTH(pb + 2)) GRID_BAR();
        }
        if (PHON(5) && EXOK(5) && IN(pb + 3)) REP(5) { PH_BEGIN();
            pg8::Gemm g{(const bf16_t*)(ws + WS_O), (const bf16_t*)(ws + WS_W + (size_t)l * W_LAYER + WO_WBR), 512}; g.skip_epi = SKIPV; BranchOrder S; S.so.init(F.G, (int)blockIdx.x);
            EpiBranch E{(const unsigned char*)(ws + WS_GATES), (bf16_t*)(ws + WS_H)};
            STAGGER(5); pg8::gemm_phase<EpiBranch, BranchOrder, false>(F.lds, g, S, E, F.wave);
            if (BOTH(pb + 3)) GRID_BAR();
        }
        if (PHON(6) && EXOK(6) && IN(pb + 4)) REP(6) { PH_BEGIN();
            pg8::Gemm g{(const bf16_t*)(ws + WS_H), (const bf16_t*)(ws + WS_W + (size_t)l * W_LAYER + WO_WOUT), DM}; g.skip_epi = SKIPV; pg8::StaticOrder<MTOK / 256, DM / 256> S; S.init(F.G, (int)blockIdx.x);
            EpiWout E{(bf16_t*)(ws + WS_Y), (float*)(ws + WS_SSP)}; E.pv = ex_;
            STAGGER(6); pg8::gemm_phase<EpiWout, pg8::StaticOrder<MTOK / 256, DM / 256>, false>(F.lds, g, S, E, F.wave);
            if (BOTH(pb + 4)) GRID_BAR();
        }
        if (PHON(7) && EXOK(7) && IN(pb + 5)) REP(7) { PH_BEGIN();
            p7_route(F, args, l, (bf16_t*)(ws + WS_X), (const bf16_t*)(ws + WS_Y), (const float*)(ws + WS_SSP), (const float*)(ws + WS_MOD) + (size_t)l * BATCH * 6 * DM, (signed char*)(ws + WS_H), (float*)(ws + WS_RS),
                     (const bf16_t*)(ws + WS_WRT) + (size_t)l * NE * DM, (unsigned*)(ws + WS_CTL) + CW_CNT + l * 32 * 64, (int*)(ws + WS_ROWTOK), (unsigned*)(ws + WS_TOKINFO));
            if (BOTH(pb + 5)) GRID_BAR();
        }
        if (PHON(8) && EXOK(8) && IN(pb + 6)) REP(8) { PH_BEGIN();
            unsigned* cnt = (unsigned*)(ws + WS_CTL) + CW_CNT + l * 32 * 64; const int* ROWTOK = (const int*)(ws + WS_ROWTOK);
            const int RT = moe_tables(F, cnt);
            LAS int* ts = (LAS int*)(F.lds + TS_OFF); LAS int* te = (LAS int*)(F.lds + TILE_E_OFF); LAS int* ri = (LAS int*)(F.lds + ROWIDX_OFF);
            const long U = (long)RT * 8; MoeOrder S; S.u0 = (int)(U * F.vcu / F.G); S.u1 = (int)(U * (F.vcu + 1) / F.G); S.NB = 8; S.rt_lo = S.u0 / 8; S.tile_e = te; S.rowidx = ri;
            if (S.u1 > S.u0) { const int rt_hi = (S.u1 - 1) / 8; int ntile = rt_hi - S.rt_lo + 1; if (ntile > 8) ntile = 8;
                for (int i = F.tid; i < ntile * 256; i += 512) { const int rt = S.rt_lo + (i >> 8), r = i & 255, e = te[rt], first = (rt - ts[e]) * 256 + r;
                    const int c = (int)__hip_atomic_load(cnt + 64 * e, __ATOMIC_RELAXED, __HIP_MEMORY_SCOPE_AGENT); ri[i] = first < c ? ROWTOK[e * 65536 + first] : 0; } }
            __syncthreads();
            pg8::Gemm g{(const bf16_t*)(ws + WS_H), (const bf16_t*)(ws + WS_W + (size_t)l * W_LAYER + WO_W1), DM}; g.skip_epi = SKIPV;
            EpiW1I8 E{(signed char*)(ws + WS_ACT), args.in[18] + (size_t)l * NE * 2 * FF, (const float*)(ws + WS_RS), (const float*)(ws + WS_CS1) + (size_t)l * NE * 2048, ri, S.rt_lo};
            STAGGER(8); pg8::gemm_phase<EpiW1I8, MoeOrder, true, true>(F.lds, g, S, E, F.wave);
            if (BOTH(pb + 6)) GRID_BAR();
        }
        if (PHON(9) && EXOK(9) && IN(pb + 7)) REP(9) { PH_BEGIN();
            const int RT = moe_tables(F, (unsigned*)(ws + WS_CTL) + CW_CNT + l * 32 * 64);
            const long U = (long)RT * 4; MoeOrder S; S.u0 = (int)(U * F.vcu / F.G); S.u1 = (int)(U * (F.vcu + 1) / F.G); S.NB = 4; S.rt_lo = 0; S.tile_e = (LAS int*)(F.lds + TILE_E_OFF); S.rowidx = nullptr;
            pg8::Gemm g{(const bf16_t*)(ws + WS_ACT), (const bf16_t*)(ws + WS_W + (size_t)l * W_LAYER + WO_W2), FF}; g.skip_epi = SKIPV;
            EpiW2 E{(bf16_t*)(ws + WS_Y2), args.in[20] + (size_t)l * NE * DM, (const float*)(ws + WS_CS2) + (size_t)l * NE * DM};
            STAGGER(9); pg8::gemm_phase<EpiW2, MoeOrder, false, true>(F.lds, g, S, E, F.wave);
            if (BOTH(pb + 7)) GRID_BAR();
        }
        if (PHON(10) && EXOK(10) && IN(pb + 8)) REP(10) { PH_BEGIN();
            (void)moe_tables(F, (unsigned*)(ws + WS_CTL) + CW_CNT + l * 32 * 64);
            p10_combine(F, args, l, (bf16_t*)(ws + WS_X), args.out, (const bf16_t*)(ws + WS_Y2), (const unsigned*)(ws + WS_TOKINFO), (const float*)(ws + WS_MOD), (signed char*)(ws + WS_H), (float*)(ws + WS_RS));
            if (BOTH(pb + 8)) GRID_BAR();
        }
    }
#undef PH_BEGIN
#undef IN
#undef BOTH
#undef GRID_BAR
}

extern "C" void kernel_launch(void* const* d_in, const int* in_sizes, int n_in, void* d_out, int out_size, void* d_ws, size_t ws_size, hipStream_t stream) {
    static int grid = 0;
    if (grid == 0) {
        if (n_in != 21 || out_size != MTOK * DM || ws_size < WS_END) { fprintf(stderr, "kernel_launch: unexpected shapes (n_in %d, out %d, ws %zu); nothing launched\n", n_in, out_size, ws_size); grid = -1; return; }
        int dev = 0, cus = 0, per_cu = 0;
        if (hipGetDevice(&dev) != hipSuccess || hipDeviceGetAttribute(&cus, hipDeviceAttributeMultiprocessorCount, dev) != hipSuccess) { grid = -1; return; }
        if (hipFuncSetAttribute((const void*)fwd, hipFuncAttributeMaxDynamicSharedMemorySize, LDS_BYTES) != hipSuccess) { fprintf(stderr, "kernel_launch: hipFuncSetAttribute failed\n"); grid = -1; return; }
        if (hipOccupancyMaxActiveBlocksPerMultiprocessor(&per_cu, (const void*)fwd, 512, LDS_BYTES) != hipSuccess || per_cu < 1) { fprintf(stderr, "kernel_launch: occupancy query says %d\n", per_cu); }
        (void)hipGetLastError();
        grid = cus > 256 ? 256 : cus;
    }
    if (grid < 0) return;
    (void)hipMemsetAsync((char*)d_ws + WS_CTL, 0, CTL_ZERO_BYTES, stream);
    Args a{};
    for (int i = 0; i < 21; ++i) a.in[i] = (const float*)d_in[i];
    a.out = (float*)d_out; a.ws = (unsigned char*)d_ws;
#if MK_ONE_LAUNCH
    a.ph_lo = 0; a.ph_hi = N_PHASES;
    hipLaunchKernelGGL(fwd, dim3(grid), dim3(512), LDS_BYTES, stream, a);
#else
    for (int p = 0; p < N_PHASES; ++p) { a.ph_lo = p; a.ph_hi = p + 1; hipLaunchKernelGGL(fwd, dim3(grid), dim3(512), LDS_BYTES, stream, a); }
#endif
}
```

```cpp
#include <hip/hip_runtime.h>
#include <cstdio>
#include <cstdint>
#include <type_traits>

#define LAS __attribute__((address_space(3)))
#define GAS __attribute__((address_space(1)))
typedef unsigned short bf16_t;
typedef short bf16x8 __attribute__((ext_vector_type(8)));
typedef float f32x2 __attribute__((ext_vector_type(2)));
typedef float f32x4 __attribute__((ext_vector_type(4)));
typedef float f32x16 __attribute__((ext_vector_type(16)));
typedef unsigned u32x2 __attribute__((ext_vector_type(2)));
typedef unsigned u32x4 __attribute__((ext_vector_type(4)));
typedef short v4i16_t __attribute__((ext_vector_type(4)));
typedef int i32x4 __attribute__((ext_vector_type(4)));

constexpr int BATCH = 32, SEQ = 2048, DM = 1024, MTOK = BATCH * SEQ, DEPTH = 2;
constexpr int NPROJ = 6144;
constexpr int PLD = 3072;
constexpr int C_QA = 0, C_KA = 512, C_VA = 640, C_QB = 768, C_KB = 1280, C_VB = 1408, C_QI = 1536, C_KI = 1792, C_WI = 1824, C_U = 2048, C_V = 2560, C_G = 3072;
constexpr int NE = 32, FF = 1024;
constexpr float RMS_EPS = 1e-5f, LN_EPS = 1e-5f;
constexpr float LOG2E = 1.4426950408889634f;
constexpr float QSCALE = 0.125f * LOG2E;

__device__ __forceinline__ unsigned f2bf(float f) { unsigned u = __builtin_bit_cast(unsigned, f); return (u + 0x7fffu + ((u >> 16) & 1u)) >> 16; }
__device__ __forceinline__ unsigned cvt_pk_bf16(float lo, float hi) { unsigned r; asm volatile("v_cvt_pk_bf16_f32 %0, %1, %2" : "=v"(r) : "v"(lo), "v"(hi)); return r; }
__device__ __forceinline__ float bf_lo(unsigned w) { return __builtin_bit_cast(float, w << 16); }
__device__ __forceinline__ float bf_hi(unsigned w) { return __builtin_bit_cast(float, w & 0xffff0000u); }
__device__ __forceinline__ float fexp2(float x) { return __builtin_amdgcn_exp2f(x); }
__device__ __forceinline__ float frcp(float x) { return __builtin_amdgcn_rcpf(x); }
__device__ __forceinline__ float sigmoidf_(float x) { return frcp(1.f + fexp2(-LOG2E * x)); }
__device__ __forceinline__ float gelu_tanh(float x) { const float t = x + 0.044715f * x * x * x; return x * frcp(1.f + fexp2(-2.302208198f * t)); }
template <int CTRL> __device__ __forceinline__ float dpp_f(float v) { return __builtin_bit_cast(float, __builtin_amdgcn_update_dpp(0, __builtin_bit_cast(int, v), CTRL, 0xF, 0xF, false)); }
__device__ __forceinline__ void swap32_asm(unsigned& a, unsigned& b) { asm volatile("s_nop 1\n\tv_permlane32_swap_b32 %0, %1" : "+v"(a), "+v"(b)); }
__device__ __forceinline__ float xor16_add(float v) { return v + __builtin_bit_cast(float, __builtin_amdgcn_ds_swizzle(__builtin_bit_cast(int, v), 0x401F)); }
__device__ __forceinline__ float xor16_max(float v) { return fmaxf(v, __builtin_bit_cast(float, __builtin_amdgcn_ds_swizzle(__builtin_bit_cast(int, v), 0x401F))); }
__device__ __forceinline__ float xor32_add(float v) { unsigned a = __builtin_bit_cast(unsigned, v), b = a; swap32_asm(a, b); return __builtin_bit_cast(float, a) + __builtin_bit_cast(float, b); }
__device__ __forceinline__ float xor32_max(float v) { unsigned a = __builtin_bit_cast(unsigned, v), b = a; swap32_asm(a, b); return fmaxf(__builtin_bit_cast(float, a), __builtin_bit_cast(float, b)); }
__device__ __forceinline__ float quad_sum(float v) { v += dpp_f<0xB1>(v); v += dpp_f<0x4E>(v); return v; }
__device__ __forceinline__ float wave_sum(float v) {
    v += dpp_f<0xB1>(v); v += dpp_f<0x4E>(v); v += dpp_f<0x141>(v); v += dpp_f<0x140>(v);
    return xor32_add(xor16_add(v));
}
__device__ __forceinline__ float wave_max(float v) {
    v = fmaxf(v, dpp_f<0xB1>(v)); v = fmaxf(v, dpp_f<0x4E>(v)); v = fmaxf(v, dpp_f<0x141>(v)); v = fmaxf(v, dpp_f<0x140>(v));
    return xor32_max(xor16_max(v));
}
__device__ __forceinline__ unsigned wave_sum_u32(unsigned v) {
    v += (unsigned)__builtin_amdgcn_update_dpp(0, (int)v, 0xB1, 0xF, 0xF, false);
    v += (unsigned)__builtin_amdgcn_update_dpp(0, (int)v, 0x4E, 0xF, 0xF, false);
    v += (unsigned)__builtin_amdgcn_update_dpp(0, (int)v, 0x141, 0xF, 0xF, false);
    v += (unsigned)__builtin_amdgcn_update_dpp(0, (int)v, 0x140, 0xF, 0xF, false);
    return __builtin_amdgcn_readlane(v, 0) + __builtin_amdgcn_readlane(v, 16) + __builtin_amdgcn_readlane(v, 32) + __builtin_amdgcn_readlane(v, 48);
}
__device__ __forceinline__ unsigned wave_max_u32(unsigned v) {
    unsigned t;
    t = (unsigned)__builtin_amdgcn_update_dpp(0, (int)v, 0xB1, 0xF, 0xF, false); v = v > t ? v : t;
    t = (unsigned)__builtin_amdgcn_update_dpp(0, (int)v, 0x4E, 0xF, 0xF, false); v = v > t ? v : t;
    t = (unsigned)__builtin_amdgcn_update_dpp(0, (int)v, 0x141, 0xF, 0xF, false); v = v > t ? v : t;
    t = (unsigned)__builtin_amdgcn_update_dpp(0, (int)v, 0x140, 0xF, 0xF, false); v = v > t ? v : t;
    unsigned a = __builtin_amdgcn_readlane(v, 0), b = __builtin_amdgcn_readlane(v, 16), c = __builtin_amdgcn_readlane(v, 32), d = __builtin_amdgcn_readlane(v, 48);
    a = a > b ? a : b; c = c > d ? c : d; return a > c ? a : c;
}
__device__ __forceinline__ unsigned q8x4(float a, float b, float c, float d, float inv) {
    unsigned r = 0u;
    r = __builtin_amdgcn_cvt_pk_u8_f32(__builtin_rintf(fmaf(a, inv, 128.f)), 0u, r);
    r = __builtin_amdgcn_cvt_pk_u8_f32(__builtin_rintf(fmaf(b, inv, 128.f)), 1u, r);
    r = __builtin_amdgcn_cvt_pk_u8_f32(__builtin_rintf(fmaf(c, inv, 128.f)), 2u, r);
    r = __builtin_amdgcn_cvt_pk_u8_f32(__builtin_rintf(fmaf(d, inv, 128.f)), 3u, r);
    return r ^ 0x80808080u;
}
__device__ __forceinline__ unsigned u8x4_floor(float a, float b, float c, float d) {
    unsigned r = 0u;
    r = __builtin_amdgcn_cvt_pk_u8_f32(__builtin_floorf(a), 0u, r); r = __builtin_amdgcn_cvt_pk_u8_f32(__builtin_floorf(b), 1u, r);
    r = __builtin_amdgcn_cvt_pk_u8_f32(__builtin_floorf(c), 2u, r); r = __builtin_amdgcn_cvt_pk_u8_f32(__builtin_floorf(d), 3u, r);
    return r;
}
__device__ __forceinline__ int lane_id_volatile(int tag = 0) { int l; asm volatile("v_mbcnt_lo_u32_b32 %0, -1, 0 ; LANETAG %1\n\tv_mbcnt_hi_u32_b32 %0, -1, %0" : "=v"(l) : "s"(tag)); return l; }
#define LDS_WAIT() asm volatile("s_waitcnt lgkmcnt(0)" ::: "memory")
#define VM_WAIT() asm volatile("s_waitcnt vmcnt(0)" ::: "memory")

namespace pg8 {
constexpr int BM = 256, BK = 64, HALF = 128, HTB = HALF * BK * 2  , STAGE_BYTES = 8 * HTB, NXCD = 8, WGM = 8;
__host__ __device__ __forceinline__ int lds_byte(int r, int c) { const int st = (r >> 4) * 2 + (c >> 5), rr = r & 15, cc = c & 31, ob = rr * 64 + cc * 2; return st * 1024 + (ob ^ (((ob >> 9) & 1) << 5)); }
__host__ __device__ __forceinline__ void stage_rc(int b, int& R, int& C) { const int st = b / 1024, sb = b % 1024, swz = sb ^ (((sb >> 9) & 1) << 5); R = (st >> 1) * 16 + swz / 64; C = (st & 1) * 32 + (swz % 64) / 2; }
__host__ __device__ __forceinline__ int perm32(int rho) { const int n = rho >> 4, i = rho & 15; return 8 * (i >> 2) + 4 * n + (i & 3); }

struct Unit { int pm, pn; };
struct Gemm { const bf16_t* A; const bf16_t* Bt; int K; bool skip_epi = false; };

template <int NM, int NN> struct StaticOrder {
    int G, c;
    __device__ void init(int G_, int c_) { G = G_; c = c_; }
    __device__ __forceinline__ bool tile(int i, int& pm, int& pn) const {
        constexpr int nwg = NM * NN;
        const long L = (long)i * G + c; if (L >= nwg) return false;
        int wgid = (int)L; { constexpr int q = nwg / NXCD, r = nwg % NXCD; const int xcd = wgid % NXCD, off = wgid / NXCD; wgid = (xcd < r ? xcd * (q + 1) : r * (q + 1) + (xcd - r) * q) + off; }
        constexpr int nig = WGM * NN; static_assert(NM % WGM == 0, "row tiles in whole groups");
        const int gid = wgid / nig, fm = gid * WGM, rem = wgid % nig;
        pm = fm + (rem % WGM); pn = rem / WGM; return true;
    }
    __device__ __forceinline__ bool next(int i, Unit& u) const { return tile(i, u.pm, u.pn); }
};

template <class Epi, class Sched, bool GATHER, bool I8 = false>
__device__ __forceinline__ void gemm_phase(LAS unsigned char* lds, const Gemm g, const Sched& S, const Epi& E, int wv  ) {
    int tid = wv * 64 + lane_id_volatile(1); asm volatile("" : "+v"(tid));
    const int wid = __builtin_amdgcn_readfirstlane(tid >> 6), lane = tid & 63, wr = wid >> 2, wc = wid & 3, fr = lane & 15, fq = lane >> 4;
    const int K = g.K, RB = I8 ? K : 2 * K  , nt = RB / (BK * 2);
    unsigned voffA[2], voffB[2]; int RA[2], CA[2];
#pragma unroll
    for (int i = 0; i < 2; ++i) { int R, C; stage_rc(tid * 16 + i * 8192, R, C); const int Rb = (R & ~31) + perm32(R & 31); RA[i] = R; CA[i] = C;
        voffA[i] = (unsigned)(R * RB + C * 2); voffB[i] = (unsigned)(Rb * RB + C * 2); }
    const size_t kstep = (size_t)(BK * 2);
    const size_t hstep = (size_t)HALF * RB;
    const size_t tstep = 2 * hstep;
    const unsigned ldsw = (unsigned)wid * 1024u;
    const int aoff = lds_byte(wr * 64 + fr, fq * 8), boff = lds_byte(wc * 32 + fr, fq * 8);
#define PG8_SA(b, h) (((b) * 2 + (h)) * HTB)
#define PG8_SB(b, h) ((4 + (b) * 2 + (h)) * HTB)
#define PG8_STAGE(bufoff, gbase, voff) do { _Pragma("unroll") for (int _i = 0; _i < 2; ++_i) \
        __builtin_amdgcn_global_load_lds((const unsigned*)((const char*)(gbase) + (voff)[_i]), (LAS unsigned*)(lds + (bufoff) + ldsw + _i * 8192), 16, 0, 0); } while (0)
#define PG8_STAGE_A(bufoff, h, ubase, koff, VO) do { if constexpr (GATHER) { PG8_STAGE(bufoff, (const char*)g.A + (koff), VO[h]); } else { PG8_STAGE(bufoff, (ubase) + (h) * hstep + (koff), voffA); } } while (0)
#define PG8_LDA(dst, b, h) do { _Pragma("unroll") for (int m = 0; m < 4; ++m) _Pragma("unroll") for (int k = 0; k < 2; ++k) dst[m][k] = *(const LAS bf16x8*)(lds + PG8_SA(b, h) + aoff + m * 2048 + k * 1024); } while (0)
#define PG8_LDB(dst, b, h) do { _Pragma("unroll") for (int n = 0; n < 2; ++n) _Pragma("unroll") for (int k = 0; k < 2; ++k) dst[n][k] = *(const LAS bf16x8*)(lds + PG8_SB(b, h) + boff + n * 2048 + k * 1024); } while (0)
#define PG8_MMA(ai, bj, At, Bt) do { __builtin_amdgcn_s_setprio(1); _Pragma("unroll") for (int m = 0; m < 4; ++m) _Pragma("unroll") for (int n = 0; n < 2; ++n) _Pragma("unroll") for (int k = 0; k < 2; ++k) \
        { if constexpr (I8) acc[ai][bj][m][n] = __builtin_amdgcn_mfma_i32_16x16x64_i8(__builtin_bit_cast(i32x4, Bt[n][k]), __builtin_bit_cast(i32x4, At[m][k]), acc[ai][bj][m][n], 0, 0, 0); \
          else acc[ai][bj][m][n] = __builtin_amdgcn_mfma_f32_16x16x32_bf16(Bt[n][k], At[m][k], acc[ai][bj][m][n], 0, 0, 0); } __builtin_amdgcn_s_setprio(0); } while (0)
#define PG8_WAIT_V(n) asm volatile("s_waitcnt vmcnt(" #n ")" ::: "memory")
#define PG8_WAIT_L(n) asm volatile("s_waitcnt lgkmcnt(" #n ")" ::: "memory")
#define PG8_BAR __builtin_amdgcn_s_barrier()
#define PG8_SCHED __builtin_amdgcn_sched_barrier(0)
    Unit cur, nxt; int ui = 0;
    if (!S.next(0, cur)) return;
    typedef typename std::conditional<I8, i32x4, f32x4>::type accv_t;
    accv_t acc[2][2][4][2];
#pragma unroll
    for (int a = 0; a < 2; ++a)
#pragma unroll
        for (int b = 0; b < 2; ++b)
#pragma unroll
            for (int m = 0; m < 4; ++m)
#pragma unroll
                for (int n = 0; n < 2; ++n) acc[a][b][m][n] = (accv_t){0, 0, 0, 0};
    bf16x8 At[4][2], B0[2][2], B1[2][2];
    unsigned oc[2][2], on[2][2];
    if constexpr (GATHER) {
#pragma unroll
        for (int h = 0; h < 2; ++h)
#pragma unroll
            for (int i = 0; i < 2; ++i) { oc[h][i] = (unsigned)(S.src_row(cur, h * HALF + RA[i]) * RB + CA[i] * 2); on[h][i] = oc[h][i]; }

    }
    const char* cA = GATHER ? (const char*)g.A : (const char*)g.A + (size_t)cur.pm * tstep; const char* cB = (const char*)g.Bt + (size_t)cur.pn * tstep;
    PG8_STAGE(PG8_SB(0, 0), cB, voffB); PG8_STAGE(PG8_SB(0, 1), cB + hstep, voffB); PG8_STAGE_A(PG8_SA(0, 0), 0, cA, 0, oc); PG8_STAGE_A(PG8_SA(0, 1), 1, cA, 0, oc);
    if (wr == 1) PG8_BAR;
    PG8_WAIT_V(2); PG8_BAR;
    PG8_STAGE(PG8_SB(1, 0), cB + kstep, voffB); PG8_STAGE_A(PG8_SA(1, 0), 0, cA, kstep, oc); PG8_STAGE(PG8_SB(1, 1), cB + hstep + kstep, voffB);
    PG8_WAIT_V(6); PG8_BAR;
    for (;;) {
        const bool has_next = S.next(ui + 1, nxt);
        const char* nA = GATHER ? (const char*)g.A : (has_next ? (const char*)g.A + (size_t)nxt.pm * tstep : cA); const char* nB = has_next ? (const char*)g.Bt + (size_t)nxt.pn * tstep : cB;
        if constexpr (GATHER) {
            if (has_next) {
                const int t2 = wv * 64 + lane_id_volatile(3); int R2[2], C2[2];
#pragma unroll
                for (int i = 0; i < 2; ++i) stage_rc(t2 * 16 + i * 8192, R2[i], C2[i]);
#pragma unroll
                for (int h = 0; h < 2; ++h)
#pragma unroll
                    for (int i = 0; i < 2; ++i) on[h][i] = (unsigned)(S.src_row(nxt, h * HALF + R2[i]) * RB + C2[i] * 2);
            }
        }
        for (int t = 0; t < nt; t += 2) {
            const bool last = (t == nt - 2);
            const size_t k1 = (size_t)(t + 1) * kstep;
            const size_t k2 = last ? (size_t)0 : (size_t)(t + 2) * kstep, k3 = k2 + kstep;
            const char* a2 = last ? nA : cA; const char* b2 = last ? nB : cB;
            unsigned o2[2][2];
            if constexpr (GATHER) {
#pragma unroll
                for (int h = 0; h < 2; ++h)
#pragma unroll
                    for (int i = 0; i < 2; ++i) o2[h][i] = last ? on[h][i] : oc[h][i];
            }
            PG8_LDB(B0, 0, 0); PG8_LDB(B1, 0, 1); PG8_SCHED; PG8_LDA(At, 0, 0); PG8_STAGE_A(PG8_SA(1, 1), 1, cA, k1, oc);
            PG8_WAIT_V(8); PG8_WAIT_L(0); PG8_BAR; PG8_MMA(0, 0, At, B0); PG8_MMA(0, 1, At, B1); PG8_BAR; PG8_SCHED;
            PG8_LDA(At, 0, 1); PG8_STAGE(PG8_SB(0, 0), b2 + k2, voffB); PG8_STAGE(PG8_SB(0, 1), b2 + hstep + k2, voffB); PG8_STAGE_A(PG8_SA(0, 0), 0, a2, k2, o2);
            PG8_WAIT_V(8); PG8_WAIT_L(0); PG8_BAR; PG8_MMA(1, 0, At, B0); PG8_MMA(1, 1, At, B1); PG8_BAR; PG8_SCHED;
            PG8_LDB(B0, 1, 0); PG8_LDB(B1, 1, 1); PG8_SCHED; PG8_LDA(At, 1, 0); PG8_STAGE_A(PG8_SA(0, 1), 1, a2, k2, o2);
            PG8_WAIT_V(8); PG8_WAIT_L(0); PG8_BAR; PG8_MMA(0, 0, At, B0); PG8_MMA(0, 1, At, B1); PG8_BAR; PG8_SCHED;
            PG8_LDA(At, 1, 1); PG8_STAGE(PG8_SB(1, 0), b2 + k3, voffB); PG8_STAGE(PG8_SB(1, 1), b2 + hstep + k3, voffB); PG8_STAGE_A(PG8_SA(1, 0), 0, a2, k3, o2);
            PG8_WAIT_V(8); PG8_WAIT_L(0); PG8_BAR; PG8_MMA(1, 0, At, B0); PG8_MMA(1, 1, At, B1); PG8_BAR; PG8_SCHED;
        }
        if (wr == 0) PG8_BAR;
#ifdef SKIP_EPI_PROBE
        const int le_ = lane_id_volatile(4);
        bool rst = true; if (!g.skip_epi) rst = E(acc, cur, wr, wc, le_ & 15, le_ >> 4);
#else
        const int le_ = lane_id_volatile(4);
        const bool rst = E(acc, cur, wr, wc, le_ & 15, le_ >> 4);
#endif
        if (!has_next) break;
        if (rst) {
#pragma unroll
        for (int a = 0; a < 2; ++a)
#pragma unroll
            for (int b = 0; b < 2; ++b)
#pragma unroll
                for (int m = 0; m < 4; ++m)
#pragma unroll
                    for (int n = 0; n < 2; ++n) acc[a][b][m][n] = (accv_t){0, 0, 0, 0};
        }
        cur = nxt; cA = nA; cB = nB; ++ui;
        if constexpr (GATHER) {
#pragma unroll
            for (int h = 0; h < 2; ++h)
#pragma unroll
                for (int i = 0; i < 2; ++i) oc[h][i] = on[h][i];
        }
        if (wr == 1) PG8_BAR;
    }
    PG8_WAIT_V(0);
    PG8_BAR;
#undef PG8_SA
#undef PG8_SB
#undef PG8_STAGE
#undef PG8_STAGE_A
#undef PG8_LDA
#undef PG8_LDB
#undef PG8_MMA
#undef PG8_WAIT_V
#undef PG8_WAIT_L
#undef PG8_BAR
#undef PG8_SCHED
}
}
typedef f32x4 acc_t[2][2][4][2];
typedef i32x4 acci_t[2][2][4][2];

struct EpiProj {
    bf16_t* O; unsigned char* G8; const float* RS  ; const float* CS  ;
    __device__ __forceinline__ bool operator()(acci_t& acc, const pg8::Unit& u, int wr, int wc, int fr, int fq) const {
        const int pn = u.pn;
        const int act = (pn <= 1 || pn == 3 || pn == 4) ? 1 : (pn >= 12 ? 3 : (pn >= 8 ? 2 : 0));
        const int row0 = u.pm * 256 + wr * 64 + fr, col0 = pn * 256 + wc * 32 + 8 * fq;
        float rsv[8];
#pragma unroll
        for (int q = 0; q < 8; ++q) rsv[q] = RS[row0 + (q >> 2) * 128 + (q & 3) * 16];
        f32x2 cs2[2][4];
#pragma unroll
        for (int bj = 0; bj < 2; ++bj) { const f32x4 c0 = *(const f32x4*)(CS + col0 + bj * 128), c1 = *(const f32x4*)(CS + col0 + bj * 128 + 4); const float k = (act == 1 ? QSCALE : 1.f);
            cs2[bj][0] = (f32x2){c0[0], c0[1]} * k; cs2[bj][1] = (f32x2){c0[2], c0[3]} * k; cs2[bj][2] = (f32x2){c1[0], c1[1]} * k; cs2[bj][3] = (f32x2){c1[2], c1[3]} * k; }
#pragma unroll
        for (int ai = 0; ai < 2; ++ai)
#pragma unroll
            for (int m = 0; m < 4; ++m) { const int row = row0 + ai * 128 + m * 16; bf16_t* rowp = O + (size_t)row * PLD + col0; const float rs = rsv[ai * 4 + m];
#pragma unroll
                for (int bj = 0; bj < 2; ++bj) { f32x2 v[4];
#pragma unroll
                    for (int p = 0; p < 4; ++p) { const int i0 = 2 * p; v[p] = (f32x2){(float)acc[ai][bj][m][i0 >> 2][i0 & 3], (float)acc[ai][bj][m][(i0 + 1) >> 2][(i0 + 1) & 3]} * (cs2[bj][p] * rs); }
                    if (act == 2) {
#pragma unroll
                        for (int p = 0; p < 4; ++p) { const f32x2 x = v[p], t = (x * x * 0.044715f + 1.f) * x * (-2.302208198f); f32x2 d = {fexp2(t[0]), fexp2(t[1])}; d = d + 1.f; v[p] = x * (f32x2){frcp(d[0]), frcp(d[1])}; } }
                    else if (act == 3) {
                        f32x2 gq[4];
#pragma unroll
                        for (int p = 0; p < 4; ++p) { const f32x2 t = v[p] * (-LOG2E); f32x2 d = {fexp2(t[0]), fexp2(t[1])}; d = d + 1.f; gq[p] = (f32x2){frcp(d[0]), frcp(d[1])} * 256.f; }
                        u32x2 w8; w8.x = u8x4_floor(gq[0][0], gq[0][1], gq[1][0], gq[1][1]); w8.y = u8x4_floor(gq[2][0], gq[2][1], gq[3][0], gq[3][1]);
                        *(u32x2*)(G8 + (size_t)row * 3072 + (col0 - C_G) + bj * 128) = w8; continue; }
                    u32x4 w; w.x = cvt_pk_bf16(v[0][0], v[0][1]); w.y = cvt_pk_bf16(v[1][0], v[1][1]); w.z = cvt_pk_bf16(v[2][0], v[2][1]); w.w = cvt_pk_bf16(v[3][0], v[3][1]);
                    *(u32x4*)(rowp + bj * 128) = w; } }
        return true;
    }
};

struct BranchOrder {
    pg8::StaticOrder<MTOK / 256, DM / 256> so;
    __device__ __forceinline__ bool next(int j, pg8::Unit& u) const { const int i = j / 3, br = j - 3 * i; int pm, pn; if (!so.tile(i, pm, pn)) return false; u.pm = br * 256 + pm; u.pn = br * 4 + pn; return true; }
};
struct EpiBranch {
    const unsigned char* G8  ; bf16_t* MERGED;
    __device__ __forceinline__ bool operator()(acc_t& acc, const pg8::Unit& u, int wr, int wc, int fr, int fq) const {
        const int br = u.pn >> 2, pn = u.pn & 3, pm = u.pm & 255;
        const int row0 = pm * 256 + wr * 64 + fr, col0 = pn * 256 + wc * 32 + 8 * fq;
#pragma unroll
        for (int rnd = 0; rnd < 2; ++rnd) { const int ai = rnd, m0 = 0;
            u32x2 gw[4][2], gd[4][2];
#pragma unroll
            for (int m = m0; m < m0 + 4; ++m)
#pragma unroll
                for (int bj = 0; bj < 2; ++bj) { const unsigned char* gp = G8 + (size_t)(row0 + ai * 128 + m * 16) * 3072 + br * 1024 + col0 + bj * 128;
                    gw[m][bj] = *(const u32x2*)gp; if (br != 2) gd[m][bj] = *(const u32x2*)(gp + 1024); }
#pragma unroll
            for (int m = m0; m < m0 + 4; ++m) { const size_t row = (size_t)(row0 + ai * 128 + m * 16);
#pragma unroll
                for (int bj = 0; bj < 2; ++bj) {
                    const u32x2 g = gw[m][bj];
                    float gn[8];
#pragma unroll
                    for (int i = 0; i < 8; ++i) gn[i] = (float)((g[i >> 2] >> (8 * (i & 3))) & 0xffu) + 0.5f;
                    if (br != 2) { const u32x2 d = gd[m][bj];
#pragma unroll
                        for (int i = 0; i < 8; ++i) gn[i] = gn[i] * frcp((float)((d[i >> 2] >> (8 * (i & 3))) & 0xffu) + 0.5f); }
                    else {
#pragma unroll
                        for (int i = 0; i < 8; ++i) gn[i] *= (1.f / 256.f); }
                    f32x4 v0 = acc[ai][bj][m][0], v1 = acc[ai][bj][m][1];
                    v0[0] *= gn[0]; v0[1] *= gn[1]; v0[2] *= gn[2]; v0[3] *= gn[3]; v1[0] *= gn[4]; v1[1] *= gn[5]; v1[2] *= gn[6]; v1[3] *= gn[7];
                    if (br != 2) { acc[ai][bj][m][0] = v0; acc[ai][bj][m][1] = v1; }
                    else { u32x4 w; w.x = cvt_pk_bf16(v0[0], v0[1]); w.y = cvt_pk_bf16(v0[2], v0[3]); w.z = cvt_pk_bf16(v1[0], v1[1]); w.w = cvt_pk_bf16(v1[2], v1[3]);
                        *(u32x4*)(MERGED + row * DM + col0 + bj * 128) = w; } } }
            asm volatile("" ::: "memory");
        }
        return br == 2;
    }
};

#ifndef WOUT_VARIANT
#define WOUT_VARIANT 0
#endif
struct EpiWout {
    bf16_t* Y; float* SSP; bool pv = false;
    __device__ __forceinline__ bool operator()(acc_t& acc, const pg8::Unit& u, int wr, int wc, int fr, int fq) const {
        const int row0 = u.pm * 256 + wr * 64 + fr, col0 = u.pn * 256 + wc * 32 + 8 * fq;
#pragma unroll
        for (int ai = 0; ai < 2; ++ai)
#pragma unroll
            for (int m = 0; m < 4; ++m) { const size_t row = (size_t)(row0 + ai * 128 + m * 16); float ss = 0.f;
#pragma unroll
                for (int bj = 0; bj < 2; ++bj) { const f32x4 v0 = acc[ai][bj][m][0], v1 = acc[ai][bj][m][1];
                    ss += (v0[0] * v0[0] + v0[1] * v0[1]) + (v0[2] * v0[2] + v0[3] * v0[3]) + (v1[0] * v1[0] + v1[1] * v1[1]) + (v1[2] * v1[2] + v1[3] * v1[3]);
                    u32x4 w; w.x = cvt_pk_bf16(v0[0], v0[1]); w.y = cvt_pk_bf16(v0[2], v0[3]); w.z = cvt_pk_bf16(v1[0], v1[1]); w.w = cvt_pk_bf16(v1[2], v1[3]);
                    if (!(WOUT_VARIANT == 2 && pv)) *(u32x4*)(Y + row * DM + col0 + bj * 128) = w; }
                if (!(WOUT_VARIANT == 3 && pv)) ss = xor32_add(xor16_add(ss));
                if (fq == 0 && !((WOUT_VARIANT == 1 || WOUT_VARIANT == 3) && pv)) SSP[row * 16 + u.pn * 4 + wc] = ss; }
        return true;
    }
};

struct MoeOrder {
    int u0, u1, NB, rt_lo;
    const LAS int* tile_e;
    const LAS int* rowidx;
    __device__ __forceinline__ bool next(int i, pg8::Unit& u) const { const int x = u0 + i; if (x >= u1) return false; const int rt = x / NB, pn = x - rt * NB; u.pm = rt; u.pn = tile_e[rt] * NB + pn; return true; }
    __device__ __forceinline__ int src_row(const pg8::Unit& u, int r) const { return rowidx[(u.pm - rt_lo) * 256 + r]; }
};
struct EpiW1 {
    bf16_t* ACT; const float* b1  ;
    __device__ __forceinline__ bool operator()(acc_t& acc, const pg8::Unit& u, int wr, int wc, int fr, int fq) const {
        const int e = u.pn >> 3, pn = u.pn & 7;
        const int row0 = u.pm * 256 + wr * 64 + fr, j0 = pn * 128 + wc * 32 + 8 * fq;
        const float* bp = b1 + (size_t)e * (2 * FF) + 2 * j0;
        float bg[8], bl[8];
#pragma unroll
        for (int q = 0; q < 4; ++q) { const f32x4 t = *(const f32x4*)(bp + 4 * q); bg[2 * q] = t[0]; bl[2 * q] = t[1]; bg[2 * q + 1] = t[2]; bl[2 * q + 1] = t[3]; }
#pragma unroll
        for (int ai = 0; ai < 2; ++ai)
#pragma unroll
            for (int m = 0; m < 4; ++m) { float a[8];
#pragma unroll
                for (int i = 0; i < 8; ++i) { float gl = acc[ai][0][m][i >> 2][i & 3] + bg[i], li = acc[ai][1][m][i >> 2][i & 3] + bl[i];
                    gl = fminf(gl, 7.f); li = fminf(fmaxf(li, -7.f), 7.f);
                    a[i] = gl * frcp(1.f + fexp2(-1.702f * LOG2E * gl)) * (li + 1.f); }
                u32x4 w; w.x = cvt_pk_bf16(a[0], a[1]); w.y = cvt_pk_bf16(a[2], a[3]); w.z = cvt_pk_bf16(a[4], a[5]); w.w = cvt_pk_bf16(a[6], a[7]);
                *(u32x4*)(ACT + (size_t)(row0 + ai * 128 + m * 16) * FF + j0) = w; }
        return true;
    }
};
constexpr float ACT_SCALE = 12.f / 127.f;
struct EpiW1I8 {
    signed char* ACT  ; const float* b1  ; const float* RS  ; const float* CS  ;
    const LAS int* rowidx; int rt_lo;
    __device__ __forceinline__ bool operator()(acci_t& acc, const pg8::Unit& u, int wr, int wc, int fr, int fq) const {
        const int e = u.pn >> 3, pn = u.pn & 7;
        const int rl0 = wr * 64 + fr, row0 = u.pm * 256 + rl0, j0 = pn * 128 + wc * 32 + 8 * fq;
        const float* bp = b1 + (size_t)e * (2 * FF) + 2 * j0;
        float bg[8], bl[8], cg[8], cl[8];
#pragma unroll
        for (int q = 0; q < 4; ++q) { const f32x4 t = *(const f32x4*)(bp + 4 * q); bg[2 * q] = t[0]; bl[2 * q] = t[1]; bg[2 * q + 1] = t[2]; bl[2 * q + 1] = t[3]; }
        { const float* cp = CS + (size_t)e * 2048 + pn * 256 + wc * 32 + 8 * fq;
          const f32x4 a0 = *(const f32x4*)cp, a1 = *(const f32x4*)(cp + 4), c0 = *(const f32x4*)(cp + 128), c1 = *(const f32x4*)(cp + 132);
#pragma unroll
          for (int i = 0; i < 4; ++i) { cg[i] = a0[i]; cg[4 + i] = a1[i]; cl[i] = c0[i]; cl[4 + i] = c1[i]; } }
        const LAS int* ri = rowidx + (u.pm - rt_lo) * 256 + rl0;
        float rsv[8];
#pragma unroll
        for (int q = 0; q < 8; ++q) rsv[q] = RS[ri[(q >> 2) * 128 + (q & 3) * 16]];
        f32x2 bg2[4], bl2[4], cg2[4], cl2[4];
#pragma unroll
        for (int p = 0; p < 4; ++p) { bg2[p] = (f32x2){bg[2 * p], bg[2 * p + 1]}; bl2[p] = (f32x2){bl[2 * p], bl[2 * p + 1]}; cg2[p] = (f32x2){cg[2 * p], cg[2 * p + 1]}; cl2[p] = (f32x2){cl[2 * p], cl[2 * p + 1]}; }
#pragma unroll
        for (int ai = 0; ai < 2; ++ai)
#pragma unroll
            for (int m = 0; m < 4; ++m) { const float rs = rsv[ai * 4 + m]; f32x2 a2[4];
#pragma unroll
                for (int p = 0; p < 4; ++p) { const int i0 = 2 * p;
                    const f32x2 ag = {(float)acc[ai][0][m][i0 >> 2][i0 & 3], (float)acc[ai][0][m][(i0 + 1) >> 2][(i0 + 1) & 3]}, al = {(float)acc[ai][1][m][i0 >> 2][i0 & 3], (float)acc[ai][1][m][(i0 + 1) >> 2][(i0 + 1) & 3]};
                    f32x2 gl = ag * (cg2[p] * rs) + bg2[p], li = al * (cl2[p] * rs) + bl2[p];
                    gl[0] = fminf(gl[0], 7.f); gl[1] = fminf(gl[1], 7.f); li[0] = fminf(fmaxf(li[0], -7.f), 7.f); li[1] = fminf(fmaxf(li[1], -7.f), 7.f);
                    const f32x2 ex = gl * (-1.702f * LOG2E); f32x2 den = {fexp2(ex[0]), fexp2(ex[1])}; den = den + 1.f; const f32x2 rc = {frcp(den[0]), frcp(den[1])};
                    a2[p] = (gl * rc) * (li + 1.f); }
                u32x2 w; w.x = q8x4(a2[0][0], a2[0][1], a2[1][0], a2[1][1], 1.f / ACT_SCALE); w.y = q8x4(a2[2][0], a2[2][1], a2[3][0], a2[3][1], 1.f / ACT_SCALE);
                *(u32x2*)(ACT + (size_t)(row0 + ai * 128 + m * 16) * FF + j0) = w; }
        return true;
    }
};
struct EpiW2 {
    bf16_t* Y2; const float* b2  ; const float* CS  ;
    __device__ __forceinline__ bool operator()(acci_t& acc, const pg8::Unit& u, int wr, int wc, int fr, int fq) const {
        const int e = u.pn >> 2, pn = u.pn & 3;
        const int row0 = u.pm * 256 + wr * 64 + fr, col0 = pn * 256 + wc * 32 + 8 * fq;
        f32x4 bv[2][2], cv[2][2];
#pragma unroll
        for (int bj = 0; bj < 2; ++bj)
#pragma unroll
            for (int n = 0; n < 2; ++n) { bv[bj][n] = *(const f32x4*)(b2 + (size_t)e * DM + col0 + bj * 128 + 4 * n); cv[bj][n] = *(const f32x4*)(CS + (size_t)e * DM + col0 + bj * 128 + 4 * n) * ACT_SCALE; }
#pragma unroll
        for (int ai = 0; ai < 2; ++ai)
#pragma unroll
            for (int m = 0; m < 4; ++m) { bf16_t* rowp = Y2 + (size_t)(row0 + ai * 128 + m * 16) * DM + col0;
#pragma unroll
                for (int bj = 0; bj < 2; ++bj) { const i32x4 a0 = acc[ai][bj][m][0], a1 = acc[ai][bj][m][1];
                    const f32x4 v0 = (f32x4){(float)a0[0], (float)a0[1], (float)a0[2], (float)a0[3]} * cv[bj][0] + bv[bj][0], v1 = (f32x4){(float)a1[0], (float)a1[1], (float)a1[2], (float)a1[3]} * cv[bj][1] + bv[bj][1];
                    u32x4 w; w.x = cvt_pk_bf16(v0[0], v0[1]); w.y = cvt_pk_bf16(v0[2], v0[3]); w.z = cvt_pk_bf16(v1[0], v1[1]); w.w = cvt_pk_bf16(v1[2], v1[3]);
                    *(u32x4*)(rowp + bj * 128) = w; } }
        return true;
    }
};
#define XB_TMO      128
#define XB_XCNT(j)  (256  + 64 * (j))
#define XB_XSUB(j)  (1280 + 64 * (j))
#define XB_XGEN(j)  (2304 + 64 * (j))
#define XB_TOP      3328
#define XB_TOPGEN   3392
#define XCD_BAR_WORDS 3456
#define XB_SPIN_CAP (1u << 18)

__device__ __forceinline__ unsigned xb_ld(unsigned* p)              { return __hip_atomic_load(p, __ATOMIC_RELAXED, __HIP_MEMORY_SCOPE_AGENT); }
__device__ __forceinline__ unsigned xb_add(unsigned* p, unsigned v) { return __hip_atomic_fetch_add(p, v, __ATOMIC_RELAXED, __HIP_MEMORY_SCOPE_AGENT); }
__device__ __forceinline__ unsigned xb_xcc_id() { return (unsigned)__builtin_amdgcn_s_getreg((3 << 11) | 20) & 0xFu; }
#define XB_SPIN(cond, bar) do { unsigned _sp = 0; while (cond) { __builtin_amdgcn_s_sleep(1); \
    if ((++_sp & 255u) == 0u) { if (xb_ld(&(bar)[XB_TMO])) break; if (_sp > XB_SPIN_CAP) { atomicAdd(&(bar)[XB_TMO], 1u); break; } } } } while (0)

struct XcdBarrier {
    unsigned* bar; unsigned x;
    int w;
    volatile LAS unsigned* st;
};

__device__ __forceinline__ bool xb_thread0(int w) { return w == 0 && lane_id_volatile(2) == 0; }
__device__ __forceinline__ XcdBarrier xcd_barrier_post(unsigned* bar, volatile LAS unsigned* st, int w) {
    XcdBarrier b; b.bar = bar; b.x = xb_xcc_id(); b.st = st; b.w = w;
    if (xb_thread0(w)) (void)xb_add(&bar[XB_XCNT(b.x)], 1u);
    return b;
}
__device__ __forceinline__ void xcd_barrier_complete(unsigned* bar, unsigned x, unsigned& nloc, unsigned& nx) {
    const unsigned G = gridDim.x * gridDim.y * gridDim.z;
    unsigned sum, cnt, mine, sp = 0u;
    for (;;) {
        sum = 0u; cnt = 0u; mine = 0u;
#pragma unroll
        for (unsigned j = 0; j < 16; ++j) { const unsigned c = xb_ld(&bar[XB_XCNT(j)]); sum += c; cnt += (c > 0u) ? 1u : 0u; mine = (j == x) ? c : mine; }
        if (sum == G) break;
        __builtin_amdgcn_s_sleep(1);
        if ((++sp & 255u) == 0u) { if (xb_ld(&bar[XB_TMO])) break; if (sp > XB_SPIN_CAP) { atomicAdd(&bar[XB_TMO], 1u); break; } }
    }
    nloc = mine > 0u ? mine : 1u; nx = cnt > 0u ? cnt : 1u;
}

__device__ __forceinline__ void xcd_barrier(const XcdBarrier& b) {
    asm volatile("s_waitcnt vmcnt(0)" ::: "memory");
    __syncthreads();
    if (xb_thread0(b.w)) {
        unsigned* bar = b.bar;
        __builtin_amdgcn_s_waitcnt(0);
        unsigned nloc = b.st[0], nx = b.st[1];
        if (nloc == 0u) { xcd_barrier_complete(bar, b.x, nloc, nx); b.st[0] = nloc; b.st[1] = nx; }
        const unsigned old = xb_add(&bar[XB_XSUB(b.x)], 1u);
        const unsigned gen = old / nloc;
        if (old + 1u == (gen + 1u) * nloc) {
            __builtin_amdgcn_fence(__ATOMIC_RELEASE, "agent");
            asm volatile("s_waitcnt vmcnt(0)" ::: "memory");
            const unsigned og = xb_add(&bar[XB_TOP], 1u);
            const unsigned tg = og / nx;
            if (og + 1u == (tg + 1u) * nx) xb_add(&bar[XB_TOPGEN], 1u);
            else XB_SPIN(xb_ld(&bar[XB_TOPGEN]) == tg, bar);
            __builtin_amdgcn_fence(__ATOMIC_ACQUIRE, "agent");
            xb_add(&bar[XB_XGEN(b.x)], 1u);
            asm volatile("s_waitcnt vmcnt(0)" ::: "memory");
        } else {
            XB_SPIN(xb_ld(&bar[XB_XGEN(b.x)]) == gen, bar);
            __builtin_amdgcn_fence(__ATOMIC_ACQUIRE, "agent");
            asm volatile("s_waitcnt vmcnt(0)" ::: "memory");
        }
    }
    __syncthreads();
}

constexpr size_t MiB = 1u << 20;
constexpr size_t WS_CTL = 0, CTL_ZERO_BYTES = 1 * MiB;
constexpr size_t WS_MOD = 1 * MiB;
constexpr size_t WS_SGW = 3 * MiB;
constexpr size_t WS_WRT = 3 * MiB + 512 * 1024;
constexpr size_t WS_RS = 4 * MiB;
constexpr size_t WS_CS1 = 5 * MiB;
constexpr size_t WS_CS2 = 6 * MiB + 512 * 1024;
constexpr size_t WS_CSIN = 6 * MiB;
constexpr size_t WS_W = 8 * MiB, W_LAYER = 209 * MiB;
constexpr size_t WO_WIN = 0, WO_WBR = 12 * MiB, WO_WOUT = 15 * MiB, WO_W1 = 17 * MiB, WO_W2 = 145 * MiB;
constexpr size_t WS_PROJ = 426 * MiB;
constexpr size_t WS_GATES = 810 * MiB;
constexpr size_t WS_ACT = WS_PROJ;
constexpr size_t WS_X = 1002 * MiB;
constexpr size_t WS_H = 1194 * MiB;
constexpr size_t WS_O = 1322 * MiB;
constexpr size_t WS_Y = 1514 * MiB;
constexpr size_t WS_BITS = 1770 * MiB;
constexpr size_t WS_Y2 = WS_O;
constexpr size_t WS_SSP = 1850 * MiB;
constexpr size_t WS_ROWTOK = 1854 * MiB;
constexpr size_t WS_TOKINFO = 1862 * MiB;
constexpr size_t WS_SLAB = 1864 * MiB;
constexpr size_t WS_END = 1928 * MiB;
static_assert(WS_Y2 + (size_t)270336 * 2048 <= WS_SSP && WS_W + 2 * W_LAYER <= WS_PROJ && WS_PROJ + (size_t)MTOK * PLD * 2 <= WS_GATES && WS_GATES + (size_t)MTOK * 3072 <= WS_H, "d_ws map");
constexpr int CW_BAR = 4096;
constexpr int CW_CNT = 16384;

constexpr int RING_BYTES = 131072;
constexpr int MISC_OFF = 134144;
constexpr int TS_OFF = MISC_OFF + 512;
constexpr int TILE_E_OFF = MISC_OFF + 1024;
constexpr int ROWIDX_OFF = MISC_OFF + 5632;
constexpr int LDS_BYTES = 151552;
static_assert(ROWIDX_OFF + 8192 <= LDS_BYTES, "LDS map");

struct Args {
    const float* in[21]; float* out; unsigned char* ws; int ph_lo, ph_hi;
};
struct Frame {
    LAS unsigned char* lds; int tid, lane, wave, vcu, G;
};
__device__ __forceinline__ Frame phase_frame(const Frame& F0) { Frame F = F0; int t = F0.wave * 64 + lane_id_volatile(3); asm volatile("" : "+v"(t)); F.tid = t; F.lane = t & 63; F.wave = F0.wave; return F; }
template <class T> __device__ __forceinline__ T* opq(T* p) { long z = 0; asm volatile("" : "+s"(z)); return (T*)((unsigned char*)p + z); }

__device__ __forceinline__ void p0_mod(const Frame& F, const float* c, const float* w_ada, const float* b_ada, float* MOD) {
    LAS float* csT = (LAS float*)F.lds;
    for (int i = F.tid; i < BATCH * DM; i += 512) { const int b = i & 31, k = i >> 5; const float v = c[b * DM + k]; csT[k * 32 + b] = v * sigmoidf_(v); }
    __syncthreads();
    const int gw = F.vcu * 8 + F.wave, NGW = F.G * 8;
    const int cg = F.lane & 15, kq = F.lane >> 4;
    for (int task = gw; task < DEPTH * 384; task += NGW) {
        const int l = task / 384, n = (task % 384) * 16 + cg;
        float acc[32];
#pragma unroll
        for (int b = 0; b < 32; ++b) acc[b] = 0.f;
        const float* w = w_ada + ((size_t)l * DM + kq * 256) * (6 * DM) + n;
#pragma unroll 4
        for (int k = 0; k < 256; ++k) {
            const float wv = w[(size_t)k * (6 * DM)];
            const LAS f32x4* cs = (const LAS f32x4*)(csT + (kq * 256 + k) * 32);
#pragma unroll
            for (int q = 0; q < 8; ++q) { const f32x4 c4 = cs[q]; acc[4 * q] += c4[0] * wv; acc[4 * q + 1] += c4[1] * wv; acc[4 * q + 2] += c4[2] * wv; acc[4 * q + 3] += c4[3] * wv; }
        }
#pragma unroll
        for (int b = 0; b < 32; ++b) { acc[b] = xor32_add(xor16_add(acc[b])); }
        if (kq == 0) { const float bb = b_ada[l * 6 * DM + n];
#pragma unroll
            for (int b = 0; b < 32; ++b) MOD[((size_t)l * BATCH + b) * (6 * DM) + n] = acc[b] + bb; }
    }
    __syncthreads();
}
__device__ __forceinline__ void tr_item(const float* W, size_t ldw, int srccol, bool valid, bf16_t* dst  , int K, LAS float* scr, int lane) {
    const float* wp = W + srccol;
#pragma unroll 8
    for (int i = 0; i < 32; ++i) { const int kk = 2 * i + (lane >> 5); scr[kk * 33 + (lane & 31)] = valid ? wp[(size_t)kk * ldw] : 0.f; }
    LDS_WAIT(); asm volatile("" ::: "memory");
    const int c = lane & 7;
#pragma unroll
    for (int j = 0; j < 4; ++j) { const int n = (lane >> 3) + 8 * j; const LAS float* s = scr + (8 * c) * 33 + n;
        u32x4 o; o.x = cvt_pk_bf16(s[0 * 33], s[1 * 33]); o.y = cvt_pk_bf16(s[2 * 33], s[3 * 33]); o.z = cvt_pk_bf16(s[4 * 33], s[5 * 33]); o.w = cvt_pk_bf16(s[6 * 33], s[7 * 33]);
        *(u32x4*)(dst + (size_t)n * K + 8 * c) = o; }
    LDS_WAIT(); asm volatile("" ::: "memory");
}
__device__ __forceinline__ void p0_weights(const Frame& F, const Args& a) {
    LAS float* scr = (LAS float*)(F.lds + F.wave * 16384);
    const int gw = F.vcu * 8 + F.wave, NGW = F.G * 8, lane = F.lane, jl = lane & 31;
    const float *w_in = a.in[8], *w_branch = a.in[13], *w_out = a.in[14], *w_router = a.in[15], *w1 = a.in[17], *w2 = a.in[19];
    constexpr int I_BR = 3 * 8 * 32, I_OUT = 16 * 32, I_RT = 16;
    constexpr int I_LAYER = I_BR + I_OUT + I_RT;
    for (int it = gw; it < DEPTH * I_LAYER; it += NGW) {
        const int l = it / I_LAYER; int r = it - l * I_LAYER;
        unsigned char* wl = a.ws + WS_W + (size_t)l * W_LAYER;
        if (r < I_BR) {
            const int br = r / 256, q = r % 256, kb = q / 32, nb = q % 32;
            tr_item(w_branch + ((size_t)(l * 3 + br) * 512 + kb * 64) * DM, DM, nb * 32 + jl, true, (bf16_t*)(wl + WO_WBR) + (size_t)(br * 1024 + nb * 32) * 512 + kb * 64, 512, scr, lane); continue; }
        r -= I_BR;
        if (r < I_OUT) {
            const int kb = r / 32, nb = r % 32;
            tr_item(w_out + ((size_t)l * DM + kb * 64) * DM, DM, nb * 32 + jl, true, (bf16_t*)(wl + WO_WOUT) + (size_t)nb * 32 * DM + kb * 64, DM, scr, lane); continue; }
        r -= I_OUT;
        {
            const int kb = r;
            tr_item(w_router + ((size_t)l * DM + kb * 64) * NE, NE, jl, true, (bf16_t*)(a.ws + WS_WRT) + (size_t)l * NE * DM + kb * 64, DM, scr, lane); }
        (void)r;
    }
    __syncthreads();
    {
    LAS float* T = (LAS float*)F.lds; LAS float* red = (LAS float*)(F.lds + ROWIDX_OFF);
    const int half = lane >> 5, wave = F.wave;
    constexpr int ST_W1 = NE * 64, ST_IN = 192, ST_W2 = NE * 32, ST_LAYER = ST_W1 + ST_IN + ST_W2;
    for (int st = F.vcu; st < DEPTH * ST_LAYER; st += F.G) {
        const int l = st / ST_LAYER, q = st % ST_LAYER;
        const float* wp; size_t ldw; bool valid = true; signed char* dst; float* csp;
        if (q < ST_W1) { const int e = q / 64, r6 = q % 64, pn = r6 >> 3, jjg = (r6 >> 1) & 3, sgl = r6 & 1, nb = pn * 8 + sgl * 4 + jjg, n = nb * 32 + jl, src = 2 * (128 * pn + jjg * 32 + jl) + sgl;
            wp = w1 + ((size_t)(l * NE + e) * DM) * (2 * FF) + src; ldw = 2 * FF;
            dst = (signed char*)(a.ws + WS_W + (size_t)l * W_LAYER + WO_W1) + ((size_t)e * 2048 + nb * 32) * DM; csp = (float*)(a.ws + WS_CS1) + ((size_t)l * NE + e) * 2048 + n; }
        else if (q >= ST_W1 + ST_IN) { const int q2 = q - ST_W1 - ST_IN, e = q2 / 32, nb = q2 % 32, n = nb * 32 + jl;
            wp = w2 + ((size_t)(l * NE + e) * FF) * DM + n; ldw = DM;
            dst = (signed char*)(a.ws + WS_W + (size_t)l * W_LAYER + WO_W2) + ((size_t)e * DM + nb * 32) * FF; csp = (float*)(a.ws + WS_CS2) + ((size_t)l * NE + e) * DM + n; }
        else { const int nb = q - ST_W1, n = nb * 32 + jl; valid = (n < 1832) || (n >= 2048); const int src = n < 1832 ? n : n - 216;
            wp = w_in + (size_t)l * DM * 5928 + (valid ? src : 0); ldw = 5928;
            dst = (signed char*)(a.ws + WS_W + (size_t)l * W_LAYER + WO_WIN) + (size_t)nb * 32 * DM; csp = (float*)(a.ws + WS_CSIN) + (size_t)l * NPROJ + n; }
        float am = 0.f;
#pragma unroll
        for (int ib = 0; ib < 2; ++ib) { float vv[32];
#pragma unroll
            for (int i = 0; i < 32; ++i) { const int k = wave * 128 + 2 * (ib * 32 + i) + half; vv[i] = valid ? __builtin_nontemporal_load(wp + (size_t)k * ldw) : 0.f; }
#pragma unroll
            for (int i = 0; i < 32; ++i) { const int k = wave * 128 + 2 * (ib * 32 + i) + half; am = fmaxf(am, fabsf(vv[i])); T[k * 32 + (jl ^ (k & 31))] = vv[i]; } }
        red[(wave * 2 + half) * 32 + jl] = am;
        __syncthreads();
        float amx = 0.f;
#pragma unroll
        for (int p = 0; p < 16; ++p) amx = fmaxf(amx, red[p * 32 + jl]);
        const float scale = valid ? fmaxf(amx, 1e-30f) * (1.f / 127.f) : 1.f, inv = valid ? 1.f / scale : 0.f;
        if (wave == 0 && half == 0) *csp = scale;
        const int k0 = 64 * (wave * 2 + half);
#pragma unroll
        for (int c16 = 0; c16 < 4; ++c16) { unsigned wq[4];
#pragma unroll
            for (int d4 = 0; d4 < 4; ++d4) { const int k = k0 + c16 * 16 + d4 * 4;
                wq[d4] = q8x4(T[k * 32 + (jl ^ (k & 31))], T[(k + 1) * 32 + (jl ^ ((k + 1) & 31))], T[(k + 2) * 32 + (jl ^ ((k + 2) & 31))], T[(k + 3) * 32 + (jl ^ ((k + 3) & 31))], inv); }
            *(u32x4*)(dst + (size_t)jl * DM + k0 + c16 * 16) = (u32x4){wq[0], wq[1], wq[2], wq[3]}; }
        __syncthreads();
    }
    }
    const float* sg_w = a.in[10]; bf16_t* SGW = (bf16_t*)(a.ws + WS_SGW);
    for (int i = (F.vcu * 512 + F.tid) * 2; i < DEPTH * 8 * 128 * 128; i += F.G * 512 * 2) { const int s = i & 127, t = (i >> 7) & 127; const f32x2 v = *(const f32x2*)(sg_w + i);
        *(unsigned*)(SGW + i) = cvt_pk_bf16(s <= t ? v[0] : 0.f, (s + 1) <= t ? v[1] : 0.f); }
}

__device__ __forceinline__ void norm_mod_row(const f32x4 (&v)[4], float ss, const float* g, const float* sc, const float* sh, signed char* orow, float* rs, int lane) {
    const float rstd = 1.f / sqrtf(ss * (1.f / DM) + RMS_EPS);
    f32x4 o[4]; float am = 0.f;
#pragma unroll
    for (int j = 0; j < 4; ++j) { const int c = 4 * lane + 256 * j; const f32x4 gg = *(const f32x4*)(g + c), s1 = *(const f32x4*)(sc + c), s0 = *(const f32x4*)(sh + c);
        o[j] = (v[j] * rstd) * gg * (s1 + 1.f) + s0;
        am = fmaxf(am, fmaxf(fmaxf(fabsf(o[j][0]), fabsf(o[j][1])), fmaxf(fabsf(o[j][2]), fabsf(o[j][3])))); }
    am = wave_max(am);
    const float scale = fmaxf(am, 1e-30f) * (1.f / 127.f), inv = 1.f / scale;
    if (lane == 0) *rs = scale;
#pragma unroll
    for (int j = 0; j < 4; ++j) *(unsigned*)(orow + 4 * lane + 256 * j) = q8x4(o[j][0], o[j][1], o[j][2], o[j][3], inv);
}
__device__ __forceinline__ void p1_norm(const Frame& F, const float* x, const float* g, const float* MOD0, signed char* H8, float* RS, bf16_t* X16) {
    const int gw = F.vcu * 8 + F.wave, NGW = F.G * 8;
    for (int row0 = gw * 4; row0 < MTOK; row0 += NGW * 4) { f32x4 v[4][4];
#pragma unroll
        for (int rr = 0; rr < 4; ++rr)
#pragma unroll
            for (int j = 0; j < 4; ++j) v[rr][j] = __builtin_nontemporal_load((const f32x4*)(x + (size_t)(row0 + rr) * DM + 4 * F.lane + 256 * j));
#pragma unroll
        for (int rr = 0; rr < 4; ++rr) { const int row = row0 + rr, b = row >> 11; float ss = 0.f;
#pragma unroll
            for (int j = 0; j < 4; ++j) ss += (v[rr][j][0] * v[rr][j][0] + v[rr][j][1] * v[rr][j][1]) + (v[rr][j][2] * v[rr][j][2] + v[rr][j][3] * v[rr][j][3]);
            ss = wave_sum(ss);
#pragma unroll
            for (int j = 0; j < 4; ++j) { u32x2 w; w.x = cvt_pk_bf16(v[rr][j][0], v[rr][j][1]); w.y = cvt_pk_bf16(v[rr][j][2], v[rr][j][3]); *(u32x2*)(X16 + (size_t)row * DM + 4 * F.lane + 256 * j) = w; }
            const float* mb = MOD0 + (size_t)b * 6 * DM;
            norm_mod_row(v[rr], ss, g, mb + DM, mb, H8 + (size_t)row * DM, RS + row, F.lane); } }
}
constexpr int TOPK_SEL = 256;
struct IdxOps { bf16x8 af[4][2]; u32x4 wraw[4][2]; bf16x8 kf[4][2]; };
__device__ __forceinline__ void dsa_index_load(IdxOps& P, const bf16_t* __restrict__ PROJ, int b, int qg, int lane, int wid) {
    asm volatile("" : "+v"(lane));
    const int n = lane & 31, hi = lane >> 5;
    const int q0 = qg * 16;
    const size_t tokbase = (size_t)b * SEQ;
    const int m = n, hm = (m >> 2) & 1, idx = (m & 3) + 4 * (m >> 3), aq = 2 * hm + (idx >> 3), ah = idx & 7;
#pragma unroll
    for (int qgp = 0; qgp < 4; ++qgp) { const bf16_t* qp = PROJ + (tokbase + q0 + 4 * qgp + aq) * PLD + C_QI + ah * 32 + 8 * hi;
        P.af[qgp][0] = *(const bf16x8*)qp; P.af[qgp][1] = *(const bf16x8*)(qp + 16); }
}
__device__ __forceinline__ void dsa_index_load_k(IdxOps& P, const bf16_t* __restrict__ PROJ, int b, int qg, int lane, int wid) {
    asm volatile("" : "+v"(lane));
    const int n = lane & 31, hi = lane >> 5;
    const int q0 = qg * 16, nkb = (q0 + 16 + 31) >> 5;
    const size_t tokbase = (size_t)b * SEQ;
#pragma unroll
    for (int qgp = 0; qgp < 4; ++qgp)
#pragma unroll
        for (int qq = 0; qq < 2; ++qq) P.wraw[qgp][qq] = *(const u32x4*)(PROJ + (tokbase + q0 + 4 * qgp + 2 * hi + qq) * PLD + C_WI);
#pragma unroll
    for (int i = 0; i < 4; ++i) { const int kb = wid + 8 * i;
        if (kb < nkb) { const bf16_t* kp = PROJ + (tokbase + 32 * kb + n) * PLD + C_KI + 8 * hi; P.kf[i][0] = *(const bf16x8*)kp; P.kf[i][1] = *(const bf16x8*)(kp + 16); } }
}
__device__ __forceinline__ void dsa_index_scores(IdxOps& P, const bf16_t* __restrict__ PROJ, LAS float* sc, int b, int qg, int lane, int wid) {
    const int n = lane & 31, hi = lane >> 5;
    const int q0 = qg * 16, nkb = (q0 + 16 + 31) >> 5;
    const size_t tokbase = (size_t)b * SEQ;
    LAS float* scw = sc + (2 * hi) * 2048 + 32 * wid + n;
    float wv[4][16];
#pragma unroll
    for (int qgp = 0; qgp < 4; ++qgp)
#pragma unroll
        for (int qq = 0; qq < 2; ++qq) { const u32x4 w = P.wraw[qgp][qq];
            wv[qgp][8 * qq + 0] = bf_lo(w.x) * 0.0625f; wv[qgp][8 * qq + 1] = bf_hi(w.x) * 0.0625f; wv[qgp][8 * qq + 2] = bf_lo(w.y) * 0.0625f; wv[qgp][8 * qq + 3] = bf_hi(w.y) * 0.0625f;
            wv[qgp][8 * qq + 4] = bf_lo(w.z) * 0.0625f; wv[qgp][8 * qq + 5] = bf_hi(w.z) * 0.0625f; wv[qgp][8 * qq + 6] = bf_lo(w.w) * 0.0625f; wv[qgp][8 * qq + 7] = bf_hi(w.w) * 0.0625f; }
#pragma unroll
    for (int i = 0; i < 8; ++i) { const int kb = wid + 8 * i;
        if (kb < nkb) {
            const bf16x8 k0 = P.kf[i & 3][0], k1 = P.kf[i & 3][1];
            if (i < 4 && kb + 32 < nkb) { const bf16_t* kp = PROJ + (tokbase + 32 * (kb + 32) + n) * PLD + C_KI + 8 * hi; P.kf[i & 3][0] = *(const bf16x8*)kp; P.kf[i & 3][1] = *(const bf16x8*)(kp + 16); }
#pragma unroll
            for (int qgp = 0; qgp < 4; ++qgp) {
                f32x16 d = {0.f, 0.f, 0.f, 0.f, 0.f, 0.f, 0.f, 0.f, 0.f, 0.f, 0.f, 0.f, 0.f, 0.f, 0.f, 0.f};
                d = __builtin_amdgcn_mfma_f32_32x32x16_bf16(P.af[qgp][0], k0, d, 0, 0, 0);
                d = __builtin_amdgcn_mfma_f32_32x32x16_bf16(P.af[qgp][1], k1, d, 0, 0, 0);
                float sa = 0.f, sb = 0.f;
#pragma unroll
                for (int r = 0; r < 8; ++r) { sa += wv[qgp][r] * fmaxf(d[r], 0.f); sb += wv[qgp][8 + r] * fmaxf(d[8 + r], 0.f); }
                scw[(4 * qgp) * 2048 + 256 * i] = sa; scw[(4 * qgp + 1) * 2048 + 256 * i] = sb;
            } } }
}
__device__ __forceinline__ void bit_transpose32(unsigned (&a)[32]) {
#pragma unroll
    for (int k = 0; k < 16; ++k) { const unsigned lo = a[k], hi = a[k + 16];
        a[k] = __builtin_amdgcn_perm(hi, lo, 0x05040100u); a[k + 16] = __builtin_amdgcn_perm(hi, lo, 0x07060302u); }
#pragma unroll
    for (int k = 0; k < 32; ++k) if ((k & 8) == 0) { const unsigned lo = a[k], hi = a[k + 8];
        a[k] = __builtin_amdgcn_perm(hi, lo, 0x06020400u); a[k + 8] = __builtin_amdgcn_perm(hi, lo, 0x07030501u); }
#pragma unroll
    for (int s = 0; s < 3; ++s) { const int j = 4 >> s; const unsigned m = (s == 0) ? 0x0F0F0F0Fu : (s == 1) ? 0x33333333u : 0x55555555u;
#pragma unroll
        for (int k = 0; k < 32; ++k) if ((k & j) == 0) { const unsigned lo = a[k], hi = a[k + j];
            a[k] = (m & lo) | (~m & (hi << j)); a[k + j] = (m & (lo >> j)) | (~m & hi); } }
}
__device__ __forceinline__ void dsa_index_select(LAS float* sc, LAS int* qctr, unsigned long long* __restrict__ bits64, int b, int qg, int lane, int wid) {
    const int q0 = qg * 16;
    const size_t tokbase = (size_t)b * SEQ;
#pragma unroll 1
    for (;;) {
        int qn = 0; if (lane == 0) qn = __hip_atomic_fetch_add(qctr, 1, __ATOMIC_RELAXED, __HIP_MEMORY_SCOPE_WORKGROUP);
        qn = __builtin_amdgcn_readfirstlane(qn); if (qn >= 16) break;
        const int ql = 15 - qn, pos = q0 + ql, nn = pos + 1, nr = (nn + 63) >> 6;
        const LAS float* scq = sc + ql * 2048;
        unsigned mlo = 0u, mhi = 0u;
        if (nn <= TOPK_SEL) {
#pragma unroll
            for (int r = 0; r < 4; ++r) if (r < nr) { const unsigned long long bal = __ballot(64 * r + lane <= pos); asm volatile("s_nop 4\n\tv_writelane_b32 %0, %2, %4\n\tv_writelane_b32 %1, %3, %4" : "+v"(mlo), "+v"(mhi) : "s"((unsigned)bal), "s"((unsigned)(bal >> 32)), "n"(r));     }
        } else {
            unsigned u[32];
#pragma unroll
            for (int r = 0; r < 32; ++r) u[r] = 0u;
#pragma unroll
            for (int g8 = 0; g8 < 4; ++g8) if (8 * g8 < nr) {
#pragma unroll
                for (int q_ = 0; q_ < 8; ++q_) { const int r = 8 * g8 + q_; const int j = 64 * r + lane; float s = scq[j]; s = (s == 0.f) ? 0.f : s; const unsigned bts = __builtin_bit_cast(unsigned, s);
                    const unsigned uu = (bts & 0x80000000u) ? ~bts : (bts | 0x80000000u); u[r] = (j <= pos) ? uu : 0u; } }
            unsigned M = 0u;
#pragma unroll
            for (int r = 0; r < 32; ++r) M |= (64 * r + lane <= pos) ? (1u << r) : 0u;
            bit_transpose32(u);
            unsigned G = 0u; unsigned need = (unsigned)TOPK_SEL, cM = (unsigned)nn;
            {
#pragma unroll
            for (int bq = 31; bq >= 0; --bq) {
                const unsigned T = M & u[bq];
                const unsigned c = wave_sum_u32((unsigned)__builtin_popcount(T));
                const bool ge = c >= need;
                G |= ge ? 0u : T; M = ge ? T : (M & ~u[bq]); cM = ge ? c : cM - c; need -= ge ? 0u : c;
                if (cM == need) { G |= M; goto sel_done; }
            }
            unsigned run = 0u;
#pragma unroll
            for (int r = 0; r < 32; ++r) if (r < nr) { const bool isc = (M >> r) & 1u; const unsigned long long eqm = __ballot(isc);
                const unsigned pre = run + __builtin_amdgcn_mbcnt_hi((unsigned)(eqm >> 32), __builtin_amdgcn_mbcnt_lo((unsigned)eqm, 0u));
                if (isc && pre < need) G |= (1u << r);
                run += (unsigned)__builtin_popcountll(eqm); }
            }
            sel_done:
#pragma unroll
            for (int r = 0; r < 32; ++r) if ((r & ~7) < nr) { const unsigned long long bal = __ballot((G >> r) & 1u); asm volatile("s_nop 4\n\tv_writelane_b32 %0, %2, %4\n\tv_writelane_b32 %1, %3, %4" : "+v"(mlo), "+v"(mhi) : "s"((unsigned)bal), "s"((unsigned)(bal >> 32)), "n"(r));     }
        }
        if (lane < nr) bits64[(tokbase + pos) * 32 + lane] = ((unsigned long long)mhi << 32) | mlo;
    }
}
__device__ __forceinline__ void dsa_index_phase(const Frame& F, const bf16_t* __restrict__ PROJ, unsigned long long* __restrict__ bits64, unsigned* stampw, bool pv = false) {
    LAS float* sc = (LAS float*)F.lds;
    LAS int* qctr = (LAS int*)(F.lds + TS_OFF);
    IdxOps P;
    int u = F.vcu;
    if (u < 4096) { dsa_index_load(P, PROJ, u & 31, u >> 5, F.lane, F.wave); dsa_index_load_k(P, PROJ, u & 31, u >> 5, F.lane, F.wave); }
#ifdef T_STAMP
    unsigned long long tA = 0, tB = 0, tC = 0, tD = 0, t0 = __builtin_amdgcn_s_memrealtime(), t1;
#define STAMP(acc) do { t1 = __builtin_amdgcn_s_memrealtime(); acc += t1 - t0; t0 = t1; } while (0)
#else
#define STAMP(acc) do { } while (0)
#endif
#pragma unroll 1
    for (; u < 4096; u += F.G) {
#if defined(IDX_PROBE) && (IDX_PROBE & 1)
        if (!pv)
#endif
        dsa_index_scores(P, PROJ, sc, u & 31, u >> 5, F.lane, F.wave);
        if (F.tid == 0) *qctr = 0;
        STAMP(tA);
        __syncthreads();
        STAMP(tB);
        const int un = u + F.G;
#if defined(IDX_PROBE) && (IDX_PROBE & 2)
        if (!pv)
#endif
        dsa_index_select(sc, qctr, bits64, u & 31, u >> 5, F.lane, F.wave);
        asm volatile("" ::: "memory");
        if (un < 4096) { dsa_index_load(P, PROJ, un & 31, un >> 5, F.lane, F.wave); dsa_index_load_k(P, PROJ, un & 31, un >> 5, F.lane, F.wave); }
        STAMP(tC);
        __syncthreads();
        STAMP(tD);
    }
#ifdef T_STAMP
    if (stampw && blockIdx.x == 17 && F.tid == 0) { const unsigned long long tot = tA + tB + tC + tD; const unsigned long long part = (T_STAMP == 0) ? tA : (T_STAMP == 1) ? tB : (T_STAMP == 2) ? tC : tD;
        *stampw = (unsigned)((part * 64ull) / (tot ? tot : 1ull)); }
#endif
#undef STAMP
}

constexpr int KS = 144, VS = 192;
#ifndef USE_TR
#define USE_TR 1
#endif
struct AttnPre { bf16x8 qf[4]; u32x4 kreg, vreg; u32x2 mreg; };
__device__ __forceinline__ void attn_decode(int u, int& b, int& g, int& qb) { const int cu = u & 255, j = u >> 8, bg = cu >> 2, s = cu & 3; qb = (j & 1) ? (8 * (j >> 1) + 7 - s) : (8 * (j >> 1) + s); b = bg >> 1; g = bg & 1; }
template <int MODE>
__device__ __forceinline__ void attn_prefetch(const Frame& F, const bf16_t* __restrict__ PROJ, const unsigned* __restrict__ bits, int b, int g, int qb, bf16x8 (&qf)[4], u32x4& kreg, u32x4& vreg, u32x2& mreg) {
    const int tid = F.tid, lane = F.lane, wid = F.wave, n = lane & 31, hi = lane >> 5;
    constexpr int CQ = MODE ? C_QB : C_QA, CK = MODE ? C_KB : C_KA, CV = MODE ? C_VB : C_VA;
    const int hq = 4 * g + (wid >> 1), qpos = qb * 64 + 32 * (wid & 1) + n;
    const size_t tokbase = (size_t)b * SEQ;
    const int kt_lo = (MODE == 0) ? (qb >= 2 ? qb - 2 : 0) : 0;
    const int srow = tid >> 3, sch = tid & 7;
    kreg = *(const u32x4*)(PROJ + (tokbase + srow + (size_t)kt_lo * 64) * PLD + CK + g * 64 + sch * 8);
    vreg = *(const u32x4*)(PROJ + (tokbase + srow + (size_t)kt_lo * 64) * PLD + CV + g * 64 + sch * 8);
    if (MODE == 1) mreg = *(const u32x2*)(bits + (tokbase + qpos) * 64 + 2 * kt_lo);
    const bf16_t* qp = PROJ + (tokbase + qpos) * PLD + CQ + hq * 64 + 8 * hi;
#pragma unroll
    for (int s = 0; s < 4; ++s) qf[s] = *(const bf16x8*)(qp + 16 * s);
}
template <int MODE>
__device__ __forceinline__ void attn_unit(const Frame& F, const bf16_t* __restrict__ PROJ, bf16_t* __restrict__ O, const unsigned* __restrict__ bits, const float* __restrict__ sinks, int b, int g, int qb, AttnPre& P, int un  ) {
    const int tid = F.tid, lane = F.lane, wid = F.wave, n = lane & 31, hi = lane >> 5;
    constexpr int CQ = MODE ? C_QB : C_QA, CK = MODE ? C_KB : C_KA, CV = MODE ? C_VB : C_VA;
    const int hq = 4 * g + (wid >> 1), qpos = qb * 64 + 32 * (wid & 1) + n;
    const size_t tokbase = (size_t)b * SEQ;
    LAS unsigned char* Ks = F.lds; LAS unsigned char* Vs = F.lds + 64 * KS;
    bf16x8 qf[4], qn[4];
#pragma unroll
    for (int s = 0; s < 4; ++s) { qf[s] = P.qf[s]; qn[s] = P.qf[s]; }
    f32x16 o0, o1;
#pragma unroll
    for (int r = 0; r < 16; ++r) { o0[r] = 0.f; o1[r] = 0.f; }
    float mrun, lsum;
    if (MODE == 0) { mrun = sinks[hq] * LOG2E; lsum = (hi == 0) ? 1.f : 0.f; } else { mrun = -1e30f; lsum = 0.f; }
    const int kt_lo = (MODE == 0) ? (qb >= 2 ? qb - 2 : 0) : 0, kt_hi = qb;
    const int srow = tid >> 3, sch = tid & 7;
    const bf16_t* kg = PROJ + (tokbase + srow) * PLD + CK + g * 64 + sch * 8;
    const bf16_t* vg = PROJ + (tokbase + srow) * PLD + CV + g * 64 + sch * 8;
    const unsigned* bp = bits + (tokbase + qpos) * 64;
    u32x4 kreg = P.kreg, vreg = P.vreg;
    u32x2 mreg = {0u, 0u};
    if (MODE == 1) mreg = P.mreg;
    const int vbase = (4 * hi + ((lane & 15) >> 2)) * VS + (16 * ((lane >> 4) & 1) + 4 * (lane & 3)) * 2;
    for (int kt = kt_lo; kt <= kt_hi; ++kt) {
        __syncthreads();
        *(LAS u32x4*)(Ks + srow * KS + sch * 16) = kreg; *(LAS u32x4*)(Vs + srow * VS + sch * 16) = vreg;
        const u32x2 mcur = mreg;
        __syncthreads();
        if (kt < kt_hi) { kreg = *(const u32x4*)(kg + (size_t)(kt + 1) * 64 * PLD); vreg = *(const u32x4*)(vg + (size_t)(kt + 1) * 64 * PLD); if (MODE == 1) mreg = *(const u32x2*)(bp + 2 * (kt + 1)); }
        else if (un < 2048) { int nb, ng, nqb; attn_decode(un, nb, ng, nqb); attn_prefetch<MODE>(F, PROJ, bits, nb, ng, nqb, qn, kreg, vreg, mreg); }
        f32x16 p0, p1;
#pragma unroll
        for (int r = 0; r < 16; ++r) { p0[r] = 0.f; p1[r] = 0.f; }
#pragma unroll
        for (int s = 0; s < 4; ++s) { const bf16x8 k0 = *(const LAS bf16x8*)(Ks + n * KS + (16 * s + 8 * hi) * 2), k1 = *(const LAS bf16x8*)(Ks + (n + 32) * KS + (16 * s + 8 * hi) * 2);
            p0 = __builtin_amdgcn_mfma_f32_32x32x16_bf16(k0, qf[s], p0, 0, 0, 0); p1 = __builtin_amdgcn_mfma_f32_32x32x16_bf16(k1, qf[s], p1, 0, 0, 0); }
        unsigned w0, w1;
        if (MODE == 1) { w0 = mcur.x >> (4 * hi); w1 = mcur.y >> (4 * hi); }
        else {
#pragma unroll
            for (int blk = 0; blk < 2; ++blk) { const int d0 = qpos - (kt * 64 + 32 * blk); unsigned mk = 0u;
                if (d0 >= 0) { const int hb = d0 > 31 ? 31 : d0; int lo = d0 - 127; if (lo <= 31) { if (lo < 0) lo = 0; mk = (0xFFFFFFFFu >> (31 - hb)) & (0xFFFFFFFFu << lo); } }
                if (blk == 0) w0 = mk >> (4 * hi); else w1 = mk >> (4 * hi); }
        }
        float mx = fmaxf(fmaxf(p0[0], p0[1]), fmaxf(p1[0], p1[1]));
#pragma unroll
        for (int r = 2; r < 16; r += 2) mx = fmaxf(mx, fmaxf(fmaxf(p0[r], p0[r + 1]), fmaxf(p1[r], p1[r + 1])));
        mx = xor32_max(mx);
        const float mnew = fmaxf(mrun, mx), alpha = fexp2(mrun - mnew); mrun = mnew;
        float ps = 0.f;
#pragma unroll
        for (int r = 0; r < 16; ++r) { const int bitpos = 8 * (r >> 2) + (r & 3);
            const float e0 = fexp2(p0[r] - mnew), e1 = fexp2(p1[r] - mnew);
            p0[r] = __builtin_bit_cast(float, __builtin_bit_cast(unsigned, e0) & (unsigned)__builtin_amdgcn_sbfe((int)w0, bitpos, 1));
            p1[r] = __builtin_bit_cast(float, __builtin_bit_cast(unsigned, e1) & (unsigned)__builtin_amdgcn_sbfe((int)w1, bitpos, 1));
            ps += p0[r] + p1[r]; }
        lsum = lsum * alpha + ps;
        if (__builtin_amdgcn_ballot_w64(alpha != 1.f) != 0ull) {
#pragma unroll
            for (int r = 0; r < 16; ++r) { o0[r] *= alpha; o1[r] *= alpha; } }
        bf16x8 pf[2][2];
#pragma unroll
        for (int s2 = 0; s2 < 2; ++s2) { u32x4 a, c;
            a.x = cvt_pk_bf16(p0[8 * s2 + 0], p0[8 * s2 + 1]); a.y = cvt_pk_bf16(p0[8 * s2 + 2], p0[8 * s2 + 3]); a.z = cvt_pk_bf16(p0[8 * s2 + 4], p0[8 * s2 + 5]); a.w = cvt_pk_bf16(p0[8 * s2 + 6], p0[8 * s2 + 7]);
            c.x = cvt_pk_bf16(p1[8 * s2 + 0], p1[8 * s2 + 1]); c.y = cvt_pk_bf16(p1[8 * s2 + 2], p1[8 * s2 + 3]); c.z = cvt_pk_bf16(p1[8 * s2 + 4], p1[8 * s2 + 5]); c.w = cvt_pk_bf16(p1[8 * s2 + 6], p1[8 * s2 + 7]);
            pf[0][s2] = __builtin_bit_cast(bf16x8, a); pf[1][s2] = __builtin_bit_cast(bf16x8, c); }
#pragma unroll
        for (int db = 0; db < 2; ++db)
#pragma unroll
            for (int blk = 0; blk < 2; ++blk)
#pragma unroll
                for (int s2 = 0; s2 < 2; ++s2) {
                    bf16x8 vf;
#if USE_TR
                    const v4i16_t t0 = __builtin_amdgcn_ds_read_tr16_b64_v4i16((LAS v4i16_t*)(Vs + vbase + (32 * blk + 16 * s2) * VS + 64 * db));
                    const v4i16_t t1 = __builtin_amdgcn_ds_read_tr16_b64_v4i16((LAS v4i16_t*)(Vs + vbase + (32 * blk + 16 * s2 + 8) * VS + 64 * db));
                    vf = (bf16x8){t0[0], t0[1], t0[2], t0[3], t1[0], t1[1], t1[2], t1[3]};
#else
#pragma unroll
                    for (int j = 0; j < 8; ++j) vf[j] = *(const LAS short*)(Vs + (32 * blk + 16 * s2 + 8 * (j >> 2) + 4 * hi + (j & 3)) * VS + (32 * db + n) * 2);
#endif
                    if (db == 0) o0 = __builtin_amdgcn_mfma_f32_32x32x16_bf16(vf, pf[blk][s2], o0, 0, 0, 0); else o1 = __builtin_amdgcn_mfma_f32_32x32x16_bf16(vf, pf[blk][s2], o1, 0, 0, 0);
                }
    }
    const float lt = xor32_add(lsum), inv = 1.f / lt;
    bf16_t* op = O + (tokbase + qpos) * 512 + hq * 64 + 8 * hi;
#pragma unroll
    for (int db = 0; db < 2; ++db)
#pragma unroll
        for (int kp = 0; kp < 2; ++kp) { const int r0 = 8 * kp;
            unsigned ax, ay, bx, by;
            if (db == 0) { ax = cvt_pk_bf16(o0[r0] * inv, o0[r0 + 1] * inv); ay = cvt_pk_bf16(o0[r0 + 2] * inv, o0[r0 + 3] * inv); bx = cvt_pk_bf16(o0[r0 + 4] * inv, o0[r0 + 5] * inv); by = cvt_pk_bf16(o0[r0 + 6] * inv, o0[r0 + 7] * inv); }
            else { ax = cvt_pk_bf16(o1[r0] * inv, o1[r0 + 1] * inv); ay = cvt_pk_bf16(o1[r0 + 2] * inv, o1[r0 + 3] * inv); bx = cvt_pk_bf16(o1[r0 + 4] * inv, o1[r0 + 5] * inv); by = cvt_pk_bf16(o1[r0 + 6] * inv, o1[r0 + 7] * inv); }
            { auto r = __builtin_amdgcn_permlane32_swap(ax, bx, false, false); ax = r[0]; bx = r[1]; }
            { auto r = __builtin_amdgcn_permlane32_swap(ay, by, false, false); ay = r[0]; by = r[1]; }
            *(u32x4*)(op + 32 * db + 16 * kp) = (u32x4){ax, ay, bx, by}; }
#pragma unroll
    for (int s = 0; s < 4; ++s) P.qf[s] = qn[s];
    P.kreg = kreg; P.vreg = vreg; P.mreg = mreg;
}

constexpr int SGS = 1040;
static_assert(128 * SGS <= MISC_OFF, "spatial-gating tile vs LDS control words");
__device__ __forceinline__ void sg_unit(const Frame& F, const bf16_t* __restrict__ PROJ, const bf16_t* __restrict__ SGWl, const float* __restrict__ sgb, const float* __restrict__ lng, bf16_t* __restrict__ OC, int b, int ch) {
    const int lane = F.lane, wid = F.wave, n = lane & 31, hi = lane >> 5;
    const size_t tok0 = (size_t)b * SEQ + ch * 128;
    LAS unsigned char* V = F.lds;
    __syncthreads();
    float gl[8];
    { const f32x4 g0 = *(const f32x4*)(lng + 8 * lane), g1 = *(const f32x4*)(lng + 8 * lane + 4); gl[0] = g0[0]; gl[1] = g0[1]; gl[2] = g0[2]; gl[3] = g0[3]; gl[4] = g1[0]; gl[5] = g1[1]; gl[6] = g1[2]; gl[7] = g1[3]; }
    u32x4 wrow16[16];
#pragma unroll
    for (int rr = 0; rr < 16; ++rr) wrow16[rr] = *(const u32x4*)(PROJ + (tok0 + 16 * wid + rr) * PLD + C_V + 8 * lane);
#pragma unroll
    for (int rr = 0; rr < 16; ++rr) { const int row = 16 * wid + rr;
        const u32x4 w = wrow16[rr];
        float x[8] = {bf_lo(w.x), bf_hi(w.x), bf_lo(w.y), bf_hi(w.y), bf_lo(w.z), bf_hi(w.z), bf_lo(w.w), bf_hi(w.w)};
        float s = 0.f;
#pragma unroll
        for (int i = 0; i < 8; ++i) s += x[i];
        const float mean = wave_sum(s) * (1.f / 512.f); float q = 0.f;
#pragma unroll
        for (int i = 0; i < 8; ++i) { x[i] -= mean; q += x[i] * x[i]; }
        const float rstd = 1.f / sqrtf(wave_sum(q) * (1.f / 512.f) + LN_EPS);
        u32x4 o; o.x = cvt_pk_bf16(x[0] * rstd * gl[0], x[1] * rstd * gl[1]); o.y = cvt_pk_bf16(x[2] * rstd * gl[2], x[3] * rstd * gl[3]);
        o.z = cvt_pk_bf16(x[4] * rstd * gl[4], x[5] * rstd * gl[5]); o.w = cvt_pk_bf16(x[6] * rstd * gl[6], x[7] * rstd * gl[7]);
        *(LAS u32x4*)(V + row * SGS + 16 * lane) = o; }
    __syncthreads();
    const int g = wid;
    const int vbase = (8 * hi + ((lane & 15) >> 2)) * SGS + (g * 64 + 16 * ((lane >> 4) & 1) + 4 * (lane & 3)) * 2;
    const bf16_t* wg = SGWl + (size_t)g * 128 * 128;
#pragma unroll 1
    for (int tb = 0; tb < 4; ++tb) {
        f32x16 a0, a1;
#pragma unroll
        for (int r = 0; r < 16; ++r) { a0[r] = 0.f; a1[r] = 0.f; }
        const bf16_t* wrow = wg + (size_t)(32 * tb + n) * 128 + 8 * hi;
        bf16x8 afr[8];
#pragma unroll
        for (int ks = 0; ks < 8; ++ks) if (ks < 2 * tb + 2) afr[ks] = *(const bf16x8*)(wrow + 16 * ks);
        const int t = 32 * tb + n;
        const float bb = sgb[g * 128 + t];
        u32x2 uu[2][4];
        { const bf16_t* up = PROJ + (tok0 + t) * PLD + C_U + g * 64 + 4 * hi;
#pragma unroll
          for (int db = 0; db < 2; ++db)
#pragma unroll
              for (int q4 = 0; q4 < 4; ++q4) uu[db][q4] = *(const u32x2*)(up + 32 * db + 8 * q4); }
#pragma unroll
        for (int ks = 0; ks < 8; ++ks) if (ks < 2 * tb + 2) {
            const bf16x8 af = afr[ks];
#pragma unroll
            for (int db = 0; db < 2; ++db) { bf16x8 vf;
#if USE_TR
                const v4i16_t t0 = __builtin_amdgcn_ds_read_tr16_b64_v4i16((LAS v4i16_t*)(V + vbase + (16 * ks) * SGS + 64 * db));
                const v4i16_t t1 = __builtin_amdgcn_ds_read_tr16_b64_v4i16((LAS v4i16_t*)(V + vbase + (16 * ks + 4) * SGS + 64 * db));
                vf = (bf16x8){t0[0], t0[1], t0[2], t0[3], t1[0], t1[1], t1[2], t1[3]};
#else
#pragma unroll
                for (int j = 0; j < 8; ++j) vf[j] = *(const LAS short*)(V + (16 * ks + 8 * hi + j) * SGS + (g * 64 + 32 * db + n) * 2);
#endif
                if (db == 0) a0 = __builtin_amdgcn_mfma_f32_32x32x16_bf16(vf, af, a0, 0, 0, 0); else a1 = __builtin_amdgcn_mfma_f32_32x32x16_bf16(vf, af, a1, 0, 0, 0); }
        }
        bf16_t* op = OC + (tok0 + t) * 512 + g * 64 + 8 * hi;
#pragma unroll
        for (int db = 0; db < 2; ++db)
#pragma unroll
            for (int kp = 0; kp < 2; ++kp) { const int r0 = 8 * kp; float v[8];
#pragma unroll
                for (int i = 0; i < 8; ++i) { const u32x2 uw = uu[db][2 * kp + (i >> 2)]; const unsigned wd = (i & 2) ? uw.y : uw.x; const float uf = (i & 1) ? bf_hi(wd) : bf_lo(wd);
                    v[i] = ((db == 0 ? a0[r0 + i] : a1[r0 + i]) + bb) * uf; }
                unsigned ax = cvt_pk_bf16(v[0], v[1]), ay = cvt_pk_bf16(v[2], v[3]), bx = cvt_pk_bf16(v[4], v[5]), by = cvt_pk_bf16(v[6], v[7]);
                { auto r = __builtin_amdgcn_permlane32_swap(ax, bx, false, false); ax = r[0]; bx = r[1]; }
                { auto r = __builtin_amdgcn_permlane32_swap(ay, by, false, false); ay = r[0]; by = r[1]; }
                *(u32x4*)(op + 32 * db + 16 * kp) = (u32x4){ax, ay, bx, by}; }
    }
}
constexpr int HS_STRIDE = 2064;
constexpr int P7_PART = 32 * HS_STRIDE;
constexpr int P7_LOG = P7_PART + 8 * 4096;
constexpr int P7_HIST = P7_LOG + 32 * 33 * 4;
__device__ __forceinline__ void p7_route(const Frame& F, const Args& a, int l, bf16_t* X16  , const bf16_t* Y, const float* SSP, const float* MODl, signed char* H8, float* RS,
                                         const bf16_t* WRTl, unsigned* cnt, int* ROWTOK, unsigned* TOKINFO) {
    const int tid = F.tid, lane = F.lane, wid = F.wave, n = lane & 31, hi = lane >> 5;
    const float* g_post = a.in[5] + l * DM; const float* g_pre = a.in[6] + l * DM; const float* b_router = a.in[16] + l * NE;
    LAS unsigned char* hs = F.lds; LAS float* part = (LAS float*)(F.lds + P7_PART); LAS float* lg = (LAS float*)(F.lds + P7_LOG); LAS int* hist = (LAS int*)(F.lds + P7_HIST); LAS int* base = hist + 32;
    if (tid < 32) hist[tid] = 0;
    __syncthreads();
    const int NBT = MTOK / 32, bt0 = (int)((long)NBT * F.vcu / F.G), bt1 = (int)((long)NBT * (F.vcu + 1) / F.G);
    bf16x8 wbf[8];
#pragma unroll
    for (int ks = 0; ks < 8; ++ks) wbf[ks] = *(const bf16x8*)(WRTl + (size_t)n * DM + (8 * wid + ks) * 16 + 8 * hi);
    const float brv = b_router[tid & 31];
    f32x4 A1[4], A2[4], A3[4]; int bcur = (bt0 < NBT ? bt0 : NBT - 1) >> 6;
#define P7_PARAMS(b_) do { const float* mb_ = MODl + (size_t)(b_) * 6 * DM; _Pragma("unroll") for (int j = 0; j < 4; ++j) { const int c = 4 * lane + 256 * j; \
        const f32x4 gp = *(const f32x4*)(g_post + c), ga = *(const f32x4*)(mb_ + 2 * DM + c), gg = *(const f32x4*)(g_pre + c), s1 = *(const f32x4*)(mb_ + 4 * DM + c), s0 = *(const f32x4*)(mb_ + 3 * DM + c); \
        A1[j] = ga * gp; A2[j] = gg * (s1 + 1.f); A3[j] = s0; } } while (0)
    P7_PARAMS(bcur);
    for (int bt = bt0; bt < bt1; ++bt) {
        const int row0 = bt * 32, b = row0 >> 11;
        if (b != bcur) { bcur = b; P7_PARAMS(b); }
        u32x2 yv[4][4], xv[4][4]; f32x4 s4v[4];
#pragma unroll
        for (int rr = 0; rr < 4; ++rr) { const size_t row = (size_t)row0 + 4 * wid + rr; s4v[rr] = *(const f32x4*)(SSP + row * 16 + 4 * (lane & 3));
#pragma unroll
            for (int j = 0; j < 4; ++j) { const int c = 4 * lane + 256 * j; yv[rr][j] = __builtin_nontemporal_load((const u32x2*)(Y + row * DM + c)); xv[rr][j] = __builtin_nontemporal_load((const u32x2*)(X16 + row * DM + c)); } }
#pragma unroll
        for (int rr = 0; rr < 4; ++rr) { const int rl = 4 * wid + rr; const size_t row = (size_t)row0 + rl;
            const f32x4 s4 = s4v[rr];
            float ssy = (s4[0] + s4[1]) + (s4[2] + s4[3]); ssy = quad_sum(ssy);
            const float rstd1 = 1.f / sqrtf(ssy * (1.f / DM) + RMS_EPS);
            f32x4 v[4]; float ss = 0.f;
#pragma unroll
            for (int j = 0; j < 4; ++j) { const int c = 4 * lane + 256 * j; const u32x2 yw_ = yv[rr][j]; const u32x2 xw_ = xv[rr][j]; const f32x4 yy = {bf_lo(yw_.x), bf_hi(yw_.x), bf_lo(yw_.y), bf_hi(yw_.y)}, xx = {bf_lo(xw_.x), bf_hi(xw_.x), bf_lo(xw_.y), bf_hi(xw_.y)};
                v[j] = xx + A1[j] * (yy * rstd1); { u32x2 xo; xo.x = cvt_pk_bf16(v[j][0], v[j][1]); xo.y = cvt_pk_bf16(v[j][2], v[j][3]); *(u32x2*)(X16 + row * DM + c) = xo; }
                ss += (v[j][0] * v[j][0] + v[j][1] * v[j][1]) + (v[j][2] * v[j][2] + v[j][3] * v[j][3]); }
            ss = wave_sum(ss);
            const float rstd = 1.f / sqrtf(ss * (1.f / DM) + RMS_EPS);
            f32x4 o[4]; float am = 0.f;
#pragma unroll
            for (int j = 0; j < 4; ++j) { const int c = 4 * lane + 256 * j;
                o[j] = (v[j] * rstd) * A2[j] + A3[j]; u32x2 w; w.x = cvt_pk_bf16(o[j][0], o[j][1]); w.y = cvt_pk_bf16(o[j][2], o[j][3]);
                *(LAS u32x2*)(hs + rl * HS_STRIDE + c * 2) = w;
                am = fmaxf(am, fmaxf(fmaxf(fabsf(o[j][0]), fabsf(o[j][1])), fmaxf(fabsf(o[j][2]), fabsf(o[j][3])))); }
            am = wave_max(am);
            const float scale = fmaxf(am, 1e-30f) * (1.f / 127.f), inv = 1.f / scale;
            if (lane == 0) RS[row] = scale;
#pragma unroll
            for (int j = 0; j < 4; ++j) *(unsigned*)(H8 + row * DM + 4 * lane + 256 * j) = q8x4(o[j][0], o[j][1], o[j][2], o[j][3], inv); }
        __syncthreads();
        {
            f32x16 d;
#pragma unroll
            for (int r = 0; r < 16; ++r) d[r] = 0.f;
#pragma unroll
            for (int ks = 0; ks < 8; ++ks) { const int k0 = (8 * wid + ks) * 16 + 8 * hi;
                const bf16x8 af = *(const LAS bf16x8*)(hs + n * HS_STRIDE + k0 * 2);
                d = __builtin_amdgcn_mfma_f32_32x32x16_bf16(af, wbf[ks], d, 0, 0, 0); }
#pragma unroll
            for (int r = 0; r < 16; ++r) part[wid * 1024 + (8 * (r >> 2) + 4 * hi + (r & 3)) * 32 + n] = d[r];
        }
        __syncthreads();
        for (int i = tid; i < 1024; i += 512) { float s = brv;
#pragma unroll
            for (int w = 0; w < 8; ++w) s += part[w * 1024 + i]; lg[(i >> 5) * 33 + (i & 31)] = s; }
        __syncthreads();
        int e_k[4] = {0, 0, 0, 0}, lp_k[4] = {0, 0, 0, 0}; float w_k[4] = {0.f, 0.f, 0.f, 0.f};
        if (tid < 32) { LAS float* mylg = lg + tid * 33; float tl[4];
#pragma unroll
            for (int k = 0; k < 4; ++k) { float best = -INFINITY; int bi = 0;
                for (int e = 0; e < 32; ++e) { const float vv = mylg[e]; if (vv > best) { best = vv; bi = e; } }
                tl[k] = best; e_k[k] = bi; mylg[bi] = -INFINITY; }
            float sum = 0.f;
#pragma unroll
            for (int k = 0; k < 4; ++k) { w_k[k] = __expf(tl[k] - tl[0]); sum += w_k[k]; }
            const float inv = 1.f / sum;
#pragma unroll
            for (int k = 0; k < 4; ++k) { w_k[k] *= inv; lp_k[k] = __hip_atomic_fetch_add(&hist[e_k[k]], 1, __ATOMIC_RELAXED, __HIP_MEMORY_SCOPE_WORKGROUP); } }
        __syncthreads();
        if (tid < 32) { const int hc = hist[tid]; base[tid] = hc > 0 ? (int)__hip_atomic_fetch_add(cnt + 64 * tid, (unsigned)hc, __ATOMIC_RELAXED, __HIP_MEMORY_SCOPE_AGENT) : 0; hist[tid] = 0; }
        __syncthreads();
        if (tid < 32) { const int token = row0 + tid; u32x4 info; f32x4 ww;
#pragma unroll
            for (int k = 0; k < 4; ++k) { const int pos = base[e_k[k]] + lp_k[k]; ROWTOK[e_k[k] * 65536 + pos] = token; info[k] = ((unsigned)e_k[k] << 17) | (unsigned)pos; ww[k] = w_k[k]; }
            *(u32x4*)(TOKINFO + (size_t)token * 8) = info; *(f32x4*)(TOKINFO + (size_t)token * 8 + 4) = ww; }
        __syncthreads();
    }
#undef P7_PARAMS
}

__device__ __forceinline__ int moe_tables(const Frame& F, unsigned* cnt) {
    LAS int* ts = (LAS int*)(F.lds + TS_OFF); LAS int* te = (LAS int*)(F.lds + TILE_E_OFF);
    __syncthreads();
    if (F.tid == 0) { int acc = 0; for (int e = 0; e < NE; ++e) { ts[e] = acc; const unsigned c = __hip_atomic_load(cnt + 64 * e, __ATOMIC_RELAXED, __HIP_MEMORY_SCOPE_AGENT); acc += (int)((c + 255u) >> 8); } ts[NE] = acc; }
    __syncthreads();
    const int RT = ts[NE];
    for (int rt = F.tid; rt < RT; rt += 512) { int e = 0;
#pragma unroll 1
        for (int q = 1; q < NE; ++q) e += (ts[q] <= rt) ? 1 : 0;
        te[rt] = e; }
    __syncthreads();
    return RT;
}

__device__ __forceinline__ void p10_combine(const Frame& F, const Args& a, int l, bf16_t* X16, float* out, const bf16_t* Y2, const unsigned* TOKINFO, const float* MODbase, signed char* H8, float* RS) {
    const int lane = F.lane; const LAS int* ts = (const LAS int*)(F.lds + TS_OFF);
    const float* g_postf = a.in[7] + l * DM;
    const int gw = F.vcu * 8 + F.wave, NGW = F.G * 8;
    for (int rowp = gw * 2; rowp < MTOK; rowp += NGW * 2) {
        u32x4 info[2]; f32x4 ww[2]; u32x2 yw[2][4][4], xv[2][4];
#pragma unroll
        for (int rr = 0; rr < 2; ++rr) { info[rr] = *(const u32x4*)(TOKINFO + (size_t)(rowp + rr) * 8); ww[rr] = *(const f32x4*)(TOKINFO + (size_t)(rowp + rr) * 8 + 4); }
#pragma unroll
        for (int rr = 0; rr < 2; ++rr) {
#pragma unroll
            for (int k = 0; k < 4; ++k) { const int e = (int)(info[rr][k] >> 17), pos = (int)(info[rr][k] & 0x1ffffu); const size_t slot = (size_t)ts[e] * 256 + pos;
#pragma unroll
                for (int j = 0; j < 4; ++j) yw[rr][k][j] = __builtin_nontemporal_load((const u32x2*)(Y2 + slot * DM + 4 * lane + 256 * j)); }
#pragma unroll
            for (int j = 0; j < 4; ++j) xv[rr][j] = *(const u32x2*)(X16 + (size_t)(rowp + rr) * DM + 4 * lane + 256 * j); }
#pragma unroll
        for (int rr = 0; rr < 2; ++rr) { const int row = rowp + rr, b = row >> 11;
        f32x4 y[4];
#pragma unroll
        for (int j = 0; j < 4; ++j) y[j] = (f32x4){0.f, 0.f, 0.f, 0.f};
#pragma unroll
        for (int k = 0; k < 4; ++k) { const float wk = ww[rr][k];
#pragma unroll
            for (int j = 0; j < 4; ++j) { const u32x2 w = yw[rr][k][j];
                y[j][0] += wk * bf_lo(w.x); y[j][1] += wk * bf_hi(w.x); y[j][2] += wk * bf_lo(w.y); y[j][3] += wk * bf_hi(w.y); } }
        float ss = 0.f;
#pragma unroll
        for (int j = 0; j < 4; ++j) ss += (y[j][0] * y[j][0] + y[j][1] * y[j][1]) + (y[j][2] * y[j][2] + y[j][3] * y[j][3]);
        ss = wave_sum(ss);
        const float rstd = 1.f / sqrtf(ss * (1.f / DM) + RMS_EPS);
        const float* mb = MODbase + ((size_t)l * BATCH + b) * 6 * DM;
        f32x4 v[4]; float s2 = 0.f;
#pragma unroll
        for (int j = 0; j < 4; ++j) { const int c = 4 * lane + 256 * j; const u32x2 xw_ = xv[rr][j]; const f32x4 xx = {bf_lo(xw_.x), bf_hi(xw_.x), bf_lo(xw_.y), bf_hi(xw_.y)}, gp = *(const f32x4*)(g_postf + c), ga = *(const f32x4*)(mb + 5 * DM + c);
            v[j] = xx + ga * (y[j] * rstd * gp);
#ifdef T_STAMP
            if (l + 1 == DEPTH) v[j] = v[j] * (1.f + (float)(*((const unsigned*)MODbase - (1u << 18) + 100)) * (1.f / 256.f));
#endif
            if (l + 1 < DEPTH) { u32x2 xo; xo.x = cvt_pk_bf16(v[j][0], v[j][1]); xo.y = cvt_pk_bf16(v[j][2], v[j][3]); *(u32x2*)(X16 + (size_t)row * DM + c) = xo; }
            else *(f32x4*)(out + (size_t)row * DM + c) = v[j];
            s2 += (v[j][0] * v[j][0] + v[j][1] * v[j][1]) + (v[j][2] * v[j][2] + v[j][3] * v[j][3]); }
        if (l + 1 < DEPTH) { s2 = wave_sum(s2); const float* mb1 = MODbase + ((size_t)(l + 1) * BATCH + b) * 6 * DM;
            norm_mod_row(v, s2, a.in[4] + (l + 1) * DM, mb1 + DM, mb1, H8 + (size_t)row * DM, RS + row, lane); }
        }
    }
}
#ifndef MK_ONE_LAUNCH
#define MK_ONE_LAUNCH 1
#endif
constexpr int N_PHASES = 2 + 9 * DEPTH;
__global__ void __launch_bounds__(512, 2) fwd(Args args) {
    extern __shared__ __attribute__((aligned(16))) unsigned char lds_raw[];
    Frame F0;
    F0.lds = (LAS unsigned char*)lds_raw;
    F0.tid = threadIdx.x; F0.lane = F0.tid & 63; F0.wave = __builtin_amdgcn_readfirstlane(F0.tid >> 6);
    F0.G = gridDim.x; { const int bx = blockIdx.x; F0.vcu = (F0.G % 8 == 0) ? (bx % 8) * (F0.G / 8) + bx / 8 : bx; }
    volatile LAS unsigned* MISC = (volatile LAS unsigned*)(F0.lds + MISC_OFF);
    for (int u = F0.tid; u < 128; u += 512) MISC[u] = 0u;
    __syncthreads();
    unsigned* ctl = (unsigned*)(args.ws + WS_CTL);
    const int lo = args.ph_lo, hi = args.ph_hi;
    XcdBarrier bar; bar.bar = ctl + CW_BAR; bar.x = 0; bar.st = nullptr; bar.w = F0.wave;
    if (hi - lo > 1) bar = xcd_barrier_post(ctl + CW_BAR, MISC + 8, F0.wave);
#ifndef PHASE_MASK
#define PHASE_MASK 0x7ff
#endif
#define PHON(j) ((PHASE_MASK >> (j)) & 1)
#ifndef REPEAT_MASK
#define REPEAT_MASK 0
#endif
#define REP(j) for (int rep_ = 0; rep_ <= ((REPEAT_MASK >> (j)) & 1); ++rep_)
#define IN(k) (lo <= (k) && (k) < hi)
#define BOTH(k) (IN(k) && IN((k) + 1))
#define GRID_BAR() xcd_barrier(bar)
#define PH_BEGIN() const Frame F = phase_frame(F0); unsigned char* ws = opq(args.ws); (void)ws
    if (PHON(0) && IN(0)) REP(0) { PH_BEGIN(); p0_mod(F, args.in[1], args.in[2], args.in[3], (float*)(ws + WS_MOD)); p0_weights(F, args); if (BOTH(0)) GRID_BAR(); }
    if (PHON(1) && IN(1)) REP(1) { PH_BEGIN(); p1_norm(F, args.in[0], args.in[4], (const float*)(ws + WS_MOD), (signed char*)(ws + WS_H), (float*)(ws + WS_RS), (bf16_t*)(ws + WS_X)); if (BOTH(1)) GRID_BAR(); }

#pragma unroll 1
#ifndef EXTRA_PHASE
#define EXTRA_PHASE (-1)
#endif
#ifdef SKIP_EPI_PROBE
#define SKIPV ex_
#else
#define SKIPV false
#endif
#ifndef STAG_MASK
#define STAG_MASK 0
#endif
#ifndef STAG_TICKS
#define STAG_TICKS 240
#endif
#define STAGGER(j) do { if ((STAG_MASK >> (j)) & 1) { const unsigned long long t0_ = __builtin_amdgcn_s_memrealtime(), dl_ = (unsigned long long)(F.vcu / (F.G / 8)) * STAG_TICKS; while (__builtin_amdgcn_s_memrealtime() - t0_ < dl_) __builtin_amdgcn_s_sleep(8); } } while (0)
#ifndef EXTRA_MASK
#define EXTRA_MASK (EXTRA_PHASE >= 0 ? (1 << EXTRA_PHASE) : 0)
#endif
#define EXOK(j) (EXTRA_MASK == 0 || !ex_ || ((EXTRA_MASK >> (j)) & 1))
    for (int it_ = 0; it_ < DEPTH + (EXTRA_MASK != 0 ? 1 : 0); ++it_) {
        const int l = it_ < DEPTH ? it_ : DEPTH - 1; const bool ex_ = it_ >= DEPTH; (void)ex_;
        const int pb = 2 + 9 * l;
        if (PHON(2) && EXOK(2) && IN(pb + 0)) REP(2) { PH_BEGIN();
            pg8::Gemm g{(const bf16_t*)(ws + WS_H), (const bf16_t*)(ws + WS_W + (size_t)l * W_LAYER + WO_WIN), DM}; g.skip_epi = SKIPV; pg8::StaticOrder<MTOK / 256, NPROJ / 256> S; S.init(F.G, (int)blockIdx.x);
            EpiProj E{(bf16_t*)(ws + WS_PROJ), (unsigned char*)(ws + WS_GATES), (const float*)(ws + WS_RS), (const float*)(ws + WS_CSIN) + (size_t)l * NPROJ};
            STAGGER(2); pg8::gemm_phase<EpiProj, pg8::StaticOrder<MTOK / 256, NPROJ / 256>, false, true>(F.lds, g, S, E, F.wave);
            if (BOTH(pb + 0)) GRID_BAR();
        }
        if (PHON(3) && EXOK(3) && IN(pb + 1)) REP(3) {
#ifndef SUBREP
#define SUBREP 0
#endif
#ifndef IDX_PROBE
#define IDX_PROBE 0
#endif
            if (!((IDX_PROBE & 8) && ex_))
            { const Frame Fa = phase_frame(F0); const bf16_t* PROJa = (const bf16_t*)(opq(args.ws) + WS_PROJ); bf16_t* OAa = (bf16_t*)(opq(args.ws) + WS_O);
            AttnPre Pa; Pa.mreg = (u32x2){0u, 0u}; { int b_, g_, qb_; attn_decode(Fa.vcu < 2048 ? Fa.vcu : 2047, b_, g_, qb_); attn_prefetch<0>(Fa, PROJa, nullptr, b_, g_, qb_, Pa.qf, Pa.kreg, Pa.vreg, Pa.mreg); }
            for (int u = Fa.vcu; u < 2048; u += Fa.G) { int b_, g_, qb_; attn_decode(u, b_, g_, qb_);
                attn_unit<0>(Fa, PROJa, OAa, nullptr, args.in[9] + l * 8, b_, g_, qb_, Pa, u + Fa.G); } }
            if (!((IDX_PROBE & 16) && ex_))
            { const Frame Fb = phase_frame(F0); unsigned char* wsb = opq(args.ws);
            for (int u = Fb.vcu; u < 512; u += Fb.G)
                sg_unit(Fb, (const bf16_t*)(wsb + WS_PROJ), (const bf16_t*)(wsb + WS_SGW) + (size_t)l * 8 * 128 * 128, args.in[11] + l * 8 * 128, args.in[12] + l * 512, (bf16_t*)(wsb + WS_O) + (size_t)2 * MTOK * 512, u >> 4, u & 15); }
            __syncthreads();
            if (!((IDX_PROBE & 4) && ex_))
            { const Frame Fi = phase_frame(F0); unsigned char* wsi = opq(args.ws);
              dsa_index_phase(Fi, (const bf16_t*)(wsi + WS_PROJ), (unsigned long long*)(wsi + WS_BITS), l == 0 ? (unsigned*)(wsi + WS_CTL) + 100 : nullptr, ex_); }
            if (BOTH(pb + 1)) GRID_BAR();
        }
        if (PHON(4) && EXOK(4) && IN(pb + 2)) REP(4) { PH_BEGIN();
            AttnPre Pd; { int b_, g_, qb_; attn_decode(F.vcu < 2048 ? F.vcu : 2047, b_, g_, qb_); attn_prefetch<1>(F, (const bf16_t*)(ws + WS_PROJ), (const unsigned*)(ws + WS_BITS), b_, g_, qb_, Pd.qf, Pd.kreg, Pd.vreg, Pd.mreg); }
            for (int u = F.vcu; u < 2048; u += F.G) { int b_, g_, qb_; attn_decode(u, b_, g_, qb_);
                attn_unit<1>(F, (const bf16_t*)(ws + WS_PROJ), (bf16_t*)(ws + WS_O) + (size_t)MTOK * 512, (const unsigned*)(ws + WS_BITS), nullptr, b_, g_, qb_, Pd, u + F.G); }
            __syncthreads();
            if (BOTH(pb + 2)) GRID_BAR();
        }
        if (PHON(5) && EXOK(5) && IN(pb + 3)) REP(5) { PH_BEGIN();
            pg8::Gemm g{(const bf16_t*)(ws + WS_O), (const bf16_t*)(ws + WS_W + (size_t)l * W_LAYER + WO_WBR), 512}; g.skip_epi = SKIPV; BranchOrder S; S.so.init(F.G, (int)blockIdx.x);
            EpiBranch E{(const unsigned char*)(ws + WS_GATES), (bf16_t*)(ws + WS_H)};
            STAGGER(5); pg8::gemm_phase<EpiBranch, BranchOrder, false>(F.lds, g, S, E, F.wave);
            if (BOTH(pb + 3)) GRID_BAR();
        }
        if (PHON(6) && EXOK(6) && IN(pb + 4)) REP(6) { PH_BEGIN();
            pg8::Gemm g{(const bf16_t*)(ws + WS_H), (const bf16_t*)(ws + WS_W + (size_t)l * W_LAYER + WO_WOUT), DM}; g.skip_epi = SKIPV; pg8::StaticOrder<MTOK / 256, DM / 256> S; S.init(F.G, (int)blockIdx.x);
            EpiWout E{(bf16_t*)(ws + WS_Y), (float*)(ws + WS_SSP)}; E.pv = ex_;
            STAGGER(6); pg8::gemm_phase<EpiWout, pg8::StaticOrder<MTOK / 256, DM / 256>, false>(F.lds, g, S, E, F.wave);
            if (BOTH(pb + 4)) GRID_BAR();
        }
        if (PHON(7) && EXOK(7) && IN(pb + 5)) REP(7) { PH_BEGIN();
            p7_route(F, args, l, (bf16_t*)(ws + WS_X), (const bf16_t*)(ws + WS_Y), (const float*)(ws + WS_SSP), (const float*)(ws + WS_MOD) + (size_t)l * BATCH * 6 * DM, (signed char*)(ws + WS_H), (float*)(ws + WS_RS),
                     (const bf16_t*)(ws + WS_WRT) + (size_t)l * NE * DM, (unsigned*)(ws + WS_CTL) + CW_CNT + l * 32 * 64, (int*)(ws + WS_ROWTOK), (unsigned*)(ws + WS_TOKINFO));
            if (BOTH(pb + 5)) GRID_BAR();
        }
        if (PHON(8) && EXOK(8) && IN(pb + 6)) REP(8) { PH_BEGIN();
            unsigned* cnt = (unsigned*)(ws + WS_CTL) + CW_CNT + l * 32 * 64; const int* ROWTOK = (const int*)(ws + WS_ROWTOK);
            const int RT = moe_tables(F, cnt);
            LAS int* ts = (LAS int*)(F.lds + TS_OFF); LAS int* te = (LAS int*)(F.lds + TILE_E_OFF); LAS int* ri = (LAS int*)(F.lds + ROWIDX_OFF);
            const long U = (long)RT * 8; MoeOrder S; S.u0 = (int)(U * F.vcu / F.G); S.u1 = (int)(U * (F.vcu + 1) / F.G); S.NB = 8; S.rt_lo = S.u0 / 8; S.tile_e = te; S.rowidx = ri;
            if (S.u1 > S.u0) { const int rt_hi = (S.u1 - 1) / 8; int ntile = rt_hi - S.rt_lo + 1; if (ntile > 8) ntile = 8;
                for (int i = F.tid; i < ntile * 256; i += 512) { const int rt = S.rt_lo + (i >> 8), r = i & 255, e = te[rt], first = (rt - ts[e]) * 256 + r;
                    const int c = (int)__hip_atomic_load(cnt + 64 * e, __ATOMIC_RELAXED, __HIP_MEMORY_SCOPE_AGENT); ri[i] = first < c ? ROWTOK[e * 65536 + first] : 0; } }
            __syncthreads();
            pg8::Gemm g{(const bf16_t*)(ws + WS_H), (const bf16_t*)(ws + WS_W + (size_t)l * W_LAYER + WO_W1), DM}; g.skip_epi = SKIPV;
            EpiW1I8 E{(signed char*)(ws + WS_ACT), args.in[18] + (size_t)l * NE * 2 * FF, (const float*)(ws + WS_RS), (const float*)(ws + WS_CS1) + (size_t)l * NE * 2048, ri, S.rt_lo};
            STAGGER(8); pg8::gemm_phase<EpiW1I8, MoeOrder, true, true>(F.lds, g, S, E, F.wave);
            if (BOTH(pb + 6)) GRID_BAR();
        }
        if (PHON(9) && EXOK(9) && IN(pb + 7)) REP(9) { PH_BEGIN();
            const int RT = moe_tables(F, (unsigned*)(ws + WS_CTL) + CW_CNT + l * 32 * 64);
            const long U = (long)RT * 4; MoeOrder S; S.u0 = (int)(U * F.vcu / F.G); S.u1 = (int)(U * (F.vcu + 1) / F.G); S.NB = 4; S.rt_lo = 0; S.tile_e = (LAS int*)(F.lds + TILE_E_OFF); S.rowidx = nullptr;
            pg8::Gemm g{(const bf16_t*)(ws + WS_ACT), (const bf16_t*)(ws + WS_W + (size_t)l * W_LAYER + WO_W2), FF}; g.skip_epi = SKIPV;
            EpiW2 E{(bf16_t*)(ws + WS_Y2), args.in[20] + (size_t)l * NE * DM, (const float*)(ws + WS_CS2) + (size_t)l * NE * DM};
            STAGGER(9); pg8::gemm_phase<EpiW2, MoeOrder, false, true>(F.lds, g, S, E, F.wave);
            if (BOTH(pb + 7)) GRID_BAR();
        }
        if (PHON(10) && EXOK(10) && IN(pb + 8)) REP(10) { PH_BEGIN();
            (void)moe_tables(F, (unsigned*)(ws + WS_CTL) + CW_CNT + l * 32 * 64);
            p10_combine(F, args, l, (bf16_t*)(ws + WS_X), args.out, (const bf16_t*)(ws + WS_Y2), (const unsigned*)(ws + WS_TOKINFO), (const float*)(ws + WS_MOD), (signed char*)(ws + WS_H), (float*)(ws + WS_RS));
            if (BOTH(pb + 8)) GRID_BAR();
        }
    }
#undef PH_BEGIN
#undef IN
#undef BOTH
#undef GRID_BAR
}

extern "C" void kernel_launch(void* const* d_in, const int* in_sizes, int n_in, void* d_out, int out_size, void* d_ws, size_t ws_size, hipStream_t stream) {
    static int grid = 0;
    if (grid == 0) {
        if (n_in != 21 || out_size != MTOK * DM || ws_size < WS_END) { fprintf(stderr, "kernel_launch: unexpected shapes (n_in %d, out %d, ws %zu); nothing launched\n", n_in, out_size, ws_size); grid = -1; return; }
        int dev = 0, cus = 0, per_cu = 0;
        if (hipGetDevice(&dev) != hipSuccess || hipDeviceGetAttribute(&cus, hipDeviceAttributeMultiprocessorCount, dev) != hipSuccess) { grid = -1; return; }
        if (hipFuncSetAttribute((const void*)fwd, hipFuncAttributeMaxDynamicSharedMemorySize, LDS_BYTES) != hipSuccess) { fprintf(stderr, "kernel_launch: hipFuncSetAttribute failed\n"); grid = -1; return; }
        if (hipOccupancyMaxActiveBlocksPerMultiprocessor(&per_cu, (const void*)fwd, 512, LDS_BYTES) != hipSuccess || per_cu < 1) { fprintf(stderr, "kernel_launch: occupancy query says %d\n", per_cu); }
        (void)hipGetLastError();
        grid = cus > 256 ? 256 : cus;
    }
    if (grid < 0) return;
    (void)hipMemsetAsync((char*)d_ws + WS_CTL, 0, CTL_ZERO_BYTES, stream);
    Args a{};
    for (int i = 0; i < 21; ++i) a.in[i] = (const float*)d_in[i];
    a.out = (float*)d_out; a.ws = (unsigned char*)d_ws;
#if MK_ONE_LAUNCH
    a.ph_lo = 0; a.ph_hi = N_PHASES;
    hipLaunchKernelGGL(fwd, dim3(grid), dim3(512), LDS_BYTES, stream, a);
#else
    for (int p = 0; p < N_PHASES; ++p) { a.ph_lo = p; a.ph_hi = p + 1; hipLaunchKernelGGL(fwd, dim3(grid), dim3(512), LDS_BYTES, stream, a); }
#endif
}
```

```cpp
#include <hip/hip_runtime.h>
#include <cstdio>
#include <cstdint>
#include <type_traits>

#define LAS __attribute__((address_space(3)))
#define GAS __attribute__((address_space(1)))
typedef unsigned short bf16_t;
typedef short bf16x8 __attribute__((ext_vector_type(8)));
typedef float f32x2 __attribute__((ext_vector_type(2)));
typedef float f32x4 __attribute__((ext_vector_type(4)));
typedef float f32x16 __attribute__((ext_vector_type(16)));
typedef unsigned u32x2 __attribute__((ext_vector_type(2)));
typedef unsigned u32x4 __attribute__((ext_vector_type(4)));
typedef short v4i16_t __attribute__((ext_vector_type(4)));
typedef int i32x4 __attribute__((ext_vector_type(4)));

constexpr int BATCH = 32, SEQ = 2048, DM = 1024, MTOK = BATCH * SEQ, DEPTH = 2;
constexpr int NPROJ = 6144;
constexpr int PLD = 3072;
constexpr int C_QA = 0, C_KA = 512, C_VA = 640, C_QB = 768, C_KB = 1280, C_VB = 1408, C_QI = 1536, C_KI = 1792, C_WI = 1824, C_U = 2048, C_V = 2560, C_G = 3072;
constexpr int NE = 32, FF = 1024;
constexpr float RMS_EPS = 1e-5f, LN_EPS = 1e-5f;
constexpr float LOG2E = 1.4426950408889634f;
constexpr float QSCALE = 0.125f * LOG2E;

__device__ __forceinline__ unsigned f2bf(float f) { unsigned u = __builtin_bit_cast(unsigned, f); return (u + 0x7fffu + ((u >> 16) & 1u)) >> 16; }
__device__ __forceinline__ unsigned cvt_pk_bf16(float lo, float hi) { unsigned r; asm volatile("v_cvt_pk_bf16_f32 %0, %1, %2" : "=v"(r) : "v"(lo), "v"(hi)); return r; }
__device__ __forceinline__ float bf_lo(unsigned w) { return __builtin_bit_cast(float, w << 16); }
__device__ __forceinline__ float bf_hi(unsigned w) { return __builtin_bit_cast(float, w & 0xffff0000u); }
__device__ __forceinline__ float fexp2(float x) { return __builtin_amdgcn_exp2f(x); }
__device__ __forceinline__ float frcp(float x) { return __builtin_amdgcn_rcpf(x); }
__device__ __forceinline__ float sigmoidf_(float x) { return frcp(1.f + fexp2(-LOG2E * x)); }
__device__ __forceinline__ float gelu_tanh(float x) { const float t = x + 0.044715f * x * x * x; return x * frcp(1.f + fexp2(-2.302208198f * t)); }
template <int CTRL> __device__ __forceinline__ float dpp_f(float v) { return __builtin_bit_cast(float, __builtin_amdgcn_update_dpp(0, __builtin_bit_cast(int, v), CTRL, 0xF, 0xF, false)); }
__device__ __forceinline__ void swap32_asm(unsigned& a, unsigned& b) { asm volatile("s_nop 1\n\tv_permlane32_swap_b32 %0, %1" : "+v"(a), "+v"(b)); }
__device__ __forceinline__ float xor16_add(float v) { return v + __builtin_bit_cast(float, __builtin_amdgcn_ds_swizzle(__builtin_bit_cast(int, v), 0x401F)); }
__device__ __forceinline__ float xor16_max(float v) { return fmaxf(v, __builtin_bit_cast(float, __builtin_amdgcn_ds_swizzle(__builtin_bit_cast(int, v), 0x401F))); }
__device__ __forceinline__ float xor32_add(float v) { unsigned a = __builtin_bit_cast(unsigned, v), b = a; swap32_asm(a, b); return __builtin_bit_cast(float, a) + __builtin_bit_cast(float, b); }
__device__ __forceinline__ float xor32_max(float v) { unsigned a = __builtin_bit_cast(unsigned, v), b = a; swap32_asm(a, b); return fmaxf(__builtin_bit_cast(float, a), __builtin_bit_cast(float, b)); }
__device__ __forceinline__ float quad_sum(float v) { v += dpp_f<0xB1>(v); v += dpp_f<0x4E>(v); return v; }
__device__ __forceinline__ float wave_sum(float v) {
    v += dpp_f<0xB1>(v); v += dpp_f<0x4E>(v); v += dpp_f<0x141>(v); v += dpp_f<0x140>(v);
    return xor32_add(xor16_add(v));
}
__device__ __forceinline__ float wave_max(float v) {
    v = fmaxf(v, dpp_f<0xB1>(v)); v = fmaxf(v, dpp_f<0x4E>(v)); v = fmaxf(v, dpp_f<0x141>(v)); v = fmaxf(v, dpp_f<0x140>(v));
    return xor32_max(xor16_max(v));
}
__device__ __forceinline__ unsigned wave_sum_u32(unsigned v) {
    v += (unsigned)__builtin_amdgcn_update_dpp(0, (int)v, 0xB1, 0xF, 0xF, false);
    v += (unsigned)__builtin_amdgcn_update_dpp(0, (int)v, 0x4E, 0xF, 0xF, false);
    v += (unsigned)__builtin_amdgcn_update_dpp(0, (int)v, 0x141, 0xF, 0xF, false);
    v += (unsigned)__builtin_amdgcn_update_dpp(0, (int)v, 0x140, 0xF, 0xF, false);
    return __builtin_amdgcn_readlane(v, 0) + __builtin_amdgcn_readlane(v, 16) + __builtin_amdgcn_readlane(v, 32) + __builtin_amdgcn_readlane(v, 48);
}
__device__ __forceinline__ unsigned wave_max_u32(unsigned v) {
    unsigned t;
    t = (unsigned)__builtin_amdgcn_update_dpp(0, (int)v, 0xB1, 0xF, 0xF, false); v = v > t ? v : t;
    t = (unsigned)__builtin_amdgcn_update_dpp(0, (int)v, 0x4E, 0xF, 0xF, false); v = v > t ? v : t;
    t = (unsigned)__builtin_amdgcn_update_dpp(0, (int)v, 0x141, 0xF, 0xF, false); v = v > t ? v : t;
    t = (unsigned)__builtin_amdgcn_update_dpp(0, (int)v, 0x140, 0xF, 0xF, false); v = v > t ? v : t;
    unsigned a = __builtin_amdgcn_readlane(v, 0), b = __builtin_amdgcn_readlane(v, 16), c = __builtin_amdgcn_readlane(v, 32), d = __builtin_amdgcn_readlane(v, 48);
    a = a > b ? a : b; c = c > d ? c : d; return a > c ? a : c;
}
__device__ __forceinline__ void lds_barrier() { asm volatile("s_waitcnt lgkmcnt(0)\n\ts_barrier" ::: "memory"); }
__device__ __forceinline__ unsigned q8x4(float a, float b, float c, float d, float inv) {
    unsigned r = 0u;
    r = __builtin_amdgcn_cvt_pk_u8_f32(__builtin_rintf(fmaf(a, inv, 128.f)), 0u, r);
    r = __builtin_amdgcn_cvt_pk_u8_f32(__builtin_rintf(fmaf(b, inv, 128.f)), 1u, r);
    r = __builtin_amdgcn_cvt_pk_u8_f32(__builtin_rintf(fmaf(c, inv, 128.f)), 2u, r);
    r = __builtin_amdgcn_cvt_pk_u8_f32(__builtin_rintf(fmaf(d, inv, 128.f)), 3u, r);
    return r ^ 0x80808080u;
}
__device__ __forceinline__ unsigned u8x4_floor(float a, float b, float c, float d) {
    unsigned r = 0u;
    r = __builtin_amdgcn_cvt_pk_u8_f32(__builtin_floorf(a), 0u, r); r = __builtin_amdgcn_cvt_pk_u8_f32(__builtin_floorf(b), 1u, r);
    r = __builtin_amdgcn_cvt_pk_u8_f32(__builtin_floorf(c), 2u, r); r = __builtin_amdgcn_cvt_pk_u8_f32(__builtin_floorf(d), 3u, r);
    return r;
}
__device__ __forceinline__ int lane_id_volatile(int tag = 0) { int l; asm volatile("v_mbcnt_lo_u32_b32 %0, -1, 0 ; LANETAG %1\n\tv_mbcnt_hi_u32_b32 %0, -1, %0" : "=v"(l) : "s"(tag)); return l; }
#define LDS_WAIT() asm volatile("s_waitcnt lgkmcnt(0)" ::: "memory")
#define VM_WAIT() asm volatile("s_waitcnt vmcnt(0)" ::: "memory")

namespace pg8 {
constexpr int BM = 256, BK = 64, HALF = 128, HTB = HALF * BK * 2  , STAGE_BYTES = 8 * HTB, NXCD = 8, WGM = 8;
__host__ __device__ __forceinline__ int lds_byte(int r, int c) { const int st = (r >> 4) * 2 + (c >> 5), rr = r & 15, cc = c & 31, ob = rr * 64 + cc * 2; return st * 1024 + (ob ^ (((ob >> 9) & 1) << 5)); }
__host__ __device__ __forceinline__ void stage_rc(int b, int& R, int& C) { const int st = b / 1024, sb = b % 1024, swz = sb ^ (((sb >> 9) & 1) << 5); R = (st >> 1) * 16 + swz / 64; C = (st & 1) * 32 + (swz % 64) / 2; }
__host__ __device__ __forceinline__ int perm32(int rho) { const int n = rho >> 4, i = rho & 15; return 8 * (i >> 2) + 4 * n + (i & 3); }

struct Unit { int pm, pn; };
struct Gemm { const bf16_t* A; const bf16_t* Bt; int K; bool skip_epi = false; };

template <int NM, int NN> struct StaticOrder {
    int G, c;
    __device__ void init(int G_, int c_) { G = G_; c = c_; }
    __device__ __forceinline__ bool tile(int i, int& pm, int& pn) const {
        constexpr int nwg = NM * NN;
        const long L = (long)i * G + c; if (L >= nwg) return false;
        int wgid = (int)L; { constexpr int q = nwg / NXCD, r = nwg % NXCD; const int xcd = wgid % NXCD, off = wgid / NXCD; wgid = (xcd < r ? xcd * (q + 1) : r * (q + 1) + (xcd - r) * q) + off; }
        constexpr int nig = WGM * NN; static_assert(NM % WGM == 0, "row tiles in whole groups");
        const int gid = wgid / nig, fm = gid * WGM, rem = wgid % nig;
        pm = fm + (rem % WGM); pn = rem / WGM; return true;
    }
    __device__ __forceinline__ bool next(int i, Unit& u) const { return tile(i, u.pm, u.pn); }
};

template <class Epi, class Sched, bool GATHER, bool I8 = false>
__device__ __forceinline__ void gemm_phase(LAS unsigned char* lds, const Gemm g, const Sched& S, const Epi& E, int wv  ) {
    int tid = wv * 64 + lane_id_volatile(1); asm volatile("" : "+v"(tid));
    const int wid = __builtin_amdgcn_readfirstlane(tid >> 6), lane = tid & 63, wr = wid >> 2, wc = wid & 3, fr = lane & 15, fq = lane >> 4;
    const int K = g.K, RB = I8 ? K : 2 * K  , nt = RB / (BK * 2);
    unsigned voffA[2], voffB[2]; int RA[2], CA[2];
#pragma unroll
    for (int i = 0; i < 2; ++i) { int R, C; stage_rc(tid * 16 + i * 8192, R, C); const int Rb = (R & ~31) + perm32(R & 31); RA[i] = R; CA[i] = C;
        voffA[i] = (unsigned)(R * RB + C * 2); voffB[i] = (unsigned)(Rb * RB + C * 2); }
    const size_t kstep = (size_t)(BK * 2);
    const size_t hstep = (size_t)HALF * RB;
    const size_t tstep = 2 * hstep;
    const unsigned ldsw = (unsigned)wid * 1024u;
    const int aoff = lds_byte(wr * 64 + fr, fq * 8), boff = lds_byte(wc * 32 + fr, fq * 8);
#define PG8_SA(b, h) (((b) * 2 + (h)) * HTB)
#define PG8_SB(b, h) ((4 + (b) * 2 + (h)) * HTB)
#define PG8_STAGE(bufoff, gbase, voff) do { _Pragma("unroll") for (int _i = 0; _i < 2; ++_i) \
        __builtin_amdgcn_global_load_lds((const unsigned*)((const char*)(gbase) + (voff)[_i]), (LAS unsigned*)(lds + (bufoff) + ldsw + _i * 8192), 16, 0, 0); } while (0)
#define PG8_STAGE_A(bufoff, h, ubase, koff, VO) do { if constexpr (GATHER) { PG8_STAGE(bufoff, (const char*)g.A + (koff), VO[h]); } else { PG8_STAGE(bufoff, (ubase) + (h) * hstep + (koff), voffA); } } while (0)
#define PG8_LDA(dst, b, h) do { _Pragma("unroll") for (int m = 0; m < 4; ++m) _Pragma("unroll") for (int k = 0; k < 2; ++k) dst[m][k] = *(const LAS bf16x8*)(lds + PG8_SA(b, h) + aoff + m * 2048 + k * 1024); } while (0)
#define PG8_LDB(dst, b, h) do { _Pragma("unroll") for (int n = 0; n < 2; ++n) _Pragma("unroll") for (int k = 0; k < 2; ++k) dst[n][k] = *(const LAS bf16x8*)(lds + PG8_SB(b, h) + boff + n * 2048 + k * 1024); } while (0)
#define PG8_MMA(ai, bj, At, Bt) do { __builtin_amdgcn_s_setprio(1); _Pragma("unroll") for (int m = 0; m < 4; ++m) _Pragma("unroll") for (int n = 0; n < 2; ++n) _Pragma("unroll") for (int k = 0; k < 2; ++k) \
        { if constexpr (I8) acc[ai][bj][m][n] = __builtin_amdgcn_mfma_i32_16x16x64_i8(__builtin_bit_cast(i32x4, Bt[n][k]), __builtin_bit_cast(i32x4, At[m][k]), acc[ai][bj][m][n], 0, 0, 0); \
          else acc[ai][bj][m][n] = __builtin_amdgcn_mfma_f32_16x16x32_bf16(Bt[n][k], At[m][k], acc[ai][bj][m][n], 0, 0, 0); } __builtin_amdgcn_s_setprio(0); } while (0)
#define PG8_WAIT_V(n) asm volatile("s_waitcnt vmcnt(" #n ")" ::: "memory")
#define PG8_WAIT_L(n) asm volatile("s_waitcnt lgkmcnt(" #n ")" ::: "memory")
#define PG8_BAR __builtin_amdgcn_s_barrier()
#define PG8_SCHED __builtin_amdgcn_sched_barrier(0)
    Unit cur, nxt; int ui = 0;
    if (!S.next(0, cur)) return;
    typedef typename std::conditional<I8, i32x4, f32x4>::type accv_t;
    accv_t acc[2][2][4][2];
#pragma unroll
    for (int a = 0; a < 2; ++a)
#pragma unroll
        for (int b = 0; b < 2; ++b)
#pragma unroll
            for (int m = 0; m < 4; ++m)
#pragma unroll
                for (int n = 0; n < 2; ++n) acc[a][b][m][n] = (accv_t){0, 0, 0, 0};
    bf16x8 At[4][2], B0[2][2], B1[2][2];
    unsigned oc[2][2], on[2][2];
    if constexpr (GATHER) {
#pragma unroll
        for (int h = 0; h < 2; ++h)
#pragma unroll
            for (int i = 0; i < 2; ++i) { oc[h][i] = (unsigned)(S.src_row(cur, h * HALF + RA[i]) * RB + CA[i] * 2); on[h][i] = oc[h][i]; }

    }
    const char* cA = GATHER ? (const char*)g.A : (const char*)g.A + (size_t)cur.pm * tstep; const char* cB = (const char*)g.Bt + (size_t)cur.pn * tstep;
    PG8_STAGE(PG8_SB(0, 0), cB, voffB); PG8_STAGE(PG8_SB(0, 1), cB + hstep, voffB); PG8_STAGE_A(PG8_SA(0, 0), 0, cA, 0, oc); PG8_STAGE_A(PG8_SA(0, 1), 1, cA, 0, oc);
    if (wr == 1) PG8_BAR;
    PG8_WAIT_V(2); PG8_BAR;
    PG8_STAGE(PG8_SB(1, 0), cB + kstep, voffB); PG8_STAGE_A(PG8_SA(1, 0), 0, cA, kstep, oc); PG8_STAGE(PG8_SB(1, 1), cB + hstep + kstep, voffB);
    PG8_WAIT_V(6); PG8_BAR;
    for (;;) {
        const bool has_next = S.next(ui + 1, nxt);
        const char* nA = GATHER ? (const char*)g.A : (has_next ? (const char*)g.A + (size_t)nxt.pm * tstep : cA); const char* nB = has_next ? (const char*)g.Bt + (size_t)nxt.pn * tstep : cB;
        if constexpr (GATHER) {
            if (has_next) {
                const int t2 = wv * 64 + lane_id_volatile(3); int R2[2], C2[2];
#pragma unroll
                for (int i = 0; i < 2; ++i) stage_rc(t2 * 16 + i * 8192, R2[i], C2[i]);
#pragma unroll
                for (int h = 0; h < 2; ++h)
#pragma unroll
                    for (int i = 0; i < 2; ++i) on[h][i] = (unsigned)(S.src_row(nxt, h * HALF + R2[i]) * RB + C2[i] * 2);
            }
        }
        for (int t = 0; t < nt; t += 2) {
            const bool last = (t == nt - 2);
            const size_t k1 = (size_t)(t + 1) * kstep;
            const size_t k2 = last ? (size_t)0 : (size_t)(t + 2) * kstep, k3 = k2 + kstep;
            const char* a2 = last ? nA : cA; const char* b2 = last ? nB : cB;
            unsigned o2[2][2];
            if constexpr (GATHER) {
#pragma unroll
                for (int h = 0; h < 2; ++h)
#pragma unroll
                    for (int i = 0; i < 2; ++i) o2[h][i] = last ? on[h][i] : oc[h][i];
            }
            PG8_LDB(B0, 0, 0); PG8_LDB(B1, 0, 1); PG8_SCHED; PG8_LDA(At, 0, 0); PG8_STAGE_A(PG8_SA(1, 1), 1, cA, k1, oc);
            PG8_WAIT_V(8); PG8_WAIT_L(0); PG8_BAR; PG8_MMA(0, 0, At, B0); PG8_MMA(0, 1, At, B1); PG8_BAR; PG8_SCHED;
            PG8_LDA(At, 0, 1); PG8_STAGE(PG8_SB(0, 0), b2 + k2, voffB); PG8_STAGE(PG8_SB(0, 1), b2 + hstep + k2, voffB); PG8_STAGE_A(PG8_SA(0, 0), 0, a2, k2, o2);
            PG8_WAIT_V(8); PG8_WAIT_L(0); PG8_BAR; PG8_MMA(1, 0, At, B0); PG8_MMA(1, 1, At, B1); PG8_BAR; PG8_SCHED;
            PG8_LDB(B0, 1, 0); PG8_LDB(B1, 1, 1); PG8_SCHED; PG8_LDA(At, 1, 0); PG8_STAGE_A(PG8_SA(0, 1), 1, a2, k2, o2);
            PG8_WAIT_V(8); PG8_WAIT_L(0); PG8_BAR; PG8_MMA(0, 0, At, B0); PG8_MMA(0, 1, At, B1); PG8_BAR; PG8_SCHED;
            PG8_LDA(At, 1, 1); PG8_STAGE(PG8_SB(1, 0), b2 + k3, voffB); PG8_STAGE(PG8_SB(1, 1), b2 + hstep + k3, voffB); PG8_STAGE_A(PG8_SA(1, 0), 0, a2, k3, o2);
            PG8_WAIT_V(8); PG8_WAIT_L(0); PG8_BAR; PG8_MMA(1, 0, At, B0); PG8_MMA(1, 1, At, B1); PG8_BAR; PG8_SCHED;
        }
        if (wr == 0) PG8_BAR;
#ifdef SKIP_EPI_PROBE
        const int le_ = lane_id_volatile(4);
        bool rst = true; if (!g.skip_epi) rst = E(acc, cur, wr, wc, le_ & 15, le_ >> 4);
#else
        const int le_ = lane_id_volatile(4);
        const bool rst = E(acc, cur, wr, wc, le_ & 15, le_ >> 4);
#endif
        if (!has_next) break;
        if (rst) {
#pragma unroll
        for (int a = 0; a < 2; ++a)
#pragma unroll
            for (int b = 0; b < 2; ++b)
#pragma unroll
                for (int m = 0; m < 4; ++m)
#pragma unroll
                    for (int n = 0; n < 2; ++n) acc[a][b][m][n] = (accv_t){0, 0, 0, 0};
        }
        cur = nxt; cA = nA; cB = nB; ++ui;
        if constexpr (GATHER) {
#pragma unroll
            for (int h = 0; h < 2; ++h)
#pragma unroll
                for (int i = 0; i < 2; ++i) oc[h][i] = on[h][i];
        }
        if (wr == 1) PG8_BAR;
    }
    PG8_WAIT_V(0);
    PG8_BAR;
#undef PG8_SA
#undef PG8_SB
#undef PG8_STAGE
#undef PG8_STAGE_A
#undef PG8_LDA
#undef PG8_LDB
#undef PG8_MMA
#undef PG8_WAIT_V
#undef PG8_WAIT_L
#undef PG8_BAR
#undef PG8_SCHED
}
}
typedef f32x4 acc_t[2][2][4][2];
typedef i32x4 acci_t[2][2][4][2];

struct EpiProj {
    bf16_t* O; unsigned char* G8; const float* RS  ; const float* CS  ;
    __device__ __forceinline__ bool operator()(acci_t& acc, const pg8::Unit& u, int wr, int wc, int fr, int fq) const {
        const int pn = u.pn;
        const int act = (pn <= 1 || pn == 3 || pn == 4) ? 1 : (pn >= 12 ? 3 : (pn >= 8 ? 2 : 0));
        const int row0 = u.pm * 256 + wr * 64 + fr, col0 = pn * 256 + wc * 32 + 8 * fq;
        float rsv[8];
#pragma unroll
        for (int q = 0; q < 8; ++q) rsv[q] = RS[row0 + (q >> 2) * 128 + (q & 3) * 16];
        f32x2 cs2[2][4];
#pragma unroll
        for (int bj = 0; bj < 2; ++bj) { const f32x4 c0 = *(const f32x4*)(CS + col0 + bj * 128), c1 = *(const f32x4*)(CS + col0 + bj * 128 + 4); const float k = (act == 1 ? QSCALE : 1.f);
            cs2[bj][0] = (f32x2){c0[0], c0[1]} * k; cs2[bj][1] = (f32x2){c0[2], c0[3]} * k; cs2[bj][2] = (f32x2){c1[0], c1[1]} * k; cs2[bj][3] = (f32x2){c1[2], c1[3]} * k; }
#pragma unroll
        for (int ai = 0; ai < 2; ++ai)
#pragma unroll
            for (int m = 0; m < 4; ++m) { const int row = row0 + ai * 128 + m * 16; bf16_t* rowp = O + (size_t)row * PLD + col0; const float rs = rsv[ai * 4 + m];
#pragma unroll
                for (int bj = 0; bj < 2; ++bj) { f32x2 v[4];
#pragma unroll
                    for (int p = 0; p < 4; ++p) { const int i0 = 2 * p; v[p] = (f32x2){(float)acc[ai][bj][m][i0 >> 2][i0 & 3], (float)acc[ai][bj][m][(i0 + 1) >> 2][(i0 + 1) & 3]} * (cs2[bj][p] * rs); }
                    if (act == 2) {
#pragma unroll
                        for (int p = 0; p < 4; ++p) { const f32x2 x = v[p], t = (x * x * 0.044715f + 1.f) * x * (-2.302208198f); f32x2 d = {fexp2(t[0]), fexp2(t[1])}; d = d + 1.f; v[p] = x * (f32x2){frcp(d[0]), frcp(d[1])}; } }
                    else if (act == 3) {
                        f32x2 gq[4];
#pragma unroll
                        for (int p = 0; p < 4; ++p) { const f32x2 t = v[p] * (-LOG2E); f32x2 d = {fexp2(t[0]), fexp2(t[1])}; d = d + 1.f; gq[p] = (f32x2){frcp(d[0]), frcp(d[1])} * 256.f; }
                        u32x2 w8; w8.x = u8x4_floor(gq[0][0], gq[0][1], gq[1][0], gq[1][1]); w8.y = u8x4_floor(gq[2][0], gq[2][1], gq[3][0], gq[3][1]);
                        *(u32x2*)(G8 + (size_t)row * 3072 + (col0 - C_G) + bj * 128) = w8; continue; }
                    u32x4 w; w.x = cvt_pk_bf16(v[0][0], v[0][1]); w.y = cvt_pk_bf16(v[1][0], v[1][1]); w.z = cvt_pk_bf16(v[2][0], v[2][1]); w.w = cvt_pk_bf16(v[3][0], v[3][1]);
                    *(u32x4*)(rowp + bj * 128) = w; } }
        return true;
    }
};

struct BranchOrder {
    pg8::StaticOrder<MTOK / 256, DM / 256> so;
    __device__ __forceinline__ bool next(int j, pg8::Unit& u) const { const int i = j / 3, br = j - 3 * i; int pm, pn; if (!so.tile(i, pm, pn)) return false; u.pm = br * 256 + pm; u.pn = br * 4 + pn; return true; }
};
struct EpiBranch {
    const unsigned char* G8  ; bf16_t* MERGED;
    __device__ __forceinline__ bool operator()(acc_t& acc, const pg8::Unit& u, int wr, int wc, int fr, int fq) const {
        const int br = u.pn >> 2, pn = u.pn & 3, pm = u.pm & 255;
        const int row0 = pm * 256 + wr * 64 + fr, col0 = pn * 256 + wc * 32 + 8 * fq;
#pragma unroll
        for (int rnd = 0; rnd < 2; ++rnd) { const int ai = rnd, m0 = 0;
            u32x2 gw[4][2], gd[4][2];
#pragma unroll
            for (int m = m0; m < m0 + 4; ++m)
#pragma unroll
                for (int bj = 0; bj < 2; ++bj) { const unsigned char* gp = G8 + (size_t)(row0 + ai * 128 + m * 16) * 3072 + br * 1024 + col0 + bj * 128;
                    gw[m][bj] = *(const u32x2*)gp; if (br != 2) gd[m][bj] = *(const u32x2*)(gp + 1024); }
#pragma unroll
            for (int m = m0; m < m0 + 4; ++m) { const size_t row = (size_t)(row0 + ai * 128 + m * 16);
#pragma unroll
                for (int bj = 0; bj < 2; ++bj) {
                    const u32x2 g = gw[m][bj];
                    float gn[8];
#pragma unroll
                    for (int i = 0; i < 8; ++i) gn[i] = (float)((g[i >> 2] >> (8 * (i & 3))) & 0xffu) + 0.5f;
                    if (br != 2) { const u32x2 d = gd[m][bj];
#pragma unroll
                        for (int i = 0; i < 8; ++i) gn[i] = gn[i] * frcp((float)((d[i >> 2] >> (8 * (i & 3))) & 0xffu) + 0.5f); }
                    else {
#pragma unroll
                        for (int i = 0; i < 8; ++i) gn[i] *= (1.f / 256.f); }
                    f32x4 v0 = acc[ai][bj][m][0], v1 = acc[ai][bj][m][1];
                    v0[0] *= gn[0]; v0[1] *= gn[1]; v0[2] *= gn[2]; v0[3] *= gn[3]; v1[0] *= gn[4]; v1[1] *= gn[5]; v1[2] *= gn[6]; v1[3] *= gn[7];
                    if (br != 2) { acc[ai][bj][m][0] = v0; acc[ai][bj][m][1] = v1; }
                    else { u32x4 w; w.x = cvt_pk_bf16(v0[0], v0[1]); w.y = cvt_pk_bf16(v0[2], v0[3]); w.z = cvt_pk_bf16(v1[0], v1[1]); w.w = cvt_pk_bf16(v1[2], v1[3]);
                        *(u32x4*)(MERGED + row * DM + col0 + bj * 128) = w; } } }
            asm volatile("" ::: "memory");
        }
        return br == 2;
    }
};

#ifndef WOUT_VARIANT
#define WOUT_VARIANT 0
#endif
struct EpiWout {
    bf16_t* Y; float* SSP; bool pv = false;
    __device__ __forceinline__ bool operator()(acc_t& acc, const pg8::Unit& u, int wr, int wc, int fr, int fq) const {
        const int row0 = u.pm * 256 + wr * 64 + fr, col0 = u.pn * 256 + wc * 32 + 8 * fq;
#pragma unroll
        for (int ai = 0; ai < 2; ++ai)
#pragma unroll
            for (int m = 0; m < 4; ++m) { const size_t row = (size_t)(row0 + ai * 128 + m * 16); float ss = 0.f;
#pragma unroll
                for (int bj = 0; bj < 2; ++bj) { const f32x4 v0 = acc[ai][bj][m][0], v1 = acc[ai][bj][m][1];
                    ss += (v0[0] * v0[0] + v0[1] * v0[1]) + (v0[2] * v0[2] + v0[3] * v0[3]) + (v1[0] * v1[0] + v1[1] * v1[1]) + (v1[2] * v1[2] + v1[3] * v1[3]);
                    u32x4 w; w.x = cvt_pk_bf16(v0[0], v0[1]); w.y = cvt_pk_bf16(v0[2], v0[3]); w.z = cvt_pk_bf16(v1[0], v1[1]); w.w = cvt_pk_bf16(v1[2], v1[3]);
                    if (!(WOUT_VARIANT == 2 && pv)) *(u32x4*)(Y + row * DM + col0 + bj * 128) = w; }
                if (!(WOUT_VARIANT == 3 && pv)) ss = xor32_add(xor16_add(ss));
                if (fq == 0 && !((WOUT_VARIANT == 1 || WOUT_VARIANT == 3) && pv)) SSP[(size_t)(u.pn * 4 + wc) * MTOK + row] = ss; }
        return true;
    }
};

struct MoeOrder {
    int u0, u1, NB, rt_lo;
    const LAS int* tile_e;
    const LAS int* rowidx;
    __device__ __forceinline__ bool next(int i, pg8::Unit& u) const { const int x = u0 + i; if (x >= u1) return false; const int rt = x / NB, pn = x - rt * NB; u.pm = rt; u.pn = tile_e[rt] * NB + pn; return true; }
    __device__ __forceinline__ int src_row(const pg8::Unit& u, int r) const { return rowidx[(u.pm - rt_lo) * 256 + r]; }
};
struct EpiW1 {
    bf16_t* ACT; const float* b1  ;
    __device__ __forceinline__ bool operator()(acc_t& acc, const pg8::Unit& u, int wr, int wc, int fr, int fq) const {
        const int e = u.pn >> 3, pn = u.pn & 7;
        const int row0 = u.pm * 256 + wr * 64 + fr, j0 = pn * 128 + wc * 32 + 8 * fq;
        const float* bp = b1 + (size_t)e * (2 * FF) + 2 * j0;
        float bg[8], bl[8];
#pragma unroll
        for (int q = 0; q < 4; ++q) { const f32x4 t = *(const f32x4*)(bp + 4 * q); bg[2 * q] = t[0]; bl[2 * q] = t[1]; bg[2 * q + 1] = t[2]; bl[2 * q + 1] = t[3]; }
#pragma unroll
        for (int ai = 0; ai < 2; ++ai)
#pragma unroll
            for (int m = 0; m < 4; ++m) { float a[8];
#pragma unroll
                for (int i = 0; i < 8; ++i) { float gl = acc[ai][0][m][i >> 2][i & 3] + bg[i], li = acc[ai][1][m][i >> 2][i & 3] + bl[i];
                    gl = fminf(gl, 7.f); li = fminf(fmaxf(li, -7.f), 7.f);
                    a[i] = gl * frcp(1.f + fexp2(-1.702f * LOG2E * gl)) * (li + 1.f); }
                u32x4 w; w.x = cvt_pk_bf16(a[0], a[1]); w.y = cvt_pk_bf16(a[2], a[3]); w.z = cvt_pk_bf16(a[4], a[5]); w.w = cvt_pk_bf16(a[6], a[7]);
                *(u32x4*)(ACT + (size_t)(row0 + ai * 128 + m * 16) * FF + j0) = w; }
        return true;
    }
};
constexpr float ACT_SCALE = 12.f / 127.f;
struct EpiW1I8 {
    signed char* ACT  ; const float* b1  ; const float* RS  ; const float* CS  ;
    const LAS int* rowidx; int rt_lo;
    __device__ __forceinline__ bool operator()(acci_t& acc, const pg8::Unit& u, int wr, int wc, int fr, int fq) const {
        const int e = u.pn >> 3, pn = u.pn & 7;
        const int rl0 = wr * 64 + fr, row0 = u.pm * 256 + rl0, j0 = pn * 128 + wc * 32 + 8 * fq;
        const float* bp = b1 + (size_t)e * (2 * FF) + 2 * j0;
        float bg[8], bl[8], cg[8], cl[8];
#pragma unroll
        for (int q = 0; q < 4; ++q) { const f32x4 t = *(const f32x4*)(bp + 4 * q); bg[2 * q] = t[0]; bl[2 * q] = t[1]; bg[2 * q + 1] = t[2]; bl[2 * q + 1] = t[3]; }
        { const float* cp = CS + (size_t)e * 2048 + pn * 256 + wc * 32 + 8 * fq;
          const f32x4 a0 = *(const f32x4*)cp, a1 = *(const f32x4*)(cp + 4), c0 = *(const f32x4*)(cp + 128), c1 = *(const f32x4*)(cp + 132);
#pragma unroll
          for (int i = 0; i < 4; ++i) { cg[i] = a0[i]; cg[4 + i] = a1[i]; cl[i] = c0[i]; cl[4 + i] = c1[i]; } }
        const LAS int* ri = rowidx + (u.pm - rt_lo) * 256 + rl0;
        float rsv[8];
#pragma unroll
        for (int q = 0; q < 8; ++q) rsv[q] = RS[ri[(q >> 2) * 128 + (q & 3) * 16]];
        f32x2 bg2[4], bl2[4], cg2[4], cl2[4];
#pragma unroll
        for (int p = 0; p < 4; ++p) { bg2[p] = (f32x2){bg[2 * p], bg[2 * p + 1]}; bl2[p] = (f32x2){bl[2 * p], bl[2 * p + 1]}; cg2[p] = (f32x2){cg[2 * p], cg[2 * p + 1]}; cl2[p] = (f32x2){cl[2 * p], cl[2 * p + 1]}; }
#pragma unroll
        for (int ai = 0; ai < 2; ++ai)
#pragma unroll
            for (int m = 0; m < 4; ++m) { const float rs = rsv[ai * 4 + m]; f32x2 a2[4];
#pragma unroll
                for (int p = 0; p < 4; ++p) { const int i0 = 2 * p;
                    const f32x2 ag = {(float)acc[ai][0][m][i0 >> 2][i0 & 3], (float)acc[ai][0][m][(i0 + 1) >> 2][(i0 + 1) & 3]}, al = {(float)acc[ai][1][m][i0 >> 2][i0 & 3], (float)acc[ai][1][m][(i0 + 1) >> 2][(i0 + 1) & 3]};
                    f32x2 gl = ag * (cg2[p] * rs) + bg2[p], li = al * (cl2[p] * rs) + bl2[p];
                    gl[0] = fminf(gl[0], 7.f); gl[1] = fminf(gl[1], 7.f); li[0] = fminf(fmaxf(li[0], -7.f), 7.f); li[1] = fminf(fmaxf(li[1], -7.f), 7.f);
                    const f32x2 ex = gl * (-1.702f * LOG2E); f32x2 den = {fexp2(ex[0]), fexp2(ex[1])}; den = den + 1.f; const f32x2 rc = {frcp(den[0]), frcp(den[1])};
                    a2[p] = (gl * rc) * (li + 1.f); }
                u32x2 w; w.x = q8x4(a2[0][0], a2[0][1], a2[1][0], a2[1][1], 1.f / ACT_SCALE); w.y = q8x4(a2[2][0], a2[2][1], a2[3][0], a2[3][1], 1.f / ACT_SCALE);
                *(u32x2*)(ACT + (size_t)(row0 + ai * 128 + m * 16) * FF + j0) = w; }
        return true;
    }
};
struct EpiW2 {
    bf16_t* Y2; const float* b2  ; const float* CS  ;
    __device__ __forceinline__ bool operator()(acci_t& acc, const pg8::Unit& u, int wr, int wc, int fr, int fq) const {
        const int e = u.pn >> 2, pn = u.pn & 3;
        const int row0 = u.pm * 256 + wr * 64 + fr, col0 = pn * 256 + wc * 32 + 8 * fq;
        f32x4 bv[2][2], cv[2][2];
#pragma unroll
        for (int bj = 0; bj < 2; ++bj)
#pragma unroll
            for (int n = 0; n < 2; ++n) { bv[bj][n] = *(const f32x4*)(b2 + (size_t)e * DM + col0 + bj * 128 + 4 * n); cv[bj][n] = *(const f32x4*)(CS + (size_t)e * DM + col0 + bj * 128 + 4 * n) * ACT_SCALE; }
#pragma unroll
        for (int ai = 0; ai < 2; ++ai)
#pragma unroll
            for (int m = 0; m < 4; ++m) { bf16_t* rowp = Y2 + (size_t)(row0 + ai * 128 + m * 16) * DM + col0;
#pragma unroll
                for (int bj = 0; bj < 2; ++bj) { const i32x4 a0 = acc[ai][bj][m][0], a1 = acc[ai][bj][m][1];
                    const f32x4 v0 = (f32x4){(float)a0[0], (float)a0[1], (float)a0[2], (float)a0[3]} * cv[bj][0] + bv[bj][0], v1 = (f32x4){(float)a1[0], (float)a1[1], (float)a1[2], (float)a1[3]} * cv[bj][1] + bv[bj][1];
                    u32x4 w; w.x = cvt_pk_bf16(v0[0], v0[1]); w.y = cvt_pk_bf16(v0[2], v0[3]); w.z = cvt_pk_bf16(v1[0], v1[1]); w.w = cvt_pk_bf16(v1[2], v1[3]);
                    *(u32x4*)(rowp + bj * 128) = w; } }
        return true;
    }
};
#define XB_TMO      128
#define XB_XCNT(j)  (256  + 64 * (j))
#define XB_XSUB(j)  (1280 + 64 * (j))
#define XB_XGEN(j)  (2304 + 64 * (j))
#define XB_TOP      3328
#define XB_TOPGEN   3392
#define XCD_BAR_WORDS 3456
#define XB_SPIN_CAP (1u << 18)

__device__ __forceinline__ unsigned xb_ld(unsigned* p)              { return __hip_atomic_load(p, __ATOMIC_RELAXED, __HIP_MEMORY_SCOPE_AGENT); }
__device__ __forceinline__ unsigned xb_add(unsigned* p, unsigned v) { return __hip_atomic_fetch_add(p, v, __ATOMIC_RELAXED, __HIP_MEMORY_SCOPE_AGENT); }
__device__ __forceinline__ unsigned xb_xcc_id() { return (unsigned)__builtin_amdgcn_s_getreg((3 << 11) | 20) & 0xFu; }
#define XB_SPIN(cond, bar) do { unsigned _sp = 0; while (cond) { __builtin_amdgcn_s_sleep(1); \
    if ((++_sp & 255u) == 0u) { if (xb_ld(&(bar)[XB_TMO])) break; if (_sp > XB_SPIN_CAP) { atomicAdd(&(bar)[XB_TMO], 1u); break; } } } } while (0)

struct XcdBarrier {
    unsigned* bar; unsigned x;
    int w;
    volatile LAS unsigned* st;
};

__device__ __forceinline__ bool xb_thread0(int w) { return w == 0 && lane_id_volatile(2) == 0; }
__device__ __forceinline__ XcdBarrier xcd_barrier_post(unsigned* bar, volatile LAS unsigned* st, int w) {
    XcdBarrier b; b.bar = bar; b.x = xb_xcc_id(); b.st = st; b.w = w;
    if (xb_thread0(w)) (void)xb_add(&bar[XB_XCNT(b.x)], 1u);
    return b;
}
__device__ __forceinline__ void xcd_barrier_complete(unsigned* bar, unsigned x, unsigned& nloc, unsigned& nx) {
    const unsigned G = gridDim.x * gridDim.y * gridDim.z;
    unsigned sum, cnt, mine, sp = 0u;
    for (;;) {
        sum = 0u; cnt = 0u; mine = 0u;
#pragma unroll
        for (unsigned j = 0; j < 16; ++j) { const unsigned c = xb_ld(&bar[XB_XCNT(j)]); sum += c; cnt += (c > 0u) ? 1u : 0u; mine = (j == x) ? c : mine; }
        if (sum == G) break;
        __builtin_amdgcn_s_sleep(1);
        if ((++sp & 255u) == 0u) { if (xb_ld(&bar[XB_TMO])) break; if (sp > XB_SPIN_CAP) { atomicAdd(&bar[XB_TMO], 1u); break; } }
    }
    nloc = mine > 0u ? mine : 1u; nx = cnt > 0u ? cnt : 1u;
}

__device__ __forceinline__ void xcd_barrier(const XcdBarrier& b) {
    asm volatile("s_waitcnt vmcnt(0)" ::: "memory");
    __syncthreads();
    if (xb_thread0(b.w)) {
        unsigned* bar = b.bar;
        __builtin_amdgcn_s_waitcnt(0);
        unsigned nloc = b.st[0], nx = b.st[1];
        if (nloc == 0u) { xcd_barrier_complete(bar, b.x, nloc, nx); b.st[0] = nloc; b.st[1] = nx; }
        const unsigned old = xb_add(&bar[XB_XSUB(b.x)], 1u);
        const unsigned gen = old / nloc;
        if (old + 1u == (gen + 1u) * nloc) {
            __builtin_amdgcn_fence(__ATOMIC_RELEASE, "agent");
            asm volatile("s_waitcnt vmcnt(0)" ::: "memory");
            const unsigned og = xb_add(&bar[XB_TOP], 1u);
            const unsigned tg = og / nx;
            if (og + 1u == (tg + 1u) * nx) xb_add(&bar[XB_TOPGEN], 1u);
            else XB_SPIN(xb_ld(&bar[XB_TOPGEN]) == tg, bar);
            __builtin_amdgcn_fence(__ATOMIC_ACQUIRE, "agent");
            xb_add(&bar[XB_XGEN(b.x)], 1u);
            asm volatile("s_waitcnt vmcnt(0)" ::: "memory");
        } else {
            XB_SPIN(xb_ld(&bar[XB_XGEN(b.x)]) == gen, bar);
            __builtin_amdgcn_fence(__ATOMIC_ACQUIRE, "agent");
            asm volatile("s_waitcnt vmcnt(0)" ::: "memory");
        }
    }
    __syncthreads();
}

constexpr size_t MiB = 1u << 20;
constexpr size_t WS_CTL = 0, CTL_ZERO_BYTES = 1 * MiB;
constexpr size_t WS_MOD = 1 * MiB;
constexpr size_t WS_SGW = 3 * MiB;
constexpr size_t WS_WRT = 3 * MiB + 512 * 1024;
constexpr size_t WS_RS = 4 * MiB;
constexpr size_t WS_CS1 = 5 * MiB;
constexpr size_t WS_CS2 = 6 * MiB + 512 * 1024;
constexpr size_t WS_CSIN = 6 * MiB;
constexpr size_t WS_W = 8 * MiB, W_LAYER = 209 * MiB;
constexpr size_t WO_WIN = 0, WO_WBR = 12 * MiB, WO_WOUT = 15 * MiB, WO_W1 = 17 * MiB, WO_W2 = 145 * MiB;
constexpr size_t WS_PROJ = 426 * MiB;
constexpr size_t WS_GATES = 810 * MiB;
constexpr size_t WS_ACT = WS_PROJ;
constexpr size_t WS_X = 1002 * MiB;
constexpr size_t WS_H = 1194 * MiB;
constexpr size_t WS_O = 1322 * MiB;
constexpr size_t WS_Y = 1514 * MiB;
constexpr size_t WS_BITS = 1770 * MiB;
constexpr size_t WS_Y2 = WS_O;
constexpr size_t WS_SSP = 1850 * MiB;
constexpr size_t WS_ROWTOK = 1854 * MiB;
constexpr size_t WS_TOKINFO = 1862 * MiB;
constexpr size_t WS_SLAB = 1864 * MiB;
constexpr size_t WS_END = 1928 * MiB;
static_assert(WS_Y2 + (size_t)270336 * 2048 <= WS_SSP && WS_W + 2 * W_LAYER <= WS_PROJ && WS_PROJ + (size_t)MTOK * PLD * 2 <= WS_GATES && WS_GATES + (size_t)MTOK * 3072 <= WS_H, "d_ws map");
constexpr int CW_BAR = 4096;
constexpr int CW_CNT = 16384;

constexpr int RING_BYTES = 131072;
constexpr int MISC_OFF = 134144;
constexpr int TS_OFF = MISC_OFF + 512;
constexpr int TILE_E_OFF = MISC_OFF + 1024;
constexpr int ROWIDX_OFF = MISC_OFF + 5632;
constexpr int LDS_BYTES = 151552;
static_assert(ROWIDX_OFF + 8192 <= LDS_BYTES, "LDS map");

struct Args {
    const float* in[21]; float* out; unsigned char* ws; int ph_lo, ph_hi;
};
struct Frame {
    LAS unsigned char* lds; int tid, lane, wave, vcu, G;
};
__device__ __forceinline__ Frame phase_frame(const Frame& F0) { Frame F = F0; int t = F0.wave * 64 + lane_id_volatile(3); asm volatile("" : "+v"(t)); F.tid = t; F.lane = t & 63; F.wave = F0.wave; return F; }
template <class T> __device__ __forceinline__ T* opq(T* p) { long z = 0; asm volatile("" : "+s"(z)); return (T*)((unsigned char*)p + z); }

__device__ __forceinline__ void p0_mod(const Frame& F, const float* c, const float* w_ada, const float* b_ada, float* MOD) {
    LAS float* csT = (LAS float*)F.lds;
    for (int i = F.tid; i < BATCH * DM; i += 512) { const int b = i & 31, k = i >> 5; const float v = c[b * DM + k]; csT[k * 32 + b] = v * sigmoidf_(v); }
    __syncthreads();
    const int gw = F.vcu * 8 + F.wave, NGW = F.G * 8;
    const int cg = F.lane & 15, kq = F.lane >> 4;
    for (int task = gw; task < DEPTH * 384; task += NGW) {
        const int l = task / 384, n = (task % 384) * 16 + cg;
        float acc[32];
#pragma unroll
        for (int b = 0; b < 32; ++b) acc[b] = 0.f;
        const float* w = w_ada + ((size_t)l * DM + kq * 256) * (6 * DM) + n;
#pragma unroll 4
        for (int k = 0; k < 256; ++k) {
            const float wv = w[(size_t)k * (6 * DM)];
            const LAS f32x4* cs = (const LAS f32x4*)(csT + (kq * 256 + k) * 32);
#pragma unroll
            for (int q = 0; q < 8; ++q) { const f32x4 c4 = cs[q]; acc[4 * q] += c4[0] * wv; acc[4 * q + 1] += c4[1] * wv; acc[4 * q + 2] += c4[2] * wv; acc[4 * q + 3] += c4[3] * wv; }
        }
#pragma unroll
        for (int b = 0; b < 32; ++b) { acc[b] = xor32_add(xor16_add(acc[b])); }
        if (kq == 0) { const float bb = b_ada[l * 6 * DM + n];
#pragma unroll
            for (int b = 0; b < 32; ++b) MOD[((size_t)l * BATCH + b) * (6 * DM) + n] = acc[b] + bb; }
    }
    __syncthreads();
}
__device__ __forceinline__ void tr_item(const float* W, size_t ldw, int srccol, bool valid, bf16_t* dst  , int K, LAS float* scr, int lane) {
    const float* wp = W + srccol;
#pragma unroll 8
    for (int i = 0; i < 32; ++i) { const int kk = 2 * i + (lane >> 5); scr[kk * 33 + (lane & 31)] = valid ? wp[(size_t)kk * ldw] : 0.f; }
    LDS_WAIT(); asm volatile("" ::: "memory");
    const int c = lane & 7;
#pragma unroll
    for (int j = 0; j < 4; ++j) { const int n = (lane >> 3) + 8 * j; const LAS float* s = scr + (8 * c) * 33 + n;
        u32x4 o; o.x = cvt_pk_bf16(s[0 * 33], s[1 * 33]); o.y = cvt_pk_bf16(s[2 * 33], s[3 * 33]); o.z = cvt_pk_bf16(s[4 * 33], s[5 * 33]); o.w = cvt_pk_bf16(s[6 * 33], s[7 * 33]);
        *(u32x4*)(dst + (size_t)n * K + 8 * c) = o; }
    LDS_WAIT(); asm volatile("" ::: "memory");
}
__device__ __forceinline__ void p0_weights(const Frame& F, const Args& a) {
    LAS float* scr = (LAS float*)(F.lds + F.wave * 16384);
    const int gw = F.vcu * 8 + F.wave, NGW = F.G * 8, lane = F.lane, jl = lane & 31;
    const float *w_in = a.in[8], *w_branch = a.in[13], *w_out = a.in[14], *w_router = a.in[15], *w1 = a.in[17], *w2 = a.in[19];
    constexpr int I_BR = 3 * 8 * 32, I_OUT = 16 * 32, I_RT = 16;
    constexpr int I_LAYER = I_BR + I_OUT + I_RT;
    for (int it = gw; it < DEPTH * I_LAYER; it += NGW) {
        const int l = it / I_LAYER; int r = it - l * I_LAYER;
        unsigned char* wl = a.ws + WS_W + (size_t)l * W_LAYER;
        if (r < I_BR) {
            const int br = r / 256, q = r % 256, kb = q / 32, nb = q % 32;
            tr_item(w_branch + ((size_t)(l * 3 + br) * 512 + kb * 64) * DM, DM, nb * 32 + jl, true, (bf16_t*)(wl + WO_WBR) + (size_t)(br * 1024 + nb * 32) * 512 + kb * 64, 512, scr, lane); continue; }
        r -= I_BR;
        if (r < I_OUT) {
            const int kb = r / 32, nb = r % 32;
            tr_item(w_out + ((size_t)l * DM + kb * 64) * DM, DM, nb * 32 + jl, true, (bf16_t*)(wl + WO_WOUT) + (size_t)nb * 32 * DM + kb * 64, DM, scr, lane); continue; }
        r -= I_OUT;
        {
            const int kb = r;
            tr_item(w_router + ((size_t)l * DM + kb * 64) * NE, NE, jl, true, (bf16_t*)(a.ws + WS_WRT) + (size_t)l * NE * DM + kb * 64, DM, scr, lane); }
        (void)r;
    }
    __syncthreads();
    {
    LAS float* T = (LAS float*)F.lds; LAS float* red = (LAS float*)(F.lds + ROWIDX_OFF);
    const int half = lane >> 5, wave = F.wave;
    constexpr int ST_W1 = NE * 64, ST_IN = 192, ST_W2 = NE * 32, ST_LAYER = ST_W1 + ST_IN + ST_W2;
#define STRIP_PARAMS(st_, wp, ldw, valid, dst, csp) do { const int l = (st_) / ST_LAYER, q = (st_) % ST_LAYER; valid = true; \
        if (q < ST_W1) { const int e = q / 64, r6 = q % 64, pn = r6 >> 3, jjg = (r6 >> 1) & 3, sgl = r6 & 1, nb = pn * 8 + sgl * 4 + jjg, n = nb * 32 + jl, src = 2 * (128 * pn + jjg * 32 + jl) + sgl; \
            wp = w1 + ((size_t)(l * NE + e) * DM) * (2 * FF) + src; ldw = 2 * FF; \
            dst = (signed char*)(a.ws + WS_W + (size_t)l * W_LAYER + WO_W1) + ((size_t)e * 2048 + nb * 32) * DM; csp = (float*)(a.ws + WS_CS1) + ((size_t)l * NE + e) * 2048 + n; } \
        else if (q >= ST_W1 + ST_IN) { const int q2 = q - ST_W1 - ST_IN, e = q2 / 32, nb = q2 % 32, n = nb * 32 + jl; \
            wp = w2 + ((size_t)(l * NE + e) * FF) * DM + n; ldw = DM; \
            dst = (signed char*)(a.ws + WS_W + (size_t)l * W_LAYER + WO_W2) + ((size_t)e * DM + nb * 32) * FF; csp = (float*)(a.ws + WS_CS2) + ((size_t)l * NE + e) * DM + n; } \
        else { const int nb = q - ST_W1, n = nb * 32 + jl; valid = (n < 1832) || (n >= 2048); const int src = n < 1832 ? n : n - 216; \
            wp = w_in + (size_t)l * DM * 5928 + (valid ? src : 0); ldw = 5928; \
            dst = (signed char*)(a.ws + WS_W + (size_t)l * W_LAYER + WO_WIN) + (size_t)nb * 32 * DM; csp = (float*)(a.ws + WS_CSIN) + (size_t)l * NPROJ + n; } } while (0)
#define STRIP_LOAD(vv, ib, wp, ldw, valid) do { _Pragma("unroll") for (int i = 0; i < 32; ++i) { const int k = wave * 128 + 2 * ((ib) * 32 + i) + half; vv[i] = valid ? __builtin_nontemporal_load(wp + (size_t)k * ldw) : 0.f; } } while (0)
    float v0[32];
    { const int st = F.vcu < DEPTH * ST_LAYER ? F.vcu : DEPTH * ST_LAYER - 1; const float* wp; size_t ldw; bool valid; signed char* dst; float* csp; STRIP_PARAMS(st, wp, ldw, valid, dst, csp); (void)dst; (void)csp; STRIP_LOAD(v0, 0, wp, ldw, valid); }
    for (int st = F.vcu; st < DEPTH * ST_LAYER; st += F.G) {
        const float* wp; size_t ldw; bool valid; signed char* dst; float* csp;
        STRIP_PARAMS(st, wp, ldw, valid, dst, csp);
        float am = 0.f;
        { float v1[32]; STRIP_LOAD(v1, 1, wp, ldw, valid);
#pragma unroll
          for (int i = 0; i < 32; ++i) { const int k = wave * 128 + 2 * i + half; am = fmaxf(am, fabsf(v0[i])); T[k * 32 + (jl ^ (k & 31))] = v0[i]; }
#pragma unroll
          for (int i = 0; i < 32; ++i) { const int k = wave * 128 + 2 * (32 + i) + half; am = fmaxf(am, fabsf(v1[i])); T[k * 32 + (jl ^ (k & 31))] = v1[i]; } }
        red[(wave * 2 + half) * 32 + jl] = am;
        lds_barrier();
        { const int stn = st + F.G; if (stn < DEPTH * ST_LAYER) { const float* wpn; size_t ldwn; bool validn; signed char* dstn; float* cspn; STRIP_PARAMS(stn, wpn, ldwn, validn, dstn, cspn); (void)dstn; (void)cspn; STRIP_LOAD(v0, 0, wpn, ldwn, validn); } }
        float amx = 0.f;
#pragma unroll
        for (int p = 0; p < 16; ++p) amx = fmaxf(amx, red[p * 32 + jl]);
        const float scale = valid ? fmaxf(amx, 1e-30f) * (1.f / 127.f) : 1.f, inv = valid ? 1.f / scale : 0.f;
        if (wave == 0 && half == 0) *csp = scale;
        const int k0 = 64 * (wave * 2 + half);
#pragma unroll
        for (int c16 = 0; c16 < 4; ++c16) { unsigned wq[4];
#pragma unroll
            for (int d4 = 0; d4 < 4; ++d4) { const int k = k0 + c16 * 16 + d4 * 4;
                wq[d4] = q8x4(T[k * 32 + (jl ^ (k & 31))], T[(k + 1) * 32 + (jl ^ ((k + 1) & 31))], T[(k + 2) * 32 + (jl ^ ((k + 2) & 31))], T[(k + 3) * 32 + (jl ^ ((k + 3) & 31))], inv); }
            *(u32x4*)(dst + (size_t)jl * DM + k0 + c16 * 16) = (u32x4){wq[0], wq[1], wq[2], wq[3]}; }
        lds_barrier();
    }
#undef STRIP_PARAMS
#undef STRIP_LOAD
    }
    const float* sg_w = a.in[10]; bf16_t* SGW = (bf16_t*)(a.ws + WS_SGW);
    for (int i = (F.vcu * 512 + F.tid) * 2; i < DEPTH * 8 * 128 * 128; i += F.G * 512 * 2) { const int s = i & 127, t = (i >> 7) & 127; const f32x2 v = *(const f32x2*)(sg_w + i);
        *(unsigned*)(SGW + i) = cvt_pk_bf16(s <= t ? v[0] : 0.f, (s + 1) <= t ? v[1] : 0.f); }
}

__device__ __forceinline__ void norm_mod_row(const f32x4 (&v)[4], float ss, const float* g, const float* sc, const float* sh, signed char* orow, float* rs, int lane) {
    const float rstd = 1.f / sqrtf(ss * (1.f / DM) + RMS_EPS);
    f32x4 o[4]; float am = 0.f;
#pragma unroll
    for (int j = 0; j < 4; ++j) { const int c = 4 * lane + 256 * j; const f32x4 gg = *(const f32x4*)(g + c), s1 = *(const f32x4*)(sc + c), s0 = *(const f32x4*)(sh + c);
        o[j] = (v[j] * rstd) * gg * (s1 + 1.f) + s0;
        am = fmaxf(am, fmaxf(fmaxf(fabsf(o[j][0]), fabsf(o[j][1])), fmaxf(fabsf(o[j][2]), fabsf(o[j][3])))); }
    am = wave_max(am);
    const float scale = fmaxf(am, 1e-30f) * (1.f / 127.f), inv = 1.f / scale;
    if (lane == 0) *rs = scale;
#pragma unroll
    for (int j = 0; j < 4; ++j) *(unsigned*)(orow + 4 * lane + 256 * j) = q8x4(o[j][0], o[j][1], o[j][2], o[j][3], inv);
}
__device__ __forceinline__ void p1_norm(const Frame& F, const float* x, const float* g, const float* MOD0, signed char* H8, float* RS, bf16_t* X16) {
    const int gw = F.vcu * 8 + F.wave, NGW = F.G * 8;
    for (int row0 = gw * 4; row0 < MTOK; row0 += NGW * 4) { f32x4 v[4][4];
#pragma unroll
        for (int rr = 0; rr < 4; ++rr)
#pragma unroll
            for (int j = 0; j < 4; ++j) v[rr][j] = __builtin_nontemporal_load((const f32x4*)(x + (size_t)(row0 + rr) * DM + 4 * F.lane + 256 * j));
#pragma unroll
        for (int rr = 0; rr < 4; ++rr) { const int row = row0 + rr, b = row >> 11; float ss = 0.f;
#pragma unroll
            for (int j = 0; j < 4; ++j) ss += (v[rr][j][0] * v[rr][j][0] + v[rr][j][1] * v[rr][j][1]) + (v[rr][j][2] * v[rr][j][2] + v[rr][j][3] * v[rr][j][3]);
            ss = wave_sum(ss);
#pragma unroll
            for (int j = 0; j < 4; ++j) { u32x2 w; w.x = cvt_pk_bf16(v[rr][j][0], v[rr][j][1]); w.y = cvt_pk_bf16(v[rr][j][2], v[rr][j][3]); *(u32x2*)(X16 + (size_t)row * DM + 4 * F.lane + 256 * j) = w; }
            const float* mb = MOD0 + (size_t)b * 6 * DM;
            norm_mod_row(v[rr], ss, g, mb + DM, mb, H8 + (size_t)row * DM, RS + row, F.lane); } }
}
constexpr int TOPK_SEL = 256;
struct IdxOps { bf16x8 af[4][2]; u32x4 wraw[4][2]; bf16x8 kf[4][2]; };
__device__ __forceinline__ void dsa_index_load(IdxOps& P, const bf16_t* __restrict__ PROJ, int b, int qg, int lane, int wid) {
    asm volatile("" : "+v"(lane));
    const int n = lane & 31, hi = lane >> 5;
    const int q0 = qg * 16;
    const size_t tokbase = (size_t)b * SEQ;
    const int m = n, hm = (m >> 2) & 1, idx = (m & 3) + 4 * (m >> 3), aq = 2 * hm + (idx >> 3), ah = idx & 7;
#pragma unroll
    for (int qgp = 0; qgp < 4; ++qgp) { const bf16_t* qp = PROJ + (tokbase + q0 + 4 * qgp + aq) * PLD + C_QI + ah * 32 + 8 * hi;
        P.af[qgp][0] = *(const bf16x8*)qp; P.af[qgp][1] = *(const bf16x8*)(qp + 16); }
}
__device__ __forceinline__ void dsa_index_load_k(IdxOps& P, const bf16_t* __restrict__ PROJ, int b, int qg, int lane, int wid) {
    asm volatile("" : "+v"(lane));
    const int n = lane & 31, hi = lane >> 5;
    const int q0 = qg * 16, nkb = (q0 + 16 + 31) >> 5;
    const size_t tokbase = (size_t)b * SEQ;
#pragma unroll
    for (int qgp = 0; qgp < 4; ++qgp)
#pragma unroll
        for (int qq = 0; qq < 2; ++qq) P.wraw[qgp][qq] = *(const u32x4*)(PROJ + (tokbase + q0 + 4 * qgp + 2 * hi + qq) * PLD + C_WI);
#pragma unroll
    for (int i = 0; i < 4; ++i) { const int kb = wid + 8 * i;
        if (kb < nkb) { const bf16_t* kp = PROJ + (tokbase + 32 * kb + n) * PLD + C_KI + 8 * hi; P.kf[i][0] = *(const bf16x8*)kp; P.kf[i][1] = *(const bf16x8*)(kp + 16); } }
}
__device__ __forceinline__ void dsa_index_scores(IdxOps& P, const bf16_t* __restrict__ PROJ, LAS float* sc, int b, int qg, int lane, int wid) {
    const int n = lane & 31, hi = lane >> 5;
    const int q0 = qg * 16, nkb = (q0 + 16 + 31) >> 5;
    const size_t tokbase = (size_t)b * SEQ;
    LAS float* scw = sc + (2 * hi) * 2048 + 32 * wid + n;
    float wv[4][16];
#pragma unroll
    for (int qgp = 0; qgp < 4; ++qgp)
#pragma unroll
        for (int qq = 0; qq < 2; ++qq) { const u32x4 w = P.wraw[qgp][qq];
            wv[qgp][8 * qq + 0] = bf_lo(w.x) * 0.0625f; wv[qgp][8 * qq + 1] = bf_hi(w.x) * 0.0625f; wv[qgp][8 * qq + 2] = bf_lo(w.y) * 0.0625f; wv[qgp][8 * qq + 3] = bf_hi(w.y) * 0.0625f;
            wv[qgp][8 * qq + 4] = bf_lo(w.z) * 0.0625f; wv[qgp][8 * qq + 5] = bf_hi(w.z) * 0.0625f; wv[qgp][8 * qq + 6] = bf_lo(w.w) * 0.0625f; wv[qgp][8 * qq + 7] = bf_hi(w.w) * 0.0625f; }
#pragma unroll
    for (int i = 0; i < 8; ++i) { const int kb = wid + 8 * i;
        if (kb < nkb) {
            const bf16x8 k0 = P.kf[i & 3][0], k1 = P.kf[i & 3][1];
            if (i < 4 && kb + 32 < nkb) { const bf16_t* kp = PROJ + (tokbase + 32 * (kb + 32) + n) * PLD + C_KI + 8 * hi; P.kf[i & 3][0] = *(const bf16x8*)kp; P.kf[i & 3][1] = *(const bf16x8*)(kp + 16); }
#pragma unroll
            for (int qgp = 0; qgp < 4; ++qgp) {
                f32x16 d = {0.f, 0.f, 0.f, 0.f, 0.f, 0.f, 0.f, 0.f, 0.f, 0.f, 0.f, 0.f, 0.f, 0.f, 0.f, 0.f};
                d = __builtin_amdgcn_mfma_f32_32x32x16_bf16(P.af[qgp][0], k0, d, 0, 0, 0);
                d = __builtin_amdgcn_mfma_f32_32x32x16_bf16(P.af[qgp][1], k1, d, 0, 0, 0);
                float sa = 0.f, sb = 0.f;
#pragma unroll
                for (int r = 0; r < 8; ++r) { sa += wv[qgp][r] * fmaxf(d[r], 0.f); sb += wv[qgp][8 + r] * fmaxf(d[8 + r], 0.f); }
                scw[(4 * qgp) * 2048 + 256 * i] = sa; scw[(4 * qgp + 1) * 2048 + 256 * i] = sb;
            } } }
}
__device__ __forceinline__ void bit_transpose32(unsigned (&a)[32]) {
#pragma unroll
    for (int k = 0; k < 16; ++k) { const unsigned lo = a[k], hi = a[k + 16];
        a[k] = __builtin_amdgcn_perm(hi, lo, 0x05040100u); a[k + 16] = __builtin_amdgcn_perm(hi, lo, 0x07060302u); }
#pragma unroll
    for (int k = 0; k < 32; ++k) if ((k & 8) == 0) { const unsigned lo = a[k], hi = a[k + 8];
        a[k] = __builtin_amdgcn_perm(hi, lo, 0x06020400u); a[k + 8] = __builtin_amdgcn_perm(hi, lo, 0x07030501u); }
#pragma unroll
    for (int s = 0; s < 3; ++s) { const int j = 4 >> s; const unsigned m = (s == 0) ? 0x0F0F0F0Fu : (s == 1) ? 0x33333333u : 0x55555555u;
#pragma unroll
        for (int k = 0; k < 32; ++k) if ((k & j) == 0) { const unsigned lo = a[k], hi = a[k + j];
            a[k] = (m & lo) | (~m & (hi << j)); a[k + j] = (m & (lo >> j)) | (~m & hi); } }
}
__device__ __forceinline__ void dsa_index_select(LAS float* sc, LAS int* qctr, unsigned long long* __restrict__ bits64, int b, int qg, int lane, int wid) {
    const int q0 = qg * 16;
    const size_t tokbase = (size_t)b * SEQ;
#pragma unroll 1
    for (;;) {
        int qn = 0; if (lane == 0) qn = __hip_atomic_fetch_add(qctr, 1, __ATOMIC_RELAXED, __HIP_MEMORY_SCOPE_WORKGROUP);
        qn = __builtin_amdgcn_readfirstlane(qn); if (qn >= 16) break;
        const int ql = 15 - qn, pos = q0 + ql, nn = pos + 1, nr = (nn + 63) >> 6;
        const LAS float* scq = sc + ql * 2048;
        unsigned mlo = 0u, mhi = 0u;
        if (nn <= TOPK_SEL) {
#pragma unroll
            for (int r = 0; r < 4; ++r) if (r < nr) { const unsigned long long bal = __ballot(64 * r + lane <= pos); asm volatile("s_nop 4\n\tv_writelane_b32 %0, %2, %4\n\tv_writelane_b32 %1, %3, %4" : "+v"(mlo), "+v"(mhi) : "s"((unsigned)bal), "s"((unsigned)(bal >> 32)), "n"(r));     }
        } else {
            unsigned u[32];
#pragma unroll
            for (int r = 0; r < 32; ++r) u[r] = 0u;
#pragma unroll
            for (int g8 = 0; g8 < 4; ++g8) if (8 * g8 < nr) {
#pragma unroll
                for (int q_ = 0; q_ < 8; ++q_) { const int r = 8 * g8 + q_; const int j = 64 * r + lane; float s = scq[j]; s = (s == 0.f) ? 0.f : s; const unsigned bts = __builtin_bit_cast(unsigned, s);
                    const unsigned uu = (bts & 0x80000000u) ? ~bts : (bts | 0x80000000u); u[r] = (j <= pos) ? uu : 0u; } }
            unsigned M = 0u;
#pragma unroll
            for (int r = 0; r < 32; ++r) M |= (64 * r + lane <= pos) ? (1u << r) : 0u;
            bit_transpose32(u);
            unsigned G = 0u; unsigned need = (unsigned)TOPK_SEL, cM = (unsigned)nn;
            {
#pragma unroll
            for (int bq = 31; bq >= 0; --bq) {
                const unsigned T = M & u[bq];
                const unsigned c = wave_sum_u32((unsigned)__builtin_popcount(T));
                const bool ge = c >= need;
                G |= ge ? 0u : T; M = ge ? T : (M & ~u[bq]); cM = ge ? c : cM - c; need -= ge ? 0u : c;
                if (cM == need) { G |= M; goto sel_done; }
            }
            unsigned run = 0u;
#pragma unroll
            for (int r = 0; r < 32; ++r) if (r < nr) { const bool isc = (M >> r) & 1u; const unsigned long long eqm = __ballot(isc);
                const unsigned pre = run + __builtin_amdgcn_mbcnt_hi((unsigned)(eqm >> 32), __builtin_amdgcn_mbcnt_lo((unsigned)eqm, 0u));
                if (isc && pre < need) G |= (1u << r);
                run += (unsigned)__builtin_popcountll(eqm); }
            }
            sel_done:
#pragma unroll
            for (int r = 0; r < 32; ++r) if ((r & ~7) < nr) { const unsigned long long bal = __ballot((G >> r) & 1u); asm volatile("s_nop 4\n\tv_writelane_b32 %0, %2, %4\n\tv_writelane_b32 %1, %3, %4" : "+v"(mlo), "+v"(mhi) : "s"((unsigned)bal), "s"((unsigned)(bal >> 32)), "n"(r));     }
        }
        if (lane < nr) bits64[(tokbase + pos) * 32 + lane] = ((unsigned long long)mhi << 32) | mlo;
    }
}
__device__ __forceinline__ void dsa_index_phase(const Frame& F, const bf16_t* __restrict__ PROJ, unsigned long long* __restrict__ bits64, unsigned* stampw, bool pv = false) {
    LAS float* sc = (LAS float*)F.lds;
    LAS int* qctr = (LAS int*)(F.lds + TS_OFF);
    IdxOps P;
    int u = F.vcu;
    if (u < 4096) { dsa_index_load(P, PROJ, u & 31, u >> 5, F.lane, F.wave); dsa_index_load_k(P, PROJ, u & 31, u >> 5, F.lane, F.wave); }
#ifdef T_STAMP
    unsigned long long tA = 0, tB = 0, tC = 0, tD = 0, t0 = __builtin_amdgcn_s_memrealtime(), t1;
#define STAMP(acc) do { t1 = __builtin_amdgcn_s_memrealtime(); acc += t1 - t0; t0 = t1; } while (0)
#else
#define STAMP(acc) do { } while (0)
#endif
#pragma unroll 1
    for (; u < 4096; u += F.G) {
#if defined(IDX_PROBE) && (IDX_PROBE & 1)
        if (!pv)
#endif
        dsa_index_scores(P, PROJ, sc, u & 31, u >> 5, F.lane, F.wave);
        if (F.tid == 0) *qctr = 0;
        STAMP(tA);
        __syncthreads();
        STAMP(tB);
        const int un = u + F.G;
#if defined(IDX_PROBE) && (IDX_PROBE & 2)
        if (!pv)
#endif
        dsa_index_select(sc, qctr, bits64, u & 31, u >> 5, F.lane, F.wave);
        asm volatile("" ::: "memory");
        if (un < 4096) { dsa_index_load(P, PROJ, un & 31, un >> 5, F.lane, F.wave); dsa_index_load_k(P, PROJ, un & 31, un >> 5, F.lane, F.wave); }
        STAMP(tC);
        __syncthreads();
        STAMP(tD);
    }
#ifdef T_STAMP
    if (stampw && blockIdx.x == 17 && F.tid == 0) { const unsigned long long tot = tA + tB + tC + tD; const unsigned long long part = (T_STAMP == 0) ? tA : (T_STAMP == 1) ? tB : (T_STAMP == 2) ? tC : tD;
        *stampw = (unsigned)((part * 64ull) / (tot ? tot : 1ull)); }
#endif
#undef STAMP
}

constexpr int KS = 144, VS = 192;
#ifndef USE_TR
#define USE_TR 1
#endif
struct AttnPre { bf16x8 qf[4]; u32x4 kreg, vreg; u32x2 mreg; };
__device__ __forceinline__ void attn_decode(int u, int& b, int& g, int& qb) { const int cu = u & 255, j = u >> 8, bg = cu >> 2, s = cu & 3; qb = (j & 1) ? (8 * (j >> 1) + 7 - s) : (8 * (j >> 1) + s); b = bg >> 1; g = bg & 1; }
template <int MODE>
__device__ __forceinline__ void attn_prefetch(const Frame& F, const bf16_t* __restrict__ PROJ, const unsigned* __restrict__ bits, int b, int g, int qb, bf16x8 (&qf)[4], u32x4& kreg, u32x4& vreg, u32x2& mreg) {
    const int tid = F.tid, lane = F.lane, wid = F.wave, n = lane & 31, hi = lane >> 5;
    constexpr int CQ = MODE ? C_QB : C_QA, CK = MODE ? C_KB : C_KA, CV = MODE ? C_VB : C_VA;
    const int hq = 4 * g + (wid >> 1), qpos = qb * 64 + 32 * (wid & 1) + n;
    const size_t tokbase = (size_t)b * SEQ;
    const int kt_lo = (MODE == 0) ? (qb >= 2 ? qb - 2 : 0) : 0;
    const int srow = tid >> 3, sch = tid & 7;
    kreg = *(const u32x4*)(PROJ + (tokbase + srow + (size_t)kt_lo * 64) * PLD + CK + g * 64 + sch * 8);
    vreg = *(const u32x4*)(PROJ + (tokbase + srow + (size_t)kt_lo * 64) * PLD + CV + g * 64 + sch * 8);
    if (MODE == 1) mreg = *(const u32x2*)(bits + (tokbase + qpos) * 64 + 2 * kt_lo);
    const bf16_t* qp = PROJ + (tokbase + qpos) * PLD + CQ + hq * 64 + 8 * hi;
#pragma unroll
    for (int s = 0; s < 4; ++s) qf[s] = *(const bf16x8*)(qp + 16 * s);
}
template <int MODE>
__device__ __forceinline__ void attn_unit(const Frame& F, const bf16_t* __restrict__ PROJ, bf16_t* __restrict__ O, const unsigned* __restrict__ bits, const float* __restrict__ sinks, int b, int g, int qb, AttnPre& P, int un  ) {
    const int tid = F.tid, lane = F.lane, wid = F.wave, n = lane & 31, hi = lane >> 5;
    constexpr int CQ = MODE ? C_QB : C_QA, CK = MODE ? C_KB : C_KA, CV = MODE ? C_VB : C_VA;
    const int hq = 4 * g + (wid >> 1), qpos = qb * 64 + 32 * (wid & 1) + n;
    const size_t tokbase = (size_t)b * SEQ;
    LAS unsigned char* Ks = F.lds; LAS unsigned char* Vs = F.lds + 64 * KS;
    bf16x8 qf[4], qn[4];
#pragma unroll
    for (int s = 0; s < 4; ++s) { qf[s] = P.qf[s]; qn[s] = P.qf[s]; }
    f32x16 o0, o1;
#pragma unroll
    for (int r = 0; r < 16; ++r) { o0[r] = 0.f; o1[r] = 0.f; }
    float mrun, lsum;
    if (MODE == 0) { mrun = sinks[hq] * LOG2E; lsum = (hi == 0) ? 1.f : 0.f; } else { mrun = -1e30f; lsum = 0.f; }
    const int kt_lo = (MODE == 0) ? (qb >= 2 ? qb - 2 : 0) : 0, kt_hi = qb;
    const int srow = tid >> 3, sch = tid & 7;
    const bf16_t* kg = PROJ + (tokbase + srow) * PLD + CK + g * 64 + sch * 8;
    const bf16_t* vg = PROJ + (tokbase + srow) * PLD + CV + g * 64 + sch * 8;
    const unsigned* bp = bits + (tokbase + qpos) * 64;
    u32x4 kreg = P.kreg, vreg = P.vreg;
    u32x2 mreg = {0u, 0u};
    if (MODE == 1) mreg = P.mreg;
    const int vbase = (4 * hi + ((lane & 15) >> 2)) * VS + (16 * ((lane >> 4) & 1) + 4 * (lane & 3)) * 2;
    for (int kt = kt_lo; kt <= kt_hi; ++kt) {
        __syncthreads();
        *(LAS u32x4*)(Ks + srow * KS + sch * 16) = kreg; *(LAS u32x4*)(Vs + srow * VS + sch * 16) = vreg;
        const u32x2 mcur = mreg;
        __syncthreads();
        if (kt < kt_hi) { kreg = *(const u32x4*)(kg + (size_t)(kt + 1) * 64 * PLD); vreg = *(const u32x4*)(vg + (size_t)(kt + 1) * 64 * PLD); if (MODE == 1) mreg = *(const u32x2*)(bp + 2 * (kt + 1)); }
        else if (un < 2048) { int nb, ng, nqb; attn_decode(un, nb, ng, nqb); attn_prefetch<MODE>(F, PROJ, bits, nb, ng, nqb, qn, kreg, vreg, mreg); }
        f32x16 p0, p1;
#pragma unroll
        for (int r = 0; r < 16; ++r) { p0[r] = 0.f; p1[r] = 0.f; }
#pragma unroll
        for (int s = 0; s < 4; ++s) { const bf16x8 k0 = *(const LAS bf16x8*)(Ks + n * KS + (16 * s + 8 * hi) * 2), k1 = *(const LAS bf16x8*)(Ks + (n + 32) * KS + (16 * s + 8 * hi) * 2);
            p0 = __builtin_amdgcn_mfma_f32_32x32x16_bf16(k0, qf[s], p0, 0, 0, 0); p1 = __builtin_amdgcn_mfma_f32_32x32x16_bf16(k1, qf[s], p1, 0, 0, 0); }
        unsigned w0, w1;
        if (MODE == 1) { w0 = mcur.x >> (4 * hi); w1 = mcur.y >> (4 * hi); }
        else {
#pragma unroll
            for (int blk = 0; blk < 2; ++blk) { const int d0 = qpos - (kt * 64 + 32 * blk); unsigned mk = 0u;
                if (d0 >= 0) { const int hb = d0 > 31 ? 31 : d0; int lo = d0 - 127; if (lo <= 31) { if (lo < 0) lo = 0; mk = (0xFFFFFFFFu >> (31 - hb)) & (0xFFFFFFFFu << lo); } }
                if (blk == 0) w0 = mk >> (4 * hi); else w1 = mk >> (4 * hi); }
        }
        float mx = fmaxf(fmaxf(p0[0], p0[1]), fmaxf(p1[0], p1[1]));
#pragma unroll
        for (int r = 2; r < 16; r += 2) mx = fmaxf(mx, fmaxf(fmaxf(p0[r], p0[r + 1]), fmaxf(p1[r], p1[r + 1])));
        mx = xor32_max(mx);
        const float mnew = fmaxf(mrun, mx), alpha = fexp2(mrun - mnew); mrun = mnew;
        float ps = 0.f;
#pragma unroll
        for (int r = 0; r < 16; ++r) { const int bitpos = 8 * (r >> 2) + (r & 3);
            const float e0 = fexp2(p0[r] - mnew), e1 = fexp2(p1[r] - mnew);
            p0[r] = __builtin_bit_cast(float, __builtin_bit_cast(unsigned, e0) & (unsigned)__builtin_amdgcn_sbfe((int)w0, bitpos, 1));
            p1[r] = __builtin_bit_cast(float, __builtin_bit_cast(unsigned, e1) & (unsigned)__builtin_amdgcn_sbfe((int)w1, bitpos, 1));
            ps += p0[r] + p1[r]; }
        lsum = lsum * alpha + ps;
        if (__builtin_amdgcn_ballot_w64(alpha != 1.f) != 0ull) {
#pragma unroll
            for (int r = 0; r < 16; ++r) { o0[r] *= alpha; o1[r] *= alpha; } }
        bf16x8 pf[2][2];
#pragma unroll
        for (int s2 = 0; s2 < 2; ++s2) { u32x4 a, c;
            a.x = cvt_pk_bf16(p0[8 * s2 + 0], p0[8 * s2 + 1]); a.y = cvt_pk_bf16(p0[8 * s2 + 2], p0[8 * s2 + 3]); a.z = cvt_pk_bf16(p0[8 * s2 + 4], p0[8 * s2 + 5]); a.w = cvt_pk_bf16(p0[8 * s2 + 6], p0[8 * s2 + 7]);
            c.x = cvt_pk_bf16(p1[8 * s2 + 0], p1[8 * s2 + 1]); c.y = cvt_pk_bf16(p1[8 * s2 + 2], p1[8 * s2 + 3]); c.z = cvt_pk_bf16(p1[8 * s2 + 4], p1[8 * s2 + 5]); c.w = cvt_pk_bf16(p1[8 * s2 + 6], p1[8 * s2 + 7]);
            pf[0][s2] = __builtin_bit_cast(bf16x8, a); pf[1][s2] = __builtin_bit_cast(bf16x8, c); }
#pragma unroll
        for (int db = 0; db < 2; ++db)
#pragma unroll
            for (int blk = 0; blk < 2; ++blk)
#pragma unroll
                for (int s2 = 0; s2 < 2; ++s2) {
                    bf16x8 vf;
#if USE_TR
                    const v4i16_t t0 = __builtin_amdgcn_ds_read_tr16_b64_v4i16((LAS v4i16_t*)(Vs + vbase + (32 * blk + 16 * s2) * VS + 64 * db));
                    const v4i16_t t1 = __builtin_amdgcn_ds_read_tr16_b64_v4i16((LAS v4i16_t*)(Vs + vbase + (32 * blk + 16 * s2 + 8) * VS + 64 * db));
                    vf = (bf16x8){t0[0], t0[1], t0[2], t0[3], t1[0], t1[1], t1[2], t1[3]};
#else
#pragma unroll
                    for (int j = 0; j < 8; ++j) vf[j] = *(const LAS short*)(Vs + (32 * blk + 16 * s2 + 8 * (j >> 2) + 4 * hi + (j & 3)) * VS + (32 * db + n) * 2);
#endif
                    if (db == 0) o0 = __builtin_amdgcn_mfma_f32_32x32x16_bf16(vf, pf[blk][s2], o0, 0, 0, 0); else o1 = __builtin_amdgcn_mfma_f32_32x32x16_bf16(vf, pf[blk][s2], o1, 0, 0, 0);
                }
    }
    const float lt = xor32_add(lsum), inv = 1.f / lt;
    bf16_t* op = O + (tokbase + qpos) * 512 + hq * 64 + 8 * hi;
#pragma unroll
    for (int db = 0; db < 2; ++db)
#pragma unroll
        for (int kp = 0; kp < 2; ++kp) { const int r0 = 8 * kp;
            unsigned ax, ay, bx, by;
            if (db == 0) { ax = cvt_pk_bf16(o0[r0] * inv, o0[r0 + 1] * inv); ay = cvt_pk_bf16(o0[r0 + 2] * inv, o0[r0 + 3] * inv); bx = cvt_pk_bf16(o0[r0 + 4] * inv, o0[r0 + 5] * inv); by = cvt_pk_bf16(o0[r0 + 6] * inv, o0[r0 + 7] * inv); }
            else { ax = cvt_pk_bf16(o1[r0] * inv, o1[r0 + 1] * inv); ay = cvt_pk_bf16(o1[r0 + 2] * inv, o1[r0 + 3] * inv); bx = cvt_pk_bf16(o1[r0 + 4] * inv, o1[r0 + 5] * inv); by = cvt_pk_bf16(o1[r0 + 6] * inv, o1[r0 + 7] * inv); }
            { auto r = __builtin_amdgcn_permlane32_swap(ax, bx, false, false); ax = r[0]; bx = r[1]; }
            { auto r = __builtin_amdgcn_permlane32_swap(ay, by, false, false); ay = r[0]; by = r[1]; }
            *(u32x4*)(op + 32 * db + 16 * kp) = (u32x4){ax, ay, bx, by}; }
#pragma unroll
    for (int s = 0; s < 4; ++s) P.qf[s] = qn[s];
    P.kreg = kreg; P.vreg = vreg; P.mreg = mreg;
}

struct SwaPre { bf16x8 qf[4]; u32x4 kreg[3], vreg[3]; };
__device__ __forceinline__ void swa_prefetch(const Frame& F, const bf16_t* __restrict__ PROJ, int b, int g, int qb, bf16x8 (&qf)[4], u32x4 (&kreg)[3], u32x4 (&vreg)[3]) {
    const int tid = F.tid, lane = F.lane, wid = F.wave, n = lane & 31, hi = lane >> 5;
    const int hq = 4 * g + (wid >> 1), qpos = qb * 64 + 32 * (wid & 1) + n;
    const size_t tokbase = (size_t)b * SEQ;
    const int srow = tid >> 3, sch = tid & 7;
#pragma unroll
    for (int i = 0; i < 3; ++i) { const int kt = qb - 2 + i;
        if (kt >= 0) { kreg[i] = *(const u32x4*)(PROJ + (tokbase + srow + (size_t)kt * 64) * PLD + C_KA + g * 64 + sch * 8); vreg[i] = *(const u32x4*)(PROJ + (tokbase + srow + (size_t)kt * 64) * PLD + C_VA + g * 64 + sch * 8); } }
    const bf16_t* qp = PROJ + (tokbase + qpos) * PLD + C_QA + hq * 64 + 8 * hi;
#pragma unroll
    for (int s = 0; s < 4; ++s) qf[s] = *(const bf16x8*)(qp + 16 * s);
}
__device__ __forceinline__ void swa_unit(const Frame& F, const bf16_t* __restrict__ PROJ, bf16_t* __restrict__ O, const float* __restrict__ sinks, int b, int g, int qb, SwaPre& P, int un  , bool pv = false) {
    const int tid = F.tid, lane = F.lane, wid = F.wave, n = lane & 31, hi = lane >> 5;
    const int hq = 4 * g + (wid >> 1), qpos = qb * 64 + 32 * (wid & 1) + n;
    const size_t tokbase = (size_t)b * SEQ;
    constexpr int TILE_B = 64 * KS + 64 * VS;
    bf16x8 qf[4], qn[4];
#pragma unroll
    for (int s = 0; s < 4; ++s) { qf[s] = P.qf[s]; qn[s] = P.qf[s]; }
    f32x16 o0, o1;
#pragma unroll
    for (int r = 0; r < 16; ++r) { o0[r] = 0.f; o1[r] = 0.f; }
    float mrun = sinks[hq] * LOG2E, lsum = (hi == 0) ? 1.f : 0.f;
    const int srow = tid >> 3, sch = tid & 7;
    __syncthreads();
#pragma unroll
    for (int i = 0; i < 3; ++i) if (qb - 2 + i >= 0) { *(LAS u32x4*)(F.lds + i * TILE_B + srow * KS + sch * 16) = P.kreg[i]; *(LAS u32x4*)(F.lds + i * TILE_B + 64 * KS + srow * VS + sch * 16) = P.vreg[i]; }
    __syncthreads();
    if (un < 2048) { int nb, ng, nqb; attn_decode(un, nb, ng, nqb); swa_prefetch(F, PROJ, nb, ng, nqb, qn, P.kreg, P.vreg); }
    const int vbase = (4 * hi + ((lane & 15) >> 2)) * VS + (16 * ((lane >> 4) & 1) + 4 * (lane & 3)) * 2;
#pragma unroll 1
#if defined(IDX_PROBE) && (IDX_PROBE & 32)
    if (!pv)
#endif
    for (int i = (qb >= 2 ? 0 : 2 - qb); i < 3; ++i) { const int kt = qb - 2 + i;
        LAS unsigned char* Ks = F.lds + i * TILE_B; LAS unsigned char* Vs = Ks + 64 * KS;
        f32x16 p0, p1;
#pragma unroll
        for (int r = 0; r < 16; ++r) { p0[r] = 0.f; p1[r] = 0.f; }
#pragma unroll
        for (int s = 0; s < 4; ++s) { const bf16x8 k0 = *(const LAS bf16x8*)(Ks + n * KS + (16 * s + 8 * hi) * 2), k1 = *(const LAS bf16x8*)(Ks + (n + 32) * KS + (16 * s + 8 * hi) * 2);
            p0 = __builtin_amdgcn_mfma_f32_32x32x16_bf16(k0, qf[s], p0, 0, 0, 0); p1 = __builtin_amdgcn_mfma_f32_32x32x16_bf16(k1, qf[s], p1, 0, 0, 0); }
        unsigned w0 = 0u, w1 = 0u;
#pragma unroll
        for (int blk = 0; blk < 2; ++blk) { const int d0 = qpos - (kt * 64 + 32 * blk); unsigned mk = 0u;
            if (d0 >= 0) { const int hb = d0 > 31 ? 31 : d0; int lo = d0 - 127; if (lo <= 31) { if (lo < 0) lo = 0; mk = (0xFFFFFFFFu >> (31 - hb)) & (0xFFFFFFFFu << lo); } }
            if (blk == 0) w0 = mk >> (4 * hi); else w1 = mk >> (4 * hi); }
        float mx = fmaxf(fmaxf(p0[0], p0[1]), fmaxf(p1[0], p1[1]));
#pragma unroll
        for (int r = 2; r < 16; r += 2) mx = fmaxf(mx, fmaxf(fmaxf(p0[r], p0[r + 1]), fmaxf(p1[r], p1[r + 1])));
        mx = xor32_max(mx);
        const float mnew = fmaxf(mrun, mx), alpha = fexp2(mrun - mnew); mrun = mnew;
        float ps = 0.f;
#pragma unroll
        for (int r = 0; r < 16; ++r) { const int bitpos = 8 * (r >> 2) + (r & 3);
            const float e0 = fexp2(p0[r] - mnew), e1 = fexp2(p1[r] - mnew);
            p0[r] = __builtin_bit_cast(float, __builtin_bit_cast(unsigned, e0) & (unsigned)__builtin_amdgcn_sbfe((int)w0, bitpos, 1));
            p1[r] = __builtin_bit_cast(float, __builtin_bit_cast(unsigned, e1) & (unsigned)__builtin_amdgcn_sbfe((int)w1, bitpos, 1));
            ps += p0[r] + p1[r]; }
        lsum = lsum * alpha + ps;
        if (__builtin_amdgcn_ballot_w64(alpha != 1.f) != 0ull) {
#pragma unroll
            for (int r = 0; r < 16; ++r) { o0[r] *= alpha; o1[r] *= alpha; } }
        bf16x8 pf[2][2];
#pragma unroll
        for (int s2 = 0; s2 < 2; ++s2) { u32x4 a, c;
            a.x = cvt_pk_bf16(p0[8 * s2 + 0], p0[8 * s2 + 1]); a.y = cvt_pk_bf16(p0[8 * s2 + 2], p0[8 * s2 + 3]); a.z = cvt_pk_bf16(p0[8 * s2 + 4], p0[8 * s2 + 5]); a.w = cvt_pk_bf16(p0[8 * s2 + 6], p0[8 * s2 + 7]);
            c.x = cvt_pk_bf16(p1[8 * s2 + 0], p1[8 * s2 + 1]); c.y = cvt_pk_bf16(p1[8 * s2 + 2], p1[8 * s2 + 3]); c.z = cvt_pk_bf16(p1[8 * s2 + 4], p1[8 * s2 + 5]); c.w = cvt_pk_bf16(p1[8 * s2 + 6], p1[8 * s2 + 7]);
            pf[0][s2] = __builtin_bit_cast(bf16x8, a); pf[1][s2] = __builtin_bit_cast(bf16x8, c); }
#pragma unroll
        for (int db = 0; db < 2; ++db)
#pragma unroll
            for (int blk = 0; blk < 2; ++blk)
#pragma unroll
                for (int s2 = 0; s2 < 2; ++s2) {
                    const v4i16_t t0 = __builtin_amdgcn_ds_read_tr16_b64_v4i16((LAS v4i16_t*)(Vs + vbase + (32 * blk + 16 * s2) * VS + 64 * db));
                    const v4i16_t t1 = __builtin_amdgcn_ds_read_tr16_b64_v4i16((LAS v4i16_t*)(Vs + vbase + (32 * blk + 16 * s2 + 8) * VS + 64 * db));
                    const bf16x8 vf = (bf16x8){t0[0], t0[1], t0[2], t0[3], t1[0], t1[1], t1[2], t1[3]};
                    if (db == 0) o0 = __builtin_amdgcn_mfma_f32_32x32x16_bf16(vf, pf[blk][s2], o0, 0, 0, 0); else o1 = __builtin_amdgcn_mfma_f32_32x32x16_bf16(vf, pf[blk][s2], o1, 0, 0, 0);
                }
    }
    const float lt = xor32_add(lsum), inv = 1.f / lt;
    bf16_t* op = O + (tokbase + qpos) * 512 + hq * 64 + 8 * hi;
#pragma unroll
    for (int db = 0; db < 2; ++db)
#pragma unroll
        for (int kp = 0; kp < 2; ++kp) { const int r0 = 8 * kp;
            unsigned ax, ay, bx, by;
            if (db == 0) { ax = cvt_pk_bf16(o0[r0] * inv, o0[r0 + 1] * inv); ay = cvt_pk_bf16(o0[r0 + 2] * inv, o0[r0 + 3] * inv); bx = cvt_pk_bf16(o0[r0 + 4] * inv, o0[r0 + 5] * inv); by = cvt_pk_bf16(o0[r0 + 6] * inv, o0[r0 + 7] * inv); }
            else { ax = cvt_pk_bf16(o1[r0] * inv, o1[r0 + 1] * inv); ay = cvt_pk_bf16(o1[r0 + 2] * inv, o1[r0 + 3] * inv); bx = cvt_pk_bf16(o1[r0 + 4] * inv, o1[r0 + 5] * inv); by = cvt_pk_bf16(o1[r0 + 6] * inv, o1[r0 + 7] * inv); }
            { auto r = __builtin_amdgcn_permlane32_swap(ax, bx, false, false); ax = r[0]; bx = r[1]; }
            { auto r = __builtin_amdgcn_permlane32_swap(ay, by, false, false); ay = r[0]; by = r[1]; }
            *(u32x4*)(op + 32 * db + 16 * kp) = (u32x4){ax, ay, bx, by}; }
#pragma unroll
    for (int s = 0; s < 4; ++s) P.qf[s] = qn[s];
}

constexpr int SGS = 1040;
static_assert(128 * SGS <= MISC_OFF, "spatial-gating tile vs LDS control words");
__device__ __forceinline__ void sg_unit(const Frame& F, const bf16_t* __restrict__ PROJ, const bf16_t* __restrict__ SGWl, const float* __restrict__ sgb, const float* __restrict__ lng, bf16_t* __restrict__ OC, int b, int ch) {
    const int lane = F.lane, wid = F.wave, n = lane & 31, hi = lane >> 5;
    const size_t tok0 = (size_t)b * SEQ + ch * 128;
    LAS unsigned char* V = F.lds;
    __syncthreads();
    float gl[8];
    { const f32x4 g0 = *(const f32x4*)(lng + 8 * lane), g1 = *(const f32x4*)(lng + 8 * lane + 4); gl[0] = g0[0]; gl[1] = g0[1]; gl[2] = g0[2]; gl[3] = g0[3]; gl[4] = g1[0]; gl[5] = g1[1]; gl[6] = g1[2]; gl[7] = g1[3]; }
    u32x4 wrow16[16];
#pragma unroll
    for (int rr = 0; rr < 16; ++rr) wrow16[rr] = *(const u32x4*)(PROJ + (tok0 + 16 * wid + rr) * PLD + C_V + 8 * lane);
#pragma unroll
    for (int rr = 0; rr < 16; ++rr) { const int row = 16 * wid + rr;
        const u32x4 w = wrow16[rr];
        float x[8] = {bf_lo(w.x), bf_hi(w.x), bf_lo(w.y), bf_hi(w.y), bf_lo(w.z), bf_hi(w.z), bf_lo(w.w), bf_hi(w.w)};
        float s = 0.f;
#pragma unroll
        for (int i = 0; i < 8; ++i) s += x[i];
        const float mean = wave_sum(s) * (1.f / 512.f); float q = 0.f;
#pragma unroll
        for (int i = 0; i < 8; ++i) { x[i] -= mean; q += x[i] * x[i]; }
        const float rstd = 1.f / sqrtf(wave_sum(q) * (1.f / 512.f) + LN_EPS);
        u32x4 o; o.x = cvt_pk_bf16(x[0] * rstd * gl[0], x[1] * rstd * gl[1]); o.y = cvt_pk_bf16(x[2] * rstd * gl[2], x[3] * rstd * gl[3]);
        o.z = cvt_pk_bf16(x[4] * rstd * gl[4], x[5] * rstd * gl[5]); o.w = cvt_pk_bf16(x[6] * rstd * gl[6], x[7] * rstd * gl[7]);
        *(LAS u32x4*)(V + row * SGS + 16 * lane) = o; }
    __syncthreads();
    const int g = wid;
    const int vbase = (8 * hi + ((lane & 15) >> 2)) * SGS + (g * 64 + 16 * ((lane >> 4) & 1) + 4 * (lane & 3)) * 2;
    const bf16_t* wg = SGWl + (size_t)g * 128 * 128;
#pragma unroll 1
    for (int tb = 0; tb < 4; ++tb) {
        f32x16 a0, a1;
#pragma unroll
        for (int r = 0; r < 16; ++r) { a0[r] = 0.f; a1[r] = 0.f; }
        const bf16_t* wrow = wg + (size_t)(32 * tb + n) * 128 + 8 * hi;
        bf16x8 afr[8];
#pragma unroll
        for (int ks = 0; ks < 8; ++ks) if (ks < 2 * tb + 2) afr[ks] = *(const bf16x8*)(wrow + 16 * ks);
        const int t = 32 * tb + n;
        const float bb = sgb[g * 128 + t];
        u32x2 uu[2][4];
        { const bf16_t* up = PROJ + (tok0 + t) * PLD + C_U + g * 64 + 4 * hi;
#pragma unroll
          for (int db = 0; db < 2; ++db)
#pragma unroll
              for (int q4 = 0; q4 < 4; ++q4) uu[db][q4] = *(const u32x2*)(up + 32 * db + 8 * q4); }
#pragma unroll
        for (int ks = 0; ks < 8; ++ks) if (ks < 2 * tb + 2) {
            const bf16x8 af = afr[ks];
#pragma unroll
            for (int db = 0; db < 2; ++db) { bf16x8 vf;
#if USE_TR
                const v4i16_t t0 = __builtin_amdgcn_ds_read_tr16_b64_v4i16((LAS v4i16_t*)(V + vbase + (16 * ks) * SGS + 64 * db));
                const v4i16_t t1 = __builtin_amdgcn_ds_read_tr16_b64_v4i16((LAS v4i16_t*)(V + vbase + (16 * ks + 4) * SGS + 64 * db));
                vf = (bf16x8){t0[0], t0[1], t0[2], t0[3], t1[0], t1[1], t1[2], t1[3]};
#else
#pragma unroll
                for (int j = 0; j < 8; ++j) vf[j] = *(const LAS short*)(V + (16 * ks + 8 * hi + j) * SGS + (g * 64 + 32 * db + n) * 2);
#endif
                if (db == 0) a0 = __builtin_amdgcn_mfma_f32_32x32x16_bf16(vf, af, a0, 0, 0, 0); else a1 = __builtin_amdgcn_mfma_f32_32x32x16_bf16(vf, af, a1, 0, 0, 0); }
        }
        bf16_t* op = OC + (tok0 + t) * 512 + g * 64 + 8 * hi;
#pragma unroll
        for (int db = 0; db < 2; ++db)
#pragma unroll
            for (int kp = 0; kp < 2; ++kp) { const int r0 = 8 * kp; float v[8];
#pragma unroll
                for (int i = 0; i < 8; ++i) { const u32x2 uw = uu[db][2 * kp + (i >> 2)]; const unsigned wd = (i & 2) ? uw.y : uw.x; const float uf = (i & 1) ? bf_hi(wd) : bf_lo(wd);
                    v[i] = ((db == 0 ? a0[r0 + i] : a1[r0 + i]) + bb) * uf; }
                unsigned ax = cvt_pk_bf16(v[0], v[1]), ay = cvt_pk_bf16(v[2], v[3]), bx = cvt_pk_bf16(v[4], v[5]), by = cvt_pk_bf16(v[6], v[7]);
                { auto r = __builtin_amdgcn_permlane32_swap(ax, bx, false, false); ax = r[0]; bx = r[1]; }
                { auto r = __builtin_amdgcn_permlane32_swap(ay, by, false, false); ay = r[0]; by = r[1]; }
                *(u32x4*)(op + 32 * db + 16 * kp) = (u32x4){ax, ay, bx, by}; }
    }
}
constexpr int HS_STRIDE = 2064;
constexpr int P7_PART = 32 * HS_STRIDE;
constexpr int P7_LOG = P7_PART + 8 * 4096;
constexpr int P7_HIST = P7_LOG + 32 * 33 * 4;
__device__ __forceinline__ void p7_route(const Frame& F, const Args& a, int l, bf16_t* X16  , const bf16_t* Y, const float* SSP, const float* MODl, signed char* H8, float* RS,
                                         const bf16_t* WRTl, unsigned* cnt, int* ROWTOK, unsigned* TOKINFO) {
    const int tid = F.tid, lane = F.lane, wid = F.wave, n = lane & 31, hi = lane >> 5;
    const float* g_post = a.in[5] + l * DM; const float* g_pre = a.in[6] + l * DM; const float* b_router = a.in[16] + l * NE;
    LAS unsigned char* hs = F.lds; LAS float* part = (LAS float*)(F.lds + P7_PART); LAS float* lg = (LAS float*)(F.lds + P7_LOG); LAS int* hist = (LAS int*)(F.lds + P7_HIST); LAS int* base = hist + 32;
    if (tid < 32) hist[tid] = 0;
    __syncthreads();
    const int NBT = MTOK / 32, bt0 = (int)((long)NBT * F.vcu / F.G), bt1 = (int)((long)NBT * (F.vcu + 1) / F.G);
    bf16x8 wbf[8];
#pragma unroll
    for (int ks = 0; ks < 8; ++ks) wbf[ks] = *(const bf16x8*)(WRTl + (size_t)n * DM + (8 * wid + ks) * 16 + 8 * hi);
    const float brv = b_router[tid & 31];
    f32x4 A1[4], A2[4], A3[4]; int bcur = (bt0 < NBT ? bt0 : NBT - 1) >> 6;
#define P7_PARAMS(b_) do { const float* mb_ = MODl + (size_t)(b_) * 6 * DM; _Pragma("unroll") for (int j = 0; j < 4; ++j) { const int c = 4 * lane + 256 * j; \
        const f32x4 gp = *(const f32x4*)(g_post + c), ga = *(const f32x4*)(mb_ + 2 * DM + c), gg = *(const f32x4*)(g_pre + c), s1 = *(const f32x4*)(mb_ + 4 * DM + c), s0 = *(const f32x4*)(mb_ + 3 * DM + c); \
        A1[j] = ga * gp; A2[j] = gg * (s1 + 1.f); A3[j] = s0; } } while (0)
    P7_PARAMS(bcur);
    u32x2 yv[4][4], xv[4][4]; float s4v[4];
#define P7_LOAD(bt_) do { _Pragma("unroll") for (int rr = 0; rr < 4; ++rr) { const size_t row = (size_t)(bt_) * 32 + 4 * wid + rr; s4v[rr] = SSP[(size_t)(lane & 15) * MTOK + row]; \
        _Pragma("unroll") for (int j = 0; j < 4; ++j) { const int c = 4 * lane + 256 * j; yv[rr][j] = __builtin_nontemporal_load((const u32x2*)(Y + row * DM + c)); xv[rr][j] = __builtin_nontemporal_load((const u32x2*)(X16 + row * DM + c)); } } } while (0)
    P7_LOAD(bt0 < NBT ? bt0 : NBT - 1);
    for (int bt = bt0; bt < bt1; ++bt) {
        const int row0 = bt * 32, b = row0 >> 11;
        if (b != bcur) { bcur = b; P7_PARAMS(b); }
#pragma unroll
        for (int rr = 0; rr < 4; ++rr) { const int rl = 4 * wid + rr; const size_t row = (size_t)row0 + rl;
            float ssy = s4v[rr]; ssy += dpp_f<0xB1>(ssy); ssy += dpp_f<0x4E>(ssy); ssy += dpp_f<0x141>(ssy); ssy += dpp_f<0x140>(ssy);
            const float rstd1 = 1.f / sqrtf(ssy * (1.f / DM) + RMS_EPS);
            f32x4 v[4]; float ss = 0.f;
#pragma unroll
            for (int j = 0; j < 4; ++j) { const int c = 4 * lane + 256 * j; const u32x2 yw_ = yv[rr][j]; const u32x2 xw_ = xv[rr][j]; const f32x4 yy = {bf_lo(yw_.x), bf_hi(yw_.x), bf_lo(yw_.y), bf_hi(yw_.y)}, xx = {bf_lo(xw_.x), bf_hi(xw_.x), bf_lo(xw_.y), bf_hi(xw_.y)};
                v[j] = xx + A1[j] * (yy * rstd1); { u32x2 xo; xo.x = cvt_pk_bf16(v[j][0], v[j][1]); xo.y = cvt_pk_bf16(v[j][2], v[j][3]); *(u32x2*)(X16 + row * DM + c) = xo; }
                ss += (v[j][0] * v[j][0] + v[j][1] * v[j][1]) + (v[j][2] * v[j][2] + v[j][3] * v[j][3]); }
            ss = wave_sum(ss);
            const float rstd = 1.f / sqrtf(ss * (1.f / DM) + RMS_EPS);
            f32x4 o[4]; float am = 0.f;
#pragma unroll
            for (int j = 0; j < 4; ++j) { const int c = 4 * lane + 256 * j;
                o[j] = (v[j] * rstd) * A2[j] + A3[j]; u32x2 w; w.x = cvt_pk_bf16(o[j][0], o[j][1]); w.y = cvt_pk_bf16(o[j][2], o[j][3]);
                *(LAS u32x2*)(hs + rl * HS_STRIDE + c * 2) = w;
                am = fmaxf(am, fmaxf(fmaxf(fabsf(o[j][0]), fabsf(o[j][1])), fmaxf(fabsf(o[j][2]), fabsf(o[j][3])))); }
            am = wave_max(am);
            const float scale = fmaxf(am, 1e-30f) * (1.f / 127.f), inv = 1.f / scale;
            if (lane == 0) RS[row] = scale;
#pragma unroll
            for (int j = 0; j < 4; ++j) *(unsigned*)(H8 + row * DM + 4 * lane + 256 * j) = q8x4(o[j][0], o[j][1], o[j][2], o[j][3], inv); }
        if (bt + 1 < bt1) P7_LOAD(bt + 1);
        lds_barrier();
        {
            f32x16 d;
#pragma unroll
            for (int r = 0; r < 16; ++r) d[r] = 0.f;
#pragma unroll
            for (int ks = 0; ks < 8; ++ks) { const int k0 = (8 * wid + ks) * 16 + 8 * hi;
                const bf16x8 af = *(const LAS bf16x8*)(hs + n * HS_STRIDE + k0 * 2);
                d = __builtin_amdgcn_mfma_f32_32x32x16_bf16(af, wbf[ks], d, 0, 0, 0); }
#pragma unroll
            for (int r = 0; r < 16; ++r) part[wid * 1024 + (8 * (r >> 2) + 4 * hi + (r & 3)) * 32 + n] = d[r];
        }
        lds_barrier();
        for (int i = tid; i < 1024; i += 512) { float s = brv;
#pragma unroll
            for (int w = 0; w < 8; ++w) s += part[w * 1024 + i]; lg[(i >> 5) * 33 + (i & 31)] = s; }
        lds_barrier();
        int e_k[4] = {0, 0, 0, 0}, lp_k[4] = {0, 0, 0, 0}; float w_k[4] = {0.f, 0.f, 0.f, 0.f};
        if (tid < 32) { LAS float* mylg = lg + tid * 33; float tl[4];
#pragma unroll
            for (int k = 0; k < 4; ++k) { float best = -INFINITY; int bi = 0;
                for (int e = 0; e < 32; ++e) { const float vv = mylg[e]; if (vv > best) { best = vv; bi = e; } }
                tl[k] = best; e_k[k] = bi; mylg[bi] = -INFINITY; }
            float sum = 0.f;
#pragma unroll
            for (int k = 0; k < 4; ++k) { w_k[k] = __expf(tl[k] - tl[0]); sum += w_k[k]; }
            const float inv = 1.f / sum;
#pragma unroll
            for (int k = 0; k < 4; ++k) { w_k[k] *= inv; lp_k[k] = __hip_atomic_fetch_add(&hist[e_k[k]], 1, __ATOMIC_RELAXED, __HIP_MEMORY_SCOPE_WORKGROUP); } }
        lds_barrier();
        if (tid < 32) { const int hc = hist[tid]; base[tid] = hc > 0 ? (int)__hip_atomic_fetch_add(cnt + 64 * tid, (unsigned)hc, __ATOMIC_RELAXED, __HIP_MEMORY_SCOPE_AGENT) : 0; hist[tid] = 0; }
        lds_barrier();
        if (tid < 32) { const int token = row0 + tid; u32x4 info; f32x4 ww;
#pragma unroll
            for (int k = 0; k < 4; ++k) { const int pos = base[e_k[k]] + lp_k[k]; ROWTOK[e_k[k] * 65536 + pos] = token; info[k] = ((unsigned)e_k[k] << 17) | (unsigned)pos; ww[k] = w_k[k]; }
            *(u32x4*)(TOKINFO + (size_t)token * 8) = info; *(f32x4*)(TOKINFO + (size_t)token * 8 + 4) = ww; }
        lds_barrier();
    }
#undef P7_PARAMS
#undef P7_LOAD
}

__device__ __forceinline__ int moe_tables(const Frame& F, unsigned* cnt) {
    LAS int* ts = (LAS int*)(F.lds + TS_OFF); LAS int* te = (LAS int*)(F.lds + TILE_E_OFF);
    __syncthreads();
    if (F.tid == 0) { int acc = 0; for (int e = 0; e < NE; ++e) { ts[e] = acc; const unsigned c = __hip_atomic_load(cnt + 64 * e, __ATOMIC_RELAXED, __HIP_MEMORY_SCOPE_AGENT); acc += (int)((c + 255u) >> 8); } ts[NE] = acc; }
    __syncthreads();
    const int RT = ts[NE];
    for (int rt = F.tid; rt < RT; rt += 512) { int e = 0;
#pragma unroll 1
        for (int q = 1; q < NE; ++q) e += (ts[q] <= rt) ? 1 : 0;
        te[rt] = e; }
    __syncthreads();
    return RT;
}

__device__ __forceinline__ void p10_combine(const Frame& F, const Args& a, int l, bf16_t* X16, float* out, const bf16_t* Y2, const unsigned* TOKINFO, const float* MODbase, signed char* H8, float* RS) {
    const int lane = F.lane; const LAS int* ts = (const LAS int*)(F.lds + TS_OFF);
    const float* g_postf = a.in[7] + l * DM;
    const int gw = F.vcu * 8 + F.wave, NGW = F.G * 8;
    const int r_lo = (int)((long)(MTOK / 2) * gw / NGW) * 2, r_hi = (int)((long)(MTOK / 2) * (gw + 1) / NGW) * 2;
    f32x4 A1[4], N2[4], N3[4]; int bcur = (r_lo < MTOK ? r_lo : MTOK - 1) >> 11;
#define P10_PARAMS(b_) do { const float* mb_ = MODbase + ((size_t)l * BATCH + (b_)) * 6 * DM; const float* mb1_ = MODbase + ((size_t)(l + 1 < DEPTH ? l + 1 : l) * BATCH + (b_)) * 6 * DM; const float* g1_ = a.in[4] + (l + 1 < DEPTH ? l + 1 : l) * DM; \
        _Pragma("unroll") for (int j = 0; j < 4; ++j) { const int c = 4 * lane + 256 * j; const f32x4 gp = *(const f32x4*)(g_postf + c), ga = *(const f32x4*)(mb_ + 5 * DM + c); A1[j] = ga * gp; \
            const f32x4 gg = *(const f32x4*)(g1_ + c), s1 = *(const f32x4*)(mb1_ + DM + c), s0 = *(const f32x4*)(mb1_ + c); N2[j] = gg * (s1 + 1.f); N3[j] = s0; } } while (0)
    P10_PARAMS(bcur);
    for (int rowp = r_lo; rowp < r_hi; rowp += 2) {
        if ((rowp >> 11) != bcur) { bcur = rowp >> 11; P10_PARAMS(bcur); }
        u32x4 info[2]; f32x4 ww[2]; u32x2 yw[2][4][4], xv[2][4];
#pragma unroll
        for (int rr = 0; rr < 2; ++rr) { info[rr] = *(const u32x4*)(TOKINFO + (size_t)(rowp + rr) * 8); ww[rr] = *(const f32x4*)(TOKINFO + (size_t)(rowp + rr) * 8 + 4); }
#pragma unroll
        for (int rr = 0; rr < 2; ++rr) {
#pragma unroll
            for (int k = 0; k < 4; ++k) { const int e = (int)(info[rr][k] >> 17), pos = (int)(info[rr][k] & 0x1ffffu); const size_t slot = (size_t)ts[e] * 256 + pos;
#pragma unroll
                for (int j = 0; j < 4; ++j) yw[rr][k][j] = __builtin_nontemporal_load((const u32x2*)(Y2 + slot * DM + 4 * lane + 256 * j)); }
#pragma unroll
            for (int j = 0; j < 4; ++j) xv[rr][j] = *(const u32x2*)(X16 + (size_t)(rowp + rr) * DM + 4 * lane + 256 * j); }
#pragma unroll
        for (int rr = 0; rr < 2; ++rr) { const int row = rowp + rr, b = row >> 11;
        f32x4 y[4];
#pragma unroll
        for (int j = 0; j < 4; ++j) y[j] = (f32x4){0.f, 0.f, 0.f, 0.f};
#pragma unroll
        for (int k = 0; k < 4; ++k) { const float wk = ww[rr][k];
#pragma unroll
            for (int j = 0; j < 4; ++j) { const u32x2 w = yw[rr][k][j];
                y[j][0] += wk * bf_lo(w.x); y[j][1] += wk * bf_hi(w.x); y[j][2] += wk * bf_lo(w.y); y[j][3] += wk * bf_hi(w.y); } }
        float ss = 0.f;
#pragma unroll
        for (int j = 0; j < 4; ++j) ss += (y[j][0] * y[j][0] + y[j][1] * y[j][1]) + (y[j][2] * y[j][2] + y[j][3] * y[j][3]);
        ss = wave_sum(ss);
        const float rstd = 1.f / sqrtf(ss * (1.f / DM) + RMS_EPS);
        f32x4 v[4]; float s2 = 0.f;
#pragma unroll
        for (int j = 0; j < 4; ++j) { const int c = 4 * lane + 256 * j; const u32x2 xw_ = xv[rr][j]; const f32x4 xx = {bf_lo(xw_.x), bf_hi(xw_.x), bf_lo(xw_.y), bf_hi(xw_.y)};
            v[j] = xx + A1[j] * (y[j] * rstd);
#ifdef T_STAMP
            if (l + 1 == DEPTH) v[j] = v[j] * (1.f + (float)(*((const unsigned*)MODbase - (1u << 18) + 100)) * (1.f / 256.f));
#endif
            if (l + 1 < DEPTH) { u32x2 xo; xo.x = cvt_pk_bf16(v[j][0], v[j][1]); xo.y = cvt_pk_bf16(v[j][2], v[j][3]); *(u32x2*)(X16 + (size_t)row * DM + c) = xo; }
            else *(f32x4*)(out + (size_t)row * DM + c) = v[j];
            s2 += (v[j][0] * v[j][0] + v[j][1] * v[j][1]) + (v[j][2] * v[j][2] + v[j][3] * v[j][3]); }
        if (l + 1 < DEPTH) { s2 = wave_sum(s2);
            const float rstd2 = 1.f / sqrtf(s2 * (1.f / DM) + RMS_EPS); f32x4 o[4]; float am = 0.f;
#pragma unroll
            for (int j = 0; j < 4; ++j) { o[j] = (v[j] * rstd2) * N2[j] + N3[j]; am = fmaxf(am, fmaxf(fmaxf(fabsf(o[j][0]), fabsf(o[j][1])), fmaxf(fabsf(o[j][2]), fabsf(o[j][3])))); }
            am = wave_max(am);
            const float scale = fmaxf(am, 1e-30f) * (1.f / 127.f), inv = 1.f / scale;
            if (lane == 0) RS[row] = scale;
#pragma unroll
            for (int j = 0; j < 4; ++j) *(unsigned*)(H8 + (size_t)row * DM + 4 * lane + 256 * j) = q8x4(o[j][0], o[j][1], o[j][2], o[j][3], inv); }
        }
    }
#undef P10_PARAMS
}
#ifndef MK_ONE_LAUNCH
#define MK_ONE_LAUNCH 1
#endif
constexpr int N_PHASES = 2 + 9 * DEPTH;
__global__ void __launch_bounds__(512, 2) fwd(Args args) {
    extern __shared__ __attribute__((aligned(16))) unsigned char lds_raw[];
    Frame F0;
    F0.lds = (LAS unsigned char*)lds_raw;
    F0.tid = threadIdx.x; F0.lane = F0.tid & 63; F0.wave = __builtin_amdgcn_readfirstlane(F0.tid >> 6);
    F0.G = gridDim.x; { const int bx = blockIdx.x; F0.vcu = (F0.G % 8 == 0) ? (bx % 8) * (F0.G / 8) + bx / 8 : bx; }
    volatile LAS unsigned* MISC = (volatile LAS unsigned*)(F0.lds + MISC_OFF);
    for (int u = F0.tid; u < 128; u += 512) MISC[u] = 0u;
    __syncthreads();
    unsigned* ctl = (unsigned*)(args.ws + WS_CTL);
    const int lo = args.ph_lo, hi = args.ph_hi;
    XcdBarrier bar; bar.bar = ctl + CW_BAR; bar.x = 0; bar.st = nullptr; bar.w = F0.wave;
    if (hi - lo > 1) bar = xcd_barrier_post(ctl + CW_BAR, MISC + 8, F0.wave);
#ifndef PHASE_MASK
#define PHASE_MASK 0x7ff
#endif
#define PHON(j) ((PHASE_MASK >> (j)) & 1)
#ifndef REPEAT_MASK
#define REPEAT_MASK 0
#endif
#define REP(j) for (int rep_ = 0; rep_ <= ((REPEAT_MASK >> (j)) & 1); ++rep_)
#define IN(k) (lo <= (k) && (k) < hi)
#define BOTH(k) (IN(k) && IN((k) + 1))
#define GRID_BAR() xcd_barrier(bar)
#define PH_BEGIN() const Frame F = phase_frame(F0); unsigned char* ws = opq(args.ws); (void)ws
    if (PHON(0) && IN(0)) REP(0) { PH_BEGIN(); p0_mod(F, args.in[1], args.in[2], args.in[3], (float*)(ws + WS_MOD)); p0_weights(F, args); if (BOTH(0)) GRID_BAR(); }
    if (PHON(1) && IN(1)) REP(1) { PH_BEGIN(); p1_norm(F, args.in[0], args.in[4], (const float*)(ws + WS_MOD), (signed char*)(ws + WS_H), (float*)(ws + WS_RS), (bf16_t*)(ws + WS_X)); if (BOTH(1)) GRID_BAR(); }

#pragma unroll 1
#ifndef EXTRA_PHASE
#define EXTRA_PHASE (-1)
#endif
#ifdef SKIP_EPI_PROBE
#define SKIPV ex_
#else
#define SKIPV false
#endif
#ifndef STAG_MASK
#define STAG_MASK 0
#endif
#ifndef STAG_TICKS
#define STAG_TICKS 240
#endif
#define STAGGER(j) do { if ((STAG_MASK >> (j)) & 1) { const unsigned long long t0_ = __builtin_amdgcn_s_memrealtime(), dl_ = (unsigned long long)(F.vcu / (F.G / 8)) * STAG_TICKS; while (__builtin_amdgcn_s_memrealtime() - t0_ < dl_) __builtin_amdgcn_s_sleep(8); } } while (0)
#ifndef EXTRA_MASK
#define EXTRA_MASK (EXTRA_PHASE >= 0 ? (1 << EXTRA_PHASE) : 0)
#endif
#define EXOK(j) (EXTRA_MASK == 0 || !ex_ || ((EXTRA_MASK >> (j)) & 1))
    for (int it_ = 0; it_ < DEPTH + (EXTRA_MASK != 0 ? 1 : 0); ++it_) {
        const int l = it_ < DEPTH ? it_ : DEPTH - 1; const bool ex_ = it_ >= DEPTH; (void)ex_;
        const int pb = 2 + 9 * l;
        if (PHON(2) && EXOK(2) && IN(pb + 0)) REP(2) { PH_BEGIN();
            pg8::Gemm g{(const bf16_t*)(ws + WS_H), (const bf16_t*)(ws + WS_W + (size_t)l * W_LAYER + WO_WIN), DM}; g.skip_epi = SKIPV; pg8::StaticOrder<MTOK / 256, NPROJ / 256> S; S.init(F.G, (int)blockIdx.x);
            EpiProj E{(bf16_t*)(ws + WS_PROJ), (unsigned char*)(ws + WS_GATES), (const float*)(ws + WS_RS), (const float*)(ws + WS_CSIN) + (size_t)l * NPROJ};
            STAGGER(2); pg8::gemm_phase<EpiProj, pg8::StaticOrder<MTOK / 256, NPROJ / 256>, false, true>(F.lds, g, S, E, F.wave);
            if (BOTH(pb + 0)) GRID_BAR();
        }
        if (PHON(3) && EXOK(3) && IN(pb + 1)) REP(3) {
#ifndef SUBREP
#define SUBREP 0
#endif
#ifndef IDX_PROBE
#define IDX_PROBE 0
#endif
            if (!((IDX_PROBE & 8) && ex_))
            { const Frame Fa = phase_frame(F0); const bf16_t* PROJa = (const bf16_t*)(opq(args.ws) + WS_PROJ); bf16_t* OAa = (bf16_t*)(opq(args.ws) + WS_O);
            SwaPre Pa;
#pragma unroll
            for (int i_ = 0; i_ < 3; ++i_) { Pa.kreg[i_] = (u32x4){0u, 0u, 0u, 0u}; Pa.vreg[i_] = (u32x4){0u, 0u, 0u, 0u}; }
            { int b_, g_, qb_; attn_decode(Fa.vcu < 2048 ? Fa.vcu : 2047, b_, g_, qb_); swa_prefetch(Fa, PROJa, b_, g_, qb_, Pa.qf, Pa.kreg, Pa.vreg); }
            for (int u = Fa.vcu; u < 2048; u += Fa.G) { int b_, g_, qb_; attn_decode(u, b_, g_, qb_);
                swa_unit(Fa, PROJa, OAa, args.in[9] + l * 8, b_, g_, qb_, Pa, u + Fa.G, ex_); } }
            if (!((IDX_PROBE & 16) && ex_))
            { const Frame Fb = phase_frame(F0); unsigned char* wsb = opq(args.ws);
            for (int u = Fb.vcu; u < 512; u += Fb.G)
                sg_unit(Fb, (const bf16_t*)(wsb + WS_PROJ), (const bf16_t*)(wsb + WS_SGW) + (size_t)l * 8 * 128 * 128, args.in[11] + l * 8 * 128, args.in[12] + l * 512, (bf16_t*)(wsb + WS_O) + (size_t)2 * MTOK * 512, u >> 4, u & 15); }
            __syncthreads();
            if (!((IDX_PROBE & 4) && ex_))
            { const Frame Fi = phase_frame(F0); unsigned char* wsi = opq(args.ws);
              dsa_index_phase(Fi, (const bf16_t*)(wsi + WS_PROJ), (unsigned long long*)(wsi + WS_BITS), l == 0 ? (unsigned*)(wsi + WS_CTL) + 100 : nullptr, ex_); }
            if (BOTH(pb + 1)) GRID_BAR();
        }
        if (PHON(4) && EXOK(4) && IN(pb + 2)) REP(4) { PH_BEGIN();
            AttnPre Pd; { int b_, g_, qb_; attn_decode(F.vcu < 2048 ? F.vcu : 2047, b_, g_, qb_); attn_prefetch<1>(F, (const bf16_t*)(ws + WS_PROJ), (const unsigned*)(ws + WS_BITS), b_, g_, qb_, Pd.qf, Pd.kreg, Pd.vreg, Pd.mreg); }
            for (int u = F.vcu; u < 2048; u += F.G) { int b_, g_, qb_; attn_decode(u, b_, g_, qb_);
                attn_unit<1>(F, (const bf16_t*)(ws + WS_PROJ), (bf16_t*)(ws + WS_O) + (size_t)MTOK * 512, (const unsigned*)(ws + WS_BITS), nullptr, b_, g_, qb_, Pd, u + F.G); }
            __syncthreads();
            if (BOTH(pb + 2)) GRID_BAR();
        }
        if (PHON(5) && EXOK(5) && IN(pb + 3)) REP(5) { PH_BEGIN();
            pg8::Gemm g{(const bf16_t*)(ws + WS_O), (const bf16_t*)(ws + WS_W + (size_t)l * W_LAYER + WO_WBR), 512}; g.skip_epi = SKIPV; BranchOrder S; S.so.init(F.G, (int)blockIdx.x);
            EpiBranch E{(const unsigned char*)(ws + WS_GATES), (bf16_t*)(ws + WS_H)};
            STAGGER(5); pg8::gemm_phase<EpiBranch, BranchOrder, false>(F.lds, g, S, E, F.wave);
            if (BOTH(pb + 3)) GRID_BAR();
        }
        if (PHON(6) && EXOK(6) && IN(pb + 4)) REP(6) { PH_BEGIN();
            pg8::Gemm g{(const bf16_t*)(ws + WS_H), (const bf16_t*)(ws + WS_W + (size_t)l * W_LAYER + WO_WOUT), DM}; g.skip_epi = SKIPV; pg8::StaticOrder<MTOK / 256, DM / 256> S; S.init(F.G, (int)blockIdx.x);
            EpiWout E{(bf16_t*)(ws + WS_Y), (float*)(ws + WS_SSP)}; E.pv = ex_;
            STAGGER(6); pg8::gemm_phase<EpiWout, pg8::StaticOrder<MTOK / 256, DM / 256>, false>(F.lds, g, S, E, F.wave);
            if (BOTH(pb + 4)) GRID_BAR();
        }
        if (PHON(7) && EXOK(7) && IN(pb + 5)) REP(7) { PH_BEGIN();
            p7_route(F, args, l, (bf16_t*)(ws + WS_X), (const bf16_t*)(ws + WS_Y), (const float*)(ws + WS_SSP), (const float*)(ws + WS_MOD) + (size_t)l * BATCH * 6 * DM, (signed char*)(ws + WS_H), (float*)(ws + WS_RS),
                     (const bf16_t*)(ws + WS_WRT) + (size_t)l * NE * DM, (unsigned*)(ws + WS_CTL) + CW_CNT + l * 32 * 64, (int*)(ws + WS_ROWTOK), (unsigned*)(ws + WS_TOKINFO));
            if (BOTH(pb + 5)) GRID_BAR();
        }
        if (PHON(8) && EXOK(8) && IN(pb + 6)) REP(8) { PH_BEGIN();
            unsigned* cnt = (unsigned*)(ws + WS_CTL) + CW_CNT + l * 32 * 64; const int* ROWTOK = (const int*)(ws + WS_ROWTOK);
            const int RT = moe_tables(F, cnt);
            LAS int* ts = (LAS int*)(F.lds + TS_OFF); LAS int* te = (LAS int*)(F.lds + TILE_E_OFF); LAS int* ri = (LAS int*)(F.lds + ROWIDX_OFF);
            const long U = (long)RT * 8; MoeOrder S; S.u0 = (int)(U * F.vcu / F.G); S.u1 = (int)(U * (F.vcu + 1) / F.G); S.NB = 8; S.rt_lo = S.u0 / 8; S.tile_e = te; S.rowidx = ri;
            if (S.u1 > S.u0) { const int rt_hi = (S.u1 - 1) / 8; int ntile = rt_hi - S.rt_lo + 1; if (ntile > 8) ntile = 8;
                for (int i = F.tid; i < ntile * 256; i += 512) { const int rt = S.rt_lo + (i >> 8), r = i & 255, e = te[rt], first = (rt - ts[e]) * 256 + r;
                    const int c = (int)__hip_atomic_load(cnt + 64 * e, __ATOMIC_RELAXED, __HIP_MEMORY_SCOPE_AGENT); ri[i] = first < c ? ROWTOK[e * 65536 + first] : 0; } }
            __syncthreads();
            pg8::Gemm g{(const bf16_t*)(ws + WS_H), (const bf16_t*)(ws + WS_W + (size_t)l * W_LAYER + WO_W1), DM}; g.skip_epi = SKIPV;
            EpiW1I8 E{(signed char*)(ws + WS_ACT), args.in[18] + (size_t)l * NE * 2 * FF, (const float*)(ws + WS_RS), (const float*)(ws + WS_CS1) + (size_t)l * NE * 2048, ri, S.rt_lo};
            STAGGER(8); pg8::gemm_phase<EpiW1I8, MoeOrder, true, true>(F.lds, g, S, E, F.wave);
            if (BOTH(pb + 6)) GRID_BAR();
        }
        if (PHON(9) && EXOK(9) && IN(pb + 7)) REP(9) { PH_BEGIN();
            const int RT = moe_tables(F, (unsigned*)(ws + WS_CTL) + CW_CNT + l * 32 * 64);
            const long U = (long)RT * 4; MoeOrder S; S.u0 = (int)(U * F.vcu / F.G); S.u1 = (int)(U * (F.vcu + 1) / F.G); S.NB = 4; S.rt_lo = 0; S.tile_e = (LAS int*)(F.lds + TILE_E_OFF); S.rowidx = nullptr;
            pg8::Gemm g{(const bf16_t*)(ws + WS_ACT), (const bf16_t*)(ws + WS_W + (size_t)l * W_LAYER + WO_W2), FF}; g.skip_epi = SKIPV;
            EpiW2 E{(bf16_t*)(ws + WS_Y2), args.in[20] + (size_t)l * NE * DM, (const float*)(ws + WS_CS2) + (size_t)l * NE * DM};
            STAGGER(9); pg8::gemm_phase<EpiW2, MoeOrder, false, true>(F.lds, g, S, E, F.wave);
            if (BOTH(pb + 7)) GRID_BAR();
        }
        if (PHON(10) && EXOK(10) && IN(pb + 8)) REP(10) { PH_BEGIN();
            (void)moe_tables(F, (unsigned*)(ws + WS_CTL) + CW_CNT + l * 32 * 64);
            p10_combine(F, args, l, (bf16_t*)(ws + WS_X), args.out, (const bf16_t*)(ws + WS_Y2), (const unsigned*)(ws + WS_TOKINFO), (const float*)(ws + WS_MOD), (signed char*)(ws + WS_H), (float*)(ws + WS_RS));
            if (BOTH(pb + 8)) GRID_BAR();
        }
    }
#undef PH_BEGIN
#undef IN
#undef BOTH
#undef GRID_BAR
}

extern "C" void kernel_launch(void* const* d_in, const int* in_sizes, int n_in, void* d_out, int out_size, void* d_ws, size_t ws_size, hipStream_t stream) {
    static int grid = 0;
    if (grid == 0) {
        if (n_in != 21 || out_size != MTOK * DM || ws_size < WS_END) { fprintf(stderr, "kernel_launch: unexpected shapes (n_in %d, out %d, ws %zu); nothing launched\n", n_in, out_size, ws_size); grid = -1; return; }
        int dev = 0, cus = 0, per_cu = 0;
        if (hipGetDevice(&dev) != hipSuccess || hipDeviceGetAttribute(&cus, hipDeviceAttributeMultiprocessorCount, dev) != hipSuccess) { grid = -1; return; }
        if (hipFuncSetAttribute((const void*)fwd, hipFuncAttributeMaxDynamicSharedMemorySize, LDS_BYTES) != hipSuccess) { fprintf(stderr, "kernel_launch: hipFuncSetAttribute failed\n"); grid = -1; return; }
        if (hipOccupancyMaxActiveBlocksPerMultiprocessor(&per_cu, (const void*)fwd, 512, LDS_BYTES) != hipSuccess || per_cu < 1) { fprintf(stderr, "kernel_launch: occupancy query says %d\n", per_cu); }
        (void)hipGetLastError();
        grid = cus > 256 ? 256 : cus;
    }
    if (grid < 0) return;
    (void)hipMemsetAsync((char*)d_ws + WS_CTL, 0, CTL_ZERO_BYTES, stream);
    Args a{};
    for (int i = 0; i < 21; ++i) a.in[i] = (const float*)d_in[i];
    a.out = (float*)d_out; a.ws = (unsigned char*)d_ws;
#if MK_ONE_LAUNCH
    a.ph_lo = 0; a.ph_hi = N_PHASES;
    hipLaunchKernelGGL(fwd, dim3(grid), dim3(512), LDS_BYTES, stream, a);
#else
    for (int p = 0; p < N_PHASES; ++p) { a.ph_lo = p; a.ph_hi = p + 1; hipLaunchKernelGGL(fwd, dim3(grid), dim3(512), LDS_BYTES, stream, a); }
#endif
}
```

```cpp
#include <hip/hip_runtime.h>
#include <cstdio>
#include <cstdint>
#include <type_traits>

#define LAS __attribute__((address_space(3)))
#define GAS __attribute__((address_space(1)))
typedef unsigned short bf16_t;
typedef short bf16x8 __attribute__((ext_vector_type(8)));
typedef float f32x2 __attribute__((ext_vector_type(2)));
typedef float f32x4 __attribute__((ext_vector_type(4)));
typedef float f32x16 __attribute__((ext_vector_type(16)));
typedef unsigned u32x2 __attribute__((ext_vector_type(2)));
typedef unsigned u32x4 __attribute__((ext_vector_type(4)));
typedef short v4i16_t __attribute__((ext_vector_type(4)));
typedef int i32x4 __attribute__((ext_vector_type(4)));

constexpr int BATCH = 32, SEQ = 2048, DM = 1024, MTOK = BATCH * SEQ, DEPTH = 2;
constexpr int NPROJ = 6144;
constexpr int PLD = 3072;
constexpr int C_QA = 0, C_KA = 512, C_VA = 640, C_QB = 768, C_KB = 1280, C_VB = 1408, C_QI = 1536, C_KI = 1792, C_WI = 1824, C_U = 2048, C_V = 2560, C_G = 3072;
constexpr int NE = 32, FF = 1024;
constexpr float RMS_EPS = 1e-5f, LN_EPS = 1e-5f;
constexpr float LOG2E = 1.4426950408889634f;
constexpr float QSCALE = 0.125f * LOG2E;

__device__ __forceinline__ unsigned f2bf(float f) { unsigned u = __builtin_bit_cast(unsigned, f); return (u + 0x7fffu + ((u >> 16) & 1u)) >> 16; }
__device__ __forceinline__ unsigned cvt_pk_bf16(float lo, float hi) { unsigned r; asm volatile("v_cvt_pk_bf16_f32 %0, %1, %2" : "=v"(r) : "v"(lo), "v"(hi)); return r; }
__device__ __forceinline__ float bf_lo(unsigned w) { return __builtin_bit_cast(float, w << 16); }
__device__ __forceinline__ float bf_hi(unsigned w) { return __builtin_bit_cast(float, w & 0xffff0000u); }
__device__ __forceinline__ float fexp2(float x) { return __builtin_amdgcn_exp2f(x); }
__device__ __forceinline__ float frcp(float x) { return __builtin_amdgcn_rcpf(x); }
__device__ __forceinline__ float sigmoidf_(float x) { return frcp(1.f + fexp2(-LOG2E * x)); }
__device__ __forceinline__ float gelu_tanh(float x) { const float t = x + 0.044715f * x * x * x; return x * frcp(1.f + fexp2(-2.302208198f * t)); }
template <int CTRL> __device__ __forceinline__ float dpp_f(float v) { return __builtin_bit_cast(float, __builtin_amdgcn_update_dpp(0, __builtin_bit_cast(int, v), CTRL, 0xF, 0xF, false)); }
__device__ __forceinline__ void swap32_asm(unsigned& a, unsigned& b) { asm volatile("s_nop 1\n\tv_permlane32_swap_b32 %0, %1" : "+v"(a), "+v"(b)); }
__device__ __forceinline__ float xor16_add(float v) { return v + __builtin_bit_cast(float, __builtin_amdgcn_ds_swizzle(__builtin_bit_cast(int, v), 0x401F)); }
__device__ __forceinline__ float xor16_max(float v) { return fmaxf(v, __builtin_bit_cast(float, __builtin_amdgcn_ds_swizzle(__builtin_bit_cast(int, v), 0x401F))); }
__device__ __forceinline__ float xor32_add(float v) { unsigned a = __builtin_bit_cast(unsigned, v), b = a; swap32_asm(a, b); return __builtin_bit_cast(float, a) + __builtin_bit_cast(float, b); }
__device__ __forceinline__ float xor32_max(float v) { unsigned a = __builtin_bit_cast(unsigned, v), b = a; swap32_asm(a, b); return fmaxf(__builtin_bit_cast(float, a), __builtin_bit_cast(float, b)); }
__device__ __forceinline__ float quad_sum(float v) { v += dpp_f<0xB1>(v); v += dpp_f<0x4E>(v); return v; }
__device__ __forceinline__ float wave_sum(float v) {
    v += dpp_f<0xB1>(v); v += dpp_f<0x4E>(v); v += dpp_f<0x141>(v); v += dpp_f<0x140>(v);
    return xor32_add(xor16_add(v));
}
__device__ __forceinline__ float wave_max(float v) {
    v = fmaxf(v, dpp_f<0xB1>(v)); v = fmaxf(v, dpp_f<0x4E>(v)); v = fmaxf(v, dpp_f<0x141>(v)); v = fmaxf(v, dpp_f<0x140>(v));
    return xor32_max(xor16_max(v));
}
__device__ __forceinline__ unsigned wave_sum_u32(unsigned v) {
    v += (unsigned)__builtin_amdgcn_update_dpp(0, (int)v, 0xB1, 0xF, 0xF, false);
    v += (unsigned)__builtin_amdgcn_update_dpp(0, (int)v, 0x4E, 0xF, 0xF, false);
    v += (unsigned)__builtin_amdgcn_update_dpp(0, (int)v, 0x141, 0xF, 0xF, false);
    v += (unsigned)__builtin_amdgcn_update_dpp(0, (int)v, 0x140, 0xF, 0xF, false);
    return __builtin_amdgcn_readlane(v, 0) + __builtin_amdgcn_readlane(v, 16) + __builtin_amdgcn_readlane(v, 32) + __builtin_amdgcn_readlane(v, 48);
}
__device__ __forceinline__ unsigned wave_max_u32(unsigned v) {
    unsigned t;
    t = (unsigned)__builtin_amdgcn_update_dpp(0, (int)v, 0xB1, 0xF, 0xF, false); v = v > t ? v : t;
    t = (unsigned)__builtin_amdgcn_update_dpp(0, (int)v, 0x4E, 0xF, 0xF, false); v = v > t ? v : t;
    t = (unsigned)__builtin_amdgcn_update_dpp(0, (int)v, 0x141, 0xF, 0xF, false); v = v > t ? v : t;
    t = (unsigned)__builtin_amdgcn_update_dpp(0, (int)v, 0x140, 0xF, 0xF, false); v = v > t ? v : t;
    unsigned a = __builtin_amdgcn_readlane(v, 0), b = __builtin_amdgcn_readlane(v, 16), c = __builtin_amdgcn_readlane(v, 32), d = __builtin_amdgcn_readlane(v, 48);
    a = a > b ? a : b; c = c > d ? c : d; return a > c ? a : c;
}
__device__ __forceinline__ void lds_barrier() { asm volatile("s_waitcnt lgkmcnt(0)\n\ts_barrier" ::: "memory"); }
__device__ __forceinline__ unsigned q8x4(float a, float b, float c, float d, float inv) {
    unsigned r = 0u;
#if 1
    r = __builtin_amdgcn_cvt_pk_u8_f32(fmaf(a, inv, 128.f), 0u, r);
    r = __builtin_amdgcn_cvt_pk_u8_f32(fmaf(b, inv, 128.f), 1u, r);
    r = __builtin_amdgcn_cvt_pk_u8_f32(fmaf(c, inv, 128.f), 2u, r);
    r = __builtin_amdgcn_cvt_pk_u8_f32(fmaf(d, inv, 128.f), 3u, r);
#else
    r = __builtin_amdgcn_cvt_pk_u8_f32(__builtin_rintf(fmaf(a, inv, 128.f)), 0u, r);
    r = __builtin_amdgcn_cvt_pk_u8_f32(__builtin_rintf(fmaf(b, inv, 128.f)), 1u, r);
    r = __builtin_amdgcn_cvt_pk_u8_f32(__builtin_rintf(fmaf(c, inv, 128.f)), 2u, r);
    r = __builtin_amdgcn_cvt_pk_u8_f32(__builtin_rintf(fmaf(d, inv, 128.f)), 3u, r);
#endif
    return r ^ 0x80808080u;
}
__device__ __forceinline__ unsigned u8x4_floor(float a, float b, float c, float d) {
    unsigned r = 0u;
#if 1
    r = __builtin_amdgcn_cvt_pk_u8_f32(a - 0.5f, 0u, r); r = __builtin_amdgcn_cvt_pk_u8_f32(b - 0.5f, 1u, r);
    r = __builtin_amdgcn_cvt_pk_u8_f32(c - 0.5f, 2u, r); r = __builtin_amdgcn_cvt_pk_u8_f32(d - 0.5f, 3u, r);
#else
    r = __builtin_amdgcn_cvt_pk_u8_f32(__builtin_floorf(a), 0u, r); r = __builtin_amdgcn_cvt_pk_u8_f32(__builtin_floorf(b), 1u, r);
    r = __builtin_amdgcn_cvt_pk_u8_f32(__builtin_floorf(c), 2u, r); r = __builtin_amdgcn_cvt_pk_u8_f32(__builtin_floorf(d), 3u, r);
#endif
    return r;
}
__device__ __forceinline__ int lane_id_volatile(int tag = 0) { int l; asm volatile("v_mbcnt_lo_u32_b32 %0, -1, 0 ; LANETAG %1\n\tv_mbcnt_hi_u32_b32 %0, -1, %0" : "=v"(l) : "s"(tag)); return l; }
#define LDS_WAIT() asm volatile("s_waitcnt lgkmcnt(0)" ::: "memory")
#define VM_WAIT() asm volatile("s_waitcnt vmcnt(0)" ::: "memory")

namespace pg8 {
constexpr int BM = 256, BK = 64, HALF = 128, HTB = HALF * BK * 2  , STAGE_BYTES = 8 * HTB, NXCD = 8, WGM = 8;
__host__ __device__ __forceinline__ int lds_byte(int r, int c) { const int st = (r >> 4) * 2 + (c >> 5), rr = r & 15, cc = c & 31, ob = rr * 64 + cc * 2; return st * 1024 + (ob ^ (((ob >> 9) & 1) << 5)); }
__host__ __device__ __forceinline__ void stage_rc(int b, int& R, int& C) { const int st = b / 1024, sb = b % 1024, swz = sb ^ (((sb >> 9) & 1) << 5); R = (st >> 1) * 16 + swz / 64; C = (st & 1) * 32 + (swz % 64) / 2; }
__host__ __device__ __forceinline__ int perm32(int rho) { const int n = rho >> 4, i = rho & 15; return 8 * (i >> 2) + 4 * n + (i & 3); }

struct Unit { int pm, pn; };
struct Gemm { const bf16_t* A; const bf16_t* Bt; int K; bool skip_epi = false; };

template <int NM, int NN> struct StaticOrder {
    int G, c;
    __device__ void init(int G_, int c_) { G = G_; c = c_; }
    __device__ __forceinline__ bool tile(int i, int& pm, int& pn) const {
        constexpr int nwg = NM * NN;
        const long L = (long)i * G + c; if (L >= nwg) return false;
        int wgid = (int)L; { constexpr int q = nwg / NXCD, r = nwg % NXCD; const int xcd = wgid % NXCD, off = wgid / NXCD; wgid = (xcd < r ? xcd * (q + 1) : r * (q + 1) + (xcd - r) * q) + off; }
        constexpr int nig = WGM * NN; static_assert(NM % WGM == 0, "row tiles in whole groups");
        const int gid = wgid / nig, fm = gid * WGM, rem = wgid % nig;
        pm = fm + (rem % WGM); pn = rem / WGM; return true;
    }
    __device__ __forceinline__ bool next(int i, Unit& u) const { return tile(i, u.pm, u.pn); }
};

template <class Epi, class Sched, bool GATHER, bool I8 = false>
__device__ __forceinline__ void gemm_phase(LAS unsigned char* lds, const Gemm g, const Sched& S, const Epi& E, int wv  ) {
    int tid = wv * 64 + lane_id_volatile(1); asm volatile("" : "+v"(tid));
    const int wid = __builtin_amdgcn_readfirstlane(tid >> 6), lane = tid & 63, wr = wid >> 2, wc = wid & 3, fr = lane & 15, fq = lane >> 4;
    const int K = g.K, RB = I8 ? K : 2 * K  , nt = RB / (BK * 2);
    unsigned voffA[2], voffB[2]; int RA[2], CA[2];
#pragma unroll
    for (int i = 0; i < 2; ++i) { int R, C; stage_rc(tid * 16 + i * 8192, R, C); const int Rb = (R & ~31) + perm32(R & 31); RA[i] = R; CA[i] = C;
        voffA[i] = (unsigned)(R * RB + C * 2); voffB[i] = (unsigned)(Rb * RB + C * 2); }
    const size_t kstep = (size_t)(BK * 2);
    const size_t hstep = (size_t)HALF * RB;
    const size_t tstep = 2 * hstep;
    const unsigned ldsw = (unsigned)wid * 1024u;
    const int aoff = lds_byte(wr * 64 + fr, fq * 8), boff = lds_byte(wc * 32 + fr, fq * 8);
#define PG8_SA(b, h) (((b) * 2 + (h)) * HTB)
#define PG8_SB(b, h) ((4 + (b) * 2 + (h)) * HTB)
#define PG8_STAGE(bufoff, gbase, voff) do { _Pragma("unroll") for (int _i = 0; _i < 2; ++_i) \
        __builtin_amdgcn_global_load_lds((const unsigned*)((const char*)(gbase) + (voff)[_i]), (LAS unsigned*)(lds + (bufoff) + ldsw + _i * 8192), 16, 0, 0); } while (0)
#define PG8_STAGE_A(bufoff, h, ubase, koff, VO) do { if constexpr (GATHER) { PG8_STAGE(bufoff, (const char*)g.A + (koff), VO[h]); } else { PG8_STAGE(bufoff, (ubase) + (h) * hstep + (koff), voffA); } } while (0)
#define PG8_LDA(dst, b, h) do { _Pragma("unroll") for (int m = 0; m < 4; ++m) _Pragma("unroll") for (int k = 0; k < 2; ++k) dst[m][k] = *(const LAS bf16x8*)(lds + PG8_SA(b, h) + aoff + m * 2048 + k * 1024); } while (0)
#define PG8_LDB(dst, b, h) do { _Pragma("unroll") for (int n = 0; n < 2; ++n) _Pragma("unroll") for (int k = 0; k < 2; ++k) dst[n][k] = *(const LAS bf16x8*)(lds + PG8_SB(b, h) + boff + n * 2048 + k * 1024); } while (0)
#define PG8_MMA(ai, bj, At, Bt) do { __builtin_amdgcn_s_setprio(1); _Pragma("unroll") for (int m = 0; m < 4; ++m) _Pragma("unroll") for (int n = 0; n < 2; ++n) _Pragma("unroll") for (int k = 0; k < 2; ++k) \
        { if constexpr (I8) acc[ai][bj][m][n] = __builtin_amdgcn_mfma_i32_16x16x64_i8(__builtin_bit_cast(i32x4, Bt[n][k]), __builtin_bit_cast(i32x4, At[m][k]), acc[ai][bj][m][n], 0, 0, 0); \
          else acc[ai][bj][m][n] = __builtin_amdgcn_mfma_f32_16x16x32_bf16(Bt[n][k], At[m][k], acc[ai][bj][m][n], 0, 0, 0); } __builtin_amdgcn_s_setprio(0); } while (0)
#define PG8_WAIT_V(n) asm volatile("s_waitcnt vmcnt(" #n ")" ::: "memory")
#define PG8_WAIT_L(n) asm volatile("s_waitcnt lgkmcnt(" #n ")" ::: "memory")
#define PG8_BAR __builtin_amdgcn_s_barrier()
#define PG8_SCHED __builtin_amdgcn_sched_barrier(0)
    Unit cur, nxt; int ui = 0;
    if (!S.next(0, cur)) return;
    typedef typename std::conditional<I8, i32x4, f32x4>::type accv_t;
    accv_t acc[2][2][4][2];
#pragma unroll
    for (int a = 0; a < 2; ++a)
#pragma unroll
        for (int b = 0; b < 2; ++b)
#pragma unroll
            for (int m = 0; m < 4; ++m)
#pragma unroll
                for (int n = 0; n < 2; ++n) acc[a][b][m][n] = (accv_t){0, 0, 0, 0};
    bf16x8 At[4][2], B0[2][2], B1[2][2];
    unsigned oc[2][2], on[2][2];
    if constexpr (GATHER) {
#pragma unroll
        for (int h = 0; h < 2; ++h)
#pragma unroll
            for (int i = 0; i < 2; ++i) { oc[h][i] = (unsigned)(S.src_row(cur, h * HALF + RA[i]) * RB + CA[i] * 2); on[h][i] = oc[h][i]; }

    }
    const char* cA = GATHER ? (const char*)g.A : (const char*)g.A + (size_t)cur.pm * tstep; const char* cB = (const char*)g.Bt + (size_t)cur.pn * tstep;
    PG8_STAGE(PG8_SB(0, 0), cB, voffB); PG8_STAGE(PG8_SB(0, 1), cB + hstep, voffB); PG8_STAGE_A(PG8_SA(0, 0), 0, cA, 0, oc); PG8_STAGE_A(PG8_SA(0, 1), 1, cA, 0, oc);
    if (wr == 1) PG8_BAR;
    PG8_WAIT_V(2); PG8_BAR;
    PG8_STAGE(PG8_SB(1, 0), cB + kstep, voffB); PG8_STAGE_A(PG8_SA(1, 0), 0, cA, kstep, oc); PG8_STAGE(PG8_SB(1, 1), cB + hstep + kstep, voffB);
    PG8_WAIT_V(6); PG8_BAR;
    for (;;) {
        const bool has_next = S.next(ui + 1, nxt);
        const char* nA = GATHER ? (const char*)g.A : (has_next ? (const char*)g.A + (size_t)nxt.pm * tstep : cA); const char* nB = has_next ? (const char*)g.Bt + (size_t)nxt.pn * tstep : cB;
        if constexpr (GATHER) {
            if (has_next) {
                const int t2 = wv * 64 + lane_id_volatile(3); int R2[2], C2[2];
#pragma unroll
                for (int i = 0; i < 2; ++i) stage_rc(t2 * 16 + i * 8192, R2[i], C2[i]);
#pragma unroll
                for (int h = 0; h < 2; ++h)
#pragma unroll
                    for (int i = 0; i < 2; ++i) on[h][i] = (unsigned)(S.src_row(nxt, h * HALF + R2[i]) * RB + C2[i] * 2);
            }
        }
        for (int t = 0; t < nt; t += 2) {
            const bool last = (t == nt - 2);
            const size_t k1 = (size_t)(t + 1) * kstep;
            const size_t k2 = last ? (size_t)0 : (size_t)(t + 2) * kstep, k3 = k2 + kstep;
            const char* a2 = last ? nA : cA; const char* b2 = last ? nB : cB;
            unsigned o2[2][2];
            if constexpr (GATHER) {
#pragma unroll
                for (int h = 0; h < 2; ++h)
#pragma unroll
                    for (int i = 0; i < 2; ++i) o2[h][i] = last ? on[h][i] : oc[h][i];
            }
            PG8_LDB(B0, 0, 0); PG8_LDB(B1, 0, 1); PG8_SCHED; PG8_LDA(At, 0, 0); PG8_STAGE_A(PG8_SA(1, 1), 1, cA, k1, oc);
            PG8_WAIT_V(8); PG8_WAIT_L(0); PG8_BAR; PG8_MMA(0, 0, At, B0); PG8_MMA(0, 1, At, B1); PG8_BAR; PG8_SCHED;
            PG8_LDA(At, 0, 1); PG8_STAGE(PG8_SB(0, 0), b2 + k2, voffB); PG8_STAGE(PG8_SB(0, 1), b2 + hstep + k2, voffB); PG8_STAGE_A(PG8_SA(0, 0), 0, a2, k2, o2);
            PG8_WAIT_V(8); PG8_WAIT_L(0); PG8_BAR; PG8_MMA(1, 0, At, B0); PG8_MMA(1, 1, At, B1); PG8_BAR; PG8_SCHED;
            PG8_LDB(B0, 1, 0); PG8_LDB(B1, 1, 1); PG8_SCHED; PG8_LDA(At, 1, 0); PG8_STAGE_A(PG8_SA(0, 1), 1, a2, k2, o2);
            PG8_WAIT_V(8); PG8_WAIT_L(0); PG8_BAR; PG8_MMA(0, 0, At, B0); PG8_MMA(0, 1, At, B1); PG8_BAR; PG8_SCHED;
            PG8_LDA(At, 1, 1); PG8_STAGE(PG8_SB(1, 0), b2 + k3, voffB); PG8_STAGE(PG8_SB(1, 1), b2 + hstep + k3, voffB); PG8_STAGE_A(PG8_SA(1, 0), 0, a2, k3, o2);
            PG8_WAIT_V(8); PG8_WAIT_L(0); PG8_BAR; PG8_MMA(1, 0, At, B0); PG8_MMA(1, 1, At, B1); PG8_BAR; PG8_SCHED;
        }
#ifndef NO_ALIGN_EPI
        if (wr == 0) PG8_BAR;
#else
        asm volatile("" ::: "memory"); PG8_SCHED;
#endif
#ifdef SKIP_EPI_PROBE
        const int le_ = lane_id_volatile(4);
        bool rst = true; if (!g.skip_epi) rst = E(acc, cur, wr, wc, le_ & 15, le_ >> 4);
#else
        const int le_ = lane_id_volatile(4);
        const bool rst = E(acc, cur, wr, wc, le_ & 15, le_ >> 4);
#endif
        if (!has_next) break;
        if (rst) {
#pragma unroll
        for (int a = 0; a < 2; ++a)
#pragma unroll
            for (int b = 0; b < 2; ++b)
#pragma unroll
                for (int m = 0; m < 4; ++m)
#pragma unroll
                    for (int n = 0; n < 2; ++n) acc[a][b][m][n] = (accv_t){0, 0, 0, 0};
        }
        cur = nxt; cA = nA; cB = nB; ++ui;
        if constexpr (GATHER) {
#pragma unroll
            for (int h = 0; h < 2; ++h)
#pragma unroll
                for (int i = 0; i < 2; ++i) oc[h][i] = on[h][i];
        }
#ifndef NO_ALIGN_EPI
        if (wr == 1) PG8_BAR;
#else
        asm volatile("" ::: "memory"); PG8_SCHED;
#endif
    }
    PG8_WAIT_V(0);
    PG8_BAR;
#undef PG8_SA
#undef PG8_SB
#undef PG8_STAGE
#undef PG8_STAGE_A
#undef PG8_LDA
#undef PG8_LDB
#undef PG8_MMA
#undef PG8_WAIT_V
#undef PG8_WAIT_L
#undef PG8_BAR
#undef PG8_SCHED
}
}
typedef f32x4 acc_t[2][2][4][2];
typedef i32x4 acci_t[2][2][4][2];

struct EpiProj {
    bf16_t* O; unsigned char* G8; const float* RS  ; const float* CS  ; bool pv = false;
    __device__ __forceinline__ bool operator()(acci_t& acc, const pg8::Unit& u, int wr, int wc, int fr, int fq) const {
#if defined(PROJ_VARIANT) && PROJ_VARIANT == 4
        if (pv) {
#pragma unroll
            for (int ai = 0; ai < 2; ++ai)
#pragma unroll
                for (int bj = 0; bj < 2; ++bj)
#pragma unroll
                    for (int m = 0; m < 4; ++m)
#pragma unroll
                        for (int n = 0; n < 2; ++n) asm volatile("" :: "v"(acc[ai][bj][m][n]));
            return true; }
#endif
        const int pn = u.pn;
        const int act = (pn <= 1 || pn == 3 || pn == 4) ? 1 : (pn >= 12 ? 3 : (pn >= 8 ? 2 : 0));
        const int row0 = u.pm * 256 + wr * 64 + fr, col0 = pn * 256 + wc * 32 + 8 * fq;
        float rsv[8];
#pragma unroll
        for (int q = 0; q < 8; ++q) rsv[q] = 1.f;
#if defined(PROJ_VARIANT) && PROJ_VARIANT == 3
        if (!pv)
#endif
        {
#pragma unroll
        for (int q = 0; q < 8; ++q) rsv[q] = RS[row0 + (q >> 2) * 128 + (q & 3) * 16];
        }
        f32x2 cs2[2][4];
#pragma unroll
        for (int bj = 0; bj < 2; ++bj) { f32x4 c0 = (f32x4){1.f, 1.f, 1.f, 1.f}, c1 = c0; const float k = (act == 1 ? QSCALE : 1.f);
#if defined(PROJ_VARIANT) && PROJ_VARIANT == 3
            if (!pv)
#endif
            { c0 = *(const f32x4*)(CS + col0 + bj * 128); c1 = *(const f32x4*)(CS + col0 + bj * 128 + 4); }
            cs2[bj][0] = (f32x2){c0[0], c0[1]} * k; cs2[bj][1] = (f32x2){c0[2], c0[3]} * k; cs2[bj][2] = (f32x2){c1[0], c1[1]} * k; cs2[bj][3] = (f32x2){c1[2], c1[3]} * k; }
#pragma unroll
        for (int ai = 0; ai < 2; ++ai)
#pragma unroll
            for (int m = 0; m < 4; ++m) { const int row = row0 + ai * 128 + m * 16; bf16_t* rowp = O + (size_t)row * PLD + col0; const float rs = rsv[ai * 4 + m];
#pragma unroll
                for (int bj = 0; bj < 2; ++bj) { f32x2 v[4];
#pragma unroll
                    for (int p = 0; p < 4; ++p) { const int i0 = 2 * p; v[p] = (f32x2){(float)acc[ai][bj][m][i0 >> 2][i0 & 3], (float)acc[ai][bj][m][(i0 + 1) >> 2][(i0 + 1) & 3]} * (cs2[bj][p] * rs); }
#if defined(PROJ_VARIANT) && PROJ_VARIANT == 2
                    if (pv) { if (act == 3) { u32x2 w8; w8.x = __builtin_bit_cast(unsigned, v[0][0]); w8.y = __builtin_bit_cast(unsigned, v[1][0]); *(u32x2*)(G8 + (size_t)row * 3072 + (col0 - C_G) + bj * 128) = w8; continue; } }
                    else
#endif
                    if (act == 2) {
#pragma unroll
                        for (int p = 0; p < 4; ++p) { const f32x2 x = v[p], t = (x * x * 0.044715f + 1.f) * x * (-2.302208198f); f32x2 d = {fexp2(t[0]), fexp2(t[1])}; d = d + 1.f; v[p] = x * (f32x2){frcp(d[0]), frcp(d[1])}; } }
                    else if (act == 3) {
                        f32x2 gq[4];
#pragma unroll
                        for (int p = 0; p < 4; ++p) { const f32x2 t = v[p] * (-LOG2E); f32x2 d = {fexp2(t[0]), fexp2(t[1])}; d = d + 1.f; gq[p] = (f32x2){frcp(d[0]), frcp(d[1])} * 256.f; }
                        u32x2 w8; w8.x = u8x4_floor(gq[0][0], gq[0][1], gq[1][0], gq[1][1]); w8.y = u8x4_floor(gq[2][0], gq[2][1], gq[3][0], gq[3][1]);
#if defined(PROJ_VARIANT) && PROJ_VARIANT == 1
                        if (pv) { asm volatile("" :: "v"(w8.x), "v"(w8.y)); continue; }
#endif
                        *(u32x2*)(G8 + (size_t)row * 3072 + (col0 - C_G) + bj * 128) = w8; continue; }
                    u32x4 w; w.x = cvt_pk_bf16(v[0][0], v[0][1]); w.y = cvt_pk_bf16(v[1][0], v[1][1]); w.z = cvt_pk_bf16(v[2][0], v[2][1]); w.w = cvt_pk_bf16(v[3][0], v[3][1]);
#if defined(PROJ_VARIANT) && PROJ_VARIANT == 1
                    if (pv) { asm volatile("" :: "v"(w.x), "v"(w.y), "v"(w.z), "v"(w.w)); continue; }
#endif
                    *(u32x4*)(rowp + bj * 128) = w; } }
        return true;
    }
};

struct BranchOrder {
    pg8::StaticOrder<MTOK / 256, DM / 256> so;
    __device__ __forceinline__ bool next(int j, pg8::Unit& u) const { const int i = j / 3, br = j - 3 * i; int pm, pn; if (!so.tile(i, pm, pn)) return false; u.pm = br * 256 + pm; u.pn = br * 4 + pn; return true; }
};
struct EpiBranch {
    const unsigned char* G8  ; bf16_t* MERGED;
    __device__ __forceinline__ bool operator()(acc_t& acc, const pg8::Unit& u, int wr, int wc, int fr, int fq) const {
        const int br = u.pn >> 2, pn = u.pn & 3, pm = u.pm & 255;
        const int row0 = pm * 256 + wr * 64 + fr, col0 = pn * 256 + wc * 32 + 8 * fq;
#pragma unroll
        for (int rnd = 0; rnd < 2; ++rnd) { const int ai = rnd, m0 = 0;
            u32x2 gw[4][2], gd[4][2];
#pragma unroll
            for (int m = m0; m < m0 + 4; ++m)
#pragma unroll
                for (int bj = 0; bj < 2; ++bj) { const unsigned char* gp = G8 + (size_t)(row0 + ai * 128 + m * 16) * 3072 + br * 1024 + col0 + bj * 128;
                    gw[m][bj] = *(const u32x2*)gp; if (br != 2) gd[m][bj] = *(const u32x2*)(gp + 1024); }
#pragma unroll
            for (int m = m0; m < m0 + 4; ++m) { const size_t row = (size_t)(row0 + ai * 128 + m * 16);
#pragma unroll
                for (int bj = 0; bj < 2; ++bj) {
                    const u32x2 g = gw[m][bj];
                    float gn[8];
#pragma unroll
                    for (int i = 0; i < 8; ++i) gn[i] = (float)((g[i >> 2] >> (8 * (i & 3))) & 0xffu) + 0.5f;
                    if (br != 2) { const u32x2 d = gd[m][bj];
#pragma unroll
                        for (int i = 0; i < 8; ++i) gn[i] = gn[i] * frcp((float)((d[i >> 2] >> (8 * (i & 3))) & 0xffu) + 0.5f); }
                    else {
#pragma unroll
                        for (int i = 0; i < 8; ++i) gn[i] *= (1.f / 256.f); }
                    f32x4 v0 = acc[ai][bj][m][0], v1 = acc[ai][bj][m][1];
                    v0[0] *= gn[0]; v0[1] *= gn[1]; v0[2] *= gn[2]; v0[3] *= gn[3]; v1[0] *= gn[4]; v1[1] *= gn[5]; v1[2] *= gn[6]; v1[3] *= gn[7];
                    if (br != 2) { acc[ai][bj][m][0] = v0; acc[ai][bj][m][1] = v1; }
                    else { u32x4 w; w.x = cvt_pk_bf16(v0[0], v0[1]); w.y = cvt_pk_bf16(v0[2], v0[3]); w.z = cvt_pk_bf16(v1[0], v1[1]); w.w = cvt_pk_bf16(v1[2], v1[3]);
                        *(u32x4*)(MERGED + row * DM + col0 + bj * 128) = w; } } }
            asm volatile("" ::: "memory");
        }
        return br == 2;
    }
};

#ifndef WOUT_VARIANT
#define WOUT_VARIANT 0
#endif
struct EpiWout {
    bf16_t* Y; float* SSP; bool pv = false;
    __device__ __forceinline__ bool operator()(acc_t& acc, const pg8::Unit& u, int wr, int wc, int fr, int fq) const {
        const int row0 = u.pm * 256 + wr * 64 + fr, col0 = u.pn * 256 + wc * 32 + 8 * fq;
#pragma unroll
        for (int ai = 0; ai < 2; ++ai)
#pragma unroll
            for (int m = 0; m < 4; ++m) { const size_t row = (size_t)(row0 + ai * 128 + m * 16); float ss = 0.f;
#pragma unroll
                for (int bj = 0; bj < 2; ++bj) { const f32x4 v0 = acc[ai][bj][m][0], v1 = acc[ai][bj][m][1];
                    ss += (v0[0] * v0[0] + v0[1] * v0[1]) + (v0[2] * v0[2] + v0[3] * v0[3]) + (v1[0] * v1[0] + v1[1] * v1[1]) + (v1[2] * v1[2] + v1[3] * v1[3]);
                    u32x4 w; w.x = cvt_pk_bf16(v0[0], v0[1]); w.y = cvt_pk_bf16(v0[2], v0[3]); w.z = cvt_pk_bf16(v1[0], v1[1]); w.w = cvt_pk_bf16(v1[2], v1[3]);
                    if (!(WOUT_VARIANT == 2 && pv)) *(u32x4*)(Y + row * DM + col0 + bj * 128) = w; }
                if (!(WOUT_VARIANT == 3 && pv)) ss = xor32_add(xor16_add(ss));
                if (fq == 0 && !((WOUT_VARIANT == 1 || WOUT_VARIANT == 3) && pv)) SSP[(size_t)(u.pn * 4 + wc) * MTOK + row] = ss; }
        return true;
    }
};

struct MoeOrder {
    int u0, u1, NB, rt_lo;
    const LAS int* tile_e;
    const LAS int* rowidx;
    __device__ __forceinline__ bool next(int i, pg8::Unit& u) const { const int x = u0 + i; if (x >= u1) return false; const int rt = x / NB, pn = x - rt * NB; u.pm = rt; u.pn = tile_e[rt] * NB + pn; return true; }
    __device__ __forceinline__ int src_row(const pg8::Unit& u, int r) const { return rowidx[(u.pm - rt_lo) * 256 + r]; }
};
struct EpiW1 {
    bf16_t* ACT; const float* b1  ;
    __device__ __forceinline__ bool operator()(acc_t& acc, const pg8::Unit& u, int wr, int wc, int fr, int fq) const {
        const int e = u.pn >> 3, pn = u.pn & 7;
        const int row0 = u.pm * 256 + wr * 64 + fr, j0 = pn * 128 + wc * 32 + 8 * fq;
        const float* bp = b1 + (size_t)e * (2 * FF) + 2 * j0;
        float bg[8], bl[8];
#pragma unroll
        for (int q = 0; q < 4; ++q) { const f32x4 t = *(const f32x4*)(bp + 4 * q); bg[2 * q] = t[0]; bl[2 * q] = t[1]; bg[2 * q + 1] = t[2]; bl[2 * q + 1] = t[3]; }
#pragma unroll
        for (int ai = 0; ai < 2; ++ai)
#pragma unroll
            for (int m = 0; m < 4; ++m) { float a[8];
#pragma unroll
                for (int i = 0; i < 8; ++i) { float gl = acc[ai][0][m][i >> 2][i & 3] + bg[i], li = acc[ai][1][m][i >> 2][i & 3] + bl[i];
                    gl = fminf(gl, 7.f); li = fminf(fmaxf(li, -7.f), 7.f);
                    a[i] = gl * frcp(1.f + fexp2(-1.702f * LOG2E * gl)) * (li + 1.f); }
                u32x4 w; w.x = cvt_pk_bf16(a[0], a[1]); w.y = cvt_pk_bf16(a[2], a[3]); w.z = cvt_pk_bf16(a[4], a[5]); w.w = cvt_pk_bf16(a[6], a[7]);
                *(u32x4*)(ACT + (size_t)(row0 + ai * 128 + m * 16) * FF + j0) = w; }
        return true;
    }
};
constexpr float ACT_SCALE = 12.f / 127.f;
struct EpiW1I8 {
    signed char* ACT  ; const float* b1  ; const float* RS  ; const float* CS  ;
    const LAS int* rowidx; int rt_lo;
    __device__ __forceinline__ bool operator()(acci_t& acc, const pg8::Unit& u, int wr, int wc, int fr, int fq) const {
        const int e = u.pn >> 3, pn = u.pn & 7;
        const int rl0 = wr * 64 + fr, row0 = u.pm * 256 + rl0, j0 = pn * 128 + wc * 32 + 8 * fq;
        const float* bp = b1 + (size_t)e * (2 * FF) + 2 * j0;
        float bg[8], bl[8], cg[8], cl[8];
#pragma unroll
        for (int q = 0; q < 4; ++q) { const f32x4 t = *(const f32x4*)(bp + 4 * q); bg[2 * q] = t[0]; bl[2 * q] = t[1]; bg[2 * q + 1] = t[2]; bl[2 * q + 1] = t[3]; }
        { const float* cp = CS + (size_t)e * 2048 + pn * 256 + wc * 32 + 8 * fq;
          const f32x4 a0 = *(const f32x4*)cp, a1 = *(const f32x4*)(cp + 4), c0 = *(const f32x4*)(cp + 128), c1 = *(const f32x4*)(cp + 132);
#pragma unroll
          for (int i = 0; i < 4; ++i) { cg[i] = a0[i]; cg[4 + i] = a1[i]; cl[i] = c0[i]; cl[4 + i] = c1[i]; } }
        const LAS int* ri = rowidx + (u.pm - rt_lo) * 256 + rl0;
        float rsv[8];
#pragma unroll
        for (int q = 0; q < 8; ++q) rsv[q] = RS[ri[(q >> 2) * 128 + (q & 3) * 16]];
        f32x2 bg2[4], bl2[4], cg2[4], cl2[4];
#pragma unroll
        for (int p = 0; p < 4; ++p) { bg2[p] = (f32x2){bg[2 * p], bg[2 * p + 1]}; bl2[p] = (f32x2){bl[2 * p], bl[2 * p + 1]}; cg2[p] = (f32x2){cg[2 * p], cg[2 * p + 1]}; cl2[p] = (f32x2){cl[2 * p], cl[2 * p + 1]}; }
#pragma unroll
        for (int ai = 0; ai < 2; ++ai)
#pragma unroll
            for (int m = 0; m < 4; ++m) { const float rs = rsv[ai * 4 + m]; f32x2 a2[4];
#pragma unroll
                for (int p = 0; p < 4; ++p) { const int i0 = 2 * p;
                    const f32x2 ag = {(float)acc[ai][0][m][i0 >> 2][i0 & 3], (float)acc[ai][0][m][(i0 + 1) >> 2][(i0 + 1) & 3]}, al = {(float)acc[ai][1][m][i0 >> 2][i0 & 3], (float)acc[ai][1][m][(i0 + 1) >> 2][(i0 + 1) & 3]};
                    f32x2 gl = ag * (cg2[p] * rs) + bg2[p], li = al * (cl2[p] * rs) + bl2[p];
                    gl[0] = fminf(gl[0], 7.f); gl[1] = fminf(gl[1], 7.f); li[0] = fminf(fmaxf(li[0], -7.f), 7.f); li[1] = fminf(fmaxf(li[1], -7.f), 7.f);
                    const f32x2 ex = gl * (-1.702f * LOG2E); f32x2 den = {fexp2(ex[0]), fexp2(ex[1])}; den = den + 1.f; const f32x2 rc = {frcp(den[0]), frcp(den[1])};
                    a2[p] = (gl * rc) * (li + 1.f); }
                u32x2 w; w.x = q8x4(a2[0][0], a2[0][1], a2[1][0], a2[1][1], 1.f / ACT_SCALE); w.y = q8x4(a2[2][0], a2[2][1], a2[3][0], a2[3][1], 1.f / ACT_SCALE);
                *(u32x2*)(ACT + (size_t)(row0 + ai * 128 + m * 16) * FF + j0) = w; }
        return true;
    }
};
struct EpiW2 {
    bf16_t* Y2; const float* b2  ; const float* CS  ;
    __device__ __forceinline__ bool operator()(acci_t& acc, const pg8::Unit& u, int wr, int wc, int fr, int fq) const {
        const int e = u.pn >> 2, pn = u.pn & 3;
        const int row0 = u.pm * 256 + wr * 64 + fr, col0 = pn * 256 + wc * 32 + 8 * fq;
        f32x4 bv[2][2], cv[2][2];
#pragma unroll
        for (int bj = 0; bj < 2; ++bj)
#pragma unroll
            for (int n = 0; n < 2; ++n) { bv[bj][n] = *(const f32x4*)(b2 + (size_t)e * DM + col0 + bj * 128 + 4 * n); cv[bj][n] = *(const f32x4*)(CS + (size_t)e * DM + col0 + bj * 128 + 4 * n) * ACT_SCALE; }
#pragma unroll
        for (int ai = 0; ai < 2; ++ai)
#pragma unroll
            for (int m = 0; m < 4; ++m) { bf16_t* rowp = Y2 + (size_t)(row0 + ai * 128 + m * 16) * DM + col0;
#pragma unroll
                for (int bj = 0; bj < 2; ++bj) { const i32x4 a0 = acc[ai][bj][m][0], a1 = acc[ai][bj][m][1];
                    const f32x4 v0 = (f32x4){(float)a0[0], (float)a0[1], (float)a0[2], (float)a0[3]} * cv[bj][0] + bv[bj][0], v1 = (f32x4){(float)a1[0], (float)a1[1], (float)a1[2], (float)a1[3]} * cv[bj][1] + bv[bj][1];
                    u32x4 w; w.x = cvt_pk_bf16(v0[0], v0[1]); w.y = cvt_pk_bf16(v0[2], v0[3]); w.z = cvt_pk_bf16(v1[0], v1[1]); w.w = cvt_pk_bf16(v1[2], v1[3]);
                    *(u32x4*)(rowp + bj * 128) = w; } }
        return true;
    }
};
#define XB_TMO      128
#define XB_XCNT(j)  (256  + 64 * (j))
#define XB_XSUB(j)  (1280 + 64 * (j))
#define XB_XGEN(j)  (2304 + 64 * (j))
#define XB_TOP      3328
#define XB_TOPGEN   3392
#define XCD_BAR_WORDS 3456
#define XB_SPIN_CAP (1u << 18)

__device__ __forceinline__ unsigned xb_ld(unsigned* p)              { return __hip_atomic_load(p, __ATOMIC_RELAXED, __HIP_MEMORY_SCOPE_AGENT); }
__device__ __forceinline__ unsigned xb_add(unsigned* p, unsigned v) { return __hip_atomic_fetch_add(p, v, __ATOMIC_RELAXED, __HIP_MEMORY_SCOPE_AGENT); }
__device__ __forceinline__ unsigned xb_xcc_id() { return (unsigned)__builtin_amdgcn_s_getreg((3 << 11) | 20) & 0xFu; }
#define XB_SPIN(cond, bar) do { unsigned _sp = 0; while (cond) { __builtin_amdgcn_s_sleep(1); \
    if ((++_sp & 255u) == 0u) { if (xb_ld(&(bar)[XB_TMO])) break; if (_sp > XB_SPIN_CAP) { atomicAdd(&(bar)[XB_TMO], 1u); break; } } } } while (0)

struct XcdBarrier {
    unsigned* bar; unsigned x;
    int w;
    volatile LAS unsigned* st;
};

__device__ __forceinline__ bool xb_thread0(int w) { return w == 0 && lane_id_volatile(2) == 0; }
__device__ __forceinline__ XcdBarrier xcd_barrier_post(unsigned* bar, volatile LAS unsigned* st, int w) {
    XcdBarrier b; b.bar = bar; b.x = xb_xcc_id(); b.st = st; b.w = w;
    if (xb_thread0(w)) (void)xb_add(&bar[XB_XCNT(b.x)], 1u);
    return b;
}
__device__ __forceinline__ void xcd_barrier_complete(unsigned* bar, unsigned x, unsigned& nloc, unsigned& nx) {
    const unsigned G = gridDim.x * gridDim.y * gridDim.z;
    unsigned sum, cnt, mine, sp = 0u;
    for (;;) {
        sum = 0u; cnt = 0u; mine = 0u;
#pragma unroll
        for (unsigned j = 0; j < 16; ++j) { const unsigned c = xb_ld(&bar[XB_XCNT(j)]); sum += c; cnt += (c > 0u) ? 1u : 0u; mine = (j == x) ? c : mine; }
        if (sum == G) break;
        __builtin_amdgcn_s_sleep(1);
        if ((++sp & 255u) == 0u) { if (xb_ld(&bar[XB_TMO])) break; if (sp > XB_SPIN_CAP) { atomicAdd(&bar[XB_TMO], 1u); break; } }
    }
    nloc = mine > 0u ? mine : 1u; nx = cnt > 0u ? cnt : 1u;
}

__device__ __forceinline__ void xcd_barrier(const XcdBarrier& b) {
    asm volatile("s_waitcnt vmcnt(0)" ::: "memory");
    __syncthreads();
    if (xb_thread0(b.w)) {
        unsigned* bar = b.bar;
        __builtin_amdgcn_s_waitcnt(0);
        unsigned nloc = b.st[0], nx = b.st[1];
        if (nloc == 0u) { xcd_barrier_complete(bar, b.x, nloc, nx); b.st[0] = nloc; b.st[1] = nx; }
        const unsigned old = xb_add(&bar[XB_XSUB(b.x)], 1u);
        const unsigned gen = old / nloc;
        if (old + 1u == (gen + 1u) * nloc) {
            __builtin_amdgcn_fence(__ATOMIC_RELEASE, "agent");
            asm volatile("s_waitcnt vmcnt(0)" ::: "memory");
            const unsigned og = xb_add(&bar[XB_TOP], 1u);
            const unsigned tg = og / nx;
            if (og + 1u == (tg + 1u) * nx) xb_add(&bar[XB_TOPGEN], 1u);
            else XB_SPIN(xb_ld(&bar[XB_TOPGEN]) == tg, bar);
            __builtin_amdgcn_fence(__ATOMIC_ACQUIRE, "agent");
            xb_add(&bar[XB_XGEN(b.x)], 1u);
            asm volatile("s_waitcnt vmcnt(0)" ::: "memory");
        } else {
            XB_SPIN(xb_ld(&bar[XB_XGEN(b.x)]) == gen, bar);
            __builtin_amdgcn_fence(__ATOMIC_ACQUIRE, "agent");
            asm volatile("s_waitcnt vmcnt(0)" ::: "memory");
        }
    }
    __syncthreads();
}

constexpr size_t MiB = 1u << 20;
constexpr size_t WS_CTL = 0, CTL_ZERO_BYTES = 1 * MiB;
constexpr size_t WS_MOD = 1 * MiB;
constexpr size_t WS_SGW = 3 * MiB;
constexpr size_t WS_WRT = 3 * MiB + 512 * 1024;
constexpr size_t WS_RS = 4 * MiB;
constexpr size_t WS_CS1 = 5 * MiB;
constexpr size_t WS_CS2 = 6 * MiB + 512 * 1024;
constexpr size_t WS_CSIN = 6 * MiB;
constexpr size_t WS_W = 8 * MiB, W_LAYER = 209 * MiB;
constexpr size_t WO_WIN = 0, WO_WBR = 12 * MiB, WO_WOUT = 15 * MiB, WO_W1 = 17 * MiB, WO_W2 = 145 * MiB;
constexpr size_t WS_PROJ = 426 * MiB;
constexpr size_t WS_GATES = 810 * MiB;
constexpr size_t WS_ACT = WS_PROJ;
constexpr size_t WS_X = 1002 * MiB;
constexpr size_t WS_H = 1194 * MiB;
constexpr size_t WS_O = 1322 * MiB;
constexpr size_t WS_Y = 1514 * MiB;
constexpr size_t WS_BITS = 1770 * MiB;
constexpr size_t WS_Y2 = WS_O;
constexpr size_t WS_SSP = 1850 * MiB;
constexpr size_t WS_ROWTOK = 1854 * MiB;
constexpr size_t WS_TOKINFO = 1862 * MiB;
constexpr size_t WS_SLAB = 1864 * MiB;
constexpr size_t WS_END = 1928 * MiB;
static_assert(WS_Y2 + (size_t)270336 * 2048 <= WS_SSP && WS_W + 2 * W_LAYER <= WS_PROJ && WS_PROJ + (size_t)MTOK * PLD * 2 <= WS_GATES && WS_GATES + (size_t)MTOK * 3072 <= WS_H, "d_ws map");
constexpr int CW_BAR = 4096;
constexpr int CW_CNT = 16384;

constexpr int RING_BYTES = 131072;
constexpr int MISC_OFF = 134144;
constexpr int TS_OFF = MISC_OFF + 512;
constexpr int TILE_E_OFF = MISC_OFF + 1024;
constexpr int ROWIDX_OFF = MISC_OFF + 5632;
constexpr int LDS_BYTES = 151552;
static_assert(ROWIDX_OFF + 8192 <= LDS_BYTES, "LDS map");

struct Args {
    const float* in[21]; float* out; unsigned char* ws; int ph_lo, ph_hi;
};
struct Frame {
    LAS unsigned char* lds; int tid, lane, wave, vcu, G;
};
__device__ __forceinline__ Frame phase_frame(const Frame& F0) { Frame F = F0; int t = F0.wave * 64 + lane_id_volatile(3); asm volatile("" : "+v"(t)); F.tid = t; F.lane = t & 63; F.wave = F0.wave; return F; }
template <class T> __device__ __forceinline__ T* opq(T* p) { long z = 0; asm volatile("" : "+s"(z)); return (T*)((unsigned char*)p + z); }

__device__ __forceinline__ void p0_mod(const Frame& F, const float* c, const float* w_ada, const float* b_ada, float* MOD) {
    LAS float* csT = (LAS float*)F.lds;
    for (int i = F.tid; i < BATCH * DM; i += 512) { const int b = i & 31, k = i >> 5; const float v = c[b * DM + k]; csT[k * 32 + b] = v * sigmoidf_(v); }
    __syncthreads();
    const int gw = F.vcu * 8 + F.wave, NGW = F.G * 8;
    const int cg = F.lane & 15, kq = F.lane >> 4;
    for (int task = gw; task < DEPTH * 384; task += NGW) {
        const int l = task / 384, n = (task % 384) * 16 + cg;
        float acc[32];
#pragma unroll
        for (int b = 0; b < 32; ++b) acc[b] = 0.f;
        const float* w = w_ada + ((size_t)l * DM + kq * 256) * (6 * DM) + n;
#pragma unroll 4
        for (int k = 0; k < 256; ++k) {
            const float wv = w[(size_t)k * (6 * DM)];
            const LAS f32x4* cs = (const LAS f32x4*)(csT + (kq * 256 + k) * 32);
#pragma unroll
            for (int q = 0; q < 8; ++q) { const f32x4 c4 = cs[q]; acc[4 * q] += c4[0] * wv; acc[4 * q + 1] += c4[1] * wv; acc[4 * q + 2] += c4[2] * wv; acc[4 * q + 3] += c4[3] * wv; }
        }
#pragma unroll
        for (int b = 0; b < 32; ++b) { acc[b] = xor32_add(xor16_add(acc[b])); }
        if (kq == 0) { const float bb = b_ada[l * 6 * DM + n];
#pragma unroll
            for (int b = 0; b < 32; ++b) MOD[((size_t)l * BATCH + b) * (6 * DM) + n] = acc[b] + bb; }
    }
    __syncthreads();
}
__device__ __forceinline__ void tr_item(const float* W, size_t ldw, int srccol, bool valid, bf16_t* dst  , int K, LAS float* scr, int lane) {
    const float* wp = W + srccol;
#pragma unroll 8
    for (int i = 0; i < 32; ++i) { const int kk = 2 * i + (lane >> 5); scr[kk * 33 + (lane & 31)] = valid ? wp[(size_t)kk * ldw] : 0.f; }
    LDS_WAIT(); asm volatile("" ::: "memory");
    const int c = lane & 7;
#pragma unroll
    for (int j = 0; j < 4; ++j) { const int n = (lane >> 3) + 8 * j; const LAS float* s = scr + (8 * c) * 33 + n;
        u32x4 o; o.x = cvt_pk_bf16(s[0 * 33], s[1 * 33]); o.y = cvt_pk_bf16(s[2 * 33], s[3 * 33]); o.z = cvt_pk_bf16(s[4 * 33], s[5 * 33]); o.w = cvt_pk_bf16(s[6 * 33], s[7 * 33]);
        *(u32x4*)(dst + (size_t)n * K + 8 * c) = o; }
    LDS_WAIT(); asm volatile("" ::: "memory");
}
__device__ __forceinline__ void p0_weights(const Frame& F, const Args& a) {
    LAS float* scr = (LAS float*)(F.lds + F.wave * 16384);
    const int gw = F.vcu * 8 + F.wave, NGW = F.G * 8, lane = F.lane, jl = lane & 31;
    const float *w_in = a.in[8], *w_branch = a.in[13], *w_out = a.in[14], *w_router = a.in[15], *w1 = a.in[17], *w2 = a.in[19];
    constexpr int I_BR = 3 * 8 * 32, I_OUT = 16 * 32, I_RT = 16;
    constexpr int I_LAYER = I_BR + I_OUT + I_RT;
    for (int it = gw; it < DEPTH * I_LAYER; it += NGW) {
        const int l = it / I_LAYER; int r = it - l * I_LAYER;
        unsigned char* wl = a.ws + WS_W + (size_t)l * W_LAYER;
        if (r < I_BR) {
            const int br = r / 256, q = r % 256, kb = q / 32, nb = q % 32;
            tr_item(w_branch + ((size_t)(l * 3 + br) * 512 + kb * 64) * DM, DM, nb * 32 + jl, true, (bf16_t*)(wl + WO_WBR) + (size_t)(br * 1024 + nb * 32) * 512 + kb * 64, 512, scr, lane); continue; }
        r -= I_BR;
        if (r < I_OUT) {
            const int kb = r / 32, nb = r % 32;
            tr_item(w_out + ((size_t)l * DM + kb * 64) * DM, DM, nb * 32 + jl, true, (bf16_t*)(wl + WO_WOUT) + (size_t)nb * 32 * DM + kb * 64, DM, scr, lane); continue; }
        r -= I_OUT;
        {
            const int kb = r;
            tr_item(w_router + ((size_t)l * DM + kb * 64) * NE, NE, jl, true, (bf16_t*)(a.ws + WS_WRT) + (size_t)l * NE * DM + kb * 64, DM, scr, lane); }
        (void)r;
    }
    __syncthreads();
    {
    LAS float* T = (LAS float*)F.lds; LAS float* red = (LAS float*)(F.lds + ROWIDX_OFF);
    const int half = lane >> 5, wave = F.wave;
    constexpr int ST_W1 = NE * 64, ST_IN = 192, ST_W2 = NE * 32, ST_LAYER = ST_W1 + ST_IN + ST_W2;
#define STRIP_PARAMS(st_, wp, ldw, valid, dst, csp) do { const int l = (st_) / ST_LAYER, q = (st_) % ST_LAYER; valid = true; \
        if (q < ST_W1) { const int e = q / 64, r6 = q % 64, pn = r6 >> 3, jjg = (r6 >> 1) & 3, sgl = r6 & 1, nb = pn * 8 + sgl * 4 + jjg, n = nb * 32 + jl, src = 2 * (128 * pn + jjg * 32 + jl) + sgl; \
            wp = w1 + ((size_t)(l * NE + e) * DM) * (2 * FF) + src; ldw = 2 * FF; \
            dst = (signed char*)(a.ws + WS_W + (size_t)l * W_LAYER + WO_W1) + ((size_t)e * 2048 + nb * 32) * DM; csp = (float*)(a.ws + WS_CS1) + ((size_t)l * NE + e) * 2048 + n; } \
        else if (q >= ST_W1 + ST_IN) { const int q2 = q - ST_W1 - ST_IN, e = q2 / 32, nb = q2 % 32, n = nb * 32 + jl; \
            wp = w2 + ((size_t)(l * NE + e) * FF) * DM + n; ldw = DM; \
            dst = (signed char*)(a.ws + WS_W + (size_t)l * W_LAYER + WO_W2) + ((size_t)e * DM + nb * 32) * FF; csp = (float*)(a.ws + WS_CS2) + ((size_t)l * NE + e) * DM + n; } \
        else { const int nb = q - ST_W1, n = nb * 32 + jl; valid = (n < 1832) || (n >= 2048); const int src = n < 1832 ? n : n - 216; \
            wp = w_in + (size_t)l * DM * 5928 + (valid ? src : 0); ldw = 5928; \
            dst = (signed char*)(a.ws + WS_W + (size_t)l * W_LAYER + WO_WIN) + (size_t)nb * 32 * DM; csp = (float*)(a.ws + WS_CSIN) + (size_t)l * NPROJ + n; } } while (0)
#define STRIP_LOAD(vv, ib, wp, ldw, valid) do { _Pragma("unroll") for (int i = 0; i < 32; ++i) { const int k = wave * 128 + 2 * ((ib) * 32 + i) + half; vv[i] = valid ? __builtin_nontemporal_load(wp + (size_t)k * ldw) : 0.f; } } while (0)
    float v0[32];
    { const int st = F.vcu < DEPTH * ST_LAYER ? F.vcu : DEPTH * ST_LAYER - 1; const float* wp; size_t ldw; bool valid; signed char* dst; float* csp; STRIP_PARAMS(st, wp, ldw, valid, dst, csp); (void)dst; (void)csp; STRIP_LOAD(v0, 0, wp, ldw, valid); }
    for (int st = F.vcu; st < DEPTH * ST_LAYER; st += F.G) {
        const float* wp; size_t ldw; bool valid; signed char* dst; float* csp;
        STRIP_PARAMS(st, wp, ldw, valid, dst, csp);
        float am = 0.f;
        { float v1[32]; STRIP_LOAD(v1, 1, wp, ldw, valid);
#pragma unroll
          for (int i = 0; i < 32; ++i) { const int k = wave * 128 + 2 * i + half; am = fmaxf(am, fabsf(v0[i])); T[k * 32 + (jl ^ (k & 31))] = v0[i]; }
#pragma unroll
          for (int i = 0; i < 32; ++i) { const int k = wave * 128 + 2 * (32 + i) + half; am = fmaxf(am, fabsf(v1[i])); T[k * 32 + (jl ^ (k & 31))] = v1[i]; } }
        red[(wave * 2 + half) * 32 + jl] = am;
        lds_barrier();
        { const int stn = st + F.G; if (stn < DEPTH * ST_LAYER) { const float* wpn; size_t ldwn; bool validn; signed char* dstn; float* cspn; STRIP_PARAMS(stn, wpn, ldwn, validn, dstn, cspn); (void)dstn; (void)cspn; STRIP_LOAD(v0, 0, wpn, ldwn, validn); } }
        float amx = 0.f;
#pragma unroll
        for (int p = 0; p < 16; ++p) amx = fmaxf(amx, red[p * 32 + jl]);
        const float scale = valid ? fmaxf(amx, 1e-30f) * (1.f / 127.f) : 1.f, inv = valid ? 1.f / scale : 0.f;
        if (wave == 0 && half == 0) *csp = scale;
        const int k0 = 64 * (wave * 2 + half);
#pragma unroll
        for (int c16 = 0; c16 < 4; ++c16) { unsigned wq[4];
#pragma unroll
            for (int d4 = 0; d4 < 4; ++d4) { const int k = k0 + c16 * 16 + d4 * 4;
                wq[d4] = q8x4(T[k * 32 + (jl ^ (k & 31))], T[(k + 1) * 32 + (jl ^ ((k + 1) & 31))], T[(k + 2) * 32 + (jl ^ ((k + 2) & 31))], T[(k + 3) * 32 + (jl ^ ((k + 3) & 31))], inv); }
            *(u32x4*)(dst + (size_t)jl * DM + k0 + c16 * 16) = (u32x4){wq[0], wq[1], wq[2], wq[3]}; }
        lds_barrier();
    }
#undef STRIP_PARAMS
#undef STRIP_LOAD
    }
    const float* sg_w = a.in[10]; bf16_t* SGW = (bf16_t*)(a.ws + WS_SGW);
    for (int i = (F.vcu * 512 + F.tid) * 2; i < DEPTH * 8 * 128 * 128; i += F.G * 512 * 2) { const int s = i & 127, t = (i >> 7) & 127; const f32x2 v = *(const f32x2*)(sg_w + i);
        *(unsigned*)(SGW + i) = cvt_pk_bf16(s <= t ? v[0] : 0.f, (s + 1) <= t ? v[1] : 0.f); }
}

__device__ __forceinline__ void norm_mod_row(const f32x4 (&v)[4], float ss, const float* g, const float* sc, const float* sh, signed char* orow, float* rs, int lane) {
    const float rstd = 1.f / sqrtf(ss * (1.f / DM) + RMS_EPS);
    f32x4 o[4]; float am = 0.f;
#pragma unroll
    for (int j = 0; j < 4; ++j) { const int c = 4 * lane + 256 * j; const f32x4 gg = *(const f32x4*)(g + c), s1 = *(const f32x4*)(sc + c), s0 = *(const f32x4*)(sh + c);
        o[j] = (v[j] * rstd) * gg * (s1 + 1.f) + s0;
        am = fmaxf(am, fmaxf(fmaxf(fabsf(o[j][0]), fabsf(o[j][1])), fmaxf(fabsf(o[j][2]), fabsf(o[j][3])))); }
    am = wave_max(am);
    const float scale = fmaxf(am, 1e-30f) * (1.f / 127.f), inv = 1.f / scale;
    if (lane == 0) *rs = scale;
#pragma unroll
    for (int j = 0; j < 4; ++j) *(unsigned*)(orow + 4 * lane + 256 * j) = q8x4(o[j][0], o[j][1], o[j][2], o[j][3], inv);
}
__device__ __forceinline__ void p1_norm(const Frame& F, const float* x, const float* g, const float* MOD0, signed char* H8, float* RS, bf16_t* X16) {
    const int gw = F.vcu * 8 + F.wave, NGW = F.G * 8, lane = F.lane;
    const int r_lo = (int)((long)(MTOK / 4) * gw / NGW) * 4, r_hi = (int)((long)(MTOK / 4) * (gw + 1) / NGW) * 4;
    f32x4 N2[4], N3[4]; int bcur = (r_lo < MTOK ? r_lo : MTOK - 1) >> 11;
#define P1_PARAMS(b_) do { const float* mb_ = MOD0 + (size_t)(b_) * 6 * DM; _Pragma("unroll") for (int j = 0; j < 4; ++j) { const int c = 4 * lane + 256 * j; \
        const f32x4 gg = *(const f32x4*)(g + c), s1 = *(const f32x4*)(mb_ + DM + c), s0 = *(const f32x4*)(mb_ + c); N2[j] = gg * (s1 + 1.f); N3[j] = s0; } } while (0)
    P1_PARAMS(bcur);
    for (int row0 = r_lo; row0 < r_hi; row0 += 4) { f32x4 v[4][4];
        if ((row0 >> 11) != bcur) { bcur = row0 >> 11; P1_PARAMS(bcur); }
#pragma unroll
        for (int rr = 0; rr < 4; ++rr)
#pragma unroll
            for (int j = 0; j < 4; ++j) v[rr][j] = __builtin_nontemporal_load((const f32x4*)(x + (size_t)(row0 + rr) * DM + 4 * lane + 256 * j));
        float ss[4], am[4]; f32x4 o[4][4];
#pragma unroll
        for (int rr = 0; rr < 4; ++rr) { ss[rr] = 0.f;
#pragma unroll
            for (int j = 0; j < 4; ++j) ss[rr] += (v[rr][j][0] * v[rr][j][0] + v[rr][j][1] * v[rr][j][1]) + (v[rr][j][2] * v[rr][j][2] + v[rr][j][3] * v[rr][j][3]); }
#pragma unroll
        for (int rr = 0; rr < 4; ++rr) ss[rr] = wave_sum(ss[rr]);
#pragma unroll
        for (int rr = 0; rr < 4; ++rr) { const int row = row0 + rr; const float rstd = 1.f / sqrtf(ss[rr] * (1.f / DM) + RMS_EPS); am[rr] = 0.f;
#pragma unroll
            for (int j = 0; j < 4; ++j) { u32x2 w; w.x = cvt_pk_bf16(v[rr][j][0], v[rr][j][1]); w.y = cvt_pk_bf16(v[rr][j][2], v[rr][j][3]); *(u32x2*)(X16 + (size_t)row * DM + 4 * lane + 256 * j) = w;
                o[rr][j] = (v[rr][j] * rstd) * N2[j] + N3[j];
                am[rr] = fmaxf(am[rr], fmaxf(fmaxf(fabsf(o[rr][j][0]), fabsf(o[rr][j][1])), fmaxf(fabsf(o[rr][j][2]), fabsf(o[rr][j][3])))); } }
#pragma unroll
        for (int rr = 0; rr < 4; ++rr) am[rr] = wave_max(am[rr]);
#pragma unroll
        for (int rr = 0; rr < 4; ++rr) { const int row = row0 + rr; const float scale = fmaxf(am[rr], 1e-30f) * (1.f / 127.f), inv = 1.f / scale;
            if (lane == 0) RS[row] = scale;
#pragma unroll
            for (int j = 0; j < 4; ++j) *(unsigned*)(H8 + (size_t)row * DM + 4 * lane + 256 * j) = q8x4(o[rr][j][0], o[rr][j][1], o[rr][j][2], o[rr][j][3], inv); } }
#undef P1_PARAMS
}
constexpr int TOPK_SEL = 256;
struct IdxOps { bf16x8 af[4][2]; u32x4 wraw[4][2]; bf16x8 kf[4][2]; };
__device__ __forceinline__ void dsa_index_load(IdxOps& P, const bf16_t* __restrict__ PROJ, int b, int qg, int lane, int wid) {
    asm volatile("" : "+v"(lane));
    const int n = lane & 31, hi = lane >> 5;
    const int q0 = qg * 16;
    const size_t tokbase = (size_t)b * SEQ;
    const int m = n, hm = (m >> 2) & 1, idx = (m & 3) + 4 * (m >> 3), aq = 2 * hm + (idx >> 3), ah = idx & 7;
#pragma unroll
    for (int qgp = 0; qgp < 4; ++qgp) { const bf16_t* qp = PROJ + (tokbase + q0 + 4 * qgp + aq) * PLD + C_QI + ah * 32 + 8 * hi;
        P.af[qgp][0] = *(const bf16x8*)qp; P.af[qgp][1] = *(const bf16x8*)(qp + 16); }
}
__device__ __forceinline__ void dsa_index_load_k(IdxOps& P, const bf16_t* __restrict__ PROJ, int b, int qg, int lane, int wid) {
    asm volatile("" : "+v"(lane));
    const int n = lane & 31, hi = lane >> 5;
    const int q0 = qg * 16, nkb = (q0 + 16 + 31) >> 5;
    const size_t tokbase = (size_t)b * SEQ;
#pragma unroll
    for (int qgp = 0; qgp < 4; ++qgp)
#pragma unroll
        for (int qq = 0; qq < 2; ++qq) P.wraw[qgp][qq] = *(const u32x4*)(PROJ + (tokbase + q0 + 4 * qgp + 2 * hi + qq) * PLD + C_WI);
#pragma unroll
    for (int i = 0; i < 4; ++i) { const int kb = wid + 8 * i;
        if (kb < nkb) { const bf16_t* kp = PROJ + (tokbase + 32 * kb + n) * PLD + C_KI + 8 * hi; P.kf[i][0] = *(const bf16x8*)kp; P.kf[i][1] = *(const bf16x8*)(kp + 16); } }
}
__device__ __forceinline__ void dsa_index_scores(IdxOps& P, const bf16_t* __restrict__ PROJ, LAS float* sc, int b, int qg, int lane, int wid) {
    const int n = lane & 31, hi = lane >> 5;
    const int q0 = qg * 16, nkb = (q0 + 16 + 31) >> 5;
    const size_t tokbase = (size_t)b * SEQ;
    LAS float* scw = sc + (2 * hi) * 2048 + 32 * wid + n;
    float wv[4][16];
#pragma unroll
    for (int qgp = 0; qgp < 4; ++qgp)
#pragma unroll
        for (int qq = 0; qq < 2; ++qq) { const u32x4 w = P.wraw[qgp][qq];
            wv[qgp][8 * qq + 0] = bf_lo(w.x) * 0.0625f; wv[qgp][8 * qq + 1] = bf_hi(w.x) * 0.0625f; wv[qgp][8 * qq + 2] = bf_lo(w.y) * 0.0625f; wv[qgp][8 * qq + 3] = bf_hi(w.y) * 0.0625f;
            wv[qgp][8 * qq + 4] = bf_lo(w.z) * 0.0625f; wv[qgp][8 * qq + 5] = bf_hi(w.z) * 0.0625f; wv[qgp][8 * qq + 6] = bf_lo(w.w) * 0.0625f; wv[qgp][8 * qq + 7] = bf_hi(w.w) * 0.0625f; }
#pragma unroll
    for (int i = 0; i < 8; ++i) { const int kb = wid + 8 * i;
        if (kb < nkb) {
            const bf16x8 k0 = P.kf[i & 3][0], k1 = P.kf[i & 3][1];
            if (i < 4 && kb + 32 < nkb) { const bf16_t* kp = PROJ + (tokbase + 32 * (kb + 32) + n) * PLD + C_KI + 8 * hi; P.kf[i & 3][0] = *(const bf16x8*)kp; P.kf[i & 3][1] = *(const bf16x8*)(kp + 16); }
#pragma unroll
            for (int qgp = 0; qgp < 4; ++qgp) {
                f32x16 d = {0.f, 0.f, 0.f, 0.f, 0.f, 0.f, 0.f, 0.f, 0.f, 0.f, 0.f, 0.f, 0.f, 0.f, 0.f, 0.f};
                d = __builtin_amdgcn_mfma_f32_32x32x16_bf16(P.af[qgp][0], k0, d, 0, 0, 0);
                d = __builtin_amdgcn_mfma_f32_32x32x16_bf16(P.af[qgp][1], k1, d, 0, 0, 0);
                float sa = 0.f, sb = 0.f;
#pragma unroll
                for (int r = 0; r < 8; ++r) { sa += wv[qgp][r] * fmaxf(d[r], 0.f); sb += wv[qgp][8 + r] * fmaxf(d[8 + r], 0.f); }
                scw[(4 * qgp) * 2048 + 256 * i] = sa; scw[(4 * qgp + 1) * 2048 + 256 * i] = sb;
            } } }
}
__device__ __forceinline__ void bit_transpose32(unsigned (&a)[32]) {
#pragma unroll
    for (int k = 0; k < 16; ++k) { const unsigned lo = a[k], hi = a[k + 16];
        a[k] = __builtin_amdgcn_perm(hi, lo, 0x05040100u); a[k + 16] = __builtin_amdgcn_perm(hi, lo, 0x07060302u); }
#pragma unroll
    for (int k = 0; k < 32; ++k) if ((k & 8) == 0) { const unsigned lo = a[k], hi = a[k + 8];
        a[k] = __builtin_amdgcn_perm(hi, lo, 0x06020400u); a[k + 8] = __builtin_amdgcn_perm(hi, lo, 0x07030501u); }
#pragma unroll
    for (int s = 0; s < 3; ++s) { const int j = 4 >> s; const unsigned m = (s == 0) ? 0x0F0F0F0Fu : (s == 1) ? 0x33333333u : 0x55555555u;
#pragma unroll
        for (int k = 0; k < 32; ++k) if ((k & j) == 0) { const unsigned lo = a[k], hi = a[k + j];
            a[k] = (m & lo) | (~m & (hi << j)); a[k + j] = (m & (lo >> j)) | (~m & hi); } }
}
__device__ __forceinline__ void dsa_index_select(LAS float* sc, LAS int* qctr, unsigned long long* __restrict__ bits64, int b, int qg, int lane, int wid) {
    const int q0 = qg * 16;
    const size_t tokbase = (size_t)b * SEQ;
#pragma unroll 1
    for (;;) {
        int qn = 0; if (lane == 0) qn = __hip_atomic_fetch_add(qctr, 1, __ATOMIC_RELAXED, __HIP_MEMORY_SCOPE_WORKGROUP);
        qn = __builtin_amdgcn_readfirstlane(qn); if (qn >= 16) break;
        const int ql = 15 - qn, pos = q0 + ql, nn = pos + 1, nr = (nn + 63) >> 6;
        const LAS float* scq = sc + ql * 2048;
        unsigned mlo = 0u, mhi = 0u;
        if (nn <= TOPK_SEL) {
#pragma unroll
            for (int r = 0; r < 4; ++r) if (r < nr) { const unsigned long long bal = __ballot(64 * r + lane <= pos); asm volatile("s_nop 4\n\tv_writelane_b32 %0, %2, %4\n\tv_writelane_b32 %1, %3, %4" : "+v"(mlo), "+v"(mhi) : "s"((unsigned)bal), "s"((unsigned)(bal >> 32)), "n"(r));     }
        } else {
            unsigned u[32];
#pragma unroll
            for (int r = 0; r < 32; ++r) u[r] = 0u;
#pragma unroll
            for (int g8 = 0; g8 < 4; ++g8) if (8 * g8 < nr) {
#pragma unroll
                for (int q_ = 0; q_ < 8; ++q_) { const int r = 8 * g8 + q_; const int j = 64 * r + lane; float s = scq[j]; s = (s == 0.f) ? 0.f : s; const unsigned bts = __builtin_bit_cast(unsigned, s);
                    const unsigned uu = (bts & 0x80000000u) ? ~bts : (bts | 0x80000000u); u[r] = (j <= pos) ? uu : 0u; } }
            unsigned M = 0u;
#pragma unroll
            for (int r = 0; r < 32; ++r) M |= (64 * r + lane <= pos) ? (1u << r) : 0u;
            bit_transpose32(u);
            unsigned G = 0u; unsigned need = (unsigned)TOPK_SEL, cM = (unsigned)nn;
            {
#pragma unroll
            for (int bq = 31; bq >= 0; --bq) {
                const unsigned T = M & u[bq];
                const unsigned c = wave_sum_u32((unsigned)__builtin_popcount(T));
                const bool ge = c >= need;
                G |= ge ? 0u : T; M = ge ? T : (M & ~u[bq]); cM = ge ? c : cM - c; need -= ge ? 0u : c;
                if (cM == need) { G |= M; goto sel_done; }
            }
            unsigned run = 0u;
#pragma unroll
            for (int r = 0; r < 32; ++r) if (r < nr) { const bool isc = (M >> r) & 1u; const unsigned long long eqm = __ballot(isc);
                const unsigned pre = run + __builtin_amdgcn_mbcnt_hi((unsigned)(eqm >> 32), __builtin_amdgcn_mbcnt_lo((unsigned)eqm, 0u));
                if (isc && pre < need) G |= (1u << r);
                run += (unsigned)__builtin_popcountll(eqm); }
            }
            sel_done:
#pragma unroll
            for (int r = 0; r < 32; ++r) if ((r & ~7) < nr) { const unsigned long long bal = __ballot((G >> r) & 1u); asm volatile("s_nop 4\n\tv_writelane_b32 %0, %2, %4\n\tv_writelane_b32 %1, %3, %4" : "+v"(mlo), "+v"(mhi) : "s"((unsigned)bal), "s"((unsigned)(bal >> 32)), "n"(r));     }
        }
        if (lane < nr) bits64[(tokbase + pos) * 32 + lane] = ((unsigned long long)mhi << 32) | mlo;
    }
}
__device__ __forceinline__ void dsa_index_phase(const Frame& F, const bf16_t* __restrict__ PROJ, unsigned long long* __restrict__ bits64, unsigned* stampw, bool pv = false) {
    LAS float* sc = (LAS float*)F.lds;
    LAS int* qctr = (LAS int*)(F.lds + TS_OFF);
    IdxOps P;
    int u = F.vcu;
    if (u < 4096) { dsa_index_load(P, PROJ, u & 31, u >> 5, F.lane, F.wave); dsa_index_load_k(P, PROJ, u & 31, u >> 5, F.lane, F.wave); }
#ifdef T_STAMP
    unsigned long long tA = 0, tB = 0, tC = 0, tD = 0, t0 = __builtin_amdgcn_s_memrealtime(), t1;
#define STAMP(acc) do { t1 = __builtin_amdgcn_s_memrealtime(); acc += t1 - t0; t0 = t1; } while (0)
#else
#define STAMP(acc) do { } while (0)
#endif
#pragma unroll 1
    for (; u < 4096; u += F.G) {
#if defined(IDX_PROBE) && (IDX_PROBE & 1)
        if (!pv)
#endif
        dsa_index_scores(P, PROJ, sc, u & 31, u >> 5, F.lane, F.wave);
        if (F.tid == 0) *qctr = 0;
        STAMP(tA);
        __syncthreads();
        STAMP(tB);
        const int un = u + F.G;
#if defined(IDX_PROBE) && (IDX_PROBE & 2)
        if (!pv)
#endif
        dsa_index_select(sc, qctr, bits64, u & 31, u >> 5, F.lane, F.wave);
        asm volatile("" ::: "memory");
        if (un < 4096) { dsa_index_load(P, PROJ, un & 31, un >> 5, F.lane, F.wave); dsa_index_load_k(P, PROJ, un & 31, un >> 5, F.lane, F.wave); }
        STAMP(tC);
        __syncthreads();
        STAMP(tD);
    }
#ifdef T_STAMP
    if (stampw && blockIdx.x == 17 && F.tid == 0) { const unsigned long long tot = tA + tB + tC + tD; const unsigned long long part = (T_STAMP == 0) ? tA : (T_STAMP == 1) ? tB : (T_STAMP == 2) ? tC : tD;
        *stampw = (unsigned)((part * 64ull) / (tot ? tot : 1ull)); }
#endif
#undef STAMP
}

constexpr int KS = 144, VS = 192;
#ifndef USE_TR
#define USE_TR 1
#endif
struct AttnPre { bf16x8 qf[4]; u32x4 kreg, vreg; u32x2 mreg; };
__device__ __forceinline__ void attn_decode(int u, int& b, int& g, int& qb) { const int cu = u & 255, j = u >> 8, bg = cu >> 2, s = cu & 3; qb = (j & 1) ? (8 * (j >> 1) + 7 - s) : (8 * (j >> 1) + s); b = bg >> 1; g = bg & 1; }
template <int MODE>
__device__ __forceinline__ void attn_prefetch(const Frame& F, const bf16_t* __restrict__ PROJ, const unsigned* __restrict__ bits, int b, int g, int qb, bf16x8 (&qf)[4], u32x4& kreg, u32x4& vreg, u32x2& mreg) {
    const int tid = F.tid, lane = F.lane, wid = F.wave, n = lane & 31, hi = lane >> 5;
    constexpr int CQ = MODE ? C_QB : C_QA, CK = MODE ? C_KB : C_KA, CV = MODE ? C_VB : C_VA;
    const int hq = 4 * g + (wid >> 1), qpos = qb * 64 + 32 * (wid & 1) + n;
    const size_t tokbase = (size_t)b * SEQ;
    const int kt_lo = (MODE == 0) ? (qb >= 2 ? qb - 2 : 0) : 0;
    const int srow = tid >> 3, sch = tid & 7;
    kreg = *(const u32x4*)(PROJ + (tokbase + srow + (size_t)kt_lo * 64) * PLD + CK + g * 64 + sch * 8);
    vreg = *(const u32x4*)(PROJ + (tokbase + srow + (size_t)kt_lo * 64) * PLD + CV + g * 64 + sch * 8);
    if (MODE == 1) mreg = *(const u32x2*)(bits + (tokbase + qpos) * 64 + 2 * kt_lo);
    const bf16_t* qp = PROJ + (tokbase + qpos) * PLD + CQ + hq * 64 + 8 * hi;
#pragma unroll
    for (int s = 0; s < 4; ++s) qf[s] = *(const bf16x8*)(qp + 16 * s);
}
template <int MODE>
__device__ __forceinline__ void attn_unit(const Frame& F, const bf16_t* __restrict__ PROJ, bf16_t* __restrict__ O, const unsigned* __restrict__ bits, const float* __restrict__ sinks, int b, int g, int qb, AttnPre& P, int un  ) {
    const int tid = F.tid, lane = F.lane, wid = F.wave, n = lane & 31, hi = lane >> 5;
    constexpr int CQ = MODE ? C_QB : C_QA, CK = MODE ? C_KB : C_KA, CV = MODE ? C_VB : C_VA;
    const int hq = 4 * g + (wid >> 1), qpos = qb * 64 + 32 * (wid & 1) + n;
    const size_t tokbase = (size_t)b * SEQ;
    LAS unsigned char* Ks = F.lds; LAS unsigned char* Vs = F.lds + 64 * KS;
    bf16x8 qf[4], qn[4];
#pragma unroll
    for (int s = 0; s < 4; ++s) { qf[s] = P.qf[s]; qn[s] = P.qf[s]; }
    f32x16 o0, o1;
#pragma unroll
    for (int r = 0; r < 16; ++r) { o0[r] = 0.f; o1[r] = 0.f; }
    float mrun, lsum;
    if (MODE == 0) { mrun = sinks[hq] * LOG2E; lsum = (hi == 0) ? 1.f : 0.f; } else { mrun = -1e30f; lsum = 0.f; }
    const int kt_lo = (MODE == 0) ? (qb >= 2 ? qb - 2 : 0) : 0, kt_hi = qb;
    const int srow = tid >> 3, sch = tid & 7;
    const bf16_t* kg = PROJ + (tokbase + srow) * PLD + CK + g * 64 + sch * 8;
    const bf16_t* vg = PROJ + (tokbase + srow) * PLD + CV + g * 64 + sch * 8;
    const unsigned* bp = bits + (tokbase + qpos) * 64;
    u32x4 kreg = P.kreg, vreg = P.vreg;
    u32x2 mreg = {0u, 0u};
    if (MODE == 1) mreg = P.mreg;
    const int vbase = (4 * hi + ((lane & 15) >> 2)) * VS + (16 * ((lane >> 4) & 1) + 4 * (lane & 3)) * 2;
    for (int kt = kt_lo; kt <= kt_hi; ++kt) {
        __syncthreads();
        *(LAS u32x4*)(Ks + srow * KS + sch * 16) = kreg; *(LAS u32x4*)(Vs + srow * VS + sch * 16) = vreg;
        const u32x2 mcur = mreg;
        __syncthreads();
        if (kt < kt_hi) { kreg = *(const u32x4*)(kg + (size_t)(kt + 1) * 64 * PLD); vreg = *(const u32x4*)(vg + (size_t)(kt + 1) * 64 * PLD); if (MODE == 1) mreg = *(const u32x2*)(bp + 2 * (kt + 1)); }
        else if (un < 2048) { int nb, ng, nqb; attn_decode(un, nb, ng, nqb); attn_prefetch<MODE>(F, PROJ, bits, nb, ng, nqb, qn, kreg, vreg, mreg); }
        f32x16 p0, p1;
#pragma unroll
        for (int r = 0; r < 16; ++r) { p0[r] = 0.f; p1[r] = 0.f; }
#pragma unroll
        for (int s = 0; s < 4; ++s) { const bf16x8 k0 = *(const LAS bf16x8*)(Ks + n * KS + (16 * s + 8 * hi) * 2), k1 = *(const LAS bf16x8*)(Ks + (n + 32) * KS + (16 * s + 8 * hi) * 2);
            p0 = __builtin_amdgcn_mfma_f32_32x32x16_bf16(k0, qf[s], p0, 0, 0, 0); p1 = __builtin_amdgcn_mfma_f32_32x32x16_bf16(k1, qf[s], p1, 0, 0, 0); }
        unsigned w0, w1;
        if (MODE == 1) { w0 = mcur.x >> (4 * hi); w1 = mcur.y >> (4 * hi); }
        else {
#pragma unroll
            for (int blk = 0; blk < 2; ++blk) { const int d0 = qpos - (kt * 64 + 32 * blk); unsigned mk = 0u;
                if (d0 >= 0) { const int hb = d0 > 31 ? 31 : d0; int lo = d0 - 127; if (lo <= 31) { if (lo < 0) lo = 0; mk = (0xFFFFFFFFu >> (31 - hb)) & (0xFFFFFFFFu << lo); } }
                if (blk == 0) w0 = mk >> (4 * hi); else w1 = mk >> (4 * hi); }
        }
        float mx = fmaxf(fmaxf(p0[0], p0[1]), fmaxf(p1[0], p1[1]));
#pragma unroll
        for (int r = 2; r < 16; r += 2) mx = fmaxf(mx, fmaxf(fmaxf(p0[r], p0[r + 1]), fmaxf(p1[r], p1[r + 1])));
        mx = xor32_max(mx);
        const float mnew = fmaxf(mrun, mx), alpha = fexp2(mrun - mnew); mrun = mnew;
        float ps = 0.f;
#pragma unroll
        for (int r = 0; r < 16; ++r) { const int bitpos = 8 * (r >> 2) + (r & 3);
            const float e0 = fexp2(p0[r] - mnew), e1 = fexp2(p1[r] - mnew);
            p0[r] = __builtin_bit_cast(float, __builtin_bit_cast(unsigned, e0) & (unsigned)__builtin_amdgcn_sbfe((int)w0, bitpos, 1));
            p1[r] = __builtin_bit_cast(float, __builtin_bit_cast(unsigned, e1) & (unsigned)__builtin_amdgcn_sbfe((int)w1, bitpos, 1));
            ps += p0[r] + p1[r]; }
        lsum = lsum * alpha + ps;
        if (__builtin_amdgcn_ballot_w64(alpha != 1.f) != 0ull) {
#pragma unroll
            for (int r = 0; r < 16; ++r) { o0[r] *= alpha; o1[r] *= alpha; } }
        bf16x8 pf[2][2];
#pragma unroll
        for (int s2 = 0; s2 < 2; ++s2) { u32x4 a, c;
            a.x = cvt_pk_bf16(p0[8 * s2 + 0], p0[8 * s2 + 1]); a.y = cvt_pk_bf16(p0[8 * s2 + 2], p0[8 * s2 + 3]); a.z = cvt_pk_bf16(p0[8 * s2 + 4], p0[8 * s2 + 5]); a.w = cvt_pk_bf16(p0[8 * s2 + 6], p0[8 * s2 + 7]);
            c.x = cvt_pk_bf16(p1[8 * s2 + 0], p1[8 * s2 + 1]); c.y = cvt_pk_bf16(p1[8 * s2 + 2], p1[8 * s2 + 3]); c.z = cvt_pk_bf16(p1[8 * s2 + 4], p1[8 * s2 + 5]); c.w = cvt_pk_bf16(p1[8 * s2 + 6], p1[8 * s2 + 7]);
            pf[0][s2] = __builtin_bit_cast(bf16x8, a); pf[1][s2] = __builtin_bit_cast(bf16x8, c); }
#pragma unroll
        for (int db = 0; db < 2; ++db)
#pragma unroll
            for (int blk = 0; blk < 2; ++blk)
#pragma unroll
                for (int s2 = 0; s2 < 2; ++s2) {
                    bf16x8 vf;
#if USE_TR
                    const v4i16_t t0 = __builtin_amdgcn_ds_read_tr16_b64_v4i16((LAS v4i16_t*)(Vs + vbase + (32 * blk + 16 * s2) * VS + 64 * db));
                    const v4i16_t t1 = __builtin_amdgcn_ds_read_tr16_b64_v4i16((LAS v4i16_t*)(Vs + vbase + (32 * blk + 16 * s2 + 8) * VS + 64 * db));
                    vf = (bf16x8){t0[0], t0[1], t0[2], t0[3], t1[0], t1[1], t1[2], t1[3]};
#else
#pragma unroll
                    for (int j = 0; j < 8; ++j) vf[j] = *(const LAS short*)(Vs + (32 * blk + 16 * s2 + 8 * (j >> 2) + 4 * hi + (j & 3)) * VS + (32 * db + n) * 2);
#endif
                    if (db == 0) o0 = __builtin_amdgcn_mfma_f32_32x32x16_bf16(vf, pf[blk][s2], o0, 0, 0, 0); else o1 = __builtin_amdgcn_mfma_f32_32x32x16_bf16(vf, pf[blk][s2], o1, 0, 0, 0);
                }
    }
    const float lt = xor32_add(lsum), inv = 1.f / lt;
    bf16_t* op = O + (tokbase + qpos) * 512 + hq * 64 + 8 * hi;
#pragma unroll
    for (int db = 0; db < 2; ++db)
#pragma unroll
        for (int kp = 0; kp < 2; ++kp) { const int r0 = 8 * kp;
            unsigned ax, ay, bx, by;
            if (db == 0) { ax = cvt_pk_bf16(o0[r0] * inv, o0[r0 + 1] * inv); ay = cvt_pk_bf16(o0[r0 + 2] * inv, o0[r0 + 3] * inv); bx = cvt_pk_bf16(o0[r0 + 4] * inv, o0[r0 + 5] * inv); by = cvt_pk_bf16(o0[r0 + 6] * inv, o0[r0 + 7] * inv); }
            else { ax = cvt_pk_bf16(o1[r0] * inv, o1[r0 + 1] * inv); ay = cvt_pk_bf16(o1[r0 + 2] * inv, o1[r0 + 3] * inv); bx = cvt_pk_bf16(o1[r0 + 4] * inv, o1[r0 + 5] * inv); by = cvt_pk_bf16(o1[r0 + 6] * inv, o1[r0 + 7] * inv); }
            { auto r = __builtin_amdgcn_permlane32_swap(ax, bx, false, false); ax = r[0]; bx = r[1]; }
            { auto r = __builtin_amdgcn_permlane32_swap(ay, by, false, false); ay = r[0]; by = r[1]; }
            *(u32x4*)(op + 32 * db + 16 * kp) = (u32x4){ax, ay, bx, by}; }
#pragma unroll
    for (int s = 0; s < 4; ++s) P.qf[s] = qn[s];
    P.kreg = kreg; P.vreg = vreg; P.mreg = mreg;
}

struct SwaPre { bf16x8 qf[4]; u32x4 kreg[3], vreg[3]; };
__device__ __forceinline__ void swa_prefetch(const Frame& F, const bf16_t* __restrict__ PROJ, int b, int g, int qb, bf16x8 (&qf)[4], u32x4 (&kreg)[3], u32x4 (&vreg)[3]) {
    const int tid = F.tid, lane = F.lane, wid = F.wave, n = lane & 31, hi = lane >> 5;
    const int hq = 4 * g + (wid >> 1), qpos = qb * 64 + 32 * (wid & 1) + n;
    const size_t tokbase = (size_t)b * SEQ;
    const int srow = tid >> 3, sch = tid & 7;
#pragma unroll
    for (int i = 0; i < 3; ++i) { const int kt = qb - 2 + i;
        if (kt >= 0) { kreg[i] = *(const u32x4*)(PROJ + (tokbase + srow + (size_t)kt * 64) * PLD + C_KA + g * 64 + sch * 8); vreg[i] = *(const u32x4*)(PROJ + (tokbase + srow + (size_t)kt * 64) * PLD + C_VA + g * 64 + sch * 8); } }
    const bf16_t* qp = PROJ + (tokbase + qpos) * PLD + C_QA + hq * 64 + 8 * hi;
#pragma unroll
    for (int s = 0; s < 4; ++s) qf[s] = *(const bf16x8*)(qp + 16 * s);
}
__device__ __forceinline__ void swa_unit(const Frame& F, const bf16_t* __restrict__ PROJ, bf16_t* __restrict__ O, const float* __restrict__ sinks, int b, int g, int qb, SwaPre& P, int un  , bool pv = false) {
    const int tid = F.tid, lane = F.lane, wid = F.wave, n = lane & 31, hi = lane >> 5;
    const int hq = 4 * g + (wid >> 1), qpos = qb * 64 + 32 * (wid & 1) + n;
    const size_t tokbase = (size_t)b * SEQ;
    constexpr int TILE_B = 64 * KS + 64 * VS;
    bf16x8 qf[4], qn[4];
#pragma unroll
    for (int s = 0; s < 4; ++s) { qf[s] = P.qf[s]; qn[s] = P.qf[s]; }
    f32x16 o0, o1;
#pragma unroll
    for (int r = 0; r < 16; ++r) { o0[r] = 0.f; o1[r] = 0.f; }
    float mrun = sinks[hq] * LOG2E, lsum = (hi == 0) ? 1.f : 0.f;
    const int srow = tid >> 3, sch = tid & 7;
    __syncthreads();
#pragma unroll
    for (int i = 0; i < 3; ++i) if (qb - 2 + i >= 0) { *(LAS u32x4*)(F.lds + i * TILE_B + srow * KS + sch * 16) = P.kreg[i]; *(LAS u32x4*)(F.lds + i * TILE_B + 64 * KS + srow * VS + sch * 16) = P.vreg[i]; }
    __syncthreads();
    if (un < 2048) { int nb, ng, nqb; attn_decode(un, nb, ng, nqb); swa_prefetch(F, PROJ, nb, ng, nqb, qn, P.kreg, P.vreg); }
    const int vbase = (4 * hi + ((lane & 15) >> 2)) * VS + (16 * ((lane >> 4) & 1) + 4 * (lane & 3)) * 2;
#pragma unroll 1
#if defined(IDX_PROBE) && (IDX_PROBE & 32)
    if (!pv)
#endif
    for (int i = (qb >= 2 ? 0 : 2 - qb); i < 3; ++i) { const int kt = qb - 2 + i;
        LAS unsigned char* Ks = F.lds + i * TILE_B; LAS unsigned char* Vs = Ks + 64 * KS;
        f32x16 p0, p1;
#pragma unroll
        for (int r = 0; r < 16; ++r) { p0[r] = 0.f; p1[r] = 0.f; }
#pragma unroll
        for (int s = 0; s < 4; ++s) { const bf16x8 k0 = *(const LAS bf16x8*)(Ks + n * KS + (16 * s + 8 * hi) * 2), k1 = *(const LAS bf16x8*)(Ks + (n + 32) * KS + (16 * s + 8 * hi) * 2);
            p0 = __builtin_amdgcn_mfma_f32_32x32x16_bf16(k0, qf[s], p0, 0, 0, 0); p1 = __builtin_amdgcn_mfma_f32_32x32x16_bf16(k1, qf[s], p1, 0, 0, 0); }
        unsigned w0 = 0u, w1 = 0u;
#pragma unroll
        for (int blk = 0; blk < 2; ++blk) { const int d0 = qpos - (kt * 64 + 32 * blk); unsigned mk = 0u;
            if (d0 >= 0) { const int hb = d0 > 31 ? 31 : d0; int lo = d0 - 127; if (lo <= 31) { if (lo < 0) lo = 0; mk = (0xFFFFFFFFu >> (31 - hb)) & (0xFFFFFFFFu << lo); } }
            if (blk == 0) w0 = mk >> (4 * hi); else w1 = mk >> (4 * hi); }
        float mx = fmaxf(fmaxf(p0[0], p0[1]), fmaxf(p1[0], p1[1]));
#pragma unroll
        for (int r = 2; r < 16; r += 2) mx = fmaxf(mx, fmaxf(fmaxf(p0[r], p0[r + 1]), fmaxf(p1[r], p1[r + 1])));
        mx = xor32_max(mx);
        const float mnew = fmaxf(mrun, mx), alpha = fexp2(mrun - mnew); mrun = mnew;
        float ps = 0.f;
#pragma unroll
        for (int r = 0; r < 16; ++r) { const int bitpos = 8 * (r >> 2) + (r & 3);
            const float e0 = fexp2(p0[r] - mnew), e1 = fexp2(p1[r] - mnew);
            p0[r] = __builtin_bit_cast(float, __builtin_bit_cast(unsigned, e0) & (unsigned)__builtin_amdgcn_sbfe((int)w0, bitpos, 1));
            p1[r] = __builtin_bit_cast(float, __builtin_bit_cast(unsigned, e1) & (unsigned)__builtin_amdgcn_sbfe((int)w1, bitpos, 1));
            ps += p0[r] + p1[r]; }
        lsum = lsum * alpha + ps;
        if (__builtin_amdgcn_ballot_w64(alpha != 1.f) != 0ull) {
#pragma unroll
            for (int r = 0; r < 16; ++r) { o0[r] *= alpha; o1[r] *= alpha; } }
        bf16x8 pf[2][2];
#pragma unroll
        for (int s2 = 0; s2 < 2; ++s2) { u32x4 a, c;
            a.x = cvt_pk_bf16(p0[8 * s2 + 0], p0[8 * s2 + 1]); a.y = cvt_pk_bf16(p0[8 * s2 + 2], p0[8 * s2 + 3]); a.z = cvt_pk_bf16(p0[8 * s2 + 4], p0[8 * s2 + 5]); a.w = cvt_pk_bf16(p0[8 * s2 + 6], p0[8 * s2 + 7]);
            c.x = cvt_pk_bf16(p1[8 * s2 + 0], p1[8 * s2 + 1]); c.y = cvt_pk_bf16(p1[8 * s2 + 2], p1[8 * s2 + 3]); c.z = cvt_pk_bf16(p1[8 * s2 + 4], p1[8 * s2 + 5]); c.w = cvt_pk_bf16(p1[8 * s2 + 6], p1[8 * s2 + 7]);
            pf[0][s2] = __builtin_bit_cast(bf16x8, a); pf[1][s2] = __builtin_bit_cast(bf16x8, c); }
#pragma unroll
        for (int db = 0; db < 2; ++db)
#pragma unroll
            for (int blk = 0; blk < 2; ++blk)
#pragma unroll
                for (int s2 = 0; s2 < 2; ++s2) {
                    const v4i16_t t0 = __builtin_amdgcn_ds_read_tr16_b64_v4i16((LAS v4i16_t*)(Vs + vbase + (32 * blk + 16 * s2) * VS + 64 * db));
                    const v4i16_t t1 = __builtin_amdgcn_ds_read_tr16_b64_v4i16((LAS v4i16_t*)(Vs + vbase + (32 * blk + 16 * s2 + 8) * VS + 64 * db));
                    const bf16x8 vf = (bf16x8){t0[0], t0[1], t0[2], t0[3], t1[0], t1[1], t1[2], t1[3]};
                    if (db == 0) o0 = __builtin_amdgcn_mfma_f32_32x32x16_bf16(vf, pf[blk][s2], o0, 0, 0, 0); else o1 = __builtin_amdgcn_mfma_f32_32x32x16_bf16(vf, pf[blk][s2], o1, 0, 0, 0);
                }
    }
    const float lt = xor32_add(lsum), inv = 1.f / lt;
    bf16_t* op = O + (tokbase + qpos) * 512 + hq * 64 + 8 * hi;
#pragma unroll
    for (int db = 0; db < 2; ++db)
#pragma unroll
        for (int kp = 0; kp < 2; ++kp) { const int r0 = 8 * kp;
            unsigned ax, ay, bx, by;
            if (db == 0) { ax = cvt_pk_bf16(o0[r0] * inv, o0[r0 + 1] * inv); ay = cvt_pk_bf16(o0[r0 + 2] * inv, o0[r0 + 3] * inv); bx = cvt_pk_bf16(o0[r0 + 4] * inv, o0[r0 + 5] * inv); by = cvt_pk_bf16(o0[r0 + 6] * inv, o0[r0 + 7] * inv); }
            else { ax = cvt_pk_bf16(o1[r0] * inv, o1[r0 + 1] * inv); ay = cvt_pk_bf16(o1[r0 + 2] * inv, o1[r0 + 3] * inv); bx = cvt_pk_bf16(o1[r0 + 4] * inv, o1[r0 + 5] * inv); by = cvt_pk_bf16(o1[r0 + 6] * inv, o1[r0 + 7] * inv); }
            { auto r = __builtin_amdgcn_permlane32_swap(ax, bx, false, false); ax = r[0]; bx = r[1]; }
            { auto r = __builtin_amdgcn_permlane32_swap(ay, by, false, false); ay = r[0]; by = r[1]; }
            *(u32x4*)(op + 32 * db + 16 * kp) = (u32x4){ax, ay, bx, by}; }
#pragma unroll
    for (int s = 0; s < 4; ++s) P.qf[s] = qn[s];
}

constexpr int SGS = 1040;
static_assert(128 * SGS <= MISC_OFF, "spatial-gating tile vs LDS control words");
__device__ __forceinline__ void sg_unit(const Frame& F, const bf16_t* __restrict__ PROJ, const bf16_t* __restrict__ SGWl, const float* __restrict__ sgb, const float* __restrict__ lng, bf16_t* __restrict__ OC, int b, int ch) {
    const int lane = F.lane, wid = F.wave, n = lane & 31, hi = lane >> 5;
    const size_t tok0 = (size_t)b * SEQ + ch * 128;
    LAS unsigned char* V = F.lds;
    __syncthreads();
    float gl[8];
    { const f32x4 g0 = *(const f32x4*)(lng + 8 * lane), g1 = *(const f32x4*)(lng + 8 * lane + 4); gl[0] = g0[0]; gl[1] = g0[1]; gl[2] = g0[2]; gl[3] = g0[3]; gl[4] = g1[0]; gl[5] = g1[1]; gl[6] = g1[2]; gl[7] = g1[3]; }
    u32x4 wrow16[16];
#pragma unroll
    for (int rr = 0; rr < 16; ++rr) wrow16[rr] = *(const u32x4*)(PROJ + (tok0 + 16 * wid + rr) * PLD + C_V + 8 * lane);
#pragma unroll
    for (int r4 = 0; r4 < 16; r4 += 4) { float x[4][8], s[4], q[4];
#pragma unroll
        for (int a = 0; a < 4; ++a) { const u32x4 w = wrow16[r4 + a];
            x[a][0] = bf_lo(w.x); x[a][1] = bf_hi(w.x); x[a][2] = bf_lo(w.y); x[a][3] = bf_hi(w.y); x[a][4] = bf_lo(w.z); x[a][5] = bf_hi(w.z); x[a][6] = bf_lo(w.w); x[a][7] = bf_hi(w.w);
            s[a] = ((x[a][0] + x[a][1]) + (x[a][2] + x[a][3])) + ((x[a][4] + x[a][5]) + (x[a][6] + x[a][7])); }
#pragma unroll
        for (int a = 0; a < 4; ++a) s[a] = wave_sum(s[a]) * (1.f / 512.f);
#pragma unroll
        for (int a = 0; a < 4; ++a) { q[a] = 0.f;
#pragma unroll
            for (int i = 0; i < 8; ++i) { x[a][i] -= s[a]; q[a] += x[a][i] * x[a][i]; } }
#pragma unroll
        for (int a = 0; a < 4; ++a) q[a] = wave_sum(q[a]);
#pragma unroll
        for (int a = 0; a < 4; ++a) { const int row = 16 * wid + r4 + a; const float rstd = 1.f / sqrtf(q[a] * (1.f / 512.f) + LN_EPS);
            u32x4 o; o.x = cvt_pk_bf16(x[a][0] * rstd * gl[0], x[a][1] * rstd * gl[1]); o.y = cvt_pk_bf16(x[a][2] * rstd * gl[2], x[a][3] * rstd * gl[3]);
            o.z = cvt_pk_bf16(x[a][4] * rstd * gl[4], x[a][5] * rstd * gl[5]); o.w = cvt_pk_bf16(x[a][6] * rstd * gl[6], x[a][7] * rstd * gl[7]);
            *(LAS u32x4*)(V + row * SGS + 16 * lane) = o; } }
    __syncthreads();
    const int g = wid;
    const int vbase = (8 * hi + ((lane & 15) >> 2)) * SGS + (g * 64 + 16 * ((lane >> 4) & 1) + 4 * (lane & 3)) * 2;
    const bf16_t* wg = SGWl + (size_t)g * 128 * 128;
#pragma unroll
    for (int tb = 0; tb < 4; ++tb) {
        f32x16 a0, a1;
#pragma unroll
        for (int r = 0; r < 16; ++r) { a0[r] = 0.f; a1[r] = 0.f; }
        const bf16_t* wrow = wg + (size_t)(32 * tb + n) * 128 + 8 * hi;
        bf16x8 afr[8];
#pragma unroll
        for (int ks = 0; ks < 8; ++ks) if (ks < 2 * tb + 2) afr[ks] = *(const bf16x8*)(wrow + 16 * ks);
        const int t = 32 * tb + n;
        const float bb = sgb[g * 128 + t];
        u32x2 uu[2][4];
        { const bf16_t* up = PROJ + (tok0 + t) * PLD + C_U + g * 64 + 4 * hi;
#pragma unroll
          for (int db = 0; db < 2; ++db)
#pragma unroll
              for (int q4 = 0; q4 < 4; ++q4) uu[db][q4] = *(const u32x2*)(up + 32 * db + 8 * q4); }
#pragma unroll
        for (int ks = 0; ks < 8; ++ks) if (ks < 2 * tb + 2) {
            const bf16x8 af = afr[ks];
#pragma unroll
            for (int db = 0; db < 2; ++db) { bf16x8 vf;
#if USE_TR
                const v4i16_t t0 = __builtin_amdgcn_ds_read_tr16_b64_v4i16((LAS v4i16_t*)(V + vbase + (16 * ks) * SGS + 64 * db));
                const v4i16_t t1 = __builtin_amdgcn_ds_read_tr16_b64_v4i16((LAS v4i16_t*)(V + vbase + (16 * ks + 4) * SGS + 64 * db));
                vf = (bf16x8){t0[0], t0[1], t0[2], t0[3], t1[0], t1[1], t1[2], t1[3]};
#else
#pragma unroll
                for (int j = 0; j < 8; ++j) vf[j] = *(const LAS short*)(V + (16 * ks + 8 * hi + j) * SGS + (g * 64 + 32 * db + n) * 2);
#endif
                if (db == 0) a0 = __builtin_amdgcn_mfma_f32_32x32x16_bf16(vf, af, a0, 0, 0, 0); else a1 = __builtin_amdgcn_mfma_f32_32x32x16_bf16(vf, af, a1, 0, 0, 0); }
        }
        bf16_t* op = OC + (tok0 + t) * 512 + g * 64 + 8 * hi;
#pragma unroll
        for (int db = 0; db < 2; ++db)
#pragma unroll
            for (int kp = 0; kp < 2; ++kp) { const int r0 = 8 * kp; float v[8];
#pragma unroll
                for (int i = 0; i < 8; ++i) { const u32x2 uw = uu[db][2 * kp + (i >> 2)]; const unsigned wd = (i & 2) ? uw.y : uw.x; const float uf = (i & 1) ? bf_hi(wd) : bf_lo(wd);
                    v[i] = ((db == 0 ? a0[r0 + i] : a1[r0 + i]) + bb) * uf; }
                unsigned ax = cvt_pk_bf16(v[0], v[1]), ay = cvt_pk_bf16(v[2], v[3]), bx = cvt_pk_bf16(v[4], v[5]), by = cvt_pk_bf16(v[6], v[7]);
                { auto r = __builtin_amdgcn_permlane32_swap(ax, bx, false, false); ax = r[0]; bx = r[1]; }
                { auto r = __builtin_amdgcn_permlane32_swap(ay, by, false, false); ay = r[0]; by = r[1]; }
                *(u32x4*)(op + 32 * db + 16 * kp) = (u32x4){ax, ay, bx, by}; }
    }
}
constexpr int HS_STRIDE = 2064;
constexpr int P7_PART = 32 * HS_STRIDE;
constexpr int P7_LOG = P7_PART + 8 * 4096;
constexpr int P7_HIST = P7_LOG + 32 * 33 * 4;
__device__ __forceinline__ void p7_route(const Frame& F, const Args& a, int l, bf16_t* X16  , const bf16_t* Y, const float* SSP, const float* MODl, signed char* H8, float* RS,
                                         const bf16_t* WRTl, unsigned* cnt, int* ROWTOK, unsigned* TOKINFO) {
    const int tid = F.tid, lane = F.lane, wid = F.wave, n = lane & 31, hi = lane >> 5;
    const float* g_post = a.in[5] + l * DM; const float* g_pre = a.in[6] + l * DM; const float* b_router = a.in[16] + l * NE;
    LAS unsigned char* hs = F.lds; LAS float* part = (LAS float*)(F.lds + P7_PART); LAS float* lg = (LAS float*)(F.lds + P7_LOG); LAS int* hist = (LAS int*)(F.lds + P7_HIST); LAS int* base = hist + 32;
    if (tid < 32) hist[tid] = 0;
    __syncthreads();
    const int NBT = MTOK / 32, bt0 = (int)((long)NBT * F.vcu / F.G), bt1 = (int)((long)NBT * (F.vcu + 1) / F.G);
    bf16x8 wbf[8];
#pragma unroll
    for (int ks = 0; ks < 8; ++ks) wbf[ks] = *(const bf16x8*)(WRTl + (size_t)n * DM + (8 * wid + ks) * 16 + 8 * hi);
    const float brv = b_router[tid & 31];
    f32x4 A1[4], A2[4], A3[4]; int bcur = (bt0 < NBT ? bt0 : NBT - 1) >> 6;
#define P7_PARAMS(b_) do { const float* mb_ = MODl + (size_t)(b_) * 6 * DM; _Pragma("unroll") for (int j = 0; j < 4; ++j) { const int c = 4 * lane + 256 * j; \
        const f32x4 gp = *(const f32x4*)(g_post + c), ga = *(const f32x4*)(mb_ + 2 * DM + c), gg = *(const f32x4*)(g_pre + c), s1 = *(const f32x4*)(mb_ + 4 * DM + c), s0 = *(const f32x4*)(mb_ + 3 * DM + c); \
        A1[j] = ga * gp; A2[j] = gg * (s1 + 1.f); A3[j] = s0; } } while (0)
    P7_PARAMS(bcur);
    u32x2 yv[4][4], xv[4][4]; float s4v[4];
#define P7_LOAD(bt_) do { _Pragma("unroll") for (int rr = 0; rr < 4; ++rr) { const size_t row = (size_t)(bt_) * 32 + 4 * wid + rr; s4v[rr] = SSP[(size_t)(lane & 15) * MTOK + row]; \
        _Pragma("unroll") for (int j = 0; j < 4; ++j) { const int c = 4 * lane + 256 * j; yv[rr][j] = __builtin_nontemporal_load((const u32x2*)(Y + row * DM + c)); xv[rr][j] = __builtin_nontemporal_load((const u32x2*)(X16 + row * DM + c)); } } } while (0)
    P7_LOAD(bt0 < NBT ? bt0 : NBT - 1);
    for (int bt = bt0; bt < bt1; ++bt) {
        const int row0 = bt * 32, b = row0 >> 11;
        if (b != bcur) { bcur = b; P7_PARAMS(b); }
#pragma unroll
        for (int rr = 0; rr < 4; ++rr) { const int rl = 4 * wid + rr; const size_t row = (size_t)row0 + rl;
            float ssy = s4v[rr]; ssy += dpp_f<0xB1>(ssy); ssy += dpp_f<0x4E>(ssy); ssy += dpp_f<0x141>(ssy); ssy += dpp_f<0x140>(ssy);
            const float rstd1 = 1.f / sqrtf(ssy * (1.f / DM) + RMS_EPS);
            f32x4 v[4]; float ss = 0.f;
#pragma unroll
            for (int j = 0; j < 4; ++j) { const int c = 4 * lane + 256 * j; const u32x2 yw_ = yv[rr][j]; const u32x2 xw_ = xv[rr][j]; const f32x4 yy = {bf_lo(yw_.x), bf_hi(yw_.x), bf_lo(yw_.y), bf_hi(yw_.y)}, xx = {bf_lo(xw_.x), bf_hi(xw_.x), bf_lo(xw_.y), bf_hi(xw_.y)};
                v[j] = xx + A1[j] * (yy * rstd1); { u32x2 xo; xo.x = cvt_pk_bf16(v[j][0], v[j][1]); xo.y = cvt_pk_bf16(v[j][2], v[j][3]); *(u32x2*)(X16 + row * DM + c) = xo; }
                ss += (v[j][0] * v[j][0] + v[j][1] * v[j][1]) + (v[j][2] * v[j][2] + v[j][3] * v[j][3]); }
            ss = wave_sum(ss);
            const float rstd = 1.f / sqrtf(ss * (1.f / DM) + RMS_EPS);
            f32x4 o[4]; float am = 0.f;
#pragma unroll
            for (int j = 0; j < 4; ++j) { const int c = 4 * lane + 256 * j;
                o[j] = (v[j] * rstd) * A2[j] + A3[j]; u32x2 w; w.x = cvt_pk_bf16(o[j][0], o[j][1]); w.y = cvt_pk_bf16(o[j][2], o[j][3]);
                *(LAS u32x2*)(hs + rl * HS_STRIDE + c * 2) = w;
                am = fmaxf(am, fmaxf(fmaxf(fabsf(o[j][0]), fabsf(o[j][1])), fmaxf(fabsf(o[j][2]), fabsf(o[j][3])))); }
            am = wave_max(am);
            const float scale = fmaxf(am, 1e-30f) * (1.f / 127.f), inv = 1.f / scale;
            if (lane == 0) RS[row] = scale;
#pragma unroll
            for (int j = 0; j < 4; ++j) *(unsigned*)(H8 + row * DM + 4 * lane + 256 * j) = q8x4(o[j][0], o[j][1], o[j][2], o[j][3], inv); }
        if (bt + 1 < bt1) P7_LOAD(bt + 1);
        lds_barrier();
        {
            f32x16 d;
#pragma unroll
            for (int r = 0; r < 16; ++r) d[r] = 0.f;
#pragma unroll
            for (int ks = 0; ks < 8; ++ks) { const int k0 = (8 * wid + ks) * 16 + 8 * hi;
                const bf16x8 af = *(const LAS bf16x8*)(hs + n * HS_STRIDE + k0 * 2);
                d = __builtin_amdgcn_mfma_f32_32x32x16_bf16(af, wbf[ks], d, 0, 0, 0); }
#pragma unroll
            for (int r = 0; r < 16; ++r) part[wid * 1024 + (8 * (r >> 2) + 4 * hi + (r & 3)) * 32 + n] = d[r];
        }
        lds_barrier();
        for (int i = tid; i < 1024; i += 512) { float s = brv;
#pragma unroll
            for (int w = 0; w < 8; ++w) s += part[w * 1024 + i]; lg[(i >> 5) * 33 + (i & 31)] = s; }
        lds_barrier();
        int e_k[4] = {0, 0, 0, 0}, lp_k[4] = {0, 0, 0, 0}; float w_k[4] = {0.f, 0.f, 0.f, 0.f};
        if (tid < 32) { LAS float* mylg = lg + tid * 33; float tl[4];
#pragma unroll
            for (int k = 0; k < 4; ++k) { float best = -INFINITY; int bi = 0;
                for (int e = 0; e < 32; ++e) { const float vv = mylg[e]; if (vv > best) { best = vv; bi = e; } }
                tl[k] = best; e_k[k] = bi; mylg[bi] = -INFINITY; }
            float sum = 0.f;
#pragma unroll
            for (int k = 0; k < 4; ++k) { w_k[k] = __expf(tl[k] - tl[0]); sum += w_k[k]; }
            const float inv = 1.f / sum;
#pragma unroll
            for (int k = 0; k < 4; ++k) { w_k[k] *= inv; lp_k[k] = __hip_atomic_fetch_add(&hist[e_k[k]], 1, __ATOMIC_RELAXED, __HIP_MEMORY_SCOPE_WORKGROUP); } }
        lds_barrier();
        if (tid < 32) { const int hc = hist[tid]; base[tid] = hc > 0 ? (int)__hip_atomic_fetch_add(cnt + 64 * tid, (unsigned)hc, __ATOMIC_RELAXED, __HIP_MEMORY_SCOPE_AGENT) : 0; hist[tid] = 0; }
        lds_barrier();
        if (tid < 32) { const int token = row0 + tid; u32x4 info; f32x4 ww;
#pragma unroll
            for (int k = 0; k < 4; ++k) { const int pos = base[e_k[k]] + lp_k[k]; ROWTOK[e_k[k] * 65536 + pos] = token; info[k] = ((unsigned)e_k[k] << 17) | (unsigned)pos; ww[k] = w_k[k]; }
            *(u32x4*)(TOKINFO + (size_t)token * 8) = info; *(f32x4*)(TOKINFO + (size_t)token * 8 + 4) = ww; }
        lds_barrier();
    }
#undef P7_PARAMS
#undef P7_LOAD
}

__device__ __forceinline__ int moe_tables(const Frame& F, unsigned* cnt) {
    LAS int* ts = (LAS int*)(F.lds + TS_OFF); LAS int* te = (LAS int*)(F.lds + TILE_E_OFF);
    __syncthreads();
    if (F.tid == 0) { int acc = 0; for (int e = 0; e < NE; ++e) { ts[e] = acc; const unsigned c = __hip_atomic_load(cnt + 64 * e, __ATOMIC_RELAXED, __HIP_MEMORY_SCOPE_AGENT); acc += (int)((c + 255u) >> 8); } ts[NE] = acc; }
    __syncthreads();
    const int RT = ts[NE];
    for (int rt = F.tid; rt < RT; rt += 512) { int e = 0;
#pragma unroll 1
        for (int q = 1; q < NE; ++q) e += (ts[q] <= rt) ? 1 : 0;
        te[rt] = e; }
    __syncthreads();
    return RT;
}

__device__ __forceinline__ void p10_combine(const Frame& F, const Args& a, int l, bf16_t* X16, float* out, const bf16_t* Y2, const unsigned* TOKINFO, const float* MODbase, signed char* H8, float* RS) {
    const int lane = F.lane; const LAS int* ts = (const LAS int*)(F.lds + TS_OFF);
    const float* g_postf = a.in[7] + l * DM;
    const int gw = F.vcu * 8 + F.wave, NGW = F.G * 8;
    const int r_lo = (int)((long)(MTOK / 2) * gw / NGW) * 2, r_hi = (int)((long)(MTOK / 2) * (gw + 1) / NGW) * 2;
    f32x4 A1[4], N2[4], N3[4]; int bcur = (r_lo < MTOK ? r_lo : MTOK - 1) >> 11;
#define P10_PARAMS(b_) do { const float* mb_ = MODbase + ((size_t)l * BATCH + (b_)) * 6 * DM; const float* mb1_ = MODbase + ((size_t)(l + 1 < DEPTH ? l + 1 : l) * BATCH + (b_)) * 6 * DM; const float* g1_ = a.in[4] + (l + 1 < DEPTH ? l + 1 : l) * DM; \
        _Pragma("unroll") for (int j = 0; j < 4; ++j) { const int c = 4 * lane + 256 * j; const f32x4 gp = *(const f32x4*)(g_postf + c), ga = *(const f32x4*)(mb_ + 5 * DM + c); A1[j] = ga * gp; \
            const f32x4 gg = *(const f32x4*)(g1_ + c), s1 = *(const f32x4*)(mb1_ + DM + c), s0 = *(const f32x4*)(mb1_ + c); N2[j] = gg * (s1 + 1.f); N3[j] = s0; } } while (0)
    P10_PARAMS(bcur);
    for (int rowp = r_lo; rowp < r_hi; rowp += 2) {
        if ((rowp >> 11) != bcur) { bcur = rowp >> 11; P10_PARAMS(bcur); }
        u32x4 info[2]; f32x4 ww[2]; u32x2 yw[2][4][4], xv[2][4];
#pragma unroll
        for (int rr = 0; rr < 2; ++rr) { info[rr] = *(const u32x4*)(TOKINFO + (size_t)(rowp + rr) * 8); ww[rr] = *(const f32x4*)(TOKINFO + (size_t)(rowp + rr) * 8 + 4); }
#pragma unroll
        for (int rr = 0; rr < 2; ++rr) {
#pragma unroll
            for (int k = 0; k < 4; ++k) { const int e = (int)(info[rr][k] >> 17), pos = (int)(info[rr][k] & 0x1ffffu); const size_t slot = (size_t)ts[e] * 256 + pos;
#pragma unroll
                for (int j = 0; j < 4; ++j) yw[rr][k][j] = __builtin_nontemporal_load((const u32x2*)(Y2 + slot * DM + 4 * lane + 256 * j)); }
#pragma unroll
            for (int j = 0; j < 4; ++j) xv[rr][j] = *(const u32x2*)(X16 + (size_t)(rowp + rr) * DM + 4 * lane + 256 * j); }
#pragma unroll
        for (int rr = 0; rr < 2; ++rr) { const int row = rowp + rr, b = row >> 11;
        f32x4 y[4];
#pragma unroll
        for (int j = 0; j < 4; ++j) y[j] = (f32x4){0.f, 0.f, 0.f, 0.f};
#pragma unroll
        for (int k = 0; k < 4; ++k) { const float wk = ww[rr][k];
#pragma unroll
            for (int j = 0; j < 4; ++j) { const u32x2 w = yw[rr][k][j];
                y[j][0] += wk * bf_lo(w.x); y[j][1] += wk * bf_hi(w.x); y[j][2] += wk * bf_lo(w.y); y[j][3] += wk * bf_hi(w.y); } }
        float ss = 0.f;
#pragma unroll
        for (int j = 0; j < 4; ++j) ss += (y[j][0] * y[j][0] + y[j][1] * y[j][1]) + (y[j][2] * y[j][2] + y[j][3] * y[j][3]);
        ss = wave_sum(ss);
        const float rstd = 1.f / sqrtf(ss * (1.f / DM) + RMS_EPS);
        f32x4 v[4]; float s2 = 0.f;
#pragma unroll
        for (int j = 0; j < 4; ++j) { const int c = 4 * lane + 256 * j; const u32x2 xw_ = xv[rr][j]; const f32x4 xx = {bf_lo(xw_.x), bf_hi(xw_.x), bf_lo(xw_.y), bf_hi(xw_.y)};
            v[j] = xx + A1[j] * (y[j] * rstd);
#ifdef T_STAMP
            if (l + 1 == DEPTH) v[j] = v[j] * (1.f + (float)(*((const unsigned*)MODbase - (1u << 18) + 100)) * (1.f / 256.f));
#endif
            if (l + 1 < DEPTH) { u32x2 xo; xo.x = cvt_pk_bf16(v[j][0], v[j][1]); xo.y = cvt_pk_bf16(v[j][2], v[j][3]); *(u32x2*)(X16 + (size_t)row * DM + c) = xo; }
            else *(f32x4*)(out + (size_t)row * DM + c) = v[j];
            s2 += (v[j][0] * v[j][0] + v[j][1] * v[j][1]) + (v[j][2] * v[j][2] + v[j][3] * v[j][3]); }
        if (l + 1 < DEPTH) { s2 = wave_sum(s2);
            const float rstd2 = 1.f / sqrtf(s2 * (1.f / DM) + RMS_EPS); f32x4 o[4]; float am = 0.f;
#pragma unroll
            for (int j = 0; j < 4; ++j) { o[j] = (v[j] * rstd2) * N2[j] + N3[j]; am = fmaxf(am, fmaxf(fmaxf(fabsf(o[j][0]), fabsf(o[j][1])), fmaxf(fabsf(o[j][2]), fabsf(o[j][3])))); }
            am = wave_max(am);
            const float scale = fmaxf(am, 1e-30f) * (1.f / 127.f), inv = 1.f / scale;
            if (lane == 0) RS[row] = scale;
#pragma unroll
            for (int j = 0; j < 4; ++j) *(unsigned*)(H8 + (size_t)row * DM + 4 * lane + 256 * j) = q8x4(o[j][0], o[j][1], o[j][2], o[j][3], inv); }
        }
    }
#undef P10_PARAMS
}
#ifndef MK_ONE_LAUNCH
#define MK_ONE_LAUNCH 1
#endif
constexpr int N_PHASES = 2 + 9 * DEPTH;
__global__ void __launch_bounds__(512, 2) fwd(Args args) {
    extern __shared__ __attribute__((aligned(16))) unsigned char lds_raw[];
    Frame F0;
    F0.lds = (LAS unsigned char*)lds_raw;
    F0.tid = threadIdx.x; F0.lane = F0.tid & 63; F0.wave = __builtin_amdgcn_readfirstlane(F0.tid >> 6);
    F0.G = gridDim.x; { const int bx = blockIdx.x; F0.vcu = (F0.G % 8 == 0) ? (bx % 8) * (F0.G / 8) + bx / 8 : bx; }
    volatile LAS unsigned* MISC = (volatile LAS unsigned*)(F0.lds + MISC_OFF);
    for (int u = F0.tid; u < 128; u += 512) MISC[u] = 0u;
    __syncthreads();
    unsigned* ctl = (unsigned*)(args.ws + WS_CTL);
    const int lo = args.ph_lo, hi = args.ph_hi;
    XcdBarrier bar; bar.bar = ctl + CW_BAR; bar.x = 0; bar.st = nullptr; bar.w = F0.wave;
    if (hi - lo > 1) bar = xcd_barrier_post(ctl + CW_BAR, MISC + 8, F0.wave);
#ifndef PHASE_MASK
#define PHASE_MASK 0x7ff
#endif
#define PHON(j) ((PHASE_MASK >> (j)) & 1)
#ifndef REPEAT_MASK
#define REPEAT_MASK 0
#endif
#define REP(j) for (int rep_ = 0; rep_ <= ((REPEAT_MASK >> (j)) & 1); ++rep_)
#define IN(k) (lo <= (k) && (k) < hi)
#define BOTH(k) (IN(k) && IN((k) + 1))
#define GRID_BAR() xcd_barrier(bar)
#define PH_BEGIN() const Frame F = phase_frame(F0); unsigned char* ws = opq(args.ws); (void)ws
    if (PHON(0) && IN(0)) REP(0) { PH_BEGIN(); p0_mod(F, args.in[1], args.in[2], args.in[3], (float*)(ws + WS_MOD)); p0_weights(F, args); if (BOTH(0)) GRID_BAR(); }
    if (PHON(1) && IN(1)) REP(1) { PH_BEGIN(); p1_norm(F, args.in[0], args.in[4], (const float*)(ws + WS_MOD), (signed char*)(ws + WS_H), (float*)(ws + WS_RS), (bf16_t*)(ws + WS_X)); if (BOTH(1)) GRID_BAR(); }

#pragma unroll 1
#ifndef EXTRA_PHASE
#define EXTRA_PHASE (-1)
#endif
#ifdef SKIP_EPI_PROBE
#define SKIPV ex_
#else
#define SKIPV false
#endif
#ifndef STAG_MASK
#define STAG_MASK 0
#endif
#ifndef STAG_TICKS
#define STAG_TICKS 240
#endif
#define STAGGER(j) do { if ((STAG_MASK >> (j)) & 1) { const unsigned long long t0_ = __builtin_amdgcn_s_memrealtime(), dl_ = (unsigned long long)(F.vcu / (F.G / 8)) * STAG_TICKS; while (__builtin_amdgcn_s_memrealtime() - t0_ < dl_) __builtin_amdgcn_s_sleep(8); } } while (0)
#ifndef EXTRA_MASK
#define EXTRA_MASK (EXTRA_PHASE >= 0 ? (1 << EXTRA_PHASE) : 0)
#endif
#define EXOK(j) (EXTRA_MASK == 0 || !ex_ || ((EXTRA_MASK >> (j)) & 1))
    for (int it_ = 0; it_ < DEPTH + (EXTRA_MASK != 0 ? 1 : 0); ++it_) {
        const int l = it_ < DEPTH ? it_ : DEPTH - 1; const bool ex_ = it_ >= DEPTH; (void)ex_;
        const int pb = 2 + 9 * l;
        if (PHON(2) && EXOK(2) && IN(pb + 0)) REP(2) { PH_BEGIN();
            pg8::Gemm g{(const bf16_t*)(ws + WS_H), (const bf16_t*)(ws + WS_W + (size_t)l * W_LAYER + WO_WIN), DM}; g.skip_epi = SKIPV; pg8::StaticOrder<MTOK / 256, NPROJ / 256> S; S.init(F.G, (int)blockIdx.x);
            EpiProj E{(bf16_t*)(ws + WS_PROJ), (unsigned char*)(ws + WS_GATES), (const float*)(ws + WS_RS), (const float*)(ws + WS_CSIN) + (size_t)l * NPROJ}; E.pv = ex_;
            STAGGER(2); pg8::gemm_phase<EpiProj, pg8::StaticOrder<MTOK / 256, NPROJ / 256>, false, true>(F.lds, g, S, E, F.wave);
            if (BOTH(pb + 0)) GRID_BAR();
        }
        if (PHON(3) && EXOK(3) && IN(pb + 1)) REP(3) {
#ifndef SUBREP
#define SUBREP 0
#endif
#ifndef IDX_PROBE
#define IDX_PROBE 0
#endif
            if (!((IDX_PROBE & 8) && ex_))
            { const Frame Fa = phase_frame(F0); const bf16_t* PROJa = (const bf16_t*)(opq(args.ws) + WS_PROJ); bf16_t* OAa = (bf16_t*)(opq(args.ws) + WS_O);
            SwaPre Pa;
#pragma unroll
            for (int i_ = 0; i_ < 3; ++i_) { Pa.kreg[i_] = (u32x4){0u, 0u, 0u, 0u}; Pa.vreg[i_] = (u32x4){0u, 0u, 0u, 0u}; }
            { int b_, g_, qb_; attn_decode(Fa.vcu < 2048 ? Fa.vcu : 2047, b_, g_, qb_); swa_prefetch(Fa, PROJa, b_, g_, qb_, Pa.qf, Pa.kreg, Pa.vreg); }
            for (int u = Fa.vcu; u < 2048; u += Fa.G) { int b_, g_, qb_; attn_decode(u, b_, g_, qb_);
                swa_unit(Fa, PROJa, OAa, args.in[9] + l * 8, b_, g_, qb_, Pa, u + Fa.G, ex_); } }
            if (!((IDX_PROBE & 16) && ex_))
            { const Frame Fb = phase_frame(F0); unsigned char* wsb = opq(args.ws);
            for (int u = Fb.vcu; u < 512; u += Fb.G)
                sg_unit(Fb, (const bf16_t*)(wsb + WS_PROJ), (const bf16_t*)(wsb + WS_SGW) + (size_t)l * 8 * 128 * 128, args.in[11] + l * 8 * 128, args.in[12] + l * 512, (bf16_t*)(wsb + WS_O) + (size_t)2 * MTOK * 512, u >> 4, u & 15); }
            __syncthreads();
            if (!((IDX_PROBE & 4) && ex_))
            { const Frame Fi = phase_frame(F0); unsigned char* wsi = opq(args.ws);
              dsa_index_phase(Fi, (const bf16_t*)(wsi + WS_PROJ), (unsigned long long*)(wsi + WS_BITS), l == 0 ? (unsigned*)(wsi + WS_CTL) + 100 : nullptr, ex_); }
            if (BOTH(pb + 1)) GRID_BAR();
        }
        if (PHON(4) && EXOK(4) && IN(pb + 2)) REP(4) { PH_BEGIN();
            AttnPre Pd; { int b_, g_, qb_; attn_decode(F.vcu < 2048 ? F.vcu : 2047, b_, g_, qb_); attn_prefetch<1>(F, (const bf16_t*)(ws + WS_PROJ), (const unsigned*)(ws + WS_BITS), b_, g_, qb_, Pd.qf, Pd.kreg, Pd.vreg, Pd.mreg); }
            for (int u = F.vcu; u < 2048; u += F.G) { int b_, g_, qb_; attn_decode(u, b_, g_, qb_);
                attn_unit<1>(F, (const bf16_t*)(ws + WS_PROJ), (bf16_t*)(ws + WS_O) + (size_t)MTOK * 512, (const unsigned*)(ws + WS_BITS), nullptr, b_, g_, qb_, Pd, u + F.G); }
            __syncthreads();
            if (BOTH(pb + 2)) GRID_BAR();
        }
        if (PHON(5) && EXOK(5) && IN(pb + 3)) REP(5) { PH_BEGIN();
            pg8::Gemm g{(const bf16_t*)(ws + WS_O), (const bf16_t*)(ws + WS_W + (size_t)l * W_LAYER + WO_WBR), 512}; g.skip_epi = SKIPV; BranchOrder S; S.so.init(F.G, (int)blockIdx.x);
            EpiBranch E{(const unsigned char*)(ws + WS_GATES), (bf16_t*)(ws + WS_H)};
            STAGGER(5); pg8::gemm_phase<EpiBranch, BranchOrder, false>(F.lds, g, S, E, F.wave);
            if (BOTH(pb + 3)) GRID_BAR();
        }
        if (PHON(6) && EXOK(6) && IN(pb + 4)) REP(6) { PH_BEGIN();
            pg8::Gemm g{(const bf16_t*)(ws + WS_H), (const bf16_t*)(ws + WS_W + (size_t)l * W_LAYER + WO_WOUT), DM}; g.skip_epi = SKIPV; pg8::StaticOrder<MTOK / 256, DM / 256> S; S.init(F.G, (int)blockIdx.x);
            EpiWout E{(bf16_t*)(ws + WS_Y), (float*)(ws + WS_SSP)}; E.pv = ex_;
            STAGGER(6); pg8::gemm_phase<EpiWout, pg8::StaticOrder<MTOK / 256, DM / 256>, false>(F.lds, g, S, E, F.wave);
            if (BOTH(pb + 4)) GRID_BAR();
        }
        if (PHON(7) && EXOK(7) && IN(pb + 5)) REP(7) { PH_BEGIN();
            p7_route(F, args, l, (bf16_t*)(ws + WS_X), (const bf16_t*)(ws + WS_Y), (const float*)(ws + WS_SSP), (const float*)(ws + WS_MOD) + (size_t)l * BATCH * 6 * DM, (signed char*)(ws + WS_H), (float*)(ws + WS_RS),
                     (const bf16_t*)(ws + WS_WRT) + (size_t)l * NE * DM, (unsigned*)(ws + WS_CTL) + CW_CNT + l * 32 * 64, (int*)(ws + WS_ROWTOK), (unsigned*)(ws + WS_TOKINFO));
            if (BOTH(pb + 5)) GRID_BAR();
        }
        if (PHON(8) && EXOK(8) && IN(pb + 6)) REP(8) { PH_BEGIN();
            unsigned* cnt = (unsigned*)(ws + WS_CTL) + CW_CNT + l * 32 * 64; const int* ROWTOK = (const int*)(ws + WS_ROWTOK);
            const int RT = moe_tables(F, cnt);
            LAS int* ts = (LAS int*)(F.lds + TS_OFF); LAS int* te = (LAS int*)(F.lds + TILE_E_OFF); LAS int* ri = (LAS int*)(F.lds + ROWIDX_OFF);
            const long U = (long)RT * 8; MoeOrder S; S.u0 = (int)(U * F.vcu / F.G); S.u1 = (int)(U * (F.vcu + 1) / F.G); S.NB = 8; S.rt_lo = S.u0 / 8; S.tile_e = te; S.rowidx = ri;
            if (S.u1 > S.u0) { const int rt_hi = (S.u1 - 1) / 8; int ntile = rt_hi - S.rt_lo + 1; if (ntile > 8) ntile = 8;
                for (int i = F.tid; i < ntile * 256; i += 512) { const int rt = S.rt_lo + (i >> 8), r = i & 255, e = te[rt], first = (rt - ts[e]) * 256 + r;
                    const int c = (int)__hip_atomic_load(cnt + 64 * e, __ATOMIC_RELAXED, __HIP_MEMORY_SCOPE_AGENT); ri[i] = first < c ? ROWTOK[e * 65536 + first] : 0; } }
            __syncthreads();
            pg8::Gemm g{(const bf16_t*)(ws + WS_H), (const bf16_t*)(ws + WS_W + (size_t)l * W_LAYER + WO_W1), DM}; g.skip_epi = SKIPV;
            EpiW1I8 E{(signed char*)(ws + WS_ACT), args.in[18] + (size_t)l * NE * 2 * FF, (const float*)(ws + WS_RS), (const float*)(ws + WS_CS1) + (size_t)l * NE * 2048, ri, S.rt_lo};
            STAGGER(8); pg8::gemm_phase<EpiW1I8, MoeOrder, true, true>(F.lds, g, S, E, F.wave);
            if (BOTH(pb + 6)) GRID_BAR();
        }
        if (PHON(9) && EXOK(9) && IN(pb + 7)) REP(9) { PH_BEGIN();
            const int RT = moe_tables(F, (unsigned*)(ws + WS_CTL) + CW_CNT + l * 32 * 64);
            const long U = (long)RT * 4; MoeOrder S; S.u0 = (int)(U * F.vcu / F.G); S.u1 = (int)(U * (F.vcu + 1) / F.G); S.NB = 4; S.rt_lo = 0; S.tile_e = (LAS int*)(F.lds + TILE_E_OFF); S.rowidx = nullptr;
            pg8::Gemm g{(const bf16_t*)(ws + WS_ACT), (const bf16_t*)(ws + WS_W + (size_t)l * W_LAYER + WO_W2), FF}; g.skip_epi = SKIPV;
            EpiW2 E{(bf16_t*)(ws + WS_Y2), args.in[20] + (size_t)l * NE * DM, (const float*)(ws + WS_CS2) + (size_t)l * NE * DM};
            STAGGER(9); pg8::gemm_phase<EpiW2, MoeOrder, false, true>(F.lds, g, S, E, F.wave);
            if (BOTH(pb + 7)) GRID_BAR();
        }
        if (PHON(10) && EXOK(10) && IN(pb + 8)) REP(10) { PH_BEGIN();
            (void)moe_tables(F, (unsigned*)(ws + WS_CTL) + CW_CNT + l * 32 * 64);
            p10_combine(F, args, l, (bf16_t*)(ws + WS_X), args.out, (const bf16_t*)(ws + WS_Y2), (const unsigned*)(ws + WS_TOKINFO), (const float*)(ws + WS_MOD), (signed char*)(ws + WS_H), (float*)(ws + WS_RS));
            if (BOTH(pb + 8)) GRID_BAR();
        }
    }
#undef PH_BEGIN
#undef IN
#undef BOTH
#undef GRID_BAR
}

extern "C" void kernel_launch(void* const* d_in, const int* in_sizes, int n_in, void* d_out, int out_size, void* d_ws, size_t ws_size, hipStream_t stream) {
    static int grid = 0;
    if (grid == 0) {
        if (n_in != 21 || out_size != MTOK * DM || ws_size < WS_END) { fprintf(stderr, "kernel_launch: unexpected shapes (n_in %d, out %d, ws %zu); nothing launched\n", n_in, out_size, ws_size); grid = -1; return; }
        int dev = 0, cus = 0, per_cu = 0;
        if (hipGetDevice(&dev) != hipSuccess || hipDeviceGetAttribute(&cus, hipDeviceAttributeMultiprocessorCount, dev) != hipSuccess) { grid = -1; return; }
        if (hipFuncSetAttribute((const void*)fwd, hipFuncAttributeMaxDynamicSharedMemorySize, LDS_BYTES) != hipSuccess) { fprintf(stderr, "kernel_launch: hipFuncSetAttribute failed\n"); grid = -1; return; }
        if (hipOccupancyMaxActiveBlocksPerMultiprocessor(&per_cu, (const void*)fwd, 512, LDS_BYTES) != hipSuccess || per_cu < 1) { fprintf(stderr, "kernel_launch: occupancy query says %d\n", per_cu); }
        (void)hipGetLastError();
        grid = cus > 256 ? 256 : cus;
    }
    if (grid < 0) return;
    (void)hipMemsetAsync((char*)d_ws + WS_CTL, 0, CTL_ZERO_BYTES, stream);
    Args a{};
    for (int i = 0; i < 21; ++i) a.in[i] = (const float*)d_in[i];
    a.out = (float*)d_out; a.ws = (unsigned char*)d_ws;
#if MK_ONE_LAUNCH
    a.ph_lo = 0; a.ph_hi = N_PHASES;
    hipLaunchKernelGGL(fwd, dim3(grid), dim3(512), LDS_BYTES, stream, a);
#else
    for (int p = 0; p < N_PHASES; ++p) { a.ph_lo = p; a.ph_hi = p + 1; hipLaunchKernelGGL(fwd, dim3(grid), dim3(512), LDS_BYTES, stream, a); }
#endif
}
```

```cpp
#include <hip/hip_runtime.h>
#include <cstdio>
#include <cstdint>
#include <type_traits>

#define LAS __attribute__((address_space(3)))
#define GAS __attribute__((address_space(1)))
typedef unsigned short bf16_t;
typedef short bf16x8 __attribute__((ext_vector_type(8)));
typedef float f32x2 __attribute__((ext_vector_type(2)));
typedef float f32x4 __attribute__((ext_vector_type(4)));
typedef float f32x16 __attribute__((ext_vector_type(16)));
typedef unsigned u32x2 __attribute__((ext_vector_type(2)));
typedef unsigned u32x4 __attribute__((ext_vector_type(4)));
typedef short v4i16_t __attribute__((ext_vector_type(4)));
typedef int i32x4 __attribute__((ext_vector_type(4)));

constexpr int BATCH = 32, SEQ = 2048, DM = 1024, MTOK = BATCH * SEQ, DEPTH = 2;
constexpr int NPROJ = 6144;
constexpr int PLD = 3072;
constexpr int C_QA = 0, C_KA = 512, C_VA = 640, C_QB = 768, C_KB = 1280, C_VB = 1408, C_QI = 1536, C_KI = 1792, C_WI = 1824, C_U = 2048, C_V = 2560, C_G = 3072;
constexpr int NE = 32, FF = 1024;
constexpr float RMS_EPS = 1e-5f, LN_EPS = 1e-5f;
constexpr float LOG2E = 1.4426950408889634f;
constexpr float QSCALE = 0.125f * LOG2E;

__device__ __forceinline__ unsigned f2bf(float f) { unsigned u = __builtin_bit_cast(unsigned, f); return (u + 0x7fffu + ((u >> 16) & 1u)) >> 16; }
__device__ __forceinline__ unsigned cvt_pk_bf16(float lo, float hi) { unsigned r; asm volatile("v_cvt_pk_bf16_f32 %0, %1, %2" : "=v"(r) : "v"(lo), "v"(hi)); return r; }
__device__ __forceinline__ float bf_lo(unsigned w) { return __builtin_bit_cast(float, w << 16); }
__device__ __forceinline__ float bf_hi(unsigned w) { return __builtin_bit_cast(float, w & 0xffff0000u); }
__device__ __forceinline__ float fexp2(float x) { return __builtin_amdgcn_exp2f(x); }
__device__ __forceinline__ float frcp(float x) { return __builtin_amdgcn_rcpf(x); }
__device__ __forceinline__ float sigmoidf_(float x) { return frcp(1.f + fexp2(-LOG2E * x)); }
__device__ __forceinline__ float gelu_tanh(float x) { const float t = x + 0.044715f * x * x * x; return x * frcp(1.f + fexp2(-2.302208198f * t)); }
template <int CTRL> __device__ __forceinline__ float dpp_f(float v) { return __builtin_bit_cast(float, __builtin_amdgcn_update_dpp(0, __builtin_bit_cast(int, v), CTRL, 0xF, 0xF, false)); }
__device__ __forceinline__ void swap32_asm(unsigned& a, unsigned& b) { asm volatile("s_nop 1\n\tv_permlane32_swap_b32 %0, %1" : "+v"(a), "+v"(b)); }
__device__ __forceinline__ float xor16_add(float v) { return v + __builtin_bit_cast(float, __builtin_amdgcn_ds_swizzle(__builtin_bit_cast(int, v), 0x401F)); }
__device__ __forceinline__ float xor16_max(float v) { return fmaxf(v, __builtin_bit_cast(float, __builtin_amdgcn_ds_swizzle(__builtin_bit_cast(int, v), 0x401F))); }
__device__ __forceinline__ float xor32_add(float v) { unsigned a = __builtin_bit_cast(unsigned, v), b = a; swap32_asm(a, b); return __builtin_bit_cast(float, a) + __builtin_bit_cast(float, b); }
__device__ __forceinline__ float xor32_max(float v) { unsigned a = __builtin_bit_cast(unsigned, v), b = a; swap32_asm(a, b); return fmaxf(__builtin_bit_cast(float, a), __builtin_bit_cast(float, b)); }
__device__ __forceinline__ float quad_sum(float v) { v += dpp_f<0xB1>(v); v += dpp_f<0x4E>(v); return v; }
__device__ __forceinline__ float wave_sum(float v) {
    v += dpp_f<0xB1>(v); v += dpp_f<0x4E>(v); v += dpp_f<0x141>(v); v += dpp_f<0x140>(v);
    return xor32_add(xor16_add(v));
}
__device__ __forceinline__ float wave_max(float v) {
    v = fmaxf(v, dpp_f<0xB1>(v)); v = fmaxf(v, dpp_f<0x4E>(v)); v = fmaxf(v, dpp_f<0x141>(v)); v = fmaxf(v, dpp_f<0x140>(v));
    return xor32_max(xor16_max(v));
}
__device__ __forceinline__ unsigned wave_sum_u32(unsigned v) {
    v += (unsigned)__builtin_amdgcn_update_dpp(0, (int)v, 0xB1, 0xF, 0xF, false);
    v += (unsigned)__builtin_amdgcn_update_dpp(0, (int)v, 0x4E, 0xF, 0xF, false);
    v += (unsigned)__builtin_amdgcn_update_dpp(0, (int)v, 0x141, 0xF, 0xF, false);
    v += (unsigned)__builtin_amdgcn_update_dpp(0, (int)v, 0x140, 0xF, 0xF, false);
    return __builtin_amdgcn_readlane(v, 0) + __builtin_amdgcn_readlane(v, 16) + __builtin_amdgcn_readlane(v, 32) + __builtin_amdgcn_readlane(v, 48);
}
__device__ __forceinline__ unsigned wave_max_u32(unsigned v) {
    unsigned t;
    t = (unsigned)__builtin_amdgcn_update_dpp(0, (int)v, 0xB1, 0xF, 0xF, false); v = v > t ? v : t;
    t = (unsigned)__builtin_amdgcn_update_dpp(0, (int)v, 0x4E, 0xF, 0xF, false); v = v > t ? v : t;
    t = (unsigned)__builtin_amdgcn_update_dpp(0, (int)v, 0x141, 0xF, 0xF, false); v = v > t ? v : t;
    t = (unsigned)__builtin_amdgcn_update_dpp(0, (int)v, 0x140, 0xF, 0xF, false); v = v > t ? v : t;
    unsigned a = __builtin_amdgcn_readlane(v, 0), b = __builtin_amdgcn_readlane(v, 16), c = __builtin_amdgcn_readlane(v, 32), d = __builtin_amdgcn_readlane(v, 48);
    a = a > b ? a : b; c = c > d ? c : d; return a > c ? a : c;
}
__device__ __forceinline__ void lds_barrier() { asm volatile("s_waitcnt lgkmcnt(0)\n\ts_barrier" ::: "memory"); }
__device__ __forceinline__ unsigned q8x4(float a, float b, float c, float d, float inv) {
    unsigned r = 0u;
#if 1
    r = __builtin_amdgcn_cvt_pk_u8_f32(fmaf(a, inv, 128.f), 0u, r);
    r = __builtin_amdgcn_cvt_pk_u8_f32(fmaf(b, inv, 128.f), 1u, r);
    r = __builtin_amdgcn_cvt_pk_u8_f32(fmaf(c, inv, 128.f), 2u, r);
    r = __builtin_amdgcn_cvt_pk_u8_f32(fmaf(d, inv, 128.f), 3u, r);
#else
    r = __builtin_amdgcn_cvt_pk_u8_f32(__builtin_rintf(fmaf(a, inv, 128.f)), 0u, r);
    r = __builtin_amdgcn_cvt_pk_u8_f32(__builtin_rintf(fmaf(b, inv, 128.f)), 1u, r);
    r = __builtin_amdgcn_cvt_pk_u8_f32(__builtin_rintf(fmaf(c, inv, 128.f)), 2u, r);
    r = __builtin_amdgcn_cvt_pk_u8_f32(__builtin_rintf(fmaf(d, inv, 128.f)), 3u, r);
#endif
    return r ^ 0x80808080u;
}
__device__ __forceinline__ unsigned u8x4_floor(float a, float b, float c, float d) {
    unsigned r = 0u;
#if 1
    r = __builtin_amdgcn_cvt_pk_u8_f32(a - 0.5f, 0u, r); r = __builtin_amdgcn_cvt_pk_u8_f32(b - 0.5f, 1u, r);
    r = __builtin_amdgcn_cvt_pk_u8_f32(c - 0.5f, 2u, r); r = __builtin_amdgcn_cvt_pk_u8_f32(d - 0.5f, 3u, r);
#else
    r = __builtin_amdgcn_cvt_pk_u8_f32(__builtin_floorf(a), 0u, r); r = __builtin_amdgcn_cvt_pk_u8_f32(__builtin_floorf(b), 1u, r);
    r = __builtin_amdgcn_cvt_pk_u8_f32(__builtin_floorf(c), 2u, r); r = __builtin_amdgcn_cvt_pk_u8_f32(__builtin_floorf(d), 3u, r);
#endif
    return r;
}
__device__ __forceinline__ int lane_id_volatile(int tag = 0) { int l; asm volatile("v_mbcnt_lo_u32_b32 %0, -1, 0 ; LANETAG %1\n\tv_mbcnt_hi_u32_b32 %0, -1, %0" : "=v"(l) : "s"(tag)); return l; }
#define LDS_WAIT() asm volatile("s_waitcnt lgkmcnt(0)" ::: "memory")
#define VM_WAIT() asm volatile("s_waitcnt vmcnt(0)" ::: "memory")

namespace pg8 {
constexpr int BM = 256, BK = 64, HALF = 128, HTB = HALF * BK * 2  , STAGE_BYTES = 8 * HTB, NXCD = 8, WGM = 8;
__host__ __device__ __forceinline__ int lds_byte(int r, int c) { const int st = (r >> 4) * 2 + (c >> 5), rr = r & 15, cc = c & 31, ob = rr * 64 + cc * 2; return st * 1024 + (ob ^ (((ob >> 9) & 1) << 5)); }
__host__ __device__ __forceinline__ void stage_rc(int b, int& R, int& C) { const int st = b / 1024, sb = b % 1024, swz = sb ^ (((sb >> 9) & 1) << 5); R = (st >> 1) * 16 + swz / 64; C = (st & 1) * 32 + (swz % 64) / 2; }
__host__ __device__ __forceinline__ int perm32(int rho) { const int n = rho >> 4, i = rho & 15; return 8 * (i >> 2) + 4 * n + (i & 3); }

struct Unit { int pm, pn; };
struct Gemm { const bf16_t* A; const bf16_t* Bt; int K; bool skip_epi = false; };

template <int NM, int NN> struct StaticOrder {
    int G, c;
    __device__ void init(int G_, int c_) { G = G_; c = c_; }
    __device__ __forceinline__ bool tile(int i, int& pm, int& pn) const {
        constexpr int nwg = NM * NN;
        const long L = (long)i * G + c; if (L >= nwg) return false;
        int wgid = (int)L; { constexpr int q = nwg / NXCD, r = nwg % NXCD; const int xcd = wgid % NXCD, off = wgid / NXCD; wgid = (xcd < r ? xcd * (q + 1) : r * (q + 1) + (xcd - r) * q) + off; }
        constexpr int nig = WGM * NN; static_assert(NM % WGM == 0, "row tiles in whole groups");
        const int gid = wgid / nig, fm = gid * WGM, rem = wgid % nig;
        pm = fm + (rem % WGM); pn = rem / WGM; return true;
    }
    __device__ __forceinline__ bool next(int i, Unit& u) const { return tile(i, u.pm, u.pn); }
};

template <class Epi, class Sched, bool GATHER, bool I8 = false>
__device__ __forceinline__ void gemm_phase(LAS unsigned char* lds, const Gemm g, const Sched& S, const Epi& E, int wv  ) {
    int tid = wv * 64 + lane_id_volatile(1); asm volatile("" : "+v"(tid));
    const int wid = __builtin_amdgcn_readfirstlane(tid >> 6), lane = tid & 63, wr = wid >> 2, wc = wid & 3, fr = lane & 15, fq = lane >> 4;
    const int K = g.K, RB = I8 ? K : 2 * K  , nt = RB / (BK * 2);
    unsigned voffA[2], voffB[2]; int RA[2], CA[2];
#pragma unroll
    for (int i = 0; i < 2; ++i) { int R, C; stage_rc(tid * 16 + i * 8192, R, C); const int Rb = (R & ~31) + perm32(R & 31); RA[i] = R; CA[i] = C;
        voffA[i] = (unsigned)(R * RB + C * 2); voffB[i] = (unsigned)(Rb * RB + C * 2); }
    const size_t kstep = (size_t)(BK * 2);
    const size_t hstep = (size_t)HALF * RB;
    const size_t tstep = 2 * hstep;
    const unsigned ldsw = (unsigned)wid * 1024u;
    const int aoff = lds_byte(wr * 64 + fr, fq * 8), boff = lds_byte(wc * 32 + fr, fq * 8);
#define PG8_SA(b, h) (((b) * 2 + (h)) * HTB)
#define PG8_SB(b, h) ((4 + (b) * 2 + (h)) * HTB)
#define PG8_STAGE(bufoff, gbase, voff) do { _Pragma("unroll") for (int _i = 0; _i < 2; ++_i) \
        __builtin_amdgcn_global_load_lds((const unsigned*)((const char*)(gbase) + (voff)[_i]), (LAS unsigned*)(lds + (bufoff) + ldsw + _i * 8192), 16, 0, 0); } while (0)
#define PG8_STAGE_A(bufoff, h, ubase, koff, VO) do { if constexpr (GATHER) { PG8_STAGE(bufoff, (const char*)g.A + (koff), VO[h]); } else { PG8_STAGE(bufoff, (ubase) + (h) * hstep + (koff), voffA); } } while (0)
#define PG8_LDA(dst, b, h) do { _Pragma("unroll") for (int m = 0; m < 4; ++m) _Pragma("unroll") for (int k = 0; k < 2; ++k) dst[m][k] = *(const LAS bf16x8*)(lds + PG8_SA(b, h) + aoff + m * 2048 + k * 1024); } while (0)
#define PG8_LDB(dst, b, h) do { _Pragma("unroll") for (int n = 0; n < 2; ++n) _Pragma("unroll") for (int k = 0; k < 2; ++k) dst[n][k] = *(const LAS bf16x8*)(lds + PG8_SB(b, h) + boff + n * 2048 + k * 1024); } while (0)
#define PG8_MMA(ai, bj, At, Bt) do { __builtin_amdgcn_s_setprio(1); _Pragma("unroll") for (int m = 0; m < 4; ++m) _Pragma("unroll") for (int n = 0; n < 2; ++n) _Pragma("unroll") for (int k = 0; k < 2; ++k) \
        { if constexpr (I8) acc[ai][bj][m][n] = __builtin_amdgcn_mfma_i32_16x16x64_i8(__builtin_bit_cast(i32x4, Bt[n][k]), __builtin_bit_cast(i32x4, At[m][k]), acc[ai][bj][m][n], 0, 0, 0); \
          else acc[ai][bj][m][n] = __builtin_amdgcn_mfma_f32_16x16x32_bf16(Bt[n][k], At[m][k], acc[ai][bj][m][n], 0, 0, 0); } __builtin_amdgcn_s_setprio(0); } while (0)
#define PG8_WAIT_V(n) asm volatile("s_waitcnt vmcnt(" #n ")" ::: "memory")
#define PG8_WAIT_L(n) asm volatile("s_waitcnt lgkmcnt(" #n ")" ::: "memory")
#define PG8_BAR __builtin_amdgcn_s_barrier()
#define PG8_SCHED __builtin_amdgcn_sched_barrier(0)
    Unit cur, nxt; int ui = 0;
    if (!S.next(0, cur)) return;
    typedef typename std::conditional<I8, i32x4, f32x4>::type accv_t;
    accv_t acc[2][2][4][2];
#pragma unroll
    for (int a = 0; a < 2; ++a)
#pragma unroll
        for (int b = 0; b < 2; ++b)
#pragma unroll
            for (int m = 0; m < 4; ++m)
#pragma unroll
                for (int n = 0; n < 2; ++n) acc[a][b][m][n] = (accv_t){0, 0, 0, 0};
    bf16x8 At[4][2], B0[2][2], B1[2][2];
    unsigned oc[2][2], on[2][2];
    if constexpr (GATHER) {
#pragma unroll
        for (int h = 0; h < 2; ++h)
#pragma unroll
            for (int i = 0; i < 2; ++i) { oc[h][i] = (unsigned)(S.src_row(cur, h * HALF + RA[i]) * RB + CA[i] * 2); on[h][i] = oc[h][i]; }

    }
    const char* cA = GATHER ? (const char*)g.A : (const char*)g.A + (size_t)cur.pm * tstep; const char* cB = (const char*)g.Bt + (size_t)cur.pn * tstep;
    PG8_STAGE(PG8_SB(0, 0), cB, voffB); PG8_STAGE(PG8_SB(0, 1), cB + hstep, voffB); PG8_STAGE_A(PG8_SA(0, 0), 0, cA, 0, oc); PG8_STAGE_A(PG8_SA(0, 1), 1, cA, 0, oc);
    if (wr == 1) PG8_BAR;
    PG8_WAIT_V(2); PG8_BAR;
    PG8_STAGE(PG8_SB(1, 0), cB + kstep, voffB); PG8_STAGE_A(PG8_SA(1, 0), 0, cA, kstep, oc); PG8_STAGE(PG8_SB(1, 1), cB + hstep + kstep, voffB);
    PG8_WAIT_V(6); PG8_BAR;
    for (;;) {
        const bool has_next = S.next(ui + 1, nxt);
        const char* nA = GATHER ? (const char*)g.A : (has_next ? (const char*)g.A + (size_t)nxt.pm * tstep : cA); const char* nB = has_next ? (const char*)g.Bt + (size_t)nxt.pn * tstep : cB;
        if constexpr (GATHER) {
            if (has_next) {
                const int t2 = wv * 64 + lane_id_volatile(3); int R2[2], C2[2];
#pragma unroll
                for (int i = 0; i < 2; ++i) stage_rc(t2 * 16 + i * 8192, R2[i], C2[i]);
#pragma unroll
                for (int h = 0; h < 2; ++h)
#pragma unroll
                    for (int i = 0; i < 2; ++i) on[h][i] = (unsigned)(S.src_row(nxt, h * HALF + R2[i]) * RB + C2[i] * 2);
            }
        }
        for (int t = 0; t < nt; t += 2) {
            const bool last = (t == nt - 2);
            const size_t k1 = (size_t)(t + 1) * kstep;
            const size_t k2 = last ? (size_t)0 : (size_t)(t + 2) * kstep, k3 = k2 + kstep;
            const char* a2 = last ? nA : cA; const char* b2 = last ? nB : cB;
            unsigned o2[2][2];
            if constexpr (GATHER) {
#pragma unroll
                for (int h = 0; h < 2; ++h)
#pragma unroll
                    for (int i = 0; i < 2; ++i) o2[h][i] = last ? on[h][i] : oc[h][i];
            }
            PG8_LDB(B0, 0, 0); PG8_LDB(B1, 0, 1); PG8_SCHED; PG8_LDA(At, 0, 0); PG8_STAGE_A(PG8_SA(1, 1), 1, cA, k1, oc);
            PG8_WAIT_V(8); PG8_WAIT_L(0); PG8_BAR; PG8_MMA(0, 0, At, B0); PG8_MMA(0, 1, At, B1); PG8_BAR; PG8_SCHED;
            PG8_LDA(At, 0, 1); PG8_STAGE(PG8_SB(0, 0), b2 + k2, voffB); PG8_STAGE(PG8_SB(0, 1), b2 + hstep + k2, voffB); PG8_STAGE_A(PG8_SA(0, 0), 0, a2, k2, o2);
            PG8_WAIT_V(8); PG8_WAIT_L(0); PG8_BAR; PG8_MMA(1, 0, At, B0); PG8_MMA(1, 1, At, B1); PG8_BAR; PG8_SCHED;
            PG8_LDB(B0, 1, 0); PG8_LDB(B1, 1, 1); PG8_SCHED; PG8_LDA(At, 1, 0); PG8_STAGE_A(PG8_SA(0, 1), 1, a2, k2, o2);
            PG8_WAIT_V(8); PG8_WAIT_L(0); PG8_BAR; PG8_MMA(0, 0, At, B0); PG8_MMA(0, 1, At, B1); PG8_BAR; PG8_SCHED;
            PG8_LDA(At, 1, 1); PG8_STAGE(PG8_SB(1, 0), b2 + k3, voffB); PG8_STAGE(PG8_SB(1, 1), b2 + hstep + k3, voffB); PG8_STAGE_A(PG8_SA(1, 0), 0, a2, k3, o2);
            PG8_WAIT_V(8); PG8_WAIT_L(0); PG8_BAR; PG8_MMA(1, 0, At, B0); PG8_MMA(1, 1, At, B1); PG8_BAR; PG8_SCHED;
        }
#ifndef NO_ALIGN_EPI
        if (wr == 0) PG8_BAR;
#else
        asm volatile("" ::: "memory"); PG8_SCHED;
#endif
#ifdef SKIP_EPI_PROBE
        const int le_ = lane_id_volatile(4);
        bool rst = true; if (!g.skip_epi) rst = E(acc, cur, wr, wc, le_ & 15, le_ >> 4);
#else
        const int le_ = lane_id_volatile(4);
        const bool rst = E(acc, cur, wr, wc, le_ & 15, le_ >> 4);
#endif
        if (!has_next) break;
        if (rst) {
#pragma unroll
        for (int a = 0; a < 2; ++a)
#pragma unroll
            for (int b = 0; b < 2; ++b)
#pragma unroll
                for (int m = 0; m < 4; ++m)
#pragma unroll
                    for (int n = 0; n < 2; ++n) acc[a][b][m][n] = (accv_t){0, 0, 0, 0};
        }
        cur = nxt; cA = nA; cB = nB; ++ui;
        if constexpr (GATHER) {
#pragma unroll
            for (int h = 0; h < 2; ++h)
#pragma unroll
                for (int i = 0; i < 2; ++i) oc[h][i] = on[h][i];
        }
#ifndef NO_ALIGN_EPI
        if (wr == 1) PG8_BAR;
#else
        asm volatile("" ::: "memory"); PG8_SCHED;
#endif
    }
    PG8_WAIT_V(0);
    PG8_BAR;
#undef PG8_SA
#undef PG8_SB
#undef PG8_STAGE
#undef PG8_STAGE_A
#undef PG8_LDA
#undef PG8_LDB
#undef PG8_MMA
#undef PG8_WAIT_V
#undef PG8_WAIT_L
#undef PG8_BAR
#undef PG8_SCHED
}
}
typedef f32x4 acc_t[2][2][4][2];
typedef i32x4 acci_t[2][2][4][2];

struct EpiProj {
    bf16_t* O; unsigned char* G8; const float* RS  ; const float* CS  ; bool pv = false;
    __device__ __forceinline__ bool operator()(acci_t& acc, const pg8::Unit& u, int wr, int wc, int fr, int fq) const {
#if defined(PROJ_VARIANT) && PROJ_VARIANT == 4
        if (pv) {
#pragma unroll
            for (int ai = 0; ai < 2; ++ai)
#pragma unroll
                for (int bj = 0; bj < 2; ++bj)
#pragma unroll
                    for (int m = 0; m < 4; ++m)
#pragma unroll
                        for (int n = 0; n < 2; ++n) asm volatile("" :: "v"(acc[ai][bj][m][n]));
            return true; }
#endif
        const int pn = u.pn;
        const int act = (pn <= 1 || pn == 3 || pn == 4) ? 1 : (pn >= 12 ? 3 : (pn >= 8 ? 2 : 0));
        const int row0 = u.pm * 256 + wr * 64 + fr, col0 = pn * 256 + wc * 32 + 8 * fq;
        float rsv[8];
#pragma unroll
        for (int q = 0; q < 8; ++q) rsv[q] = 1.f;
#if defined(PROJ_VARIANT) && PROJ_VARIANT == 3
        if (!pv)
#endif
        {
#pragma unroll
        for (int q = 0; q < 8; ++q) rsv[q] = RS[row0 + (q >> 2) * 128 + (q & 3) * 16];
        }
        f32x2 cs2[2][4];
#pragma unroll
        for (int bj = 0; bj < 2; ++bj) { f32x4 c0 = (f32x4){1.f, 1.f, 1.f, 1.f}, c1 = c0; const float k = (act == 1 ? QSCALE : 1.f);
#if defined(PROJ_VARIANT) && PROJ_VARIANT == 3
            if (!pv)
#endif
            { c0 = *(const f32x4*)(CS + col0 + bj * 128); c1 = *(const f32x4*)(CS + col0 + bj * 128 + 4); }
            cs2[bj][0] = (f32x2){c0[0], c0[1]} * k; cs2[bj][1] = (f32x2){c0[2], c0[3]} * k; cs2[bj][2] = (f32x2){c1[0], c1[1]} * k; cs2[bj][3] = (f32x2){c1[2], c1[3]} * k; }
#pragma unroll
        for (int ai = 0; ai < 2; ++ai)
#pragma unroll
            for (int m = 0; m < 4; ++m) { const int row = row0 + ai * 128 + m * 16; bf16_t* rowp = O + (size_t)row * PLD + col0; const float rs = rsv[ai * 4 + m]; u32x2 w8s[2] = {{0u, 0u}, {0u, 0u}};
#pragma unroll
                for (int bj = 0; bj < 2; ++bj) { f32x2 v[4];
#pragma unroll
                    for (int p = 0; p < 4; ++p) { const int i0 = 2 * p; v[p] = (f32x2){(float)acc[ai][bj][m][i0 >> 2][i0 & 3], (float)acc[ai][bj][m][(i0 + 1) >> 2][(i0 + 1) & 3]} * (cs2[bj][p] * rs); }
                    if (act == 2) {
#pragma unroll
                        for (int p = 0; p < 4; ++p) { const f32x2 x = v[p], t = (x * x * 0.044715f + 1.f) * x * (-2.302208198f); f32x2 d = {fexp2(t[0]), fexp2(t[1])}; d = d + 1.f; v[p] = x * (f32x2){frcp(d[0]), frcp(d[1])}; } }
                    else if (act == 3) {
                        f32x2 gq[4];
#pragma unroll
                        for (int p = 0; p < 4; ++p) { const f32x2 t = v[p] * (-LOG2E); f32x2 d = {fexp2(t[0]), fexp2(t[1])}; d = d + 1.f; gq[p] = (f32x2){frcp(d[0]), frcp(d[1])} * 256.f; }
                        u32x2 w8; w8.x = u8x4_floor(gq[0][0], gq[0][1], gq[1][0], gq[1][1]); w8.y = u8x4_floor(gq[2][0], gq[2][1], gq[3][0], gq[3][1]);
                        w8s[bj] = w8;
                        if (bj == 1) *(u32x4*)(G8 + (size_t)row * 3072 + (pn - 12) * 256 + wc * 64 + fq * 16) = (u32x4){w8s[0].x, w8s[0].y, w8s[1].x, w8s[1].y};
                        continue; }
                    u32x4 w; w.x = cvt_pk_bf16(v[0][0], v[0][1]); w.y = cvt_pk_bf16(v[1][0], v[1][1]); w.z = cvt_pk_bf16(v[2][0], v[2][1]); w.w = cvt_pk_bf16(v[3][0], v[3][1]);
#if defined(PROJ_VARIANT) && PROJ_VARIANT == 1
                    if (pv) { asm volatile("" :: "v"(w.x), "v"(w.y), "v"(w.z), "v"(w.w)); continue; }
#endif
                    *(u32x4*)(rowp + bj * 128) = w; } }
        return true;
    }
};

struct BranchOrder {
    pg8::StaticOrder<MTOK / 256, DM / 256> so;
    __device__ __forceinline__ bool next(int j, pg8::Unit& u) const { const int i = j / 3, br = j - 3 * i; int pm, pn; if (!so.tile(i, pm, pn)) return false; u.pm = br * 256 + pm; u.pn = br * 4 + pn; return true; }
};
struct EpiBranch {
    const unsigned char* G8  ; bf16_t* MERGED;
    __device__ __forceinline__ bool operator()(acc_t& acc, const pg8::Unit& u, int wr, int wc, int fr, int fq) const {
        const int br = u.pn >> 2, pn = u.pn & 3, pm = u.pm & 255;
        const int row0 = pm * 256 + wr * 64 + fr, col0 = pn * 256 + wc * 32 + 8 * fq;
#pragma unroll
        for (int rnd = 0; rnd < 2; ++rnd) { const int ai = rnd, m0 = 0;
            u32x2 gw[4][2], gd[4][2];
#pragma unroll
            for (int m = m0; m < m0 + 4; ++m) { const unsigned char* gp = G8 + (size_t)(row0 + ai * 128 + m * 16) * 3072 + br * 1024 + pn * 256 + wc * 64 + fq * 16;
                const u32x4 a = *(const u32x4*)gp; gw[m][0] = (u32x2){a.x, a.y}; gw[m][1] = (u32x2){a.z, a.w};
                if (br != 2) { const u32x4 d = *(const u32x4*)(gp + 1024); gd[m][0] = (u32x2){d.x, d.y}; gd[m][1] = (u32x2){d.z, d.w}; } }
#pragma unroll
            for (int m = m0; m < m0 + 4; ++m) { const size_t row = (size_t)(row0 + ai * 128 + m * 16);
#pragma unroll
                for (int bj = 0; bj < 2; ++bj) {
                    const u32x2 g = gw[m][bj];
                    float gn[8];
#pragma unroll
                    for (int i = 0; i < 8; ++i) gn[i] = (float)((g[i >> 2] >> (8 * (i & 3))) & 0xffu) + 0.5f;
                    if (br != 2) { const u32x2 d = gd[m][bj];
#pragma unroll
                        for (int i = 0; i < 8; ++i) gn[i] = gn[i] * frcp((float)((d[i >> 2] >> (8 * (i & 3))) & 0xffu) + 0.5f); }
                    else {
#pragma unroll
                        for (int i = 0; i < 8; ++i) gn[i] *= (1.f / 256.f); }
                    f32x4 v0 = acc[ai][bj][m][0], v1 = acc[ai][bj][m][1];
                    v0[0] *= gn[0]; v0[1] *= gn[1]; v0[2] *= gn[2]; v0[3] *= gn[3]; v1[0] *= gn[4]; v1[1] *= gn[5]; v1[2] *= gn[6]; v1[3] *= gn[7];
                    if (br != 2) { acc[ai][bj][m][0] = v0; acc[ai][bj][m][1] = v1; }
                    else { u32x4 w; w.x = cvt_pk_bf16(v0[0], v0[1]); w.y = cvt_pk_bf16(v0[2], v0[3]); w.z = cvt_pk_bf16(v1[0], v1[1]); w.w = cvt_pk_bf16(v1[2], v1[3]);
                        *(u32x4*)(MERGED + row * DM + col0 + bj * 128) = w; } } }
            asm volatile("" ::: "memory");
        }
        return br == 2;
    }
};

#ifndef WOUT_VARIANT
#define WOUT_VARIANT 0
#endif
struct EpiWout {
    bf16_t* Y; float* SSP; bool pv = false;
    __device__ __forceinline__ bool operator()(acc_t& acc, const pg8::Unit& u, int wr, int wc, int fr, int fq) const {
        const int row0 = u.pm * 256 + wr * 64 + fr, col0 = u.pn * 256 + wc * 32 + 8 * fq;
#pragma unroll
        for (int ai = 0; ai < 2; ++ai)
#pragma unroll
            for (int m = 0; m < 4; ++m) { const size_t row = (size_t)(row0 + ai * 128 + m * 16); float ss = 0.f;
#pragma unroll
                for (int bj = 0; bj < 2; ++bj) { const f32x4 v0 = acc[ai][bj][m][0], v1 = acc[ai][bj][m][1];
                    ss += (v0[0] * v0[0] + v0[1] * v0[1]) + (v0[2] * v0[2] + v0[3] * v0[3]) + (v1[0] * v1[0] + v1[1] * v1[1]) + (v1[2] * v1[2] + v1[3] * v1[3]);
                    u32x4 w; w.x = cvt_pk_bf16(v0[0], v0[1]); w.y = cvt_pk_bf16(v0[2], v0[3]); w.z = cvt_pk_bf16(v1[0], v1[1]); w.w = cvt_pk_bf16(v1[2], v1[3]);
                    if (!(WOUT_VARIANT == 2 && pv)) *(u32x4*)(Y + row * DM + col0 + bj * 128) = w; }
                if (!(WOUT_VARIANT == 3 && pv)) ss = xor32_add(xor16_add(ss));
                if (fq == 0 && !((WOUT_VARIANT == 1 || WOUT_VARIANT == 3) && pv)) SSP[(size_t)(u.pn * 4 + wc) * MTOK + row] = ss; }
        return true;
    }
};

struct MoeOrder {
    int u0, u1, NB, rt_lo;
    const LAS int* tile_e;
    const LAS int* rowidx;
    __device__ __forceinline__ bool next(int i, pg8::Unit& u) const { const int x = u0 + i; if (x >= u1) return false; const int rt = x / NB, pn = x - rt * NB; u.pm = rt; u.pn = tile_e[rt] * NB + pn; return true; }
    __device__ __forceinline__ int src_row(const pg8::Unit& u, int r) const { return rowidx[(u.pm - rt_lo) * 256 + r]; }
};
struct EpiW1 {
    bf16_t* ACT; const float* b1  ;
    __device__ __forceinline__ bool operator()(acc_t& acc, const pg8::Unit& u, int wr, int wc, int fr, int fq) const {
        const int e = u.pn >> 3, pn = u.pn & 7;
        const int row0 = u.pm * 256 + wr * 64 + fr, j0 = pn * 128 + wc * 32 + 8 * fq;
        const float* bp = b1 + (size_t)e * (2 * FF) + 2 * j0;
        float bg[8], bl[8];
#pragma unroll
        for (int q = 0; q < 4; ++q) { const f32x4 t = *(const f32x4*)(bp + 4 * q); bg[2 * q] = t[0]; bl[2 * q] = t[1]; bg[2 * q + 1] = t[2]; bl[2 * q + 1] = t[3]; }
#pragma unroll
        for (int ai = 0; ai < 2; ++ai)
#pragma unroll
            for (int m = 0; m < 4; ++m) { float a[8];
#pragma unroll
                for (int i = 0; i < 8; ++i) { float gl = acc[ai][0][m][i >> 2][i & 3] + bg[i], li = acc[ai][1][m][i >> 2][i & 3] + bl[i];
                    gl = fminf(gl, 7.f); li = fminf(fmaxf(li, -7.f), 7.f);
                    a[i] = gl * frcp(1.f + fexp2(-1.702f * LOG2E * gl)) * (li + 1.f); }
                u32x4 w; w.x = cvt_pk_bf16(a[0], a[1]); w.y = cvt_pk_bf16(a[2], a[3]); w.z = cvt_pk_bf16(a[4], a[5]); w.w = cvt_pk_bf16(a[6], a[7]);
                *(u32x4*)(ACT + (size_t)(row0 + ai * 128 + m * 16) * FF + j0) = w; }
        return true;
    }
};
constexpr float ACT_SCALE = 12.f / 127.f;
struct EpiW1I8 {
    signed char* ACT  ; const float* b1  ; const float* RS  ; const float* CS  ;
    const LAS int* rowidx; int rt_lo;
    __device__ __forceinline__ bool operator()(acci_t& acc, const pg8::Unit& u, int wr, int wc, int fr, int fq) const {
        const int e = u.pn >> 3, pn = u.pn & 7;
        const int rl0 = wr * 64 + fr, row0 = u.pm * 256 + rl0, j0 = pn * 128 + wc * 32 + 8 * fq;
        const float* bp = b1 + (size_t)e * (2 * FF) + 2 * j0;
        float bg[8], bl[8], cg[8], cl[8];
#pragma unroll
        for (int q = 0; q < 4; ++q) { const f32x4 t = *(const f32x4*)(bp + 4 * q); bg[2 * q] = t[0]; bl[2 * q] = t[1]; bg[2 * q + 1] = t[2]; bl[2 * q + 1] = t[3]; }
        { const float* cp = CS + (size_t)e * 2048 + pn * 256 + wc * 32 + 8 * fq;
          const f32x4 a0 = *(const f32x4*)cp, a1 = *(const f32x4*)(cp + 4), c0 = *(const f32x4*)(cp + 128), c1 = *(const f32x4*)(cp + 132);
#pragma unroll
          for (int i = 0; i < 4; ++i) { cg[i] = a0[i]; cg[4 + i] = a1[i]; cl[i] = c0[i]; cl[4 + i] = c1[i]; } }
        const LAS int* ri = rowidx + (u.pm - rt_lo) * 256 + rl0;
        float rsv[8];
#pragma unroll
        for (int q = 0; q < 8; ++q) rsv[q] = RS[ri[(q >> 2) * 128 + (q & 3) * 16]];
        f32x2 bg2[4], bl2[4], cg2[4], cl2[4];
#pragma unroll
        for (int p = 0; p < 4; ++p) { bg2[p] = (f32x2){bg[2 * p], bg[2 * p + 1]}; bl2[p] = (f32x2){bl[2 * p], bl[2 * p + 1]}; cg2[p] = (f32x2){cg[2 * p], cg[2 * p + 1]}; cl2[p] = (f32x2){cl[2 * p], cl[2 * p + 1]}; }
#pragma unroll
        for (int ai = 0; ai < 2; ++ai)
#pragma unroll
            for (int m = 0; m < 4; ++m) { const float rs = rsv[ai * 4 + m]; f32x2 a2[4];
#pragma unroll
                for (int p = 0; p < 4; ++p) { const int i0 = 2 * p;
                    const f32x2 ag = {(float)acc[ai][0][m][i0 >> 2][i0 & 3], (float)acc[ai][0][m][(i0 + 1) >> 2][(i0 + 1) & 3]}, al = {(float)acc[ai][1][m][i0 >> 2][i0 & 3], (float)acc[ai][1][m][(i0 + 1) >> 2][(i0 + 1) & 3]};
                    f32x2 gl = ag * (cg2[p] * rs) + bg2[p], li = al * (cl2[p] * rs) + bl2[p];
                    gl[0] = fminf(gl[0], 7.f); gl[1] = fminf(gl[1], 7.f); li[0] = fminf(fmaxf(li[0], -7.f), 7.f); li[1] = fminf(fmaxf(li[1], -7.f), 7.f);
                    const f32x2 ex = gl * (-1.702f * LOG2E); f32x2 den = {fexp2(ex[0]), fexp2(ex[1])}; den = den + 1.f; const f32x2 rc = {frcp(den[0]), frcp(den[1])};
                    a2[p] = (gl * rc) * (li + 1.f); }
                u32x2 w; w.x = q8x4(a2[0][0], a2[0][1], a2[1][0], a2[1][1], 1.f / ACT_SCALE); w.y = q8x4(a2[2][0], a2[2][1], a2[3][0], a2[3][1], 1.f / ACT_SCALE);
                *(u32x2*)(ACT + (size_t)(row0 + ai * 128 + m * 16) * FF + j0) = w; }
        return true;
    }
};
struct EpiW2 {
    bf16_t* Y2; const float* b2  ; const float* CS  ;
    __device__ __forceinline__ bool operator()(acci_t& acc, const pg8::Unit& u, int wr, int wc, int fr, int fq) const {
        const int e = u.pn >> 2, pn = u.pn & 3;
        const int row0 = u.pm * 256 + wr * 64 + fr, col0 = pn * 256 + wc * 32 + 8 * fq;
        f32x4 bv[2][2], cv[2][2];
#pragma unroll
        for (int bj = 0; bj < 2; ++bj)
#pragma unroll
            for (int n = 0; n < 2; ++n) { bv[bj][n] = *(const f32x4*)(b2 + (size_t)e * DM + col0 + bj * 128 + 4 * n); cv[bj][n] = *(const f32x4*)(CS + (size_t)e * DM + col0 + bj * 128 + 4 * n) * ACT_SCALE; }
#pragma unroll
        for (int ai = 0; ai < 2; ++ai)
#pragma unroll
            for (int m = 0; m < 4; ++m) { bf16_t* rowp = Y2 + (size_t)(row0 + ai * 128 + m * 16) * DM + col0;
#pragma unroll
                for (int bj = 0; bj < 2; ++bj) { const i32x4 a0 = acc[ai][bj][m][0], a1 = acc[ai][bj][m][1];
                    const f32x4 v0 = (f32x4){(float)a0[0], (float)a0[1], (float)a0[2], (float)a0[3]} * cv[bj][0] + bv[bj][0], v1 = (f32x4){(float)a1[0], (float)a1[1], (float)a1[2], (float)a1[3]} * cv[bj][1] + bv[bj][1];
                    u32x4 w; w.x = cvt_pk_bf16(v0[0], v0[1]); w.y = cvt_pk_bf16(v0[2], v0[3]); w.z = cvt_pk_bf16(v1[0], v1[1]); w.w = cvt_pk_bf16(v1[2], v1[3]);
                    *(u32x4*)(rowp + bj * 128) = w; } }
        return true;
    }
};
#define XB_TMO      128
#define XB_XCNT(j)  (256  + 64 * (j))
#define XB_XSUB(j)  (1280 + 64 * (j))
#define XB_XGEN(j)  (2304 + 64 * (j))
#define XB_TOP      3328
#define XB_TOPGEN   3392
#define XCD_BAR_WORDS 3456
#define XB_SPIN_CAP (1u << 18)

__device__ __forceinline__ unsigned xb_ld(unsigned* p)              { return __hip_atomic_load(p, __ATOMIC_RELAXED, __HIP_MEMORY_SCOPE_AGENT); }
__device__ __forceinline__ unsigned xb_add(unsigned* p, unsigned v) { return __hip_atomic_fetch_add(p, v, __ATOMIC_RELAXED, __HIP_MEMORY_SCOPE_AGENT); }
__device__ __forceinline__ unsigned xb_xcc_id() { return (unsigned)__builtin_amdgcn_s_getreg((3 << 11) | 20) & 0xFu; }
#define XB_SPIN(cond, bar) do { unsigned _sp = 0; while (cond) { __builtin_amdgcn_s_sleep(1); \
    if ((++_sp & 255u) == 0u) { if (xb_ld(&(bar)[XB_TMO])) break; if (_sp > XB_SPIN_CAP) { atomicAdd(&(bar)[XB_TMO], 1u); break; } } } } while (0)

struct XcdBarrier {
    unsigned* bar; unsigned x;
    int w;
    volatile LAS unsigned* st;
};

__device__ __forceinline__ bool xb_thread0(int w) { return w == 0 && lane_id_volatile(2) == 0; }
__device__ __forceinline__ XcdBarrier xcd_barrier_post(unsigned* bar, volatile LAS unsigned* st, int w) {
    XcdBarrier b; b.bar = bar; b.x = xb_xcc_id(); b.st = st; b.w = w;
    if (xb_thread0(w)) (void)xb_add(&bar[XB_XCNT(b.x)], 1u);
    return b;
}
__device__ __forceinline__ void xcd_barrier_complete(unsigned* bar, unsigned x, unsigned& nloc, unsigned& nx) {
    const unsigned G = gridDim.x * gridDim.y * gridDim.z;
    unsigned sum, cnt, mine, sp = 0u;
    for (;;) {
        sum = 0u; cnt = 0u; mine = 0u;
#pragma unroll
        for (unsigned j = 0; j < 16; ++j) { const unsigned c = xb_ld(&bar[XB_XCNT(j)]); sum += c; cnt += (c > 0u) ? 1u : 0u; mine = (j == x) ? c : mine; }
        if (sum == G) break;
        __builtin_amdgcn_s_sleep(1);
        if ((++sp & 255u) == 0u) { if (xb_ld(&bar[XB_TMO])) break; if (sp > XB_SPIN_CAP) { atomicAdd(&bar[XB_TMO], 1u); break; } }
    }
    nloc = mine > 0u ? mine : 1u; nx = cnt > 0u ? cnt : 1u;
}

__device__ __forceinline__ void xcd_barrier(const XcdBarrier& b) {
    asm volatile("s_waitcnt vmcnt(0)" ::: "memory");
    __syncthreads();
    if (xb_thread0(b.w)) {
        unsigned* bar = b.bar;
        __builtin_amdgcn_s_waitcnt(0);
        unsigned nloc = b.st[0], nx = b.st[1];
        if (nloc == 0u) { xcd_barrier_complete(bar, b.x, nloc, nx); b.st[0] = nloc; b.st[1] = nx; }
        const unsigned old = xb_add(&bar[XB_XSUB(b.x)], 1u);
        const unsigned gen = old / nloc;
        if (old + 1u == (gen + 1u) * nloc) {
            __builtin_amdgcn_fence(__ATOMIC_RELEASE, "agent");
            asm volatile("s_waitcnt vmcnt(0)" ::: "memory");
            const unsigned og = xb_add(&bar[XB_TOP], 1u);
            const unsigned tg = og / nx;
            if (og + 1u == (tg + 1u) * nx) xb_add(&bar[XB_TOPGEN], 1u);
            else XB_SPIN(xb_ld(&bar[XB_TOPGEN]) == tg, bar);
            __builtin_amdgcn_fence(__ATOMIC_ACQUIRE, "agent");
            xb_add(&bar[XB_XGEN(b.x)], 1u);
            asm volatile("s_waitcnt vmcnt(0)" ::: "memory");
        } else {
            XB_SPIN(xb_ld(&bar[XB_XGEN(b.x)]) == gen, bar);
            __builtin_amdgcn_fence(__ATOMIC_ACQUIRE, "agent");
            asm volatile("s_waitcnt vmcnt(0)" ::: "memory");
        }
    }
    __syncthreads();
}

constexpr size_t MiB = 1u << 20;
constexpr size_t WS_CTL = 0, CTL_ZERO_BYTES = 1 * MiB;
constexpr size_t WS_MOD = 1 * MiB;
constexpr size_t WS_SGW = 3 * MiB;
constexpr size_t WS_WRT = 3 * MiB + 512 * 1024;
constexpr size_t WS_RS = 4 * MiB;
constexpr size_t WS_CS1 = 5 * MiB;
constexpr size_t WS_CS2 = 6 * MiB + 512 * 1024;
constexpr size_t WS_CSIN = 6 * MiB;
constexpr size_t WS_W = 8 * MiB, W_LAYER = 209 * MiB;
constexpr size_t WO_WIN = 0, WO_WBR = 12 * MiB, WO_WOUT = 15 * MiB, WO_W1 = 17 * MiB, WO_W2 = 145 * MiB;
constexpr size_t WS_PROJ = 426 * MiB;
constexpr size_t WS_GATES = 810 * MiB;
constexpr size_t WS_ACT = WS_PROJ;
constexpr size_t WS_X = 1002 * MiB;
constexpr size_t WS_H = 1194 * MiB;
constexpr size_t WS_O = 1322 * MiB;
constexpr size_t WS_Y = 1514 * MiB;
constexpr size_t WS_BITS = 1770 * MiB;
constexpr size_t WS_Y2 = WS_O;
constexpr size_t WS_SSP = 1850 * MiB;
constexpr size_t WS_ROWTOK = 1854 * MiB;
constexpr size_t WS_TOKINFO = 1862 * MiB;
constexpr size_t WS_SLAB = 1864 * MiB;
constexpr size_t WS_END = 1928 * MiB;
static_assert(WS_Y2 + (size_t)270336 * 2048 <= WS_SSP && WS_W + 2 * W_LAYER <= WS_PROJ && WS_PROJ + (size_t)MTOK * PLD * 2 <= WS_GATES && WS_GATES + (size_t)MTOK * 3072 <= WS_H, "d_ws map");
constexpr int CW_BAR = 4096;
constexpr int CW_CNT = 16384;

constexpr int RING_BYTES = 131072;
constexpr int MISC_OFF = 134144;
constexpr int TS_OFF = MISC_OFF + 512;
constexpr int TILE_E_OFF = MISC_OFF + 1024;
constexpr int ROWIDX_OFF = MISC_OFF + 5632;
constexpr int LDS_BYTES = 151552;
static_assert(ROWIDX_OFF + 8192 <= LDS_BYTES, "LDS map");

struct Args {
    const float* in[21]; float* out; unsigned char* ws; int ph_lo, ph_hi;
};
struct Frame {
    LAS unsigned char* lds; int tid, lane, wave, vcu, G;
};
__device__ __forceinline__ Frame phase_frame(const Frame& F0) { Frame F = F0; int t = F0.wave * 64 + lane_id_volatile(3); asm volatile("" : "+v"(t)); F.tid = t; F.lane = t & 63; F.wave = F0.wave; return F; }
template <class T> __device__ __forceinline__ T* opq(T* p) { long z = 0; asm volatile("" : "+s"(z)); return (T*)((unsigned char*)p + z); }

__device__ __forceinline__ void p0_mod(const Frame& F, const float* c, const float* w_ada, const float* b_ada, float* MOD) {
    LAS float* csT = (LAS float*)F.lds;
    for (int i = F.tid; i < BATCH * DM; i += 512) { const int b = i & 31, k = i >> 5; const float v = c[b * DM + k]; csT[k * 32 + b] = v * sigmoidf_(v); }
    __syncthreads();
    const int gw = F.vcu * 8 + F.wave, NGW = F.G * 8;
    const int cg = F.lane & 15, kq = F.lane >> 4;
    for (int task = gw; task < DEPTH * 384; task += NGW) {
        const int l = task / 384, n = (task % 384) * 16 + cg;
        float acc[32];
#pragma unroll
        for (int b = 0; b < 32; ++b) acc[b] = 0.f;
        const float* w = w_ada + ((size_t)l * DM + kq * 256) * (6 * DM) + n;
#pragma unroll 4
        for (int k = 0; k < 256; ++k) {
            const float wv = w[(size_t)k * (6 * DM)];
            const LAS f32x4* cs = (const LAS f32x4*)(csT + (kq * 256 + k) * 32);
#pragma unroll
            for (int q = 0; q < 8; ++q) { const f32x4 c4 = cs[q]; acc[4 * q] += c4[0] * wv; acc[4 * q + 1] += c4[1] * wv; acc[4 * q + 2] += c4[2] * wv; acc[4 * q + 3] += c4[3] * wv; }
        }
#pragma unroll
        for (int b = 0; b < 32; ++b) { acc[b] = xor32_add(xor16_add(acc[b])); }
        if (kq == 0) { const float bb = b_ada[l * 6 * DM + n];
#pragma unroll
            for (int b = 0; b < 32; ++b) MOD[((size_t)l * BATCH + b) * (6 * DM) + n] = acc[b] + bb; }
    }
    __syncthreads();
}
__device__ __forceinline__ void tr_item(const float* W, size_t ldw, int srccol, bool valid, bf16_t* dst  , int K, LAS float* scr, int lane) {
    const float* wp = W + srccol;
#pragma unroll 8
    for (int i = 0; i < 32; ++i) { const int kk = 2 * i + (lane >> 5); scr[kk * 33 + (lane & 31)] = valid ? wp[(size_t)kk * ldw] : 0.f; }
    LDS_WAIT(); asm volatile("" ::: "memory");
    const int c = lane & 7;
#pragma unroll
    for (int j = 0; j < 4; ++j) { const int n = (lane >> 3) + 8 * j; const LAS float* s = scr + (8 * c) * 33 + n;
        u32x4 o; o.x = cvt_pk_bf16(s[0 * 33], s[1 * 33]); o.y = cvt_pk_bf16(s[2 * 33], s[3 * 33]); o.z = cvt_pk_bf16(s[4 * 33], s[5 * 33]); o.w = cvt_pk_bf16(s[6 * 33], s[7 * 33]);
        *(u32x4*)(dst + (size_t)n * K + 8 * c) = o; }
    LDS_WAIT(); asm volatile("" ::: "memory");
}
__device__ __forceinline__ void p0_weights(const Frame& F, const Args& a) {
    LAS float* scr = (LAS float*)(F.lds + F.wave * 16384);
    const int gw = F.vcu * 8 + F.wave, NGW = F.G * 8, lane = F.lane, jl = lane & 31;
    const float *w_in = a.in[8], *w_branch = a.in[13], *w_out = a.in[14], *w_router = a.in[15], *w1 = a.in[17], *w2 = a.in[19];
    constexpr int I_BR = 3 * 8 * 32, I_OUT = 16 * 32, I_RT = 16;
    constexpr int I_LAYER = I_BR + I_OUT + I_RT;
    for (int it = gw; it < DEPTH * I_LAYER; it += NGW) {
        const int l = it / I_LAYER; int r = it - l * I_LAYER;
        unsigned char* wl = a.ws + WS_W + (size_t)l * W_LAYER;
        if (r < I_BR) {
            const int br = r / 256, q = r % 256, kb = q / 32, nb = q % 32;
            tr_item(w_branch + ((size_t)(l * 3 + br) * 512 + kb * 64) * DM, DM, nb * 32 + jl, true, (bf16_t*)(wl + WO_WBR) + (size_t)(br * 1024 + nb * 32) * 512 + kb * 64, 512, scr, lane); continue; }
        r -= I_BR;
        if (r < I_OUT) {
            const int kb = r / 32, nb = r % 32;
            tr_item(w_out + ((size_t)l * DM + kb * 64) * DM, DM, nb * 32 + jl, true, (bf16_t*)(wl + WO_WOUT) + (size_t)nb * 32 * DM + kb * 64, DM, scr, lane); continue; }
        r -= I_OUT;
        {
            const int kb = r;
            tr_item(w_router + ((size_t)l * DM + kb * 64) * NE, NE, jl, true, (bf16_t*)(a.ws + WS_WRT) + (size_t)l * NE * DM + kb * 64, DM, scr, lane); }
        (void)r;
    }
    __syncthreads();
    {
    LAS float* T = (LAS float*)F.lds; LAS float* red = (LAS float*)(F.lds + ROWIDX_OFF);
    const int half = lane >> 5, wave = F.wave;
    constexpr int ST_W1 = NE * 64, ST_IN = 192, ST_W2 = NE * 32, ST_LAYER = ST_W1 + ST_IN + ST_W2;
#define STRIP_PARAMS(st_, wp, ldw, valid, dst, csp) do { const int l = (st_) / ST_LAYER, q = (st_) % ST_LAYER; valid = true; \
        if (q < ST_W1) { const int e = q / 64, r6 = q % 64, pn = r6 >> 3, jjg = (r6 >> 1) & 3, sgl = r6 & 1, nb = pn * 8 + sgl * 4 + jjg, n = nb * 32 + jl, src = 2 * (128 * pn + jjg * 32 + jl) + sgl; \
            wp = w1 + ((size_t)(l * NE + e) * DM) * (2 * FF) + src; ldw = 2 * FF; \
            dst = (signed char*)(a.ws + WS_W + (size_t)l * W_LAYER + WO_W1) + ((size_t)e * 2048 + nb * 32) * DM; csp = (float*)(a.ws + WS_CS1) + ((size_t)l * NE + e) * 2048 + n; } \
        else if (q >= ST_W1 + ST_IN) { const int q2 = q - ST_W1 - ST_IN, e = q2 / 32, nb = q2 % 32, n = nb * 32 + jl; \
            wp = w2 + ((size_t)(l * NE + e) * FF) * DM + n; ldw = DM; \
            dst = (signed char*)(a.ws + WS_W + (size_t)l * W_LAYER + WO_W2) + ((size_t)e * DM + nb * 32) * FF; csp = (float*)(a.ws + WS_CS2) + ((size_t)l * NE + e) * DM + n; } \
        else { const int nb = q - ST_W1, n = nb * 32 + jl; valid = (n < 1832) || (n >= 2048); const int src = n < 1832 ? n : n - 216; \
            wp = w_in + (size_t)l * DM * 5928 + (valid ? src : 0); ldw = 5928; \
            dst = (signed char*)(a.ws + WS_W + (size_t)l * W_LAYER + WO_WIN) + (size_t)nb * 32 * DM; csp = (float*)(a.ws + WS_CSIN) + (size_t)l * NPROJ + n; } } while (0)
#define STRIP_LOAD(vv, ib, wp, ldw, valid) do { _Pragma("unroll") for (int i = 0; i < 32; ++i) { const int k = wave * 128 + 2 * ((ib) * 32 + i) + half; vv[i] = valid ? __builtin_nontemporal_load(wp + (size_t)k * ldw) : 0.f; } } while (0)
    float v0[32];
    { const int st = F.vcu < DEPTH * ST_LAYER ? F.vcu : DEPTH * ST_LAYER - 1; const float* wp; size_t ldw; bool valid; signed char* dst; float* csp; STRIP_PARAMS(st, wp, ldw, valid, dst, csp); (void)dst; (void)csp; STRIP_LOAD(v0, 0, wp, ldw, valid); }
    for (int st = F.vcu; st < DEPTH * ST_LAYER; st += F.G) {
        const float* wp; size_t ldw; bool valid; signed char* dst; float* csp;
        STRIP_PARAMS(st, wp, ldw, valid, dst, csp);
        float am = 0.f;
        { float v1[32]; STRIP_LOAD(v1, 1, wp, ldw, valid);
#pragma unroll
          for (int i = 0; i < 32; ++i) { const int k = wave * 128 + 2 * i + half; am = fmaxf(am, fabsf(v0[i])); T[k * 32 + (jl ^ (k & 31))] = v0[i]; }
#pragma unroll
          for (int i = 0; i < 32; ++i) { const int k = wave * 128 + 2 * (32 + i) + half; am = fmaxf(am, fabsf(v1[i])); T[k * 32 + (jl ^ (k & 31))] = v1[i]; } }
        red[(wave * 2 + half) * 32 + jl] = am;
        lds_barrier();
        { const int stn = st + F.G; if (stn < DEPTH * ST_LAYER) { const float* wpn; size_t ldwn; bool validn; signed char* dstn; float* cspn; STRIP_PARAMS(stn, wpn, ldwn, validn, dstn, cspn); (void)dstn; (void)cspn; STRIP_LOAD(v0, 0, wpn, ldwn, validn); } }
        float amx = 0.f;
#pragma unroll
        for (int p = 0; p < 16; ++p) amx = fmaxf(amx, red[p * 32 + jl]);
        const float scale = valid ? fmaxf(amx, 1e-30f) * (1.f / 127.f) : 1.f, inv = valid ? 1.f / scale : 0.f;
        if (wave == 0 && half == 0) *csp = scale;
        const int k0 = 64 * (wave * 2 + half);
#pragma unroll
        for (int c16 = 0; c16 < 4; ++c16) { unsigned wq[4];
#pragma unroll
            for (int d4 = 0; d4 < 4; ++d4) { const int k = k0 + c16 * 16 + d4 * 4;
                wq[d4] = q8x4(T[k * 32 + (jl ^ (k & 31))], T[(k + 1) * 32 + (jl ^ ((k + 1) & 31))], T[(k + 2) * 32 + (jl ^ ((k + 2) & 31))], T[(k + 3) * 32 + (jl ^ ((k + 3) & 31))], inv); }
            *(u32x4*)(dst + (size_t)jl * DM + k0 + c16 * 16) = (u32x4){wq[0], wq[1], wq[2], wq[3]}; }
        lds_barrier();
    }
#undef STRIP_PARAMS
#undef STRIP_LOAD
    }
    const float* sg_w = a.in[10]; bf16_t* SGW = (bf16_t*)(a.ws + WS_SGW);
    for (int i = (F.vcu * 512 + F.tid) * 2; i < DEPTH * 8 * 128 * 128; i += F.G * 512 * 2) { const int s = i & 127, t = (i >> 7) & 127; const f32x2 v = *(const f32x2*)(sg_w + i);
        *(unsigned*)(SGW + i) = cvt_pk_bf16(s <= t ? v[0] : 0.f, (s + 1) <= t ? v[1] : 0.f); }
}

__device__ __forceinline__ void norm_mod_row(const f32x4 (&v)[4], float ss, const float* g, const float* sc, const float* sh, signed char* orow, float* rs, int lane) {
    const float rstd = 1.f / sqrtf(ss * (1.f / DM) + RMS_EPS);
    f32x4 o[4]; float am = 0.f;
#pragma unroll
    for (int j = 0; j < 4; ++j) { const int c = 4 * lane + 256 * j; const f32x4 gg = *(const f32x4*)(g + c), s1 = *(const f32x4*)(sc + c), s0 = *(const f32x4*)(sh + c);
        o[j] = (v[j] * rstd) * gg * (s1 + 1.f) + s0;
        am = fmaxf(am, fmaxf(fmaxf(fabsf(o[j][0]), fabsf(o[j][1])), fmaxf(fabsf(o[j][2]), fabsf(o[j][3])))); }
    am = wave_max(am);
    const float scale = fmaxf(am, 1e-30f) * (1.f / 127.f), inv = 1.f / scale;
    if (lane == 0) *rs = scale;
#pragma unroll
    for (int j = 0; j < 4; ++j) *(unsigned*)(orow + 4 * lane + 256 * j) = q8x4(o[j][0], o[j][1], o[j][2], o[j][3], inv);
}
__device__ __forceinline__ void p1_norm(const Frame& F, const float* x, const float* g, const float* MOD0, signed char* H8, float* RS, bf16_t* X16) {
    const int gw = F.vcu * 8 + F.wave, NGW = F.G * 8, lane = F.lane;
    const int r_lo = (int)((long)(MTOK / 4) * gw / NGW) * 4, r_hi = (int)((long)(MTOK / 4) * (gw + 1) / NGW) * 4;
    f32x4 N2[4], N3[4]; int bcur = (r_lo < MTOK ? r_lo : MTOK - 1) >> 11;
#define P1_PARAMS(b_) do { const float* mb_ = MOD0 + (size_t)(b_) * 6 * DM; _Pragma("unroll") for (int j = 0; j < 4; ++j) { const int c = 4 * lane + 256 * j; \
        const f32x4 gg = *(const f32x4*)(g + c), s1 = *(const f32x4*)(mb_ + DM + c), s0 = *(const f32x4*)(mb_ + c); N2[j] = gg * (s1 + 1.f); N3[j] = s0; } } while (0)
    P1_PARAMS(bcur);
    for (int row0 = r_lo; row0 < r_hi; row0 += 4) { f32x4 v[4][4];
        if ((row0 >> 11) != bcur) { bcur = row0 >> 11; P1_PARAMS(bcur); }
#pragma unroll
        for (int rr = 0; rr < 4; ++rr)
#pragma unroll
            for (int j = 0; j < 4; ++j) v[rr][j] = __builtin_nontemporal_load((const f32x4*)(x + (size_t)(row0 + rr) * DM + 4 * lane + 256 * j));
        float ss[4], am[4]; f32x4 o[4][4];
#pragma unroll
        for (int rr = 0; rr < 4; ++rr) { ss[rr] = 0.f;
#pragma unroll
            for (int j = 0; j < 4; ++j) ss[rr] += (v[rr][j][0] * v[rr][j][0] + v[rr][j][1] * v[rr][j][1]) + (v[rr][j][2] * v[rr][j][2] + v[rr][j][3] * v[rr][j][3]); }
#pragma unroll
        for (int rr = 0; rr < 4; ++rr) ss[rr] = wave_sum(ss[rr]);
#pragma unroll
        for (int rr = 0; rr < 4; ++rr) { const int row = row0 + rr; const float rstd = 1.f / sqrtf(ss[rr] * (1.f / DM) + RMS_EPS); am[rr] = 0.f;
#pragma unroll
            for (int j = 0; j < 4; ++j) { u32x2 w; w.x = cvt_pk_bf16(v[rr][j][0], v[rr][j][1]); w.y = cvt_pk_bf16(v[rr][j][2], v[rr][j][3]); *(u32x2*)(X16 + (size_t)row * DM + 4 * lane + 256 * j) = w;
                o[rr][j] = (v[rr][j] * rstd) * N2[j] + N3[j];
                am[rr] = fmaxf(am[rr], fmaxf(fmaxf(fabsf(o[rr][j][0]), fabsf(o[rr][j][1])), fmaxf(fabsf(o[rr][j][2]), fabsf(o[rr][j][3])))); } }
#pragma unroll
        for (int rr = 0; rr < 4; ++rr) am[rr] = wave_max(am[rr]);
#pragma unroll
        for (int rr = 0; rr < 4; ++rr) { const int row = row0 + rr; const float scale = fmaxf(am[rr], 1e-30f) * (1.f / 127.f), inv = 1.f / scale;
            if (lane == 0) RS[row] = scale;
#pragma unroll
            for (int j = 0; j < 4; ++j) *(unsigned*)(H8 + (size_t)row * DM + 4 * lane + 256 * j) = q8x4(o[rr][j][0], o[rr][j][1], o[rr][j][2], o[rr][j][3], inv); } }
#undef P1_PARAMS
}
constexpr int TOPK_SEL = 256;
struct IdxOps { bf16x8 af[4][2]; u32x4 wraw[4][2]; bf16x8 kf[4][2]; };
__device__ __forceinline__ void dsa_index_load(IdxOps& P, const bf16_t* __restrict__ PROJ, int b, int qg, int lane, int wid) {
    asm volatile("" : "+v"(lane));
    const int n = lane & 31, hi = lane >> 5;
    const int q0 = qg * 16;
    const size_t tokbase = (size_t)b * SEQ;
    const int m = n, hm = (m >> 2) & 1, idx = (m & 3) + 4 * (m >> 3), aq = 2 * hm + (idx >> 3), ah = idx & 7;
#pragma unroll
    for (int qgp = 0; qgp < 4; ++qgp) { const bf16_t* qp = PROJ + (tokbase + q0 + 4 * qgp + aq) * PLD + C_QI + ah * 32 + 8 * hi;
        P.af[qgp][0] = *(const bf16x8*)qp; P.af[qgp][1] = *(const bf16x8*)(qp + 16); }
}
__device__ __forceinline__ void dsa_index_load_k(IdxOps& P, const bf16_t* __restrict__ PROJ, int b, int qg, int lane, int wid) {
    asm volatile("" : "+v"(lane));
    const int n = lane & 31, hi = lane >> 5;
    const int q0 = qg * 16, nkb = (q0 + 16 + 31) >> 5;
    const size_t tokbase = (size_t)b * SEQ;
#pragma unroll
    for (int qgp = 0; qgp < 4; ++qgp)
#pragma unroll
        for (int qq = 0; qq < 2; ++qq) P.wraw[qgp][qq] = *(const u32x4*)(PROJ + (tokbase + q0 + 4 * qgp + 2 * hi + qq) * PLD + C_WI);
#pragma unroll
    for (int i = 0; i < 4; ++i) { const int kb = wid + 8 * i;
        if (kb < nkb) { const bf16_t* kp = PROJ + (tokbase + 32 * kb + n) * PLD + C_KI + 8 * hi; P.kf[i][0] = *(const bf16x8*)kp; P.kf[i][1] = *(const bf16x8*)(kp + 16); } }
}
__device__ __forceinline__ void dsa_index_scores(IdxOps& P, const bf16_t* __restrict__ PROJ, LAS float* sc, int b, int qg, int lane, int wid) {
    const int n = lane & 31, hi = lane >> 5;
    const int q0 = qg * 16, nkb = (q0 + 16 + 31) >> 5;
    const size_t tokbase = (size_t)b * SEQ;
    LAS float* scw = sc + (2 * hi) * 2048 + 32 * wid + n;
    float wv[4][16];
#pragma unroll
    for (int qgp = 0; qgp < 4; ++qgp)
#pragma unroll
        for (int qq = 0; qq < 2; ++qq) { const u32x4 w = P.wraw[qgp][qq];
            wv[qgp][8 * qq + 0] = bf_lo(w.x) * 0.0625f; wv[qgp][8 * qq + 1] = bf_hi(w.x) * 0.0625f; wv[qgp][8 * qq + 2] = bf_lo(w.y) * 0.0625f; wv[qgp][8 * qq + 3] = bf_hi(w.y) * 0.0625f;
            wv[qgp][8 * qq + 4] = bf_lo(w.z) * 0.0625f; wv[qgp][8 * qq + 5] = bf_hi(w.z) * 0.0625f; wv[qgp][8 * qq + 6] = bf_lo(w.w) * 0.0625f; wv[qgp][8 * qq + 7] = bf_hi(w.w) * 0.0625f; }
#pragma unroll
    for (int i = 0; i < 8; ++i) { const int kb = wid + 8 * i;
        if (kb < nkb) {
            const bf16x8 k0 = P.kf[i & 3][0], k1 = P.kf[i & 3][1];
            if (i < 4 && kb + 32 < nkb) { const bf16_t* kp = PROJ + (tokbase + 32 * (kb + 32) + n) * PLD + C_KI + 8 * hi; P.kf[i & 3][0] = *(const bf16x8*)kp; P.kf[i & 3][1] = *(const bf16x8*)(kp + 16); }
#pragma unroll
            for (int qgp = 0; qgp < 4; ++qgp) {
                f32x16 d = {0.f, 0.f, 0.f, 0.f, 0.f, 0.f, 0.f, 0.f, 0.f, 0.f, 0.f, 0.f, 0.f, 0.f, 0.f, 0.f};
                d = __builtin_amdgcn_mfma_f32_32x32x16_bf16(P.af[qgp][0], k0, d, 0, 0, 0);
                d = __builtin_amdgcn_mfma_f32_32x32x16_bf16(P.af[qgp][1], k1, d, 0, 0, 0);
                float sa = 0.f, sb = 0.f;
#pragma unroll
                for (int r = 0; r < 8; ++r) { sa += wv[qgp][r] * fmaxf(d[r], 0.f); sb += wv[qgp][8 + r] * fmaxf(d[8 + r], 0.f); }
                scw[(4 * qgp) * 2048 + 256 * i] = sa; scw[(4 * qgp + 1) * 2048 + 256 * i] = sb;
            } } }
}
__device__ __forceinline__ void bit_transpose32(unsigned (&a)[32]) {
#pragma unroll
    for (int k = 0; k < 16; ++k) { const unsigned lo = a[k], hi = a[k + 16];
        a[k] = __builtin_amdgcn_perm(hi, lo, 0x05040100u); a[k + 16] = __builtin_amdgcn_perm(hi, lo, 0x07060302u); }
#pragma unroll
    for (int k = 0; k < 32; ++k) if ((k & 8) == 0) { const unsigned lo = a[k], hi = a[k + 8];
        a[k] = __builtin_amdgcn_perm(hi, lo, 0x06020400u); a[k + 8] = __builtin_amdgcn_perm(hi, lo, 0x07030501u); }
#pragma unroll
    for (int s = 0; s < 3; ++s) { const int j = 4 >> s; const unsigned m = (s == 0) ? 0x0F0F0F0Fu : (s == 1) ? 0x33333333u : 0x55555555u;
#pragma unroll
        for (int k = 0; k < 32; ++k) if ((k & j) == 0) { const unsigned lo = a[k], hi = a[k + j];
            a[k] = (m & lo) | (~m & (hi << j)); a[k + j] = (m & (lo >> j)) | (~m & hi); } }
}
__device__ __forceinline__ void dsa_index_select(LAS float* sc, LAS int* qctr, unsigned long long* __restrict__ bits64, int b, int qg, int lane, int wid) {
    const int q0 = qg * 16;
    const size_t tokbase = (size_t)b * SEQ;
#pragma unroll 1
    for (;;) {
        int qn = 0; if (lane == 0) qn = __hip_atomic_fetch_add(qctr, 1, __ATOMIC_RELAXED, __HIP_MEMORY_SCOPE_WORKGROUP);
        qn = __builtin_amdgcn_readfirstlane(qn); if (qn >= 16) break;
        const int ql = 15 - qn, pos = q0 + ql, nn = pos + 1, nr = (nn + 63) >> 6;
        const LAS float* scq = sc + ql * 2048;
        unsigned mlo = 0u, mhi = 0u;
        if (nn <= TOPK_SEL) {
#pragma unroll
            for (int r = 0; r < 4; ++r) if (r < nr) { const unsigned long long bal = __ballot(64 * r + lane <= pos); asm volatile("s_nop 4\n\tv_writelane_b32 %0, %2, %4\n\tv_writelane_b32 %1, %3, %4" : "+v"(mlo), "+v"(mhi) : "s"((unsigned)bal), "s"((unsigned)(bal >> 32)), "n"(r));     }
        } else {
            unsigned u[32];
#pragma unroll
            for (int r = 0; r < 32; ++r) u[r] = 0u;
#pragma unroll
            for (int g8 = 0; g8 < 4; ++g8) if (8 * g8 < nr) {
#pragma unroll
                for (int q_ = 0; q_ < 8; ++q_) { const int r = 8 * g8 + q_; const int j = 64 * r + lane; float s = scq[j]; s = (s == 0.f) ? 0.f : s; const unsigned bts = __builtin_bit_cast(unsigned, s);
                    const unsigned uu = (bts & 0x80000000u) ? ~bts : (bts | 0x80000000u); u[r] = (j <= pos) ? uu : 0u; } }
            unsigned M = 0u;
#pragma unroll
            for (int r = 0; r < 32; ++r) M |= (64 * r + lane <= pos) ? (1u << r) : 0u;
            bit_transpose32(u);
            unsigned G = 0u; unsigned need = (unsigned)TOPK_SEL, cM = (unsigned)nn;
            {
#pragma unroll
            for (int bq = 31; bq >= 0; --bq) {
                const unsigned T = M & u[bq];
                const unsigned c = wave_sum_u32((unsigned)__builtin_popcount(T));
                const bool ge = c >= need;
                G |= ge ? 0u : T; M = ge ? T : (M & ~u[bq]); cM = ge ? c : cM - c; need -= ge ? 0u : c;
                if (cM == need) { G |= M; goto sel_done; }
            }
            unsigned run = 0u;
#pragma unroll
            for (int r = 0; r < 32; ++r) if (r < nr) { const bool isc = (M >> r) & 1u; const unsigned long long eqm = __ballot(isc);
                const unsigned pre = run + __builtin_amdgcn_mbcnt_hi((unsigned)(eqm >> 32), __builtin_amdgcn_mbcnt_lo((unsigned)eqm, 0u));
                if (isc && pre < need) G |= (1u << r);
                run += (unsigned)__builtin_popcountll(eqm); }
            }
            sel_done:
#pragma unroll
            for (int r = 0; r < 32; ++r) if ((r & ~7) < nr) { const unsigned long long bal = __ballot((G >> r) & 1u); asm volatile("s_nop 4\n\tv_writelane_b32 %0, %2, %4\n\tv_writelane_b32 %1, %3, %4" : "+v"(mlo), "+v"(mhi) : "s"((unsigned)bal), "s"((unsigned)(bal >> 32)), "n"(r));     }
        }
        if (lane < nr) bits64[(tokbase + pos) * 32 + lane] = ((unsigned long long)mhi << 32) | mlo;
    }
}
__device__ __forceinline__ void dsa_index_phase(const Frame& F, const bf16_t* __restrict__ PROJ, unsigned long long* __restrict__ bits64, unsigned* stampw, bool pv = false) {
    LAS float* sc = (LAS float*)F.lds;
    LAS int* qctr = (LAS int*)(F.lds + TS_OFF);
    IdxOps P;
    int u = F.vcu;
    if (u < 4096) { dsa_index_load(P, PROJ, u & 31, u >> 5, F.lane, F.wave); dsa_index_load_k(P, PROJ, u & 31, u >> 5, F.lane, F.wave); }
#ifdef T_STAMP
    unsigned long long tA = 0, tB = 0, tC = 0, tD = 0, t0 = __builtin_amdgcn_s_memrealtime(), t1;
#define STAMP(acc) do { t1 = __builtin_amdgcn_s_memrealtime(); acc += t1 - t0; t0 = t1; } while (0)
#else
#define STAMP(acc) do { } while (0)
#endif
#pragma unroll 1
    for (; u < 4096; u += F.G) {
#if defined(IDX_PROBE) && (IDX_PROBE & 1)
        if (!pv)
#endif
        dsa_index_scores(P, PROJ, sc, u & 31, u >> 5, F.lane, F.wave);
        if (F.tid == 0) *qctr = 0;
        STAMP(tA);
        __syncthreads();
        STAMP(tB);
        const int un = u + F.G;
#if defined(IDX_PROBE) && (IDX_PROBE & 2)
        if (!pv)
#endif
        dsa_index_select(sc, qctr, bits64, u & 31, u >> 5, F.lane, F.wave);
        asm volatile("" ::: "memory");
        if (un < 4096) { dsa_index_load(P, PROJ, un & 31, un >> 5, F.lane, F.wave); dsa_index_load_k(P, PROJ, un & 31, un >> 5, F.lane, F.wave); }
        STAMP(tC);
        __syncthreads();
        STAMP(tD);
    }
#ifdef T_STAMP
    if (stampw && blockIdx.x == 17 && F.tid == 0) { const unsigned long long tot = tA + tB + tC + tD; const unsigned long long part = (T_STAMP == 0) ? tA : (T_STAMP == 1) ? tB : (T_STAMP == 2) ? tC : tD;
        *stampw = (unsigned)((part * 64ull) / (tot ? tot : 1ull)); }
#endif
#undef STAMP
}

constexpr int KS = 144, VS = 192;
#ifndef USE_TR
#define USE_TR 1
#endif
struct AttnPre { bf16x8 qf[4]; u32x4 kreg, vreg; u32x2 mreg; };
__device__ __forceinline__ void attn_decode(int u, int& b, int& g, int& qb) { const int cu = u & 255, j = u >> 8, bg = cu >> 2, s = cu & 3; qb = (j & 1) ? (8 * (j >> 1) + 7 - s) : (8 * (j >> 1) + s); b = bg >> 1; g = bg & 1; }
template <int MODE>
__device__ __forceinline__ void attn_prefetch(const Frame& F, const bf16_t* __restrict__ PROJ, const unsigned* __restrict__ bits, int b, int g, int qb, bf16x8 (&qf)[4], u32x4& kreg, u32x4& vreg, u32x2& mreg) {
    const int tid = F.tid, lane = F.lane, wid = F.wave, n = lane & 31, hi = lane >> 5;
    constexpr int CQ = MODE ? C_QB : C_QA, CK = MODE ? C_KB : C_KA, CV = MODE ? C_VB : C_VA;
    const int hq = 4 * g + (wid >> 1), qpos = qb * 64 + 32 * (wid & 1) + n;
    const size_t tokbase = (size_t)b * SEQ;
    const int kt_lo = (MODE == 0) ? (qb >= 2 ? qb - 2 : 0) : 0;
    const int srow = tid >> 3, sch = tid & 7;
    kreg = *(const u32x4*)(PROJ + (tokbase + srow + (size_t)kt_lo * 64) * PLD + CK + g * 64 + sch * 8);
    vreg = *(const u32x4*)(PROJ + (tokbase + srow + (size_t)kt_lo * 64) * PLD + CV + g * 64 + sch * 8);
    if (MODE == 1) mreg = *(const u32x2*)(bits + (tokbase + qpos) * 64 + 2 * kt_lo);
    const bf16_t* qp = PROJ + (tokbase + qpos) * PLD + CQ + hq * 64 + 8 * hi;
#pragma unroll
    for (int s = 0; s < 4; ++s) qf[s] = *(const bf16x8*)(qp + 16 * s);
}
template <int MODE>
__device__ __forceinline__ void attn_unit(const Frame& F, const bf16_t* __restrict__ PROJ, bf16_t* __restrict__ O, const unsigned* __restrict__ bits, const float* __restrict__ sinks, int b, int g, int qb, AttnPre& P, int un  ) {
    const int tid = F.tid, lane = F.lane, wid = F.wave, n = lane & 31, hi = lane >> 5;
    constexpr int CQ = MODE ? C_QB : C_QA, CK = MODE ? C_KB : C_KA, CV = MODE ? C_VB : C_VA;
    const int hq = 4 * g + (wid >> 1), qpos = qb * 64 + 32 * (wid & 1) + n;
    const size_t tokbase = (size_t)b * SEQ;
    LAS unsigned char* Ks = F.lds; LAS unsigned char* Vs = F.lds + 64 * KS;
    bf16x8 qf[4], qn[4];
#pragma unroll
    for (int s = 0; s < 4; ++s) { qf[s] = P.qf[s]; qn[s] = P.qf[s]; }
    f32x16 o0, o1;
#pragma unroll
    for (int r = 0; r < 16; ++r) { o0[r] = 0.f; o1[r] = 0.f; }
    float mrun, lsum;
    if (MODE == 0) { mrun = sinks[hq] * LOG2E; lsum = (hi == 0) ? 1.f : 0.f; } else { mrun = -1e30f; lsum = 0.f; }
    const int kt_lo = (MODE == 0) ? (qb >= 2 ? qb - 2 : 0) : 0, kt_hi = qb;
    const int srow = tid >> 3, sch = tid & 7;
    const bf16_t* kg = PROJ + (tokbase + srow) * PLD + CK + g * 64 + sch * 8;
    const bf16_t* vg = PROJ + (tokbase + srow) * PLD + CV + g * 64 + sch * 8;
    const unsigned* bp = bits + (tokbase + qpos) * 64;
    u32x4 kreg = P.kreg, vreg = P.vreg;
    u32x2 mreg = {0u, 0u};
    if (MODE == 1) mreg = P.mreg;
    const int vbase = (4 * hi + ((lane & 15) >> 2)) * VS + (16 * ((lane >> 4) & 1) + 4 * (lane & 3)) * 2;
    for (int kt = kt_lo; kt <= kt_hi; ++kt) {
        __syncthreads();
        *(LAS u32x4*)(Ks + srow * KS + sch * 16) = kreg; *(LAS u32x4*)(Vs + srow * VS + sch * 16) = vreg;
        const u32x2 mcur = mreg;
        __syncthreads();
        if (kt < kt_hi) { kreg = *(const u32x4*)(kg + (size_t)(kt + 1) * 64 * PLD); vreg = *(const u32x4*)(vg + (size_t)(kt + 1) * 64 * PLD); if (MODE == 1) mreg = *(const u32x2*)(bp + 2 * (kt + 1)); }
        else if (un < 2048) { int nb, ng, nqb; attn_decode(un, nb, ng, nqb); attn_prefetch<MODE>(F, PROJ, bits, nb, ng, nqb, qn, kreg, vreg, mreg); }
        f32x16 p0, p1;
#pragma unroll
        for (int r = 0; r < 16; ++r) { p0[r] = 0.f; p1[r] = 0.f; }
#pragma unroll
        for (int s = 0; s < 4; ++s) { const bf16x8 k0 = *(const LAS bf16x8*)(Ks + n * KS + (16 * s + 8 * hi) * 2), k1 = *(const LAS bf16x8*)(Ks + (n + 32) * KS + (16 * s + 8 * hi) * 2);
            p0 = __builtin_amdgcn_mfma_f32_32x32x16_bf16(k0, qf[s], p0, 0, 0, 0); p1 = __builtin_amdgcn_mfma_f32_32x32x16_bf16(k1, qf[s], p1, 0, 0, 0); }
        unsigned w0, w1;
        if (MODE == 1) { w0 = mcur.x >> (4 * hi); w1 = mcur.y >> (4 * hi); }
        else {
#pragma unroll
            for (int blk = 0; blk < 2; ++blk) { const int d0 = qpos - (kt * 64 + 32 * blk); unsigned mk = 0u;
                if (d0 >= 0) { const int hb = d0 > 31 ? 31 : d0; int lo = d0 - 127; if (lo <= 31) { if (lo < 0) lo = 0; mk = (0xFFFFFFFFu >> (31 - hb)) & (0xFFFFFFFFu << lo); } }
                if (blk == 0) w0 = mk >> (4 * hi); else w1 = mk >> (4 * hi); }
        }
        float mx = fmaxf(fmaxf(p0[0], p0[1]), fmaxf(p1[0], p1[1]));
#pragma unroll
        for (int r = 2; r < 16; r += 2) mx = fmaxf(mx, fmaxf(fmaxf(p0[r], p0[r + 1]), fmaxf(p1[r], p1[r + 1])));
        mx = xor32_max(mx);
        const float mnew = fmaxf(mrun, mx), alpha = fexp2(mrun - mnew); mrun = mnew;
        float ps = 0.f;
#pragma unroll
        for (int r = 0; r < 16; ++r) { const int bitpos = 8 * (r >> 2) + (r & 3);
            const float e0 = fexp2(p0[r] - mnew), e1 = fexp2(p1[r] - mnew);
            p0[r] = __builtin_bit_cast(float, __builtin_bit_cast(unsigned, e0) & (unsigned)__builtin_amdgcn_sbfe((int)w0, bitpos, 1));
            p1[r] = __builtin_bit_cast(float, __builtin_bit_cast(unsigned, e1) & (unsigned)__builtin_amdgcn_sbfe((int)w1, bitpos, 1));
            ps += p0[r] + p1[r]; }
        lsum = lsum * alpha + ps;
        if (__builtin_amdgcn_ballot_w64(alpha != 1.f) != 0ull) {
#pragma unroll
            for (int r = 0; r < 16; ++r) { o0[r] *= alpha; o1[r] *= alpha; } }
        bf16x8 pf[2][2];
#pragma unroll
        for (int s2 = 0; s2 < 2; ++s2) { u32x4 a, c;
            a.x = cvt_pk_bf16(p0[8 * s2 + 0], p0[8 * s2 + 1]); a.y = cvt_pk_bf16(p0[8 * s2 + 2], p0[8 * s2 + 3]); a.z = cvt_pk_bf16(p0[8 * s2 + 4], p0[8 * s2 + 5]); a.w = cvt_pk_bf16(p0[8 * s2 + 6], p0[8 * s2 + 7]);
            c.x = cvt_pk_bf16(p1[8 * s2 + 0], p1[8 * s2 + 1]); c.y = cvt_pk_bf16(p1[8 * s2 + 2], p1[8 * s2 + 3]); c.z = cvt_pk_bf16(p1[8 * s2 + 4], p1[8 * s2 + 5]); c.w = cvt_pk_bf16(p1[8 * s2 + 6], p1[8 * s2 + 7]);
            pf[0][s2] = __builtin_bit_cast(bf16x8, a); pf[1][s2] = __builtin_bit_cast(bf16x8, c); }
#pragma unroll
        for (int db = 0; db < 2; ++db)
#pragma unroll
            for (int blk = 0; blk < 2; ++blk)
#pragma unroll
                for (int s2 = 0; s2 < 2; ++s2) {
                    bf16x8 vf;
#if USE_TR
                    const v4i16_t t0 = __builtin_amdgcn_ds_read_tr16_b64_v4i16((LAS v4i16_t*)(Vs + vbase + (32 * blk + 16 * s2) * VS + 64 * db));
                    const v4i16_t t1 = __builtin_amdgcn_ds_read_tr16_b64_v4i16((LAS v4i16_t*)(Vs + vbase + (32 * blk + 16 * s2 + 8) * VS + 64 * db));
                    vf = (bf16x8){t0[0], t0[1], t0[2], t0[3], t1[0], t1[1], t1[2], t1[3]};
#else
#pragma unroll
                    for (int j = 0; j < 8; ++j) vf[j] = *(const LAS short*)(Vs + (32 * blk + 16 * s2 + 8 * (j >> 2) + 4 * hi + (j & 3)) * VS + (32 * db + n) * 2);
#endif
                    if (db == 0) o0 = __builtin_amdgcn_mfma_f32_32x32x16_bf16(vf, pf[blk][s2], o0, 0, 0, 0); else o1 = __builtin_amdgcn_mfma_f32_32x32x16_bf16(vf, pf[blk][s2], o1, 0, 0, 0);
                }
    }
    const float lt = xor32_add(lsum), inv = 1.f / lt;
    bf16_t* op = O + (tokbase + qpos) * 512 + hq * 64 + 8 * hi;
#pragma unroll
    for (int db = 0; db < 2; ++db)
#pragma unroll
        for (int kp = 0; kp < 2; ++kp) { const int r0 = 8 * kp;
            unsigned ax, ay, bx, by;
            if (db == 0) { ax = cvt_pk_bf16(o0[r0] * inv, o0[r0 + 1] * inv); ay = cvt_pk_bf16(o0[r0 + 2] * inv, o0[r0 + 3] * inv); bx = cvt_pk_bf16(o0[r0 + 4] * inv, o0[r0 + 5] * inv); by = cvt_pk_bf16(o0[r0 + 6] * inv, o0[r0 + 7] * inv); }
            else { ax = cvt_pk_bf16(o1[r0] * inv, o1[r0 + 1] * inv); ay = cvt_pk_bf16(o1[r0 + 2] * inv, o1[r0 + 3] * inv); bx = cvt_pk_bf16(o1[r0 + 4] * inv, o1[r0 + 5] * inv); by = cvt_pk_bf16(o1[r0 + 6] * inv, o1[r0 + 7] * inv); }
            { auto r = __builtin_amdgcn_permlane32_swap(ax, bx, false, false); ax = r[0]; bx = r[1]; }
            { auto r = __builtin_amdgcn_permlane32_swap(ay, by, false, false); ay = r[0]; by = r[1]; }
            *(u32x4*)(op + 32 * db + 16 * kp) = (u32x4){ax, ay, bx, by}; }
#pragma unroll
    for (int s = 0; s < 4; ++s) P.qf[s] = qn[s];
    P.kreg = kreg; P.vreg = vreg; P.mreg = mreg;
}

struct SwaPre { bf16x8 qf[4]; u32x4 kreg[3], vreg[3]; };
__device__ __forceinline__ void swa_prefetch(const Frame& F, const bf16_t* __restrict__ PROJ, int b, int g, int qb, bf16x8 (&qf)[4], u32x4 (&kreg)[3], u32x4 (&vreg)[3]) {
    const int tid = F.tid, lane = F.lane, wid = F.wave, n = lane & 31, hi = lane >> 5;
    const int hq = 4 * g + (wid >> 1), qpos = qb * 64 + 32 * (wid & 1) + n;
    const size_t tokbase = (size_t)b * SEQ;
    const int srow = tid >> 3, sch = tid & 7;
#pragma unroll
    for (int i = 0; i < 3; ++i) { const int kt = qb - 2 + i;
        if (kt >= 0) { kreg[i] = *(const u32x4*)(PROJ + (tokbase + srow + (size_t)kt * 64) * PLD + C_KA + g * 64 + sch * 8); vreg[i] = *(const u32x4*)(PROJ + (tokbase + srow + (size_t)kt * 64) * PLD + C_VA + g * 64 + sch * 8); } }
    const bf16_t* qp = PROJ + (tokbase + qpos) * PLD + C_QA + hq * 64 + 8 * hi;
#pragma unroll
    for (int s = 0; s < 4; ++s) qf[s] = *(const bf16x8*)(qp + 16 * s);
}
__device__ __forceinline__ void swa_unit(const Frame& F, const bf16_t* __restrict__ PROJ, bf16_t* __restrict__ O, const float* __restrict__ sinks, int b, int g, int qb, SwaPre& P, int un  , bool pv = false) {
    const int tid = F.tid, lane = F.lane, wid = F.wave, n = lane & 31, hi = lane >> 5;
    const int hq = 4 * g + (wid >> 1), qpos = qb * 64 + 32 * (wid & 1) + n;
    const size_t tokbase = (size_t)b * SEQ;
    constexpr int TILE_B = 64 * KS + 64 * VS;
    bf16x8 qf[4], qn[4];
#pragma unroll
    for (int s = 0; s < 4; ++s) { qf[s] = P.qf[s]; qn[s] = P.qf[s]; }
    f32x16 o0, o1;
#pragma unroll
    for (int r = 0; r < 16; ++r) { o0[r] = 0.f; o1[r] = 0.f; }
    float mrun = sinks[hq] * LOG2E, lsum = (hi == 0) ? 1.f : 0.f;
    const int srow = tid >> 3, sch = tid & 7;
    __syncthreads();
#pragma unroll
    for (int i = 0; i < 3; ++i) if (qb - 2 + i >= 0) { *(LAS u32x4*)(F.lds + i * TILE_B + srow * KS + sch * 16) = P.kreg[i]; *(LAS u32x4*)(F.lds + i * TILE_B + 64 * KS + srow * VS + sch * 16) = P.vreg[i]; }
    __syncthreads();
    if (un < 2048) { int nb, ng, nqb; attn_decode(un, nb, ng, nqb); swa_prefetch(F, PROJ, nb, ng, nqb, qn, P.kreg, P.vreg); }
    const int vbase = (4 * hi + ((lane & 15) >> 2)) * VS + (16 * ((lane >> 4) & 1) + 4 * (lane & 3)) * 2;
#pragma unroll 1
#if defined(IDX_PROBE) && (IDX_PROBE & 32)
    if (!pv)
#endif
    for (int i = (qb >= 2 ? 0 : 2 - qb); i < 3; ++i) { const int kt = qb - 2 + i;
        LAS unsigned char* Ks = F.lds + i * TILE_B; LAS unsigned char* Vs = Ks + 64 * KS;
        f32x16 p0, p1;
#pragma unroll
        for (int r = 0; r < 16; ++r) { p0[r] = 0.f; p1[r] = 0.f; }
#pragma unroll
        for (int s = 0; s < 4; ++s) { const bf16x8 k0 = *(const LAS bf16x8*)(Ks + n * KS + (16 * s + 8 * hi) * 2), k1 = *(const LAS bf16x8*)(Ks + (n + 32) * KS + (16 * s + 8 * hi) * 2);
            p0 = __builtin_amdgcn_mfma_f32_32x32x16_bf16(k0, qf[s], p0, 0, 0, 0); p1 = __builtin_amdgcn_mfma_f32_32x32x16_bf16(k1, qf[s], p1, 0, 0, 0); }
        unsigned w0 = 0u, w1 = 0u;
#pragma unroll
        for (int blk = 0; blk < 2; ++blk) { const int d0 = qpos - (kt * 64 + 32 * blk); unsigned mk = 0u;
            if (d0 >= 0) { const int hb = d0 > 31 ? 31 : d0; int lo = d0 - 127; if (lo <= 31) { if (lo < 0) lo = 0; mk = (0xFFFFFFFFu >> (31 - hb)) & (0xFFFFFFFFu << lo); } }
            if (blk == 0) w0 = mk >> (4 * hi); else w1 = mk >> (4 * hi); }
        float mx = fmaxf(fmaxf(p0[0], p0[1]), fmaxf(p1[0], p1[1]));
#pragma unroll
        for (int r = 2; r < 16; r += 2) mx = fmaxf(mx, fmaxf(fmaxf(p0[r], p0[r + 1]), fmaxf(p1[r], p1[r + 1])));
        mx = xor32_max(mx);
        const float mnew = fmaxf(mrun, mx), alpha = fexp2(mrun - mnew); mrun = mnew;
        float ps = 0.f;
#pragma unroll
        for (int r = 0; r < 16; ++r) { const int bitpos = 8 * (r >> 2) + (r & 3);
            const float e0 = fexp2(p0[r] - mnew), e1 = fexp2(p1[r] - mnew);
            p0[r] = __builtin_bit_cast(float, __builtin_bit_cast(unsigned, e0) & (unsigned)__builtin_amdgcn_sbfe((int)w0, bitpos, 1));
            p1[r] = __builtin_bit_cast(float, __builtin_bit_cast(unsigned, e1) & (unsigned)__builtin_amdgcn_sbfe((int)w1, bitpos, 1));
            ps += p0[r] + p1[r]; }
        lsum = lsum * alpha + ps;
        if (__builtin_amdgcn_ballot_w64(alpha != 1.f) != 0ull) {
#pragma unroll
            for (int r = 0; r < 16; ++r) { o0[r] *= alpha; o1[r] *= alpha; } }
        bf16x8 pf[2][2];
#pragma unroll
        for (int s2 = 0; s2 < 2; ++s2) { u32x4 a, c;
            a.x = cvt_pk_bf16(p0[8 * s2 + 0], p0[8 * s2 + 1]); a.y = cvt_pk_bf16(p0[8 * s2 + 2], p0[8 * s2 + 3]); a.z = cvt_pk_bf16(p0[8 * s2 + 4], p0[8 * s2 + 5]); a.w = cvt_pk_bf16(p0[8 * s2 + 6], p0[8 * s2 + 7]);
            c.x = cvt_pk_bf16(p1[8 * s2 + 0], p1[8 * s2 + 1]); c.y = cvt_pk_bf16(p1[8 * s2 + 2], p1[8 * s2 + 3]); c.z = cvt_pk_bf16(p1[8 * s2 + 4], p1[8 * s2 + 5]); c.w = cvt_pk_bf16(p1[8 * s2 + 6], p1[8 * s2 + 7]);
            pf[0][s2] = __builtin_bit_cast(bf16x8, a); pf[1][s2] = __builtin_bit_cast(bf16x8, c); }
#pragma unroll
        for (int db = 0; db < 2; ++db)
#pragma unroll
            for (int blk = 0; blk < 2; ++blk)
#pragma unroll
                for (int s2 = 0; s2 < 2; ++s2) {
                    const v4i16_t t0 = __builtin_amdgcn_ds_read_tr16_b64_v4i16((LAS v4i16_t*)(Vs + vbase + (32 * blk + 16 * s2) * VS + 64 * db));
                    const v4i16_t t1 = __builtin_amdgcn_ds_read_tr16_b64_v4i16((LAS v4i16_t*)(Vs + vbase + (32 * blk + 16 * s2 + 8) * VS + 64 * db));
                    const bf16x8 vf = (bf16x8){t0[0], t0[1], t0[2], t0[3], t1[0], t1[1], t1[2], t1[3]};
                    if (db == 0) o0 = __builtin_amdgcn_mfma_f32_32x32x16_bf16(vf, pf[blk][s2], o0, 0, 0, 0); else o1 = __builtin_amdgcn_mfma_f32_32x32x16_bf16(vf, pf[blk][s2], o1, 0, 0, 0);
                }
    }
    const float lt = xor32_add(lsum), inv = 1.f / lt;
    bf16_t* op = O + (tokbase + qpos) * 512 + hq * 64 + 8 * hi;
#pragma unroll
    for (int db = 0; db < 2; ++db)
#pragma unroll
        for (int kp = 0; kp < 2; ++kp) { const int r0 = 8 * kp;
            unsigned ax, ay, bx, by;
            if (db == 0) { ax = cvt_pk_bf16(o0[r0] * inv, o0[r0 + 1] * inv); ay = cvt_pk_bf16(o0[r0 + 2] * inv, o0[r0 + 3] * inv); bx = cvt_pk_bf16(o0[r0 + 4] * inv, o0[r0 + 5] * inv); by = cvt_pk_bf16(o0[r0 + 6] * inv, o0[r0 + 7] * inv); }
            else { ax = cvt_pk_bf16(o1[r0] * inv, o1[r0 + 1] * inv); ay = cvt_pk_bf16(o1[r0 + 2] * inv, o1[r0 + 3] * inv); bx = cvt_pk_bf16(o1[r0 + 4] * inv, o1[r0 + 5] * inv); by = cvt_pk_bf16(o1[r0 + 6] * inv, o1[r0 + 7] * inv); }
            { auto r = __builtin_amdgcn_permlane32_swap(ax, bx, false, false); ax = r[0]; bx = r[1]; }
            { auto r = __builtin_amdgcn_permlane32_swap(ay, by, false, false); ay = r[0]; by = r[1]; }
            *(u32x4*)(op + 32 * db + 16 * kp) = (u32x4){ax, ay, bx, by}; }
#pragma unroll
    for (int s = 0; s < 4; ++s) P.qf[s] = qn[s];
}

constexpr int SGS = 1040;
static_assert(128 * SGS <= MISC_OFF, "spatial-gating tile vs LDS control words");
__device__ __forceinline__ void sg_unit(const Frame& F, const bf16_t* __restrict__ PROJ, const bf16_t* __restrict__ SGWl, const float* __restrict__ sgb, const float* __restrict__ lng, bf16_t* __restrict__ OC, int b, int ch) {
    const int lane = F.lane, wid = F.wave, n = lane & 31, hi = lane >> 5;
    const size_t tok0 = (size_t)b * SEQ + ch * 128;
    LAS unsigned char* V = F.lds;
    __syncthreads();
    float gl[8];
    { const f32x4 g0 = *(const f32x4*)(lng + 8 * lane), g1 = *(const f32x4*)(lng + 8 * lane + 4); gl[0] = g0[0]; gl[1] = g0[1]; gl[2] = g0[2]; gl[3] = g0[3]; gl[4] = g1[0]; gl[5] = g1[1]; gl[6] = g1[2]; gl[7] = g1[3]; }
    u32x4 wrow16[16];
#pragma unroll
    for (int rr = 0; rr < 16; ++rr) wrow16[rr] = *(const u32x4*)(PROJ + (tok0 + 16 * wid + rr) * PLD + C_V + 8 * lane);
#pragma unroll
    for (int r4 = 0; r4 < 16; r4 += 4) { float x[4][8], s[4], q[4];
#pragma unroll
        for (int a = 0; a < 4; ++a) { const u32x4 w = wrow16[r4 + a];
            x[a][0] = bf_lo(w.x); x[a][1] = bf_hi(w.x); x[a][2] = bf_lo(w.y); x[a][3] = bf_hi(w.y); x[a][4] = bf_lo(w.z); x[a][5] = bf_hi(w.z); x[a][6] = bf_lo(w.w); x[a][7] = bf_hi(w.w);
            s[a] = ((x[a][0] + x[a][1]) + (x[a][2] + x[a][3])) + ((x[a][4] + x[a][5]) + (x[a][6] + x[a][7])); }
#pragma unroll
        for (int a = 0; a < 4; ++a) s[a] = wave_sum(s[a]) * (1.f / 512.f);
#pragma unroll
        for (int a = 0; a < 4; ++a) { q[a] = 0.f;
#pragma unroll
            for (int i = 0; i < 8; ++i) { x[a][i] -= s[a]; q[a] += x[a][i] * x[a][i]; } }
#pragma unroll
        for (int a = 0; a < 4; ++a) q[a] = wave_sum(q[a]);
#pragma unroll
        for (int a = 0; a < 4; ++a) { const int row = 16 * wid + r4 + a; const float rstd = 1.f / sqrtf(q[a] * (1.f / 512.f) + LN_EPS);
            u32x4 o; o.x = cvt_pk_bf16(x[a][0] * rstd * gl[0], x[a][1] * rstd * gl[1]); o.y = cvt_pk_bf16(x[a][2] * rstd * gl[2], x[a][3] * rstd * gl[3]);
            o.z = cvt_pk_bf16(x[a][4] * rstd * gl[4], x[a][5] * rstd * gl[5]); o.w = cvt_pk_bf16(x[a][6] * rstd * gl[6], x[a][7] * rstd * gl[7]);
            *(LAS u32x4*)(V + row * SGS + 16 * lane) = o; } }
    __syncthreads();
    const int g = wid;
    const int vbase = (8 * hi + ((lane & 15) >> 2)) * SGS + (g * 64 + 16 * ((lane >> 4) & 1) + 4 * (lane & 3)) * 2;
    const bf16_t* wg = SGWl + (size_t)g * 128 * 128;
#pragma unroll
    for (int tb = 0; tb < 4; ++tb) {
        f32x16 a0, a1;
#pragma unroll
        for (int r = 0; r < 16; ++r) { a0[r] = 0.f; a1[r] = 0.f; }
        const bf16_t* wrow = wg + (size_t)(32 * tb + n) * 128 + 8 * hi;
        bf16x8 afr[8];
#pragma unroll
        for (int ks = 0; ks < 8; ++ks) if (ks < 2 * tb + 2) afr[ks] = *(const bf16x8*)(wrow + 16 * ks);
        const int t = 32 * tb + n;
        const float bb = sgb[g * 128 + t];
        u32x2 uu[2][4];
        { const bf16_t* up = PROJ + (tok0 + t) * PLD + C_U + g * 64 + 4 * hi;
#pragma unroll
          for (int db = 0; db < 2; ++db)
#pragma unroll
              for (int q4 = 0; q4 < 4; ++q4) uu[db][q4] = *(const u32x2*)(up + 32 * db + 8 * q4); }
#pragma unroll
        for (int ks = 0; ks < 8; ++ks) if (ks < 2 * tb + 2) {
            const bf16x8 af = afr[ks];
#pragma unroll
            for (int db = 0; db < 2; ++db) { bf16x8 vf;
#if USE_TR
                const v4i16_t t0 = __builtin_amdgcn_ds_read_tr16_b64_v4i16((LAS v4i16_t*)(V + vbase + (16 * ks) * SGS + 64 * db));
                const v4i16_t t1 = __builtin_amdgcn_ds_read_tr16_b64_v4i16((LAS v4i16_t*)(V + vbase + (16 * ks + 4) * SGS + 64 * db));
                vf = (bf16x8){t0[0], t0[1], t0[2], t0[3], t1[0], t1[1], t1[2], t1[3]};
#else
#pragma unroll
                for (int j = 0; j < 8; ++j) vf[j] = *(const LAS short*)(V + (16 * ks + 8 * hi + j) * SGS + (g * 64 + 32 * db + n) * 2);
#endif
                if (db == 0) a0 = __builtin_amdgcn_mfma_f32_32x32x16_bf16(vf, af, a0, 0, 0, 0); else a1 = __builtin_amdgcn_mfma_f32_32x32x16_bf16(vf, af, a1, 0, 0, 0); }
        }
        bf16_t* op = OC + (tok0 + t) * 512 + g * 64 + 8 * hi;
#pragma unroll
        for (int db = 0; db < 2; ++db)
#pragma unroll
            for (int kp = 0; kp < 2; ++kp) { const int r0 = 8 * kp; float v[8];
#pragma unroll
                for (int i = 0; i < 8; ++i) { const u32x2 uw = uu[db][2 * kp + (i >> 2)]; const unsigned wd = (i & 2) ? uw.y : uw.x; const float uf = (i & 1) ? bf_hi(wd) : bf_lo(wd);
                    v[i] = ((db == 0 ? a0[r0 + i] : a1[r0 + i]) + bb) * uf; }
                unsigned ax = cvt_pk_bf16(v[0], v[1]), ay = cvt_pk_bf16(v[2], v[3]), bx = cvt_pk_bf16(v[4], v[5]), by = cvt_pk_bf16(v[6], v[7]);
                { auto r = __builtin_amdgcn_permlane32_swap(ax, bx, false, false); ax = r[0]; bx = r[1]; }
                { auto r = __builtin_amdgcn_permlane32_swap(ay, by, false, false); ay = r[0]; by = r[1]; }
                *(u32x4*)(op + 32 * db + 16 * kp) = (u32x4){ax, ay, bx, by}; }
    }
}
constexpr int HS_STRIDE = 2064;
constexpr int P7_PART = 32 * HS_STRIDE;
constexpr int P7_LOG = P7_PART + 8 * 4096;
constexpr int P7_HIST = P7_LOG + 32 * 33 * 4;
constexpr int P7_TOKB = P7_HIST + 256;
static_assert(P7_TOKB + 32 * 32 * 4 * 4 <= 134144, "route LDS map");
__device__ __forceinline__ void p7_route(const Frame& F, const Args& a, int l, bf16_t* X16  , const bf16_t* Y, const float* SSP, const float* MODl, signed char* H8, float* RS,
                                         const bf16_t* WRTl, unsigned* cnt, int* ROWTOK, unsigned* TOKINFO) {
    const int tid = F.tid, lane = F.lane, wid = F.wave, n = lane & 31, hi = lane >> 5;
    const float* g_post = a.in[5] + l * DM; const float* g_pre = a.in[6] + l * DM; const float* b_router = a.in[16] + l * NE;
    LAS unsigned char* hs = F.lds; LAS float* part = (LAS float*)(F.lds + P7_PART); LAS float* lg = (LAS float*)(F.lds + P7_LOG); LAS int* hist = (LAS int*)(F.lds + P7_HIST); LAS int* base = hist + 32;
    if (tid < 32) hist[tid] = 0;
    __syncthreads();
    const int NBT = MTOK / 32, bt0 = (int)((long)NBT * F.vcu / F.G), bt1 = (int)((long)NBT * (F.vcu + 1) / F.G);
    bf16x8 wbf[8];
#pragma unroll
    for (int ks = 0; ks < 8; ++ks) wbf[ks] = *(const bf16x8*)(WRTl + (size_t)n * DM + (8 * wid + ks) * 16 + 8 * hi);
    const float brv = b_router[tid & 31];
    f32x4 A1[4], A2[4], A3[4]; int bcur = (bt0 < NBT ? bt0 : NBT - 1) >> 6;
#define P7_PARAMS(b_) do { const float* mb_ = MODl + (size_t)(b_) * 6 * DM; _Pragma("unroll") for (int j = 0; j < 4; ++j) { const int c = 4 * lane + 256 * j; \
        const f32x4 gp = *(const f32x4*)(g_post + c), ga = *(const f32x4*)(mb_ + 2 * DM + c), gg = *(const f32x4*)(g_pre + c), s1 = *(const f32x4*)(mb_ + 4 * DM + c), s0 = *(const f32x4*)(mb_ + 3 * DM + c); \
        A1[j] = ga * gp; A2[j] = gg * (s1 + 1.f); A3[j] = s0; } } while (0)
    P7_PARAMS(bcur);
    u32x2 yv[4][4], xv[4][4]; float s4v[4];
#define P7_LOAD(bt_) do { _Pragma("unroll") for (int rr = 0; rr < 4; ++rr) { const size_t row = (size_t)(bt_) * 32 + 4 * wid + rr; s4v[rr] = SSP[(size_t)(lane & 15) * MTOK + row]; \
        _Pragma("unroll") for (int j = 0; j < 4; ++j) { const int c = 4 * lane + 256 * j; yv[rr][j] = __builtin_nontemporal_load((const u32x2*)(Y + row * DM + c)); xv[rr][j] = __builtin_nontemporal_load((const u32x2*)(X16 + row * DM + c)); } } } while (0)
    P7_LOAD(bt0 < NBT ? bt0 : NBT - 1);
    LAS unsigned* tokb = (LAS unsigned*)(F.lds + P7_TOKB); int btf = bt0;
    for (int bt = bt0; bt < bt1; ++bt) {
        const int row0 = bt * 32, b = row0 >> 11;
        if (b != bcur) { bcur = b; P7_PARAMS(b); }
#pragma unroll
        for (int rr = 0; rr < 4; ++rr) { const int rl = 4 * wid + rr; const size_t row = (size_t)row0 + rl;
            float ssy = s4v[rr]; ssy += dpp_f<0xB1>(ssy); ssy += dpp_f<0x4E>(ssy); ssy += dpp_f<0x141>(ssy); ssy += dpp_f<0x140>(ssy);
            const float rstd1 = 1.f / sqrtf(ssy * (1.f / DM) + RMS_EPS);
            f32x4 v[4]; float ss = 0.f;
#pragma unroll
            for (int j = 0; j < 4; ++j) { const int c = 4 * lane + 256 * j; const u32x2 yw_ = yv[rr][j]; const u32x2 xw_ = xv[rr][j]; const f32x4 yy = {bf_lo(yw_.x), bf_hi(yw_.x), bf_lo(yw_.y), bf_hi(yw_.y)}, xx = {bf_lo(xw_.x), bf_hi(xw_.x), bf_lo(xw_.y), bf_hi(xw_.y)};
                v[j] = xx + A1[j] * (yy * rstd1); { u32x2 xo; xo.x = cvt_pk_bf16(v[j][0], v[j][1]); xo.y = cvt_pk_bf16(v[j][2], v[j][3]); *(u32x2*)(X16 + row * DM + c) = xo; }
                ss += (v[j][0] * v[j][0] + v[j][1] * v[j][1]) + (v[j][2] * v[j][2] + v[j][3] * v[j][3]); }
            ss = wave_sum(ss);
            const float rstd = 1.f / sqrtf(ss * (1.f / DM) + RMS_EPS);
            f32x4 o[4]; float am = 0.f;
#pragma unroll
            for (int j = 0; j < 4; ++j) { const int c = 4 * lane + 256 * j;
                o[j] = (v[j] * rstd) * A2[j] + A3[j]; u32x2 w; w.x = cvt_pk_bf16(o[j][0], o[j][1]); w.y = cvt_pk_bf16(o[j][2], o[j][3]);
                *(LAS u32x2*)(hs + rl * HS_STRIDE + c * 2) = w;
                am = fmaxf(am, fmaxf(fmaxf(fabsf(o[j][0]), fabsf(o[j][1])), fmaxf(fabsf(o[j][2]), fabsf(o[j][3])))); }
            am = wave_max(am);
            const float scale = fmaxf(am, 1e-30f) * (1.f / 127.f), inv = 1.f / scale;
            if (lane == 0) RS[row] = scale;
#pragma unroll
            for (int j = 0; j < 4; ++j) *(unsigned*)(H8 + row * DM + 4 * lane + 256 * j) = q8x4(o[j][0], o[j][1], o[j][2], o[j][3], inv); }
        if (bt + 1 < bt1) P7_LOAD(bt + 1);
        lds_barrier();
        {
            f32x16 d;
#pragma unroll
            for (int r = 0; r < 16; ++r) d[r] = 0.f;
#pragma unroll
            for (int ks = 0; ks < 8; ++ks) { const int k0 = (8 * wid + ks) * 16 + 8 * hi;
                const bf16x8 af = *(const LAS bf16x8*)(hs + n * HS_STRIDE + k0 * 2);
                d = __builtin_amdgcn_mfma_f32_32x32x16_bf16(af, wbf[ks], d, 0, 0, 0); }
#pragma unroll
            for (int r = 0; r < 16; ++r) part[wid * 1024 + (8 * (r >> 2) + 4 * hi + (r & 3)) * 32 + n] = d[r];
        }
        lds_barrier();
        for (int i = tid; i < 1024; i += 512) { float s = brv;
#pragma unroll
            for (int w = 0; w < 8; ++w) s += part[w * 1024 + i]; lg[(i >> 5) * 33 + (i & 31)] = s; }
        lds_barrier();
        int e_k[4] = {0, 0, 0, 0}, lp_k[4] = {0, 0, 0, 0}; float w_k[4] = {0.f, 0.f, 0.f, 0.f};
        if (tid < 32) { LAS float* mylg = lg + tid * 33; float tl[4];
#pragma unroll
            for (int k = 0; k < 4; ++k) { float best = -INFINITY; int bi = 0;
                for (int e = 0; e < 32; ++e) { const float vv = mylg[e]; if (vv > best) { best = vv; bi = e; } }
                tl[k] = best; e_k[k] = bi; mylg[bi] = -INFINITY; }
            float sum = 0.f;
#pragma unroll
            for (int k = 0; k < 4; ++k) { w_k[k] = __expf(tl[k] - tl[0]); sum += w_k[k]; }
            const float inv = 1.f / sum;
#pragma unroll
            for (int k = 0; k < 4; ++k) { w_k[k] *= inv; lp_k[k] = __hip_atomic_fetch_add(&hist[e_k[k]], 1, __ATOMIC_RELAXED, __HIP_MEMORY_SCOPE_WORKGROUP); }
            const int token = row0 + tid, tl_ = (bt - btf) * 32 + tid; u32x4 pk; f32x4 ww;
#pragma unroll
            for (int k = 0; k < 4; ++k) { pk[k] = ((unsigned)e_k[k] << 17) | (unsigned)lp_k[k]; ww[k] = w_k[k]; }
            *(LAS u32x4*)(tokb + tl_ * 4) = pk; *(f32x4*)(TOKINFO + (size_t)token * 8 + 4) = ww; }
        lds_barrier();
        if (bt + 1 == bt1 || bt + 1 - btf == 32) {
            if (tid < 32) { const int hc = hist[tid]; base[tid] = hc > 0 ? (int)__hip_atomic_fetch_add(cnt + 64 * tid, (unsigned)hc, __ATOMIC_RELAXED, __HIP_MEMORY_SCOPE_AGENT) : 0; hist[tid] = 0; }
            lds_barrier();
            const int npend = (bt + 1 - btf) * 128;
            for (int i = tid; i < npend; i += 512) { const unsigned pk = tokb[i]; const int e = (int)(pk >> 17), pos = base[e] + (int)(pk & 0x1ffffu), token = btf * 32 + (i >> 2);
                ROWTOK[e * 65536 + pos] = token; TOKINFO[(size_t)token * 8 + (i & 3)] = ((unsigned)e << 17) | (unsigned)pos; }
            btf = bt + 1;
            lds_barrier();
        }
    }
#undef P7_PARAMS
#undef P7_LOAD
}

__device__ __forceinline__ int moe_tables(const Frame& F, unsigned* cnt) {
    LAS int* ts = (LAS int*)(F.lds + TS_OFF); LAS int* te = (LAS int*)(F.lds + TILE_E_OFF);
    __syncthreads();
    if (F.tid == 0) { int acc = 0; for (int e = 0; e < NE; ++e) { ts[e] = acc; const unsigned c = __hip_atomic_load(cnt + 64 * e, __ATOMIC_RELAXED, __HIP_MEMORY_SCOPE_AGENT); acc += (int)((c + 255u) >> 8); } ts[NE] = acc; }
    __syncthreads();
    const int RT = ts[NE];
    for (int rt = F.tid; rt < RT; rt += 512) { int e = 0;
#pragma unroll 1
        for (int q = 1; q < NE; ++q) e += (ts[q] <= rt) ? 1 : 0;
        te[rt] = e; }
    __syncthreads();
    return RT;
}

__device__ __forceinline__ void p10_combine(const Frame& F, const Args& a, int l, bf16_t* X16, float* out, const bf16_t* Y2, const unsigned* TOKINFO, const float* MODbase, signed char* H8, float* RS) {
    const int lane = F.lane; const LAS int* ts = (const LAS int*)(F.lds + TS_OFF);
    const float* g_postf = a.in[7] + l * DM;
    const int gw = F.vcu * 8 + F.wave, NGW = F.G * 8;
    const int r_lo = (int)((long)(MTOK / 2) * gw / NGW) * 2, r_hi = (int)((long)(MTOK / 2) * (gw + 1) / NGW) * 2;
    f32x4 A1[4], N2[4], N3[4]; int bcur = (r_lo < MTOK ? r_lo : MTOK - 1) >> 11;
#define P10_PARAMS(b_) do { const float* mb_ = MODbase + ((size_t)l * BATCH + (b_)) * 6 * DM; const float* mb1_ = MODbase + ((size_t)(l + 1 < DEPTH ? l + 1 : l) * BATCH + (b_)) * 6 * DM; const float* g1_ = a.in[4] + (l + 1 < DEPTH ? l + 1 : l) * DM; \
        _Pragma("unroll") for (int j = 0; j < 4; ++j) { const int c = 4 * lane + 256 * j; const f32x4 gp = *(const f32x4*)(g_postf + c), ga = *(const f32x4*)(mb_ + 5 * DM + c); A1[j] = ga * gp; \
            const f32x4 gg = *(const f32x4*)(g1_ + c), s1 = *(const f32x4*)(mb1_ + DM + c), s0 = *(const f32x4*)(mb1_ + c); N2[j] = gg * (s1 + 1.f); N3[j] = s0; } } while (0)
    P10_PARAMS(bcur);
    for (int rowp = r_lo; rowp < r_hi; rowp += 2) {
        if ((rowp >> 11) != bcur) { bcur = rowp >> 11; P10_PARAMS(bcur); }
        u32x4 info[2]; f32x4 ww[2]; u32x2 yw[2][4][4], xv[2][4];
#pragma unroll
        for (int rr = 0; rr < 2; ++rr) { info[rr] = *(const u32x4*)(TOKINFO + (size_t)(rowp + rr) * 8); ww[rr] = *(const f32x4*)(TOKINFO + (size_t)(rowp + rr) * 8 + 4); }
#pragma unroll
        for (int rr = 0; rr < 2; ++rr) {
#pragma unroll
            for (int k = 0; k < 4; ++k) { const int e = (int)(info[rr][k] >> 17), pos = (int)(info[rr][k] & 0x1ffffu); const size_t slot = (size_t)ts[e] * 256 + pos;
#pragma unroll
                for (int j = 0; j < 4; ++j) yw[rr][k][j] = __builtin_nontemporal_load((const u32x2*)(Y2 + slot * DM + 4 * lane + 256 * j)); }
#pragma unroll
            for (int j = 0; j < 4; ++j) xv[rr][j] = *(const u32x2*)(X16 + (size_t)(rowp + rr) * DM + 4 * lane + 256 * j); }
#pragma unroll
        for (int rr = 0; rr < 2; ++rr) { const int row = rowp + rr, b = row >> 11;
        f32x4 y[4];
#pragma unroll
        for (int j = 0; j < 4; ++j) y[j] = (f32x4){0.f, 0.f, 0.f, 0.f};
#pragma unroll
        for (int k = 0; k < 4; ++k) { const float wk = ww[rr][k];
#pragma unroll
            for (int j = 0; j < 4; ++j) { const u32x2 w = yw[rr][k][j];
                y[j][0] += wk * bf_lo(w.x); y[j][1] += wk * bf_hi(w.x); y[j][2] += wk * bf_lo(w.y); y[j][3] += wk * bf_hi(w.y); } }
        float ss = 0.f;
#pragma unroll
        for (int j = 0; j < 4; ++j) ss += (y[j][0] * y[j][0] + y[j][1] * y[j][1]) + (y[j][2] * y[j][2] + y[j][3] * y[j][3]);
        ss = wave_sum(ss);
        const float rstd = 1.f / sqrtf(ss * (1.f / DM) + RMS_EPS);
        f32x4 v[4]; float s2 = 0.f;
#pragma unroll
        for (int j = 0; j < 4; ++j) { const int c = 4 * lane + 256 * j; const u32x2 xw_ = xv[rr][j]; const f32x4 xx = {bf_lo(xw_.x), bf_hi(xw_.x), bf_lo(xw_.y), bf_hi(xw_.y)};
            v[j] = xx + A1[j] * (y[j] * rstd);
#ifdef T_STAMP
            if (l + 1 == DEPTH) v[j] = v[j] * (1.f + (float)(*((const unsigned*)MODbase - (1u << 18) + 100)) * (1.f / 256.f));
#endif
            if (l + 1 < DEPTH) { u32x2 xo; xo.x = cvt_pk_bf16(v[j][0], v[j][1]); xo.y = cvt_pk_bf16(v[j][2], v[j][3]); *(u32x2*)(X16 + (size_t)row * DM + c) = xo; }
            else *(f32x4*)(out + (size_t)row * DM + c) = v[j];
            s2 += (v[j][0] * v[j][0] + v[j][1] * v[j][1]) + (v[j][2] * v[j][2] + v[j][3] * v[j][3]); }
        if (l + 1 < DEPTH) { s2 = wave_sum(s2);
            const float rstd2 = 1.f / sqrtf(s2 * (1.f / DM) + RMS_EPS); f32x4 o[4]; float am = 0.f;
#pragma unroll
            for (int j = 0; j < 4; ++j) { o[j] = (v[j] * rstd2) * N2[j] + N3[j]; am = fmaxf(am, fmaxf(fmaxf(fabsf(o[j][0]), fabsf(o[j][1])), fmaxf(fabsf(o[j][2]), fabsf(o[j][3])))); }
            am = wave_max(am);
            const float scale = fmaxf(am, 1e-30f) * (1.f / 127.f), inv = 1.f / scale;
            if (lane == 0) RS[row] = scale;
#pragma unroll
            for (int j = 0; j < 4; ++j) *(unsigned*)(H8 + (size_t)row * DM + 4 * lane + 256 * j) = q8x4(o[j][0], o[j][1], o[j][2], o[j][3], inv); }
        }
    }
#undef P10_PARAMS
}
#ifndef MK_ONE_LAUNCH
#define MK_ONE_LAUNCH 1
#endif
constexpr int N_PHASES = 2 + 9 * DEPTH;
__global__ void __launch_bounds__(512, 2) fwd(Args args) {
    extern __shared__ __attribute__((aligned(16))) unsigned char lds_raw[];
    Frame F0;
    F0.lds = (LAS unsigned char*)lds_raw;
    F0.tid = threadIdx.x; F0.lane = F0.tid & 63; F0.wave = __builtin_amdgcn_readfirstlane(F0.tid >> 6);
    F0.G = gridDim.x; { const int bx = blockIdx.x; F0.vcu = (F0.G % 8 == 0) ? (bx % 8) * (F0.G / 8) + bx / 8 : bx; }
    volatile LAS unsigned* MISC = (volatile LAS unsigned*)(F0.lds + MISC_OFF);
    for (int u = F0.tid; u < 128; u += 512) MISC[u] = 0u;
    __syncthreads();
    unsigned* ctl = (unsigned*)(args.ws + WS_CTL);
    const int lo = args.ph_lo, hi = args.ph_hi;
    XcdBarrier bar; bar.bar = ctl + CW_BAR; bar.x = 0; bar.st = nullptr; bar.w = F0.wave;
    if (hi - lo > 1) bar = xcd_barrier_post(ctl + CW_BAR, MISC + 8, F0.wave);
#ifndef PHASE_MASK
#define PHASE_MASK 0x7ff
#endif
#define PHON(j) ((PHASE_MASK >> (j)) & 1)
#ifndef REPEAT_MASK
#define REPEAT_MASK 0
#endif
#define REP(j) for (int rep_ = 0; rep_ <= ((REPEAT_MASK >> (j)) & 1); ++rep_)
#define IN(k) (lo <= (k) && (k) < hi)
#define BOTH(k) (IN(k) && IN((k) + 1))
#define GRID_BAR() xcd_barrier(bar)
#define PH_BEGIN() const Frame F = phase_frame(F0); unsigned char* ws = opq(args.ws); (void)ws
    if (PHON(0) && IN(0)) REP(0) { PH_BEGIN(); p0_mod(F, args.in[1], args.in[2], args.in[3], (float*)(ws + WS_MOD)); p0_weights(F, args); if (BOTH(0)) GRID_BAR(); }
    if (PHON(1) && IN(1)) REP(1) { PH_BEGIN(); p1_norm(F, args.in[0], args.in[4], (const float*)(ws + WS_MOD), (signed char*)(ws + WS_H), (float*)(ws + WS_RS), (bf16_t*)(ws + WS_X)); if (BOTH(1)) GRID_BAR(); }

#pragma unroll 1
#ifndef EXTRA_PHASE
#define EXTRA_PHASE (-1)
#endif
#ifdef SKIP_EPI_PROBE
#define SKIPV ex_
#else
#define SKIPV false
#endif
#ifndef STAG_MASK
#define STAG_MASK 0
#endif
#ifndef STAG_MODE
#define STAG_MODE 0
#endif
#ifndef STAG_TICKS
#define STAG_TICKS 240
#endif
#define STAGGER(j) do { if ((STAG_MASK >> (j)) & 1) { const unsigned long long t0_ = __builtin_amdgcn_s_memrealtime(), dl_ = (unsigned long long)(STAG_MODE ? (F.vcu % (F.G / 8)) : (F.vcu / (F.G / 8))) * STAG_TICKS; while (__builtin_amdgcn_s_memrealtime() - t0_ < dl_) __builtin_amdgcn_s_sleep(8); } } while (0)
#ifndef EXTRA_MASK
#define EXTRA_MASK (EXTRA_PHASE >= 0 ? (1 << EXTRA_PHASE) : 0)
#endif
#define EXOK(j) (EXTRA_MASK == 0 || !ex_ || ((EXTRA_MASK >> (j)) & 1))
    for (int it_ = 0; it_ < DEPTH + (EXTRA_MASK != 0 ? 1 : 0); ++it_) {
        const int l = it_ < DEPTH ? it_ : DEPTH - 1; const bool ex_ = it_ >= DEPTH; (void)ex_;
        const int pb = 2 + 9 * l;
        if (PHON(2) && EXOK(2) && IN(pb + 0)) REP(2) { PH_BEGIN();
            pg8::Gemm g{(const bf16_t*)(ws + WS_H), (const bf16_t*)(ws + WS_W + (size_t)l * W_LAYER + WO_WIN), DM}; g.skip_epi = SKIPV; pg8::StaticOrder<MTOK / 256, NPROJ / 256> S; S.init(F.G, (int)blockIdx.x);
            EpiProj E{(bf16_t*)(ws + WS_PROJ), (unsigned char*)(ws + WS_GATES), (const float*)(ws + WS_RS), (const float*)(ws + WS_CSIN) + (size_t)l * NPROJ}; E.pv = ex_;
            STAGGER(2); pg8::gemm_phase<EpiProj, pg8::StaticOrder<MTOK / 256, NPROJ / 256>, false, true>(F.lds, g, S, E, F.wave);
            if (BOTH(pb + 0)) GRID_BAR();
        }
        if (PHON(3) && EXOK(3) && IN(pb + 1)) REP(3) {
#ifndef SUBREP
#define SUBREP 0
#endif
#ifndef IDX_PROBE
#define IDX_PROBE 0
#endif
            if (!((IDX_PROBE & 8) && ex_))
            { const Frame Fa = phase_frame(F0); const bf16_t* PROJa = (const bf16_t*)(opq(args.ws) + WS_PROJ); bf16_t* OAa = (bf16_t*)(opq(args.ws) + WS_O);
            SwaPre Pa;
#pragma unroll
            for (int i_ = 0; i_ < 3; ++i_) { Pa.kreg[i_] = (u32x4){0u, 0u, 0u, 0u}; Pa.vreg[i_] = (u32x4){0u, 0u, 0u, 0u}; }
            { int b_, g_, qb_; attn_decode(Fa.vcu < 2048 ? Fa.vcu : 2047, b_, g_, qb_); swa_prefetch(Fa, PROJa, b_, g_, qb_, Pa.qf, Pa.kreg, Pa.vreg); }
            for (int u = Fa.vcu; u < 2048; u += Fa.G) { int b_, g_, qb_; attn_decode(u, b_, g_, qb_);
                swa_unit(Fa, PROJa, OAa, args.in[9] + l * 8, b_, g_, qb_, Pa, u + Fa.G, ex_); } }
            if (!((IDX_PROBE & 16) && ex_))
            { const Frame Fb = phase_frame(F0); unsigned char* wsb = opq(args.ws);
            for (int u = Fb.vcu; u < 512; u += Fb.G)
                sg_unit(Fb, (const bf16_t*)(wsb + WS_PROJ), (const bf16_t*)(wsb + WS_SGW) + (size_t)l * 8 * 128 * 128, args.in[11] + l * 8 * 128, args.in[12] + l * 512, (bf16_t*)(wsb + WS_O) + (size_t)2 * MTOK * 512, u >> 4, u & 15); }
            __syncthreads();
            if (!((IDX_PROBE & 4) && ex_))
            { const Frame Fi = phase_frame(F0); unsigned char* wsi = opq(args.ws);
              dsa_index_phase(Fi, (const bf16_t*)(wsi + WS_PROJ), (unsigned long long*)(wsi + WS_BITS), l == 0 ? (unsigned*)(wsi + WS_CTL) + 100 : nullptr, ex_); }
            if (BOTH(pb + 1)) GRID_BAR();
        }
        if (PHON(4) && EXOK(4) && IN(pb + 2)) REP(4) { PH_BEGIN();
            AttnPre Pd; { int b_, g_, qb_; attn_decode(F.vcu < 2048 ? F.vcu : 2047, b_, g_, qb_); attn_prefetch<1>(F, (const bf16_t*)(ws + WS_PROJ), (const unsigned*)(ws + WS_BITS), b_, g_, qb_, Pd.qf, Pd.kreg, Pd.vreg, Pd.mreg); }
            for (int u = F.vcu; u < 2048; u += F.G) { int b_, g_, qb_; attn_decode(u, b_, g_, qb_);
                attn_unit<1>(F, (const bf16_t*)(ws + WS_PROJ), (bf16_t*)(ws + WS_O) + (size_t)MTOK * 512, (const unsigned*)(ws + WS_BITS), nullptr, b_, g_, qb_, Pd, u + F.G); }
            __syncthreads();
            if (BOTH(pb + 2)) GRID_BAR();
        }
        if (PHON(5) && EXOK(5) && IN(pb + 3)) REP(5) { PH_BEGIN();
            pg8::Gemm g{(const bf16_t*)(ws + WS_O), (const bf16_t*)(ws + WS_W + (size_t)l * W_LAYER + WO_WBR), 512}; g.skip_epi = SKIPV; BranchOrder S; S.so.init(F.G, (int)blockIdx.x);
            EpiBranch E{(const unsigned char*)(ws + WS_GATES), (bf16_t*)(ws + WS_H)};
            STAGGER(5); pg8::gemm_phase<EpiBranch, BranchOrder, false>(F.lds, g, S, E, F.wave);
            if (BOTH(pb + 3)) GRID_BAR();
        }
        if (PHON(6) && EXOK(6) && IN(pb + 4)) REP(6) { PH_BEGIN();
            pg8::Gemm g{(const bf16_t*)(ws + WS_H), (const bf16_t*)(ws + WS_W + (size_t)l * W_LAYER + WO_WOUT), DM}; g.skip_epi = SKIPV; pg8::StaticOrder<MTOK / 256, DM / 256> S; S.init(F.G, (int)blockIdx.x);
            EpiWout E{(bf16_t*)(ws + WS_Y), (float*)(ws + WS_SSP)}; E.pv = ex_;
            STAGGER(6); pg8::gemm_phase<EpiWout, pg8::StaticOrder<MTOK / 256, DM / 256>, false>(F.lds, g, S, E, F.wave);
            if (BOTH(pb + 4)) GRID_BAR();
        }
        if (PHON(7) && EXOK(7) && IN(pb + 5)) REP(7) { PH_BEGIN();
            p7_route(F, args, l, (bf16_t*)(ws + WS_X), (const bf16_t*)(ws + WS_Y), (const float*)(ws + WS_SSP), (const float*)(ws + WS_MOD) + (size_t)l * BATCH * 6 * DM, (signed char*)(ws + WS_H), (float*)(ws + WS_RS),
                     (const bf16_t*)(ws + WS_WRT) + (size_t)l * NE * DM, (unsigned*)(ws + WS_CTL) + CW_CNT + l * 32 * 64, (int*)(ws + WS_ROWTOK), (unsigned*)(ws + WS_TOKINFO));
            if (BOTH(pb + 5)) GRID_BAR();
        }
        if (PHON(8) && EXOK(8) && IN(pb + 6)) REP(8) { PH_BEGIN();
            unsigned* cnt = (unsigned*)(ws + WS_CTL) + CW_CNT + l * 32 * 64; const int* ROWTOK = (const int*)(ws + WS_ROWTOK);
            const int RT = moe_tables(F, cnt);
            LAS int* ts = (LAS int*)(F.lds + TS_OFF); LAS int* te = (LAS int*)(F.lds + TILE_E_OFF); LAS int* ri = (LAS int*)(F.lds + ROWIDX_OFF);
            const long U = (long)RT * 8; MoeOrder S; S.u0 = (int)(U * F.vcu / F.G); S.u1 = (int)(U * (F.vcu + 1) / F.G); S.NB = 8; S.rt_lo = S.u0 / 8; S.tile_e = te; S.rowidx = ri;
            if (S.u1 > S.u0) { const int rt_hi = (S.u1 - 1) / 8; int ntile = rt_hi - S.rt_lo + 1; if (ntile > 8) ntile = 8;
                for (int i = F.tid; i < ntile * 256; i += 512) { const int rt = S.rt_lo + (i >> 8), r = i & 255, e = te[rt], first = (rt - ts[e]) * 256 + r;
                    const int c = (int)__hip_atomic_load(cnt + 64 * e, __ATOMIC_RELAXED, __HIP_MEMORY_SCOPE_AGENT); ri[i] = first < c ? ROWTOK[e * 65536 + first] : 0; } }
            __syncthreads();
            pg8::Gemm g{(const bf16_t*)(ws + WS_H), (const bf16_t*)(ws + WS_W + (size_t)l * W_LAYER + WO_W1), DM}; g.skip_epi = SKIPV;
            EpiW1I8 E{(signed char*)(ws + WS_ACT), args.in[18] + (size_t)l * NE * 2 * FF, (const float*)(ws + WS_RS), (const float*)(ws + WS_CS1) + (size_t)l * NE * 2048, ri, S.rt_lo};
            STAGGER(8); pg8::gemm_phase<EpiW1I8, MoeOrder, true, true>(F.lds, g, S, E, F.wave);
            if (BOTH(pb + 6)) GRID_BAR();
        }
        if (PHON(9) && EXOK(9) && IN(pb + 7)) REP(9) { PH_BEGIN();
            const int RT = moe_tables(F, (unsigned*)(ws + WS_CTL) + CW_CNT + l * 32 * 64);
            const long U = (long)RT * 4; MoeOrder S; S.u0 = (int)(U * F.vcu / F.G); S.u1 = (int)(U * (F.vcu + 1) / F.G); S.NB = 4; S.rt_lo = 0; S.tile_e = (LAS int*)(F.lds + TILE_E_OFF); S.rowidx = nullptr;
            pg8::Gemm g{(const bf16_t*)(ws + WS_ACT), (const bf16_t*)(ws + WS_W + (size_t)l * W_LAYER + WO_W2), FF}; g.skip_epi = SKIPV;
            EpiW2 E{(bf16_t*)(ws + WS_Y2), args.in[20] + (size_t)l * NE * DM, (const float*)(ws + WS_CS2) + (size_t)l * NE * DM};
            STAGGER(9); pg8::gemm_phase<EpiW2, MoeOrder, false, true>(F.lds, g, S, E, F.wave);
            if (BOTH(pb + 7)) GRID_BAR();
        }
        if (PHON(10) && EXOK(10) && IN(pb + 8)) REP(10) { PH_BEGIN();
            (void)moe_tables(F, (unsigned*)(ws + WS_CTL) + CW_CNT + l * 32 * 64);
            p10_combine(F, args, l, (bf16_t*)(ws + WS_X), args.out, (const bf16_t*)(ws + WS_Y2), (const unsigned*)(ws + WS_TOKINFO), (const float*)(ws + WS_MOD), (signed char*)(ws + WS_H), (float*)(ws + WS_RS));
            if (BOTH(pb + 8)) GRID_BAR();
        }
    }
#undef PH_BEGIN
#undef IN
#undef BOTH
#undef GRID_BAR
}

extern "C" void kernel_launch(void* const* d_in, const int* in_sizes, int n_in, void* d_out, int out_size, void* d_ws, size_t ws_size, hipStream_t stream) {
    static int grid = 0;
    if (grid == 0) {
        if (n_in != 21 || out_size != MTOK * DM || ws_size < WS_END) { fprintf(stderr, "kernel_launch: unexpected shapes (n_in %d, out %d, ws %zu); nothing launched\n", n_in, out_size, ws_size); grid = -1; return; }
        int dev = 0, cus = 0, per_cu = 0;
        if (hipGetDevice(&dev) != hipSuccess || hipDeviceGetAttribute(&cus, hipDeviceAttributeMultiprocessorCount, dev) != hipSuccess) { grid = -1; return; }
        if (hipFuncSetAttribute((const void*)fwd, hipFuncAttributeMaxDynamicSharedMemorySize, LDS_BYTES) != hipSuccess) { fprintf(stderr, "kernel_launch: hipFuncSetAttribute failed\n"); grid = -1; return; }
        if (hipOccupancyMaxActiveBlocksPerMultiprocessor(&per_cu, (const void*)fwd, 512, LDS_BYTES) != hipSuccess || per_cu < 1) { fprintf(stderr, "kernel_launch: occupancy query says %d\n", per_cu); }
        (void)hipGetLastError();
        grid = cus > 256 ? 256 : cus;
    }
    if (grid < 0) return;
    (void)hipMemsetAsync((char*)d_ws + WS_CTL, 0, CTL_ZERO_BYTES, stream);
    Args a{};
    for (int i = 0; i < 21; ++i) a.in[i] = (const float*)d_in[i];
    a.out = (float*)d_out; a.ws = (unsigned char*)d_ws;
#if MK_ONE_LAUNCH
    a.ph_lo = 0; a.ph_hi = N_PHASES;
    hipLaunchKernelGGL(fwd, dim3(grid), dim3(512), LDS_BYTES, stream, a);
#else
    for (int p = 0; p < N_PHASES; ++p) { a.ph_lo = p; a.ph_hi = p + 1; hipLaunchKernelGGL(fwd, dim3(grid), dim3(512), LDS_BYTES, stream, a); }
#endif
}
```

```cpp
#include <hip/hip_runtime.h>
#include <cstdio>
#include <cstdint>
#include <type_traits>

#define LAS __attribute__((address_space(3)))
#define GAS __attribute__((address_space(1)))
typedef unsigned short bf16_t;
typedef short bf16x8 __attribute__((ext_vector_type(8)));
typedef float f32x2 __attribute__((ext_vector_type(2)));
typedef float f32x4 __attribute__((ext_vector_type(4)));
typedef float f32x16 __attribute__((ext_vector_type(16)));
typedef unsigned u32x2 __attribute__((ext_vector_type(2)));
typedef unsigned u32x4 __attribute__((ext_vector_type(4)));
typedef short v4i16_t __attribute__((ext_vector_type(4)));
typedef int i32x4 __attribute__((ext_vector_type(4)));

constexpr int BATCH = 32, SEQ = 2048, DM = 1024, MTOK = BATCH * SEQ, DEPTH = 2;
constexpr int NPROJ = 6144;
constexpr int PLD = 3072;
constexpr int C_QA = 0, C_KA = 512, C_VA = 640, C_QB = 768, C_KB = 1280, C_VB = 1408, C_QI = 1536, C_KI = 1792, C_WI = 1824, C_U = 2048, C_V = 2560, C_G = 3072;
constexpr int NE = 32, FF = 1024;
constexpr float RMS_EPS = 1e-5f, LN_EPS = 1e-5f;
constexpr float LOG2E = 1.4426950408889634f;
constexpr float QSCALE = 0.125f * LOG2E;

__device__ __forceinline__ unsigned f2bf(float f) { unsigned u = __builtin_bit_cast(unsigned, f); return (u + 0x7fffu + ((u >> 16) & 1u)) >> 16; }
__device__ __forceinline__ unsigned cvt_pk_bf16(float lo, float hi) { unsigned r; asm volatile("v_cvt_pk_bf16_f32 %0, %1, %2" : "=v"(r) : "v"(lo), "v"(hi)); return r; }
__device__ __forceinline__ float bf_lo(unsigned w) { return __builtin_bit_cast(float, w << 16); }
__device__ __forceinline__ float bf_hi(unsigned w) { return __builtin_bit_cast(float, w & 0xffff0000u); }
__device__ __forceinline__ float fexp2(float x) { return __builtin_amdgcn_exp2f(x); }
__device__ __forceinline__ float frcp(float x) { return __builtin_amdgcn_rcpf(x); }
__device__ __forceinline__ float sigmoidf_(float x) { return frcp(1.f + fexp2(-LOG2E * x)); }
__device__ __forceinline__ float gelu_tanh(float x) { const float t = x + 0.044715f * x * x * x; return x * frcp(1.f + fexp2(-2.302208198f * t)); }
template <int CTRL> __device__ __forceinline__ float dpp_f(float v) { return __builtin_bit_cast(float, __builtin_amdgcn_update_dpp(0, __builtin_bit_cast(int, v), CTRL, 0xF, 0xF, false)); }
__device__ __forceinline__ void swap32_asm(unsigned& a, unsigned& b) { asm volatile("s_nop 1\n\tv_permlane32_swap_b32 %0, %1" : "+v"(a), "+v"(b)); }
__device__ __forceinline__ float xor16_add(float v) { return v + __builtin_bit_cast(float, __builtin_amdgcn_ds_swizzle(__builtin_bit_cast(int, v), 0x401F)); }
__device__ __forceinline__ float xor16_max(float v) { return fmaxf(v, __builtin_bit_cast(float, __builtin_amdgcn_ds_swizzle(__builtin_bit_cast(int, v), 0x401F))); }
__device__ __forceinline__ float xor32_add(float v) { unsigned a = __builtin_bit_cast(unsigned, v), b = a; swap32_asm(a, b); return __builtin_bit_cast(float, a) + __builtin_bit_cast(float, b); }
__device__ __forceinline__ float xor32_max(float v) { unsigned a = __builtin_bit_cast(unsigned, v), b = a; swap32_asm(a, b); return fmaxf(__builtin_bit_cast(float, a), __builtin_bit_cast(float, b)); }
__device__ __forceinline__ float quad_sum(float v) { v += dpp_f<0xB1>(v); v += dpp_f<0x4E>(v); return v; }
__device__ __forceinline__ float wave_sum(float v) {
    v += dpp_f<0xB1>(v); v += dpp_f<0x4E>(v); v += dpp_f<0x141>(v); v += dpp_f<0x140>(v);
    return xor32_add(xor16_add(v));
}
__device__ __forceinline__ float wave_max(float v) {
    v = fmaxf(v, dpp_f<0xB1>(v)); v = fmaxf(v, dpp_f<0x4E>(v)); v = fmaxf(v, dpp_f<0x141>(v)); v = fmaxf(v, dpp_f<0x140>(v));
    return xor32_max(xor16_max(v));
}
__device__ __forceinline__ unsigned wave_sum_u32(unsigned v) {
    v += (unsigned)__builtin_amdgcn_update_dpp(0, (int)v, 0xB1, 0xF, 0xF, false);
    v += (unsigned)__builtin_amdgcn_update_dpp(0, (int)v, 0x4E, 0xF, 0xF, false);
    v += (unsigned)__builtin_amdgcn_update_dpp(0, (int)v, 0x141, 0xF, 0xF, false);
    v += (unsigned)__builtin_amdgcn_update_dpp(0, (int)v, 0x140, 0xF, 0xF, false);
    return __builtin_amdgcn_readlane(v, 0) + __builtin_amdgcn_readlane(v, 16) + __builtin_amdgcn_readlane(v, 32) + __builtin_amdgcn_readlane(v, 48);
}
__device__ __forceinline__ unsigned wave_max_u32(unsigned v) {
    unsigned t;
    t = (unsigned)__builtin_amdgcn_update_dpp(0, (int)v, 0xB1, 0xF, 0xF, false); v = v > t ? v : t;
    t = (unsigned)__builtin_amdgcn_update_dpp(0, (int)v, 0x4E, 0xF, 0xF, false); v = v > t ? v : t;
    t = (unsigned)__builtin_amdgcn_update_dpp(0, (int)v, 0x141, 0xF, 0xF, false); v = v > t ? v : t;
    t = (unsigned)__builtin_amdgcn_update_dpp(0, (int)v, 0x140, 0xF, 0xF, false); v = v > t ? v : t;
    unsigned a = __builtin_amdgcn_readlane(v, 0), b = __builtin_amdgcn_readlane(v, 16), c = __builtin_amdgcn_readlane(v, 32), d = __builtin_amdgcn_readlane(v, 48);
    a = a > b ? a : b; c = c > d ? c : d; return a > c ? a : c;
}
__device__ __forceinline__ void lds_barrier() { asm volatile("s_waitcnt lgkmcnt(0)\n\ts_barrier" ::: "memory"); }
__device__ __forceinline__ unsigned q8x4(float a, float b, float c, float d, float inv) {
    unsigned r = 0u;
#if 1
    r = __builtin_amdgcn_cvt_pk_u8_f32(fmaf(a, inv, 128.f), 0u, r);
    r = __builtin_amdgcn_cvt_pk_u8_f32(fmaf(b, inv, 128.f), 1u, r);
    r = __builtin_amdgcn_cvt_pk_u8_f32(fmaf(c, inv, 128.f), 2u, r);
    r = __builtin_amdgcn_cvt_pk_u8_f32(fmaf(d, inv, 128.f), 3u, r);
#else
    r = __builtin_amdgcn_cvt_pk_u8_f32(__builtin_rintf(fmaf(a, inv, 128.f)), 0u, r);
    r = __builtin_amdgcn_cvt_pk_u8_f32(__builtin_rintf(fmaf(b, inv, 128.f)), 1u, r);
    r = __builtin_amdgcn_cvt_pk_u8_f32(__builtin_rintf(fmaf(c, inv, 128.f)), 2u, r);
    r = __builtin_amdgcn_cvt_pk_u8_f32(__builtin_rintf(fmaf(d, inv, 128.f)), 3u, r);
#endif
    return r ^ 0x80808080u;
}
__device__ __forceinline__ unsigned u8x4_floor(float a, float b, float c, float d) {
    unsigned r = 0u;
#if 1
    r = __builtin_amdgcn_cvt_pk_u8_f32(a - 0.5f, 0u, r); r = __builtin_amdgcn_cvt_pk_u8_f32(b - 0.5f, 1u, r);
    r = __builtin_amdgcn_cvt_pk_u8_f32(c - 0.5f, 2u, r); r = __builtin_amdgcn_cvt_pk_u8_f32(d - 0.5f, 3u, r);
#else
    r = __builtin_amdgcn_cvt_pk_u8_f32(__builtin_floorf(a), 0u, r); r = __builtin_amdgcn_cvt_pk_u8_f32(__builtin_floorf(b), 1u, r);
    r = __builtin_amdgcn_cvt_pk_u8_f32(__builtin_floorf(c), 2u, r); r = __builtin_amdgcn_cvt_pk_u8_f32(__builtin_floorf(d), 3u, r);
#endif
    return r;
}
__device__ __forceinline__ int lane_id_volatile(int tag = 0) { int l; asm volatile("v_mbcnt_lo_u32_b32 %0, -1, 0 ; LANETAG %1\n\tv_mbcnt_hi_u32_b32 %0, -1, %0" : "=v"(l) : "s"(tag)); return l; }
#define LDS_WAIT() asm volatile("s_waitcnt lgkmcnt(0)" ::: "memory")
#define VM_WAIT() asm volatile("s_waitcnt vmcnt(0)" ::: "memory")

namespace pg8 {
constexpr int BM = 256, BK = 64, HALF = 128, HTB = HALF * BK * 2  , STAGE_BYTES = 8 * HTB, NXCD = 8, WGM = 8;
__host__ __device__ __forceinline__ int lds_byte(int r, int c) { const int st = (r >> 4) * 2 + (c >> 5), rr = r & 15, cc = c & 31, ob = rr * 64 + cc * 2; return st * 1024 + (ob ^ (((ob >> 9) & 1) << 5)); }
__host__ __device__ __forceinline__ void stage_rc(int b, int& R, int& C) { const int st = b / 1024, sb = b % 1024, swz = sb ^ (((sb >> 9) & 1) << 5); R = (st >> 1) * 16 + swz / 64; C = (st & 1) * 32 + (swz % 64) / 2; }
__host__ __device__ __forceinline__ int perm32(int rho) { const int n = rho >> 4, i = rho & 15; return 8 * (i >> 2) + 4 * n + (i & 3); }

struct Unit { int pm, pn; };
struct Gemm { const bf16_t* A; const bf16_t* Bt; int K; bool skip_epi = false; };

template <int NM, int NN> struct StaticOrder {
    int G, c;
    __device__ void init(int G_, int c_) { G = G_; c = c_; }
    __device__ __forceinline__ bool tile(int i, int& pm, int& pn) const {
        constexpr int nwg = NM * NN;
        const long L = (long)i * G + c; if (L >= nwg) return false;
        int wgid = (int)L; { constexpr int q = nwg / NXCD, r = nwg % NXCD; const int xcd = wgid % NXCD, off = wgid / NXCD; wgid = (xcd < r ? xcd * (q + 1) : r * (q + 1) + (xcd - r) * q) + off; }
        constexpr int nig = WGM * NN; static_assert(NM % WGM == 0, "row tiles in whole groups");
        const int gid = wgid / nig, fm = gid * WGM, rem = wgid % nig;
        pm = fm + (rem % WGM); pn = rem / WGM; return true;
    }
    __device__ __forceinline__ bool next(int i, Unit& u) const { return tile(i, u.pm, u.pn); }
};

template <class Epi, class Sched, bool GATHER, bool I8 = false>
__device__ __forceinline__ void gemm_phase(LAS unsigned char* lds, const Gemm g, const Sched& S, const Epi& E, int wv  ) {
    int tid = wv * 64 + lane_id_volatile(1); asm volatile("" : "+v"(tid));
    const int wid = __builtin_amdgcn_readfirstlane(tid >> 6), lane = tid & 63, wr = wid >> 2, wc = wid & 3, fr = lane & 15, fq = lane >> 4;
    const int K = g.K, RB = I8 ? K : 2 * K  , nt = RB / (BK * 2);
    unsigned voffA[2], voffB[2]; int RA[2], CA[2];
#pragma unroll
    for (int i = 0; i < 2; ++i) { int R, C; stage_rc(tid * 16 + i * 8192, R, C); const int Rb = (R & ~31) + perm32(R & 31); RA[i] = R; CA[i] = C;
        voffA[i] = (unsigned)(R * RB + C * 2); voffB[i] = (unsigned)(Rb * RB + C * 2); }
    const size_t kstep = (size_t)(BK * 2);
    const size_t hstep = (size_t)HALF * RB;
    const size_t tstep = 2 * hstep;
    const unsigned ldsw = (unsigned)wid * 1024u;
    const int aoff = lds_byte(wr * 64 + fr, fq * 8), boff = lds_byte(wc * 32 + fr, fq * 8);
#define PG8_SA(b, h) (((b) * 2 + (h)) * HTB)
#define PG8_SB(b, h) ((4 + (b) * 2 + (h)) * HTB)
#define PG8_STAGE(bufoff, gbase, voff) do { _Pragma("unroll") for (int _i = 0; _i < 2; ++_i) \
        __builtin_amdgcn_global_load_lds((const unsigned*)((const char*)(gbase) + (voff)[_i]), (LAS unsigned*)(lds + (bufoff) + ldsw + _i * 8192), 16, 0, 0); } while (0)
#define PG8_STAGE_A(bufoff, h, ubase, koff, VO) do { if constexpr (GATHER) { PG8_STAGE(bufoff, (const char*)g.A + (koff), VO[h]); } else { PG8_STAGE(bufoff, (ubase) + (h) * hstep + (koff), voffA); } } while (0)
#define PG8_LDA(dst, b, h) do { _Pragma("unroll") for (int m = 0; m < 4; ++m) _Pragma("unroll") for (int k = 0; k < 2; ++k) dst[m][k] = *(const LAS bf16x8*)(lds + PG8_SA(b, h) + aoff + m * 2048 + k * 1024); } while (0)
#define PG8_LDB(dst, b, h) do { _Pragma("unroll") for (int n = 0; n < 2; ++n) _Pragma("unroll") for (int k = 0; k < 2; ++k) dst[n][k] = *(const LAS bf16x8*)(lds + PG8_SB(b, h) + boff + n * 2048 + k * 1024); } while (0)
#define PG8_MMA(ai, bj, At, Bt) do { __builtin_amdgcn_s_setprio(1); _Pragma("unroll") for (int m = 0; m < 4; ++m) _Pragma("unroll") for (int n = 0; n < 2; ++n) _Pragma("unroll") for (int k = 0; k < 2; ++k) \
        { if constexpr (I8) acc[ai][bj][m][n] = __builtin_amdgcn_mfma_i32_16x16x64_i8(__builtin_bit_cast(i32x4, Bt[n][k]), __builtin_bit_cast(i32x4, At[m][k]), acc[ai][bj][m][n], 0, 0, 0); \
          else acc[ai][bj][m][n] = __builtin_amdgcn_mfma_f32_16x16x32_bf16(Bt[n][k], At[m][k], acc[ai][bj][m][n], 0, 0, 0); } __builtin_amdgcn_s_setprio(0); } while (0)
#define PG8_WAIT_V(n) asm volatile("s_waitcnt vmcnt(" #n ")" ::: "memory")
#define PG8_WAIT_L(n) asm volatile("s_waitcnt lgkmcnt(" #n ")" ::: "memory")
#define PG8_BAR __builtin_amdgcn_s_barrier()
#define PG8_SCHED __builtin_amdgcn_sched_barrier(0)
    Unit cur, nxt; int ui = 0;
    if (!S.next(0, cur)) return;
    typedef typename std::conditional<I8, i32x4, f32x4>::type accv_t;
    accv_t acc[2][2][4][2];
#pragma unroll
    for (int a = 0; a < 2; ++a)
#pragma unroll
        for (int b = 0; b < 2; ++b)
#pragma unroll
            for (int m = 0; m < 4; ++m)
#pragma unroll
                for (int n = 0; n < 2; ++n) acc[a][b][m][n] = (accv_t){0, 0, 0, 0};
    bf16x8 At[4][2], B0[2][2], B1[2][2];
    unsigned oc[2][2], on[2][2];
    if constexpr (GATHER) {
#pragma unroll
        for (int h = 0; h < 2; ++h)
#pragma unroll
            for (int i = 0; i < 2; ++i) { oc[h][i] = (unsigned)(S.src_row(cur, h * HALF + RA[i]) * RB + CA[i] * 2); on[h][i] = oc[h][i]; }

    }
    const char* cA = GATHER ? (const char*)g.A : (const char*)g.A + (size_t)cur.pm * tstep; const char* cB = (const char*)g.Bt + (size_t)cur.pn * tstep;
    PG8_STAGE(PG8_SB(0, 0), cB, voffB); PG8_STAGE(PG8_SB(0, 1), cB + hstep, voffB); PG8_STAGE_A(PG8_SA(0, 0), 0, cA, 0, oc); PG8_STAGE_A(PG8_SA(0, 1), 1, cA, 0, oc);
    if (wr == 1) PG8_BAR;
    PG8_WAIT_V(2); PG8_BAR;
    PG8_STAGE(PG8_SB(1, 0), cB + kstep, voffB); PG8_STAGE_A(PG8_SA(1, 0), 0, cA, kstep, oc); PG8_STAGE(PG8_SB(1, 1), cB + hstep + kstep, voffB);
    PG8_WAIT_V(6); PG8_BAR;
    for (;;) {
        const bool has_next = S.next(ui + 1, nxt);
        const char* nA = GATHER ? (const char*)g.A : (has_next ? (const char*)g.A + (size_t)nxt.pm * tstep : cA); const char* nB = has_next ? (const char*)g.Bt + (size_t)nxt.pn * tstep : cB;
        if constexpr (GATHER) {
            if (has_next) {
                const int t2 = wv * 64 + lane_id_volatile(3); int R2[2], C2[2];
#pragma unroll
                for (int i = 0; i < 2; ++i) stage_rc(t2 * 16 + i * 8192, R2[i], C2[i]);
#pragma unroll
                for (int h = 0; h < 2; ++h)
#pragma unroll
                    for (int i = 0; i < 2; ++i) on[h][i] = (unsigned)(S.src_row(nxt, h * HALF + R2[i]) * RB + C2[i] * 2);
            }
        }
        for (int t = 0; t < nt; t += 2) {
            const bool last = (t == nt - 2);
            const size_t k1 = (size_t)(t + 1) * kstep;
            const size_t k2 = last ? (size_t)0 : (size_t)(t + 2) * kstep, k3 = k2 + kstep;
            const char* a2 = last ? nA : cA; const char* b2 = last ? nB : cB;
            unsigned o2[2][2];
            if constexpr (GATHER) {
#pragma unroll
                for (int h = 0; h < 2; ++h)
#pragma unroll
                    for (int i = 0; i < 2; ++i) o2[h][i] = last ? on[h][i] : oc[h][i];
            }
            PG8_LDB(B0, 0, 0); PG8_LDB(B1, 0, 1); PG8_SCHED; PG8_LDA(At, 0, 0); PG8_STAGE_A(PG8_SA(1, 1), 1, cA, k1, oc);
            PG8_WAIT_V(8); PG8_WAIT_L(0); PG8_BAR; PG8_MMA(0, 0, At, B0); PG8_MMA(0, 1, At, B1); PG8_BAR; PG8_SCHED;
            PG8_LDA(At, 0, 1); PG8_STAGE(PG8_SB(0, 0), b2 + k2, voffB); PG8_STAGE(PG8_SB(0, 1), b2 + hstep + k2, voffB); PG8_STAGE_A(PG8_SA(0, 0), 0, a2, k2, o2);
            PG8_WAIT_V(8); PG8_WAIT_L(0); PG8_BAR; PG8_MMA(1, 0, At, B0); PG8_MMA(1, 1, At, B1); PG8_BAR; PG8_SCHED;
            PG8_LDB(B0, 1, 0); PG8_LDB(B1, 1, 1); PG8_SCHED; PG8_LDA(At, 1, 0); PG8_STAGE_A(PG8_SA(0, 1), 1, a2, k2, o2);
            PG8_WAIT_V(8); PG8_WAIT_L(0); PG8_BAR; PG8_MMA(0, 0, At, B0); PG8_MMA(0, 1, At, B1); PG8_BAR; PG8_SCHED;
            PG8_LDA(At, 1, 1); PG8_STAGE(PG8_SB(1, 0), b2 + k3, voffB); PG8_STAGE(PG8_SB(1, 1), b2 + hstep + k3, voffB); PG8_STAGE_A(PG8_SA(1, 0), 0, a2, k3, o2);
            PG8_WAIT_V(8); PG8_WAIT_L(0); PG8_BAR; PG8_MMA(1, 0, At, B0); PG8_MMA(1, 1, At, B1); PG8_BAR; PG8_SCHED;
        }
#ifndef NO_ALIGN_EPI
        if (wr == 0) PG8_BAR;
#else
        asm volatile("" ::: "memory"); PG8_SCHED;
#endif
#ifdef SKIP_EPI_PROBE
        const int le_ = lane_id_volatile(4);
        bool rst = true; if (!g.skip_epi) rst = E(acc, cur, wr, wc, le_ & 15, le_ >> 4);
#else
        const int le_ = lane_id_volatile(4);
        const bool rst = E(acc, cur, wr, wc, le_ & 15, le_ >> 4);
#endif
        if (!has_next) break;
        if (rst) {
#pragma unroll
        for (int a = 0; a < 2; ++a)
#pragma unroll
            for (int b = 0; b < 2; ++b)
#pragma unroll
                for (int m = 0; m < 4; ++m)
#pragma unroll
                    for (int n = 0; n < 2; ++n) acc[a][b][m][n] = (accv_t){0, 0, 0, 0};
        }
        cur = nxt; cA = nA; cB = nB; ++ui;
        if constexpr (GATHER) {
#pragma unroll
            for (int h = 0; h < 2; ++h)
#pragma unroll
                for (int i = 0; i < 2; ++i) oc[h][i] = on[h][i];
        }
#ifndef NO_ALIGN_EPI
        if (wr == 1) PG8_BAR;
#else
        asm volatile("" ::: "memory"); PG8_SCHED;
#endif
    }
    PG8_WAIT_V(0);
    PG8_BAR;
#undef PG8_SA
#undef PG8_SB
#undef PG8_STAGE
#undef PG8_STAGE_A
#undef PG8_LDA
#undef PG8_LDB
#undef PG8_MMA
#undef PG8_WAIT_V
#undef PG8_WAIT_L
#undef PG8_BAR
#undef PG8_SCHED
}
}
typedef f32x4 acc_t[2][2][4][2];
typedef i32x4 acci_t[2][2][4][2];

struct EpiProj {
    bf16_t* O; unsigned char* G8; const float* RS  ; const float* CS  ; bool pv = false;
    __device__ __forceinline__ bool operator()(acci_t& acc, const pg8::Unit& u, int wr, int wc, int fr, int fq) const {
#if defined(PROJ_VARIANT) && PROJ_VARIANT == 4
        if (pv) {
#pragma unroll
            for (int ai = 0; ai < 2; ++ai)
#pragma unroll
                for (int bj = 0; bj < 2; ++bj)
#pragma unroll
                    for (int m = 0; m < 4; ++m)
#pragma unroll
                        for (int n = 0; n < 2; ++n) asm volatile("" :: "v"(acc[ai][bj][m][n]));
            return true; }
#endif
        const int pn = u.pn;
        const int act = (pn <= 1 || pn == 3 || pn == 4) ? 1 : (pn >= 12 ? 3 : (pn >= 8 ? 2 : 0));
        const int row0 = u.pm * 256 + wr * 64 + fr, col0 = pn * 256 + wc * 32 + 8 * fq;
        float rsv[8];
#pragma unroll
        for (int q = 0; q < 8; ++q) rsv[q] = 1.f;
#if defined(PROJ_VARIANT) && PROJ_VARIANT == 3
        if (!pv)
#endif
        {
#pragma unroll
        for (int q = 0; q < 8; ++q) rsv[q] = RS[row0 + (q >> 2) * 128 + (q & 3) * 16];
        }
        f32x2 cs2[2][4];
#pragma unroll
        for (int bj = 0; bj < 2; ++bj) { f32x4 c0 = (f32x4){1.f, 1.f, 1.f, 1.f}, c1 = c0; const float k = (act == 1 ? QSCALE : 1.f);
#if defined(PROJ_VARIANT) && PROJ_VARIANT == 3
            if (!pv)
#endif
            { c0 = *(const f32x4*)(CS + col0 + bj * 128); c1 = *(const f32x4*)(CS + col0 + bj * 128 + 4); }
            cs2[bj][0] = (f32x2){c0[0], c0[1]} * k; cs2[bj][1] = (f32x2){c0[2], c0[3]} * k; cs2[bj][2] = (f32x2){c1[0], c1[1]} * k; cs2[bj][3] = (f32x2){c1[2], c1[3]} * k; }
#pragma unroll
        for (int ai = 0; ai < 2; ++ai)
#pragma unroll
            for (int m = 0; m < 4; ++m) { const int row = row0 + ai * 128 + m * 16; bf16_t* rowp = O + (size_t)row * PLD + col0; const float rs = rsv[ai * 4 + m]; u32x2 w8s[2] = {{0u, 0u}, {0u, 0u}};
#pragma unroll
                for (int bj = 0; bj < 2; ++bj) { f32x2 v[4];
#pragma unroll
                    for (int p = 0; p < 4; ++p) { const int i0 = 2 * p; v[p] = (f32x2){(float)acc[ai][bj][m][i0 >> 2][i0 & 3], (float)acc[ai][bj][m][(i0 + 1) >> 2][(i0 + 1) & 3]} * (cs2[bj][p] * rs); }
                    if (act == 2) {
#pragma unroll
                        for (int p = 0; p < 4; ++p) { const f32x2 x = v[p], t = (x * x * 0.044715f + 1.f) * x * (-2.302208198f); f32x2 d = {fexp2(t[0]), fexp2(t[1])}; d = d + 1.f; v[p] = x * (f32x2){frcp(d[0]), frcp(d[1])}; } }
                    else if (act == 3) {
                        f32x2 gq[4];
#pragma unroll
                        for (int p = 0; p < 4; ++p) { const f32x2 t = v[p] * (-LOG2E); f32x2 d = {fexp2(t[0]), fexp2(t[1])}; d = d + 1.f; gq[p] = (f32x2){frcp(d[0]), frcp(d[1])} * 256.f; }
                        u32x2 w8; w8.x = u8x4_floor(gq[0][0], gq[0][1], gq[1][0], gq[1][1]); w8.y = u8x4_floor(gq[2][0], gq[2][1], gq[3][0], gq[3][1]);
                        w8s[bj] = w8;
                        if (bj == 1) *(u32x4*)(G8 + (size_t)row * 3072 + (pn - 12) * 256 + wc * 64 + fq * 16) = (u32x4){w8s[0].x, w8s[0].y, w8s[1].x, w8s[1].y};
                        continue; }
                    u32x4 w; w.x = cvt_pk_bf16(v[0][0], v[0][1]); w.y = cvt_pk_bf16(v[1][0], v[1][1]); w.z = cvt_pk_bf16(v[2][0], v[2][1]); w.w = cvt_pk_bf16(v[3][0], v[3][1]);
#if defined(PROJ_VARIANT) && PROJ_VARIANT == 1
                    if (pv) { asm volatile("" :: "v"(w.x), "v"(w.y), "v"(w.z), "v"(w.w)); continue; }
#endif
                    *(u32x4*)(rowp + bj * 128) = w; } }
        return true;
    }
};

struct BranchOrder {
    pg8::StaticOrder<MTOK / 256, DM / 256> so;
    __device__ __forceinline__ bool next(int j, pg8::Unit& u) const { const int i = j / 3, br = j - 3 * i; int pm, pn; if (!so.tile(i, pm, pn)) return false; u.pm = br * 256 + pm; u.pn = br * 4 + pn; return true; }
};
struct EpiBranch {
    const unsigned char* G8  ; bf16_t* MERGED;
    __device__ __forceinline__ bool operator()(acc_t& acc, const pg8::Unit& u, int wr, int wc, int fr, int fq) const {
        const int br = u.pn >> 2, pn = u.pn & 3, pm = u.pm & 255;
        const int row0 = pm * 256 + wr * 64 + fr, col0 = pn * 256 + wc * 32 + 8 * fq;
#pragma unroll
        for (int rnd = 0; rnd < 2; ++rnd) { const int ai = rnd, m0 = 0;
            u32x2 gw[4][2], gd[4][2];
#pragma unroll
            for (int m = m0; m < m0 + 4; ++m) { const unsigned char* gp = G8 + (size_t)(row0 + ai * 128 + m * 16) * 3072 + br * 1024 + pn * 256 + wc * 64 + fq * 16;
                const u32x4 a = *(const u32x4*)gp; gw[m][0] = (u32x2){a.x, a.y}; gw[m][1] = (u32x2){a.z, a.w};
                if (br != 2) { const u32x4 d = *(const u32x4*)(gp + 1024); gd[m][0] = (u32x2){d.x, d.y}; gd[m][1] = (u32x2){d.z, d.w}; } }
#pragma unroll
            for (int m = m0; m < m0 + 4; ++m) { const size_t row = (size_t)(row0 + ai * 128 + m * 16);
#pragma unroll
                for (int bj = 0; bj < 2; ++bj) {
                    const u32x2 g = gw[m][bj];
                    float gn[8];
#pragma unroll
                    for (int i = 0; i < 8; ++i) gn[i] = (float)((g[i >> 2] >> (8 * (i & 3))) & 0xffu) + 0.5f;
                    if (br != 2) { const u32x2 d = gd[m][bj];
#pragma unroll
                        for (int i = 0; i < 8; ++i) gn[i] = gn[i] * frcp((float)((d[i >> 2] >> (8 * (i & 3))) & 0xffu) + 0.5f); }
                    else {
#pragma unroll
                        for (int i = 0; i < 8; ++i) gn[i] *= (1.f / 256.f); }
                    f32x4 v0 = acc[ai][bj][m][0], v1 = acc[ai][bj][m][1];
                    v0[0] *= gn[0]; v0[1] *= gn[1]; v0[2] *= gn[2]; v0[3] *= gn[3]; v1[0] *= gn[4]; v1[1] *= gn[5]; v1[2] *= gn[6]; v1[3] *= gn[7];
                    if (br != 2) { acc[ai][bj][m][0] = v0; acc[ai][bj][m][1] = v1; }
                    else { u32x4 w; w.x = cvt_pk_bf16(v0[0], v0[1]); w.y = cvt_pk_bf16(v0[2], v0[3]); w.z = cvt_pk_bf16(v1[0], v1[1]); w.w = cvt_pk_bf16(v1[2], v1[3]);
                        *(u32x4*)(MERGED + row * DM + col0 + bj * 128) = w; } } }
            asm volatile("" ::: "memory");
        }
        return br == 2;
    }
};

#ifndef WOUT_VARIANT
#define WOUT_VARIANT 0
#endif
struct EpiWout {
    bf16_t* Y; float* SSP; bool pv = false;
    __device__ __forceinline__ bool operator()(acc_t& acc, const pg8::Unit& u, int wr, int wc, int fr, int fq) const {
        const int row0 = u.pm * 256 + wr * 64 + fr, col0 = u.pn * 256 + wc * 32 + 8 * fq;
#pragma unroll
        for (int ai = 0; ai < 2; ++ai)
#pragma unroll
            for (int m = 0; m < 4; ++m) { const size_t row = (size_t)(row0 + ai * 128 + m * 16); float ss = 0.f;
#pragma unroll
                for (int bj = 0; bj < 2; ++bj) { const f32x4 v0 = acc[ai][bj][m][0], v1 = acc[ai][bj][m][1];
                    ss += (v0[0] * v0[0] + v0[1] * v0[1]) + (v0[2] * v0[2] + v0[3] * v0[3]) + (v1[0] * v1[0] + v1[1] * v1[1]) + (v1[2] * v1[2] + v1[3] * v1[3]);
                    u32x4 w; w.x = cvt_pk_bf16(v0[0], v0[1]); w.y = cvt_pk_bf16(v0[2], v0[3]); w.z = cvt_pk_bf16(v1[0], v1[1]); w.w = cvt_pk_bf16(v1[2], v1[3]);
                    if (!(WOUT_VARIANT == 2 && pv)) *(u32x4*)(Y + row * DM + col0 + bj * 128) = w; }
                if (!(WOUT_VARIANT == 3 && pv)) ss = xor32_add(xor16_add(ss));
                if (fq == 0 && !((WOUT_VARIANT == 1 || WOUT_VARIANT == 3) && pv)) SSP[(size_t)(u.pn * 4 + wc) * MTOK + row] = ss; }
        return true;
    }
};

struct MoeOrder {
    int u0, u1, NB, rt_lo;
    const LAS int* tile_e;
    const LAS int* rowidx;
    __device__ __forceinline__ bool next(int i, pg8::Unit& u) const { const int x = u0 + i; if (x >= u1) return false; const int rt = x / NB, pn = x - rt * NB; u.pm = rt; u.pn = tile_e[rt] * NB + pn; return true; }
    __device__ __forceinline__ int src_row(const pg8::Unit& u, int r) const { return rowidx[(u.pm - rt_lo) * 256 + r]; }
};
struct EpiW1 {
    bf16_t* ACT; const float* b1  ;
    __device__ __forceinline__ bool operator()(acc_t& acc, const pg8::Unit& u, int wr, int wc, int fr, int fq) const {
        const int e = u.pn >> 3, pn = u.pn & 7;
        const int row0 = u.pm * 256 + wr * 64 + fr, j0 = pn * 128 + wc * 32 + 8 * fq;
        const float* bp = b1 + (size_t)e * (2 * FF) + 2 * j0;
        float bg[8], bl[8];
#pragma unroll
        for (int q = 0; q < 4; ++q) { const f32x4 t = *(const f32x4*)(bp + 4 * q); bg[2 * q] = t[0]; bl[2 * q] = t[1]; bg[2 * q + 1] = t[2]; bl[2 * q + 1] = t[3]; }
#pragma unroll
        for (int ai = 0; ai < 2; ++ai)
#pragma unroll
            for (int m = 0; m < 4; ++m) { float a[8];
#pragma unroll
                for (int i = 0; i < 8; ++i) { float gl = acc[ai][0][m][i >> 2][i & 3] + bg[i], li = acc[ai][1][m][i >> 2][i & 3] + bl[i];
                    gl = fminf(gl, 7.f); li = fminf(fmaxf(li, -7.f), 7.f);
                    a[i] = gl * frcp(1.f + fexp2(-1.702f * LOG2E * gl)) * (li + 1.f); }
                u32x4 w; w.x = cvt_pk_bf16(a[0], a[1]); w.y = cvt_pk_bf16(a[2], a[3]); w.z = cvt_pk_bf16(a[4], a[5]); w.w = cvt_pk_bf16(a[6], a[7]);
                *(u32x4*)(ACT + (size_t)(row0 + ai * 128 + m * 16) * FF + j0) = w; }
        return true;
    }
};
constexpr float ACT_SCALE = 12.f / 127.f;
struct EpiW1I8 {
    signed char* ACT  ; const float* b1  ; const float* RS  ; const float* CS  ;
    const LAS int* rowidx; int rt_lo;
    __device__ __forceinline__ bool operator()(acci_t& acc, const pg8::Unit& u, int wr, int wc, int fr, int fq) const {
        const int e = u.pn >> 3, pn = u.pn & 7;
        const int rl0 = wr * 64 + fr, row0 = u.pm * 256 + rl0, j0 = pn * 128 + wc * 32 + 8 * fq;
        const float* bp = b1 + (size_t)e * (2 * FF) + 2 * j0;
        float bg[8], bl[8], cg[8], cl[8];
#pragma unroll
        for (int q = 0; q < 4; ++q) { const f32x4 t = *(const f32x4*)(bp + 4 * q); bg[2 * q] = t[0]; bl[2 * q] = t[1]; bg[2 * q + 1] = t[2]; bl[2 * q + 1] = t[3]; }
        { const float* cp = CS + (size_t)e * 2048 + pn * 256 + wc * 32 + 8 * fq;
          const f32x4 a0 = *(const f32x4*)cp, a1 = *(const f32x4*)(cp + 4), c0 = *(const f32x4*)(cp + 128), c1 = *(const f32x4*)(cp + 132);
#pragma unroll
          for (int i = 0; i < 4; ++i) { cg[i] = a0[i]; cg[4 + i] = a1[i]; cl[i] = c0[i]; cl[4 + i] = c1[i]; } }
        const LAS int* ri = rowidx + (u.pm - rt_lo) * 256 + rl0;
        float rsv[8];
#pragma unroll
        for (int q = 0; q < 8; ++q) rsv[q] = RS[ri[(q >> 2) * 128 + (q & 3) * 16]];
        f32x2 bg2[4], bl2[4], cg2[4], cl2[4];
#pragma unroll
        for (int p = 0; p < 4; ++p) { bg2[p] = (f32x2){bg[2 * p], bg[2 * p + 1]}; bl2[p] = (f32x2){bl[2 * p], bl[2 * p + 1]}; cg2[p] = (f32x2){cg[2 * p], cg[2 * p + 1]}; cl2[p] = (f32x2){cl[2 * p], cl[2 * p + 1]}; }
#pragma unroll
        for (int ai = 0; ai < 2; ++ai)
#pragma unroll
            for (int m = 0; m < 4; ++m) { const float rs = rsv[ai * 4 + m]; f32x2 a2[4];
#pragma unroll
                for (int p = 0; p < 4; ++p) { const int i0 = 2 * p;
                    const f32x2 ag = {(float)acc[ai][0][m][i0 >> 2][i0 & 3], (float)acc[ai][0][m][(i0 + 1) >> 2][(i0 + 1) & 3]}, al = {(float)acc[ai][1][m][i0 >> 2][i0 & 3], (float)acc[ai][1][m][(i0 + 1) >> 2][(i0 + 1) & 3]};
                    f32x2 gl = ag * (cg2[p] * rs) + bg2[p], li = al * (cl2[p] * rs) + bl2[p];
                    gl[0] = fminf(gl[0], 7.f); gl[1] = fminf(gl[1], 7.f); li[0] = fminf(fmaxf(li[0], -7.f), 7.f); li[1] = fminf(fmaxf(li[1], -7.f), 7.f);
                    const f32x2 ex = gl * (-1.702f * LOG2E); f32x2 den = {fexp2(ex[0]), fexp2(ex[1])}; den = den + 1.f; const f32x2 rc = {frcp(den[0]), frcp(den[1])};
                    a2[p] = (gl * rc) * (li + 1.f); }
                u32x2 w; w.x = q8x4(a2[0][0], a2[0][1], a2[1][0], a2[1][1], 1.f / ACT_SCALE); w.y = q8x4(a2[2][0], a2[2][1], a2[3][0], a2[3][1], 1.f / ACT_SCALE);
                *(u32x2*)(ACT + (size_t)(row0 + ai * 128 + m * 16) * FF + j0) = w; }
        return true;
    }
};
struct EpiW2 {
    bf16_t* Y2; const float* b2  ; const float* CS  ;
    __device__ __forceinline__ bool operator()(acci_t& acc, const pg8::Unit& u, int wr, int wc, int fr, int fq) const {
        const int e = u.pn >> 2, pn = u.pn & 3;
        const int row0 = u.pm * 256 + wr * 64 + fr, col0 = pn * 256 + wc * 32 + 8 * fq;
        f32x4 bv[2][2], cv[2][2];
#pragma unroll
        for (int bj = 0; bj < 2; ++bj)
#pragma unroll
            for (int n = 0; n < 2; ++n) { bv[bj][n] = *(const f32x4*)(b2 + (size_t)e * DM + col0 + bj * 128 + 4 * n); cv[bj][n] = *(const f32x4*)(CS + (size_t)e * DM + col0 + bj * 128 + 4 * n) * ACT_SCALE; }
#pragma unroll
        for (int ai = 0; ai < 2; ++ai)
#pragma unroll
            for (int m = 0; m < 4; ++m) { bf16_t* rowp = Y2 + (size_t)(row0 + ai * 128 + m * 16) * DM + col0;
#pragma unroll
                for (int bj = 0; bj < 2; ++bj) { const i32x4 a0 = acc[ai][bj][m][0], a1 = acc[ai][bj][m][1];
                    const f32x4 v0 = (f32x4){(float)a0[0], (float)a0[1], (float)a0[2], (float)a0[3]} * cv[bj][0] + bv[bj][0], v1 = (f32x4){(float)a1[0], (float)a1[1], (float)a1[2], (float)a1[3]} * cv[bj][1] + bv[bj][1];
                    u32x4 w; w.x = cvt_pk_bf16(v0[0], v0[1]); w.y = cvt_pk_bf16(v0[2], v0[3]); w.z = cvt_pk_bf16(v1[0], v1[1]); w.w = cvt_pk_bf16(v1[2], v1[3]);
                    *(u32x4*)(rowp + bj * 128) = w; } }
        return true;
    }
};
#define XB_TMO      128
#define XB_XCNT(j)  (256  + 64 * (j))
#define XB_XSUB(j)  (1280 + 64 * (j))
#define XB_XGEN(j)  (2304 + 64 * (j))
#define XB_TOP      3328
#define XB_TOPGEN   3392
#define XCD_BAR_WORDS 3456
#define XB_SPIN_CAP (1u << 18)

__device__ __forceinline__ unsigned xb_ld(unsigned* p)              { return __hip_atomic_load(p, __ATOMIC_RELAXED, __HIP_MEMORY_SCOPE_AGENT); }
__device__ __forceinline__ unsigned xb_add(unsigned* p, unsigned v) { return __hip_atomic_fetch_add(p, v, __ATOMIC_RELAXED, __HIP_MEMORY_SCOPE_AGENT); }
__device__ __forceinline__ unsigned xb_xcc_id() { return (unsigned)__builtin_amdgcn_s_getreg((3 << 11) | 20) & 0xFu; }
#define XB_SPIN(cond, bar) do { unsigned _sp = 0; while (cond) { __builtin_amdgcn_s_sleep(1); \
    if ((++_sp & 255u) == 0u) { if (xb_ld(&(bar)[XB_TMO])) break; if (_sp > XB_SPIN_CAP) { atomicAdd(&(bar)[XB_TMO], 1u); break; } } } } while (0)

struct XcdBarrier {
    unsigned* bar; unsigned x;
    int w;
    volatile LAS unsigned* st;
};

__device__ __forceinline__ bool xb_thread0(int w) { return w == 0 && lane_id_volatile(2) == 0; }
__device__ __forceinline__ XcdBarrier xcd_barrier_post(unsigned* bar, volatile LAS unsigned* st, int w) {
    XcdBarrier b; b.bar = bar; b.x = xb_xcc_id(); b.st = st; b.w = w;
    if (xb_thread0(w)) (void)xb_add(&bar[XB_XCNT(b.x)], 1u);
    return b;
}
__device__ __forceinline__ void xcd_barrier_complete(unsigned* bar, unsigned x, unsigned& nloc, unsigned& nx) {
    const unsigned G = gridDim.x * gridDim.y * gridDim.z;
    unsigned sum, cnt, mine, sp = 0u;
    for (;;) {
        sum = 0u; cnt = 0u; mine = 0u;
#pragma unroll
        for (unsigned j = 0; j < 16; ++j) { const unsigned c = xb_ld(&bar[XB_XCNT(j)]); sum += c; cnt += (c > 0u) ? 1u : 0u; mine = (j == x) ? c : mine; }
        if (sum == G) break;
        __builtin_amdgcn_s_sleep(1);
        if ((++sp & 255u) == 0u) { if (xb_ld(&bar[XB_TMO])) break; if (sp > XB_SPIN_CAP) { atomicAdd(&bar[XB_TMO], 1u); break; } }
    }
    nloc = mine > 0u ? mine : 1u; nx = cnt > 0u ? cnt : 1u;
}

__device__ __forceinline__ void xcd_barrier(const XcdBarrier& b) {
    asm volatile("s_waitcnt vmcnt(0)" ::: "memory");
    __syncthreads();
    if (xb_thread0(b.w)) {
        unsigned* bar = b.bar;
        __builtin_amdgcn_s_waitcnt(0);
        unsigned nloc = b.st[0], nx = b.st[1];
        if (nloc == 0u) { xcd_barrier_complete(bar, b.x, nloc, nx); b.st[0] = nloc; b.st[1] = nx; }
        const unsigned old = xb_add(&bar[XB_XSUB(b.x)], 1u);
        const unsigned gen = old / nloc;
        if (old + 1u == (gen + 1u) * nloc) {
            __builtin_amdgcn_fence(__ATOMIC_RELEASE, "agent");
            asm volatile("s_waitcnt vmcnt(0)" ::: "memory");
            const unsigned og = xb_add(&bar[XB_TOP], 1u);
            const unsigned tg = og / nx;
            if (og + 1u == (tg + 1u) * nx) xb_add(&bar[XB_TOPGEN], 1u);
            else XB_SPIN(xb_ld(&bar[XB_TOPGEN]) == tg, bar);
            __builtin_amdgcn_fence(__ATOMIC_ACQUIRE, "agent");
            xb_add(&bar[XB_XGEN(b.x)], 1u);
            asm volatile("s_waitcnt vmcnt(0)" ::: "memory");
        } else {
            XB_SPIN(xb_ld(&bar[XB_XGEN(b.x)]) == gen, bar);
            __builtin_amdgcn_fence(__ATOMIC_ACQUIRE, "agent");
            asm volatile("s_waitcnt vmcnt(0)" ::: "memory");
        }
    }
    __syncthreads();
}

constexpr size_t MiB = 1u << 20;
constexpr size_t WS_CTL = 0, CTL_ZERO_BYTES = 1 * MiB;
constexpr size_t WS_MOD = 1 * MiB;
constexpr size_t WS_SGW = 3 * MiB;
constexpr size_t WS_WRT = 3 * MiB + 512 * 1024;
constexpr size_t WS_RS = 4 * MiB;
constexpr size_t WS_CS1 = 5 * MiB;
constexpr size_t WS_CS2 = 6 * MiB + 512 * 1024;
constexpr size_t WS_CSIN = 6 * MiB;
constexpr size_t WS_W = 8 * MiB, W_LAYER = 209 * MiB;
constexpr size_t WO_WIN = 0, WO_WBR = 12 * MiB, WO_WOUT = 15 * MiB, WO_W1 = 17 * MiB, WO_W2 = 145 * MiB;
constexpr size_t WS_PROJ = 426 * MiB;
constexpr size_t WS_GATES = 810 * MiB;
constexpr size_t WS_ACT = WS_PROJ;
constexpr size_t WS_X = 1002 * MiB;
constexpr size_t WS_H = 1194 * MiB;
constexpr size_t WS_O = 1322 * MiB;
constexpr size_t WS_Y = 1514 * MiB;
constexpr size_t WS_BITS = 1770 * MiB;
constexpr size_t WS_Y2 = WS_O;
constexpr size_t WS_SSP = 1850 * MiB;
constexpr size_t WS_ROWTOK = 1854 * MiB;
constexpr size_t WS_TOKINFO = 1862 * MiB;
constexpr size_t WS_SLAB = 1864 * MiB;
constexpr size_t WS_END = 1928 * MiB;
static_assert(WS_Y2 + (size_t)270336 * 2048 <= WS_SSP && WS_W + 2 * W_LAYER <= WS_PROJ && WS_PROJ + (size_t)MTOK * PLD * 2 <= WS_GATES && WS_GATES + (size_t)MTOK * 3072 <= WS_H, "d_ws map");
constexpr int CW_BAR = 4096;
constexpr int CW_CNT = 16384;

constexpr int RING_BYTES = 131072;
constexpr int MISC_OFF = 134144;
constexpr int TS_OFF = MISC_OFF + 512;
constexpr int TILE_E_OFF = MISC_OFF + 1024;
constexpr int ROWIDX_OFF = MISC_OFF + 5632;
constexpr int LDS_BYTES = 151552;
static_assert(ROWIDX_OFF + 8192 <= LDS_BYTES, "LDS map");

struct Args {
    const float* in[21]; float* out; unsigned char* ws; int ph_lo, ph_hi;
};
struct Frame {
    LAS unsigned char* lds; int tid, lane, wave, vcu, G;
};
__device__ __forceinline__ Frame phase_frame(const Frame& F0) { Frame F = F0; int t = F0.wave * 64 + lane_id_volatile(3); asm volatile("" : "+v"(t)); F.tid = t; F.lane = t & 63; F.wave = F0.wave; return F; }
template <class T> __device__ __forceinline__ T* opq(T* p) { long z = 0; asm volatile("" : "+s"(z)); return (T*)((unsigned char*)p + z); }

__device__ __forceinline__ void p0_mod(const Frame& F, const float* c, const float* w_ada, const float* b_ada, float* MOD) {
    LAS float* csT = (LAS float*)F.lds;
    for (int i = F.tid; i < BATCH * DM; i += 512) { const int b = i & 31, k = i >> 5; const float v = c[b * DM + k]; csT[k * 32 + b] = v * sigmoidf_(v); }
    __syncthreads();
    const int gw = F.vcu * 8 + F.wave, NGW = F.G * 8;
    const int cg = F.lane & 15, kq = F.lane >> 4;
    for (int task = gw; task < DEPTH * 384; task += NGW) {
        const int l = task / 384, n = (task % 384) * 16 + cg;
        float acc[32];
#pragma unroll
        for (int b = 0; b < 32; ++b) acc[b] = 0.f;
        const float* w = w_ada + ((size_t)l * DM + kq * 256) * (6 * DM) + n;
#pragma unroll 4
        for (int k = 0; k < 256; ++k) {
            const float wv = w[(size_t)k * (6 * DM)];
            const LAS f32x4* cs = (const LAS f32x4*)(csT + (kq * 256 + k) * 32);
#pragma unroll
            for (int q = 0; q < 8; ++q) { const f32x4 c4 = cs[q]; acc[4 * q] += c4[0] * wv; acc[4 * q + 1] += c4[1] * wv; acc[4 * q + 2] += c4[2] * wv; acc[4 * q + 3] += c4[3] * wv; }
        }
#pragma unroll
        for (int b = 0; b < 32; ++b) { acc[b] = xor32_add(xor16_add(acc[b])); }
        if (kq == 0) { const float bb = b_ada[l * 6 * DM + n];
#pragma unroll
            for (int b = 0; b < 32; ++b) MOD[((size_t)l * BATCH + b) * (6 * DM) + n] = acc[b] + bb; }
    }
    __syncthreads();
}
__device__ __forceinline__ void tr_item(const float* W, size_t ldw, int srccol, bool valid, bf16_t* dst  , int K, LAS float* scr, int lane) {
    const float* wp = W + srccol;
#pragma unroll 8
    for (int i = 0; i < 32; ++i) { const int kk = 2 * i + (lane >> 5); scr[kk * 33 + (lane & 31)] = valid ? wp[(size_t)kk * ldw] : 0.f; }
    LDS_WAIT(); asm volatile("" ::: "memory");
    const int c = lane & 7;
#pragma unroll
    for (int j = 0; j < 4; ++j) { const int n = (lane >> 3) + 8 * j; const LAS float* s = scr + (8 * c) * 33 + n;
        u32x4 o; o.x = cvt_pk_bf16(s[0 * 33], s[1 * 33]); o.y = cvt_pk_bf16(s[2 * 33], s[3 * 33]); o.z = cvt_pk_bf16(s[4 * 33], s[5 * 33]); o.w = cvt_pk_bf16(s[6 * 33], s[7 * 33]);
        *(u32x4*)(dst + (size_t)n * K + 8 * c) = o; }
    LDS_WAIT(); asm volatile("" ::: "memory");
}
__device__ __forceinline__ void p0_weights(const Frame& F, const Args& a) {
    LAS float* scr = (LAS float*)(F.lds + F.wave * 16384);
    const int gw = F.vcu * 8 + F.wave, NGW = F.G * 8, lane = F.lane, jl = lane & 31;
    const float *w_in = a.in[8], *w_branch = a.in[13], *w_out = a.in[14], *w_router = a.in[15], *w1 = a.in[17], *w2 = a.in[19];
    constexpr int I_BR = 3 * 8 * 32, I_OUT = 16 * 32, I_RT = 16;
    constexpr int I_LAYER = I_BR + I_OUT + I_RT;
    for (int it = gw; it < DEPTH * I_LAYER; it += NGW) {
        const int l = it / I_LAYER; int r = it - l * I_LAYER;
        unsigned char* wl = a.ws + WS_W + (size_t)l * W_LAYER;
        if (r < I_BR) {
            const int br = r / 256, q = r % 256, kb = q / 32, nb = q % 32;
            tr_item(w_branch + ((size_t)(l * 3 + br) * 512 + kb * 64) * DM, DM, nb * 32 + jl, true, (bf16_t*)(wl + WO_WBR) + (size_t)(br * 1024 + nb * 32) * 512 + kb * 64, 512, scr, lane); continue; }
        r -= I_BR;
        if (r < I_OUT) {
            const int kb = r / 32, nb = r % 32;
            tr_item(w_out + ((size_t)l * DM + kb * 64) * DM, DM, nb * 32 + jl, true, (bf16_t*)(wl + WO_WOUT) + (size_t)nb * 32 * DM + kb * 64, DM, scr, lane); continue; }
        r -= I_OUT;
        {
            const int kb = r;
            tr_item(w_router + ((size_t)l * DM + kb * 64) * NE, NE, jl, true, (bf16_t*)(a.ws + WS_WRT) + (size_t)l * NE * DM + kb * 64, DM, scr, lane); }
        (void)r;
    }
    __syncthreads();
    {
    LAS float* T = (LAS float*)F.lds; LAS float* red = (LAS float*)(F.lds + ROWIDX_OFF);
    const int half = lane >> 5, wave = F.wave;
    constexpr int ST_W1 = NE * 64, ST_IN = 192, ST_W2 = NE * 32, ST_LAYER = ST_W1 + ST_IN + ST_W2;
#define STRIP_PARAMS(st_, wp, ldw, valid, dst, csp) do { const int l = (st_) / ST_LAYER, q = (st_) % ST_LAYER; valid = true; \
        if (q < ST_W1) { const int e = q / 64, r6 = q % 64, src = r6 * 32 + jl, j = src >> 1, sgl = src & 1, n = (j >> 7) * 256 + sgl * 128 + (j & 127);     \
            wp = w1 + ((size_t)(l * NE + e) * DM) * (2 * FF) + src; ldw = 2 * FF; \
            dst = (signed char*)(a.ws + WS_W + (size_t)l * W_LAYER + WO_W1) + ((size_t)e * 2048 + n) * DM; csp = (float*)(a.ws + WS_CS1) + ((size_t)l * NE + e) * 2048 + n; } \
        else if (q >= ST_W1 + ST_IN) { const int q2 = q - ST_W1 - ST_IN, e = q2 / 32, nb = q2 % 32, n = nb * 32 + jl; \
            wp = w2 + ((size_t)(l * NE + e) * FF) * DM + n; ldw = DM; \
            dst = (signed char*)(a.ws + WS_W + (size_t)l * W_LAYER + WO_W2) + ((size_t)e * DM + n) * FF; csp = (float*)(a.ws + WS_CS2) + ((size_t)l * NE + e) * DM + n; } \
        else { const int nb = q - ST_W1, n = nb * 32 + jl; valid = (n < 1832) || (n >= 2048); const int src = n < 1832 ? n : n - 216; \
            wp = w_in + (size_t)l * DM * 5928 + (valid ? src : 0); ldw = 5928; \
            dst = (signed char*)(a.ws + WS_W + (size_t)l * W_LAYER + WO_WIN) + (size_t)n * DM; csp = (float*)(a.ws + WS_CSIN) + (size_t)l * NPROJ + n; } } while (0)
#define STRIP_LOAD64(vv, wp, ldw, valid) do { const float* p_ = wp + (size_t)(wave * 128 + half) * ldw; const size_t st_ = 2 * ldw; \
        _Pragma("unroll") for (int i = 0; i < 64; ++i) { vv[i] = valid ? __builtin_nontemporal_load(p_) : 0.f; p_ += st_; asm volatile("" : "+v"(p_)); } } while (0)
    float va[64];
    { const int st = F.vcu < DEPTH * ST_LAYER ? F.vcu : DEPTH * ST_LAYER - 1; const float* wp; size_t ldw; bool valid; signed char* dst; float* csp; STRIP_PARAMS(st, wp, ldw, valid, dst, csp); (void)dst; (void)csp; STRIP_LOAD64(va, wp, ldw, valid); }
    for (int st = F.vcu; st < DEPTH * ST_LAYER; st += F.G) {
        const float* wp; size_t ldw; bool valid; signed char* dst; float* csp;
        STRIP_PARAMS(st, wp, ldw, valid, dst, csp); (void)wp; (void)ldw;
        float vb[64];
        { const int stn = st + F.G;
          if (stn < DEPTH * ST_LAYER) { const float* wpn; size_t ldwn; bool validn; signed char* dstn; float* cspn; STRIP_PARAMS(stn, wpn, ldwn, validn, dstn, cspn); (void)dstn; (void)cspn; STRIP_LOAD64(vb, wpn, ldwn, validn); }
          else {
#pragma unroll
              for (int i = 0; i < 64; ++i) vb[i] = 0.f; } }
        float am = 0.f;
#pragma unroll
        for (int i16 = 0; i16 < 16; ++i16) { const int k = wave * 128 + 2 * i16 + half; LAS float* tp = T + k * 32 + (jl ^ (k & 31));
#pragma unroll
            for (int g = 0; g < 4; ++g) { const float x = va[i16 + 16 * g]; am = fmaxf(am, fabsf(x)); tp[g * 1024] = x; } }
        red[(wave * 2 + half) * 32 + jl] = am;
        lds_barrier();
        float amx = 0.f;
#pragma unroll
        for (int p = 0; p < 16; ++p) amx = fmaxf(amx, red[p * 32 + jl]);
        const float scale = valid ? fmaxf(amx, 1e-30f) * (1.f / 127.f) : 1.f, inv = valid ? 1.f / scale : 0.f;
        if (wave == 0 && half == 0) *csp = scale;
        const int k0 = 64 * (wave * 2 + half);
#pragma unroll
        for (int c16 = 0; c16 < 4; ++c16) { unsigned wq[4];
#pragma unroll
            for (int d4 = 0; d4 < 4; ++d4) { const int k = k0 + c16 * 16 + d4 * 4;
                wq[d4] = q8x4(T[k * 32 + (jl ^ (k & 31))], T[(k + 1) * 32 + (jl ^ ((k + 1) & 31))], T[(k + 2) * 32 + (jl ^ ((k + 2) & 31))], T[(k + 3) * 32 + (jl ^ ((k + 3) & 31))], inv); }
            *(u32x4*)(dst + k0 + c16 * 16) = (u32x4){wq[0], wq[1], wq[2], wq[3]}; }
        lds_barrier();
#pragma unroll
        for (int i = 0; i < 64; ++i) va[i] = vb[i];
    }
#undef STRIP_LOAD64
#undef STRIP_PARAMS
    }
    const float* sg_w = a.in[10]; bf16_t* SGW = (bf16_t*)(a.ws + WS_SGW);
    for (int i = (F.vcu * 512 + F.tid) * 2; i < DEPTH * 8 * 128 * 128; i += F.G * 512 * 2) { const int s = i & 127, t = (i >> 7) & 127; const f32x2 v = *(const f32x2*)(sg_w + i);
        *(unsigned*)(SGW + i) = cvt_pk_bf16(s <= t ? v[0] : 0.f, (s + 1) <= t ? v[1] : 0.f); }
}

__device__ __forceinline__ void norm_mod_row(const f32x4 (&v)[4], float ss, const float* g, const float* sc, const float* sh, signed char* orow, float* rs, int lane) {
    const float rstd = 1.f / sqrtf(ss * (1.f / DM) + RMS_EPS);
    f32x4 o[4]; float am = 0.f;
#pragma unroll
    for (int j = 0; j < 4; ++j) { const int c = 4 * lane + 256 * j; const f32x4 gg = *(const f32x4*)(g + c), s1 = *(const f32x4*)(sc + c), s0 = *(const f32x4*)(sh + c);
        o[j] = (v[j] * rstd) * gg * (s1 + 1.f) + s0;
        am = fmaxf(am, fmaxf(fmaxf(fabsf(o[j][0]), fabsf(o[j][1])), fmaxf(fabsf(o[j][2]), fabsf(o[j][3])))); }
    am = wave_max(am);
    const float scale = fmaxf(am, 1e-30f) * (1.f / 127.f), inv = 1.f / scale;
    if (lane == 0) *rs = scale;
#pragma unroll
    for (int j = 0; j < 4; ++j) *(unsigned*)(orow + 4 * lane + 256 * j) = q8x4(o[j][0], o[j][1], o[j][2], o[j][3], inv);
}
__device__ __forceinline__ void p1_norm(const Frame& F, const float* x, const float* g, const float* MOD0, signed char* H8, float* RS, bf16_t* X16) {
    const int gw = F.vcu * 8 + F.wave, NGW = F.G * 8, lane = F.lane;
    const int r_lo = (int)((long)(MTOK / 4) * gw / NGW) * 4, r_hi = (int)((long)(MTOK / 4) * (gw + 1) / NGW) * 4;
    f32x4 N2[4], N3[4]; int bcur = (r_lo < MTOK ? r_lo : MTOK - 1) >> 11;
#define P1_PARAMS(b_) do { const float* mb_ = MOD0 + (size_t)(b_) * 6 * DM; _Pragma("unroll") for (int j = 0; j < 4; ++j) { const int c = 4 * lane + 256 * j; \
        const f32x4 gg = *(const f32x4*)(g + c), s1 = *(const f32x4*)(mb_ + DM + c), s0 = *(const f32x4*)(mb_ + c); N2[j] = gg * (s1 + 1.f); N3[j] = s0; } } while (0)
    P1_PARAMS(bcur);
    for (int row0 = r_lo; row0 < r_hi; row0 += 4) { f32x4 v[4][4];
        if ((row0 >> 11) != bcur) { bcur = row0 >> 11; P1_PARAMS(bcur); }
#pragma unroll
        for (int rr = 0; rr < 4; ++rr)
#pragma unroll
            for (int j = 0; j < 4; ++j) v[rr][j] = __builtin_nontemporal_load((const f32x4*)(x + (size_t)(row0 + rr) * DM + 4 * lane + 256 * j));
        float ss[4], am[4]; f32x4 o[4][4];
#pragma unroll
        for (int rr = 0; rr < 4; ++rr) { ss[rr] = 0.f;
#pragma unroll
            for (int j = 0; j < 4; ++j) ss[rr] += (v[rr][j][0] * v[rr][j][0] + v[rr][j][1] * v[rr][j][1]) + (v[rr][j][2] * v[rr][j][2] + v[rr][j][3] * v[rr][j][3]); }
#pragma unroll
        for (int rr = 0; rr < 4; ++rr) ss[rr] = wave_sum(ss[rr]);
#pragma unroll
        for (int rr = 0; rr < 4; ++rr) { const int row = row0 + rr; const float rstd = 1.f / sqrtf(ss[rr] * (1.f / DM) + RMS_EPS); am[rr] = 0.f;
#pragma unroll
            for (int j = 0; j < 4; ++j) { u32x2 w; w.x = cvt_pk_bf16(v[rr][j][0], v[rr][j][1]); w.y = cvt_pk_bf16(v[rr][j][2], v[rr][j][3]); *(u32x2*)(X16 + (size_t)row * DM + 4 * lane + 256 * j) = w;
                o[rr][j] = (v[rr][j] * rstd) * N2[j] + N3[j];
                am[rr] = fmaxf(am[rr], fmaxf(fmaxf(fabsf(o[rr][j][0]), fabsf(o[rr][j][1])), fmaxf(fabsf(o[rr][j][2]), fabsf(o[rr][j][3])))); } }
#pragma unroll
        for (int rr = 0; rr < 4; ++rr) am[rr] = wave_max(am[rr]);
#pragma unroll
        for (int rr = 0; rr < 4; ++rr) { const int row = row0 + rr; const float scale = fmaxf(am[rr], 1e-30f) * (1.f / 127.f), inv = 1.f / scale;
            if (lane == 0) RS[row] = scale;
#pragma unroll
            for (int j = 0; j < 4; ++j) *(unsigned*)(H8 + (size_t)row * DM + 4 * lane + 256 * j) = q8x4(o[rr][j][0], o[rr][j][1], o[rr][j][2], o[rr][j][3], inv); } }
#undef P1_PARAMS
}
constexpr int TOPK_SEL = 256;
struct IdxOps { bf16x8 af[4][2]; u32x4 wraw[4][2]; bf16x8 kf[4][2]; };
__device__ __forceinline__ void dsa_index_load(IdxOps& P, const bf16_t* __restrict__ PROJ, int b, int qg, int lane, int wid) {
    asm volatile("" : "+v"(lane));
    const int n = lane & 31, hi = lane >> 5;
    const int q0 = qg * 16;
    const size_t tokbase = (size_t)b * SEQ;
    const int m = n, hm = (m >> 2) & 1, idx = (m & 3) + 4 * (m >> 3), aq = 2 * hm + (idx >> 3), ah = idx & 7;
#pragma unroll
    for (int qgp = 0; qgp < 4; ++qgp) { const bf16_t* qp = PROJ + (tokbase + q0 + 4 * qgp + aq) * PLD + C_QI + ah * 32 + 8 * hi;
        P.af[qgp][0] = *(const bf16x8*)qp; P.af[qgp][1] = *(const bf16x8*)(qp + 16); }
}
__device__ __forceinline__ void dsa_index_load_k(IdxOps& P, const bf16_t* __restrict__ PROJ, int b, int qg, int lane, int wid) {
    asm volatile("" : "+v"(lane));
    const int n = lane & 31, hi = lane >> 5;
    const int q0 = qg * 16, nkb = (q0 + 16 + 31) >> 5;
    const size_t tokbase = (size_t)b * SEQ;
#pragma unroll
    for (int qgp = 0; qgp < 4; ++qgp)
#pragma unroll
        for (int qq = 0; qq < 2; ++qq) P.wraw[qgp][qq] = *(const u32x4*)(PROJ + (tokbase + q0 + 4 * qgp + 2 * hi + qq) * PLD + C_WI);
#pragma unroll
    for (int i = 0; i < 4; ++i) { const int kb = wid + 8 * i;
        if (kb < nkb) { const bf16_t* kp = PROJ + (tokbase + 32 * kb + n) * PLD + C_KI + 8 * hi; P.kf[i][0] = *(const bf16x8*)kp; P.kf[i][1] = *(const bf16x8*)(kp + 16); } }
}
__device__ __forceinline__ void dsa_index_scores(IdxOps& P, const bf16_t* __restrict__ PROJ, LAS float* sc, int b, int qg, int lane, int wid) {
    const int n = lane & 31, hi = lane >> 5;
    const int q0 = qg * 16, nkb = (q0 + 16 + 31) >> 5;
    const size_t tokbase = (size_t)b * SEQ;
    LAS float* scw = sc + (2 * hi) * 2048 + 32 * wid + n;
    float wv[4][16];
#pragma unroll
    for (int qgp = 0; qgp < 4; ++qgp)
#pragma unroll
        for (int qq = 0; qq < 2; ++qq) { const u32x4 w = P.wraw[qgp][qq];
            wv[qgp][8 * qq + 0] = bf_lo(w.x) * 0.0625f; wv[qgp][8 * qq + 1] = bf_hi(w.x) * 0.0625f; wv[qgp][8 * qq + 2] = bf_lo(w.y) * 0.0625f; wv[qgp][8 * qq + 3] = bf_hi(w.y) * 0.0625f;
            wv[qgp][8 * qq + 4] = bf_lo(w.z) * 0.0625f; wv[qgp][8 * qq + 5] = bf_hi(w.z) * 0.0625f; wv[qgp][8 * qq + 6] = bf_lo(w.w) * 0.0625f; wv[qgp][8 * qq + 7] = bf_hi(w.w) * 0.0625f; }
#pragma unroll
    for (int i = 0; i < 8; ++i) { const int kb = wid + 8 * i;
        if (kb < nkb) {
            const bf16x8 k0 = P.kf[i & 3][0], k1 = P.kf[i & 3][1];
            if (i < 4 && kb + 32 < nkb) { const bf16_t* kp = PROJ + (tokbase + 32 * (kb + 32) + n) * PLD + C_KI + 8 * hi; P.kf[i & 3][0] = *(const bf16x8*)kp; P.kf[i & 3][1] = *(const bf16x8*)(kp + 16); }
#pragma unroll
            for (int qgp = 0; qgp < 4; ++qgp) {
                f32x16 d = {0.f, 0.f, 0.f, 0.f, 0.f, 0.f, 0.f, 0.f, 0.f, 0.f, 0.f, 0.f, 0.f, 0.f, 0.f, 0.f};
                d = __builtin_amdgcn_mfma_f32_32x32x16_bf16(P.af[qgp][0], k0, d, 0, 0, 0);
                d = __builtin_amdgcn_mfma_f32_32x32x16_bf16(P.af[qgp][1], k1, d, 0, 0, 0);
                float sa = 0.f, sb = 0.f;
#pragma unroll
                for (int r = 0; r < 8; ++r) { sa += wv[qgp][r] * fmaxf(d[r], 0.f); sb += wv[qgp][8 + r] * fmaxf(d[8 + r], 0.f); }
                scw[(4 * qgp) * 2048 + 256 * i] = sa; scw[(4 * qgp + 1) * 2048 + 256 * i] = sb;
            } } }
}
__device__ __forceinline__ void bit_transpose32(unsigned (&a)[32]) {
#pragma unroll
    for (int k = 0; k < 16; ++k) { const unsigned lo = a[k], hi = a[k + 16];
        a[k] = __builtin_amdgcn_perm(hi, lo, 0x05040100u); a[k + 16] = __builtin_amdgcn_perm(hi, lo, 0x07060302u); }
#pragma unroll
    for (int k = 0; k < 32; ++k) if ((k & 8) == 0) { const unsigned lo = a[k], hi = a[k + 8];
        a[k] = __builtin_amdgcn_perm(hi, lo, 0x06020400u); a[k + 8] = __builtin_amdgcn_perm(hi, lo, 0x07030501u); }
#pragma unroll
    for (int s = 0; s < 3; ++s) { const int j = 4 >> s; const unsigned m = (s == 0) ? 0x0F0F0F0Fu : (s == 1) ? 0x33333333u : 0x55555555u;
#pragma unroll
        for (int k = 0; k < 32; ++k) if ((k & j) == 0) { const unsigned lo = a[k], hi = a[k + j];
            a[k] = (m & lo) | (~m & (hi << j)); a[k + j] = (m & (lo >> j)) | (~m & hi); } }
}
__device__ __forceinline__ void dsa_index_select(LAS float* sc, LAS int* qctr, unsigned long long* __restrict__ bits64, int b, int qg, int lane, int wid) {
    const int q0 = qg * 16;
    const size_t tokbase = (size_t)b * SEQ;
#pragma unroll 1
    for (;;) {
        int qn = 0; if (lane == 0) qn = __hip_atomic_fetch_add(qctr, 1, __ATOMIC_RELAXED, __HIP_MEMORY_SCOPE_WORKGROUP);
        qn = __builtin_amdgcn_readfirstlane(qn); if (qn >= 16) break;
        const int ql = 15 - qn, pos = q0 + ql, nn = pos + 1, nr = (nn + 63) >> 6;
        const LAS float* scq = sc + ql * 2048;
        unsigned mlo = 0u, mhi = 0u;
        if (nn <= TOPK_SEL) {
#pragma unroll
            for (int r = 0; r < 4; ++r) if (r < nr) { const unsigned long long bal = __ballot(64 * r + lane <= pos); asm volatile("s_nop 4\n\tv_writelane_b32 %0, %2, %4\n\tv_writelane_b32 %1, %3, %4" : "+v"(mlo), "+v"(mhi) : "s"((unsigned)bal), "s"((unsigned)(bal >> 32)), "n"(r));     }
        } else {
            unsigned u[32];
#pragma unroll
            for (int r = 0; r < 32; ++r) u[r] = 0u;
#pragma unroll
            for (int g8 = 0; g8 < 4; ++g8) if (8 * g8 < nr) {
#pragma unroll
                for (int q_ = 0; q_ < 8; ++q_) { const int r = 8 * g8 + q_; const int j = 64 * r + lane; float s = scq[j]; s = (s == 0.f) ? 0.f : s; const unsigned bts = __builtin_bit_cast(unsigned, s);
                    const unsigned uu = (bts & 0x80000000u) ? ~bts : (bts | 0x80000000u); u[r] = (j <= pos) ? uu : 0u; } }
            unsigned M = 0u;
#pragma unroll
            for (int r = 0; r < 32; ++r) M |= (64 * r + lane <= pos) ? (1u << r) : 0u;
            bit_transpose32(u);
            unsigned G = 0u; unsigned need = (unsigned)TOPK_SEL, cM = (unsigned)nn;
            {
#pragma unroll
            for (int bq = 31; bq >= 0; --bq) {
                const unsigned T = M & u[bq];
                const unsigned c = wave_sum_u32((unsigned)__builtin_popcount(T));
                const bool ge = c >= need;
                G |= ge ? 0u : T; M = ge ? T : (M & ~u[bq]); cM = ge ? c : cM - c; need -= ge ? 0u : c;
                if (cM == need) { G |= M; goto sel_done; }
            }
            unsigned run = 0u;
#pragma unroll
            for (int r = 0; r < 32; ++r) if (r < nr) { const bool isc = (M >> r) & 1u; const unsigned long long eqm = __ballot(isc);
                const unsigned pre = run + __builtin_amdgcn_mbcnt_hi((unsigned)(eqm >> 32), __builtin_amdgcn_mbcnt_lo((unsigned)eqm, 0u));
                if (isc && pre < need) G |= (1u << r);
                run += (unsigned)__builtin_popcountll(eqm); }
            }
            sel_done:
#pragma unroll
            for (int r = 0; r < 32; ++r) if ((r & ~7) < nr) { const unsigned long long bal = __ballot((G >> r) & 1u); asm volatile("s_nop 4\n\tv_writelane_b32 %0, %2, %4\n\tv_writelane_b32 %1, %3, %4" : "+v"(mlo), "+v"(mhi) : "s"((unsigned)bal), "s"((unsigned)(bal >> 32)), "n"(r));     }
        }
        if (lane < nr) bits64[(tokbase + pos) * 32 + lane] = ((unsigned long long)mhi << 32) | mlo;
    }
}
__device__ __forceinline__ void dsa_index_phase(const Frame& F, const bf16_t* __restrict__ PROJ, unsigned long long* __restrict__ bits64, unsigned* stampw, bool pv = false) {
    LAS float* sc = (LAS float*)F.lds;
    LAS int* qctr = (LAS int*)(F.lds + TS_OFF);
    IdxOps P;
    int u = F.vcu;
    if (u < 4096) { dsa_index_load(P, PROJ, u & 31, u >> 5, F.lane, F.wave); dsa_index_load_k(P, PROJ, u & 31, u >> 5, F.lane, F.wave); }
#ifdef T_STAMP
    unsigned long long tA = 0, tB = 0, tC = 0, tD = 0, t0 = __builtin_amdgcn_s_memrealtime(), t1;
#define STAMP(acc) do { t1 = __builtin_amdgcn_s_memrealtime(); acc += t1 - t0; t0 = t1; } while (0)
#else
#define STAMP(acc) do { } while (0)
#endif
#pragma unroll 1
    for (; u < 4096; u += F.G) {
#if defined(IDX_PROBE) && (IDX_PROBE & 1)
        if (!pv)
#endif
        dsa_index_scores(P, PROJ, sc, u & 31, u >> 5, F.lane, F.wave);
        if (F.tid == 0) *qctr = 0;
        STAMP(tA);
        __syncthreads();
        STAMP(tB);
        const int un = u + F.G;
#if defined(IDX_PROBE) && (IDX_PROBE & 2)
        if (!pv)
#endif
        dsa_index_select(sc, qctr, bits64, u & 31, u >> 5, F.lane, F.wave);
        asm volatile("" ::: "memory");
        if (un < 4096) { dsa_index_load(P, PROJ, un & 31, un >> 5, F.lane, F.wave); dsa_index_load_k(P, PROJ, un & 31, un >> 5, F.lane, F.wave); }
        STAMP(tC);
        __syncthreads();
        STAMP(tD);
    }
#ifdef T_STAMP
    if (stampw && blockIdx.x == 17 && F.tid == 0) { const unsigned long long tot = tA + tB + tC + tD; const unsigned long long part = (T_STAMP == 0) ? tA : (T_STAMP == 1) ? tB : (T_STAMP == 2) ? tC : tD;
        *stampw = (unsigned)((part * 64ull) / (tot ? tot : 1ull)); }
#endif
#undef STAMP
}

constexpr int KS = 144, VS = 192;
#ifndef USE_TR
#define USE_TR 1
#endif
struct AttnPre { bf16x8 qf[4]; u32x4 kreg, vreg; u32x2 mreg; };
__device__ __forceinline__ void attn_decode(int u, int& b, int& g, int& qb) { const int cu = u & 255, j = u >> 8, bg = cu >> 2, s = cu & 3; qb = (j & 1) ? (8 * (j >> 1) + 7 - s) : (8 * (j >> 1) + s); b = bg >> 1; g = bg & 1; }
template <int MODE>
__device__ __forceinline__ void attn_prefetch(const Frame& F, const bf16_t* __restrict__ PROJ, const unsigned* __restrict__ bits, int b, int g, int qb, bf16x8 (&qf)[4], u32x4& kreg, u32x4& vreg, u32x2& mreg) {
    const int tid = F.tid, lane = F.lane, wid = F.wave, n = lane & 31, hi = lane >> 5;
    constexpr int CQ = MODE ? C_QB : C_QA, CK = MODE ? C_KB : C_KA, CV = MODE ? C_VB : C_VA;
    const int hq = 4 * g + (wid >> 1), qpos = qb * 64 + 32 * (wid & 1) + n;
    const size_t tokbase = (size_t)b * SEQ;
    const int kt_lo = (MODE == 0) ? (qb >= 2 ? qb - 2 : 0) : 0;
    const int srow = tid >> 3, sch = tid & 7;
    kreg = *(const u32x4*)(PROJ + (tokbase + srow + (size_t)kt_lo * 64) * PLD + CK + g * 64 + sch * 8);
    vreg = *(const u32x4*)(PROJ + (tokbase + srow + (size_t)kt_lo * 64) * PLD + CV + g * 64 + sch * 8);
    if (MODE == 1) mreg = *(const u32x2*)(bits + (tokbase + qpos) * 64 + 2 * kt_lo);
    const bf16_t* qp = PROJ + (tokbase + qpos) * PLD + CQ + hq * 64 + 8 * hi;
#pragma unroll
    for (int s = 0; s < 4; ++s) qf[s] = *(const bf16x8*)(qp + 16 * s);
}
template <int MODE>
__device__ __forceinline__ void attn_unit(const Frame& F, const bf16_t* __restrict__ PROJ, bf16_t* __restrict__ O, const unsigned* __restrict__ bits, const float* __restrict__ sinks, int b, int g, int qb, AttnPre& P, int un  ) {
    const int tid = F.tid, lane = F.lane, wid = F.wave, n = lane & 31, hi = lane >> 5;
    constexpr int CQ = MODE ? C_QB : C_QA, CK = MODE ? C_KB : C_KA, CV = MODE ? C_VB : C_VA;
    const int hq = 4 * g + (wid >> 1), qpos = qb * 64 + 32 * (wid & 1) + n;
    const size_t tokbase = (size_t)b * SEQ;
    LAS unsigned char* Ks = F.lds; LAS unsigned char* Vs = F.lds + 64 * KS;
    bf16x8 qf[4], qn[4];
#pragma unroll
    for (int s = 0; s < 4; ++s) { qf[s] = P.qf[s]; qn[s] = P.qf[s]; }
    f32x16 o0, o1;
#pragma unroll
    for (int r = 0; r < 16; ++r) { o0[r] = 0.f; o1[r] = 0.f; }
    float mrun, lsum;
    if (MODE == 0) { mrun = sinks[hq] * LOG2E; lsum = (hi == 0) ? 1.f : 0.f; } else { mrun = -1e30f; lsum = 0.f; }
    const int kt_lo = (MODE == 0) ? (qb >= 2 ? qb - 2 : 0) : 0, kt_hi = qb;
    const int srow = tid >> 3, sch = tid & 7;
    const bf16_t* kg = PROJ + (tokbase + srow) * PLD + CK + g * 64 + sch * 8;
    const bf16_t* vg = PROJ + (tokbase + srow) * PLD + CV + g * 64 + sch * 8;
    const unsigned* bp = bits + (tokbase + qpos) * 64;
    u32x4 kreg = P.kreg, vreg = P.vreg;
    u32x2 mreg = {0u, 0u};
    if (MODE == 1) mreg = P.mreg;
    const int vbase = (4 * hi + ((lane & 15) >> 2)) * VS + (16 * ((lane >> 4) & 1) + 4 * (lane & 3)) * 2;
    for (int kt = kt_lo; kt <= kt_hi; ++kt) {
        __syncthreads();
        *(LAS u32x4*)(Ks + srow * KS + sch * 16) = kreg; *(LAS u32x4*)(Vs + srow * VS + sch * 16) = vreg;
        const u32x2 mcur = mreg;
        __syncthreads();
        if (kt < kt_hi) { kreg = *(const u32x4*)(kg + (size_t)(kt + 1) * 64 * PLD); vreg = *(const u32x4*)(vg + (size_t)(kt + 1) * 64 * PLD); if (MODE == 1) mreg = *(const u32x2*)(bp + 2 * (kt + 1)); }
        else if (un < 2048) { int nb, ng, nqb; attn_decode(un, nb, ng, nqb); attn_prefetch<MODE>(F, PROJ, bits, nb, ng, nqb, qn, kreg, vreg, mreg); }
        f32x16 p0, p1;
#pragma unroll
        for (int r = 0; r < 16; ++r) { p0[r] = 0.f; p1[r] = 0.f; }
#pragma unroll
        for (int s = 0; s < 4; ++s) { const bf16x8 k0 = *(const LAS bf16x8*)(Ks + n * KS + (16 * s + 8 * hi) * 2), k1 = *(const LAS bf16x8*)(Ks + (n + 32) * KS + (16 * s + 8 * hi) * 2);
            p0 = __builtin_amdgcn_mfma_f32_32x32x16_bf16(k0, qf[s], p0, 0, 0, 0); p1 = __builtin_amdgcn_mfma_f32_32x32x16_bf16(k1, qf[s], p1, 0, 0, 0); }
        unsigned w0, w1;
        if (MODE == 1) { w0 = mcur.x >> (4 * hi); w1 = mcur.y >> (4 * hi); }
        else {
#pragma unroll
            for (int blk = 0; blk < 2; ++blk) { const int d0 = qpos - (kt * 64 + 32 * blk); unsigned mk = 0u;
                if (d0 >= 0) { const int hb = d0 > 31 ? 31 : d0; int lo = d0 - 127; if (lo <= 31) { if (lo < 0) lo = 0; mk = (0xFFFFFFFFu >> (31 - hb)) & (0xFFFFFFFFu << lo); } }
                if (blk == 0) w0 = mk >> (4 * hi); else w1 = mk >> (4 * hi); }
        }
        float mx = fmaxf(fmaxf(p0[0], p0[1]), fmaxf(p1[0], p1[1]));
#pragma unroll
        for (int r = 2; r < 16; r += 2) mx = fmaxf(mx, fmaxf(fmaxf(p0[r], p0[r + 1]), fmaxf(p1[r], p1[r + 1])));
        mx = xor32_max(mx);
        const float mnew = fmaxf(mrun, mx), alpha = fexp2(mrun - mnew); mrun = mnew;
        float ps = 0.f;
#pragma unroll
        for (int r = 0; r < 16; ++r) { const int bitpos = 8 * (r >> 2) + (r & 3);
            const float e0 = fexp2(p0[r] - mnew), e1 = fexp2(p1[r] - mnew);
            p0[r] = __builtin_bit_cast(float, __builtin_bit_cast(unsigned, e0) & (unsigned)__builtin_amdgcn_sbfe((int)w0, bitpos, 1));
            p1[r] = __builtin_bit_cast(float, __builtin_bit_cast(unsigned, e1) & (unsigned)__builtin_amdgcn_sbfe((int)w1, bitpos, 1));
            ps += p0[r] + p1[r]; }
        lsum = lsum * alpha + ps;
        if (__builtin_amdgcn_ballot_w64(alpha != 1.f) != 0ull) {
#pragma unroll
            for (int r = 0; r < 16; ++r) { o0[r] *= alpha; o1[r] *= alpha; } }
        bf16x8 pf[2][2];
#pragma unroll
        for (int s2 = 0; s2 < 2; ++s2) { u32x4 a, c;
            a.x = cvt_pk_bf16(p0[8 * s2 + 0], p0[8 * s2 + 1]); a.y = cvt_pk_bf16(p0[8 * s2 + 2], p0[8 * s2 + 3]); a.z = cvt_pk_bf16(p0[8 * s2 + 4], p0[8 * s2 + 5]); a.w = cvt_pk_bf16(p0[8 * s2 + 6], p0[8 * s2 + 7]);
            c.x = cvt_pk_bf16(p1[8 * s2 + 0], p1[8 * s2 + 1]); c.y = cvt_pk_bf16(p1[8 * s2 + 2], p1[8 * s2 + 3]); c.z = cvt_pk_bf16(p1[8 * s2 + 4], p1[8 * s2 + 5]); c.w = cvt_pk_bf16(p1[8 * s2 + 6], p1[8 * s2 + 7]);
            pf[0][s2] = __builtin_bit_cast(bf16x8, a); pf[1][s2] = __builtin_bit_cast(bf16x8, c); }
#pragma unroll
        for (int db = 0; db < 2; ++db)
#pragma unroll
            for (int blk = 0; blk < 2; ++blk)
#pragma unroll
                for (int s2 = 0; s2 < 2; ++s2) {
                    bf16x8 vf;
#if USE_TR
                    const v4i16_t t0 = __builtin_amdgcn_ds_read_tr16_b64_v4i16((LAS v4i16_t*)(Vs + vbase + (32 * blk + 16 * s2) * VS + 64 * db));
                    const v4i16_t t1 = __builtin_amdgcn_ds_read_tr16_b64_v4i16((LAS v4i16_t*)(Vs + vbase + (32 * blk + 16 * s2 + 8) * VS + 64 * db));
                    vf = (bf16x8){t0[0], t0[1], t0[2], t0[3], t1[0], t1[1], t1[2], t1[3]};
#else
#pragma unroll
                    for (int j = 0; j < 8; ++j) vf[j] = *(const LAS short*)(Vs + (32 * blk + 16 * s2 + 8 * (j >> 2) + 4 * hi + (j & 3)) * VS + (32 * db + n) * 2);
#endif
                    if (db == 0) o0 = __builtin_amdgcn_mfma_f32_32x32x16_bf16(vf, pf[blk][s2], o0, 0, 0, 0); else o1 = __builtin_amdgcn_mfma_f32_32x32x16_bf16(vf, pf[blk][s2], o1, 0, 0, 0);
                }
    }
    const float lt = xor32_add(lsum), inv = 1.f / lt;
    bf16_t* op = O + (tokbase + qpos) * 512 + hq * 64 + 8 * hi;
#pragma unroll
    for (int db = 0; db < 2; ++db)
#pragma unroll
        for (int kp = 0; kp < 2; ++kp) { const int r0 = 8 * kp;
            unsigned ax, ay, bx, by;
            if (db == 0) { ax = cvt_pk_bf16(o0[r0] * inv, o0[r0 + 1] * inv); ay = cvt_pk_bf16(o0[r0 + 2] * inv, o0[r0 + 3] * inv); bx = cvt_pk_bf16(o0[r0 + 4] * inv, o0[r0 + 5] * inv); by = cvt_pk_bf16(o0[r0 + 6] * inv, o0[r0 + 7] * inv); }
            else { ax = cvt_pk_bf16(o1[r0] * inv, o1[r0 + 1] * inv); ay = cvt_pk_bf16(o1[r0 + 2] * inv, o1[r0 + 3] * inv); bx = cvt_pk_bf16(o1[r0 + 4] * inv, o1[r0 + 5] * inv); by = cvt_pk_bf16(o1[r0 + 6] * inv, o1[r0 + 7] * inv); }
            { auto r = __builtin_amdgcn_permlane32_swap(ax, bx, false, false); ax = r[0]; bx = r[1]; }
            { auto r = __builtin_amdgcn_permlane32_swap(ay, by, false, false); ay = r[0]; by = r[1]; }
            *(u32x4*)(op + 32 * db + 16 * kp) = (u32x4){ax, ay, bx, by}; }
#pragma unroll
    for (int s = 0; s < 4; ++s) P.qf[s] = qn[s];
    P.kreg = kreg; P.vreg = vreg; P.mreg = mreg;
}

struct SwaPre { bf16x8 qf[4]; u32x4 kreg[3], vreg[3]; };
__device__ __forceinline__ void swa_prefetch(const Frame& F, const bf16_t* __restrict__ PROJ, int b, int g, int qb, bf16x8 (&qf)[4], u32x4 (&kreg)[3], u32x4 (&vreg)[3]) {
    const int tid = F.tid, lane = F.lane, wid = F.wave, n = lane & 31, hi = lane >> 5;
    const int hq = 4 * g + (wid >> 1), qpos = qb * 64 + 32 * (wid & 1) + n;
    const size_t tokbase = (size_t)b * SEQ;
    const int srow = tid >> 3, sch = tid & 7;
#pragma unroll
    for (int i = 0; i < 3; ++i) { const int kt = qb - 2 + i;
        if (kt >= 0) { kreg[i] = *(const u32x4*)(PROJ + (tokbase + srow + (size_t)kt * 64) * PLD + C_KA + g * 64 + sch * 8); vreg[i] = *(const u32x4*)(PROJ + (tokbase + srow + (size_t)kt * 64) * PLD + C_VA + g * 64 + sch * 8); } }
    const bf16_t* qp = PROJ + (tokbase + qpos) * PLD + C_QA + hq * 64 + 8 * hi;
#pragma unroll
    for (int s = 0; s < 4; ++s) qf[s] = *(const bf16x8*)(qp + 16 * s);
}
__device__ __forceinline__ void swa_unit(const Frame& F, const bf16_t* __restrict__ PROJ, bf16_t* __restrict__ O, float sinkv  , int b, int g, int qb, SwaPre& P, int un  , bool pv = false) {
    const int tid = F.tid, lane = F.lane, wid = F.wave, n = lane & 31, hi = lane >> 5;
    const int hq = 4 * g + (wid >> 1), qpos = qb * 64 + 32 * (wid & 1) + n;
    const size_t tokbase = (size_t)b * SEQ;
    constexpr int TILE_B = 64 * KS + 64 * VS;
    bf16x8 qf[4], qn[4];
#pragma unroll
    for (int s = 0; s < 4; ++s) { qf[s] = P.qf[s]; qn[s] = P.qf[s]; }
    f32x16 o0, o1;
#pragma unroll
    for (int r = 0; r < 16; ++r) { o0[r] = 0.f; o1[r] = 0.f; }
    float mrun = sinkv * LOG2E, lsum = (hi == 0) ? 1.f : 0.f;
    const int srow = tid >> 3, sch = tid & 7;
    __syncthreads();
#pragma unroll
    for (int i = 0; i < 3; ++i) if (qb - 2 + i >= 0) { *(LAS u32x4*)(F.lds + i * TILE_B + srow * KS + sch * 16) = P.kreg[i]; *(LAS u32x4*)(F.lds + i * TILE_B + 64 * KS + srow * VS + sch * 16) = P.vreg[i]; }
    __syncthreads();
    if (un < 2048) { int nb, ng, nqb; attn_decode(un, nb, ng, nqb); swa_prefetch(F, PROJ, nb, ng, nqb, qn, P.kreg, P.vreg); }
    const int vbase = (4 * hi + ((lane & 15) >> 2)) * VS + (16 * ((lane >> 4) & 1) + 4 * (lane & 3)) * 2;
#pragma unroll 1
#if defined(IDX_PROBE) && (IDX_PROBE & 32)
    if (!pv)
#endif
    for (int i = (qb >= 2 ? 0 : 2 - qb); i < 3; ++i) { const int kt = qb - 2 + i;
        LAS unsigned char* Ks = F.lds + i * TILE_B; LAS unsigned char* Vs = Ks + 64 * KS;
        f32x16 p0, p1;
#pragma unroll
        for (int r = 0; r < 16; ++r) { p0[r] = 0.f; p1[r] = 0.f; }
#pragma unroll
        for (int s = 0; s < 4; ++s) { const bf16x8 k0 = *(const LAS bf16x8*)(Ks + n * KS + (16 * s + 8 * hi) * 2), k1 = *(const LAS bf16x8*)(Ks + (n + 32) * KS + (16 * s + 8 * hi) * 2);
            p0 = __builtin_amdgcn_mfma_f32_32x32x16_bf16(k0, qf[s], p0, 0, 0, 0); p1 = __builtin_amdgcn_mfma_f32_32x32x16_bf16(k1, qf[s], p1, 0, 0, 0); }
        unsigned w0 = 0u, w1 = 0u;
#pragma unroll
        for (int blk = 0; blk < 2; ++blk) { const int d0 = qpos - (kt * 64 + 32 * blk); unsigned mk = 0u;
            if (d0 >= 0) { const int hb = d0 > 31 ? 31 : d0; int lo = d0 - 127; if (lo <= 31) { if (lo < 0) lo = 0; mk = (0xFFFFFFFFu >> (31 - hb)) & (0xFFFFFFFFu << lo); } }
            if (blk == 0) w0 = mk >> (4 * hi); else w1 = mk >> (4 * hi); }
        float mx = fmaxf(fmaxf(p0[0], p0[1]), fmaxf(p1[0], p1[1]));
#pragma unroll
        for (int r = 2; r < 16; r += 2) mx = fmaxf(mx, fmaxf(fmaxf(p0[r], p0[r + 1]), fmaxf(p1[r], p1[r + 1])));
        mx = xor32_max(mx);
        const float mnew = fmaxf(mrun, mx), alpha = fexp2(mrun - mnew); mrun = mnew;
        float ps = 0.f;
#pragma unroll
        for (int r = 0; r < 16; ++r) { const int bitpos = 8 * (r >> 2) + (r & 3);
            const float e0 = fexp2(p0[r] - mnew), e1 = fexp2(p1[r] - mnew);
            p0[r] = __builtin_bit_cast(float, __builtin_bit_cast(unsigned, e0) & (unsigned)__builtin_amdgcn_sbfe((int)w0, bitpos, 1));
            p1[r] = __builtin_bit_cast(float, __builtin_bit_cast(unsigned, e1) & (unsigned)__builtin_amdgcn_sbfe((int)w1, bitpos, 1));
            ps += p0[r] + p1[r]; }
        lsum = lsum * alpha + ps;
        if (__builtin_amdgcn_ballot_w64(alpha != 1.f) != 0ull) {
#pragma unroll
            for (int r = 0; r < 16; ++r) { o0[r] *= alpha; o1[r] *= alpha; } }
        bf16x8 pf[2][2];
#pragma unroll
        for (int s2 = 0; s2 < 2; ++s2) { u32x4 a, c;
            a.x = cvt_pk_bf16(p0[8 * s2 + 0], p0[8 * s2 + 1]); a.y = cvt_pk_bf16(p0[8 * s2 + 2], p0[8 * s2 + 3]); a.z = cvt_pk_bf16(p0[8 * s2 + 4], p0[8 * s2 + 5]); a.w = cvt_pk_bf16(p0[8 * s2 + 6], p0[8 * s2 + 7]);
            c.x = cvt_pk_bf16(p1[8 * s2 + 0], p1[8 * s2 + 1]); c.y = cvt_pk_bf16(p1[8 * s2 + 2], p1[8 * s2 + 3]); c.z = cvt_pk_bf16(p1[8 * s2 + 4], p1[8 * s2 + 5]); c.w = cvt_pk_bf16(p1[8 * s2 + 6], p1[8 * s2 + 7]);
            pf[0][s2] = __builtin_bit_cast(bf16x8, a); pf[1][s2] = __builtin_bit_cast(bf16x8, c); }
#pragma unroll
        for (int db = 0; db < 2; ++db)
#pragma unroll
            for (int blk = 0; blk < 2; ++blk)
#pragma unroll
                for (int s2 = 0; s2 < 2; ++s2) {
                    const v4i16_t t0 = __builtin_amdgcn_ds_read_tr16_b64_v4i16((LAS v4i16_t*)(Vs + vbase + (32 * blk + 16 * s2) * VS + 64 * db));
                    const v4i16_t t1 = __builtin_amdgcn_ds_read_tr16_b64_v4i16((LAS v4i16_t*)(Vs + vbase + (32 * blk + 16 * s2 + 8) * VS + 64 * db));
                    const bf16x8 vf = (bf16x8){t0[0], t0[1], t0[2], t0[3], t1[0], t1[1], t1[2], t1[3]};
                    if (db == 0) o0 = __builtin_amdgcn_mfma_f32_32x32x16_bf16(vf, pf[blk][s2], o0, 0, 0, 0); else o1 = __builtin_amdgcn_mfma_f32_32x32x16_bf16(vf, pf[blk][s2], o1, 0, 0, 0);
                }
    }
    const float lt = xor32_add(lsum), inv = 1.f / lt;
    bf16_t* op = O + (tokbase + qpos) * 512 + hq * 64 + 8 * hi;
#pragma unroll
    for (int db = 0; db < 2; ++db)
#pragma unroll
        for (int kp = 0; kp < 2; ++kp) { const int r0 = 8 * kp;
            unsigned ax, ay, bx, by;
            if (db == 0) { ax = cvt_pk_bf16(o0[r0] * inv, o0[r0 + 1] * inv); ay = cvt_pk_bf16(o0[r0 + 2] * inv, o0[r0 + 3] * inv); bx = cvt_pk_bf16(o0[r0 + 4] * inv, o0[r0 + 5] * inv); by = cvt_pk_bf16(o0[r0 + 6] * inv, o0[r0 + 7] * inv); }
            else { ax = cvt_pk_bf16(o1[r0] * inv, o1[r0 + 1] * inv); ay = cvt_pk_bf16(o1[r0 + 2] * inv, o1[r0 + 3] * inv); bx = cvt_pk_bf16(o1[r0 + 4] * inv, o1[r0 + 5] * inv); by = cvt_pk_bf16(o1[r0 + 6] * inv, o1[r0 + 7] * inv); }
            { auto r = __builtin_amdgcn_permlane32_swap(ax, bx, false, false); ax = r[0]; bx = r[1]; }
            { auto r = __builtin_amdgcn_permlane32_swap(ay, by, false, false); ay = r[0]; by = r[1]; }
            *(u32x4*)(op + 32 * db + 16 * kp) = (u32x4){ax, ay, bx, by}; }
#pragma unroll
    for (int s = 0; s < 4; ++s) P.qf[s] = qn[s];
}

constexpr int SGS = 1040;
static_assert(128 * SGS <= MISC_OFF, "spatial-gating tile vs LDS control words");
__device__ __forceinline__ void sg_unit(const Frame& F, const bf16_t* __restrict__ PROJ, const bf16_t* __restrict__ SGWl, const float* __restrict__ sgb, const float* __restrict__ lng, bf16_t* __restrict__ OC, int b, int ch) {
    const int lane = F.lane, wid = F.wave, n = lane & 31, hi = lane >> 5;
    const size_t tok0 = (size_t)b * SEQ + ch * 128;
    LAS unsigned char* V = F.lds;
    __syncthreads();
    float gl[8];
    { const f32x4 g0 = *(const f32x4*)(lng + 8 * lane), g1 = *(const f32x4*)(lng + 8 * lane + 4); gl[0] = g0[0]; gl[1] = g0[1]; gl[2] = g0[2]; gl[3] = g0[3]; gl[4] = g1[0]; gl[5] = g1[1]; gl[6] = g1[2]; gl[7] = g1[3]; }
    u32x4 wrow16[16];
#pragma unroll
    for (int rr = 0; rr < 16; ++rr) wrow16[rr] = *(const u32x4*)(PROJ + (tok0 + 16 * wid + rr) * PLD + C_V + 8 * lane);
#pragma unroll
    for (int r4 = 0; r4 < 16; r4 += 4) { float x[4][8], s[4], q[4];
#pragma unroll
        for (int a = 0; a < 4; ++a) { const u32x4 w = wrow16[r4 + a];
            x[a][0] = bf_lo(w.x); x[a][1] = bf_hi(w.x); x[a][2] = bf_lo(w.y); x[a][3] = bf_hi(w.y); x[a][4] = bf_lo(w.z); x[a][5] = bf_hi(w.z); x[a][6] = bf_lo(w.w); x[a][7] = bf_hi(w.w);
            s[a] = ((x[a][0] + x[a][1]) + (x[a][2] + x[a][3])) + ((x[a][4] + x[a][5]) + (x[a][6] + x[a][7])); }
#pragma unroll
        for (int a = 0; a < 4; ++a) s[a] = wave_sum(s[a]) * (1.f / 512.f);
#pragma unroll
        for (int a = 0; a < 4; ++a) { q[a] = 0.f;
#pragma unroll
            for (int i = 0; i < 8; ++i) { x[a][i] -= s[a]; q[a] += x[a][i] * x[a][i]; } }
#pragma unroll
        for (int a = 0; a < 4; ++a) q[a] = wave_sum(q[a]);
#pragma unroll
        for (int a = 0; a < 4; ++a) { const int row = 16 * wid + r4 + a; const float rstd = 1.f / sqrtf(q[a] * (1.f / 512.f) + LN_EPS);
            u32x4 o; o.x = cvt_pk_bf16(x[a][0] * rstd * gl[0], x[a][1] * rstd * gl[1]); o.y = cvt_pk_bf16(x[a][2] * rstd * gl[2], x[a][3] * rstd * gl[3]);
            o.z = cvt_pk_bf16(x[a][4] * rstd * gl[4], x[a][5] * rstd * gl[5]); o.w = cvt_pk_bf16(x[a][6] * rstd * gl[6], x[a][7] * rstd * gl[7]);
            *(LAS u32x4*)(V + row * SGS + 16 * lane) = o; } }
    __syncthreads();
    const int g = wid;
    const int vbase = (8 * hi + ((lane & 15) >> 2)) * SGS + (g * 64 + 16 * ((lane >> 4) & 1) + 4 * (lane & 3)) * 2;
    const bf16_t* wg = SGWl + (size_t)g * 128 * 128;
#pragma unroll
    for (int tb = 0; tb < 4; ++tb) {
        f32x16 a0, a1;
#pragma unroll
        for (int r = 0; r < 16; ++r) { a0[r] = 0.f; a1[r] = 0.f; }
        const bf16_t* wrow = wg + (size_t)(32 * tb + n) * 128 + 8 * hi;
        bf16x8 afr[8];
#pragma unroll
        for (int ks = 0; ks < 8; ++ks) if (ks < 2 * tb + 2) afr[ks] = *(const bf16x8*)(wrow + 16 * ks);
        const int t = 32 * tb + n;
        const float bb = sgb[g * 128 + t];
        u32x2 uu[2][4];
        { const bf16_t* up = PROJ + (tok0 + t) * PLD + C_U + g * 64 + 4 * hi;
#pragma unroll
          for (int db = 0; db < 2; ++db)
#pragma unroll
              for (int q4 = 0; q4 < 4; ++q4) uu[db][q4] = *(const u32x2*)(up + 32 * db + 8 * q4); }
#pragma unroll
        for (int ks = 0; ks < 8; ++ks) if (ks < 2 * tb + 2) {
            const bf16x8 af = afr[ks];
#pragma unroll
            for (int db = 0; db < 2; ++db) { bf16x8 vf;
#if USE_TR
                const v4i16_t t0 = __builtin_amdgcn_ds_read_tr16_b64_v4i16((LAS v4i16_t*)(V + vbase + (16 * ks) * SGS + 64 * db));
                const v4i16_t t1 = __builtin_amdgcn_ds_read_tr16_b64_v4i16((LAS v4i16_t*)(V + vbase + (16 * ks + 4) * SGS + 64 * db));
                vf = (bf16x8){t0[0], t0[1], t0[2], t0[3], t1[0], t1[1], t1[2], t1[3]};
#else
#pragma unroll
                for (int j = 0; j < 8; ++j) vf[j] = *(const LAS short*)(V + (16 * ks + 8 * hi + j) * SGS + (g * 64 + 32 * db + n) * 2);
#endif
                if (db == 0) a0 = __builtin_amdgcn_mfma_f32_32x32x16_bf16(vf, af, a0, 0, 0, 0); else a1 = __builtin_amdgcn_mfma_f32_32x32x16_bf16(vf, af, a1, 0, 0, 0); }
        }
        bf16_t* op = OC + (tok0 + t) * 512 + g * 64 + 8 * hi;
#pragma unroll
        for (int db = 0; db < 2; ++db)
#pragma unroll
            for (int kp = 0; kp < 2; ++kp) { const int r0 = 8 * kp; float v[8];
#pragma unroll
                for (int i = 0; i < 8; ++i) { const u32x2 uw = uu[db][2 * kp + (i >> 2)]; const unsigned wd = (i & 2) ? uw.y : uw.x; const float uf = (i & 1) ? bf_hi(wd) : bf_lo(wd);
                    v[i] = ((db == 0 ? a0[r0 + i] : a1[r0 + i]) + bb) * uf; }
                unsigned ax = cvt_pk_bf16(v[0], v[1]), ay = cvt_pk_bf16(v[2], v[3]), bx = cvt_pk_bf16(v[4], v[5]), by = cvt_pk_bf16(v[6], v[7]);
                { auto r = __builtin_amdgcn_permlane32_swap(ax, bx, false, false); ax = r[0]; bx = r[1]; }
                { auto r = __builtin_amdgcn_permlane32_swap(ay, by, false, false); ay = r[0]; by = r[1]; }
                *(u32x4*)(op + 32 * db + 16 * kp) = (u32x4){ax, ay, bx, by}; }
    }
}
constexpr int HS_STRIDE = 2064;
constexpr int P7_PART = 32 * HS_STRIDE;
constexpr int P7_LOG = P7_PART + 8 * 4096;
constexpr int P7_HIST = P7_LOG + 32 * 33 * 4;
constexpr int P7_TOKB = P7_HIST + 256;
static_assert(P7_TOKB + 32 * 32 * 4 * 4 <= 134144, "route LDS map");
__device__ __forceinline__ void p7_route(const Frame& F, const Args& a, int l, bf16_t* X16  , const bf16_t* Y, const float* SSP, const float* MODl, signed char* H8, float* RS,
                                         const bf16_t* WRTl, unsigned* cnt, int* ROWTOK, unsigned* TOKINFO) {
    const int tid = F.tid, lane = F.lane, wid = F.wave, n = lane & 31, hi = lane >> 5;
    const float* g_post = a.in[5] + l * DM; const float* g_pre = a.in[6] + l * DM; const float* b_router = a.in[16] + l * NE;
    LAS unsigned char* hs = F.lds; LAS float* part = (LAS float*)(F.lds + P7_PART); LAS float* lg = (LAS float*)(F.lds + P7_LOG); LAS int* hist = (LAS int*)(F.lds + P7_HIST); LAS int* base = hist + 32;
    if (tid < 32) hist[tid] = 0;
    __syncthreads();
    const int NBT = MTOK / 32, bt0 = (int)((long)NBT * F.vcu / F.G), bt1 = (int)((long)NBT * (F.vcu + 1) / F.G);
    bf16x8 wbf[8];
#pragma unroll
    for (int ks = 0; ks < 8; ++ks) wbf[ks] = *(const bf16x8*)(WRTl + (size_t)n * DM + (8 * wid + ks) * 16 + 8 * hi);
    const float brv = b_router[tid & 31];
    f32x4 A1[4], A2[4], A3[4]; int bcur = (bt0 < NBT ? bt0 : NBT - 1) >> 6;
#define P7_PARAMS(b_) do { const float* mb_ = MODl + (size_t)(b_) * 6 * DM; _Pragma("unroll") for (int j = 0; j < 4; ++j) { const int c = 4 * lane + 256 * j; \
        const f32x4 gp = *(const f32x4*)(g_post + c), ga = *(const f32x4*)(mb_ + 2 * DM + c), gg = *(const f32x4*)(g_pre + c), s1 = *(const f32x4*)(mb_ + 4 * DM + c), s0 = *(const f32x4*)(mb_ + 3 * DM + c); \
        A1[j] = ga * gp; A2[j] = gg * (s1 + 1.f); A3[j] = s0; } } while (0)
    P7_PARAMS(bcur);
    u32x2 yv[4][4], xv[4][4]; float s4v[4];
#define P7_LOAD(bt_) do { _Pragma("unroll") for (int rr = 0; rr < 4; ++rr) { const size_t row = (size_t)(bt_) * 32 + 4 * wid + rr; s4v[rr] = SSP[(size_t)(lane & 15) * MTOK + row]; \
        _Pragma("unroll") for (int j = 0; j < 4; ++j) { const int c = 4 * lane + 256 * j; yv[rr][j] = __builtin_nontemporal_load((const u32x2*)(Y + row * DM + c)); xv[rr][j] = __builtin_nontemporal_load((const u32x2*)(X16 + row * DM + c)); } } } while (0)
    P7_LOAD(bt0 < NBT ? bt0 : NBT - 1);
    LAS unsigned* tokb = (LAS unsigned*)(F.lds + P7_TOKB); int btf = bt0;
    for (int bt = bt0; bt < bt1; ++bt) {
        const int row0 = bt * 32, b = row0 >> 11;
        if (b != bcur) { bcur = b; P7_PARAMS(b); }
#pragma unroll
        for (int rr = 0; rr < 4; ++rr) { const int rl = 4 * wid + rr; const size_t row = (size_t)row0 + rl;
            float ssy = s4v[rr]; ssy += dpp_f<0xB1>(ssy); ssy += dpp_f<0x4E>(ssy); ssy += dpp_f<0x141>(ssy); ssy += dpp_f<0x140>(ssy);
            const float rstd1 = 1.f / sqrtf(ssy * (1.f / DM) + RMS_EPS);
            f32x4 v[4]; float ss = 0.f;
#pragma unroll
            for (int j = 0; j < 4; ++j) { const int c = 4 * lane + 256 * j; const u32x2 yw_ = yv[rr][j]; const u32x2 xw_ = xv[rr][j]; const f32x4 yy = {bf_lo(yw_.x), bf_hi(yw_.x), bf_lo(yw_.y), bf_hi(yw_.y)}, xx = {bf_lo(xw_.x), bf_hi(xw_.x), bf_lo(xw_.y), bf_hi(xw_.y)};
                v[j] = xx + A1[j] * (yy * rstd1); { u32x2 xo; xo.x = cvt_pk_bf16(v[j][0], v[j][1]); xo.y = cvt_pk_bf16(v[j][2], v[j][3]); *(u32x2*)(X16 + row * DM + c) = xo; }
                ss += (v[j][0] * v[j][0] + v[j][1] * v[j][1]) + (v[j][2] * v[j][2] + v[j][3] * v[j][3]); }
            ss = wave_sum(ss);
            const float rstd = 1.f / sqrtf(ss * (1.f / DM) + RMS_EPS);
            f32x4 o[4]; float am = 0.f;
#pragma unroll
            for (int j = 0; j < 4; ++j) { const int c = 4 * lane + 256 * j;
                o[j] = (v[j] * rstd) * A2[j] + A3[j]; u32x2 w; w.x = cvt_pk_bf16(o[j][0], o[j][1]); w.y = cvt_pk_bf16(o[j][2], o[j][3]);
                *(LAS u32x2*)(hs + rl * HS_STRIDE + c * 2) = w;
                am = fmaxf(am, fmaxf(fmaxf(fabsf(o[j][0]), fabsf(o[j][1])), fmaxf(fabsf(o[j][2]), fabsf(o[j][3])))); }
            am = wave_max(am);
            const float scale = fmaxf(am, 1e-30f) * (1.f / 127.f), inv = 1.f / scale;
            if (lane == 0) RS[row] = scale;
#pragma unroll
            for (int j = 0; j < 4; ++j) *(unsigned*)(H8 + row * DM + 4 * lane + 256 * j) = q8x4(o[j][0], o[j][1], o[j][2], o[j][3], inv); }
        if (bt + 1 < bt1) P7_LOAD(bt + 1);
        lds_barrier();
        {
            f32x16 d;
#pragma unroll
            for (int r = 0; r < 16; ++r) d[r] = 0.f;
#pragma unroll
            for (int ks = 0; ks < 8; ++ks) { const int k0 = (8 * wid + ks) * 16 + 8 * hi;
                const bf16x8 af = *(const LAS bf16x8*)(hs + n * HS_STRIDE + k0 * 2);
                d = __builtin_amdgcn_mfma_f32_32x32x16_bf16(af, wbf[ks], d, 0, 0, 0); }
#pragma unroll
            for (int r = 0; r < 16; ++r) part[wid * 1024 + (8 * (r >> 2) + 4 * hi + (r & 3)) * 32 + n] = d[r];
        }
        lds_barrier();
        for (int i = tid; i < 1024; i += 512) { float s = brv;
#pragma unroll
            for (int w = 0; w < 8; ++w) s += part[w * 1024 + i]; lg[(i >> 5) * 33 + (i & 31)] = s; }
        lds_barrier();
        int e_k[4] = {0, 0, 0, 0}, lp_k[4] = {0, 0, 0, 0}; float w_k[4] = {0.f, 0.f, 0.f, 0.f};
        if (tid < 32) { LAS float* mylg = lg + tid * 33; float tl[4];
#pragma unroll
            for (int k = 0; k < 4; ++k) { float best = -INFINITY; int bi = 0;
                for (int e = 0; e < 32; ++e) { const float vv = mylg[e]; if (vv > best) { best = vv; bi = e; } }
                tl[k] = best; e_k[k] = bi; mylg[bi] = -INFINITY; }
            float sum = 0.f;
#pragma unroll
            for (int k = 0; k < 4; ++k) { w_k[k] = __expf(tl[k] - tl[0]); sum += w_k[k]; }
            const float inv = 1.f / sum;
#pragma unroll
            for (int k = 0; k < 4; ++k) { w_k[k] *= inv; lp_k[k] = __hip_atomic_fetch_add(&hist[e_k[k]], 1, __ATOMIC_RELAXED, __HIP_MEMORY_SCOPE_WORKGROUP); }
            const int token = row0 + tid, tl_ = (bt - btf) * 32 + tid; u32x4 pk; f32x4 ww;
#pragma unroll
            for (int k = 0; k < 4; ++k) { pk[k] = ((unsigned)e_k[k] << 17) | (unsigned)lp_k[k]; ww[k] = w_k[k]; }
            *(LAS u32x4*)(tokb + tl_ * 4) = pk; *(f32x4*)(TOKINFO + (size_t)token * 8 + 4) = ww; }
        lds_barrier();
        if (bt + 1 == bt1 || bt + 1 - btf == 32) {
            if (tid < 32) { const int hc = hist[tid]; base[tid] = hc > 0 ? (int)__hip_atomic_fetch_add(cnt + 64 * tid, (unsigned)hc, __ATOMIC_RELAXED, __HIP_MEMORY_SCOPE_AGENT) : 0; hist[tid] = 0; }
            lds_barrier();
            const int npend = (bt + 1 - btf) * 128;
            for (int i = tid; i < npend; i += 512) { const unsigned pk = tokb[i]; const int e = (int)(pk >> 17), pos = base[e] + (int)(pk & 0x1ffffu), token = btf * 32 + (i >> 2);
                ROWTOK[e * 65536 + pos] = token; TOKINFO[(size_t)token * 8 + (i & 3)] = ((unsigned)e << 17) | (unsigned)pos; }
            btf = bt + 1;
            lds_barrier();
        }
    }
#undef P7_PARAMS
#undef P7_LOAD
}

__device__ __forceinline__ int moe_tables(const Frame& F, unsigned* cnt) {
    LAS int* ts = (LAS int*)(F.lds + TS_OFF); LAS int* te = (LAS int*)(F.lds + TILE_E_OFF);
    __syncthreads();
    if (F.tid == 0) { int acc = 0; for (int e = 0; e < NE; ++e) { ts[e] = acc; const unsigned c = __hip_atomic_load(cnt + 64 * e, __ATOMIC_RELAXED, __HIP_MEMORY_SCOPE_AGENT); acc += (int)((c + 255u) >> 8); } ts[NE] = acc; }
    __syncthreads();
    const int RT = ts[NE];
    for (int rt = F.tid; rt < RT; rt += 512) { int e = 0;
#pragma unroll 1
        for (int q = 1; q < NE; ++q) e += (ts[q] <= rt) ? 1 : 0;
        te[rt] = e; }
    __syncthreads();
    return RT;
}

__device__ __forceinline__ void p10_combine(const Frame& F, const Args& a, int l, bf16_t* X16, float* out, const bf16_t* Y2, const unsigned* TOKINFO, const float* MODbase, signed char* H8, float* RS) {
    const int lane = F.lane; const LAS int* ts = (const LAS int*)(F.lds + TS_OFF);
    const float* g_postf = a.in[7] + l * DM;
    const int gw = F.vcu * 8 + F.wave, NGW = F.G * 8;
    const int r_lo = (int)((long)(MTOK / 2) * gw / NGW) * 2, r_hi = (int)((long)(MTOK / 2) * (gw + 1) / NGW) * 2;
    f32x4 A1[4], N2[4], N3[4]; int bcur = (r_lo < MTOK ? r_lo : MTOK - 1) >> 11;
#define P10_PARAMS(b_) do { const float* mb_ = MODbase + ((size_t)l * BATCH + (b_)) * 6 * DM; const float* mb1_ = MODbase + ((size_t)(l + 1 < DEPTH ? l + 1 : l) * BATCH + (b_)) * 6 * DM; const float* g1_ = a.in[4] + (l + 1 < DEPTH ? l + 1 : l) * DM; \
        _Pragma("unroll") for (int j = 0; j < 4; ++j) { const int c = 4 * lane + 256 * j; const f32x4 gp = *(const f32x4*)(g_postf + c), ga = *(const f32x4*)(mb_ + 5 * DM + c); A1[j] = ga * gp; \
            const f32x4 gg = *(const f32x4*)(g1_ + c), s1 = *(const f32x4*)(mb1_ + DM + c), s0 = *(const f32x4*)(mb1_ + c); N2[j] = gg * (s1 + 1.f); N3[j] = s0; } } while (0)
    P10_PARAMS(bcur);
    for (int rowp = r_lo; rowp < r_hi; rowp += 2) {
        if ((rowp >> 11) != bcur) { bcur = rowp >> 11; P10_PARAMS(bcur); }
        u32x4 info[2]; f32x4 ww[2]; u32x2 yw[2][4][4], xv[2][4];
#pragma unroll
        for (int rr = 0; rr < 2; ++rr) { info[rr] = *(const u32x4*)(TOKINFO + (size_t)(rowp + rr) * 8); ww[rr] = *(const f32x4*)(TOKINFO + (size_t)(rowp + rr) * 8 + 4); }
#pragma unroll
        for (int rr = 0; rr < 2; ++rr) {
#pragma unroll
            for (int k = 0; k < 4; ++k) { const int e = (int)(info[rr][k] >> 17), pos = (int)(info[rr][k] & 0x1ffffu); const size_t slot = (size_t)ts[e] * 256 + pos;
#pragma unroll
                for (int j = 0; j < 4; ++j) yw[rr][k][j] = __builtin_nontemporal_load((const u32x2*)(Y2 + slot * DM + 4 * lane + 256 * j)); }
#pragma unroll
            for (int j = 0; j < 4; ++j) xv[rr][j] = *(const u32x2*)(X16 + (size_t)(rowp + rr) * DM + 4 * lane + 256 * j); }
#pragma unroll
        for (int rr = 0; rr < 2; ++rr) { const int row = rowp + rr, b = row >> 11;
        f32x4 y[4];
#pragma unroll
        for (int j = 0; j < 4; ++j) y[j] = (f32x4){0.f, 0.f, 0.f, 0.f};
#pragma unroll
        for (int k = 0; k < 4; ++k) { const float wk = ww[rr][k];
#pragma unroll
            for (int j = 0; j < 4; ++j) { const u32x2 w = yw[rr][k][j];
                y[j][0] += wk * bf_lo(w.x); y[j][1] += wk * bf_hi(w.x); y[j][2] += wk * bf_lo(w.y); y[j][3] += wk * bf_hi(w.y); } }
        float ss = 0.f;
#pragma unroll
        for (int j = 0; j < 4; ++j) ss += (y[j][0] * y[j][0] + y[j][1] * y[j][1]) + (y[j][2] * y[j][2] + y[j][3] * y[j][3]);
        ss = wave_sum(ss);
        const float rstd = 1.f / sqrtf(ss * (1.f / DM) + RMS_EPS);
        f32x4 v[4]; float s2 = 0.f;
#pragma unroll
        for (int j = 0; j < 4; ++j) { const int c = 4 * lane + 256 * j; const u32x2 xw_ = xv[rr][j]; const f32x4 xx = {bf_lo(xw_.x), bf_hi(xw_.x), bf_lo(xw_.y), bf_hi(xw_.y)};
            v[j] = xx + A1[j] * (y[j] * rstd);
#ifdef T_STAMP
            if (l + 1 == DEPTH) v[j] = v[j] * (1.f + (float)(*((const unsigned*)MODbase - (1u << 18) + 100)) * (1.f / 256.f));
#endif
            if (l + 1 < DEPTH) { u32x2 xo; xo.x = cvt_pk_bf16(v[j][0], v[j][1]); xo.y = cvt_pk_bf16(v[j][2], v[j][3]); *(u32x2*)(X16 + (size_t)row * DM + c) = xo; }
            else *(f32x4*)(out + (size_t)row * DM + c) = v[j];
            s2 += (v[j][0] * v[j][0] + v[j][1] * v[j][1]) + (v[j][2] * v[j][2] + v[j][3] * v[j][3]); }
        if (l + 1 < DEPTH) { s2 = wave_sum(s2);
            const float rstd2 = 1.f / sqrtf(s2 * (1.f / DM) + RMS_EPS); f32x4 o[4]; float am = 0.f;
#pragma unroll
            for (int j = 0; j < 4; ++j) { o[j] = (v[j] * rstd2) * N2[j] + N3[j]; am = fmaxf(am, fmaxf(fmaxf(fabsf(o[j][0]), fabsf(o[j][1])), fmaxf(fabsf(o[j][2]), fabsf(o[j][3])))); }
            am = wave_max(am);
            const float scale = fmaxf(am, 1e-30f) * (1.f / 127.f), inv = 1.f / scale;
            if (lane == 0) RS[row] = scale;
#pragma unroll
            for (int j = 0; j < 4; ++j) *(unsigned*)(H8 + (size_t)row * DM + 4 * lane + 256 * j) = q8x4(o[j][0], o[j][1], o[j][2], o[j][3], inv); }
        }
    }
#undef P10_PARAMS
}
#ifndef MK_ONE_LAUNCH
#define MK_ONE_LAUNCH 1
#endif
constexpr int N_PHASES = 2 + 9 * DEPTH;
__global__ void __launch_bounds__(512, 2) fwd(Args args) {
    extern __shared__ __attribute__((aligned(16))) unsigned char lds_raw[];
    Frame F0;
    F0.lds = (LAS unsigned char*)lds_raw;
    F0.tid = threadIdx.x; F0.lane = F0.tid & 63; F0.wave = __builtin_amdgcn_readfirstlane(F0.tid >> 6);
    F0.G = gridDim.x; { const int bx = blockIdx.x; F0.vcu = (F0.G % 8 == 0) ? (bx % 8) * (F0.G / 8) + bx / 8 : bx; }
    volatile LAS unsigned* MISC = (volatile LAS unsigned*)(F0.lds + MISC_OFF);
    for (int u = F0.tid; u < 128; u += 512) MISC[u] = 0u;
    __syncthreads();
    unsigned* ctl = (unsigned*)(args.ws + WS_CTL);
    const int lo = args.ph_lo, hi = args.ph_hi;
    XcdBarrier bar; bar.bar = ctl + CW_BAR; bar.x = 0; bar.st = nullptr; bar.w = F0.wave;
    if (hi - lo > 1) bar = xcd_barrier_post(ctl + CW_BAR, MISC + 8, F0.wave);
#ifndef PHASE_MASK
#define PHASE_MASK 0x7ff
#endif
#define PHON(j) ((PHASE_MASK >> (j)) & 1)
#ifndef REPEAT_MASK
#define REPEAT_MASK 0
#endif
#define REP(j) for (int rep_ = 0; rep_ <= ((REPEAT_MASK >> (j)) & 1); ++rep_)
#define IN(k) (lo <= (k) && (k) < hi)
#define BOTH(k) (IN(k) && IN((k) + 1))
#define GRID_BAR() xcd_barrier(bar)
#define PH_BEGIN() const Frame F = phase_frame(F0); unsigned char* ws = opq(args.ws); (void)ws
    if (PHON(0) && IN(0)) REP(0) { PH_BEGIN(); p0_mod(F, args.in[1], args.in[2], args.in[3], (float*)(ws + WS_MOD)); p0_weights(F, args); if (BOTH(0)) GRID_BAR(); }
    if (PHON(1) && IN(1)) REP(1) { PH_BEGIN(); p1_norm(F, args.in[0], args.in[4], (const float*)(ws + WS_MOD), (signed char*)(ws + WS_H), (float*)(ws + WS_RS), (bf16_t*)(ws + WS_X)); if (BOTH(1)) GRID_BAR(); }

#pragma unroll 1
#ifndef EXTRA_PHASE
#define EXTRA_PHASE (-1)
#endif
#ifdef SKIP_EPI_PROBE
#define SKIPV ex_
#else
#define SKIPV false
#endif
#ifndef STAG_MASK
#define STAG_MASK 0
#endif
#ifndef STAG_MODE
#define STAG_MODE 0
#endif
#ifndef STAG_TICKS
#define STAG_TICKS 240
#endif
#define STAGGER(j) do { if ((STAG_MASK >> (j)) & 1) { const unsigned long long t0_ = __builtin_amdgcn_s_memrealtime(), dl_ = (unsigned long long)(STAG_MODE ? (F.vcu % (F.G / 8)) : (F.vcu / (F.G / 8))) * STAG_TICKS; while (__builtin_amdgcn_s_memrealtime() - t0_ < dl_) __builtin_amdgcn_s_sleep(8); } } while (0)
#ifndef EXTRA_MASK
#define EXTRA_MASK (EXTRA_PHASE >= 0 ? (1 << EXTRA_PHASE) : 0)
#endif
#define EXOK(j) (EXTRA_MASK == 0 || !ex_ || ((EXTRA_MASK >> (j)) & 1))
    for (int it_ = 0; it_ < DEPTH + (EXTRA_MASK != 0 ? 1 : 0); ++it_) {
        const int l = it_ < DEPTH ? it_ : DEPTH - 1; const bool ex_ = it_ >= DEPTH; (void)ex_;
        const int pb = 2 + 9 * l;
        if (PHON(2) && EXOK(2) && IN(pb + 0)) REP(2) { PH_BEGIN();
            pg8::Gemm g{(const bf16_t*)(ws + WS_H), (const bf16_t*)(ws + WS_W + (size_t)l * W_LAYER + WO_WIN), DM}; g.skip_epi = SKIPV; pg8::StaticOrder<MTOK / 256, NPROJ / 256> S; S.init(F.G, (int)blockIdx.x);
            EpiProj E{(bf16_t*)(ws + WS_PROJ), (unsigned char*)(ws + WS_GATES), (const float*)(ws + WS_RS), (const float*)(ws + WS_CSIN) + (size_t)l * NPROJ}; E.pv = ex_;
            STAGGER(2); pg8::gemm_phase<EpiProj, pg8::StaticOrder<MTOK / 256, NPROJ / 256>, false, true>(F.lds, g, S, E, F.wave);
            if (BOTH(pb + 0)) GRID_BAR();
        }
        if (PHON(3) && EXOK(3) && IN(pb + 1)) REP(3) {
#ifndef SUBREP
#define SUBREP 0
#endif
#ifndef IDX_PROBE
#define IDX_PROBE 0
#endif
            if (!((IDX_PROBE & 8) && ex_))
            { const Frame Fa = phase_frame(F0); const bf16_t* PROJa = (const bf16_t*)(opq(args.ws) + WS_PROJ); bf16_t* OAa = (bf16_t*)(opq(args.ws) + WS_O);
            SwaPre Pa;
#pragma unroll
            for (int i_ = 0; i_ < 3; ++i_) { Pa.kreg[i_] = (u32x4){0u, 0u, 0u, 0u}; Pa.vreg[i_] = (u32x4){0u, 0u, 0u, 0u}; }
            { int b_, g_, qb_; attn_decode(Fa.vcu < 2048 ? Fa.vcu : 2047, b_, g_, qb_); swa_prefetch(Fa, PROJa, b_, g_, qb_, Pa.qf, Pa.kreg, Pa.vreg); }
            const float sk0_ = args.in[9][l * 8 + (Fa.wave >> 1)], sk1_ = args.in[9][l * 8 + 4 + (Fa.wave >> 1)];
            for (int u = Fa.vcu; u < 2048; u += Fa.G) { int b_, g_, qb_; attn_decode(u, b_, g_, qb_);
                swa_unit(Fa, PROJa, OAa, g_ ? sk1_ : sk0_, b_, g_, qb_, Pa, u + Fa.G, ex_); } }
            if (!((IDX_PROBE & 16) && ex_))
            { const Frame Fb = phase_frame(F0); unsigned char* wsb = opq(args.ws);
            for (int u = Fb.vcu; u < 512; u += Fb.G)
                sg_unit(Fb, (const bf16_t*)(wsb + WS_PROJ), (const bf16_t*)(wsb + WS_SGW) + (size_t)l * 8 * 128 * 128, args.in[11] + l * 8 * 128, args.in[12] + l * 512, (bf16_t*)(wsb + WS_O) + (size_t)2 * MTOK * 512, u >> 4, u & 15); }
            __syncthreads();
            if (!((IDX_PROBE & 4) && ex_))
            { const Frame Fi = phase_frame(F0); unsigned char* wsi = opq(args.ws);
              dsa_index_phase(Fi, (const bf16_t*)(wsi + WS_PROJ), (unsigned long long*)(wsi + WS_BITS), l == 0 ? (unsigned*)(wsi + WS_CTL) + 100 : nullptr, ex_); }
            if (BOTH(pb + 1)) GRID_BAR();
        }
        if (PHON(4) && EXOK(4) && IN(pb + 2)) REP(4) { PH_BEGIN();
            AttnPre Pd; { int b_, g_, qb_; attn_decode(F.vcu < 2048 ? F.vcu : 2047, b_, g_, qb_); attn_prefetch<1>(F, (const bf16_t*)(ws + WS_PROJ), (const unsigned*)(ws + WS_BITS), b_, g_, qb_, Pd.qf, Pd.kreg, Pd.vreg, Pd.mreg); }
            for (int u = F.vcu; u < 2048; u += F.G) { int b_, g_, qb_; attn_decode(u, b_, g_, qb_);
                attn_unit<1>(F, (const bf16_t*)(ws + WS_PROJ), (bf16_t*)(ws + WS_O) + (size_t)MTOK * 512, (const unsigned*)(ws + WS_BITS), nullptr, b_, g_, qb_, Pd, u + F.G); }
            __syncthreads();
            if (BOTH(pb + 2)) GRID_BAR();
        }
        if (PHON(5) && EXOK(5) && IN(pb + 3)) REP(5) { PH_BEGIN();
            pg8::Gemm g{(const bf16_t*)(ws + WS_O), (const bf16_t*)(ws + WS_W + (size_t)l * W_LAYER + WO_WBR), 512}; g.skip_epi = SKIPV; BranchOrder S; S.so.init(F.G, (int)blockIdx.x);
            EpiBranch E{(const unsigned char*)(ws + WS_GATES), (bf16_t*)(ws + WS_H)};
            STAGGER(5); pg8::gemm_phase<EpiBranch, BranchOrder, false>(F.lds, g, S, E, F.wave);
            if (BOTH(pb + 3)) GRID_BAR();
        }
        if (PHON(6) && EXOK(6) && IN(pb + 4)) REP(6) { PH_BEGIN();
            pg8::Gemm g{(const bf16_t*)(ws + WS_H), (const bf16_t*)(ws + WS_W + (size_t)l * W_LAYER + WO_WOUT), DM}; g.skip_epi = SKIPV; pg8::StaticOrder<MTOK / 256, DM / 256> S; S.init(F.G, (int)blockIdx.x);
            EpiWout E{(bf16_t*)(ws + WS_Y), (float*)(ws + WS_SSP)}; E.pv = ex_;
            STAGGER(6); pg8::gemm_phase<EpiWout, pg8::StaticOrder<MTOK / 256, DM / 256>, false>(F.lds, g, S, E, F.wave);
            if (BOTH(pb + 4)) GRID_BAR();
        }
        if (PHON(7) && EXOK(7) && IN(pb + 5)) REP(7) { PH_BEGIN();
            p7_route(F, args, l, (bf16_t*)(ws + WS_X), (const bf16_t*)(ws + WS_Y), (const float*)(ws + WS_SSP), (const float*)(ws + WS_MOD) + (size_t)l * BATCH * 6 * DM, (signed char*)(ws + WS_H), (float*)(ws + WS_RS),
                     (const bf16_t*)(ws + WS_WRT) + (size_t)l * NE * DM, (unsigned*)(ws + WS_CTL) + CW_CNT + l * 32 * 64, (int*)(ws + WS_ROWTOK), (unsigned*)(ws + WS_TOKINFO));
            if (BOTH(pb + 5)) GRID_BAR();
        }
        if (PHON(8) && EXOK(8) && IN(pb + 6)) REP(8) { PH_BEGIN();
            unsigned* cnt = (unsigned*)(ws + WS_CTL) + CW_CNT + l * 32 * 64; const int* ROWTOK = (const int*)(ws + WS_ROWTOK);
            const int RT = moe_tables(F, cnt);
            LAS int* ts = (LAS int*)(F.lds + TS_OFF); LAS int* te = (LAS int*)(F.lds + TILE_E_OFF); LAS int* ri = (LAS int*)(F.lds + ROWIDX_OFF);
            const long U = (long)RT * 8; MoeOrder S; S.u0 = (int)(U * F.vcu / F.G); S.u1 = (int)(U * (F.vcu + 1) / F.G); S.NB = 8; S.rt_lo = S.u0 / 8; S.tile_e = te; S.rowidx = ri;
            if (S.u1 > S.u0) { const int rt_hi = (S.u1 - 1) / 8; int ntile = rt_hi - S.rt_lo + 1; if (ntile > 8) ntile = 8;
                for (int i = F.tid; i < ntile * 256; i += 512) { const int rt = S.rt_lo + (i >> 8), r = i & 255, e = te[rt], first = (rt - ts[e]) * 256 + r;
                    const int c = (int)__hip_atomic_load(cnt + 64 * e, __ATOMIC_RELAXED, __HIP_MEMORY_SCOPE_AGENT); ri[i] = first < c ? ROWTOK[e * 65536 + first] : 0; } }
            __syncthreads();
            pg8::Gemm g{(const bf16_t*)(ws + WS_H), (const bf16_t*)(ws + WS_W + (size_t)l * W_LAYER + WO_W1), DM}; g.skip_epi = SKIPV;
            EpiW1I8 E{(signed char*)(ws + WS_ACT), args.in[18] + (size_t)l * NE * 2 * FF, (const float*)(ws + WS_RS), (const float*)(ws + WS_CS1) + (size_t)l * NE * 2048, ri, S.rt_lo};
            STAGGER(8); pg8::gemm_phase<EpiW1I8, MoeOrder, true, true>(F.lds, g, S, E, F.wave);
            if (BOTH(pb + 6)) GRID_BAR();
        }
        if (PHON(9) && EXOK(9) && IN(pb + 7)) REP(9) { PH_BEGIN();
            const int RT = moe_tables(F, (unsigned*)(ws + WS_CTL) + CW_CNT + l * 32 * 64);
            const long U = (long)RT * 4; MoeOrder S; S.u0 = (int)(U * F.vcu / F.G); S.u1 = (int)(U * (F.vcu + 1) / F.G); S.NB = 4; S.rt_lo = 0; S.tile_e = (LAS int*)(F.lds + TILE_E_OFF); S.rowidx = nullptr;
            pg8::Gemm g{(const bf16_t*)(ws + WS_ACT), (const bf16_t*)(ws + WS_W + (size_t)l * W_LAYER + WO_W2), FF}; g.skip_epi = SKIPV;
            EpiW2 E{(bf16_t*)(ws + WS_Y2), args.in[20] + (size_t)l * NE * DM, (const float*)(ws + WS_CS2) + (size_t)l * NE * DM};
            STAGGER(9); pg8::gemm_phase<EpiW2, MoeOrder, false, true>(F.lds, g, S, E, F.wave);
            if (BOTH(pb + 7)) GRID_BAR();
        }
        if (PHON(10) && EXOK(10) && IN(pb + 8)) REP(10) { PH_BEGIN();
            (void)moe_tables(F, (unsigned*)(ws + WS_CTL) + CW_CNT + l * 32 * 64);
            p10_combine(F, args, l, (bf16_t*)(ws + WS_X), args.out, (const bf16_t*)(ws + WS_Y2), (const unsigned*)(ws + WS_TOKINFO), (const float*)(ws + WS_MOD), (signed char*)(ws + WS_H), (float*)(ws + WS_RS));
            if (BOTH(pb + 8)) GRID_BAR();
        }
    }
#undef PH_BEGIN
#undef IN
#undef BOTH
#undef GRID_BAR
}

extern "C" void kernel_launch(void* const* d_in, const int* in_sizes, int n_in, void* d_out, int out_size, void* d_ws, size_t ws_size, hipStream_t stream) {
    static int grid = 0;
    if (grid == 0) {
        if (n_in != 21 || out_size != MTOK * DM || ws_size < WS_END) { fprintf(stderr, "kernel_launch: unexpected shapes (n_in %d, out %d, ws %zu); nothing launched\n", n_in, out_size, ws_size); grid = -1; return; }
        int dev = 0, cus = 0, per_cu = 0;
        if (hipGetDevice(&dev) != hipSuccess || hipDeviceGetAttribute(&cus, hipDeviceAttributeMultiprocessorCount, dev) != hipSuccess) { grid = -1; return; }
        if (hipFuncSetAttribute((const void*)fwd, hipFuncAttributeMaxDynamicSharedMemorySize, LDS_BYTES) != hipSuccess) { fprintf(stderr, "kernel_launch: hipFuncSetAttribute failed\n"); grid = -1; return; }
        if (hipOccupancyMaxActiveBlocksPerMultiprocessor(&per_cu, (const void*)fwd, 512, LDS_BYTES) != hipSuccess || per_cu < 1) { fprintf(stderr, "kernel_launch: occupancy query says %d\n", per_cu); }
        (void)hipGetLastError();
        grid = cus > 256 ? 256 : cus;
    }
    if (grid < 0) return;
    (void)hipMemsetAsync((char*)d_ws + WS_CTL, 0, CTL_ZERO_BYTES, stream);
    Args a{};
    for (int i = 0; i < 21; ++i) a.in[i] = (const float*)d_in[i];
    a.out = (float*)d_out; a.ws = (unsigned char*)d_ws;
#if MK_ONE_LAUNCH
    a.ph_lo = 0; a.ph_hi = N_PHASES;
    hipLaunchKernelGGL(fwd, dim3(grid), dim3(512), LDS_BYTES, stream, a);
#else
    for (int p = 0; p < N_PHASES; ++p) { a.ph_lo = p; a.ph_hi = p + 1; hipLaunchKernelGGL(fwd, dim3(grid), dim3(512), LDS_BYTES, stream, a); }
#endif
}
```
